# Optimizing an MI355X kernel written in HIP

```python
import jax, jax.numpy as jnp
from jax import lax
import numpy as np

D_MODEL = 2048
BATCH = 8
SEQ = 4096
DEPTH = 2

MLA_HEADS = 8
MLA_NOPE = 128
MLA_ROPE = 64
MLA_QK = MLA_NOPE + MLA_ROPE
MLA_V = 128
MLA_Q_RANK = 512
MLA_KV_RANK = 512
MLA_WIDTH = MLA_HEADS * MLA_V
ROPE_THETA = 10000.0
Q_BLOCK = 128
SGU_GROUPS = 8
SGU_CHUNK = 128
SGU_WIDTH = 1024
SGU_GROUP_DIM = SGU_WIDTH // SGU_GROUPS
GLA_HEADS = 4
GLA_DK = 128
GLA_DV = 256
GLA_GATE_RANK = 16
GLA_TAU = 16.0
GLA_CHUNK = 128
GLA_WIDTH = GLA_HEADS * GLA_DV
N_BRANCH = 3
BRANCH_WIDTH = 1024
EPS = 1e-6

IN_SIZES = (MLA_Q_RANK, MLA_KV_RANK, MLA_ROPE, MLA_WIDTH,
            SGU_WIDTH, SGU_WIDTH, SGU_WIDTH,
            GLA_HEADS * GLA_DK, GLA_HEADS * GLA_DK, GLA_WIDTH, GLA_GATE_RANK, GLA_WIDTH,
            N_BRANCH * D_MODEL)
IN_COLS = sum(IN_SIZES)
IN_SPLITS = tuple(int(c) for c in np.cumsum(IN_SIZES)[:-1])

kernel_name = "hybrid_mla_sgu_gla_gated_merge"


def rms_norm(x, g):
    xf = x.astype(jnp.float32)
    y = xf * lax.rsqrt(jnp.mean(xf * xf, axis=-1, keepdims=True) + EPS)
    return (y * g.astype(jnp.float32)).astype(x.dtype)


def rope_tables(positions, dtype):
    inv_freq = 1.0 / (ROPE_THETA ** (jnp.arange(0, MLA_ROPE, 2, dtype=jnp.float32) / MLA_ROPE))
    ang = positions.astype(jnp.float32)[..., None] * inv_freq
    return jnp.cos(ang).astype(dtype)[:, :, None, :], jnp.sin(ang).astype(dtype)[:, :, None, :]


def apply_rope(x, cos, sin):
    half = x.shape[-1] // 2
    x1, x2 = x[..., :half], x[..., half:]
    return jnp.concatenate([x1 * cos - x2 * sin, x2 * cos + x1 * sin], axis=-1)


def causal_block_attention(q, k, v):
    S = q.shape[1]
    scale = MLA_QK ** -0.5
    neg = jnp.finfo(jnp.float32).min
    outs = []
    for i in range(S // Q_BLOCK):
        q0, q1 = i * Q_BLOCK, (i + 1) * Q_BLOCK
        qb, kb, vb = q[:, q0:q1], k[:, :q1], v[:, :q1]
        s = jnp.einsum('bqhd,bkhd->bhqk', qb, kb).astype(jnp.float32) * scale
        mask = (q0 + jnp.arange(Q_BLOCK))[:, None] >= jnp.arange(q1)[None, :]
        p = jax.nn.softmax(jnp.where(mask, s, neg), axis=-1).astype(v.dtype)
        outs.append(jnp.einsum('bhqk,bkhd->bqhd', p, vb))
    return jnp.concatenate(outs, axis=1)


def mla_branch(c_q, c_kv, k_rope, cq_g, ckv_g, w_uq, w_ukv, q_g, k_g, cos, sin):
    B, S, _ = c_q.shape
    q = (rms_norm(c_q, cq_g) @ w_uq).reshape(B, S, MLA_HEADS, MLA_QK)
    kv = (rms_norm(c_kv, ckv_g) @ w_ukv).reshape(B, S, MLA_HEADS, MLA_NOPE + MLA_V)
    k_nope, v = kv[..., :MLA_NOPE], kv[..., MLA_NOPE:]
    k = jnp.concatenate([k_nope, jnp.broadcast_to(k_rope[:, :, None, :], (B, S, MLA_HEADS, MLA_ROPE))], axis=-1)
    q = rms_norm(q, q_g)
    k = rms_norm(k, k_g)
    q = jnp.concatenate([q[..., :MLA_NOPE], apply_rope(q[..., MLA_NOPE:], cos, sin)], axis=-1)
    k = jnp.concatenate([k[..., :MLA_NOPE], apply_rope(k[..., MLA_NOPE:], cos, sin)], axis=-1)
    o = causal_block_attention(q, k, v)
    return o.reshape(B, S, MLA_WIDTH)


def sgu_branch(u, v, v_g, w_s, b_s):
    B, S, _ = u.shape
    nc = S // SGU_CHUNK
    v = rms_norm(v, v_g).reshape(B, nc, SGU_CHUNK, SGU_GROUPS, SGU_GROUP_DIM)
    mix = jnp.einsum('gts,bcsgd->bctgd', jnp.tril(w_s), v) + b_s.T[:, :, None]
    return u * mix.reshape(B, S, SGU_WIDTH)


def gla_branch(q, k, v, a_r, w_a2, b_a, o_g):
    B, S, _ = q.shape
    nc = S // GLA_CHUNK
    L = GLA_CHUNK
    log_a = jax.nn.log_sigmoid((a_r @ w_a2 + b_a).astype(jnp.float32)) / GLA_TAU

    def chunks(t, d):
        return t.reshape(B, nc, L, GLA_HEADS, d).transpose(1, 0, 3, 2, 4)

    qc = chunks(q.astype(jnp.float32) * GLA_DK ** -0.5, GLA_DK)
    kc = chunks(k.astype(jnp.float32), GLA_DK)
    vc = chunks(v.astype(jnp.float32), GLA_DV)
    bc = jnp.cumsum(chunks(log_a, GLA_DK), axis=3)
    mask = jnp.tril(jnp.ones((L, L), dtype=bool))[:, :, None]

    def step(state, inp):
        q_, k_, v_, b_ = inp
        o_inter = jnp.einsum('bhtk,bhkv->bhtv', q_ * jnp.exp(b_), state)
        diff = b_[:, :, :, None, :] - b_[:, :, None, :, :]
        decay = jnp.where(mask, jnp.exp(jnp.where(mask, diff, 0.0)), 0.0)
        attn = jnp.einsum('bhtk,bhtsk,bhsk->bhts', q_, decay, k_)
        o = o_inter + jnp.einsum('bhts,bhsv->bhtv', attn, v_)
        b_last = b_[:, :, -1:, :]
        new_state = jnp.exp(b_last[:, :, 0, :])[..., None] * state + \
            jnp.einsum('bhsk,bhsv->bhkv', k_ * jnp.exp(b_last - b_), v_)
        return new_state, o

    state0 = jnp.zeros((B, GLA_HEADS, GLA_DK, GLA_DV), jnp.float32)
    _, o = lax.scan(step, state0, (qc, kc, vc, bc))
    o = o.transpose(1, 0, 3, 2, 4).reshape(B, S, GLA_HEADS, GLA_DV)
    o = rms_norm(o, o_g).astype(v.dtype)
    return o.reshape(B, S, GLA_WIDTH)


def hybrid_layer(x, cos, sin, norm_g, w_in, cq_g, ckv_g, w_uq, w_ukv, q_g, k_g,
                 v_g, w_s, b_s, w_a2, b_a, o_g, w_branch, w_out):
    B, S, D = x.shape
    h = rms_norm(x, norm_g)
    proj = h @ w_in
    (c_q, c_kv, k_rope, z_a, u_b, v_b, z_b, q_c, k_c, v_c, a_r, z_c, gate_logits) = \
        jnp.split(proj, IN_SPLITS, axis=-1)
    y_a = mla_branch(c_q, c_kv, k_rope, cq_g, ckv_g, w_uq, w_ukv, q_g, k_g, cos, sin) * jax.nn.silu(z_a)
    y_b = sgu_branch(jax.nn.gelu(u_b), jax.nn.gelu(v_b), v_g, w_s, b_s) * jax.nn.silu(z_b)
    y_c = gla_branch(q_c, k_c, v_c, a_r, w_a2, b_a, o_g) * jax.nn.silu(z_c)
    g = jax.nn.sigmoid(gate_logits.astype(jnp.float32)).astype(x.dtype).reshape(B, S, N_BRANCH, D)
    merged = (g[:, :, 0] * (y_a @ w_branch[0])
              + g[:, :, 1] * (y_b @ w_branch[1])
              + g[:, :, 2] * (y_c @ w_branch[2]))
    return x + merged @ w_out


def setup_inputs(seed: int = 0) -> dict:
    key = jax.random.key(seed)
    ks = jax.random.split(key, 20)
    f32 = jnp.float32

    def nrm(k, shape, fan_in, mult=1.0):
        return jax.random.normal(k, shape, f32) * (fan_in ** -0.5) * mult

    def gain(k, shape):
        return 1.0 + 0.02 * jax.random.normal(k, shape, f32)

    x = jax.random.normal(ks[0], (BATCH, SEQ, D_MODEL), f32)
    offset = jax.random.randint(ks[1], (BATCH, 1), 0, SEQ, dtype=jnp.int32)
    positions = (offset + jnp.arange(SEQ, dtype=jnp.int32)[None, :]).astype(jnp.int32)
    return {
        "x": x,
        "positions": positions,
        "norm_g": gain(ks[2], (DEPTH, D_MODEL)),
        "w_in": nrm(ks[3], (DEPTH, D_MODEL, IN_COLS), D_MODEL),
        "mla_cq_norm": gain(ks[4], (DEPTH, MLA_Q_RANK)),
        "mla_ckv_norm": gain(ks[5], (DEPTH, MLA_KV_RANK)),
        "mla_w_uq": nrm(ks[6], (DEPTH, MLA_Q_RANK, MLA_HEADS * MLA_QK), MLA_Q_RANK),
        "mla_w_ukv": nrm(ks[7], (DEPTH, MLA_KV_RANK, MLA_HEADS * (MLA_NOPE + MLA_V)), MLA_KV_RANK),
        "mla_q_norm": gain(ks[8], (DEPTH, MLA_QK)),
        "mla_k_norm": gain(ks[9], (DEPTH, MLA_QK)),
        "sgu_v_norm": gain(ks[10], (DEPTH, SGU_WIDTH)),
        "sgu_w_s": nrm(ks[11], (DEPTH, SGU_GROUPS, SGU_CHUNK, SGU_CHUNK), SGU_CHUNK),
        "sgu_b_s": 1.0 + 0.02 * jax.random.normal(ks[12], (DEPTH, SGU_GROUPS, SGU_CHUNK), f32),
        "gla_w_a2": nrm(ks[13], (DEPTH, GLA_GATE_RANK, GLA_HEADS * GLA_DK), GLA_GATE_RANK),
        "gla_b_a": 0.1 * jax.random.normal(ks[14], (DEPTH, GLA_HEADS * GLA_DK), f32),
        "gla_o_norm": gain(ks[15], (DEPTH, GLA_DV)),
        "w_branch": nrm(ks[16], (DEPTH, N_BRANCH, BRANCH_WIDTH, D_MODEL), BRANCH_WIDTH),
        "w_out": nrm(ks[17], (DEPTH, D_MODEL, D_MODEL), D_MODEL, 0.5),
    }


def reference(x, positions, norm_g, w_in, mla_cq_norm, mla_ckv_norm, mla_w_uq, mla_w_ukv,
              mla_q_norm, mla_k_norm, sgu_v_norm, sgu_w_s, sgu_b_s, gla_w_a2, gla_b_a,
              gla_o_norm, w_branch, w_out):
    cos, sin = rope_tables(positions, x.dtype)
    for l in range(DEPTH):
        x = hybrid_layer(x, cos, sin, norm_g[l], w_in[l], mla_cq_norm[l], mla_ckv_norm[l],
                         mla_w_uq[l], mla_w_ukv[l], mla_q_norm[l], mla_k_norm[l],
                         sgu_v_norm[l], sgu_w_s[l], sgu_b_s[l], gla_w_a2[l], gla_b_a[l],
                         gla_o_norm[l], w_branch[l], w_out[l])
    return x
```

```cpp
#include <hip/hip_runtime.h>
#include <cstdio>
#include <cstdint>
namespace pg8 {
#define PG8_LAS __attribute__((address_space(3)))
typedef unsigned short bf16_t;
typedef short bf16x8 __attribute__((ext_vector_type(8)));
typedef float f32x4 __attribute__((ext_vector_type(4)));
typedef unsigned u32x4 __attribute__((ext_vector_type(4)));
constexpr int BM = 256, BK = 64, HALF = 128, HTB = HALF * BK * 2  , STAGE_BYTES = 8 * HTB, NXCD = 8, WGM = 8;

__host__ __device__ __forceinline__ int lds_byte(int r, int c) { const int st = (r >> 4) * 2 + (c >> 5), rr = r & 15, cc = c & 31, ob = rr * 64 + cc * 2; return st * 1024 + (ob ^ (((ob >> 9) & 1) << 5)); }
__host__ __device__ __forceinline__ void stage_rc(int b, int& R, int& C) { const int st = b / 1024, sb = b % 1024, swz = sb ^ (((sb >> 9) & 1) << 5); R = (st >> 1) * 16 + swz / 64; C = (st & 1) * 32 + (swz % 64) / 2; }
__host__ __device__ __forceinline__ int perm32(int rho) { const int n = rho >> 4, i = rho & 15; return 8 * (i >> 2) + 4 * n + (i & 3); }

struct Unit { int pm, pn; };
struct Gemm { const bf16_t* A; const bf16_t* Bt; int M, N, K; };

struct StaticOrder {
    int nM, nN, nwg, G, c;
    __host__ __device__ void init(int M, int N, int G_, int c_) { nM = M / BM; nN = N / BM; nwg = nM * nN; G = G_; c = c_; }
    __host__ __device__ bool next(int i, Unit& u) const {
        const long L = (long)i * G + c; if (L >= nwg) return false;
        int wgid = (int)L; { const int q = nwg / NXCD, r = nwg % NXCD, xcd = wgid % NXCD, off = wgid / NXCD; wgid = (xcd < r ? xcd * (q + 1) : r * (q + 1) + (xcd - r) * q) + off; }
        const int nig = WGM * nN, gid = wgid / nig, fm = gid * WGM, gsz = (nM - fm) < WGM ? (nM - fm) : WGM;
        u.pm = fm + ((wgid % nig) % gsz); u.pn = (wgid % nig) / gsz; return true;
    }
    __device__ __forceinline__ void a_ready(const Unit&) const {}
    __device__ __forceinline__ void done(const Unit&) const {}
};

__device__ __forceinline__ unsigned cvt_pk_bf16(float lo, float hi) { unsigned r; asm volatile("v_cvt_pk_bf16_f32 %0, %1, %2" : "=v"(r) : "v"(lo), "v"(hi)); return r; }
typedef float f32x2 __attribute__((ext_vector_type(2)));
__device__ __forceinline__ f32x2 gelu_pk(f32x2 v) {
    const f32x2 av = __builtin_elementwise_abs(v), d = av * 0.2316418882f + 1.0f;
    f32x2 t; t.x = __builtin_amdgcn_rcpf(d.x); t.y = __builtin_amdgcn_rcpf(d.y);
    f32x2 q = t * 0.5307027145f + (-0.7265760135f); q = q * t + 0.7107068705f; q = q * t + (-0.142248368f); q = q * t + 0.127414796f; q = q * t;
    const f32x2 s = (v * v) * (-0.72134752044f);
    f32x2 e; e.x = __builtin_amdgcn_exp2f(s.x); e.y = __builtin_amdgcn_exp2f(s.y);
    const f32x2 m = v * (q * e), r = v - m;
    f32x2 o; o.x = v.x < 0.f ? m.x : r.x; o.y = v.y < 0.f ? m.y : r.y; return o;
}

struct EpiF32 {
    static constexpr bool PERM = false, AFTER_DRAIN = false;
    float* C; int ldc; const float* bias;
    __device__ __forceinline__ void operator()(const f32x4 (&acc)[2][2][4][2], const Unit& u, int wr, int wc, int fr, int fq) const {
        const int row0 = u.pm * BM + wr * 64 + fr, col0 = u.pn * BM + wc * 32 + 4 * fq;
        f32x4 bv[2][2];
#pragma unroll
        for (int bj = 0; bj < 2; ++bj)
#pragma unroll
            for (int n = 0; n < 2; ++n) bv[bj][n] = bias ? *(const f32x4*)(bias + col0 + bj * HALF + n * 16) : (f32x4){0.f, 0.f, 0.f, 0.f};
#pragma unroll
        for (int ai = 0; ai < 2; ++ai)
#pragma unroll
            for (int m = 0; m < 4; ++m) { float* rowp = C + (size_t)(row0 + ai * HALF + m * 16) * ldc + col0;
#pragma unroll
                for (int bj = 0; bj < 2; ++bj)
#pragma unroll
                    for (int n = 0; n < 2; ++n) *(f32x4*)(rowp + bj * HALF + n * 16) = acc[ai][bj][m][n] + bv[bj][n]; }
    }
};
template <int ACT  > struct EpiBf16 {
    static constexpr bool PERM = true, AFTER_DRAIN = false;
    bf16_t* O; int ldc; const float* bias; int split_cols; size_t split_stride;
    __device__ __forceinline__ void operator()(const f32x4 (&acc)[2][2][4][2], const Unit& u, int wr, int wc, int fr, int fq) const {
        const int row0 = u.pm * BM + wr * 64 + fr; int colt = u.pn * BM; bf16_t* base = O;
        if (split_cols) { const int t = colt / split_cols; base += (size_t)t * split_stride; colt -= t * split_cols; }
        const int col0 = colt + wc * 32 + 8 * fq, bcol0 = u.pn * BM + wc * 32 + 8 * fq;
        f32x4 bv[2][2];
#pragma unroll
        for (int bj = 0; bj < 2; ++bj)
#pragma unroll
            for (int n = 0; n < 2; ++n) bv[bj][n] = bias ? *(const f32x4*)(bias + bcol0 + bj * HALF + 4 * n) : (f32x4){0.f, 0.f, 0.f, 0.f};
#pragma unroll
        for (int ai = 0; ai < 2; ++ai)
#pragma unroll
            for (int m = 0; m < 4; ++m) { bf16_t* rowp = base + (size_t)(row0 + ai * HALF + m * 16) * ldc + col0;
#pragma unroll
                for (int bj = 0; bj < 2; ++bj) { f32x4 v0 = acc[ai][bj][m][0] + bv[bj][0], v1 = acc[ai][bj][m][1] + bv[bj][1];
                    if (ACT == 1) { f32x2 a = gelu_pk((f32x2){v0[0], v0[1]}), b = gelu_pk((f32x2){v0[2], v0[3]}), c = gelu_pk((f32x2){v1[0], v1[1]}), d = gelu_pk((f32x2){v1[2], v1[3]});
                        v0 = (f32x4){a.x, a.y, b.x, b.y}; v1 = (f32x4){c.x, c.y, d.x, d.y}; }
                    if (ACT == 2) {
#pragma unroll
                        for (int j = 0; j < 4; ++j) { v0[j] = 0.5f * v0[j] * (1.0f + erff(v0[j] * 0.70710678f)); v1[j] = 0.5f * v1[j] * (1.0f + erff(v1[j] * 0.70710678f)); } }
                    u32x4 w; w.x = cvt_pk_bf16(v0[0], v0[1]); w.y = cvt_pk_bf16(v0[2], v0[3]); w.z = cvt_pk_bf16(v1[0], v1[1]); w.w = cvt_pk_bf16(v1[2], v1[3]);
                    *(u32x4*)(rowp + bj * HALF) = w; } }
    }
};

template <class Epi, class Sched, bool STAMP = false>
__device__ __forceinline__ void gemm_phase(PG8_LAS unsigned char* lds, const Gemm g, const Sched& S, const Epi& E, unsigned long long* stamps) {
    const int tid = threadIdx.x, wid = __builtin_amdgcn_readfirstlane(tid >> 6), lane = tid & 63, wr = wid >> 2, wc = wid & 3, fr = lane & 15, fq = lane >> 4;
    const int K = g.K, nt = K / BK;
    int ts_lo = 0, ts_hi = 0, nts = 0; const unsigned long long rt_entry = STAMP ? (unsigned long long)wall_clock64() : 0ull;
#define PG8_STAMP() do { if (STAMP && wid == 0 && nts < 64) { const unsigned long long _c = (unsigned long long)clock64(); \
        ts_lo = (lane == nts) ? (int)(unsigned)_c : ts_lo; ts_hi = (lane == nts) ? (int)(unsigned)(_c >> 32) : ts_hi; ++nts; } } while (0)
    PG8_STAMP();
    unsigned voffA[2], voffB[2];
#pragma unroll
    for (int i = 0; i < 2; ++i) { int R, C; stage_rc(tid * 16 + i * 8192, R, C); const int Rb = Epi::PERM ? ((R & ~31) + perm32(R & 31)) : R;
        voffA[i] = (unsigned)(R * K + C) * 2u; voffB[i] = (unsigned)(Rb * K + C) * 2u; }
    const size_t kstep = (size_t)(BK * 2);
    const size_t hstep = (size_t)HALF * K * 2;
    const size_t tstep = 2 * hstep;
    const unsigned ldsw = (unsigned)wid * 1024u;
    const int aoff = lds_byte(wr * 64 + fr, fq * 8), boff = lds_byte(wc * 32 + fr, fq * 8);
#define PG8_SA(b, h) (((b) * 2 + (h)) * HTB)
#define PG8_SB(b, h) ((4 + (b) * 2 + (h)) * HTB)
#define PG8_STAGE(bufoff, gbase, voff) do { _Pragma("unroll") for (int _i = 0; _i < 2; ++_i) \
        __builtin_amdgcn_global_load_lds((const unsigned*)((const char*)(gbase) + (voff)[_i]), (PG8_LAS unsigned*)(lds + (bufoff) + ldsw + _i * 8192), 16, 0, 0); } while (0)
#define PG8_LDA(dst, b, h) do { _Pragma("unroll") for (int m = 0; m < 4; ++m) _Pragma("unroll") for (int k = 0; k < 2; ++k) dst[m][k] = *(const PG8_LAS bf16x8*)(lds + PG8_SA(b, h) + aoff + m * 2048 + k * 1024); } while (0)
#define PG8_LDB(dst, b, h) do { _Pragma("unroll") for (int n = 0; n < 2; ++n) _Pragma("unroll") for (int k = 0; k < 2; ++k) dst[n][k] = *(const PG8_LAS bf16x8*)(lds + PG8_SB(b, h) + boff + n * 2048 + k * 1024); } while (0)
#define PG8_MMA(ai, bj, At, Bt) do { __builtin_amdgcn_s_setprio(1); _Pragma("unroll") for (int m = 0; m < 4; ++m) _Pragma("unroll") for (int n = 0; n < 2; ++n) _Pragma("unroll") for (int k = 0; k < 2; ++k) \
        acc[ai][bj][m][n] = __builtin_amdgcn_mfma_f32_16x16x32_bf16(Bt[n][k], At[m][k], acc[ai][bj][m][n], 0, 0, 0); __builtin_amdgcn_s_setprio(0); } while (0)
#define PG8_WAIT_V(n) asm volatile("s_waitcnt vmcnt(" #n ")" ::: "memory")
#define PG8_WAIT_L(n) asm volatile("s_waitcnt lgkmcnt(" #n ")" ::: "memory")
#define PG8_BAR __builtin_amdgcn_s_barrier()
#define PG8_SCHED __builtin_amdgcn_sched_barrier(0)
    Unit cur, nxt; int ui = 0;
    if (!S.next(0, cur)) return;
    f32x4 acc[2][2][4][2];
#pragma unroll
    for (int a = 0; a < 2; ++a)
#pragma unroll
        for (int b = 0; b < 2; ++b)
#pragma unroll
            for (int m = 0; m < 4; ++m)
#pragma unroll
                for (int n = 0; n < 2; ++n) acc[a][b][m][n] = (f32x4){0.f, 0.f, 0.f, 0.f};
    bf16x8 At[4][2], B0[2][2], B1[2][2];
    const char* cA = (const char*)g.A + (size_t)cur.pm * tstep; const char* cB = (const char*)g.Bt + (size_t)cur.pn * tstep;
    S.a_ready(cur);
    PG8_STAGE(PG8_SB(0, 0), cB, voffB); PG8_STAGE(PG8_SA(0, 0), cA, voffA); PG8_STAGE(PG8_SB(0, 1), cB + hstep, voffB); PG8_STAGE(PG8_SA(0, 1), cA + hstep, voffA);
    if (wr == 1) PG8_BAR;
    PG8_WAIT_V(4); PG8_BAR;
    PG8_STAGE(PG8_SB(1, 0), cB + kstep, voffB); PG8_STAGE(PG8_SA(1, 0), cA + kstep, voffA); PG8_STAGE(PG8_SB(1, 1), cB + hstep + kstep, voffB);
    PG8_WAIT_V(6); PG8_BAR;
    PG8_STAMP();
    for (;;) {
        const bool has_next = S.next(ui + 1, nxt);
        const char* nA = has_next ? (const char*)g.A + (size_t)nxt.pm * tstep : cA; const char* nB = has_next ? (const char*)g.Bt + (size_t)nxt.pn * tstep : cB;
        for (int t = 0; t < nt; t += 2) {
            const bool last = (t == nt - 2);
            const char* a1 = cA + (size_t)(t + 1) * kstep;
            const char* a2 = last ? nA : cA + (size_t)(t + 2) * kstep; const char* b2 = last ? nB : cB + (size_t)(t + 2) * kstep;
            const char* a3 = a2 + kstep; const char* b3 = b2 + kstep;
            if (last && has_next) S.a_ready(nxt);
            PG8_LDB(B0, 0, 0); PG8_SCHED; PG8_LDA(At, 0, 0); PG8_STAGE(PG8_SA(1, 1), a1 + hstep, voffA);
            PG8_WAIT_L(8); PG8_BAR; PG8_WAIT_L(0); PG8_MMA(0, 0, At, B0); PG8_BAR; PG8_SCHED;
            PG8_LDB(B1, 0, 1); PG8_STAGE(PG8_SB(0, 0), b2, voffB);
            PG8_BAR; PG8_WAIT_L(0); PG8_MMA(0, 1, At, B1); PG8_BAR;
            PG8_LDA(At, 0, 1); PG8_STAGE(PG8_SA(0, 0), a2, voffA);
            PG8_BAR; PG8_WAIT_L(0); PG8_MMA(1, 0, At, B0); PG8_BAR; PG8_SCHED;
            PG8_STAGE(PG8_SB(0, 1), b2 + hstep, voffB);
            PG8_WAIT_V(6); PG8_BAR; PG8_MMA(1, 1, At, B1); PG8_BAR;
            PG8_LDB(B0, 1, 0); PG8_SCHED; PG8_LDA(At, 1, 0); PG8_STAGE(PG8_SA(0, 1), a2 + hstep, voffA);
            PG8_WAIT_L(8); PG8_BAR; PG8_WAIT_L(0); PG8_MMA(0, 0, At, B0); PG8_BAR; PG8_SCHED;
            PG8_LDB(B1, 1, 1); PG8_STAGE(PG8_SB(1, 0), b3, voffB);
            PG8_BAR; PG8_WAIT_L(0); PG8_MMA(0, 1, At, B1); PG8_BAR;
            PG8_LDA(At, 1, 1); PG8_STAGE(PG8_SA(1, 0), a3, voffA);
            PG8_BAR; PG8_WAIT_L(0); PG8_MMA(1, 0, At, B0); PG8_BAR; PG8_SCHED;
            PG8_STAGE(PG8_SB(1, 1), b3 + hstep, voffB);
            PG8_WAIT_V(6); PG8_BAR; PG8_MMA(1, 1, At, B1); PG8_BAR;
        }
        PG8_STAMP();
        if constexpr (!Epi::AFTER_DRAIN) { E(acc, cur, wr, wc, fr, fq); S.done(cur); }
        PG8_STAMP();
        if (!has_next) break;
#pragma unroll
        for (int a = 0; a < 2; ++a)
#pragma unroll
            for (int b = 0; b < 2; ++b)
#pragma unroll
                for (int m = 0; m < 4; ++m)
#pragma unroll
                    for (int n = 0; n < 2; ++n) acc[a][b][m][n] = (f32x4){0.f, 0.f, 0.f, 0.f};
        cur = nxt; cA = nA; cB = nB; ++ui;
    }
    PG8_WAIT_V(0);
    if (wr == 0) PG8_BAR;
    PG8_BAR;
    if constexpr (Epi::AFTER_DRAIN) { E.fused(acc, cur, wr, wc, fr, fq, lds, wid, lane); S.done(cur); }
    PG8_STAMP();
    if (STAMP && wid == 0) { stamps[lane] = lane < nts ? (((unsigned long long)(unsigned)ts_hi << 32) | (unsigned)ts_lo) : 0ull;
        if (lane == 62) stamps[62] = rt_entry; if (lane == 63) stamps[63] = (unsigned long long)wall_clock64(); }
#undef PG8_STAMP
#undef PG8_SA
#undef PG8_SB
#undef PG8_STAGE
#undef PG8_LDA
#undef PG8_LDB
#undef PG8_MMA
#undef PG8_WAIT_V
#undef PG8_WAIT_L
#undef PG8_BAR
#undef PG8_SCHED
}
}
#define XB_TMO      128
#define XB_XCNT(j)  (256  + 64 * (j))
#define XB_XSUB(j)  (1280 + 64 * (j))
#define XB_XGEN(j)  (2304 + 64 * (j))
#define XB_TOP      3328
#define XB_TOPGEN   3392
#define XCD_BAR_WORDS 3456
#define XB_SPIN_CAP (1u << 18)
#define LAS __attribute__((address_space(3)))

__device__ __forceinline__ unsigned xb_ld(unsigned* p)              { return __hip_atomic_load(p, __ATOMIC_RELAXED, __HIP_MEMORY_SCOPE_AGENT); }
__device__ __forceinline__ unsigned xb_add(unsigned* p, unsigned v) { return __hip_atomic_fetch_add(p, v, __ATOMIC_RELAXED, __HIP_MEMORY_SCOPE_AGENT); }
__device__ __forceinline__ unsigned xb_xcc_id() { return (unsigned)__builtin_amdgcn_s_getreg((3 << 11) | 20) & 0xFu; }
#define XB_SPIN(cond, bar) do { unsigned _sp = 0; while (cond) { __builtin_amdgcn_s_sleep(1); \
    if ((++_sp & 255u) == 0u) { if (xb_ld(&(bar)[XB_TMO])) break; if (_sp > XB_SPIN_CAP) { atomicAdd(&(bar)[XB_TMO], 1u); break; } } } } while (0)

struct XcdBarrier {
    unsigned* bar; unsigned x;
    volatile LAS unsigned* st;
};

__device__ __forceinline__ XcdBarrier xcd_barrier_post(unsigned* bar, volatile LAS unsigned* st) {
    XcdBarrier b; b.bar = bar; b.x = xb_xcc_id(); b.st = st;
    if (threadIdx.x == 0) (void)xb_add(&bar[XB_XCNT(b.x)], 1u);
    return b;
}
__device__ __forceinline__ void xcd_barrier_complete(unsigned* bar, unsigned x, unsigned& nloc, unsigned& nx) {
    const unsigned G = gridDim.x * gridDim.y * gridDim.z;
    unsigned sum, cnt, mine, sp = 0u;
    for (;;) {
        sum = 0u; cnt = 0u; mine = 0u;
#pragma unroll
        for (unsigned j = 0; j < 16; ++j) { const unsigned c = xb_ld(&bar[XB_XCNT(j)]); sum += c; cnt += (c > 0u) ? 1u : 0u; mine = (j == x) ? c : mine; }
        if (sum == G) break;
        __builtin_amdgcn_s_sleep(1);
        if ((++sp & 255u) == 0u) { if (xb_ld(&bar[XB_TMO])) break; if (sp > XB_SPIN_CAP) { atomicAdd(&bar[XB_TMO], 1u); break; } }
    }
    nloc = mine > 0u ? mine : 1u; nx = cnt > 0u ? cnt : 1u;
}

__device__ __forceinline__ void xcd_barrier(const XcdBarrier& b) {
    asm volatile("s_waitcnt vmcnt(0)" ::: "memory");
    __syncthreads();
    if (threadIdx.x == 0) {
        unsigned* bar = b.bar;
        __builtin_amdgcn_s_waitcnt(0);
        unsigned nloc = b.st[0], nx = b.st[1];
        if (nloc == 0u) { xcd_barrier_complete(bar, b.x, nloc, nx); b.st[0] = nloc; b.st[1] = nx; }
        const unsigned old = xb_add(&bar[XB_XSUB(b.x)], 1u);
        const unsigned gen = old / nloc;
        if (old + 1u == (gen + 1u) * nloc) {
            __builtin_amdgcn_fence(__ATOMIC_RELEASE, "agent");
            asm volatile("s_waitcnt vmcnt(0)" ::: "memory");
            const unsigned og = xb_add(&bar[XB_TOP], 1u);
            const unsigned tg = og / nx;
            if (og + 1u == (tg + 1u) * nx) xb_add(&bar[XB_TOPGEN], 1u);
            else XB_SPIN(xb_ld(&bar[XB_TOPGEN]) == tg, bar);
            __builtin_amdgcn_fence(__ATOMIC_ACQUIRE, "agent");
            xb_add(&bar[XB_XGEN(b.x)], 1u);
            asm volatile("s_waitcnt vmcnt(0)" ::: "memory");
        } else {
            XB_SPIN(xb_ld(&bar[XB_XGEN(b.x)]) == gen, bar);
            __builtin_amdgcn_fence(__ATOMIC_ACQUIRE, "agent");
            asm volatile("s_waitcnt vmcnt(0)" ::: "memory");
        }
    }
    __syncthreads();
}


typedef unsigned short bf16;
typedef unsigned v4u __attribute__((ext_vector_type(4)));
typedef unsigned v2u __attribute__((ext_vector_type(2)));
typedef float v4f __attribute__((ext_vector_type(4)));

constexpr int DM = 2048, NBATCH = 8, SEQ = 4096, DEPTH = 2, MTOK = NBATCH * SEQ;
constexpr int IN_COLS = 14416, NPROJ = 14592;
constexpr int C_CQ = 0, C_CKV = 512, C_ZA = 1024, C_UB = 2048, C_VB = 3072, C_ZB = 4096, C_QC = 5120, C_KC = 5632, C_VC = 6144, C_ZC = 7168,
              C_GATE = 8192, C_KROPE = 14336, C_AR = 14400;
constexpr float EPS = 1e-6f;
#ifndef NBP
#define NBP 2
#endif
constexpr int MP = NBP * SEQ, NPASS = NBATCH / NBP;
constexpr int STEPS_PER_PASS = 13;
constexpr int NSTEPS = 1 + DEPTH * NPASS * STEPS_PER_PASS;

constexpr size_t al256(size_t x) { return (x + 255) & ~(size_t)255; }
constexpr size_t WS_CTL = 0, CTL_BYTES = 1u << 20;
constexpr size_t SZ_WIN = (size_t)NPROJ * DM * 2, SZ_WUQ = (size_t)1536 * 512 * 2, SZ_WUKV = (size_t)2048 * 512 * 2, SZ_WB = (size_t)3 * 2048 * 1024 * 2, SZ_WO = (size_t)2048 * 2048 * 2;
constexpr size_t SZ_WLAYER = SZ_WIN + SZ_WUQ + SZ_WUKV + SZ_WB + SZ_WO;
constexpr size_t WS_W = CTL_BYTES;
constexpr size_t WS_COS = WS_W + DEPTH * SZ_WLAYER, WS_SIN = WS_COS + (size_t)MTOK * 32 * 4;
constexpr size_t WS_H = WS_SIN + (size_t)MTOK * 32 * 4;
constexpr size_t WS_PROJ = WS_H + (size_t)MP * DM * 2;
constexpr size_t WS_CQN = WS_PROJ + (size_t)MP * NPROJ * 2;
constexpr size_t WS_CKVN = WS_CQN + (size_t)MP * 512 * 2;
constexpr size_t WS_RV = WS_CKVN + (size_t)MP * 512 * 2;
constexpr size_t WS_Q = WS_RV + al256((size_t)MP * 4);
constexpr size_t WS_KV = WS_Q + (size_t)MP * 1536 * 2;
constexpr size_t WS_K = WS_KV + (size_t)MP * 2048 * 2;
constexpr size_t WS_YA = WS_K + (size_t)MP * 1536 * 2;
constexpr size_t WS_YB = WS_YA + (size_t)MP * 1024 * 2;
constexpr size_t WS_YC = WS_YB + (size_t)MP * 1024 * 2;
constexpr size_t WS_OC = WS_YC + (size_t)MP * 1024 * 2;
constexpr size_t WS_PB = WS_OC + (size_t)MP * 1024 * 4;
constexpr size_t WS_MG = WS_PB + (size_t)3 * MP * 2048 * 2;
constexpr size_t WS_U = WS_MG + (size_t)MP * 2048 * 2;
constexpr size_t WS_END = WS_U + (size_t)MP * 2048 * 4;
static_assert(WS_END <= ((size_t)1 << 30), "workspace map exceeds 1 GiB");

constexpr int LDS_BYTES = 147456;
constexpr int LDSCTL_OFF = LDS_BYTES - 256;
constexpr int CW_BAR = 4096;

__device__ __forceinline__ float bf2f(unsigned v) { return __uint_as_float(v << 16); }
__device__ __forceinline__ unsigned f2bf(float f) { unsigned u = __float_as_uint(f); return (u + 0x7fffu + ((u >> 16) & 1u)) >> 16; }
__device__ __forceinline__ unsigned pk2(float lo, float hi) { return f2bf(lo) | (f2bf(hi) << 16); }
__device__ __forceinline__ float lo16(unsigned w) { return __uint_as_float(w << 16); }
__device__ __forceinline__ float hi16(unsigned w) { return __uint_as_float(w & 0xffff0000u); }
__device__ __forceinline__ float sigmoid_f(float x) { return 1.f / (1.f + __expf(-x)); }
__device__ __forceinline__ float silu_f(float x) { return x / (1.f + __expf(-x)); }
__device__ __forceinline__ float gelu_f(float x) { const float u = 0.7978845608028654f * (x + 0.044715f * x * x * x); return 0.5f * x * (1.f + tanhf(u)); }
__device__ __forceinline__ float wave_sum(float v) {
#pragma unroll
    for (int o = 32; o >= 1; o >>= 1) v += __shfl_xor(v, o);
    return v; }
__device__ __forceinline__ float wave_max(float v) {
#pragma unroll
    for (int o = 32; o >= 1; o >>= 1) v = fmaxf(v, __shfl_xor(v, o));
    return v; }
#define LDS_FENCE() asm volatile("s_waitcnt lgkmcnt(0)" ::: "memory")

struct Args { const void* in[18]; float* out; unsigned char* ws; int lo, hi, pad0, pad1; };

template <int MODE> __device__ __forceinline__ int src_col(int n) {
    if (MODE == 0) return n;
    if (n < C_ZA) return n;
    if (n < C_ZC) return n + 64;
    if (n < C_KROPE) return n + 80;
    if (n < C_AR) return 1024 + (n - C_KROPE);
    if (n < C_AR + 16) return 7232 + (n - C_AR);
    return -1;
}
template <int MODE> __device__ __forceinline__ void convert_T(const float* W, int K, int Nsrc, bf16* WT, int Ndst, LAS float* tile, int vb, int nvb) {
    const int tid = threadIdx.x, ntk = K / 64, ntn = Ndst / 64, ntiles = ntk * ntn;
    for (int t = vb; t < ntiles; t += nvb) {
        const int k0 = (t % ntk) * 64, n0 = (t / ntk) * 64;
        { const int nn = tid & 63, sc = src_col<MODE>(n0 + nn);
#pragma unroll
          for (int i = 0; i < 8; ++i) { const int kk = (tid >> 6) + 8 * i; tile[kk * 65 + nn] = sc >= 0 ? W[(size_t)(k0 + kk) * Nsrc + sc] : 0.f; } }
        __syncthreads();
        { const int kk = tid & 63;
#pragma unroll
          for (int i = 0; i < 8; ++i) { const int nn = (tid >> 6) + 8 * i; WT[(size_t)(n0 + nn) * K + k0 + kk] = (bf16)f2bf(tile[kk * 65 + nn]); } }
        __syncthreads();
    }
}

__device__ __forceinline__ void ph_norm(const float* xin, const float* g, bf16* h, int rows, int vb, int nvb) {
    const int lane = threadIdx.x & 63, wave = threadIdx.x >> 6;
    for (int r = vb * 8 + wave; r < rows; r += nvb * 8) {
        const v4f* xr = (const v4f*)(xin + (size_t)r * DM);
        v4f v[8]; float ss = 0.f;
#pragma unroll
        for (int j = 0; j < 8; ++j) { v[j] = xr[lane + 64 * j]; ss += v[j].x * v[j].x + v[j].y * v[j].y + v[j].z * v[j].z + v[j].w * v[j].w; }
        ss = wave_sum(ss);
        const float rn = 1.0f / sqrtf(ss * (1.0f / DM) + EPS);
#pragma unroll
        for (int j = 0; j < 8; ++j) { const v4f gg = ((const v4f*)g)[lane + 64 * j];
            v2u o; o.x = pk2(v[j].x * rn * gg.x, v[j].y * rn * gg.y); o.y = pk2(v[j].z * rn * gg.z, v[j].w * rn * gg.w);
            *(v2u*)(h + (size_t)r * DM + (lane + 64 * j) * 4) = o; }
    }
}
__device__ __forceinline__ void ph_prep(const bf16* proj, const float* gq, const float* gkv, bf16* cqn, bf16* ckvn, float* rv, int vb, int nvb) {
    const int lane = threadIdx.x & 63, wave = threadIdx.x >> 6;
    for (int r = vb * 8 + wave; r < MP; r += nvb * 8) {
        const bf16* pr = proj + (size_t)r * NPROJ;
#pragma unroll
        for (int which = 0; which < 2; ++which) {
            const v4u w = *(const v4u*)(pr + (which ? C_CKV : C_CQ) + lane * 8);
            float x[8] = {lo16(w.x), hi16(w.x), lo16(w.y), hi16(w.y), lo16(w.z), hi16(w.z), lo16(w.w), hi16(w.w)};
            float ss = 0.f;
#pragma unroll
            for (int i = 0; i < 8; ++i) ss += x[i] * x[i];
            ss = wave_sum(ss);
            const float rn = 1.0f / sqrtf(ss * (1.0f / 512.f) + EPS);
            const float* g = (which ? gkv : gq) + lane * 8;
            v4u o; o.x = pk2(x[0] * rn * g[0], x[1] * rn * g[1]); o.y = pk2(x[2] * rn * g[2], x[3] * rn * g[3]); o.z = pk2(x[4] * rn * g[4], x[5] * rn * g[5]); o.w = pk2(x[6] * rn * g[6], x[7] * rn * g[7]);
            *(v4u*)((which ? ckvn : cqn) + (size_t)r * 512 + lane * 8) = o;
        }
        float ss = 0.f;
#pragma unroll
        for (int j = 0; j < 2; ++j) { const v4u w = *(const v4u*)(pr + C_VB + (lane + 64 * j) * 8);
            const float x[8] = {lo16(w.x), hi16(w.x), lo16(w.y), hi16(w.y), lo16(w.z), hi16(w.z), lo16(w.w), hi16(w.w)};
#pragma unroll
            for (int i = 0; i < 8; ++i) { const float gv = gelu_f(x[i]); ss += gv * gv; } }
        ss = wave_sum(ss);
        if (lane == 0) rv[r] = 1.0f / sqrtf(ss * (1.0f / 1024.f) + EPS);
    }
}
__device__ __forceinline__ void ph_qkfin(bf16* q, const bf16* kv, const bf16* proj, bf16* K, const float* qg, const float* kg, const float* cosT, const float* sinT, int row0, int vb, int nvb) {
    const int lane = threadIdx.x & 63, wave = threadIdx.x >> 6;
    for (int it = vb * 8 + wave; it < MP * 8; it += nvb * 8) {
        const int r = it >> 3, hd = it & 7;
        const float c = cosT[(size_t)(row0 + r) * 32 + (lane & 31)], s = sinT[(size_t)(row0 + r) * 32 + (lane & 31)];
        {   bf16* qp = q + ((size_t)r * 8 + hd) * 192;
            const float v0 = bf2f(qp[lane]), v1 = bf2f(qp[lane + 64]), v2 = bf2f(qp[lane + 128]);
            const float ss = wave_sum(v0 * v0 + v1 * v1 + v2 * v2);
            const float rn = 1.0f / sqrtf(ss * (1.0f / 192.f) + EPS);
            const float n0 = v0 * rn * qg[lane], n1 = v1 * rn * qg[lane + 64], n2 = v2 * rn * qg[lane + 128];
            const float pn = __shfl_xor(n2, 32);
            const float o2 = lane < 32 ? n2 * c - pn * s : n2 * c + pn * s;
            qp[lane] = (bf16)f2bf(n0); qp[lane + 64] = (bf16)f2bf(n1); qp[lane + 128] = (bf16)f2bf(o2); }
        {   const bf16* kp = kv + (size_t)r * 2048 + hd * 256;
            const float v0 = bf2f(kp[lane]), v1 = bf2f(kp[lane + 64]), v2 = bf2f(proj[(size_t)r * NPROJ + C_KROPE + lane]);
            const float ss = wave_sum(v0 * v0 + v1 * v1 + v2 * v2);
            const float rn = 1.0f / sqrtf(ss * (1.0f / 192.f) + EPS);
            const float n0 = v0 * rn * kg[lane], n1 = v1 * rn * kg[lane + 64], n2 = v2 * rn * kg[lane + 128];
            const float pn = __shfl_xor(n2, 32);
            const float o2 = lane < 32 ? n2 * c - pn * s : n2 * c + pn * s;
            bf16* ko = K + ((size_t)r * 8 + hd) * 192;
            ko[lane] = (bf16)f2bf(n0); ko[lane + 64] = (bf16)f2bf(n1); ko[lane + 128] = (bf16)f2bf(o2); }
    }
}
__device__ __forceinline__ void ph_attn_naive(const bf16* Q, const bf16* K, const bf16* KV, const bf16* proj, bf16* YA, LAS float* lds, int vb, int nvb) {
    const int lane = threadIdx.x & 63, wave = threadIdx.x >> 6;
    LAS float* qs = lds + wave * (4096 + 192); LAS float* ps = qs + 192;
    const float scale = 0.07216878364870322f;
    for (int it = vb * 8 + wave; it < NBP * 8 * SEQ; it += nvb * 8) {
        const int t = it % SEQ, bh = it / SEQ, h = bh & 7, b = bh >> 3, r = b * SEQ + t;
        { const bf16* qp = Q + ((size_t)r * 8 + h) * 192; qs[lane] = bf2f(qp[lane]); qs[lane + 64] = bf2f(qp[lane + 64]); qs[lane + 128] = bf2f(qp[lane + 128]); }
        LDS_FENCE();
        float m = -3.0e38f;
        for (int j = lane; j <= t; j += 64) {
            const v4u* kr = (const v4u*)(K + ((size_t)(b * SEQ + j) * 8 + h) * 192);
            float s = 0.f;
#pragma unroll 4
            for (int c = 0; c < 24; ++c) { const v4u w = kr[c]; const LAS float* qq = qs + c * 8;
                s += qq[0] * lo16(w.x) + qq[1] * hi16(w.x) + qq[2] * lo16(w.y) + qq[3] * hi16(w.y) + qq[4] * lo16(w.z) + qq[5] * hi16(w.z) + qq[6] * lo16(w.w) + qq[7] * hi16(w.w); }
            s *= scale; ps[j] = s; m = fmaxf(m, s);
        }
        m = wave_max(m);
        float l = 0.f;
        for (int j = lane; j <= t; j += 64) { const float p = __expf(ps[j] - m); ps[j] = p; l += p; }
        l = wave_sum(l);
        LDS_FENCE();
        float a0 = 0.f, a1 = 0.f;
        const bf16* vp = KV + (size_t)(b * SEQ) * 2048 + h * 256 + 128 + 2 * lane;
        for (int j = 0; j <= t; ++j) { const float p = ps[j]; const unsigned w = *(const unsigned*)(vp + (size_t)j * 2048); a0 += p * lo16(w); a1 += p * hi16(w); }
        const float inv = 1.0f / l;
        const unsigned zw = *(const unsigned*)(proj + (size_t)r * NPROJ + C_ZA + h * 128 + 2 * lane);
        *(unsigned*)(YA + (size_t)r * 1024 + h * 128 + 2 * lane) = pk2(a0 * inv * silu_f(lo16(zw)), a1 * inv * silu_f(hi16(zw)));
        LDS_FENCE();
    }
}
__device__ __forceinline__ void ph_sgu_naive(const bf16* proj, const float* rv, const float* Ws, const float* bs, const float* vg, bf16* YB, int vb, int nvb) {
    for (size_t idx = (size_t)vb * 512 + threadIdx.x; idx < (size_t)MP * 1024; idx += (size_t)nvb * 512) {
        const int r = (int)(idx >> 10), col = (int)(idx & 1023), g = col >> 7, tl = r & 127, rc = r - tl;
        float acc = 0.f;
        const float* wrow = Ws + ((size_t)g * 128 + tl) * 128;
        for (int sl = 0; sl <= tl; ++sl) acc += wrow[sl] * gelu_f(bf2f(proj[(size_t)(rc + sl) * NPROJ + C_VB + col])) * rv[rc + sl];
        acc = acc * vg[col] + bs[g * 128 + tl];
        const float u = gelu_f(bf2f(proj[(size_t)r * NPROJ + C_UB + col])), z = silu_f(bf2f(proj[(size_t)r * NPROJ + C_ZB + col]));
        YB[idx] = (bf16)f2bf(u * acc * z);
    }
}
__device__ __forceinline__ void ph_gla_naive(const bf16* proj, const float* wa2, const float* ba, float* OC, LAS float* lds, int vb, int nvb) {
    const int lane = threadIdx.x & 63, wave = threadIdx.x >> 6;
    LAS float* sh = lds + wave * 512;
    for (int it = wave * nvb + vb; it < NBP * 16; it += nvb * 8) {
        const int b = it >> 4, h = (it >> 2) & 3, vq = it & 3;
        float st[128];
#pragma unroll
        for (int k = 0; k < 128; ++k) st[k] = 0.f;
        float wa0[16], wa1[16];
#pragma unroll
        for (int j = 0; j < 16; ++j) { wa0[j] = wa2[j * 512 + h * 128 + lane]; wa1[j] = wa2[j * 512 + h * 128 + 64 + lane]; }
        const float ba0 = ba[h * 128 + lane], ba1 = ba[h * 128 + 64 + lane];
        for (int t = 0; t < SEQ; ++t) {
            const bf16* pr = proj + (size_t)(b * SEQ + t) * NPROJ;
            const v4u w0 = *(const v4u*)(pr + C_AR), w1 = *(const v4u*)(pr + C_AR + 8);
            const float ar[16] = {lo16(w0.x), hi16(w0.x), lo16(w0.y), hi16(w0.y), lo16(w0.z), hi16(w0.z), lo16(w0.w), hi16(w0.w),
                                  lo16(w1.x), hi16(w1.x), lo16(w1.y), hi16(w1.y), lo16(w1.z), hi16(w1.z), lo16(w1.w), hi16(w1.w)};
            float x0 = ba0, x1 = ba1;
#pragma unroll
            for (int j = 0; j < 16; ++j) { x0 += ar[j] * wa0[j]; x1 += ar[j] * wa1[j]; }
            const float ls0 = fminf(x0, 0.f) - log1pf(__expf(-fabsf(x0))), ls1 = fminf(x1, 0.f) - log1pf(__expf(-fabsf(x1)));
            sh[lane] = __expf(ls0 * 0.0625f); sh[64 + lane] = __expf(ls1 * 0.0625f);
            sh[128 + lane] = bf2f(pr[C_QC + h * 128 + lane]) * 0.08838834764831845f; sh[192 + lane] = bf2f(pr[C_QC + h * 128 + 64 + lane]) * 0.08838834764831845f;
            sh[256 + lane] = bf2f(pr[C_KC + h * 128 + lane]); sh[320 + lane] = bf2f(pr[C_KC + h * 128 + 64 + lane]);
            const float v = bf2f(pr[C_VC + h * 256 + vq * 64 + lane]);
            LDS_FENCE();
            float o = 0.f;
#pragma unroll
            for (int k = 0; k < 128; ++k) { st[k] = sh[k] * st[k] + sh[256 + k] * v; o += sh[128 + k] * st[k]; }
            LDS_FENCE();
            OC[(size_t)(b * SEQ + t) * 1024 + h * 256 + vq * 64 + lane] = o;
        }
    }
}
__device__ __forceinline__ void ph_glafin(const float* OC, const bf16* proj, const float* og, bf16* YC, int vb, int nvb) {
    const int lane = threadIdx.x & 63, wave = threadIdx.x >> 6;
    for (int it = vb * 8 + wave; it < MP * 4; it += nvb * 8) {
        const int r = it >> 2, h = it & 3;
        const v4f o = *(const v4f*)(OC + (size_t)r * 1024 + h * 256 + lane * 4);
        const float ss = wave_sum(o.x * o.x + o.y * o.y + o.z * o.z + o.w * o.w);
        const float rn = 1.0f / sqrtf(ss * (1.0f / 256.f) + EPS);
        const v4f g = *(const v4f*)(og + lane * 4);
        const v2u zw = *(const v2u*)(proj + (size_t)r * NPROJ + C_ZC + h * 256 + lane * 4);
        v2u w; w.x = pk2(o.x * rn * g.x * silu_f(lo16(zw.x)), o.y * rn * g.y * silu_f(hi16(zw.x))); w.y = pk2(o.z * rn * g.z * silu_f(lo16(zw.y)), o.w * rn * g.w * silu_f(hi16(zw.y)));
        *(v2u*)(YC + (size_t)r * 1024 + h * 256 + lane * 4) = w;
    }
}
__device__ __forceinline__ void ph_merge(const bf16* proj, const bf16* PB, bf16* MG, int vb, int nvb) {
    for (size_t idx = (size_t)vb * 512 + threadIdx.x; idx < (size_t)MP * 1024; idx += (size_t)nvb * 512) {
        const int r = (int)(idx >> 10), j = (int)(idx & 1023) * 2;
        float m0 = 0.f, m1 = 0.f;
#pragma unroll
        for (int b = 0; b < 3; ++b) { const unsigned gw = *(const unsigned*)(proj + (size_t)r * NPROJ + C_GATE + b * 2048 + j), pw = *(const unsigned*)(PB + ((size_t)b * MP + r) * 2048 + j);
            m0 += sigmoid_f(lo16(gw)) * lo16(pw); m1 += sigmoid_f(hi16(gw)) * hi16(pw); }
        *(unsigned*)(MG + (size_t)r * 2048 + j) = pk2(m0, m1);
    }
}
__device__ __forceinline__ void ph_outadd(const float* xin, const float* U, float* xout, int vb, int nvb) {
    for (size_t idx = (size_t)vb * 512 + threadIdx.x; idx < (size_t)MP * 512; idx += (size_t)nvb * 512) {
        const v4f a = ((const v4f*)xin)[idx], u = ((const v4f*)U)[idx]; ((v4f*)xout)[idx] = a + u; }
}


#define KLB __global__ void __launch_bounds__(512, 2)
extern __shared__ __attribute__((aligned(16))) unsigned char lds_raw[];
#define LDSP ((LAS unsigned char*)lds_raw)
KLB k_convert(const float* w_in, const float* w_uq, const float* w_ukv, const float* w_b, const float* w_o, const int* positions, unsigned char* ws) {
    const int vb = blockIdx.x, nvb = gridDim.x, tid = threadIdx.x;
    for (int l = 0; l < DEPTH; ++l) {
        unsigned char* wl = ws + WS_W + (size_t)l * SZ_WLAYER;
        convert_T<1>(w_in + (size_t)l * DM * IN_COLS, DM, IN_COLS, (bf16*)wl, NPROJ, (LAS float*)LDSP, vb, nvb);
        convert_T<0>(w_uq + (size_t)l * 512 * 1536, 512, 1536, (bf16*)(wl + SZ_WIN), 1536, (LAS float*)LDSP, (vb + 64) % nvb, nvb);
        convert_T<0>(w_ukv + (size_t)l * 512 * 2048, 512, 2048, (bf16*)(wl + SZ_WIN + SZ_WUQ), 2048, (LAS float*)LDSP, (vb + 128) % nvb, nvb);
        for (int b = 0; b < 3; ++b)
            convert_T<0>(w_b + ((size_t)l * 3 + b) * 1024 * 2048, 1024, 2048, (bf16*)(wl + SZ_WIN + SZ_WUQ + SZ_WUKV) + (size_t)b * 2048 * 1024, 2048, (LAS float*)LDSP, (vb + 32 * b) % nvb, nvb);
        convert_T<0>(w_o + (size_t)l * 2048 * 2048, 2048, 2048, (bf16*)(wl + SZ_WIN + SZ_WUQ + SZ_WUKV + SZ_WB), 2048, (LAS float*)LDSP, (vb + 192) % nvb, nvb);
    }
    float* cosT = (float*)(ws + WS_COS); float* sinT = (float*)(ws + WS_SIN);
    for (int idx = vb * 512 + tid; idx < MTOK * 32; idx += nvb * 512) {
        const int t = idx >> 5, i = idx & 31;
        const float inv = 1.0f / exp2f((float)(2 * i) * (1.0f / 64.0f) * 13.287712379549449f);
        const float ang = (float)positions[t] * inv;
        const double ad = (double)ang; const double kq = rint(ad * 0.15915494309189535); const float rr = (float)(ad - kq * 6.283185307179586);
        cosT[idx] = cosf(rr); sinT[idx] = sinf(rr);
    }
}
KLB k_norm(const float* xin, const float* g, bf16* h) { ph_norm(xin, g, h, MP, blockIdx.x, gridDim.x); }
KLB k_gemm_bf16(const bf16* A, const bf16* Bt, int M, int N, int K, bf16* O, int ldc) {
    pg8::Gemm g{A, Bt, M, N, K}; pg8::StaticOrder S; S.init(M, N, gridDim.x, blockIdx.x); pg8::EpiBf16<0> E{O, ldc, nullptr, 0, 0};
    pg8::gemm_phase<pg8::EpiBf16<0>, pg8::StaticOrder>(LDSP, g, S, E, nullptr); }
KLB k_gemm_f32(const bf16* A, const bf16* Bt, int M, int N, int K, float* O, int ldc) {
    pg8::Gemm g{A, Bt, M, N, K}; pg8::StaticOrder S; S.init(M, N, gridDim.x, blockIdx.x); pg8::EpiF32 E{O, ldc, nullptr};
    pg8::gemm_phase<pg8::EpiF32, pg8::StaticOrder>(LDSP, g, S, E, nullptr); }
KLB k_prep(const bf16* proj, const float* gq, const float* gkv, bf16* cqn, bf16* ckvn, float* rv) { ph_prep(proj, gq, gkv, cqn, ckvn, rv, blockIdx.x, gridDim.x); }
KLB k_qkfin(bf16* q, const bf16* kv, const bf16* proj, bf16* K, const float* qg, const float* kg, const float* cosT, const float* sinT, int row0) { ph_qkfin(q, kv, proj, K, qg, kg, cosT, sinT, row0, blockIdx.x, gridDim.x); }
KLB k_attn(const bf16* Q, const bf16* K, const bf16* KV, const bf16* proj, bf16* YA) { ph_attn_naive(Q, K, KV, proj, YA, (LAS float*)LDSP, blockIdx.x, gridDim.x); }
KLB k_sgu(const bf16* proj, const float* rv, const float* Ws, const float* bs, const float* vg, bf16* YB) { ph_sgu_naive(proj, rv, Ws, bs, vg, YB, blockIdx.x, gridDim.x); }
KLB k_gla(const bf16* proj, const float* wa2, const float* ba, float* OC) { ph_gla_naive(proj, wa2, ba, OC, (LAS float*)LDSP, blockIdx.x, gridDim.x); }
KLB k_glafin(const float* OC, const bf16* proj, const float* og, bf16* YC) { ph_glafin(OC, proj, og, YC, blockIdx.x, gridDim.x); }
KLB k_merge(const bf16* proj, const bf16* PB, bf16* MG) { ph_merge(proj, PB, MG, blockIdx.x, gridDim.x); }
KLB k_outadd(const float* xin, const float* U, float* xout) { ph_outadd(xin, U, xout, blockIdx.x, gridDim.x); }

extern "C" void kernel_launch(void* const* d_in, const int* in_sizes, int n_in, void* d_out, int out_size, void* d_ws, size_t ws_size, hipStream_t stream) {
    static int grid = 0;
    if (grid == 0) {
        if (n_in != 18 || out_size != MTOK * DM || ws_size < WS_END) { fprintf(stderr, "kernel_launch: unexpected shapes (n_in %d out %d ws %zu need %zu)\n", n_in, out_size, ws_size, (size_t)WS_END); grid = -1; return; }
        int dev = 0, cus = 0;
        if (hipGetDevice(&dev) != hipSuccess || hipDeviceGetAttribute(&cus, hipDeviceAttributeMultiprocessorCount, dev) != hipSuccess) { grid = -1; return; }
        bool ok = true;
        ok &= hipFuncSetAttribute((const void*)k_convert, hipFuncAttributeMaxDynamicSharedMemorySize, LDS_BYTES) == hipSuccess;
        ok &= hipFuncSetAttribute((const void*)k_gemm_bf16, hipFuncAttributeMaxDynamicSharedMemorySize, LDS_BYTES) == hipSuccess;
        ok &= hipFuncSetAttribute((const void*)k_gemm_f32, hipFuncAttributeMaxDynamicSharedMemorySize, LDS_BYTES) == hipSuccess;
        ok &= hipFuncSetAttribute((const void*)k_attn, hipFuncAttributeMaxDynamicSharedMemorySize, LDS_BYTES) == hipSuccess;
        ok &= hipFuncSetAttribute((const void*)k_gla, hipFuncAttributeMaxDynamicSharedMemorySize, LDS_BYTES) == hipSuccess;
        if (!ok) { fprintf(stderr, "kernel_launch: hipFuncSetAttribute failed\n"); grid = -1; return; }
        grid = cus;
    }
    if (grid < 0) return;
    unsigned char* ws = (unsigned char*)d_ws;
    const float* x = (const float*)d_in[0]; float* out = (float*)d_out;
    float* cosT = (float*)(ws + WS_COS); float* sinT = (float*)(ws + WS_SIN);
    bf16* H = (bf16*)(ws + WS_H); bf16* PROJ = (bf16*)(ws + WS_PROJ); bf16* CQN = (bf16*)(ws + WS_CQN); bf16* CKVN = (bf16*)(ws + WS_CKVN); float* RV = (float*)(ws + WS_RV);
    bf16* Qb = (bf16*)(ws + WS_Q); bf16* KVb = (bf16*)(ws + WS_KV); bf16* Kb = (bf16*)(ws + WS_K);
    bf16* YA = (bf16*)(ws + WS_YA); bf16* YB = (bf16*)(ws + WS_YB); bf16* YC = (bf16*)(ws + WS_YC); float* OC = (float*)(ws + WS_OC);
    bf16* PB = (bf16*)(ws + WS_PB); bf16* MG = (bf16*)(ws + WS_MG); float* U = (float*)(ws + WS_U);
    const dim3 G(grid), B(512);
#define IN_F(i) ((const float*)d_in[i])
    hipLaunchKernelGGL(k_convert, G, B, LDS_BYTES, stream, IN_F(3), IN_F(6), IN_F(7), IN_F(16), IN_F(17), (const int*)d_in[1], ws);
    for (int l = 0; l < DEPTH; ++l) {
        const unsigned char* wl = ws + WS_W + (size_t)l * SZ_WLAYER;
        const bf16* WinT = (const bf16*)wl; const bf16* WuqT = (const bf16*)(wl + SZ_WIN); const bf16* WukvT = (const bf16*)(wl + SZ_WIN + SZ_WUQ);
        const bf16* WbT = (const bf16*)(wl + SZ_WIN + SZ_WUQ + SZ_WUKV); const bf16* WoT = (const bf16*)(wl + SZ_WIN + SZ_WUQ + SZ_WUKV + SZ_WB);
        const float* xin_all = l == 0 ? x : out;
        for (int p = 0; p < NPASS; ++p) {
            const int row0 = p * MP; const float* xin = xin_all + (size_t)row0 * DM;
            hipLaunchKernelGGL(k_norm, G, B, 0, stream, xin, IN_F(2) + l * DM, H);
            hipLaunchKernelGGL(k_gemm_bf16, G, B, LDS_BYTES, stream, (const bf16*)H, WinT, MP, NPROJ, DM, PROJ, NPROJ);
            hipLaunchKernelGGL(k_prep, G, B, 0, stream, (const bf16*)PROJ, IN_F(4) + l * 512, IN_F(5) + l * 512, CQN, CKVN, RV);
            hipLaunchKernelGGL(k_gemm_bf16, G, B, LDS_BYTES, stream, (const bf16*)CQN, WuqT, MP, 1536, 512, Qb, 1536);
            hipLaunchKernelGGL(k_gemm_bf16, G, B, LDS_BYTES, stream, (const bf16*)CKVN, WukvT, MP, 2048, 512, KVb, 2048);
            hipLaunchKernelGGL(k_qkfin, G, B, 0, stream, Qb, (const bf16*)KVb, (const bf16*)PROJ, Kb, IN_F(8) + l * 192, IN_F(9) + l * 192, (const float*)cosT, (const float*)sinT, row0);
            hipLaunchKernelGGL(k_attn, G, B, LDS_BYTES, stream, (const bf16*)Qb, (const bf16*)Kb, (const bf16*)KVb, (const bf16*)PROJ, YA);
            hipLaunchKernelGGL(k_sgu, G, B, 0, stream, (const bf16*)PROJ, (const float*)RV, IN_F(11) + (size_t)l * 8 * 128 * 128, IN_F(12) + l * 8 * 128, IN_F(10) + l * 1024, YB);
            hipLaunchKernelGGL(k_gla, G, B, LDS_BYTES, stream, (const bf16*)PROJ, IN_F(13) + l * 16 * 512, IN_F(14) + l * 512, OC);
            hipLaunchKernelGGL(k_glafin, G, B, 0, stream, (const float*)OC, (const bf16*)PROJ, IN_F(15) + l * 256, YC);
            for (int b = 0; b < 3; ++b)
                hipLaunchKernelGGL(k_gemm_bf16, G, B, LDS_BYTES, stream, (const bf16*)(b == 0 ? YA : (b == 1 ? YB : YC)), WbT + (size_t)b * 2048 * 1024, MP, 2048, 1024, PB + (size_t)b * MP * 2048, 2048);
            hipLaunchKernelGGL(k_merge, G, B, 0, stream, (const bf16*)PROJ, (const bf16*)PB, MG);
            hipLaunchKernelGGL(k_gemm_f32, G, B, LDS_BYTES, stream, (const bf16*)MG, WoT, MP, 2048, 2048, U, 2048);
            hipLaunchKernelGGL(k_outadd, G, B, 0, stream, xin, (const float*)U, out + (size_t)row0 * DM);
        }
    }
}
```

```cpp
#define ONE_LAUNCH 1
#include <hip/hip_runtime.h>
#include <cstdio>
#include <cstdint>

__device__ __forceinline__ int otid() { int t = threadIdx.x; asm volatile("" : "+v"(t)); return t; }
__device__ __forceinline__ int obid() { int t = blockIdx.x; asm volatile("" : "+s"(t)); return t; }
namespace pg8 {
#define PG8_LAS __attribute__((address_space(3)))
typedef unsigned short bf16_t;
typedef short bf16x8 __attribute__((ext_vector_type(8)));
typedef float f32x4 __attribute__((ext_vector_type(4)));
typedef unsigned u32x4 __attribute__((ext_vector_type(4)));
constexpr int BM = 256, BK = 64, HALF = 128, HTB = HALF * BK * 2  , STAGE_BYTES = 8 * HTB, NXCD = 8, WGM = 8;

__host__ __device__ __forceinline__ int lds_byte(int r, int c) { const int st = (r >> 4) * 2 + (c >> 5), rr = r & 15, cc = c & 31, ob = rr * 64 + cc * 2; return st * 1024 + (ob ^ (((ob >> 9) & 1) << 5)); }
__host__ __device__ __forceinline__ void stage_rc(int b, int& R, int& C) { const int st = b / 1024, sb = b % 1024, swz = sb ^ (((sb >> 9) & 1) << 5); R = (st >> 1) * 16 + swz / 64; C = (st & 1) * 32 + (swz % 64) / 2; }
__host__ __device__ __forceinline__ int perm32(int rho) { const int n = rho >> 4, i = rho & 15; return 8 * (i >> 2) + 4 * n + (i & 3); }

struct Unit { int pm, pn; };
struct Gemm { const bf16_t* A; const bf16_t* Bt; int M, N, K; };

struct StaticOrder {
    int nM, nN, nwg, G, c;
    __host__ __device__ void init(int M, int N, int G_, int c_) { nM = M / BM; nN = N / BM; nwg = nM * nN; G = G_; c = c_; }
    __host__ __device__ bool next(int i, Unit& u) const {
        const long L = (long)i * G + c; if (L >= nwg) return false;
        int wgid = (int)L; { const int q = nwg / NXCD, r = nwg % NXCD, xcd = wgid % NXCD, off = wgid / NXCD; wgid = (xcd < r ? xcd * (q + 1) : r * (q + 1) + (xcd - r) * q) + off; }
        const int nig = WGM * nN, gid = wgid / nig, fm = gid * WGM, gsz = (nM - fm) < WGM ? (nM - fm) : WGM;
        u.pm = fm + ((wgid % nig) % gsz); u.pn = (wgid % nig) / gsz; return true;
    }
    __device__ __forceinline__ void a_ready(const Unit&) const {}
    __device__ __forceinline__ void done(const Unit&) const {}
};

__device__ __forceinline__ unsigned cvt_pk_bf16(float lo, float hi) { unsigned r; asm volatile("v_cvt_pk_bf16_f32 %0, %1, %2" : "=v"(r) : "v"(lo), "v"(hi)); return r; }
typedef float f32x2 __attribute__((ext_vector_type(2)));
__device__ __forceinline__ f32x2 gelu_pk(f32x2 v) {
    const f32x2 av = __builtin_elementwise_abs(v), d = av * 0.2316418882f + 1.0f;
    f32x2 t; t.x = __builtin_amdgcn_rcpf(d.x); t.y = __builtin_amdgcn_rcpf(d.y);
    f32x2 q = t * 0.5307027145f + (-0.7265760135f); q = q * t + 0.7107068705f; q = q * t + (-0.142248368f); q = q * t + 0.127414796f; q = q * t;
    const f32x2 s = (v * v) * (-0.72134752044f);
    f32x2 e; e.x = __builtin_amdgcn_exp2f(s.x); e.y = __builtin_amdgcn_exp2f(s.y);
    const f32x2 m = v * (q * e), r = v - m;
    f32x2 o; o.x = v.x < 0.f ? m.x : r.x; o.y = v.y < 0.f ? m.y : r.y; return o;
}

struct EpiF32 {
    static constexpr bool PERM = false, AFTER_DRAIN = false;
    float* C; int ldc; const float* bias;
    __device__ __forceinline__ void operator()(const f32x4 (&acc)[2][2][4][2], const Unit& u, int wr, int wc, int fr, int fq) const {
        const int row0 = u.pm * BM + wr * 64 + fr, col0 = u.pn * BM + wc * 32 + 4 * fq;
        f32x4 bv[2][2];
#pragma unroll
        for (int bj = 0; bj < 2; ++bj)
#pragma unroll
            for (int n = 0; n < 2; ++n) bv[bj][n] = bias ? *(const f32x4*)(bias + col0 + bj * HALF + n * 16) : (f32x4){0.f, 0.f, 0.f, 0.f};
#pragma unroll
        for (int ai = 0; ai < 2; ++ai)
#pragma unroll
            for (int m = 0; m < 4; ++m) { float* rowp = C + (size_t)(row0 + ai * HALF + m * 16) * ldc + col0;
#pragma unroll
                for (int bj = 0; bj < 2; ++bj)
#pragma unroll
                    for (int n = 0; n < 2; ++n) *(f32x4*)(rowp + bj * HALF + n * 16) = acc[ai][bj][m][n] + bv[bj][n]; }
    }
};
template <int ACT  > struct EpiBf16 {
    static constexpr bool PERM = true, AFTER_DRAIN = false;
    bf16_t* O; int ldc; const float* bias; int split_cols; size_t split_stride;
    __device__ __forceinline__ void operator()(const f32x4 (&acc)[2][2][4][2], const Unit& u, int wr, int wc, int fr, int fq) const {
        const int row0 = u.pm * BM + wr * 64 + fr; int colt = u.pn * BM; bf16_t* base = O;
        if (split_cols) { const int t = colt / split_cols; base += (size_t)t * split_stride; colt -= t * split_cols; }
        const int col0 = colt + wc * 32 + 8 * fq, bcol0 = u.pn * BM + wc * 32 + 8 * fq;
        f32x4 bv[2][2];
#pragma unroll
        for (int bj = 0; bj < 2; ++bj)
#pragma unroll
            for (int n = 0; n < 2; ++n) bv[bj][n] = bias ? *(const f32x4*)(bias + bcol0 + bj * HALF + 4 * n) : (f32x4){0.f, 0.f, 0.f, 0.f};
#pragma unroll
        for (int ai = 0; ai < 2; ++ai)
#pragma unroll
            for (int m = 0; m < 4; ++m) { bf16_t* rowp = base + (size_t)(row0 + ai * HALF + m * 16) * ldc + col0;
#pragma unroll
                for (int bj = 0; bj < 2; ++bj) { f32x4 v0 = acc[ai][bj][m][0] + bv[bj][0], v1 = acc[ai][bj][m][1] + bv[bj][1];
                    if (ACT == 1) { f32x2 a = gelu_pk((f32x2){v0[0], v0[1]}), b = gelu_pk((f32x2){v0[2], v0[3]}), c = gelu_pk((f32x2){v1[0], v1[1]}), d = gelu_pk((f32x2){v1[2], v1[3]});
                        v0 = (f32x4){a.x, a.y, b.x, b.y}; v1 = (f32x4){c.x, c.y, d.x, d.y}; }
                    if (ACT == 2) {
#pragma unroll
                        for (int j = 0; j < 4; ++j) { v0[j] = 0.5f * v0[j] * (1.0f + erff(v0[j] * 0.70710678f)); v1[j] = 0.5f * v1[j] * (1.0f + erff(v1[j] * 0.70710678f)); } }
                    u32x4 w; w.x = cvt_pk_bf16(v0[0], v0[1]); w.y = cvt_pk_bf16(v0[2], v0[3]); w.z = cvt_pk_bf16(v1[0], v1[1]); w.w = cvt_pk_bf16(v1[2], v1[3]);
                    *(u32x4*)(rowp + bj * HALF) = w; } }
    }
};

template <class Epi, class Sched, bool STAMP = false>
__device__ __forceinline__ void gemm_phase(PG8_LAS unsigned char* lds, const Gemm g, const Sched& S, const Epi& E, unsigned long long* stamps) {
    const int tid = otid(), wid = __builtin_amdgcn_readfirstlane(tid >> 6), lane = tid & 63, wr = wid >> 2, wc = wid & 3, fr = lane & 15, fq = lane >> 4;
    const int K = g.K, nt = K / BK;
    int ts_lo = 0, ts_hi = 0, nts = 0; const unsigned long long rt_entry = STAMP ? (unsigned long long)wall_clock64() : 0ull;
#define PG8_STAMP() do { if (STAMP && wid == 0 && nts < 64) { const unsigned long long _c = (unsigned long long)clock64(); \
        ts_lo = (lane == nts) ? (int)(unsigned)_c : ts_lo; ts_hi = (lane == nts) ? (int)(unsigned)(_c >> 32) : ts_hi; ++nts; } } while (0)
    PG8_STAMP();
    unsigned voffA[2], voffB[2];
#pragma unroll
    for (int i = 0; i < 2; ++i) { int R, C; stage_rc(tid * 16 + i * 8192, R, C); const int Rb = Epi::PERM ? ((R & ~31) + perm32(R & 31)) : R;
        voffA[i] = (unsigned)(R * K + C) * 2u; voffB[i] = (unsigned)(Rb * K + C) * 2u; }
    const size_t kstep = (size_t)(BK * 2);
    const size_t hstep = (size_t)HALF * K * 2;
    const size_t tstep = 2 * hstep;
    const unsigned ldsw = (unsigned)wid * 1024u;
    const int aoff = lds_byte(wr * 64 + fr, fq * 8), boff = lds_byte(wc * 32 + fr, fq * 8);
#define PG8_SA(b, h) (((b) * 2 + (h)) * HTB)
#define PG8_SB(b, h) ((4 + (b) * 2 + (h)) * HTB)
#define PG8_STAGE(bufoff, gbase, voff) do { _Pragma("unroll") for (int _i = 0; _i < 2; ++_i) \
        __builtin_amdgcn_global_load_lds((const unsigned*)((const char*)(gbase) + (voff)[_i]), (PG8_LAS unsigned*)(lds + (bufoff) + ldsw + _i * 8192), 16, 0, 0); } while (0)
#define PG8_LDA(dst, b, h) do { _Pragma("unroll") for (int m = 0; m < 4; ++m) _Pragma("unroll") for (int k = 0; k < 2; ++k) dst[m][k] = *(const PG8_LAS bf16x8*)(lds + PG8_SA(b, h) + aoff + m * 2048 + k * 1024); } while (0)
#define PG8_LDB(dst, b, h) do { _Pragma("unroll") for (int n = 0; n < 2; ++n) _Pragma("unroll") for (int k = 0; k < 2; ++k) dst[n][k] = *(const PG8_LAS bf16x8*)(lds + PG8_SB(b, h) + boff + n * 2048 + k * 1024); } while (0)
#define PG8_MMA(ai, bj, At, Bt) do { __builtin_amdgcn_s_setprio(1); _Pragma("unroll") for (int m = 0; m < 4; ++m) _Pragma("unroll") for (int n = 0; n < 2; ++n) _Pragma("unroll") for (int k = 0; k < 2; ++k) \
        acc[ai][bj][m][n] = __builtin_amdgcn_mfma_f32_16x16x32_bf16(Bt[n][k], At[m][k], acc[ai][bj][m][n], 0, 0, 0); __builtin_amdgcn_s_setprio(0); } while (0)
#define PG8_WAIT_V(n) asm volatile("s_waitcnt vmcnt(" #n ")" ::: "memory")
#define PG8_WAIT_L(n) asm volatile("s_waitcnt lgkmcnt(" #n ")" ::: "memory")
#define PG8_BAR __builtin_amdgcn_s_barrier()
#define PG8_SCHED __builtin_amdgcn_sched_barrier(0)
    Unit cur, nxt; int ui = 0;
    if (!S.next(0, cur)) return;
    f32x4 acc[2][2][4][2];
#pragma unroll
    for (int a = 0; a < 2; ++a)
#pragma unroll
        for (int b = 0; b < 2; ++b)
#pragma unroll
            for (int m = 0; m < 4; ++m)
#pragma unroll
                for (int n = 0; n < 2; ++n) acc[a][b][m][n] = (f32x4){0.f, 0.f, 0.f, 0.f};
    bf16x8 At[4][2], B0[2][2], B1[2][2];
    const char* cA = (const char*)g.A + (size_t)cur.pm * tstep; const char* cB = (const char*)g.Bt + (size_t)cur.pn * tstep;
    S.a_ready(cur);
    PG8_STAGE(PG8_SB(0, 0), cB, voffB); PG8_STAGE(PG8_SA(0, 0), cA, voffA); PG8_STAGE(PG8_SB(0, 1), cB + hstep, voffB); PG8_STAGE(PG8_SA(0, 1), cA + hstep, voffA);
    if (wr == 1) PG8_BAR;
    PG8_WAIT_V(4); PG8_BAR;
    PG8_STAGE(PG8_SB(1, 0), cB + kstep, voffB); PG8_STAGE(PG8_SA(1, 0), cA + kstep, voffA); PG8_STAGE(PG8_SB(1, 1), cB + hstep + kstep, voffB);
    PG8_WAIT_V(6); PG8_BAR;
    PG8_STAMP();
    for (;;) {
        const bool has_next = S.next(ui + 1, nxt);
        const char* nA = has_next ? (const char*)g.A + (size_t)nxt.pm * tstep : cA; const char* nB = has_next ? (const char*)g.Bt + (size_t)nxt.pn * tstep : cB;
        for (int t = 0; t < nt; t += 2) {
            const bool last = (t == nt - 2);
            const char* a1 = cA + (size_t)(t + 1) * kstep;
            const char* a2 = last ? nA : cA + (size_t)(t + 2) * kstep; const char* b2 = last ? nB : cB + (size_t)(t + 2) * kstep;
            const char* a3 = a2 + kstep; const char* b3 = b2 + kstep;
            if (last && has_next) S.a_ready(nxt);
            PG8_LDB(B0, 0, 0); PG8_SCHED; PG8_LDA(At, 0, 0); PG8_STAGE(PG8_SA(1, 1), a1 + hstep, voffA);
            PG8_WAIT_L(8); PG8_BAR; PG8_WAIT_L(0); PG8_MMA(0, 0, At, B0); PG8_BAR; PG8_SCHED;
            PG8_LDB(B1, 0, 1); PG8_STAGE(PG8_SB(0, 0), b2, voffB);
            PG8_BAR; PG8_WAIT_L(0); PG8_MMA(0, 1, At, B1); PG8_BAR;
            PG8_LDA(At, 0, 1); PG8_STAGE(PG8_SA(0, 0), a2, voffA);
            PG8_BAR; PG8_WAIT_L(0); PG8_MMA(1, 0, At, B0); PG8_BAR; PG8_SCHED;
            PG8_STAGE(PG8_SB(0, 1), b2 + hstep, voffB);
            PG8_WAIT_V(6); PG8_BAR; PG8_MMA(1, 1, At, B1); PG8_BAR;
            PG8_LDB(B0, 1, 0); PG8_SCHED; PG8_LDA(At, 1, 0); PG8_STAGE(PG8_SA(0, 1), a2 + hstep, voffA);
            PG8_WAIT_L(8); PG8_BAR; PG8_WAIT_L(0); PG8_MMA(0, 0, At, B0); PG8_BAR; PG8_SCHED;
            PG8_LDB(B1, 1, 1); PG8_STAGE(PG8_SB(1, 0), b3, voffB);
            PG8_BAR; PG8_WAIT_L(0); PG8_MMA(0, 1, At, B1); PG8_BAR;
            PG8_LDA(At, 1, 1); PG8_STAGE(PG8_SA(1, 0), a3, voffA);
            PG8_BAR; PG8_WAIT_L(0); PG8_MMA(1, 0, At, B0); PG8_BAR; PG8_SCHED;
            PG8_STAGE(PG8_SB(1, 1), b3 + hstep, voffB);
            PG8_WAIT_V(6); PG8_BAR; PG8_MMA(1, 1, At, B1); PG8_BAR;
        }
        PG8_STAMP();
        if constexpr (!Epi::AFTER_DRAIN) { E(acc, cur, wr, wc, fr, fq); S.done(cur); }
        PG8_STAMP();
        if (!has_next) break;
#pragma unroll
        for (int a = 0; a < 2; ++a)
#pragma unroll
            for (int b = 0; b < 2; ++b)
#pragma unroll
                for (int m = 0; m < 4; ++m)
#pragma unroll
                    for (int n = 0; n < 2; ++n) acc[a][b][m][n] = (f32x4){0.f, 0.f, 0.f, 0.f};
        cur = nxt; cA = nA; cB = nB; ++ui;
    }
    PG8_WAIT_V(0);
    if (wr == 0) PG8_BAR;
    PG8_BAR;
    if constexpr (Epi::AFTER_DRAIN) { E.fused(acc, cur, wr, wc, fr, fq, lds, wid, lane); S.done(cur); }
    PG8_STAMP();
    if (STAMP && wid == 0) { stamps[lane] = lane < nts ? (((unsigned long long)(unsigned)ts_hi << 32) | (unsigned)ts_lo) : 0ull;
        if (lane == 62) stamps[62] = rt_entry; if (lane == 63) stamps[63] = (unsigned long long)wall_clock64(); }
#undef PG8_STAMP
#undef PG8_SA
#undef PG8_SB
#undef PG8_STAGE
#undef PG8_LDA
#undef PG8_LDB
#undef PG8_MMA
#undef PG8_WAIT_V
#undef PG8_WAIT_L
#undef PG8_BAR
#undef PG8_SCHED
}
}
#define XB_TMO      128
#define XB_XCNT(j)  (256  + 64 * (j))
#define XB_XSUB(j)  (1280 + 64 * (j))
#define XB_XGEN(j)  (2304 + 64 * (j))
#define XB_TOP      3328
#define XB_TOPGEN   3392
#define XCD_BAR_WORDS 3456
#define XB_SPIN_CAP (1u << 18)
#define LAS __attribute__((address_space(3)))

__device__ __forceinline__ unsigned xb_ld(unsigned* p)              { return __hip_atomic_load(p, __ATOMIC_RELAXED, __HIP_MEMORY_SCOPE_AGENT); }
__device__ __forceinline__ unsigned xb_add(unsigned* p, unsigned v) { return __hip_atomic_fetch_add(p, v, __ATOMIC_RELAXED, __HIP_MEMORY_SCOPE_AGENT); }
__device__ __forceinline__ unsigned xb_xcc_id() { return (unsigned)__builtin_amdgcn_s_getreg((3 << 11) | 20) & 0xFu; }
#define XB_SPIN(cond, bar) do { unsigned _sp = 0; while (cond) { __builtin_amdgcn_s_sleep(1); \
    if ((++_sp & 255u) == 0u) { if (xb_ld(&(bar)[XB_TMO])) break; if (_sp > XB_SPIN_CAP) { atomicAdd(&(bar)[XB_TMO], 1u); break; } } } } while (0)

struct XcdBarrier {
    unsigned* bar; unsigned x;
    volatile LAS unsigned* st;
};

__device__ __forceinline__ XcdBarrier xcd_barrier_post(unsigned* bar, volatile LAS unsigned* st) {
    XcdBarrier b; b.bar = bar; b.x = xb_xcc_id(); b.st = st;
    if (threadIdx.x == 0) (void)xb_add(&bar[XB_XCNT(b.x)], 1u);
    return b;
}
__device__ __forceinline__ void xcd_barrier_complete(unsigned* bar, unsigned x, unsigned& nloc, unsigned& nx) {
    const unsigned G = gridDim.x * gridDim.y * gridDim.z;
    unsigned sum, cnt, mine, sp = 0u;
    for (;;) {
        sum = 0u; cnt = 0u; mine = 0u;
#pragma unroll
        for (unsigned j = 0; j < 16; ++j) { const unsigned c = xb_ld(&bar[XB_XCNT(j)]); sum += c; cnt += (c > 0u) ? 1u : 0u; mine = (j == x) ? c : mine; }
        if (sum == G) break;
        __builtin_amdgcn_s_sleep(1);
        if ((++sp & 255u) == 0u) { if (xb_ld(&bar[XB_TMO])) break; if (sp > XB_SPIN_CAP) { atomicAdd(&bar[XB_TMO], 1u); break; } }
    }
    nloc = mine > 0u ? mine : 1u; nx = cnt > 0u ? cnt : 1u;
}

__device__ __forceinline__ void xcd_barrier(const XcdBarrier& b) {
    asm volatile("s_waitcnt vmcnt(0)" ::: "memory");
    __syncthreads();
    if (threadIdx.x == 0) {
        unsigned* bar = b.bar;
        __builtin_amdgcn_s_waitcnt(0);
        unsigned nloc = b.st[0], nx = b.st[1];
        if (nloc == 0u) { xcd_barrier_complete(bar, b.x, nloc, nx); b.st[0] = nloc; b.st[1] = nx; }
        const unsigned old = xb_add(&bar[XB_XSUB(b.x)], 1u);
        const unsigned gen = old / nloc;
        if (old + 1u == (gen + 1u) * nloc) {
            __builtin_amdgcn_fence(__ATOMIC_RELEASE, "agent");
            asm volatile("s_waitcnt vmcnt(0)" ::: "memory");
            const unsigned og = xb_add(&bar[XB_TOP], 1u);
            const unsigned tg = og / nx;
            if (og + 1u == (tg + 1u) * nx) xb_add(&bar[XB_TOPGEN], 1u);
            else XB_SPIN(xb_ld(&bar[XB_TOPGEN]) == tg, bar);
            __builtin_amdgcn_fence(__ATOMIC_ACQUIRE, "agent");
            xb_add(&bar[XB_XGEN(b.x)], 1u);
            asm volatile("s_waitcnt vmcnt(0)" ::: "memory");
        } else {
            XB_SPIN(xb_ld(&bar[XB_XGEN(b.x)]) == gen, bar);
            __builtin_amdgcn_fence(__ATOMIC_ACQUIRE, "agent");
            asm volatile("s_waitcnt vmcnt(0)" ::: "memory");
        }
    }
    __syncthreads();
}


typedef unsigned short bf16;
typedef unsigned v4u __attribute__((ext_vector_type(4)));
typedef unsigned v2u __attribute__((ext_vector_type(2)));
typedef float v4f __attribute__((ext_vector_type(4)));

constexpr int DM = 2048, NBATCH = 8, SEQ = 4096, DEPTH = 2, MTOK = NBATCH * SEQ;
constexpr int IN_COLS = 14416, NPROJ = 14592;
constexpr int C_CQ = 0, C_CKV = 512, C_ZA = 1024, C_UB = 2048, C_VB = 3072, C_ZB = 4096, C_QC = 5120, C_KC = 5632, C_VC = 6144, C_ZC = 7168,
              C_GATE = 8192, C_KROPE = 14336, C_AR = 14400;
constexpr float EPS = 1e-6f;
#ifndef NBP
#define NBP 2
#endif
constexpr int MP = NBP * SEQ, NPASS = NBATCH / NBP;
constexpr int STEPS_PER_PASS = 13;
constexpr int NSTEPS = 1 + DEPTH * NPASS * STEPS_PER_PASS;

constexpr size_t al256(size_t x) { return (x + 255) & ~(size_t)255; }
constexpr size_t WS_CTL = 0, CTL_BYTES = 1u << 20;
constexpr size_t SZ_WIN = (size_t)NPROJ * DM * 2, SZ_WUQ = (size_t)1536 * 512 * 2, SZ_WUKV = (size_t)2048 * 512 * 2, SZ_WB = (size_t)3 * 2048 * 1024 * 2, SZ_WO = (size_t)2048 * 2048 * 2;
constexpr size_t SZ_WLAYER = SZ_WIN + SZ_WUQ + SZ_WUKV + SZ_WB + SZ_WO;
constexpr size_t WS_W = CTL_BYTES;
constexpr size_t WS_COS = WS_W + DEPTH * SZ_WLAYER, WS_SIN = WS_COS + (size_t)MTOK * 32 * 4;
constexpr size_t WS_H = WS_SIN + (size_t)MTOK * 32 * 4;
constexpr size_t WS_PROJ = WS_H + (size_t)MP * DM * 2;
constexpr size_t WS_CQN = WS_PROJ + (size_t)MP * NPROJ * 2;
constexpr size_t WS_CKVN = WS_CQN + (size_t)MP * 512 * 2;
constexpr size_t WS_RV = WS_CKVN + (size_t)MP * 512 * 2;
constexpr size_t WS_Q = WS_RV + al256((size_t)MP * 4);
constexpr size_t WS_KV = WS_Q + (size_t)MP * 1536 * 2;
constexpr size_t WS_K = WS_KV + (size_t)MP * 2048 * 2;
constexpr size_t WS_YA = WS_K + (size_t)MP * 1536 * 2;
constexpr size_t WS_YB = WS_YA + (size_t)MP * 1024 * 2;
constexpr size_t WS_YC = WS_YB + (size_t)MP * 1024 * 2;
constexpr size_t WS_OC = WS_YC + (size_t)MP * 1024 * 2;
constexpr size_t WS_PB = WS_OC + (size_t)MP * 1024 * 4;
constexpr size_t WS_MG = WS_PB + (size_t)3 * MP * 2048 * 2;
constexpr size_t WS_U = WS_MG + (size_t)MP * 2048 * 2;
constexpr size_t WS_END = WS_U + (size_t)MP * 2048 * 4;
static_assert(WS_END <= ((size_t)1 << 30), "workspace map exceeds 1 GiB");

constexpr int LDS_BYTES = 147456;
constexpr int LDSCTL_OFF = LDS_BYTES - 256;
constexpr int CW_BAR = 4096;

__device__ __forceinline__ float bf2f(unsigned v) { return __uint_as_float(v << 16); }
__device__ __forceinline__ unsigned f2bf(float f) { unsigned u = __float_as_uint(f); return (u + 0x7fffu + ((u >> 16) & 1u)) >> 16; }
__device__ __forceinline__ unsigned pk2(float lo, float hi) { return f2bf(lo) | (f2bf(hi) << 16); }
__device__ __forceinline__ float lo16(unsigned w) { return __uint_as_float(w << 16); }
__device__ __forceinline__ float hi16(unsigned w) { return __uint_as_float(w & 0xffff0000u); }
__device__ __forceinline__ float sigmoid_f(float x) { return 1.f / (1.f + __expf(-x)); }
__device__ __forceinline__ float silu_f(float x) { return x / (1.f + __expf(-x)); }
__device__ __forceinline__ float gelu_f(float x) { const float u = 0.7978845608028654f * (x + 0.044715f * x * x * x); return 0.5f * x * (1.f + tanhf(u)); }
__device__ __forceinline__ float wave_sum(float v) {
#pragma unroll
    for (int o = 32; o >= 1; o >>= 1) v += __shfl_xor(v, o);
    return v; }
__device__ __forceinline__ float wave_max(float v) {
#pragma unroll
    for (int o = 32; o >= 1; o >>= 1) v = fmaxf(v, __shfl_xor(v, o));
    return v; }
#define LDS_FENCE() asm volatile("s_waitcnt lgkmcnt(0)" ::: "memory")

struct Args { const void* in[18]; float* out; unsigned char* ws; int lo, hi, pad0, pad1; };

template <int MODE> __device__ __forceinline__ int src_col(int n) {
    if (MODE == 0) return n;
    if (n < C_ZA) return n;
    if (n < C_ZC) return n + 64;
    if (n < C_KROPE) return n + 80;
    if (n < C_AR) return 1024 + (n - C_KROPE);
    if (n < C_AR + 16) return 7232 + (n - C_AR);
    return -1;
}
template <int MODE> __device__ __forceinline__ void convert_T(const float* W, int K, int Nsrc, bf16* WT, int Ndst, LAS float* tile, int vb, int nvb) {
    const int tid = otid(), ntk = K / 64, ntn = Ndst / 64, ntiles = ntk * ntn;
    for (int t = vb; t < ntiles; t += nvb) {
        const int k0 = (t % ntk) * 64, n0 = (t / ntk) * 64;
        { const int nn = tid & 63, sc = src_col<MODE>(n0 + nn);
#pragma unroll
          for (int i = 0; i < 8; ++i) { const int kk = (tid >> 6) + 8 * i; tile[kk * 65 + nn] = sc >= 0 ? W[(size_t)(k0 + kk) * Nsrc + sc] : 0.f; } }
        __syncthreads();
        { const int kk = tid & 63;
#pragma unroll
          for (int i = 0; i < 8; ++i) { const int nn = (tid >> 6) + 8 * i; WT[(size_t)(n0 + nn) * K + k0 + kk] = (bf16)f2bf(tile[kk * 65 + nn]); } }
        __syncthreads();
    }
}

__device__ __forceinline__ void ph_norm(const float* xin, const float* g, bf16* h, int rows, int vb, int nvb) {
    const int tid_ = otid(); const int lane = tid_ & 63, wave = tid_ >> 6;
    for (int r = vb * 8 + wave; r < rows; r += nvb * 8) {
        const v4f* xr = (const v4f*)(xin + (size_t)r * DM);
        v4f v[8]; float ss = 0.f;
#pragma unroll
        for (int j = 0; j < 8; ++j) { v[j] = xr[lane + 64 * j]; ss += v[j].x * v[j].x + v[j].y * v[j].y + v[j].z * v[j].z + v[j].w * v[j].w; }
        ss = wave_sum(ss);
        const float rn = 1.0f / sqrtf(ss * (1.0f / DM) + EPS);
#pragma unroll
        for (int j = 0; j < 8; ++j) { const v4f gg = ((const v4f*)g)[lane + 64 * j];
            v2u o; o.x = pk2(v[j].x * rn * gg.x, v[j].y * rn * gg.y); o.y = pk2(v[j].z * rn * gg.z, v[j].w * rn * gg.w);
            *(v2u*)(h + (size_t)r * DM + (lane + 64 * j) * 4) = o; }
    }
}
__device__ __forceinline__ void ph_prep(const bf16* proj, const float* gq, const float* gkv, bf16* cqn, bf16* ckvn, float* rv, int vb, int nvb) {
    const int tid_ = otid(); const int lane = tid_ & 63, wave = tid_ >> 6;
    for (int r = vb * 8 + wave; r < MP; r += nvb * 8) {
        const bf16* pr = proj + (size_t)r * NPROJ;
#pragma unroll
        for (int which = 0; which < 2; ++which) {
            const v4u w = *(const v4u*)(pr + (which ? C_CKV : C_CQ) + lane * 8);
            float x[8] = {lo16(w.x), hi16(w.x), lo16(w.y), hi16(w.y), lo16(w.z), hi16(w.z), lo16(w.w), hi16(w.w)};
            float ss = 0.f;
#pragma unroll
            for (int i = 0; i < 8; ++i) ss += x[i] * x[i];
            ss = wave_sum(ss);
            const float rn = 1.0f / sqrtf(ss * (1.0f / 512.f) + EPS);
            const float* g = (which ? gkv : gq) + lane * 8;
            v4u o; o.x = pk2(x[0] * rn * g[0], x[1] * rn * g[1]); o.y = pk2(x[2] * rn * g[2], x[3] * rn * g[3]); o.z = pk2(x[4] * rn * g[4], x[5] * rn * g[5]); o.w = pk2(x[6] * rn * g[6], x[7] * rn * g[7]);
            *(v4u*)((which ? ckvn : cqn) + (size_t)r * 512 + lane * 8) = o;
        }
        float ss = 0.f;
#pragma unroll
        for (int j = 0; j < 2; ++j) { const v4u w = *(const v4u*)(pr + C_VB + (lane + 64 * j) * 8);
            const float x[8] = {lo16(w.x), hi16(w.x), lo16(w.y), hi16(w.y), lo16(w.z), hi16(w.z), lo16(w.w), hi16(w.w)};
#pragma unroll
            for (int i = 0; i < 8; ++i) { const float gv = gelu_f(x[i]); ss += gv * gv; } }
        ss = wave_sum(ss);
        if (lane == 0) rv[r] = 1.0f / sqrtf(ss * (1.0f / 1024.f) + EPS);
    }
}
__device__ __forceinline__ void ph_qkfin(bf16* q, const bf16* kv, const bf16* proj, bf16* K, const float* qg, const float* kg, const float* cosT, const float* sinT, int row0, int vb, int nvb) {
    const int tid_ = otid(); const int lane = tid_ & 63, wave = tid_ >> 6;
    for (int it = vb * 8 + wave; it < MP * 8; it += nvb * 8) {
        const int r = it >> 3, hd = it & 7;
        const float c = cosT[(size_t)(row0 + r) * 32 + (lane & 31)], s = sinT[(size_t)(row0 + r) * 32 + (lane & 31)];
        {   bf16* qp = q + ((size_t)r * 8 + hd) * 192;
            const float v0 = bf2f(qp[lane]), v1 = bf2f(qp[lane + 64]), v2 = bf2f(qp[lane + 128]);
            const float ss = wave_sum(v0 * v0 + v1 * v1 + v2 * v2);
            const float rn = 1.0f / sqrtf(ss * (1.0f / 192.f) + EPS);
            const float n0 = v0 * rn * qg[lane], n1 = v1 * rn * qg[lane + 64], n2 = v2 * rn * qg[lane + 128];
            const float pn = __shfl_xor(n2, 32);
            const float o2 = lane < 32 ? n2 * c - pn * s : n2 * c + pn * s;
            qp[lane] = (bf16)f2bf(n0); qp[lane + 64] = (bf16)f2bf(n1); qp[lane + 128] = (bf16)f2bf(o2); }
        {   const bf16* kp = kv + (size_t)r * 2048 + hd * 256;
            const float v0 = bf2f(kp[lane]), v1 = bf2f(kp[lane + 64]), v2 = bf2f(proj[(size_t)r * NPROJ + C_KROPE + lane]);
            const float ss = wave_sum(v0 * v0 + v1 * v1 + v2 * v2);
            const float rn = 1.0f / sqrtf(ss * (1.0f / 192.f) + EPS);
            const float n0 = v0 * rn * kg[lane], n1 = v1 * rn * kg[lane + 64], n2 = v2 * rn * kg[lane + 128];
            const float pn = __shfl_xor(n2, 32);
            const float o2 = lane < 32 ? n2 * c - pn * s : n2 * c + pn * s;
            bf16* ko = K + ((size_t)r * 8 + hd) * 192;
            ko[lane] = (bf16)f2bf(n0); ko[lane + 64] = (bf16)f2bf(n1); ko[lane + 128] = (bf16)f2bf(o2); }
    }
}
__device__ __forceinline__ void ph_attn_naive(const bf16* Q, const bf16* K, const bf16* KV, const bf16* proj, bf16* YA, LAS float* lds, int vb, int nvb) {
    const int tid_ = otid(); const int lane = tid_ & 63, wave = tid_ >> 6;
    LAS float* qs = lds + wave * (4096 + 192); LAS float* ps = qs + 192;
    const float scale = 0.07216878364870322f;
    for (int it = vb * 8 + wave; it < NBP * 8 * SEQ; it += nvb * 8) {
        const int t = it % SEQ, bh = it / SEQ, h = bh & 7, b = bh >> 3, r = b * SEQ + t;
        { const bf16* qp = Q + ((size_t)r * 8 + h) * 192; qs[lane] = bf2f(qp[lane]); qs[lane + 64] = bf2f(qp[lane + 64]); qs[lane + 128] = bf2f(qp[lane + 128]); }
        LDS_FENCE();
        float m = -3.0e38f;
        for (int j = lane; j <= t; j += 64) {
            const v4u* kr = (const v4u*)(K + ((size_t)(b * SEQ + j) * 8 + h) * 192);
            float s = 0.f;
#pragma unroll 4
            for (int c = 0; c < 24; ++c) { const v4u w = kr[c]; const LAS float* qq = qs + c * 8;
                s += qq[0] * lo16(w.x) + qq[1] * hi16(w.x) + qq[2] * lo16(w.y) + qq[3] * hi16(w.y) + qq[4] * lo16(w.z) + qq[5] * hi16(w.z) + qq[6] * lo16(w.w) + qq[7] * hi16(w.w); }
            s *= scale; ps[j] = s; m = fmaxf(m, s);
        }
        m = wave_max(m);
        float l = 0.f;
        for (int j = lane; j <= t; j += 64) { const float p = __expf(ps[j] - m); ps[j] = p; l += p; }
        l = wave_sum(l);
        LDS_FENCE();
        float a0 = 0.f, a1 = 0.f;
        const bf16* vp = KV + (size_t)(b * SEQ) * 2048 + h * 256 + 128 + 2 * lane;
        for (int j = 0; j <= t; ++j) { const float p = ps[j]; const unsigned w = *(const unsigned*)(vp + (size_t)j * 2048); a0 += p * lo16(w); a1 += p * hi16(w); }
        const float inv = 1.0f / l;
        const unsigned zw = *(const unsigned*)(proj + (size_t)r * NPROJ + C_ZA + h * 128 + 2 * lane);
        *(unsigned*)(YA + (size_t)r * 1024 + h * 128 + 2 * lane) = pk2(a0 * inv * silu_f(lo16(zw)), a1 * inv * silu_f(hi16(zw)));
        LDS_FENCE();
    }
}
__device__ __forceinline__ void ph_sgu_naive(const bf16* proj, const float* rv, const float* Ws, const float* bs, const float* vg, bf16* YB, int vb, int nvb) {
    for (size_t idx = (size_t)vb * 512 + otid(); idx < (size_t)MP * 1024; idx += (size_t)nvb * 512) {
        const int r = (int)(idx >> 10), col = (int)(idx & 1023), g = col >> 7, tl = r & 127, rc = r - tl;
        float acc = 0.f;
        const float* wrow = Ws + ((size_t)g * 128 + tl) * 128;
        for (int sl = 0; sl <= tl; ++sl) acc += wrow[sl] * gelu_f(bf2f(proj[(size_t)(rc + sl) * NPROJ + C_VB + col])) * rv[rc + sl];
        acc = acc * vg[col] + bs[g * 128 + tl];
        const float u = gelu_f(bf2f(proj[(size_t)r * NPROJ + C_UB + col])), z = silu_f(bf2f(proj[(size_t)r * NPROJ + C_ZB + col]));
        YB[idx] = (bf16)f2bf(u * acc * z);
    }
}
__device__ __forceinline__ void ph_gla_naive(const bf16* proj, const float* wa2, const float* ba, float* OC, LAS float* lds, int vb, int nvb) {
    const int tid_ = otid(); const int lane = tid_ & 63, wave = tid_ >> 6;
    LAS float* sh = lds + wave * 512;
    for (int it = wave * nvb + vb; it < NBP * 16; it += nvb * 8) {
        const int b = it >> 4, h = (it >> 2) & 3, vq = it & 3;
        float st[128];
#pragma unroll
        for (int k = 0; k < 128; ++k) st[k] = 0.f;
        float wa0[16], wa1[16];
#pragma unroll
        for (int j = 0; j < 16; ++j) { wa0[j] = wa2[j * 512 + h * 128 + lane]; wa1[j] = wa2[j * 512 + h * 128 + 64 + lane]; }
        const float ba0 = ba[h * 128 + lane], ba1 = ba[h * 128 + 64 + lane];
        for (int t = 0; t < SEQ; ++t) {
            const bf16* pr = proj + (size_t)(b * SEQ + t) * NPROJ;
            const v4u w0 = *(const v4u*)(pr + C_AR), w1 = *(const v4u*)(pr + C_AR + 8);
            const float ar[16] = {lo16(w0.x), hi16(w0.x), lo16(w0.y), hi16(w0.y), lo16(w0.z), hi16(w0.z), lo16(w0.w), hi16(w0.w),
                                  lo16(w1.x), hi16(w1.x), lo16(w1.y), hi16(w1.y), lo16(w1.z), hi16(w1.z), lo16(w1.w), hi16(w1.w)};
            float x0 = ba0, x1 = ba1;
#pragma unroll
            for (int j = 0; j < 16; ++j) { x0 += ar[j] * wa0[j]; x1 += ar[j] * wa1[j]; }
            const float ls0 = fminf(x0, 0.f) - log1pf(__expf(-fabsf(x0))), ls1 = fminf(x1, 0.f) - log1pf(__expf(-fabsf(x1)));
            sh[lane] = __expf(ls0 * 0.0625f); sh[64 + lane] = __expf(ls1 * 0.0625f);
            sh[128 + lane] = bf2f(pr[C_QC + h * 128 + lane]) * 0.08838834764831845f; sh[192 + lane] = bf2f(pr[C_QC + h * 128 + 64 + lane]) * 0.08838834764831845f;
            sh[256 + lane] = bf2f(pr[C_KC + h * 128 + lane]); sh[320 + lane] = bf2f(pr[C_KC + h * 128 + 64 + lane]);
            const float v = bf2f(pr[C_VC + h * 256 + vq * 64 + lane]);
            LDS_FENCE();
            float o = 0.f;
#pragma unroll
            for (int k = 0; k < 128; ++k) { st[k] = sh[k] * st[k] + sh[256 + k] * v; o += sh[128 + k] * st[k]; }
            LDS_FENCE();
            OC[(size_t)(b * SEQ + t) * 1024 + h * 256 + vq * 64 + lane] = o;
        }
    }
}
__device__ __forceinline__ void ph_glafin(const float* OC, const bf16* proj, const float* og, bf16* YC, int vb, int nvb) {
    const int tid_ = otid(); const int lane = tid_ & 63, wave = tid_ >> 6;
    for (int it = vb * 8 + wave; it < MP * 4; it += nvb * 8) {
        const int r = it >> 2, h = it & 3;
        const v4f o = *(const v4f*)(OC + (size_t)r * 1024 + h * 256 + lane * 4);
        const float ss = wave_sum(o.x * o.x + o.y * o.y + o.z * o.z + o.w * o.w);
        const float rn = 1.0f / sqrtf(ss * (1.0f / 256.f) + EPS);
        const v4f g = *(const v4f*)(og + lane * 4);
        const v2u zw = *(const v2u*)(proj + (size_t)r * NPROJ + C_ZC + h * 256 + lane * 4);
        v2u w; w.x = pk2(o.x * rn * g.x * silu_f(lo16(zw.x)), o.y * rn * g.y * silu_f(hi16(zw.x))); w.y = pk2(o.z * rn * g.z * silu_f(lo16(zw.y)), o.w * rn * g.w * silu_f(hi16(zw.y)));
        *(v2u*)(YC + (size_t)r * 1024 + h * 256 + lane * 4) = w;
    }
}
__device__ __forceinline__ void ph_merge(const bf16* proj, const bf16* PB, bf16* MG, int vb, int nvb) {
    for (size_t idx = (size_t)vb * 512 + otid(); idx < (size_t)MP * 1024; idx += (size_t)nvb * 512) {
        const int r = (int)(idx >> 10), j = (int)(idx & 1023) * 2;
        float m0 = 0.f, m1 = 0.f;
#pragma unroll
        for (int b = 0; b < 3; ++b) { const unsigned gw = *(const unsigned*)(proj + (size_t)r * NPROJ + C_GATE + b * 2048 + j), pw = *(const unsigned*)(PB + ((size_t)b * MP + r) * 2048 + j);
            m0 += sigmoid_f(lo16(gw)) * lo16(pw); m1 += sigmoid_f(hi16(gw)) * hi16(pw); }
        *(unsigned*)(MG + (size_t)r * 2048 + j) = pk2(m0, m1);
    }
}
__device__ __forceinline__ void ph_outadd(const float* xin, const float* U, float* xout, int vb, int nvb) {
    for (size_t idx = (size_t)vb * 512 + otid(); idx < (size_t)MP * 512; idx += (size_t)nvb * 512) {
        const v4f a = ((const v4f*)xin)[idx], u = ((const v4f*)U)[idx]; ((v4f*)xout)[idx] = a + u; }
}

__global__ void __launch_bounds__(512, 2) fwd(Args a) {
    extern __shared__ __attribute__((aligned(16))) unsigned char lds_raw[];
    LAS unsigned char* lds = (LAS unsigned char*)lds_raw;
    const int tid = threadIdx.x, vb = blockIdx.x, nvb = gridDim.x;
    unsigned char* ws = a.ws;
    const int lo = a.lo, hi = a.hi;
    const bool multi = (hi - lo) > 1;
    XcdBarrier bar; bar.bar = (unsigned*)(ws + WS_CTL) + CW_BAR; bar.x = 0; bar.st = nullptr;
    if (multi) {
        if (tid < 4) ((LAS unsigned*)(lds + LDSCTL_OFF))[tid] = 0u;
        __syncthreads();
        bar = xcd_barrier_post((unsigned*)(ws + WS_CTL) + CW_BAR, (volatile LAS unsigned*)(lds + LDSCTL_OFF));
    }
    const float* x = (const float*)a.in[0]; const int* positions = (const int*)a.in[1];
    float* cosT = (float*)(ws + WS_COS); float* sinT = (float*)(ws + WS_SIN);
    bf16* H = (bf16*)(ws + WS_H); bf16* PROJ = (bf16*)(ws + WS_PROJ); bf16* CQN = (bf16*)(ws + WS_CQN); bf16* CKVN = (bf16*)(ws + WS_CKVN); float* RV = (float*)(ws + WS_RV);
    bf16* Qb = (bf16*)(ws + WS_Q); bf16* KVb = (bf16*)(ws + WS_KV); bf16* Kb = (bf16*)(ws + WS_K);
    bf16* YA = (bf16*)(ws + WS_YA); bf16* YB = (bf16*)(ws + WS_YB); bf16* YC = (bf16*)(ws + WS_YC); float* OC = (float*)(ws + WS_OC);
    bf16* PB = (bf16*)(ws + WS_PB); bf16* MG = (bf16*)(ws + WS_MG); float* U = (float*)(ws + WS_U);

    int step = 0;
#define PH_BEGIN if (step >= lo && step < hi) {
#define PH_END   if (step + 1 < hi) xcd_barrier(bar); } ++step;

    PH_BEGIN
        for (int l = 0; l < DEPTH; ++l) {
            unsigned char* wl = ws + WS_W + (size_t)l * SZ_WLAYER;
            convert_T<1>((const float*)a.in[3] + (size_t)l * DM * IN_COLS, DM, IN_COLS, (bf16*)wl, NPROJ, (LAS float*)lds, vb, nvb);
            convert_T<0>((const float*)a.in[6] + (size_t)l * 512 * 1536, 512, 1536, (bf16*)(wl + SZ_WIN), 1536, (LAS float*)lds, (vb + 64) % nvb, nvb);
            convert_T<0>((const float*)a.in[7] + (size_t)l * 512 * 2048, 512, 2048, (bf16*)(wl + SZ_WIN + SZ_WUQ), 2048, (LAS float*)lds, (vb + 128) % nvb, nvb);
            for (int b = 0; b < 3; ++b)
                convert_T<0>((const float*)a.in[16] + ((size_t)l * 3 + b) * 1024 * 2048, 1024, 2048, (bf16*)(wl + SZ_WIN + SZ_WUQ + SZ_WUKV) + (size_t)b * 2048 * 1024, 2048, (LAS float*)lds, (vb + 32 * b) % nvb, nvb);
            convert_T<0>((const float*)a.in[17] + (size_t)l * 2048 * 2048, 2048, 2048, (bf16*)(wl + SZ_WIN + SZ_WUQ + SZ_WUKV + SZ_WB), 2048, (LAS float*)lds, (vb + 192) % nvb, nvb);
        }
        for (int idx = vb * 512 + tid; idx < MTOK * 32; idx += nvb * 512) {
            const int t = idx >> 5, i = idx & 31;
            const float inv = 1.0f / powf(10000.0f, (float)(2 * i) * (1.0f / 64.0f));
            const float ang = (float)positions[t] * inv;
            float sn, cs; sincosf(ang, &sn, &cs);
            cosT[idx] = cs; sinT[idx] = sn;
        }
    PH_END

    for (int l = 0; l < DEPTH; ++l) {
        const unsigned char* wl = ws + WS_W + (size_t)l * SZ_WLAYER;
        const bf16* WinT = (const bf16*)wl; const bf16* WuqT = (const bf16*)(wl + SZ_WIN); const bf16* WukvT = (const bf16*)(wl + SZ_WIN + SZ_WUQ);
        const bf16* WbT = (const bf16*)(wl + SZ_WIN + SZ_WUQ + SZ_WUKV); const bf16* WoT = (const bf16*)(wl + SZ_WIN + SZ_WUQ + SZ_WUKV + SZ_WB);
        const float* xin_all = l == 0 ? x : a.out;
        for (int p = 0; p < NPASS; ++p) {
            const int row0 = p * MP;
            const float* xin = xin_all + (size_t)row0 * DM;
            PH_BEGIN ph_norm(xin, (const float*)a.in[2] + l * DM, H, MP, vb, nvb); PH_END
            PH_BEGIN { pg8::Gemm g{H, WinT, MP, NPROJ, DM}; pg8::StaticOrder S; S.init(MP, NPROJ, nvb, vb); pg8::EpiBf16<0> E{PROJ, NPROJ, nullptr, 0, 0};
                       pg8::gemm_phase<pg8::EpiBf16<0>, pg8::StaticOrder>(lds, g, S, E, nullptr); } PH_END
            PH_BEGIN ph_prep(PROJ, (const float*)a.in[4] + l * 512, (const float*)a.in[5] + l * 512, CQN, CKVN, RV, vb, nvb); PH_END
            PH_BEGIN { { pg8::Gemm g{CQN, WuqT, MP, 1536, 512}; pg8::StaticOrder S; S.init(MP, 1536, nvb, vb); pg8::EpiBf16<0> E{Qb, 1536, nullptr, 0, 0};
                         pg8::gemm_phase<pg8::EpiBf16<0>, pg8::StaticOrder>(lds, g, S, E, nullptr); }
                       { pg8::Gemm g{CKVN, WukvT, MP, 2048, 512}; pg8::StaticOrder S; S.init(MP, 2048, nvb, vb); pg8::EpiBf16<0> E{KVb, 2048, nullptr, 0, 0};
                         pg8::gemm_phase<pg8::EpiBf16<0>, pg8::StaticOrder>(lds, g, S, E, nullptr); } } PH_END
            PH_BEGIN ph_qkfin(Qb, KVb, PROJ, Kb, (const float*)a.in[8] + l * 192, (const float*)a.in[9] + l * 192, cosT, sinT, row0, vb, nvb); PH_END
            PH_BEGIN ph_attn_naive(Qb, Kb, KVb, PROJ, YA, (LAS float*)lds, vb, nvb); PH_END
            PH_BEGIN ph_sgu_naive(PROJ, RV, (const float*)a.in[11] + (size_t)l * 8 * 128 * 128, (const float*)a.in[12] + l * 8 * 128, (const float*)a.in[10] + l * 1024, YB, vb, nvb); PH_END
            PH_BEGIN ph_gla_naive(PROJ, (const float*)a.in[13] + l * 16 * 512, (const float*)a.in[14] + l * 512, OC, (LAS float*)lds, vb, nvb); PH_END
            PH_BEGIN ph_glafin(OC, PROJ, (const float*)a.in[15] + l * 256, YC, vb, nvb); PH_END
            PH_BEGIN for (int b = 0; b < 3; ++b) { pg8::Gemm g{b == 0 ? YA : (b == 1 ? YB : YC), WbT + (size_t)b * 2048 * 1024, MP, 2048, 1024}; pg8::StaticOrder S; S.init(MP, 2048, nvb, (vb + 85 * b) % nvb);
                       pg8::EpiBf16<0> E{PB + (size_t)b * MP * 2048, 2048, nullptr, 0, 0}; pg8::gemm_phase<pg8::EpiBf16<0>, pg8::StaticOrder>(lds, g, S, E, nullptr); } PH_END
            PH_BEGIN ph_merge(PROJ, PB, MG, vb, nvb); PH_END
            PH_BEGIN { pg8::Gemm g{MG, WoT, MP, 2048, 2048}; pg8::StaticOrder S; S.init(MP, 2048, nvb, vb); pg8::EpiF32 E{U, 2048, nullptr};
                       pg8::gemm_phase<pg8::EpiF32, pg8::StaticOrder>(lds, g, S, E, nullptr); } PH_END
            PH_BEGIN ph_outadd(xin, U, a.out + (size_t)row0 * DM, vb, nvb); PH_END
        }
    }
#undef PH_BEGIN
#undef PH_END
}

#ifndef ONE_LAUNCH
#define ONE_LAUNCH 0
#endif
extern "C" void kernel_launch(void* const* d_in, const int* in_sizes, int n_in, void* d_out, int out_size, void* d_ws, size_t ws_size, hipStream_t stream) {
    static int grid = 0;
    if (grid == 0) {
        if (n_in != 18 || out_size != MTOK * DM || ws_size < WS_END) { fprintf(stderr, "kernel_launch: unexpected shapes (n_in %d out %d ws %zu need %zu)\n", n_in, out_size, ws_size, (size_t)WS_END); grid = -1; return; }
        int dev = 0, cus = 0, per_cu = 0;
        if (hipGetDevice(&dev) != hipSuccess || hipDeviceGetAttribute(&cus, hipDeviceAttributeMultiprocessorCount, dev) != hipSuccess) { grid = -1; return; }
        if (hipFuncSetAttribute((const void*)fwd, hipFuncAttributeMaxDynamicSharedMemorySize, LDS_BYTES) != hipSuccess) { fprintf(stderr, "kernel_launch: hipFuncSetAttribute failed\n"); grid = -1; return; }
        if (hipOccupancyMaxActiveBlocksPerMultiprocessor(&per_cu, (const void*)fwd, 512, LDS_BYTES) != hipSuccess || per_cu < 1) { fprintf(stderr, "kernel_launch: occupancy query says %d\n", per_cu); }
        (void)hipGetLastError();
        grid = cus;
    }
    if (grid < 0) return;
    (void)hipMemsetAsync((char*)d_ws + WS_CTL, 0, CTL_BYTES, stream);
    Args a{};
    for (int i = 0; i < 18; ++i) a.in[i] = d_in[i];
    a.out = (float*)d_out; a.ws = (unsigned char*)d_ws; a.pad0 = 0; a.pad1 = 0;
#if ONE_LAUNCH
    a.lo = 0; a.hi = NSTEPS;
    hipLaunchKernelGGL(fwd, dim3(grid), dim3(512), LDS_BYTES, stream, a);
#else
    for (int s = 0; s < NSTEPS; ++s) { a.lo = s; a.hi = s + 1; hipLaunchKernelGGL(fwd, dim3(grid), dim3(512), LDS_BYTES, stream, a); }
#endif
}
```

```cpp
#include <hip/hip_runtime.h>
#include <cstdio>
#include <cstdint>
__device__ __forceinline__ int otid() { int t = threadIdx.x; asm volatile("" : "+v"(t)); return t; }
__device__ __forceinline__ int obid() { int t = blockIdx.x; asm volatile("" : "+s"(t)); return t; }
namespace pg8 {
#define PG8_LAS __attribute__((address_space(3)))
typedef unsigned short bf16_t;
typedef short bf16x8 __attribute__((ext_vector_type(8)));
typedef float f32x4 __attribute__((ext_vector_type(4)));
typedef unsigned u32x4 __attribute__((ext_vector_type(4)));
constexpr int BM = 256, BK = 64, HALF = 128, HTB = HALF * BK * 2  , STAGE_BYTES = 8 * HTB, NXCD = 8, WGM = 8;

__host__ __device__ __forceinline__ int lds_byte(int r, int c) { const int st = (r >> 4) * 2 + (c >> 5), rr = r & 15, cc = c & 31, ob = rr * 64 + cc * 2; return st * 1024 + (ob ^ (((ob >> 9) & 1) << 5)); }
__host__ __device__ __forceinline__ void stage_rc(int b, int& R, int& C) { const int st = b / 1024, sb = b % 1024, swz = sb ^ (((sb >> 9) & 1) << 5); R = (st >> 1) * 16 + swz / 64; C = (st & 1) * 32 + (swz % 64) / 2; }
__host__ __device__ __forceinline__ int perm32(int rho) { const int n = rho >> 4, i = rho & 15; return 8 * (i >> 2) + 4 * n + (i & 3); }

struct Unit { int pm, pn; };
struct Gemm { const bf16_t* A; const bf16_t* Bt; int M, N, K; };

struct StaticOrder {
    int nM, nN, nwg, G, c;
    __host__ __device__ void init(int M, int N, int G_, int c_) { nM = M / BM; nN = N / BM; nwg = nM * nN; G = G_; c = c_; }
    __host__ __device__ bool next(int i, Unit& u) const {
        const long L = (long)i * G + c; if (L >= nwg) return false;
        int wgid = (int)L; { const int q = nwg / NXCD, r = nwg % NXCD, xcd = wgid % NXCD, off = wgid / NXCD; wgid = (xcd < r ? xcd * (q + 1) : r * (q + 1) + (xcd - r) * q) + off; }
        const int nig = WGM * nN, gid = wgid / nig, fm = gid * WGM, gsz = (nM - fm) < WGM ? (nM - fm) : WGM;
        u.pm = fm + ((wgid % nig) % gsz); u.pn = (wgid % nig) / gsz; return true;
    }
    __device__ __forceinline__ void a_ready(const Unit&) const {}
    __device__ __forceinline__ void done(const Unit&) const {}
};

__device__ __forceinline__ unsigned cvt_pk_bf16(float lo, float hi) { unsigned r; asm volatile("v_cvt_pk_bf16_f32 %0, %1, %2" : "=v"(r) : "v"(lo), "v"(hi)); return r; }
typedef float f32x2 __attribute__((ext_vector_type(2)));
__device__ __forceinline__ f32x2 gelu_pk(f32x2 v) {
    const f32x2 av = __builtin_elementwise_abs(v), d = av * 0.2316418882f + 1.0f;
    f32x2 t; t.x = __builtin_amdgcn_rcpf(d.x); t.y = __builtin_amdgcn_rcpf(d.y);
    f32x2 q = t * 0.5307027145f + (-0.7265760135f); q = q * t + 0.7107068705f; q = q * t + (-0.142248368f); q = q * t + 0.127414796f; q = q * t;
    const f32x2 s = (v * v) * (-0.72134752044f);
    f32x2 e; e.x = __builtin_amdgcn_exp2f(s.x); e.y = __builtin_amdgcn_exp2f(s.y);
    const f32x2 m = v * (q * e), r = v - m;
    f32x2 o; o.x = v.x < 0.f ? m.x : r.x; o.y = v.y < 0.f ? m.y : r.y; return o;
}

struct EpiF32 {
    static constexpr bool PERM = false, AFTER_DRAIN = false;
    float* C; int ldc; const float* bias;
    __device__ __forceinline__ void operator()(const f32x4 (&acc)[2][2][4][2], const Unit& u, int wr, int wc, int fr, int fq) const {
        const int row0 = u.pm * BM + wr * 64 + fr, col0 = u.pn * BM + wc * 32 + 4 * fq;
        f32x4 bv[2][2];
#pragma unroll
        for (int bj = 0; bj < 2; ++bj)
#pragma unroll
            for (int n = 0; n < 2; ++n) bv[bj][n] = bias ? *(const f32x4*)(bias + col0 + bj * HALF + n * 16) : (f32x4){0.f, 0.f, 0.f, 0.f};
#pragma unroll
        for (int ai = 0; ai < 2; ++ai)
#pragma unroll
            for (int m = 0; m < 4; ++m) { float* rowp = C + (size_t)(row0 + ai * HALF + m * 16) * ldc + col0;
#pragma unroll
                for (int bj = 0; bj < 2; ++bj)
#pragma unroll
                    for (int n = 0; n < 2; ++n) *(f32x4*)(rowp + bj * HALF + n * 16) = acc[ai][bj][m][n] + bv[bj][n]; }
    }
};
template <int ACT  > struct EpiBf16 {
    static constexpr bool PERM = true, AFTER_DRAIN = false;
    bf16_t* O; int ldc; const float* bias; int split_cols; size_t split_stride;
    __device__ __forceinline__ void operator()(const f32x4 (&acc)[2][2][4][2], const Unit& u, int wr, int wc, int fr, int fq) const {
        const int row0 = u.pm * BM + wr * 64 + fr; int colt = u.pn * BM; bf16_t* base = O;
        if (split_cols) { const int t = colt / split_cols; base += (size_t)t * split_stride; colt -= t * split_cols; }
        const int col0 = colt + wc * 32 + 8 * fq, bcol0 = u.pn * BM + wc * 32 + 8 * fq;
        f32x4 bv[2][2];
#pragma unroll
        for (int bj = 0; bj < 2; ++bj)
#pragma unroll
            for (int n = 0; n < 2; ++n) bv[bj][n] = bias ? *(const f32x4*)(bias + bcol0 + bj * HALF + 4 * n) : (f32x4){0.f, 0.f, 0.f, 0.f};
#pragma unroll
        for (int ai = 0; ai < 2; ++ai)
#pragma unroll
            for (int m = 0; m < 4; ++m) { bf16_t* rowp = base + (size_t)(row0 + ai * HALF + m * 16) * ldc + col0;
#pragma unroll
                for (int bj = 0; bj < 2; ++bj) { f32x4 v0 = acc[ai][bj][m][0] + bv[bj][0], v1 = acc[ai][bj][m][1] + bv[bj][1];
                    if (ACT == 1) { f32x2 a = gelu_pk((f32x2){v0[0], v0[1]}), b = gelu_pk((f32x2){v0[2], v0[3]}), c = gelu_pk((f32x2){v1[0], v1[1]}), d = gelu_pk((f32x2){v1[2], v1[3]});
                        v0 = (f32x4){a.x, a.y, b.x, b.y}; v1 = (f32x4){c.x, c.y, d.x, d.y}; }
                    if (ACT == 2) {
#pragma unroll
                        for (int j = 0; j < 4; ++j) { v0[j] = 0.5f * v0[j] * (1.0f + erff(v0[j] * 0.70710678f)); v1[j] = 0.5f * v1[j] * (1.0f + erff(v1[j] * 0.70710678f)); } }
                    u32x4 w; w.x = cvt_pk_bf16(v0[0], v0[1]); w.y = cvt_pk_bf16(v0[2], v0[3]); w.z = cvt_pk_bf16(v1[0], v1[1]); w.w = cvt_pk_bf16(v1[2], v1[3]);
                    *(u32x4*)(rowp + bj * HALF) = w; } }
    }
};

template <class Epi, class Sched, bool STAMP = false>
__device__ __forceinline__ void gemm_phase(PG8_LAS unsigned char* lds, const Gemm g, const Sched& S, const Epi& E, unsigned long long* stamps) {
    const int tid = otid(), wid = __builtin_amdgcn_readfirstlane(tid >> 6), lane = tid & 63, wr = wid >> 2, wc = wid & 3, fr = lane & 15, fq = lane >> 4;
    const int K = g.K, nt = K / BK;
    int ts_lo = 0, ts_hi = 0, nts = 0; const unsigned long long rt_entry = STAMP ? (unsigned long long)wall_clock64() : 0ull;
#define PG8_STAMP() do { if (STAMP && wid == 0 && nts < 64) { const unsigned long long _c = (unsigned long long)clock64(); \
        ts_lo = (lane == nts) ? (int)(unsigned)_c : ts_lo; ts_hi = (lane == nts) ? (int)(unsigned)(_c >> 32) : ts_hi; ++nts; } } while (0)
    PG8_STAMP();
    unsigned voffA[2], voffB[2];
#pragma unroll
    for (int i = 0; i < 2; ++i) { int R, C; stage_rc(tid * 16 + i * 8192, R, C); const int Rb = Epi::PERM ? ((R & ~31) + perm32(R & 31)) : R;
        voffA[i] = (unsigned)(R * K + C) * 2u; voffB[i] = (unsigned)(Rb * K + C) * 2u; }
    const size_t kstep = (size_t)(BK * 2);
    const size_t hstep = (size_t)HALF * K * 2;
    const size_t tstep = 2 * hstep;
    const unsigned ldsw = (unsigned)wid * 1024u;
    const int aoff = lds_byte(wr * 64 + fr, fq * 8), boff = lds_byte(wc * 32 + fr, fq * 8);
#define PG8_SA(b, h) (((b) * 2 + (h)) * HTB)
#define PG8_SB(b, h) ((4 + (b) * 2 + (h)) * HTB)
#define PG8_STAGE(bufoff, gbase, voff) do { _Pragma("unroll") for (int _i = 0; _i < 2; ++_i) \
        __builtin_amdgcn_global_load_lds((const unsigned*)((const char*)(gbase) + (voff)[_i]), (PG8_LAS unsigned*)(lds + (bufoff) + ldsw + _i * 8192), 16, 0, 0); } while (0)
#define PG8_LDA(dst, b, h) do { _Pragma("unroll") for (int m = 0; m < 4; ++m) _Pragma("unroll") for (int k = 0; k < 2; ++k) dst[m][k] = *(const PG8_LAS bf16x8*)(lds + PG8_SA(b, h) + aoff + m * 2048 + k * 1024); } while (0)
#define PG8_LDB(dst, b, h) do { _Pragma("unroll") for (int n = 0; n < 2; ++n) _Pragma("unroll") for (int k = 0; k < 2; ++k) dst[n][k] = *(const PG8_LAS bf16x8*)(lds + PG8_SB(b, h) + boff + n * 2048 + k * 1024); } while (0)
#define PG8_MMA(ai, bj, At, Bt) do { __builtin_amdgcn_s_setprio(1); _Pragma("unroll") for (int m = 0; m < 4; ++m) _Pragma("unroll") for (int n = 0; n < 2; ++n) _Pragma("unroll") for (int k = 0; k < 2; ++k) \
        acc[ai][bj][m][n] = __builtin_amdgcn_mfma_f32_16x16x32_bf16(Bt[n][k], At[m][k], acc[ai][bj][m][n], 0, 0, 0); __builtin_amdgcn_s_setprio(0); } while (0)
#define PG8_WAIT_V(n) asm volatile("s_waitcnt vmcnt(" #n ")" ::: "memory")
#define PG8_WAIT_L(n) asm volatile("s_waitcnt lgkmcnt(" #n ")" ::: "memory")
#define PG8_BAR __builtin_amdgcn_s_barrier()
#define PG8_SCHED __builtin_amdgcn_sched_barrier(0)
    Unit cur, nxt; int ui = 0;
    if (!S.next(0, cur)) return;
    f32x4 acc[2][2][4][2];
#pragma unroll
    for (int a = 0; a < 2; ++a)
#pragma unroll
        for (int b = 0; b < 2; ++b)
#pragma unroll
            for (int m = 0; m < 4; ++m)
#pragma unroll
                for (int n = 0; n < 2; ++n) acc[a][b][m][n] = (f32x4){0.f, 0.f, 0.f, 0.f};
    bf16x8 At[4][2], B0[2][2], B1[2][2];
    const char* cA = (const char*)g.A + (size_t)cur.pm * tstep; const char* cB = (const char*)g.Bt + (size_t)cur.pn * tstep;
    S.a_ready(cur);
    PG8_STAGE(PG8_SB(0, 0), cB, voffB); PG8_STAGE(PG8_SA(0, 0), cA, voffA); PG8_STAGE(PG8_SB(0, 1), cB + hstep, voffB); PG8_STAGE(PG8_SA(0, 1), cA + hstep, voffA);
    if (wr == 1) PG8_BAR;
    PG8_WAIT_V(4); PG8_BAR;
    PG8_STAGE(PG8_SB(1, 0), cB + kstep, voffB); PG8_STAGE(PG8_SA(1, 0), cA + kstep, voffA); PG8_STAGE(PG8_SB(1, 1), cB + hstep + kstep, voffB);
    PG8_WAIT_V(6); PG8_BAR;
    PG8_STAMP();
    for (;;) {
        const bool has_next = S.next(ui + 1, nxt);
        const char* nA = has_next ? (const char*)g.A + (size_t)nxt.pm * tstep : cA; const char* nB = has_next ? (const char*)g.Bt + (size_t)nxt.pn * tstep : cB;
        for (int t = 0; t < nt; t += 2) {
            const bool last = (t == nt - 2);
            const char* a1 = cA + (size_t)(t + 1) * kstep;
            const char* a2 = last ? nA : cA + (size_t)(t + 2) * kstep; const char* b2 = last ? nB : cB + (size_t)(t + 2) * kstep;
            const char* a3 = a2 + kstep; const char* b3 = b2 + kstep;
            if (last && has_next) S.a_ready(nxt);
            PG8_LDB(B0, 0, 0); PG8_SCHED; PG8_LDA(At, 0, 0); PG8_STAGE(PG8_SA(1, 1), a1 + hstep, voffA);
            PG8_WAIT_L(8); PG8_BAR; PG8_WAIT_L(0); PG8_MMA(0, 0, At, B0); PG8_BAR; PG8_SCHED;
            PG8_LDB(B1, 0, 1); PG8_STAGE(PG8_SB(0, 0), b2, voffB);
            PG8_BAR; PG8_WAIT_L(0); PG8_MMA(0, 1, At, B1); PG8_BAR;
            PG8_LDA(At, 0, 1); PG8_STAGE(PG8_SA(0, 0), a2, voffA);
            PG8_BAR; PG8_WAIT_L(0); PG8_MMA(1, 0, At, B0); PG8_BAR; PG8_SCHED;
            PG8_STAGE(PG8_SB(0, 1), b2 + hstep, voffB);
            PG8_WAIT_V(6); PG8_BAR; PG8_MMA(1, 1, At, B1); PG8_BAR;
            PG8_LDB(B0, 1, 0); PG8_SCHED; PG8_LDA(At, 1, 0); PG8_STAGE(PG8_SA(0, 1), a2 + hstep, voffA);
            PG8_WAIT_L(8); PG8_BAR; PG8_WAIT_L(0); PG8_MMA(0, 0, At, B0); PG8_BAR; PG8_SCHED;
            PG8_LDB(B1, 1, 1); PG8_STAGE(PG8_SB(1, 0), b3, voffB);
            PG8_BAR; PG8_WAIT_L(0); PG8_MMA(0, 1, At, B1); PG8_BAR;
            PG8_LDA(At, 1, 1); PG8_STAGE(PG8_SA(1, 0), a3, voffA);
            PG8_BAR; PG8_WAIT_L(0); PG8_MMA(1, 0, At, B0); PG8_BAR; PG8_SCHED;
            PG8_STAGE(PG8_SB(1, 1), b3 + hstep, voffB);
            PG8_WAIT_V(6); PG8_BAR; PG8_MMA(1, 1, At, B1); PG8_BAR;
        }
        PG8_STAMP();
        if constexpr (!Epi::AFTER_DRAIN) { E(acc, cur, wr, wc, fr, fq); S.done(cur); }
        PG8_STAMP();
        if (!has_next) break;
#pragma unroll
        for (int a = 0; a < 2; ++a)
#pragma unroll
            for (int b = 0; b < 2; ++b)
#pragma unroll
                for (int m = 0; m < 4; ++m)
#pragma unroll
                    for (int n = 0; n < 2; ++n) acc[a][b][m][n] = (f32x4){0.f, 0.f, 0.f, 0.f};
        cur = nxt; cA = nA; cB = nB; ++ui;
    }
    PG8_WAIT_V(0);
    if (wr == 0) PG8_BAR;
    PG8_BAR;
    if constexpr (Epi::AFTER_DRAIN) { E.fused(acc, cur, wr, wc, fr, fq, lds, wid, lane); S.done(cur); }
    PG8_STAMP();
    if (STAMP && wid == 0) { stamps[lane] = lane < nts ? (((unsigned long long)(unsigned)ts_hi << 32) | (unsigned)ts_lo) : 0ull;
        if (lane == 62) stamps[62] = rt_entry; if (lane == 63) stamps[63] = (unsigned long long)wall_clock64(); }
#undef PG8_STAMP
#undef PG8_SA
#undef PG8_SB
#undef PG8_STAGE
#undef PG8_LDA
#undef PG8_LDB
#undef PG8_MMA
#undef PG8_WAIT_V
#undef PG8_WAIT_L
#undef PG8_BAR
#undef PG8_SCHED
}
}
#define XB_TMO      128
#define XB_XCNT(j)  (256  + 64 * (j))
#define XB_XSUB(j)  (1280 + 64 * (j))
#define XB_XGEN(j)  (2304 + 64 * (j))
#define XB_TOP      3328
#define XB_TOPGEN   3392
#define XCD_BAR_WORDS 3456
#define XB_SPIN_CAP (1u << 18)
#define LAS __attribute__((address_space(3)))

__device__ __forceinline__ unsigned xb_ld(unsigned* p)              { return __hip_atomic_load(p, __ATOMIC_RELAXED, __HIP_MEMORY_SCOPE_AGENT); }
__device__ __forceinline__ unsigned xb_add(unsigned* p, unsigned v) { return __hip_atomic_fetch_add(p, v, __ATOMIC_RELAXED, __HIP_MEMORY_SCOPE_AGENT); }
__device__ __forceinline__ unsigned xb_xcc_id() { return (unsigned)__builtin_amdgcn_s_getreg((3 << 11) | 20) & 0xFu; }
#define XB_SPIN(cond, bar) do { unsigned _sp = 0; while (cond) { __builtin_amdgcn_s_sleep(1); \
    if ((++_sp & 255u) == 0u) { if (xb_ld(&(bar)[XB_TMO])) break; if (_sp > XB_SPIN_CAP) { atomicAdd(&(bar)[XB_TMO], 1u); break; } } } } while (0)

struct XcdBarrier {
    unsigned* bar; unsigned x;
    volatile LAS unsigned* st;
};

__device__ __forceinline__ XcdBarrier xcd_barrier_post(unsigned* bar, volatile LAS unsigned* st) {
    XcdBarrier b; b.bar = bar; b.x = xb_xcc_id(); b.st = st;
    if (threadIdx.x == 0) (void)xb_add(&bar[XB_XCNT(b.x)], 1u);
    return b;
}
__device__ __forceinline__ void xcd_barrier_complete(unsigned* bar, unsigned x, unsigned& nloc, unsigned& nx) {
    const unsigned G = gridDim.x * gridDim.y * gridDim.z;
    unsigned sum, cnt, mine, sp = 0u;
    for (;;) {
        sum = 0u; cnt = 0u; mine = 0u;
#pragma unroll
        for (unsigned j = 0; j < 16; ++j) { const unsigned c = xb_ld(&bar[XB_XCNT(j)]); sum += c; cnt += (c > 0u) ? 1u : 0u; mine = (j == x) ? c : mine; }
        if (sum == G) break;
        __builtin_amdgcn_s_sleep(1);
        if ((++sp & 255u) == 0u) { if (xb_ld(&bar[XB_TMO])) break; if (sp > XB_SPIN_CAP) { atomicAdd(&bar[XB_TMO], 1u); break; } }
    }
    nloc = mine > 0u ? mine : 1u; nx = cnt > 0u ? cnt : 1u;
}

__device__ __forceinline__ void xcd_barrier(const XcdBarrier& b) {
    asm volatile("s_waitcnt vmcnt(0)" ::: "memory");
    __syncthreads();
    if (threadIdx.x == 0) {
        unsigned* bar = b.bar;
        __builtin_amdgcn_s_waitcnt(0);
        unsigned nloc = b.st[0], nx = b.st[1];
        if (nloc == 0u) { xcd_barrier_complete(bar, b.x, nloc, nx); b.st[0] = nloc; b.st[1] = nx; }
        const unsigned old = xb_add(&bar[XB_XSUB(b.x)], 1u);
        const unsigned gen = old / nloc;
        if (old + 1u == (gen + 1u) * nloc) {
            __builtin_amdgcn_fence(__ATOMIC_RELEASE, "agent");
            asm volatile("s_waitcnt vmcnt(0)" ::: "memory");
            const unsigned og = xb_add(&bar[XB_TOP], 1u);
            const unsigned tg = og / nx;
            if (og + 1u == (tg + 1u) * nx) xb_add(&bar[XB_TOPGEN], 1u);
            else XB_SPIN(xb_ld(&bar[XB_TOPGEN]) == tg, bar);
            __builtin_amdgcn_fence(__ATOMIC_ACQUIRE, "agent");
            xb_add(&bar[XB_XGEN(b.x)], 1u);
            asm volatile("s_waitcnt vmcnt(0)" ::: "memory");
        } else {
            XB_SPIN(xb_ld(&bar[XB_XGEN(b.x)]) == gen, bar);
            __builtin_amdgcn_fence(__ATOMIC_ACQUIRE, "agent");
            asm volatile("s_waitcnt vmcnt(0)" ::: "memory");
        }
    }
    __syncthreads();
}


typedef unsigned short bf16;
typedef unsigned v4u __attribute__((ext_vector_type(4)));
typedef unsigned v2u __attribute__((ext_vector_type(2)));
typedef float v4f __attribute__((ext_vector_type(4)));

constexpr int DM = 2048, NBATCH = 8, SEQ = 4096, DEPTH = 2, MTOK = NBATCH * SEQ;
constexpr int IN_COLS = 14416, NPROJ = 14592;
constexpr int C_CQ = 0, C_CKV = 512, C_ZA = 1024, C_UB = 2048, C_VB = 3072, C_ZB = 4096, C_QC = 5120, C_KC = 5632, C_VC = 6144, C_ZC = 7168,
              C_GATE = 8192, C_KROPE = 14336, C_AR = 14400;
constexpr float EPS = 1e-6f;
#ifndef NBP
#define NBP 2
#endif
constexpr int MP = NBP * SEQ, NPASS = NBATCH / NBP;
constexpr int STEPS_PER_PASS = 13;
constexpr int NSTEPS = 1 + DEPTH * NPASS * STEPS_PER_PASS;

constexpr size_t al256(size_t x) { return (x + 255) & ~(size_t)255; }
constexpr size_t WS_CTL = 0, CTL_BYTES = 1u << 20;
constexpr size_t SZ_WIN = (size_t)NPROJ * DM * 2, SZ_WUQ = (size_t)1536 * 512 * 2, SZ_WUKV = (size_t)2048 * 512 * 2, SZ_WB = (size_t)3 * 2048 * 1024 * 2, SZ_WO = (size_t)2048 * 2048 * 2;
constexpr size_t SZ_WLAYER = SZ_WIN + SZ_WUQ + SZ_WUKV + SZ_WB + SZ_WO;
constexpr size_t WS_W = CTL_BYTES;
constexpr size_t WS_COS = WS_W + DEPTH * SZ_WLAYER, WS_SIN = WS_COS + (size_t)MTOK * 32 * 4;
constexpr size_t WS_H = WS_SIN + (size_t)MTOK * 32 * 4;
constexpr size_t WS_PROJ = WS_H + (size_t)MP * DM * 2;
constexpr size_t WS_CQN = WS_PROJ + (size_t)MP * NPROJ * 2;
constexpr size_t WS_CKVN = WS_CQN + (size_t)MP * 512 * 2;
constexpr size_t WS_RV = WS_CKVN + (size_t)MP * 512 * 2;
constexpr size_t WS_Q = WS_RV + al256((size_t)MP * 4);
constexpr size_t WS_KV = WS_Q + (size_t)MP * 1536 * 2;
constexpr size_t WS_K = WS_KV + (size_t)MP * 2048 * 2;
constexpr size_t WS_YA = WS_K + (size_t)MP * 1536 * 2;
constexpr size_t WS_YB = WS_YA + (size_t)MP * 1024 * 2;
constexpr size_t WS_YC = WS_YB + (size_t)MP * 1024 * 2;
constexpr size_t WS_OC = WS_YC + (size_t)MP * 1024 * 2;
constexpr size_t WS_PB = WS_OC + (size_t)MP * 1024 * 4;
constexpr size_t WS_MG = WS_PB + (size_t)3 * MP * 2048 * 2;
constexpr size_t WS_U = WS_MG + (size_t)MP * 2048 * 2;
constexpr size_t WS_QE = WS_U + (size_t)MP * 2048 * 4;
constexpr size_t WS_KE = WS_QE + (size_t)MP * 512 * 2, WS_KL = WS_KE + (size_t)MP * 512 * 2;
constexpr size_t WS_DS = WS_KL + (size_t)MP * 512 * 2;
constexpr size_t WS_END = WS_DS + (size_t)(MP / 128) * 512 * 4;
static_assert(WS_END <= ((size_t)1 << 30), "workspace map exceeds 1 GiB");

constexpr int LDS_BYTES = 147456;
constexpr int LDSCTL_OFF = LDS_BYTES - 256;
constexpr int CW_BAR = 4096;

__device__ __forceinline__ float bf2f(unsigned v) { return __uint_as_float(v << 16); }
__device__ __forceinline__ unsigned f2bf(float f) { unsigned u = __float_as_uint(f); return (u + 0x7fffu + ((u >> 16) & 1u)) >> 16; }
__device__ __forceinline__ unsigned pk2(float lo, float hi) { return f2bf(lo) | (f2bf(hi) << 16); }
__device__ __forceinline__ float lo16(unsigned w) { return __uint_as_float(w << 16); }
__device__ __forceinline__ float hi16(unsigned w) { return __uint_as_float(w & 0xffff0000u); }
__device__ __forceinline__ float sigmoid_f(float x) { return 1.f / (1.f + __expf(-x)); }
__device__ __forceinline__ float silu_f(float x) { return x / (1.f + __expf(-x)); }
__device__ __forceinline__ float gelu_f(float x) { const float u = 0.7978845608028654f * (x + 0.044715f * x * x * x); return 0.5f * x * (1.f + tanhf(u)); }
template <int O> __device__ __forceinline__ float lane_xor(float v) {
    if (O == 1) return __uint_as_float((unsigned)__builtin_amdgcn_mov_dpp((int)__float_as_uint(v), 0xB1, 0xf, 0xf, true));
    if (O == 2) return __uint_as_float((unsigned)__builtin_amdgcn_mov_dpp((int)__float_as_uint(v), 0x4E, 0xf, 0xf, true));
    return __uint_as_float((unsigned)__builtin_amdgcn_ds_swizzle((int)__float_as_uint(v), (O << 10) | 0x1f)); }
__device__ __forceinline__ float lane_xor32(float v, int lane) {
    auto rr = __builtin_amdgcn_permlane32_swap(__float_as_uint(v), __float_as_uint(v), false, false);
    return __uint_as_float(lane < 32 ? rr[1] : rr[0]); }
__device__ __forceinline__ float wave_sum(float v) {
    v += lane_xor<1>(v); v += lane_xor<2>(v); v += lane_xor<4>(v); v += lane_xor<8>(v); v += lane_xor<16>(v);
    auto rr = __builtin_amdgcn_permlane32_swap(__float_as_uint(v), __float_as_uint(v), false, false);
    return __uint_as_float(rr[0]) + __uint_as_float(rr[1]); }
__device__ __forceinline__ float wave_max(float v) {
    v = fmaxf(v, lane_xor<1>(v)); v = fmaxf(v, lane_xor<2>(v)); v = fmaxf(v, lane_xor<4>(v)); v = fmaxf(v, lane_xor<8>(v)); v = fmaxf(v, lane_xor<16>(v));
    auto rr = __builtin_amdgcn_permlane32_swap(__float_as_uint(v), __float_as_uint(v), false, false);
    return fmaxf(__uint_as_float(rr[0]), __uint_as_float(rr[1])); }
#define LDS_FENCE() asm volatile("s_waitcnt lgkmcnt(0)" ::: "memory")

struct Args { const void* in[18]; float* out; unsigned char* ws; int lo, hi, pad0, pad1; };

template <int MODE> __device__ __forceinline__ int src_col(int n) {
    if (MODE == 0) return n;
    if (n < C_ZA) return n;
    if (n < C_ZC) return n + 64;
    if (n < C_KROPE) return n + 80;
    if (n < C_AR) return 1024 + (n - C_KROPE);
    if (n < C_AR + 16) return 7232 + (n - C_AR);
    return -1;
}
template <int MODE> __device__ __forceinline__ void convert_T(const float* W, int K, int Nsrc, bf16* WT, int Ndst, LAS float* tile, int vb, int nvb) {
    const int tid = otid(), ntk = K / 64, ntn = Ndst / 64, ntiles = ntk * ntn;
    for (int t = vb; t < ntiles; t += nvb) {
        const int k0 = (t % ntk) * 64, n0 = (t / ntk) * 64;
        { const int nn = tid & 63, sc = src_col<MODE>(n0 + nn);
#pragma unroll
          for (int i = 0; i < 8; ++i) { const int kk = (tid >> 6) + 8 * i; tile[kk * 65 + nn] = sc >= 0 ? W[(size_t)(k0 + kk) * Nsrc + sc] : 0.f; } }
        __syncthreads();
        { const int kk = tid & 63;
#pragma unroll
          for (int i = 0; i < 8; ++i) { const int nn = (tid >> 6) + 8 * i; WT[(size_t)(n0 + nn) * K + k0 + kk] = (bf16)f2bf(tile[kk * 65 + nn]); } }
        __syncthreads();
    }
}

__device__ __forceinline__ void ph_norm(const float* xin, const float* g, bf16* h, int rows, int vb, int nvb) {
    const int tid_ = otid(); const int lane = tid_ & 63, wave = tid_ >> 6;
    for (int r = vb * 8 + wave; r < rows; r += nvb * 8) {
        const v4f* xr = (const v4f*)(xin + (size_t)r * DM);
        v4f v[8]; float ss = 0.f;
#pragma unroll
        for (int j = 0; j < 8; ++j) { v[j] = xr[lane + 64 * j]; ss += v[j].x * v[j].x + v[j].y * v[j].y + v[j].z * v[j].z + v[j].w * v[j].w; }
        ss = wave_sum(ss);
        const float rn = 1.0f / sqrtf(ss * (1.0f / DM) + EPS);
#pragma unroll
        for (int j = 0; j < 8; ++j) { const v4f gg = ((const v4f*)g)[lane + 64 * j];
            v2u o; o.x = pk2(v[j].x * rn * gg.x, v[j].y * rn * gg.y); o.y = pk2(v[j].z * rn * gg.z, v[j].w * rn * gg.w);
            *(v2u*)(h + (size_t)r * DM + (lane + 64 * j) * 4) = o; }
    }
}
__device__ __forceinline__ void ph_prep(const bf16* proj, const float* gq, const float* gkv, bf16* cqn, bf16* ckvn, float* rv, int vb, int nvb) {
    const int tid_ = otid(); const int lane = tid_ & 63, wave = tid_ >> 6;
    for (int r = vb * 8 + wave; r < MP; r += nvb * 8) {
        const bf16* pr = proj + (size_t)r * NPROJ;
#pragma unroll
        for (int which = 0; which < 2; ++which) {
            const v4u w = *(const v4u*)(pr + (which ? C_CKV : C_CQ) + lane * 8);
            float x[8] = {lo16(w.x), hi16(w.x), lo16(w.y), hi16(w.y), lo16(w.z), hi16(w.z), lo16(w.w), hi16(w.w)};
            float ss = 0.f;
#pragma unroll
            for (int i = 0; i < 8; ++i) ss += x[i] * x[i];
            ss = wave_sum(ss);
            const float rn = 1.0f / sqrtf(ss * (1.0f / 512.f) + EPS);
            const float* g = (which ? gkv : gq) + lane * 8;
            v4u o; o.x = pk2(x[0] * rn * g[0], x[1] * rn * g[1]); o.y = pk2(x[2] * rn * g[2], x[3] * rn * g[3]); o.z = pk2(x[4] * rn * g[4], x[5] * rn * g[5]); o.w = pk2(x[6] * rn * g[6], x[7] * rn * g[7]);
            *(v4u*)((which ? ckvn : cqn) + (size_t)r * 512 + lane * 8) = o;
        }
        float ss = 0.f;
#pragma unroll
        for (int j = 0; j < 2; ++j) { const v4u w = *(const v4u*)(pr + C_VB + (lane + 64 * j) * 8);
            const float x[8] = {lo16(w.x), hi16(w.x), lo16(w.y), hi16(w.y), lo16(w.z), hi16(w.z), lo16(w.w), hi16(w.w)};
#pragma unroll
            for (int i = 0; i < 8; ++i) { const float gv = gelu_f(x[i]); ss += gv * gv; } }
        ss = wave_sum(ss);
        if (lane == 0) rv[r] = 1.0f / sqrtf(ss * (1.0f / 1024.f) + EPS);
    }
}
__device__ __forceinline__ void ph_qkfin(bf16* q, const bf16* kv, const bf16* proj, bf16* K, const float* qg, const float* kg, const float* cosT, const float* sinT, int row0, int vb, int nvb) {
    const int tid_ = otid(); const int lane = tid_ & 63, wave = tid_ >> 6;
    for (int it = vb * 8 + wave; it < MP * 8; it += nvb * 8) {
        const int r = it >> 3, hd = it & 7;
        const float c = cosT[(size_t)(row0 + r) * 32 + (lane & 31)], s = sinT[(size_t)(row0 + r) * 32 + (lane & 31)];
        {   bf16* qp = q + ((size_t)r * 8 + hd) * 192;
            const float v0 = bf2f(qp[lane]), v1 = bf2f(qp[lane + 64]), v2 = bf2f(qp[lane + 128]);
            const float ss = wave_sum(v0 * v0 + v1 * v1 + v2 * v2);
            const float rn = 1.0f / sqrtf(ss * (1.0f / 192.f) + EPS);
            const float n0 = v0 * rn * qg[lane], n1 = v1 * rn * qg[lane + 64], n2 = v2 * rn * qg[lane + 128];
            const float pn = lane_xor32(n2, lane);
            const float o2 = lane < 32 ? n2 * c - pn * s : n2 * c + pn * s;
            qp[lane] = (bf16)f2bf(n0); qp[lane + 64] = (bf16)f2bf(n1); qp[lane + 128] = (bf16)f2bf(o2); }
        {   const bf16* kp = kv + (size_t)r * 2048 + hd * 256;
            const float v0 = bf2f(kp[lane]), v1 = bf2f(kp[lane + 64]), v2 = bf2f(proj[(size_t)r * NPROJ + C_KROPE + lane]);
            const float ss = wave_sum(v0 * v0 + v1 * v1 + v2 * v2);
            const float rn = 1.0f / sqrtf(ss * (1.0f / 192.f) + EPS);
            const float n0 = v0 * rn * kg[lane], n1 = v1 * rn * kg[lane + 64], n2 = v2 * rn * kg[lane + 128];
            const float pn = lane_xor32(n2, lane);
            const float o2 = lane < 32 ? n2 * c - pn * s : n2 * c + pn * s;
            bf16* ko = K + ((size_t)r * 8 + hd) * 192;
            ko[lane] = (bf16)f2bf(n0); ko[lane + 64] = (bf16)f2bf(n1); ko[lane + 128] = (bf16)f2bf(o2); }
    }
}
__device__ __forceinline__ void ph_attn_naive(const bf16* Q, const bf16* K, const bf16* KV, const bf16* proj, bf16* YA, LAS float* lds, int vb, int nvb) {
    const int tid_ = otid(); const int lane = tid_ & 63, wave = tid_ >> 6;
    LAS float* qs = lds + wave * (4096 + 192); LAS float* ps = qs + 192;
    const float scale = 0.07216878364870322f;
    for (int it = vb * 8 + wave; it < NBP * 8 * SEQ; it += nvb * 8) {
        const int t = it % SEQ, bh = it / SEQ, h = bh & 7, b = bh >> 3, r = b * SEQ + t;
        { const bf16* qp = Q + ((size_t)r * 8 + h) * 192; qs[lane] = bf2f(qp[lane]); qs[lane + 64] = bf2f(qp[lane + 64]); qs[lane + 128] = bf2f(qp[lane + 128]); }
        LDS_FENCE();
        float m = -3.0e38f;
        for (int j = lane; j <= t; j += 64) {
            const v4u* kr = (const v4u*)(K + ((size_t)(b * SEQ + j) * 8 + h) * 192);
            float s = 0.f;
#pragma unroll 4
            for (int c = 0; c < 24; ++c) { const v4u w = kr[c]; const LAS float* qq = qs + c * 8;
                s += qq[0] * lo16(w.x) + qq[1] * hi16(w.x) + qq[2] * lo16(w.y) + qq[3] * hi16(w.y) + qq[4] * lo16(w.z) + qq[5] * hi16(w.z) + qq[6] * lo16(w.w) + qq[7] * hi16(w.w); }
            s *= scale; ps[j] = s; m = fmaxf(m, s);
        }
        m = wave_max(m);
        float l = 0.f;
        for (int j = lane; j <= t; j += 64) { const float p = __expf(ps[j] - m); ps[j] = p; l += p; }
        l = wave_sum(l);
        LDS_FENCE();
        float a0 = 0.f, a1 = 0.f;
        const bf16* vp = KV + (size_t)(b * SEQ) * 2048 + h * 256 + 128 + 2 * lane;
        for (int j = 0; j <= t; ++j) { const float p = ps[j]; const unsigned w = *(const unsigned*)(vp + (size_t)j * 2048); a0 += p * lo16(w); a1 += p * hi16(w); }
        const float inv = 1.0f / l;
        const unsigned zw = *(const unsigned*)(proj + (size_t)r * NPROJ + C_ZA + h * 128 + 2 * lane);
        *(unsigned*)(YA + (size_t)r * 1024 + h * 128 + 2 * lane) = pk2(a0 * inv * silu_f(lo16(zw)), a1 * inv * silu_f(hi16(zw)));
        LDS_FENCE();
    }
}
__device__ __forceinline__ void ph_sgu_naive(const bf16* proj, const float* rv, const float* Ws, const float* bs, const float* vg, bf16* YB, int vb, int nvb) {
    for (size_t idx = (size_t)vb * 512 + otid(); idx < (size_t)MP * 1024; idx += (size_t)nvb * 512) {
        const int r = (int)(idx >> 10), col = (int)(idx & 1023), g = col >> 7, tl = r & 127, rc = r - tl;
        float acc = 0.f;
        const float* wrow = Ws + ((size_t)g * 128 + tl) * 128;
        for (int sl = 0; sl <= tl; ++sl) acc += wrow[sl] * gelu_f(bf2f(proj[(size_t)(rc + sl) * NPROJ + C_VB + col])) * rv[rc + sl];
        acc = acc * vg[col] + bs[g * 128 + tl];
        const float u = gelu_f(bf2f(proj[(size_t)r * NPROJ + C_UB + col])), z = silu_f(bf2f(proj[(size_t)r * NPROJ + C_ZB + col]));
        YB[idx] = (bf16)f2bf(u * acc * z);
    }
}
__device__ __forceinline__ void ph_gla_naive(const bf16* proj, const float* wa2, const float* ba, float* OC, LAS float* lds, int vb, int nvb) {
    const int tid_ = otid(); const int lane = tid_ & 63, wave = tid_ >> 6;
    LAS float* sh = lds + wave * 512;
    for (int it = wave * nvb + vb; it < NBP * 16; it += nvb * 8) {
        const int b = it >> 4, h = (it >> 2) & 3, vq = it & 3;
        float st[128];
#pragma unroll
        for (int k = 0; k < 128; ++k) st[k] = 0.f;
        float wa0[16], wa1[16];
#pragma unroll
        for (int j = 0; j < 16; ++j) { wa0[j] = wa2[j * 512 + h * 128 + lane]; wa1[j] = wa2[j * 512 + h * 128 + 64 + lane]; }
        const float ba0 = ba[h * 128 + lane], ba1 = ba[h * 128 + 64 + lane];
        for (int t = 0; t < SEQ; ++t) {
            const bf16* pr = proj + (size_t)(b * SEQ + t) * NPROJ;
            const v4u w0 = *(const v4u*)(pr + C_AR), w1 = *(const v4u*)(pr + C_AR + 8);
            const float ar[16] = {lo16(w0.x), hi16(w0.x), lo16(w0.y), hi16(w0.y), lo16(w0.z), hi16(w0.z), lo16(w0.w), hi16(w0.w),
                                  lo16(w1.x), hi16(w1.x), lo16(w1.y), hi16(w1.y), lo16(w1.z), hi16(w1.z), lo16(w1.w), hi16(w1.w)};
            float x0 = ba0, x1 = ba1;
#pragma unroll
            for (int j = 0; j < 16; ++j) { x0 += ar[j] * wa0[j]; x1 += ar[j] * wa1[j]; }
            const float ls0 = fminf(x0, 0.f) - log1pf(__expf(-fabsf(x0))), ls1 = fminf(x1, 0.f) - log1pf(__expf(-fabsf(x1)));
            sh[lane] = __expf(ls0 * 0.0625f); sh[64 + lane] = __expf(ls1 * 0.0625f);
            sh[128 + lane] = bf2f(pr[C_QC + h * 128 + lane]) * 0.08838834764831845f; sh[192 + lane] = bf2f(pr[C_QC + h * 128 + 64 + lane]) * 0.08838834764831845f;
            sh[256 + lane] = bf2f(pr[C_KC + h * 128 + lane]); sh[320 + lane] = bf2f(pr[C_KC + h * 128 + 64 + lane]);
            const float v = bf2f(pr[C_VC + h * 256 + vq * 64 + lane]);
            LDS_FENCE();
            float o = 0.f;
#pragma unroll
            for (int k = 0; k < 128; ++k) { st[k] = sh[k] * st[k] + sh[256 + k] * v; o += sh[128 + k] * st[k]; }
            LDS_FENCE();
            OC[(size_t)(b * SEQ + t) * 1024 + h * 256 + vq * 64 + lane] = o;
        }
    }
}
__device__ __forceinline__ void ph_glafin(const float* OC, const bf16* proj, const float* og, bf16* YC, int vb, int nvb) {
    const int tid_ = otid(); const int lane = tid_ & 63, wave = tid_ >> 6;
    for (int it = vb * 8 + wave; it < MP * 4; it += nvb * 8) {
        const int r = it >> 2, h = it & 3;
        const v4f o = *(const v4f*)(OC + (size_t)r * 1024 + h * 256 + lane * 4);
        const float ss = wave_sum(o.x * o.x + o.y * o.y + o.z * o.z + o.w * o.w);
        const float rn = 1.0f / sqrtf(ss * (1.0f / 256.f) + EPS);
        const v4f g = *(const v4f*)(og + lane * 4);
        const v2u zw = *(const v2u*)(proj + (size_t)r * NPROJ + C_ZC + h * 256 + lane * 4);
        v2u w; w.x = pk2(o.x * rn * g.x * silu_f(lo16(zw.x)), o.y * rn * g.y * silu_f(hi16(zw.x))); w.y = pk2(o.z * rn * g.z * silu_f(lo16(zw.y)), o.w * rn * g.w * silu_f(hi16(zw.y)));
        *(v2u*)(YC + (size_t)r * 1024 + h * 256 + lane * 4) = w;
    }
}
__device__ __forceinline__ void ph_merge(const bf16* proj, const bf16* PB, bf16* MG, int vb, int nvb) {
    for (size_t idx = (size_t)vb * 512 + otid(); idx < (size_t)MP * 1024; idx += (size_t)nvb * 512) {
        const int r = (int)(idx >> 10), j = (int)(idx & 1023) * 2;
        float m0 = 0.f, m1 = 0.f;
#pragma unroll
        for (int b = 0; b < 3; ++b) { const unsigned gw = *(const unsigned*)(proj + (size_t)r * NPROJ + C_GATE + b * 2048 + j), pw = *(const unsigned*)(PB + ((size_t)b * MP + r) * 2048 + j);
            m0 += sigmoid_f(lo16(gw)) * lo16(pw); m1 += sigmoid_f(hi16(gw)) * hi16(pw); }
        *(unsigned*)(MG + (size_t)r * 2048 + j) = pk2(m0, m1);
    }
}
__device__ __forceinline__ void ph_outadd(const float* xin, const float* U, float* xout, int vb, int nvb) {
    for (size_t idx = (size_t)vb * 512 + otid(); idx < (size_t)MP * 512; idx += (size_t)nvb * 512) {
        const v4f a = ((const v4f*)xin)[idx], u = ((const v4f*)U)[idx]; ((v4f*)xout)[idx] = a + u; }
}


namespace at {
typedef short bf16x8 __attribute__((ext_vector_type(8)));
typedef short s16x4 __attribute__((ext_vector_type(4)));
typedef float f32x16 __attribute__((ext_vector_type(16)));
typedef unsigned u32x4 __attribute__((ext_vector_type(4)));
constexpr int SHM_V = 16384, SHM_K = 16384, SHM_KR = 8192;
constexpr int OFF_V = 0, OFF_K = 2 * SHM_V, OFF_KR = OFF_K + 2 * SHM_K, OFF_WS = OFF_KR + 2 * SHM_KR, LDS_NEED = OFF_WS + 8 * 64 * 4;
constexpr float SCALE = 0.07216878364870322f;
constexpr float THR = 8.f;
#define AT_KSWZ(row, colB) ((row) * 256 + ((colB) ^ (((row) & 7) << 4)))
#define AT_KRSWZ(row, colB) ((row) * 128 + ((colB) ^ (((row) & 7) << 4)))
#define AT_SBAR() __builtin_amdgcn_sched_barrier(0)
__device__ __forceinline__ int v_st(int k, int c) { const int kk = (k & ~0xC) | ((k & 4) << 1) | ((k & 8) >> 1); return ((kk >> 3) * 4 + (c >> 5)) * 512 + ((kk & 7) * 32 + (c & 31)) * 2; }
__device__ __forceinline__ int v_rd_base(int lane) { return ((lane & 3) << 3) | (((lane >> 2) & 3) << 6) | (((lane >> 4) & 1) << 5) | (((lane >> 5) & 1) << 8); }
constexpr int v_rd_off(int d0, int ks, int half) { return d0 * 512 + ks * 4096 + half * 2048; }
__device__ __forceinline__ int crow(int r, int hi) { return (r & 3) + 8 * (r >> 2) + 4 * hi; }
__device__ __forceinline__ unsigned cvtpk(float lo, float hi) { unsigned r; asm volatile("v_cvt_pk_bf16_f32 %0, %1, %2" : "=v"(r) : "v"(lo), "v"(hi)); return r; }

__device__ __forceinline__ void mask_tile(f32x16& p0, f32x16& p1, int dq) {
    const float NEG = -__builtin_inff();
#pragma unroll
    for (int r = 0; r < 16; ++r) { const int c = (r & 3) + 8 * (r >> 2); if (dq < c) p0[r] = NEG; if (dq < c + 32) p1[r] = NEG; }
}
__device__ __forceinline__ void partialSM(f32x16& p0, f32x16& p1, float& m_reg, float& mn, float& alpha) {
    float pmax = p0[0];
#pragma unroll
    for (int r = 1; r < 16; ++r) pmax = fmaxf(pmax, p0[r]);
#pragma unroll
    for (int r = 0; r < 16; ++r) pmax = fmaxf(pmax, p1[r]);
    { auto rr = __builtin_amdgcn_permlane32_swap(__float_as_uint(pmax), __float_as_uint(pmax), false, false);
      pmax = fmaxf(__uint_as_float(rr[0]), __uint_as_float(rr[1])); }
    constexpr float C2 = 1.4426950408889634f * SCALE;
    if (__builtin_expect(__all((pmax - m_reg) * SCALE <= THR), 1)) { mn = m_reg; alpha = 1.f; }
    else { mn = fmaxf(m_reg, pmax); alpha = __builtin_amdgcn_exp2f((m_reg - mn) * C2); m_reg = mn; }
    const float mnL = -mn * C2;
#pragma unroll
    for (int r = 0; r < 16; ++r) p0[r] = fmaf(p0[r], C2, mnL);
#pragma unroll
    for (int r = 0; r < 16; ++r) p1[r] = fmaf(p1[r], C2, mnL);
#pragma unroll
    for (int r = 0; r < 16; ++r) p0[r] = __builtin_amdgcn_exp2f(p0[r]);
}
__device__ __forceinline__ void finishSM(f32x16& p0, f32x16& p1, float alpha, float& l_reg, bf16x8& pa0, bf16x8& pa1, bf16x8& pa2, bf16x8& pa3) {
#pragma unroll
    for (int r = 0; r < 16; ++r) p1[r] = __builtin_amdgcn_exp2f(p1[r]);
    float ps = 0;
#pragma unroll
    for (int r = 0; r < 16; ++r) ps += p0[r];
#pragma unroll
    for (int r = 0; r < 16; ++r) ps += p1[r];
    { auto rr = __builtin_amdgcn_permlane32_swap(__float_as_uint(ps), __float_as_uint(ps), false, false);
      ps = __uint_as_float(rr[0]) + __uint_as_float(rr[1]); }
    l_reg = l_reg * alpha + ps;
#define AT_PK4(P, B_, OUT) do { unsigned a0 = cvtpk(P[B_+0], P[B_+1]), a1 = cvtpk(P[B_+2], P[B_+3]);                          \
        unsigned b0 = cvtpk(P[B_+4], P[B_+5]), b1 = cvtpk(P[B_+6], P[B_+7]);                                             \
        auto r0 = __builtin_amdgcn_permlane32_swap(a0, b0, false, false); auto r1 = __builtin_amdgcn_permlane32_swap(a1, b1, false, false); \
        u32x4 w = {r0[0], r1[0], r0[1], r1[1]}; OUT = *reinterpret_cast<bf16x8*>(&w); } while (0)
    AT_PK4(p0, 0, pa0); AT_PK4(p0, 8, pa1); AT_PK4(p1, 0, pa2); AT_PK4(p1, 8, pa3);
#undef AT_PK4
}
__device__ __forceinline__ void qkt(f32x16& p0, f32x16& p1, const LAS unsigned char* Kb, const LAS unsigned char* KRb, int r32, int hi, const bf16x8* qr) {
    p0 = f32x16{}; p1 = f32x16{};
    const LAS unsigned char* kb[4]; const LAS unsigned char* krb[4];
#pragma unroll
    for (int dd = 0; dd < 4; ++dd) { kb[dd] = Kb + AT_KSWZ(r32, (dd * 16 + hi * 8) * 2); krb[dd] = KRb + AT_KRSWZ(r32, (dd * 16 + hi * 8) * 2); }
#pragma unroll
    for (int d0 = 0; d0 < 8; ++d0) { const LAS unsigned char* a = kb[d0 & 3] + (d0 >> 2) * 128;
        const bf16x8 b0 = *reinterpret_cast<const LAS bf16x8*>(a);
        const bf16x8 b1 = *reinterpret_cast<const LAS bf16x8*>(a + 32 * 256);
        p0 = __builtin_amdgcn_mfma_f32_32x32x16_bf16(b0, qr[d0], p0, 0, 0, 0);
        p1 = __builtin_amdgcn_mfma_f32_32x32x16_bf16(b1, qr[d0], p1, 0, 0, 0); }
#pragma unroll
    for (int d0 = 0; d0 < 4; ++d0) { const LAS unsigned char* a = krb[d0];
        const bf16x8 b0 = *reinterpret_cast<const LAS bf16x8*>(a);
        const bf16x8 b1 = *reinterpret_cast<const LAS bf16x8*>(a + 32 * 128);
        p0 = __builtin_amdgcn_mfma_f32_32x32x16_bf16(b0, qr[8 + d0], p0, 0, 0, 0);
        p1 = __builtin_amdgcn_mfma_f32_32x32x16_bf16(b1, qr[8 + d0], p1, 0, 0, 0); }
}
__device__ __forceinline__ void pv_tile(f32x16* o, unsigned vb0, bf16x8 pa0, bf16x8 pa1, bf16x8 pa2, bf16x8 pa3) {
#define AT_TRRD(dst, off) asm volatile("ds_read_b64_tr_b16 %0, %1 offset:%2" : "=&v"(dst) : "v"(vb0), "i"(off) : "memory")
#define AT_PV_D0(d0) do { s16x4 l0, l1, l2, l3, h0, h1, h2, h3; constexpr int b_ = v_rd_off(d0, 0, 0); \
        AT_TRRD(l0, b_); AT_TRRD(h0, b_ + 2048); AT_TRRD(l1, b_ + 4096); AT_TRRD(h1, b_ + 6144); AT_TRRD(l2, b_ + 8192); AT_TRRD(h2, b_ + 10240); AT_TRRD(l3, b_ + 12288); AT_TRRD(h3, b_ + 14336); \
        asm volatile("s_waitcnt lgkmcnt(0)" ::: "memory"); AT_SBAR();   \
        o[d0] = __builtin_amdgcn_mfma_f32_32x32x16_bf16(pa0, (bf16x8){l0[0], l0[1], l0[2], l0[3], h0[0], h0[1], h0[2], h0[3]}, o[d0], 0, 0, 0);   \
        o[d0] = __builtin_amdgcn_mfma_f32_32x32x16_bf16(pa1, (bf16x8){l1[0], l1[1], l1[2], l1[3], h1[0], h1[1], h1[2], h1[3]}, o[d0], 0, 0, 0);   \
        o[d0] = __builtin_amdgcn_mfma_f32_32x32x16_bf16(pa2, (bf16x8){l2[0], l2[1], l2[2], l2[3], h2[0], h2[1], h2[2], h2[3]}, o[d0], 0, 0, 0);   \
        o[d0] = __builtin_amdgcn_mfma_f32_32x32x16_bf16(pa3, (bf16x8){l3[0], l3[1], l3[2], l3[3], h3[0], h3[1], h3[2], h3[3]}, o[d0], 0, 0, 0); } while (0)
    AT_PV_D0(0); AT_PV_D0(1); AT_PV_D0(2); AT_PV_D0(3);
#undef AT_PV_D0
#undef AT_TRRD
}

__device__ __forceinline__ void attn_block(LAS unsigned char* lds, const bf16* Q, const bf16* K, const bf16* KV, const bf16* proj, bf16* YA, int b, int h, int qb) {
    const int tid = otid(), wid = __builtin_amdgcn_readfirstlane(tid >> 6), lane = tid & 63, r32 = lane & 31, hi = lane >> 5;
    const int P0 = qb * 256, NT = 4 * (qb + 1), qlo = P0 + wid * 32;
    LAS unsigned char* V_lds = lds + OFF_V; LAS unsigned char* K_lds = lds + OFF_K; LAS unsigned char* KR_lds = lds + OFF_KR;
    LAS float* wsf = (LAS float*)(lds + OFF_WS) + wid * 64; LAS float* li_l = wsf; LAS float* al_l = wsf + 32;
    bf16x8 qr[12];
    { const bf16* qp = Q + ((size_t)(b * SEQ + qlo + r32) * 8 + h) * 192 + hi * 8;
#pragma unroll
      for (int d0 = 0; d0 < 12; ++d0) qr[d0] = *(const bf16x8*)(qp + d0 * 16); }
    const int sr = tid >> 4, sc = (tid & 15) * 8, kws = AT_KSWZ(sr, sc * 2), vst0 = v_st(sr, sc), vst1 = v_st(32 + sr, sc);
    const int rr = tid >> 3, rc = (tid & 7) * 8, krws = AT_KRSWZ(rr, rc * 2);
    const bf16* Kg = K + ((size_t)(b * SEQ) * 8 + h) * 192;
    const bf16* Vg = KV + (size_t)(b * SEQ) * 2048 + h * 256 + 128;
    bf16x8 st_k0, st_k1, st_kr, st_v0, st_v1;
#define AT_SLOAD(kb_) do { st_k0 = *(const bf16x8*)(Kg + (size_t)((kb_) + sr) * 1536 + sc); st_k1 = *(const bf16x8*)(Kg + (size_t)((kb_) + 32 + sr) * 1536 + sc); \
        st_kr = *(const bf16x8*)(Kg + (size_t)((kb_) + rr) * 1536 + 128 + rc); \
        st_v0 = *(const bf16x8*)(Vg + (size_t)((kb_) + sr) * 2048 + sc); st_v1 = *(const bf16x8*)(Vg + (size_t)((kb_) + 32 + sr) * 2048 + sc); } while (0)
#define AT_SWRITE(bf) do { *(LAS bf16x8*)(K_lds + (bf) * SHM_K + kws) = st_k0; *(LAS bf16x8*)(K_lds + (bf) * SHM_K + kws + 32 * 256) = st_k1; \
        *(LAS bf16x8*)(KR_lds + (bf) * SHM_KR + krws) = st_kr; \
        *(LAS bf16x8*)(V_lds + (bf) * SHM_V + vst0) = st_v0; *(LAS bf16x8*)(V_lds + (bf) * SHM_V + vst1) = st_v1; } while (0)
    AT_SLOAD(0); AT_SWRITE(0);
    __syncthreads();
    float m_reg = -1e30f, l_reg = 0.f; f32x16 o[4] = {};
    const unsigned vbase = (unsigned)(size_t)V_lds + (unsigned)v_rd_base(lane);
    for (int t = 0; t < NT; ++t) {
        const int buf = t & 1, kb = t * 64;
        if (t + 1 < NT) AT_SLOAD(kb + 64);
        if (kb <= qlo + 31) {
            f32x16 p0, p1; float mn, alpha; bf16x8 pa0, pa1, pa2, pa3;
            qkt(p0, p1, K_lds + buf * SHM_K, KR_lds + buf * SHM_KR, r32, hi, qr);
            if (kb + 63 > qlo) mask_tile(p0, p1, qlo + r32 - 4 * hi - kb);
            partialSM(p0, p1, m_reg, mn, alpha);
            finishSM(p0, p1, alpha, l_reg, pa0, pa1, pa2, pa3);
            if (__any(alpha < 1.f)) { if (hi == 0) al_l[r32] = alpha; asm volatile("s_waitcnt lgkmcnt(0)" ::: "memory");
#pragma unroll
                for (int d_ = 0; d_ < 4; ++d_)
#pragma unroll
                    for (int r = 0; r < 16; ++r) o[d_][r] *= al_l[crow(r, hi)];
                asm volatile("s_waitcnt lgkmcnt(0)" ::: "memory"); }
            AT_SBAR();
            pv_tile(o, vbase + buf * SHM_V, pa0, pa1, pa2, pa3);
        }
        if (t + 1 < NT) AT_SWRITE(buf ^ 1);
        __syncthreads();
    }
    if (hi == 0) li_l[r32] = l_reg;
    asm volatile("s_waitcnt lgkmcnt(0)" ::: "memory");
    float rli[16];
#pragma unroll
    for (int r = 0; r < 16; ++r) rli[r] = 1.0f / li_l[crow(r, hi)];
#pragma unroll
    for (int r = 0; r < 16; ++r) { const int row = b * SEQ + qlo + crow(r, hi);
#pragma unroll
        for (int d0 = 0; d0 < 4; ++d0) { const int col = h * 128 + d0 * 32 + r32;
            const float z = bf2f(proj[(size_t)row * NPROJ + C_ZA + col]);
            const float v = o[d0][r] * rli[r] * silu_f(z);
            const float vn = lane_xor<1>(v);
            if ((r32 & 1) == 0) *(unsigned*)(YA + (size_t)row * 1024 + col) = cvtpk(v, vn); } }
    asm volatile("s_waitcnt lgkmcnt(0)" ::: "memory");
    __syncthreads();
#undef AT_SLOAD
#undef AT_SWRITE
}
__device__ __forceinline__ void ph_attn(LAS unsigned char* lds, const bf16* Q, const bf16* K, const bf16* KV, const bf16* proj, bf16* YA, int vb, int nvb) {
    const int nitems = NBP * 8 * 8;
    for (int it = vb; it < nitems; it += nvb) {
        const int grp = it >> 6, within = it & 63, pair = within >> 3, bh = grp * 8 + (within & 7), b = bh >> 3, h = bh & 7;
        attn_block(lds, Q, K, KV, proj, YA, b, h, 15 - pair);
        attn_block(lds, Q, K, KV, proj, YA, b, h, pair);
    }
}
}


namespace sg {
using at::bf16x8; using at::f32x16;
__device__ __forceinline__ void ph_sgu(LAS unsigned char* lds, const bf16* proj, const float* rv, const float* Ws, const float* bs, const float* vg, bf16* YB, int vb, int nvb) {
    const int tid = otid(), wid = __builtin_amdgcn_readfirstlane(tid >> 6), lane = tid & 63, r32 = lane & 31, hi = lane >> 5;
    const int nitems = (MP / 128) * 4;
    for (int it = vb; it < nitems; it += nvb) {
        const int ch = it >> 2, gp = it & 3, R0 = ch * 128;
#pragma unroll
        for (int i = 0; i < 8; ++i) {
            const int idx = tid + 512 * i, gsel = idx >> 11, row = (idx >> 4) & 127, cc = idx & 15;
            const v4u w = *(const v4u*)(proj + (size_t)(R0 + row) * NPROJ + C_VB + (2 * gp + gsel) * 128 + cc * 8);
            const float s = rv[R0 + row];
            v4u o; o.x = pk2(gelu_f(lo16(w.x)) * s, gelu_f(hi16(w.x)) * s); o.y = pk2(gelu_f(lo16(w.y)) * s, gelu_f(hi16(w.y)) * s);
            o.z = pk2(gelu_f(lo16(w.z)) * s, gelu_f(hi16(w.z)) * s); o.w = pk2(gelu_f(lo16(w.w)) * s, gelu_f(hi16(w.w)) * s);
            *(LAS v4u*)(lds + (gsel * 2 + (row >> 6)) * 16384 + at::v_st(row & 63, cc * 8)) = o;
        }
        __syncthreads();
        const int gsel = wid >> 2, g = 2 * gp + gsel, t = 32 * (wid & 3) + r32;
        f32x16 o[4] = {};
        const int nst = (wid & 3) >= 2 ? 2 : 1;
        for (int st = 0; st < nst; ++st) {
            bf16x8 pa[4];
#pragma unroll
            for (int ks = 0; ks < 4; ++ks) {
                const int s0 = st * 64 + ks * 16 + hi * 8;
                const float* wp = Ws + ((size_t)g * 128 + t) * 128 + s0;
                const v4f a = *(const v4f*)wp, b = *(const v4f*)(wp + 4);
                float x[8] = {a.x, a.y, a.z, a.w, b.x, b.y, b.z, b.w};
#pragma unroll
                for (int j = 0; j < 8; ++j) if (s0 + j > t) x[j] = 0.f;
                at::u32x4 w4 = {at::cvtpk(x[0], x[1]), at::cvtpk(x[2], x[3]), at::cvtpk(x[4], x[5]), at::cvtpk(x[6], x[7])};
                pa[ks] = *reinterpret_cast<bf16x8*>(&w4);
            }
            const unsigned vbase = (unsigned)(size_t)(lds + (gsel * 2 + st) * 16384) + (unsigned)at::v_rd_base(lane);
            at::pv_tile(o, vbase, pa[0], pa[1], pa[2], pa[3]);
        }
#pragma unroll
        for (int r = 0; r < 16; ++r) { const int tl = 32 * (wid & 3) + at::crow(r, hi); const size_t row = (size_t)(R0 + tl);
            const float bias = bs[g * 128 + tl];
#pragma unroll
            for (int d0 = 0; d0 < 4; ++d0) { const int gc = g * 128 + d0 * 32 + r32;
                const float mix = o[d0][r] * vg[gc] + bias;
                const float u = gelu_f(bf2f(proj[row * NPROJ + C_UB + gc])), z = silu_f(bf2f(proj[row * NPROJ + C_ZB + gc]));
                const float y = u * mix * z, yn = lane_xor<1>(y);
                if ((r32 & 1) == 0) *(unsigned*)(YB + row * 1024 + gc) = at::cvtpk(y, yn); } }
        __syncthreads();
    }
}
}


namespace gl {
using at::bf16x8; using at::f32x16; using at::s16x4; using at::u32x4;
constexpr int OFF_VIMG = 0, OFF_KLIMG = 65536, OFF_ATT = 98304, OFF_DS = 131072;

__device__ __forceinline__ void ph_gla_prep(LAS unsigned char* lds, const bf16* proj, const float* wa2, const float* ba, bf16* QE, bf16* KE, bf16* KL, float* DS, int vb, int nvb) {
    const int tid = otid(), k = tid & 127, tq = tid >> 7;
    LAS float* seg = (LAS float*)lds;
    const int nitems = (MP / 128) * 4;
    for (int it = vb; it < nitems; it += nvb) {
        const int ch = it >> 2, h = it & 3, R0 = ch * 128 + tq * 32;
        float wa[16];
#pragma unroll
        for (int j = 0; j < 16; ++j) wa[j] = wa2[j * 512 + h * 128 + k];
        const float bak = ba[h * 128 + k];
        float la[32]; float run = 0.f;
#pragma unroll
        for (int i = 0; i < 32; ++i) {
            const bf16* pr = proj + (size_t)(R0 + i) * NPROJ + C_AR;
            const v4u w0 = *(const v4u*)pr, w1 = *(const v4u*)(pr + 8);
            const float ar[16] = {lo16(w0.x), hi16(w0.x), lo16(w0.y), hi16(w0.y), lo16(w0.z), hi16(w0.z), lo16(w0.w), hi16(w0.w),
                                  lo16(w1.x), hi16(w1.x), lo16(w1.y), hi16(w1.y), lo16(w1.z), hi16(w1.z), lo16(w1.w), hi16(w1.w)};
            float x = bak;
#pragma unroll
            for (int j = 0; j < 16; ++j) x += ar[j] * wa[j];
            const float ls = fminf(x, 0.f) - log1pf(__expf(-fabsf(x)));
            run += ls * 0.0625f; la[i] = run;
        }
        seg[tq * 128 + k] = run;
        __syncthreads();
        float pre = 0.f, total = 0.f;
#pragma unroll
        for (int q = 0; q < 4; ++q) { const float sgm = seg[q * 128 + k]; total += sgm; if (q < tq) pre += sgm; }
#pragma unroll
        for (int i = 0; i < 32; ++i) {
            const float b = la[i] + pre; const size_t row = (size_t)(R0 + i);
            const float qv = bf2f(proj[row * NPROJ + C_QC + h * 128 + k]) * 0.08838834764831845f, kv = bf2f(proj[row * NPROJ + C_KC + h * 128 + k]);
            QE[row * 512 + h * 128 + k] = (bf16)f2bf(qv * __expf(b));
            KE[row * 512 + h * 128 + k] = (bf16)f2bf(kv * __expf(-b));
            KL[row * 512 + h * 128 + k] = (bf16)f2bf(kv * __expf(total - b));
        }
        if (tq == 0) DS[((size_t)ch * 4 + h) * 128 + k] = __expf(total);
        __syncthreads();
    }
}

#define GL_PK4(P, B_, OUT) do { unsigned a0 = at::cvtpk(P[B_+0], P[B_+1]), a1 = at::cvtpk(P[B_+2], P[B_+3]);                          \
        unsigned b0 = at::cvtpk(P[B_+4], P[B_+5]), b1 = at::cvtpk(P[B_+6], P[B_+7]);                                             \
        auto r0 = __builtin_amdgcn_permlane32_swap(a0, b0, false, false); auto r1 = __builtin_amdgcn_permlane32_swap(a1, b1, false, false); \
        u32x4 w = {r0[0], r1[0], r0[1], r1[1]}; OUT = *reinterpret_cast<bf16x8*>(&w); } while (0)
#define GL_TRRD(dst, addr, off) asm volatile("ds_read_b64_tr_b16 %0, %1 offset:%2" : "=&v"(dst) : "v"(addr), "i"(off) : "memory")

__device__ __forceinline__ void ph_gla_scan(LAS unsigned char* lds, const bf16* proj, const bf16* QE, const bf16* KE, const bf16* KL, const float* DS, float* OC, int vb, int nvb) {
    const int tid = otid(), wid = __builtin_amdgcn_readfirstlane(tid >> 6), lane = tid & 63, r32 = lane & 31, hi = lane >> 5;
    const int nitems = NBP * 4;
    LAS float* dsl = (LAS float*)(lds + OFF_DS);
    for (int it = vb; it < nitems; it += nvb) {
        const int b = it >> 2, h = it & 3;
        f32x16 X[4] = {};
        for (int c = 0; c < SEQ / 128; ++c) {
            const int R0 = b * SEQ + c * 128;
#pragma unroll
            for (int i = 0; i < 8; ++i) { const int idx = tid + 512 * i, s = idx >> 5, cc = idx & 31;
                const v4u w = *(const v4u*)(proj + (size_t)(R0 + s) * NPROJ + C_VC + h * 256 + cc * 8);
                *(LAS v4u*)(lds + OFF_VIMG + ((s >> 6) * 2 + (cc >> 4)) * 16384 + at::v_st(s & 63, (cc & 15) * 8)) = w; }
#pragma unroll
            for (int i = 0; i < 4; ++i) { const int idx = tid + 512 * i, s = idx >> 4, cc = idx & 15;
                const v4u w = *(const v4u*)(KL + (size_t)(R0 + s) * 512 + h * 128 + cc * 8);
                *(LAS v4u*)(lds + OFF_KLIMG + (s >> 6) * 16384 + at::v_st(s & 63, cc * 8)) = w; }
            if (tid < 128) dsl[tid] = DS[((size_t)(R0 >> 7) * 4 + h) * 128 + tid];
#pragma unroll
            for (int j = 0; j < 2; ++j) {
                const int ti = 2 * wid + j, st = ti >> 2, tt = ti & 3;
                if (st <= tt) {
                    f32x16 p = {};
                    const bf16* ap = KE + (size_t)(R0 + 32 * st + r32) * 512 + h * 128 + hi * 8;
                    const bf16* bp = QE + (size_t)(R0 + 32 * tt + r32) * 512 + h * 128 + hi * 8;
#pragma unroll
                    for (int ks = 0; ks < 8; ++ks) p = __builtin_amdgcn_mfma_f32_32x32x16_bf16(*(const bf16x8*)(ap + ks * 16), *(const bf16x8*)(bp + ks * 16), p, 0, 0, 0);
                    if (st == tt) {
#pragma unroll
                        for (int r = 0; r < 16; ++r) if (at::crow(r, hi) > r32) p[r] = 0.f; }
                    const int t = 32 * tt + r32;
#pragma unroll
                    for (int g = 0; g < 4; ++g) { v2u w; w.x = at::cvtpk(p[4 * g], p[4 * g + 1]); w.y = at::cvtpk(p[4 * g + 2], p[4 * g + 3]);
                        *(LAS v2u*)(lds + OFF_ATT + t * 256 + ((64 * st + 16 * g) ^ ((t & 7) << 4)) + 8 * hi) = w; }
                }
            }
            f32x16 acc[4] = {};
#pragma unroll
            for (int kt = 0; kt < 4; ++kt) {
                bf16x8 xb0, xb1; GL_PK4(X[kt], 0, xb0); GL_PK4(X[kt], 8, xb1);
#pragma unroll
                for (int tt = 0; tt < 4; ++tt) {
                    const bf16* qp = QE + (size_t)(R0 + 32 * tt + r32) * 512 + h * 128 + 32 * kt + hi * 8;
                    acc[tt] = __builtin_amdgcn_mfma_f32_32x32x16_bf16(*(const bf16x8*)qp, xb0, acc[tt], 0, 0, 0);
                    acc[tt] = __builtin_amdgcn_mfma_f32_32x32x16_bf16(*(const bf16x8*)(qp + 16), xb1, acc[tt], 0, 0, 0); }
            }
            __syncthreads();
            bf16x8 vfr[8];
            { const unsigned vaddr = (unsigned)(size_t)(lds + OFF_VIMG + (wid >> 2) * 16384) + (unsigned)at::v_rd_base(lane) + (unsigned)((wid & 3) * 512);
              s16x4 vl[8], vh[8];
#define GL_VF(ks8) do { constexpr int o_ = ((ks8) >> 2) * 32768 + ((ks8) & 3) * 4096; GL_TRRD(vl[ks8], vaddr, o_); GL_TRRD(vh[ks8], vaddr, o_ + 2048); } while (0)
              GL_VF(0); GL_VF(1); GL_VF(2); GL_VF(3); GL_VF(4); GL_VF(5); GL_VF(6); GL_VF(7);
#undef GL_VF
              asm volatile("s_waitcnt lgkmcnt(0)" ::: "memory"); AT_SBAR();
#pragma unroll
              for (int q = 0; q < 8; ++q) vfr[q] = (bf16x8){vl[q][0], vl[q][1], vl[q][2], vl[q][3], vh[q][0], vh[q][1], vh[q][2], vh[q][3]};
              AT_SBAR(); }
#pragma unroll
            for (int tt = 0; tt < 4; ++tt) {
                const LAS unsigned char* arow = lds + OFF_ATT;
#pragma unroll
                for (int ks8 = 0; ks8 < 8; ++ks8) if (ks8 <= 2 * tt + 1) {
                    const int t = 32 * tt + r32;
                    const bf16x8 a = *(const LAS bf16x8*)(arow + t * 256 + (((16 * ks8 + 8 * hi) * 2) ^ ((t & 7) << 4)));
                    acc[tt] = __builtin_amdgcn_mfma_f32_32x32x16_bf16(a, vfr[ks8], acc[tt], 0, 0, 0); }
            }
#pragma unroll
            for (int tt = 0; tt < 4; ++tt)
#pragma unroll
                for (int r = 0; r < 16; ++r) OC[(size_t)(R0 + 32 * tt + at::crow(r, hi)) * 1024 + h * 256 + 32 * wid + r32] = acc[tt][r];
#pragma unroll
            for (int kt = 0; kt < 4; ++kt) {
#pragma unroll
                for (int r = 0; r < 16; ++r) X[kt][r] *= dsl[32 * kt + at::crow(r, hi)];
                const unsigned kaddr = (unsigned)(size_t)(lds + OFF_KLIMG) + (unsigned)at::v_rd_base(lane) + (unsigned)(kt * 512);
#define GL_KF(ks8) do { s16x4 l_, h_; constexpr int o_ = ((ks8) >> 2) * 16384 + ((ks8) & 3) * 4096; GL_TRRD(l_, kaddr, o_); GL_TRRD(h_, kaddr, o_ + 2048); \
                asm volatile("s_waitcnt lgkmcnt(0)" ::: "memory"); AT_SBAR(); \
                X[kt] = __builtin_amdgcn_mfma_f32_32x32x16_bf16((bf16x8){l_[0], l_[1], l_[2], l_[3], h_[0], h_[1], h_[2], h_[3]}, vfr[ks8], X[kt], 0, 0, 0); } while (0)
                GL_KF(0); GL_KF(1); GL_KF(2); GL_KF(3); GL_KF(4); GL_KF(5); GL_KF(6); GL_KF(7);
#undef GL_KF
            }
            __syncthreads();
        }
    }
}
#undef GL_PK4
#undef GL_TRRD
}


typedef const __attribute__((address_space(4))) Args* KArgP;
#define KARG() ({ KArgP p_ = (KArgP)__builtin_amdgcn_kernarg_segment_ptr(); asm volatile("" : "+s"(p_)); p_; })
#define INF(i) ((const float*)ap->in[i])
__device__ __forceinline__ void grid_bar(const XcdBarrier& b0) { XcdBarrier b = b0; asm volatile("" : "+s"(b.bar)); xcd_barrier(b); }

__global__ void __launch_bounds__(512, 2) fwd(Args a) {
    extern __shared__ __attribute__((aligned(16))) unsigned char lds_raw[];
    LAS unsigned char* lds = (LAS unsigned char*)lds_raw;
    const int lo = a.lo, hi = a.hi;
    XcdBarrier bar; bar.bar = (unsigned*)(a.ws + WS_CTL) + CW_BAR; bar.x = 0; bar.st = nullptr;
    if (hi - lo > 1) {
        if (threadIdx.x < 4) ((LAS unsigned*)(lds + LDSCTL_OFF))[threadIdx.x] = 0u;
        __syncthreads();
        bar = xcd_barrier_post((unsigned*)(a.ws + WS_CTL) + CW_BAR, (volatile LAS unsigned*)(lds + LDSCTL_OFF));
    }
    int step = 0;
#define PH_BEGIN if (step >= lo && step < hi) { const KArgP ap = KARG(); unsigned char* const ws = ap->ws; const int vb = obid(), nvb = gridDim.x; (void)ws; (void)vb; (void)nvb;
#define PH_END   if (step + 1 < hi) grid_bar(bar); } ++step;
#define WL(l) (ws + WS_W + (size_t)(l) * SZ_WLAYER)
#define B_(T, off) ((T*)(ws + (off)))

    PH_BEGIN
        for (int l = 0; l < DEPTH; ++l) {
            unsigned char* wl = WL(l);
            convert_T<1>(INF(3) + (size_t)l * DM * IN_COLS, DM, IN_COLS, (bf16*)wl, NPROJ, (LAS float*)lds, vb, nvb);
            convert_T<0>(INF(6) + (size_t)l * 512 * 1536, 512, 1536, (bf16*)(wl + SZ_WIN), 1536, (LAS float*)lds, (vb + 64) % nvb, nvb);
            convert_T<0>(INF(7) + (size_t)l * 512 * 2048, 512, 2048, (bf16*)(wl + SZ_WIN + SZ_WUQ), 2048, (LAS float*)lds, (vb + 128) % nvb, nvb);
            for (int b = 0; b < 3; ++b)
                convert_T<0>(INF(16) + ((size_t)l * 3 + b) * 1024 * 2048, 1024, 2048, (bf16*)(wl + SZ_WIN + SZ_WUQ + SZ_WUKV) + (size_t)b * 2048 * 1024, 2048, (LAS float*)lds, (vb + 32 * b) % nvb, nvb);
            convert_T<0>(INF(17) + (size_t)l * 2048 * 2048, 2048, 2048, (bf16*)(wl + SZ_WIN + SZ_WUQ + SZ_WUKV + SZ_WB), 2048, (LAS float*)lds, (vb + 192) % nvb, nvb);
        }
        { const int* positions = (const int*)ap->in[1]; float* cosT = B_(float, WS_COS); float* sinT = B_(float, WS_SIN);
          for (int idx = vb * 512 + otid(); idx < MTOK * 32; idx += nvb * 512) {
            const int t = idx >> 5, i = idx & 31;
            const float inv = 1.0f / powf(10000.0f, (float)(2 * i) * (1.0f / 64.0f));
            const float ang = (float)positions[t] * inv;
            float sn, cs; sincosf(ang, &sn, &cs);
            cosT[idx] = cs; sinT[idx] = sn; } }
    PH_END

    for (int l = 0; l < DEPTH; ++l) {
        for (int p = 0; p < NPASS; ++p) {
            const int row0 = p * MP;
#define XIN ((l == 0 ? (const float*)ap->in[0] : (const float*)ap->out) + (size_t)row0 * DM)
            PH_BEGIN ph_norm(XIN, INF(2) + l * DM, B_(bf16, WS_H), MP, vb, nvb); PH_END
            PH_BEGIN { pg8::Gemm g{B_(bf16, WS_H), (const bf16*)WL(l), MP, NPROJ, DM}; pg8::StaticOrder S; S.init(MP, NPROJ, nvb, vb); pg8::EpiBf16<0> E{B_(bf16, WS_PROJ), NPROJ, nullptr, 0, 0};
                       pg8::gemm_phase<pg8::EpiBf16<0>, pg8::StaticOrder>(lds, g, S, E, nullptr); } PH_END
            PH_BEGIN ph_prep(B_(bf16, WS_PROJ), INF(4) + l * 512, INF(5) + l * 512, B_(bf16, WS_CQN), B_(bf16, WS_CKVN), B_(float, WS_RV), vb, nvb);
                     gl::ph_gla_prep(lds, B_(bf16, WS_PROJ), INF(13) + l * 16 * 512, INF(14) + l * 512, B_(bf16, WS_QE), B_(bf16, WS_KE), B_(bf16, WS_KL), B_(float, WS_DS), vb, nvb); PH_END
            PH_BEGIN { { pg8::Gemm g{B_(bf16, WS_CQN), (const bf16*)(WL(l) + SZ_WIN), MP, 1536, 512}; pg8::StaticOrder S; S.init(MP, 1536, nvb, vb); pg8::EpiBf16<0> E{B_(bf16, WS_Q), 1536, nullptr, 0, 0};
                         pg8::gemm_phase<pg8::EpiBf16<0>, pg8::StaticOrder>(lds, g, S, E, nullptr); }
                       { pg8::Gemm g{B_(bf16, WS_CKVN), (const bf16*)(WL(l) + SZ_WIN + SZ_WUQ), MP, 2048, 512}; pg8::StaticOrder S; S.init(MP, 2048, nvb, vb); pg8::EpiBf16<0> E{B_(bf16, WS_KV), 2048, nullptr, 0, 0};
                         pg8::gemm_phase<pg8::EpiBf16<0>, pg8::StaticOrder>(lds, g, S, E, nullptr); } } PH_END
            PH_BEGIN ph_qkfin(B_(bf16, WS_Q), B_(bf16, WS_KV), B_(bf16, WS_PROJ), B_(bf16, WS_K), INF(8) + l * 192, INF(9) + l * 192, B_(float, WS_COS), B_(float, WS_SIN), row0, vb, nvb); PH_END
            PH_BEGIN at::ph_attn(lds, B_(bf16, WS_Q), B_(bf16, WS_K), B_(bf16, WS_KV), B_(bf16, WS_PROJ), B_(bf16, WS_YA), vb, nvb); PH_END
            PH_BEGIN sg::ph_sgu(lds, B_(bf16, WS_PROJ), B_(float, WS_RV), INF(11) + (size_t)l * 8 * 128 * 128, INF(12) + l * 8 * 128, INF(10) + l * 1024, B_(bf16, WS_YB), vb, nvb); PH_END
            PH_BEGIN gl::ph_gla_scan(lds, B_(bf16, WS_PROJ), B_(bf16, WS_QE), B_(bf16, WS_KE), B_(bf16, WS_KL), B_(float, WS_DS), B_(float, WS_OC), vb, nvb); PH_END
            PH_BEGIN ph_glafin(B_(float, WS_OC), B_(bf16, WS_PROJ), INF(15) + l * 256, B_(bf16, WS_YC), vb, nvb); PH_END
            PH_BEGIN for (int b = 0; b < 3; ++b) { pg8::Gemm g{B_(bf16, WS_YA) + (size_t)b * MP * 1024, (const bf16*)(WL(l) + SZ_WIN + SZ_WUQ + SZ_WUKV) + (size_t)b * 2048 * 1024, MP, 2048, 1024};
                       pg8::StaticOrder S; S.init(MP, 2048, nvb, (vb + 85 * b) % nvb);
                       pg8::EpiBf16<0> E{B_(bf16, WS_PB) + (size_t)b * MP * 2048, 2048, nullptr, 0, 0}; pg8::gemm_phase<pg8::EpiBf16<0>, pg8::StaticOrder>(lds, g, S, E, nullptr); } PH_END
            PH_BEGIN ph_merge(B_(bf16, WS_PROJ), B_(bf16, WS_PB), B_(bf16, WS_MG), vb, nvb); PH_END
            PH_BEGIN { pg8::Gemm g{B_(bf16, WS_MG), (const bf16*)(WL(l) + SZ_WIN + SZ_WUQ + SZ_WUKV + SZ_WB), MP, 2048, 2048}; pg8::StaticOrder S; S.init(MP, 2048, nvb, vb); pg8::EpiF32 E{B_(float, WS_U), 2048, nullptr};
                       pg8::gemm_phase<pg8::EpiF32, pg8::StaticOrder>(lds, g, S, E, nullptr); } PH_END
            PH_BEGIN ph_outadd(XIN, B_(float, WS_U), ap->out + (size_t)row0 * DM, vb, nvb); PH_END
        }
    }
#undef PH_BEGIN
#undef PH_END
}

#ifndef ONE_LAUNCH
#define ONE_LAUNCH 1
#endif
extern "C" void kernel_launch(void* const* d_in, const int* in_sizes, int n_in, void* d_out, int out_size, void* d_ws, size_t ws_size, hipStream_t stream) {
    static int grid = 0;
    if (grid == 0) {
        if (n_in != 18 || out_size != MTOK * DM || ws_size < WS_END) { fprintf(stderr, "kernel_launch: unexpected shapes (n_in %d out %d ws %zu need %zu)\n", n_in, out_size, ws_size, (size_t)WS_END); grid = -1; return; }
        int dev = 0, cus = 0, per_cu = 0;
        if (hipGetDevice(&dev) != hipSuccess || hipDeviceGetAttribute(&cus, hipDeviceAttributeMultiprocessorCount, dev) != hipSuccess) { grid = -1; return; }
        if (hipFuncSetAttribute((const void*)fwd, hipFuncAttributeMaxDynamicSharedMemorySize, LDS_BYTES) != hipSuccess) { fprintf(stderr, "kernel_launch: hipFuncSetAttribute failed\n"); grid = -1; return; }
        if (hipOccupancyMaxActiveBlocksPerMultiprocessor(&per_cu, (const void*)fwd, 512, LDS_BYTES) != hipSuccess || per_cu < 1) { fprintf(stderr, "kernel_launch: occupancy query says %d\n", per_cu); }
        (void)hipGetLastError();
        grid = cus;
    }
    if (grid < 0) return;
    (void)hipMemsetAsync((char*)d_ws + WS_CTL, 0, CTL_BYTES, stream);
    Args a{};
    for (int i = 0; i < 18; ++i) a.in[i] = d_in[i];
    a.out = (float*)d_out; a.ws = (unsigned char*)d_ws; a.pad0 = 0; a.pad1 = 0;
#if ONE_LAUNCH
    a.lo = 0; a.hi = NSTEPS;
    hipLaunchKernelGGL(fwd, dim3(grid), dim3(512), LDS_BYTES, stream, a);
#else
    for (int s = 0; s < NSTEPS; ++s) { a.lo = s; a.hi = s + 1; hipLaunchKernelGGL(fwd, dim3(grid), dim3(512), LDS_BYTES, stream, a); }
#endif
}
```

```cpp
#include <hip/hip_runtime.h>
#include <cstdio>
#include <cstdint>
__device__ __forceinline__ int otid() { int t = threadIdx.x; asm volatile("" : "+v"(t)); return t; }
__device__ __forceinline__ int obid() { int t = blockIdx.x; asm volatile("" : "+s"(t)); return t; }
namespace pg8 {
#define PG8_LAS __attribute__((address_space(3)))
typedef unsigned short bf16_t;
typedef short bf16x8 __attribute__((ext_vector_type(8)));
typedef float f32x4 __attribute__((ext_vector_type(4)));
typedef unsigned u32x4 __attribute__((ext_vector_type(4)));
constexpr int BM = 256, BK = 64, HALF = 128, HTB = HALF * BK * 2  , STAGE_BYTES = 8 * HTB, NXCD = 8, WGM = 8;

__host__ __device__ __forceinline__ int lds_byte(int r, int c) { const int st = (r >> 4) * 2 + (c >> 5), rr = r & 15, cc = c & 31, ob = rr * 64 + cc * 2; return st * 1024 + (ob ^ (((ob >> 9) & 1) << 5)); }
__host__ __device__ __forceinline__ void stage_rc(int b, int& R, int& C) { const int st = b / 1024, sb = b % 1024, swz = sb ^ (((sb >> 9) & 1) << 5); R = (st >> 1) * 16 + swz / 64; C = (st & 1) * 32 + (swz % 64) / 2; }
__host__ __device__ __forceinline__ int perm32(int rho) { const int n = rho >> 4, i = rho & 15; return 8 * (i >> 2) + 4 * n + (i & 3); }

struct Unit { int pm, pn; };
struct Gemm { const bf16_t* A; const bf16_t* Bt; int M, N, K; };

struct StaticOrder {
    int nM, nN, nwg, G, c;
    __host__ __device__ void init(int M, int N, int G_, int c_) { nM = M / BM; nN = N / BM; nwg = nM * nN; G = G_; c = c_; }
    __host__ __device__ bool next(int i, Unit& u) const {
        const long L = (long)i * G + c; if (L >= nwg) return false;
        int wgid = (int)L; { const int q = nwg / NXCD, r = nwg % NXCD, xcd = wgid % NXCD, off = wgid / NXCD; wgid = (xcd < r ? xcd * (q + 1) : r * (q + 1) + (xcd - r) * q) + off; }
        const int nig = WGM * nN, gid = wgid / nig, fm = gid * WGM, gsz = (nM - fm) < WGM ? (nM - fm) : WGM;
        u.pm = fm + ((wgid % nig) % gsz); u.pn = (wgid % nig) / gsz; return true;
    }
    __device__ __forceinline__ void a_ready(const Unit&) const {}
    __device__ __forceinline__ void done(const Unit&) const {}
};

__device__ __forceinline__ unsigned cvt_pk_bf16(float lo, float hi) { unsigned r; asm volatile("v_cvt_pk_bf16_f32 %0, %1, %2" : "=v"(r) : "v"(lo), "v"(hi)); return r; }
typedef float f32x2 __attribute__((ext_vector_type(2)));
__device__ __forceinline__ f32x2 gelu_pk(f32x2 v) {
    const f32x2 av = __builtin_elementwise_abs(v), d = av * 0.2316418882f + 1.0f;
    f32x2 t; t.x = __builtin_amdgcn_rcpf(d.x); t.y = __builtin_amdgcn_rcpf(d.y);
    f32x2 q = t * 0.5307027145f + (-0.7265760135f); q = q * t + 0.7107068705f; q = q * t + (-0.142248368f); q = q * t + 0.127414796f; q = q * t;
    const f32x2 s = (v * v) * (-0.72134752044f);
    f32x2 e; e.x = __builtin_amdgcn_exp2f(s.x); e.y = __builtin_amdgcn_exp2f(s.y);
    const f32x2 m = v * (q * e), r = v - m;
    f32x2 o; o.x = v.x < 0.f ? m.x : r.x; o.y = v.y < 0.f ? m.y : r.y; return o;
}

struct EpiF32 {
    static constexpr bool PERM = false, AFTER_DRAIN = false;
    float* C; int ldc; const float* bias;
    __device__ __forceinline__ void operator()(const f32x4 (&acc)[2][2][4][2], const Unit& u, int wr, int wc, int fr, int fq) const {
        const int row0 = u.pm * BM + wr * 64 + fr, col0 = u.pn * BM + wc * 32 + 4 * fq;
        f32x4 bv[2][2];
#pragma unroll
        for (int bj = 0; bj < 2; ++bj)
#pragma unroll
            for (int n = 0; n < 2; ++n) bv[bj][n] = bias ? *(const f32x4*)(bias + col0 + bj * HALF + n * 16) : (f32x4){0.f, 0.f, 0.f, 0.f};
#pragma unroll
        for (int ai = 0; ai < 2; ++ai)
#pragma unroll
            for (int m = 0; m < 4; ++m) { float* rowp = C + (size_t)(row0 + ai * HALF + m * 16) * ldc + col0;
#pragma unroll
                for (int bj = 0; bj < 2; ++bj)
#pragma unroll
                    for (int n = 0; n < 2; ++n) *(f32x4*)(rowp + bj * HALF + n * 16) = acc[ai][bj][m][n] + bv[bj][n]; }
    }
};
template <int ACT  > struct EpiBf16 {
    static constexpr bool PERM = true, AFTER_DRAIN = false;
    bf16_t* O; int ldc; const float* bias; int split_cols; size_t split_stride;
    __device__ __forceinline__ void operator()(const f32x4 (&acc)[2][2][4][2], const Unit& u, int wr, int wc, int fr, int fq) const {
        const int row0 = u.pm * BM + wr * 64 + fr; int colt = u.pn * BM; bf16_t* base = O;
        if (split_cols) { const int t = colt / split_cols; base += (size_t)t * split_stride; colt -= t * split_cols; }
        const int col0 = colt + wc * 32 + 8 * fq, bcol0 = u.pn * BM + wc * 32 + 8 * fq;
        f32x4 bv[2][2];
#pragma unroll
        for (int bj = 0; bj < 2; ++bj)
#pragma unroll
            for (int n = 0; n < 2; ++n) bv[bj][n] = bias ? *(const f32x4*)(bias + bcol0 + bj * HALF + 4 * n) : (f32x4){0.f, 0.f, 0.f, 0.f};
#pragma unroll
        for (int ai = 0; ai < 2; ++ai)
#pragma unroll
            for (int m = 0; m < 4; ++m) { bf16_t* rowp = base + (size_t)(row0 + ai * HALF + m * 16) * ldc + col0;
#pragma unroll
                for (int bj = 0; bj < 2; ++bj) { f32x4 v0 = acc[ai][bj][m][0] + bv[bj][0], v1 = acc[ai][bj][m][1] + bv[bj][1];
                    if (ACT == 1) { f32x2 a = gelu_pk((f32x2){v0[0], v0[1]}), b = gelu_pk((f32x2){v0[2], v0[3]}), c = gelu_pk((f32x2){v1[0], v1[1]}), d = gelu_pk((f32x2){v1[2], v1[3]});
                        v0 = (f32x4){a.x, a.y, b.x, b.y}; v1 = (f32x4){c.x, c.y, d.x, d.y}; }
                    if (ACT == 2) {
#pragma unroll
                        for (int j = 0; j < 4; ++j) { v0[j] = 0.5f * v0[j] * (1.0f + erff(v0[j] * 0.70710678f)); v1[j] = 0.5f * v1[j] * (1.0f + erff(v1[j] * 0.70710678f)); } }
                    u32x4 w; w.x = cvt_pk_bf16(v0[0], v0[1]); w.y = cvt_pk_bf16(v0[2], v0[3]); w.z = cvt_pk_bf16(v1[0], v1[1]); w.w = cvt_pk_bf16(v1[2], v1[3]);
                    *(u32x4*)(rowp + bj * HALF) = w; } }
    }
};

template <class Epi, class Sched, bool STAMP = false>
__device__ __forceinline__ void gemm_phase(PG8_LAS unsigned char* lds, const Gemm g, const Sched& S, const Epi& E, unsigned long long* stamps) {
    const int tid = otid(), wid = __builtin_amdgcn_readfirstlane(tid >> 6), lane = tid & 63, wr = wid >> 2, wc = wid & 3, fr = lane & 15, fq = lane >> 4;
    const int K = g.K, nt = K / BK;
    int ts_lo = 0, ts_hi = 0, nts = 0; const unsigned long long rt_entry = STAMP ? (unsigned long long)wall_clock64() : 0ull;
#define PG8_STAMP() do { if (STAMP && wid == 0 && nts < 64) { const unsigned long long _c = (unsigned long long)clock64(); \
        ts_lo = (lane == nts) ? (int)(unsigned)_c : ts_lo; ts_hi = (lane == nts) ? (int)(unsigned)(_c >> 32) : ts_hi; ++nts; } } while (0)
    PG8_STAMP();
    unsigned voffA[2], voffB[2];
#pragma unroll
    for (int i = 0; i < 2; ++i) { int R, C; stage_rc(tid * 16 + i * 8192, R, C); const int Rb = Epi::PERM ? ((R & ~31) + perm32(R & 31)) : R;
        voffA[i] = (unsigned)(R * K + C) * 2u; voffB[i] = (unsigned)(Rb * K + C) * 2u; }
    const size_t kstep = (size_t)(BK * 2);
    const size_t hstep = (size_t)HALF * K * 2;
    const size_t tstep = 2 * hstep;
    const unsigned ldsw = (unsigned)wid * 1024u;
    const int aoff = lds_byte(wr * 64 + fr, fq * 8), boff = lds_byte(wc * 32 + fr, fq * 8);
#define PG8_SA(b, h) (((b) * 2 + (h)) * HTB)
#define PG8_SB(b, h) ((4 + (b) * 2 + (h)) * HTB)
#define PG8_STAGE(bufoff, gbase, voff) do { _Pragma("unroll") for (int _i = 0; _i < 2; ++_i) \
        __builtin_amdgcn_global_load_lds((const unsigned*)((const char*)(gbase) + (voff)[_i]), (PG8_LAS unsigned*)(lds + (bufoff) + ldsw + _i * 8192), 16, 0, 0); } while (0)
#define PG8_LDA(dst, b, h) do { _Pragma("unroll") for (int m = 0; m < 4; ++m) _Pragma("unroll") for (int k = 0; k < 2; ++k) dst[m][k] = *(const PG8_LAS bf16x8*)(lds + PG8_SA(b, h) + aoff + m * 2048 + k * 1024); } while (0)
#define PG8_LDB(dst, b, h) do { _Pragma("unroll") for (int n = 0; n < 2; ++n) _Pragma("unroll") for (int k = 0; k < 2; ++k) dst[n][k] = *(const PG8_LAS bf16x8*)(lds + PG8_SB(b, h) + boff + n * 2048 + k * 1024); } while (0)
#define PG8_MMA(ai, bj, At, Bt) do { __builtin_amdgcn_s_setprio(1); _Pragma("unroll") for (int m = 0; m < 4; ++m) _Pragma("unroll") for (int n = 0; n < 2; ++n) _Pragma("unroll") for (int k = 0; k < 2; ++k) \
        acc[ai][bj][m][n] = __builtin_amdgcn_mfma_f32_16x16x32_bf16(Bt[n][k], At[m][k], acc[ai][bj][m][n], 0, 0, 0); __builtin_amdgcn_s_setprio(0); } while (0)
#define PG8_WAIT_V(n) asm volatile("s_waitcnt vmcnt(" #n ")" ::: "memory")
#define PG8_WAIT_L(n) asm volatile("s_waitcnt lgkmcnt(" #n ")" ::: "memory")
#define PG8_BAR __builtin_amdgcn_s_barrier()
#define PG8_SCHED __builtin_amdgcn_sched_barrier(0)
    Unit cur, nxt; int ui = 0;
    if (!S.next(0, cur)) return;
    f32x4 acc[2][2][4][2];
#pragma unroll
    for (int a = 0; a < 2; ++a)
#pragma unroll
        for (int b = 0; b < 2; ++b)
#pragma unroll
            for (int m = 0; m < 4; ++m)
#pragma unroll
                for (int n = 0; n < 2; ++n) acc[a][b][m][n] = (f32x4){0.f, 0.f, 0.f, 0.f};
    bf16x8 At[4][2], B0[2][2], B1[2][2];
    const char* cA = (const char*)g.A + (size_t)cur.pm * tstep; const char* cB = (const char*)g.Bt + (size_t)cur.pn * tstep;
    S.a_ready(cur);
    PG8_STAGE(PG8_SB(0, 0), cB, voffB); PG8_STAGE(PG8_SA(0, 0), cA, voffA); PG8_STAGE(PG8_SB(0, 1), cB + hstep, voffB); PG8_STAGE(PG8_SA(0, 1), cA + hstep, voffA);
    if (wr == 1) PG8_BAR;
    PG8_WAIT_V(4); PG8_BAR;
    PG8_STAGE(PG8_SB(1, 0), cB + kstep, voffB); PG8_STAGE(PG8_SA(1, 0), cA + kstep, voffA); PG8_STAGE(PG8_SB(1, 1), cB + hstep + kstep, voffB);
    PG8_WAIT_V(6); PG8_BAR;
    PG8_STAMP();
    for (;;) {
        const bool has_next = S.next(ui + 1, nxt);
        const char* nA = has_next ? (const char*)g.A + (size_t)nxt.pm * tstep : cA; const char* nB = has_next ? (const char*)g.Bt + (size_t)nxt.pn * tstep : cB;
        for (int t = 0; t < nt; t += 2) {
            const bool last = (t == nt - 2);
            const char* a1 = cA + (size_t)(t + 1) * kstep;
            const char* a2 = last ? nA : cA + (size_t)(t + 2) * kstep; const char* b2 = last ? nB : cB + (size_t)(t + 2) * kstep;
            const char* a3 = a2 + kstep; const char* b3 = b2 + kstep;
            if (last && has_next) S.a_ready(nxt);
            PG8_LDB(B0, 0, 0); PG8_SCHED; PG8_LDA(At, 0, 0); PG8_STAGE(PG8_SA(1, 1), a1 + hstep, voffA);
            PG8_WAIT_L(8); PG8_BAR; PG8_WAIT_L(0); PG8_MMA(0, 0, At, B0); PG8_BAR; PG8_SCHED;
            PG8_LDB(B1, 0, 1); PG8_STAGE(PG8_SB(0, 0), b2, voffB);
            PG8_BAR; PG8_WAIT_L(0); PG8_MMA(0, 1, At, B1); PG8_BAR;
            PG8_LDA(At, 0, 1); PG8_STAGE(PG8_SA(0, 0), a2, voffA);
            PG8_BAR; PG8_WAIT_L(0); PG8_MMA(1, 0, At, B0); PG8_BAR; PG8_SCHED;
            PG8_STAGE(PG8_SB(0, 1), b2 + hstep, voffB);
            PG8_WAIT_V(6); PG8_BAR; PG8_MMA(1, 1, At, B1); PG8_BAR;
            PG8_LDB(B0, 1, 0); PG8_SCHED; PG8_LDA(At, 1, 0); PG8_STAGE(PG8_SA(0, 1), a2 + hstep, voffA);
            PG8_WAIT_L(8); PG8_BAR; PG8_WAIT_L(0); PG8_MMA(0, 0, At, B0); PG8_BAR; PG8_SCHED;
            PG8_LDB(B1, 1, 1); PG8_STAGE(PG8_SB(1, 0), b3, voffB);
            PG8_BAR; PG8_WAIT_L(0); PG8_MMA(0, 1, At, B1); PG8_BAR;
            PG8_LDA(At, 1, 1); PG8_STAGE(PG8_SA(1, 0), a3, voffA);
            PG8_BAR; PG8_WAIT_L(0); PG8_MMA(1, 0, At, B0); PG8_BAR; PG8_SCHED;
            PG8_STAGE(PG8_SB(1, 1), b3 + hstep, voffB);
            PG8_WAIT_V(6); PG8_BAR; PG8_MMA(1, 1, At, B1); PG8_BAR;
        }
        PG8_STAMP();
        if constexpr (!Epi::AFTER_DRAIN) { E(acc, cur, wr, wc, fr, fq); S.done(cur); }
        PG8_STAMP();
        if (!has_next) break;
#pragma unroll
        for (int a = 0; a < 2; ++a)
#pragma unroll
            for (int b = 0; b < 2; ++b)
#pragma unroll
                for (int m = 0; m < 4; ++m)
#pragma unroll
                    for (int n = 0; n < 2; ++n) acc[a][b][m][n] = (f32x4){0.f, 0.f, 0.f, 0.f};
        cur = nxt; cA = nA; cB = nB; ++ui;
    }
    PG8_WAIT_V(0);
    if (wr == 0) PG8_BAR;
    PG8_BAR;
    if constexpr (Epi::AFTER_DRAIN) { E.fused(acc, cur, wr, wc, fr, fq, lds, wid, lane); S.done(cur); }
    PG8_STAMP();
    if (STAMP && wid == 0) { stamps[lane] = lane < nts ? (((unsigned long long)(unsigned)ts_hi << 32) | (unsigned)ts_lo) : 0ull;
        if (lane == 62) stamps[62] = rt_entry; if (lane == 63) stamps[63] = (unsigned long long)wall_clock64(); }
#undef PG8_STAMP
#undef PG8_SA
#undef PG8_SB
#undef PG8_STAGE
#undef PG8_LDA
#undef PG8_LDB
#undef PG8_MMA
#undef PG8_WAIT_V
#undef PG8_WAIT_L
#undef PG8_BAR
#undef PG8_SCHED
}
}
#define XB_TMO      128
#define XB_XCNT(j)  (256  + 64 * (j))
#define XB_XSUB(j)  (1280 + 64 * (j))
#define XB_XGEN(j)  (2304 + 64 * (j))
#define XB_TOP      3328
#define XB_TOPGEN   3392
#define XCD_BAR_WORDS 3456
#define XB_SPIN_CAP (1u << 18)
#define LAS __attribute__((address_space(3)))

__device__ __forceinline__ unsigned xb_ld(unsigned* p)              { return __hip_atomic_load(p, __ATOMIC_RELAXED, __HIP_MEMORY_SCOPE_AGENT); }
__device__ __forceinline__ unsigned xb_add(unsigned* p, unsigned v) { return __hip_atomic_fetch_add(p, v, __ATOMIC_RELAXED, __HIP_MEMORY_SCOPE_AGENT); }
__device__ __forceinline__ unsigned xb_xcc_id() { return (unsigned)__builtin_amdgcn_s_getreg((3 << 11) | 20) & 0xFu; }
#define XB_SPIN(cond, bar) do { unsigned _sp = 0; while (cond) { __builtin_amdgcn_s_sleep(1); \
    if ((++_sp & 255u) == 0u) { if (xb_ld(&(bar)[XB_TMO])) break; if (_sp > XB_SPIN_CAP) { atomicAdd(&(bar)[XB_TMO], 1u); break; } } } } while (0)

struct XcdBarrier {
    unsigned* bar; unsigned x;
    volatile LAS unsigned* st;
};

__device__ __forceinline__ XcdBarrier xcd_barrier_post(unsigned* bar, volatile LAS unsigned* st) {
    XcdBarrier b; b.bar = bar; b.x = xb_xcc_id(); b.st = st;
    if (threadIdx.x == 0) (void)xb_add(&bar[XB_XCNT(b.x)], 1u);
    return b;
}
__device__ __forceinline__ void xcd_barrier_complete(unsigned* bar, unsigned x, unsigned& nloc, unsigned& nx) {
    const unsigned G = gridDim.x * gridDim.y * gridDim.z;
    unsigned sum, cnt, mine, sp = 0u;
    for (;;) {
        sum = 0u; cnt = 0u; mine = 0u;
#pragma unroll
        for (unsigned j = 0; j < 16; ++j) { const unsigned c = xb_ld(&bar[XB_XCNT(j)]); sum += c; cnt += (c > 0u) ? 1u : 0u; mine = (j == x) ? c : mine; }
        if (sum == G) break;
        __builtin_amdgcn_s_sleep(1);
        if ((++sp & 255u) == 0u) { if (xb_ld(&bar[XB_TMO])) break; if (sp > XB_SPIN_CAP) { atomicAdd(&bar[XB_TMO], 1u); break; } }
    }
    nloc = mine > 0u ? mine : 1u; nx = cnt > 0u ? cnt : 1u;
}

__device__ __forceinline__ void xcd_barrier(const XcdBarrier& b) {
    asm volatile("s_waitcnt vmcnt(0)" ::: "memory");
    __syncthreads();
    if (threadIdx.x == 0) {
        unsigned* bar = b.bar;
        __builtin_amdgcn_s_waitcnt(0);
        unsigned nloc = b.st[0], nx = b.st[1];
        if (nloc == 0u) { xcd_barrier_complete(bar, b.x, nloc, nx); b.st[0] = nloc; b.st[1] = nx; }
        const unsigned old = xb_add(&bar[XB_XSUB(b.x)], 1u);
        const unsigned gen = old / nloc;
        if (old + 1u == (gen + 1u) * nloc) {
            __builtin_amdgcn_fence(__ATOMIC_RELEASE, "agent");
            asm volatile("s_waitcnt vmcnt(0)" ::: "memory");
            const unsigned og = xb_add(&bar[XB_TOP], 1u);
            const unsigned tg = og / nx;
            if (og + 1u == (tg + 1u) * nx) xb_add(&bar[XB_TOPGEN], 1u);
            else XB_SPIN(xb_ld(&bar[XB_TOPGEN]) == tg, bar);
            __builtin_amdgcn_fence(__ATOMIC_ACQUIRE, "agent");
            xb_add(&bar[XB_XGEN(b.x)], 1u);
            asm volatile("s_waitcnt vmcnt(0)" ::: "memory");
        } else {
            XB_SPIN(xb_ld(&bar[XB_XGEN(b.x)]) == gen, bar);
            __builtin_amdgcn_fence(__ATOMIC_ACQUIRE, "agent");
            asm volatile("s_waitcnt vmcnt(0)" ::: "memory");
        }
    }
    __syncthreads();
}


typedef unsigned short bf16;
typedef unsigned v4u __attribute__((ext_vector_type(4)));
typedef unsigned v2u __attribute__((ext_vector_type(2)));
typedef float v4f __attribute__((ext_vector_type(4)));

constexpr int DM = 2048, NBATCH = 8, SEQ = 4096, DEPTH = 2, MTOK = NBATCH * SEQ;
constexpr int IN_COLS = 14416, NPROJ = 14592;
constexpr int C_CQ = 0, C_CKV = 512, C_ZA = 1024, C_UB = 2048, C_VB = 3072, C_ZB = 4096, C_QC = 5120, C_KC = 5632, C_VC = 6144, C_ZC = 7168,
              C_GATE = 8192, C_KROPE = 14336, C_AR = 14400;
constexpr float EPS = 1e-6f;
#ifndef NBP
#define NBP 2
#endif
constexpr int MP = NBP * SEQ, NPASS = NBATCH / NBP;
constexpr int STEPS_PER_PASS = 10;
constexpr int NSTEPS = 1 + DEPTH * NPASS * STEPS_PER_PASS;

constexpr size_t al256(size_t x) { return (x + 255) & ~(size_t)255; }
constexpr size_t WS_CTL = 0, CTL_BYTES = 1u << 20;
constexpr size_t SZ_WIN = (size_t)NPROJ * DM * 2, SZ_WUQ = (size_t)1536 * 512 * 2, SZ_WUKV = (size_t)2048 * 512 * 2, SZ_WB = (size_t)3 * 2048 * 1024 * 2, SZ_WO = (size_t)2048 * 2048 * 2;
constexpr size_t SZ_WLAYER = SZ_WIN + SZ_WUQ + SZ_WUKV + SZ_WB + SZ_WO;
constexpr size_t WS_W = CTL_BYTES;
constexpr size_t WS_COS = WS_W + DEPTH * SZ_WLAYER, WS_SIN = WS_COS + (size_t)MTOK * 32 * 4;
constexpr size_t WS_H = WS_SIN + (size_t)MTOK * 32 * 4;
constexpr size_t WS_PROJ = WS_H + (size_t)MP * DM * 2;
constexpr size_t WS_CQN = WS_PROJ + (size_t)MP * NPROJ * 2;
constexpr size_t WS_CKVN = WS_CQN + (size_t)MP * 512 * 2;
constexpr size_t WS_RV = WS_CKVN + (size_t)MP * 512 * 2;
constexpr size_t WS_Q = WS_RV + al256((size_t)MP * 4);
constexpr size_t WS_KV = WS_Q + (size_t)MP * 1536 * 2;
constexpr size_t WS_K = WS_KV + (size_t)MP * 2048 * 2;
constexpr size_t WS_YA = WS_K + (size_t)MP * 1536 * 2;
constexpr size_t WS_YB = WS_YA + (size_t)MP * 1024 * 2;
constexpr size_t WS_YC = WS_YB + (size_t)MP * 1024 * 2;
constexpr size_t WS_OC = WS_YC + (size_t)MP * 1024 * 2;
constexpr size_t WS_PB = WS_OC + (size_t)MP * 1024 * 4;
constexpr size_t WS_MG = WS_PB + (size_t)3 * MP * 2048 * 2;
constexpr size_t WS_U = WS_MG + (size_t)MP * 2048 * 2;
constexpr size_t WS_QE = WS_U + (size_t)MP * 2048 * 4;
constexpr size_t WS_KE = WS_QE + (size_t)MP * 512 * 2, WS_KL = WS_KE + (size_t)MP * 512 * 2;
constexpr size_t WS_DS = WS_KL + (size_t)MP * 512 * 2;
constexpr size_t WS_DL = WS_DS + (size_t)(MP / 128) * 512 * 4;
constexpr size_t WS_XB = WS_DL + (size_t)MP * 1024 * 4;
constexpr size_t WS_END = WS_XB + (size_t)MP * 1024 * 2;
static_assert(WS_END <= ((size_t)1 << 30), "workspace map exceeds 1 GiB");

constexpr int LDS_BYTES = 147456;
constexpr int LDSCTL_OFF = LDS_BYTES - 256;
constexpr int CW_BAR = 4096;

__device__ __forceinline__ float bf2f(unsigned v) { return __uint_as_float(v << 16); }
__device__ __forceinline__ unsigned f2bf(float f) { unsigned u = __float_as_uint(f); return (u + 0x7fffu + ((u >> 16) & 1u)) >> 16; }
__device__ __forceinline__ unsigned pk2(float lo, float hi) { return f2bf(lo) | (f2bf(hi) << 16); }
__device__ __forceinline__ float lo16(unsigned w) { return __uint_as_float(w << 16); }
__device__ __forceinline__ float hi16(unsigned w) { return __uint_as_float(w & 0xffff0000u); }
__device__ __forceinline__ float sigmoid_f(float x) { return 1.f / (1.f + __expf(-x)); }
__device__ __forceinline__ float silu_f(float x) { return x / (1.f + __expf(-x)); }
__device__ __forceinline__ float gelu_f(float x) { const float u = 0.7978845608028654f * (x + 0.044715f * x * x * x); return 0.5f * x * (1.f + tanhf(u)); }
template <int O> __device__ __forceinline__ float lane_xor(float v) {
    if (O == 1) return __uint_as_float((unsigned)__builtin_amdgcn_mov_dpp((int)__float_as_uint(v), 0xB1, 0xf, 0xf, true));
    if (O == 2) return __uint_as_float((unsigned)__builtin_amdgcn_mov_dpp((int)__float_as_uint(v), 0x4E, 0xf, 0xf, true));
    return __uint_as_float((unsigned)__builtin_amdgcn_ds_swizzle((int)__float_as_uint(v), (O << 10) | 0x1f)); }
__device__ __forceinline__ float lane_xor32(float v, int lane) {
    auto rr = __builtin_amdgcn_permlane32_swap(__float_as_uint(v), __float_as_uint(v), false, false);
    return __uint_as_float(lane < 32 ? rr[1] : rr[0]); }
__device__ __forceinline__ float wave_sum(float v) {
    v += lane_xor<1>(v); v += lane_xor<2>(v); v += lane_xor<4>(v); v += lane_xor<8>(v); v += lane_xor<16>(v);
    auto rr = __builtin_amdgcn_permlane32_swap(__float_as_uint(v), __float_as_uint(v), false, false);
    return __uint_as_float(rr[0]) + __uint_as_float(rr[1]); }
__device__ __forceinline__ float wave_max(float v) {
    v = fmaxf(v, lane_xor<1>(v)); v = fmaxf(v, lane_xor<2>(v)); v = fmaxf(v, lane_xor<4>(v)); v = fmaxf(v, lane_xor<8>(v)); v = fmaxf(v, lane_xor<16>(v));
    auto rr = __builtin_amdgcn_permlane32_swap(__float_as_uint(v), __float_as_uint(v), false, false);
    return fmaxf(__uint_as_float(rr[0]), __uint_as_float(rr[1])); }
#define LDS_FENCE() asm volatile("s_waitcnt lgkmcnt(0)" ::: "memory")

struct Args { const void* in[18]; float* out; unsigned char* ws; int lo, hi, pad0, pad1; };

template <int MODE> __device__ __forceinline__ int src_col(int n) {
    if (MODE == 0) return n;
    if (n < C_ZA) return n;
    if (n < C_ZC) return n + 64;
    if (n < C_KROPE) return n + 80;
    if (n < C_AR) return 1024 + (n - C_KROPE);
    if (n < C_AR + 16) return 7232 + (n - C_AR);
    return -1;
}
template <int MODE> __device__ __forceinline__ void convert_T(const float* W, int K, int Nsrc, bf16* WT, int Ndst, LAS float* tile, int vb, int nvb) {
    const int tid = otid(), ntk = K / 64, ntn = Ndst / 64, ntiles = ntk * ntn;
    for (int t = vb; t < ntiles; t += nvb) {
        const int k0 = (t % ntk) * 64, n0 = (t / ntk) * 64;
        { const int nn = tid & 63, sc = src_col<MODE>(n0 + nn);
#pragma unroll
          for (int i = 0; i < 8; ++i) { const int kk = (tid >> 6) + 8 * i; tile[kk * 65 + nn] = sc >= 0 ? W[(size_t)(k0 + kk) * Nsrc + sc] : 0.f; } }
        __syncthreads();
        { const int kk = tid & 63;
#pragma unroll
          for (int i = 0; i < 8; ++i) { const int nn = (tid >> 6) + 8 * i; WT[(size_t)(n0 + nn) * K + k0 + kk] = (bf16)f2bf(tile[kk * 65 + nn]); } }
        __syncthreads();
    }
}

__device__ __forceinline__ void ph_norm(const float* xin, const float* g, bf16* h, int rows, int vb, int nvb) {
    const int tid_ = otid(); const int lane = tid_ & 63, wave = tid_ >> 6;
    for (int r = vb * 8 + wave; r < rows; r += nvb * 8) {
        const v4f* xr = (const v4f*)(xin + (size_t)r * DM);
        v4f v[8]; float ss = 0.f;
#pragma unroll
        for (int j = 0; j < 8; ++j) { v[j] = xr[lane + 64 * j]; ss += v[j].x * v[j].x + v[j].y * v[j].y + v[j].z * v[j].z + v[j].w * v[j].w; }
        ss = wave_sum(ss);
        const float rn = 1.0f / sqrtf(ss * (1.0f / DM) + EPS);
#pragma unroll
        for (int j = 0; j < 8; ++j) { const v4f gg = ((const v4f*)g)[lane + 64 * j];
            v2u o; o.x = pk2(v[j].x * rn * gg.x, v[j].y * rn * gg.y); o.y = pk2(v[j].z * rn * gg.z, v[j].w * rn * gg.w);
            *(v2u*)(h + (size_t)r * DM + (lane + 64 * j) * 4) = o; }
    }
}
__device__ __forceinline__ void ph_prep(const bf16* proj, const float* gq, const float* gkv, bf16* cqn, bf16* ckvn, float* rv, int vb, int nvb) {
    const int tid_ = otid(); const int lane = tid_ & 63, wave = tid_ >> 6;
    for (int r = vb * 8 + wave; r < MP; r += nvb * 8) {
        const bf16* pr = proj + (size_t)r * NPROJ;
#pragma unroll
        for (int which = 0; which < 2; ++which) {
            const v4u w = *(const v4u*)(pr + (which ? C_CKV : C_CQ) + lane * 8);
            float x[8] = {lo16(w.x), hi16(w.x), lo16(w.y), hi16(w.y), lo16(w.z), hi16(w.z), lo16(w.w), hi16(w.w)};
            float ss = 0.f;
#pragma unroll
            for (int i = 0; i < 8; ++i) ss += x[i] * x[i];
            ss = wave_sum(ss);
            const float rn = 1.0f / sqrtf(ss * (1.0f / 512.f) + EPS);
            const float* g = (which ? gkv : gq) + lane * 8;
            v4u o; o.x = pk2(x[0] * rn * g[0], x[1] * rn * g[1]); o.y = pk2(x[2] * rn * g[2], x[3] * rn * g[3]); o.z = pk2(x[4] * rn * g[4], x[5] * rn * g[5]); o.w = pk2(x[6] * rn * g[6], x[7] * rn * g[7]);
            *(v4u*)((which ? ckvn : cqn) + (size_t)r * 512 + lane * 8) = o;
        }
        float ss = 0.f;
#pragma unroll
        for (int j = 0; j < 2; ++j) { const v4u w = *(const v4u*)(pr + C_VB + (lane + 64 * j) * 8);
            const float x[8] = {lo16(w.x), hi16(w.x), lo16(w.y), hi16(w.y), lo16(w.z), hi16(w.z), lo16(w.w), hi16(w.w)};
#pragma unroll
            for (int i = 0; i < 8; ++i) { const float gv = gelu_f(x[i]); ss += gv * gv; } }
        ss = wave_sum(ss);
        if (lane == 0) rv[r] = 1.0f / sqrtf(ss * (1.0f / 1024.f) + EPS);
    }
}
__device__ __forceinline__ void ph_qkfin(bf16* q, const bf16* kv, const bf16* proj, bf16* K, const float* qg, const float* kg, const float* cosT, const float* sinT, int row0, int vb, int nvb) {
    const int tid_ = otid(); const int lane = tid_ & 63, wave = tid_ >> 6;
    for (int it = vb * 8 + wave; it < MP * 8; it += nvb * 8) {
        const int r = it >> 3, hd = it & 7;
        const float c = cosT[(size_t)(row0 + r) * 32 + (lane & 31)], s = sinT[(size_t)(row0 + r) * 32 + (lane & 31)];
        {   bf16* qp = q + ((size_t)r * 8 + hd) * 192;
            const float v0 = bf2f(qp[lane]), v1 = bf2f(qp[lane + 64]), v2 = bf2f(qp[lane + 128]);
            const float ss = wave_sum(v0 * v0 + v1 * v1 + v2 * v2);
            const float rn = 1.0f / sqrtf(ss * (1.0f / 192.f) + EPS);
            const float n0 = v0 * rn * qg[lane], n1 = v1 * rn * qg[lane + 64], n2 = v2 * rn * qg[lane + 128];
            const float pn = lane_xor32(n2, lane);
            const float o2 = lane < 32 ? n2 * c - pn * s : n2 * c + pn * s;
            qp[lane] = (bf16)f2bf(n0); qp[lane + 64] = (bf16)f2bf(n1); qp[lane + 128] = (bf16)f2bf(o2); }
        {   const bf16* kp = kv + (size_t)r * 2048 + hd * 256;
            const float v0 = bf2f(kp[lane]), v1 = bf2f(kp[lane + 64]), v2 = bf2f(proj[(size_t)r * NPROJ + C_KROPE + lane]);
            const float ss = wave_sum(v0 * v0 + v1 * v1 + v2 * v2);
            const float rn = 1.0f / sqrtf(ss * (1.0f / 192.f) + EPS);
            const float n0 = v0 * rn * kg[lane], n1 = v1 * rn * kg[lane + 64], n2 = v2 * rn * kg[lane + 128];
            const float pn = lane_xor32(n2, lane);
            const float o2 = lane < 32 ? n2 * c - pn * s : n2 * c + pn * s;
            bf16* ko = K + ((size_t)r * 8 + hd) * 192;
            ko[lane] = (bf16)f2bf(n0); ko[lane + 64] = (bf16)f2bf(n1); ko[lane + 128] = (bf16)f2bf(o2); }
    }
}
__device__ __forceinline__ void ph_attn_naive(const bf16* Q, const bf16* K, const bf16* KV, const bf16* proj, bf16* YA, LAS float* lds, int vb, int nvb) {
    const int tid_ = otid(); const int lane = tid_ & 63, wave = tid_ >> 6;
    LAS float* qs = lds + wave * (4096 + 192); LAS float* ps = qs + 192;
    const float scale = 0.07216878364870322f;
    for (int it = vb * 8 + wave; it < NBP * 8 * SEQ; it += nvb * 8) {
        const int t = it % SEQ, bh = it / SEQ, h = bh & 7, b = bh >> 3, r = b * SEQ + t;
        { const bf16* qp = Q + ((size_t)r * 8 + h) * 192; qs[lane] = bf2f(qp[lane]); qs[lane + 64] = bf2f(qp[lane + 64]); qs[lane + 128] = bf2f(qp[lane + 128]); }
        LDS_FENCE();
        float m = -3.0e38f;
        for (int j = lane; j <= t; j += 64) {
            const v4u* kr = (const v4u*)(K + ((size_t)(b * SEQ + j) * 8 + h) * 192);
            float s = 0.f;
#pragma unroll 4
            for (int c = 0; c < 24; ++c) { const v4u w = kr[c]; const LAS float* qq = qs + c * 8;
                s += qq[0] * lo16(w.x) + qq[1] * hi16(w.x) + qq[2] * lo16(w.y) + qq[3] * hi16(w.y) + qq[4] * lo16(w.z) + qq[5] * hi16(w.z) + qq[6] * lo16(w.w) + qq[7] * hi16(w.w); }
            s *= scale; ps[j] = s; m = fmaxf(m, s);
        }
        m = wave_max(m);
        float l = 0.f;
        for (int j = lane; j <= t; j += 64) { const float p = __expf(ps[j] - m); ps[j] = p; l += p; }
        l = wave_sum(l);
        LDS_FENCE();
        float a0 = 0.f, a1 = 0.f;
        const bf16* vp = KV + (size_t)(b * SEQ) * 2048 + h * 256 + 128 + 2 * lane;
        for (int j = 0; j <= t; ++j) { const float p = ps[j]; const unsigned w = *(const unsigned*)(vp + (size_t)j * 2048); a0 += p * lo16(w); a1 += p * hi16(w); }
        const float inv = 1.0f / l;
        const unsigned zw = *(const unsigned*)(proj + (size_t)r * NPROJ + C_ZA + h * 128 + 2 * lane);
        *(unsigned*)(YA + (size_t)r * 1024 + h * 128 + 2 * lane) = pk2(a0 * inv * silu_f(lo16(zw)), a1 * inv * silu_f(hi16(zw)));
        LDS_FENCE();
    }
}
__device__ __forceinline__ void ph_sgu_naive(const bf16* proj, const float* rv, const float* Ws, const float* bs, const float* vg, bf16* YB, int vb, int nvb) {
    for (size_t idx = (size_t)vb * 512 + otid(); idx < (size_t)MP * 1024; idx += (size_t)nvb * 512) {
        const int r = (int)(idx >> 10), col = (int)(idx & 1023), g = col >> 7, tl = r & 127, rc = r - tl;
        float acc = 0.f;
        const float* wrow = Ws + ((size_t)g * 128 + tl) * 128;
        for (int sl = 0; sl <= tl; ++sl) acc += wrow[sl] * gelu_f(bf2f(proj[(size_t)(rc + sl) * NPROJ + C_VB + col])) * rv[rc + sl];
        acc = acc * vg[col] + bs[g * 128 + tl];
        const float u = gelu_f(bf2f(proj[(size_t)r * NPROJ + C_UB + col])), z = silu_f(bf2f(proj[(size_t)r * NPROJ + C_ZB + col]));
        YB[idx] = (bf16)f2bf(u * acc * z);
    }
}
__device__ __forceinline__ void ph_gla_naive(const bf16* proj, const float* wa2, const float* ba, float* OC, LAS float* lds, int vb, int nvb) {
    const int tid_ = otid(); const int lane = tid_ & 63, wave = tid_ >> 6;
    LAS float* sh = lds + wave * 512;
    for (int it = wave * nvb + vb; it < NBP * 16; it += nvb * 8) {
        const int b = it >> 4, h = (it >> 2) & 3, vq = it & 3;
        float st[128];
#pragma unroll
        for (int k = 0; k < 128; ++k) st[k] = 0.f;
        float wa0[16], wa1[16];
#pragma unroll
        for (int j = 0; j < 16; ++j) { wa0[j] = wa2[j * 512 + h * 128 + lane]; wa1[j] = wa2[j * 512 + h * 128 + 64 + lane]; }
        const float ba0 = ba[h * 128 + lane], ba1 = ba[h * 128 + 64 + lane];
        for (int t = 0; t < SEQ; ++t) {
            const bf16* pr = proj + (size_t)(b * SEQ + t) * NPROJ;
            const v4u w0 = *(const v4u*)(pr + C_AR), w1 = *(const v4u*)(pr + C_AR + 8);
            const float ar[16] = {lo16(w0.x), hi16(w0.x), lo16(w0.y), hi16(w0.y), lo16(w0.z), hi16(w0.z), lo16(w0.w), hi16(w0.w),
                                  lo16(w1.x), hi16(w1.x), lo16(w1.y), hi16(w1.y), lo16(w1.z), hi16(w1.z), lo16(w1.w), hi16(w1.w)};
            float x0 = ba0, x1 = ba1;
#pragma unroll
            for (int j = 0; j < 16; ++j) { x0 += ar[j] * wa0[j]; x1 += ar[j] * wa1[j]; }
            const float ls0 = fminf(x0, 0.f) - log1pf(__expf(-fabsf(x0))), ls1 = fminf(x1, 0.f) - log1pf(__expf(-fabsf(x1)));
            sh[lane] = __expf(ls0 * 0.0625f); sh[64 + lane] = __expf(ls1 * 0.0625f);
            sh[128 + lane] = bf2f(pr[C_QC + h * 128 + lane]) * 0.08838834764831845f; sh[192 + lane] = bf2f(pr[C_QC + h * 128 + 64 + lane]) * 0.08838834764831845f;
            sh[256 + lane] = bf2f(pr[C_KC + h * 128 + lane]); sh[320 + lane] = bf2f(pr[C_KC + h * 128 + 64 + lane]);
            const float v = bf2f(pr[C_VC + h * 256 + vq * 64 + lane]);
            LDS_FENCE();
            float o = 0.f;
#pragma unroll
            for (int k = 0; k < 128; ++k) { st[k] = sh[k] * st[k] + sh[256 + k] * v; o += sh[128 + k] * st[k]; }
            LDS_FENCE();
            OC[(size_t)(b * SEQ + t) * 1024 + h * 256 + vq * 64 + lane] = o;
        }
    }
}
__device__ __forceinline__ void ph_glafin(const float* OC, const bf16* proj, const float* og, bf16* YC, int vb, int nvb) {
    const int tid_ = otid(); const int lane = tid_ & 63, wave = tid_ >> 6;
    for (int it = vb * 8 + wave; it < MP * 4; it += nvb * 8) {
        const int r = it >> 2, h = it & 3;
        const v4f o = *(const v4f*)(OC + (size_t)r * 1024 + h * 256 + lane * 4);
        const float ss = wave_sum(o.x * o.x + o.y * o.y + o.z * o.z + o.w * o.w);
        const float rn = 1.0f / sqrtf(ss * (1.0f / 256.f) + EPS);
        const v4f g = *(const v4f*)(og + lane * 4);
        const v2u zw = *(const v2u*)(proj + (size_t)r * NPROJ + C_ZC + h * 256 + lane * 4);
        v2u w; w.x = pk2(o.x * rn * g.x * silu_f(lo16(zw.x)), o.y * rn * g.y * silu_f(hi16(zw.x))); w.y = pk2(o.z * rn * g.z * silu_f(lo16(zw.y)), o.w * rn * g.w * silu_f(hi16(zw.y)));
        *(v2u*)(YC + (size_t)r * 1024 + h * 256 + lane * 4) = w;
    }
}
__device__ __forceinline__ void ph_merge(const bf16* proj, const bf16* PB, bf16* MG, int vb, int nvb) {
    for (size_t idx = (size_t)vb * 512 + otid(); idx < (size_t)MP * 1024; idx += (size_t)nvb * 512) {
        const int r = (int)(idx >> 10), j = (int)(idx & 1023) * 2;
        float m0 = 0.f, m1 = 0.f;
#pragma unroll
        for (int b = 0; b < 3; ++b) { const unsigned gw = *(const unsigned*)(proj + (size_t)r * NPROJ + C_GATE + b * 2048 + j), pw = *(const unsigned*)(PB + ((size_t)b * MP + r) * 2048 + j);
            m0 += sigmoid_f(lo16(gw)) * lo16(pw); m1 += sigmoid_f(hi16(gw)) * hi16(pw); }
        *(unsigned*)(MG + (size_t)r * 2048 + j) = pk2(m0, m1);
    }
}
__device__ __forceinline__ void ph_outadd(const float* xin, const float* U, float* xout, int vb, int nvb) {
    for (size_t idx = (size_t)vb * 512 + otid(); idx < (size_t)MP * 512; idx += (size_t)nvb * 512) {
        const v4f a = ((const v4f*)xin)[idx], u = ((const v4f*)U)[idx]; ((v4f*)xout)[idx] = a + u; }
}


namespace at {
typedef short bf16x8 __attribute__((ext_vector_type(8)));
typedef short s16x4 __attribute__((ext_vector_type(4)));
typedef float f32x16 __attribute__((ext_vector_type(16)));
typedef unsigned u32x4 __attribute__((ext_vector_type(4)));
constexpr int SHM_V = 16384, SHM_K = 16384, SHM_KR = 8192;
constexpr int OFF_V = 0, OFF_K = 2 * SHM_V, OFF_KR = OFF_K + 2 * SHM_K, OFF_WS = OFF_KR + 2 * SHM_KR, LDS_NEED = OFF_WS + 8 * 64 * 4;
constexpr float SCALE = 0.07216878364870322f;
constexpr float THR = 8.f;
#define AT_KSWZ(row, colB) ((row) * 256 + ((colB) ^ (((row) & 7) << 4)))
#define AT_KRSWZ(row, colB) ((row) * 128 + ((colB) ^ (((row) & 7) << 4)))
#define AT_SBAR() __builtin_amdgcn_sched_barrier(0)
__device__ __forceinline__ int v_st(int k, int c) { const int kk = (k & ~0xC) | ((k & 4) << 1) | ((k & 8) >> 1); return ((kk >> 3) * 4 + (c >> 5)) * 512 + ((kk & 7) * 32 + (c & 31)) * 2; }
__device__ __forceinline__ int v_rd_base(int lane) { return ((lane & 3) << 3) | (((lane >> 2) & 3) << 6) | (((lane >> 4) & 1) << 5) | (((lane >> 5) & 1) << 8); }
constexpr int v_rd_off(int d0, int ks, int half) { return d0 * 512 + ks * 4096 + half * 2048; }
__device__ __forceinline__ int crow(int r, int hi) { return (r & 3) + 8 * (r >> 2) + 4 * hi; }
__device__ __forceinline__ unsigned cvtpk(float lo, float hi) { unsigned r; asm("v_cvt_pk_bf16_f32 %0, %1, %2" : "=v"(r) : "v"(lo), "v"(hi)); return r; }

__device__ __forceinline__ void mask_tile(f32x16& p0, f32x16& p1, int dq) {
    const float NEG = -__builtin_inff();
#pragma unroll
    for (int r = 0; r < 16; ++r) { const int c = (r & 3) + 8 * (r >> 2); if (dq < c) p0[r] = NEG; if (dq < c + 32) p1[r] = NEG; }
}
__device__ __forceinline__ void partialSM(f32x16& p0, f32x16& p1, float& m_reg, float& mn, float& alpha) {
    float pmax = p0[0];
#pragma unroll
    for (int r = 1; r < 16; ++r) pmax = fmaxf(pmax, p0[r]);
#pragma unroll
    for (int r = 0; r < 16; ++r) pmax = fmaxf(pmax, p1[r]);
    { auto rr = __builtin_amdgcn_permlane32_swap(__float_as_uint(pmax), __float_as_uint(pmax), false, false);
      pmax = fmaxf(__uint_as_float(rr[0]), __uint_as_float(rr[1])); }
    constexpr float C2 = 1.4426950408889634f * SCALE;
    if (__builtin_expect(__all((pmax - m_reg) * SCALE <= THR), 1)) { mn = m_reg; alpha = 1.f; }
    else { mn = fmaxf(m_reg, pmax); alpha = __builtin_amdgcn_exp2f((m_reg - mn) * C2); m_reg = mn; }
    const float mnL = -mn * C2;
#pragma unroll
    for (int r = 0; r < 16; ++r) p0[r] = fmaf(p0[r], C2, mnL);
#pragma unroll
    for (int r = 0; r < 16; ++r) p1[r] = fmaf(p1[r], C2, mnL);
#pragma unroll
    for (int r = 0; r < 16; ++r) p0[r] = __builtin_amdgcn_exp2f(p0[r]);
}
__device__ __forceinline__ void finishSM(f32x16& p0, f32x16& p1, float alpha, float& l_reg, bf16x8& pa0, bf16x8& pa1, bf16x8& pa2, bf16x8& pa3) {
#pragma unroll
    for (int r = 0; r < 16; ++r) p1[r] = __builtin_amdgcn_exp2f(p1[r]);
    float ps = 0;
#pragma unroll
    for (int r = 0; r < 16; ++r) ps += p0[r];
#pragma unroll
    for (int r = 0; r < 16; ++r) ps += p1[r];
    { auto rr = __builtin_amdgcn_permlane32_swap(__float_as_uint(ps), __float_as_uint(ps), false, false);
      ps = __uint_as_float(rr[0]) + __uint_as_float(rr[1]); }
    l_reg = l_reg * alpha + ps;
#define AT_PK4(P, B_, OUT) do { unsigned a0 = cvtpk(P[B_+0], P[B_+1]), a1 = cvtpk(P[B_+2], P[B_+3]);                          \
        unsigned b0 = cvtpk(P[B_+4], P[B_+5]), b1 = cvtpk(P[B_+6], P[B_+7]);                                             \
        auto r0 = __builtin_amdgcn_permlane32_swap(a0, b0, false, false); auto r1 = __builtin_amdgcn_permlane32_swap(a1, b1, false, false); \
        u32x4 w = {r0[0], r1[0], r0[1], r1[1]}; OUT = *reinterpret_cast<bf16x8*>(&w); } while (0)
    AT_PK4(p0, 0, pa0); AT_PK4(p0, 8, pa1); AT_PK4(p1, 0, pa2); AT_PK4(p1, 8, pa3);
#undef AT_PK4
}
__device__ __forceinline__ void qkt(f32x16& p0, f32x16& p1, const LAS unsigned char* Kb, const LAS unsigned char* KRb, int r32, int hi, const bf16x8* qr) {
    p0 = f32x16{}; p1 = f32x16{};
    const LAS unsigned char* kb[4]; const LAS unsigned char* krb[4];
#pragma unroll
    for (int dd = 0; dd < 4; ++dd) { kb[dd] = Kb + AT_KSWZ(r32, (dd * 16 + hi * 8) * 2); krb[dd] = KRb + AT_KRSWZ(r32, (dd * 16 + hi * 8) * 2); }
#pragma unroll
    for (int d0 = 0; d0 < 8; ++d0) { const LAS unsigned char* a = kb[d0 & 3] + (d0 >> 2) * 128;
        const bf16x8 b0 = *reinterpret_cast<const LAS bf16x8*>(a);
        const bf16x8 b1 = *reinterpret_cast<const LAS bf16x8*>(a + 32 * 256);
        p0 = __builtin_amdgcn_mfma_f32_32x32x16_bf16(b0, qr[d0], p0, 0, 0, 0);
        p1 = __builtin_amdgcn_mfma_f32_32x32x16_bf16(b1, qr[d0], p1, 0, 0, 0); }
#pragma unroll
    for (int d0 = 0; d0 < 4; ++d0) { const LAS unsigned char* a = krb[d0];
        const bf16x8 b0 = *reinterpret_cast<const LAS bf16x8*>(a);
        const bf16x8 b1 = *reinterpret_cast<const LAS bf16x8*>(a + 32 * 128);
        p0 = __builtin_amdgcn_mfma_f32_32x32x16_bf16(b0, qr[8 + d0], p0, 0, 0, 0);
        p1 = __builtin_amdgcn_mfma_f32_32x32x16_bf16(b1, qr[8 + d0], p1, 0, 0, 0); }
}
__device__ __forceinline__ void pv_tile(f32x16* o, unsigned vb0, bf16x8 pa0, bf16x8 pa1, bf16x8 pa2, bf16x8 pa3) {
#define AT_TRRD(dst, off) asm volatile("ds_read_b64_tr_b16 %0, %1 offset:%2" : "=&v"(dst) : "v"(vb0), "i"(off) : "memory")
#define AT_PV_D0(d0) do { s16x4 l0, l1, l2, l3, h0, h1, h2, h3; constexpr int b_ = v_rd_off(d0, 0, 0); \
        AT_TRRD(l0, b_); AT_TRRD(h0, b_ + 2048); AT_TRRD(l1, b_ + 4096); AT_TRRD(h1, b_ + 6144); AT_TRRD(l2, b_ + 8192); AT_TRRD(h2, b_ + 10240); AT_TRRD(l3, b_ + 12288); AT_TRRD(h3, b_ + 14336); \
        asm volatile("s_waitcnt lgkmcnt(0)" ::: "memory"); AT_SBAR();   \
        o[d0] = __builtin_amdgcn_mfma_f32_32x32x16_bf16(pa0, (bf16x8){l0[0], l0[1], l0[2], l0[3], h0[0], h0[1], h0[2], h0[3]}, o[d0], 0, 0, 0);   \
        o[d0] = __builtin_amdgcn_mfma_f32_32x32x16_bf16(pa1, (bf16x8){l1[0], l1[1], l1[2], l1[3], h1[0], h1[1], h1[2], h1[3]}, o[d0], 0, 0, 0);   \
        o[d0] = __builtin_amdgcn_mfma_f32_32x32x16_bf16(pa2, (bf16x8){l2[0], l2[1], l2[2], l2[3], h2[0], h2[1], h2[2], h2[3]}, o[d0], 0, 0, 0);   \
        o[d0] = __builtin_amdgcn_mfma_f32_32x32x16_bf16(pa3, (bf16x8){l3[0], l3[1], l3[2], l3[3], h3[0], h3[1], h3[2], h3[3]}, o[d0], 0, 0, 0); } while (0)
    AT_PV_D0(0); AT_PV_D0(1); AT_PV_D0(2); AT_PV_D0(3);
#undef AT_PV_D0
#undef AT_TRRD
}

__device__ __forceinline__ void attn_block(LAS unsigned char* lds, const bf16* Q, const bf16* K, const bf16* KV, const bf16* proj, bf16* YA, int b, int h, int qb) {
    const int tid = otid(), wid = __builtin_amdgcn_readfirstlane(tid >> 6), lane = tid & 63, r32 = lane & 31, hi = lane >> 5;
    const int P0 = qb * 256, NT = 4 * (qb + 1), qlo = P0 + wid * 32;
    LAS unsigned char* V_lds = lds + OFF_V; LAS unsigned char* K_lds = lds + OFF_K; LAS unsigned char* KR_lds = lds + OFF_KR;
    LAS float* wsf = (LAS float*)(lds + OFF_WS) + wid * 64; LAS float* li_l = wsf; LAS float* al_l = wsf + 32;
    bf16x8 qr[12];
    { const bf16* qp = Q + ((size_t)(b * SEQ + qlo + r32) * 8 + h) * 192 + hi * 8;
#pragma unroll
      for (int d0 = 0; d0 < 12; ++d0) qr[d0] = *(const bf16x8*)(qp + d0 * 16); }
    const int sr = tid >> 4, sc = (tid & 15) * 8, kws = AT_KSWZ(sr, sc * 2), vst0 = v_st(sr, sc), vst1 = v_st(32 + sr, sc);
    const int rr = tid >> 3, rc = (tid & 7) * 8, krws = AT_KRSWZ(rr, rc * 2);
    const bf16* Kg = K + ((size_t)(b * SEQ) * 8 + h) * 192;
    const bf16* Vg = KV + (size_t)(b * SEQ) * 2048 + h * 256 + 128;
    bf16x8 st_k0, st_k1, st_kr, st_v0, st_v1;
#define AT_SLOAD(kb_) do { st_k0 = *(const bf16x8*)(Kg + (size_t)((kb_) + sr) * 1536 + sc); st_k1 = *(const bf16x8*)(Kg + (size_t)((kb_) + 32 + sr) * 1536 + sc); \
        st_kr = *(const bf16x8*)(Kg + (size_t)((kb_) + rr) * 1536 + 128 + rc); \
        st_v0 = *(const bf16x8*)(Vg + (size_t)((kb_) + sr) * 2048 + sc); st_v1 = *(const bf16x8*)(Vg + (size_t)((kb_) + 32 + sr) * 2048 + sc); } while (0)
#define AT_SWRITE(bf) do { *(LAS bf16x8*)(K_lds + (bf) * SHM_K + kws) = st_k0; *(LAS bf16x8*)(K_lds + (bf) * SHM_K + kws + 32 * 256) = st_k1; \
        *(LAS bf16x8*)(KR_lds + (bf) * SHM_KR + krws) = st_kr; \
        *(LAS bf16x8*)(V_lds + (bf) * SHM_V + vst0) = st_v0; *(LAS bf16x8*)(V_lds + (bf) * SHM_V + vst1) = st_v1; } while (0)
    AT_SLOAD(0); AT_SWRITE(0);
    __syncthreads();
    float m_reg = -1e30f, l_reg = 0.f; f32x16 o[4] = {};
    const unsigned vbase = (unsigned)(size_t)V_lds + (unsigned)v_rd_base(lane);
    for (int t = 0; t < NT; ++t) {
        const int buf = t & 1, kb = t * 64;
        if (t + 1 < NT) AT_SLOAD(kb + 64);
        if (kb <= qlo + 31) {
            f32x16 p0, p1; float mn, alpha; bf16x8 pa0, pa1, pa2, pa3;
            qkt(p0, p1, K_lds + buf * SHM_K, KR_lds + buf * SHM_KR, r32, hi, qr);
            if (kb + 63 > qlo) mask_tile(p0, p1, qlo + r32 - 4 * hi - kb);
            partialSM(p0, p1, m_reg, mn, alpha);
            finishSM(p0, p1, alpha, l_reg, pa0, pa1, pa2, pa3);
            if (__any(alpha < 1.f)) { if (hi == 0) al_l[r32] = alpha; asm volatile("s_waitcnt lgkmcnt(0)" ::: "memory");
#pragma unroll
                for (int d_ = 0; d_ < 4; ++d_)
#pragma unroll
                    for (int r = 0; r < 16; ++r) o[d_][r] *= al_l[crow(r, hi)];
                asm volatile("s_waitcnt lgkmcnt(0)" ::: "memory"); }
            AT_SBAR();
            pv_tile(o, vbase + buf * SHM_V, pa0, pa1, pa2, pa3);
        }
        if (t + 1 < NT) AT_SWRITE(buf ^ 1);
        __syncthreads();
    }
    if (hi == 0) li_l[r32] = l_reg;
    asm volatile("s_waitcnt lgkmcnt(0)" ::: "memory");
    float rli[16];
#pragma unroll
    for (int r = 0; r < 16; ++r) rli[r] = 1.0f / li_l[crow(r, hi)];
#pragma unroll
    for (int d0 = 0; d0 < 4; ++d0) { const int col = h * 128 + d0 * 32 + r32;
        unsigned short zr[16];
#pragma unroll
        for (int r = 0; r < 16; ++r) zr[r] = proj[(size_t)(b * SEQ + qlo + crow(r, hi)) * NPROJ + C_ZA + col];
#pragma unroll
        for (int r = 0; r < 16; ++r) { const int row = b * SEQ + qlo + crow(r, hi);
            const float v = o[d0][r] * rli[r] * silu_f(bf2f(zr[r]));
            const float vn = lane_xor<1>(v);
            if ((r32 & 1) == 0) *(unsigned*)(YA + (size_t)row * 1024 + col) = cvtpk(v, vn); } }
    asm volatile("s_waitcnt lgkmcnt(0)" ::: "memory");
    __syncthreads();
#undef AT_SLOAD
#undef AT_SWRITE
}
__device__ __forceinline__ void ph_attn(LAS unsigned char* lds, const bf16* Q, const bf16* K, const bf16* KV, const bf16* proj, bf16* YA, int vb, int nvb) {
    const int nitems = NBP * 8 * 8;
    for (int it = vb; it < nitems; it += nvb) {
        const int grp = it >> 6, within = it & 63, pair = within >> 3, bh = grp * 8 + (within & 7), b = bh >> 3, h = bh & 7;
        attn_block(lds, Q, K, KV, proj, YA, b, h, 15 - pair);
        attn_block(lds, Q, K, KV, proj, YA, b, h, pair);
    }
}
}


namespace sg {
using at::bf16x8; using at::f32x16;
__device__ __forceinline__ void sgu_item(LAS unsigned char* lds, const bf16* proj, const float* rv, const float* Ws, const float* bs, const float* vg, bf16* YB, int it) {
    const int tid = otid(), wid = __builtin_amdgcn_readfirstlane(tid >> 6), lane = tid & 63, r32 = lane & 31, hi = lane >> 5;
    {
        const int ch = it >> 2, gp = it & 3, R0 = ch * 128;
#pragma unroll
        for (int i = 0; i < 8; ++i) {
            const int idx = tid + 512 * i, gsel = idx >> 11, row = (idx >> 4) & 127, cc = idx & 15;
            const v4u w = *(const v4u*)(proj + (size_t)(R0 + row) * NPROJ + C_VB + (2 * gp + gsel) * 128 + cc * 8);
            const float s = rv[R0 + row];
            v4u o; o.x = pk2(gelu_f(lo16(w.x)) * s, gelu_f(hi16(w.x)) * s); o.y = pk2(gelu_f(lo16(w.y)) * s, gelu_f(hi16(w.y)) * s);
            o.z = pk2(gelu_f(lo16(w.z)) * s, gelu_f(hi16(w.z)) * s); o.w = pk2(gelu_f(lo16(w.w)) * s, gelu_f(hi16(w.w)) * s);
            *(LAS v4u*)(lds + (gsel * 2 + (row >> 6)) * 16384 + at::v_st(row & 63, cc * 8)) = o;
        }
        __syncthreads();
        const int gsel = wid >> 2, g = 2 * gp + gsel, t = 32 * (wid & 3) + r32;
        f32x16 o[4] = {};
        const int nst = (wid & 3) >= 2 ? 2 : 1;
        for (int st = 0; st < nst; ++st) {
            bf16x8 pa[4];
#pragma unroll
            for (int ks = 0; ks < 4; ++ks) {
                const int s0 = st * 64 + ks * 16 + hi * 8;
                const float* wp = Ws + ((size_t)g * 128 + t) * 128 + s0;
                const v4f a = *(const v4f*)wp, b = *(const v4f*)(wp + 4);
                float x[8] = {a.x, a.y, a.z, a.w, b.x, b.y, b.z, b.w};
#pragma unroll
                for (int j = 0; j < 8; ++j) if (s0 + j > t) x[j] = 0.f;
                at::u32x4 w4 = {at::cvtpk(x[0], x[1]), at::cvtpk(x[2], x[3]), at::cvtpk(x[4], x[5]), at::cvtpk(x[6], x[7])};
                pa[ks] = *reinterpret_cast<bf16x8*>(&w4);
            }
            const unsigned vbase = (unsigned)(size_t)(lds + (gsel * 2 + st) * 16384) + (unsigned)at::v_rd_base(lane);
            at::pv_tile(o, vbase, pa[0], pa[1], pa[2], pa[3]);
        }
#pragma unroll
        for (int d0 = 0; d0 < 4; ++d0) { const int gc = g * 128 + d0 * 32 + r32; const float vgc = vg[gc];
            unsigned short ur[16], zr[16];
#pragma unroll
            for (int r = 0; r < 16; ++r) { const size_t row = (size_t)(R0 + 32 * (wid & 3) + at::crow(r, hi)); ur[r] = proj[row * NPROJ + C_UB + gc]; zr[r] = proj[row * NPROJ + C_ZB + gc]; }
#pragma unroll
            for (int r = 0; r < 16; ++r) { const int tl = 32 * (wid & 3) + at::crow(r, hi); const size_t row = (size_t)(R0 + tl);
                const float mix = o[d0][r] * vgc + bs[g * 128 + tl];
                const float y = gelu_f(bf2f(ur[r])) * mix * silu_f(bf2f(zr[r])), yn = lane_xor<1>(y);
                if ((r32 & 1) == 0) *(unsigned*)(YB + row * 1024 + gc) = at::cvtpk(y, yn); } }
        __syncthreads();
    }
}
}


namespace gl {
using at::bf16x8; using at::f32x16; using at::s16x4; using at::u32x4;
constexpr int OFF_VIMG = 0, OFF_KLIMG = 65536, OFF_ATT = 98304, OFF_DS = 131072, OFF_PART = 131584, LDS_NEED = OFF_PART + 4096;

__device__ __forceinline__ void ph_gla_prep(LAS unsigned char* lds, const bf16* proj, const float* wa2, const float* ba, bf16* QE, bf16* KE, bf16* KL, float* DS, int vb, int nvb) {
    const int tid = otid(), k = tid & 127, tq = tid >> 7;
    LAS float* seg = (LAS float*)lds;
    const int nitems = (MP / 128) * 4;
    for (int it = vb; it < nitems; it += nvb) {
        const int ch = it >> 2, h = it & 3, R0 = ch * 128 + tq * 32;
        float wa[16];
#pragma unroll
        for (int j = 0; j < 16; ++j) wa[j] = wa2[j * 512 + h * 128 + k];
        const float bak = ba[h * 128 + k];
        float la[32]; float run = 0.f;
#pragma unroll
        for (int i = 0; i < 32; ++i) {
            const bf16* pr = proj + (size_t)(R0 + i) * NPROJ + C_AR;
            const v4u w0 = *(const v4u*)pr, w1 = *(const v4u*)(pr + 8);
            const float ar[16] = {lo16(w0.x), hi16(w0.x), lo16(w0.y), hi16(w0.y), lo16(w0.z), hi16(w0.z), lo16(w0.w), hi16(w0.w),
                                  lo16(w1.x), hi16(w1.x), lo16(w1.y), hi16(w1.y), lo16(w1.z), hi16(w1.z), lo16(w1.w), hi16(w1.w)};
            float x = bak;
#pragma unroll
            for (int j = 0; j < 16; ++j) x += ar[j] * wa[j];
            const float ls = fminf(x, 0.f) - log1pf(__expf(-fabsf(x)));
            run += ls * 0.0625f; la[i] = run;
        }
        seg[tq * 128 + k] = run;
        __syncthreads();
        float pre = 0.f, total = 0.f;
#pragma unroll
        for (int q = 0; q < 4; ++q) { const float sgm = seg[q * 128 + k]; total += sgm; if (q < tq) pre += sgm; }
#pragma unroll
        for (int i = 0; i < 32; ++i) {
            const float b = la[i] + pre; const size_t row = (size_t)(R0 + i);
            const float qv = bf2f(proj[row * NPROJ + C_QC + h * 128 + k]) * 0.08838834764831845f, kv = bf2f(proj[row * NPROJ + C_KC + h * 128 + k]);
            QE[row * 512 + h * 128 + k] = (bf16)f2bf(qv * __expf(b));
            KE[row * 512 + h * 128 + k] = (bf16)f2bf(kv * __expf(-b));
            KL[row * 512 + h * 128 + k] = (bf16)f2bf(kv * __expf(total - b));
        }
        if (tq == 0) DS[((size_t)ch * 4 + h) * 128 + k] = __expf(total);
        __syncthreads();
    }
}

#define GL_PK4(P, B_, OUT) do { unsigned a0 = at::cvtpk(P[B_+0], P[B_+1]), a1 = at::cvtpk(P[B_+2], P[B_+3]);                          \
        unsigned b0 = at::cvtpk(P[B_+4], P[B_+5]), b1 = at::cvtpk(P[B_+6], P[B_+7]);                                             \
        auto r0 = __builtin_amdgcn_permlane32_swap(a0, b0, false, false); auto r1 = __builtin_amdgcn_permlane32_swap(a1, b1, false, false); \
        u32x4 w = {r0[0], r1[0], r0[1], r1[1]}; OUT = *reinterpret_cast<bf16x8*>(&w); } while (0)
#define GL_TRRD(dst, addr, off) asm volatile("ds_read_b64_tr_b16 %0, %1 offset:%2" : "=&v"(dst) : "v"(addr), "i"(off) : "memory")

__device__ __forceinline__ void gla_chunk_item(LAS unsigned char* lds, const bf16* proj, const bf16* QE, const bf16* KE, const bf16* KL, float* OI, float* DL, int ci) {
    const int tid = otid(), wid = __builtin_amdgcn_readfirstlane(tid >> 6), lane = tid & 63, r32 = lane & 31, hi = lane >> 5;
    const int h = ci & 3, R0 = (ci >> 2) * 128;
    {
        {
#pragma unroll
            for (int i = 0; i < 8; ++i) { const int idx = tid + 512 * i, s = idx >> 5, cc = idx & 31;
                const v4u w = *(const v4u*)(proj + (size_t)(R0 + s) * NPROJ + C_VC + h * 256 + cc * 8);
                *(LAS v4u*)(lds + OFF_VIMG + ((s >> 6) * 2 + (cc >> 4)) * 16384 + at::v_st(s & 63, (cc & 15) * 8)) = w; }
#pragma unroll
            for (int i = 0; i < 4; ++i) { const int idx = tid + 512 * i, s = idx >> 4, cc = idx & 15;
                const v4u w = *(const v4u*)(KL + (size_t)(R0 + s) * 512 + h * 128 + cc * 8);
                *(LAS v4u*)(lds + OFF_KLIMG + (s >> 6) * 16384 + at::v_st(s & 63, cc * 8)) = w; }
#pragma unroll
            for (int j = 0; j < 2; ++j) {
                const int ti = 2 * wid + j, st = ti >> 2, tt = ti & 3;
                if (st <= tt) {
                    f32x16 p = {};
                    const bf16* ap = KE + (size_t)(R0 + 32 * st + r32) * 512 + h * 128 + hi * 8;
                    const bf16* bp = QE + (size_t)(R0 + 32 * tt + r32) * 512 + h * 128 + hi * 8;
#pragma unroll
                    for (int ks = 0; ks < 8; ++ks) p = __builtin_amdgcn_mfma_f32_32x32x16_bf16(*(const bf16x8*)(ap + ks * 16), *(const bf16x8*)(bp + ks * 16), p, 0, 0, 0);
                    if (st == tt) {
#pragma unroll
                        for (int r = 0; r < 16; ++r) if (at::crow(r, hi) > r32) p[r] = 0.f; }
                    const int t = 32 * tt + r32;
#pragma unroll
                    for (int g = 0; g < 4; ++g) { v2u w; w.x = at::cvtpk(p[4 * g], p[4 * g + 1]); w.y = at::cvtpk(p[4 * g + 2], p[4 * g + 3]);
                        *(LAS v2u*)(lds + OFF_ATT + t * 256 + ((64 * st + 16 * g) ^ ((t & 7) << 4)) + 8 * hi) = w; }
                }
            }
            __syncthreads();
            bf16x8 vfr[8];
            { const unsigned vaddr = (unsigned)(size_t)(lds + OFF_VIMG + (wid >> 2) * 16384) + (unsigned)at::v_rd_base(lane) + (unsigned)((wid & 3) * 512);
              s16x4 vl[8], vh[8];
#define GL_VF(ks8) do { constexpr int o_ = ((ks8) >> 2) * 32768 + ((ks8) & 3) * 4096; GL_TRRD(vl[ks8], vaddr, o_); GL_TRRD(vh[ks8], vaddr, o_ + 2048); } while (0)
              GL_VF(0); GL_VF(1); GL_VF(2); GL_VF(3); GL_VF(4); GL_VF(5); GL_VF(6); GL_VF(7);
#undef GL_VF
              asm volatile("s_waitcnt lgkmcnt(0)" ::: "memory"); AT_SBAR();
#pragma unroll
              for (int q = 0; q < 8; ++q) vfr[q] = (bf16x8){vl[q][0], vl[q][1], vl[q][2], vl[q][3], vh[q][0], vh[q][1], vh[q][2], vh[q][3]};
              AT_SBAR(); }
            float* oi = OI + (((size_t)ci * 8 + wid) * 16 * 64 + lane) * 4;
            float* dl = DL + (((size_t)ci * 8 + wid) * 16 * 64 + lane) * 4;
#pragma unroll
            for (int tt = 0; tt < 4; ++tt) {
                f32x16 acc = {};
                const int t = 32 * tt + r32;
#pragma unroll
                for (int ks8 = 0; ks8 < 8; ++ks8) if (ks8 <= 2 * tt + 1) {
                    const bf16x8 a = *(const LAS bf16x8*)(lds + OFF_ATT + t * 256 + (((16 * ks8 + 8 * hi) * 2) ^ ((t & 7) << 4)));
                    acc = __builtin_amdgcn_mfma_f32_32x32x16_bf16(a, vfr[ks8], acc, 0, 0, 0); }
#pragma unroll
                for (int r4 = 0; r4 < 4; ++r4) *(v4f*)(oi + (size_t)(tt * 4 + r4) * 256) = (v4f){acc[4 * r4], acc[4 * r4 + 1], acc[4 * r4 + 2], acc[4 * r4 + 3]};
            }
#pragma unroll
            for (int kt = 0; kt < 4; ++kt) {
                f32x16 D = {};
                const unsigned kaddr = (unsigned)(size_t)(lds + OFF_KLIMG) + (unsigned)at::v_rd_base(lane) + (unsigned)(kt * 512);
#define GL_KF(ks8) do { s16x4 l_, h_; constexpr int o_ = ((ks8) >> 2) * 16384 + ((ks8) & 3) * 4096; GL_TRRD(l_, kaddr, o_); GL_TRRD(h_, kaddr, o_ + 2048); \
                asm volatile("s_waitcnt lgkmcnt(0)" ::: "memory"); AT_SBAR(); \
                D = __builtin_amdgcn_mfma_f32_32x32x16_bf16((bf16x8){l_[0], l_[1], l_[2], l_[3], h_[0], h_[1], h_[2], h_[3]}, vfr[ks8], D, 0, 0, 0); } while (0)
                GL_KF(0); GL_KF(1); GL_KF(2); GL_KF(3); GL_KF(4); GL_KF(5); GL_KF(6); GL_KF(7);
#undef GL_KF
#pragma unroll
                for (int r4 = 0; r4 < 4; ++r4) *(v4f*)(dl + (size_t)(kt * 4 + r4) * 256) = (v4f){D[4 * r4], D[4 * r4 + 1], D[4 * r4 + 2], D[4 * r4 + 3]};
            }
            __syncthreads();
        }
    }
}

__device__ __forceinline__ void gla_stageA_item(const float* DS, const float* DL, bf16* XB, int b, int h, int vp) {
    const int tid = otid(), wid = __builtin_amdgcn_readfirstlane(tid >> 6), lane = tid & 63, hi = lane >> 5;
    const int vb = 2 * vp + (wid >> 2), kt = wid & 3;
    constexpr int PF = 4, NC = SEQ / 128;
    f32x16 X = {};
    v4f dq[PF][4], sq[PF][4];
    const size_t ci0 = (size_t)(b * 32) * 4 + h;
#define GL_ALOAD(slot, c_) do { const size_t ci_ = ci0 + (size_t)(c_) * 4; const float* dl_ = DL + ((ci_ * 8 + vb) * 16 * 64 + lane) * 4 + (size_t)(kt * 4) * 256; const float* ds_ = DS + ci_ * 128 + 32 * kt + 4 * hi; \
        _Pragma("unroll") for (int r4 = 0; r4 < 4; ++r4) { dq[slot][r4] = *(const v4f*)(dl_ + (size_t)r4 * 256); sq[slot][r4] = *(const v4f*)(ds_ + 8 * r4); } } while (0)
#pragma unroll
    for (int s = 0; s < PF; ++s) GL_ALOAD(s, s);
    for (int c0 = 0; c0 < NC; c0 += PF) {
#pragma unroll
        for (int s = 0; s < PF; ++s) {
            const int c = c0 + s; const size_t ci = ci0 + (size_t)c * 4;
            bf16* xo = XB + (((ci * 8 + vb) * 8 + kt * 2) * 64 + lane) * 8;
            bf16x8 xb0, xb1; GL_PK4(X, 0, xb0); GL_PK4(X, 8, xb1);
            *(bf16x8*)xo = xb0; *(bf16x8*)(xo + 512) = xb1;
#pragma unroll
            for (int r4 = 0; r4 < 4; ++r4) { const v4f w = dq[s][r4], d4 = sq[s][r4];
                X[4 * r4] = X[4 * r4] * d4.x + w.x; X[4 * r4 + 1] = X[4 * r4 + 1] * d4.y + w.y; X[4 * r4 + 2] = X[4 * r4 + 2] * d4.z + w.z; X[4 * r4 + 3] = X[4 * r4 + 3] * d4.w + w.w; }
            if (c + PF < NC) GL_ALOAD(s, c + PF);
        }
    }
#undef GL_ALOAD
}
__device__ __forceinline__ void gla_stageB_item(const bf16* proj, const bf16* QE, const float* OI, const bf16* XB, const float* og, bf16* YC, int b, int h, int cp) {
    const int tid = otid(), wid = __builtin_amdgcn_readfirstlane(tid >> 6), lane = tid & 63, r32 = lane & 31, hi = lane >> 5;
    {
        const int c = 2 * cp + (wid >> 2), tt = wid & 3, R0 = b * SEQ + c * 128;
        const size_t ci = (size_t)(b * 32 + c) * 4 + h;
        f32x16 acc[8];
#pragma unroll
        for (int vb = 0; vb < 8; ++vb) { const float* oi = OI + ((ci * 8 + vb) * 16 * 64 + lane) * 4 + (size_t)(tt * 4) * 256;
#pragma unroll
            for (int r4 = 0; r4 < 4; ++r4) { const v4f w = *(const v4f*)(oi + (size_t)r4 * 256); acc[vb][4 * r4] = w.x; acc[vb][4 * r4 + 1] = w.y; acc[vb][4 * r4 + 2] = w.z; acc[vb][4 * r4 + 3] = w.w; } }
        bf16x8 qa[8];
        { const bf16* qp = QE + (size_t)(R0 + 32 * tt + r32) * 512 + h * 128 + hi * 8;
#pragma unroll
          for (int ks = 0; ks < 8; ++ks) qa[ks] = *(const bf16x8*)(qp + ks * 16); }
        if (c > 0) {
#pragma unroll
            for (int vb = 0; vb < 8; ++vb) { const bf16* xi = XB + (((ci * 8 + vb) * 8) * 64 + lane) * 8;
#pragma unroll
                for (int ks = 0; ks < 8; ++ks) acc[vb] = __builtin_amdgcn_mfma_f32_32x32x16_bf16(qa[ks], *(const bf16x8*)(xi + (size_t)ks * 512), acc[vb], 0, 0, 0); }
        }
        float rn[16];
#pragma unroll
        for (int r = 0; r < 16; ++r) { float s = 0.f;
#pragma unroll
            for (int vb = 0; vb < 8; ++vb) s += acc[vb][r] * acc[vb][r];
            s += lane_xor<1>(s); s += lane_xor<2>(s); s += lane_xor<4>(s); s += lane_xor<8>(s); s += lane_xor<16>(s);
            rn[r] = 1.0f / sqrtf(s * (1.0f / 256.f) + EPS); }
#pragma unroll
        for (int vb = 0; vb < 8; ++vb) { const float gcol = og[32 * vb + r32];
            unsigned short zr[16];
#pragma unroll
            for (int r = 0; r < 16; ++r) zr[r] = proj[(size_t)(R0 + 32 * tt + at::crow(r, hi)) * NPROJ + C_ZC + h * 256 + 32 * vb + r32];
#pragma unroll
            for (int r = 0; r < 16; ++r) { const size_t row = (size_t)(R0 + 32 * tt + at::crow(r, hi));
                const float y = acc[vb][r] * rn[r] * gcol * silu_f(bf2f(zr[r])), yn = lane_xor<1>(y);
                if ((r32 & 1) == 0) *(unsigned*)(YC + row * 1024 + h * 256 + 32 * vb + r32) = at::cvtpk(y, yn); } }
    }
}
#undef GL_PK4
#undef GL_TRRD
}


constexpr int CW_Q = 65536;
__device__ __forceinline__ int q_pop(unsigned* ctr, LAS unsigned* slot) {
    if (otid() == 0) *slot = __hip_atomic_fetch_add(ctr, 1u, __ATOMIC_RELAXED, __HIP_MEMORY_SCOPE_AGENT);
    __syncthreads(); const int v = (int)*slot; __syncthreads(); return v; }
__device__ __forceinline__ void ph_mixers(LAS unsigned char* lds, unsigned char* ws, unsigned* qctr, const float* Ws, const float* bs, const float* vg, const float* og, int vb) {
    constexpr int NGLA = NBP * 8, NATT = 16 * NBP, NSGU = 16 * NBP, NQ = NGLA + NATT + NSGU;
    static_assert(NBP % 2 == 0, "NBP even");
    LAS unsigned* slot = (LAS unsigned*)(lds + LDSCTL_OFF + 64);
    bf16* proj = (bf16*)(ws + WS_PROJ);
    for (int dq = 0; dq < 8; ++dq) {
        const int q = (vb + dq) & 7;
        for (;;) {
            const int idx = q_pop(qctr + q * 64, slot);
            if (idx >= NQ) break;
            if (idx >= NATT && idx < NATT + NGLA) { const int gi = q * NGLA + (idx - NATT), bh = gi >> 4, cp = gi & 15;
                gl::gla_stageB_item(proj, (const bf16*)(ws + WS_QE), (const float*)(ws + WS_OC), (const bf16*)(ws + WS_XB), og, (bf16*)(ws + WS_YC), bh >> 2, bh & 3, cp); }
            else if (idx < NATT) { const int j = idx, qb = 15 - j / NBP, bh = q * NBP + j % NBP;
                at::attn_block(lds, (const bf16*)(ws + WS_Q), (const bf16*)(ws + WS_K), (const bf16*)(ws + WS_KV), proj, (bf16*)(ws + WS_YA), bh >> 3, bh & 7, qb); }
            else { const int it = q * NSGU + (idx - NGLA - NATT);
                sg::sgu_item(lds, proj, (const float*)(ws + WS_RV), Ws, bs, vg, (bf16*)(ws + WS_YB), it); }
        }
    }
}
typedef const __attribute__((address_space(4))) Args* KArgP;
#define KARG() ({ KArgP p_ = (KArgP)__builtin_amdgcn_kernarg_segment_ptr(); asm volatile("" : "+s"(p_)); p_; })
#define INF(i) ((const float*)ap->in[i])
__device__ __forceinline__ void grid_bar(const XcdBarrier& b0) { XcdBarrier b = b0; asm volatile("" : "+s"(b.bar)); xcd_barrier(b); }

__global__ void __launch_bounds__(512, 2) fwd(Args a) {
    extern __shared__ __attribute__((aligned(16))) unsigned char lds_raw[];
    LAS unsigned char* lds = (LAS unsigned char*)lds_raw;
    const int lo = a.lo, hi = a.hi;
    XcdBarrier bar; bar.bar = (unsigned*)(a.ws + WS_CTL) + CW_BAR; bar.x = 0; bar.st = nullptr;
    if (hi - lo > 1) {
        if (threadIdx.x < 4) ((LAS unsigned*)(lds + LDSCTL_OFF))[threadIdx.x] = 0u;
        __syncthreads();
        bar = xcd_barrier_post((unsigned*)(a.ws + WS_CTL) + CW_BAR, (volatile LAS unsigned*)(lds + LDSCTL_OFF));
    }
    int step = 0;
#define PH_BEGIN if (step >= lo && step < hi) { const KArgP ap = KARG(); unsigned char* const ws = ap->ws; const int vb = obid(), nvb = gridDim.x; (void)ws; (void)vb; (void)nvb;
#define PH_END   if (step + 1 < hi) grid_bar(bar); } ++step;
#define WL(l) (ws + WS_W + (size_t)(l) * SZ_WLAYER)
#define B_(T, off) ((T*)(ws + (off)))

    PH_BEGIN
        for (int l = 0; l < DEPTH; ++l) {
            unsigned char* wl = WL(l);
            convert_T<1>(INF(3) + (size_t)l * DM * IN_COLS, DM, IN_COLS, (bf16*)wl, NPROJ, (LAS float*)lds, vb, nvb);
            convert_T<0>(INF(6) + (size_t)l * 512 * 1536, 512, 1536, (bf16*)(wl + SZ_WIN), 1536, (LAS float*)lds, (vb + 64) % nvb, nvb);
            convert_T<0>(INF(7) + (size_t)l * 512 * 2048, 512, 2048, (bf16*)(wl + SZ_WIN + SZ_WUQ), 2048, (LAS float*)lds, (vb + 128) % nvb, nvb);
            for (int b = 0; b < 3; ++b)
                convert_T<0>(INF(16) + ((size_t)l * 3 + b) * 1024 * 2048, 1024, 2048, (bf16*)(wl + SZ_WIN + SZ_WUQ + SZ_WUKV) + (size_t)b * 2048 * 1024, 2048, (LAS float*)lds, (vb + 32 * b) % nvb, nvb);
            convert_T<0>(INF(17) + (size_t)l * 2048 * 2048, 2048, 2048, (bf16*)(wl + SZ_WIN + SZ_WUQ + SZ_WUKV + SZ_WB), 2048, (LAS float*)lds, (vb + 192) % nvb, nvb);
        }
        { const int* positions = (const int*)ap->in[1]; float* cosT = B_(float, WS_COS); float* sinT = B_(float, WS_SIN);
          for (int idx = vb * 512 + otid(); idx < MTOK * 32; idx += nvb * 512) {
            const int t = idx >> 5, i = idx & 31;
            const float inv = 1.0f / powf(10000.0f, (float)(2 * i) * (1.0f / 64.0f));
            const float ang = (float)positions[t] * inv;
            float sn, cs; sincosf(ang, &sn, &cs);
            cosT[idx] = cs; sinT[idx] = sn; } }
    PH_END

    for (int l = 0; l < DEPTH; ++l) {
        for (int p = 0; p < NPASS; ++p) {
            const int row0 = p * MP;
#define XIN ((l == 0 ? (const float*)ap->in[0] : (const float*)ap->out) + (size_t)row0 * DM)
            PH_BEGIN ph_norm(XIN, INF(2) + l * DM, B_(bf16, WS_H), MP, vb, nvb); PH_END
            PH_BEGIN { pg8::Gemm g{B_(bf16, WS_H), (const bf16*)WL(l), MP, NPROJ, DM}; pg8::StaticOrder S; S.init(MP, NPROJ, nvb, vb); pg8::EpiBf16<0> E{B_(bf16, WS_PROJ), NPROJ, nullptr, 0, 0};
                       pg8::gemm_phase<pg8::EpiBf16<0>, pg8::StaticOrder>(lds, g, S, E, nullptr); } PH_END
            PH_BEGIN ph_prep(B_(bf16, WS_PROJ), INF(4) + l * 512, INF(5) + l * 512, B_(bf16, WS_CQN), B_(bf16, WS_CKVN), B_(float, WS_RV), vb, nvb);
                     gl::ph_gla_prep(lds, B_(bf16, WS_PROJ), INF(13) + l * 16 * 512, INF(14) + l * 512, B_(bf16, WS_QE), B_(bf16, WS_KE), B_(bf16, WS_KL), B_(float, WS_DS), vb, nvb); PH_END
            PH_BEGIN { { pg8::Gemm g{B_(bf16, WS_CQN), (const bf16*)(WL(l) + SZ_WIN), MP, 1536, 512}; pg8::StaticOrder S; S.init(MP, 1536, nvb, vb); pg8::EpiBf16<0> E{B_(bf16, WS_Q), 1536, nullptr, 0, 0};
                         pg8::gemm_phase<pg8::EpiBf16<0>, pg8::StaticOrder>(lds, g, S, E, nullptr); }
                       { pg8::Gemm g{B_(bf16, WS_CKVN), (const bf16*)(WL(l) + SZ_WIN + SZ_WUQ), MP, 2048, 512}; pg8::StaticOrder S; S.init(MP, 2048, nvb, vb); pg8::EpiBf16<0> E{B_(bf16, WS_KV), 2048, nullptr, 0, 0};
                         pg8::gemm_phase<pg8::EpiBf16<0>, pg8::StaticOrder>(lds, g, S, E, nullptr); }
                       for (int ci = nvb - 1 - vb; ci < (MP / 128) * 4; ci += nvb) gl::gla_chunk_item(lds, B_(bf16, WS_PROJ), B_(bf16, WS_QE), B_(bf16, WS_KE), B_(bf16, WS_KL), B_(float, WS_OC), B_(float, WS_DL), ci); } PH_END
            PH_BEGIN ph_qkfin(B_(bf16, WS_Q), B_(bf16, WS_KV), B_(bf16, WS_PROJ), B_(bf16, WS_K), INF(8) + l * 192, INF(9) + l * 192, B_(float, WS_COS), B_(float, WS_SIN), row0, vb, nvb);
                     for (int it = vb; it < NBP * 4 * 4; it += nvb) gl::gla_stageA_item(B_(float, WS_DS), B_(float, WS_DL), B_(bf16, WS_XB), it >> 4, (it >> 2) & 3, it & 3); PH_END
            PH_BEGIN ph_mixers(lds, ws, (unsigned*)(ws + WS_CTL) + CW_Q + (l * NPASS + p) * 8 * 64, INF(11) + (size_t)l * 8 * 128 * 128, INF(12) + l * 8 * 128, INF(10) + l * 1024, INF(15) + l * 256, vb); PH_END
            PH_BEGIN for (int b = 0; b < 3; ++b) { pg8::Gemm g{B_(bf16, WS_YA) + (size_t)b * MP * 1024, (const bf16*)(WL(l) + SZ_WIN + SZ_WUQ + SZ_WUKV) + (size_t)b * 2048 * 1024, MP, 2048, 1024};
                       pg8::StaticOrder S; S.init(MP, 2048, nvb, (vb + 85 * b) % nvb);
                       pg8::EpiBf16<0> E{B_(bf16, WS_PB) + (size_t)b * MP * 2048, 2048, nullptr, 0, 0}; pg8::gemm_phase<pg8::EpiBf16<0>, pg8::StaticOrder>(lds, g, S, E, nullptr); } PH_END
            PH_BEGIN ph_merge(B_(bf16, WS_PROJ), B_(bf16, WS_PB), B_(bf16, WS_MG), vb, nvb); PH_END
            PH_BEGIN { pg8::Gemm g{B_(bf16, WS_MG), (const bf16*)(WL(l) + SZ_WIN + SZ_WUQ + SZ_WUKV + SZ_WB), MP, 2048, 2048}; pg8::StaticOrder S; S.init(MP, 2048, nvb, vb); pg8::EpiF32 E{B_(float, WS_U), 2048, nullptr};
                       pg8::gemm_phase<pg8::EpiF32, pg8::StaticOrder>(lds, g, S, E, nullptr); } PH_END
            PH_BEGIN ph_outadd(XIN, B_(float, WS_U), ap->out + (size_t)row0 * DM, vb, nvb); PH_END
        }
    }
#undef PH_BEGIN
#undef PH_END
}

#ifndef ONE_LAUNCH
#define ONE_LAUNCH 1
#endif
extern "C" void kernel_launch(void* const* d_in, const int* in_sizes, int n_in, void* d_out, int out_size, void* d_ws, size_t ws_size, hipStream_t stream) {
    static int grid = 0;
    if (grid == 0) {
        if (n_in != 18 || out_size != MTOK * DM || ws_size < WS_END) { fprintf(stderr, "kernel_launch: unexpected shapes (n_in %d out %d ws %zu need %zu)\n", n_in, out_size, ws_size, (size_t)WS_END); grid = -1; return; }
        int dev = 0, cus = 0, per_cu = 0;
        if (hipGetDevice(&dev) != hipSuccess || hipDeviceGetAttribute(&cus, hipDeviceAttributeMultiprocessorCount, dev) != hipSuccess) { grid = -1; return; }
        if (hipFuncSetAttribute((const void*)fwd, hipFuncAttributeMaxDynamicSharedMemorySize, LDS_BYTES) != hipSuccess) { fprintf(stderr, "kernel_launch: hipFuncSetAttribute failed\n"); grid = -1; return; }
        if (hipOccupancyMaxActiveBlocksPerMultiprocessor(&per_cu, (const void*)fwd, 512, LDS_BYTES) != hipSuccess || per_cu < 1) { fprintf(stderr, "kernel_launch: occupancy query says %d\n", per_cu); }
        (void)hipGetLastError();
        grid = cus;
    }
    if (grid < 0) return;
    (void)hipMemsetAsync((char*)d_ws + WS_CTL, 0, CTL_BYTES, stream);
    Args a{};
    for (int i = 0; i < 18; ++i) a.in[i] = d_in[i];
    a.out = (float*)d_out; a.ws = (unsigned char*)d_ws; a.pad0 = 0; a.pad1 = 0;
#if ONE_LAUNCH
    a.lo = 0; a.hi = NSTEPS;
    hipLaunchKernelGGL(fwd, dim3(grid), dim3(512), LDS_BYTES, stream, a);
#else
    for (int s = 0; s < NSTEPS; ++s) { a.lo = s; a.hi = s + 1; hipLaunchKernelGGL(fwd, dim3(grid), dim3(512), LDS_BYTES, stream, a); }
#endif
}
```

```cpp
#include <hip/hip_runtime.h>
#include <cstdio>
#include <cstdint>
__device__ __forceinline__ int otid() { int t = threadIdx.x; asm volatile("" : "+v"(t)); return t; }
__device__ __forceinline__ int obid() { int t = blockIdx.x; asm volatile("" : "+s"(t)); return t; }
namespace pg8 {
#define PG8_LAS __attribute__((address_space(3)))
typedef unsigned short bf16_t;
typedef short bf16x8 __attribute__((ext_vector_type(8)));
typedef float f32x4 __attribute__((ext_vector_type(4)));
typedef unsigned u32x4 __attribute__((ext_vector_type(4)));
constexpr int BM = 256, BK = 64, HALF = 128, HTB = HALF * BK * 2  , STAGE_BYTES = 8 * HTB, NXCD = 8, WGM = 8;

__host__ __device__ __forceinline__ int lds_byte(int r, int c) { const int st = (r >> 4) * 2 + (c >> 5), rr = r & 15, cc = c & 31, ob = rr * 64 + cc * 2; return st * 1024 + (ob ^ (((ob >> 9) & 1) << 5)); }
__host__ __device__ __forceinline__ void stage_rc(int b, int& R, int& C) { const int st = b / 1024, sb = b % 1024, swz = sb ^ (((sb >> 9) & 1) << 5); R = (st >> 1) * 16 + swz / 64; C = (st & 1) * 32 + (swz % 64) / 2; }
__host__ __device__ __forceinline__ int perm32(int rho) { const int n = rho >> 4, i = rho & 15; return 8 * (i >> 2) + 4 * n + (i & 3); }

struct Unit { int pm, pn; };
struct Gemm { const bf16_t* A; const bf16_t* Bt; int M, N, K; };

struct StaticOrder {
    int nM, nN, nwg, G, c;
    __host__ __device__ void init(int M, int N, int G_, int c_) { nM = M / BM; nN = N / BM; nwg = nM * nN; G = G_; c = c_; }
    __host__ __device__ bool next(int i, Unit& u) const {
        const long L = (long)i * G + c; if (L >= nwg) return false;
        int wgid = (int)L; { const int q = nwg / NXCD, r = nwg % NXCD, xcd = wgid % NXCD, off = wgid / NXCD; wgid = (xcd < r ? xcd * (q + 1) : r * (q + 1) + (xcd - r) * q) + off; }
        const int nig = WGM * nN, gid = wgid / nig, fm = gid * WGM, gsz = (nM - fm) < WGM ? (nM - fm) : WGM;
        u.pm = fm + ((wgid % nig) % gsz); u.pn = (wgid % nig) / gsz; return true;
    }
    __device__ __forceinline__ void a_ready(const Unit&) const {}
    __device__ __forceinline__ void done(const Unit&) const {}
};

__device__ __forceinline__ unsigned cvt_pk_bf16(float lo, float hi) { unsigned r; asm volatile("v_cvt_pk_bf16_f32 %0, %1, %2" : "=v"(r) : "v"(lo), "v"(hi)); return r; }
typedef float f32x2 __attribute__((ext_vector_type(2)));
__device__ __forceinline__ f32x2 gelu_pk(f32x2 v) {
    const f32x2 av = __builtin_elementwise_abs(v), d = av * 0.2316418882f + 1.0f;
    f32x2 t; t.x = __builtin_amdgcn_rcpf(d.x); t.y = __builtin_amdgcn_rcpf(d.y);
    f32x2 q = t * 0.5307027145f + (-0.7265760135f); q = q * t + 0.7107068705f; q = q * t + (-0.142248368f); q = q * t + 0.127414796f; q = q * t;
    const f32x2 s = (v * v) * (-0.72134752044f);
    f32x2 e; e.x = __builtin_amdgcn_exp2f(s.x); e.y = __builtin_amdgcn_exp2f(s.y);
    const f32x2 m = v * (q * e), r = v - m;
    f32x2 o; o.x = v.x < 0.f ? m.x : r.x; o.y = v.y < 0.f ? m.y : r.y; return o;
}

struct EpiF32 {
    static constexpr bool PERM = false, AFTER_DRAIN = false;
    float* C; int ldc; const float* bias;
    __device__ __forceinline__ void operator()(const f32x4 (&acc)[2][2][4][2], const Unit& u, int wr, int wc, int fr, int fq) const {
        const int row0 = u.pm * BM + wr * 64 + fr, col0 = u.pn * BM + wc * 32 + 4 * fq;
        f32x4 bv[2][2];
#pragma unroll
        for (int bj = 0; bj < 2; ++bj)
#pragma unroll
            for (int n = 0; n < 2; ++n) bv[bj][n] = bias ? *(const f32x4*)(bias + col0 + bj * HALF + n * 16) : (f32x4){0.f, 0.f, 0.f, 0.f};
#pragma unroll
        for (int ai = 0; ai < 2; ++ai)
#pragma unroll
            for (int m = 0; m < 4; ++m) { float* rowp = C + (size_t)(row0 + ai * HALF + m * 16) * ldc + col0;
#pragma unroll
                for (int bj = 0; bj < 2; ++bj)
#pragma unroll
                    for (int n = 0; n < 2; ++n) *(f32x4*)(rowp + bj * HALF + n * 16) = acc[ai][bj][m][n] + bv[bj][n]; }
    }
};
template <int ACT  > struct EpiBf16 {
    static constexpr bool PERM = true, AFTER_DRAIN = false;
    bf16_t* O; int ldc; const float* bias; int split_cols; size_t split_stride;
    __device__ __forceinline__ void operator()(const f32x4 (&acc)[2][2][4][2], const Unit& u, int wr, int wc, int fr, int fq) const {
        const int row0 = u.pm * BM + wr * 64 + fr; int colt = u.pn * BM; bf16_t* base = O;
        if (split_cols) { const int t = colt / split_cols; base += (size_t)t * split_stride; colt -= t * split_cols; }
        const int col0 = colt + wc * 32 + 8 * fq, bcol0 = u.pn * BM + wc * 32 + 8 * fq;
        f32x4 bv[2][2];
#pragma unroll
        for (int bj = 0; bj < 2; ++bj)
#pragma unroll
            for (int n = 0; n < 2; ++n) bv[bj][n] = bias ? *(const f32x4*)(bias + bcol0 + bj * HALF + 4 * n) : (f32x4){0.f, 0.f, 0.f, 0.f};
#pragma unroll
        for (int ai = 0; ai < 2; ++ai)
#pragma unroll
            for (int m = 0; m < 4; ++m) { bf16_t* rowp = base + (size_t)(row0 + ai * HALF + m * 16) * ldc + col0;
#pragma unroll
                for (int bj = 0; bj < 2; ++bj) { f32x4 v0 = acc[ai][bj][m][0] + bv[bj][0], v1 = acc[ai][bj][m][1] + bv[bj][1];
                    if (ACT == 1) { f32x2 a = gelu_pk((f32x2){v0[0], v0[1]}), b = gelu_pk((f32x2){v0[2], v0[3]}), c = gelu_pk((f32x2){v1[0], v1[1]}), d = gelu_pk((f32x2){v1[2], v1[3]});
                        v0 = (f32x4){a.x, a.y, b.x, b.y}; v1 = (f32x4){c.x, c.y, d.x, d.y}; }
                    if (ACT == 2) {
#pragma unroll
                        for (int j = 0; j < 4; ++j) { v0[j] = 0.5f * v0[j] * (1.0f + erff(v0[j] * 0.70710678f)); v1[j] = 0.5f * v1[j] * (1.0f + erff(v1[j] * 0.70710678f)); } }
                    u32x4 w; w.x = cvt_pk_bf16(v0[0], v0[1]); w.y = cvt_pk_bf16(v0[2], v0[3]); w.z = cvt_pk_bf16(v1[0], v1[1]); w.w = cvt_pk_bf16(v1[2], v1[3]);
                    *(u32x4*)(rowp + bj * HALF) = w; } }
    }
};


struct EpiRes {
    static constexpr bool PERM = false, AFTER_DRAIN = false;
    const float* base; float* C; int ldc;
    __device__ __forceinline__ void operator()(const f32x4 (&acc)[2][2][4][2], const Unit& u, int wr, int wc, int fr, int fq) const {
        const int row0 = u.pm * BM + wr * 64 + fr, col0 = u.pn * BM + wc * 32 + 4 * fq;
#pragma unroll
        for (int ai = 0; ai < 2; ++ai) {
            f32x4 bs[4][2][2];
#pragma unroll
            for (int m = 0; m < 4; ++m) { const size_t off = (size_t)(row0 + ai * HALF + m * 16) * ldc + col0;
#pragma unroll
                for (int bj = 0; bj < 2; ++bj)
#pragma unroll
                    for (int n = 0; n < 2; ++n) bs[m][bj][n] = *(const f32x4*)(base + off + bj * HALF + n * 16); }
#pragma unroll
            for (int m = 0; m < 4; ++m) { const size_t off = (size_t)(row0 + ai * HALF + m * 16) * ldc + col0;
#pragma unroll
                for (int bj = 0; bj < 2; ++bj)
#pragma unroll
                    for (int n = 0; n < 2; ++n) *(f32x4*)(C + off + bj * HALF + n * 16) = acc[ai][bj][m][n] + bs[m][bj][n]; }
            asm volatile("" ::: "memory");
        }
    }
};
struct EpiMerge {
    static constexpr bool PERM = true, AFTER_DRAIN = false;
    const bf16_t* G; int ldg; bf16_t* MG; int ldc; int first;
    __device__ __forceinline__ void operator()(const f32x4 (&acc)[2][2][4][2], const Unit& u, int wr, int wc, int fr, int fq) const {
        const int row0 = u.pm * BM + wr * 64 + fr, col0 = u.pn * BM + wc * 32 + 8 * fq;
#pragma unroll
        for (int ai = 0; ai < 2; ++ai) {
            u32x4 gw[4][2], ow[4][2];
#pragma unroll
            for (int m = 0; m < 4; ++m) { const size_t row = (size_t)(row0 + ai * HALF + m * 16);
#pragma unroll
                for (int bj = 0; bj < 2; ++bj) { gw[m][bj] = *(const u32x4*)(G + row * ldg + col0 + bj * HALF); ow[m][bj] = first ? (u32x4){0u, 0u, 0u, 0u} : *(const u32x4*)(MG + row * ldc + col0 + bj * HALF); } }
#pragma unroll
            for (int m = 0; m < 4; ++m) { const size_t row = (size_t)(row0 + ai * HALF + m * 16);
#pragma unroll
                for (int bj = 0; bj < 2; ++bj) { const f32x4 v0 = acc[ai][bj][m][0], v1 = acc[ai][bj][m][1];
                    const unsigned g4[4] = {gw[m][bj].x, gw[m][bj].y, gw[m][bj].z, gw[m][bj].w}, o4[4] = {ow[m][bj].x, ow[m][bj].y, ow[m][bj].z, ow[m][bj].w};
                    const float a8[8] = {v0[0], v0[1], v0[2], v0[3], v1[0], v1[1], v1[2], v1[3]};
                    unsigned w4[4];
#pragma unroll
                    for (int q = 0; q < 4; ++q) {
                        const float g0 = __uint_as_float(g4[q] << 16), g1 = __uint_as_float(g4[q] & 0xffff0000u);
                        const float r0 = __uint_as_float(o4[q] << 16) + a8[2 * q] * __builtin_amdgcn_rcpf(1.0f + __expf(-g0));
                        const float r1 = __uint_as_float(o4[q] & 0xffff0000u) + a8[2 * q + 1] * __builtin_amdgcn_rcpf(1.0f + __expf(-g1));
                        unsigned pk; asm("v_cvt_pk_bf16_f32 %0, %1, %2" : "=v"(pk) : "v"(r0), "v"(r1)); w4[q] = pk; }
                    *(u32x4*)(MG + row * ldc + col0 + bj * HALF) = (u32x4){w4[0], w4[1], w4[2], w4[3]}; } }
            asm volatile("" ::: "memory");
        }
    }
};

template <class Epi, class Sched, bool STAMP = false>
__device__ __forceinline__ void gemm_phase(PG8_LAS unsigned char* lds, const Gemm g, const Sched& S, const Epi& E, unsigned long long* stamps) {
    const int tid = otid(), wid = __builtin_amdgcn_readfirstlane(tid >> 6), lane = tid & 63, wr = wid >> 2, wc = wid & 3, fr = lane & 15, fq = lane >> 4;
    const int K = g.K, nt = K / BK;
    int ts_lo = 0, ts_hi = 0, nts = 0; const unsigned long long rt_entry = STAMP ? (unsigned long long)wall_clock64() : 0ull;
#define PG8_STAMP() do { if (STAMP && wid == 0 && nts < 64) { const unsigned long long _c = (unsigned long long)clock64(); \
        ts_lo = (lane == nts) ? (int)(unsigned)_c : ts_lo; ts_hi = (lane == nts) ? (int)(unsigned)(_c >> 32) : ts_hi; ++nts; } } while (0)
    PG8_STAMP();
    unsigned voffA[2], voffB[2];
#pragma unroll
    for (int i = 0; i < 2; ++i) { int R, C; stage_rc(tid * 16 + i * 8192, R, C); const int Rb = Epi::PERM ? ((R & ~31) + perm32(R & 31)) : R;
        voffA[i] = (unsigned)(R * K + C) * 2u; voffB[i] = (unsigned)(Rb * K + C) * 2u; }
    const size_t kstep = (size_t)(BK * 2);
    const size_t hstep = (size_t)HALF * K * 2;
    const size_t tstep = 2 * hstep;
    const unsigned ldsw = (unsigned)wid * 1024u;
    const int aoff = lds_byte(wr * 64 + fr, fq * 8), boff = lds_byte(wc * 32 + fr, fq * 8);
#define PG8_SA(b, h) (((b) * 2 + (h)) * HTB)
#define PG8_SB(b, h) ((4 + (b) * 2 + (h)) * HTB)
#define PG8_STAGE(bufoff, gbase, voff) do { _Pragma("unroll") for (int _i = 0; _i < 2; ++_i) \
        __builtin_amdgcn_global_load_lds((const unsigned*)((const char*)(gbase) + (voff)[_i]), (PG8_LAS unsigned*)(lds + (bufoff) + ldsw + _i * 8192), 16, 0, 0); } while (0)
#define PG8_LDA(dst, b, h) do { _Pragma("unroll") for (int m = 0; m < 4; ++m) _Pragma("unroll") for (int k = 0; k < 2; ++k) dst[m][k] = *(const PG8_LAS bf16x8*)(lds + PG8_SA(b, h) + aoff + m * 2048 + k * 1024); } while (0)
#define PG8_LDB(dst, b, h) do { _Pragma("unroll") for (int n = 0; n < 2; ++n) _Pragma("unroll") for (int k = 0; k < 2; ++k) dst[n][k] = *(const PG8_LAS bf16x8*)(lds + PG8_SB(b, h) + boff + n * 2048 + k * 1024); } while (0)
#define PG8_MMA(ai, bj, At, Bt) do { __builtin_amdgcn_s_setprio(1); _Pragma("unroll") for (int m = 0; m < 4; ++m) _Pragma("unroll") for (int n = 0; n < 2; ++n) _Pragma("unroll") for (int k = 0; k < 2; ++k) \
        acc[ai][bj][m][n] = __builtin_amdgcn_mfma_f32_16x16x32_bf16(Bt[n][k], At[m][k], acc[ai][bj][m][n], 0, 0, 0); __builtin_amdgcn_s_setprio(0); } while (0)
#define PG8_WAIT_V(n) asm volatile("s_waitcnt vmcnt(" #n ")" ::: "memory")
#define PG8_WAIT_L(n) asm volatile("s_waitcnt lgkmcnt(" #n ")" ::: "memory")
#define PG8_BAR __builtin_amdgcn_s_barrier()
#define PG8_SCHED __builtin_amdgcn_sched_barrier(0)
    Unit cur, nxt; int ui = 0;
    if (!S.next(0, cur)) return;
    f32x4 acc[2][2][4][2];
#pragma unroll
    for (int a = 0; a < 2; ++a)
#pragma unroll
        for (int b = 0; b < 2; ++b)
#pragma unroll
            for (int m = 0; m < 4; ++m)
#pragma unroll
                for (int n = 0; n < 2; ++n) acc[a][b][m][n] = (f32x4){0.f, 0.f, 0.f, 0.f};
    bf16x8 At[4][2], B0[2][2], B1[2][2];
    const char* cA = (const char*)g.A + (size_t)cur.pm * tstep; const char* cB = (const char*)g.Bt + (size_t)cur.pn * tstep;
    S.a_ready(cur);
    PG8_STAGE(PG8_SB(0, 0), cB, voffB); PG8_STAGE(PG8_SA(0, 0), cA, voffA); PG8_STAGE(PG8_SB(0, 1), cB + hstep, voffB); PG8_STAGE(PG8_SA(0, 1), cA + hstep, voffA);
    if (wr == 1) PG8_BAR;
    PG8_WAIT_V(4); PG8_BAR;
    PG8_STAGE(PG8_SB(1, 0), cB + kstep, voffB); PG8_STAGE(PG8_SA(1, 0), cA + kstep, voffA); PG8_STAGE(PG8_SB(1, 1), cB + hstep + kstep, voffB);
    PG8_WAIT_V(6); PG8_BAR;
    PG8_STAMP();
    for (;;) {
        const bool has_next = S.next(ui + 1, nxt);
        const char* nA = has_next ? (const char*)g.A + (size_t)nxt.pm * tstep : cA; const char* nB = has_next ? (const char*)g.Bt + (size_t)nxt.pn * tstep : cB;
        for (int t = 0; t < nt; t += 2) {
            const bool last = (t == nt - 2);
            const char* a1 = cA + (size_t)(t + 1) * kstep;
            const char* a2 = last ? nA : cA + (size_t)(t + 2) * kstep; const char* b2 = last ? nB : cB + (size_t)(t + 2) * kstep;
            const char* a3 = a2 + kstep; const char* b3 = b2 + kstep;
            if (last && has_next) S.a_ready(nxt);
            PG8_LDB(B0, 0, 0); PG8_SCHED; PG8_LDA(At, 0, 0); PG8_STAGE(PG8_SA(1, 1), a1 + hstep, voffA);
            PG8_WAIT_L(8); PG8_BAR; PG8_WAIT_L(0); PG8_MMA(0, 0, At, B0); PG8_BAR; PG8_SCHED;
            PG8_LDB(B1, 0, 1); PG8_STAGE(PG8_SB(0, 0), b2, voffB);
            PG8_BAR; PG8_WAIT_L(0); PG8_MMA(0, 1, At, B1); PG8_BAR;
            PG8_LDA(At, 0, 1); PG8_STAGE(PG8_SA(0, 0), a2, voffA);
            PG8_BAR; PG8_WAIT_L(0); PG8_MMA(1, 0, At, B0); PG8_BAR; PG8_SCHED;
            PG8_STAGE(PG8_SB(0, 1), b2 + hstep, voffB);
            PG8_WAIT_V(6); PG8_BAR; PG8_MMA(1, 1, At, B1); PG8_BAR;
            PG8_LDB(B0, 1, 0); PG8_SCHED; PG8_LDA(At, 1, 0); PG8_STAGE(PG8_SA(0, 1), a2 + hstep, voffA);
            PG8_WAIT_L(8); PG8_BAR; PG8_WAIT_L(0); PG8_MMA(0, 0, At, B0); PG8_BAR; PG8_SCHED;
            PG8_LDB(B1, 1, 1); PG8_STAGE(PG8_SB(1, 0), b3, voffB);
            PG8_BAR; PG8_WAIT_L(0); PG8_MMA(0, 1, At, B1); PG8_BAR;
            PG8_LDA(At, 1, 1); PG8_STAGE(PG8_SA(1, 0), a3, voffA);
            PG8_BAR; PG8_WAIT_L(0); PG8_MMA(1, 0, At, B0); PG8_BAR; PG8_SCHED;
            PG8_STAGE(PG8_SB(1, 1), b3 + hstep, voffB);
            PG8_WAIT_V(6); PG8_BAR; PG8_MMA(1, 1, At, B1); PG8_BAR;
        }
        PG8_STAMP();
        if constexpr (!Epi::AFTER_DRAIN) { E(acc, cur, wr, wc, fr, fq); S.done(cur); }
        PG8_STAMP();
        if (!has_next) break;
#pragma unroll
        for (int a = 0; a < 2; ++a)
#pragma unroll
            for (int b = 0; b < 2; ++b)
#pragma unroll
                for (int m = 0; m < 4; ++m)
#pragma unroll
                    for (int n = 0; n < 2; ++n) acc[a][b][m][n] = (f32x4){0.f, 0.f, 0.f, 0.f};
        cur = nxt; cA = nA; cB = nB; ++ui;
    }
    PG8_WAIT_V(0);
    if (wr == 0) PG8_BAR;
    PG8_BAR;
    if constexpr (Epi::AFTER_DRAIN) { E.fused(acc, cur, wr, wc, fr, fq, lds, wid, lane); S.done(cur); }
    PG8_STAMP();
    if (STAMP && wid == 0) { stamps[lane] = lane < nts ? (((unsigned long long)(unsigned)ts_hi << 32) | (unsigned)ts_lo) : 0ull;
        if (lane == 62) stamps[62] = rt_entry; if (lane == 63) stamps[63] = (unsigned long long)wall_clock64(); }
#undef PG8_STAMP
#undef PG8_SA
#undef PG8_SB
#undef PG8_STAGE
#undef PG8_LDA
#undef PG8_LDB
#undef PG8_MMA
#undef PG8_WAIT_V
#undef PG8_WAIT_L
#undef PG8_BAR
#undef PG8_SCHED
}
}
#define XB_TMO      128
#define XB_XCNT(j)  (256  + 64 * (j))
#define XB_XSUB(j)  (1280 + 64 * (j))
#define XB_XGEN(j)  (2304 + 64 * (j))
#define XB_TOP      3328
#define XB_TOPGEN   3392
#define XCD_BAR_WORDS 3456
#define XB_SPIN_CAP (1u << 18)
#define LAS __attribute__((address_space(3)))

__device__ __forceinline__ unsigned xb_ld(unsigned* p)              { return __hip_atomic_load(p, __ATOMIC_RELAXED, __HIP_MEMORY_SCOPE_AGENT); }
__device__ __forceinline__ unsigned xb_add(unsigned* p, unsigned v) { return __hip_atomic_fetch_add(p, v, __ATOMIC_RELAXED, __HIP_MEMORY_SCOPE_AGENT); }
__device__ __forceinline__ unsigned xb_xcc_id() { return (unsigned)__builtin_amdgcn_s_getreg((3 << 11) | 20) & 0xFu; }
#define XB_SPIN(cond, bar) do { unsigned _sp = 0; while (cond) { __builtin_amdgcn_s_sleep(1); \
    if ((++_sp & 255u) == 0u) { if (xb_ld(&(bar)[XB_TMO])) break; if (_sp > XB_SPIN_CAP) { atomicAdd(&(bar)[XB_TMO], 1u); break; } } } } while (0)

struct XcdBarrier {
    unsigned* bar; unsigned x;
    volatile LAS unsigned* st;
};

__device__ __forceinline__ XcdBarrier xcd_barrier_post(unsigned* bar, volatile LAS unsigned* st) {
    XcdBarrier b; b.bar = bar; b.x = xb_xcc_id(); b.st = st;
    if (threadIdx.x == 0) (void)xb_add(&bar[XB_XCNT(b.x)], 1u);
    return b;
}
__device__ __forceinline__ void xcd_barrier_complete(unsigned* bar, unsigned x, unsigned& nloc, unsigned& nx) {
    const unsigned G = gridDim.x * gridDim.y * gridDim.z;
    unsigned sum, cnt, mine, sp = 0u;
    for (;;) {
        sum = 0u; cnt = 0u; mine = 0u;
#pragma unroll
        for (unsigned j = 0; j < 16; ++j) { const unsigned c = xb_ld(&bar[XB_XCNT(j)]); sum += c; cnt += (c > 0u) ? 1u : 0u; mine = (j == x) ? c : mine; }
        if (sum == G) break;
        __builtin_amdgcn_s_sleep(1);
        if ((++sp & 255u) == 0u) { if (xb_ld(&bar[XB_TMO])) break; if (sp > XB_SPIN_CAP) { atomicAdd(&bar[XB_TMO], 1u); break; } }
    }
    nloc = mine > 0u ? mine : 1u; nx = cnt > 0u ? cnt : 1u;
}

__device__ __forceinline__ void xcd_barrier(const XcdBarrier& b) {
    asm volatile("s_waitcnt vmcnt(0)" ::: "memory");
    __syncthreads();
    if (threadIdx.x == 0) {
        unsigned* bar = b.bar;
        __builtin_amdgcn_s_waitcnt(0);
        unsigned nloc = b.st[0], nx = b.st[1];
        if (nloc == 0u) { xcd_barrier_complete(bar, b.x, nloc, nx); b.st[0] = nloc; b.st[1] = nx; }
        const unsigned old = xb_add(&bar[XB_XSUB(b.x)], 1u);
        const unsigned gen = old / nloc;
        if (old + 1u == (gen + 1u) * nloc) {
            __builtin_amdgcn_fence(__ATOMIC_RELEASE, "agent");
            asm volatile("s_waitcnt vmcnt(0)" ::: "memory");
            const unsigned og = xb_add(&bar[XB_TOP], 1u);
            const unsigned tg = og / nx;
            if (og + 1u == (tg + 1u) * nx) xb_add(&bar[XB_TOPGEN], 1u);
            else XB_SPIN(xb_ld(&bar[XB_TOPGEN]) == tg, bar);
            __builtin_amdgcn_fence(__ATOMIC_ACQUIRE, "agent");
            xb_add(&bar[XB_XGEN(b.x)], 1u);
            asm volatile("s_waitcnt vmcnt(0)" ::: "memory");
        } else {
            XB_SPIN(xb_ld(&bar[XB_XGEN(b.x)]) == gen, bar);
            __builtin_amdgcn_fence(__ATOMIC_ACQUIRE, "agent");
            asm volatile("s_waitcnt vmcnt(0)" ::: "memory");
        }
    }
    __syncthreads();
}


typedef unsigned short bf16;
typedef unsigned v4u __attribute__((ext_vector_type(4)));
typedef unsigned v2u __attribute__((ext_vector_type(2)));
typedef float v4f __attribute__((ext_vector_type(4)));

constexpr int DM = 2048, NBATCH = 8, SEQ = 4096, DEPTH = 2, MTOK = NBATCH * SEQ;
constexpr int IN_COLS = 14416, NPROJ = 14592;
constexpr int C_CQ = 0, C_CKV = 512, C_ZA = 1024, C_UB = 2048, C_VB = 3072, C_ZB = 4096, C_QC = 5120, C_KC = 5632, C_VC = 6144, C_ZC = 7168,
              C_GATE = 8192, C_KROPE = 14336, C_AR = 14400;
constexpr float EPS = 1e-6f;
#ifndef NBP
#define NBP 4
#endif
constexpr int MP = NBP * SEQ, NPASS = NBATCH / NBP;
constexpr int STEPS_PER_PASS = 8;
constexpr int NSTEPS = DEPTH * (1 + NPASS * STEPS_PER_PASS);

constexpr size_t al256(size_t x) { return (x + 255) & ~(size_t)255; }
constexpr size_t WS_CTL = 0, CTL_BYTES = 1u << 20;
constexpr size_t SZ_WIN = (size_t)NPROJ * DM * 2, SZ_WUQ = (size_t)1536 * 512 * 2, SZ_WUKV = (size_t)2048 * 512 * 2, SZ_WB = (size_t)3 * 2048 * 1024 * 2, SZ_WO = (size_t)2048 * 2048 * 2;
constexpr size_t SZ_WLAYER = SZ_WIN + SZ_WUQ + SZ_WUKV + SZ_WB + SZ_WO;
constexpr size_t WS_W = CTL_BYTES;
constexpr size_t WS_COS = WS_W + SZ_WLAYER, WS_SIN = WS_COS + (size_t)MTOK * 32 * 4;
constexpr size_t WS_H = WS_SIN + (size_t)MTOK * 32 * 4;
constexpr size_t WS_MG = WS_H;
constexpr size_t WS_PROJ = WS_H + (size_t)MP * DM * 2;
constexpr size_t WS_CQN = WS_PROJ + (size_t)MP * NPROJ * 2;
constexpr size_t WS_CKVN = WS_CQN + (size_t)MP * 512 * 2;
constexpr size_t WS_XB = WS_CQN;
constexpr size_t WS_RV = WS_CKVN + (size_t)MP * 512 * 2;
constexpr size_t WS_Q = WS_RV + al256((size_t)MP * 4);
constexpr size_t WS_KV = WS_Q + (size_t)MP * 1536 * 2;
constexpr size_t WS_K = WS_KV + (size_t)MP * 2048 * 2;
constexpr size_t WS_YA = WS_K + (size_t)MP * 1536 * 2;
constexpr size_t WS_YB = WS_YA + (size_t)MP * 1024 * 2;
constexpr size_t WS_DL = WS_YA;
constexpr size_t WS_YC = WS_YB + (size_t)MP * 1024 * 2;
constexpr size_t WS_OC = WS_YC + (size_t)MP * 1024 * 2;
constexpr size_t WS_QE = WS_OC + (size_t)MP * 1024 * 4;
constexpr size_t WS_KE = WS_QE + (size_t)MP * 512 * 2, WS_KL = WS_KE + (size_t)MP * 512 * 2;
constexpr size_t WS_DS = WS_KL + (size_t)MP * 512 * 2;
constexpr size_t WS_END = WS_DS + (size_t)(MP / 128) * 512 * 4;
static_assert(WS_END <= ((size_t)1 << 30), "workspace map exceeds 1 GiB");

constexpr int LDS_BYTES = 147456;
constexpr int LDSCTL_OFF = LDS_BYTES - 256;
constexpr int CW_BAR = 4096;

__device__ __forceinline__ float bf2f(unsigned v) { return __uint_as_float(v << 16); }
__device__ __forceinline__ unsigned f2bf(float f) { unsigned u = __float_as_uint(f); return (u + 0x7fffu + ((u >> 16) & 1u)) >> 16; }
__device__ __forceinline__ unsigned pk2(float lo, float hi) { return f2bf(lo) | (f2bf(hi) << 16); }
__device__ __forceinline__ float lo16(unsigned w) { return __uint_as_float(w << 16); }
__device__ __forceinline__ float hi16(unsigned w) { return __uint_as_float(w & 0xffff0000u); }
__device__ __forceinline__ float sigmoid_f(float x) { return 1.f / (1.f + __expf(-x)); }
__device__ __forceinline__ float silu_f(float x) { return x / (1.f + __expf(-x)); }
__device__ __forceinline__ float gelu_f(float x) { const float u2 = 1.5957691216057308f * (x + 0.044715f * x * x * x); return x * __builtin_amdgcn_rcpf(1.f + __expf(-u2)); }
template <int O> __device__ __forceinline__ float lane_xor(float v) {
    if (O == 1) return __uint_as_float((unsigned)__builtin_amdgcn_mov_dpp((int)__float_as_uint(v), 0xB1, 0xf, 0xf, true));
    if (O == 2) return __uint_as_float((unsigned)__builtin_amdgcn_mov_dpp((int)__float_as_uint(v), 0x4E, 0xf, 0xf, true));
    return __uint_as_float((unsigned)__builtin_amdgcn_ds_swizzle((int)__float_as_uint(v), (O << 10) | 0x1f)); }
__device__ __forceinline__ float lane_xor32(float v, int lane) {
    auto rr = __builtin_amdgcn_permlane32_swap(__float_as_uint(v), __float_as_uint(v), false, false);
    return __uint_as_float(lane < 32 ? rr[1] : rr[0]); }
__device__ __forceinline__ float wave_sum(float v) {
    v += lane_xor<1>(v); v += lane_xor<2>(v); v += lane_xor<4>(v); v += lane_xor<8>(v); v += lane_xor<16>(v);
    auto rr = __builtin_amdgcn_permlane32_swap(__float_as_uint(v), __float_as_uint(v), false, false);
    return __uint_as_float(rr[0]) + __uint_as_float(rr[1]); }
__device__ __forceinline__ float wave_max(float v) {
    v = fmaxf(v, lane_xor<1>(v)); v = fmaxf(v, lane_xor<2>(v)); v = fmaxf(v, lane_xor<4>(v)); v = fmaxf(v, lane_xor<8>(v)); v = fmaxf(v, lane_xor<16>(v));
    auto rr = __builtin_amdgcn_permlane32_swap(__float_as_uint(v), __float_as_uint(v), false, false);
    return fmaxf(__uint_as_float(rr[0]), __uint_as_float(rr[1])); }
#define LDS_FENCE() asm volatile("s_waitcnt lgkmcnt(0)" ::: "memory")

struct Args { const void* in[18]; float* out; unsigned char* ws; int lo, hi, pad0, pad1; };

template <int MODE> __device__ __forceinline__ int src_col(int n) {
    if (MODE == 0) return n;
    if (n < C_ZA) return n;
    if (n < C_ZC) return n + 64;
    if (n < C_KROPE) return n + 80;
    if (n < C_AR) return 1024 + (n - C_KROPE);
    if (n < C_AR + 16) return 7232 + (n - C_AR);
    return -1;
}
template <int MODE> __device__ __forceinline__ void convert_T(const float* W, int K, int Nsrc, bf16* WT, int Ndst, LAS float* tile, int vb, int nvb) {
    const int tid = otid(), ntk = K / 64, ntn = Ndst / 64, ntiles = ntk * ntn;
    for (int t = vb; t < ntiles; t += nvb) {
        const int k0 = (t % ntk) * 64, n0 = (t / ntk) * 64;
        { const int nn = tid & 63, sc = src_col<MODE>(n0 + nn);
#pragma unroll
          for (int i = 0; i < 8; ++i) { const int kk = (tid >> 6) + 8 * i; tile[kk * 65 + nn] = sc >= 0 ? W[(size_t)(k0 + kk) * Nsrc + sc] : 0.f; } }
        __syncthreads();
        { const int nn = tid & 63, kg = tid >> 6;
          const LAS float* tp = tile + (kg * 8) * 65 + nn;
          v4u o; o.x = pk2(tp[0], tp[65]); o.y = pk2(tp[2 * 65], tp[3 * 65]); o.z = pk2(tp[4 * 65], tp[5 * 65]); o.w = pk2(tp[6 * 65], tp[7 * 65]);
          *(v4u*)(WT + (size_t)(n0 + nn) * K + k0 + kg * 8) = o; }
        __syncthreads();
    }
}

__device__ __forceinline__ void ph_norm(const float* xin, const float* g, bf16* h, int rows, int vb, int nvb) {
    const int tid_ = otid(); const int lane = tid_ & 63, wave = tid_ >> 6;
    for (int r = vb * 8 + wave; r < rows; r += nvb * 8) {
        const v4f* xr = (const v4f*)(xin + (size_t)r * DM);
        v4f v[8]; float ss = 0.f;
#pragma unroll
        for (int j = 0; j < 8; ++j) { v[j] = xr[lane + 64 * j]; ss += v[j].x * v[j].x + v[j].y * v[j].y + v[j].z * v[j].z + v[j].w * v[j].w; }
        ss = wave_sum(ss);
        const float rn = 1.0f / sqrtf(ss * (1.0f / DM) + EPS);
#pragma unroll
        for (int j = 0; j < 8; ++j) { const v4f gg = ((const v4f*)g)[lane + 64 * j];
            v2u o; o.x = pk2(v[j].x * rn * gg.x, v[j].y * rn * gg.y); o.y = pk2(v[j].z * rn * gg.z, v[j].w * rn * gg.w);
            *(v2u*)(h + (size_t)r * DM + (lane + 64 * j) * 4) = o; }
    }
}
__device__ __forceinline__ void ph_prep(const bf16* proj, const float* gq, const float* gkv, bf16* cqn, bf16* ckvn, float* rv, int vb, int nvb) {
    const int tid_ = otid(); const int lane = tid_ & 63, wave = tid_ >> 6;
    for (int r = vb * 8 + wave; r < MP; r += nvb * 8) {
        const bf16* pr = proj + (size_t)r * NPROJ;
#pragma unroll
        for (int which = 0; which < 2; ++which) {
            const v4u w = *(const v4u*)(pr + (which ? C_CKV : C_CQ) + lane * 8);
            float x[8] = {lo16(w.x), hi16(w.x), lo16(w.y), hi16(w.y), lo16(w.z), hi16(w.z), lo16(w.w), hi16(w.w)};
            float ss = 0.f;
#pragma unroll
            for (int i = 0; i < 8; ++i) ss += x[i] * x[i];
            ss = wave_sum(ss);
            const float rn = 1.0f / sqrtf(ss * (1.0f / 512.f) + EPS);
            const float* g = (which ? gkv : gq) + lane * 8;
            v4u o; o.x = pk2(x[0] * rn * g[0], x[1] * rn * g[1]); o.y = pk2(x[2] * rn * g[2], x[3] * rn * g[3]); o.z = pk2(x[4] * rn * g[4], x[5] * rn * g[5]); o.w = pk2(x[6] * rn * g[6], x[7] * rn * g[7]);
            *(v4u*)((which ? ckvn : cqn) + (size_t)r * 512 + lane * 8) = o;
        }
        float ss = 0.f;
#pragma unroll
        for (int j = 0; j < 2; ++j) { const v4u w = *(const v4u*)(pr + C_VB + (lane + 64 * j) * 8);
            const float x[8] = {lo16(w.x), hi16(w.x), lo16(w.y), hi16(w.y), lo16(w.z), hi16(w.z), lo16(w.w), hi16(w.w)};
#pragma unroll
            for (int i = 0; i < 8; ++i) { const float gv = gelu_f(x[i]); ss += gv * gv; } }
        ss = wave_sum(ss);
        if (lane == 0) rv[r] = 1.0f / sqrtf(ss * (1.0f / 1024.f) + EPS);
    }
}
__device__ __forceinline__ void ph_qkfin(bf16* q, const bf16* kv, const bf16* proj, bf16* K, const float* qg, const float* kg, const float* cosT, const float* sinT, int row0, int vb, int nvb) {
    const int tid_ = otid(); const int lane = tid_ & 63, wave = tid_ >> 6;
    const float qg0 = qg[lane], qg1 = qg[lane + 64], qg2 = qg[lane + 128], kg0 = kg[lane], kg1 = kg[lane + 64], kg2 = kg[lane + 128];
    for (int it = (vb * 8 + wave) * 4; it < MP * 8; it += nvb * 8 * 4) {
        const int r = it >> 3, hd0 = it & 7;
        const float c = cosT[(size_t)(row0 + r) * 32 + (lane & 31)], s = sinT[(size_t)(row0 + r) * 32 + (lane & 31)];
        unsigned short qv[4][3], kvv[4][2]; const unsigned short krv = proj[(size_t)r * NPROJ + C_KROPE + lane];
#pragma unroll
        for (int j = 0; j < 4; ++j) { const bf16* qp = q + ((size_t)r * 8 + hd0 + j) * 192; const bf16* kp = kv + (size_t)r * 2048 + (hd0 + j) * 256;
            qv[j][0] = qp[lane]; qv[j][1] = qp[lane + 64]; qv[j][2] = qp[lane + 128]; kvv[j][0] = kp[lane]; kvv[j][1] = kp[lane + 64]; }
#pragma unroll
        for (int j = 0; j < 4; ++j) {
            {   bf16* qp = q + ((size_t)r * 8 + hd0 + j) * 192;
                const float v0 = bf2f(qv[j][0]), v1 = bf2f(qv[j][1]), v2 = bf2f(qv[j][2]);
                const float ss = wave_sum(v0 * v0 + v1 * v1 + v2 * v2);
                const float rn = 1.0f / sqrtf(ss * (1.0f / 192.f) + EPS);
                const float n0 = v0 * rn * qg0, n1 = v1 * rn * qg1, n2 = v2 * rn * qg2;
                const float pn = lane_xor32(n2, lane);
                const float o2 = lane < 32 ? n2 * c - pn * s : n2 * c + pn * s;
                qp[lane] = (bf16)f2bf(n0); qp[lane + 64] = (bf16)f2bf(n1); qp[lane + 128] = (bf16)f2bf(o2); }
            {   const float v0 = bf2f(kvv[j][0]), v1 = bf2f(kvv[j][1]), v2 = bf2f(krv);
                const float ss = wave_sum(v0 * v0 + v1 * v1 + v2 * v2);
                const float rn = 1.0f / sqrtf(ss * (1.0f / 192.f) + EPS);
                const float n0 = v0 * rn * kg0, n1 = v1 * rn * kg1, n2 = v2 * rn * kg2;
                const float pn = lane_xor32(n2, lane);
                const float o2 = lane < 32 ? n2 * c - pn * s : n2 * c + pn * s;
                bf16* ko = K + ((size_t)r * 8 + hd0 + j) * 192;
                ko[lane] = (bf16)f2bf(n0); ko[lane + 64] = (bf16)f2bf(n1); ko[lane + 128] = (bf16)f2bf(o2); }
        }
    }
}
__device__ __forceinline__ void ph_attn_naive(const bf16* Q, const bf16* K, const bf16* KV, const bf16* proj, bf16* YA, LAS float* lds, int vb, int nvb) {
    const int tid_ = otid(); const int lane = tid_ & 63, wave = tid_ >> 6;
    LAS float* qs = lds + wave * (4096 + 192); LAS float* ps = qs + 192;
    const float scale = 0.07216878364870322f;
    for (int it = vb * 8 + wave; it < NBP * 8 * SEQ; it += nvb * 8) {
        const int t = it % SEQ, bh = it / SEQ, h = bh & 7, b = bh >> 3, r = b * SEQ + t;
        { const bf16* qp = Q + ((size_t)r * 8 + h) * 192; qs[lane] = bf2f(qp[lane]); qs[lane + 64] = bf2f(qp[lane + 64]); qs[lane + 128] = bf2f(qp[lane + 128]); }
        LDS_FENCE();
        float m = -3.0e38f;
        for (int j = lane; j <= t; j += 64) {
            const v4u* kr = (const v4u*)(K + ((size_t)(b * SEQ + j) * 8 + h) * 192);
            float s = 0.f;
#pragma unroll 4
            for (int c = 0; c < 24; ++c) { const v4u w = kr[c]; const LAS float* qq = qs + c * 8;
                s += qq[0] * lo16(w.x) + qq[1] * hi16(w.x) + qq[2] * lo16(w.y) + qq[3] * hi16(w.y) + qq[4] * lo16(w.z) + qq[5] * hi16(w.z) + qq[6] * lo16(w.w) + qq[7] * hi16(w.w); }
            s *= scale; ps[j] = s; m = fmaxf(m, s);
        }
        m = wave_max(m);
        float l = 0.f;
        for (int j = lane; j <= t; j += 64) { const float p = __expf(ps[j] - m); ps[j] = p; l += p; }
        l = wave_sum(l);
        LDS_FENCE();
        float a0 = 0.f, a1 = 0.f;
        const bf16* vp = KV + (size_t)(b * SEQ) * 2048 + h * 256 + 128 + 2 * lane;
        for (int j = 0; j <= t; ++j) { const float p = ps[j]; const unsigned w = *(const unsigned*)(vp + (size_t)j * 2048); a0 += p * lo16(w); a1 += p * hi16(w); }
        const float inv = 1.0f / l;
        const unsigned zw = *(const unsigned*)(proj + (size_t)r * NPROJ + C_ZA + h * 128 + 2 * lane);
        *(unsigned*)(YA + (size_t)r * 1024 + h * 128 + 2 * lane) = pk2(a0 * inv * silu_f(lo16(zw)), a1 * inv * silu_f(hi16(zw)));
        LDS_FENCE();
    }
}
__device__ __forceinline__ void ph_sgu_naive(const bf16* proj, const float* rv, const float* Ws, const float* bs, const float* vg, bf16* YB, int vb, int nvb) {
    for (size_t idx = (size_t)vb * 512 + otid(); idx < (size_t)MP * 1024; idx += (size_t)nvb * 512) {
        const int r = (int)(idx >> 10), col = (int)(idx & 1023), g = col >> 7, tl = r & 127, rc = r - tl;
        float acc = 0.f;
        const float* wrow = Ws + ((size_t)g * 128 + tl) * 128;
        for (int sl = 0; sl <= tl; ++sl) acc += wrow[sl] * gelu_f(bf2f(proj[(size_t)(rc + sl) * NPROJ + C_VB + col])) * rv[rc + sl];
        acc = acc * vg[col] + bs[g * 128 + tl];
        const float u = gelu_f(bf2f(proj[(size_t)r * NPROJ + C_UB + col])), z = silu_f(bf2f(proj[(size_t)r * NPROJ + C_ZB + col]));
        YB[idx] = (bf16)f2bf(u * acc * z);
    }
}
__device__ __forceinline__ void ph_gla_naive(const bf16* proj, const float* wa2, const float* ba, float* OC, LAS float* lds, int vb, int nvb) {
    const int tid_ = otid(); const int lane = tid_ & 63, wave = tid_ >> 6;
    LAS float* sh = lds + wave * 512;
    for (int it = wave * nvb + vb; it < NBP * 16; it += nvb * 8) {
        const int b = it >> 4, h = (it >> 2) & 3, vq = it & 3;
        float st[128];
#pragma unroll
        for (int k = 0; k < 128; ++k) st[k] = 0.f;
        float wa0[16], wa1[16];
#pragma unroll
        for (int j = 0; j < 16; ++j) { wa0[j] = wa2[j * 512 + h * 128 + lane]; wa1[j] = wa2[j * 512 + h * 128 + 64 + lane]; }
        const float ba0 = ba[h * 128 + lane], ba1 = ba[h * 128 + 64 + lane];
        for (int t = 0; t < SEQ; ++t) {
            const bf16* pr = proj + (size_t)(b * SEQ + t) * NPROJ;
            const v4u w0 = *(const v4u*)(pr + C_AR), w1 = *(const v4u*)(pr + C_AR + 8);
            const float ar[16] = {lo16(w0.x), hi16(w0.x), lo16(w0.y), hi16(w0.y), lo16(w0.z), hi16(w0.z), lo16(w0.w), hi16(w0.w),
                                  lo16(w1.x), hi16(w1.x), lo16(w1.y), hi16(w1.y), lo16(w1.z), hi16(w1.z), lo16(w1.w), hi16(w1.w)};
            float x0 = ba0, x1 = ba1;
#pragma unroll
            for (int j = 0; j < 16; ++j) { x0 += ar[j] * wa0[j]; x1 += ar[j] * wa1[j]; }
            const float ls0 = fminf(x0, 0.f) - log1pf(__expf(-fabsf(x0))), ls1 = fminf(x1, 0.f) - log1pf(__expf(-fabsf(x1)));
            sh[lane] = __expf(ls0 * 0.0625f); sh[64 + lane] = __expf(ls1 * 0.0625f);
            sh[128 + lane] = bf2f(pr[C_QC + h * 128 + lane]) * 0.08838834764831845f; sh[192 + lane] = bf2f(pr[C_QC + h * 128 + 64 + lane]) * 0.08838834764831845f;
            sh[256 + lane] = bf2f(pr[C_KC + h * 128 + lane]); sh[320 + lane] = bf2f(pr[C_KC + h * 128 + 64 + lane]);
            const float v = bf2f(pr[C_VC + h * 256 + vq * 64 + lane]);
            LDS_FENCE();
            float o = 0.f;
#pragma unroll
            for (int k = 0; k < 128; ++k) { st[k] = sh[k] * st[k] + sh[256 + k] * v; o += sh[128 + k] * st[k]; }
            LDS_FENCE();
            OC[(size_t)(b * SEQ + t) * 1024 + h * 256 + vq * 64 + lane] = o;
        }
    }
}
__device__ __forceinline__ void ph_glafin(const float* OC, const bf16* proj, const float* og, bf16* YC, int vb, int nvb) {
    const int tid_ = otid(); const int lane = tid_ & 63, wave = tid_ >> 6;
    for (int it = vb * 8 + wave; it < MP * 4; it += nvb * 8) {
        const int r = it >> 2, h = it & 3;
        const v4f o = *(const v4f*)(OC + (size_t)r * 1024 + h * 256 + lane * 4);
        const float ss = wave_sum(o.x * o.x + o.y * o.y + o.z * o.z + o.w * o.w);
        const float rn = 1.0f / sqrtf(ss * (1.0f / 256.f) + EPS);
        const v4f g = *(const v4f*)(og + lane * 4);
        const v2u zw = *(const v2u*)(proj + (size_t)r * NPROJ + C_ZC + h * 256 + lane * 4);
        v2u w; w.x = pk2(o.x * rn * g.x * silu_f(lo16(zw.x)), o.y * rn * g.y * silu_f(hi16(zw.x))); w.y = pk2(o.z * rn * g.z * silu_f(lo16(zw.y)), o.w * rn * g.w * silu_f(hi16(zw.y)));
        *(v2u*)(YC + (size_t)r * 1024 + h * 256 + lane * 4) = w;
    }
}
__device__ __forceinline__ void ph_merge(const bf16* proj, const bf16* PB, bf16* MG, int vb, int nvb) {
    for (size_t idx = (size_t)vb * 512 + otid(); idx < (size_t)MP * 1024; idx += (size_t)nvb * 512) {
        const int r = (int)(idx >> 10), j = (int)(idx & 1023) * 2;
        float m0 = 0.f, m1 = 0.f;
#pragma unroll
        for (int b = 0; b < 3; ++b) { const unsigned gw = *(const unsigned*)(proj + (size_t)r * NPROJ + C_GATE + b * 2048 + j), pw = *(const unsigned*)(PB + ((size_t)b * MP + r) * 2048 + j);
            m0 += sigmoid_f(lo16(gw)) * lo16(pw); m1 += sigmoid_f(hi16(gw)) * hi16(pw); }
        *(unsigned*)(MG + (size_t)r * 2048 + j) = pk2(m0, m1);
    }
}
__device__ __forceinline__ void ph_outadd(const float* xin, const float* U, float* xout, int vb, int nvb) {
    for (size_t idx = (size_t)vb * 512 + otid(); idx < (size_t)MP * 512; idx += (size_t)nvb * 512) {
        const v4f a = ((const v4f*)xin)[idx], u = ((const v4f*)U)[idx]; ((v4f*)xout)[idx] = a + u; }
}


namespace at {
typedef short bf16x8 __attribute__((ext_vector_type(8)));
typedef short s16x4 __attribute__((ext_vector_type(4)));
typedef float f32x16 __attribute__((ext_vector_type(16)));
typedef unsigned u32x4 __attribute__((ext_vector_type(4)));
constexpr int SHM_V = 16384, SHM_K = 16384, SHM_KR = 8192;
constexpr int OFF_V = 0, OFF_K = 3 * SHM_V, OFF_KR = OFF_K + 2 * SHM_K, OFF_WS = OFF_KR + 2 * SHM_KR, LDS_NEED = OFF_WS + 8 * 64 * 4;
constexpr float SCALE = 0.07216878364870322f;
constexpr float THR = 8.f;
#define AT_KSWZ(row, colB) ((row) * 256 + ((colB) ^ (((row) & 7) << 4)))
#define AT_KRSWZ(row, colB) ((row) * 128 + ((colB) ^ (((row) & 7) << 4)))
#define AT_SBAR() __builtin_amdgcn_sched_barrier(0)
__device__ __forceinline__ int v_st(int k, int c) { const int kk = (k & ~0xC) | ((k & 4) << 1) | ((k & 8) >> 1); return ((kk >> 3) * 4 + (c >> 5)) * 512 + ((kk & 7) * 32 + (c & 31)) * 2; }
__device__ __forceinline__ int v_rd_base(int lane) { return ((lane & 3) << 3) | (((lane >> 2) & 3) << 6) | (((lane >> 4) & 1) << 5) | (((lane >> 5) & 1) << 8); }
constexpr int v_rd_off(int d0, int ks, int half) { return d0 * 512 + ks * 4096 + half * 2048; }
__device__ __forceinline__ int crow(int r, int hi) { return (r & 3) + 8 * (r >> 2) + 4 * hi; }
__device__ __forceinline__ unsigned cvtpk(float lo, float hi) { unsigned r; asm("v_cvt_pk_bf16_f32 %0, %1, %2" : "=v"(r) : "v"(lo), "v"(hi)); return r; }

__device__ __forceinline__ void mask_tile(f32x16& p0, f32x16& p1, int dq) {
    const float NEG = -__builtin_inff();
#pragma unroll
    for (int r = 0; r < 16; ++r) { const int c = (r & 3) + 8 * (r >> 2); if (dq < c) p0[r] = NEG; if (dq < c + 32) p1[r] = NEG; }
}
__device__ __forceinline__ void partialSM(f32x16& p0, f32x16& p1, float& m_reg, float& mn, float& alpha) {
    float pmax = p0[0];
#pragma unroll
    for (int r = 1; r < 16; ++r) pmax = fmaxf(pmax, p0[r]);
#pragma unroll
    for (int r = 0; r < 16; ++r) pmax = fmaxf(pmax, p1[r]);
    { auto rr = __builtin_amdgcn_permlane32_swap(__float_as_uint(pmax), __float_as_uint(pmax), false, false);
      pmax = fmaxf(__uint_as_float(rr[0]), __uint_as_float(rr[1])); }
    constexpr float C2 = 1.4426950408889634f * SCALE;
    if (__builtin_expect(__all((pmax - m_reg) * SCALE <= THR), 1)) { mn = m_reg; alpha = 1.f; }
    else { mn = fmaxf(m_reg, pmax); alpha = __builtin_amdgcn_exp2f((m_reg - mn) * C2); m_reg = mn; }
    const float mnL = -mn * C2;
#pragma unroll
    for (int r = 0; r < 16; ++r) p0[r] = fmaf(p0[r], C2, mnL);
#pragma unroll
    for (int r = 0; r < 16; ++r) p1[r] = fmaf(p1[r], C2, mnL);
#pragma unroll
    for (int r = 0; r < 16; ++r) p0[r] = __builtin_amdgcn_exp2f(p0[r]);
}
__device__ __forceinline__ void finishSM(f32x16& p0, f32x16& p1, float alpha, float& l_reg, bf16x8& pa0, bf16x8& pa1, bf16x8& pa2, bf16x8& pa3) {
#pragma unroll
    for (int r = 0; r < 16; ++r) p1[r] = __builtin_amdgcn_exp2f(p1[r]);
    float ps = 0;
#pragma unroll
    for (int r = 0; r < 16; ++r) ps += p0[r];
#pragma unroll
    for (int r = 0; r < 16; ++r) ps += p1[r];
    { auto rr = __builtin_amdgcn_permlane32_swap(__float_as_uint(ps), __float_as_uint(ps), false, false);
      ps = __uint_as_float(rr[0]) + __uint_as_float(rr[1]); }
    l_reg = l_reg * alpha + ps;
#define AT_PK4(P, B_, OUT) do { unsigned a0 = cvtpk(P[B_+0], P[B_+1]), a1 = cvtpk(P[B_+2], P[B_+3]);                          \
        unsigned b0 = cvtpk(P[B_+4], P[B_+5]), b1 = cvtpk(P[B_+6], P[B_+7]);                                             \
        auto r0 = __builtin_amdgcn_permlane32_swap(a0, b0, false, false); auto r1 = __builtin_amdgcn_permlane32_swap(a1, b1, false, false); \
        u32x4 w = {r0[0], r1[0], r0[1], r1[1]}; OUT = *reinterpret_cast<bf16x8*>(&w); } while (0)
    AT_PK4(p0, 0, pa0); AT_PK4(p0, 8, pa1); AT_PK4(p1, 0, pa2); AT_PK4(p1, 8, pa3);
#undef AT_PK4
}
__device__ __forceinline__ void qkt(f32x16& p0, f32x16& p1, const LAS unsigned char* Kb, const LAS unsigned char* KRb, int r32, int hi, const bf16x8* qr) {
    p0 = f32x16{}; p1 = f32x16{};
    const LAS unsigned char* kb[4]; const LAS unsigned char* krb[4];
#pragma unroll
    for (int dd = 0; dd < 4; ++dd) { kb[dd] = Kb + AT_KSWZ(r32, (dd * 16 + hi * 8) * 2); krb[dd] = KRb + AT_KRSWZ(r32, (dd * 16 + hi * 8) * 2); }
    bf16x8 f[24];
#pragma unroll
    for (int d0 = 0; d0 < 8; ++d0) { const LAS unsigned char* a = kb[d0 & 3] + (d0 >> 2) * 128;
        f[2 * d0] = *reinterpret_cast<const LAS bf16x8*>(a); f[2 * d0 + 1] = *reinterpret_cast<const LAS bf16x8*>(a + 32 * 256); }
#pragma unroll
    for (int d0 = 0; d0 < 4; ++d0) { const LAS unsigned char* a = krb[d0];
        f[16 + 2 * d0] = *reinterpret_cast<const LAS bf16x8*>(a); f[16 + 2 * d0 + 1] = *reinterpret_cast<const LAS bf16x8*>(a + 32 * 128); }
#pragma unroll
    for (int d0 = 0; d0 < 12; ++d0) {
        p0 = __builtin_amdgcn_mfma_f32_32x32x16_bf16(f[2 * d0], qr[d0], p0, 0, 0, 0);
        p1 = __builtin_amdgcn_mfma_f32_32x32x16_bf16(f[2 * d0 + 1], qr[d0], p1, 0, 0, 0); }
    __builtin_amdgcn_sched_group_barrier(0x100, 4, 0);
#pragma unroll
    for (int i = 0; i < 20; ++i) { __builtin_amdgcn_sched_group_barrier(0x008, 1, 0); __builtin_amdgcn_sched_group_barrier(0x100, 1, 0); }
    __builtin_amdgcn_sched_group_barrier(0x008, 4, 0);
}
__device__ __forceinline__ void pv_tile(f32x16* o, unsigned vb0, bf16x8 pa0, bf16x8 pa1, bf16x8 pa2, bf16x8 pa3) {
#define AT_TRRD(dst, off) asm volatile("ds_read_b64_tr_b16 %0, %1 offset:%2" : "=&v"(dst) : "v"(vb0), "i"(off) : "memory")
#define AT_PV_RD(d0, L, H) do { constexpr int b_ = v_rd_off(d0, 0, 0); \
        AT_TRRD(L[0], b_); AT_TRRD(H[0], b_ + 2048); AT_TRRD(L[1], b_ + 4096); AT_TRRD(H[1], b_ + 6144); AT_TRRD(L[2], b_ + 8192); AT_TRRD(H[2], b_ + 10240); AT_TRRD(L[3], b_ + 12288); AT_TRRD(H[3], b_ + 14336); } while (0)
#define AT_PV_MM(d0, L, H) do { \
        o[d0] = __builtin_amdgcn_mfma_f32_32x32x16_bf16(pa0, (bf16x8){L[0][0], L[0][1], L[0][2], L[0][3], H[0][0], H[0][1], H[0][2], H[0][3]}, o[d0], 0, 0, 0);   \
        o[d0] = __builtin_amdgcn_mfma_f32_32x32x16_bf16(pa1, (bf16x8){L[1][0], L[1][1], L[1][2], L[1][3], H[1][0], H[1][1], H[1][2], H[1][3]}, o[d0], 0, 0, 0);   \
        o[d0] = __builtin_amdgcn_mfma_f32_32x32x16_bf16(pa2, (bf16x8){L[2][0], L[2][1], L[2][2], L[2][3], H[2][0], H[2][1], H[2][2], H[2][3]}, o[d0], 0, 0, 0);   \
        o[d0] = __builtin_amdgcn_mfma_f32_32x32x16_bf16(pa3, (bf16x8){L[3][0], L[3][1], L[3][2], L[3][3], H[3][0], H[3][1], H[3][2], H[3][3]}, o[d0], 0, 0, 0); } while (0)
    s16x4 la[4], ha[4], lb[4], hb[4];
    asm volatile("s_waitcnt lgkmcnt(0)" ::: "memory");
    AT_PV_RD(0, la, ha); AT_PV_RD(1, lb, hb);
    asm volatile("s_waitcnt lgkmcnt(8)" ::: "memory"); AT_SBAR(); AT_PV_MM(0, la, ha); AT_SBAR();
    AT_PV_RD(2, la, ha);
    asm volatile("s_waitcnt lgkmcnt(8)" ::: "memory"); AT_SBAR(); AT_PV_MM(1, lb, hb); AT_SBAR();
    AT_PV_RD(3, lb, hb);
    asm volatile("s_waitcnt lgkmcnt(8)" ::: "memory"); AT_SBAR(); AT_PV_MM(2, la, ha); AT_SBAR();
    asm volatile("s_waitcnt lgkmcnt(0)" ::: "memory"); AT_SBAR(); AT_PV_MM(3, lb, hb);
#undef AT_PV_RD
#undef AT_PV_MM
#undef AT_TRRD
}

__device__ __forceinline__ void attn_block(LAS unsigned char* lds, const bf16* Q, const bf16* K, const bf16* KV, const bf16* proj, bf16* YA, int b, int h, int qb) {
    const int tid = otid(), wid = __builtin_amdgcn_readfirstlane(tid >> 6), lane = tid & 63, r32 = lane & 31, hi = lane >> 5;
    const int P0 = qb * 256, NT = 4 * (qb + 1), qlo = P0 + wid * 32;
    LAS unsigned char* V_lds = lds + OFF_V; LAS unsigned char* K_lds = lds + OFF_K; LAS unsigned char* KR_lds = lds + OFF_KR;
    LAS float* wsf = (LAS float*)(lds + OFF_WS) + wid * 64; LAS float* li_l = wsf; LAS float* al_l = wsf + 32;
    bf16x8 qr[12];
    { const bf16* qp = Q + ((size_t)(b * SEQ + qlo + r32) * 8 + h) * 192 + hi * 8;
#pragma unroll
      for (int d0 = 0; d0 < 12; ++d0) qr[d0] = *(const bf16x8*)(qp + d0 * 16); }
    const int sr = tid >> 4, sc = (tid & 15) * 8, kws = AT_KSWZ(sr, sc * 2), vst0 = v_st(sr, sc), vst1 = v_st(32 + sr, sc);
    const int rr = tid >> 3, rc = (tid & 7) * 8, krws = AT_KRSWZ(rr, rc * 2);
    const bf16* Kg = K + ((size_t)(b * SEQ) * 8 + h) * 192;
    const bf16* Vg = KV + (size_t)(b * SEQ) * 2048 + h * 256 + 128;
    bf16x8 sa_k0, sa_k1, sa_kr, sa_v0, sa_v1, sb_k0, sb_k1, sb_kr, sb_v0, sb_v1;
#define AT_SLOAD(S, kb_) do { S##_k0 = *(const bf16x8*)(Kg + (size_t)((kb_) + sr) * 1536 + sc); S##_k1 = *(const bf16x8*)(Kg + (size_t)((kb_) + 32 + sr) * 1536 + sc); \
        S##_kr = *(const bf16x8*)(Kg + (size_t)((kb_) + rr) * 1536 + 128 + rc); \
        S##_v0 = *(const bf16x8*)(Vg + (size_t)((kb_) + sr) * 2048 + sc); S##_v1 = *(const bf16x8*)(Vg + (size_t)((kb_) + 32 + sr) * 2048 + sc); } while (0)
#define AT_SWRITE(S, bf, vbf) do { *(LAS bf16x8*)(K_lds + (bf) * SHM_K + kws) = S##_k0; *(LAS bf16x8*)(K_lds + (bf) * SHM_K + kws + 32 * 256) = S##_k1; \
        *(LAS bf16x8*)(KR_lds + (bf) * SHM_KR + krws) = S##_kr; \
        *(LAS bf16x8*)(V_lds + (vbf) * SHM_V + vst0) = S##_v0; *(LAS bf16x8*)(V_lds + (vbf) * SHM_V + vst1) = S##_v1; } while (0)
    AT_SLOAD(sa, 0); AT_SLOAD(sb, 64); AT_SWRITE(sa, 0, 0);
    __syncthreads();
    float m_reg = -1e30f, l_reg = 0.f; f32x16 o[4] = {};
    const unsigned vbase = (unsigned)(size_t)V_lds + (unsigned)v_rd_base(lane);
    const bool late = wid >= 4;
    bool pend = false; int pvb = 0; int vb3 = 0;
    bf16x8 pa0, pa1, pa2, pa3;
#define AT_STEP(t, SL, SW) do { \
        const int buf = (t) & 1, kb = (t) * 64; \
        if ((t) + 2 < NT) AT_SLOAD(SL, kb + 128);                         \
        if (late && pend) { pv_tile(o, vbase + pvb * SHM_V, pa0, pa1, pa2, pa3); pend = false; AT_SBAR(); } \
        if (kb <= qlo + 31) { \
            f32x16 p0, p1; float mn, alpha; \
            qkt(p0, p1, K_lds + buf * SHM_K, KR_lds + buf * SHM_KR, r32, hi, qr); \
            if (kb + 63 > qlo) mask_tile(p0, p1, qlo + r32 - 4 * hi - kb); \
            partialSM(p0, p1, m_reg, mn, alpha); \
            finishSM(p0, p1, alpha, l_reg, pa0, pa1, pa2, pa3); \
            if (__any(alpha < 1.f)) { if (hi == 0) al_l[r32] = alpha; asm volatile("s_waitcnt lgkmcnt(0)" ::: "memory"); \
                _Pragma("unroll") for (int d_ = 0; d_ < 4; ++d_) _Pragma("unroll") for (int r = 0; r < 16; ++r) o[d_][r] *= al_l[crow(r, hi)]; \
                asm volatile("s_waitcnt lgkmcnt(0)" ::: "memory"); } \
            AT_SBAR(); \
            if (late) { pend = true; pvb = vb3; } \
            else pv_tile(o, vbase + vb3 * SHM_V, pa0, pa1, pa2, pa3); \
        } \
        const int vn3 = vb3 == 2 ? 0 : vb3 + 1; \
        if ((t) + 1 < NT) AT_SWRITE(SW, buf ^ 1, vn3);                    \
        vb3 = vn3; \
        __syncthreads(); } while (0)
    for (int t = 0; t < NT; t += 2) { AT_STEP(t, sa, sb); AT_STEP(t + 1, sb, sa); }
#undef AT_STEP
    if (late && pend) pv_tile(o, vbase + pvb * SHM_V, pa0, pa1, pa2, pa3);
    if (hi == 0) li_l[r32] = l_reg;
    asm volatile("s_waitcnt lgkmcnt(0)" ::: "memory");
    float rli[16];
#pragma unroll
    for (int r = 0; r < 16; ++r) rli[r] = 1.0f / li_l[crow(r, hi)];
#pragma unroll
    for (int d0 = 0; d0 < 4; ++d0) { const int col = h * 128 + d0 * 32 + r32;
        unsigned short zr[16];
#pragma unroll
        for (int r = 0; r < 16; ++r) zr[r] = proj[(size_t)(b * SEQ + qlo + crow(r, hi)) * NPROJ + C_ZA + col];
#pragma unroll
        for (int r = 0; r < 16; ++r) { const int row = b * SEQ + qlo + crow(r, hi);
            const float v = o[d0][r] * rli[r] * silu_f(bf2f(zr[r]));
            const float vn = lane_xor<1>(v);
            if ((r32 & 1) == 0) *(unsigned*)(YA + (size_t)row * 1024 + col) = cvtpk(v, vn); } }
    asm volatile("s_waitcnt lgkmcnt(0)" ::: "memory");
    __syncthreads();
#undef AT_SLOAD
#undef AT_SWRITE
}
__device__ __forceinline__ void ph_attn(LAS unsigned char* lds, const bf16* Q, const bf16* K, const bf16* KV, const bf16* proj, bf16* YA, int vb, int nvb) {
    const int nitems = NBP * 8 * 8;
    for (int it = vb; it < nitems; it += nvb) {
        const int grp = it >> 6, within = it & 63, pair = within >> 3, bh = grp * 8 + (within & 7), b = bh >> 3, h = bh & 7;
        attn_block(lds, Q, K, KV, proj, YA, b, h, 15 - pair);
        attn_block(lds, Q, K, KV, proj, YA, b, h, pair);
    }
}
}


namespace sg {
using at::bf16x8; using at::f32x16;
__device__ __forceinline__ void sgu_item(LAS unsigned char* lds, const bf16* proj, const float* rv, const float* Ws, const float* bs, const float* vg, bf16* YB, int it) {
    const int tid = otid(), wid = __builtin_amdgcn_readfirstlane(tid >> 6), lane = tid & 63, r32 = lane & 31, hi = lane >> 5;
    {
        const int ch = it >> 2, gp = it & 3, R0 = ch * 128;
#pragma unroll
        for (int i = 0; i < 8; ++i) {
            const int idx = tid + 512 * i, gsel = idx >> 11, row = (idx >> 4) & 127, cc = idx & 15;
            const v4u w = *(const v4u*)(proj + (size_t)(R0 + row) * NPROJ + C_VB + (2 * gp + gsel) * 128 + cc * 8);
            const float s = rv[R0 + row];
            v4u o; o.x = pk2(gelu_f(lo16(w.x)) * s, gelu_f(hi16(w.x)) * s); o.y = pk2(gelu_f(lo16(w.y)) * s, gelu_f(hi16(w.y)) * s);
            o.z = pk2(gelu_f(lo16(w.z)) * s, gelu_f(hi16(w.z)) * s); o.w = pk2(gelu_f(lo16(w.w)) * s, gelu_f(hi16(w.w)) * s);
            *(LAS v4u*)(lds + (gsel * 2 + (row >> 6)) * 16384 + at::v_st(row & 63, cc * 8)) = o;
        }
        __syncthreads();
        const int gsel = wid >> 2, g = 2 * gp + gsel, t = 32 * (wid & 3) + r32;
        f32x16 o[4] = {};
        const int nst = (wid & 3) >= 2 ? 2 : 1;
        for (int st = 0; st < nst; ++st) {
            bf16x8 pa[4];
#pragma unroll
            for (int ks = 0; ks < 4; ++ks) {
                const int s0 = st * 64 + ks * 16 + hi * 8;
                const float* wp = Ws + ((size_t)g * 128 + t) * 128 + s0;
                const v4f a = *(const v4f*)wp, b = *(const v4f*)(wp + 4);
                float x[8] = {a.x, a.y, a.z, a.w, b.x, b.y, b.z, b.w};
#pragma unroll
                for (int j = 0; j < 8; ++j) if (s0 + j > t) x[j] = 0.f;
                at::u32x4 w4 = {at::cvtpk(x[0], x[1]), at::cvtpk(x[2], x[3]), at::cvtpk(x[4], x[5]), at::cvtpk(x[6], x[7])};
                pa[ks] = *reinterpret_cast<bf16x8*>(&w4);
            }
            const unsigned vbase = (unsigned)(size_t)(lds + (gsel * 2 + st) * 16384) + (unsigned)at::v_rd_base(lane);
            at::pv_tile(o, vbase, pa[0], pa[1], pa[2], pa[3]);
        }
#pragma unroll
        for (int d0 = 0; d0 < 4; ++d0) { const int gc = g * 128 + d0 * 32 + r32; const float vgc = vg[gc];
            unsigned short ur[16], zr[16];
#pragma unroll
            for (int r = 0; r < 16; ++r) { const size_t row = (size_t)(R0 + 32 * (wid & 3) + at::crow(r, hi)); ur[r] = proj[row * NPROJ + C_UB + gc]; zr[r] = proj[row * NPROJ + C_ZB + gc]; }
#pragma unroll
            for (int r = 0; r < 16; ++r) { const int tl = 32 * (wid & 3) + at::crow(r, hi); const size_t row = (size_t)(R0 + tl);
                const float mix = o[d0][r] * vgc + bs[g * 128 + tl];
                const float y = gelu_f(bf2f(ur[r])) * mix * silu_f(bf2f(zr[r])), yn = lane_xor<1>(y);
                if ((r32 & 1) == 0) *(unsigned*)(YB + row * 1024 + gc) = at::cvtpk(y, yn); } }
        __syncthreads();
    }
}
}


namespace gl {
using at::bf16x8; using at::f32x16; using at::s16x4; using at::u32x4;
constexpr int OFF_VIMG = 0, OFF_KLIMG = 65536, OFF_ATT = 98304, OFF_DS = 131072, OFF_PART = 131584, LDS_NEED = OFF_PART + 4096;

__device__ __forceinline__ void ph_gla_prep(LAS unsigned char* lds, const bf16* proj, const float* wa2, const float* ba, bf16* QE, bf16* KE, bf16* KL, float* DS, int vb, int nvb) {
    const int tid = otid(), k = tid & 127, tq = tid >> 7;
    LAS float* seg = (LAS float*)lds;
    const int nitems = (MP / 128) * 4;
    for (int it = vb; it < nitems; it += nvb) {
        const int ch = it >> 2, h = it & 3, R0 = ch * 128 + tq * 32;
        float wa[16];
#pragma unroll
        for (int j = 0; j < 16; ++j) wa[j] = wa2[j * 512 + h * 128 + k];
        const float bak = ba[h * 128 + k];
        float la[32]; float run = 0.f;
#pragma unroll
        for (int i = 0; i < 32; ++i) {
            const bf16* pr = proj + (size_t)(R0 + i) * NPROJ + C_AR;
            const v4u w0 = *(const v4u*)pr, w1 = *(const v4u*)(pr + 8);
            const float ar[16] = {lo16(w0.x), hi16(w0.x), lo16(w0.y), hi16(w0.y), lo16(w0.z), hi16(w0.z), lo16(w0.w), hi16(w0.w),
                                  lo16(w1.x), hi16(w1.x), lo16(w1.y), hi16(w1.y), lo16(w1.z), hi16(w1.z), lo16(w1.w), hi16(w1.w)};
            float x = bak;
#pragma unroll
            for (int j = 0; j < 16; ++j) x += ar[j] * wa[j];
            const float ls = fminf(x, 0.f) - __logf(1.0f + __expf(-fabsf(x)));
            run += ls * 0.0625f; la[i] = run;
        }
        seg[tq * 128 + k] = run;
        __syncthreads();
        float pre = 0.f, total = 0.f;
#pragma unroll
        for (int q = 0; q < 4; ++q) { const float sgm = seg[q * 128 + k]; total += sgm; if (q < tq) pre += sgm; }
#pragma unroll
        for (int i = 0; i < 32; ++i) {
            const float b = la[i] + pre; const size_t row = (size_t)(R0 + i);
            const float qv = bf2f(proj[row * NPROJ + C_QC + h * 128 + k]) * 0.08838834764831845f, kv = bf2f(proj[row * NPROJ + C_KC + h * 128 + k]);
            QE[row * 512 + h * 128 + k] = (bf16)f2bf(qv * __expf(b));
            KE[row * 512 + h * 128 + k] = (bf16)f2bf(kv * __expf(-b));
            KL[row * 512 + h * 128 + k] = (bf16)f2bf(kv * __expf(total - b));
        }
        if (tq == 0) DS[((size_t)ch * 4 + h) * 128 + k] = __expf(total);
        __syncthreads();
    }
}

#define GL_PK4(P, B_, OUT) do { unsigned a0 = at::cvtpk(P[B_+0], P[B_+1]), a1 = at::cvtpk(P[B_+2], P[B_+3]);                          \
        unsigned b0 = at::cvtpk(P[B_+4], P[B_+5]), b1 = at::cvtpk(P[B_+6], P[B_+7]);                                             \
        auto r0 = __builtin_amdgcn_permlane32_swap(a0, b0, false, false); auto r1 = __builtin_amdgcn_permlane32_swap(a1, b1, false, false); \
        u32x4 w = {r0[0], r1[0], r0[1], r1[1]}; OUT = *reinterpret_cast<bf16x8*>(&w); } while (0)
#define GL_TRRD(dst, addr, off) asm volatile("ds_read_b64_tr_b16 %0, %1 offset:%2" : "=&v"(dst) : "v"(addr), "i"(off) : "memory")

__device__ __forceinline__ void gla_chunk_item(LAS unsigned char* lds, const bf16* proj, const bf16* QE, const bf16* KE, const bf16* KL, float* OI, float* DL, int ci) {
    const int tid = otid(), wid = __builtin_amdgcn_readfirstlane(tid >> 6), lane = tid & 63, r32 = lane & 31, hi = lane >> 5;
    const int h = ci & 3, R0 = (ci >> 2) * 128;
    {
        {
#pragma unroll
            for (int i = 0; i < 8; ++i) { const int idx = tid + 512 * i, s = idx >> 5, cc = idx & 31;
                const v4u w = *(const v4u*)(proj + (size_t)(R0 + s) * NPROJ + C_VC + h * 256 + cc * 8);
                *(LAS v4u*)(lds + OFF_VIMG + ((s >> 6) * 2 + (cc >> 4)) * 16384 + at::v_st(s & 63, (cc & 15) * 8)) = w; }
#pragma unroll
            for (int i = 0; i < 4; ++i) { const int idx = tid + 512 * i, s = idx >> 4, cc = idx & 15;
                const v4u w = *(const v4u*)(KL + (size_t)(R0 + s) * 512 + h * 128 + cc * 8);
                *(LAS v4u*)(lds + OFF_KLIMG + (s >> 6) * 16384 + at::v_st(s & 63, cc * 8)) = w; }
#pragma unroll
            for (int j = 0; j < 2; ++j) {
                const int ti = 2 * wid + j, st = ti >> 2, tt = ti & 3;
                if (st <= tt) {
                    f32x16 p = {};
                    const bf16* ap = KE + (size_t)(R0 + 32 * st + r32) * 512 + h * 128 + hi * 8;
                    const bf16* bp = QE + (size_t)(R0 + 32 * tt + r32) * 512 + h * 128 + hi * 8;
                    bf16x8 fa[8], fb[8];
#pragma unroll
                    for (int ks = 0; ks < 8; ++ks) { fa[ks] = *(const bf16x8*)(ap + ks * 16); fb[ks] = *(const bf16x8*)(bp + ks * 16); }
#pragma unroll
                    for (int ks = 0; ks < 8; ++ks) p = __builtin_amdgcn_mfma_f32_32x32x16_bf16(fa[ks], fb[ks], p, 0, 0, 0);
                    __builtin_amdgcn_sched_group_barrier(0x020, 16, 0); __builtin_amdgcn_sched_group_barrier(0x008, 8, 0);
                    if (st == tt) {
#pragma unroll
                        for (int r = 0; r < 16; ++r) if (at::crow(r, hi) > r32) p[r] = 0.f; }
                    const int t = 32 * tt + r32;
#pragma unroll
                    for (int g = 0; g < 4; ++g) { v2u w; w.x = at::cvtpk(p[4 * g], p[4 * g + 1]); w.y = at::cvtpk(p[4 * g + 2], p[4 * g + 3]);
                        *(LAS v2u*)(lds + OFF_ATT + t * 256 + ((64 * st + 16 * g) ^ ((t & 7) << 4)) + 8 * hi) = w; }
                }
            }
            __syncthreads();
            bf16x8 vfr[8];
            { const unsigned vaddr = (unsigned)(size_t)(lds + OFF_VIMG + (wid >> 2) * 16384) + (unsigned)at::v_rd_base(lane) + (unsigned)((wid & 3) * 512);
              s16x4 vl[8], vh[8];
#define GL_VF(ks8) do { constexpr int o_ = ((ks8) >> 2) * 32768 + ((ks8) & 3) * 4096; GL_TRRD(vl[ks8], vaddr, o_); GL_TRRD(vh[ks8], vaddr, o_ + 2048); } while (0)
              GL_VF(0); GL_VF(1); GL_VF(2); GL_VF(3); GL_VF(4); GL_VF(5); GL_VF(6); GL_VF(7);
#undef GL_VF
              asm volatile("s_waitcnt lgkmcnt(0)" ::: "memory"); AT_SBAR();
#pragma unroll
              for (int q = 0; q < 8; ++q) vfr[q] = (bf16x8){vl[q][0], vl[q][1], vl[q][2], vl[q][3], vh[q][0], vh[q][1], vh[q][2], vh[q][3]};
              AT_SBAR(); }
            float* oi = OI + (((size_t)ci * 8 + wid) * 16 * 64 + lane) * 4;
            float* dl = DL + (((size_t)ci * 8 + wid) * 16 * 64 + lane) * 4;
#pragma unroll
            for (int tt = 0; tt < 4; ++tt) {
                f32x16 acc = {};
                const int t = 32 * tt + r32;
#pragma unroll
                for (int ks8 = 0; ks8 < 8; ++ks8) if (ks8 <= 2 * tt + 1) {
                    const bf16x8 a = *(const LAS bf16x8*)(lds + OFF_ATT + t * 256 + (((16 * ks8 + 8 * hi) * 2) ^ ((t & 7) << 4)));
                    acc = __builtin_amdgcn_mfma_f32_32x32x16_bf16(a, vfr[ks8], acc, 0, 0, 0); }
#pragma unroll
                for (int r4 = 0; r4 < 4; ++r4) *(v4f*)(oi + (size_t)(tt * 4 + r4) * 256) = (v4f){acc[4 * r4], acc[4 * r4 + 1], acc[4 * r4 + 2], acc[4 * r4 + 3]};
            }
#pragma unroll
            for (int kt = 0; kt < 4; ++kt) {
                f32x16 D = {};
                const unsigned kaddr = (unsigned)(size_t)(lds + OFF_KLIMG) + (unsigned)at::v_rd_base(lane) + (unsigned)(kt * 512);
#define GL_KF(ks8) do { s16x4 l_, h_; constexpr int o_ = ((ks8) >> 2) * 16384 + ((ks8) & 3) * 4096; GL_TRRD(l_, kaddr, o_); GL_TRRD(h_, kaddr, o_ + 2048); \
                asm volatile("s_waitcnt lgkmcnt(0)" ::: "memory"); AT_SBAR(); \
                D = __builtin_amdgcn_mfma_f32_32x32x16_bf16((bf16x8){l_[0], l_[1], l_[2], l_[3], h_[0], h_[1], h_[2], h_[3]}, vfr[ks8], D, 0, 0, 0); } while (0)
                GL_KF(0); GL_KF(1); GL_KF(2); GL_KF(3); GL_KF(4); GL_KF(5); GL_KF(6); GL_KF(7);
#undef GL_KF
#pragma unroll
                for (int r4 = 0; r4 < 4; ++r4) *(v4f*)(dl + (size_t)(kt * 4 + r4) * 256) = (v4f){D[4 * r4], D[4 * r4 + 1], D[4 * r4 + 2], D[4 * r4 + 3]};
            }
            __syncthreads();
        }
    }
}

__device__ __forceinline__ void gla_stageA_item(const float* DS, const float* DL, bf16* XB, int b, int h, int vp) {
    const int tid = otid(), wid = __builtin_amdgcn_readfirstlane(tid >> 6), lane = tid & 63, hi = lane >> 5;
    const int vb = 2 * vp + (wid >> 2), kt = wid & 3;
    constexpr int PF = 4, NC = SEQ / 128;
    f32x16 X = {};
    v4f dq[PF][4], sq[PF][4];
    const size_t ci0 = (size_t)(b * 32) * 4 + h;
#define GL_ALOAD(slot, c_) do { const size_t ci_ = ci0 + (size_t)(c_) * 4; const float* dl_ = DL + ((ci_ * 8 + vb) * 16 * 64 + lane) * 4 + (size_t)(kt * 4) * 256; const float* ds_ = DS + ci_ * 128 + 32 * kt + 4 * hi; \
        _Pragma("unroll") for (int r4 = 0; r4 < 4; ++r4) { dq[slot][r4] = *(const v4f*)(dl_ + (size_t)r4 * 256); sq[slot][r4] = *(const v4f*)(ds_ + 8 * r4); } } while (0)
#pragma unroll
    for (int s = 0; s < PF; ++s) GL_ALOAD(s, s);
    for (int c0 = 0; c0 < NC; c0 += PF) {
#pragma unroll
        for (int s = 0; s < PF; ++s) {
            const int c = c0 + s; const size_t ci = ci0 + (size_t)c * 4;
            bf16* xo = XB + (((ci * 8 + vb) * 8 + kt * 2) * 64 + lane) * 8;
            bf16x8 xb0, xb1; GL_PK4(X, 0, xb0); GL_PK4(X, 8, xb1);
            *(bf16x8*)xo = xb0; *(bf16x8*)(xo + 512) = xb1;
#pragma unroll
            for (int r4 = 0; r4 < 4; ++r4) { const v4f w = dq[s][r4], d4 = sq[s][r4];
                X[4 * r4] = X[4 * r4] * d4.x + w.x; X[4 * r4 + 1] = X[4 * r4 + 1] * d4.y + w.y; X[4 * r4 + 2] = X[4 * r4 + 2] * d4.z + w.z; X[4 * r4 + 3] = X[4 * r4 + 3] * d4.w + w.w; }
            if (c + PF < NC) GL_ALOAD(s, c + PF);
        }
    }
#undef GL_ALOAD
}
__device__ __forceinline__ void gla_stageB_item(const bf16* proj, const bf16* QE, const float* OI, const bf16* XB, const float* og, bf16* YC, int b, int h, int cp) {
    const int tid = otid(), wid = __builtin_amdgcn_readfirstlane(tid >> 6), lane = tid & 63, r32 = lane & 31, hi = lane >> 5;
    {
        const int c = 2 * cp + (wid >> 2), tt = wid & 3, R0 = b * SEQ + c * 128;
        const size_t ci = (size_t)(b * 32 + c) * 4 + h;
        f32x16 acc[8];
#pragma unroll
        for (int vb = 0; vb < 8; ++vb) { const float* oi = OI + ((ci * 8 + vb) * 16 * 64 + lane) * 4 + (size_t)(tt * 4) * 256;
#pragma unroll
            for (int r4 = 0; r4 < 4; ++r4) { const v4f w = *(const v4f*)(oi + (size_t)r4 * 256); acc[vb][4 * r4] = w.x; acc[vb][4 * r4 + 1] = w.y; acc[vb][4 * r4 + 2] = w.z; acc[vb][4 * r4 + 3] = w.w; } }
        bf16x8 qa[8];
        { const bf16* qp = QE + (size_t)(R0 + 32 * tt + r32) * 512 + h * 128 + hi * 8;
#pragma unroll
          for (int ks = 0; ks < 8; ++ks) qa[ks] = *(const bf16x8*)(qp + ks * 16); }
        if (c > 0) {
            const bf16* xi = XB + (((ci * 8) * 8) * 64 + lane) * 8;
            bf16x8 xf[64];
#pragma unroll
            for (int i = 0; i < 64; ++i) xf[i] = *(const bf16x8*)(xi + (size_t)i * 512);
#pragma unroll
            for (int i = 0; i < 64; ++i) acc[i >> 3] = __builtin_amdgcn_mfma_f32_32x32x16_bf16(qa[i & 7], xf[i], acc[i >> 3], 0, 0, 0);
            __builtin_amdgcn_sched_group_barrier(0x020, 16, 0);
#pragma unroll
            for (int i = 0; i < 48; ++i) { __builtin_amdgcn_sched_group_barrier(0x008, 1, 0); __builtin_amdgcn_sched_group_barrier(0x020, 1, 0); }
            __builtin_amdgcn_sched_group_barrier(0x008, 16, 0);
        }
        float rn[16];
#pragma unroll
        for (int r = 0; r < 16; ++r) { float s = 0.f;
#pragma unroll
            for (int vb = 0; vb < 8; ++vb) s += acc[vb][r] * acc[vb][r];
            s += lane_xor<1>(s); s += lane_xor<2>(s); s += lane_xor<4>(s); s += lane_xor<8>(s); s += lane_xor<16>(s);
            rn[r] = 1.0f / sqrtf(s * (1.0f / 256.f) + EPS); }
#pragma unroll
        for (int vb = 0; vb < 8; ++vb) { const float gcol = og[32 * vb + r32];
            unsigned short zr[16];
#pragma unroll
            for (int r = 0; r < 16; ++r) zr[r] = proj[(size_t)(R0 + 32 * tt + at::crow(r, hi)) * NPROJ + C_ZC + h * 256 + 32 * vb + r32];
#pragma unroll
            for (int r = 0; r < 16; ++r) { const size_t row = (size_t)(R0 + 32 * tt + at::crow(r, hi));
                const float y = acc[vb][r] * rn[r] * gcol * silu_f(bf2f(zr[r])), yn = lane_xor<1>(y);
                if ((r32 & 1) == 0) *(unsigned*)(YC + row * 1024 + h * 256 + 32 * vb + r32) = at::cvtpk(y, yn); } }
    }
}
#undef GL_PK4
#undef GL_TRRD
}


constexpr int CW_Q = 65536;
__device__ __forceinline__ int q_pop(unsigned* ctr, LAS unsigned* slot) {
    if (otid() == 0) *slot = __hip_atomic_fetch_add(ctr, 1u, __ATOMIC_RELAXED, __HIP_MEMORY_SCOPE_AGENT);
    __syncthreads(); const int v = (int)*slot; __syncthreads(); return v; }
__device__ __forceinline__ void ph_mixers(LAS unsigned char* lds, unsigned char* ws, unsigned* qctr, const float* Ws, const float* bs, const float* vg, const float* og, int vb) {
    constexpr int NGLA = NBP * 8, NATT = 16 * NBP, NSGU = 16 * NBP, NQ = NGLA + NATT + NSGU;
    static_assert(NBP % 2 == 0, "NBP even");
    LAS unsigned* slot = (LAS unsigned*)(lds + LDSCTL_OFF + 64);
    bf16* proj = (bf16*)(ws + WS_PROJ);
    for (int dq = 0; dq < 8; ++dq) {
        const int q = (vb + dq) & 7;
        for (;;) {
            const int idx = q_pop(qctr + q * 64, slot);
            if (idx >= NQ) break;
            if (idx >= NATT && idx < NATT + NGLA) { const int gi = q * NGLA + (idx - NATT), bh = gi >> 4, cp = gi & 15;
                gl::gla_stageB_item(proj, (const bf16*)(ws + WS_QE), (const float*)(ws + WS_OC), (const bf16*)(ws + WS_XB), og, (bf16*)(ws + WS_YC), bh >> 2, bh & 3, cp); }
            else if (idx < NATT) { const int j = idx, qb = 15 - j / NBP, bh = q * NBP + j % NBP;
                at::attn_block(lds, (const bf16*)(ws + WS_Q), (const bf16*)(ws + WS_K), (const bf16*)(ws + WS_KV), proj, (bf16*)(ws + WS_YA), bh >> 3, bh & 7, qb); }
            else { const int it = q * NSGU + (idx - NGLA - NATT);
                sg::sgu_item(lds, proj, (const float*)(ws + WS_RV), Ws, bs, vg, (bf16*)(ws + WS_YB), it); }
        }
    }
}
typedef const __attribute__((address_space(4))) Args* KArgP;
#define KARG() ({ KArgP p_ = (KArgP)__builtin_amdgcn_kernarg_segment_ptr(); asm volatile("" : "+s"(p_)); p_; })
#define INF(i) ((const float*)ap->in[i])
__device__ __forceinline__ void grid_bar(const XcdBarrier& b0) { XcdBarrier b = b0; asm volatile("" : "+s"(b.bar)); xcd_barrier(b); }

__global__ void __launch_bounds__(512, 2) fwd(Args a) {
    extern __shared__ __attribute__((aligned(16))) unsigned char lds_raw[];
    LAS unsigned char* lds = (LAS unsigned char*)lds_raw;
    const int lo = a.lo, hi = a.hi;
    XcdBarrier bar; bar.bar = (unsigned*)(a.ws + WS_CTL) + CW_BAR; bar.x = 0; bar.st = nullptr;
    if (hi - lo > 1) {
        if (threadIdx.x < 4) ((LAS unsigned*)(lds + LDSCTL_OFF))[threadIdx.x] = 0u;
        __syncthreads();
        bar = xcd_barrier_post((unsigned*)(a.ws + WS_CTL) + CW_BAR, (volatile LAS unsigned*)(lds + LDSCTL_OFF));
    }
    int step = 0;
#define PH_BEGIN if (step >= lo && step < hi) { const KArgP ap = KARG(); unsigned char* const ws = ap->ws; const int vb = obid(), nvb = gridDim.x; (void)ws; (void)vb; (void)nvb;
#define PH_END   if (step + 1 < hi) grid_bar(bar); } ++step;
#define WL(l) (ws + WS_W + (size_t)(l) * SZ_WLAYER)
#define B_(T, off) ((T*)(ws + (off)))

    for (int l = 0; l < DEPTH; ++l) {
        PH_BEGIN
            { unsigned char* wl = ws + WS_W;
              convert_T<1>(INF(3) + (size_t)l * DM * IN_COLS, DM, IN_COLS, (bf16*)wl, NPROJ, (LAS float*)lds, vb, nvb);
              convert_T<0>(INF(6) + (size_t)l * 512 * 1536, 512, 1536, (bf16*)(wl + SZ_WIN), 1536, (LAS float*)lds, (vb + 64) % nvb, nvb);
              convert_T<0>(INF(7) + (size_t)l * 512 * 2048, 512, 2048, (bf16*)(wl + SZ_WIN + SZ_WUQ), 2048, (LAS float*)lds, (vb + 128) % nvb, nvb);
              for (int b = 0; b < 3; ++b)
                  convert_T<0>(INF(16) + ((size_t)l * 3 + b) * 1024 * 2048, 1024, 2048, (bf16*)(wl + SZ_WIN + SZ_WUQ + SZ_WUKV) + (size_t)b * 2048 * 1024, 2048, (LAS float*)lds, (vb + 32 * b) % nvb, nvb);
              convert_T<0>(INF(17) + (size_t)l * 2048 * 2048, 2048, 2048, (bf16*)(wl + SZ_WIN + SZ_WUQ + SZ_WUKV + SZ_WB), 2048, (LAS float*)lds, (vb + 192) % nvb, nvb); }
            if (l == 0) { const int* positions = (const int*)ap->in[1]; float* cosT = B_(float, WS_COS); float* sinT = B_(float, WS_SIN);
              for (int idx = vb * 512 + otid(); idx < MTOK * 32; idx += nvb * 512) {
                const int t = idx >> 5, i = idx & 31;
                const float inv = 1.0f / powf(10000.0f, (float)(2 * i) * (1.0f / 64.0f));
                const float ang = (float)positions[t] * inv;
                float sn, cs; sincosf(ang, &sn, &cs);
                cosT[idx] = cs; sinT[idx] = sn; } }
        PH_END
        for (int p = 0; p < NPASS; ++p) {
            const int row0 = p * MP;
#define XIN ((l == 0 ? (const float*)ap->in[0] : (const float*)ap->out) + (size_t)row0 * DM)
#define WLP (ws + WS_W)
            PH_BEGIN ph_norm(XIN, INF(2) + l * DM, B_(bf16, WS_H), MP, vb, nvb); PH_END
            PH_BEGIN { pg8::Gemm g{B_(bf16, WS_H), (const bf16*)WLP, MP, NPROJ, DM}; pg8::StaticOrder S; S.init(MP, NPROJ, nvb, vb); pg8::EpiBf16<0> E{B_(bf16, WS_PROJ), NPROJ, nullptr, 0, 0};
                       pg8::gemm_phase<pg8::EpiBf16<0>, pg8::StaticOrder>(lds, g, S, E, nullptr); } PH_END
            PH_BEGIN ph_prep(B_(bf16, WS_PROJ), INF(4) + l * 512, INF(5) + l * 512, B_(bf16, WS_CQN), B_(bf16, WS_CKVN), B_(float, WS_RV), vb, nvb);
                     gl::ph_gla_prep(lds, B_(bf16, WS_PROJ), INF(13) + l * 16 * 512, INF(14) + l * 512, B_(bf16, WS_QE), B_(bf16, WS_KE), B_(bf16, WS_KL), B_(float, WS_DS), vb, nvb); PH_END
            PH_BEGIN { { pg8::Gemm g{B_(bf16, WS_CQN), (const bf16*)(WLP + SZ_WIN), MP, 1536, 512}; pg8::StaticOrder S; S.init(MP, 1536, nvb, vb); pg8::EpiBf16<0> E{B_(bf16, WS_Q), 1536, nullptr, 0, 0};
                         pg8::gemm_phase<pg8::EpiBf16<0>, pg8::StaticOrder>(lds, g, S, E, nullptr); }
                       { pg8::Gemm g{B_(bf16, WS_CKVN), (const bf16*)(WLP + SZ_WIN + SZ_WUQ), MP, 2048, 512}; pg8::StaticOrder S; S.init(MP, 2048, nvb, nvb - 1 - vb); pg8::EpiBf16<0> E{B_(bf16, WS_KV), 2048, nullptr, 0, 0};
                         pg8::gemm_phase<pg8::EpiBf16<0>, pg8::StaticOrder>(lds, g, S, E, nullptr); }
                       for (int ci = vb; ci < (MP / 128) * 4; ci += nvb) gl::gla_chunk_item(lds, B_(bf16, WS_PROJ), B_(bf16, WS_QE), B_(bf16, WS_KE), B_(bf16, WS_KL), B_(float, WS_OC), B_(float, WS_DL), ci); } PH_END
            PH_BEGIN for (int it = vb; it < NBP * 4 * 4; it += nvb) gl::gla_stageA_item(B_(float, WS_DS), B_(float, WS_DL), B_(bf16, WS_XB), it >> 4, (it >> 2) & 3, it & 3);
                     ph_qkfin(B_(bf16, WS_Q), B_(bf16, WS_KV), B_(bf16, WS_PROJ), B_(bf16, WS_K), INF(8) + l * 192, INF(9) + l * 192, B_(float, WS_COS), B_(float, WS_SIN), row0, vb, nvb); PH_END
            PH_BEGIN ph_mixers(lds, ws, (unsigned*)(ws + WS_CTL) + CW_Q + (l * NPASS + p) * 8 * 64, INF(11) + (size_t)l * 8 * 128 * 128, INF(12) + l * 8 * 128, INF(10) + l * 1024, INF(15) + l * 256, vb); PH_END
            PH_BEGIN for (int b = 0; b < 3; ++b) { pg8::Gemm g{b == 0 ? B_(bf16, WS_YA) : (b == 1 ? B_(bf16, WS_YB) : B_(bf16, WS_YC)), (const bf16*)(WLP + SZ_WIN + SZ_WUQ + SZ_WUKV) + (size_t)b * 2048 * 1024, MP, 2048, 1024};
                       pg8::StaticOrder S; S.init(MP, 2048, nvb, vb);
                       pg8::EpiMerge E{B_(bf16, WS_PROJ) + C_GATE + b * 2048, NPROJ, B_(bf16, WS_MG), 2048, b == 0 ? 1 : 0}; pg8::gemm_phase<pg8::EpiMerge, pg8::StaticOrder>(lds, g, S, E, nullptr); } PH_END
            PH_BEGIN { pg8::Gemm g{B_(bf16, WS_MG), (const bf16*)(WLP + SZ_WIN + SZ_WUQ + SZ_WUKV + SZ_WB), MP, 2048, 2048}; pg8::StaticOrder S; S.init(MP, 2048, nvb, vb); pg8::EpiRes E{XIN, ap->out + (size_t)row0 * DM, 2048};
                       pg8::gemm_phase<pg8::EpiRes, pg8::StaticOrder>(lds, g, S, E, nullptr); } PH_END
        }
    }
#undef PH_BEGIN
#undef PH_END
}

#ifndef ONE_LAUNCH
#define ONE_LAUNCH 1
#endif
extern "C" void kernel_launch(void* const* d_in, const int* in_sizes, int n_in, void* d_out, int out_size, void* d_ws, size_t ws_size, hipStream_t stream) {
    static int grid = 0;
    if (grid == 0) {
        if (n_in != 18 || out_size != MTOK * DM || ws_size < WS_END) { fprintf(stderr, "kernel_launch: unexpected shapes (n_in %d out %d ws %zu need %zu)\n", n_in, out_size, ws_size, (size_t)WS_END); grid = -1; return; }
        int dev = 0, cus = 0, per_cu = 0;
        if (hipGetDevice(&dev) != hipSuccess || hipDeviceGetAttribute(&cus, hipDeviceAttributeMultiprocessorCount, dev) != hipSuccess) { grid = -1; return; }
        if (hipFuncSetAttribute((const void*)fwd, hipFuncAttributeMaxDynamicSharedMemorySize, LDS_BYTES) != hipSuccess) { fprintf(stderr, "kernel_launch: hipFuncSetAttribute failed\n"); grid = -1; return; }
        if (hipOccupancyMaxActiveBlocksPerMultiprocessor(&per_cu, (const void*)fwd, 512, LDS_BYTES) != hipSuccess || per_cu < 1) { fprintf(stderr, "kernel_launch: occupancy query says %d\n", per_cu); }
        (void)hipGetLastError();
        grid = cus;
    }
    if (grid < 0) return;
    (void)hipMemsetAsync((char*)d_ws + WS_CTL, 0, CTL_BYTES, stream);
    Args a{};
    for (int i = 0; i < 18; ++i) a.in[i] = d_in[i];
    a.out = (float*)d_out; a.ws = (unsigned char*)d_ws; a.pad0 = 0; a.pad1 = 0;
#if ONE_LAUNCH
    a.lo = 0; a.hi = NSTEPS;
    hipLaunchKernelGGL(fwd, dim3(grid), dim3(512), LDS_BYTES, stream, a);
#else
    for (int s = 0; s < NSTEPS; ++s) { a.lo = s; a.hi = s + 1; hipLaunchKernelGGL(fwd, dim3(grid), dim3(512), LDS_BYTES, stream, a); }
#endif
}
```

```cpp
#include <hip/hip_runtime.h>
#include <cstdio>
#include <cstdint>
__device__ __forceinline__ int otid() { int t = threadIdx.x; asm volatile("" : "+v"(t)); return t; }
__device__ __forceinline__ int obid() { int t = blockIdx.x; asm volatile("" : "+s"(t)); return t; }
namespace pg8 {
#define PG8_LAS __attribute__((address_space(3)))
typedef unsigned short bf16_t;
typedef short bf16x8 __attribute__((ext_vector_type(8)));
typedef float f32x4 __attribute__((ext_vector_type(4)));
typedef unsigned u32x4 __attribute__((ext_vector_type(4)));
constexpr int BM = 256, BK = 64, HALF = 128, HTB = HALF * BK * 2  , STAGE_BYTES = 8 * HTB, NXCD = 8, WGM = 4;

__host__ __device__ __forceinline__ int lds_byte(int r, int c) { const int st = (r >> 4) * 2 + (c >> 5), rr = r & 15, cc = c & 31, ob = rr * 64 + cc * 2; return st * 1024 + (ob ^ (((ob >> 9) & 1) << 5)); }
__host__ __device__ __forceinline__ void stage_rc(int b, int& R, int& C) { const int st = b / 1024, sb = b % 1024, swz = sb ^ (((sb >> 9) & 1) << 5); R = (st >> 1) * 16 + swz / 64; C = (st & 1) * 32 + (swz % 64) / 2; }
__host__ __device__ __forceinline__ int perm32(int rho) { const int n = rho >> 4, i = rho & 15; return 8 * (i >> 2) + 4 * n + (i & 3); }

struct Unit { int pm, pn, pb; };
struct Gemm { const bf16_t* A; const bf16_t* Bt; int M, N, K; };

struct StaticOrder {
    int nM, nN, nwg, G, c;
    __host__ __device__ void init(int M, int N, int G_, int c_) { nM = M / BM; nN = N / BM; nwg = nM * nN; G = G_; c = c_; }
    __host__ __device__ bool next(int i, Unit& u) const {
        const long L = (long)i * G + c; if (L >= nwg) return false;
        int wgid = (int)L; { const int q = nwg / NXCD, r = nwg % NXCD, xcd = wgid % NXCD, off = wgid / NXCD; wgid = (xcd < r ? xcd * (q + 1) : r * (q + 1) + (xcd - r) * q) + off; }
        const int nig = WGM * nN, gid = wgid / nig, fm = gid * WGM, gsz = (nM - fm) < WGM ? (nM - fm) : WGM;
        u.pm = fm + ((wgid % nig) % gsz); u.pn = (wgid % nig) / gsz; u.pb = 0; return true;
    }
    __device__ __forceinline__ size_t a_off(const Unit&) const { return 0; }
    __device__ __forceinline__ size_t b_off(const Unit&) const { return 0; }
    __device__ __forceinline__ void a_ready(const Unit&) const {}
    __device__ __forceinline__ void done(const Unit&) const {}
};

struct BranchOrder : StaticOrder {
    int NB; size_t a_stride, b_stride;
    __device__ bool next(int i, Unit& u) const { const int ti = i / NB; if (!StaticOrder::next(ti, u)) return false; u.pb = i - ti * NB; return true; }
    __device__ __forceinline__ size_t a_off(const Unit& u) const { return (size_t)u.pb * a_stride; }
    __device__ __forceinline__ size_t b_off(const Unit& u) const { return (size_t)u.pb * b_stride; }
};

__device__ __forceinline__ unsigned cvt_pk_bf16(float lo, float hi) { unsigned r; asm volatile("v_cvt_pk_bf16_f32 %0, %1, %2" : "=v"(r) : "v"(lo), "v"(hi)); return r; }
typedef float f32x2 __attribute__((ext_vector_type(2)));
__device__ __forceinline__ f32x2 gelu_pk(f32x2 v) {
    const f32x2 av = __builtin_elementwise_abs(v), d = av * 0.2316418882f + 1.0f;
    f32x2 t; t.x = __builtin_amdgcn_rcpf(d.x); t.y = __builtin_amdgcn_rcpf(d.y);
    f32x2 q = t * 0.5307027145f + (-0.7265760135f); q = q * t + 0.7107068705f; q = q * t + (-0.142248368f); q = q * t + 0.127414796f; q = q * t;
    const f32x2 s = (v * v) * (-0.72134752044f);
    f32x2 e; e.x = __builtin_amdgcn_exp2f(s.x); e.y = __builtin_amdgcn_exp2f(s.y);
    const f32x2 m = v * (q * e), r = v - m;
    f32x2 o; o.x = v.x < 0.f ? m.x : r.x; o.y = v.y < 0.f ? m.y : r.y; return o;
}

struct EpiF32 {
    static constexpr bool PERM = false, AFTER_DRAIN = false;
    float* C; int ldc; const float* bias;
    __device__ __forceinline__ void operator()(const f32x4 (&acc)[2][2][4][2], const Unit& u, int wr, int wc, int fr, int fq) const {
        const int row0 = u.pm * BM + wr * 64 + fr, col0 = u.pn * BM + wc * 32 + 4 * fq;
        f32x4 bv[2][2];
#pragma unroll
        for (int bj = 0; bj < 2; ++bj)
#pragma unroll
            for (int n = 0; n < 2; ++n) bv[bj][n] = bias ? *(const f32x4*)(bias + col0 + bj * HALF + n * 16) : (f32x4){0.f, 0.f, 0.f, 0.f};
#pragma unroll
        for (int ai = 0; ai < 2; ++ai)
#pragma unroll
            for (int m = 0; m < 4; ++m) { float* rowp = C + (size_t)(row0 + ai * HALF + m * 16) * ldc + col0;
#pragma unroll
                for (int bj = 0; bj < 2; ++bj)
#pragma unroll
                    for (int n = 0; n < 2; ++n) *(f32x4*)(rowp + bj * HALF + n * 16) = acc[ai][bj][m][n] + bv[bj][n]; }
    }
};
template <int ACT  > struct EpiBf16 {
    static constexpr bool PERM = true, AFTER_DRAIN = false;
    bf16_t* O; int ldc; const float* bias; int split_cols; size_t split_stride;
    __device__ __forceinline__ void operator()(const f32x4 (&acc)[2][2][4][2], const Unit& u, int wr, int wc, int fr, int fq) const {
        const int row0 = u.pm * BM + wr * 64 + fr; int colt = u.pn * BM; bf16_t* base = O;
        if (split_cols) { const int t = colt / split_cols; base += (size_t)t * split_stride; colt -= t * split_cols; }
        const int col0 = colt + wc * 32 + 8 * fq, bcol0 = u.pn * BM + wc * 32 + 8 * fq;
        f32x4 bv[2][2];
#pragma unroll
        for (int bj = 0; bj < 2; ++bj)
#pragma unroll
            for (int n = 0; n < 2; ++n) bv[bj][n] = bias ? *(const f32x4*)(bias + bcol0 + bj * HALF + 4 * n) : (f32x4){0.f, 0.f, 0.f, 0.f};
#pragma unroll
        for (int ai = 0; ai < 2; ++ai)
#pragma unroll
            for (int m = 0; m < 4; ++m) { bf16_t* rowp = base + (size_t)(row0 + ai * HALF + m * 16) * ldc + col0;
#pragma unroll
                for (int bj = 0; bj < 2; ++bj) { f32x4 v0 = acc[ai][bj][m][0] + bv[bj][0], v1 = acc[ai][bj][m][1] + bv[bj][1];
                    if (ACT == 1) { f32x2 a = gelu_pk((f32x2){v0[0], v0[1]}), b = gelu_pk((f32x2){v0[2], v0[3]}), c = gelu_pk((f32x2){v1[0], v1[1]}), d = gelu_pk((f32x2){v1[2], v1[3]});
                        v0 = (f32x4){a.x, a.y, b.x, b.y}; v1 = (f32x4){c.x, c.y, d.x, d.y}; }
                    if (ACT == 2) {
#pragma unroll
                        for (int j = 0; j < 4; ++j) { v0[j] = 0.5f * v0[j] * (1.0f + erff(v0[j] * 0.70710678f)); v1[j] = 0.5f * v1[j] * (1.0f + erff(v1[j] * 0.70710678f)); } }
                    u32x4 w; w.x = cvt_pk_bf16(v0[0], v0[1]); w.y = cvt_pk_bf16(v0[2], v0[3]); w.z = cvt_pk_bf16(v1[0], v1[1]); w.w = cvt_pk_bf16(v1[2], v1[3]);
                    *(u32x4*)(rowp + bj * HALF) = w; } }
    }
};


struct EpiRes {
    static constexpr bool PERM = false, AFTER_DRAIN = false;
    const float* base; float* C; int ldc;
    __device__ __forceinline__ void operator()(const f32x4 (&acc)[2][2][4][2], const Unit& u, int wr, int wc, int fr, int fq) const {
        const int row0 = u.pm * BM + wr * 64 + fr, col0 = u.pn * BM + wc * 32 + 4 * fq;
#pragma unroll
        for (int ai = 0; ai < 2; ++ai) {
            f32x4 bs[4][2][2];
#pragma unroll
            for (int m = 0; m < 4; ++m) { const size_t off = (size_t)(row0 + ai * HALF + m * 16) * ldc + col0;
#pragma unroll
                for (int bj = 0; bj < 2; ++bj)
#pragma unroll
                    for (int n = 0; n < 2; ++n) bs[m][bj][n] = *(const f32x4*)(base + off + bj * HALF + n * 16); }
#pragma unroll
            for (int m = 0; m < 4; ++m) { const size_t off = (size_t)(row0 + ai * HALF + m * 16) * ldc + col0;
#pragma unroll
                for (int bj = 0; bj < 2; ++bj)
#pragma unroll
                    for (int n = 0; n < 2; ++n) *(f32x4*)(C + off + bj * HALF + n * 16) = acc[ai][bj][m][n] + bs[m][bj][n]; }
            asm volatile("" ::: "memory");
        }
    }
};
struct EpiMerge {
    static constexpr bool PERM = true, AFTER_DRAIN = false;
    const bf16_t* G0; int ldg; bf16_t* MG; int ldc; int gstride;
    __device__ __forceinline__ void operator()(const f32x4 (&acc)[2][2][4][2], const Unit& u, int wr, int wc, int fr, int fq) const {
        const int row0 = u.pm * BM + wr * 64 + fr, col0 = u.pn * BM + wc * 32 + 8 * fq; const bf16_t* G = G0 + (size_t)u.pb * gstride; const bool first = u.pb == 0;
#pragma unroll
        for (int ai = 0; ai < 2; ++ai) {
            u32x4 gw[4][2], ow[4][2];
#pragma unroll
            for (int m = 0; m < 4; ++m) { const size_t row = (size_t)(row0 + ai * HALF + m * 16);
#pragma unroll
                for (int bj = 0; bj < 2; ++bj) { gw[m][bj] = *(const u32x4*)(G + row * ldg + col0 + bj * HALF); ow[m][bj] = first ? (u32x4){0u, 0u, 0u, 0u} : *(const u32x4*)(MG + row * ldc + col0 + bj * HALF); } }
#pragma unroll
            for (int m = 0; m < 4; ++m) { const size_t row = (size_t)(row0 + ai * HALF + m * 16);
#pragma unroll
                for (int bj = 0; bj < 2; ++bj) { const f32x4 v0 = acc[ai][bj][m][0], v1 = acc[ai][bj][m][1];
                    const unsigned g4[4] = {gw[m][bj].x, gw[m][bj].y, gw[m][bj].z, gw[m][bj].w}, o4[4] = {ow[m][bj].x, ow[m][bj].y, ow[m][bj].z, ow[m][bj].w};
                    const float a8[8] = {v0[0], v0[1], v0[2], v0[3], v1[0], v1[1], v1[2], v1[3]};
                    unsigned w4[4];
#pragma unroll
                    for (int q = 0; q < 4; ++q) {
                        const float g0 = __uint_as_float(g4[q] << 16), g1 = __uint_as_float(g4[q] & 0xffff0000u);
                        const float r0 = __uint_as_float(o4[q] << 16) + a8[2 * q] * __builtin_amdgcn_rcpf(1.0f + __expf(-g0));
                        const float r1 = __uint_as_float(o4[q] & 0xffff0000u) + a8[2 * q + 1] * __builtin_amdgcn_rcpf(1.0f + __expf(-g1));
                        unsigned pk; asm("v_cvt_pk_bf16_f32 %0, %1, %2" : "=v"(pk) : "v"(r0), "v"(r1)); w4[q] = pk; }
                    *(u32x4*)(MG + row * ldc + col0 + bj * HALF) = (u32x4){w4[0], w4[1], w4[2], w4[3]}; } }
            asm volatile("" ::: "memory");
        }
    }
};

template <class Epi, class Sched, bool STAMP = false, bool ALIGN_EPI = false, bool SP2 = false>
__device__ __forceinline__ void gemm_phase(PG8_LAS unsigned char* lds, const Gemm g, const Sched& S, const Epi& E, unsigned long long* stamps) {
    const int tid = otid(), wid = __builtin_amdgcn_readfirstlane(tid >> 6), lane = tid & 63, wr = wid >> 2, wc = wid & 3, fr = lane & 15, fq = lane >> 4;
    const int K = g.K, nt = K / BK;
    int ts_lo = 0, ts_hi = 0, nts = 0; const unsigned long long rt_entry = STAMP ? (unsigned long long)wall_clock64() : 0ull;
#define PG8_STAMP() do { if (STAMP && wid == 0 && nts < 64) { const unsigned long long _c = (unsigned long long)clock64(); \
        ts_lo = (lane == nts) ? (int)(unsigned)_c : ts_lo; ts_hi = (lane == nts) ? (int)(unsigned)(_c >> 32) : ts_hi; ++nts; } } while (0)
    PG8_STAMP();
    unsigned voffA[2], voffB[2];
#pragma unroll
    for (int i = 0; i < 2; ++i) { int R, C; stage_rc(tid * 16 + i * 8192, R, C); const int Rb = Epi::PERM ? ((R & ~31) + perm32(R & 31)) : R;
        voffA[i] = (unsigned)(R * K + C) * 2u; voffB[i] = (unsigned)(Rb * K + C) * 2u; }
    const size_t kstep = (size_t)(BK * 2);
    const size_t hstep = (size_t)HALF * K * 2;
    const size_t tstep = 2 * hstep;
    const unsigned ldsw = (unsigned)wid * 1024u;
    const int aoff = lds_byte(wr * 64 + fr, fq * 8), boff = lds_byte(wc * 32 + fr, fq * 8);
#define PG8_SA(b, h) (((b) * 2 + (h)) * HTB)
#define PG8_SB(b, h) ((4 + (b) * 2 + (h)) * HTB)
#define PG8_STAGE(bufoff, gbase, voff) do { _Pragma("unroll") for (int _i = 0; _i < 2; ++_i) \
        __builtin_amdgcn_global_load_lds((const unsigned*)((const char*)(gbase) + (voff)[_i]), (PG8_LAS unsigned*)(lds + (bufoff) + ldsw + _i * 8192), 16, 0, 0); } while (0)
#define PG8_LDA(dst, b, h) do { _Pragma("unroll") for (int m = 0; m < 4; ++m) _Pragma("unroll") for (int k = 0; k < 2; ++k) dst[m][k] = *(const PG8_LAS bf16x8*)(lds + PG8_SA(b, h) + aoff + m * 2048 + k * 1024); } while (0)
#define PG8_LDB(dst, b, h) do { _Pragma("unroll") for (int n = 0; n < 2; ++n) _Pragma("unroll") for (int k = 0; k < 2; ++k) dst[n][k] = *(const PG8_LAS bf16x8*)(lds + PG8_SB(b, h) + boff + n * 2048 + k * 1024); } while (0)
#define PG8_MMA(ai, bj, At, Bt) do { __builtin_amdgcn_s_setprio(1); _Pragma("unroll") for (int m = 0; m < 4; ++m) _Pragma("unroll") for (int n = 0; n < 2; ++n) _Pragma("unroll") for (int k = 0; k < 2; ++k) \
        acc[ai][bj][m][n] = __builtin_amdgcn_mfma_f32_16x16x32_bf16(Bt[n][k], At[m][k], acc[ai][bj][m][n], 0, 0, 0); __builtin_amdgcn_s_setprio(0); } while (0)
#define PG8_WAIT_V(n) asm volatile("s_waitcnt vmcnt(" #n ")" ::: "memory")
#define PG8_WAIT_L(n) asm volatile("s_waitcnt lgkmcnt(" #n ")" ::: "memory")
#define PG8_BAR __builtin_amdgcn_s_barrier()
#define PG8_SCHED __builtin_amdgcn_sched_barrier(0)
    Unit cur, nxt; int ui = 0;
    if (!S.next(0, cur)) return;
    f32x4 acc[2][2][4][2];
#pragma unroll
    for (int a = 0; a < 2; ++a)
#pragma unroll
        for (int b = 0; b < 2; ++b)
#pragma unroll
            for (int m = 0; m < 4; ++m)
#pragma unroll
                for (int n = 0; n < 2; ++n) acc[a][b][m][n] = (f32x4){0.f, 0.f, 0.f, 0.f};
    bf16x8 At[4][2], B0[2][2], B1[2][2];
    const char* cA = (const char*)g.A + (size_t)cur.pm * tstep + S.a_off(cur); const char* cB = (const char*)g.Bt + (size_t)cur.pn * tstep + S.b_off(cur);
    S.a_ready(cur);
    if constexpr (SP2) {
        PG8_STAGE(PG8_SB(0, 0), cB, voffB); PG8_STAGE(PG8_SB(0, 1), cB + hstep, voffB); PG8_STAGE(PG8_SA(0, 0), cA, voffA); PG8_STAGE(PG8_SA(0, 1), cA + hstep, voffA);
        if (wr == 1) PG8_BAR;
        PG8_WAIT_V(2); PG8_BAR;
        PG8_STAGE(PG8_SB(1, 0), cB + kstep, voffB); PG8_STAGE(PG8_SA(1, 0), cA + kstep, voffA); PG8_STAGE(PG8_SB(1, 1), cB + hstep + kstep, voffB);
        PG8_WAIT_V(6); PG8_BAR;
    } else {
    PG8_STAGE(PG8_SB(0, 0), cB, voffB); PG8_STAGE(PG8_SA(0, 0), cA, voffA); PG8_STAGE(PG8_SB(0, 1), cB + hstep, voffB); PG8_STAGE(PG8_SA(0, 1), cA + hstep, voffA);
    if (wr == 1) PG8_BAR;
    PG8_WAIT_V(4); PG8_BAR;
    PG8_STAGE(PG8_SB(1, 0), cB + kstep, voffB); PG8_STAGE(PG8_SA(1, 0), cA + kstep, voffA); PG8_STAGE(PG8_SB(1, 1), cB + hstep + kstep, voffB);
    PG8_WAIT_V(6); PG8_BAR;
    }
    PG8_STAMP();
    for (;;) {
        const bool has_next = S.next(ui + 1, nxt);
        const char* nA = has_next ? (const char*)g.A + (size_t)nxt.pm * tstep + S.a_off(nxt) : cA; const char* nB = has_next ? (const char*)g.Bt + (size_t)nxt.pn * tstep + S.b_off(nxt) : cB;
        for (int t = 0; t < nt; t += 2) {
            const bool last = (t == nt - 2);
            const char* a1 = cA + (size_t)(t + 1) * kstep;
            const char* a2 = last ? nA : cA + (size_t)(t + 2) * kstep; const char* b2 = last ? nB : cB + (size_t)(t + 2) * kstep;
            const char* a3 = a2 + kstep; const char* b3 = b2 + kstep;
            if (last && has_next) S.a_ready(nxt);
            if constexpr (SP2) {
            PG8_LDB(B0, 0, 0); PG8_LDB(B1, 0, 1); PG8_SCHED; PG8_LDA(At, 0, 0); PG8_STAGE(PG8_SA(1, 1), a1 + hstep, voffA);
            PG8_WAIT_V(8); PG8_WAIT_L(0); PG8_BAR; PG8_MMA(0, 0, At, B0); PG8_MMA(0, 1, At, B1); PG8_BAR; PG8_SCHED;
            PG8_LDA(At, 0, 1); PG8_STAGE(PG8_SB(0, 0), b2, voffB); PG8_STAGE(PG8_SB(0, 1), b2 + hstep, voffB); PG8_STAGE(PG8_SA(0, 0), a2, voffA);
            PG8_WAIT_V(8); PG8_WAIT_L(0); PG8_BAR; PG8_MMA(1, 0, At, B0); PG8_MMA(1, 1, At, B1); PG8_BAR; PG8_SCHED;
            PG8_LDB(B0, 1, 0); PG8_LDB(B1, 1, 1); PG8_SCHED; PG8_LDA(At, 1, 0); PG8_STAGE(PG8_SA(0, 1), a2 + hstep, voffA);
            PG8_WAIT_V(8); PG8_WAIT_L(0); PG8_BAR; PG8_MMA(0, 0, At, B0); PG8_MMA(0, 1, At, B1); PG8_BAR; PG8_SCHED;
            PG8_LDA(At, 1, 1); PG8_STAGE(PG8_SB(1, 0), b3, voffB); PG8_STAGE(PG8_SB(1, 1), b3 + hstep, voffB); PG8_STAGE(PG8_SA(1, 0), a3, voffA);
            PG8_WAIT_V(8); PG8_WAIT_L(0); PG8_BAR; PG8_MMA(1, 0, At, B0); PG8_MMA(1, 1, At, B1); PG8_BAR; PG8_SCHED;
            } else {
            PG8_LDB(B0, 0, 0); PG8_SCHED; PG8_LDA(At, 0, 0); PG8_STAGE(PG8_SA(1, 1), a1 + hstep, voffA);
            PG8_WAIT_L(8); PG8_BAR; PG8_WAIT_L(0); PG8_MMA(0, 0, At, B0); PG8_BAR; PG8_SCHED;
            PG8_LDB(B1, 0, 1); PG8_STAGE(PG8_SB(0, 0), b2, voffB);
            PG8_BAR; PG8_WAIT_L(0); PG8_MMA(0, 1, At, B1); PG8_BAR;
            PG8_LDA(At, 0, 1); PG8_STAGE(PG8_SA(0, 0), a2, voffA);
            PG8_BAR; PG8_WAIT_L(0); PG8_MMA(1, 0, At, B0); PG8_BAR; PG8_SCHED;
            PG8_STAGE(PG8_SB(0, 1), b2 + hstep, voffB);
            PG8_WAIT_V(6); PG8_BAR; PG8_MMA(1, 1, At, B1); PG8_BAR;
            PG8_LDB(B0, 1, 0); PG8_SCHED; PG8_LDA(At, 1, 0); PG8_STAGE(PG8_SA(0, 1), a2 + hstep, voffA);
            PG8_WAIT_L(8); PG8_BAR; PG8_WAIT_L(0); PG8_MMA(0, 0, At, B0); PG8_BAR; PG8_SCHED;
            PG8_LDB(B1, 1, 1); PG8_STAGE(PG8_SB(1, 0), b3, voffB);
            PG8_BAR; PG8_WAIT_L(0); PG8_MMA(0, 1, At, B1); PG8_BAR;
            PG8_LDA(At, 1, 1); PG8_STAGE(PG8_SA(1, 0), a3, voffA);
            PG8_BAR; PG8_WAIT_L(0); PG8_MMA(1, 0, At, B0); PG8_BAR; PG8_SCHED;
            PG8_STAGE(PG8_SB(1, 1), b3 + hstep, voffB);
            PG8_WAIT_V(6); PG8_BAR; PG8_MMA(1, 1, At, B1); PG8_BAR;
            }
        }
        if constexpr (ALIGN_EPI) { if (wr == 0) PG8_BAR; }
        PG8_STAMP();
        if constexpr (!Epi::AFTER_DRAIN) { E(acc, cur, wr, wc, fr, fq); S.done(cur); }
        PG8_STAMP();
        if (!has_next) break;
#pragma unroll
        for (int a = 0; a < 2; ++a)
#pragma unroll
            for (int b = 0; b < 2; ++b)
#pragma unroll
                for (int m = 0; m < 4; ++m)
#pragma unroll
                    for (int n = 0; n < 2; ++n) acc[a][b][m][n] = (f32x4){0.f, 0.f, 0.f, 0.f};
        cur = nxt; cA = nA; cB = nB; ++ui;
        if constexpr (ALIGN_EPI) { if (wr == 1) PG8_BAR; }
    }
    PG8_WAIT_V(0);
    if constexpr (!ALIGN_EPI) { if (wr == 0) PG8_BAR; }
    PG8_BAR;
    if constexpr (Epi::AFTER_DRAIN) { E.fused(acc, cur, wr, wc, fr, fq, lds, wid, lane); S.done(cur); }
    PG8_STAMP();
    if (STAMP && wid == 0) { stamps[lane] = lane < nts ? (((unsigned long long)(unsigned)ts_hi << 32) | (unsigned)ts_lo) : 0ull;
        if (lane == 62) stamps[62] = rt_entry; if (lane == 63) stamps[63] = (unsigned long long)wall_clock64(); }
#undef PG8_STAMP
#undef PG8_SA
#undef PG8_SB
#undef PG8_STAGE
#undef PG8_LDA
#undef PG8_LDB
#undef PG8_MMA
#undef PG8_WAIT_V
#undef PG8_WAIT_L
#undef PG8_BAR
#undef PG8_SCHED
}
}
#define XB_TMO      128
#define XB_XCNT(j)  (256  + 64 * (j))
#define XB_XSUB(j)  (1280 + 64 * (j))
#define XB_XGEN(j)  (2304 + 64 * (j))
#define XB_TOP      3328
#define XB_TOPGEN   3392
#define XCD_BAR_WORDS 3456
#define XB_SPIN_CAP (1u << 18)
#define LAS __attribute__((address_space(3)))

__device__ __forceinline__ unsigned xb_ld(unsigned* p)              { return __hip_atomic_load(p, __ATOMIC_RELAXED, __HIP_MEMORY_SCOPE_AGENT); }
__device__ __forceinline__ unsigned xb_add(unsigned* p, unsigned v) { return __hip_atomic_fetch_add(p, v, __ATOMIC_RELAXED, __HIP_MEMORY_SCOPE_AGENT); }
__device__ __forceinline__ unsigned xb_xcc_id() { return (unsigned)__builtin_amdgcn_s_getreg((3 << 11) | 20) & 0xFu; }
#define XB_SPIN(cond, bar) do { unsigned _sp = 0; while (cond) { __builtin_amdgcn_s_sleep(1); \
    if ((++_sp & 255u) == 0u) { if (xb_ld(&(bar)[XB_TMO])) break; if (_sp > XB_SPIN_CAP) { atomicAdd(&(bar)[XB_TMO], 1u); break; } } } } while (0)

struct XcdBarrier {
    unsigned* bar; unsigned x;
    volatile LAS unsigned* st;
};

__device__ __forceinline__ XcdBarrier xcd_barrier_post(unsigned* bar, volatile LAS unsigned* st) {
    XcdBarrier b; b.bar = bar; b.x = xb_xcc_id(); b.st = st;
    if (threadIdx.x == 0) (void)xb_add(&bar[XB_XCNT(b.x)], 1u);
    return b;
}
__device__ __forceinline__ void xcd_barrier_complete(unsigned* bar, unsigned x, unsigned& nloc, unsigned& nx) {
    const unsigned G = gridDim.x * gridDim.y * gridDim.z;
    unsigned sum, cnt, mine, sp = 0u;
    for (;;) {
        sum = 0u; cnt = 0u; mine = 0u;
#pragma unroll
        for (unsigned j = 0; j < 16; ++j) { const unsigned c = xb_ld(&bar[XB_XCNT(j)]); sum += c; cnt += (c > 0u) ? 1u : 0u; mine = (j == x) ? c : mine; }
        if (sum == G) break;
        __builtin_amdgcn_s_sleep(1);
        if ((++sp & 255u) == 0u) { if (xb_ld(&bar[XB_TMO])) break; if (sp > XB_SPIN_CAP) { atomicAdd(&bar[XB_TMO], 1u); break; } }
    }
    nloc = mine > 0u ? mine : 1u; nx = cnt > 0u ? cnt : 1u;
}

__device__ __forceinline__ void xcd_barrier(const XcdBarrier& b) {
    asm volatile("s_waitcnt vmcnt(0)" ::: "memory");
    __syncthreads();
    if (threadIdx.x == 0) {
        unsigned* bar = b.bar;
        __builtin_amdgcn_s_waitcnt(0);
        unsigned nloc = b.st[0], nx = b.st[1];
        if (nloc == 0u) { xcd_barrier_complete(bar, b.x, nloc, nx); b.st[0] = nloc; b.st[1] = nx; }
        const unsigned old = xb_add(&bar[XB_XSUB(b.x)], 1u);
        const unsigned gen = old / nloc;
        if (old + 1u == (gen + 1u) * nloc) {
            __builtin_amdgcn_fence(__ATOMIC_RELEASE, "agent");
            asm volatile("s_waitcnt vmcnt(0)" ::: "memory");
            const unsigned og = xb_add(&bar[XB_TOP], 1u);
            const unsigned tg = og / nx;
            if (og + 1u == (tg + 1u) * nx) xb_add(&bar[XB_TOPGEN], 1u);
            else XB_SPIN(xb_ld(&bar[XB_TOPGEN]) == tg, bar);
            __builtin_amdgcn_fence(__ATOMIC_ACQUIRE, "agent");
            xb_add(&bar[XB_XGEN(b.x)], 1u);
            asm volatile("s_waitcnt vmcnt(0)" ::: "memory");
        } else {
            XB_SPIN(xb_ld(&bar[XB_XGEN(b.x)]) == gen, bar);
            __builtin_amdgcn_fence(__ATOMIC_ACQUIRE, "agent");
            asm volatile("s_waitcnt vmcnt(0)" ::: "memory");
        }
    }
    __syncthreads();
}


typedef unsigned short bf16;
typedef unsigned v4u __attribute__((ext_vector_type(4)));
typedef unsigned v2u __attribute__((ext_vector_type(2)));
typedef float v4f __attribute__((ext_vector_type(4)));
typedef float v2f __attribute__((ext_vector_type(2)));

constexpr int DM = 2048, NBATCH = 8, SEQ = 4096, DEPTH = 2, MTOK = NBATCH * SEQ;
constexpr int IN_COLS = 14416, NPROJ = 14592;
constexpr int C_CQ = 0, C_CKV = 512, C_ZA = 1024, C_UB = 2048, C_VB = 3072, C_ZB = 4096, C_QC = 5120, C_KC = 5632, C_VC = 6144, C_ZC = 7168,
              C_GATE = 8192, C_KROPE = 14336, C_AR = 14400;
constexpr float EPS = 1e-6f;
#ifndef NBP
#define NBP 4
#endif
constexpr int MP = NBP * SEQ, NPASS = NBATCH / NBP;
constexpr int STEPS_PER_PASS = 8;
constexpr int NSTEPS = DEPTH * (1 + NPASS * STEPS_PER_PASS);

constexpr size_t al256(size_t x) { return (x + 255) & ~(size_t)255; }
constexpr size_t WS_CTL = 0, CTL_BYTES = 1u << 20;
constexpr size_t SZ_WIN = (size_t)NPROJ * DM * 2, SZ_WUQ = (size_t)1536 * 512 * 2, SZ_WUKV = (size_t)2048 * 512 * 2, SZ_WB = (size_t)3 * 2048 * 1024 * 2, SZ_WO = (size_t)2048 * 2048 * 2;
constexpr size_t SZ_WLAYER = SZ_WIN + SZ_WUQ + SZ_WUKV + SZ_WB + SZ_WO;
constexpr size_t WS_W = CTL_BYTES;
constexpr size_t WS_COS = WS_W + SZ_WLAYER, WS_SIN = WS_COS + (size_t)MTOK * 32 * 4;
constexpr size_t WS_H = WS_SIN + (size_t)MTOK * 32 * 4;
constexpr size_t WS_MG = WS_H;
constexpr size_t WS_PROJ = WS_H + (size_t)MP * DM * 2;
constexpr size_t WS_CQN = WS_PROJ + (size_t)MP * NPROJ * 2;
constexpr size_t WS_CKVN = WS_CQN + (size_t)MP * 512 * 2;
constexpr size_t WS_XB = WS_CQN;
constexpr size_t WS_RV = WS_CKVN + (size_t)MP * 512 * 2;
constexpr size_t WS_Q = WS_RV + al256((size_t)MP * 4);
constexpr size_t WS_KV = WS_Q + (size_t)MP * 1536 * 2;
constexpr size_t WS_K = WS_KV + (size_t)MP * 2048 * 2;
constexpr size_t WS_YA = WS_K + (size_t)MP * 1536 * 2;
constexpr size_t WS_YB = WS_YA + (size_t)MP * 1024 * 2;
constexpr size_t WS_DL = WS_YA;
constexpr size_t WS_YC = WS_YB + (size_t)MP * 1024 * 2;
constexpr size_t WS_OC = WS_YC + (size_t)MP * 1024 * 2;
constexpr size_t WS_QE = WS_OC + (size_t)MP * 1024 * 4;
constexpr size_t WS_KE = WS_QE + (size_t)MP * 512 * 2, WS_KL = WS_KE + (size_t)MP * 512 * 2;
constexpr size_t WS_DS = WS_KL + (size_t)MP * 512 * 2;
constexpr size_t WS_END = WS_DS + (size_t)(MP / 128) * 512 * 4;
static_assert(WS_END <= ((size_t)1 << 30), "workspace map exceeds 1 GiB");

constexpr int LDS_BYTES = 147456;
constexpr int LDSCTL_OFF = LDS_BYTES - 256;
constexpr int CW_BAR = 4096;

__device__ __forceinline__ float bf2f(unsigned v) { return __uint_as_float(v << 16); }
__device__ __forceinline__ unsigned f2bf(float f) { unsigned u = __float_as_uint(f); return (u + 0x7fffu + ((u >> 16) & 1u)) >> 16; }
__device__ __forceinline__ unsigned pk2(float lo, float hi) { return f2bf(lo) | (f2bf(hi) << 16); }
__device__ __forceinline__ float lo16(unsigned w) { return __uint_as_float(w << 16); }
__device__ __forceinline__ float hi16(unsigned w) { return __uint_as_float(w & 0xffff0000u); }
__device__ __forceinline__ float sigmoid_f(float x) { return 1.f / (1.f + __expf(-x)); }
__device__ __forceinline__ float silu_f(float x) { return x / (1.f + __expf(-x)); }
__device__ __forceinline__ float gelu_f(float x) { const float u2 = 1.5957691216057308f * (x + 0.044715f * x * x * x); return x * __builtin_amdgcn_rcpf(1.f + __expf(-u2)); }
template <int O> __device__ __forceinline__ float lane_xor(float v) {
    if (O == 1) return __uint_as_float((unsigned)__builtin_amdgcn_mov_dpp((int)__float_as_uint(v), 0xB1, 0xf, 0xf, true));
    if (O == 2) return __uint_as_float((unsigned)__builtin_amdgcn_mov_dpp((int)__float_as_uint(v), 0x4E, 0xf, 0xf, true));
    return __uint_as_float((unsigned)__builtin_amdgcn_ds_swizzle((int)__float_as_uint(v), (O << 10) | 0x1f)); }
__device__ __forceinline__ float lane_xor32(float v, int lane) {
    auto rr = __builtin_amdgcn_permlane32_swap(__float_as_uint(v), __float_as_uint(v), false, false);
    return __uint_as_float(lane < 32 ? rr[1] : rr[0]); }
__device__ __forceinline__ float wave_sum(float v) {
    v += lane_xor<1>(v); v += lane_xor<2>(v); v += lane_xor<4>(v); v += lane_xor<8>(v); v += lane_xor<16>(v);
    auto rr = __builtin_amdgcn_permlane32_swap(__float_as_uint(v), __float_as_uint(v), false, false);
    return __uint_as_float(rr[0]) + __uint_as_float(rr[1]); }
__device__ __forceinline__ float wave_max(float v) {
    v = fmaxf(v, lane_xor<1>(v)); v = fmaxf(v, lane_xor<2>(v)); v = fmaxf(v, lane_xor<4>(v)); v = fmaxf(v, lane_xor<8>(v)); v = fmaxf(v, lane_xor<16>(v));
    auto rr = __builtin_amdgcn_permlane32_swap(__float_as_uint(v), __float_as_uint(v), false, false);
    return fmaxf(__uint_as_float(rr[0]), __uint_as_float(rr[1])); }
#define LDS_FENCE() asm volatile("s_waitcnt lgkmcnt(0)" ::: "memory")

struct Args { const void* in[18]; float* out; unsigned char* ws; int lo, hi, pad0, pad1; };

template <int MODE> __device__ __forceinline__ int src_col(int n) {
    if (MODE == 0) return n;
    if (n < C_ZA) return n;
    if (n < C_ZC) return n + 64;
    if (n < C_KROPE) return n + 80;
    if (n < C_AR) return 1024 + (n - C_KROPE);
    if (n < C_AR + 16) return 7232 + (n - C_AR);
    return -1;
}
template <int MODE> __device__ __forceinline__ void convert_T(const float* W, int K, int Nsrc, bf16* WT, int Ndst, LAS float* tile, int vb, int nvb) {
    const int tid = otid(), ntk = K / 64, ntn = Ndst / 64, ntiles = ntk * ntn;
    for (int t = vb; t < ntiles; t += nvb) {
        const int k0 = (t % ntk) * 64, n0 = (t / ntk) * 64;
        { const int nn = tid & 63, sc = src_col<MODE>(n0 + nn);
#pragma unroll
          for (int i = 0; i < 8; ++i) { const int kk = (tid >> 6) + 8 * i; tile[kk * 65 + nn] = sc >= 0 ? W[(size_t)(k0 + kk) * Nsrc + sc] : 0.f; } }
        __syncthreads();
        { const int nn = tid & 63, kg = tid >> 6;
          const LAS float* tp = tile + (kg * 8) * 65 + nn;
          v4u o; o.x = pk2(tp[0], tp[65]); o.y = pk2(tp[2 * 65], tp[3 * 65]); o.z = pk2(tp[4 * 65], tp[5 * 65]); o.w = pk2(tp[6 * 65], tp[7 * 65]);
          *(v4u*)(WT + (size_t)(n0 + nn) * K + k0 + kg * 8) = o; }
        __syncthreads();
    }
}

__device__ __forceinline__ void ph_norm(const float* xin, const float* g, bf16* h, int rows, int vb, int nvb) {
    const int tid_ = otid(); const int lane = tid_ & 63, wave = tid_ >> 6;
    for (int r = vb * 8 + wave; r < rows; r += nvb * 8) {
        const v4f* xr = (const v4f*)(xin + (size_t)r * DM);
        v4f v[8]; float ss = 0.f;
#pragma unroll
        for (int j = 0; j < 8; ++j) { v[j] = xr[lane + 64 * j]; ss += v[j].x * v[j].x + v[j].y * v[j].y + v[j].z * v[j].z + v[j].w * v[j].w; }
        ss = wave_sum(ss);
        const float rn = 1.0f / sqrtf(ss * (1.0f / DM) + EPS);
#pragma unroll
        for (int j = 0; j < 8; ++j) { const v4f gg = ((const v4f*)g)[lane + 64 * j];
            v2u o; o.x = pk2(v[j].x * rn * gg.x, v[j].y * rn * gg.y); o.y = pk2(v[j].z * rn * gg.z, v[j].w * rn * gg.w);
            *(v2u*)(h + (size_t)r * DM + (lane + 64 * j) * 4) = o; }
    }
}
__device__ __forceinline__ void ph_prep(const bf16* proj, const float* gq, const float* gkv, bf16* cqn, bf16* ckvn, float* rv, int vb, int nvb) {
    const int tid_ = otid(); const int lane = tid_ & 63, wave = tid_ >> 6;
    for (int r = vb * 8 + wave; r < MP; r += nvb * 8) {
        const bf16* pr = proj + (size_t)r * NPROJ;
#pragma unroll
        for (int which = 0; which < 2; ++which) {
            const v4u w = *(const v4u*)(pr + (which ? C_CKV : C_CQ) + lane * 8);
            float x[8] = {lo16(w.x), hi16(w.x), lo16(w.y), hi16(w.y), lo16(w.z), hi16(w.z), lo16(w.w), hi16(w.w)};
            float ss = 0.f;
#pragma unroll
            for (int i = 0; i < 8; ++i) ss += x[i] * x[i];
            ss = wave_sum(ss);
            const float rn = 1.0f / sqrtf(ss * (1.0f / 512.f) + EPS);
            const float* g = (which ? gkv : gq) + lane * 8;
            v4u o; o.x = pk2(x[0] * rn * g[0], x[1] * rn * g[1]); o.y = pk2(x[2] * rn * g[2], x[3] * rn * g[3]); o.z = pk2(x[4] * rn * g[4], x[5] * rn * g[5]); o.w = pk2(x[6] * rn * g[6], x[7] * rn * g[7]);
            *(v4u*)((which ? ckvn : cqn) + (size_t)r * 512 + lane * 8) = o;
        }
        float ss = 0.f;
#pragma unroll
        for (int j = 0; j < 2; ++j) { const v4u w = *(const v4u*)(pr + C_VB + (lane + 64 * j) * 8);
            const float x[8] = {lo16(w.x), hi16(w.x), lo16(w.y), hi16(w.y), lo16(w.z), hi16(w.z), lo16(w.w), hi16(w.w)};
#pragma unroll
            for (int i = 0; i < 8; ++i) { const float gv = gelu_f(x[i]); ss += gv * gv; } }
        ss = wave_sum(ss);
        if (lane == 0) rv[r] = 1.0f / sqrtf(ss * (1.0f / 1024.f) + EPS);
    }
}
__device__ __forceinline__ float row16_sum(float v) {
    v += __uint_as_float((unsigned)__builtin_amdgcn_mov_dpp((int)__float_as_uint(v), 0xB1, 0xf, 0xf, true));
    v += __uint_as_float((unsigned)__builtin_amdgcn_mov_dpp((int)__float_as_uint(v), 0x4E, 0xf, 0xf, true));
    v += __uint_as_float((unsigned)__builtin_amdgcn_mov_dpp((int)__float_as_uint(v), 0x141, 0xf, 0xf, true));
    v += __uint_as_float((unsigned)__builtin_amdgcn_mov_dpp((int)__float_as_uint(v), 0x140, 0xf, 0xf, true));
    return v; }
__device__ __forceinline__ void ph_kfin(const bf16* kv, const bf16* proj, bf16* K, const float* kg, const float* cosT, const float* sinT, int row0, int vb, int nvb) {
    const int tid_ = otid(); const int lane = tid_ & 63, wave = tid_ >> 6, g16 = lane >> 4, c = lane & 15;
    float gn[8], gr[8];
#pragma unroll
    for (int j = 0; j < 8; ++j) { gn[j] = kg[c * 8 + j]; gr[j] = kg[128 + (c & 7) * 8 + j]; }
    for (int r = vb * 8 + wave; r < MP; r += nvb * 8) {
        const v4u n0 = *(const v4u*)(kv + (size_t)r * 2048 + g16 * 256 + c * 8), n1 = *(const v4u*)(kv + (size_t)r * 2048 + (g16 + 4) * 256 + c * 8);
        const v4u rw = *(const v4u*)(proj + (size_t)r * NPROJ + C_KROPE + (c & 7) * 8);
        const v4f c0 = *(const v4f*)(cosT + (size_t)(row0 + r) * 32 + (c & 3) * 8), c1 = *(const v4f*)(cosT + (size_t)(row0 + r) * 32 + (c & 3) * 8 + 4);
        const v4f s0 = *(const v4f*)(sinT + (size_t)(row0 + r) * 32 + (c & 3) * 8), s1 = *(const v4f*)(sinT + (size_t)(row0 + r) * 32 + (c & 3) * 8 + 4);
        float a[8] = {lo16(n0.x), hi16(n0.x), lo16(n0.y), hi16(n0.y), lo16(n0.z), hi16(n0.z), lo16(n0.w), hi16(n0.w)};
        float b[8] = {lo16(n1.x), hi16(n1.x), lo16(n1.y), hi16(n1.y), lo16(n1.z), hi16(n1.z), lo16(n1.w), hi16(n1.w)};
        float kr[8] = {lo16(rw.x), hi16(rw.x), lo16(rw.y), hi16(rw.y), lo16(rw.z), hi16(rw.z), lo16(rw.w), hi16(rw.w)};
        const float cs[8] = {c0.x, c0.y, c0.z, c0.w, c1.x, c1.y, c1.z, c1.w}, sn[8] = {s0.x, s0.y, s0.z, s0.w, s1.x, s1.y, s1.z, s1.w};
        float sa = 0.f, sb = 0.f, sr = 0.f;
#pragma unroll
        for (int j = 0; j < 8; ++j) { sa += a[j] * a[j]; sb += b[j] * b[j]; sr += kr[j] * kr[j]; }
        if (c >= 8) sr = 0.f;
        sa = row16_sum(sa); sb = row16_sum(sb); sr = row16_sum(sr);
        const float rna = 1.0f / sqrtf((sa + sr) * (1.0f / 192.f) + EPS), rnb = 1.0f / sqrtf((sb + sr) * (1.0f / 192.f) + EPS);
        float R[8];
#pragma unroll
        for (int j = 0; j < 8; ++j) { const float mine = kr[j] * gr[j]; const float oth = lane_xor<4>(mine);
            R[j] = (c & 4) ? mine * cs[j] + oth * sn[j] : mine * cs[j] - oth * sn[j]; }
        bf16* ka = K + ((size_t)r * 8 + g16) * 192; bf16* kb = K + ((size_t)r * 8 + g16 + 4) * 192;
        { v4u o; o.x = pk2(a[0] * rna * gn[0], a[1] * rna * gn[1]); o.y = pk2(a[2] * rna * gn[2], a[3] * rna * gn[3]); o.z = pk2(a[4] * rna * gn[4], a[5] * rna * gn[5]); o.w = pk2(a[6] * rna * gn[6], a[7] * rna * gn[7]); *(v4u*)(ka + c * 8) = o; }
        { v4u o; o.x = pk2(b[0] * rnb * gn[0], b[1] * rnb * gn[1]); o.y = pk2(b[2] * rnb * gn[2], b[3] * rnb * gn[3]); o.z = pk2(b[4] * rnb * gn[4], b[5] * rnb * gn[5]); o.w = pk2(b[6] * rnb * gn[6], b[7] * rnb * gn[7]); *(v4u*)(kb + c * 8) = o; }
        if (c < 8) {
            v4u o; o.x = pk2(R[0] * rna, R[1] * rna); o.y = pk2(R[2] * rna, R[3] * rna); o.z = pk2(R[4] * rna, R[5] * rna); o.w = pk2(R[6] * rna, R[7] * rna); *(v4u*)(ka + 128 + c * 8) = o;
            v4u p; p.x = pk2(R[0] * rnb, R[1] * rnb); p.y = pk2(R[2] * rnb, R[3] * rnb); p.z = pk2(R[4] * rnb, R[5] * rnb); p.w = pk2(R[6] * rnb, R[7] * rnb); *(v4u*)(kb + 128 + c * 8) = p; }
    }
}
__device__ __forceinline__ void ph_attn_naive(const bf16* Q, const bf16* K, const bf16* KV, const bf16* proj, bf16* YA, LAS float* lds, int vb, int nvb) {
    const int tid_ = otid(); const int lane = tid_ & 63, wave = tid_ >> 6;
    LAS float* qs = lds + wave * (4096 + 192); LAS float* ps = qs + 192;
    const float scale = 0.07216878364870322f;
    for (int it = vb * 8 + wave; it < NBP * 8 * SEQ; it += nvb * 8) {
        const int t = it % SEQ, bh = it / SEQ, h = bh & 7, b = bh >> 3, r = b * SEQ + t;
        { const bf16* qp = Q + ((size_t)r * 8 + h) * 192; qs[lane] = bf2f(qp[lane]); qs[lane + 64] = bf2f(qp[lane + 64]); qs[lane + 128] = bf2f(qp[lane + 128]); }
        LDS_FENCE();
        float m = -3.0e38f;
        for (int j = lane; j <= t; j += 64) {
            const v4u* kr = (const v4u*)(K + ((size_t)(b * SEQ + j) * 8 + h) * 192);
            float s = 0.f;
#pragma unroll 4
            for (int c = 0; c < 24; ++c) { const v4u w = kr[c]; const LAS float* qq = qs + c * 8;
                s += qq[0] * lo16(w.x) + qq[1] * hi16(w.x) + qq[2] * lo16(w.y) + qq[3] * hi16(w.y) + qq[4] * lo16(w.z) + qq[5] * hi16(w.z) + qq[6] * lo16(w.w) + qq[7] * hi16(w.w); }
            s *= scale; ps[j] = s; m = fmaxf(m, s);
        }
        m = wave_max(m);
        float l = 0.f;
        for (int j = lane; j <= t; j += 64) { const float p = __expf(ps[j] - m); ps[j] = p; l += p; }
        l = wave_sum(l);
        LDS_FENCE();
        float a0 = 0.f, a1 = 0.f;
        const bf16* vp = KV + (size_t)(b * SEQ) * 2048 + h * 256 + 128 + 2 * lane;
        for (int j = 0; j <= t; ++j) { const float p = ps[j]; const unsigned w = *(const unsigned*)(vp + (size_t)j * 2048); a0 += p * lo16(w); a1 += p * hi16(w); }
        const float inv = 1.0f / l;
        const unsigned zw = *(const unsigned*)(proj + (size_t)r * NPROJ + C_ZA + h * 128 + 2 * lane);
        *(unsigned*)(YA + (size_t)r * 1024 + h * 128 + 2 * lane) = pk2(a0 * inv * silu_f(lo16(zw)), a1 * inv * silu_f(hi16(zw)));
        LDS_FENCE();
    }
}
__device__ __forceinline__ void ph_sgu_naive(const bf16* proj, const float* rv, const float* Ws, const float* bs, const float* vg, bf16* YB, int vb, int nvb) {
    for (size_t idx = (size_t)vb * 512 + otid(); idx < (size_t)MP * 1024; idx += (size_t)nvb * 512) {
        const int r = (int)(idx >> 10), col = (int)(idx & 1023), g = col >> 7, tl = r & 127, rc = r - tl;
        float acc = 0.f;
        const float* wrow = Ws + ((size_t)g * 128 + tl) * 128;
        for (int sl = 0; sl <= tl; ++sl) acc += wrow[sl] * gelu_f(bf2f(proj[(size_t)(rc + sl) * NPROJ + C_VB + col])) * rv[rc + sl];
        acc = acc * vg[col] + bs[g * 128 + tl];
        const float u = gelu_f(bf2f(proj[(size_t)r * NPROJ + C_UB + col])), z = silu_f(bf2f(proj[(size_t)r * NPROJ + C_ZB + col]));
        YB[idx] = (bf16)f2bf(u * acc * z);
    }
}
__device__ __forceinline__ void ph_gla_naive(const bf16* proj, const float* wa2, const float* ba, float* OC, LAS float* lds, int vb, int nvb) {
    const int tid_ = otid(); const int lane = tid_ & 63, wave = tid_ >> 6;
    LAS float* sh = lds + wave * 512;
    for (int it = wave * nvb + vb; it < NBP * 16; it += nvb * 8) {
        const int b = it >> 4, h = (it >> 2) & 3, vq = it & 3;
        float st[128];
#pragma unroll
        for (int k = 0; k < 128; ++k) st[k] = 0.f;
        float wa0[16], wa1[16];
#pragma unroll
        for (int j = 0; j < 16; ++j) { wa0[j] = wa2[j * 512 + h * 128 + lane]; wa1[j] = wa2[j * 512 + h * 128 + 64 + lane]; }
        const float ba0 = ba[h * 128 + lane], ba1 = ba[h * 128 + 64 + lane];
        for (int t = 0; t < SEQ; ++t) {
            const bf16* pr = proj + (size_t)(b * SEQ + t) * NPROJ;
            const v4u w0 = *(const v4u*)(pr + C_AR), w1 = *(const v4u*)(pr + C_AR + 8);
            const float ar[16] = {lo16(w0.x), hi16(w0.x), lo16(w0.y), hi16(w0.y), lo16(w0.z), hi16(w0.z), lo16(w0.w), hi16(w0.w),
                                  lo16(w1.x), hi16(w1.x), lo16(w1.y), hi16(w1.y), lo16(w1.z), hi16(w1.z), lo16(w1.w), hi16(w1.w)};
            float x0 = ba0, x1 = ba1;
#pragma unroll
            for (int j = 0; j < 16; ++j) { x0 += ar[j] * wa0[j]; x1 += ar[j] * wa1[j]; }
            const float ls0 = fminf(x0, 0.f) - log1pf(__expf(-fabsf(x0))), ls1 = fminf(x1, 0.f) - log1pf(__expf(-fabsf(x1)));
            sh[lane] = __expf(ls0 * 0.0625f); sh[64 + lane] = __expf(ls1 * 0.0625f);
            sh[128 + lane] = bf2f(pr[C_QC + h * 128 + lane]) * 0.08838834764831845f; sh[192 + lane] = bf2f(pr[C_QC + h * 128 + 64 + lane]) * 0.08838834764831845f;
            sh[256 + lane] = bf2f(pr[C_KC + h * 128 + lane]); sh[320 + lane] = bf2f(pr[C_KC + h * 128 + 64 + lane]);
            const float v = bf2f(pr[C_VC + h * 256 + vq * 64 + lane]);
            LDS_FENCE();
            float o = 0.f;
#pragma unroll
            for (int k = 0; k < 128; ++k) { st[k] = sh[k] * st[k] + sh[256 + k] * v; o += sh[128 + k] * st[k]; }
            LDS_FENCE();
            OC[(size_t)(b * SEQ + t) * 1024 + h * 256 + vq * 64 + lane] = o;
        }
    }
}
__device__ __forceinline__ void ph_glafin(const float* OC, const bf16* proj, const float* og, bf16* YC, int vb, int nvb) {
    const int tid_ = otid(); const int lane = tid_ & 63, wave = tid_ >> 6;
    for (int it = vb * 8 + wave; it < MP * 4; it += nvb * 8) {
        const int r = it >> 2, h = it & 3;
        const v4f o = *(const v4f*)(OC + (size_t)r * 1024 + h * 256 + lane * 4);
        const float ss = wave_sum(o.x * o.x + o.y * o.y + o.z * o.z + o.w * o.w);
        const float rn = 1.0f / sqrtf(ss * (1.0f / 256.f) + EPS);
        const v4f g = *(const v4f*)(og + lane * 4);
        const v2u zw = *(const v2u*)(proj + (size_t)r * NPROJ + C_ZC + h * 256 + lane * 4);
        v2u w; w.x = pk2(o.x * rn * g.x * silu_f(lo16(zw.x)), o.y * rn * g.y * silu_f(hi16(zw.x))); w.y = pk2(o.z * rn * g.z * silu_f(lo16(zw.y)), o.w * rn * g.w * silu_f(hi16(zw.y)));
        *(v2u*)(YC + (size_t)r * 1024 + h * 256 + lane * 4) = w;
    }
}
__device__ __forceinline__ void ph_merge(const bf16* proj, const bf16* PB, bf16* MG, int vb, int nvb) {
    for (size_t idx = (size_t)vb * 512 + otid(); idx < (size_t)MP * 1024; idx += (size_t)nvb * 512) {
        const int r = (int)(idx >> 10), j = (int)(idx & 1023) * 2;
        float m0 = 0.f, m1 = 0.f;
#pragma unroll
        for (int b = 0; b < 3; ++b) { const unsigned gw = *(const unsigned*)(proj + (size_t)r * NPROJ + C_GATE + b * 2048 + j), pw = *(const unsigned*)(PB + ((size_t)b * MP + r) * 2048 + j);
            m0 += sigmoid_f(lo16(gw)) * lo16(pw); m1 += sigmoid_f(hi16(gw)) * hi16(pw); }
        *(unsigned*)(MG + (size_t)r * 2048 + j) = pk2(m0, m1);
    }
}
__device__ __forceinline__ void ph_outadd(const float* xin, const float* U, float* xout, int vb, int nvb) {
    for (size_t idx = (size_t)vb * 512 + otid(); idx < (size_t)MP * 512; idx += (size_t)nvb * 512) {
        const v4f a = ((const v4f*)xin)[idx], u = ((const v4f*)U)[idx]; ((v4f*)xout)[idx] = a + u; }
}


namespace at {
typedef short bf16x8 __attribute__((ext_vector_type(8)));
typedef short s16x4 __attribute__((ext_vector_type(4)));
typedef float f32x16 __attribute__((ext_vector_type(16)));
typedef unsigned u32x4 __attribute__((ext_vector_type(4)));
constexpr int SHM_V = 16384, SHM_K = 16384, SHM_KR = 8192;
constexpr int OFF_V = 0, OFF_K = 3 * SHM_V, OFF_KR = OFF_K + 2 * SHM_K, OFF_WS = OFF_KR + 2 * SHM_KR, LDS_NEED = OFF_WS + 8 * 64 * 4;
constexpr float SCALE = 0.07216878364870322f;
constexpr float THR = 8.f;
#define AT_KSWZ(row, colB) ((row) * 256 + ((colB) ^ (((row) & 7) << 4)))
#define AT_KRSWZ(row, colB) ((row) * 128 + ((colB) ^ (((row) & 7) << 4)))
#define AT_SBAR() __builtin_amdgcn_sched_barrier(0)
__device__ __forceinline__ int v_st(int k, int c) { const int kk = (k & ~0xC) | ((k & 4) << 1) | ((k & 8) >> 1); return ((kk >> 3) * 4 + (c >> 5)) * 512 + ((kk & 7) * 32 + (c & 31)) * 2; }
__device__ __forceinline__ int v_rd_base(int lane) { return ((lane & 3) << 3) | (((lane >> 2) & 3) << 6) | (((lane >> 4) & 1) << 5) | (((lane >> 5) & 1) << 8); }
constexpr int v_rd_off(int d0, int ks, int half) { return d0 * 512 + ks * 4096 + half * 2048; }
__device__ __forceinline__ int crow(int r, int hi) { return (r & 3) + 8 * (r >> 2) + 4 * hi; }
__device__ __forceinline__ unsigned cvtpk(float lo, float hi) { unsigned r; asm("v_cvt_pk_bf16_f32 %0, %1, %2" : "=v"(r) : "v"(lo), "v"(hi)); return r; }

__device__ __forceinline__ void mask_tile(f32x16& p0, f32x16& p1, int dq) {
    const float NEG = -__builtin_inff();
#pragma unroll
    for (int r = 0; r < 16; ++r) { const int c = (r & 3) + 8 * (r >> 2); if (dq < c) p0[r] = NEG; if (dq < c + 32) p1[r] = NEG; }
}
__device__ __forceinline__ void partialSM(f32x16& p0, f32x16& p1, float& m_reg, float& mn, float& alpha) {
    float pmax = p0[0];
#pragma unroll
    for (int r = 1; r < 16; ++r) pmax = fmaxf(pmax, p0[r]);
#pragma unroll
    for (int r = 0; r < 16; ++r) pmax = fmaxf(pmax, p1[r]);
    { auto rr = __builtin_amdgcn_permlane32_swap(__float_as_uint(pmax), __float_as_uint(pmax), false, false);
      pmax = fmaxf(__uint_as_float(rr[0]), __uint_as_float(rr[1])); }
    constexpr float C2 = 1.4426950408889634f * SCALE;
    if (__builtin_expect(__all((pmax - m_reg) * SCALE <= THR), 1)) { mn = m_reg; alpha = 1.f; }
    else { mn = fmaxf(m_reg, pmax); alpha = __builtin_amdgcn_exp2f((m_reg - mn) * C2); m_reg = mn; }
    const float mnL = -mn * C2;
#pragma unroll
    for (int r = 0; r < 16; ++r) p0[r] = fmaf(p0[r], C2, mnL);
#pragma unroll
    for (int r = 0; r < 16; ++r) p1[r] = fmaf(p1[r], C2, mnL);
#pragma unroll
    for (int r = 0; r < 16; ++r) p0[r] = __builtin_amdgcn_exp2f(p0[r]);
}
__device__ __forceinline__ void finishSM(f32x16& p0, f32x16& p1, float alpha, float& l_reg, bf16x8& pa0, bf16x8& pa1, bf16x8& pa2, bf16x8& pa3) {
#pragma unroll
    for (int r = 0; r < 16; ++r) p1[r] = __builtin_amdgcn_exp2f(p1[r]);
    float ps = 0;
#pragma unroll
    for (int r = 0; r < 16; ++r) ps += p0[r];
#pragma unroll
    for (int r = 0; r < 16; ++r) ps += p1[r];
    { auto rr = __builtin_amdgcn_permlane32_swap(__float_as_uint(ps), __float_as_uint(ps), false, false);
      ps = __uint_as_float(rr[0]) + __uint_as_float(rr[1]); }
    l_reg = l_reg * alpha + ps;
#define AT_PK4(P, B_, OUT) do { unsigned a0 = cvtpk(P[B_+0], P[B_+1]), a1 = cvtpk(P[B_+2], P[B_+3]);                          \
        unsigned b0 = cvtpk(P[B_+4], P[B_+5]), b1 = cvtpk(P[B_+6], P[B_+7]);                                             \
        auto r0 = __builtin_amdgcn_permlane32_swap(a0, b0, false, false); auto r1 = __builtin_amdgcn_permlane32_swap(a1, b1, false, false); \
        u32x4 w = {r0[0], r1[0], r0[1], r1[1]}; OUT = *reinterpret_cast<bf16x8*>(&w); } while (0)
    AT_PK4(p0, 0, pa0); AT_PK4(p0, 8, pa1); AT_PK4(p1, 0, pa2); AT_PK4(p1, 8, pa3);
#undef AT_PK4
}
__device__ __forceinline__ void qkt(f32x16& p0, f32x16& p1, const LAS unsigned char* Kb, const LAS unsigned char* KRb, int r32, int hi, const bf16x8* qr) {
    p0 = f32x16{}; p1 = f32x16{};
    const LAS unsigned char* kb[4]; const LAS unsigned char* krb[4];
#pragma unroll
    for (int dd = 0; dd < 4; ++dd) { kb[dd] = Kb + AT_KSWZ(r32, (dd * 16 + hi * 8) * 2); krb[dd] = KRb + AT_KRSWZ(r32, (dd * 16 + hi * 8) * 2); }
    bf16x8 f[24];
#pragma unroll
    for (int d0 = 0; d0 < 8; ++d0) { const LAS unsigned char* a = kb[d0 & 3] + (d0 >> 2) * 128;
        f[2 * d0] = *reinterpret_cast<const LAS bf16x8*>(a); f[2 * d0 + 1] = *reinterpret_cast<const LAS bf16x8*>(a + 32 * 256); }
#pragma unroll
    for (int d0 = 0; d0 < 4; ++d0) { const LAS unsigned char* a = krb[d0];
        f[16 + 2 * d0] = *reinterpret_cast<const LAS bf16x8*>(a); f[16 + 2 * d0 + 1] = *reinterpret_cast<const LAS bf16x8*>(a + 32 * 128); }
#pragma unroll
    for (int d0 = 0; d0 < 12; ++d0) {
        p0 = __builtin_amdgcn_mfma_f32_32x32x16_bf16(f[2 * d0], qr[d0], p0, 0, 0, 0);
        p1 = __builtin_amdgcn_mfma_f32_32x32x16_bf16(f[2 * d0 + 1], qr[d0], p1, 0, 0, 0); }
    __builtin_amdgcn_sched_group_barrier(0x100, 4, 0);
#pragma unroll
    for (int i = 0; i < 20; ++i) { __builtin_amdgcn_sched_group_barrier(0x008, 1, 0); __builtin_amdgcn_sched_group_barrier(0x100, 1, 0); }
    __builtin_amdgcn_sched_group_barrier(0x008, 4, 0);
}
__device__ __forceinline__ void pv_tile(f32x16* o, unsigned vb0, bf16x8 pa0, bf16x8 pa1, bf16x8 pa2, bf16x8 pa3) {
#define AT_TRRD(dst, off) asm volatile("ds_read_b64_tr_b16 %0, %1 offset:%2" : "=&v"(dst) : "v"(vb0), "i"(off) : "memory")
#define AT_PV_RD(d0, L, H) do { constexpr int b_ = v_rd_off(d0, 0, 0); \
        AT_TRRD(L[0], b_); AT_TRRD(H[0], b_ + 2048); AT_TRRD(L[1], b_ + 4096); AT_TRRD(H[1], b_ + 6144); AT_TRRD(L[2], b_ + 8192); AT_TRRD(H[2], b_ + 10240); AT_TRRD(L[3], b_ + 12288); AT_TRRD(H[3], b_ + 14336); } while (0)
#define AT_PV_MM(d0, L, H) do { \
        o[d0] = __builtin_amdgcn_mfma_f32_32x32x16_bf16(pa0, (bf16x8){L[0][0], L[0][1], L[0][2], L[0][3], H[0][0], H[0][1], H[0][2], H[0][3]}, o[d0], 0, 0, 0);   \
        o[d0] = __builtin_amdgcn_mfma_f32_32x32x16_bf16(pa1, (bf16x8){L[1][0], L[1][1], L[1][2], L[1][3], H[1][0], H[1][1], H[1][2], H[1][3]}, o[d0], 0, 0, 0);   \
        o[d0] = __builtin_amdgcn_mfma_f32_32x32x16_bf16(pa2, (bf16x8){L[2][0], L[2][1], L[2][2], L[2][3], H[2][0], H[2][1], H[2][2], H[2][3]}, o[d0], 0, 0, 0);   \
        o[d0] = __builtin_amdgcn_mfma_f32_32x32x16_bf16(pa3, (bf16x8){L[3][0], L[3][1], L[3][2], L[3][3], H[3][0], H[3][1], H[3][2], H[3][3]}, o[d0], 0, 0, 0); } while (0)
    s16x4 la[4], ha[4], lb[4], hb[4];
    asm volatile("s_waitcnt lgkmcnt(0)" ::: "memory");
    AT_PV_RD(0, la, ha); AT_PV_RD(1, lb, hb);
    asm volatile("s_waitcnt lgkmcnt(8)" ::: "memory"); AT_SBAR(); AT_PV_MM(0, la, ha); AT_SBAR();
    AT_PV_RD(2, la, ha);
    asm volatile("s_waitcnt lgkmcnt(8)" ::: "memory"); AT_SBAR(); AT_PV_MM(1, lb, hb); AT_SBAR();
    AT_PV_RD(3, lb, hb);
    asm volatile("s_waitcnt lgkmcnt(8)" ::: "memory"); AT_SBAR(); AT_PV_MM(2, la, ha); AT_SBAR();
    asm volatile("s_waitcnt lgkmcnt(0)" ::: "memory"); AT_SBAR(); AT_PV_MM(3, lb, hb);
#undef AT_PV_RD
#undef AT_PV_MM
#undef AT_TRRD
}

__device__ __forceinline__ void attn_block(LAS unsigned char* lds, const bf16* Q, const bf16* K, const bf16* KV, const bf16* proj, bf16* YA, const float* qg, const float* cosT, const float* sinT, int b, int h, int qb) {
    const int tid = otid(), wid = __builtin_amdgcn_readfirstlane(tid >> 6), lane = tid & 63, r32 = lane & 31, hi = lane >> 5;
    const int P0 = qb * 256, NT = 4 * (qb + 1), qlo = P0 + wid * 32;
    LAS unsigned char* V_lds = lds + OFF_V; LAS unsigned char* K_lds = lds + OFF_K; LAS unsigned char* KR_lds = lds + OFF_KR;
    LAS float* wsf = (LAS float*)(lds + OFF_WS) + wid * 64; LAS float* li_l = wsf; LAS float* al_l = wsf + 32;
    bf16x8 qr[12];
    { const bf16* qp = Q + ((size_t)(b * SEQ + qlo + r32) * 8 + h) * 192 + hi * 8;
      bf16x8 raw[12];
#pragma unroll
      for (int d0 = 0; d0 < 12; ++d0) raw[d0] = *(const bf16x8*)(qp + d0 * 16);
      float ss = 0.f;
#pragma unroll
      for (int d0 = 0; d0 < 12; ++d0)
#pragma unroll
          for (int j = 0; j < 8; ++j) { const float v = bf2f((unsigned short)raw[d0][j]); ss += v * v; }
      { auto rr = __builtin_amdgcn_permlane32_swap(__float_as_uint(ss), __float_as_uint(ss), false, false); ss = __uint_as_float(rr[0]) + __uint_as_float(rr[1]); }
      const float rn = 1.0f / sqrtf(ss * (1.0f / 192.f) + EPS);
      const float* ct = cosT + (size_t)(b * SEQ + qlo + r32) * 32 + hi * 8; const float* st = sinT + (size_t)(b * SEQ + qlo + r32) * 32 + hi * 8;
#pragma unroll
      for (int d0 = 0; d0 < 8; ++d0) { const v4f g0 = *(const v4f*)(qg + d0 * 16 + hi * 8), g1 = *(const v4f*)(qg + d0 * 16 + hi * 8 + 4);
          const float g[8] = {g0.x, g0.y, g0.z, g0.w, g1.x, g1.y, g1.z, g1.w}; float x[8];
#pragma unroll
          for (int j = 0; j < 8; ++j) x[j] = bf2f((unsigned short)raw[d0][j]) * rn * g[j];
          u32x4 w = {cvtpk(x[0], x[1]), cvtpk(x[2], x[3]), cvtpk(x[4], x[5]), cvtpk(x[6], x[7])}; qr[d0] = *reinterpret_cast<bf16x8*>(&w); }
#pragma unroll
      for (int d0 = 8; d0 < 10; ++d0) { const int i0 = (d0 - 8) * 16;
          const v4f ga0 = *(const v4f*)(qg + d0 * 16 + hi * 8), ga1 = *(const v4f*)(qg + d0 * 16 + hi * 8 + 4), gb0 = *(const v4f*)(qg + (d0 + 2) * 16 + hi * 8), gb1 = *(const v4f*)(qg + (d0 + 2) * 16 + hi * 8 + 4);
          const v4f c0 = *(const v4f*)(ct + i0), c1 = *(const v4f*)(ct + i0 + 4), s0 = *(const v4f*)(st + i0), s1 = *(const v4f*)(st + i0 + 4);
          const float ga[8] = {ga0.x, ga0.y, ga0.z, ga0.w, ga1.x, ga1.y, ga1.z, ga1.w}, gb[8] = {gb0.x, gb0.y, gb0.z, gb0.w, gb1.x, gb1.y, gb1.z, gb1.w};
          const float cs[8] = {c0.x, c0.y, c0.z, c0.w, c1.x, c1.y, c1.z, c1.w}, sn[8] = {s0.x, s0.y, s0.z, s0.w, s1.x, s1.y, s1.z, s1.w};
          float y1[8], y2[8];
#pragma unroll
          for (int j = 0; j < 8; ++j) { const float x1 = bf2f((unsigned short)raw[d0][j]) * rn * ga[j], x2 = bf2f((unsigned short)raw[d0 + 2][j]) * rn * gb[j];
              y1[j] = x1 * cs[j] - x2 * sn[j]; y2[j] = x2 * cs[j] + x1 * sn[j]; }
          u32x4 w1 = {cvtpk(y1[0], y1[1]), cvtpk(y1[2], y1[3]), cvtpk(y1[4], y1[5]), cvtpk(y1[6], y1[7])}; qr[d0] = *reinterpret_cast<bf16x8*>(&w1);
          u32x4 w2 = {cvtpk(y2[0], y2[1]), cvtpk(y2[2], y2[3]), cvtpk(y2[4], y2[5]), cvtpk(y2[6], y2[7])}; qr[d0 + 2] = *reinterpret_cast<bf16x8*>(&w2); }
    }
    const int sr = tid >> 4, sc = (tid & 15) * 8, kws = AT_KSWZ(sr, sc * 2), vst0 = v_st(sr, sc), vst1 = v_st(32 + sr, sc);
    const int rr = tid >> 3, rc = (tid & 7) * 8, krws = AT_KRSWZ(rr, rc * 2);
    const bf16* Kg = K + ((size_t)(b * SEQ) * 8 + h) * 192;
    const bf16* Vg = KV + (size_t)(b * SEQ) * 2048 + h * 256 + 128;
    bf16x8 sa_k0, sa_k1, sa_kr, sa_v0, sa_v1, sb_k0, sb_k1, sb_kr, sb_v0, sb_v1;
#define AT_SLOAD(S, kb_) do { S##_k0 = *(const bf16x8*)(Kg + (size_t)((kb_) + sr) * 1536 + sc); S##_k1 = *(const bf16x8*)(Kg + (size_t)((kb_) + 32 + sr) * 1536 + sc); \
        S##_kr = *(const bf16x8*)(Kg + (size_t)((kb_) + rr) * 1536 + 128 + rc); \
        S##_v0 = *(const bf16x8*)(Vg + (size_t)((kb_) + sr) * 2048 + sc); S##_v1 = *(const bf16x8*)(Vg + (size_t)((kb_) + 32 + sr) * 2048 + sc); } while (0)
#define AT_SWRITE(S, bf, vbf) do { *(LAS bf16x8*)(K_lds + (bf) * SHM_K + kws) = S##_k0; *(LAS bf16x8*)(K_lds + (bf) * SHM_K + kws + 32 * 256) = S##_k1; \
        *(LAS bf16x8*)(KR_lds + (bf) * SHM_KR + krws) = S##_kr; \
        *(LAS bf16x8*)(V_lds + (vbf) * SHM_V + vst0) = S##_v0; *(LAS bf16x8*)(V_lds + (vbf) * SHM_V + vst1) = S##_v1; } while (0)
    AT_SLOAD(sa, 0); AT_SLOAD(sb, 64); AT_SWRITE(sa, 0, 0);
    __syncthreads();
    float m_reg = -1e30f, l_reg = 0.f; f32x16 o[4] = {};
    const unsigned vbase = (unsigned)(size_t)V_lds + (unsigned)v_rd_base(lane);
    const bool late = wid >= 4;
    bool pend = false; int pvb = 0; int vb3 = 0;
    bf16x8 pa0, pa1, pa2, pa3;
#define AT_STEP(t, SL, SW) do { \
        const int buf = (t) & 1, kb = (t) * 64; \
        if ((t) + 2 < NT) AT_SLOAD(SL, kb + 128);                         \
        if (late && pend) { pv_tile(o, vbase + pvb * SHM_V, pa0, pa1, pa2, pa3); pend = false; AT_SBAR(); } \
        if (kb <= qlo + 31) { \
            f32x16 p0, p1; float mn, alpha; \
            qkt(p0, p1, K_lds + buf * SHM_K, KR_lds + buf * SHM_KR, r32, hi, qr); \
            if (kb + 63 > qlo) mask_tile(p0, p1, qlo + r32 - 4 * hi - kb); \
            partialSM(p0, p1, m_reg, mn, alpha); \
            finishSM(p0, p1, alpha, l_reg, pa0, pa1, pa2, pa3); \
            if (__any(alpha < 1.f)) { if (hi == 0) al_l[r32] = alpha; asm volatile("s_waitcnt lgkmcnt(0)" ::: "memory"); \
                _Pragma("unroll") for (int d_ = 0; d_ < 4; ++d_) _Pragma("unroll") for (int r = 0; r < 16; ++r) o[d_][r] *= al_l[crow(r, hi)]; \
                asm volatile("s_waitcnt lgkmcnt(0)" ::: "memory"); } \
            AT_SBAR(); \
            if (late) { pend = true; pvb = vb3; } \
            else pv_tile(o, vbase + vb3 * SHM_V, pa0, pa1, pa2, pa3); \
        } \
        const int vn3 = vb3 == 2 ? 0 : vb3 + 1; \
        if ((t) + 1 < NT) AT_SWRITE(SW, buf ^ 1, vn3);                    \
        vb3 = vn3; \
        __syncthreads(); } while (0)
    for (int t = 0; t < NT; t += 2) { AT_STEP(t, sa, sb); AT_STEP(t + 1, sb, sa); }
#undef AT_STEP
    if (late && pend) pv_tile(o, vbase + pvb * SHM_V, pa0, pa1, pa2, pa3);
    if (hi == 0) li_l[r32] = l_reg;
    asm volatile("s_waitcnt lgkmcnt(0)" ::: "memory");
    float rli[16];
#pragma unroll
    for (int r = 0; r < 16; ++r) rli[r] = 1.0f / li_l[crow(r, hi)];
#pragma unroll
    for (int d0 = 0; d0 < 4; ++d0) { const int col = h * 128 + d0 * 32 + r32;
        unsigned short zr[16];
#pragma unroll
        for (int r = 0; r < 16; ++r) zr[r] = proj[(size_t)(b * SEQ + qlo + crow(r, hi)) * NPROJ + C_ZA + col];
#pragma unroll
        for (int r = 0; r < 16; ++r) { const int row = b * SEQ + qlo + crow(r, hi);
            const float v = o[d0][r] * rli[r] * silu_f(bf2f(zr[r]));
            const float vn = lane_xor<1>(v);
            if ((r32 & 1) == 0) *(unsigned*)(YA + (size_t)row * 1024 + col) = cvtpk(v, vn); } }
    asm volatile("s_waitcnt lgkmcnt(0)" ::: "memory");
    __syncthreads();
#undef AT_SLOAD
#undef AT_SWRITE
}
}


namespace sg {
using at::bf16x8; using at::f32x16;
__device__ __forceinline__ void sgu_item(LAS unsigned char* lds, const bf16* proj, const float* rv, const float* Ws, const float* bs, const float* vg, bf16* YB, int it) {
    const int tid = otid(), wid = __builtin_amdgcn_readfirstlane(tid >> 6), lane = tid & 63, r32 = lane & 31, hi = lane >> 5;
    {
        const int ch = it >> 2, gp = it & 3, R0 = ch * 128;
#pragma unroll
        for (int i = 0; i < 8; ++i) {
            const int idx = tid + 512 * i, gsel = idx >> 11, row = (idx >> 4) & 127, cc = idx & 15;
            const v4u w = *(const v4u*)(proj + (size_t)(R0 + row) * NPROJ + C_VB + (2 * gp + gsel) * 128 + cc * 8);
            const float s = rv[R0 + row];
            v4u o; o.x = pk2(gelu_f(lo16(w.x)) * s, gelu_f(hi16(w.x)) * s); o.y = pk2(gelu_f(lo16(w.y)) * s, gelu_f(hi16(w.y)) * s);
            o.z = pk2(gelu_f(lo16(w.z)) * s, gelu_f(hi16(w.z)) * s); o.w = pk2(gelu_f(lo16(w.w)) * s, gelu_f(hi16(w.w)) * s);
            *(LAS v4u*)(lds + (gsel * 2 + (row >> 6)) * 16384 + at::v_st(row & 63, cc * 8)) = o;
        }
        __syncthreads();
        const int gsel = wid >> 2, g = 2 * gp + gsel, t = 32 * (wid & 3) + r32;
        f32x16 o[4] = {};
        const int nst = (wid & 3) >= 2 ? 2 : 1;
        for (int st = 0; st < nst; ++st) {
            bf16x8 pa[4];
#pragma unroll
            for (int ks = 0; ks < 4; ++ks) {
                const int s0 = st * 64 + ks * 16 + hi * 8;
                const float* wp = Ws + ((size_t)g * 128 + t) * 128 + s0;
                const v4f a = *(const v4f*)wp, b = *(const v4f*)(wp + 4);
                float x[8] = {a.x, a.y, a.z, a.w, b.x, b.y, b.z, b.w};
#pragma unroll
                for (int j = 0; j < 8; ++j) if (s0 + j > t) x[j] = 0.f;
                at::u32x4 w4 = {at::cvtpk(x[0], x[1]), at::cvtpk(x[2], x[3]), at::cvtpk(x[4], x[5]), at::cvtpk(x[6], x[7])};
                pa[ks] = *reinterpret_cast<bf16x8*>(&w4);
            }
            const unsigned vbase = (unsigned)(size_t)(lds + (gsel * 2 + st) * 16384) + (unsigned)at::v_rd_base(lane);
            at::pv_tile(o, vbase, pa[0], pa[1], pa[2], pa[3]);
        }
#pragma unroll
        for (int d0 = 0; d0 < 4; ++d0) { const int gc = g * 128 + d0 * 32 + r32; const float vgc = vg[gc];
            unsigned short ur[16], zr[16];
#pragma unroll
            for (int r = 0; r < 16; ++r) { const size_t row = (size_t)(R0 + 32 * (wid & 3) + at::crow(r, hi)); ur[r] = proj[row * NPROJ + C_UB + gc]; zr[r] = proj[row * NPROJ + C_ZB + gc]; }
#pragma unroll
            for (int r = 0; r < 16; ++r) { const int tl = 32 * (wid & 3) + at::crow(r, hi); const size_t row = (size_t)(R0 + tl);
                const float mix = o[d0][r] * vgc + bs[g * 128 + tl];
                const float y = gelu_f(bf2f(ur[r])) * mix * silu_f(bf2f(zr[r])), yn = lane_xor<1>(y);
                if ((r32 & 1) == 0) *(unsigned*)(YB + row * 1024 + gc) = at::cvtpk(y, yn); } }
        __syncthreads();
    }
}
}


namespace gl {
using at::bf16x8; using at::f32x16; using at::s16x4; using at::u32x4;
constexpr int OFF_VIMG = 0, OFF_KLIMG = 65536, OFF_ATT = 98304, OFF_DS = 131072, OFF_PART = 131584, LDS_NEED = OFF_PART + 4096;

__device__ __forceinline__ void gla_prep_item(LAS unsigned char* lds, int seg_off, const bf16* proj, const float* wa2, const float* ba, bf16* QE, bf16* KE, bf16* KL, float* DS, int ci) {
    const int tid = otid(), k2 = tid & 63, ts = tid >> 6, k = 2 * k2;
    LAS float* seg = (LAS float*)(lds + seg_off);
    {
        const int ch = ci >> 2, h = ci & 3, R0 = ch * 128 + ts * 16;
        float wa0[16], wa1[16];
#pragma unroll
        for (int j = 0; j < 16; ++j) { const v2f w = *(const v2f*)(wa2 + j * 512 + h * 128 + k); wa0[j] = w.x; wa1[j] = w.y; }
        const v2f bak = *(const v2f*)(ba + h * 128 + k);
        float la0[16], la1[16]; float run0 = 0.f, run1 = 0.f;
#pragma unroll
        for (int i = 0; i < 16; ++i) {
            const bf16* pr = proj + (size_t)(R0 + i) * NPROJ + C_AR;
            const v4u w0 = *(const v4u*)pr, w1 = *(const v4u*)(pr + 8);
            const float ar[16] = {lo16(w0.x), hi16(w0.x), lo16(w0.y), hi16(w0.y), lo16(w0.z), hi16(w0.z), lo16(w0.w), hi16(w0.w),
                                  lo16(w1.x), hi16(w1.x), lo16(w1.y), hi16(w1.y), lo16(w1.z), hi16(w1.z), lo16(w1.w), hi16(w1.w)};
            float x0 = bak.x, x1 = bak.y;
#pragma unroll
            for (int j = 0; j < 16; ++j) { x0 += ar[j] * wa0[j]; x1 += ar[j] * wa1[j]; }
            run0 += (fminf(x0, 0.f) - __logf(1.0f + __expf(-fabsf(x0)))) * 0.0625f; la0[i] = run0;
            run1 += (fminf(x1, 0.f) - __logf(1.0f + __expf(-fabsf(x1)))) * 0.0625f; la1[i] = run1;
        }
        *(LAS v2f*)(seg + ts * 128 + k) = (v2f){run0, run1};
        __syncthreads();
        float pre0 = 0.f, pre1 = 0.f, tot0 = 0.f, tot1 = 0.f;
#pragma unroll
        for (int q = 0; q < 8; ++q) { const v2f sg = *(const LAS v2f*)(seg + q * 128 + k); tot0 += sg.x; tot1 += sg.y; if (q < ts) { pre0 += sg.x; pre1 += sg.y; } }
        const float et0 = __expf(tot0), et1 = __expf(tot1);
        unsigned qw[16], kw[16];
#pragma unroll
        for (int i = 0; i < 16; ++i) { const size_t row = (size_t)(R0 + i); qw[i] = *(const unsigned*)(proj + row * NPROJ + C_QC + h * 128 + k); kw[i] = *(const unsigned*)(proj + row * NPROJ + C_KC + h * 128 + k); }
#pragma unroll
        for (int i = 0; i < 16; ++i) {
            const size_t o = (size_t)(R0 + i) * 512 + h * 128 + k;
            const float e0 = __expf(la0[i] + pre0), e1 = __expf(la1[i] + pre1), r0 = __builtin_amdgcn_rcpf(e0), r1 = __builtin_amdgcn_rcpf(e1);
            const float q0 = lo16(qw[i]) * 0.08838834764831845f, q1 = hi16(qw[i]) * 0.08838834764831845f, kk0 = lo16(kw[i]) * r0, kk1 = hi16(kw[i]) * r1;
            *(unsigned*)(QE + o) = pk2(q0 * e0, q1 * e1);
            *(unsigned*)(KE + o) = pk2(kk0, kk1);
            *(unsigned*)(KL + o) = pk2(kk0 * et0, kk1 * et1);
        }
        if (ts == 0) *(v2f*)(DS + ((size_t)ch * 4 + h) * 128 + k) = (v2f){et0, et1};
        __syncthreads();
    }
}

#define GL_PK4(P, B_, OUT) do { unsigned a0 = at::cvtpk(P[B_+0], P[B_+1]), a1 = at::cvtpk(P[B_+2], P[B_+3]);                          \
        unsigned b0 = at::cvtpk(P[B_+4], P[B_+5]), b1 = at::cvtpk(P[B_+6], P[B_+7]);                                             \
        auto r0 = __builtin_amdgcn_permlane32_swap(a0, b0, false, false); auto r1 = __builtin_amdgcn_permlane32_swap(a1, b1, false, false); \
        u32x4 w = {r0[0], r1[0], r0[1], r1[1]}; OUT = *reinterpret_cast<bf16x8*>(&w); } while (0)
#define GL_TRRD(dst, addr, off) asm volatile("ds_read_b64_tr_b16 %0, %1 offset:%2" : "=&v"(dst) : "v"(addr), "i"(off) : "memory")

__device__ __forceinline__ void gla_chunk_item(LAS unsigned char* lds, const bf16* proj, const bf16* QE, const bf16* KE, const bf16* KL, float* OI, float* DL, int ci) {
    const int tid = otid(), wid = __builtin_amdgcn_readfirstlane(tid >> 6), lane = tid & 63, r32 = lane & 31, hi = lane >> 5;
    const int h = ci & 3, R0 = (ci >> 2) * 128;
    {
        {
#pragma unroll
            for (int i = 0; i < 8; ++i) { const int idx = tid + 512 * i, s = idx >> 5, cc = idx & 31;
                const v4u w = *(const v4u*)(proj + (size_t)(R0 + s) * NPROJ + C_VC + h * 256 + cc * 8);
                *(LAS v4u*)(lds + OFF_VIMG + ((s >> 6) * 2 + (cc >> 4)) * 16384 + at::v_st(s & 63, (cc & 15) * 8)) = w; }
#pragma unroll
            for (int i = 0; i < 4; ++i) { const int idx = tid + 512 * i, s = idx >> 4, cc = idx & 15;
                const v4u w = *(const v4u*)(KL + (size_t)(R0 + s) * 512 + h * 128 + cc * 8);
                *(LAS v4u*)(lds + OFF_KLIMG + (s >> 6) * 16384 + at::v_st(s & 63, cc * 8)) = w; }
#pragma unroll
            for (int j = 0; j < 2; ++j) {
                const int ti = 2 * wid + j, st = ti >> 2, tt = ti & 3;
                if (st <= tt) {
                    f32x16 p = {};
                    const bf16* ap = KE + (size_t)(R0 + 32 * st + r32) * 512 + h * 128 + hi * 8;
                    const bf16* bp = QE + (size_t)(R0 + 32 * tt + r32) * 512 + h * 128 + hi * 8;
                    bf16x8 fa[8], fb[8];
#pragma unroll
                    for (int ks = 0; ks < 8; ++ks) { fa[ks] = *(const bf16x8*)(ap + ks * 16); fb[ks] = *(const bf16x8*)(bp + ks * 16); }
#pragma unroll
                    for (int ks = 0; ks < 8; ++ks) p = __builtin_amdgcn_mfma_f32_32x32x16_bf16(fa[ks], fb[ks], p, 0, 0, 0);
                    __builtin_amdgcn_sched_group_barrier(0x020, 16, 0); __builtin_amdgcn_sched_group_barrier(0x008, 8, 0);
                    if (st == tt) {
#pragma unroll
                        for (int r = 0; r < 16; ++r) if (at::crow(r, hi) > r32) p[r] = 0.f; }
                    const int t = 32 * tt + r32;
#pragma unroll
                    for (int g = 0; g < 4; ++g) { v2u w; w.x = at::cvtpk(p[4 * g], p[4 * g + 1]); w.y = at::cvtpk(p[4 * g + 2], p[4 * g + 3]);
                        *(LAS v2u*)(lds + OFF_ATT + t * 256 + ((64 * st + 16 * g) ^ ((t & 7) << 4)) + 8 * hi) = w; }
                }
            }
            __syncthreads();
            bf16x8 vfr[8];
            { const unsigned vaddr = (unsigned)(size_t)(lds + OFF_VIMG + (wid >> 2) * 16384) + (unsigned)at::v_rd_base(lane) + (unsigned)((wid & 3) * 512);
              s16x4 vl[8], vh[8];
#define GL_VF(ks8) do { constexpr int o_ = ((ks8) >> 2) * 32768 + ((ks8) & 3) * 4096; GL_TRRD(vl[ks8], vaddr, o_); GL_TRRD(vh[ks8], vaddr, o_ + 2048); } while (0)
              GL_VF(0); GL_VF(1); GL_VF(2); GL_VF(3); GL_VF(4); GL_VF(5); GL_VF(6); GL_VF(7);
#undef GL_VF
              asm volatile("s_waitcnt lgkmcnt(0)" ::: "memory"); AT_SBAR();
#pragma unroll
              for (int q = 0; q < 8; ++q) vfr[q] = (bf16x8){vl[q][0], vl[q][1], vl[q][2], vl[q][3], vh[q][0], vh[q][1], vh[q][2], vh[q][3]};
              AT_SBAR(); }
            float* oi = OI + (((size_t)ci * 8 + wid) * 16 * 64 + lane) * 4;
            float* dl = DL + (((size_t)ci * 8 + wid) * 16 * 64 + lane) * 4;
#pragma unroll
            for (int tt = 0; tt < 4; ++tt) {
                f32x16 acc = {};
                const int t = 32 * tt + r32;
#pragma unroll
                for (int ks8 = 0; ks8 < 8; ++ks8) if (ks8 <= 2 * tt + 1) {
                    const bf16x8 a = *(const LAS bf16x8*)(lds + OFF_ATT + t * 256 + (((16 * ks8 + 8 * hi) * 2) ^ ((t & 7) << 4)));
                    acc = __builtin_amdgcn_mfma_f32_32x32x16_bf16(a, vfr[ks8], acc, 0, 0, 0); }
#pragma unroll
                for (int r4 = 0; r4 < 4; ++r4) *(v4f*)(oi + (size_t)(tt * 4 + r4) * 256) = (v4f){acc[4 * r4], acc[4 * r4 + 1], acc[4 * r4 + 2], acc[4 * r4 + 3]};
            }
#pragma unroll
            for (int kt = 0; kt < 4; ++kt) {
                f32x16 D = {};
                const unsigned kaddr = (unsigned)(size_t)(lds + OFF_KLIMG) + (unsigned)at::v_rd_base(lane) + (unsigned)(kt * 512);
#define GL_KF(ks8) do { s16x4 l_, h_; constexpr int o_ = ((ks8) >> 2) * 16384 + ((ks8) & 3) * 4096; GL_TRRD(l_, kaddr, o_); GL_TRRD(h_, kaddr, o_ + 2048); \
                asm volatile("s_waitcnt lgkmcnt(0)" ::: "memory"); AT_SBAR(); \
                D = __builtin_amdgcn_mfma_f32_32x32x16_bf16((bf16x8){l_[0], l_[1], l_[2], l_[3], h_[0], h_[1], h_[2], h_[3]}, vfr[ks8], D, 0, 0, 0); } while (0)
                GL_KF(0); GL_KF(1); GL_KF(2); GL_KF(3); GL_KF(4); GL_KF(5); GL_KF(6); GL_KF(7);
#undef GL_KF
#pragma unroll
                for (int r4 = 0; r4 < 4; ++r4) *(v4f*)(dl + (size_t)(kt * 4 + r4) * 256) = (v4f){D[4 * r4], D[4 * r4 + 1], D[4 * r4 + 2], D[4 * r4 + 3]};
            }
            __syncthreads();
        }
    }
}

__device__ __forceinline__ void gla_stageA_item(const float* DS, const float* DL, bf16* XB, int b, int h, int vp) {
    const int tid = otid(), wid = __builtin_amdgcn_readfirstlane(tid >> 6), lane = tid & 63, hi = lane >> 5;
    const int vb = 2 * vp + (wid >> 2), kt = wid & 3;
    constexpr int PF = 4, NC = SEQ / 128;
    f32x16 X = {};
    v4f dq[PF][4], sq[PF][4];
    const size_t ci0 = (size_t)(b * 32) * 4 + h;
#define GL_ALOAD(slot, c_) do { const size_t ci_ = ci0 + (size_t)(c_) * 4; const float* dl_ = DL + ((ci_ * 8 + vb) * 16 * 64 + lane) * 4 + (size_t)(kt * 4) * 256; const float* ds_ = DS + ci_ * 128 + 32 * kt + 4 * hi; \
        _Pragma("unroll") for (int r4 = 0; r4 < 4; ++r4) { dq[slot][r4] = *(const v4f*)(dl_ + (size_t)r4 * 256); sq[slot][r4] = *(const v4f*)(ds_ + 8 * r4); } } while (0)
#pragma unroll
    for (int s = 0; s < PF; ++s) GL_ALOAD(s, s);
    for (int c0 = 0; c0 < NC; c0 += PF) {
#pragma unroll
        for (int s = 0; s < PF; ++s) {
            const int c = c0 + s; const size_t ci = ci0 + (size_t)c * 4;
            bf16* xo = XB + (((ci * 8 + vb) * 8 + kt * 2) * 64 + lane) * 8;
            bf16x8 xb0, xb1; GL_PK4(X, 0, xb0); GL_PK4(X, 8, xb1);
            *(bf16x8*)xo = xb0; *(bf16x8*)(xo + 512) = xb1;
#pragma unroll
            for (int r4 = 0; r4 < 4; ++r4) { const v4f w = dq[s][r4], d4 = sq[s][r4];
                X[4 * r4] = X[4 * r4] * d4.x + w.x; X[4 * r4 + 1] = X[4 * r4 + 1] * d4.y + w.y; X[4 * r4 + 2] = X[4 * r4 + 2] * d4.z + w.z; X[4 * r4 + 3] = X[4 * r4 + 3] * d4.w + w.w; }
            if (c + PF < NC) GL_ALOAD(s, c + PF);
        }
    }
#undef GL_ALOAD
}
__device__ __forceinline__ void gla_stageB_item(const bf16* proj, const bf16* QE, const float* OI, const bf16* XB, const float* og, bf16* YC, int b, int h, int cp) {
    const int tid = otid(), wid = __builtin_amdgcn_readfirstlane(tid >> 6), lane = tid & 63, r32 = lane & 31, hi = lane >> 5;
    {
        const int c = 2 * cp + (wid >> 2), tt = wid & 3, R0 = b * SEQ + c * 128;
        const size_t ci = (size_t)(b * 32 + c) * 4 + h;
        f32x16 acc[8];
#pragma unroll
        for (int vb = 0; vb < 8; ++vb) { const float* oi = OI + ((ci * 8 + vb) * 16 * 64 + lane) * 4 + (size_t)(tt * 4) * 256;
#pragma unroll
            for (int r4 = 0; r4 < 4; ++r4) { const v4f w = *(const v4f*)(oi + (size_t)r4 * 256); acc[vb][4 * r4] = w.x; acc[vb][4 * r4 + 1] = w.y; acc[vb][4 * r4 + 2] = w.z; acc[vb][4 * r4 + 3] = w.w; } }
        bf16x8 qa[8];
        { const bf16* qp = QE + (size_t)(R0 + 32 * tt + r32) * 512 + h * 128 + hi * 8;
#pragma unroll
          for (int ks = 0; ks < 8; ++ks) qa[ks] = *(const bf16x8*)(qp + ks * 16); }
        if (c > 0) {
            const bf16* xi = XB + (((ci * 8) * 8) * 64 + lane) * 8;
            bf16x8 xf[64];
#pragma unroll
            for (int i = 0; i < 64; ++i) xf[i] = *(const bf16x8*)(xi + (size_t)i * 512);
#pragma unroll
            for (int i = 0; i < 64; ++i) acc[i >> 3] = __builtin_amdgcn_mfma_f32_32x32x16_bf16(qa[i & 7], xf[i], acc[i >> 3], 0, 0, 0);
            __builtin_amdgcn_sched_group_barrier(0x020, 16, 0);
#pragma unroll
            for (int i = 0; i < 48; ++i) { __builtin_amdgcn_sched_group_barrier(0x008, 1, 0); __builtin_amdgcn_sched_group_barrier(0x020, 1, 0); }
            __builtin_amdgcn_sched_group_barrier(0x008, 16, 0);
        }
        float rn[16];
#pragma unroll
        for (int r = 0; r < 16; ++r) { float s = 0.f;
#pragma unroll
            for (int vb = 0; vb < 8; ++vb) s += acc[vb][r] * acc[vb][r];
            s += lane_xor<1>(s); s += lane_xor<2>(s); s += lane_xor<4>(s); s += lane_xor<8>(s); s += lane_xor<16>(s);
            rn[r] = 1.0f / sqrtf(s * (1.0f / 256.f) + EPS); }
#pragma unroll
        for (int vb = 0; vb < 8; ++vb) { const float gcol = og[32 * vb + r32];
            unsigned short zr[16];
#pragma unroll
            for (int r = 0; r < 16; ++r) zr[r] = proj[(size_t)(R0 + 32 * tt + at::crow(r, hi)) * NPROJ + C_ZC + h * 256 + 32 * vb + r32];
#pragma unroll
            for (int r = 0; r < 16; ++r) { const size_t row = (size_t)(R0 + 32 * tt + at::crow(r, hi));
                const float y = acc[vb][r] * rn[r] * gcol * silu_f(bf2f(zr[r])), yn = lane_xor<1>(y);
                if ((r32 & 1) == 0) *(unsigned*)(YC + row * 1024 + h * 256 + 32 * vb + r32) = at::cvtpk(y, yn); } }
    }
}
#undef GL_PK4
#undef GL_TRRD
}


constexpr int CW_Q = 65536;
__device__ __forceinline__ int q_pop(unsigned* ctr, LAS unsigned* slot) {
    if (otid() == 0) *slot = __hip_atomic_fetch_add(ctr, 1u, __ATOMIC_RELAXED, __HIP_MEMORY_SCOPE_AGENT);
    __syncthreads(); const int v = (int)*slot; __syncthreads(); return v; }
__device__ __forceinline__ void ph_mixers(LAS unsigned char* lds, unsigned char* ws, unsigned* qctr, const float* Ws, const float* bs, const float* vg, const float* og, const float* qg, int row0, int vb) {
    constexpr int NGLA = NBP * 8, NATT = 16 * NBP, NSGU = 16 * NBP, NQ = NGLA + NATT + NSGU;
    static_assert(NBP % 2 == 0, "NBP even");
    LAS unsigned* slot = (LAS unsigned*)(lds + LDSCTL_OFF + 64);
    bf16* proj = (bf16*)(ws + WS_PROJ);
    for (int dq = 0; dq < 8; ++dq) {
        const int q = (vb + dq) & 7;
        for (;;) {
            const int idx = q_pop(qctr + q * 64, slot);
            if (idx >= NQ) break;
            if (idx >= NATT && idx < NATT + NGLA) { const int gi = q * NGLA + (idx - NATT), bh = gi >> 4, cp = gi & 15;
                gl::gla_stageB_item(proj, (const bf16*)(ws + WS_QE), (const float*)(ws + WS_OC), (const bf16*)(ws + WS_XB), og, (bf16*)(ws + WS_YC), bh >> 2, bh & 3, cp); }
            else if (idx < NATT) { const int j = idx, qb = 15 - j / NBP, bh = q * NBP + j % NBP;
                at::attn_block(lds, (const bf16*)(ws + WS_Q), (const bf16*)(ws + WS_K), (const bf16*)(ws + WS_KV), proj, (bf16*)(ws + WS_YA), qg, (const float*)(ws + WS_COS) + (size_t)row0 * 32, (const float*)(ws + WS_SIN) + (size_t)row0 * 32, bh >> 3, bh & 7, qb); }
            else { const int it = q * NSGU + (idx - NGLA - NATT);
                sg::sgu_item(lds, proj, (const float*)(ws + WS_RV), Ws, bs, vg, (bf16*)(ws + WS_YB), it); }
        }
    }
}
#ifndef GEMM_SP2
#define GEMM_SP2 true
#endif
#ifndef GEMM_ALIGN
#define GEMM_ALIGN true
#endif
typedef const __attribute__((address_space(4))) Args* KArgP;
#define KARG() ({ KArgP p_ = (KArgP)__builtin_amdgcn_kernarg_segment_ptr(); asm volatile("" : "+s"(p_)); p_; })
#define INF(i) ((const float*)ap->in[i])
__device__ __forceinline__ void grid_bar(const XcdBarrier& b0) { XcdBarrier b = b0; asm volatile("" : "+s"(b.bar)); xcd_barrier(b); }

__global__ void __launch_bounds__(512, 2) fwd(Args a) {
    extern __shared__ __attribute__((aligned(16))) unsigned char lds_raw[];
    LAS unsigned char* lds = (LAS unsigned char*)lds_raw;
    const int lo = a.lo, hi = a.hi;
    XcdBarrier bar; bar.bar = (unsigned*)(a.ws + WS_CTL) + CW_BAR; bar.x = 0; bar.st = nullptr;
    if (hi - lo > 1) {
        if (threadIdx.x < 4) ((LAS unsigned*)(lds + LDSCTL_OFF))[threadIdx.x] = 0u;
        __syncthreads();
        bar = xcd_barrier_post((unsigned*)(a.ws + WS_CTL) + CW_BAR, (volatile LAS unsigned*)(lds + LDSCTL_OFF));
    }
    int step = 0;
#define PH_BEGIN if (step >= lo && step < hi) { const KArgP ap = KARG(); unsigned char* const ws = ap->ws; const int vb = obid(), nvb = gridDim.x; (void)ws; (void)vb; (void)nvb;
#define PH_END   if (step + 1 < hi) grid_bar(bar); } ++step;
#define WL(l) (ws + WS_W + (size_t)(l) * SZ_WLAYER)
#define B_(T, off) ((T*)(ws + (off)))

    for (int l = 0; l < DEPTH; ++l) {
        PH_BEGIN
            { unsigned char* wl = ws + WS_W;
              convert_T<1>(INF(3) + (size_t)l * DM * IN_COLS, DM, IN_COLS, (bf16*)wl, NPROJ, (LAS float*)lds, vb, nvb);
              convert_T<0>(INF(6) + (size_t)l * 512 * 1536, 512, 1536, (bf16*)(wl + SZ_WIN), 1536, (LAS float*)lds, (vb + 64) % nvb, nvb);
              convert_T<0>(INF(7) + (size_t)l * 512 * 2048, 512, 2048, (bf16*)(wl + SZ_WIN + SZ_WUQ), 2048, (LAS float*)lds, (vb + 128) % nvb, nvb);
              for (int b = 0; b < 3; ++b)
                  convert_T<0>(INF(16) + ((size_t)l * 3 + b) * 1024 * 2048, 1024, 2048, (bf16*)(wl + SZ_WIN + SZ_WUQ + SZ_WUKV) + (size_t)b * 2048 * 1024, 2048, (LAS float*)lds, (vb + 32 * b) % nvb, nvb);
              convert_T<0>(INF(17) + (size_t)l * 2048 * 2048, 2048, 2048, (bf16*)(wl + SZ_WIN + SZ_WUQ + SZ_WUKV + SZ_WB), 2048, (LAS float*)lds, (vb + 192) % nvb, nvb); }
            if (l == 0) { const int* positions = (const int*)ap->in[1]; float* cosT = B_(float, WS_COS); float* sinT = B_(float, WS_SIN);
              for (int idx = vb * 512 + otid(); idx < MTOK * 32; idx += nvb * 512) {
                const int t = idx >> 5, i = idx & 31;
                const float inv = 1.0f / powf(10000.0f, (float)(2 * i) * (1.0f / 64.0f));
                const float ang = (float)positions[t] * inv;
                float sn, cs; sincosf(ang, &sn, &cs);
                cosT[idx] = cs; sinT[idx] = sn; } }
        PH_END
        for (int p = 0; p < NPASS; ++p) {
            const int row0 = p * MP;
#define XIN ((l == 0 ? (const float*)ap->in[0] : (const float*)ap->out) + (size_t)row0 * DM)
#define WLP (ws + WS_W)
            PH_BEGIN ph_norm(XIN, INF(2) + l * DM, B_(bf16, WS_H), MP, vb, nvb); PH_END
            PH_BEGIN { pg8::Gemm g{B_(bf16, WS_H), (const bf16*)WLP, MP, NPROJ, DM}; pg8::StaticOrder S; S.init(MP, NPROJ, nvb, vb); pg8::EpiBf16<0> E{B_(bf16, WS_PROJ), NPROJ, nullptr, 0, 0};
                       pg8::gemm_phase<pg8::EpiBf16<0>, pg8::StaticOrder, false, GEMM_ALIGN, GEMM_SP2>(lds, g, S, E, nullptr); } PH_END
            PH_BEGIN ph_prep(B_(bf16, WS_PROJ), INF(4) + l * 512, INF(5) + l * 512, B_(bf16, WS_CQN), B_(bf16, WS_CKVN), B_(float, WS_RV), vb, nvb); PH_END
            PH_BEGIN { { pg8::Gemm g{B_(bf16, WS_CQN), (const bf16*)(WLP + SZ_WIN), MP, 1536, 512}; pg8::StaticOrder S; S.init(MP, 1536, nvb, vb); pg8::EpiBf16<0> E{B_(bf16, WS_Q), 1536, nullptr, 0, 0};
                         pg8::gemm_phase<pg8::EpiBf16<0>, pg8::StaticOrder, false, GEMM_ALIGN, GEMM_SP2>(lds, g, S, E, nullptr); }
                       { pg8::Gemm g{B_(bf16, WS_CKVN), (const bf16*)(WLP + SZ_WIN + SZ_WUQ), MP, 2048, 512}; pg8::StaticOrder S; S.init(MP, 2048, nvb, nvb - 1 - vb); pg8::EpiBf16<0> E{B_(bf16, WS_KV), 2048, nullptr, 0, 0};
                         pg8::gemm_phase<pg8::EpiBf16<0>, pg8::StaticOrder, false, GEMM_ALIGN, GEMM_SP2>(lds, g, S, E, nullptr); }
                       for (int ci = vb; ci < (MP / 128) * 4; ci += nvb) {
                           gl::gla_prep_item(lds, 135168, B_(bf16, WS_PROJ), INF(13) + l * 16 * 512, INF(14) + l * 512, B_(bf16, WS_QE), B_(bf16, WS_KE), B_(bf16, WS_KL), B_(float, WS_DS), ci);
                           gl::gla_chunk_item(lds, B_(bf16, WS_PROJ), B_(bf16, WS_QE), B_(bf16, WS_KE), B_(bf16, WS_KL), B_(float, WS_OC), B_(float, WS_DL), ci); } } PH_END
            PH_BEGIN { constexpr int NA = NBP * 16;
                       if (nvb > 2 * NA) { if (vb < NA) gl::gla_stageA_item(B_(float, WS_DS), B_(float, WS_DL), B_(bf16, WS_XB), vb >> 4, (vb >> 2) & 3, vb & 3);
                                           else ph_kfin(B_(bf16, WS_KV), B_(bf16, WS_PROJ), B_(bf16, WS_K), INF(9) + l * 192, B_(float, WS_COS), B_(float, WS_SIN), row0, vb - NA, nvb - NA); }
                       else { for (int it = vb; it < NA; it += nvb) gl::gla_stageA_item(B_(float, WS_DS), B_(float, WS_DL), B_(bf16, WS_XB), it >> 4, (it >> 2) & 3, it & 3);
                              ph_kfin(B_(bf16, WS_KV), B_(bf16, WS_PROJ), B_(bf16, WS_K), INF(9) + l * 192, B_(float, WS_COS), B_(float, WS_SIN), row0, vb, nvb); } } PH_END
            PH_BEGIN ph_mixers(lds, ws, (unsigned*)(ws + WS_CTL) + CW_Q + (l * NPASS + p) * 8 * 64, INF(11) + (size_t)l * 8 * 128 * 128, INF(12) + l * 8 * 128, INF(10) + l * 1024, INF(15) + l * 256, INF(8) + l * 192, row0, vb); PH_END
            PH_BEGIN { pg8::Gemm g{B_(bf16, WS_YA), (const bf16*)(WLP + SZ_WIN + SZ_WUQ + SZ_WUKV), MP, 2048, 1024};
                       pg8::BranchOrder S; S.init(MP, 2048, nvb, vb); S.NB = 3; S.a_stride = (size_t)MP * 1024 * 2; S.b_stride = (size_t)2048 * 1024 * 2;
                       pg8::EpiMerge E{B_(bf16, WS_PROJ) + C_GATE, NPROJ, B_(bf16, WS_MG), 2048, 2048}; pg8::gemm_phase<pg8::EpiMerge, pg8::BranchOrder, false, GEMM_ALIGN, GEMM_SP2>(lds, g, S, E, nullptr); } PH_END
            PH_BEGIN { pg8::Gemm g{B_(bf16, WS_MG), (const bf16*)(WLP + SZ_WIN + SZ_WUQ + SZ_WUKV + SZ_WB), MP, 2048, 2048}; pg8::StaticOrder S; S.init(MP, 2048, nvb, vb); pg8::EpiRes E{XIN, ap->out + (size_t)row0 * DM, 2048};
                       pg8::gemm_phase<pg8::EpiRes, pg8::StaticOrder, false, GEMM_ALIGN, GEMM_SP2>(lds, g, S, E, nullptr); } PH_END
        }
    }
#undef PH_BEGIN
#undef PH_END
}

#ifndef ONE_LAUNCH
#define ONE_LAUNCH 1
#endif
extern "C" void kernel_launch(void* const* d_in, const int* in_sizes, int n_in, void* d_out, int out_size, void* d_ws, size_t ws_size, hipStream_t stream) {
    static int grid = 0;
    if (grid == 0) {
        if (n_in != 18 || out_size != MTOK * DM || ws_size < WS_END) { fprintf(stderr, "kernel_launch: unexpected shapes (n_in %d out %d ws %zu need %zu)\n", n_in, out_size, ws_size, (size_t)WS_END); grid = -1; return; }
        int dev = 0, cus = 0, per_cu = 0;
        if (hipGetDevice(&dev) != hipSuccess || hipDeviceGetAttribute(&cus, hipDeviceAttributeMultiprocessorCount, dev) != hipSuccess) { grid = -1; return; }
        if (hipFuncSetAttribute((const void*)fwd, hipFuncAttributeMaxDynamicSharedMemorySize, LDS_BYTES) != hipSuccess) { fprintf(stderr, "kernel_launch: hipFuncSetAttribute failed\n"); grid = -1; return; }
        if (hipOccupancyMaxActiveBlocksPerMultiprocessor(&per_cu, (const void*)fwd, 512, LDS_BYTES) != hipSuccess || per_cu < 1) { fprintf(stderr, "kernel_launch: occupancy query says %d\n", per_cu); }
        (void)hipGetLastError();
        grid = cus;
    }
    if (grid < 0) return;
    (void)hipMemsetAsync((char*)d_ws + WS_CTL, 0, CTL_BYTES, stream);
    Args a{};
    for (int i = 0; i < 18; ++i) a.in[i] = d_in[i];
    a.out = (float*)d_out; a.ws = (unsigned char*)d_ws; a.pad0 = 0; a.pad1 = 0;
#if ONE_LAUNCH
    a.lo = 0; a.hi = NSTEPS;
    hipLaunchKernelGGL(fwd, dim3(grid), dim3(512), LDS_BYTES, stream, a);
#else
    for (int s = 0; s < NSTEPS; ++s) { a.lo = s; a.hi = s + 1; hipLaunchKernelGGL(fwd, dim3(grid), dim3(512), LDS_BYTES, stream, a); }
#endif
}
```

```cpp
#include <hip/hip_runtime.h>
#include <cstdio>
#include <cstdint>
__device__ __forceinline__ int otid() { int t = threadIdx.x; asm volatile("" : "+v"(t)); return t; }
__device__ __forceinline__ int obid() { int t = blockIdx.x; asm volatile("" : "+s"(t)); return t; }
namespace pg8 {
#define PG8_LAS __attribute__((address_space(3)))
typedef unsigned short bf16_t;
typedef short bf16x8 __attribute__((ext_vector_type(8)));
typedef float f32x4 __attribute__((ext_vector_type(4)));
typedef unsigned u32x4 __attribute__((ext_vector_type(4)));
constexpr int BM = 256, BK = 64, HALF = 128, HTB = HALF * BK * 2  , STAGE_BYTES = 8 * HTB, NXCD = 8, WGM = 4;

__host__ __device__ __forceinline__ int lds_byte(int r, int c) { const int st = (r >> 4) * 2 + (c >> 5), rr = r & 15, cc = c & 31, ob = rr * 64 + cc * 2; return st * 1024 + (ob ^ (((ob >> 9) & 1) << 5)); }
__host__ __device__ __forceinline__ void stage_rc(int b, int& R, int& C) { const int st = b / 1024, sb = b % 1024, swz = sb ^ (((sb >> 9) & 1) << 5); R = (st >> 1) * 16 + swz / 64; C = (st & 1) * 32 + (swz % 64) / 2; }
__host__ __device__ __forceinline__ int perm32(int rho) { const int n = rho >> 4, i = rho & 15; return 8 * (i >> 2) + 4 * n + (i & 3); }

struct Unit { int pm, pn, pb; };
struct Gemm { const bf16_t* A; const bf16_t* Bt; int M, N, K; int lda; };

struct StaticOrder {
    int nM, nN, nwg, G, c;
    __host__ __device__ void init(int M, int N, int G_, int c_) { nM = M / BM; nN = N / BM; nwg = nM * nN; G = G_; c = c_; }
    __host__ __device__ bool next(int i, Unit& u) const {
        const long L = (long)i * G + c; if (L >= nwg) return false;
        int wgid = (int)L; { const int q = nwg / NXCD, r = nwg % NXCD, xcd = wgid % NXCD, off = wgid / NXCD; wgid = (xcd < r ? xcd * (q + 1) : r * (q + 1) + (xcd - r) * q) + off; }
        const int nig = WGM * nN, gid = wgid / nig, fm = gid * WGM, gsz = (nM - fm) < WGM ? (nM - fm) : WGM;
        u.pm = fm + ((wgid % nig) % gsz); u.pn = (wgid % nig) / gsz; u.pb = 0; return true;
    }
    __device__ __forceinline__ size_t a_off(const Unit&) const { return 0; }
    __device__ __forceinline__ size_t b_off(const Unit&) const { return 0; }
    __device__ __forceinline__ void a_ready(const Unit&) const {}
    __device__ __forceinline__ void done(const Unit&) const {}
};

struct BranchOrder : StaticOrder {
    int NB; size_t a_stride, b_stride;
    __device__ bool next(int i, Unit& u) const { const int ti = i / NB; if (!StaticOrder::next(ti, u)) return false; u.pb = i - ti * NB; return true; }
    __device__ __forceinline__ size_t a_off(const Unit& u) const { return (size_t)u.pb * a_stride; }
    __device__ __forceinline__ size_t b_off(const Unit& u) const { return (size_t)u.pb * b_stride; }
};

__device__ __forceinline__ unsigned cvt_pk_bf16(float lo, float hi) { unsigned r; asm volatile("v_cvt_pk_bf16_f32 %0, %1, %2" : "=v"(r) : "v"(lo), "v"(hi)); return r; }
typedef float f32x2 __attribute__((ext_vector_type(2)));
__device__ __forceinline__ f32x2 gelu_pk(f32x2 v) {
    const f32x2 av = __builtin_elementwise_abs(v), d = av * 0.2316418882f + 1.0f;
    f32x2 t; t.x = __builtin_amdgcn_rcpf(d.x); t.y = __builtin_amdgcn_rcpf(d.y);
    f32x2 q = t * 0.5307027145f + (-0.7265760135f); q = q * t + 0.7107068705f; q = q * t + (-0.142248368f); q = q * t + 0.127414796f; q = q * t;
    const f32x2 s = (v * v) * (-0.72134752044f);
    f32x2 e; e.x = __builtin_amdgcn_exp2f(s.x); e.y = __builtin_amdgcn_exp2f(s.y);
    const f32x2 m = v * (q * e), r = v - m;
    f32x2 o; o.x = v.x < 0.f ? m.x : r.x; o.y = v.y < 0.f ? m.y : r.y; return o;
}

struct EpiF32 {
    static constexpr bool PERM = false, AFTER_DRAIN = false;
    float* C; int ldc; const float* bias;
    __device__ __forceinline__ void operator()(const f32x4 (&acc)[2][2][4][2], const Unit& u, int wr, int wc, int fr, int fq) const {
        const int row0 = u.pm * BM + wr * 64 + fr, col0 = u.pn * BM + wc * 32 + 4 * fq;
        f32x4 bv[2][2];
#pragma unroll
        for (int bj = 0; bj < 2; ++bj)
#pragma unroll
            for (int n = 0; n < 2; ++n) bv[bj][n] = bias ? *(const f32x4*)(bias + col0 + bj * HALF + n * 16) : (f32x4){0.f, 0.f, 0.f, 0.f};
#pragma unroll
        for (int ai = 0; ai < 2; ++ai)
#pragma unroll
            for (int m = 0; m < 4; ++m) { float* rowp = C + (size_t)(row0 + ai * HALF + m * 16) * ldc + col0;
#pragma unroll
                for (int bj = 0; bj < 2; ++bj)
#pragma unroll
                    for (int n = 0; n < 2; ++n) *(f32x4*)(rowp + bj * HALF + n * 16) = acc[ai][bj][m][n] + bv[bj][n]; }
    }
};
template <int ACT  > struct EpiBf16 {
    static constexpr bool PERM = true, AFTER_DRAIN = false;
    bf16_t* O; int ldc; const float* bias; int split_cols; size_t split_stride;
    __device__ __forceinline__ void operator()(const f32x4 (&acc)[2][2][4][2], const Unit& u, int wr, int wc, int fr, int fq) const {
        const int row0 = u.pm * BM + wr * 64 + fr; int colt = u.pn * BM; bf16_t* base = O;
        if (split_cols) { const int t = colt / split_cols; base += (size_t)t * split_stride; colt -= t * split_cols; }
        const int col0 = colt + wc * 32 + 8 * fq, bcol0 = u.pn * BM + wc * 32 + 8 * fq;
        f32x4 bv[2][2];
#pragma unroll
        for (int bj = 0; bj < 2; ++bj)
#pragma unroll
            for (int n = 0; n < 2; ++n) bv[bj][n] = bias ? *(const f32x4*)(bias + bcol0 + bj * HALF + 4 * n) : (f32x4){0.f, 0.f, 0.f, 0.f};
#pragma unroll
        for (int ai = 0; ai < 2; ++ai)
#pragma unroll
            for (int m = 0; m < 4; ++m) { bf16_t* rowp = base + (size_t)(row0 + ai * HALF + m * 16) * ldc + col0;
#pragma unroll
                for (int bj = 0; bj < 2; ++bj) { f32x4 v0 = acc[ai][bj][m][0] + bv[bj][0], v1 = acc[ai][bj][m][1] + bv[bj][1];
                    if (ACT == 1) { f32x2 a = gelu_pk((f32x2){v0[0], v0[1]}), b = gelu_pk((f32x2){v0[2], v0[3]}), c = gelu_pk((f32x2){v1[0], v1[1]}), d = gelu_pk((f32x2){v1[2], v1[3]});
                        v0 = (f32x4){a.x, a.y, b.x, b.y}; v1 = (f32x4){c.x, c.y, d.x, d.y}; }
                    if (ACT == 2) {
#pragma unroll
                        for (int j = 0; j < 4; ++j) { v0[j] = 0.5f * v0[j] * (1.0f + erff(v0[j] * 0.70710678f)); v1[j] = 0.5f * v1[j] * (1.0f + erff(v1[j] * 0.70710678f)); } }
                    u32x4 w; w.x = cvt_pk_bf16(v0[0], v0[1]); w.y = cvt_pk_bf16(v0[2], v0[3]); w.z = cvt_pk_bf16(v1[0], v1[1]); w.w = cvt_pk_bf16(v1[2], v1[3]);
                    *(u32x4*)(rowp + bj * HALF) = w; } }
    }
};


__device__ __forceinline__ float gelu_tanh_f(float x) { const float u2 = 1.5957691216057308f * (x + 0.044715f * x * x * x); return x * __builtin_amdgcn_rcpf(1.f + __expf(-u2)); }
struct EpiProj {
    static constexpr bool PERM = true, AFTER_DRAIN = false;
    bf16_t* O; int ldc; float* SSQ; int mrows;
    __device__ __forceinline__ void operator()(const f32x4 (&acc)[2][2][4][2], const Unit& u, int wr, int wc, int fr, int fq) const {
        const int row0 = u.pm * BM + wr * 64 + fr, col0 = u.pn * BM + wc * 32 + 8 * fq;
        const int seg = u.pn < 2 ? 0 : (u.pn < 4 ? 1 : ((u.pn >= 12 && u.pn < 16) ? 2 : -1));
#pragma unroll
        for (int ai = 0; ai < 2; ++ai)
#pragma unroll
            for (int m = 0; m < 4; ++m) { const int row = row0 + ai * HALF + m * 16; bf16_t* rowp = O + (size_t)row * ldc + col0;
                float ss = 0.f;
#pragma unroll
                for (int bj = 0; bj < 2; ++bj) { const f32x4 v0 = acc[ai][bj][m][0], v1 = acc[ai][bj][m][1];
                    u32x4 w; w.x = cvt_pk_bf16(v0[0], v0[1]); w.y = cvt_pk_bf16(v0[2], v0[3]); w.z = cvt_pk_bf16(v1[0], v1[1]); w.w = cvt_pk_bf16(v1[2], v1[3]);
                    *(u32x4*)(rowp + bj * HALF) = w;
                    if (seg >= 0) {
#pragma unroll
                        for (int j = 0; j < 4; ++j) { float a = v0[j], b = v1[j]; if (seg == 2) { a = gelu_tanh_f(a); b = gelu_tanh_f(b); } ss += a * a + b * b; } } }
                if (seg >= 0) {
                    ss += __uint_as_float((unsigned)__builtin_amdgcn_ds_swizzle((int)__float_as_uint(ss), (16 << 10) | 0x1f));
                    auto rr = __builtin_amdgcn_permlane32_swap(__float_as_uint(ss), __float_as_uint(ss), false, false);
                    ss = __uint_as_float(rr[0]) + __uint_as_float(rr[1]);
                    if (fq == 0) atomicAdd(SSQ + (size_t)seg * mrows + row, ss); } }
    }
};
struct EpiBf16Row {
    static constexpr bool PERM = true, AFTER_DRAIN = false;
    bf16_t* O; int ldc; const float* SSQ; float inv_n, eps;
    __device__ __forceinline__ void operator()(const f32x4 (&acc)[2][2][4][2], const Unit& u, int wr, int wc, int fr, int fq) const {
        const int row0 = u.pm * BM + wr * 64 + fr, col0 = u.pn * BM + wc * 32 + 8 * fq;
#pragma unroll
        for (int ai = 0; ai < 2; ++ai)
#pragma unroll
            for (int m = 0; m < 4; ++m) { const int row = row0 + ai * HALF + m * 16; bf16_t* rowp = O + (size_t)row * ldc + col0;
                const float rn = 1.0f / sqrtf(SSQ[row] * inv_n + eps);
#pragma unroll
                for (int bj = 0; bj < 2; ++bj) { const f32x4 v0 = acc[ai][bj][m][0] * rn, v1 = acc[ai][bj][m][1] * rn;
                    u32x4 w; w.x = cvt_pk_bf16(v0[0], v0[1]); w.y = cvt_pk_bf16(v0[2], v0[3]); w.z = cvt_pk_bf16(v1[0], v1[1]); w.w = cvt_pk_bf16(v1[2], v1[3]);
                    *(u32x4*)(rowp + bj * HALF) = w; } }
    }
};

struct EpiRes {
    static constexpr bool PERM = false, AFTER_DRAIN = false;
    const float* base; float* C; int ldc;
    __device__ __forceinline__ void operator()(const f32x4 (&acc)[2][2][4][2], const Unit& u, int wr, int wc, int fr, int fq) const {
        const int row0 = u.pm * BM + wr * 64 + fr, col0 = u.pn * BM + wc * 32 + 4 * fq;
#pragma unroll
        for (int ai = 0; ai < 2; ++ai) {
            f32x4 bs[4][2][2];
#pragma unroll
            for (int m = 0; m < 4; ++m) { const size_t off = (size_t)(row0 + ai * HALF + m * 16) * ldc + col0;
#pragma unroll
                for (int bj = 0; bj < 2; ++bj)
#pragma unroll
                    for (int n = 0; n < 2; ++n) bs[m][bj][n] = *(const f32x4*)(base + off + bj * HALF + n * 16); }
#pragma unroll
            for (int m = 0; m < 4; ++m) { const size_t off = (size_t)(row0 + ai * HALF + m * 16) * ldc + col0;
#pragma unroll
                for (int bj = 0; bj < 2; ++bj)
#pragma unroll
                    for (int n = 0; n < 2; ++n) *(f32x4*)(C + off + bj * HALF + n * 16) = acc[ai][bj][m][n] + bs[m][bj][n]; }
            asm volatile("" ::: "memory");
        }
    }
};
struct EpiMerge {
    static constexpr bool PERM = true, AFTER_DRAIN = false;
    const bf16_t* G0; int ldg; bf16_t* MG; int ldc; int gstride;
    __device__ __forceinline__ void operator()(const f32x4 (&acc)[2][2][4][2], const Unit& u, int wr, int wc, int fr, int fq) const {
        const int row0 = u.pm * BM + wr * 64 + fr, col0 = u.pn * BM + wc * 32 + 8 * fq; const bf16_t* G = G0 + (size_t)u.pb * gstride; const bool first = u.pb == 0;
#pragma unroll
        for (int ai = 0; ai < 2; ++ai) {
            u32x4 gw[4][2], ow[4][2];
#pragma unroll
            for (int m = 0; m < 4; ++m) { const size_t row = (size_t)(row0 + ai * HALF + m * 16);
#pragma unroll
                for (int bj = 0; bj < 2; ++bj) { gw[m][bj] = *(const u32x4*)(G + row * ldg + col0 + bj * HALF); ow[m][bj] = first ? (u32x4){0u, 0u, 0u, 0u} : *(const u32x4*)(MG + row * ldc + col0 + bj * HALF); } }
#pragma unroll
            for (int m = 0; m < 4; ++m) { const size_t row = (size_t)(row0 + ai * HALF + m * 16);
#pragma unroll
                for (int bj = 0; bj < 2; ++bj) { const f32x4 v0 = acc[ai][bj][m][0], v1 = acc[ai][bj][m][1];
                    const unsigned g4[4] = {gw[m][bj].x, gw[m][bj].y, gw[m][bj].z, gw[m][bj].w}, o4[4] = {ow[m][bj].x, ow[m][bj].y, ow[m][bj].z, ow[m][bj].w};
                    const float a8[8] = {v0[0], v0[1], v0[2], v0[3], v1[0], v1[1], v1[2], v1[3]};
                    unsigned w4[4];
#pragma unroll
                    for (int q = 0; q < 4; ++q) {
                        const float g0 = __uint_as_float(g4[q] << 16), g1 = __uint_as_float(g4[q] & 0xffff0000u);
                        const float r0 = __uint_as_float(o4[q] << 16) + a8[2 * q] * __builtin_amdgcn_rcpf(1.0f + __expf(-g0));
                        const float r1 = __uint_as_float(o4[q] & 0xffff0000u) + a8[2 * q + 1] * __builtin_amdgcn_rcpf(1.0f + __expf(-g1));
                        unsigned pk; asm("v_cvt_pk_bf16_f32 %0, %1, %2" : "=v"(pk) : "v"(r0), "v"(r1)); w4[q] = pk; }
                    *(u32x4*)(MG + row * ldc + col0 + bj * HALF) = (u32x4){w4[0], w4[1], w4[2], w4[3]}; } }
            asm volatile("" ::: "memory");
        }
    }
};

template <class Epi, class Sched, bool STAMP = false, bool ALIGN_EPI = false, bool SP2 = false>
__device__ __forceinline__ void gemm_phase(PG8_LAS unsigned char* lds, const Gemm g, const Sched& S, const Epi& E, unsigned long long* stamps) {
    const int tid = otid(), wid = __builtin_amdgcn_readfirstlane(tid >> 6), lane = tid & 63, wr = wid >> 2, wc = wid & 3, fr = lane & 15, fq = lane >> 4;
    const int K = g.K, nt = K / BK, LDA = g.lda ? g.lda : g.K;
    int ts_lo = 0, ts_hi = 0, nts = 0; const unsigned long long rt_entry = STAMP ? (unsigned long long)wall_clock64() : 0ull;
#define PG8_STAMP() do { if (STAMP && wid == 0 && nts < 64) { const unsigned long long _c = (unsigned long long)clock64(); \
        ts_lo = (lane == nts) ? (int)(unsigned)_c : ts_lo; ts_hi = (lane == nts) ? (int)(unsigned)(_c >> 32) : ts_hi; ++nts; } } while (0)
    PG8_STAMP();
    unsigned voffA[2], voffB[2];
#pragma unroll
    for (int i = 0; i < 2; ++i) { int R, C; stage_rc(tid * 16 + i * 8192, R, C); const int Rb = Epi::PERM ? ((R & ~31) + perm32(R & 31)) : R;
        voffA[i] = (unsigned)(R * LDA + C) * 2u; voffB[i] = (unsigned)(Rb * K + C) * 2u; }
    const size_t kstep = (size_t)(BK * 2);
    const size_t hstepB = (size_t)HALF * K * 2, hstepA = (size_t)HALF * LDA * 2;
    const size_t tstepB = 2 * hstepB, tstepA = 2 * hstepA;
    const unsigned ldsw = (unsigned)wid * 1024u;
    const int aoff = lds_byte(wr * 64 + fr, fq * 8), boff = lds_byte(wc * 32 + fr, fq * 8);
#define PG8_SA(b, h) (((b) * 2 + (h)) * HTB)
#define PG8_SB(b, h) ((4 + (b) * 2 + (h)) * HTB)
#define PG8_STAGE(bufoff, gbase, voff) do { _Pragma("unroll") for (int _i = 0; _i < 2; ++_i) \
        __builtin_amdgcn_global_load_lds((const unsigned*)((const char*)(gbase) + (voff)[_i]), (PG8_LAS unsigned*)(lds + (bufoff) + ldsw + _i * 8192), 16, 0, 0); } while (0)
#define PG8_LDA(dst, b, h) do { _Pragma("unroll") for (int m = 0; m < 4; ++m) _Pragma("unroll") for (int k = 0; k < 2; ++k) dst[m][k] = *(const PG8_LAS bf16x8*)(lds + PG8_SA(b, h) + aoff + m * 2048 + k * 1024); } while (0)
#define PG8_LDB(dst, b, h) do { _Pragma("unroll") for (int n = 0; n < 2; ++n) _Pragma("unroll") for (int k = 0; k < 2; ++k) dst[n][k] = *(const PG8_LAS bf16x8*)(lds + PG8_SB(b, h) + boff + n * 2048 + k * 1024); } while (0)
#define PG8_MMA(ai, bj, At, Bt) do { __builtin_amdgcn_s_setprio(1); _Pragma("unroll") for (int m = 0; m < 4; ++m) _Pragma("unroll") for (int n = 0; n < 2; ++n) _Pragma("unroll") for (int k = 0; k < 2; ++k) \
        acc[ai][bj][m][n] = __builtin_amdgcn_mfma_f32_16x16x32_bf16(Bt[n][k], At[m][k], acc[ai][bj][m][n], 0, 0, 0); __builtin_amdgcn_s_setprio(0); } while (0)
#define PG8_WAIT_V(n) asm volatile("s_waitcnt vmcnt(" #n ")" ::: "memory")
#define PG8_WAIT_L(n) asm volatile("s_waitcnt lgkmcnt(" #n ")" ::: "memory")
#define PG8_BAR __builtin_amdgcn_s_barrier()
#define PG8_SCHED __builtin_amdgcn_sched_barrier(0)
    Unit cur, nxt; int ui = 0;
    if (!S.next(0, cur)) return;
    f32x4 acc[2][2][4][2];
#pragma unroll
    for (int a = 0; a < 2; ++a)
#pragma unroll
        for (int b = 0; b < 2; ++b)
#pragma unroll
            for (int m = 0; m < 4; ++m)
#pragma unroll
                for (int n = 0; n < 2; ++n) acc[a][b][m][n] = (f32x4){0.f, 0.f, 0.f, 0.f};
    bf16x8 At[4][2], B0[2][2], B1[2][2];
    const char* cA = (const char*)g.A + (size_t)cur.pm * tstepA + S.a_off(cur); const char* cB = (const char*)g.Bt + (size_t)cur.pn * tstepB + S.b_off(cur);
    S.a_ready(cur);
    if constexpr (SP2) {
        PG8_STAGE(PG8_SB(0, 0), cB, voffB); PG8_STAGE(PG8_SB(0, 1), cB + hstepB, voffB); PG8_STAGE(PG8_SA(0, 0), cA, voffA); PG8_STAGE(PG8_SA(0, 1), cA + hstepA, voffA);
        if (wr == 1) PG8_BAR;
        PG8_WAIT_V(2); PG8_BAR;
        PG8_STAGE(PG8_SB(1, 0), cB + kstep, voffB); PG8_STAGE(PG8_SA(1, 0), cA + kstep, voffA); PG8_STAGE(PG8_SB(1, 1), cB + hstepB + kstep, voffB);
        PG8_WAIT_V(6); PG8_BAR;
    } else {
    PG8_STAGE(PG8_SB(0, 0), cB, voffB); PG8_STAGE(PG8_SA(0, 0), cA, voffA); PG8_STAGE(PG8_SB(0, 1), cB + hstepB, voffB); PG8_STAGE(PG8_SA(0, 1), cA + hstepA, voffA);
    if (wr == 1) PG8_BAR;
    PG8_WAIT_V(4); PG8_BAR;
    PG8_STAGE(PG8_SB(1, 0), cB + kstep, voffB); PG8_STAGE(PG8_SA(1, 0), cA + kstep, voffA); PG8_STAGE(PG8_SB(1, 1), cB + hstepB + kstep, voffB);
    PG8_WAIT_V(6); PG8_BAR;
    }
    PG8_STAMP();
    for (;;) {
        const bool has_next = S.next(ui + 1, nxt);
        const char* nA = has_next ? (const char*)g.A + (size_t)nxt.pm * tstepA + S.a_off(nxt) : cA; const char* nB = has_next ? (const char*)g.Bt + (size_t)nxt.pn * tstepB + S.b_off(nxt) : cB;
        for (int t = 0; t < nt; t += 2) {
            const bool last = (t == nt - 2);
            const char* a1 = cA + (size_t)(t + 1) * kstep;
            const char* a2 = last ? nA : cA + (size_t)(t + 2) * kstep; const char* b2 = last ? nB : cB + (size_t)(t + 2) * kstep;
            const char* a3 = a2 + kstep; const char* b3 = b2 + kstep;
            if (last && has_next) S.a_ready(nxt);
            if constexpr (SP2) {
            PG8_LDB(B0, 0, 0); PG8_LDB(B1, 0, 1); PG8_SCHED; PG8_LDA(At, 0, 0); PG8_STAGE(PG8_SA(1, 1), a1 + hstepA, voffA);
            PG8_WAIT_V(8); PG8_WAIT_L(0); PG8_BAR; PG8_MMA(0, 0, At, B0); PG8_MMA(0, 1, At, B1); PG8_BAR; PG8_SCHED;
            PG8_LDA(At, 0, 1); PG8_STAGE(PG8_SB(0, 0), b2, voffB); PG8_STAGE(PG8_SB(0, 1), b2 + hstepB, voffB); PG8_STAGE(PG8_SA(0, 0), a2, voffA);
            PG8_WAIT_V(8); PG8_WAIT_L(0); PG8_BAR; PG8_MMA(1, 0, At, B0); PG8_MMA(1, 1, At, B1); PG8_BAR; PG8_SCHED;
            PG8_LDB(B0, 1, 0); PG8_LDB(B1, 1, 1); PG8_SCHED; PG8_LDA(At, 1, 0); PG8_STAGE(PG8_SA(0, 1), a2 + hstepA, voffA);
            PG8_WAIT_V(8); PG8_WAIT_L(0); PG8_BAR; PG8_MMA(0, 0, At, B0); PG8_MMA(0, 1, At, B1); PG8_BAR; PG8_SCHED;
            PG8_LDA(At, 1, 1); PG8_STAGE(PG8_SB(1, 0), b3, voffB); PG8_STAGE(PG8_SB(1, 1), b3 + hstepB, voffB); PG8_STAGE(PG8_SA(1, 0), a3, voffA);
            PG8_WAIT_V(8); PG8_WAIT_L(0); PG8_BAR; PG8_MMA(1, 0, At, B0); PG8_MMA(1, 1, At, B1); PG8_BAR; PG8_SCHED;
            } else {
            PG8_LDB(B0, 0, 0); PG8_SCHED; PG8_LDA(At, 0, 0); PG8_STAGE(PG8_SA(1, 1), a1 + hstepA, voffA);
            PG8_WAIT_L(8); PG8_BAR; PG8_WAIT_L(0); PG8_MMA(0, 0, At, B0); PG8_BAR; PG8_SCHED;
            PG8_LDB(B1, 0, 1); PG8_STAGE(PG8_SB(0, 0), b2, voffB);
            PG8_BAR; PG8_WAIT_L(0); PG8_MMA(0, 1, At, B1); PG8_BAR;
            PG8_LDA(At, 0, 1); PG8_STAGE(PG8_SA(0, 0), a2, voffA);
            PG8_BAR; PG8_WAIT_L(0); PG8_MMA(1, 0, At, B0); PG8_BAR; PG8_SCHED;
            PG8_STAGE(PG8_SB(0, 1), b2 + hstepB, voffB);
            PG8_WAIT_V(6); PG8_BAR; PG8_MMA(1, 1, At, B1); PG8_BAR;
            PG8_LDB(B0, 1, 0); PG8_SCHED; PG8_LDA(At, 1, 0); PG8_STAGE(PG8_SA(0, 1), a2 + hstepA, voffA);
            PG8_WAIT_L(8); PG8_BAR; PG8_WAIT_L(0); PG8_MMA(0, 0, At, B0); PG8_BAR; PG8_SCHED;
            PG8_LDB(B1, 1, 1); PG8_STAGE(PG8_SB(1, 0), b3, voffB);
            PG8_BAR; PG8_WAIT_L(0); PG8_MMA(0, 1, At, B1); PG8_BAR;
            PG8_LDA(At, 1, 1); PG8_STAGE(PG8_SA(1, 0), a3, voffA);
            PG8_BAR; PG8_WAIT_L(0); PG8_MMA(1, 0, At, B0); PG8_BAR; PG8_SCHED;
            PG8_STAGE(PG8_SB(1, 1), b3 + hstepB, voffB);
            PG8_WAIT_V(6); PG8_BAR; PG8_MMA(1, 1, At, B1); PG8_BAR;
            }
        }
        if constexpr (ALIGN_EPI) { if (wr == 0) PG8_BAR; }
        PG8_STAMP();
        if constexpr (!Epi::AFTER_DRAIN) { E(acc, cur, wr, wc, fr, fq); S.done(cur); }
        PG8_STAMP();
        if (!has_next) break;
#pragma unroll
        for (int a = 0; a < 2; ++a)
#pragma unroll
            for (int b = 0; b < 2; ++b)
#pragma unroll
                for (int m = 0; m < 4; ++m)
#pragma unroll
                    for (int n = 0; n < 2; ++n) acc[a][b][m][n] = (f32x4){0.f, 0.f, 0.f, 0.f};
        cur = nxt; cA = nA; cB = nB; ++ui;
        if constexpr (ALIGN_EPI) { if (wr == 1) PG8_BAR; }
    }
    PG8_WAIT_V(0);
    if constexpr (!ALIGN_EPI) { if (wr == 0) PG8_BAR; }
    PG8_BAR;
    if constexpr (Epi::AFTER_DRAIN) { E.fused(acc, cur, wr, wc, fr, fq, lds, wid, lane); S.done(cur); }
    PG8_STAMP();
    if (STAMP && wid == 0) { stamps[lane] = lane < nts ? (((unsigned long long)(unsigned)ts_hi << 32) | (unsigned)ts_lo) : 0ull;
        if (lane == 62) stamps[62] = rt_entry; if (lane == 63) stamps[63] = (unsigned long long)wall_clock64(); }
#undef PG8_STAMP
#undef PG8_SA
#undef PG8_SB
#undef PG8_STAGE
#undef PG8_LDA
#undef PG8_LDB
#undef PG8_MMA
#undef PG8_WAIT_V
#undef PG8_WAIT_L
#undef PG8_BAR
#undef PG8_SCHED
}
}
#define XB_TMO      128
#define XB_XCNT(j)  (256  + 64 * (j))
#define XB_XSUB(j)  (1280 + 64 * (j))
#define XB_XGEN(j)  (2304 + 64 * (j))
#define XB_TOP      3328
#define XB_TOPGEN   3392
#define XCD_BAR_WORDS 3456
#define XB_SPIN_CAP (1u << 18)
#define LAS __attribute__((address_space(3)))

__device__ __forceinline__ unsigned xb_ld(unsigned* p)              { return __hip_atomic_load(p, __ATOMIC_RELAXED, __HIP_MEMORY_SCOPE_AGENT); }
__device__ __forceinline__ unsigned xb_add(unsigned* p, unsigned v) { return __hip_atomic_fetch_add(p, v, __ATOMIC_RELAXED, __HIP_MEMORY_SCOPE_AGENT); }
__device__ __forceinline__ unsigned xb_xcc_id() { return (unsigned)__builtin_amdgcn_s_getreg((3 << 11) | 20) & 0xFu; }
#define XB_SPIN(cond, bar) do { unsigned _sp = 0; while (cond) { __builtin_amdgcn_s_sleep(1); \
    if ((++_sp & 255u) == 0u) { if (xb_ld(&(bar)[XB_TMO])) break; if (_sp > XB_SPIN_CAP) { atomicAdd(&(bar)[XB_TMO], 1u); break; } } } } while (0)

struct XcdBarrier {
    unsigned* bar; unsigned x;
    volatile LAS unsigned* st;
};

__device__ __forceinline__ XcdBarrier xcd_barrier_post(unsigned* bar, volatile LAS unsigned* st) {
    XcdBarrier b; b.bar = bar; b.x = xb_xcc_id(); b.st = st;
    if (threadIdx.x == 0) (void)xb_add(&bar[XB_XCNT(b.x)], 1u);
    return b;
}
__device__ __forceinline__ void xcd_barrier_complete(unsigned* bar, unsigned x, unsigned& nloc, unsigned& nx) {
    const unsigned G = gridDim.x * gridDim.y * gridDim.z;
    unsigned sum, cnt, mine, sp = 0u;
    for (;;) {
        sum = 0u; cnt = 0u; mine = 0u;
#pragma unroll
        for (unsigned j = 0; j < 16; ++j) { const unsigned c = xb_ld(&bar[XB_XCNT(j)]); sum += c; cnt += (c > 0u) ? 1u : 0u; mine = (j == x) ? c : mine; }
        if (sum == G) break;
        __builtin_amdgcn_s_sleep(1);
        if ((++sp & 255u) == 0u) { if (xb_ld(&bar[XB_TMO])) break; if (sp > XB_SPIN_CAP) { atomicAdd(&bar[XB_TMO], 1u); break; } }
    }
    nloc = mine > 0u ? mine : 1u; nx = cnt > 0u ? cnt : 1u;
}

__device__ __forceinline__ void xcd_barrier(const XcdBarrier& b) {
    asm volatile("s_waitcnt vmcnt(0)" ::: "memory");
    __syncthreads();
    if (threadIdx.x == 0) {
        unsigned* bar = b.bar;
        __builtin_amdgcn_s_waitcnt(0);
        unsigned nloc = b.st[0], nx = b.st[1];
        if (nloc == 0u) { xcd_barrier_complete(bar, b.x, nloc, nx); b.st[0] = nloc; b.st[1] = nx; }
        const unsigned old = xb_add(&bar[XB_XSUB(b.x)], 1u);
        const unsigned gen = old / nloc;
        if (old + 1u == (gen + 1u) * nloc) {
            __builtin_amdgcn_fence(__ATOMIC_RELEASE, "agent");
            asm volatile("s_waitcnt vmcnt(0)" ::: "memory");
            const unsigned og = xb_add(&bar[XB_TOP], 1u);
            const unsigned tg = og / nx;
            if (og + 1u == (tg + 1u) * nx) xb_add(&bar[XB_TOPGEN], 1u);
            else XB_SPIN(xb_ld(&bar[XB_TOPGEN]) == tg, bar);
            __builtin_amdgcn_fence(__ATOMIC_ACQUIRE, "agent");
            xb_add(&bar[XB_XGEN(b.x)], 1u);
            asm volatile("s_waitcnt vmcnt(0)" ::: "memory");
        } else {
            XB_SPIN(xb_ld(&bar[XB_XGEN(b.x)]) == gen, bar);
            __builtin_amdgcn_fence(__ATOMIC_ACQUIRE, "agent");
            asm volatile("s_waitcnt vmcnt(0)" ::: "memory");
        }
    }
    __syncthreads();
}


typedef unsigned short bf16;
typedef unsigned v4u __attribute__((ext_vector_type(4)));
typedef unsigned v2u __attribute__((ext_vector_type(2)));
typedef float v4f __attribute__((ext_vector_type(4)));
typedef float v2f __attribute__((ext_vector_type(2)));

constexpr int DM = 2048, NBATCH = 8, SEQ = 4096, DEPTH = 2, MTOK = NBATCH * SEQ;
constexpr int IN_COLS = 14416, NPROJ = 14592;
constexpr int C_CQ = 0, C_CKV = 512, C_ZA = 1024, C_UB = 2048, C_VB = 3072, C_ZB = 4096, C_QC = 5120, C_KC = 5632, C_VC = 6144, C_ZC = 7168,
              C_GATE = 8192, C_KROPE = 14336, C_AR = 14400;
constexpr float EPS = 1e-6f;
#ifndef NBP
#define NBP 4
#endif
constexpr int MP = NBP * SEQ, NPASS = NBATCH / NBP;
constexpr int STEPS_PER_PASS = 7;
constexpr int NSTEPS = DEPTH * (1 + NPASS * STEPS_PER_PASS);

constexpr size_t al256(size_t x) { return (x + 255) & ~(size_t)255; }
constexpr size_t WS_CTL = 0, CTL_BYTES = 1u << 20;
constexpr size_t SZ_WIN = (size_t)NPROJ * DM * 2, SZ_WUQ = (size_t)1536 * 512 * 2, SZ_WUKV = (size_t)2048 * 512 * 2, SZ_WB = (size_t)3 * 2048 * 1024 * 2, SZ_WO = (size_t)2048 * 2048 * 2;
constexpr size_t SZ_WLAYER = SZ_WIN + SZ_WUQ + SZ_WUKV + SZ_WB + SZ_WO;
constexpr size_t WS_W = CTL_BYTES;
constexpr size_t WS_COS = WS_W + SZ_WLAYER, WS_SIN = WS_COS + (size_t)MTOK * 32 * 4;
constexpr size_t WS_H = WS_SIN + (size_t)MTOK * 32 * 4;
constexpr size_t WS_MG = WS_H;
constexpr size_t WS_PROJ = WS_H + (size_t)MP * DM * 2;
constexpr size_t WS_CQN = WS_PROJ + (size_t)MP * NPROJ * 2;
constexpr size_t WS_CKVN = WS_CQN + (size_t)MP * 512 * 2;
constexpr size_t WS_XB = WS_CQN;
constexpr size_t WS_SSQ = WS_CKVN + (size_t)MP * 512 * 2;
constexpr size_t WS_Q = WS_SSQ + al256((size_t)3 * MP * 4);
constexpr size_t WS_KV = WS_Q + (size_t)MP * 1536 * 2;
constexpr size_t WS_K = WS_KV + (size_t)MP * 2048 * 2;
constexpr size_t WS_YA = WS_K + (size_t)MP * 1536 * 2;
constexpr size_t WS_YB = WS_YA + (size_t)MP * 1024 * 2;
constexpr size_t WS_DL = WS_YA;
constexpr size_t WS_YC = WS_YB + (size_t)MP * 1024 * 2;
constexpr size_t WS_OC = WS_YC + (size_t)MP * 1024 * 2;
constexpr size_t WS_QE = WS_OC + (size_t)MP * 1024 * 4;
constexpr size_t WS_KE = WS_QE + (size_t)MP * 512 * 2, WS_KL = WS_KE + (size_t)MP * 512 * 2;
constexpr size_t WS_DS = WS_KL + (size_t)MP * 512 * 2;
constexpr size_t WS_END = WS_DS + (size_t)(MP / 128) * 512 * 4;
static_assert(WS_END <= ((size_t)1 << 30), "workspace map exceeds 1 GiB");

constexpr int LDS_BYTES = 147456;
constexpr int LDSCTL_OFF = LDS_BYTES - 256;
constexpr int CW_BAR = 4096;

__device__ __forceinline__ float bf2f(unsigned v) { return __uint_as_float(v << 16); }
__device__ __forceinline__ unsigned f2bf(float f) { unsigned u = __float_as_uint(f); return (u + 0x7fffu + ((u >> 16) & 1u)) >> 16; }
__device__ __forceinline__ unsigned pk2(float lo, float hi) { return f2bf(lo) | (f2bf(hi) << 16); }
__device__ __forceinline__ float lo16(unsigned w) { return __uint_as_float(w << 16); }
__device__ __forceinline__ float hi16(unsigned w) { return __uint_as_float(w & 0xffff0000u); }
__device__ __forceinline__ float sigmoid_f(float x) { return 1.f / (1.f + __expf(-x)); }
__device__ __forceinline__ float silu_f(float x) { return x / (1.f + __expf(-x)); }
__device__ __forceinline__ float gelu_f(float x) { const float u2 = 1.5957691216057308f * (x + 0.044715f * x * x * x); return x * __builtin_amdgcn_rcpf(1.f + __expf(-u2)); }
template <int O> __device__ __forceinline__ float lane_xor(float v) {
    if (O == 1) return __uint_as_float((unsigned)__builtin_amdgcn_mov_dpp((int)__float_as_uint(v), 0xB1, 0xf, 0xf, true));
    if (O == 2) return __uint_as_float((unsigned)__builtin_amdgcn_mov_dpp((int)__float_as_uint(v), 0x4E, 0xf, 0xf, true));
    return __uint_as_float((unsigned)__builtin_amdgcn_ds_swizzle((int)__float_as_uint(v), (O << 10) | 0x1f)); }
__device__ __forceinline__ float lane_xor32(float v, int lane) {
    auto rr = __builtin_amdgcn_permlane32_swap(__float_as_uint(v), __float_as_uint(v), false, false);
    return __uint_as_float(lane < 32 ? rr[1] : rr[0]); }
__device__ __forceinline__ float wave_sum(float v) {
    v += lane_xor<1>(v); v += lane_xor<2>(v); v += lane_xor<4>(v); v += lane_xor<8>(v); v += lane_xor<16>(v);
    auto rr = __builtin_amdgcn_permlane32_swap(__float_as_uint(v), __float_as_uint(v), false, false);
    return __uint_as_float(rr[0]) + __uint_as_float(rr[1]); }
__device__ __forceinline__ float wave_max(float v) {
    v = fmaxf(v, lane_xor<1>(v)); v = fmaxf(v, lane_xor<2>(v)); v = fmaxf(v, lane_xor<4>(v)); v = fmaxf(v, lane_xor<8>(v)); v = fmaxf(v, lane_xor<16>(v));
    auto rr = __builtin_amdgcn_permlane32_swap(__float_as_uint(v), __float_as_uint(v), false, false);
    return fmaxf(__uint_as_float(rr[0]), __uint_as_float(rr[1])); }
#define LDS_FENCE() asm volatile("s_waitcnt lgkmcnt(0)" ::: "memory")

struct Args { const void* in[18]; float* out; unsigned char* ws; int lo, hi, pad0, pad1; };

template <int MODE> __device__ __forceinline__ int src_col(int n) {
    if (MODE == 0) return n;
    if (n < C_ZA) return n;
    if (n < C_ZC) return n + 64;
    if (n < C_KROPE) return n + 80;
    if (n < C_AR) return 1024 + (n - C_KROPE);
    if (n < C_AR + 16) return 7232 + (n - C_AR);
    return -1;
}
template <int MODE> __device__ __forceinline__ void convert_T(const float* W, int K, int Nsrc, bf16* WT, int Ndst, LAS float* tile, int vb, int nvb, const float* kscale = nullptr) {
    const int tid = otid(), ntk = K / 64, ntn = Ndst / 64, ntiles = ntk * ntn;
    for (int t = vb; t < ntiles; t += nvb) {
        const int k0 = (t % ntk) * 64, n0 = (t / ntk) * 64;
        { const int nn = tid & 63, sc = src_col<MODE>(n0 + nn);
#pragma unroll
          for (int i = 0; i < 8; ++i) { const int kk = (tid >> 6) + 8 * i; tile[kk * 65 + nn] = sc >= 0 ? W[(size_t)(k0 + kk) * Nsrc + sc] * (kscale ? kscale[k0 + kk] : 1.f) : 0.f; } }
        __syncthreads();
        { const int nn = tid & 63, kg = tid >> 6;
          const LAS float* tp = tile + (kg * 8) * 65 + nn;
          v4u o; o.x = pk2(tp[0], tp[65]); o.y = pk2(tp[2 * 65], tp[3 * 65]); o.z = pk2(tp[4 * 65], tp[5 * 65]); o.w = pk2(tp[6 * 65], tp[7 * 65]);
          *(v4u*)(WT + (size_t)(n0 + nn) * K + k0 + kg * 8) = o; }
        __syncthreads();
    }
}

__device__ __forceinline__ void ph_norm(const float* xin, const float* g, bf16* h, int rows, int vb, int nvb) {
    const int tid_ = otid(); const int lane = tid_ & 63, wave = tid_ >> 6;
    for (int r = vb * 8 + wave; r < rows; r += nvb * 8) {
        const v4f* xr = (const v4f*)(xin + (size_t)r * DM);
        v4f v[8]; float ss = 0.f;
#pragma unroll
        for (int j = 0; j < 8; ++j) { v[j] = xr[lane + 64 * j]; ss += v[j].x * v[j].x + v[j].y * v[j].y + v[j].z * v[j].z + v[j].w * v[j].w; }
        ss = wave_sum(ss);
        const float rn = 1.0f / sqrtf(ss * (1.0f / DM) + EPS);
#pragma unroll
        for (int j = 0; j < 8; ++j) { const v4f gg = ((const v4f*)g)[lane + 64 * j];
            v2u o; o.x = pk2(v[j].x * rn * gg.x, v[j].y * rn * gg.y); o.y = pk2(v[j].z * rn * gg.z, v[j].w * rn * gg.w);
            *(v2u*)(h + (size_t)r * DM + (lane + 64 * j) * 4) = o; }
    }
}
__device__ __forceinline__ void ph_prep(const bf16* proj, const float* gq, const float* gkv, bf16* cqn, bf16* ckvn, float* rv, int vb, int nvb) {
    const int tid_ = otid(); const int lane = tid_ & 63, wave = tid_ >> 6;
    for (int r = vb * 8 + wave; r < MP; r += nvb * 8) {
        const bf16* pr = proj + (size_t)r * NPROJ;
#pragma unroll
        for (int which = 0; which < 2; ++which) {
            const v4u w = *(const v4u*)(pr + (which ? C_CKV : C_CQ) + lane * 8);
            float x[8] = {lo16(w.x), hi16(w.x), lo16(w.y), hi16(w.y), lo16(w.z), hi16(w.z), lo16(w.w), hi16(w.w)};
            float ss = 0.f;
#pragma unroll
            for (int i = 0; i < 8; ++i) ss += x[i] * x[i];
            ss = wave_sum(ss);
            const float rn = 1.0f / sqrtf(ss * (1.0f / 512.f) + EPS);
            const float* g = (which ? gkv : gq) + lane * 8;
            v4u o; o.x = pk2(x[0] * rn * g[0], x[1] * rn * g[1]); o.y = pk2(x[2] * rn * g[2], x[3] * rn * g[3]); o.z = pk2(x[4] * rn * g[4], x[5] * rn * g[5]); o.w = pk2(x[6] * rn * g[6], x[7] * rn * g[7]);
            *(v4u*)((which ? ckvn : cqn) + (size_t)r * 512 + lane * 8) = o;
        }
        float ss = 0.f;
#pragma unroll
        for (int j = 0; j < 2; ++j) { const v4u w = *(const v4u*)(pr + C_VB + (lane + 64 * j) * 8);
            const float x[8] = {lo16(w.x), hi16(w.x), lo16(w.y), hi16(w.y), lo16(w.z), hi16(w.z), lo16(w.w), hi16(w.w)};
#pragma unroll
            for (int i = 0; i < 8; ++i) { const float gv = gelu_f(x[i]); ss += gv * gv; } }
        ss = wave_sum(ss);
        if (lane == 0) rv[r] = 1.0f / sqrtf(ss * (1.0f / 1024.f) + EPS);
    }
}
__device__ __forceinline__ float row16_sum(float v) {
    v += __uint_as_float((unsigned)__builtin_amdgcn_mov_dpp((int)__float_as_uint(v), 0xB1, 0xf, 0xf, true));
    v += __uint_as_float((unsigned)__builtin_amdgcn_mov_dpp((int)__float_as_uint(v), 0x4E, 0xf, 0xf, true));
    v += __uint_as_float((unsigned)__builtin_amdgcn_mov_dpp((int)__float_as_uint(v), 0x141, 0xf, 0xf, true));
    v += __uint_as_float((unsigned)__builtin_amdgcn_mov_dpp((int)__float_as_uint(v), 0x140, 0xf, 0xf, true));
    return v; }
__device__ __forceinline__ void ph_kfin(const bf16* kv, const bf16* proj, bf16* K, const float* kg, const float* cosT, const float* sinT, int row0, int vb, int nvb) {
    const int tid_ = otid(); const int lane = tid_ & 63, wave = tid_ >> 6, g16 = lane >> 4, c = lane & 15;
    float gn[8], gr[8];
#pragma unroll
    for (int j = 0; j < 8; ++j) { gn[j] = kg[c * 8 + j]; gr[j] = kg[128 + (c & 7) * 8 + j]; }
    for (int r = vb * 8 + wave; r < MP; r += nvb * 8) {
        const v4u n0 = *(const v4u*)(kv + (size_t)r * 2048 + g16 * 256 + c * 8), n1 = *(const v4u*)(kv + (size_t)r * 2048 + (g16 + 4) * 256 + c * 8);
        const v4u rw = *(const v4u*)(proj + (size_t)r * NPROJ + C_KROPE + (c & 7) * 8);
        const v4f c0 = *(const v4f*)(cosT + (size_t)(row0 + r) * 32 + (c & 3) * 8), c1 = *(const v4f*)(cosT + (size_t)(row0 + r) * 32 + (c & 3) * 8 + 4);
        const v4f s0 = *(const v4f*)(sinT + (size_t)(row0 + r) * 32 + (c & 3) * 8), s1 = *(const v4f*)(sinT + (size_t)(row0 + r) * 32 + (c & 3) * 8 + 4);
        float a[8] = {lo16(n0.x), hi16(n0.x), lo16(n0.y), hi16(n0.y), lo16(n0.z), hi16(n0.z), lo16(n0.w), hi16(n0.w)};
        float b[8] = {lo16(n1.x), hi16(n1.x), lo16(n1.y), hi16(n1.y), lo16(n1.z), hi16(n1.z), lo16(n1.w), hi16(n1.w)};
        float kr[8] = {lo16(rw.x), hi16(rw.x), lo16(rw.y), hi16(rw.y), lo16(rw.z), hi16(rw.z), lo16(rw.w), hi16(rw.w)};
        const float cs[8] = {c0.x, c0.y, c0.z, c0.w, c1.x, c1.y, c1.z, c1.w}, sn[8] = {s0.x, s0.y, s0.z, s0.w, s1.x, s1.y, s1.z, s1.w};
        float sa = 0.f, sb = 0.f, sr = 0.f;
#pragma unroll
        for (int j = 0; j < 8; ++j) { sa += a[j] * a[j]; sb += b[j] * b[j]; sr += kr[j] * kr[j]; }
        if (c >= 8) sr = 0.f;
        sa = row16_sum(sa); sb = row16_sum(sb); sr = row16_sum(sr);
        const float rna = 1.0f / sqrtf((sa + sr) * (1.0f / 192.f) + EPS), rnb = 1.0f / sqrtf((sb + sr) * (1.0f / 192.f) + EPS);
        float R[8];
#pragma unroll
        for (int j = 0; j < 8; ++j) { const float mine = kr[j] * gr[j]; const float oth = lane_xor<4>(mine);
            R[j] = (c & 4) ? mine * cs[j] + oth * sn[j] : mine * cs[j] - oth * sn[j]; }
        bf16* ka = K + ((size_t)r * 8 + g16) * 192; bf16* kb = K + ((size_t)r * 8 + g16 + 4) * 192;
        { v4u o; o.x = pk2(a[0] * rna * gn[0], a[1] * rna * gn[1]); o.y = pk2(a[2] * rna * gn[2], a[3] * rna * gn[3]); o.z = pk2(a[4] * rna * gn[4], a[5] * rna * gn[5]); o.w = pk2(a[6] * rna * gn[6], a[7] * rna * gn[7]); *(v4u*)(ka + c * 8) = o; }
        { v4u o; o.x = pk2(b[0] * rnb * gn[0], b[1] * rnb * gn[1]); o.y = pk2(b[2] * rnb * gn[2], b[3] * rnb * gn[3]); o.z = pk2(b[4] * rnb * gn[4], b[5] * rnb * gn[5]); o.w = pk2(b[6] * rnb * gn[6], b[7] * rnb * gn[7]); *(v4u*)(kb + c * 8) = o; }
        if (c < 8) {
            v4u o; o.x = pk2(R[0] * rna, R[1] * rna); o.y = pk2(R[2] * rna, R[3] * rna); o.z = pk2(R[4] * rna, R[5] * rna); o.w = pk2(R[6] * rna, R[7] * rna); *(v4u*)(ka + 128 + c * 8) = o;
            v4u p; p.x = pk2(R[0] * rnb, R[1] * rnb); p.y = pk2(R[2] * rnb, R[3] * rnb); p.z = pk2(R[4] * rnb, R[5] * rnb); p.w = pk2(R[6] * rnb, R[7] * rnb); *(v4u*)(kb + 128 + c * 8) = p; }
    }
}
__device__ __forceinline__ void ph_attn_naive(const bf16* Q, const bf16* K, const bf16* KV, const bf16* proj, bf16* YA, LAS float* lds, int vb, int nvb) {
    const int tid_ = otid(); const int lane = tid_ & 63, wave = tid_ >> 6;
    LAS float* qs = lds + wave * (4096 + 192); LAS float* ps = qs + 192;
    const float scale = 0.07216878364870322f;
    for (int it = vb * 8 + wave; it < NBP * 8 * SEQ; it += nvb * 8) {
        const int t = it % SEQ, bh = it / SEQ, h = bh & 7, b = bh >> 3, r = b * SEQ + t;
        { const bf16* qp = Q + ((size_t)r * 8 + h) * 192; qs[lane] = bf2f(qp[lane]); qs[lane + 64] = bf2f(qp[lane + 64]); qs[lane + 128] = bf2f(qp[lane + 128]); }
        LDS_FENCE();
        float m = -3.0e38f;
        for (int j = lane; j <= t; j += 64) {
            const v4u* kr = (const v4u*)(K + ((size_t)(b * SEQ + j) * 8 + h) * 192);
            float s = 0.f;
#pragma unroll 4
            for (int c = 0; c < 24; ++c) { const v4u w = kr[c]; const LAS float* qq = qs + c * 8;
                s += qq[0] * lo16(w.x) + qq[1] * hi16(w.x) + qq[2] * lo16(w.y) + qq[3] * hi16(w.y) + qq[4] * lo16(w.z) + qq[5] * hi16(w.z) + qq[6] * lo16(w.w) + qq[7] * hi16(w.w); }
            s *= scale; ps[j] = s; m = fmaxf(m, s);
        }
        m = wave_max(m);
        float l = 0.f;
        for (int j = lane; j <= t; j += 64) { const float p = __expf(ps[j] - m); ps[j] = p; l += p; }
        l = wave_sum(l);
        LDS_FENCE();
        float a0 = 0.f, a1 = 0.f;
        const bf16* vp = KV + (size_t)(b * SEQ) * 2048 + h * 256 + 128 + 2 * lane;
        for (int j = 0; j <= t; ++j) { const float p = ps[j]; const unsigned w = *(const unsigned*)(vp + (size_t)j * 2048); a0 += p * lo16(w); a1 += p * hi16(w); }
        const float inv = 1.0f / l;
        const unsigned zw = *(const unsigned*)(proj + (size_t)r * NPROJ + C_ZA + h * 128 + 2 * lane);
        *(unsigned*)(YA + (size_t)r * 1024 + h * 128 + 2 * lane) = pk2(a0 * inv * silu_f(lo16(zw)), a1 * inv * silu_f(hi16(zw)));
        LDS_FENCE();
    }
}
__device__ __forceinline__ void ph_sgu_naive(const bf16* proj, const float* rv, const float* Ws, const float* bs, const float* vg, bf16* YB, int vb, int nvb) {
    for (size_t idx = (size_t)vb * 512 + otid(); idx < (size_t)MP * 1024; idx += (size_t)nvb * 512) {
        const int r = (int)(idx >> 10), col = (int)(idx & 1023), g = col >> 7, tl = r & 127, rc = r - tl;
        float acc = 0.f;
        const float* wrow = Ws + ((size_t)g * 128 + tl) * 128;
        for (int sl = 0; sl <= tl; ++sl) acc += wrow[sl] * gelu_f(bf2f(proj[(size_t)(rc + sl) * NPROJ + C_VB + col])) * rv[rc + sl];
        acc = acc * vg[col] + bs[g * 128 + tl];
        const float u = gelu_f(bf2f(proj[(size_t)r * NPROJ + C_UB + col])), z = silu_f(bf2f(proj[(size_t)r * NPROJ + C_ZB + col]));
        YB[idx] = (bf16)f2bf(u * acc * z);
    }
}
__device__ __forceinline__ void ph_gla_naive(const bf16* proj, const float* wa2, const float* ba, float* OC, LAS float* lds, int vb, int nvb) {
    const int tid_ = otid(); const int lane = tid_ & 63, wave = tid_ >> 6;
    LAS float* sh = lds + wave * 512;
    for (int it = wave * nvb + vb; it < NBP * 16; it += nvb * 8) {
        const int b = it >> 4, h = (it >> 2) & 3, vq = it & 3;
        float st[128];
#pragma unroll
        for (int k = 0; k < 128; ++k) st[k] = 0.f;
        float wa0[16], wa1[16];
#pragma unroll
        for (int j = 0; j < 16; ++j) { wa0[j] = wa2[j * 512 + h * 128 + lane]; wa1[j] = wa2[j * 512 + h * 128 + 64 + lane]; }
        const float ba0 = ba[h * 128 + lane], ba1 = ba[h * 128 + 64 + lane];
        for (int t = 0; t < SEQ; ++t) {
            const bf16* pr = proj + (size_t)(b * SEQ + t) * NPROJ;
            const v4u w0 = *(const v4u*)(pr + C_AR), w1 = *(const v4u*)(pr + C_AR + 8);
            const float ar[16] = {lo16(w0.x), hi16(w0.x), lo16(w0.y), hi16(w0.y), lo16(w0.z), hi16(w0.z), lo16(w0.w), hi16(w0.w),
                                  lo16(w1.x), hi16(w1.x), lo16(w1.y), hi16(w1.y), lo16(w1.z), hi16(w1.z), lo16(w1.w), hi16(w1.w)};
            float x0 = ba0, x1 = ba1;
#pragma unroll
            for (int j = 0; j < 16; ++j) { x0 += ar[j] * wa0[j]; x1 += ar[j] * wa1[j]; }
            const float ls0 = fminf(x0, 0.f) - log1pf(__expf(-fabsf(x0))), ls1 = fminf(x1, 0.f) - log1pf(__expf(-fabsf(x1)));
            sh[lane] = __expf(ls0 * 0.0625f); sh[64 + lane] = __expf(ls1 * 0.0625f);
            sh[128 + lane] = bf2f(pr[C_QC + h * 128 + lane]) * 0.08838834764831845f; sh[192 + lane] = bf2f(pr[C_QC + h * 128 + 64 + lane]) * 0.08838834764831845f;
            sh[256 + lane] = bf2f(pr[C_KC + h * 128 + lane]); sh[320 + lane] = bf2f(pr[C_KC + h * 128 + 64 + lane]);
            const float v = bf2f(pr[C_VC + h * 256 + vq * 64 + lane]);
            LDS_FENCE();
            float o = 0.f;
#pragma unroll
            for (int k = 0; k < 128; ++k) { st[k] = sh[k] * st[k] + sh[256 + k] * v; o += sh[128 + k] * st[k]; }
            LDS_FENCE();
            OC[(size_t)(b * SEQ + t) * 1024 + h * 256 + vq * 64 + lane] = o;
        }
    }
}
__device__ __forceinline__ void ph_glafin(const float* OC, const bf16* proj, const float* og, bf16* YC, int vb, int nvb) {
    const int tid_ = otid(); const int lane = tid_ & 63, wave = tid_ >> 6;
    for (int it = vb * 8 + wave; it < MP * 4; it += nvb * 8) {
        const int r = it >> 2, h = it & 3;
        const v4f o = *(const v4f*)(OC + (size_t)r * 1024 + h * 256 + lane * 4);
        const float ss = wave_sum(o.x * o.x + o.y * o.y + o.z * o.z + o.w * o.w);
        const float rn = 1.0f / sqrtf(ss * (1.0f / 256.f) + EPS);
        const v4f g = *(const v4f*)(og + lane * 4);
        const v2u zw = *(const v2u*)(proj + (size_t)r * NPROJ + C_ZC + h * 256 + lane * 4);
        v2u w; w.x = pk2(o.x * rn * g.x * silu_f(lo16(zw.x)), o.y * rn * g.y * silu_f(hi16(zw.x))); w.y = pk2(o.z * rn * g.z * silu_f(lo16(zw.y)), o.w * rn * g.w * silu_f(hi16(zw.y)));
        *(v2u*)(YC + (size_t)r * 1024 + h * 256 + lane * 4) = w;
    }
}
__device__ __forceinline__ void ph_merge(const bf16* proj, const bf16* PB, bf16* MG, int vb, int nvb) {
    for (size_t idx = (size_t)vb * 512 + otid(); idx < (size_t)MP * 1024; idx += (size_t)nvb * 512) {
        const int r = (int)(idx >> 10), j = (int)(idx & 1023) * 2;
        float m0 = 0.f, m1 = 0.f;
#pragma unroll
        for (int b = 0; b < 3; ++b) { const unsigned gw = *(const unsigned*)(proj + (size_t)r * NPROJ + C_GATE + b * 2048 + j), pw = *(const unsigned*)(PB + ((size_t)b * MP + r) * 2048 + j);
            m0 += sigmoid_f(lo16(gw)) * lo16(pw); m1 += sigmoid_f(hi16(gw)) * hi16(pw); }
        *(unsigned*)(MG + (size_t)r * 2048 + j) = pk2(m0, m1);
    }
}
__device__ __forceinline__ void ph_outadd(const float* xin, const float* U, float* xout, int vb, int nvb) {
    for (size_t idx = (size_t)vb * 512 + otid(); idx < (size_t)MP * 512; idx += (size_t)nvb * 512) {
        const v4f a = ((const v4f*)xin)[idx], u = ((const v4f*)U)[idx]; ((v4f*)xout)[idx] = a + u; }
}


namespace at {
typedef short bf16x8 __attribute__((ext_vector_type(8)));
typedef short s16x4 __attribute__((ext_vector_type(4)));
typedef float f32x16 __attribute__((ext_vector_type(16)));
typedef unsigned u32x4 __attribute__((ext_vector_type(4)));
constexpr int SHM_V = 16384, SHM_K = 16384, SHM_KR = 8192;
constexpr int OFF_V = 0, OFF_K = 3 * SHM_V, OFF_KR = OFF_K + 2 * SHM_K, OFF_WS = OFF_KR + 2 * SHM_KR, LDS_NEED = OFF_WS + 8 * 64 * 4;
constexpr float SCALE = 0.07216878364870322f;
constexpr float THR = 8.f;
#define AT_KSWZ(row, colB) ((row) * 256 + ((colB) ^ (((row) & 7) << 4)))
#define AT_KRSWZ(row, colB) ((row) * 128 + ((colB) ^ (((row) & 7) << 4)))
#define AT_SBAR() __builtin_amdgcn_sched_barrier(0)
__device__ __forceinline__ int v_st(int k, int c) { const int kk = (k & ~0xC) | ((k & 4) << 1) | ((k & 8) >> 1); return ((kk >> 3) * 4 + (c >> 5)) * 512 + ((kk & 7) * 32 + (c & 31)) * 2; }
__device__ __forceinline__ int v_rd_base(int lane) { return ((lane & 3) << 3) | (((lane >> 2) & 3) << 6) | (((lane >> 4) & 1) << 5) | (((lane >> 5) & 1) << 8); }
constexpr int v_rd_off(int d0, int ks, int half) { return d0 * 512 + ks * 4096 + half * 2048; }
__device__ __forceinline__ int crow(int r, int hi) { return (r & 3) + 8 * (r >> 2) + 4 * hi; }
__device__ __forceinline__ unsigned cvtpk(float lo, float hi) { unsigned r; asm("v_cvt_pk_bf16_f32 %0, %1, %2" : "=v"(r) : "v"(lo), "v"(hi)); return r; }

__device__ __forceinline__ void mask_tile(f32x16& p0, f32x16& p1, int dq) {
    const float NEG = -__builtin_inff();
#pragma unroll
    for (int r = 0; r < 16; ++r) { const int c = (r & 3) + 8 * (r >> 2); if (dq < c) p0[r] = NEG; if (dq < c + 32) p1[r] = NEG; }
}
__device__ __forceinline__ void partialSM(f32x16& p0, f32x16& p1, float& m_reg, float& mn, float& alpha) {
    float pmax = p0[0];
#pragma unroll
    for (int r = 1; r < 16; ++r) pmax = fmaxf(pmax, p0[r]);
#pragma unroll
    for (int r = 0; r < 16; ++r) pmax = fmaxf(pmax, p1[r]);
    { auto rr = __builtin_amdgcn_permlane32_swap(__float_as_uint(pmax), __float_as_uint(pmax), false, false);
      pmax = fmaxf(__uint_as_float(rr[0]), __uint_as_float(rr[1])); }
    constexpr float C2 = 1.4426950408889634f * SCALE;
    if (__builtin_expect(__all((pmax - m_reg) * SCALE <= THR), 1)) { mn = m_reg; alpha = 1.f; }
    else { mn = fmaxf(m_reg, pmax); alpha = __builtin_amdgcn_exp2f((m_reg - mn) * C2); m_reg = mn; }
    const float mnL = -mn * C2;
#pragma unroll
    for (int r = 0; r < 16; ++r) p0[r] = fmaf(p0[r], C2, mnL);
#pragma unroll
    for (int r = 0; r < 16; ++r) p1[r] = fmaf(p1[r], C2, mnL);
#pragma unroll
    for (int r = 0; r < 16; ++r) p0[r] = __builtin_amdgcn_exp2f(p0[r]);
}
__device__ __forceinline__ void finishSM(f32x16& p0, f32x16& p1, float alpha, float& l_reg, bf16x8& pa0, bf16x8& pa1, bf16x8& pa2, bf16x8& pa3) {
#pragma unroll
    for (int r = 0; r < 16; ++r) p1[r] = __builtin_amdgcn_exp2f(p1[r]);
    float ps = 0;
#pragma unroll
    for (int r = 0; r < 16; ++r) ps += p0[r];
#pragma unroll
    for (int r = 0; r < 16; ++r) ps += p1[r];
    { auto rr = __builtin_amdgcn_permlane32_swap(__float_as_uint(ps), __float_as_uint(ps), false, false);
      ps = __uint_as_float(rr[0]) + __uint_as_float(rr[1]); }
    l_reg = l_reg * alpha + ps;
#define AT_PK4(P, B_, OUT) do { unsigned a0 = cvtpk(P[B_+0], P[B_+1]), a1 = cvtpk(P[B_+2], P[B_+3]);                          \
        unsigned b0 = cvtpk(P[B_+4], P[B_+5]), b1 = cvtpk(P[B_+6], P[B_+7]);                                             \
        auto r0 = __builtin_amdgcn_permlane32_swap(a0, b0, false, false); auto r1 = __builtin_amdgcn_permlane32_swap(a1, b1, false, false); \
        u32x4 w = {r0[0], r1[0], r0[1], r1[1]}; OUT = *reinterpret_cast<bf16x8*>(&w); } while (0)
    AT_PK4(p0, 0, pa0); AT_PK4(p0, 8, pa1); AT_PK4(p1, 0, pa2); AT_PK4(p1, 8, pa3);
#undef AT_PK4
}
__device__ __forceinline__ void qkt(f32x16& p0, f32x16& p1, const LAS unsigned char* Kb, const LAS unsigned char* KRb, int r32, int hi, const bf16x8* qr) {
    p0 = f32x16{}; p1 = f32x16{};
    const LAS unsigned char* kb[4]; const LAS unsigned char* krb[4];
#pragma unroll
    for (int dd = 0; dd < 4; ++dd) { kb[dd] = Kb + AT_KSWZ(r32, (dd * 16 + hi * 8) * 2); krb[dd] = KRb + AT_KRSWZ(r32, (dd * 16 + hi * 8) * 2); }
    bf16x8 f[24];
#pragma unroll
    for (int d0 = 0; d0 < 8; ++d0) { const LAS unsigned char* a = kb[d0 & 3] + (d0 >> 2) * 128;
        f[2 * d0] = *reinterpret_cast<const LAS bf16x8*>(a); f[2 * d0 + 1] = *reinterpret_cast<const LAS bf16x8*>(a + 32 * 256); }
#pragma unroll
    for (int d0 = 0; d0 < 4; ++d0) { const LAS unsigned char* a = krb[d0];
        f[16 + 2 * d0] = *reinterpret_cast<const LAS bf16x8*>(a); f[16 + 2 * d0 + 1] = *reinterpret_cast<const LAS bf16x8*>(a + 32 * 128); }
#pragma unroll
    for (int d0 = 0; d0 < 12; ++d0) {
        p0 = __builtin_amdgcn_mfma_f32_32x32x16_bf16(f[2 * d0], qr[d0], p0, 0, 0, 0);
        p1 = __builtin_amdgcn_mfma_f32_32x32x16_bf16(f[2 * d0 + 1], qr[d0], p1, 0, 0, 0); }
    __builtin_amdgcn_sched_group_barrier(0x100, 4, 0);
#pragma unroll
    for (int i = 0; i < 20; ++i) { __builtin_amdgcn_sched_group_barrier(0x008, 1, 0); __builtin_amdgcn_sched_group_barrier(0x100, 1, 0); }
    __builtin_amdgcn_sched_group_barrier(0x008, 4, 0);
}
__device__ __forceinline__ void pv_tile(f32x16* o, unsigned vb0, bf16x8 pa0, bf16x8 pa1, bf16x8 pa2, bf16x8 pa3) {
#define AT_TRRD(dst, off) asm volatile("ds_read_b64_tr_b16 %0, %1 offset:%2" : "=&v"(dst) : "v"(vb0), "i"(off) : "memory")
#define AT_PV_RD(d0, L, H) do { constexpr int b_ = v_rd_off(d0, 0, 0); \
        AT_TRRD(L[0], b_); AT_TRRD(H[0], b_ + 2048); AT_TRRD(L[1], b_ + 4096); AT_TRRD(H[1], b_ + 6144); AT_TRRD(L[2], b_ + 8192); AT_TRRD(H[2], b_ + 10240); AT_TRRD(L[3], b_ + 12288); AT_TRRD(H[3], b_ + 14336); } while (0)
#define AT_PV_MM(d0, L, H) do { \
        o[d0] = __builtin_amdgcn_mfma_f32_32x32x16_bf16(pa0, (bf16x8){L[0][0], L[0][1], L[0][2], L[0][3], H[0][0], H[0][1], H[0][2], H[0][3]}, o[d0], 0, 0, 0);   \
        o[d0] = __builtin_amdgcn_mfma_f32_32x32x16_bf16(pa1, (bf16x8){L[1][0], L[1][1], L[1][2], L[1][3], H[1][0], H[1][1], H[1][2], H[1][3]}, o[d0], 0, 0, 0);   \
        o[d0] = __builtin_amdgcn_mfma_f32_32x32x16_bf16(pa2, (bf16x8){L[2][0], L[2][1], L[2][2], L[2][3], H[2][0], H[2][1], H[2][2], H[2][3]}, o[d0], 0, 0, 0);   \
        o[d0] = __builtin_amdgcn_mfma_f32_32x32x16_bf16(pa3, (bf16x8){L[3][0], L[3][1], L[3][2], L[3][3], H[3][0], H[3][1], H[3][2], H[3][3]}, o[d0], 0, 0, 0); } while (0)
    s16x4 la[4], ha[4], lb[4], hb[4];
    asm volatile("s_waitcnt lgkmcnt(0)" ::: "memory");
    AT_PV_RD(0, la, ha); AT_PV_RD(1, lb, hb);
    asm volatile("s_waitcnt lgkmcnt(8)" ::: "memory"); AT_SBAR(); AT_PV_MM(0, la, ha); AT_SBAR();
    AT_PV_RD(2, la, ha);
    asm volatile("s_waitcnt lgkmcnt(8)" ::: "memory"); AT_SBAR(); AT_PV_MM(1, lb, hb); AT_SBAR();
    AT_PV_RD(3, lb, hb);
    asm volatile("s_waitcnt lgkmcnt(8)" ::: "memory"); AT_SBAR(); AT_PV_MM(2, la, ha); AT_SBAR();
    asm volatile("s_waitcnt lgkmcnt(0)" ::: "memory"); AT_SBAR(); AT_PV_MM(3, lb, hb);
#undef AT_PV_RD
#undef AT_PV_MM
#undef AT_TRRD
}

__device__ __forceinline__ void attn_block(LAS unsigned char* lds, const bf16* Q, const bf16* K, const bf16* KV, const bf16* proj, bf16* YA, const float* qg, const float* cosT, const float* sinT, int b, int h, int qb) {
    const int tid = otid(), wid = __builtin_amdgcn_readfirstlane(tid >> 6), lane = tid & 63, r32 = lane & 31, hi = lane >> 5;
    const int P0 = qb * 256, NT = 4 * (qb + 1), qlo = P0 + wid * 32;
    LAS unsigned char* V_lds = lds + OFF_V; LAS unsigned char* K_lds = lds + OFF_K; LAS unsigned char* KR_lds = lds + OFF_KR;
    LAS float* wsf = (LAS float*)(lds + OFF_WS) + wid * 64; LAS float* li_l = wsf; LAS float* al_l = wsf + 32;
    bf16x8 qr[12];
    { const bf16* qp = Q + ((size_t)(b * SEQ + qlo + r32) * 8 + h) * 192 + hi * 8;
      bf16x8 raw[12];
#pragma unroll
      for (int d0 = 0; d0 < 12; ++d0) raw[d0] = *(const bf16x8*)(qp + d0 * 16);
      float ss = 0.f;
#pragma unroll
      for (int d0 = 0; d0 < 12; ++d0)
#pragma unroll
          for (int j = 0; j < 8; ++j) { const float v = bf2f((unsigned short)raw[d0][j]); ss += v * v; }
      { auto rr = __builtin_amdgcn_permlane32_swap(__float_as_uint(ss), __float_as_uint(ss), false, false); ss = __uint_as_float(rr[0]) + __uint_as_float(rr[1]); }
      const float rn = 1.0f / sqrtf(ss * (1.0f / 192.f) + EPS);
      const float* ct = cosT + (size_t)(b * SEQ + qlo + r32) * 32 + hi * 8; const float* st = sinT + (size_t)(b * SEQ + qlo + r32) * 32 + hi * 8;
#pragma unroll
      for (int d0 = 0; d0 < 8; ++d0) { const v4f g0 = *(const v4f*)(qg + d0 * 16 + hi * 8), g1 = *(const v4f*)(qg + d0 * 16 + hi * 8 + 4);
          const float g[8] = {g0.x, g0.y, g0.z, g0.w, g1.x, g1.y, g1.z, g1.w}; float x[8];
#pragma unroll
          for (int j = 0; j < 8; ++j) x[j] = bf2f((unsigned short)raw[d0][j]) * rn * g[j];
          u32x4 w = {cvtpk(x[0], x[1]), cvtpk(x[2], x[3]), cvtpk(x[4], x[5]), cvtpk(x[6], x[7])}; qr[d0] = *reinterpret_cast<bf16x8*>(&w); }
#pragma unroll
      for (int d0 = 8; d0 < 10; ++d0) { const int i0 = (d0 - 8) * 16;
          const v4f ga0 = *(const v4f*)(qg + d0 * 16 + hi * 8), ga1 = *(const v4f*)(qg + d0 * 16 + hi * 8 + 4), gb0 = *(const v4f*)(qg + (d0 + 2) * 16 + hi * 8), gb1 = *(const v4f*)(qg + (d0 + 2) * 16 + hi * 8 + 4);
          const v4f c0 = *(const v4f*)(ct + i0), c1 = *(const v4f*)(ct + i0 + 4), s0 = *(const v4f*)(st + i0), s1 = *(const v4f*)(st + i0 + 4);
          const float ga[8] = {ga0.x, ga0.y, ga0.z, ga0.w, ga1.x, ga1.y, ga1.z, ga1.w}, gb[8] = {gb0.x, gb0.y, gb0.z, gb0.w, gb1.x, gb1.y, gb1.z, gb1.w};
          const float cs[8] = {c0.x, c0.y, c0.z, c0.w, c1.x, c1.y, c1.z, c1.w}, sn[8] = {s0.x, s0.y, s0.z, s0.w, s1.x, s1.y, s1.z, s1.w};
          float y1[8], y2[8];
#pragma unroll
          for (int j = 0; j < 8; ++j) { const float x1 = bf2f((unsigned short)raw[d0][j]) * rn * ga[j], x2 = bf2f((unsigned short)raw[d0 + 2][j]) * rn * gb[j];
              y1[j] = x1 * cs[j] - x2 * sn[j]; y2[j] = x2 * cs[j] + x1 * sn[j]; }
          u32x4 w1 = {cvtpk(y1[0], y1[1]), cvtpk(y1[2], y1[3]), cvtpk(y1[4], y1[5]), cvtpk(y1[6], y1[7])}; qr[d0] = *reinterpret_cast<bf16x8*>(&w1);
          u32x4 w2 = {cvtpk(y2[0], y2[1]), cvtpk(y2[2], y2[3]), cvtpk(y2[4], y2[5]), cvtpk(y2[6], y2[7])}; qr[d0 + 2] = *reinterpret_cast<bf16x8*>(&w2); }
    }
    const int sr = tid >> 4, sc = (tid & 15) * 8, kws = AT_KSWZ(sr, sc * 2), vst0 = v_st(sr, sc), vst1 = v_st(32 + sr, sc);
    const int rr = tid >> 3, rc = (tid & 7) * 8, krws = AT_KRSWZ(rr, rc * 2);
    const bf16* Kg = K + ((size_t)(b * SEQ) * 8 + h) * 192;
    const bf16* Vg = KV + (size_t)(b * SEQ) * 2048 + h * 256 + 128;
    bf16x8 sa_k0, sa_k1, sa_kr, sa_v0, sa_v1, sb_k0, sb_k1, sb_kr, sb_v0, sb_v1;
#define AT_SLOAD(S, kb_) do { S##_k0 = *(const bf16x8*)(Kg + (size_t)((kb_) + sr) * 1536 + sc); S##_k1 = *(const bf16x8*)(Kg + (size_t)((kb_) + 32 + sr) * 1536 + sc); \
        S##_kr = *(const bf16x8*)(Kg + (size_t)((kb_) + rr) * 1536 + 128 + rc); \
        S##_v0 = *(const bf16x8*)(Vg + (size_t)((kb_) + sr) * 2048 + sc); S##_v1 = *(const bf16x8*)(Vg + (size_t)((kb_) + 32 + sr) * 2048 + sc); } while (0)
#define AT_SWRITE(S, bf, vbf) do { *(LAS bf16x8*)(K_lds + (bf) * SHM_K + kws) = S##_k0; *(LAS bf16x8*)(K_lds + (bf) * SHM_K + kws + 32 * 256) = S##_k1; \
        *(LAS bf16x8*)(KR_lds + (bf) * SHM_KR + krws) = S##_kr; \
        *(LAS bf16x8*)(V_lds + (vbf) * SHM_V + vst0) = S##_v0; *(LAS bf16x8*)(V_lds + (vbf) * SHM_V + vst1) = S##_v1; } while (0)
    AT_SLOAD(sa, 0); AT_SLOAD(sb, 64); AT_SWRITE(sa, 0, 0);
    __syncthreads();
    float m_reg = -1e30f, l_reg = 0.f; f32x16 o[4] = {};
    const unsigned vbase = (unsigned)(size_t)V_lds + (unsigned)v_rd_base(lane);
    const bool late = wid >= 4;
    bool pend = false; int pvb = 0; int vb3 = 0;
    bf16x8 pa0, pa1, pa2, pa3;
#define AT_STEP(t, SL, SW) do { \
        const int buf = (t) & 1, kb = (t) * 64; \
        if ((t) + 2 < NT) AT_SLOAD(SL, kb + 128);                         \
        if (late && pend) { pv_tile(o, vbase + pvb * SHM_V, pa0, pa1, pa2, pa3); pend = false; AT_SBAR(); } \
        if (kb <= qlo + 31) { \
            f32x16 p0, p1; float mn, alpha; \
            qkt(p0, p1, K_lds + buf * SHM_K, KR_lds + buf * SHM_KR, r32, hi, qr); \
            if (kb + 63 > qlo) mask_tile(p0, p1, qlo + r32 - 4 * hi - kb); \
            partialSM(p0, p1, m_reg, mn, alpha); \
            finishSM(p0, p1, alpha, l_reg, pa0, pa1, pa2, pa3); \
            if (__any(alpha < 1.f)) { if (hi == 0) al_l[r32] = alpha; asm volatile("s_waitcnt lgkmcnt(0)" ::: "memory"); \
                _Pragma("unroll") for (int d_ = 0; d_ < 4; ++d_) _Pragma("unroll") for (int r = 0; r < 16; ++r) o[d_][r] *= al_l[crow(r, hi)]; \
                asm volatile("s_waitcnt lgkmcnt(0)" ::: "memory"); } \
            AT_SBAR(); \
            if (late) { pend = true; pvb = vb3; } \
            else pv_tile(o, vbase + vb3 * SHM_V, pa0, pa1, pa2, pa3); \
        } \
        const int vn3 = vb3 == 2 ? 0 : vb3 + 1; \
        if ((t) + 1 < NT) AT_SWRITE(SW, buf ^ 1, vn3);                    \
        vb3 = vn3; \
        __syncthreads(); } while (0)
    for (int t = 0; t < NT; t += 2) { AT_STEP(t, sa, sb); AT_STEP(t + 1, sb, sa); }
#undef AT_STEP
    if (late && pend) pv_tile(o, vbase + pvb * SHM_V, pa0, pa1, pa2, pa3);
    if (hi == 0) li_l[r32] = l_reg;
    asm volatile("s_waitcnt lgkmcnt(0)" ::: "memory");
    float rli[16];
#pragma unroll
    for (int r = 0; r < 16; ++r) rli[r] = 1.0f / li_l[crow(r, hi)];
#pragma unroll
    for (int d0 = 0; d0 < 4; ++d0) { const int col = h * 128 + d0 * 32 + r32;
        unsigned short zr[16];
#pragma unroll
        for (int r = 0; r < 16; ++r) zr[r] = proj[(size_t)(b * SEQ + qlo + crow(r, hi)) * NPROJ + C_ZA + col];
#pragma unroll
        for (int r = 0; r < 16; ++r) { const int row = b * SEQ + qlo + crow(r, hi);
            const float v = o[d0][r] * rli[r] * silu_f(bf2f(zr[r]));
            const float vn = lane_xor<1>(v);
            if ((r32 & 1) == 0) *(unsigned*)(YA + (size_t)row * 1024 + col) = cvtpk(v, vn); } }
    asm volatile("s_waitcnt lgkmcnt(0)" ::: "memory");
    __syncthreads();
#undef AT_SLOAD
#undef AT_SWRITE
}
}


namespace sg {
using at::bf16x8; using at::f32x16;
__device__ __forceinline__ void sgu_item(LAS unsigned char* lds, const bf16* proj, const float* rv, const float* Ws, const float* bs, const float* vg, bf16* YB, int it) {
    const int tid = otid(), wid = __builtin_amdgcn_readfirstlane(tid >> 6), lane = tid & 63, r32 = lane & 31, hi = lane >> 5;
    {
        const int ch = it >> 2, gp = it & 3, R0 = ch * 128;
#pragma unroll
        for (int i = 0; i < 8; ++i) {
            const int idx = tid + 512 * i, gsel = idx >> 11, row = (idx >> 4) & 127, cc = idx & 15;
            const v4u w = *(const v4u*)(proj + (size_t)(R0 + row) * NPROJ + C_VB + (2 * gp + gsel) * 128 + cc * 8);
            const float s = 1.0f / sqrtf(rv[R0 + row] * (1.0f / 1024.f) + EPS);
            v4u o; o.x = pk2(gelu_f(lo16(w.x)) * s, gelu_f(hi16(w.x)) * s); o.y = pk2(gelu_f(lo16(w.y)) * s, gelu_f(hi16(w.y)) * s);
            o.z = pk2(gelu_f(lo16(w.z)) * s, gelu_f(hi16(w.z)) * s); o.w = pk2(gelu_f(lo16(w.w)) * s, gelu_f(hi16(w.w)) * s);
            *(LAS v4u*)(lds + (gsel * 2 + (row >> 6)) * 16384 + at::v_st(row & 63, cc * 8)) = o;
        }
        __syncthreads();
        const int gsel = wid >> 2, g = 2 * gp + gsel, t = 32 * (wid & 3) + r32;
        f32x16 o[4] = {};
        const int nst = (wid & 3) >= 2 ? 2 : 1;
        for (int st = 0; st < nst; ++st) {
            bf16x8 pa[4];
#pragma unroll
            for (int ks = 0; ks < 4; ++ks) {
                const int s0 = st * 64 + ks * 16 + hi * 8;
                const float* wp = Ws + ((size_t)g * 128 + t) * 128 + s0;
                const v4f a = *(const v4f*)wp, b = *(const v4f*)(wp + 4);
                float x[8] = {a.x, a.y, a.z, a.w, b.x, b.y, b.z, b.w};
#pragma unroll
                for (int j = 0; j < 8; ++j) if (s0 + j > t) x[j] = 0.f;
                at::u32x4 w4 = {at::cvtpk(x[0], x[1]), at::cvtpk(x[2], x[3]), at::cvtpk(x[4], x[5]), at::cvtpk(x[6], x[7])};
                pa[ks] = *reinterpret_cast<bf16x8*>(&w4);
            }
            const unsigned vbase = (unsigned)(size_t)(lds + (gsel * 2 + st) * 16384) + (unsigned)at::v_rd_base(lane);
            at::pv_tile(o, vbase, pa[0], pa[1], pa[2], pa[3]);
        }
#pragma unroll
        for (int d0 = 0; d0 < 4; ++d0) { const int gc = g * 128 + d0 * 32 + r32; const float vgc = vg[gc];
            unsigned short ur[16], zr[16];
#pragma unroll
            for (int r = 0; r < 16; ++r) { const size_t row = (size_t)(R0 + 32 * (wid & 3) + at::crow(r, hi)); ur[r] = proj[row * NPROJ + C_UB + gc]; zr[r] = proj[row * NPROJ + C_ZB + gc]; }
#pragma unroll
            for (int r = 0; r < 16; ++r) { const int tl = 32 * (wid & 3) + at::crow(r, hi); const size_t row = (size_t)(R0 + tl);
                const float mix = o[d0][r] * vgc + bs[g * 128 + tl];
                const float y = gelu_f(bf2f(ur[r])) * mix * silu_f(bf2f(zr[r])), yn = lane_xor<1>(y);
                if ((r32 & 1) == 0) *(unsigned*)(YB + row * 1024 + gc) = at::cvtpk(y, yn); } }
        __syncthreads();
    }
}
}


namespace gl {
using at::bf16x8; using at::f32x16; using at::s16x4; using at::u32x4;
constexpr int OFF_VIMG = 0, OFF_KLIMG = 65536, OFF_ATT = 98304, OFF_DS = 131072, OFF_PART = 131584, LDS_NEED = OFF_PART + 4096;

__device__ __forceinline__ void gla_prep_item(LAS unsigned char* lds, int seg_off, const bf16* proj, const float* wa2, const float* ba, bf16* QE, bf16* KE, bf16* KL, float* DS, int ci) {
    const int tid = otid(), k2 = tid & 63, ts = tid >> 6, k = 2 * k2;
    LAS float* seg = (LAS float*)(lds + seg_off);
    {
        const int ch = ci >> 2, h = ci & 3, R0 = ch * 128 + ts * 16;
        float wa0[16], wa1[16];
#pragma unroll
        for (int j = 0; j < 16; ++j) { const v2f w = *(const v2f*)(wa2 + j * 512 + h * 128 + k); wa0[j] = w.x; wa1[j] = w.y; }
        const v2f bak = *(const v2f*)(ba + h * 128 + k);
        float la0[16], la1[16]; float run0 = 0.f, run1 = 0.f;
#pragma unroll
        for (int i = 0; i < 16; ++i) {
            const bf16* pr = proj + (size_t)(R0 + i) * NPROJ + C_AR;
            const v4u w0 = *(const v4u*)pr, w1 = *(const v4u*)(pr + 8);
            const float ar[16] = {lo16(w0.x), hi16(w0.x), lo16(w0.y), hi16(w0.y), lo16(w0.z), hi16(w0.z), lo16(w0.w), hi16(w0.w),
                                  lo16(w1.x), hi16(w1.x), lo16(w1.y), hi16(w1.y), lo16(w1.z), hi16(w1.z), lo16(w1.w), hi16(w1.w)};
            float x0 = bak.x, x1 = bak.y;
#pragma unroll
            for (int j = 0; j < 16; ++j) { x0 += ar[j] * wa0[j]; x1 += ar[j] * wa1[j]; }
            run0 += (fminf(x0, 0.f) - __logf(1.0f + __expf(-fabsf(x0)))) * 0.0625f; la0[i] = run0;
            run1 += (fminf(x1, 0.f) - __logf(1.0f + __expf(-fabsf(x1)))) * 0.0625f; la1[i] = run1;
        }
        *(LAS v2f*)(seg + ts * 128 + k) = (v2f){run0, run1};
        __syncthreads();
        float pre0 = 0.f, pre1 = 0.f, tot0 = 0.f, tot1 = 0.f;
#pragma unroll
        for (int q = 0; q < 8; ++q) { const v2f sg = *(const LAS v2f*)(seg + q * 128 + k); tot0 += sg.x; tot1 += sg.y; if (q < ts) { pre0 += sg.x; pre1 += sg.y; } }
        const float et0 = __expf(tot0), et1 = __expf(tot1);
        unsigned qw[16], kw[16];
#pragma unroll
        for (int i = 0; i < 16; ++i) { const size_t row = (size_t)(R0 + i); qw[i] = *(const unsigned*)(proj + row * NPROJ + C_QC + h * 128 + k); kw[i] = *(const unsigned*)(proj + row * NPROJ + C_KC + h * 128 + k); }
#pragma unroll
        for (int i = 0; i < 16; ++i) {
            const size_t o = (size_t)(R0 + i) * 512 + h * 128 + k;
            const float e0 = __expf(la0[i] + pre0), e1 = __expf(la1[i] + pre1), r0 = __builtin_amdgcn_rcpf(e0), r1 = __builtin_amdgcn_rcpf(e1);
            const float q0 = lo16(qw[i]) * 0.08838834764831845f, q1 = hi16(qw[i]) * 0.08838834764831845f, kk0 = lo16(kw[i]) * r0, kk1 = hi16(kw[i]) * r1;
            *(unsigned*)(QE + o) = pk2(q0 * e0, q1 * e1);
            *(unsigned*)(KE + o) = pk2(kk0, kk1);
            *(unsigned*)(KL + o) = pk2(kk0 * et0, kk1 * et1);
        }
        if (ts == 0) *(v2f*)(DS + ((size_t)ch * 4 + h) * 128 + k) = (v2f){et0, et1};
        __syncthreads();
    }
}

#define GL_PK4(P, B_, OUT) do { unsigned a0 = at::cvtpk(P[B_+0], P[B_+1]), a1 = at::cvtpk(P[B_+2], P[B_+3]);                          \
        unsigned b0 = at::cvtpk(P[B_+4], P[B_+5]), b1 = at::cvtpk(P[B_+6], P[B_+7]);                                             \
        auto r0 = __builtin_amdgcn_permlane32_swap(a0, b0, false, false); auto r1 = __builtin_amdgcn_permlane32_swap(a1, b1, false, false); \
        u32x4 w = {r0[0], r1[0], r0[1], r1[1]}; OUT = *reinterpret_cast<bf16x8*>(&w); } while (0)
#define GL_TRRD(dst, addr, off) asm volatile("ds_read_b64_tr_b16 %0, %1 offset:%2" : "=&v"(dst) : "v"(addr), "i"(off) : "memory")

__device__ __forceinline__ void gla_chunk_item(LAS unsigned char* lds, const bf16* proj, const bf16* QE, const bf16* KE, const bf16* KL, float* OI, float* DL, int ci) {
    const int tid = otid(), wid = __builtin_amdgcn_readfirstlane(tid >> 6), lane = tid & 63, r32 = lane & 31, hi = lane >> 5;
    const int h = ci & 3, R0 = (ci >> 2) * 128;
    {
        {
#pragma unroll
            for (int i = 0; i < 8; ++i) { const int idx = tid + 512 * i, s = idx >> 5, cc = idx & 31;
                const v4u w = *(const v4u*)(proj + (size_t)(R0 + s) * NPROJ + C_VC + h * 256 + cc * 8);
                *(LAS v4u*)(lds + OFF_VIMG + ((s >> 6) * 2 + (cc >> 4)) * 16384 + at::v_st(s & 63, (cc & 15) * 8)) = w; }
#pragma unroll
            for (int i = 0; i < 4; ++i) { const int idx = tid + 512 * i, s = idx >> 4, cc = idx & 15;
                const v4u w = *(const v4u*)(KL + (size_t)(R0 + s) * 512 + h * 128 + cc * 8);
                *(LAS v4u*)(lds + OFF_KLIMG + (s >> 6) * 16384 + at::v_st(s & 63, cc * 8)) = w; }
#pragma unroll
            for (int j = 0; j < 2; ++j) {
                const int ti = 2 * wid + j, st = ti >> 2, tt = ti & 3;
                if (st <= tt) {
                    f32x16 p = {};
                    const bf16* ap = KE + (size_t)(R0 + 32 * st + r32) * 512 + h * 128 + hi * 8;
                    const bf16* bp = QE + (size_t)(R0 + 32 * tt + r32) * 512 + h * 128 + hi * 8;
                    bf16x8 fa[8], fb[8];
#pragma unroll
                    for (int ks = 0; ks < 8; ++ks) { fa[ks] = *(const bf16x8*)(ap + ks * 16); fb[ks] = *(const bf16x8*)(bp + ks * 16); }
#pragma unroll
                    for (int ks = 0; ks < 8; ++ks) p = __builtin_amdgcn_mfma_f32_32x32x16_bf16(fa[ks], fb[ks], p, 0, 0, 0);
                    __builtin_amdgcn_sched_group_barrier(0x020, 16, 0); __builtin_amdgcn_sched_group_barrier(0x008, 8, 0);
                    if (st == tt) {
#pragma unroll
                        for (int r = 0; r < 16; ++r) if (at::crow(r, hi) > r32) p[r] = 0.f; }
                    const int t = 32 * tt + r32;
#pragma unroll
                    for (int g = 0; g < 4; ++g) { v2u w; w.x = at::cvtpk(p[4 * g], p[4 * g + 1]); w.y = at::cvtpk(p[4 * g + 2], p[4 * g + 3]);
                        *(LAS v2u*)(lds + OFF_ATT + t * 256 + ((64 * st + 16 * g) ^ ((t & 7) << 4)) + 8 * hi) = w; }
                }
            }
            __syncthreads();
            bf16x8 vfr[8];
            { const unsigned vaddr = (unsigned)(size_t)(lds + OFF_VIMG + (wid >> 2) * 16384) + (unsigned)at::v_rd_base(lane) + (unsigned)((wid & 3) * 512);
              s16x4 vl[8], vh[8];
#define GL_VF(ks8) do { constexpr int o_ = ((ks8) >> 2) * 32768 + ((ks8) & 3) * 4096; GL_TRRD(vl[ks8], vaddr, o_); GL_TRRD(vh[ks8], vaddr, o_ + 2048); } while (0)
              GL_VF(0); GL_VF(1); GL_VF(2); GL_VF(3); GL_VF(4); GL_VF(5); GL_VF(6); GL_VF(7);
#undef GL_VF
              asm volatile("s_waitcnt lgkmcnt(0)" ::: "memory"); AT_SBAR();
#pragma unroll
              for (int q = 0; q < 8; ++q) vfr[q] = (bf16x8){vl[q][0], vl[q][1], vl[q][2], vl[q][3], vh[q][0], vh[q][1], vh[q][2], vh[q][3]};
              AT_SBAR(); }
            float* oi = OI + (((size_t)ci * 8 + wid) * 16 * 64 + lane) * 4;
            float* dl = DL + (((size_t)ci * 8 + wid) * 16 * 64 + lane) * 4;
#pragma unroll
            for (int tt = 0; tt < 4; ++tt) {
                f32x16 acc = {};
                const int t = 32 * tt + r32;
#pragma unroll
                for (int ks8 = 0; ks8 < 8; ++ks8) if (ks8 <= 2 * tt + 1) {
                    const bf16x8 a = *(const LAS bf16x8*)(lds + OFF_ATT + t * 256 + (((16 * ks8 + 8 * hi) * 2) ^ ((t & 7) << 4)));
                    acc = __builtin_amdgcn_mfma_f32_32x32x16_bf16(a, vfr[ks8], acc, 0, 0, 0); }
#pragma unroll
                for (int r4 = 0; r4 < 4; ++r4) *(v4f*)(oi + (size_t)(tt * 4 + r4) * 256) = (v4f){acc[4 * r4], acc[4 * r4 + 1], acc[4 * r4 + 2], acc[4 * r4 + 3]};
            }
#pragma unroll
            for (int kt = 0; kt < 4; ++kt) {
                f32x16 D = {};
                const unsigned kaddr = (unsigned)(size_t)(lds + OFF_KLIMG) + (unsigned)at::v_rd_base(lane) + (unsigned)(kt * 512);
#define GL_KF(ks8) do { s16x4 l_, h_; constexpr int o_ = ((ks8) >> 2) * 16384 + ((ks8) & 3) * 4096; GL_TRRD(l_, kaddr, o_); GL_TRRD(h_, kaddr, o_ + 2048); \
                asm volatile("s_waitcnt lgkmcnt(0)" ::: "memory"); AT_SBAR(); \
                D = __builtin_amdgcn_mfma_f32_32x32x16_bf16((bf16x8){l_[0], l_[1], l_[2], l_[3], h_[0], h_[1], h_[2], h_[3]}, vfr[ks8], D, 0, 0, 0); } while (0)
                GL_KF(0); GL_KF(1); GL_KF(2); GL_KF(3); GL_KF(4); GL_KF(5); GL_KF(6); GL_KF(7);
#undef GL_KF
#pragma unroll
                for (int r4 = 0; r4 < 4; ++r4) *(v4f*)(dl + (size_t)(kt * 4 + r4) * 256) = (v4f){D[4 * r4], D[4 * r4 + 1], D[4 * r4 + 2], D[4 * r4 + 3]};
            }
            __syncthreads();
        }
    }
}

__device__ __forceinline__ void gla_stageA_item(const float* DS, const float* DL, bf16* XB, int b, int h, int vp) {
    const int tid = otid(), wid = __builtin_amdgcn_readfirstlane(tid >> 6), lane = tid & 63, hi = lane >> 5;
    const int vb = 2 * vp + (wid >> 2), kt = wid & 3;
    constexpr int PF = 4, NC = SEQ / 128;
    f32x16 X = {};
    v4f dq[PF][4], sq[PF][4];
    const size_t ci0 = (size_t)(b * 32) * 4 + h;
#define GL_ALOAD(slot, c_) do { const size_t ci_ = ci0 + (size_t)(c_) * 4; const float* dl_ = DL + ((ci_ * 8 + vb) * 16 * 64 + lane) * 4 + (size_t)(kt * 4) * 256; const float* ds_ = DS + ci_ * 128 + 32 * kt + 4 * hi; \
        _Pragma("unroll") for (int r4 = 0; r4 < 4; ++r4) { dq[slot][r4] = *(const v4f*)(dl_ + (size_t)r4 * 256); sq[slot][r4] = *(const v4f*)(ds_ + 8 * r4); } } while (0)
#pragma unroll
    for (int s = 0; s < PF; ++s) GL_ALOAD(s, s);
    for (int c0 = 0; c0 < NC; c0 += PF) {
#pragma unroll
        for (int s = 0; s < PF; ++s) {
            const int c = c0 + s; const size_t ci = ci0 + (size_t)c * 4;
            bf16* xo = XB + (((ci * 8 + vb) * 8 + kt * 2) * 64 + lane) * 8;
            bf16x8 xb0, xb1; GL_PK4(X, 0, xb0); GL_PK4(X, 8, xb1);
            *(bf16x8*)xo = xb0; *(bf16x8*)(xo + 512) = xb1;
#pragma unroll
            for (int r4 = 0; r4 < 4; ++r4) { const v4f w = dq[s][r4], d4 = sq[s][r4];
                X[4 * r4] = X[4 * r4] * d4.x + w.x; X[4 * r4 + 1] = X[4 * r4 + 1] * d4.y + w.y; X[4 * r4 + 2] = X[4 * r4 + 2] * d4.z + w.z; X[4 * r4 + 3] = X[4 * r4 + 3] * d4.w + w.w; }
            if (c + PF < NC) GL_ALOAD(s, c + PF);
        }
    }
#undef GL_ALOAD
}
__device__ __forceinline__ void gla_stageB_item(const bf16* proj, const bf16* QE, const float* OI, const bf16* XB, const float* og, bf16* YC, int b, int h, int cp) {
    const int tid = otid(), wid = __builtin_amdgcn_readfirstlane(tid >> 6), lane = tid & 63, r32 = lane & 31, hi = lane >> 5;
    {
        const int c = 2 * cp + (wid >> 2), tt = wid & 3, R0 = b * SEQ + c * 128;
        const size_t ci = (size_t)(b * 32 + c) * 4 + h;
        f32x16 acc[8];
#pragma unroll
        for (int vb = 0; vb < 8; ++vb) { const float* oi = OI + ((ci * 8 + vb) * 16 * 64 + lane) * 4 + (size_t)(tt * 4) * 256;
#pragma unroll
            for (int r4 = 0; r4 < 4; ++r4) { const v4f w = *(const v4f*)(oi + (size_t)r4 * 256); acc[vb][4 * r4] = w.x; acc[vb][4 * r4 + 1] = w.y; acc[vb][4 * r4 + 2] = w.z; acc[vb][4 * r4 + 3] = w.w; } }
        bf16x8 qa[8];
        { const bf16* qp = QE + (size_t)(R0 + 32 * tt + r32) * 512 + h * 128 + hi * 8;
#pragma unroll
          for (int ks = 0; ks < 8; ++ks) qa[ks] = *(const bf16x8*)(qp + ks * 16); }
        if (c > 0) {
            const bf16* xi = XB + (((ci * 8) * 8) * 64 + lane) * 8;
            bf16x8 xf[64];
#pragma unroll
            for (int i = 0; i < 64; ++i) xf[i] = *(const bf16x8*)(xi + (size_t)i * 512);
#pragma unroll
            for (int i = 0; i < 64; ++i) acc[i >> 3] = __builtin_amdgcn_mfma_f32_32x32x16_bf16(qa[i & 7], xf[i], acc[i >> 3], 0, 0, 0);
            __builtin_amdgcn_sched_group_barrier(0x020, 16, 0);
#pragma unroll
            for (int i = 0; i < 48; ++i) { __builtin_amdgcn_sched_group_barrier(0x008, 1, 0); __builtin_amdgcn_sched_group_barrier(0x020, 1, 0); }
            __builtin_amdgcn_sched_group_barrier(0x008, 16, 0);
        }
        float rn[16];
#pragma unroll
        for (int r = 0; r < 16; ++r) { float s = 0.f;
#pragma unroll
            for (int vb = 0; vb < 8; ++vb) s += acc[vb][r] * acc[vb][r];
            s += lane_xor<1>(s); s += lane_xor<2>(s); s += lane_xor<4>(s); s += lane_xor<8>(s); s += lane_xor<16>(s);
            rn[r] = 1.0f / sqrtf(s * (1.0f / 256.f) + EPS); }
#pragma unroll
        for (int vb = 0; vb < 8; ++vb) { const float gcol = og[32 * vb + r32];
            unsigned short zr[16];
#pragma unroll
            for (int r = 0; r < 16; ++r) zr[r] = proj[(size_t)(R0 + 32 * tt + at::crow(r, hi)) * NPROJ + C_ZC + h * 256 + 32 * vb + r32];
#pragma unroll
            for (int r = 0; r < 16; ++r) { const size_t row = (size_t)(R0 + 32 * tt + at::crow(r, hi));
                const float y = acc[vb][r] * rn[r] * gcol * silu_f(bf2f(zr[r])), yn = lane_xor<1>(y);
                if ((r32 & 1) == 0) *(unsigned*)(YC + row * 1024 + h * 256 + 32 * vb + r32) = at::cvtpk(y, yn); } }
    }
}
#undef GL_PK4
#undef GL_TRRD
}


constexpr int CW_Q = 65536;
__device__ __forceinline__ int q_pop(unsigned* ctr, LAS unsigned* slot) {
    if (otid() == 0) *slot = __hip_atomic_fetch_add(ctr, 1u, __ATOMIC_RELAXED, __HIP_MEMORY_SCOPE_AGENT);
    __syncthreads(); const int v = (int)*slot; __syncthreads(); return v; }
__device__ __forceinline__ void ph_mixers(LAS unsigned char* lds, unsigned char* ws, unsigned* qctr, const float* Ws, const float* bs, const float* vg, const float* og, const float* qg, int row0, int vb) {
    constexpr int NGLA = NBP * 8, NATT = 16 * NBP, NSGU = 16 * NBP, NQ = NGLA + NATT + NSGU;
    static_assert(NBP % 2 == 0, "NBP even");
    LAS unsigned* slot = (LAS unsigned*)(lds + LDSCTL_OFF + 64);
    bf16* proj = (bf16*)(ws + WS_PROJ);
    for (int dq = 0; dq < 8; ++dq) {
        const int q = (vb + dq) & 7;
        for (;;) {
            const int idx = q_pop(qctr + q * 64, slot);
            if (idx >= NQ) break;
            if (idx >= NATT && idx < NATT + NGLA) { const int gi = q * NGLA + (idx - NATT), bh = gi >> 4, cp = gi & 15;
                gl::gla_stageB_item(proj, (const bf16*)(ws + WS_QE), (const float*)(ws + WS_OC), (const bf16*)(ws + WS_XB), og, (bf16*)(ws + WS_YC), bh >> 2, bh & 3, cp); }
            else if (idx < NATT) { const int j = idx, qb = 15 - j / NBP, bh = q * NBP + j % NBP;
                at::attn_block(lds, (const bf16*)(ws + WS_Q), (const bf16*)(ws + WS_K), (const bf16*)(ws + WS_KV), proj, (bf16*)(ws + WS_YA), qg, (const float*)(ws + WS_COS) + (size_t)row0 * 32, (const float*)(ws + WS_SIN) + (size_t)row0 * 32, bh >> 3, bh & 7, qb); }
            else { const int it = q * NSGU + (idx - NGLA - NATT);
                sg::sgu_item(lds, proj, (const float*)(ws + WS_SSQ) + 2 * MP, Ws, bs, vg, (bf16*)(ws + WS_YB), it); }
        }
    }
}
#ifndef GEMM_SP2
#define GEMM_SP2 true
#endif
#ifndef GEMM_ALIGN
#define GEMM_ALIGN true
#endif
typedef const __attribute__((address_space(4))) Args* KArgP;
#define KARG() ({ KArgP p_ = (KArgP)__builtin_amdgcn_kernarg_segment_ptr(); asm volatile("" : "+s"(p_)); p_; })
#define INF(i) ((const float*)ap->in[i])
__device__ __forceinline__ void grid_bar(const XcdBarrier& b0) { XcdBarrier b = b0; asm volatile("" : "+s"(b.bar)); xcd_barrier(b); }

__global__ void __launch_bounds__(512, 2) fwd(Args a) {
    extern __shared__ __attribute__((aligned(16))) unsigned char lds_raw[];
    LAS unsigned char* lds = (LAS unsigned char*)lds_raw;
    const int lo = a.lo, hi = a.hi;
    XcdBarrier bar; bar.bar = (unsigned*)(a.ws + WS_CTL) + CW_BAR; bar.x = 0; bar.st = nullptr;
    if (hi - lo > 1) {
        if (threadIdx.x < 4) ((LAS unsigned*)(lds + LDSCTL_OFF))[threadIdx.x] = 0u;
        __syncthreads();
        bar = xcd_barrier_post((unsigned*)(a.ws + WS_CTL) + CW_BAR, (volatile LAS unsigned*)(lds + LDSCTL_OFF));
    }
    int step = 0;
#define PH_BEGIN if (step >= lo && step < hi) { const KArgP ap = KARG(); unsigned char* const ws = ap->ws; const int vb = obid(), nvb = gridDim.x; (void)ws; (void)vb; (void)nvb;
#define PH_END   if (step + 1 < hi) grid_bar(bar); } ++step;
#define WL(l) (ws + WS_W + (size_t)(l) * SZ_WLAYER)
#define B_(T, off) ((T*)(ws + (off)))

    for (int l = 0; l < DEPTH; ++l) {
        PH_BEGIN
            { unsigned char* wl = ws + WS_W;
              convert_T<1>(INF(3) + (size_t)l * DM * IN_COLS, DM, IN_COLS, (bf16*)wl, NPROJ, (LAS float*)lds, vb, nvb);
              convert_T<0>(INF(6) + (size_t)l * 512 * 1536, 512, 1536, (bf16*)(wl + SZ_WIN), 1536, (LAS float*)lds, (vb + 64) % nvb, nvb, INF(4) + l * 512);
              convert_T<0>(INF(7) + (size_t)l * 512 * 2048, 512, 2048, (bf16*)(wl + SZ_WIN + SZ_WUQ), 2048, (LAS float*)lds, (vb + 128) % nvb, nvb, INF(5) + l * 512);
              for (int b = 0; b < 3; ++b)
                  convert_T<0>(INF(16) + ((size_t)l * 3 + b) * 1024 * 2048, 1024, 2048, (bf16*)(wl + SZ_WIN + SZ_WUQ + SZ_WUKV) + (size_t)b * 2048 * 1024, 2048, (LAS float*)lds, (vb + 32 * b) % nvb, nvb);
              convert_T<0>(INF(17) + (size_t)l * 2048 * 2048, 2048, 2048, (bf16*)(wl + SZ_WIN + SZ_WUQ + SZ_WUKV + SZ_WB), 2048, (LAS float*)lds, (vb + 192) % nvb, nvb); }
            if (l == 0) { const int* positions = (const int*)ap->in[1]; float* cosT = B_(float, WS_COS); float* sinT = B_(float, WS_SIN);
              for (int idx = vb * 512 + otid(); idx < MTOK * 32; idx += nvb * 512) {
                const int t = idx >> 5, i = idx & 31;
                const float inv = 1.0f / powf(10000.0f, (float)(2 * i) * (1.0f / 64.0f));
                const float ang = (float)positions[t] * inv;
                float sn, cs; sincosf(ang, &sn, &cs);
                cosT[idx] = cs; sinT[idx] = sn; } }
        PH_END
        for (int p = 0; p < NPASS; ++p) {
            const int row0 = p * MP;
#define XIN ((l == 0 ? (const float*)ap->in[0] : (const float*)ap->out) + (size_t)row0 * DM)
#define WLP (ws + WS_W)
            PH_BEGIN ph_norm(XIN, INF(2) + l * DM, B_(bf16, WS_H), MP, vb, nvb);
                     { float* ssq = B_(float, WS_SSQ); for (int i = vb * 512 + otid(); i < 3 * MP; i += nvb * 512) ssq[i] = 0.f; } PH_END
            PH_BEGIN { pg8::Gemm g{B_(bf16, WS_H), (const bf16*)WLP, MP, NPROJ, DM}; pg8::StaticOrder S; S.init(MP, NPROJ, nvb, vb); pg8::EpiProj E{B_(bf16, WS_PROJ), NPROJ, B_(float, WS_SSQ), MP};
                       pg8::gemm_phase<pg8::EpiProj, pg8::StaticOrder, false, GEMM_ALIGN, GEMM_SP2>(lds, g, S, E, nullptr); } PH_END
            PH_BEGIN { { pg8::Gemm g{B_(bf16, WS_PROJ) + C_CQ, (const bf16*)(WLP + SZ_WIN), MP, 1536, 512, NPROJ}; pg8::StaticOrder S; S.init(MP, 1536, nvb, vb); pg8::EpiBf16Row E{B_(bf16, WS_Q), 1536, B_(float, WS_SSQ), 1.0f / 512.f, EPS};
                         pg8::gemm_phase<pg8::EpiBf16Row, pg8::StaticOrder, false, GEMM_ALIGN, GEMM_SP2>(lds, g, S, E, nullptr); }
                       { pg8::Gemm g{B_(bf16, WS_PROJ) + C_CKV, (const bf16*)(WLP + SZ_WIN + SZ_WUQ), MP, 2048, 512, NPROJ}; pg8::StaticOrder S; S.init(MP, 2048, nvb, nvb - 1 - vb); pg8::EpiBf16Row E{B_(bf16, WS_KV), 2048, B_(float, WS_SSQ) + MP, 1.0f / 512.f, EPS};
                         pg8::gemm_phase<pg8::EpiBf16Row, pg8::StaticOrder, false, GEMM_ALIGN, GEMM_SP2>(lds, g, S, E, nullptr); }
                       for (int ci = vb; ci < (MP / 128) * 4; ci += nvb) {
                           gl::gla_prep_item(lds, 135168, B_(bf16, WS_PROJ), INF(13) + l * 16 * 512, INF(14) + l * 512, B_(bf16, WS_QE), B_(bf16, WS_KE), B_(bf16, WS_KL), B_(float, WS_DS), ci);
                           gl::gla_chunk_item(lds, B_(bf16, WS_PROJ), B_(bf16, WS_QE), B_(bf16, WS_KE), B_(bf16, WS_KL), B_(float, WS_OC), B_(float, WS_DL), ci); } } PH_END
            PH_BEGIN { constexpr int NA = NBP * 16;
                       if (nvb > 2 * NA) { if (vb < NA) gl::gla_stageA_item(B_(float, WS_DS), B_(float, WS_DL), B_(bf16, WS_XB), vb >> 4, (vb >> 2) & 3, vb & 3);
                                           else ph_kfin(B_(bf16, WS_KV), B_(bf16, WS_PROJ), B_(bf16, WS_K), INF(9) + l * 192, B_(float, WS_COS), B_(float, WS_SIN), row0, vb - NA, nvb - NA); }
                       else { for (int it = vb; it < NA; it += nvb) gl::gla_stageA_item(B_(float, WS_DS), B_(float, WS_DL), B_(bf16, WS_XB), it >> 4, (it >> 2) & 3, it & 3);
                              ph_kfin(B_(bf16, WS_KV), B_(bf16, WS_PROJ), B_(bf16, WS_K), INF(9) + l * 192, B_(float, WS_COS), B_(float, WS_SIN), row0, vb, nvb); } } PH_END
            PH_BEGIN ph_mixers(lds, ws, (unsigned*)(ws + WS_CTL) + CW_Q + (l * NPASS + p) * 8 * 64, INF(11) + (size_t)l * 8 * 128 * 128, INF(12) + l * 8 * 128, INF(10) + l * 1024, INF(15) + l * 256, INF(8) + l * 192, row0, vb); PH_END
            PH_BEGIN { pg8::Gemm g{B_(bf16, WS_YA), (const bf16*)(WLP + SZ_WIN + SZ_WUQ + SZ_WUKV), MP, 2048, 1024};
                       pg8::BranchOrder S; S.init(MP, 2048, nvb, vb); S.NB = 3; S.a_stride = (size_t)MP * 1024 * 2; S.b_stride = (size_t)2048 * 1024 * 2;
                       pg8::EpiMerge E{B_(bf16, WS_PROJ) + C_GATE, NPROJ, B_(bf16, WS_MG), 2048, 2048}; pg8::gemm_phase<pg8::EpiMerge, pg8::BranchOrder, false, GEMM_ALIGN, GEMM_SP2>(lds, g, S, E, nullptr); } PH_END
            PH_BEGIN { pg8::Gemm g{B_(bf16, WS_MG), (const bf16*)(WLP + SZ_WIN + SZ_WUQ + SZ_WUKV + SZ_WB), MP, 2048, 2048}; pg8::StaticOrder S; S.init(MP, 2048, nvb, vb); pg8::EpiRes E{XIN, ap->out + (size_t)row0 * DM, 2048};
                       pg8::gemm_phase<pg8::EpiRes, pg8::StaticOrder, false, GEMM_ALIGN, GEMM_SP2>(lds, g, S, E, nullptr); } PH_END
        }
    }
#undef PH_BEGIN
#undef PH_END
}

#ifndef ONE_LAUNCH
#define ONE_LAUNCH 1
#endif
extern "C" void kernel_launch(void* const* d_in, const int* in_sizes, int n_in, void* d_out, int out_size, void* d_ws, size_t ws_size, hipStream_t stream) {
    static int grid = 0;
    if (grid == 0) {
        if (n_in != 18 || out_size != MTOK * DM || ws_size < WS_END) { fprintf(stderr, "kernel_launch: unexpected shapes (n_in %d out %d ws %zu need %zu)\n", n_in, out_size, ws_size, (size_t)WS_END); grid = -1; return; }
        int dev = 0, cus = 0, per_cu = 0;
        if (hipGetDevice(&dev) != hipSuccess || hipDeviceGetAttribute(&cus, hipDeviceAttributeMultiprocessorCount, dev) != hipSuccess) { grid = -1; return; }
        if (hipFuncSetAttribute((const void*)fwd, hipFuncAttributeMaxDynamicSharedMemorySize, LDS_BYTES) != hipSuccess) { fprintf(stderr, "kernel_launch: hipFuncSetAttribute failed\n"); grid = -1; return; }
        if (hipOccupancyMaxActiveBlocksPerMultiprocessor(&per_cu, (const void*)fwd, 512, LDS_BYTES) != hipSuccess || per_cu < 1) { fprintf(stderr, "kernel_launch: occupancy query says %d\n", per_cu); }
        (void)hipGetLastError();
        grid = cus;
    }
    if (grid < 0) return;
    (void)hipMemsetAsync((char*)d_ws + WS_CTL, 0, CTL_BYTES, stream);
    Args a{};
    for (int i = 0; i < 18; ++i) a.in[i] = d_in[i];
    a.out = (float*)d_out; a.ws = (unsigned char*)d_ws; a.pad0 = 0; a.pad1 = 0;
#if ONE_LAUNCH
    a.lo = 0; a.hi = NSTEPS;
    hipLaunchKernelGGL(fwd, dim3(grid), dim3(512), LDS_BYTES, stream, a);
#else
    for (int s = 0; s < NSTEPS; ++s) { a.lo = s; a.hi = s + 1; hipLaunchKernelGGL(fwd, dim3(grid), dim3(512), LDS_BYTES, stream, a); }
#endif
}
```

```cpp
#include <hip/hip_runtime.h>
#include <cstdio>
#include <cstdint>
__device__ __forceinline__ int otid() { int t = threadIdx.x; asm volatile("" : "+v"(t)); return t; }
__device__ __forceinline__ int obid() { int t = blockIdx.x; asm volatile("" : "+s"(t)); return t; }
namespace pg8 {
#define PG8_LAS __attribute__((address_space(3)))
typedef unsigned short bf16_t;
typedef short bf16x8 __attribute__((ext_vector_type(8)));
typedef float f32x4 __attribute__((ext_vector_type(4)));
typedef unsigned u32x4 __attribute__((ext_vector_type(4)));
constexpr int BM = 256, BK = 64, HALF = 128, HTB = HALF * BK * 2  , STAGE_BYTES = 8 * HTB, NXCD = 8, WGM = 4;

__host__ __device__ __forceinline__ int lds_byte(int r, int c) { const int st = (r >> 4) * 2 + (c >> 5), rr = r & 15, cc = c & 31, ob = rr * 64 + cc * 2; return st * 1024 + (ob ^ (((ob >> 9) & 1) << 5)); }
__host__ __device__ __forceinline__ void stage_rc(int b, int& R, int& C) { const int st = b / 1024, sb = b % 1024, swz = sb ^ (((sb >> 9) & 1) << 5); R = (st >> 1) * 16 + swz / 64; C = (st & 1) * 32 + (swz % 64) / 2; }
__host__ __device__ __forceinline__ int perm32(int rho) { const int n = rho >> 4, i = rho & 15; return 8 * (i >> 2) + 4 * n + (i & 3); }

struct Unit { int pm, pn, pb; };
struct Gemm { const bf16_t* A; const bf16_t* Bt; int M, N, K; int lda; };

struct StaticOrder {
    int nM, nN, nwg, G, c;
    __host__ __device__ void init(int M, int N, int G_, int c_) { nM = M / BM; nN = N / BM; nwg = nM * nN; G = G_; c = c_; }
    __host__ __device__ bool next(int i, Unit& u) const {
        const long L = (long)i * G + c; if (L >= nwg) return false;
        int wgid = (int)L; { const int q = nwg / NXCD, r = nwg % NXCD, xcd = wgid % NXCD, off = wgid / NXCD; wgid = (xcd < r ? xcd * (q + 1) : r * (q + 1) + (xcd - r) * q) + off; }
        const int nig = WGM * nN, gid = wgid / nig, fm = gid * WGM, gsz = (nM - fm) < WGM ? (nM - fm) : WGM;
        u.pm = fm + ((wgid % nig) % gsz); u.pn = (wgid % nig) / gsz; u.pb = 0; return true;
    }
    __device__ __forceinline__ size_t a_off(const Unit&) const { return 0; }
    __device__ __forceinline__ size_t b_off(const Unit&) const { return 0; }
    __device__ __forceinline__ void a_ready(const Unit&) const {}
    __device__ __forceinline__ void done(const Unit&) const {}
};

struct BranchOrder : StaticOrder {
    int NB; size_t a_stride, b_stride;
    __device__ bool next(int i, Unit& u) const { const int ti = i / NB; if (!StaticOrder::next(ti, u)) return false; u.pb = i - ti * NB; return true; }
    __device__ __forceinline__ size_t a_off(const Unit& u) const { return (size_t)u.pb * a_stride; }
    __device__ __forceinline__ size_t b_off(const Unit& u) const { return (size_t)u.pb * b_stride; }
};

__device__ __forceinline__ unsigned cvt_pk_bf16(float lo, float hi) { unsigned r; asm volatile("v_cvt_pk_bf16_f32 %0, %1, %2" : "=v"(r) : "v"(lo), "v"(hi)); return r; }
__device__ __forceinline__ float gelu_tanh_f(float x) { const float u2 = 1.5957691216057308f * (x + 0.044715f * x * x * x); return x * __builtin_amdgcn_rcpf(1.f + __expf(-u2)); }
struct EpiProj {
    static constexpr bool PERM = true, AFTER_DRAIN = false;
    bf16_t* O; int ldc; float* SSQ; int mrows;
    __device__ __forceinline__ void operator()(const f32x4 (&acc)[2][2][4][2], const Unit& u, int wr, int wc, int fr, int fq) const {
        const int row0 = u.pm * BM + wr * 64 + fr, col0 = u.pn * BM + wc * 32 + 8 * fq;
        const int seg = u.pn < 2 ? 0 : (u.pn < 4 ? 1 : ((u.pn >= 12 && u.pn < 16) ? 2 : -1));
#pragma unroll
        for (int ai = 0; ai < 2; ++ai)
#pragma unroll
            for (int m = 0; m < 4; ++m) { const int row = row0 + ai * HALF + m * 16; bf16_t* rowp = O + (size_t)row * ldc + col0;
                float ss = 0.f;
#pragma unroll
                for (int bj = 0; bj < 2; ++bj) { const f32x4 v0 = acc[ai][bj][m][0], v1 = acc[ai][bj][m][1];
                    u32x4 w; w.x = cvt_pk_bf16(v0[0], v0[1]); w.y = cvt_pk_bf16(v0[2], v0[3]); w.z = cvt_pk_bf16(v1[0], v1[1]); w.w = cvt_pk_bf16(v1[2], v1[3]);
                    *(u32x4*)(rowp + bj * HALF) = w;
                    if (seg >= 0) {
#pragma unroll
                        for (int j = 0; j < 4; ++j) { float a = v0[j], b = v1[j]; if (seg == 2) { a = gelu_tanh_f(a); b = gelu_tanh_f(b); } ss += a * a + b * b; } } }
                if (seg >= 0) {
                    ss += __uint_as_float((unsigned)__builtin_amdgcn_ds_swizzle((int)__float_as_uint(ss), (16 << 10) | 0x1f));
                    auto rr = __builtin_amdgcn_permlane32_swap(__float_as_uint(ss), __float_as_uint(ss), false, false);
                    ss = __uint_as_float(rr[0]) + __uint_as_float(rr[1]);
                    if (fq == 0) atomicAdd(SSQ + (size_t)seg * mrows + row, ss); } }
    }
};
struct EpiBf16Row {
    static constexpr bool PERM = true, AFTER_DRAIN = false;
    bf16_t* O; int ldc; const float* SSQ; float inv_n, eps;
    __device__ __forceinline__ void operator()(const f32x4 (&acc)[2][2][4][2], const Unit& u, int wr, int wc, int fr, int fq) const {
        const int row0 = u.pm * BM + wr * 64 + fr, col0 = u.pn * BM + wc * 32 + 8 * fq;
#pragma unroll
        for (int ai = 0; ai < 2; ++ai)
#pragma unroll
            for (int m = 0; m < 4; ++m) { const int row = row0 + ai * HALF + m * 16; bf16_t* rowp = O + (size_t)row * ldc + col0;
                const float rn = 1.0f / sqrtf(SSQ[row] * inv_n + eps);
#pragma unroll
                for (int bj = 0; bj < 2; ++bj) { const f32x4 v0 = acc[ai][bj][m][0] * rn, v1 = acc[ai][bj][m][1] * rn;
                    u32x4 w; w.x = cvt_pk_bf16(v0[0], v0[1]); w.y = cvt_pk_bf16(v0[2], v0[3]); w.z = cvt_pk_bf16(v1[0], v1[1]); w.w = cvt_pk_bf16(v1[2], v1[3]);
                    *(u32x4*)(rowp + bj * HALF) = w; } }
    }
};

struct EpiRes {
    static constexpr bool PERM = false, AFTER_DRAIN = false;
    const float* base; float* C; int ldc;
    __device__ __forceinline__ void operator()(const f32x4 (&acc)[2][2][4][2], const Unit& u, int wr, int wc, int fr, int fq) const {
        const int row0 = u.pm * BM + wr * 64 + fr, col0 = u.pn * BM + wc * 32 + 4 * fq;
#pragma unroll
        for (int ai = 0; ai < 2; ++ai) {
            f32x4 bs[4][2][2];
#pragma unroll
            for (int m = 0; m < 4; ++m) { const size_t off = (size_t)(row0 + ai * HALF + m * 16) * ldc + col0;
#pragma unroll
                for (int bj = 0; bj < 2; ++bj)
#pragma unroll
                    for (int n = 0; n < 2; ++n) bs[m][bj][n] = *(const f32x4*)(base + off + bj * HALF + n * 16); }
#pragma unroll
            for (int m = 0; m < 4; ++m) { const size_t off = (size_t)(row0 + ai * HALF + m * 16) * ldc + col0;
#pragma unroll
                for (int bj = 0; bj < 2; ++bj)
#pragma unroll
                    for (int n = 0; n < 2; ++n) *(f32x4*)(C + off + bj * HALF + n * 16) = acc[ai][bj][m][n] + bs[m][bj][n]; }
            asm volatile("" ::: "memory");
        }
    }
};
struct EpiMerge {
    static constexpr bool PERM = true, AFTER_DRAIN = false;
    const bf16_t* G0; int ldg; bf16_t* MG; int ldc; int gstride;
    __device__ __forceinline__ void operator()(const f32x4 (&acc)[2][2][4][2], const Unit& u, int wr, int wc, int fr, int fq) const {
        const int row0 = u.pm * BM + wr * 64 + fr, col0 = u.pn * BM + wc * 32 + 8 * fq; const bf16_t* G = G0 + (size_t)u.pb * gstride; const bool first = u.pb == 0;
#pragma unroll
        for (int ai = 0; ai < 2; ++ai) {
            u32x4 gw[4][2], ow[4][2];
#pragma unroll
            for (int m = 0; m < 4; ++m) { const size_t row = (size_t)(row0 + ai * HALF + m * 16);
#pragma unroll
                for (int bj = 0; bj < 2; ++bj) { gw[m][bj] = *(const u32x4*)(G + row * ldg + col0 + bj * HALF); ow[m][bj] = first ? (u32x4){0u, 0u, 0u, 0u} : *(const u32x4*)(MG + row * ldc + col0 + bj * HALF); } }
#pragma unroll
            for (int m = 0; m < 4; ++m) { const size_t row = (size_t)(row0 + ai * HALF + m * 16);
#pragma unroll
                for (int bj = 0; bj < 2; ++bj) { const f32x4 v0 = acc[ai][bj][m][0], v1 = acc[ai][bj][m][1];
                    const unsigned g4[4] = {gw[m][bj].x, gw[m][bj].y, gw[m][bj].z, gw[m][bj].w}, o4[4] = {ow[m][bj].x, ow[m][bj].y, ow[m][bj].z, ow[m][bj].w};
                    const float a8[8] = {v0[0], v0[1], v0[2], v0[3], v1[0], v1[1], v1[2], v1[3]};
                    unsigned w4[4];
#pragma unroll
                    for (int q = 0; q < 4; ++q) {
                        const float g0 = __uint_as_float(g4[q] << 16), g1 = __uint_as_float(g4[q] & 0xffff0000u);
                        const float r0 = __uint_as_float(o4[q] << 16) + a8[2 * q] * __builtin_amdgcn_rcpf(1.0f + __expf(-g0));
                        const float r1 = __uint_as_float(o4[q] & 0xffff0000u) + a8[2 * q + 1] * __builtin_amdgcn_rcpf(1.0f + __expf(-g1));
                        unsigned pk; asm("v_cvt_pk_bf16_f32 %0, %1, %2" : "=v"(pk) : "v"(r0), "v"(r1)); w4[q] = pk; }
                    *(u32x4*)(MG + row * ldc + col0 + bj * HALF) = (u32x4){w4[0], w4[1], w4[2], w4[3]}; } }
            asm volatile("" ::: "memory");
        }
    }
};

template <class Epi, class Sched, bool STAMP = false, bool ALIGN_EPI = false, bool SP2 = false>
__device__ __forceinline__ void gemm_phase(PG8_LAS unsigned char* lds, const Gemm g, const Sched& S, const Epi& E, unsigned long long* stamps) {
    const int tid = otid(), wid = __builtin_amdgcn_readfirstlane(tid >> 6), lane = tid & 63, wr = wid >> 2, wc = wid & 3, fr = lane & 15, fq = lane >> 4;
    const int K = g.K, nt = K / BK, LDA = g.lda ? g.lda : g.K;
    int ts_lo = 0, ts_hi = 0, nts = 0; const unsigned long long rt_entry = STAMP ? (unsigned long long)wall_clock64() : 0ull;
#define PG8_STAMP() do { if (STAMP && wid == 0 && nts < 64) { const unsigned long long _c = (unsigned long long)clock64(); \
        ts_lo = (lane == nts) ? (int)(unsigned)_c : ts_lo; ts_hi = (lane == nts) ? (int)(unsigned)(_c >> 32) : ts_hi; ++nts; } } while (0)
    PG8_STAMP();
    unsigned voffA[2], voffB[2];
#pragma unroll
    for (int i = 0; i < 2; ++i) { int R, C; stage_rc(tid * 16 + i * 8192, R, C); const int Rb = Epi::PERM ? ((R & ~31) + perm32(R & 31)) : R;
        voffA[i] = (unsigned)(R * LDA + C) * 2u; voffB[i] = (unsigned)(Rb * K + C) * 2u; }
    const size_t kstep = (size_t)(BK * 2);
    const size_t hstepB = (size_t)HALF * K * 2, hstepA = (size_t)HALF * LDA * 2;
    const size_t tstepB = 2 * hstepB, tstepA = 2 * hstepA;
    const unsigned ldsw = (unsigned)wid * 1024u;
    const int aoff = lds_byte(wr * 64 + fr, fq * 8), boff = lds_byte(wc * 32 + fr, fq * 8);
#define PG8_SA(b, h) (((b) * 2 + (h)) * HTB)
#define PG8_SB(b, h) ((4 + (b) * 2 + (h)) * HTB)
#define PG8_STAGE(bufoff, gbase, voff) do { _Pragma("unroll") for (int _i = 0; _i < 2; ++_i) \
        __builtin_amdgcn_global_load_lds((const unsigned*)((const char*)(gbase) + (voff)[_i]), (PG8_LAS unsigned*)(lds + (bufoff) + ldsw + _i * 8192), 16, 0, 0); } while (0)
#define PG8_LDA(dst, b, h) do { _Pragma("unroll") for (int m = 0; m < 4; ++m) _Pragma("unroll") for (int k = 0; k < 2; ++k) dst[m][k] = *(const PG8_LAS bf16x8*)(lds + PG8_SA(b, h) + aoff + m * 2048 + k * 1024); } while (0)
#define PG8_LDB(dst, b, h) do { _Pragma("unroll") for (int n = 0; n < 2; ++n) _Pragma("unroll") for (int k = 0; k < 2; ++k) dst[n][k] = *(const PG8_LAS bf16x8*)(lds + PG8_SB(b, h) + boff + n * 2048 + k * 1024); } while (0)
#define PG8_MMA(ai, bj, At, Bt) do { __builtin_amdgcn_s_setprio(1); _Pragma("unroll") for (int m = 0; m < 4; ++m) _Pragma("unroll") for (int n = 0; n < 2; ++n) _Pragma("unroll") for (int k = 0; k < 2; ++k) \
        acc[ai][bj][m][n] = __builtin_amdgcn_mfma_f32_16x16x32_bf16(Bt[n][k], At[m][k], acc[ai][bj][m][n], 0, 0, 0); __builtin_amdgcn_s_setprio(0); } while (0)
#define PG8_WAIT_V(n) asm volatile("s_waitcnt vmcnt(" #n ")" ::: "memory")
#define PG8_WAIT_L(n) asm volatile("s_waitcnt lgkmcnt(" #n ")" ::: "memory")
#define PG8_BAR __builtin_amdgcn_s_barrier()
#define PG8_SCHED __builtin_amdgcn_sched_barrier(0)
    Unit cur, nxt; int ui = 0;
    if (!S.next(0, cur)) return;
    f32x4 acc[2][2][4][2];
#pragma unroll
    for (int a = 0; a < 2; ++a)
#pragma unroll
        for (int b = 0; b < 2; ++b)
#pragma unroll
            for (int m = 0; m < 4; ++m)
#pragma unroll
                for (int n = 0; n < 2; ++n) acc[a][b][m][n] = (f32x4){0.f, 0.f, 0.f, 0.f};
    bf16x8 At[4][2], B0[2][2], B1[2][2];
    const char* cA = (const char*)g.A + (size_t)cur.pm * tstepA + S.a_off(cur); const char* cB = (const char*)g.Bt + (size_t)cur.pn * tstepB + S.b_off(cur);
    S.a_ready(cur);
    if constexpr (SP2) {
        PG8_STAGE(PG8_SB(0, 0), cB, voffB); PG8_STAGE(PG8_SB(0, 1), cB + hstepB, voffB); PG8_STAGE(PG8_SA(0, 0), cA, voffA); PG8_STAGE(PG8_SA(0, 1), cA + hstepA, voffA);
        if (wr == 1) PG8_BAR;
        PG8_WAIT_V(2); PG8_BAR;
        PG8_STAGE(PG8_SB(1, 0), cB + kstep, voffB); PG8_STAGE(PG8_SA(1, 0), cA + kstep, voffA); PG8_STAGE(PG8_SB(1, 1), cB + hstepB + kstep, voffB);
        PG8_WAIT_V(6); PG8_BAR;
    } else {
    PG8_STAGE(PG8_SB(0, 0), cB, voffB); PG8_STAGE(PG8_SA(0, 0), cA, voffA); PG8_STAGE(PG8_SB(0, 1), cB + hstepB, voffB); PG8_STAGE(PG8_SA(0, 1), cA + hstepA, voffA);
    if (wr == 1) PG8_BAR;
    PG8_WAIT_V(4); PG8_BAR;
    PG8_STAGE(PG8_SB(1, 0), cB + kstep, voffB); PG8_STAGE(PG8_SA(1, 0), cA + kstep, voffA); PG8_STAGE(PG8_SB(1, 1), cB + hstepB + kstep, voffB);
    PG8_WAIT_V(6); PG8_BAR;
    }
    PG8_STAMP();
    for (;;) {
        const bool has_next = S.next(ui + 1, nxt);
        const char* nA = has_next ? (const char*)g.A + (size_t)nxt.pm * tstepA + S.a_off(nxt) : cA; const char* nB = has_next ? (const char*)g.Bt + (size_t)nxt.pn * tstepB + S.b_off(nxt) : cB;
        for (int t = 0; t < nt; t += 2) {
            const bool last = (t == nt - 2);
            const char* a1 = cA + (size_t)(t + 1) * kstep;
            const char* a2 = last ? nA : cA + (size_t)(t + 2) * kstep; const char* b2 = last ? nB : cB + (size_t)(t + 2) * kstep;
            const char* a3 = a2 + kstep; const char* b3 = b2 + kstep;
            if (last && has_next) S.a_ready(nxt);
            if constexpr (SP2) {
            PG8_LDB(B0, 0, 0); PG8_LDB(B1, 0, 1); PG8_SCHED; PG8_LDA(At, 0, 0); PG8_STAGE(PG8_SA(1, 1), a1 + hstepA, voffA);
            PG8_WAIT_V(8); PG8_WAIT_L(0); PG8_BAR; PG8_MMA(0, 0, At, B0); PG8_MMA(0, 1, At, B1); PG8_BAR; PG8_SCHED;
            PG8_LDA(At, 0, 1); PG8_STAGE(PG8_SB(0, 0), b2, voffB); PG8_STAGE(PG8_SB(0, 1), b2 + hstepB, voffB); PG8_STAGE(PG8_SA(0, 0), a2, voffA);
            PG8_WAIT_V(8); PG8_WAIT_L(0); PG8_BAR; PG8_MMA(1, 0, At, B0); PG8_MMA(1, 1, At, B1); PG8_BAR; PG8_SCHED;
            PG8_LDB(B0, 1, 0); PG8_LDB(B1, 1, 1); PG8_SCHED; PG8_LDA(At, 1, 0); PG8_STAGE(PG8_SA(0, 1), a2 + hstepA, voffA);
            PG8_WAIT_V(8); PG8_WAIT_L(0); PG8_BAR; PG8_MMA(0, 0, At, B0); PG8_MMA(0, 1, At, B1); PG8_BAR; PG8_SCHED;
            PG8_LDA(At, 1, 1); PG8_STAGE(PG8_SB(1, 0), b3, voffB); PG8_STAGE(PG8_SB(1, 1), b3 + hstepB, voffB); PG8_STAGE(PG8_SA(1, 0), a3, voffA);
            PG8_WAIT_V(8); PG8_WAIT_L(0); PG8_BAR; PG8_MMA(1, 0, At, B0); PG8_MMA(1, 1, At, B1); PG8_BAR; PG8_SCHED;
            } else {
            PG8_LDB(B0, 0, 0); PG8_SCHED; PG8_LDA(At, 0, 0); PG8_STAGE(PG8_SA(1, 1), a1 + hstepA, voffA);
            PG8_WAIT_L(8); PG8_BAR; PG8_WAIT_L(0); PG8_MMA(0, 0, At, B0); PG8_BAR; PG8_SCHED;
            PG8_LDB(B1, 0, 1); PG8_STAGE(PG8_SB(0, 0), b2, voffB);
            PG8_BAR; PG8_WAIT_L(0); PG8_MMA(0, 1, At, B1); PG8_BAR;
            PG8_LDA(At, 0, 1); PG8_STAGE(PG8_SA(0, 0), a2, voffA);
            PG8_BAR; PG8_WAIT_L(0); PG8_MMA(1, 0, At, B0); PG8_BAR; PG8_SCHED;
            PG8_STAGE(PG8_SB(0, 1), b2 + hstepB, voffB);
            PG8_WAIT_V(6); PG8_BAR; PG8_MMA(1, 1, At, B1); PG8_BAR;
            PG8_LDB(B0, 1, 0); PG8_SCHED; PG8_LDA(At, 1, 0); PG8_STAGE(PG8_SA(0, 1), a2 + hstepA, voffA);
            PG8_WAIT_L(8); PG8_BAR; PG8_WAIT_L(0); PG8_MMA(0, 0, At, B0); PG8_BAR; PG8_SCHED;
            PG8_LDB(B1, 1, 1); PG8_STAGE(PG8_SB(1, 0), b3, voffB);
            PG8_BAR; PG8_WAIT_L(0); PG8_MMA(0, 1, At, B1); PG8_BAR;
            PG8_LDA(At, 1, 1); PG8_STAGE(PG8_SA(1, 0), a3, voffA);
            PG8_BAR; PG8_WAIT_L(0); PG8_MMA(1, 0, At, B0); PG8_BAR; PG8_SCHED;
            PG8_STAGE(PG8_SB(1, 1), b3 + hstepB, voffB);
            PG8_WAIT_V(6); PG8_BAR; PG8_MMA(1, 1, At, B1); PG8_BAR;
            }
        }
        if constexpr (ALIGN_EPI) { if (wr == 0) PG8_BAR; }
        PG8_STAMP();
        if constexpr (!Epi::AFTER_DRAIN) { E(acc, cur, wr, wc, fr, fq); S.done(cur); }
        PG8_STAMP();
        if (!has_next) break;
#pragma unroll
        for (int a = 0; a < 2; ++a)
#pragma unroll
            for (int b = 0; b < 2; ++b)
#pragma unroll
                for (int m = 0; m < 4; ++m)
#pragma unroll
                    for (int n = 0; n < 2; ++n) acc[a][b][m][n] = (f32x4){0.f, 0.f, 0.f, 0.f};
        cur = nxt; cA = nA; cB = nB; ++ui;
        if constexpr (ALIGN_EPI) { if (wr == 1) PG8_BAR; }
    }
    PG8_WAIT_V(0);
    if constexpr (!ALIGN_EPI) { if (wr == 0) PG8_BAR; }
    PG8_BAR;
    if constexpr (Epi::AFTER_DRAIN) { E.fused(acc, cur, wr, wc, fr, fq, lds, wid, lane); S.done(cur); }
    PG8_STAMP();
    if (STAMP && wid == 0) { stamps[lane] = lane < nts ? (((unsigned long long)(unsigned)ts_hi << 32) | (unsigned)ts_lo) : 0ull;
        if (lane == 62) stamps[62] = rt_entry; if (lane == 63) stamps[63] = (unsigned long long)wall_clock64(); }
#undef PG8_STAMP
#undef PG8_SA
#undef PG8_SB
#undef PG8_STAGE
#undef PG8_LDA
#undef PG8_LDB
#undef PG8_MMA
#undef PG8_WAIT_V
#undef PG8_WAIT_L
#undef PG8_BAR
#undef PG8_SCHED
}
}
#define XB_TMO      128
#define XB_XCNT(j)  (256  + 64 * (j))
#define XB_XSUB(j)  (1280 + 64 * (j))
#define XB_XGEN(j)  (2304 + 64 * (j))
#define XB_TOP      3328
#define XB_TOPGEN   3392
#define XCD_BAR_WORDS 3456
#define XB_SPIN_CAP (1u << 18)
#define LAS __attribute__((address_space(3)))

__device__ __forceinline__ unsigned xb_ld(unsigned* p)              { return __hip_atomic_load(p, __ATOMIC_RELAXED, __HIP_MEMORY_SCOPE_AGENT); }
__device__ __forceinline__ unsigned xb_add(unsigned* p, unsigned v) { return __hip_atomic_fetch_add(p, v, __ATOMIC_RELAXED, __HIP_MEMORY_SCOPE_AGENT); }
__device__ __forceinline__ unsigned xb_xcc_id() { return (unsigned)__builtin_amdgcn_s_getreg((3 << 11) | 20) & 0xFu; }
#define XB_SPIN(cond, bar) do { unsigned _sp = 0; while (cond) { __builtin_amdgcn_s_sleep(1); \
    if ((++_sp & 255u) == 0u) { if (xb_ld(&(bar)[XB_TMO])) break; if (_sp > XB_SPIN_CAP) { atomicAdd(&(bar)[XB_TMO], 1u); break; } } } } while (0)

struct XcdBarrier {
    unsigned* bar; unsigned x;
    volatile LAS unsigned* st;
};

__device__ __forceinline__ XcdBarrier xcd_barrier_post(unsigned* bar, volatile LAS unsigned* st) {
    XcdBarrier b; b.bar = bar; b.x = xb_xcc_id(); b.st = st;
    if (threadIdx.x == 0) (void)xb_add(&bar[XB_XCNT(b.x)], 1u);
    return b;
}
__device__ __forceinline__ void xcd_barrier_complete(unsigned* bar, unsigned x, unsigned& nloc, unsigned& nx) {
    const unsigned G = gridDim.x * gridDim.y * gridDim.z;
    unsigned sum, cnt, mine, sp = 0u;
    for (;;) {
        sum = 0u; cnt = 0u; mine = 0u;
#pragma unroll
        for (unsigned j = 0; j < 16; ++j) { const unsigned c = xb_ld(&bar[XB_XCNT(j)]); sum += c; cnt += (c > 0u) ? 1u : 0u; mine = (j == x) ? c : mine; }
        if (sum == G) break;
        __builtin_amdgcn_s_sleep(1);
        if ((++sp & 255u) == 0u) { if (xb_ld(&bar[XB_TMO])) break; if (sp > XB_SPIN_CAP) { atomicAdd(&bar[XB_TMO], 1u); break; } }
    }
    nloc = mine > 0u ? mine : 1u; nx = cnt > 0u ? cnt : 1u;
}

__device__ __forceinline__ void xcd_barrier(const XcdBarrier& b) {
    asm volatile("s_waitcnt vmcnt(0)" ::: "memory");
    __syncthreads();
    if (threadIdx.x == 0) {
        unsigned* bar = b.bar;
        __builtin_amdgcn_s_waitcnt(0);
        unsigned nloc = b.st[0], nx = b.st[1];
        if (nloc == 0u) { xcd_barrier_complete(bar, b.x, nloc, nx); b.st[0] = nloc; b.st[1] = nx; }
        const unsigned old = xb_add(&bar[XB_XSUB(b.x)], 1u);
        const unsigned gen = old / nloc;
        if (old + 1u == (gen + 1u) * nloc) {
            __builtin_amdgcn_fence(__ATOMIC_RELEASE, "agent");
            asm volatile("s_waitcnt vmcnt(0)" ::: "memory");
            const unsigned og = xb_add(&bar[XB_TOP], 1u);
            const unsigned tg = og / nx;
            if (og + 1u == (tg + 1u) * nx) xb_add(&bar[XB_TOPGEN], 1u);
            else XB_SPIN(xb_ld(&bar[XB_TOPGEN]) == tg, bar);
            __builtin_amdgcn_fence(__ATOMIC_ACQUIRE, "agent");
            xb_add(&bar[XB_XGEN(b.x)], 1u);
            asm volatile("s_waitcnt vmcnt(0)" ::: "memory");
        } else {
            XB_SPIN(xb_ld(&bar[XB_XGEN(b.x)]) == gen, bar);
            __builtin_amdgcn_fence(__ATOMIC_ACQUIRE, "agent");
            asm volatile("s_waitcnt vmcnt(0)" ::: "memory");
        }
    }
    __syncthreads();
}


typedef unsigned short bf16;
typedef unsigned v4u __attribute__((ext_vector_type(4)));
typedef unsigned v2u __attribute__((ext_vector_type(2)));
typedef float v4f __attribute__((ext_vector_type(4)));
typedef float v2f __attribute__((ext_vector_type(2)));

constexpr int DM = 2048, NBATCH = 8, SEQ = 4096, DEPTH = 2, MTOK = NBATCH * SEQ;
constexpr int IN_COLS = 14416, NPROJ = 14592;
constexpr int C_CQ = 0, C_CKV = 512, C_ZA = 1024, C_UB = 2048, C_VB = 3072, C_ZB = 4096, C_QC = 5120, C_KC = 5632, C_VC = 6144, C_ZC = 7168,
              C_GATE = 8192, C_KROPE = 14336, C_AR = 14400;
constexpr float EPS = 1e-6f;
#ifndef NBP
#define NBP 4
#endif
constexpr int MP = NBP * SEQ, NPASS = NBATCH / NBP;
constexpr int STEPS_PER_PASS = 7;
constexpr int NSTEPS = DEPTH * (1 + NPASS * STEPS_PER_PASS);

constexpr size_t al256(size_t x) { return (x + 255) & ~(size_t)255; }
constexpr size_t WS_CTL = 0, CTL_BYTES = 1u << 20;
constexpr size_t SZ_WIN = (size_t)NPROJ * DM * 2, SZ_WUQ = (size_t)1536 * 512 * 2, SZ_WUKV = (size_t)2048 * 512 * 2, SZ_WB = (size_t)3 * 2048 * 1024 * 2, SZ_WO = (size_t)2048 * 2048 * 2;
constexpr size_t SZ_WLAYER = SZ_WIN + SZ_WUQ + SZ_WUKV + SZ_WB + SZ_WO;
constexpr size_t WS_W = CTL_BYTES;
constexpr size_t WS_COS = WS_W + SZ_WLAYER, WS_SIN = WS_COS + (size_t)MTOK * 32 * 4;
constexpr size_t WS_H = WS_SIN + (size_t)MTOK * 32 * 4;
constexpr size_t WS_MG = WS_H;
constexpr size_t WS_PROJ = WS_H + (size_t)MP * DM * 2;
constexpr size_t WS_XB = WS_PROJ + (size_t)MP * NPROJ * 2;
constexpr size_t WS_SSQ = WS_XB + (size_t)MP * 2048;
constexpr size_t WS_Q = WS_SSQ + al256((size_t)3 * MP * 4);
constexpr size_t WS_KV = WS_Q + (size_t)MP * 1536 * 2;
constexpr size_t WS_K = WS_KV + (size_t)MP * 2048 * 2;
constexpr size_t WS_YA = WS_K + (size_t)MP * 1536 * 2;
constexpr size_t WS_YB = WS_YA + (size_t)MP * 1024 * 2;
constexpr size_t WS_DL = WS_YA;
constexpr size_t WS_YC = WS_YB + (size_t)MP * 1024 * 2;
constexpr size_t WS_OC = WS_YC + (size_t)MP * 1024 * 2;
constexpr size_t WS_QE = WS_OC + (size_t)MP * 1024 * 4;
constexpr size_t WS_KE = WS_QE + (size_t)MP * 512 * 2, WS_KL = WS_KE + (size_t)MP * 512 * 2;
constexpr size_t WS_DS = WS_KL + (size_t)MP * 512 * 2;
constexpr size_t WS_END = WS_DS + (size_t)(MP / 128) * 512 * 4;
static_assert(WS_END <= ((size_t)1 << 30), "workspace map exceeds 1 GiB");

constexpr int LDS_BYTES = 147456;
constexpr int LDSCTL_OFF = LDS_BYTES - 256;
constexpr int CW_BAR = 4096;

__device__ __forceinline__ float bf2f(unsigned v) { return __uint_as_float(v << 16); }
__device__ __forceinline__ unsigned f2bf(float f) { unsigned u = __float_as_uint(f); return (u + 0x7fffu + ((u >> 16) & 1u)) >> 16; }
__device__ __forceinline__ unsigned pk2(float lo, float hi) { return f2bf(lo) | (f2bf(hi) << 16); }
__device__ __forceinline__ float lo16(unsigned w) { return __uint_as_float(w << 16); }
__device__ __forceinline__ float hi16(unsigned w) { return __uint_as_float(w & 0xffff0000u); }
__device__ __forceinline__ float sigmoid_f(float x) { return 1.f / (1.f + __expf(-x)); }
__device__ __forceinline__ float silu_f(float x) { return x / (1.f + __expf(-x)); }
__device__ __forceinline__ float gelu_f(float x) { const float u2 = 1.5957691216057308f * (x + 0.044715f * x * x * x); return x * __builtin_amdgcn_rcpf(1.f + __expf(-u2)); }
template <int O> __device__ __forceinline__ float lane_xor(float v) {
    if (O == 1) return __uint_as_float((unsigned)__builtin_amdgcn_mov_dpp((int)__float_as_uint(v), 0xB1, 0xf, 0xf, true));
    if (O == 2) return __uint_as_float((unsigned)__builtin_amdgcn_mov_dpp((int)__float_as_uint(v), 0x4E, 0xf, 0xf, true));
    return __uint_as_float((unsigned)__builtin_amdgcn_ds_swizzle((int)__float_as_uint(v), (O << 10) | 0x1f)); }
__device__ __forceinline__ float lane_xor32(float v, int lane) {
    auto rr = __builtin_amdgcn_permlane32_swap(__float_as_uint(v), __float_as_uint(v), false, false);
    return __uint_as_float(lane < 32 ? rr[1] : rr[0]); }
__device__ __forceinline__ float wave_sum(float v) {
    v += lane_xor<1>(v); v += lane_xor<2>(v); v += lane_xor<4>(v); v += lane_xor<8>(v); v += lane_xor<16>(v);
    auto rr = __builtin_amdgcn_permlane32_swap(__float_as_uint(v), __float_as_uint(v), false, false);
    return __uint_as_float(rr[0]) + __uint_as_float(rr[1]); }
__device__ __forceinline__ float wave_max(float v) {
    v = fmaxf(v, lane_xor<1>(v)); v = fmaxf(v, lane_xor<2>(v)); v = fmaxf(v, lane_xor<4>(v)); v = fmaxf(v, lane_xor<8>(v)); v = fmaxf(v, lane_xor<16>(v));
    auto rr = __builtin_amdgcn_permlane32_swap(__float_as_uint(v), __float_as_uint(v), false, false);
    return fmaxf(__uint_as_float(rr[0]), __uint_as_float(rr[1])); }
#define LDS_FENCE() asm volatile("s_waitcnt lgkmcnt(0)" ::: "memory")

struct Args { const void* in[18]; float* out; unsigned char* ws; int lo, hi, pad0, pad1; };

template <int MODE> __device__ __forceinline__ int src_col(int n) {
    if (MODE == 0) return n;
    if (n < C_ZA) return n;
    if (n < C_ZC) return n + 64;
    if (n < C_KROPE) return n + 80;
    if (n < C_AR) return 1024 + (n - C_KROPE);
    if (n < C_AR + 16) return 7232 + (n - C_AR);
    return -1;
}
template <int MODE> __device__ __forceinline__ void convert_T(const float* W, int K, int Nsrc, bf16* WT, int Ndst, LAS float* tile, int vb, int nvb, const float* kscale = nullptr) {
    const int tid = otid(), ntk = K / 64, ntn = Ndst / 64, ntiles = ntk * ntn;
    for (int t = vb; t < ntiles; t += nvb) {
        const int k0 = (t % ntk) * 64, n0 = (t / ntk) * 64;
        { const int nn = tid & 63, sc = src_col<MODE>(n0 + nn);
#pragma unroll
          for (int i = 0; i < 8; ++i) { const int kk = (tid >> 6) + 8 * i; tile[kk * 65 + nn] = sc >= 0 ? W[(size_t)(k0 + kk) * Nsrc + sc] * (kscale ? kscale[k0 + kk] : 1.f) : 0.f; } }
        __syncthreads();
        { const int nn = tid & 63, kg = tid >> 6;
          const LAS float* tp = tile + (kg * 8) * 65 + nn;
          v4u o; o.x = pk2(tp[0], tp[65]); o.y = pk2(tp[2 * 65], tp[3 * 65]); o.z = pk2(tp[4 * 65], tp[5 * 65]); o.w = pk2(tp[6 * 65], tp[7 * 65]);
          *(v4u*)(WT + (size_t)(n0 + nn) * K + k0 + kg * 8) = o; }
        __syncthreads();
    }
}

__device__ __forceinline__ void ph_norm(const float* xin, const float* g, bf16* h, int rows, int vb, int nvb) {
    const int tid_ = otid(); const int lane = tid_ & 63, wave = tid_ >> 6;
    for (int r = vb * 8 + wave; r < rows; r += nvb * 8) {
        const v4f* xr = (const v4f*)(xin + (size_t)r * DM);
        v4f v[8]; float ss = 0.f;
#pragma unroll
        for (int j = 0; j < 8; ++j) { v[j] = xr[lane + 64 * j]; ss += v[j].x * v[j].x + v[j].y * v[j].y + v[j].z * v[j].z + v[j].w * v[j].w; }
        ss = wave_sum(ss);
        const float rn = 1.0f / sqrtf(ss * (1.0f / DM) + EPS);
#pragma unroll
        for (int j = 0; j < 8; ++j) { const v4f gg = ((const v4f*)g)[lane + 64 * j];
            v2u o; o.x = pk2(v[j].x * rn * gg.x, v[j].y * rn * gg.y); o.y = pk2(v[j].z * rn * gg.z, v[j].w * rn * gg.w);
            *(v2u*)(h + (size_t)r * DM + (lane + 64 * j) * 4) = o; }
    }
}
__device__ __forceinline__ float row16_sum(float v) {
    v += __uint_as_float((unsigned)__builtin_amdgcn_mov_dpp((int)__float_as_uint(v), 0xB1, 0xf, 0xf, true));
    v += __uint_as_float((unsigned)__builtin_amdgcn_mov_dpp((int)__float_as_uint(v), 0x4E, 0xf, 0xf, true));
    v += __uint_as_float((unsigned)__builtin_amdgcn_mov_dpp((int)__float_as_uint(v), 0x141, 0xf, 0xf, true));
    v += __uint_as_float((unsigned)__builtin_amdgcn_mov_dpp((int)__float_as_uint(v), 0x140, 0xf, 0xf, true));
    return v; }
__device__ __forceinline__ void ph_kfin(const bf16* kv, const bf16* proj, bf16* K, const float* kg, const float* cosT, const float* sinT, int row0, int vb, int nvb) {
    const int tid_ = otid(); const int lane = tid_ & 63, wave = tid_ >> 6, g16 = lane >> 4, c = lane & 15;
    float gn[8], gr[8];
#pragma unroll
    for (int j = 0; j < 8; ++j) { gn[j] = kg[c * 8 + j]; gr[j] = kg[128 + (c & 7) * 8 + j]; }
    for (int r = vb * 8 + wave; r < MP; r += nvb * 8) {
        const v4u n0 = *(const v4u*)(kv + (size_t)r * 2048 + g16 * 256 + c * 8), n1 = *(const v4u*)(kv + (size_t)r * 2048 + (g16 + 4) * 256 + c * 8);
        const v4u rw = *(const v4u*)(proj + (size_t)r * NPROJ + C_KROPE + (c & 7) * 8);
        const v4f c0 = *(const v4f*)(cosT + (size_t)(row0 + r) * 32 + (c & 3) * 8), c1 = *(const v4f*)(cosT + (size_t)(row0 + r) * 32 + (c & 3) * 8 + 4);
        const v4f s0 = *(const v4f*)(sinT + (size_t)(row0 + r) * 32 + (c & 3) * 8), s1 = *(const v4f*)(sinT + (size_t)(row0 + r) * 32 + (c & 3) * 8 + 4);
        float a[8] = {lo16(n0.x), hi16(n0.x), lo16(n0.y), hi16(n0.y), lo16(n0.z), hi16(n0.z), lo16(n0.w), hi16(n0.w)};
        float b[8] = {lo16(n1.x), hi16(n1.x), lo16(n1.y), hi16(n1.y), lo16(n1.z), hi16(n1.z), lo16(n1.w), hi16(n1.w)};
        float kr[8] = {lo16(rw.x), hi16(rw.x), lo16(rw.y), hi16(rw.y), lo16(rw.z), hi16(rw.z), lo16(rw.w), hi16(rw.w)};
        const float cs[8] = {c0.x, c0.y, c0.z, c0.w, c1.x, c1.y, c1.z, c1.w}, sn[8] = {s0.x, s0.y, s0.z, s0.w, s1.x, s1.y, s1.z, s1.w};
        float sa = 0.f, sb = 0.f, sr = 0.f;
#pragma unroll
        for (int j = 0; j < 8; ++j) { sa += a[j] * a[j]; sb += b[j] * b[j]; sr += kr[j] * kr[j]; }
        if (c >= 8) sr = 0.f;
        sa = row16_sum(sa); sb = row16_sum(sb); sr = row16_sum(sr);
        const float rna = 1.0f / sqrtf((sa + sr) * (1.0f / 192.f) + EPS), rnb = 1.0f / sqrtf((sb + sr) * (1.0f / 192.f) + EPS);
        float R[8];
#pragma unroll
        for (int j = 0; j < 8; ++j) { const float mine = kr[j] * gr[j]; const float oth = lane_xor<4>(mine);
            R[j] = (c & 4) ? mine * cs[j] + oth * sn[j] : mine * cs[j] - oth * sn[j]; }
        bf16* ka = K + ((size_t)r * 8 + g16) * 192; bf16* kb = K + ((size_t)r * 8 + g16 + 4) * 192;
        { v4u o; o.x = pk2(a[0] * rna * gn[0], a[1] * rna * gn[1]); o.y = pk2(a[2] * rna * gn[2], a[3] * rna * gn[3]); o.z = pk2(a[4] * rna * gn[4], a[5] * rna * gn[5]); o.w = pk2(a[6] * rna * gn[6], a[7] * rna * gn[7]); *(v4u*)(ka + c * 8) = o; }
        { v4u o; o.x = pk2(b[0] * rnb * gn[0], b[1] * rnb * gn[1]); o.y = pk2(b[2] * rnb * gn[2], b[3] * rnb * gn[3]); o.z = pk2(b[4] * rnb * gn[4], b[5] * rnb * gn[5]); o.w = pk2(b[6] * rnb * gn[6], b[7] * rnb * gn[7]); *(v4u*)(kb + c * 8) = o; }
        if (c < 8) {
            v4u o; o.x = pk2(R[0] * rna, R[1] * rna); o.y = pk2(R[2] * rna, R[3] * rna); o.z = pk2(R[4] * rna, R[5] * rna); o.w = pk2(R[6] * rna, R[7] * rna); *(v4u*)(ka + 128 + c * 8) = o;
            v4u p; p.x = pk2(R[0] * rnb, R[1] * rnb); p.y = pk2(R[2] * rnb, R[3] * rnb); p.z = pk2(R[4] * rnb, R[5] * rnb); p.w = pk2(R[6] * rnb, R[7] * rnb); *(v4u*)(kb + 128 + c * 8) = p; }
    }
}

namespace at {
typedef short bf16x8 __attribute__((ext_vector_type(8)));
typedef short s16x4 __attribute__((ext_vector_type(4)));
typedef float f32x16 __attribute__((ext_vector_type(16)));
typedef unsigned u32x4 __attribute__((ext_vector_type(4)));
constexpr int SHM_V = 16384, SHM_K = 16384, SHM_KR = 8192;
constexpr int OFF_V = 0, OFF_K = 3 * SHM_V, OFF_KR = OFF_K + 2 * SHM_K, OFF_WS = OFF_KR + 2 * SHM_KR, LDS_NEED = OFF_WS + 8 * 64 * 4;
constexpr float SCALE = 0.07216878364870322f;
constexpr float THR = 8.f;
#define AT_KSWZ(row, colB) ((row) * 256 + ((colB) ^ (((row) & 7) << 4)))
#define AT_KRSWZ(row, colB) ((row) * 128 + ((colB) ^ (((row) & 7) << 4)))
#define AT_SBAR() __builtin_amdgcn_sched_barrier(0)
__device__ __forceinline__ int v_st(int k, int c) { const int kk = (k & ~0xC) | ((k & 4) << 1) | ((k & 8) >> 1); return ((kk >> 3) * 4 + (c >> 5)) * 512 + ((kk & 7) * 32 + (c & 31)) * 2; }
__device__ __forceinline__ int v_rd_base(int lane) { return ((lane & 3) << 3) | (((lane >> 2) & 3) << 6) | (((lane >> 4) & 1) << 5) | (((lane >> 5) & 1) << 8); }
constexpr int v_rd_off(int d0, int ks, int half) { return d0 * 512 + ks * 4096 + half * 2048; }
__device__ __forceinline__ int crow(int r, int hi) { return (r & 3) + 8 * (r >> 2) + 4 * hi; }
__device__ __forceinline__ unsigned cvtpk(float lo, float hi) { unsigned r; asm("v_cvt_pk_bf16_f32 %0, %1, %2" : "=v"(r) : "v"(lo), "v"(hi)); return r; }

__device__ __forceinline__ void mask_tile(f32x16& p0, f32x16& p1, int dq) {
    const float NEG = -__builtin_inff();
#pragma unroll
    for (int r = 0; r < 16; ++r) { const int c = (r & 3) + 8 * (r >> 2); if (dq < c) p0[r] = NEG; if (dq < c + 32) p1[r] = NEG; }
}
__device__ __forceinline__ void partialSM(f32x16& p0, f32x16& p1, float& m_reg, float& mn, float& alpha) {
    float pmax = p0[0];
#pragma unroll
    for (int r = 1; r < 16; ++r) pmax = fmaxf(pmax, p0[r]);
#pragma unroll
    for (int r = 0; r < 16; ++r) pmax = fmaxf(pmax, p1[r]);
    { auto rr = __builtin_amdgcn_permlane32_swap(__float_as_uint(pmax), __float_as_uint(pmax), false, false);
      pmax = fmaxf(__uint_as_float(rr[0]), __uint_as_float(rr[1])); }
    constexpr float C2 = 1.4426950408889634f * SCALE;
    if (__builtin_expect(__all((pmax - m_reg) * SCALE <= THR), 1)) { mn = m_reg; alpha = 1.f; }
    else { mn = fmaxf(m_reg, pmax); alpha = __builtin_amdgcn_exp2f((m_reg - mn) * C2); m_reg = mn; }
    const float mnL = -mn * C2;
#pragma unroll
    for (int r = 0; r < 16; ++r) p0[r] = fmaf(p0[r], C2, mnL);
#pragma unroll
    for (int r = 0; r < 16; ++r) p1[r] = fmaf(p1[r], C2, mnL);
#pragma unroll
    for (int r = 0; r < 16; ++r) p0[r] = __builtin_amdgcn_exp2f(p0[r]);
}
__device__ __forceinline__ void finishSM(f32x16& p0, f32x16& p1, float alpha, float& l_reg, bf16x8& pa0, bf16x8& pa1, bf16x8& pa2, bf16x8& pa3) {
#pragma unroll
    for (int r = 0; r < 16; ++r) p1[r] = __builtin_amdgcn_exp2f(p1[r]);
    float ps = 0;
#pragma unroll
    for (int r = 0; r < 16; ++r) ps += p0[r];
#pragma unroll
    for (int r = 0; r < 16; ++r) ps += p1[r];
    { auto rr = __builtin_amdgcn_permlane32_swap(__float_as_uint(ps), __float_as_uint(ps), false, false);
      ps = __uint_as_float(rr[0]) + __uint_as_float(rr[1]); }
    l_reg = l_reg * alpha + ps;
#define AT_PK4(P, B_, OUT) do { unsigned a0 = cvtpk(P[B_+0], P[B_+1]), a1 = cvtpk(P[B_+2], P[B_+3]);                          \
        unsigned b0 = cvtpk(P[B_+4], P[B_+5]), b1 = cvtpk(P[B_+6], P[B_+7]);                                             \
        auto r0 = __builtin_amdgcn_permlane32_swap(a0, b0, false, false); auto r1 = __builtin_amdgcn_permlane32_swap(a1, b1, false, false); \
        u32x4 w = {r0[0], r1[0], r0[1], r1[1]}; OUT = *reinterpret_cast<bf16x8*>(&w); } while (0)
    AT_PK4(p0, 0, pa0); AT_PK4(p0, 8, pa1); AT_PK4(p1, 0, pa2); AT_PK4(p1, 8, pa3);
#undef AT_PK4
}
__device__ __forceinline__ void qkt(f32x16& p0, f32x16& p1, const LAS unsigned char* Kb, const LAS unsigned char* KRb, int r32, int hi, const bf16x8* qr) {
    p0 = f32x16{}; p1 = f32x16{};
    const LAS unsigned char* kb[4]; const LAS unsigned char* krb[4];
#pragma unroll
    for (int dd = 0; dd < 4; ++dd) { kb[dd] = Kb + AT_KSWZ(r32, (dd * 16 + hi * 8) * 2); krb[dd] = KRb + AT_KRSWZ(r32, (dd * 16 + hi * 8) * 2); }
    bf16x8 f[24];
#pragma unroll
    for (int d0 = 0; d0 < 8; ++d0) { const LAS unsigned char* a = kb[d0 & 3] + (d0 >> 2) * 128;
        f[2 * d0] = *reinterpret_cast<const LAS bf16x8*>(a); f[2 * d0 + 1] = *reinterpret_cast<const LAS bf16x8*>(a + 32 * 256); }
#pragma unroll
    for (int d0 = 0; d0 < 4; ++d0) { const LAS unsigned char* a = krb[d0];
        f[16 + 2 * d0] = *reinterpret_cast<const LAS bf16x8*>(a); f[16 + 2 * d0 + 1] = *reinterpret_cast<const LAS bf16x8*>(a + 32 * 128); }
#pragma unroll
    for (int d0 = 0; d0 < 12; ++d0) {
        p0 = __builtin_amdgcn_mfma_f32_32x32x16_bf16(f[2 * d0], qr[d0], p0, 0, 0, 0);
        p1 = __builtin_amdgcn_mfma_f32_32x32x16_bf16(f[2 * d0 + 1], qr[d0], p1, 0, 0, 0); }
    __builtin_amdgcn_sched_group_barrier(0x100, 4, 0);
#pragma unroll
    for (int i = 0; i < 20; ++i) { __builtin_amdgcn_sched_group_barrier(0x008, 1, 0); __builtin_amdgcn_sched_group_barrier(0x100, 1, 0); }
    __builtin_amdgcn_sched_group_barrier(0x008, 4, 0);
}
__device__ __forceinline__ void pv_tile(f32x16* o, unsigned vb0, bf16x8 pa0, bf16x8 pa1, bf16x8 pa2, bf16x8 pa3) {
#define AT_TRRD(dst, off) asm volatile("ds_read_b64_tr_b16 %0, %1 offset:%2" : "=&v"(dst) : "v"(vb0), "i"(off) : "memory")
#define AT_PV_RD(d0, L, H) do { constexpr int b_ = v_rd_off(d0, 0, 0); \
        AT_TRRD(L[0], b_); AT_TRRD(H[0], b_ + 2048); AT_TRRD(L[1], b_ + 4096); AT_TRRD(H[1], b_ + 6144); AT_TRRD(L[2], b_ + 8192); AT_TRRD(H[2], b_ + 10240); AT_TRRD(L[3], b_ + 12288); AT_TRRD(H[3], b_ + 14336); } while (0)
#define AT_PV_MM(d0, L, H) do { \
        o[d0] = __builtin_amdgcn_mfma_f32_32x32x16_bf16(pa0, (bf16x8){L[0][0], L[0][1], L[0][2], L[0][3], H[0][0], H[0][1], H[0][2], H[0][3]}, o[d0], 0, 0, 0);   \
        o[d0] = __builtin_amdgcn_mfma_f32_32x32x16_bf16(pa1, (bf16x8){L[1][0], L[1][1], L[1][2], L[1][3], H[1][0], H[1][1], H[1][2], H[1][3]}, o[d0], 0, 0, 0);   \
        o[d0] = __builtin_amdgcn_mfma_f32_32x32x16_bf16(pa2, (bf16x8){L[2][0], L[2][1], L[2][2], L[2][3], H[2][0], H[2][1], H[2][2], H[2][3]}, o[d0], 0, 0, 0);   \
        o[d0] = __builtin_amdgcn_mfma_f32_32x32x16_bf16(pa3, (bf16x8){L[3][0], L[3][1], L[3][2], L[3][3], H[3][0], H[3][1], H[3][2], H[3][3]}, o[d0], 0, 0, 0); } while (0)
    s16x4 la[4], ha[4], lb[4], hb[4];
    asm volatile("s_waitcnt lgkmcnt(0)" ::: "memory");
    AT_PV_RD(0, la, ha); AT_PV_RD(1, lb, hb);
    asm volatile("s_waitcnt lgkmcnt(8)" ::: "memory"); AT_SBAR(); AT_PV_MM(0, la, ha); AT_SBAR();
    AT_PV_RD(2, la, ha);
    asm volatile("s_waitcnt lgkmcnt(8)" ::: "memory"); AT_SBAR(); AT_PV_MM(1, lb, hb); AT_SBAR();
    AT_PV_RD(3, lb, hb);
    asm volatile("s_waitcnt lgkmcnt(8)" ::: "memory"); AT_SBAR(); AT_PV_MM(2, la, ha); AT_SBAR();
    asm volatile("s_waitcnt lgkmcnt(0)" ::: "memory"); AT_SBAR(); AT_PV_MM(3, lb, hb);
#undef AT_PV_RD
#undef AT_PV_MM
#undef AT_TRRD
}

__device__ __forceinline__ void attn_block(LAS unsigned char* lds, const bf16* Q, const bf16* K, const bf16* KV, const bf16* proj, bf16* YA, const float* qg, const float* cosT, const float* sinT, int b, int h, int qb) {
    const int tid = otid(), wid = __builtin_amdgcn_readfirstlane(tid >> 6), lane = tid & 63, r32 = lane & 31, hi = lane >> 5;
    const int P0 = qb * 256, NT = 4 * (qb + 1), qlo = P0 + wid * 32;
    LAS unsigned char* V_lds = lds + OFF_V; LAS unsigned char* K_lds = lds + OFF_K; LAS unsigned char* KR_lds = lds + OFF_KR;
    LAS float* wsf = (LAS float*)(lds + OFF_WS) + wid * 64; LAS float* li_l = wsf; LAS float* al_l = wsf + 32;
    bf16x8 qr[12];
    { const bf16* qp = Q + ((size_t)(b * SEQ + qlo + r32) * 8 + h) * 192 + hi * 8;
      bf16x8 raw[12];
#pragma unroll
      for (int d0 = 0; d0 < 12; ++d0) raw[d0] = *(const bf16x8*)(qp + d0 * 16);
      float ss = 0.f;
#pragma unroll
      for (int d0 = 0; d0 < 12; ++d0)
#pragma unroll
          for (int j = 0; j < 8; ++j) { const float v = bf2f((unsigned short)raw[d0][j]); ss += v * v; }
      { auto rr = __builtin_amdgcn_permlane32_swap(__float_as_uint(ss), __float_as_uint(ss), false, false); ss = __uint_as_float(rr[0]) + __uint_as_float(rr[1]); }
      const float rn = 1.0f / sqrtf(ss * (1.0f / 192.f) + EPS);
      const float* ct = cosT + (size_t)(b * SEQ + qlo + r32) * 32 + hi * 8; const float* st = sinT + (size_t)(b * SEQ + qlo + r32) * 32 + hi * 8;
#pragma unroll
      for (int d0 = 0; d0 < 8; ++d0) { const v4f g0 = *(const v4f*)(qg + d0 * 16 + hi * 8), g1 = *(const v4f*)(qg + d0 * 16 + hi * 8 + 4);
          const float g[8] = {g0.x, g0.y, g0.z, g0.w, g1.x, g1.y, g1.z, g1.w}; float x[8];
#pragma unroll
          for (int j = 0; j < 8; ++j) x[j] = bf2f((unsigned short)raw[d0][j]) * rn * g[j];
          u32x4 w = {cvtpk(x[0], x[1]), cvtpk(x[2], x[3]), cvtpk(x[4], x[5]), cvtpk(x[6], x[7])}; qr[d0] = *reinterpret_cast<bf16x8*>(&w); }
#pragma unroll
      for (int d0 = 8; d0 < 10; ++d0) { const int i0 = (d0 - 8) * 16;
          const v4f ga0 = *(const v4f*)(qg + d0 * 16 + hi * 8), ga1 = *(const v4f*)(qg + d0 * 16 + hi * 8 + 4), gb0 = *(const v4f*)(qg + (d0 + 2) * 16 + hi * 8), gb1 = *(const v4f*)(qg + (d0 + 2) * 16 + hi * 8 + 4);
          const v4f c0 = *(const v4f*)(ct + i0), c1 = *(const v4f*)(ct + i0 + 4), s0 = *(const v4f*)(st + i0), s1 = *(const v4f*)(st + i0 + 4);
          const float ga[8] = {ga0.x, ga0.y, ga0.z, ga0.w, ga1.x, ga1.y, ga1.z, ga1.w}, gb[8] = {gb0.x, gb0.y, gb0.z, gb0.w, gb1.x, gb1.y, gb1.z, gb1.w};
          const float cs[8] = {c0.x, c0.y, c0.z, c0.w, c1.x, c1.y, c1.z, c1.w}, sn[8] = {s0.x, s0.y, s0.z, s0.w, s1.x, s1.y, s1.z, s1.w};
          float y1[8], y2[8];
#pragma unroll
          for (int j = 0; j < 8; ++j) { const float x1 = bf2f((unsigned short)raw[d0][j]) * rn * ga[j], x2 = bf2f((unsigned short)raw[d0 + 2][j]) * rn * gb[j];
              y1[j] = x1 * cs[j] - x2 * sn[j]; y2[j] = x2 * cs[j] + x1 * sn[j]; }
          u32x4 w1 = {cvtpk(y1[0], y1[1]), cvtpk(y1[2], y1[3]), cvtpk(y1[4], y1[5]), cvtpk(y1[6], y1[7])}; qr[d0] = *reinterpret_cast<bf16x8*>(&w1);
          u32x4 w2 = {cvtpk(y2[0], y2[1]), cvtpk(y2[2], y2[3]), cvtpk(y2[4], y2[5]), cvtpk(y2[6], y2[7])}; qr[d0 + 2] = *reinterpret_cast<bf16x8*>(&w2); }
    }
    const int sr = tid >> 4, sc = (tid & 15) * 8, kws = AT_KSWZ(sr, sc * 2), vst0 = v_st(sr, sc), vst1 = v_st(32 + sr, sc);
    const int rr = tid >> 3, rc = (tid & 7) * 8, krws = AT_KRSWZ(rr, rc * 2);
    const bf16* Kg = K + ((size_t)(b * SEQ) * 8 + h) * 192;
    const bf16* Vg = KV + (size_t)(b * SEQ) * 2048 + h * 256 + 128;
    bf16x8 sa_k0, sa_k1, sa_kr, sa_v0, sa_v1, sb_k0, sb_k1, sb_kr, sb_v0, sb_v1;
#define AT_SLOAD(S, kb_) do { S##_k0 = *(const bf16x8*)(Kg + (size_t)((kb_) + sr) * 1536 + sc); S##_k1 = *(const bf16x8*)(Kg + (size_t)((kb_) + 32 + sr) * 1536 + sc); \
        S##_kr = *(const bf16x8*)(Kg + (size_t)((kb_) + rr) * 1536 + 128 + rc); \
        S##_v0 = *(const bf16x8*)(Vg + (size_t)((kb_) + sr) * 2048 + sc); S##_v1 = *(const bf16x8*)(Vg + (size_t)((kb_) + 32 + sr) * 2048 + sc); } while (0)
#define AT_SWRITE(S, bf, vbf) do { *(LAS bf16x8*)(K_lds + (bf) * SHM_K + kws) = S##_k0; *(LAS bf16x8*)(K_lds + (bf) * SHM_K + kws + 32 * 256) = S##_k1; \
        *(LAS bf16x8*)(KR_lds + (bf) * SHM_KR + krws) = S##_kr; \
        *(LAS bf16x8*)(V_lds + (vbf) * SHM_V + vst0) = S##_v0; *(LAS bf16x8*)(V_lds + (vbf) * SHM_V + vst1) = S##_v1; } while (0)
    AT_SLOAD(sa, 0); AT_SLOAD(sb, 64); AT_SWRITE(sa, 0, 0);
    __syncthreads();
    float m_reg = -1e30f, l_reg = 0.f; f32x16 o[4] = {};
    const unsigned vbase = (unsigned)(size_t)V_lds + (unsigned)v_rd_base(lane);
    const bool late = wid >= 4;
    bool pend = false; int pvb = 0; int vb3 = 0;
    bf16x8 pa0, pa1, pa2, pa3;
#define AT_STEP(t, SL, SW) do { \
        const int buf = (t) & 1, kb = (t) * 64; \
        if ((t) + 2 < NT) AT_SLOAD(SL, kb + 128);                         \
        if (late && pend) { pv_tile(o, vbase + pvb * SHM_V, pa0, pa1, pa2, pa3); pend = false; AT_SBAR(); } \
        if (kb <= qlo + 31) { \
            f32x16 p0, p1; float mn, alpha; \
            qkt(p0, p1, K_lds + buf * SHM_K, KR_lds + buf * SHM_KR, r32, hi, qr); \
            if (kb + 63 > qlo) mask_tile(p0, p1, qlo + r32 - 4 * hi - kb); \
            partialSM(p0, p1, m_reg, mn, alpha); \
            finishSM(p0, p1, alpha, l_reg, pa0, pa1, pa2, pa3); \
            if (__any(alpha < 1.f)) { if (hi == 0) al_l[r32] = alpha; asm volatile("s_waitcnt lgkmcnt(0)" ::: "memory"); \
                _Pragma("unroll") for (int d_ = 0; d_ < 4; ++d_) _Pragma("unroll") for (int r = 0; r < 16; ++r) o[d_][r] *= al_l[crow(r, hi)]; \
                asm volatile("s_waitcnt lgkmcnt(0)" ::: "memory"); } \
            AT_SBAR(); \
            if (late) { pend = true; pvb = vb3; } \
            else pv_tile(o, vbase + vb3 * SHM_V, pa0, pa1, pa2, pa3); \
        } \
        const int vn3 = vb3 == 2 ? 0 : vb3 + 1; \
        if ((t) + 1 < NT) AT_SWRITE(SW, buf ^ 1, vn3);                    \
        vb3 = vn3; \
        __syncthreads(); } while (0)
    for (int t = 0; t < NT; t += 2) { AT_STEP(t, sa, sb); AT_STEP(t + 1, sb, sa); }
#undef AT_STEP
    if (late && pend) pv_tile(o, vbase + pvb * SHM_V, pa0, pa1, pa2, pa3);
    if (hi == 0) li_l[r32] = l_reg;
    asm volatile("s_waitcnt lgkmcnt(0)" ::: "memory");
    float rli[16];
#pragma unroll
    for (int r = 0; r < 16; ++r) rli[r] = 1.0f / li_l[crow(r, hi)];
#pragma unroll
    for (int d0 = 0; d0 < 4; ++d0) { const int col = h * 128 + d0 * 32 + r32;
        unsigned short zr[16];
#pragma unroll
        for (int r = 0; r < 16; ++r) zr[r] = proj[(size_t)(b * SEQ + qlo + crow(r, hi)) * NPROJ + C_ZA + col];
#pragma unroll
        for (int r = 0; r < 16; ++r) { const int row = b * SEQ + qlo + crow(r, hi);
            const float v = o[d0][r] * rli[r] * silu_f(bf2f(zr[r]));
            const float vn = lane_xor<1>(v);
            if ((r32 & 1) == 0) *(unsigned*)(YA + (size_t)row * 1024 + col) = cvtpk(v, vn); } }
    asm volatile("s_waitcnt lgkmcnt(0)" ::: "memory");
    __syncthreads();
#undef AT_SLOAD
#undef AT_SWRITE
}
}


namespace sg {
using at::bf16x8; using at::f32x16;
__device__ __forceinline__ void sgu_item(LAS unsigned char* lds, const bf16* proj, const float* rv, const float* Ws, const float* bs, const float* vg, bf16* YB, int it) {
    const int tid = otid(), wid = __builtin_amdgcn_readfirstlane(tid >> 6), lane = tid & 63, r32 = lane & 31, hi = lane >> 5;
    {
        const int ch = it >> 2, gp = it & 3, R0 = ch * 128;
#pragma unroll
        for (int i = 0; i < 8; ++i) {
            const int idx = tid + 512 * i, gsel = idx >> 11, row = (idx >> 4) & 127, cc = idx & 15;
            const v4u w = *(const v4u*)(proj + (size_t)(R0 + row) * NPROJ + C_VB + (2 * gp + gsel) * 128 + cc * 8);
            const float s = 1.0f / sqrtf(rv[R0 + row] * (1.0f / 1024.f) + EPS);
            v4u o; o.x = pk2(gelu_f(lo16(w.x)) * s, gelu_f(hi16(w.x)) * s); o.y = pk2(gelu_f(lo16(w.y)) * s, gelu_f(hi16(w.y)) * s);
            o.z = pk2(gelu_f(lo16(w.z)) * s, gelu_f(hi16(w.z)) * s); o.w = pk2(gelu_f(lo16(w.w)) * s, gelu_f(hi16(w.w)) * s);
            *(LAS v4u*)(lds + (gsel * 2 + (row >> 6)) * 16384 + at::v_st(row & 63, cc * 8)) = o;
        }
        __syncthreads();
        const int gsel = wid >> 2, g = 2 * gp + gsel, t = 32 * (wid & 3) + r32;
        f32x16 o[4] = {};
        const int nst = (wid & 3) >= 2 ? 2 : 1;
        for (int st = 0; st < nst; ++st) {
            bf16x8 pa[4];
#pragma unroll
            for (int ks = 0; ks < 4; ++ks) {
                const int s0 = st * 64 + ks * 16 + hi * 8;
                const float* wp = Ws + ((size_t)g * 128 + t) * 128 + s0;
                const v4f a = *(const v4f*)wp, b = *(const v4f*)(wp + 4);
                float x[8] = {a.x, a.y, a.z, a.w, b.x, b.y, b.z, b.w};
#pragma unroll
                for (int j = 0; j < 8; ++j) if (s0 + j > t) x[j] = 0.f;
                at::u32x4 w4 = {at::cvtpk(x[0], x[1]), at::cvtpk(x[2], x[3]), at::cvtpk(x[4], x[5]), at::cvtpk(x[6], x[7])};
                pa[ks] = *reinterpret_cast<bf16x8*>(&w4);
            }
            const unsigned vbase = (unsigned)(size_t)(lds + (gsel * 2 + st) * 16384) + (unsigned)at::v_rd_base(lane);
            at::pv_tile(o, vbase, pa[0], pa[1], pa[2], pa[3]);
        }
#pragma unroll
        for (int d0 = 0; d0 < 4; ++d0) { const int gc = g * 128 + d0 * 32 + r32; const float vgc = vg[gc];
            unsigned short ur[16], zr[16];
#pragma unroll
            for (int r = 0; r < 16; ++r) { const size_t row = (size_t)(R0 + 32 * (wid & 3) + at::crow(r, hi)); ur[r] = proj[row * NPROJ + C_UB + gc]; zr[r] = proj[row * NPROJ + C_ZB + gc]; }
#pragma unroll
            for (int r = 0; r < 16; ++r) { const int tl = 32 * (wid & 3) + at::crow(r, hi); const size_t row = (size_t)(R0 + tl);
                const float mix = o[d0][r] * vgc + bs[g * 128 + tl];
                const float y = gelu_f(bf2f(ur[r])) * mix * silu_f(bf2f(zr[r])), yn = lane_xor<1>(y);
                if ((r32 & 1) == 0) *(unsigned*)(YB + row * 1024 + gc) = at::cvtpk(y, yn); } }
        __syncthreads();
    }
}
}


namespace gl {
using at::bf16x8; using at::f32x16; using at::s16x4; using at::u32x4;
constexpr int OFF_VIMG = 0, OFF_KLIMG = 65536, OFF_ATT = 98304, OFF_DS = 131072, OFF_PART = 131584, LDS_NEED = OFF_PART + 4096;

__device__ __forceinline__ void gla_prep_item(LAS unsigned char* lds, int seg_off, const bf16* proj, const float* wa2, const float* ba, bf16* QE, bf16* KE, bf16* KL, float* DS, int ci) {
    const int tid = otid(), k2 = tid & 63, ts = tid >> 6, k = 2 * k2;
    LAS float* seg = (LAS float*)(lds + seg_off);
    {
        const int ch = ci >> 2, h = ci & 3, R0 = ch * 128 + ts * 16;
        float wa0[16], wa1[16];
#pragma unroll
        for (int j = 0; j < 16; ++j) { const v2f w = *(const v2f*)(wa2 + j * 512 + h * 128 + k); wa0[j] = w.x; wa1[j] = w.y; }
        const v2f bak = *(const v2f*)(ba + h * 128 + k);
        float la0[16], la1[16]; float run0 = 0.f, run1 = 0.f;
#pragma unroll
        for (int i = 0; i < 16; ++i) {
            const bf16* pr = proj + (size_t)(R0 + i) * NPROJ + C_AR;
            const v4u w0 = *(const v4u*)pr, w1 = *(const v4u*)(pr + 8);
            const float ar[16] = {lo16(w0.x), hi16(w0.x), lo16(w0.y), hi16(w0.y), lo16(w0.z), hi16(w0.z), lo16(w0.w), hi16(w0.w),
                                  lo16(w1.x), hi16(w1.x), lo16(w1.y), hi16(w1.y), lo16(w1.z), hi16(w1.z), lo16(w1.w), hi16(w1.w)};
            float x0 = bak.x, x1 = bak.y;
#pragma unroll
            for (int j = 0; j < 16; ++j) { x0 += ar[j] * wa0[j]; x1 += ar[j] * wa1[j]; }
            run0 += (fminf(x0, 0.f) - __logf(1.0f + __expf(-fabsf(x0)))) * 0.0625f; la0[i] = run0;
            run1 += (fminf(x1, 0.f) - __logf(1.0f + __expf(-fabsf(x1)))) * 0.0625f; la1[i] = run1;
        }
        *(LAS v2f*)(seg + ts * 128 + k) = (v2f){run0, run1};
        __syncthreads();
        float pre0 = 0.f, pre1 = 0.f, tot0 = 0.f, tot1 = 0.f;
#pragma unroll
        for (int q = 0; q < 8; ++q) { const v2f sg = *(const LAS v2f*)(seg + q * 128 + k); tot0 += sg.x; tot1 += sg.y; if (q < ts) { pre0 += sg.x; pre1 += sg.y; } }
        const float et0 = __expf(tot0), et1 = __expf(tot1);
        unsigned qw[16], kw[16];
#pragma unroll
        for (int i = 0; i < 16; ++i) { const size_t row = (size_t)(R0 + i); qw[i] = *(const unsigned*)(proj + row * NPROJ + C_QC + h * 128 + k); kw[i] = *(const unsigned*)(proj + row * NPROJ + C_KC + h * 128 + k); }
#pragma unroll
        for (int i = 0; i < 16; ++i) {
            const size_t o = (size_t)(R0 + i) * 512 + h * 128 + k;
            const float e0 = __expf(la0[i] + pre0), e1 = __expf(la1[i] + pre1), r0 = __builtin_amdgcn_rcpf(e0), r1 = __builtin_amdgcn_rcpf(e1);
            const float q0 = lo16(qw[i]) * 0.08838834764831845f, q1 = hi16(qw[i]) * 0.08838834764831845f, kk0 = lo16(kw[i]) * r0, kk1 = hi16(kw[i]) * r1;
            *(unsigned*)(QE + o) = pk2(q0 * e0, q1 * e1);
            *(unsigned*)(KE + o) = pk2(kk0, kk1);
            *(unsigned*)(KL + o) = pk2(kk0 * et0, kk1 * et1);
        }
        if (ts == 0) *(v2f*)(DS + ((size_t)ch * 4 + h) * 128 + k) = (v2f){et0, et1};
        __syncthreads();
    }
}

#define GL_PK4(P, B_, OUT) do { unsigned a0 = at::cvtpk(P[B_+0], P[B_+1]), a1 = at::cvtpk(P[B_+2], P[B_+3]);                          \
        unsigned b0 = at::cvtpk(P[B_+4], P[B_+5]), b1 = at::cvtpk(P[B_+6], P[B_+7]);                                             \
        auto r0 = __builtin_amdgcn_permlane32_swap(a0, b0, false, false); auto r1 = __builtin_amdgcn_permlane32_swap(a1, b1, false, false); \
        u32x4 w = {r0[0], r1[0], r0[1], r1[1]}; OUT = *reinterpret_cast<bf16x8*>(&w); } while (0)
#define GL_TRRD(dst, addr, off) asm volatile("ds_read_b64_tr_b16 %0, %1 offset:%2" : "=&v"(dst) : "v"(addr), "i"(off) : "memory")

__device__ __forceinline__ void gla_chunk_item(LAS unsigned char* lds, const bf16* proj, const bf16* QE, const bf16* KE, const bf16* KL, float* OI, float* DL, int ci) {
    const int tid = otid(), wid = __builtin_amdgcn_readfirstlane(tid >> 6), lane = tid & 63, r32 = lane & 31, hi = lane >> 5;
    const int h = ci & 3, R0 = (ci >> 2) * 128;
    {
        {
#pragma unroll
            for (int i = 0; i < 8; ++i) { const int idx = tid + 512 * i, s = idx >> 5, cc = idx & 31;
                const v4u w = *(const v4u*)(proj + (size_t)(R0 + s) * NPROJ + C_VC + h * 256 + cc * 8);
                *(LAS v4u*)(lds + OFF_VIMG + ((s >> 6) * 2 + (cc >> 4)) * 16384 + at::v_st(s & 63, (cc & 15) * 8)) = w; }
#pragma unroll
            for (int i = 0; i < 4; ++i) { const int idx = tid + 512 * i, s = idx >> 4, cc = idx & 15;
                const v4u w = *(const v4u*)(KL + (size_t)(R0 + s) * 512 + h * 128 + cc * 8);
                *(LAS v4u*)(lds + OFF_KLIMG + (s >> 6) * 16384 + at::v_st(s & 63, cc * 8)) = w; }
#pragma unroll
            for (int j = 0; j < 2; ++j) {
                const int ti = 2 * wid + j, st = ti >> 2, tt = ti & 3;
                if (st <= tt) {
                    f32x16 p = {};
                    const bf16* ap = KE + (size_t)(R0 + 32 * st + r32) * 512 + h * 128 + hi * 8;
                    const bf16* bp = QE + (size_t)(R0 + 32 * tt + r32) * 512 + h * 128 + hi * 8;
                    bf16x8 fa[8], fb[8];
#pragma unroll
                    for (int ks = 0; ks < 8; ++ks) { fa[ks] = *(const bf16x8*)(ap + ks * 16); fb[ks] = *(const bf16x8*)(bp + ks * 16); }
#pragma unroll
                    for (int ks = 0; ks < 8; ++ks) p = __builtin_amdgcn_mfma_f32_32x32x16_bf16(fa[ks], fb[ks], p, 0, 0, 0);
                    __builtin_amdgcn_sched_group_barrier(0x020, 16, 0); __builtin_amdgcn_sched_group_barrier(0x008, 8, 0);
                    if (st == tt) {
#pragma unroll
                        for (int r = 0; r < 16; ++r) if (at::crow(r, hi) > r32) p[r] = 0.f; }
                    const int t = 32 * tt + r32;
#pragma unroll
                    for (int g = 0; g < 4; ++g) { v2u w; w.x = at::cvtpk(p[4 * g], p[4 * g + 1]); w.y = at::cvtpk(p[4 * g + 2], p[4 * g + 3]);
                        *(LAS v2u*)(lds + OFF_ATT + t * 256 + ((64 * st + 16 * g) ^ ((t & 7) << 4)) + 8 * hi) = w; }
                }
            }
            __syncthreads();
            bf16x8 vfr[8];
            { const unsigned vaddr = (unsigned)(size_t)(lds + OFF_VIMG + (wid >> 2) * 16384) + (unsigned)at::v_rd_base(lane) + (unsigned)((wid & 3) * 512);
              s16x4 vl[8], vh[8];
#define GL_VF(ks8) do { constexpr int o_ = ((ks8) >> 2) * 32768 + ((ks8) & 3) * 4096; GL_TRRD(vl[ks8], vaddr, o_); GL_TRRD(vh[ks8], vaddr, o_ + 2048); } while (0)
              GL_VF(0); GL_VF(1); GL_VF(2); GL_VF(3); GL_VF(4); GL_VF(5); GL_VF(6); GL_VF(7);
#undef GL_VF
              asm volatile("s_waitcnt lgkmcnt(0)" ::: "memory"); AT_SBAR();
#pragma unroll
              for (int q = 0; q < 8; ++q) vfr[q] = (bf16x8){vl[q][0], vl[q][1], vl[q][2], vl[q][3], vh[q][0], vh[q][1], vh[q][2], vh[q][3]};
              AT_SBAR(); }
            float* oi = OI + (((size_t)ci * 8 + wid) * 16 * 64 + lane) * 4;
            float* dl = DL + (((size_t)ci * 8 + wid) * 16 * 64 + lane) * 4;
#pragma unroll
            for (int tt = 0; tt < 4; ++tt) {
                f32x16 acc = {};
                const int t = 32 * tt + r32;
#pragma unroll
                for (int ks8 = 0; ks8 < 8; ++ks8) if (ks8 <= 2 * tt + 1) {
                    const bf16x8 a = *(const LAS bf16x8*)(lds + OFF_ATT + t * 256 + (((16 * ks8 + 8 * hi) * 2) ^ ((t & 7) << 4)));
                    acc = __builtin_amdgcn_mfma_f32_32x32x16_bf16(a, vfr[ks8], acc, 0, 0, 0); }
#pragma unroll
                for (int r4 = 0; r4 < 4; ++r4) *(v4f*)(oi + (size_t)(tt * 4 + r4) * 256) = (v4f){acc[4 * r4], acc[4 * r4 + 1], acc[4 * r4 + 2], acc[4 * r4 + 3]};
            }
#pragma unroll
            for (int kt = 0; kt < 4; ++kt) {
                f32x16 D = {};
                const unsigned kaddr = (unsigned)(size_t)(lds + OFF_KLIMG) + (unsigned)at::v_rd_base(lane) + (unsigned)(kt * 512);
#define GL_KF(ks8) do { s16x4 l_, h_; constexpr int o_ = ((ks8) >> 2) * 16384 + ((ks8) & 3) * 4096; GL_TRRD(l_, kaddr, o_); GL_TRRD(h_, kaddr, o_ + 2048); \
                asm volatile("s_waitcnt lgkmcnt(0)" ::: "memory"); AT_SBAR(); \
                D = __builtin_amdgcn_mfma_f32_32x32x16_bf16((bf16x8){l_[0], l_[1], l_[2], l_[3], h_[0], h_[1], h_[2], h_[3]}, vfr[ks8], D, 0, 0, 0); } while (0)
                GL_KF(0); GL_KF(1); GL_KF(2); GL_KF(3); GL_KF(4); GL_KF(5); GL_KF(6); GL_KF(7);
#undef GL_KF
#pragma unroll
                for (int r4 = 0; r4 < 4; ++r4) *(v4f*)(dl + (size_t)(kt * 4 + r4) * 256) = (v4f){D[4 * r4], D[4 * r4 + 1], D[4 * r4 + 2], D[4 * r4 + 3]};
            }
            __syncthreads();
        }
    }
}

__device__ __forceinline__ void gla_stageA_item(const float* DS, const float* DL, bf16* XB, int b, int h, int vp) {
    const int tid = otid(), wid = __builtin_amdgcn_readfirstlane(tid >> 6), lane = tid & 63, hi = lane >> 5;
    const int vb = 2 * vp + (wid >> 2), kt = wid & 3;
    constexpr int PF = 4, NC = SEQ / 128;
    f32x16 X = {};
    v4f dq[PF][4], sq[PF][4];
    const size_t ci0 = (size_t)(b * 32) * 4 + h;
#define GL_ALOAD(slot, c_) do { const size_t ci_ = ci0 + (size_t)(c_) * 4; const float* dl_ = DL + ((ci_ * 8 + vb) * 16 * 64 + lane) * 4 + (size_t)(kt * 4) * 256; const float* ds_ = DS + ci_ * 128 + 32 * kt + 4 * hi; \
        _Pragma("unroll") for (int r4 = 0; r4 < 4; ++r4) { dq[slot][r4] = *(const v4f*)(dl_ + (size_t)r4 * 256); sq[slot][r4] = *(const v4f*)(ds_ + 8 * r4); } } while (0)
#pragma unroll
    for (int s = 0; s < PF; ++s) GL_ALOAD(s, s);
    for (int c0 = 0; c0 < NC; c0 += PF) {
#pragma unroll
        for (int s = 0; s < PF; ++s) {
            const int c = c0 + s; const size_t ci = ci0 + (size_t)c * 4;
            bf16* xo = XB + (((ci * 8 + vb) * 8 + kt * 2) * 64 + lane) * 8;
            bf16x8 xb0, xb1; GL_PK4(X, 0, xb0); GL_PK4(X, 8, xb1);
            *(bf16x8*)xo = xb0; *(bf16x8*)(xo + 512) = xb1;
#pragma unroll
            for (int r4 = 0; r4 < 4; ++r4) { const v4f w = dq[s][r4], d4 = sq[s][r4];
                X[4 * r4] = X[4 * r4] * d4.x + w.x; X[4 * r4 + 1] = X[4 * r4 + 1] * d4.y + w.y; X[4 * r4 + 2] = X[4 * r4 + 2] * d4.z + w.z; X[4 * r4 + 3] = X[4 * r4 + 3] * d4.w + w.w; }
            if (c + PF < NC) GL_ALOAD(s, c + PF);
        }
    }
#undef GL_ALOAD
}
__device__ __forceinline__ void gla_stageB_item(const bf16* proj, const bf16* QE, const float* OI, const bf16* XB, const float* og, bf16* YC, int b, int h, int cp) {
    const int tid = otid(), wid = __builtin_amdgcn_readfirstlane(tid >> 6), lane = tid & 63, r32 = lane & 31, hi = lane >> 5;
    {
        const int c = 2 * cp + (wid >> 2), tt = wid & 3, R0 = b * SEQ + c * 128;
        const size_t ci = (size_t)(b * 32 + c) * 4 + h;
        f32x16 acc[8];
#pragma unroll
        for (int vb = 0; vb < 8; ++vb) { const float* oi = OI + ((ci * 8 + vb) * 16 * 64 + lane) * 4 + (size_t)(tt * 4) * 256;
#pragma unroll
            for (int r4 = 0; r4 < 4; ++r4) { const v4f w = *(const v4f*)(oi + (size_t)r4 * 256); acc[vb][4 * r4] = w.x; acc[vb][4 * r4 + 1] = w.y; acc[vb][4 * r4 + 2] = w.z; acc[vb][4 * r4 + 3] = w.w; } }
        bf16x8 qa[8];
        { const bf16* qp = QE + (size_t)(R0 + 32 * tt + r32) * 512 + h * 128 + hi * 8;
#pragma unroll
          for (int ks = 0; ks < 8; ++ks) qa[ks] = *(const bf16x8*)(qp + ks * 16); }
        if (c > 0) {
            const bf16* xi = XB + (((ci * 8) * 8) * 64 + lane) * 8;
            bf16x8 xf[64];
#pragma unroll
            for (int i = 0; i < 64; ++i) xf[i] = *(const bf16x8*)(xi + (size_t)i * 512);
#pragma unroll
            for (int i = 0; i < 64; ++i) acc[i >> 3] = __builtin_amdgcn_mfma_f32_32x32x16_bf16(qa[i & 7], xf[i], acc[i >> 3], 0, 0, 0);
            __builtin_amdgcn_sched_group_barrier(0x020, 16, 0);
#pragma unroll
            for (int i = 0; i < 48; ++i) { __builtin_amdgcn_sched_group_barrier(0x008, 1, 0); __builtin_amdgcn_sched_group_barrier(0x020, 1, 0); }
            __builtin_amdgcn_sched_group_barrier(0x008, 16, 0);
        }
        float rn[16];
#pragma unroll
        for (int r = 0; r < 16; ++r) { float s = 0.f;
#pragma unroll
            for (int vb = 0; vb < 8; ++vb) s += acc[vb][r] * acc[vb][r];
            s += lane_xor<1>(s); s += lane_xor<2>(s); s += lane_xor<4>(s); s += lane_xor<8>(s); s += lane_xor<16>(s);
            rn[r] = 1.0f / sqrtf(s * (1.0f / 256.f) + EPS); }
#pragma unroll
        for (int vb = 0; vb < 8; ++vb) { const float gcol = og[32 * vb + r32];
            unsigned short zr[16];
#pragma unroll
            for (int r = 0; r < 16; ++r) zr[r] = proj[(size_t)(R0 + 32 * tt + at::crow(r, hi)) * NPROJ + C_ZC + h * 256 + 32 * vb + r32];
#pragma unroll
            for (int r = 0; r < 16; ++r) { const size_t row = (size_t)(R0 + 32 * tt + at::crow(r, hi));
                const float y = acc[vb][r] * rn[r] * gcol * silu_f(bf2f(zr[r])), yn = lane_xor<1>(y);
                if ((r32 & 1) == 0) *(unsigned*)(YC + row * 1024 + h * 256 + 32 * vb + r32) = at::cvtpk(y, yn); } }
    }
}
#undef GL_PK4
#undef GL_TRRD
}


constexpr int CW_Q = 65536;
__device__ __forceinline__ int q_pop(unsigned* ctr, LAS unsigned* slot) {
    if (otid() == 0) *slot = __hip_atomic_fetch_add(ctr, 1u, __ATOMIC_RELAXED, __HIP_MEMORY_SCOPE_AGENT);
    __syncthreads(); const int v = (int)*slot; __syncthreads(); return v; }
__device__ __forceinline__ void ph_mixers(LAS unsigned char* lds, unsigned char* ws, unsigned* qctr, const float* Ws, const float* bs, const float* vg, const float* og, const float* qg, int row0, int vb) {
    constexpr int NGLA = NBP * 8, NATT = 16 * NBP, NSGU = 16 * NBP, NQ = NGLA + NATT + NSGU;
    static_assert(NBP % 2 == 0, "NBP even");
    LAS unsigned* slot = (LAS unsigned*)(lds + LDSCTL_OFF + 64);
    bf16* proj = (bf16*)(ws + WS_PROJ);
    for (int dq = 0; dq < 8; ++dq) {
        const int q = (vb + dq) & 7;
        for (;;) {
            const int idx = q_pop(qctr + q * 64, slot);
            if (idx >= NQ) break;
            if (idx >= NATT && idx < NATT + NGLA) { const int gi = q * NGLA + (idx - NATT), bh = gi >> 4, cp = gi & 15;
                gl::gla_stageB_item(proj, (const bf16*)(ws + WS_QE), (const float*)(ws + WS_OC), (const bf16*)(ws + WS_XB), og, (bf16*)(ws + WS_YC), bh >> 2, bh & 3, cp); }
            else if (idx < NATT) { const int j = idx, qb = 15 - j / NBP, bh = q * NBP + j % NBP;
                at::attn_block(lds, (const bf16*)(ws + WS_Q), (const bf16*)(ws + WS_K), (const bf16*)(ws + WS_KV), proj, (bf16*)(ws + WS_YA), qg, (const float*)(ws + WS_COS) + (size_t)row0 * 32, (const float*)(ws + WS_SIN) + (size_t)row0 * 32, bh >> 3, bh & 7, qb); }
            else { const int it = q * NSGU + (idx - NGLA - NATT);
                sg::sgu_item(lds, proj, (const float*)(ws + WS_SSQ) + 2 * MP, Ws, bs, vg, (bf16*)(ws + WS_YB), it); }
        }
    }
}
#ifndef GEMM_SP2
#define GEMM_SP2 true
#endif
#ifndef GEMM_ALIGN
#define GEMM_ALIGN true
#endif
typedef const __attribute__((address_space(4))) Args* KArgP;
#define KARG() ({ KArgP p_ = (KArgP)__builtin_amdgcn_kernarg_segment_ptr(); asm volatile("" : "+s"(p_)); p_; })
#define INF(i) ((const float*)ap->in[i])
__device__ __forceinline__ void grid_bar(const XcdBarrier& b0) { XcdBarrier b = b0; asm volatile("" : "+s"(b.bar)); xcd_barrier(b); }

__global__ void __launch_bounds__(512, 2) fwd(Args a) {
    extern __shared__ __attribute__((aligned(16))) unsigned char lds_raw[];
    LAS unsigned char* lds = (LAS unsigned char*)lds_raw;
    const int lo = a.lo, hi = a.hi;
    XcdBarrier bar; bar.bar = (unsigned*)(a.ws + WS_CTL) + CW_BAR; bar.x = 0; bar.st = nullptr;
    if (hi - lo > 1) {
        if (threadIdx.x < 4) ((LAS unsigned*)(lds + LDSCTL_OFF))[threadIdx.x] = 0u;
        __syncthreads();
        bar = xcd_barrier_post((unsigned*)(a.ws + WS_CTL) + CW_BAR, (volatile LAS unsigned*)(lds + LDSCTL_OFF));
    }
    int step = 0;
#define PH_BEGIN if (step >= lo && step < hi) { const KArgP ap = KARG(); unsigned char* const ws = ap->ws; const int vb = obid(), nvb = gridDim.x; (void)ws; (void)vb; (void)nvb;
#define PH_END   if (step + 1 < hi) grid_bar(bar); } ++step;
#define WL(l) (ws + WS_W + (size_t)(l) * SZ_WLAYER)
#define B_(T, off) ((T*)(ws + (off)))

    for (int l = 0; l < DEPTH; ++l) {
        PH_BEGIN
            { unsigned char* wl = ws + WS_W;
              convert_T<1>(INF(3) + (size_t)l * DM * IN_COLS, DM, IN_COLS, (bf16*)wl, NPROJ, (LAS float*)lds, vb, nvb);
              convert_T<0>(INF(6) + (size_t)l * 512 * 1536, 512, 1536, (bf16*)(wl + SZ_WIN), 1536, (LAS float*)lds, (vb + 64) % nvb, nvb, INF(4) + l * 512);
              convert_T<0>(INF(7) + (size_t)l * 512 * 2048, 512, 2048, (bf16*)(wl + SZ_WIN + SZ_WUQ), 2048, (LAS float*)lds, (vb + 128) % nvb, nvb, INF(5) + l * 512);
              for (int b = 0; b < 3; ++b)
                  convert_T<0>(INF(16) + ((size_t)l * 3 + b) * 1024 * 2048, 1024, 2048, (bf16*)(wl + SZ_WIN + SZ_WUQ + SZ_WUKV) + (size_t)b * 2048 * 1024, 2048, (LAS float*)lds, (vb + 32 * b) % nvb, nvb);
              convert_T<0>(INF(17) + (size_t)l * 2048 * 2048, 2048, 2048, (bf16*)(wl + SZ_WIN + SZ_WUQ + SZ_WUKV + SZ_WB), 2048, (LAS float*)lds, (vb + 192) % nvb, nvb); }
            if (l == 0) { const int* positions = (const int*)ap->in[1]; float* cosT = B_(float, WS_COS); float* sinT = B_(float, WS_SIN);
              for (int idx = vb * 512 + otid(); idx < MTOK * 32; idx += nvb * 512) {
                const int t = idx >> 5, i = idx & 31;
                const float inv = 1.0f / powf(10000.0f, (float)(2 * i) * (1.0f / 64.0f));
                const float ang = (float)positions[t] * inv;
                float sn, cs; sincosf(ang, &sn, &cs);
                cosT[idx] = cs; sinT[idx] = sn; } }
        PH_END
        for (int p = 0; p < NPASS; ++p) {
            const int row0 = p * MP;
#define XIN ((l == 0 ? (const float*)ap->in[0] : (const float*)ap->out) + (size_t)row0 * DM)
#define WLP (ws + WS_W)
            PH_BEGIN ph_norm(XIN, INF(2) + l * DM, B_(bf16, WS_H), MP, vb, nvb);
                     { float* ssq = B_(float, WS_SSQ); for (int i = vb * 512 + otid(); i < 3 * MP; i += nvb * 512) ssq[i] = 0.f; } PH_END
            PH_BEGIN { pg8::Gemm g{B_(bf16, WS_H), (const bf16*)WLP, MP, NPROJ, DM}; pg8::StaticOrder S; S.init(MP, NPROJ, nvb, vb); pg8::EpiProj E{B_(bf16, WS_PROJ), NPROJ, B_(float, WS_SSQ), MP};
                       pg8::gemm_phase<pg8::EpiProj, pg8::StaticOrder, false, GEMM_ALIGN, GEMM_SP2>(lds, g, S, E, nullptr); } PH_END
            PH_BEGIN { { pg8::Gemm g{B_(bf16, WS_PROJ) + C_CQ, (const bf16*)(WLP + SZ_WIN), MP, 1536, 512, NPROJ}; pg8::StaticOrder S; S.init(MP, 1536, nvb, vb); pg8::EpiBf16Row E{B_(bf16, WS_Q), 1536, B_(float, WS_SSQ), 1.0f / 512.f, EPS};
                         pg8::gemm_phase<pg8::EpiBf16Row, pg8::StaticOrder, false, GEMM_ALIGN, GEMM_SP2>(lds, g, S, E, nullptr); }
                       { pg8::Gemm g{B_(bf16, WS_PROJ) + C_CKV, (const bf16*)(WLP + SZ_WIN + SZ_WUQ), MP, 2048, 512, NPROJ}; pg8::StaticOrder S; S.init(MP, 2048, nvb, nvb - 1 - vb); pg8::EpiBf16Row E{B_(bf16, WS_KV), 2048, B_(float, WS_SSQ) + MP, 1.0f / 512.f, EPS};
                         pg8::gemm_phase<pg8::EpiBf16Row, pg8::StaticOrder, false, GEMM_ALIGN, GEMM_SP2>(lds, g, S, E, nullptr); }
                       for (int ci = vb; ci < (MP / 128) * 4; ci += nvb) {
                           gl::gla_prep_item(lds, 135168, B_(bf16, WS_PROJ), INF(13) + l * 16 * 512, INF(14) + l * 512, B_(bf16, WS_QE), B_(bf16, WS_KE), B_(bf16, WS_KL), B_(float, WS_DS), ci);
                           gl::gla_chunk_item(lds, B_(bf16, WS_PROJ), B_(bf16, WS_QE), B_(bf16, WS_KE), B_(bf16, WS_KL), B_(float, WS_OC), B_(float, WS_DL), ci); } } PH_END
            PH_BEGIN { constexpr int NA = NBP * 16;
                       if (nvb > 2 * NA) { if (vb < NA) gl::gla_stageA_item(B_(float, WS_DS), B_(float, WS_DL), B_(bf16, WS_XB), vb >> 4, (vb >> 2) & 3, vb & 3);
                                           else ph_kfin(B_(bf16, WS_KV), B_(bf16, WS_PROJ), B_(bf16, WS_K), INF(9) + l * 192, B_(float, WS_COS), B_(float, WS_SIN), row0, vb - NA, nvb - NA); }
                       else { for (int it = vb; it < NA; it += nvb) gl::gla_stageA_item(B_(float, WS_DS), B_(float, WS_DL), B_(bf16, WS_XB), it >> 4, (it >> 2) & 3, it & 3);
                              ph_kfin(B_(bf16, WS_KV), B_(bf16, WS_PROJ), B_(bf16, WS_K), INF(9) + l * 192, B_(float, WS_COS), B_(float, WS_SIN), row0, vb, nvb); } } PH_END
            PH_BEGIN ph_mixers(lds, ws, (unsigned*)(ws + WS_CTL) + CW_Q + (l * NPASS + p) * 8 * 64, INF(11) + (size_t)l * 8 * 128 * 128, INF(12) + l * 8 * 128, INF(10) + l * 1024, INF(15) + l * 256, INF(8) + l * 192, row0, vb); PH_END
            PH_BEGIN { pg8::Gemm g{B_(bf16, WS_YA), (const bf16*)(WLP + SZ_WIN + SZ_WUQ + SZ_WUKV), MP, 2048, 1024};
                       pg8::BranchOrder S; S.init(MP, 2048, nvb, vb); S.NB = 3; S.a_stride = (size_t)MP * 1024 * 2; S.b_stride = (size_t)2048 * 1024 * 2;
                       pg8::EpiMerge E{B_(bf16, WS_PROJ) + C_GATE, NPROJ, B_(bf16, WS_MG), 2048, 2048}; pg8::gemm_phase<pg8::EpiMerge, pg8::BranchOrder, false, GEMM_ALIGN, GEMM_SP2>(lds, g, S, E, nullptr); } PH_END
            PH_BEGIN { pg8::Gemm g{B_(bf16, WS_MG), (const bf16*)(WLP + SZ_WIN + SZ_WUQ + SZ_WUKV + SZ_WB), MP, 2048, 2048}; pg8::StaticOrder S; S.init(MP, 2048, nvb, vb); pg8::EpiRes E{XIN, ap->out + (size_t)row0 * DM, 2048};
                       pg8::gemm_phase<pg8::EpiRes, pg8::StaticOrder, false, GEMM_ALIGN, GEMM_SP2>(lds, g, S, E, nullptr); } PH_END
        }
    }
#undef PH_BEGIN
#undef PH_END
}

#ifndef ONE_LAUNCH
#define ONE_LAUNCH 1
#endif
extern "C" void kernel_launch(void* const* d_in, const int* in_sizes, int n_in, void* d_out, int out_size, void* d_ws, size_t ws_size, hipStream_t stream) {
    static int grid = 0;
    if (grid == 0) {
        if (n_in != 18 || out_size != MTOK * DM || ws_size < WS_END) { fprintf(stderr, "kernel_launch: unexpected shapes (n_in %d out %d ws %zu need %zu)\n", n_in, out_size, ws_size, (size_t)WS_END); grid = -1; return; }
        int dev = 0, cus = 0, per_cu = 0;
        if (hipGetDevice(&dev) != hipSuccess || hipDeviceGetAttribute(&cus, hipDeviceAttributeMultiprocessorCount, dev) != hipSuccess) { grid = -1; return; }
        if (hipFuncSetAttribute((const void*)fwd, hipFuncAttributeMaxDynamicSharedMemorySize, LDS_BYTES) != hipSuccess) { fprintf(stderr, "kernel_launch: hipFuncSetAttribute failed\n"); grid = -1; return; }
        if (hipOccupancyMaxActiveBlocksPerMultiprocessor(&per_cu, (const void*)fwd, 512, LDS_BYTES) != hipSuccess || per_cu < 1) { fprintf(stderr, "kernel_launch: occupancy query says %d\n", per_cu); }
        (void)hipGetLastError();
        grid = cus;
    }
    if (grid < 0) return;
    (void)hipMemsetAsync((char*)d_ws + WS_CTL, 0, CTL_BYTES, stream);
    Args a{};
    for (int i = 0; i < 18; ++i) a.in[i] = d_in[i];
    a.out = (float*)d_out; a.ws = (unsigned char*)d_ws; a.pad0 = 0; a.pad1 = 0;
#if ONE_LAUNCH
    a.lo = 0; a.hi = NSTEPS;
    hipLaunchKernelGGL(fwd, dim3(grid), dim3(512), LDS_BYTES, stream, a);
#else
    for (int s = 0; s < NSTEPS; ++s) { a.lo = s; a.hi = s + 1; hipLaunchKernelGGL(fwd, dim3(grid), dim3(512), LDS_BYTES, stream, a); }
#endif
}
```

```cpp
#include <hip/hip_runtime.h>
#include <cstdio>
#include <cstdint>
__device__ __forceinline__ int otid() { int t = threadIdx.x; asm volatile("" : "+v"(t)); return t; }
__device__ __forceinline__ int obid() { int t = blockIdx.x; asm volatile("" : "+s"(t)); return t; }
namespace pg8 {
#define PG8_LAS __attribute__((address_space(3)))
typedef unsigned short bf16_t;
typedef short bf16x8 __attribute__((ext_vector_type(8)));
typedef float f32x4 __attribute__((ext_vector_type(4)));
typedef unsigned u32x4 __attribute__((ext_vector_type(4)));
constexpr int BM = 256, BK = 64, HALF = 128, HTB = HALF * BK * 2  , STAGE_BYTES = 8 * HTB, NXCD = 8, WGM = 4;

__host__ __device__ __forceinline__ int lds_byte(int r, int c) { const int st = (r >> 4) * 2 + (c >> 5), rr = r & 15, cc = c & 31, ob = rr * 64 + cc * 2; return st * 1024 + (ob ^ (((ob >> 9) & 1) << 5)); }
__host__ __device__ __forceinline__ void stage_rc(int b, int& R, int& C) { const int st = b / 1024, sb = b % 1024, swz = sb ^ (((sb >> 9) & 1) << 5); R = (st >> 1) * 16 + swz / 64; C = (st & 1) * 32 + (swz % 64) / 2; }
__host__ __device__ __forceinline__ int perm32(int rho) { const int n = rho >> 4, i = rho & 15; return 8 * (i >> 2) + 4 * n + (i & 3); }

struct Unit { int pm, pn, pb; };
struct Gemm { const bf16_t* A; const bf16_t* Bt; int M, N, K; int lda; };

struct StaticOrder {
    int nM, nN, nwg, G, c;
    __host__ __device__ void init(int M, int N, int G_, int c_) { nM = M / BM; nN = N / BM; nwg = nM * nN; G = G_; c = c_; }
    __host__ __device__ bool next(int i, Unit& u) const {
        const long L = (long)i * G + c; if (L >= nwg) return false;
        int wgid = (int)L; { const int q = nwg / NXCD, r = nwg % NXCD, xcd = wgid % NXCD, off = wgid / NXCD; wgid = (xcd < r ? xcd * (q + 1) : r * (q + 1) + (xcd - r) * q) + off; }
        const int nig = WGM * nN, gid = wgid / nig, fm = gid * WGM, gsz = (nM - fm) < WGM ? (nM - fm) : WGM;
        u.pm = fm + ((wgid % nig) % gsz); u.pn = (wgid % nig) / gsz; u.pb = 0; return true;
    }
    __device__ __forceinline__ size_t a_off(const Unit&) const { return 0; }
    __device__ __forceinline__ size_t b_off(const Unit&) const { return 0; }
    __device__ __forceinline__ void a_ready(const Unit&) const {}
    __device__ __forceinline__ void done(const Unit&) const {}
};

struct BranchOrder : StaticOrder {
    int NB; size_t a_stride, b_stride;
    __device__ bool next(int i, Unit& u) const { const int ti = i / NB; if (!StaticOrder::next(ti, u)) return false; u.pb = i - ti * NB; return true; }
    __device__ __forceinline__ size_t a_off(const Unit& u) const { return (size_t)u.pb * a_stride; }
    __device__ __forceinline__ size_t b_off(const Unit& u) const { return (size_t)u.pb * b_stride; }
};

__device__ __forceinline__ unsigned cvt_pk_bf16(float lo, float hi) { unsigned r; asm volatile("v_cvt_pk_bf16_f32 %0, %1, %2" : "=v"(r) : "v"(lo), "v"(hi)); return r; }
__device__ __forceinline__ float gelu_tanh_f(float x) { const float u2 = 1.5957691216057308f * (x + 0.044715f * x * x * x); return x * __builtin_amdgcn_rcpf(1.f + __expf(-u2)); }
struct EpiProj {
    static constexpr bool PERM = true, AFTER_DRAIN = false;
    bf16_t* O; int ldc; float* SSQ; int mrows;
    __device__ __forceinline__ void operator()(const f32x4 (&acc)[2][2][4][2], const Unit& u, int wr, int wc, int fr, int fq) const {
        const int row0 = u.pm * BM + wr * 64 + fr, col0 = u.pn * BM + wc * 32 + 8 * fq;
        const int seg = !SSQ ? -1 : (u.pn < 2 ? 0 : (u.pn < 4 ? 1 : ((u.pn >= 12 && u.pn < 16) ? 2 : -1)));
#pragma unroll
        for (int ai = 0; ai < 2; ++ai)
#pragma unroll
            for (int m = 0; m < 4; ++m) { const int row = row0 + ai * HALF + m * 16; bf16_t* rowp = O + (size_t)row * ldc + col0;
                float ss = 0.f;
#pragma unroll
                for (int bj = 0; bj < 2; ++bj) { const f32x4 v0 = acc[ai][bj][m][0], v1 = acc[ai][bj][m][1];
                    u32x4 w; w.x = cvt_pk_bf16(v0[0], v0[1]); w.y = cvt_pk_bf16(v0[2], v0[3]); w.z = cvt_pk_bf16(v1[0], v1[1]); w.w = cvt_pk_bf16(v1[2], v1[3]);
                    *(u32x4*)(rowp + bj * HALF) = w;
                    if (seg >= 0) {
#pragma unroll
                        for (int j = 0; j < 4; ++j) { float a = v0[j], b = v1[j]; if (seg == 2) { a = gelu_tanh_f(a); b = gelu_tanh_f(b); } ss += a * a + b * b; } } }
                if (seg >= 0) {
                    ss += __uint_as_float((unsigned)__builtin_amdgcn_ds_swizzle((int)__float_as_uint(ss), (16 << 10) | 0x1f));
                    auto rr = __builtin_amdgcn_permlane32_swap(__float_as_uint(ss), __float_as_uint(ss), false, false);
                    ss = __uint_as_float(rr[0]) + __uint_as_float(rr[1]);
                    if (fq == 0) atomicAdd(SSQ + (size_t)seg * mrows + row, ss); } }
    }
};
struct EpiBf16Row {
    static constexpr bool PERM = true, AFTER_DRAIN = false;
    bf16_t* O; int ldc; const float* SSQ; float inv_n, eps;
    __device__ __forceinline__ void operator()(const f32x4 (&acc)[2][2][4][2], const Unit& u, int wr, int wc, int fr, int fq) const {
        const int row0 = u.pm * BM + wr * 64 + fr, col0 = u.pn * BM + wc * 32 + 8 * fq;
#pragma unroll
        for (int ai = 0; ai < 2; ++ai)
#pragma unroll
            for (int m = 0; m < 4; ++m) { const int row = row0 + ai * HALF + m * 16; bf16_t* rowp = O + (size_t)row * ldc + col0;
                const float rn = 1.0f / sqrtf(SSQ[row] * inv_n + eps);
#pragma unroll
                for (int bj = 0; bj < 2; ++bj) { const f32x4 v0 = acc[ai][bj][m][0] * rn, v1 = acc[ai][bj][m][1] * rn;
                    u32x4 w; w.x = cvt_pk_bf16(v0[0], v0[1]); w.y = cvt_pk_bf16(v0[2], v0[3]); w.z = cvt_pk_bf16(v1[0], v1[1]); w.w = cvt_pk_bf16(v1[2], v1[3]);
                    *(u32x4*)(rowp + bj * HALF) = w; } }
    }
};

struct EpiRes {
    static constexpr bool PERM = false, AFTER_DRAIN = false;
    const float* base; float* C; int ldc;
    __device__ __forceinline__ void operator()(const f32x4 (&acc)[2][2][4][2], const Unit& u, int wr, int wc, int fr, int fq) const {
        const int row0 = u.pm * BM + wr * 64 + fr, col0 = u.pn * BM + wc * 32 + 4 * fq;
#pragma unroll
        for (int ai = 0; ai < 2; ++ai) {
            f32x4 bs[4][2][2];
#pragma unroll
            for (int m = 0; m < 4; ++m) { const size_t off = (size_t)(row0 + ai * HALF + m * 16) * ldc + col0;
#pragma unroll
                for (int bj = 0; bj < 2; ++bj)
#pragma unroll
                    for (int n = 0; n < 2; ++n) bs[m][bj][n] = *(const f32x4*)(base + off + bj * HALF + n * 16); }
#pragma unroll
            for (int m = 0; m < 4; ++m) { const size_t off = (size_t)(row0 + ai * HALF + m * 16) * ldc + col0;
#pragma unroll
                for (int bj = 0; bj < 2; ++bj)
#pragma unroll
                    for (int n = 0; n < 2; ++n) *(f32x4*)(C + off + bj * HALF + n * 16) = acc[ai][bj][m][n] + bs[m][bj][n]; }
            asm volatile("" ::: "memory");
        }
    }
};
struct EpiMerge {
    static constexpr bool PERM = true, AFTER_DRAIN = false;
    const bf16_t* G0; int ldg; bf16_t* MG; int ldc; int gstride;
    __device__ __forceinline__ void operator()(const f32x4 (&acc)[2][2][4][2], const Unit& u, int wr, int wc, int fr, int fq) const {
        const int row0 = u.pm * BM + wr * 64 + fr, col0 = u.pn * BM + wc * 32 + 8 * fq; const bf16_t* G = G0 + (size_t)u.pb * gstride; const bool first = u.pb == 0;
#pragma unroll
        for (int ai = 0; ai < 2; ++ai) {
            u32x4 gw[4][2], ow[4][2];
#pragma unroll
            for (int m = 0; m < 4; ++m) { const size_t row = (size_t)(row0 + ai * HALF + m * 16);
#pragma unroll
                for (int bj = 0; bj < 2; ++bj) { gw[m][bj] = *(const u32x4*)(G + row * ldg + col0 + bj * HALF); ow[m][bj] = first ? (u32x4){0u, 0u, 0u, 0u} : *(const u32x4*)(MG + row * ldc + col0 + bj * HALF); } }
#pragma unroll
            for (int m = 0; m < 4; ++m) { const size_t row = (size_t)(row0 + ai * HALF + m * 16);
#pragma unroll
                for (int bj = 0; bj < 2; ++bj) { const f32x4 v0 = acc[ai][bj][m][0], v1 = acc[ai][bj][m][1];
                    const unsigned g4[4] = {gw[m][bj].x, gw[m][bj].y, gw[m][bj].z, gw[m][bj].w}, o4[4] = {ow[m][bj].x, ow[m][bj].y, ow[m][bj].z, ow[m][bj].w};
                    const float a8[8] = {v0[0], v0[1], v0[2], v0[3], v1[0], v1[1], v1[2], v1[3]};
                    unsigned w4[4];
#pragma unroll
                    for (int q = 0; q < 4; ++q) {
                        const float g0 = __uint_as_float(g4[q] << 16), g1 = __uint_as_float(g4[q] & 0xffff0000u);
                        const float r0 = __uint_as_float(o4[q] << 16) + a8[2 * q] * __builtin_amdgcn_rcpf(1.0f + __expf(-g0));
                        const float r1 = __uint_as_float(o4[q] & 0xffff0000u) + a8[2 * q + 1] * __builtin_amdgcn_rcpf(1.0f + __expf(-g1));
                        unsigned pk; asm("v_cvt_pk_bf16_f32 %0, %1, %2" : "=v"(pk) : "v"(r0), "v"(r1)); w4[q] = pk; }
                    *(u32x4*)(MG + row * ldc + col0 + bj * HALF) = (u32x4){w4[0], w4[1], w4[2], w4[3]}; } }
            asm volatile("" ::: "memory");
        }
    }
};

typedef int pg8_v8i __attribute__((ext_vector_type(8)));
typedef int pg8_v4i __attribute__((ext_vector_type(4)));
template <class Epi, class Sched, bool STAMP = false, bool ALIGN_EPI = false, bool SP2 = false, bool FP8 = false>
__device__ __forceinline__ void gemm_phase(PG8_LAS unsigned char* lds, const Gemm g, const Sched& S, const Epi& E, unsigned long long* stamps) {
    const int tid = otid(), wid = __builtin_amdgcn_readfirstlane(tid >> 6), lane = tid & 63, wr = wid >> 2, wc = wid & 3, fr = lane & 15, fq = lane >> 4;
    const int K = g.K, nt = K / BK, LDA = g.lda ? g.lda : g.K;
    int ts_lo = 0, ts_hi = 0, nts = 0; const unsigned long long rt_entry = STAMP ? (unsigned long long)wall_clock64() : 0ull;
#define PG8_STAMP() do { if (STAMP && wid == 0 && nts < 64) { const unsigned long long _c = (unsigned long long)clock64(); \
        ts_lo = (lane == nts) ? (int)(unsigned)_c : ts_lo; ts_hi = (lane == nts) ? (int)(unsigned)(_c >> 32) : ts_hi; ++nts; } } while (0)
    PG8_STAMP();
    unsigned voffA[2], voffB[2];
#pragma unroll
    for (int i = 0; i < 2; ++i) { int R, C; stage_rc(tid * 16 + i * 8192, R, C); const int Rb = Epi::PERM ? ((R & ~31) + perm32(R & 31)) : R;
        voffA[i] = (unsigned)(R * LDA + C) * 2u; voffB[i] = (unsigned)(Rb * K + C) * 2u; }
    const size_t kstep = (size_t)(BK * 2);
    const size_t hstepB = (size_t)HALF * K * 2, hstepA = (size_t)HALF * LDA * 2;
    const size_t tstepB = 2 * hstepB, tstepA = 2 * hstepA;
    const unsigned ldsw = (unsigned)wid * 1024u;
    const int aoff = lds_byte(wr * 64 + fr, fq * 8), boff = lds_byte(wc * 32 + fr, fq * 8);
#define PG8_SA(b, h) (((b) * 2 + (h)) * HTB)
#define PG8_SB(b, h) ((4 + (b) * 2 + (h)) * HTB)
#define PG8_STAGE(bufoff, gbase, voff) do { _Pragma("unroll") for (int _i = 0; _i < 2; ++_i) \
        __builtin_amdgcn_global_load_lds((const unsigned*)((const char*)(gbase) + (voff)[_i]), (PG8_LAS unsigned*)(lds + (bufoff) + ldsw + _i * 8192), 16, 0, 0); } while (0)
#define PG8_I4(p) (*(const PG8_LAS pg8_v4i*)(p))
#define PG8_LDA(dst, b, h) do { if constexpr (FP8) { _Pragma("unroll") for (int m = 0; m < 4; ++m) dst##8[m] = __builtin_shufflevector(PG8_I4(lds + PG8_SA(b, h) + aoff + m * 2048), PG8_I4(lds + PG8_SA(b, h) + aoff + m * 2048 + 1024), 0, 1, 2, 3, 4, 5, 6, 7); } \
        else { _Pragma("unroll") for (int m = 0; m < 4; ++m) _Pragma("unroll") for (int k = 0; k < 2; ++k) dst[m][k] = *(const PG8_LAS bf16x8*)(lds + PG8_SA(b, h) + aoff + m * 2048 + k * 1024); } } while (0)
#define PG8_LDB(dst, b, h) do { if constexpr (FP8) { _Pragma("unroll") for (int n = 0; n < 2; ++n) dst##8[n] = __builtin_shufflevector(PG8_I4(lds + PG8_SB(b, h) + boff + n * 2048), PG8_I4(lds + PG8_SB(b, h) + boff + n * 2048 + 1024), 0, 1, 2, 3, 4, 5, 6, 7); } \
        else { _Pragma("unroll") for (int n = 0; n < 2; ++n) _Pragma("unroll") for (int k = 0; k < 2; ++k) dst[n][k] = *(const PG8_LAS bf16x8*)(lds + PG8_SB(b, h) + boff + n * 2048 + k * 1024); } } while (0)
#define PG8_MMA_BF(ai, bj, At, Bt) do { __builtin_amdgcn_s_setprio(1); _Pragma("unroll") for (int m = 0; m < 4; ++m) _Pragma("unroll") for (int n = 0; n < 2; ++n) _Pragma("unroll") for (int k = 0; k < 2; ++k) \
        acc[ai][bj][m][n] = __builtin_amdgcn_mfma_f32_16x16x32_bf16(Bt[n][k], At[m][k], acc[ai][bj][m][n], 0, 0, 0); __builtin_amdgcn_s_setprio(0); } while (0)
#define PG8_MMA_F8(ai, bj, At, Bt) do { __builtin_amdgcn_s_setprio(1); _Pragma("unroll") for (int m = 0; m < 4; ++m) _Pragma("unroll") for (int n = 0; n < 2; ++n) \
        asm volatile("v_mfma_scale_f32_16x16x128_f8f6f4 %0, %1, %2, %0, %3, %4 op_sel_hi:[0,0,0]" : "+v"(acc[ai][bj][m][n]) : "v"(Bt##8[n]), "v"(At##8[m]), "v"(f8_scale_w), "v"(f8_scale_x)); \
        __builtin_amdgcn_s_setprio(0); } while (0)
#define PG8_F8_DRAIN() do { if constexpr (FP8) asm volatile("s_nop 15\n\ts_nop 15" ::: "memory"); } while (0)
#define PG8_MMA(ai, bj, At, Bt) do { if constexpr (FP8) PG8_MMA_F8(ai, bj, At, Bt); else PG8_MMA_BF(ai, bj, At, Bt); } while (0)
#define PG8_WAIT_V(n) asm volatile("s_waitcnt vmcnt(" #n ")" ::: "memory")
#define PG8_WAIT_L(n) asm volatile("s_waitcnt lgkmcnt(" #n ")" ::: "memory")
#define PG8_BAR __builtin_amdgcn_s_barrier()
#define PG8_SCHED __builtin_amdgcn_sched_barrier(0)
    Unit cur, nxt; int ui = 0;
    if (!S.next(0, cur)) return;
    f32x4 acc[2][2][4][2];
#pragma unroll
    for (int a = 0; a < 2; ++a)
#pragma unroll
        for (int b = 0; b < 2; ++b)
#pragma unroll
            for (int m = 0; m < 4; ++m)
#pragma unroll
                for (int n = 0; n < 2; ++n) acc[a][b][m][n] = (f32x4){0.f, 0.f, 0.f, 0.f};
    int f8_scale_w = 0x79797979, f8_scale_x = 0x7f7f7f7f; (void)f8_scale_w; (void)f8_scale_x;
    bf16x8 At[4][2], B0[2][2], B1[2][2]; pg8_v8i At8[4], B08[2], B18[2];
    (void)At; (void)B0; (void)B1; (void)At8; (void)B08; (void)B18;
    const char* cA = (const char*)g.A + (size_t)cur.pm * tstepA + S.a_off(cur); const char* cB = (const char*)g.Bt + (size_t)cur.pn * tstepB + S.b_off(cur);
    S.a_ready(cur);
    if constexpr (SP2) {
        PG8_STAGE(PG8_SB(0, 0), cB, voffB); PG8_STAGE(PG8_SB(0, 1), cB + hstepB, voffB); PG8_STAGE(PG8_SA(0, 0), cA, voffA); PG8_STAGE(PG8_SA(0, 1), cA + hstepA, voffA);
        if (wr == 1) PG8_BAR;
        PG8_WAIT_V(2); PG8_BAR;
        PG8_STAGE(PG8_SB(1, 0), cB + kstep, voffB); PG8_STAGE(PG8_SA(1, 0), cA + kstep, voffA); PG8_STAGE(PG8_SB(1, 1), cB + hstepB + kstep, voffB);
        PG8_WAIT_V(6); PG8_BAR;
    } else {
    PG8_STAGE(PG8_SB(0, 0), cB, voffB); PG8_STAGE(PG8_SA(0, 0), cA, voffA); PG8_STAGE(PG8_SB(0, 1), cB + hstepB, voffB); PG8_STAGE(PG8_SA(0, 1), cA + hstepA, voffA);
    if (wr == 1) PG8_BAR;
    PG8_WAIT_V(4); PG8_BAR;
    PG8_STAGE(PG8_SB(1, 0), cB + kstep, voffB); PG8_STAGE(PG8_SA(1, 0), cA + kstep, voffA); PG8_STAGE(PG8_SB(1, 1), cB + hstepB + kstep, voffB);
    PG8_WAIT_V(6); PG8_BAR;
    }
    PG8_STAMP();
    for (;;) {
        const bool has_next = S.next(ui + 1, nxt);
        const char* nA = has_next ? (const char*)g.A + (size_t)nxt.pm * tstepA + S.a_off(nxt) : cA; const char* nB = has_next ? (const char*)g.Bt + (size_t)nxt.pn * tstepB + S.b_off(nxt) : cB;
        for (int t = 0; t < nt; t += 2) {
            const bool last = (t == nt - 2);
            const char* a1 = cA + (size_t)(t + 1) * kstep;
            const char* a2 = last ? nA : cA + (size_t)(t + 2) * kstep; const char* b2 = last ? nB : cB + (size_t)(t + 2) * kstep;
            const char* a3 = a2 + kstep; const char* b3 = b2 + kstep;
            if (last && has_next) S.a_ready(nxt);
            if constexpr (SP2) {
            PG8_LDB(B0, 0, 0); PG8_LDB(B1, 0, 1); PG8_SCHED; PG8_LDA(At, 0, 0); PG8_STAGE(PG8_SA(1, 1), a1 + hstepA, voffA);
            PG8_WAIT_V(8); PG8_WAIT_L(0); PG8_BAR; PG8_MMA(0, 0, At, B0); PG8_MMA(0, 1, At, B1); PG8_BAR; PG8_SCHED;
            PG8_LDA(At, 0, 1); PG8_STAGE(PG8_SB(0, 0), b2, voffB); PG8_STAGE(PG8_SB(0, 1), b2 + hstepB, voffB); PG8_STAGE(PG8_SA(0, 0), a2, voffA);
            PG8_WAIT_V(8); PG8_WAIT_L(0); PG8_BAR; PG8_MMA(1, 0, At, B0); PG8_MMA(1, 1, At, B1); PG8_BAR; PG8_SCHED;
            PG8_LDB(B0, 1, 0); PG8_LDB(B1, 1, 1); PG8_SCHED; PG8_LDA(At, 1, 0); PG8_STAGE(PG8_SA(0, 1), a2 + hstepA, voffA);
            PG8_WAIT_V(8); PG8_WAIT_L(0); PG8_BAR; PG8_MMA(0, 0, At, B0); PG8_MMA(0, 1, At, B1); PG8_BAR; PG8_SCHED;
            PG8_LDA(At, 1, 1); PG8_STAGE(PG8_SB(1, 0), b3, voffB); PG8_STAGE(PG8_SB(1, 1), b3 + hstepB, voffB); PG8_STAGE(PG8_SA(1, 0), a3, voffA);
            PG8_WAIT_V(8); PG8_WAIT_L(0); PG8_BAR; PG8_MMA(1, 0, At, B0); PG8_MMA(1, 1, At, B1); PG8_BAR; PG8_SCHED;
            } else {
            PG8_LDB(B0, 0, 0); PG8_SCHED; PG8_LDA(At, 0, 0); PG8_STAGE(PG8_SA(1, 1), a1 + hstepA, voffA);
            PG8_WAIT_L(8); PG8_BAR; PG8_WAIT_L(0); PG8_MMA(0, 0, At, B0); PG8_BAR; PG8_SCHED;
            PG8_LDB(B1, 0, 1); PG8_STAGE(PG8_SB(0, 0), b2, voffB);
            PG8_BAR; PG8_WAIT_L(0); PG8_MMA(0, 1, At, B1); PG8_BAR;
            PG8_LDA(At, 0, 1); PG8_STAGE(PG8_SA(0, 0), a2, voffA);
            PG8_BAR; PG8_WAIT_L(0); PG8_MMA(1, 0, At, B0); PG8_BAR; PG8_SCHED;
            PG8_STAGE(PG8_SB(0, 1), b2 + hstepB, voffB);
            PG8_WAIT_V(6); PG8_BAR; PG8_MMA(1, 1, At, B1); PG8_BAR;
            PG8_LDB(B0, 1, 0); PG8_SCHED; PG8_LDA(At, 1, 0); PG8_STAGE(PG8_SA(0, 1), a2 + hstepA, voffA);
            PG8_WAIT_L(8); PG8_BAR; PG8_WAIT_L(0); PG8_MMA(0, 0, At, B0); PG8_BAR; PG8_SCHED;
            PG8_LDB(B1, 1, 1); PG8_STAGE(PG8_SB(1, 0), b3, voffB);
            PG8_BAR; PG8_WAIT_L(0); PG8_MMA(0, 1, At, B1); PG8_BAR;
            PG8_LDA(At, 1, 1); PG8_STAGE(PG8_SA(1, 0), a3, voffA);
            PG8_BAR; PG8_WAIT_L(0); PG8_MMA(1, 0, At, B0); PG8_BAR; PG8_SCHED;
            PG8_STAGE(PG8_SB(1, 1), b3 + hstepB, voffB);
            PG8_WAIT_V(6); PG8_BAR; PG8_MMA(1, 1, At, B1); PG8_BAR;
            }
        }
        if constexpr (ALIGN_EPI) { if (wr == 0) PG8_BAR; }
        PG8_STAMP();
        PG8_F8_DRAIN();
        if constexpr (!Epi::AFTER_DRAIN) { E(acc, cur, wr, wc, fr, fq); S.done(cur); }
        PG8_STAMP();
        if (!has_next) break;
#pragma unroll
        for (int a = 0; a < 2; ++a)
#pragma unroll
            for (int b = 0; b < 2; ++b)
#pragma unroll
                for (int m = 0; m < 4; ++m)
#pragma unroll
                    for (int n = 0; n < 2; ++n) acc[a][b][m][n] = (f32x4){0.f, 0.f, 0.f, 0.f};
        cur = nxt; cA = nA; cB = nB; ++ui;
        if constexpr (ALIGN_EPI) { if (wr == 1) PG8_BAR; }
    }
    PG8_WAIT_V(0);
    if constexpr (!ALIGN_EPI) { if (wr == 0) PG8_BAR; }
    PG8_BAR;
    if constexpr (Epi::AFTER_DRAIN) { E.fused(acc, cur, wr, wc, fr, fq, lds, wid, lane); S.done(cur); }
    PG8_STAMP();
    if (STAMP && wid == 0) { stamps[lane] = lane < nts ? (((unsigned long long)(unsigned)ts_hi << 32) | (unsigned)ts_lo) : 0ull;
        if (lane == 62) stamps[62] = rt_entry; if (lane == 63) stamps[63] = (unsigned long long)wall_clock64(); }
#undef PG8_STAMP
#undef PG8_SA
#undef PG8_SB
#undef PG8_STAGE
#undef PG8_LDA
#undef PG8_LDB
#undef PG8_MMA
#undef PG8_MMA_BF
#undef PG8_MMA_F8
#undef PG8_I4
#undef PG8_F8_DRAIN
#undef PG8_WAIT_V
#undef PG8_WAIT_L
#undef PG8_BAR
#undef PG8_SCHED
}
}
#define XB_TMO      128
#define XB_XCNT(j)  (256  + 64 * (j))
#define XB_XSUB(j)  (1280 + 64 * (j))
#define XB_XGEN(j)  (2304 + 64 * (j))
#define XB_TOP      3328
#define XB_TOPGEN   3392
#define XCD_BAR_WORDS 3456
#define XB_SPIN_CAP (1u << 18)
#define LAS __attribute__((address_space(3)))

__device__ __forceinline__ unsigned xb_ld(unsigned* p)              { return __hip_atomic_load(p, __ATOMIC_RELAXED, __HIP_MEMORY_SCOPE_AGENT); }
__device__ __forceinline__ unsigned xb_add(unsigned* p, unsigned v) { return __hip_atomic_fetch_add(p, v, __ATOMIC_RELAXED, __HIP_MEMORY_SCOPE_AGENT); }
__device__ __forceinline__ unsigned xb_xcc_id() { return (unsigned)__builtin_amdgcn_s_getreg((3 << 11) | 20) & 0xFu; }
#define XB_SPIN(cond, bar) do { unsigned _sp = 0; while (cond) { __builtin_amdgcn_s_sleep(1); \
    if ((++_sp & 255u) == 0u) { if (xb_ld(&(bar)[XB_TMO])) break; if (_sp > XB_SPIN_CAP) { atomicAdd(&(bar)[XB_TMO], 1u); break; } } } } while (0)

struct XcdBarrier {
    unsigned* bar; unsigned x;
    volatile LAS unsigned* st;
};

__device__ __forceinline__ XcdBarrier xcd_barrier_post(unsigned* bar, volatile LAS unsigned* st) {
    XcdBarrier b; b.bar = bar; b.x = xb_xcc_id(); b.st = st;
    if (threadIdx.x == 0) (void)xb_add(&bar[XB_XCNT(b.x)], 1u);
    return b;
}
__device__ __forceinline__ void xcd_barrier_complete(unsigned* bar, unsigned x, unsigned& nloc, unsigned& nx) {
    const unsigned G = gridDim.x * gridDim.y * gridDim.z;
    unsigned sum, cnt, mine, sp = 0u;
    for (;;) {
        sum = 0u; cnt = 0u; mine = 0u;
#pragma unroll
        for (unsigned j = 0; j < 16; ++j) { const unsigned c = xb_ld(&bar[XB_XCNT(j)]); sum += c; cnt += (c > 0u) ? 1u : 0u; mine = (j == x) ? c : mine; }
        if (sum == G) break;
        __builtin_amdgcn_s_sleep(1);
        if ((++sp & 255u) == 0u) { if (xb_ld(&bar[XB_TMO])) break; if (sp > XB_SPIN_CAP) { atomicAdd(&bar[XB_TMO], 1u); break; } }
    }
    nloc = mine > 0u ? mine : 1u; nx = cnt > 0u ? cnt : 1u;
}

__device__ __forceinline__ void xcd_barrier(const XcdBarrier& b) {
    asm volatile("s_waitcnt vmcnt(0)" ::: "memory");
    __syncthreads();
    if (threadIdx.x == 0) {
        unsigned* bar = b.bar;
        __builtin_amdgcn_s_waitcnt(0);
        unsigned nloc = b.st[0], nx = b.st[1];
        if (nloc == 0u) { xcd_barrier_complete(bar, b.x, nloc, nx); b.st[0] = nloc; b.st[1] = nx; }
        const unsigned old = xb_add(&bar[XB_XSUB(b.x)], 1u);
        const unsigned gen = old / nloc;
        if (old + 1u == (gen + 1u) * nloc) {
            __builtin_amdgcn_fence(__ATOMIC_RELEASE, "agent");
            asm volatile("s_waitcnt vmcnt(0)" ::: "memory");
            const unsigned og = xb_add(&bar[XB_TOP], 1u);
            const unsigned tg = og / nx;
            if (og + 1u == (tg + 1u) * nx) xb_add(&bar[XB_TOPGEN], 1u);
            else XB_SPIN(xb_ld(&bar[XB_TOPGEN]) == tg, bar);
            __builtin_amdgcn_fence(__ATOMIC_ACQUIRE, "agent");
            xb_add(&bar[XB_XGEN(b.x)], 1u);
            asm volatile("s_waitcnt vmcnt(0)" ::: "memory");
        } else {
            XB_SPIN(xb_ld(&bar[XB_XGEN(b.x)]) == gen, bar);
            __builtin_amdgcn_fence(__ATOMIC_ACQUIRE, "agent");
            asm volatile("s_waitcnt vmcnt(0)" ::: "memory");
        }
    }
    __syncthreads();
}


typedef unsigned short bf16;
typedef unsigned v4u __attribute__((ext_vector_type(4)));
typedef unsigned v2u __attribute__((ext_vector_type(2)));
typedef float v4f __attribute__((ext_vector_type(4)));
typedef float v2f __attribute__((ext_vector_type(2)));

constexpr int DM = 2048, NBATCH = 8, SEQ = 4096, DEPTH = 2, MTOK = NBATCH * SEQ;
constexpr int IN_COLS = 14416, NPROJ = 14592;
constexpr int C_CQ = 0, C_CKV = 512, C_ZA = 1024, C_UB = 2048, C_VB = 3072, C_ZB = 4096, C_QC = 5120, C_KC = 5632, C_VC = 6144, C_ZC = 7168,
              C_KROPE = 8192, C_AR = 8256, C_GATE = 8448;
constexpr int NBF = C_GATE, NGATE = 3 * DM;
constexpr float EPS = 1e-6f;
#ifndef NBP
#define NBP 4
#endif
constexpr int MP = NBP * SEQ, NPASS = NBATCH / NBP;
constexpr int STEPS_PER_PASS = 7;
constexpr int NSTEPS = DEPTH * (1 + NPASS * STEPS_PER_PASS);

constexpr size_t al256(size_t x) { return (x + 255) & ~(size_t)255; }
constexpr size_t WS_CTL = 0, CTL_BYTES = 1u << 20;
constexpr size_t SZ_WINB = (size_t)NBF * DM * 2  , SZ_WIN = SZ_WINB + (size_t)NGATE * DM  , SZ_WUQ = (size_t)1536 * 512 * 2, SZ_WUKV = (size_t)2048 * 512 * 2, SZ_WB = (size_t)3 * 2048 * 1024 * 2, SZ_WO = (size_t)2048 * 2048 * 2;
constexpr size_t SZ_WLAYER = SZ_WIN + SZ_WUQ + SZ_WUKV + SZ_WB + SZ_WO;
constexpr size_t WS_W = CTL_BYTES;
constexpr size_t WS_COS = WS_W + SZ_WLAYER, WS_SIN = WS_COS + (size_t)MTOK * 32 * 4;
constexpr size_t WS_H = WS_SIN + (size_t)MTOK * 32 * 4;
constexpr size_t WS_MG = WS_H;
constexpr size_t WS_PROJ = WS_H + (size_t)MP * DM * 2;
constexpr size_t WS_XB = WS_PROJ + (size_t)MP * NPROJ * 2;
constexpr size_t WS_SSQ = WS_XB + (size_t)MP * 2048;
constexpr size_t WS_Q = WS_SSQ + al256((size_t)3 * MP * 4);
constexpr size_t WS_KV = WS_Q + (size_t)MP * 1536 * 2;
constexpr size_t WS_K = WS_KV + (size_t)MP * 2048 * 2;
constexpr size_t WS_YA = WS_K + (size_t)MP * 1536 * 2;
constexpr size_t WS_YB = WS_YA + (size_t)MP * 1024 * 2;
constexpr size_t WS_DL = WS_YA;
constexpr size_t WS_YC = WS_YB + (size_t)MP * 1024 * 2;
constexpr size_t WS_OC = WS_YC + (size_t)MP * 1024 * 2;
constexpr size_t WS_QE = WS_OC + (size_t)MP * 1024 * 4;
constexpr size_t WS_KE = WS_QE + (size_t)MP * 512 * 2, WS_KL = WS_KE + (size_t)MP * 512 * 2;
constexpr size_t WS_H8 = WS_KE;
constexpr size_t WS_DS = WS_KL + (size_t)MP * 512 * 2;
constexpr size_t WS_END = WS_DS + (size_t)(MP / 128) * 512 * 4;
static_assert(WS_END <= ((size_t)1 << 30), "workspace map exceeds 1 GiB");

constexpr int LDS_BYTES = 147456;
constexpr int LDSCTL_OFF = LDS_BYTES - 256;
constexpr int CW_BAR = 4096;

__device__ __forceinline__ float bf2f(unsigned v) { return __uint_as_float(v << 16); }
__device__ __forceinline__ unsigned f2bf(float f) { unsigned u = __float_as_uint(f); return (u + 0x7fffu + ((u >> 16) & 1u)) >> 16; }
__device__ __forceinline__ unsigned pk2(float lo, float hi) { return f2bf(lo) | (f2bf(hi) << 16); }
__device__ __forceinline__ float lo16(unsigned w) { return __uint_as_float(w << 16); }
__device__ __forceinline__ float hi16(unsigned w) { return __uint_as_float(w & 0xffff0000u); }
__device__ __forceinline__ float sigmoid_f(float x) { return 1.f / (1.f + __expf(-x)); }
__device__ __forceinline__ float silu_f(float x) { return x / (1.f + __expf(-x)); }
__device__ __forceinline__ float gelu_f(float x) { const float u2 = 1.5957691216057308f * (x + 0.044715f * x * x * x); return x * __builtin_amdgcn_rcpf(1.f + __expf(-u2)); }
template <int O> __device__ __forceinline__ float lane_xor(float v) {
    if (O == 1) return __uint_as_float((unsigned)__builtin_amdgcn_mov_dpp((int)__float_as_uint(v), 0xB1, 0xf, 0xf, true));
    if (O == 2) return __uint_as_float((unsigned)__builtin_amdgcn_mov_dpp((int)__float_as_uint(v), 0x4E, 0xf, 0xf, true));
    return __uint_as_float((unsigned)__builtin_amdgcn_ds_swizzle((int)__float_as_uint(v), (O << 10) | 0x1f)); }
__device__ __forceinline__ float lane_xor32(float v, int lane) {
    auto rr = __builtin_amdgcn_permlane32_swap(__float_as_uint(v), __float_as_uint(v), false, false);
    return __uint_as_float(lane < 32 ? rr[1] : rr[0]); }
__device__ __forceinline__ float wave_sum(float v) {
    v += lane_xor<1>(v); v += lane_xor<2>(v); v += lane_xor<4>(v); v += lane_xor<8>(v); v += lane_xor<16>(v);
    auto rr = __builtin_amdgcn_permlane32_swap(__float_as_uint(v), __float_as_uint(v), false, false);
    return __uint_as_float(rr[0]) + __uint_as_float(rr[1]); }
__device__ __forceinline__ float wave_max(float v) {
    v = fmaxf(v, lane_xor<1>(v)); v = fmaxf(v, lane_xor<2>(v)); v = fmaxf(v, lane_xor<4>(v)); v = fmaxf(v, lane_xor<8>(v)); v = fmaxf(v, lane_xor<16>(v));
    auto rr = __builtin_amdgcn_permlane32_swap(__float_as_uint(v), __float_as_uint(v), false, false);
    return fmaxf(__uint_as_float(rr[0]), __uint_as_float(rr[1])); }
#define LDS_FENCE() asm volatile("s_waitcnt lgkmcnt(0)" ::: "memory")

struct Args { const void* in[18]; float* out; unsigned char* ws; int lo, hi, pad0, pad1; };

template <int MODE> __device__ __forceinline__ int src_col(int n) {
    if (MODE == 0) return n;
    if (n < C_ZA) return n;
    if (n < C_ZC) return n + 64;
    if (n < C_KROPE) return n + 80;
    if (n < C_AR) return 1024 + (n - C_KROPE);
    if (n < C_AR + 16) return 7232 + (n - C_AR);
    if (n < C_GATE) return -1;
    return 8272 + (n - C_GATE);
}
template <int MODE> __device__ __forceinline__ void convert_T(const float* W, int K, int Nsrc, bf16* WT, int Ndst, LAS float* tile, int vb, int nvb, const float* kscale = nullptr) {
    const int tid = otid(), ntk = K / 64, ntn = Ndst / 64, ntiles = ntk * ntn;
    for (int t = vb; t < ntiles; t += nvb) {
        const int k0 = (t % ntk) * 64, n0 = (t / ntk) * 64;
        { const int nn = tid & 63, sc = src_col<MODE>(n0 + nn);
#pragma unroll
          for (int i = 0; i < 8; ++i) { const int kk = (tid >> 6) + 8 * i; tile[kk * 65 + nn] = sc >= 0 ? W[(size_t)(k0 + kk) * Nsrc + sc] * (kscale ? kscale[k0 + kk] : 1.f) : 0.f; } }
        __syncthreads();
        { const int nn = tid & 63, kg = tid >> 6;
          const LAS float* tp = tile + (kg * 8) * 65 + nn;
          v4u o; o.x = pk2(tp[0], tp[65]); o.y = pk2(tp[2 * 65], tp[3 * 65]); o.z = pk2(tp[4 * 65], tp[5 * 65]); o.w = pk2(tp[6 * 65], tp[7 * 65]);
          *(v4u*)(WT + (size_t)(n0 + nn) * K + k0 + kg * 8) = o; }
        __syncthreads();
    }
}

__device__ __forceinline__ void convert_T8(const float* W, int K, int Nsrc, int col0, unsigned char* WT, int Ndst, LAS float* tile, int vb, int nvb) {
    const int tid = otid(), ntk = K / 64, ntn = Ndst / 64, ntiles = ntk * ntn;
    for (int t = vb; t < ntiles; t += nvb) {
        const int k0 = (t % ntk) * 64, n0 = (t / ntk) * 64;
        { const int nn = tid & 63;
#pragma unroll
          for (int i = 0; i < 8; ++i) { const int kk = (tid >> 6) + 8 * i; tile[kk * 65 + nn] = W[(size_t)(k0 + kk) * Nsrc + col0 + n0 + nn] * 64.0f; } }
        __syncthreads();
        { const int nn = tid & 63, kg = tid >> 6;
          const LAS float* tp = tile + (kg * 8) * 65 + nn;
          unsigned w0 = 0u, w1 = 0u;
          w0 = __builtin_amdgcn_cvt_pk_fp8_f32(tp[0], tp[65], w0, false); w0 = __builtin_amdgcn_cvt_pk_fp8_f32(tp[2 * 65], tp[3 * 65], w0, true);
          w1 = __builtin_amdgcn_cvt_pk_fp8_f32(tp[4 * 65], tp[5 * 65], w1, false); w1 = __builtin_amdgcn_cvt_pk_fp8_f32(tp[6 * 65], tp[7 * 65], w1, true);
          *(v2u*)(WT + (size_t)(n0 + nn) * K + k0 + kg * 8) = (v2u){w0, w1}; }
        __syncthreads();
    }
}

__device__ __forceinline__ void ph_norm(const float* xin, const float* g, bf16* h, unsigned char* h8, int rows, int vb, int nvb) {
    const int tid_ = otid(); const int lane = tid_ & 63, wave = tid_ >> 6;
    for (int r = vb * 8 + wave; r < rows; r += nvb * 8) {
        const v4f* xr = (const v4f*)(xin + (size_t)r * DM);
        v4f v[8]; float ss = 0.f;
#pragma unroll
        for (int j = 0; j < 8; ++j) { v[j] = xr[lane + 64 * j]; ss += v[j].x * v[j].x + v[j].y * v[j].y + v[j].z * v[j].z + v[j].w * v[j].w; }
        ss = wave_sum(ss);
        const float rn = 1.0f / sqrtf(ss * (1.0f / DM) + EPS);
#pragma unroll
        for (int j = 0; j < 8; ++j) { const v4f gg = ((const v4f*)g)[lane + 64 * j];
            const float y0 = v[j].x * rn * gg.x, y1 = v[j].y * rn * gg.y, y2 = v[j].z * rn * gg.z, y3 = v[j].w * rn * gg.w;
            v2u o; o.x = pk2(y0, y1); o.y = pk2(y2, y3);
            *(v2u*)(h + (size_t)r * DM + (lane + 64 * j) * 4) = o;
            unsigned w8 = 0u; w8 = __builtin_amdgcn_cvt_pk_fp8_f32(y0, y1, w8, false); w8 = __builtin_amdgcn_cvt_pk_fp8_f32(y2, y3, w8, true);
            *(unsigned*)(h8 + (size_t)r * DM + (lane + 64 * j) * 4) = w8; }
    }
}
__device__ __forceinline__ float row16_sum(float v) {
    v += __uint_as_float((unsigned)__builtin_amdgcn_mov_dpp((int)__float_as_uint(v), 0xB1, 0xf, 0xf, true));
    v += __uint_as_float((unsigned)__builtin_amdgcn_mov_dpp((int)__float_as_uint(v), 0x4E, 0xf, 0xf, true));
    v += __uint_as_float((unsigned)__builtin_amdgcn_mov_dpp((int)__float_as_uint(v), 0x141, 0xf, 0xf, true));
    v += __uint_as_float((unsigned)__builtin_amdgcn_mov_dpp((int)__float_as_uint(v), 0x140, 0xf, 0xf, true));
    return v; }
__device__ __forceinline__ void ph_kfin(const bf16* kv, const bf16* proj, bf16* K, const float* kg, const float* cosT, const float* sinT, int row0, int vb, int nvb) {
    const int tid_ = otid(); const int lane = tid_ & 63, wave = tid_ >> 6, g16 = lane >> 4, c = lane & 15;
    float gn[8], gr[8];
#pragma unroll
    for (int j = 0; j < 8; ++j) { gn[j] = kg[c * 8 + j]; gr[j] = kg[128 + (c & 7) * 8 + j]; }
    for (int r = vb * 8 + wave; r < MP; r += nvb * 8) {
        const v4u n0 = *(const v4u*)(kv + (size_t)r * 2048 + g16 * 256 + c * 8), n1 = *(const v4u*)(kv + (size_t)r * 2048 + (g16 + 4) * 256 + c * 8);
        const v4u rw = *(const v4u*)(proj + (size_t)r * NPROJ + C_KROPE + (c & 7) * 8);
        const v4f c0 = *(const v4f*)(cosT + (size_t)(row0 + r) * 32 + (c & 3) * 8), c1 = *(const v4f*)(cosT + (size_t)(row0 + r) * 32 + (c & 3) * 8 + 4);
        const v4f s0 = *(const v4f*)(sinT + (size_t)(row0 + r) * 32 + (c & 3) * 8), s1 = *(const v4f*)(sinT + (size_t)(row0 + r) * 32 + (c & 3) * 8 + 4);
        float a[8] = {lo16(n0.x), hi16(n0.x), lo16(n0.y), hi16(n0.y), lo16(n0.z), hi16(n0.z), lo16(n0.w), hi16(n0.w)};
        float b[8] = {lo16(n1.x), hi16(n1.x), lo16(n1.y), hi16(n1.y), lo16(n1.z), hi16(n1.z), lo16(n1.w), hi16(n1.w)};
        float kr[8] = {lo16(rw.x), hi16(rw.x), lo16(rw.y), hi16(rw.y), lo16(rw.z), hi16(rw.z), lo16(rw.w), hi16(rw.w)};
        const float cs[8] = {c0.x, c0.y, c0.z, c0.w, c1.x, c1.y, c1.z, c1.w}, sn[8] = {s0.x, s0.y, s0.z, s0.w, s1.x, s1.y, s1.z, s1.w};
        float sa = 0.f, sb = 0.f, sr = 0.f;
#pragma unroll
        for (int j = 0; j < 8; ++j) { sa += a[j] * a[j]; sb += b[j] * b[j]; sr += kr[j] * kr[j]; }
        if (c >= 8) sr = 0.f;
        sa = row16_sum(sa); sb = row16_sum(sb); sr = row16_sum(sr);
        const float rna = 1.0f / sqrtf((sa + sr) * (1.0f / 192.f) + EPS), rnb = 1.0f / sqrtf((sb + sr) * (1.0f / 192.f) + EPS);
        float R[8];
#pragma unroll
        for (int j = 0; j < 8; ++j) { const float mine = kr[j] * gr[j]; const float oth = lane_xor<4>(mine);
            R[j] = (c & 4) ? mine * cs[j] + oth * sn[j] : mine * cs[j] - oth * sn[j]; }
        bf16* ka = K + ((size_t)r * 8 + g16) * 192; bf16* kb = K + ((size_t)r * 8 + g16 + 4) * 192;
        { v4u o; o.x = pk2(a[0] * rna * gn[0], a[1] * rna * gn[1]); o.y = pk2(a[2] * rna * gn[2], a[3] * rna * gn[3]); o.z = pk2(a[4] * rna * gn[4], a[5] * rna * gn[5]); o.w = pk2(a[6] * rna * gn[6], a[7] * rna * gn[7]); *(v4u*)(ka + c * 8) = o; }
        { v4u o; o.x = pk2(b[0] * rnb * gn[0], b[1] * rnb * gn[1]); o.y = pk2(b[2] * rnb * gn[2], b[3] * rnb * gn[3]); o.z = pk2(b[4] * rnb * gn[4], b[5] * rnb * gn[5]); o.w = pk2(b[6] * rnb * gn[6], b[7] * rnb * gn[7]); *(v4u*)(kb + c * 8) = o; }
        if (c < 8) {
            v4u o; o.x = pk2(R[0] * rna, R[1] * rna); o.y = pk2(R[2] * rna, R[3] * rna); o.z = pk2(R[4] * rna, R[5] * rna); o.w = pk2(R[6] * rna, R[7] * rna); *(v4u*)(ka + 128 + c * 8) = o;
            v4u p; p.x = pk2(R[0] * rnb, R[1] * rnb); p.y = pk2(R[2] * rnb, R[3] * rnb); p.z = pk2(R[4] * rnb, R[5] * rnb); p.w = pk2(R[6] * rnb, R[7] * rnb); *(v4u*)(kb + 128 + c * 8) = p; }
    }
}

namespace at {
typedef short bf16x8 __attribute__((ext_vector_type(8)));
typedef short s16x4 __attribute__((ext_vector_type(4)));
typedef float f32x16 __attribute__((ext_vector_type(16)));
typedef unsigned u32x4 __attribute__((ext_vector_type(4)));
constexpr int SHM_V = 16384, SHM_K = 16384, SHM_KR = 8192;
constexpr int OFF_V = 0, OFF_K = 3 * SHM_V, OFF_KR = OFF_K + 2 * SHM_K, OFF_WS = OFF_KR + 2 * SHM_KR, LDS_NEED = OFF_WS + 8 * 64 * 4;
constexpr float SCALE = 0.07216878364870322f;
constexpr float THR = 8.f;
#define AT_KSWZ(row, colB) ((row) * 256 + ((colB) ^ (((row) & 7) << 4)))
#define AT_KRSWZ(row, colB) ((row) * 128 + ((colB) ^ (((row) & 7) << 4)))
#define AT_SBAR() __builtin_amdgcn_sched_barrier(0)
__device__ __forceinline__ int v_st(int k, int c) { const int kk = (k & ~0xC) | ((k & 4) << 1) | ((k & 8) >> 1); return ((kk >> 3) * 4 + (c >> 5)) * 512 + ((kk & 7) * 32 + (c & 31)) * 2; }
__device__ __forceinline__ int v_rd_base(int lane) { return ((lane & 3) << 3) | (((lane >> 2) & 3) << 6) | (((lane >> 4) & 1) << 5) | (((lane >> 5) & 1) << 8); }
constexpr int v_rd_off(int d0, int ks, int half) { return d0 * 512 + ks * 4096 + half * 2048; }
__device__ __forceinline__ int crow(int r, int hi) { return (r & 3) + 8 * (r >> 2) + 4 * hi; }
__device__ __forceinline__ unsigned cvtpk(float lo, float hi) { unsigned r; asm("v_cvt_pk_bf16_f32 %0, %1, %2" : "=v"(r) : "v"(lo), "v"(hi)); return r; }

__device__ __forceinline__ void mask_tile(f32x16& p0, f32x16& p1, int dq) {
    const float NEG = -__builtin_inff();
#pragma unroll
    for (int r = 0; r < 16; ++r) { const int c = (r & 3) + 8 * (r >> 2); if (dq < c) p0[r] = NEG; if (dq < c + 32) p1[r] = NEG; }
}
__device__ __forceinline__ void partialSM(f32x16& p0, f32x16& p1, float& m_reg, float& mn, float& alpha) {
    float pmax = p0[0];
#pragma unroll
    for (int r = 1; r < 16; ++r) pmax = fmaxf(pmax, p0[r]);
#pragma unroll
    for (int r = 0; r < 16; ++r) pmax = fmaxf(pmax, p1[r]);
    { auto rr = __builtin_amdgcn_permlane32_swap(__float_as_uint(pmax), __float_as_uint(pmax), false, false);
      pmax = fmaxf(__uint_as_float(rr[0]), __uint_as_float(rr[1])); }
    constexpr float C2 = 1.4426950408889634f * SCALE;
    if (__builtin_expect(__all((pmax - m_reg) * SCALE <= THR), 1)) { mn = m_reg; alpha = 1.f; }
    else { mn = fmaxf(m_reg, pmax); alpha = __builtin_amdgcn_exp2f((m_reg - mn) * C2); m_reg = mn; }
    const float mnL = -mn * C2;
#pragma unroll
    for (int r = 0; r < 16; ++r) p0[r] = fmaf(p0[r], C2, mnL);
#pragma unroll
    for (int r = 0; r < 16; ++r) p1[r] = fmaf(p1[r], C2, mnL);
#pragma unroll
    for (int r = 0; r < 16; ++r) p0[r] = __builtin_amdgcn_exp2f(p0[r]);
}
__device__ __forceinline__ void finishSM(f32x16& p0, f32x16& p1, float alpha, float& l_reg, bf16x8& pa0, bf16x8& pa1, bf16x8& pa2, bf16x8& pa3) {
#pragma unroll
    for (int r = 0; r < 16; ++r) p1[r] = __builtin_amdgcn_exp2f(p1[r]);
    float ps = 0;
#pragma unroll
    for (int r = 0; r < 16; ++r) ps += p0[r];
#pragma unroll
    for (int r = 0; r < 16; ++r) ps += p1[r];
    { auto rr = __builtin_amdgcn_permlane32_swap(__float_as_uint(ps), __float_as_uint(ps), false, false);
      ps = __uint_as_float(rr[0]) + __uint_as_float(rr[1]); }
    l_reg = l_reg * alpha + ps;
#define AT_PK4(P, B_, OUT) do { unsigned a0 = cvtpk(P[B_+0], P[B_+1]), a1 = cvtpk(P[B_+2], P[B_+3]);                          \
        unsigned b0 = cvtpk(P[B_+4], P[B_+5]), b1 = cvtpk(P[B_+6], P[B_+7]);                                             \
        auto r0 = __builtin_amdgcn_permlane32_swap(a0, b0, false, false); auto r1 = __builtin_amdgcn_permlane32_swap(a1, b1, false, false); \
        u32x4 w = {r0[0], r1[0], r0[1], r1[1]}; OUT = *reinterpret_cast<bf16x8*>(&w); } while (0)
    AT_PK4(p0, 0, pa0); AT_PK4(p0, 8, pa1); AT_PK4(p1, 0, pa2); AT_PK4(p1, 8, pa3);
#undef AT_PK4
}
__device__ __forceinline__ void qkt(f32x16& p0, f32x16& p1, const LAS unsigned char* Kb, const LAS unsigned char* KRb, int r32, int hi, const bf16x8* qr) {
    p0 = f32x16{}; p1 = f32x16{};
    const LAS unsigned char* kb[4]; const LAS unsigned char* krb[4];
#pragma unroll
    for (int dd = 0; dd < 4; ++dd) { kb[dd] = Kb + AT_KSWZ(r32, (dd * 16 + hi * 8) * 2); krb[dd] = KRb + AT_KRSWZ(r32, (dd * 16 + hi * 8) * 2); }
    bf16x8 f[24];
#pragma unroll
    for (int d0 = 0; d0 < 8; ++d0) { const LAS unsigned char* a = kb[d0 & 3] + (d0 >> 2) * 128;
        f[2 * d0] = *reinterpret_cast<const LAS bf16x8*>(a); f[2 * d0 + 1] = *reinterpret_cast<const LAS bf16x8*>(a + 32 * 256); }
#pragma unroll
    for (int d0 = 0; d0 < 4; ++d0) { const LAS unsigned char* a = krb[d0];
        f[16 + 2 * d0] = *reinterpret_cast<const LAS bf16x8*>(a); f[16 + 2 * d0 + 1] = *reinterpret_cast<const LAS bf16x8*>(a + 32 * 128); }
#pragma unroll
    for (int d0 = 0; d0 < 12; ++d0) {
        p0 = __builtin_amdgcn_mfma_f32_32x32x16_bf16(f[2 * d0], qr[d0], p0, 0, 0, 0);
        p1 = __builtin_amdgcn_mfma_f32_32x32x16_bf16(f[2 * d0 + 1], qr[d0], p1, 0, 0, 0); }
    __builtin_amdgcn_sched_group_barrier(0x100, 4, 0);
#pragma unroll
    for (int i = 0; i < 20; ++i) { __builtin_amdgcn_sched_group_barrier(0x008, 1, 0); __builtin_amdgcn_sched_group_barrier(0x100, 1, 0); }
    __builtin_amdgcn_sched_group_barrier(0x008, 4, 0);
}
__device__ __forceinline__ void pv_tile(f32x16* o, unsigned vb0, bf16x8 pa0, bf16x8 pa1, bf16x8 pa2, bf16x8 pa3) {
#define AT_TRRD(dst, off) asm volatile("ds_read_b64_tr_b16 %0, %1 offset:%2" : "=&v"(dst) : "v"(vb0), "i"(off) : "memory")
#define AT_PV_RD(d0, L, H) do { constexpr int b_ = v_rd_off(d0, 0, 0); \
        AT_TRRD(L[0], b_); AT_TRRD(H[0], b_ + 2048); AT_TRRD(L[1], b_ + 4096); AT_TRRD(H[1], b_ + 6144); AT_TRRD(L[2], b_ + 8192); AT_TRRD(H[2], b_ + 10240); AT_TRRD(L[3], b_ + 12288); AT_TRRD(H[3], b_ + 14336); } while (0)
#define AT_PV_MM(d0, L, H) do { \
        o[d0] = __builtin_amdgcn_mfma_f32_32x32x16_bf16(pa0, (bf16x8){L[0][0], L[0][1], L[0][2], L[0][3], H[0][0], H[0][1], H[0][2], H[0][3]}, o[d0], 0, 0, 0);   \
        o[d0] = __builtin_amdgcn_mfma_f32_32x32x16_bf16(pa1, (bf16x8){L[1][0], L[1][1], L[1][2], L[1][3], H[1][0], H[1][1], H[1][2], H[1][3]}, o[d0], 0, 0, 0);   \
        o[d0] = __builtin_amdgcn_mfma_f32_32x32x16_bf16(pa2, (bf16x8){L[2][0], L[2][1], L[2][2], L[2][3], H[2][0], H[2][1], H[2][2], H[2][3]}, o[d0], 0, 0, 0);   \
        o[d0] = __builtin_amdgcn_mfma_f32_32x32x16_bf16(pa3, (bf16x8){L[3][0], L[3][1], L[3][2], L[3][3], H[3][0], H[3][1], H[3][2], H[3][3]}, o[d0], 0, 0, 0); } while (0)
    s16x4 la[4], ha[4], lb[4], hb[4];
    asm volatile("s_waitcnt lgkmcnt(0)" ::: "memory");
    AT_PV_RD(0, la, ha); AT_PV_RD(1, lb, hb);
    asm volatile("s_waitcnt lgkmcnt(8)" ::: "memory"); AT_SBAR(); AT_PV_MM(0, la, ha); AT_SBAR();
    AT_PV_RD(2, la, ha);
    asm volatile("s_waitcnt lgkmcnt(8)" ::: "memory"); AT_SBAR(); AT_PV_MM(1, lb, hb); AT_SBAR();
    AT_PV_RD(3, lb, hb);
    asm volatile("s_waitcnt lgkmcnt(8)" ::: "memory"); AT_SBAR(); AT_PV_MM(2, la, ha); AT_SBAR();
    asm volatile("s_waitcnt lgkmcnt(0)" ::: "memory"); AT_SBAR(); AT_PV_MM(3, lb, hb);
#undef AT_PV_RD
#undef AT_PV_MM
#undef AT_TRRD
}

__device__ __forceinline__ void attn_block(LAS unsigned char* lds, const bf16* Q, const bf16* K, const bf16* KV, const bf16* proj, bf16* YA, const float* qg, const float* cosT, const float* sinT, int b, int h, int qb) {
    const int tid = otid(), wid = __builtin_amdgcn_readfirstlane(tid >> 6), lane = tid & 63, r32 = lane & 31, hi = lane >> 5;
    const int P0 = qb * 256, NT = 4 * (qb + 1), qlo = P0 + wid * 32;
    LAS unsigned char* V_lds = lds + OFF_V; LAS unsigned char* K_lds = lds + OFF_K; LAS unsigned char* KR_lds = lds + OFF_KR;
    LAS float* wsf = (LAS float*)(lds + OFF_WS) + wid * 64; LAS float* li_l = wsf; LAS float* al_l = wsf + 32;
    bf16x8 qr[12];
    { const bf16* qp = Q + ((size_t)(b * SEQ + qlo + r32) * 8 + h) * 192 + hi * 8;
      bf16x8 raw[12];
#pragma unroll
      for (int d0 = 0; d0 < 12; ++d0) raw[d0] = *(const bf16x8*)(qp + d0 * 16);
      float ss = 0.f;
#pragma unroll
      for (int d0 = 0; d0 < 12; ++d0)
#pragma unroll
          for (int j = 0; j < 8; ++j) { const float v = bf2f((unsigned short)raw[d0][j]); ss += v * v; }
      { auto rr = __builtin_amdgcn_permlane32_swap(__float_as_uint(ss), __float_as_uint(ss), false, false); ss = __uint_as_float(rr[0]) + __uint_as_float(rr[1]); }
      const float rn = 1.0f / sqrtf(ss * (1.0f / 192.f) + EPS);
      const float* ct = cosT + (size_t)(b * SEQ + qlo + r32) * 32 + hi * 8; const float* st = sinT + (size_t)(b * SEQ + qlo + r32) * 32 + hi * 8;
#pragma unroll
      for (int d0 = 0; d0 < 8; ++d0) { const v4f g0 = *(const v4f*)(qg + d0 * 16 + hi * 8), g1 = *(const v4f*)(qg + d0 * 16 + hi * 8 + 4);
          const float g[8] = {g0.x, g0.y, g0.z, g0.w, g1.x, g1.y, g1.z, g1.w}; float x[8];
#pragma unroll
          for (int j = 0; j < 8; ++j) x[j] = bf2f((unsigned short)raw[d0][j]) * rn * g[j];
          u32x4 w = {cvtpk(x[0], x[1]), cvtpk(x[2], x[3]), cvtpk(x[4], x[5]), cvtpk(x[6], x[7])}; qr[d0] = *reinterpret_cast<bf16x8*>(&w); }
#pragma unroll
      for (int d0 = 8; d0 < 10; ++d0) { const int i0 = (d0 - 8) * 16;
          const v4f ga0 = *(const v4f*)(qg + d0 * 16 + hi * 8), ga1 = *(const v4f*)(qg + d0 * 16 + hi * 8 + 4), gb0 = *(const v4f*)(qg + (d0 + 2) * 16 + hi * 8), gb1 = *(const v4f*)(qg + (d0 + 2) * 16 + hi * 8 + 4);
          const v4f c0 = *(const v4f*)(ct + i0), c1 = *(const v4f*)(ct + i0 + 4), s0 = *(const v4f*)(st + i0), s1 = *(const v4f*)(st + i0 + 4);
          const float ga[8] = {ga0.x, ga0.y, ga0.z, ga0.w, ga1.x, ga1.y, ga1.z, ga1.w}, gb[8] = {gb0.x, gb0.y, gb0.z, gb0.w, gb1.x, gb1.y, gb1.z, gb1.w};
          const float cs[8] = {c0.x, c0.y, c0.z, c0.w, c1.x, c1.y, c1.z, c1.w}, sn[8] = {s0.x, s0.y, s0.z, s0.w, s1.x, s1.y, s1.z, s1.w};
          float y1[8], y2[8];
#pragma unroll
          for (int j = 0; j < 8; ++j) { const float x1 = bf2f((unsigned short)raw[d0][j]) * rn * ga[j], x2 = bf2f((unsigned short)raw[d0 + 2][j]) * rn * gb[j];
              y1[j] = x1 * cs[j] - x2 * sn[j]; y2[j] = x2 * cs[j] + x1 * sn[j]; }
          u32x4 w1 = {cvtpk(y1[0], y1[1]), cvtpk(y1[2], y1[3]), cvtpk(y1[4], y1[5]), cvtpk(y1[6], y1[7])}; qr[d0] = *reinterpret_cast<bf16x8*>(&w1);
          u32x4 w2 = {cvtpk(y2[0], y2[1]), cvtpk(y2[2], y2[3]), cvtpk(y2[4], y2[5]), cvtpk(y2[6], y2[7])}; qr[d0 + 2] = *reinterpret_cast<bf16x8*>(&w2); }
    }
    const int sr = tid >> 4, sc = (tid & 15) * 8, kws = AT_KSWZ(sr, sc * 2), vst0 = v_st(sr, sc), vst1 = v_st(32 + sr, sc);
    const int rr = tid >> 3, rc = (tid & 7) * 8, krws = AT_KRSWZ(rr, rc * 2);
    const bf16* Kg = K + ((size_t)(b * SEQ) * 8 + h) * 192;
    const bf16* Vg = KV + (size_t)(b * SEQ) * 2048 + h * 256 + 128;
    bf16x8 sa_k0, sa_k1, sa_kr, sa_v0, sa_v1, sb_k0, sb_k1, sb_kr, sb_v0, sb_v1;
#define AT_SLOAD(S, kb_) do { S##_k0 = *(const bf16x8*)(Kg + (size_t)((kb_) + sr) * 1536 + sc); S##_k1 = *(const bf16x8*)(Kg + (size_t)((kb_) + 32 + sr) * 1536 + sc); \
        S##_kr = *(const bf16x8*)(Kg + (size_t)((kb_) + rr) * 1536 + 128 + rc); \
        S##_v0 = *(const bf16x8*)(Vg + (size_t)((kb_) + sr) * 2048 + sc); S##_v1 = *(const bf16x8*)(Vg + (size_t)((kb_) + 32 + sr) * 2048 + sc); } while (0)
#define AT_SWRITE(S, bf, vbf) do { *(LAS bf16x8*)(K_lds + (bf) * SHM_K + kws) = S##_k0; *(LAS bf16x8*)(K_lds + (bf) * SHM_K + kws + 32 * 256) = S##_k1; \
        *(LAS bf16x8*)(KR_lds + (bf) * SHM_KR + krws) = S##_kr; \
        *(LAS bf16x8*)(V_lds + (vbf) * SHM_V + vst0) = S##_v0; *(LAS bf16x8*)(V_lds + (vbf) * SHM_V + vst1) = S##_v1; } while (0)
    AT_SLOAD(sa, 0); AT_SLOAD(sb, 64); AT_SWRITE(sa, 0, 0);
    __syncthreads();
    float m_reg = -1e30f, l_reg = 0.f; f32x16 o[4] = {};
    const unsigned vbase = (unsigned)(size_t)V_lds + (unsigned)v_rd_base(lane);
    const bool late = wid >= 4;
    bool pend = false; int pvb = 0; int vb3 = 0;
    bf16x8 pa0, pa1, pa2, pa3;
#define AT_STEP(t, SL, SW) do { \
        const int buf = (t) & 1, kb = (t) * 64; \
        if ((t) + 2 < NT) AT_SLOAD(SL, kb + 128);                         \
        if (late && pend) { pv_tile(o, vbase + pvb * SHM_V, pa0, pa1, pa2, pa3); pend = false; AT_SBAR(); } \
        if (kb <= qlo + 31) { \
            f32x16 p0, p1; float mn, alpha; \
            qkt(p0, p1, K_lds + buf * SHM_K, KR_lds + buf * SHM_KR, r32, hi, qr); \
            if (kb + 63 > qlo) mask_tile(p0, p1, qlo + r32 - 4 * hi - kb); \
            partialSM(p0, p1, m_reg, mn, alpha); \
            finishSM(p0, p1, alpha, l_reg, pa0, pa1, pa2, pa3); \
            if (__any(alpha < 1.f)) { if (hi == 0) al_l[r32] = alpha; asm volatile("s_waitcnt lgkmcnt(0)" ::: "memory"); \
                _Pragma("unroll") for (int d_ = 0; d_ < 4; ++d_) _Pragma("unroll") for (int r = 0; r < 16; ++r) o[d_][r] *= al_l[crow(r, hi)]; \
                asm volatile("s_waitcnt lgkmcnt(0)" ::: "memory"); } \
            AT_SBAR(); \
            if (late) { pend = true; pvb = vb3; } \
            else pv_tile(o, vbase + vb3 * SHM_V, pa0, pa1, pa2, pa3); \
        } \
        const int vn3 = vb3 == 2 ? 0 : vb3 + 1; \
        if ((t) + 1 < NT) AT_SWRITE(SW, buf ^ 1, vn3);                    \
        vb3 = vn3; \
        __syncthreads(); } while (0)
    for (int t = 0; t < NT; t += 2) { AT_STEP(t, sa, sb); AT_STEP(t + 1, sb, sa); }
#undef AT_STEP
    if (late && pend) pv_tile(o, vbase + pvb * SHM_V, pa0, pa1, pa2, pa3);
    if (hi == 0) li_l[r32] = l_reg;
    asm volatile("s_waitcnt lgkmcnt(0)" ::: "memory");
    float rli[16];
#pragma unroll
    for (int r = 0; r < 16; ++r) rli[r] = 1.0f / li_l[crow(r, hi)];
#pragma unroll
    for (int d0 = 0; d0 < 4; ++d0) { const int col = h * 128 + d0 * 32 + r32;
        unsigned short zr[16];
#pragma unroll
        for (int r = 0; r < 16; ++r) zr[r] = proj[(size_t)(b * SEQ + qlo + crow(r, hi)) * NPROJ + C_ZA + col];
#pragma unroll
        for (int r = 0; r < 16; ++r) { const int row = b * SEQ + qlo + crow(r, hi);
            const float v = o[d0][r] * rli[r] * silu_f(bf2f(zr[r]));
            const float vn = lane_xor<1>(v);
            if ((r32 & 1) == 0) *(unsigned*)(YA + (size_t)row * 1024 + col) = cvtpk(v, vn); } }
    asm volatile("s_waitcnt lgkmcnt(0)" ::: "memory");
    __syncthreads();
#undef AT_SLOAD
#undef AT_SWRITE
}
}


namespace sg {
using at::bf16x8; using at::f32x16;
__device__ __forceinline__ void sgu_item(LAS unsigned char* lds, const bf16* proj, const float* rv, const float* Ws, const float* bs, const float* vg, bf16* YB, int it) {
    const int tid = otid(), wid = __builtin_amdgcn_readfirstlane(tid >> 6), lane = tid & 63, r32 = lane & 31, hi = lane >> 5;
    {
        const int ch = it >> 2, gp = it & 3, R0 = ch * 128;
#pragma unroll
        for (int i = 0; i < 8; ++i) {
            const int idx = tid + 512 * i, gsel = idx >> 11, row = (idx >> 4) & 127, cc = idx & 15;
            const v4u w = *(const v4u*)(proj + (size_t)(R0 + row) * NPROJ + C_VB + (2 * gp + gsel) * 128 + cc * 8);
            const float s = 1.0f / sqrtf(rv[R0 + row] * (1.0f / 1024.f) + EPS);
            v4u o; o.x = pk2(gelu_f(lo16(w.x)) * s, gelu_f(hi16(w.x)) * s); o.y = pk2(gelu_f(lo16(w.y)) * s, gelu_f(hi16(w.y)) * s);
            o.z = pk2(gelu_f(lo16(w.z)) * s, gelu_f(hi16(w.z)) * s); o.w = pk2(gelu_f(lo16(w.w)) * s, gelu_f(hi16(w.w)) * s);
            *(LAS v4u*)(lds + (gsel * 2 + (row >> 6)) * 16384 + at::v_st(row & 63, cc * 8)) = o;
        }
        __syncthreads();
        const int gsel = wid >> 2, g = 2 * gp + gsel, t = 32 * (wid & 3) + r32;
        f32x16 o[4] = {};
        const int nst = (wid & 3) >= 2 ? 2 : 1;
        for (int st = 0; st < nst; ++st) {
            bf16x8 pa[4];
#pragma unroll
            for (int ks = 0; ks < 4; ++ks) {
                const int s0 = st * 64 + ks * 16 + hi * 8;
                const float* wp = Ws + ((size_t)g * 128 + t) * 128 + s0;
                const v4f a = *(const v4f*)wp, b = *(const v4f*)(wp + 4);
                float x[8] = {a.x, a.y, a.z, a.w, b.x, b.y, b.z, b.w};
#pragma unroll
                for (int j = 0; j < 8; ++j) if (s0 + j > t) x[j] = 0.f;
                at::u32x4 w4 = {at::cvtpk(x[0], x[1]), at::cvtpk(x[2], x[3]), at::cvtpk(x[4], x[5]), at::cvtpk(x[6], x[7])};
                pa[ks] = *reinterpret_cast<bf16x8*>(&w4);
            }
            const unsigned vbase = (unsigned)(size_t)(lds + (gsel * 2 + st) * 16384) + (unsigned)at::v_rd_base(lane);
            at::pv_tile(o, vbase, pa[0], pa[1], pa[2], pa[3]);
        }
#pragma unroll
        for (int d0 = 0; d0 < 4; ++d0) { const int gc = g * 128 + d0 * 32 + r32; const float vgc = vg[gc];
            unsigned short ur[16], zr[16];
#pragma unroll
            for (int r = 0; r < 16; ++r) { const size_t row = (size_t)(R0 + 32 * (wid & 3) + at::crow(r, hi)); ur[r] = proj[row * NPROJ + C_UB + gc]; zr[r] = proj[row * NPROJ + C_ZB + gc]; }
#pragma unroll
            for (int r = 0; r < 16; ++r) { const int tl = 32 * (wid & 3) + at::crow(r, hi); const size_t row = (size_t)(R0 + tl);
                const float mix = o[d0][r] * vgc + bs[g * 128 + tl];
                const float y = gelu_f(bf2f(ur[r])) * mix * silu_f(bf2f(zr[r])), yn = lane_xor<1>(y);
                if ((r32 & 1) == 0) *(unsigned*)(YB + row * 1024 + gc) = at::cvtpk(y, yn); } }
        __syncthreads();
    }
}
}


namespace gl {
using at::bf16x8; using at::f32x16; using at::s16x4; using at::u32x4;
constexpr int OFF_VIMG = 0, OFF_KLIMG = 65536, OFF_ATT = 98304, OFF_DS = 131072, OFF_PART = 131584, LDS_NEED = OFF_PART + 4096;

__device__ __forceinline__ void gla_prep_item(LAS unsigned char* lds, int seg_off, const bf16* proj, const float* wa2, const float* ba, bf16* QE, bf16* KE, bf16* KL, float* DS, int ci) {
    const int tid = otid(), k2 = tid & 63, ts = tid >> 6, k = 2 * k2;
    LAS float* seg = (LAS float*)(lds + seg_off);
    {
        const int ch = ci >> 2, h = ci & 3, R0 = ch * 128 + ts * 16;
        float wa0[16], wa1[16];
#pragma unroll
        for (int j = 0; j < 16; ++j) { const v2f w = *(const v2f*)(wa2 + j * 512 + h * 128 + k); wa0[j] = w.x; wa1[j] = w.y; }
        const v2f bak = *(const v2f*)(ba + h * 128 + k);
        float la0[16], la1[16]; float run0 = 0.f, run1 = 0.f;
#pragma unroll
        for (int i = 0; i < 16; ++i) {
            const bf16* pr = proj + (size_t)(R0 + i) * NPROJ + C_AR;
            const v4u w0 = *(const v4u*)pr, w1 = *(const v4u*)(pr + 8);
            const float ar[16] = {lo16(w0.x), hi16(w0.x), lo16(w0.y), hi16(w0.y), lo16(w0.z), hi16(w0.z), lo16(w0.w), hi16(w0.w),
                                  lo16(w1.x), hi16(w1.x), lo16(w1.y), hi16(w1.y), lo16(w1.z), hi16(w1.z), lo16(w1.w), hi16(w1.w)};
            float x0 = bak.x, x1 = bak.y;
#pragma unroll
            for (int j = 0; j < 16; ++j) { x0 += ar[j] * wa0[j]; x1 += ar[j] * wa1[j]; }
            run0 += (fminf(x0, 0.f) - __logf(1.0f + __expf(-fabsf(x0)))) * 0.0625f; la0[i] = run0;
            run1 += (fminf(x1, 0.f) - __logf(1.0f + __expf(-fabsf(x1)))) * 0.0625f; la1[i] = run1;
        }
        *(LAS v2f*)(seg + ts * 128 + k) = (v2f){run0, run1};
        __syncthreads();
        float pre0 = 0.f, pre1 = 0.f, tot0 = 0.f, tot1 = 0.f;
#pragma unroll
        for (int q = 0; q < 8; ++q) { const v2f sg = *(const LAS v2f*)(seg + q * 128 + k); tot0 += sg.x; tot1 += sg.y; if (q < ts) { pre0 += sg.x; pre1 += sg.y; } }
        const float et0 = __expf(tot0), et1 = __expf(tot1);
        unsigned qw[16], kw[16];
#pragma unroll
        for (int i = 0; i < 16; ++i) { const size_t row = (size_t)(R0 + i); qw[i] = *(const unsigned*)(proj + row * NPROJ + C_QC + h * 128 + k); kw[i] = *(const unsigned*)(proj + row * NPROJ + C_KC + h * 128 + k); }
#pragma unroll
        for (int i = 0; i < 16; ++i) {
            const size_t o = (size_t)(R0 + i) * 512 + h * 128 + k;
            const float e0 = __expf(la0[i] + pre0), e1 = __expf(la1[i] + pre1), r0 = __builtin_amdgcn_rcpf(e0), r1 = __builtin_amdgcn_rcpf(e1);
            const float q0 = lo16(qw[i]) * 0.08838834764831845f, q1 = hi16(qw[i]) * 0.08838834764831845f, kk0 = lo16(kw[i]) * r0, kk1 = hi16(kw[i]) * r1;
            *(unsigned*)(QE + o) = pk2(q0 * e0, q1 * e1);
            *(unsigned*)(KE + o) = pk2(kk0, kk1);
            *(unsigned*)(KL + o) = pk2(kk0 * et0, kk1 * et1);
        }
        if (ts == 0) *(v2f*)(DS + ((size_t)ch * 4 + h) * 128 + k) = (v2f){et0, et1};
        __syncthreads();
    }
}

#define GL_PK4(P, B_, OUT) do { unsigned a0 = at::cvtpk(P[B_+0], P[B_+1]), a1 = at::cvtpk(P[B_+2], P[B_+3]);                          \
        unsigned b0 = at::cvtpk(P[B_+4], P[B_+5]), b1 = at::cvtpk(P[B_+6], P[B_+7]);                                             \
        auto r0 = __builtin_amdgcn_permlane32_swap(a0, b0, false, false); auto r1 = __builtin_amdgcn_permlane32_swap(a1, b1, false, false); \
        u32x4 w = {r0[0], r1[0], r0[1], r1[1]}; OUT = *reinterpret_cast<bf16x8*>(&w); } while (0)
#define GL_TRRD(dst, addr, off) asm volatile("ds_read_b64_tr_b16 %0, %1 offset:%2" : "=&v"(dst) : "v"(addr), "i"(off) : "memory")

__device__ __forceinline__ void gla_chunk_item(LAS unsigned char* lds, const bf16* proj, const bf16* QE, const bf16* KE, const bf16* KL, float* OI, float* DL, int ci) {
    const int tid = otid(), wid = __builtin_amdgcn_readfirstlane(tid >> 6), lane = tid & 63, r32 = lane & 31, hi = lane >> 5;
    const int h = ci & 3, R0 = (ci >> 2) * 128;
    {
        {
#pragma unroll
            for (int i = 0; i < 8; ++i) { const int idx = tid + 512 * i, s = idx >> 5, cc = idx & 31;
                const v4u w = *(const v4u*)(proj + (size_t)(R0 + s) * NPROJ + C_VC + h * 256 + cc * 8);
                *(LAS v4u*)(lds + OFF_VIMG + ((s >> 6) * 2 + (cc >> 4)) * 16384 + at::v_st(s & 63, (cc & 15) * 8)) = w; }
#pragma unroll
            for (int i = 0; i < 4; ++i) { const int idx = tid + 512 * i, s = idx >> 4, cc = idx & 15;
                const v4u w = *(const v4u*)(KL + (size_t)(R0 + s) * 512 + h * 128 + cc * 8);
                *(LAS v4u*)(lds + OFF_KLIMG + (s >> 6) * 16384 + at::v_st(s & 63, cc * 8)) = w; }
#pragma unroll
            for (int j = 0; j < 2; ++j) {
                const int ti = 2 * wid + j, st = ti >> 2, tt = ti & 3;
                if (st <= tt) {
                    f32x16 p = {};
                    const bf16* ap = KE + (size_t)(R0 + 32 * st + r32) * 512 + h * 128 + hi * 8;
                    const bf16* bp = QE + (size_t)(R0 + 32 * tt + r32) * 512 + h * 128 + hi * 8;
                    bf16x8 fa[8], fb[8];
#pragma unroll
                    for (int ks = 0; ks < 8; ++ks) { fa[ks] = *(const bf16x8*)(ap + ks * 16); fb[ks] = *(const bf16x8*)(bp + ks * 16); }
#pragma unroll
                    for (int ks = 0; ks < 8; ++ks) p = __builtin_amdgcn_mfma_f32_32x32x16_bf16(fa[ks], fb[ks], p, 0, 0, 0);
                    __builtin_amdgcn_sched_group_barrier(0x020, 16, 0); __builtin_amdgcn_sched_group_barrier(0x008, 8, 0);
                    if (st == tt) {
#pragma unroll
                        for (int r = 0; r < 16; ++r) if (at::crow(r, hi) > r32) p[r] = 0.f; }
                    const int t = 32 * tt + r32;
#pragma unroll
                    for (int g = 0; g < 4; ++g) { v2u w; w.x = at::cvtpk(p[4 * g], p[4 * g + 1]); w.y = at::cvtpk(p[4 * g + 2], p[4 * g + 3]);
                        *(LAS v2u*)(lds + OFF_ATT + t * 256 + ((64 * st + 16 * g) ^ ((t & 7) << 4)) + 8 * hi) = w; }
                }
            }
            __syncthreads();
            bf16x8 vfr[8];
            { const unsigned vaddr = (unsigned)(size_t)(lds + OFF_VIMG + (wid >> 2) * 16384) + (unsigned)at::v_rd_base(lane) + (unsigned)((wid & 3) * 512);
              s16x4 vl[8], vh[8];
#define GL_VF(ks8) do { constexpr int o_ = ((ks8) >> 2) * 32768 + ((ks8) & 3) * 4096; GL_TRRD(vl[ks8], vaddr, o_); GL_TRRD(vh[ks8], vaddr, o_ + 2048); } while (0)
              GL_VF(0); GL_VF(1); GL_VF(2); GL_VF(3); GL_VF(4); GL_VF(5); GL_VF(6); GL_VF(7);
#undef GL_VF
              asm volatile("s_waitcnt lgkmcnt(0)" ::: "memory"); AT_SBAR();
#pragma unroll
              for (int q = 0; q < 8; ++q) vfr[q] = (bf16x8){vl[q][0], vl[q][1], vl[q][2], vl[q][3], vh[q][0], vh[q][1], vh[q][2], vh[q][3]};
              AT_SBAR(); }
            float* oi = OI + (((size_t)ci * 8 + wid) * 16 * 64 + lane) * 4;
            float* dl = DL + (((size_t)ci * 8 + wid) * 16 * 64 + lane) * 4;
#pragma unroll
            for (int tt = 0; tt < 4; ++tt) {
                f32x16 acc = {};
                const int t = 32 * tt + r32;
#pragma unroll
                for (int ks8 = 0; ks8 < 8; ++ks8) if (ks8 <= 2 * tt + 1) {
                    const bf16x8 a = *(const LAS bf16x8*)(lds + OFF_ATT + t * 256 + (((16 * ks8 + 8 * hi) * 2) ^ ((t & 7) << 4)));
                    acc = __builtin_amdgcn_mfma_f32_32x32x16_bf16(a, vfr[ks8], acc, 0, 0, 0); }
#pragma unroll
                for (int r4 = 0; r4 < 4; ++r4) *(v4f*)(oi + (size_t)(tt * 4 + r4) * 256) = (v4f){acc[4 * r4], acc[4 * r4 + 1], acc[4 * r4 + 2], acc[4 * r4 + 3]};
            }
#pragma unroll
            for (int kt = 0; kt < 4; ++kt) {
                f32x16 D = {};
                const unsigned kaddr = (unsigned)(size_t)(lds + OFF_KLIMG) + (unsigned)at::v_rd_base(lane) + (unsigned)(kt * 512);
#define GL_KF(ks8) do { s16x4 l_, h_; constexpr int o_ = ((ks8) >> 2) * 16384 + ((ks8) & 3) * 4096; GL_TRRD(l_, kaddr, o_); GL_TRRD(h_, kaddr, o_ + 2048); \
                asm volatile("s_waitcnt lgkmcnt(0)" ::: "memory"); AT_SBAR(); \
                D = __builtin_amdgcn_mfma_f32_32x32x16_bf16((bf16x8){l_[0], l_[1], l_[2], l_[3], h_[0], h_[1], h_[2], h_[3]}, vfr[ks8], D, 0, 0, 0); } while (0)
                GL_KF(0); GL_KF(1); GL_KF(2); GL_KF(3); GL_KF(4); GL_KF(5); GL_KF(6); GL_KF(7);
#undef GL_KF
#pragma unroll
                for (int r4 = 0; r4 < 4; ++r4) *(v4f*)(dl + (size_t)(kt * 4 + r4) * 256) = (v4f){D[4 * r4], D[4 * r4 + 1], D[4 * r4 + 2], D[4 * r4 + 3]};
            }
            __syncthreads();
        }
    }
}

__device__ __forceinline__ void gla_stageA_item(const float* DS, const float* DL, bf16* XB, int b, int h, int vp) {
    const int tid = otid(), wid = __builtin_amdgcn_readfirstlane(tid >> 6), lane = tid & 63, hi = lane >> 5;
    const int vb = 2 * vp + (wid >> 2), kt = wid & 3;
    constexpr int PF = 4, NC = SEQ / 128;
    f32x16 X = {};
    v4f dq[PF][4], sq[PF][4];
    const size_t ci0 = (size_t)(b * 32) * 4 + h;
#define GL_ALOAD(slot, c_) do { const size_t ci_ = ci0 + (size_t)(c_) * 4; const float* dl_ = DL + ((ci_ * 8 + vb) * 16 * 64 + lane) * 4 + (size_t)(kt * 4) * 256; const float* ds_ = DS + ci_ * 128 + 32 * kt + 4 * hi; \
        _Pragma("unroll") for (int r4 = 0; r4 < 4; ++r4) { dq[slot][r4] = *(const v4f*)(dl_ + (size_t)r4 * 256); sq[slot][r4] = *(const v4f*)(ds_ + 8 * r4); } } while (0)
#pragma unroll
    for (int s = 0; s < PF; ++s) GL_ALOAD(s, s);
    for (int c0 = 0; c0 < NC; c0 += PF) {
#pragma unroll
        for (int s = 0; s < PF; ++s) {
            const int c = c0 + s; const size_t ci = ci0 + (size_t)c * 4;
            bf16* xo = XB + (((ci * 8 + vb) * 8 + kt * 2) * 64 + lane) * 8;
            bf16x8 xb0, xb1; GL_PK4(X, 0, xb0); GL_PK4(X, 8, xb1);
            *(bf16x8*)xo = xb0; *(bf16x8*)(xo + 512) = xb1;
#pragma unroll
            for (int r4 = 0; r4 < 4; ++r4) { const v4f w = dq[s][r4], d4 = sq[s][r4];
                X[4 * r4] = X[4 * r4] * d4.x + w.x; X[4 * r4 + 1] = X[4 * r4 + 1] * d4.y + w.y; X[4 * r4 + 2] = X[4 * r4 + 2] * d4.z + w.z; X[4 * r4 + 3] = X[4 * r4 + 3] * d4.w + w.w; }
            if (c + PF < NC) GL_ALOAD(s, c + PF);
        }
    }
#undef GL_ALOAD
}
__device__ __forceinline__ void gla_stageB_item(const bf16* proj, const bf16* QE, const float* OI, const bf16* XB, const float* og, bf16* YC, int b, int h, int cp) {
    const int tid = otid(), wid = __builtin_amdgcn_readfirstlane(tid >> 6), lane = tid & 63, r32 = lane & 31, hi = lane >> 5;
    {
        const int c = 2 * cp + (wid >> 2), tt = wid & 3, R0 = b * SEQ + c * 128;
        const size_t ci = (size_t)(b * 32 + c) * 4 + h;
        f32x16 acc[8];
#pragma unroll
        for (int vb = 0; vb < 8; ++vb) { const float* oi = OI + ((ci * 8 + vb) * 16 * 64 + lane) * 4 + (size_t)(tt * 4) * 256;
#pragma unroll
            for (int r4 = 0; r4 < 4; ++r4) { const v4f w = *(const v4f*)(oi + (size_t)r4 * 256); acc[vb][4 * r4] = w.x; acc[vb][4 * r4 + 1] = w.y; acc[vb][4 * r4 + 2] = w.z; acc[vb][4 * r4 + 3] = w.w; } }
        bf16x8 qa[8];
        { const bf16* qp = QE + (size_t)(R0 + 32 * tt + r32) * 512 + h * 128 + hi * 8;
#pragma unroll
          for (int ks = 0; ks < 8; ++ks) qa[ks] = *(const bf16x8*)(qp + ks * 16); }
        if (c > 0) {
            const bf16* xi = XB + (((ci * 8) * 8) * 64 + lane) * 8;
            bf16x8 xf[64];
#pragma unroll
            for (int i = 0; i < 64; ++i) xf[i] = *(const bf16x8*)(xi + (size_t)i * 512);
#pragma unroll
            for (int i = 0; i < 64; ++i) acc[i >> 3] = __builtin_amdgcn_mfma_f32_32x32x16_bf16(qa[i & 7], xf[i], acc[i >> 3], 0, 0, 0);
            __builtin_amdgcn_sched_group_barrier(0x020, 16, 0);
#pragma unroll
            for (int i = 0; i < 48; ++i) { __builtin_amdgcn_sched_group_barrier(0x008, 1, 0); __builtin_amdgcn_sched_group_barrier(0x020, 1, 0); }
            __builtin_amdgcn_sched_group_barrier(0x008, 16, 0);
        }
        float rn[16];
#pragma unroll
        for (int r = 0; r < 16; ++r) { float s = 0.f;
#pragma unroll
            for (int vb = 0; vb < 8; ++vb) s += acc[vb][r] * acc[vb][r];
            s += lane_xor<1>(s); s += lane_xor<2>(s); s += lane_xor<4>(s); s += lane_xor<8>(s); s += lane_xor<16>(s);
            rn[r] = 1.0f / sqrtf(s * (1.0f / 256.f) + EPS); }
#pragma unroll
        for (int vb = 0; vb < 8; ++vb) { const float gcol = og[32 * vb + r32];
            unsigned short zr[16];
#pragma unroll
            for (int r = 0; r < 16; ++r) zr[r] = proj[(size_t)(R0 + 32 * tt + at::crow(r, hi)) * NPROJ + C_ZC + h * 256 + 32 * vb + r32];
#pragma unroll
            for (int r = 0; r < 16; ++r) { const size_t row = (size_t)(R0 + 32 * tt + at::crow(r, hi));
                const float y = acc[vb][r] * rn[r] * gcol * silu_f(bf2f(zr[r])), yn = lane_xor<1>(y);
                if ((r32 & 1) == 0) *(unsigned*)(YC + row * 1024 + h * 256 + 32 * vb + r32) = at::cvtpk(y, yn); } }
    }
}
#undef GL_PK4
#undef GL_TRRD
}


constexpr int CW_Q = 65536;
__device__ __forceinline__ int q_pop(unsigned* ctr, LAS unsigned* slot) {
    if (otid() == 0) *slot = __hip_atomic_fetch_add(ctr, 1u, __ATOMIC_RELAXED, __HIP_MEMORY_SCOPE_AGENT);
    __syncthreads(); const int v = (int)*slot; __syncthreads(); return v; }
__device__ __forceinline__ void ph_mixers(LAS unsigned char* lds, unsigned char* ws, unsigned* qctr, const float* Ws, const float* bs, const float* vg, const float* og, const float* qg, int row0, int vb) {
    constexpr int NGLA = NBP * 8, NATT = 16 * NBP, NSGU = 16 * NBP, NQ = NGLA + NATT + NSGU;
    static_assert(NBP % 2 == 0, "NBP even");
    LAS unsigned* slot = (LAS unsigned*)(lds + LDSCTL_OFF + 64);
    bf16* proj = (bf16*)(ws + WS_PROJ);
    for (int dq = 0; dq < 8; ++dq) {
        const int q = (vb + dq) & 7;
        for (;;) {
            const int idx = q_pop(qctr + q * 64, slot);
            if (idx >= NQ) break;
            if (idx >= NATT && idx < NATT + NGLA) { const int gi = q * NGLA + (idx - NATT), bh = gi >> 4, cp = gi & 15;
                gl::gla_stageB_item(proj, (const bf16*)(ws + WS_QE), (const float*)(ws + WS_OC), (const bf16*)(ws + WS_XB), og, (bf16*)(ws + WS_YC), bh >> 2, bh & 3, cp); }
            else if (idx < NATT) { const int j = idx, qb = 15 - j / NBP, bh = q * NBP + j % NBP;
                at::attn_block(lds, (const bf16*)(ws + WS_Q), (const bf16*)(ws + WS_K), (const bf16*)(ws + WS_KV), proj, (bf16*)(ws + WS_YA), qg, (const float*)(ws + WS_COS) + (size_t)row0 * 32, (const float*)(ws + WS_SIN) + (size_t)row0 * 32, bh >> 3, bh & 7, qb); }
            else { const int it = q * NSGU + (idx - NGLA - NATT);
                sg::sgu_item(lds, proj, (const float*)(ws + WS_SSQ) + 2 * MP, Ws, bs, vg, (bf16*)(ws + WS_YB), it); }
        }
    }
}
#ifndef GEMM_SP2
#define GEMM_SP2 true
#endif
#ifndef GEMM_ALIGN
#define GEMM_ALIGN true
#endif
typedef const __attribute__((address_space(4))) Args* KArgP;
#define KARG() ({ KArgP p_ = (KArgP)__builtin_amdgcn_kernarg_segment_ptr(); asm volatile("" : "+s"(p_)); p_; })
#define INF(i) ((const float*)ap->in[i])
__device__ __forceinline__ void grid_bar(const XcdBarrier& b0) { XcdBarrier b = b0; asm volatile("" : "+s"(b.bar)); xcd_barrier(b); }

__global__ void __launch_bounds__(512, 2) fwd(Args a) {
    extern __shared__ __attribute__((aligned(16))) unsigned char lds_raw[];
    LAS unsigned char* lds = (LAS unsigned char*)lds_raw;
    const int lo = a.lo, hi = a.hi;
    XcdBarrier bar; bar.bar = (unsigned*)(a.ws + WS_CTL) + CW_BAR; bar.x = 0; bar.st = nullptr;
    if (hi - lo > 1) {
        if (threadIdx.x < 4) ((LAS unsigned*)(lds + LDSCTL_OFF))[threadIdx.x] = 0u;
        __syncthreads();
        bar = xcd_barrier_post((unsigned*)(a.ws + WS_CTL) + CW_BAR, (volatile LAS unsigned*)(lds + LDSCTL_OFF));
    }
    int step = 0;
#define PH_BEGIN if (step >= lo && step < hi) { const KArgP ap = KARG(); unsigned char* const ws = ap->ws; const int vb = obid(), nvb = gridDim.x; (void)ws; (void)vb; (void)nvb;
#define PH_END   if (step + 1 < hi) grid_bar(bar); } ++step;
#define WL(l) (ws + WS_W + (size_t)(l) * SZ_WLAYER)
#define B_(T, off) ((T*)(ws + (off)))

    for (int l = 0; l < DEPTH; ++l) {
        PH_BEGIN
            { unsigned char* wl = ws + WS_W;
              convert_T<1>(INF(3) + (size_t)l * DM * IN_COLS, DM, IN_COLS, (bf16*)wl, NBF, (LAS float*)lds, vb, nvb);
              convert_T8(INF(3) + (size_t)l * DM * IN_COLS, DM, IN_COLS, 8272, wl + SZ_WINB, NGATE, (LAS float*)lds, (vb + 96) % nvb, nvb);
              convert_T<0>(INF(6) + (size_t)l * 512 * 1536, 512, 1536, (bf16*)(wl + SZ_WIN), 1536, (LAS float*)lds, (vb + 64) % nvb, nvb, INF(4) + l * 512);
              convert_T<0>(INF(7) + (size_t)l * 512 * 2048, 512, 2048, (bf16*)(wl + SZ_WIN + SZ_WUQ), 2048, (LAS float*)lds, (vb + 128) % nvb, nvb, INF(5) + l * 512);
              for (int b = 0; b < 3; ++b)
                  convert_T<0>(INF(16) + ((size_t)l * 3 + b) * 1024 * 2048, 1024, 2048, (bf16*)(wl + SZ_WIN + SZ_WUQ + SZ_WUKV) + (size_t)b * 2048 * 1024, 2048, (LAS float*)lds, (vb + 32 * b) % nvb, nvb);
              convert_T<0>(INF(17) + (size_t)l * 2048 * 2048, 2048, 2048, (bf16*)(wl + SZ_WIN + SZ_WUQ + SZ_WUKV + SZ_WB), 2048, (LAS float*)lds, (vb + 192) % nvb, nvb); }
            if (l == 0) { const int* positions = (const int*)ap->in[1]; float* cosT = B_(float, WS_COS); float* sinT = B_(float, WS_SIN);
              for (int idx = vb * 512 + otid(); idx < MTOK * 32; idx += nvb * 512) {
                const int t = idx >> 5, i = idx & 31;
                const float inv = 1.0f / powf(10000.0f, (float)(2 * i) * (1.0f / 64.0f));
                const float ang = (float)positions[t] * inv;
                float sn, cs; sincosf(ang, &sn, &cs);
                cosT[idx] = cs; sinT[idx] = sn; } }
        PH_END
        for (int p = 0; p < NPASS; ++p) {
            const int row0 = p * MP;
#define XIN ((l == 0 ? (const float*)ap->in[0] : (const float*)ap->out) + (size_t)row0 * DM)
#define WLP (ws + WS_W)
            PH_BEGIN ph_norm(XIN, INF(2) + l * DM, B_(bf16, WS_H), B_(unsigned char, WS_H8), MP, vb, nvb);
                     { float* ssq = B_(float, WS_SSQ); for (int i = vb * 512 + otid(); i < 3 * MP; i += nvb * 512) ssq[i] = 0.f; } PH_END
            PH_BEGIN { { pg8::Gemm g{B_(bf16, WS_H), (const bf16*)WLP, MP, NBF, DM}; pg8::StaticOrder S; S.init(MP, NBF, nvb, vb); pg8::EpiProj E{B_(bf16, WS_PROJ), NPROJ, B_(float, WS_SSQ), MP};
                         pg8::gemm_phase<pg8::EpiProj, pg8::StaticOrder, false, GEMM_ALIGN, GEMM_SP2>(lds, g, S, E, nullptr); }
                       { pg8::Gemm g{(const bf16*)B_(unsigned char, WS_H8), (const bf16*)(WLP + SZ_WINB), MP, NGATE, DM / 2}; pg8::StaticOrder S; S.init(MP, NGATE, nvb, nvb - 1 - vb); pg8::EpiProj E{B_(bf16, WS_PROJ) + C_GATE, NPROJ, nullptr, MP};
                         pg8::gemm_phase<pg8::EpiProj, pg8::StaticOrder, false, GEMM_ALIGN, GEMM_SP2, true>(lds, g, S, E, nullptr); } } PH_END
            PH_BEGIN { { pg8::Gemm g{B_(bf16, WS_PROJ) + C_CQ, (const bf16*)(WLP + SZ_WIN), MP, 1536, 512, NPROJ}; pg8::StaticOrder S; S.init(MP, 1536, nvb, vb); pg8::EpiBf16Row E{B_(bf16, WS_Q), 1536, B_(float, WS_SSQ), 1.0f / 512.f, EPS};
                         pg8::gemm_phase<pg8::EpiBf16Row, pg8::StaticOrder, false, GEMM_ALIGN, GEMM_SP2>(lds, g, S, E, nullptr); }
                       { pg8::Gemm g{B_(bf16, WS_PROJ) + C_CKV, (const bf16*)(WLP + SZ_WIN + SZ_WUQ), MP, 2048, 512, NPROJ}; pg8::StaticOrder S; S.init(MP, 2048, nvb, nvb - 1 - vb); pg8::EpiBf16Row E{B_(bf16, WS_KV), 2048, B_(float, WS_SSQ) + MP, 1.0f / 512.f, EPS};
                         pg8::gemm_phase<pg8::EpiBf16Row, pg8::StaticOrder, false, GEMM_ALIGN, GEMM_SP2>(lds, g, S, E, nullptr); }
                       for (int ci = vb; ci < (MP / 128) * 4; ci += nvb) {
                           gl::gla_prep_item(lds, 135168, B_(bf16, WS_PROJ), INF(13) + l * 16 * 512, INF(14) + l * 512, B_(bf16, WS_QE), B_(bf16, WS_KE), B_(bf16, WS_KL), B_(float, WS_DS), ci);
                           gl::gla_chunk_item(lds, B_(bf16, WS_PROJ), B_(bf16, WS_QE), B_(bf16, WS_KE), B_(bf16, WS_KL), B_(float, WS_OC), B_(float, WS_DL), ci); } } PH_END
            PH_BEGIN { constexpr int NA = NBP * 16;
                       if (nvb > 2 * NA) { if (vb < NA) gl::gla_stageA_item(B_(float, WS_DS), B_(float, WS_DL), B_(bf16, WS_XB), vb >> 4, (vb >> 2) & 3, vb & 3);
                                           else ph_kfin(B_(bf16, WS_KV), B_(bf16, WS_PROJ), B_(bf16, WS_K), INF(9) + l * 192, B_(float, WS_COS), B_(float, WS_SIN), row0, vb - NA, nvb - NA); }
                       else { for (int it = vb; it < NA; it += nvb) gl::gla_stageA_item(B_(float, WS_DS), B_(float, WS_DL), B_(bf16, WS_XB), it >> 4, (it >> 2) & 3, it & 3);
                              ph_kfin(B_(bf16, WS_KV), B_(bf16, WS_PROJ), B_(bf16, WS_K), INF(9) + l * 192, B_(float, WS_COS), B_(float, WS_SIN), row0, vb, nvb); } } PH_END
            PH_BEGIN ph_mixers(lds, ws, (unsigned*)(ws + WS_CTL) + CW_Q + (l * NPASS + p) * 8 * 64, INF(11) + (size_t)l * 8 * 128 * 128, INF(12) + l * 8 * 128, INF(10) + l * 1024, INF(15) + l * 256, INF(8) + l * 192, row0, vb); PH_END
            PH_BEGIN { pg8::Gemm g{B_(bf16, WS_YA), (const bf16*)(WLP + SZ_WIN + SZ_WUQ + SZ_WUKV), MP, 2048, 1024};
                       pg8::BranchOrder S; S.init(MP, 2048, nvb, vb); S.NB = 3; S.a_stride = (size_t)MP * 1024 * 2; S.b_stride = (size_t)2048 * 1024 * 2;
                       pg8::EpiMerge E{B_(bf16, WS_PROJ) + C_GATE, NPROJ, B_(bf16, WS_MG), 2048, 2048}; pg8::gemm_phase<pg8::EpiMerge, pg8::BranchOrder, false, GEMM_ALIGN, GEMM_SP2>(lds, g, S, E, nullptr); } PH_END
            PH_BEGIN { pg8::Gemm g{B_(bf16, WS_MG), (const bf16*)(WLP + SZ_WIN + SZ_WUQ + SZ_WUKV + SZ_WB), MP, 2048, 2048}; pg8::StaticOrder S; S.init(MP, 2048, nvb, vb); pg8::EpiRes E{XIN, ap->out + (size_t)row0 * DM, 2048};
                       pg8::gemm_phase<pg8::EpiRes, pg8::StaticOrder, false, GEMM_ALIGN, GEMM_SP2>(lds, g, S, E, nullptr); } PH_END
        }
    }
#undef PH_BEGIN
#undef PH_END
}

#ifndef ONE_LAUNCH
#define ONE_LAUNCH 1
#endif
extern "C" void kernel_launch(void* const* d_in, const int* in_sizes, int n_in, void* d_out, int out_size, void* d_ws, size_t ws_size, hipStream_t stream) {
    static int grid = 0;
    if (grid == 0) {
        if (n_in != 18 || out_size != MTOK * DM || ws_size < WS_END) { fprintf(stderr, "kernel_launch: unexpected shapes (n_in %d out %d ws %zu need %zu)\n", n_in, out_size, ws_size, (size_t)WS_END); grid = -1; return; }
        int dev = 0, cus = 0, per_cu = 0;
        if (hipGetDevice(&dev) != hipSuccess || hipDeviceGetAttribute(&cus, hipDeviceAttributeMultiprocessorCount, dev) != hipSuccess) { grid = -1; return; }
        if (hipFuncSetAttribute((const void*)fwd, hipFuncAttributeMaxDynamicSharedMemorySize, LDS_BYTES) != hipSuccess) { fprintf(stderr, "kernel_launch: hipFuncSetAttribute failed\n"); grid = -1; return; }
        if (hipOccupancyMaxActiveBlocksPerMultiprocessor(&per_cu, (const void*)fwd, 512, LDS_BYTES) != hipSuccess || per_cu < 1) { fprintf(stderr, "kernel_launch: occupancy query says %d\n", per_cu); }
        (void)hipGetLastError();
        grid = cus;
    }
    if (grid < 0) return;
    (void)hipMemsetAsync((char*)d_ws + WS_CTL, 0, CTL_BYTES, stream);
    Args a{};
    for (int i = 0; i < 18; ++i) a.in[i] = d_in[i];
    a.out = (float*)d_out; a.ws = (unsigned char*)d_ws; a.pad0 = 0; a.pad1 = 0;
#if ONE_LAUNCH
    a.lo = 0; a.hi = NSTEPS;
    hipLaunchKernelGGL(fwd, dim3(grid), dim3(512), LDS_BYTES, stream, a);
#else
    for (int s = 0; s < NSTEPS; ++s) { a.lo = s; a.hi = s + 1; hipLaunchKernelGGL(fwd, dim3(grid), dim3(512), LDS_BYTES, stream, a); }
#endif
}
```

```cpp
#include <hip/hip_runtime.h>
#include <cstdio>
#include <cstdint>
__device__ __forceinline__ int otid() { int t = threadIdx.x; asm volatile("" : "+v"(t)); return t; }
__device__ __forceinline__ int obid() { int t = blockIdx.x; asm volatile("" : "+s"(t)); return t; }
namespace pg8 {
#define PG8_LAS __attribute__((address_space(3)))
typedef unsigned short bf16_t;
typedef short bf16x8 __attribute__((ext_vector_type(8)));
typedef float f32x4 __attribute__((ext_vector_type(4)));
typedef unsigned u32x4 __attribute__((ext_vector_type(4)));
constexpr int BM = 256, BK = 64, HALF = 128, HTB = HALF * BK * 2  , STAGE_BYTES = 8 * HTB, NXCD = 8, WGM = 4;

__host__ __device__ __forceinline__ int lds_byte(int r, int c) { const int st = (r >> 4) * 2 + (c >> 5), rr = r & 15, cc = c & 31, ob = rr * 64 + cc * 2; return st * 1024 + (ob ^ (((ob >> 9) & 1) << 5)); }
__host__ __device__ __forceinline__ void stage_rc(int b, int& R, int& C) { const int st = b / 1024, sb = b % 1024, swz = sb ^ (((sb >> 9) & 1) << 5); R = (st >> 1) * 16 + swz / 64; C = (st & 1) * 32 + (swz % 64) / 2; }
__host__ __device__ __forceinline__ int perm32(int rho) { const int n = rho >> 4, i = rho & 15; return 8 * (i >> 2) + 4 * n + (i & 3); }

struct Unit { int pm, pn, pb; };
struct Gemm { const bf16_t* A; const bf16_t* Bt; int M, N, K; int lda; };

struct StaticOrder {
    int nM, nN, nwg, G, c;
    __host__ __device__ void init(int M, int N, int G_, int c_) { nM = M / BM; nN = N / BM; nwg = nM * nN; G = G_; c = c_; }
    __host__ __device__ bool next(int i, Unit& u) const {
        const long L = (long)i * G + c; if (L >= nwg) return false;
        int wgid = (int)L; { const int q = nwg / NXCD, r = nwg % NXCD, xcd = wgid % NXCD, off = wgid / NXCD; wgid = (xcd < r ? xcd * (q + 1) : r * (q + 1) + (xcd - r) * q) + off; }
        const int nig = WGM * nN, gid = wgid / nig, fm = gid * WGM, gsz = (nM - fm) < WGM ? (nM - fm) : WGM;
        u.pm = fm + ((wgid % nig) % gsz); u.pn = (wgid % nig) / gsz; u.pb = 0; return true;
    }
    __device__ __forceinline__ size_t a_off(const Unit&) const { return 0; }
    __device__ __forceinline__ size_t b_off(const Unit&) const { return 0; }
    __device__ __forceinline__ void a_ready(const Unit&) const {}
    __device__ __forceinline__ void done(const Unit&) const {}
};

struct BranchOrder : StaticOrder {
    int NB; size_t a_stride, b_stride;
    __device__ bool next(int i, Unit& u) const { const int ti = i / NB; if (!StaticOrder::next(ti, u)) return false; u.pb = i - ti * NB; return true; }
    __device__ __forceinline__ size_t a_off(const Unit& u) const { return (size_t)u.pb * a_stride; }
    __device__ __forceinline__ size_t b_off(const Unit& u) const { return (size_t)u.pb * b_stride; }
};

__device__ __forceinline__ unsigned cvt_pk_bf16(float lo, float hi) { unsigned r; asm volatile("v_cvt_pk_bf16_f32 %0, %1, %2" : "=v"(r) : "v"(lo), "v"(hi)); return r; }
__device__ __forceinline__ float gelu_tanh_f(float x) { const float u2 = 1.5957691216057308f * (x + 0.044715f * x * x * x); return x * __builtin_amdgcn_rcpf(1.f + __expf(-u2)); }
struct EpiProj {
    static constexpr bool PERM = true, AFTER_DRAIN = false;
    bf16_t* O; int ldc; float* SSQ; int mrows; int pn0;
    __device__ __forceinline__ void operator()(const f32x4 (&acc)[2][2][4][2], const Unit& u, int wr, int wc, int fr, int fq) const {
        const int row0 = u.pm * BM + wr * 64 + fr, col0 = u.pn * BM + wc * 32 + 8 * fq;
        const int apn = u.pn + pn0;
        const int seg = !SSQ ? -1 : ((apn == 25 || apn == 26) ? 0 : ((apn == 27 || apn == 28) ? 1 : ((apn >= 4 && apn < 8) ? 2 : -1)));
#pragma unroll
        for (int ai = 0; ai < 2; ++ai)
#pragma unroll
            for (int m = 0; m < 4; ++m) { const int row = row0 + ai * HALF + m * 16; bf16_t* rowp = O + (size_t)row * ldc + col0;
                float ss = 0.f;
#pragma unroll
                for (int bj = 0; bj < 2; ++bj) { const f32x4 v0 = acc[ai][bj][m][0], v1 = acc[ai][bj][m][1];
                    u32x4 w; w.x = cvt_pk_bf16(v0[0], v0[1]); w.y = cvt_pk_bf16(v0[2], v0[3]); w.z = cvt_pk_bf16(v1[0], v1[1]); w.w = cvt_pk_bf16(v1[2], v1[3]);
                    *(u32x4*)(rowp + bj * HALF) = w;
                    if (seg >= 0) {
#pragma unroll
                        for (int j = 0; j < 4; ++j) { float a = v0[j], b = v1[j]; if (seg == 2) { a = gelu_tanh_f(a); b = gelu_tanh_f(b); } ss += a * a + b * b; } } }
                if (seg >= 0) {
                    ss += __uint_as_float((unsigned)__builtin_amdgcn_ds_swizzle((int)__float_as_uint(ss), (16 << 10) | 0x1f));
                    auto rr = __builtin_amdgcn_permlane32_swap(__float_as_uint(ss), __float_as_uint(ss), false, false);
                    ss = __uint_as_float(rr[0]) + __uint_as_float(rr[1]);
                    if (fq == 0) atomicAdd(SSQ + (size_t)seg * mrows + row, ss); } }
    }
};
struct EpiBf16Row {
    static constexpr bool PERM = true, AFTER_DRAIN = false;
    bf16_t* O; int ldc; const float* SSQ; float inv_n, eps;
    __device__ __forceinline__ void operator()(const f32x4 (&acc)[2][2][4][2], const Unit& u, int wr, int wc, int fr, int fq) const {
        const int row0 = u.pm * BM + wr * 64 + fr, col0 = u.pn * BM + wc * 32 + 8 * fq;
#pragma unroll
        for (int ai = 0; ai < 2; ++ai)
#pragma unroll
            for (int m = 0; m < 4; ++m) { const int row = row0 + ai * HALF + m * 16; bf16_t* rowp = O + (size_t)row * ldc + col0;
                const float rn = 1.0f / sqrtf(SSQ[row] * inv_n + eps);
#pragma unroll
                for (int bj = 0; bj < 2; ++bj) { const f32x4 v0 = acc[ai][bj][m][0] * rn, v1 = acc[ai][bj][m][1] * rn;
                    u32x4 w; w.x = cvt_pk_bf16(v0[0], v0[1]); w.y = cvt_pk_bf16(v0[2], v0[3]); w.z = cvt_pk_bf16(v1[0], v1[1]); w.w = cvt_pk_bf16(v1[2], v1[3]);
                    *(u32x4*)(rowp + bj * HALF) = w; } }
    }
};

struct EpiRes {
    static constexpr bool PERM = false, AFTER_DRAIN = false;
    const float* base; float* C; int ldc;
    __device__ __forceinline__ void operator()(const f32x4 (&acc)[2][2][4][2], const Unit& u, int wr, int wc, int fr, int fq) const {
        const int row0 = u.pm * BM + wr * 64 + fr, col0 = u.pn * BM + wc * 32 + 4 * fq;
#pragma unroll
        for (int ai = 0; ai < 2; ++ai) {
            f32x4 bs[4][2][2];
#pragma unroll
            for (int m = 0; m < 4; ++m) { const size_t off = (size_t)(row0 + ai * HALF + m * 16) * ldc + col0;
#pragma unroll
                for (int bj = 0; bj < 2; ++bj)
#pragma unroll
                    for (int n = 0; n < 2; ++n) bs[m][bj][n] = *(const f32x4*)(base + off + bj * HALF + n * 16); }
#pragma unroll
            for (int m = 0; m < 4; ++m) { const size_t off = (size_t)(row0 + ai * HALF + m * 16) * ldc + col0;
#pragma unroll
                for (int bj = 0; bj < 2; ++bj)
#pragma unroll
                    for (int n = 0; n < 2; ++n) *(f32x4*)(C + off + bj * HALF + n * 16) = acc[ai][bj][m][n] + bs[m][bj][n]; }
            asm volatile("" ::: "memory");
        }
    }
};
struct EpiMerge {
    static constexpr bool PERM = true, AFTER_DRAIN = false;
    const bf16_t* G0; int ldg; bf16_t* MG; int ldc; int gstride;
    __device__ __forceinline__ void operator()(const f32x4 (&acc)[2][2][4][2], const Unit& u, int wr, int wc, int fr, int fq) const {
        const int row0 = u.pm * BM + wr * 64 + fr, col0 = u.pn * BM + wc * 32 + 8 * fq; const bf16_t* G = G0 + (size_t)u.pb * gstride; const bool first = u.pb == 0;
#pragma unroll
        for (int ai = 0; ai < 2; ++ai) {
            u32x4 gw[4][2], ow[4][2];
#pragma unroll
            for (int m = 0; m < 4; ++m) { const size_t row = (size_t)(row0 + ai * HALF + m * 16);
#pragma unroll
                for (int bj = 0; bj < 2; ++bj) { gw[m][bj] = *(const u32x4*)(G + row * ldg + col0 + bj * HALF); ow[m][bj] = first ? (u32x4){0u, 0u, 0u, 0u} : *(const u32x4*)(MG + row * ldc + col0 + bj * HALF); } }
#pragma unroll
            for (int m = 0; m < 4; ++m) { const size_t row = (size_t)(row0 + ai * HALF + m * 16);
#pragma unroll
                for (int bj = 0; bj < 2; ++bj) { const f32x4 v0 = acc[ai][bj][m][0], v1 = acc[ai][bj][m][1];
                    const unsigned g4[4] = {gw[m][bj].x, gw[m][bj].y, gw[m][bj].z, gw[m][bj].w}, o4[4] = {ow[m][bj].x, ow[m][bj].y, ow[m][bj].z, ow[m][bj].w};
                    const float a8[8] = {v0[0], v0[1], v0[2], v0[3], v1[0], v1[1], v1[2], v1[3]};
                    unsigned w4[4];
#pragma unroll
                    for (int q = 0; q < 4; ++q) {
                        const float g0 = __uint_as_float(g4[q] << 16), g1 = __uint_as_float(g4[q] & 0xffff0000u);
                        const float r0 = __uint_as_float(o4[q] << 16) + a8[2 * q] * __builtin_amdgcn_rcpf(1.0f + __expf(-g0));
                        const float r1 = __uint_as_float(o4[q] & 0xffff0000u) + a8[2 * q + 1] * __builtin_amdgcn_rcpf(1.0f + __expf(-g1));
                        unsigned pk; asm("v_cvt_pk_bf16_f32 %0, %1, %2" : "=v"(pk) : "v"(r0), "v"(r1)); w4[q] = pk; }
                    *(u32x4*)(MG + row * ldc + col0 + bj * HALF) = (u32x4){w4[0], w4[1], w4[2], w4[3]}; } }
            asm volatile("" ::: "memory");
        }
    }
};

typedef int pg8_v8i __attribute__((ext_vector_type(8)));
typedef int pg8_v4i __attribute__((ext_vector_type(4)));
template <class Epi, class Sched, bool STAMP = false, bool ALIGN_EPI = false, bool SP2 = false, bool FP8 = false>
__device__ __forceinline__ void gemm_phase(PG8_LAS unsigned char* lds, const Gemm g, const Sched& S, const Epi& E, unsigned long long* stamps) {
    const int tid = otid(), wid = __builtin_amdgcn_readfirstlane(tid >> 6), lane = tid & 63, wr = wid >> 2, wc = wid & 3, fr = lane & 15, fq = lane >> 4;
    const int K = g.K, nt = K / BK, LDA = g.lda ? g.lda : g.K;
    int ts_lo = 0, ts_hi = 0, nts = 0; const unsigned long long rt_entry = STAMP ? (unsigned long long)wall_clock64() : 0ull;
#define PG8_STAMP() do { if (STAMP && wid == 0 && nts < 64) { const unsigned long long _c = (unsigned long long)clock64(); \
        ts_lo = (lane == nts) ? (int)(unsigned)_c : ts_lo; ts_hi = (lane == nts) ? (int)(unsigned)(_c >> 32) : ts_hi; ++nts; } } while (0)
    PG8_STAMP();
    unsigned voffA[2], voffB[2];
#pragma unroll
    for (int i = 0; i < 2; ++i) { int R, C; stage_rc(tid * 16 + i * 8192, R, C); const int Rb = Epi::PERM ? ((R & ~31) + perm32(R & 31)) : R;
        voffA[i] = (unsigned)(R * LDA + C) * 2u; voffB[i] = (unsigned)(Rb * K + C) * 2u; }
    const size_t kstep = (size_t)(BK * 2);
    const size_t hstepB = (size_t)HALF * K * 2, hstepA = (size_t)HALF * LDA * 2;
    const size_t tstepB = 2 * hstepB, tstepA = 2 * hstepA;
    const unsigned ldsw = (unsigned)wid * 1024u;
    const int aoff = lds_byte(wr * 64 + fr, fq * 8), boff = lds_byte(wc * 32 + fr, fq * 8);
#define PG8_SA(b, h) (((b) * 2 + (h)) * HTB)
#define PG8_SB(b, h) ((4 + (b) * 2 + (h)) * HTB)
#define PG8_STAGE(bufoff, gbase, voff) do { _Pragma("unroll") for (int _i = 0; _i < 2; ++_i) \
        __builtin_amdgcn_global_load_lds((const unsigned*)((const char*)(gbase) + (voff)[_i]), (PG8_LAS unsigned*)(lds + (bufoff) + ldsw + _i * 8192), 16, 0, 0); } while (0)
#define PG8_I4(p) (*(const PG8_LAS pg8_v4i*)(p))
#define PG8_LDA(dst, b, h) do { if constexpr (FP8) { _Pragma("unroll") for (int m = 0; m < 4; ++m) dst##8[m] = __builtin_shufflevector(PG8_I4(lds + PG8_SA(b, h) + aoff + m * 2048), PG8_I4(lds + PG8_SA(b, h) + aoff + m * 2048 + 1024), 0, 1, 2, 3, 4, 5, 6, 7); } \
        else { _Pragma("unroll") for (int m = 0; m < 4; ++m) _Pragma("unroll") for (int k = 0; k < 2; ++k) dst[m][k] = *(const PG8_LAS bf16x8*)(lds + PG8_SA(b, h) + aoff + m * 2048 + k * 1024); } } while (0)
#define PG8_LDB(dst, b, h) do { if constexpr (FP8) { _Pragma("unroll") for (int n = 0; n < 2; ++n) dst##8[n] = __builtin_shufflevector(PG8_I4(lds + PG8_SB(b, h) + boff + n * 2048), PG8_I4(lds + PG8_SB(b, h) + boff + n * 2048 + 1024), 0, 1, 2, 3, 4, 5, 6, 7); } \
        else { _Pragma("unroll") for (int n = 0; n < 2; ++n) _Pragma("unroll") for (int k = 0; k < 2; ++k) dst[n][k] = *(const PG8_LAS bf16x8*)(lds + PG8_SB(b, h) + boff + n * 2048 + k * 1024); } } while (0)
#define PG8_MMA_BF(ai, bj, At, Bt) do { __builtin_amdgcn_s_setprio(1); _Pragma("unroll") for (int m = 0; m < 4; ++m) _Pragma("unroll") for (int n = 0; n < 2; ++n) _Pragma("unroll") for (int k = 0; k < 2; ++k) \
        acc[ai][bj][m][n] = __builtin_amdgcn_mfma_f32_16x16x32_bf16(Bt[n][k], At[m][k], acc[ai][bj][m][n], 0, 0, 0); __builtin_amdgcn_s_setprio(0); } while (0)
#define PG8_MMA_F8(ai, bj, At, Bt) do { __builtin_amdgcn_s_setprio(1); _Pragma("unroll") for (int m = 0; m < 4; ++m) _Pragma("unroll") for (int n = 0; n < 2; ++n) \
        asm volatile("v_mfma_scale_f32_16x16x128_f8f6f4 %0, %1, %2, %0, %3, %4 op_sel_hi:[0,0,0]" : "+v"(acc[ai][bj][m][n]) : "v"(Bt##8[n]), "v"(At##8[m]), "v"(f8_scale_w), "v"(f8_scale_x)); \
        __builtin_amdgcn_s_setprio(0); } while (0)
#define PG8_F8_DRAIN() do { if constexpr (FP8) asm volatile("s_nop 15\n\ts_nop 15" ::: "memory"); } while (0)
#define PG8_MMA(ai, bj, At, Bt) do { if constexpr (FP8) PG8_MMA_F8(ai, bj, At, Bt); else PG8_MMA_BF(ai, bj, At, Bt); } while (0)
#define PG8_WAIT_V(n) asm volatile("s_waitcnt vmcnt(" #n ")" ::: "memory")
#define PG8_WAIT_L(n) asm volatile("s_waitcnt lgkmcnt(" #n ")" ::: "memory")
#define PG8_BAR __builtin_amdgcn_s_barrier()
#define PG8_SCHED __builtin_amdgcn_sched_barrier(0)
    Unit cur, nxt; int ui = 0;
    if (!S.next(0, cur)) return;
    f32x4 acc[2][2][4][2];
#pragma unroll
    for (int a = 0; a < 2; ++a)
#pragma unroll
        for (int b = 0; b < 2; ++b)
#pragma unroll
            for (int m = 0; m < 4; ++m)
#pragma unroll
                for (int n = 0; n < 2; ++n) acc[a][b][m][n] = (f32x4){0.f, 0.f, 0.f, 0.f};
    int f8_scale_w = 0x79797979, f8_scale_x = 0x7f7f7f7f; (void)f8_scale_w; (void)f8_scale_x;
    bf16x8 At[4][2], B0[2][2], B1[2][2]; pg8_v8i At8[4], B08[2], B18[2];
    (void)At; (void)B0; (void)B1; (void)At8; (void)B08; (void)B18;
    const char* cA = (const char*)g.A + (size_t)cur.pm * tstepA + S.a_off(cur); const char* cB = (const char*)g.Bt + (size_t)cur.pn * tstepB + S.b_off(cur);
    S.a_ready(cur);
    if constexpr (SP2) {
        PG8_STAGE(PG8_SB(0, 0), cB, voffB); PG8_STAGE(PG8_SB(0, 1), cB + hstepB, voffB); PG8_STAGE(PG8_SA(0, 0), cA, voffA); PG8_STAGE(PG8_SA(0, 1), cA + hstepA, voffA);
        if (wr == 1) PG8_BAR;
        PG8_WAIT_V(2); PG8_BAR;
        PG8_STAGE(PG8_SB(1, 0), cB + kstep, voffB); PG8_STAGE(PG8_SA(1, 0), cA + kstep, voffA); PG8_STAGE(PG8_SB(1, 1), cB + hstepB + kstep, voffB);
        PG8_WAIT_V(6); PG8_BAR;
    } else {
    PG8_STAGE(PG8_SB(0, 0), cB, voffB); PG8_STAGE(PG8_SA(0, 0), cA, voffA); PG8_STAGE(PG8_SB(0, 1), cB + hstepB, voffB); PG8_STAGE(PG8_SA(0, 1), cA + hstepA, voffA);
    if (wr == 1) PG8_BAR;
    PG8_WAIT_V(4); PG8_BAR;
    PG8_STAGE(PG8_SB(1, 0), cB + kstep, voffB); PG8_STAGE(PG8_SA(1, 0), cA + kstep, voffA); PG8_STAGE(PG8_SB(1, 1), cB + hstepB + kstep, voffB);
    PG8_WAIT_V(6); PG8_BAR;
    }
    PG8_STAMP();
    for (;;) {
        const bool has_next = S.next(ui + 1, nxt);
        const char* nA = has_next ? (const char*)g.A + (size_t)nxt.pm * tstepA + S.a_off(nxt) : cA; const char* nB = has_next ? (const char*)g.Bt + (size_t)nxt.pn * tstepB + S.b_off(nxt) : cB;
        for (int t = 0; t < nt; t += 2) {
            const bool last = (t == nt - 2);
            const char* a1 = cA + (size_t)(t + 1) * kstep;
            const char* a2 = last ? nA : cA + (size_t)(t + 2) * kstep; const char* b2 = last ? nB : cB + (size_t)(t + 2) * kstep;
            const char* a3 = a2 + kstep; const char* b3 = b2 + kstep;
            if (last && has_next) S.a_ready(nxt);
            if constexpr (SP2) {
            PG8_LDB(B0, 0, 0); PG8_LDB(B1, 0, 1); PG8_SCHED; PG8_LDA(At, 0, 0); PG8_STAGE(PG8_SA(1, 1), a1 + hstepA, voffA);
            PG8_WAIT_V(8); PG8_WAIT_L(0); PG8_BAR; PG8_MMA(0, 0, At, B0); PG8_MMA(0, 1, At, B1); PG8_BAR; PG8_SCHED;
            PG8_LDA(At, 0, 1); PG8_STAGE(PG8_SB(0, 0), b2, voffB); PG8_STAGE(PG8_SB(0, 1), b2 + hstepB, voffB); PG8_STAGE(PG8_SA(0, 0), a2, voffA);
            PG8_WAIT_V(8); PG8_WAIT_L(0); PG8_BAR; PG8_MMA(1, 0, At, B0); PG8_MMA(1, 1, At, B1); PG8_BAR; PG8_SCHED;
            PG8_LDB(B0, 1, 0); PG8_LDB(B1, 1, 1); PG8_SCHED; PG8_LDA(At, 1, 0); PG8_STAGE(PG8_SA(0, 1), a2 + hstepA, voffA);
            PG8_WAIT_V(8); PG8_WAIT_L(0); PG8_BAR; PG8_MMA(0, 0, At, B0); PG8_MMA(0, 1, At, B1); PG8_BAR; PG8_SCHED;
            PG8_LDA(At, 1, 1); PG8_STAGE(PG8_SB(1, 0), b3, voffB); PG8_STAGE(PG8_SB(1, 1), b3 + hstepB, voffB); PG8_STAGE(PG8_SA(1, 0), a3, voffA);
            PG8_WAIT_V(8); PG8_WAIT_L(0); PG8_BAR; PG8_MMA(1, 0, At, B0); PG8_MMA(1, 1, At, B1); PG8_BAR; PG8_SCHED;
            } else {
            PG8_LDB(B0, 0, 0); PG8_SCHED; PG8_LDA(At, 0, 0); PG8_STAGE(PG8_SA(1, 1), a1 + hstepA, voffA);
            PG8_WAIT_L(8); PG8_BAR; PG8_WAIT_L(0); PG8_MMA(0, 0, At, B0); PG8_BAR; PG8_SCHED;
            PG8_LDB(B1, 0, 1); PG8_STAGE(PG8_SB(0, 0), b2, voffB);
            PG8_BAR; PG8_WAIT_L(0); PG8_MMA(0, 1, At, B1); PG8_BAR;
            PG8_LDA(At, 0, 1); PG8_STAGE(PG8_SA(0, 0), a2, voffA);
            PG8_BAR; PG8_WAIT_L(0); PG8_MMA(1, 0, At, B0); PG8_BAR; PG8_SCHED;
            PG8_STAGE(PG8_SB(0, 1), b2 + hstepB, voffB);
            PG8_WAIT_V(6); PG8_BAR; PG8_MMA(1, 1, At, B1); PG8_BAR;
            PG8_LDB(B0, 1, 0); PG8_SCHED; PG8_LDA(At, 1, 0); PG8_STAGE(PG8_SA(0, 1), a2 + hstepA, voffA);
            PG8_WAIT_L(8); PG8_BAR; PG8_WAIT_L(0); PG8_MMA(0, 0, At, B0); PG8_BAR; PG8_SCHED;
            PG8_LDB(B1, 1, 1); PG8_STAGE(PG8_SB(1, 0), b3, voffB);
            PG8_BAR; PG8_WAIT_L(0); PG8_MMA(0, 1, At, B1); PG8_BAR;
            PG8_LDA(At, 1, 1); PG8_STAGE(PG8_SA(1, 0), a3, voffA);
            PG8_BAR; PG8_WAIT_L(0); PG8_MMA(1, 0, At, B0); PG8_BAR; PG8_SCHED;
            PG8_STAGE(PG8_SB(1, 1), b3 + hstepB, voffB);
            PG8_WAIT_V(6); PG8_BAR; PG8_MMA(1, 1, At, B1); PG8_BAR;
            }
        }
        if constexpr (ALIGN_EPI) { if (wr == 0) PG8_BAR; }
        PG8_STAMP();
        PG8_F8_DRAIN();
        if constexpr (!Epi::AFTER_DRAIN) { E(acc, cur, wr, wc, fr, fq); S.done(cur); }
        PG8_STAMP();
        if (!has_next) break;
#pragma unroll
        for (int a = 0; a < 2; ++a)
#pragma unroll
            for (int b = 0; b < 2; ++b)
#pragma unroll
                for (int m = 0; m < 4; ++m)
#pragma unroll
                    for (int n = 0; n < 2; ++n) acc[a][b][m][n] = (f32x4){0.f, 0.f, 0.f, 0.f};
        cur = nxt; cA = nA; cB = nB; ++ui;
        if constexpr (ALIGN_EPI) { if (wr == 1) PG8_BAR; }
    }
    PG8_WAIT_V(0);
    if constexpr (!ALIGN_EPI) { if (wr == 0) PG8_BAR; }
    PG8_BAR;
    if constexpr (Epi::AFTER_DRAIN) { E.fused(acc, cur, wr, wc, fr, fq, lds, wid, lane); S.done(cur); }
    PG8_STAMP();
    if (STAMP && wid == 0) { stamps[lane] = lane < nts ? (((unsigned long long)(unsigned)ts_hi << 32) | (unsigned)ts_lo) : 0ull;
        if (lane == 62) stamps[62] = rt_entry; if (lane == 63) stamps[63] = (unsigned long long)wall_clock64(); }
#undef PG8_STAMP
#undef PG8_SA
#undef PG8_SB
#undef PG8_STAGE
#undef PG8_LDA
#undef PG8_LDB
#undef PG8_MMA
#undef PG8_MMA_BF
#undef PG8_MMA_F8
#undef PG8_I4
#undef PG8_F8_DRAIN
#undef PG8_WAIT_V
#undef PG8_WAIT_L
#undef PG8_BAR
#undef PG8_SCHED
}
}
#define XB_TMO      128
#define XB_XCNT(j)  (256  + 64 * (j))
#define XB_XSUB(j)  (1280 + 64 * (j))
#define XB_XGEN(j)  (2304 + 64 * (j))
#define XB_TOP      3328
#define XB_TOPGEN   3392
#define XCD_BAR_WORDS 3456
#define XB_SPIN_CAP (1u << 18)
#define LAS __attribute__((address_space(3)))

__device__ __forceinline__ unsigned xb_ld(unsigned* p)              { return __hip_atomic_load(p, __ATOMIC_RELAXED, __HIP_MEMORY_SCOPE_AGENT); }
__device__ __forceinline__ unsigned xb_add(unsigned* p, unsigned v) { return __hip_atomic_fetch_add(p, v, __ATOMIC_RELAXED, __HIP_MEMORY_SCOPE_AGENT); }
__device__ __forceinline__ unsigned xb_xcc_id() { return (unsigned)__builtin_amdgcn_s_getreg((3 << 11) | 20) & 0xFu; }
#define XB_SPIN(cond, bar) do { unsigned _sp = 0; while (cond) { __builtin_amdgcn_s_sleep(1); \
    if ((++_sp & 255u) == 0u) { if (xb_ld(&(bar)[XB_TMO])) break; if (_sp > XB_SPIN_CAP) { atomicAdd(&(bar)[XB_TMO], 1u); break; } } } } while (0)

struct XcdBarrier {
    unsigned* bar; unsigned x;
    volatile LAS unsigned* st;
};

__device__ __forceinline__ XcdBarrier xcd_barrier_post(unsigned* bar, volatile LAS unsigned* st) {
    XcdBarrier b; b.bar = bar; b.x = xb_xcc_id(); b.st = st;
    if (threadIdx.x == 0) (void)xb_add(&bar[XB_XCNT(b.x)], 1u);
    return b;
}
__device__ __forceinline__ void xcd_barrier_complete(unsigned* bar, unsigned x, unsigned& nloc, unsigned& nx) {
    const unsigned G = gridDim.x * gridDim.y * gridDim.z;
    unsigned sum, cnt, mine, sp = 0u;
    for (;;) {
        sum = 0u; cnt = 0u; mine = 0u;
#pragma unroll
        for (unsigned j = 0; j < 16; ++j) { const unsigned c = xb_ld(&bar[XB_XCNT(j)]); sum += c; cnt += (c > 0u) ? 1u : 0u; mine = (j == x) ? c : mine; }
        if (sum == G) break;
        __builtin_amdgcn_s_sleep(1);
        if ((++sp & 255u) == 0u) { if (xb_ld(&bar[XB_TMO])) break; if (sp > XB_SPIN_CAP) { atomicAdd(&bar[XB_TMO], 1u); break; } }
    }
    nloc = mine > 0u ? mine : 1u; nx = cnt > 0u ? cnt : 1u;
}

__device__ __forceinline__ void xcd_barrier(const XcdBarrier& b) {
    asm volatile("s_waitcnt vmcnt(0)" ::: "memory");
    __syncthreads();
    if (threadIdx.x == 0) {
        unsigned* bar = b.bar;
        __builtin_amdgcn_s_waitcnt(0);
        unsigned nloc = b.st[0], nx = b.st[1];
        if (nloc == 0u) { xcd_barrier_complete(bar, b.x, nloc, nx); b.st[0] = nloc; b.st[1] = nx; }
        const unsigned old = xb_add(&bar[XB_XSUB(b.x)], 1u);
        const unsigned gen = old / nloc;
        if (old + 1u == (gen + 1u) * nloc) {
            __builtin_amdgcn_fence(__ATOMIC_RELEASE, "agent");
            asm volatile("s_waitcnt vmcnt(0)" ::: "memory");
            const unsigned og = xb_add(&bar[XB_TOP], 1u);
            const unsigned tg = og / nx;
            if (og + 1u == (tg + 1u) * nx) xb_add(&bar[XB_TOPGEN], 1u);
            else XB_SPIN(xb_ld(&bar[XB_TOPGEN]) == tg, bar);
            __builtin_amdgcn_fence(__ATOMIC_ACQUIRE, "agent");
            xb_add(&bar[XB_XGEN(b.x)], 1u);
            asm volatile("s_waitcnt vmcnt(0)" ::: "memory");
        } else {
            XB_SPIN(xb_ld(&bar[XB_XGEN(b.x)]) == gen, bar);
            __builtin_amdgcn_fence(__ATOMIC_ACQUIRE, "agent");
            asm volatile("s_waitcnt vmcnt(0)" ::: "memory");
        }
    }
    __syncthreads();
}


typedef unsigned short bf16;
typedef unsigned v4u __attribute__((ext_vector_type(4)));
typedef unsigned v2u __attribute__((ext_vector_type(2)));
typedef float v4f __attribute__((ext_vector_type(4)));
typedef float v2f __attribute__((ext_vector_type(2)));

constexpr int DM = 2048, NBATCH = 8, SEQ = 4096, DEPTH = 2, MTOK = NBATCH * SEQ;
constexpr int IN_COLS = 14416, NPROJ = 14592;
constexpr int C_UB = 0, C_VB = 1024, C_ZB = 2048, C_QC = 3072, C_KC = 3584, C_VC = 4096, C_ZC = 5120, C_KROPE = 6144, C_AR = 6208,
              C_CQ = 6400, C_CKV = 6912, C_ZA = 7424, C_GATE = 8448;
constexpr int NBF = C_CQ, NF8 = NPROJ - NBF;
constexpr float EPS = 1e-6f;
#ifndef NBP
#define NBP 4
#endif
constexpr int MP = NBP * SEQ, NPASS = NBATCH / NBP;
constexpr int STEPS_PER_PASS = 7;
constexpr int NSTEPS = DEPTH * (1 + NPASS * STEPS_PER_PASS);

constexpr size_t al256(size_t x) { return (x + 255) & ~(size_t)255; }
constexpr size_t WS_CTL = 0, CTL_BYTES = 1u << 20;
constexpr size_t SZ_WINB = (size_t)NBF * DM * 2  , SZ_WIN = SZ_WINB + (size_t)NF8 * DM  , SZ_WUQ = (size_t)1536 * 512 * 2, SZ_WUKV = (size_t)2048 * 512 * 2, SZ_WB = (size_t)3 * 2048 * 1024 * 2, SZ_WO = (size_t)2048 * 2048 * 2;
constexpr size_t SZ_WLAYER = SZ_WIN + SZ_WUQ + SZ_WUKV + SZ_WB + SZ_WO;
constexpr size_t WS_W = CTL_BYTES;
constexpr size_t WS_COS = WS_W + SZ_WLAYER, WS_SIN = WS_COS + (size_t)MTOK * 32 * 4;
constexpr size_t WS_H = WS_SIN + (size_t)MTOK * 32 * 4;
constexpr size_t WS_MG = WS_H;
constexpr size_t WS_PROJ = WS_H + (size_t)MP * DM * 2;
constexpr size_t WS_XB = WS_PROJ + (size_t)MP * NPROJ * 2;
constexpr size_t WS_SSQ = WS_XB + (size_t)MP * 2048;
constexpr size_t WS_Q = WS_SSQ + al256((size_t)3 * MP * 4);
constexpr size_t WS_KV = WS_Q + (size_t)MP * 1536 * 2;
constexpr size_t WS_K = WS_KV + (size_t)MP * 2048 * 2;
constexpr size_t WS_YA = WS_K + (size_t)MP * 1536 * 2;
constexpr size_t WS_YB = WS_YA + (size_t)MP * 1024 * 2;
constexpr size_t WS_DL = WS_YA;
constexpr size_t WS_YC = WS_YB + (size_t)MP * 1024 * 2;
constexpr size_t WS_OC = WS_YC + (size_t)MP * 1024 * 2;
constexpr size_t WS_QE = WS_OC + (size_t)MP * 1024 * 4;
constexpr size_t WS_KE = WS_QE + (size_t)MP * 512 * 2, WS_KL = WS_KE + (size_t)MP * 512 * 2;
constexpr size_t WS_H8 = WS_KE;
constexpr size_t WS_DS = WS_KL + (size_t)MP * 512 * 2;
constexpr size_t WS_END = WS_DS + (size_t)(MP / 128) * 512 * 4;
static_assert(WS_END <= ((size_t)1 << 30), "workspace map exceeds 1 GiB");

constexpr int LDS_BYTES = 147456;
constexpr int LDSCTL_OFF = LDS_BYTES - 256;
constexpr int CW_BAR = 4096;

__device__ __forceinline__ float bf2f(unsigned v) { return __uint_as_float(v << 16); }
__device__ __forceinline__ unsigned f2bf(float f) { unsigned u = __float_as_uint(f); return (u + 0x7fffu + ((u >> 16) & 1u)) >> 16; }
__device__ __forceinline__ unsigned pk2(float lo, float hi) { return f2bf(lo) | (f2bf(hi) << 16); }
__device__ __forceinline__ float lo16(unsigned w) { return __uint_as_float(w << 16); }
__device__ __forceinline__ float hi16(unsigned w) { return __uint_as_float(w & 0xffff0000u); }
__device__ __forceinline__ float sigmoid_f(float x) { return 1.f / (1.f + __expf(-x)); }
__device__ __forceinline__ float silu_f(float x) { return x / (1.f + __expf(-x)); }
__device__ __forceinline__ float gelu_f(float x) { const float u2 = 1.5957691216057308f * (x + 0.044715f * x * x * x); return x * __builtin_amdgcn_rcpf(1.f + __expf(-u2)); }
template <int O> __device__ __forceinline__ float lane_xor(float v) {
    if (O == 1) return __uint_as_float((unsigned)__builtin_amdgcn_mov_dpp((int)__float_as_uint(v), 0xB1, 0xf, 0xf, true));
    if (O == 2) return __uint_as_float((unsigned)__builtin_amdgcn_mov_dpp((int)__float_as_uint(v), 0x4E, 0xf, 0xf, true));
    return __uint_as_float((unsigned)__builtin_amdgcn_ds_swizzle((int)__float_as_uint(v), (O << 10) | 0x1f)); }
__device__ __forceinline__ float lane_xor32(float v, int lane) {
    auto rr = __builtin_amdgcn_permlane32_swap(__float_as_uint(v), __float_as_uint(v), false, false);
    return __uint_as_float(lane < 32 ? rr[1] : rr[0]); }
__device__ __forceinline__ float wave_sum(float v) {
    v += lane_xor<1>(v); v += lane_xor<2>(v); v += lane_xor<4>(v); v += lane_xor<8>(v); v += lane_xor<16>(v);
    auto rr = __builtin_amdgcn_permlane32_swap(__float_as_uint(v), __float_as_uint(v), false, false);
    return __uint_as_float(rr[0]) + __uint_as_float(rr[1]); }
__device__ __forceinline__ float wave_max(float v) {
    v = fmaxf(v, lane_xor<1>(v)); v = fmaxf(v, lane_xor<2>(v)); v = fmaxf(v, lane_xor<4>(v)); v = fmaxf(v, lane_xor<8>(v)); v = fmaxf(v, lane_xor<16>(v));
    auto rr = __builtin_amdgcn_permlane32_swap(__float_as_uint(v), __float_as_uint(v), false, false);
    return fmaxf(__uint_as_float(rr[0]), __uint_as_float(rr[1])); }
#define LDS_FENCE() asm volatile("s_waitcnt lgkmcnt(0)" ::: "memory")

struct Args { const void* in[18]; float* out; unsigned char* ws; int lo, hi, pad0, pad1; };

template <int MODE> __device__ __forceinline__ int src_col(int n) {
    if (MODE == 0) return n;
    if (MODE == 2) n += NBF;
    if (n < C_VB) return 2112 + n;
    if (n < C_ZB) return 3136 + (n - C_VB);
    if (n < C_QC) return 4160 + (n - C_ZB);
    if (n < C_KC) return 5184 + (n - C_QC);
    if (n < C_VC) return 5696 + (n - C_KC);
    if (n < C_ZC) return 6208 + (n - C_VC);
    if (n < C_KROPE) return 7248 + (n - C_ZC);
    if (n < C_AR) return 1024 + (n - C_KROPE);
    if (n < C_AR + 16) return 7232 + (n - C_AR);
    if (n < C_CQ) return -1;
    if (n < C_CKV) return n - C_CQ;
    if (n < C_ZA) return 512 + (n - C_CKV);
    if (n < C_GATE) return 1088 + (n - C_ZA);
    return 8272 + (n - C_GATE);
}
template <int MODE> __device__ __forceinline__ void convert_T(const float* W, int K, int Nsrc, bf16* WT, int Ndst, LAS float* tile, int vb, int nvb, const float* kscale = nullptr) {
    const int tid = otid(), ntk = K / 64, ntn = Ndst / 64, ntiles = ntk * ntn;
    for (int t = vb; t < ntiles; t += nvb) {
        const int k0 = (t % ntk) * 64, n0 = (t / ntk) * 64;
        { const int nn = tid & 63, sc = src_col<MODE>(n0 + nn);
#pragma unroll
          for (int i = 0; i < 8; ++i) { const int kk = (tid >> 6) + 8 * i; tile[kk * 65 + nn] = sc >= 0 ? W[(size_t)(k0 + kk) * Nsrc + sc] * (kscale ? kscale[k0 + kk] : 1.f) : 0.f; } }
        __syncthreads();
        { const int nn = tid & 63, kg = tid >> 6;
          const LAS float* tp = tile + (kg * 8) * 65 + nn;
          v4u o; o.x = pk2(tp[0], tp[65]); o.y = pk2(tp[2 * 65], tp[3 * 65]); o.z = pk2(tp[4 * 65], tp[5 * 65]); o.w = pk2(tp[6 * 65], tp[7 * 65]);
          *(v4u*)(WT + (size_t)(n0 + nn) * K + k0 + kg * 8) = o; }
        __syncthreads();
    }
}

__device__ __forceinline__ void convert_T8(const float* W, int K, int Nsrc, unsigned char* WT, int Ndst, LAS float* tile, int vb, int nvb) {
    const int tid = otid(), ntk = K / 64, ntn = Ndst / 64, ntiles = ntk * ntn;
    for (int t = vb; t < ntiles; t += nvb) {
        const int k0 = (t % ntk) * 64, n0 = (t / ntk) * 64;
        { const int nn = tid & 63;
          const int sc = src_col<2>(n0 + nn);
#pragma unroll
          for (int i = 0; i < 8; ++i) { const int kk = (tid >> 6) + 8 * i; tile[kk * 65 + nn] = W[(size_t)(k0 + kk) * Nsrc + sc] * 64.0f; } }
        __syncthreads();
        { const int nn = tid & 63, kg = tid >> 6;
          const LAS float* tp = tile + (kg * 8) * 65 + nn;
          unsigned w0 = 0u, w1 = 0u;
          w0 = __builtin_amdgcn_cvt_pk_fp8_f32(tp[0], tp[65], w0, false); w0 = __builtin_amdgcn_cvt_pk_fp8_f32(tp[2 * 65], tp[3 * 65], w0, true);
          w1 = __builtin_amdgcn_cvt_pk_fp8_f32(tp[4 * 65], tp[5 * 65], w1, false); w1 = __builtin_amdgcn_cvt_pk_fp8_f32(tp[6 * 65], tp[7 * 65], w1, true);
          *(v2u*)(WT + (size_t)(n0 + nn) * K + k0 + kg * 8) = (v2u){w0, w1}; }
        __syncthreads();
    }
}

__device__ __forceinline__ void ph_norm(const float* xin, const float* g, bf16* h, unsigned char* h8, int rows, int vb, int nvb) {
    const int tid_ = otid(); const int lane = tid_ & 63, wave = tid_ >> 6;
    for (int r = vb * 8 + wave; r < rows; r += nvb * 8) {
        const v4f* xr = (const v4f*)(xin + (size_t)r * DM);
        v4f v[8]; float ss = 0.f;
#pragma unroll
        for (int j = 0; j < 8; ++j) { v[j] = xr[lane + 64 * j]; ss += v[j].x * v[j].x + v[j].y * v[j].y + v[j].z * v[j].z + v[j].w * v[j].w; }
        ss = wave_sum(ss);
        const float rn = 1.0f / sqrtf(ss * (1.0f / DM) + EPS);
#pragma unroll
        for (int j = 0; j < 8; ++j) { const v4f gg = ((const v4f*)g)[lane + 64 * j];
            const float y0 = v[j].x * rn * gg.x, y1 = v[j].y * rn * gg.y, y2 = v[j].z * rn * gg.z, y3 = v[j].w * rn * gg.w;
            v2u o; o.x = pk2(y0, y1); o.y = pk2(y2, y3);
            *(v2u*)(h + (size_t)r * DM + (lane + 64 * j) * 4) = o;
            unsigned w8 = 0u; w8 = __builtin_amdgcn_cvt_pk_fp8_f32(y0, y1, w8, false); w8 = __builtin_amdgcn_cvt_pk_fp8_f32(y2, y3, w8, true);
            *(unsigned*)(h8 + (size_t)r * DM + (lane + 64 * j) * 4) = w8; }
    }
}
__device__ __forceinline__ float row16_sum(float v) {
    v += __uint_as_float((unsigned)__builtin_amdgcn_mov_dpp((int)__float_as_uint(v), 0xB1, 0xf, 0xf, true));
    v += __uint_as_float((unsigned)__builtin_amdgcn_mov_dpp((int)__float_as_uint(v), 0x4E, 0xf, 0xf, true));
    v += __uint_as_float((unsigned)__builtin_amdgcn_mov_dpp((int)__float_as_uint(v), 0x141, 0xf, 0xf, true));
    v += __uint_as_float((unsigned)__builtin_amdgcn_mov_dpp((int)__float_as_uint(v), 0x140, 0xf, 0xf, true));
    return v; }
__device__ __forceinline__ void ph_kfin(const bf16* kv, const bf16* proj, bf16* K, const float* kg, const float* cosT, const float* sinT, int row0, int vb, int nvb) {
    const int tid_ = otid(); const int lane = tid_ & 63, wave = tid_ >> 6, g16 = lane >> 4, c = lane & 15;
    float gn[8], gr[8];
#pragma unroll
    for (int j = 0; j < 8; ++j) { gn[j] = kg[c * 8 + j]; gr[j] = kg[128 + (c & 7) * 8 + j]; }
    for (int r = vb * 8 + wave; r < MP; r += nvb * 8) {
        const v4u n0 = *(const v4u*)(kv + (size_t)r * 2048 + g16 * 256 + c * 8), n1 = *(const v4u*)(kv + (size_t)r * 2048 + (g16 + 4) * 256 + c * 8);
        const v4u rw = *(const v4u*)(proj + (size_t)r * NPROJ + C_KROPE + (c & 7) * 8);
        const v4f c0 = *(const v4f*)(cosT + (size_t)(row0 + r) * 32 + (c & 3) * 8), c1 = *(const v4f*)(cosT + (size_t)(row0 + r) * 32 + (c & 3) * 8 + 4);
        const v4f s0 = *(const v4f*)(sinT + (size_t)(row0 + r) * 32 + (c & 3) * 8), s1 = *(const v4f*)(sinT + (size_t)(row0 + r) * 32 + (c & 3) * 8 + 4);
        float a[8] = {lo16(n0.x), hi16(n0.x), lo16(n0.y), hi16(n0.y), lo16(n0.z), hi16(n0.z), lo16(n0.w), hi16(n0.w)};
        float b[8] = {lo16(n1.x), hi16(n1.x), lo16(n1.y), hi16(n1.y), lo16(n1.z), hi16(n1.z), lo16(n1.w), hi16(n1.w)};
        float kr[8] = {lo16(rw.x), hi16(rw.x), lo16(rw.y), hi16(rw.y), lo16(rw.z), hi16(rw.z), lo16(rw.w), hi16(rw.w)};
        const float cs[8] = {c0.x, c0.y, c0.z, c0.w, c1.x, c1.y, c1.z, c1.w}, sn[8] = {s0.x, s0.y, s0.z, s0.w, s1.x, s1.y, s1.z, s1.w};
        float sa = 0.f, sb = 0.f, sr = 0.f;
#pragma unroll
        for (int j = 0; j < 8; ++j) { sa += a[j] * a[j]; sb += b[j] * b[j]; sr += kr[j] * kr[j]; }
        if (c >= 8) sr = 0.f;
        sa = row16_sum(sa); sb = row16_sum(sb); sr = row16_sum(sr);
        const float rna = 1.0f / sqrtf((sa + sr) * (1.0f / 192.f) + EPS), rnb = 1.0f / sqrtf((sb + sr) * (1.0f / 192.f) + EPS);
        float R[8];
#pragma unroll
        for (int j = 0; j < 8; ++j) { const float mine = kr[j] * gr[j]; const float oth = lane_xor<4>(mine);
            R[j] = (c & 4) ? mine * cs[j] + oth * sn[j] : mine * cs[j] - oth * sn[j]; }
        bf16* ka = K + ((size_t)r * 8 + g16) * 192; bf16* kb = K + ((size_t)r * 8 + g16 + 4) * 192;
        { v4u o; o.x = pk2(a[0] * rna * gn[0], a[1] * rna * gn[1]); o.y = pk2(a[2] * rna * gn[2], a[3] * rna * gn[3]); o.z = pk2(a[4] * rna * gn[4], a[5] * rna * gn[5]); o.w = pk2(a[6] * rna * gn[6], a[7] * rna * gn[7]); *(v4u*)(ka + c * 8) = o; }
        { v4u o; o.x = pk2(b[0] * rnb * gn[0], b[1] * rnb * gn[1]); o.y = pk2(b[2] * rnb * gn[2], b[3] * rnb * gn[3]); o.z = pk2(b[4] * rnb * gn[4], b[5] * rnb * gn[5]); o.w = pk2(b[6] * rnb * gn[6], b[7] * rnb * gn[7]); *(v4u*)(kb + c * 8) = o; }
        if (c < 8) {
            v4u o; o.x = pk2(R[0] * rna, R[1] * rna); o.y = pk2(R[2] * rna, R[3] * rna); o.z = pk2(R[4] * rna, R[5] * rna); o.w = pk2(R[6] * rna, R[7] * rna); *(v4u*)(ka + 128 + c * 8) = o;
            v4u p; p.x = pk2(R[0] * rnb, R[1] * rnb); p.y = pk2(R[2] * rnb, R[3] * rnb); p.z = pk2(R[4] * rnb, R[5] * rnb); p.w = pk2(R[6] * rnb, R[7] * rnb); *(v4u*)(kb + 128 + c * 8) = p; }
    }
}

namespace at {
typedef short bf16x8 __attribute__((ext_vector_type(8)));
typedef short s16x4 __attribute__((ext_vector_type(4)));
typedef float f32x16 __attribute__((ext_vector_type(16)));
typedef unsigned u32x4 __attribute__((ext_vector_type(4)));
constexpr int SHM_V = 16384, SHM_K = 16384, SHM_KR = 8192;
constexpr int OFF_V = 0, OFF_K = 3 * SHM_V, OFF_KR = OFF_K + 2 * SHM_K, OFF_WS = OFF_KR + 2 * SHM_KR, LDS_NEED = OFF_WS + 8 * 64 * 4;
constexpr float SCALE = 0.07216878364870322f;
constexpr float THR = 8.f;
#define AT_KSWZ(row, colB) ((row) * 256 + ((colB) ^ (((row) & 7) << 4)))
#define AT_KRSWZ(row, colB) ((row) * 128 + ((colB) ^ (((row) & 7) << 4)))
#define AT_SBAR() __builtin_amdgcn_sched_barrier(0)
__device__ __forceinline__ int v_st(int k, int c) { const int kk = (k & ~0xC) | ((k & 4) << 1) | ((k & 8) >> 1); return ((kk >> 3) * 4 + (c >> 5)) * 512 + ((kk & 7) * 32 + (c & 31)) * 2; }
__device__ __forceinline__ int v_rd_base(int lane) { return ((lane & 3) << 3) | (((lane >> 2) & 3) << 6) | (((lane >> 4) & 1) << 5) | (((lane >> 5) & 1) << 8); }
constexpr int v_rd_off(int d0, int ks, int half) { return d0 * 512 + ks * 4096 + half * 2048; }
__device__ __forceinline__ int crow(int r, int hi) { return (r & 3) + 8 * (r >> 2) + 4 * hi; }
__device__ __forceinline__ unsigned cvtpk(float lo, float hi) { unsigned r; asm("v_cvt_pk_bf16_f32 %0, %1, %2" : "=v"(r) : "v"(lo), "v"(hi)); return r; }

__device__ __forceinline__ void mask_tile(f32x16& p0, f32x16& p1, int dq) {
    const float NEG = -__builtin_inff();
#pragma unroll
    for (int r = 0; r < 16; ++r) { const int c = (r & 3) + 8 * (r >> 2); if (dq < c) p0[r] = NEG; if (dq < c + 32) p1[r] = NEG; }
}
__device__ __forceinline__ void partialSM(f32x16& p0, f32x16& p1, float& m_reg, float& mn, float& alpha) {
    float pmax = p0[0];
#pragma unroll
    for (int r = 1; r < 16; ++r) pmax = fmaxf(pmax, p0[r]);
#pragma unroll
    for (int r = 0; r < 16; ++r) pmax = fmaxf(pmax, p1[r]);
    { auto rr = __builtin_amdgcn_permlane32_swap(__float_as_uint(pmax), __float_as_uint(pmax), false, false);
      pmax = fmaxf(__uint_as_float(rr[0]), __uint_as_float(rr[1])); }
    constexpr float C2 = 1.4426950408889634f * SCALE;
    if (__builtin_expect(__all((pmax - m_reg) * SCALE <= THR), 1)) { mn = m_reg; alpha = 1.f; }
    else { mn = fmaxf(m_reg, pmax); alpha = __builtin_amdgcn_exp2f((m_reg - mn) * C2); m_reg = mn; }
    const float mnL = -mn * C2;
#pragma unroll
    for (int r = 0; r < 16; ++r) p0[r] = fmaf(p0[r], C2, mnL);
#pragma unroll
    for (int r = 0; r < 16; ++r) p1[r] = fmaf(p1[r], C2, mnL);
#pragma unroll
    for (int r = 0; r < 16; ++r) p0[r] = __builtin_amdgcn_exp2f(p0[r]);
}
__device__ __forceinline__ void finishSM(f32x16& p0, f32x16& p1, float alpha, float& l_reg, bf16x8& pa0, bf16x8& pa1, bf16x8& pa2, bf16x8& pa3) {
#pragma unroll
    for (int r = 0; r < 16; ++r) p1[r] = __builtin_amdgcn_exp2f(p1[r]);
    float ps = 0;
#pragma unroll
    for (int r = 0; r < 16; ++r) ps += p0[r];
#pragma unroll
    for (int r = 0; r < 16; ++r) ps += p1[r];
    { auto rr = __builtin_amdgcn_permlane32_swap(__float_as_uint(ps), __float_as_uint(ps), false, false);
      ps = __uint_as_float(rr[0]) + __uint_as_float(rr[1]); }
    l_reg = l_reg * alpha + ps;
#define AT_PK4(P, B_, OUT) do { unsigned a0 = cvtpk(P[B_+0], P[B_+1]), a1 = cvtpk(P[B_+2], P[B_+3]);                          \
        unsigned b0 = cvtpk(P[B_+4], P[B_+5]), b1 = cvtpk(P[B_+6], P[B_+7]);                                             \
        auto r0 = __builtin_amdgcn_permlane32_swap(a0, b0, false, false); auto r1 = __builtin_amdgcn_permlane32_swap(a1, b1, false, false); \
        u32x4 w = {r0[0], r1[0], r0[1], r1[1]}; OUT = *reinterpret_cast<bf16x8*>(&w); } while (0)
    AT_PK4(p0, 0, pa0); AT_PK4(p0, 8, pa1); AT_PK4(p1, 0, pa2); AT_PK4(p1, 8, pa3);
#undef AT_PK4
}
__device__ __forceinline__ void qkt(f32x16& p0, f32x16& p1, const LAS unsigned char* Kb, const LAS unsigned char* KRb, int r32, int hi, const bf16x8* qr) {
    p0 = f32x16{}; p1 = f32x16{};
    const LAS unsigned char* kb[4]; const LAS unsigned char* krb[4];
#pragma unroll
    for (int dd = 0; dd < 4; ++dd) { kb[dd] = Kb + AT_KSWZ(r32, (dd * 16 + hi * 8) * 2); krb[dd] = KRb + AT_KRSWZ(r32, (dd * 16 + hi * 8) * 2); }
    bf16x8 f[24];
#pragma unroll
    for (int d0 = 0; d0 < 8; ++d0) { const LAS unsigned char* a = kb[d0 & 3] + (d0 >> 2) * 128;
        f[2 * d0] = *reinterpret_cast<const LAS bf16x8*>(a); f[2 * d0 + 1] = *reinterpret_cast<const LAS bf16x8*>(a + 32 * 256); }
#pragma unroll
    for (int d0 = 0; d0 < 4; ++d0) { const LAS unsigned char* a = krb[d0];
        f[16 + 2 * d0] = *reinterpret_cast<const LAS bf16x8*>(a); f[16 + 2 * d0 + 1] = *reinterpret_cast<const LAS bf16x8*>(a + 32 * 128); }
#pragma unroll
    for (int d0 = 0; d0 < 12; ++d0) {
        p0 = __builtin_amdgcn_mfma_f32_32x32x16_bf16(f[2 * d0], qr[d0], p0, 0, 0, 0);
        p1 = __builtin_amdgcn_mfma_f32_32x32x16_bf16(f[2 * d0 + 1], qr[d0], p1, 0, 0, 0); }
    __builtin_amdgcn_sched_group_barrier(0x100, 4, 0);
#pragma unroll
    for (int i = 0; i < 20; ++i) { __builtin_amdgcn_sched_group_barrier(0x008, 1, 0); __builtin_amdgcn_sched_group_barrier(0x100, 1, 0); }
    __builtin_amdgcn_sched_group_barrier(0x008, 4, 0);
}
__device__ __forceinline__ void pv_tile(f32x16* o, unsigned vb0, bf16x8 pa0, bf16x8 pa1, bf16x8 pa2, bf16x8 pa3) {
#define AT_TRRD(dst, off) asm volatile("ds_read_b64_tr_b16 %0, %1 offset:%2" : "=&v"(dst) : "v"(vb0), "i"(off) : "memory")
#define AT_PV_RD(d0, L, H) do { constexpr int b_ = v_rd_off(d0, 0, 0); \
        AT_TRRD(L[0], b_); AT_TRRD(H[0], b_ + 2048); AT_TRRD(L[1], b_ + 4096); AT_TRRD(H[1], b_ + 6144); AT_TRRD(L[2], b_ + 8192); AT_TRRD(H[2], b_ + 10240); AT_TRRD(L[3], b_ + 12288); AT_TRRD(H[3], b_ + 14336); } while (0)
#define AT_PV_MM(d0, L, H) do { \
        o[d0] = __builtin_amdgcn_mfma_f32_32x32x16_bf16(pa0, (bf16x8){L[0][0], L[0][1], L[0][2], L[0][3], H[0][0], H[0][1], H[0][2], H[0][3]}, o[d0], 0, 0, 0);   \
        o[d0] = __builtin_amdgcn_mfma_f32_32x32x16_bf16(pa1, (bf16x8){L[1][0], L[1][1], L[1][2], L[1][3], H[1][0], H[1][1], H[1][2], H[1][3]}, o[d0], 0, 0, 0);   \
        o[d0] = __builtin_amdgcn_mfma_f32_32x32x16_bf16(pa2, (bf16x8){L[2][0], L[2][1], L[2][2], L[2][3], H[2][0], H[2][1], H[2][2], H[2][3]}, o[d0], 0, 0, 0);   \
        o[d0] = __builtin_amdgcn_mfma_f32_32x32x16_bf16(pa3, (bf16x8){L[3][0], L[3][1], L[3][2], L[3][3], H[3][0], H[3][1], H[3][2], H[3][3]}, o[d0], 0, 0, 0); } while (0)
    s16x4 la[4], ha[4], lb[4], hb[4];
    asm volatile("s_waitcnt lgkmcnt(0)" ::: "memory");
    AT_PV_RD(0, la, ha); AT_PV_RD(1, lb, hb);
    asm volatile("s_waitcnt lgkmcnt(8)" ::: "memory"); AT_SBAR(); AT_PV_MM(0, la, ha); AT_SBAR();
    AT_PV_RD(2, la, ha);
    asm volatile("s_waitcnt lgkmcnt(8)" ::: "memory"); AT_SBAR(); AT_PV_MM(1, lb, hb); AT_SBAR();
    AT_PV_RD(3, lb, hb);
    asm volatile("s_waitcnt lgkmcnt(8)" ::: "memory"); AT_SBAR(); AT_PV_MM(2, la, ha); AT_SBAR();
    asm volatile("s_waitcnt lgkmcnt(0)" ::: "memory"); AT_SBAR(); AT_PV_MM(3, lb, hb);
#undef AT_PV_RD
#undef AT_PV_MM
#undef AT_TRRD
}

__device__ __forceinline__ void attn_block(LAS unsigned char* lds, const bf16* Q, const bf16* K, const bf16* KV, const bf16* proj, bf16* YA, const float* qg, const float* cosT, const float* sinT, int b, int h, int qb) {
    const int tid = otid(), wid = __builtin_amdgcn_readfirstlane(tid >> 6), lane = tid & 63, r32 = lane & 31, hi = lane >> 5;
    const int P0 = qb * 256, NT = 4 * (qb + 1), qlo = P0 + wid * 32;
    LAS unsigned char* V_lds = lds + OFF_V; LAS unsigned char* K_lds = lds + OFF_K; LAS unsigned char* KR_lds = lds + OFF_KR;
    LAS float* wsf = (LAS float*)(lds + OFF_WS) + wid * 64; LAS float* li_l = wsf; LAS float* al_l = wsf + 32;
    bf16x8 qr[12];
    { const bf16* qp = Q + ((size_t)(b * SEQ + qlo + r32) * 8 + h) * 192 + hi * 8;
      bf16x8 raw[12];
#pragma unroll
      for (int d0 = 0; d0 < 12; ++d0) raw[d0] = *(const bf16x8*)(qp + d0 * 16);
      float ss = 0.f;
#pragma unroll
      for (int d0 = 0; d0 < 12; ++d0)
#pragma unroll
          for (int j = 0; j < 8; ++j) { const float v = bf2f((unsigned short)raw[d0][j]); ss += v * v; }
      { auto rr = __builtin_amdgcn_permlane32_swap(__float_as_uint(ss), __float_as_uint(ss), false, false); ss = __uint_as_float(rr[0]) + __uint_as_float(rr[1]); }
      const float rn = 1.0f / sqrtf(ss * (1.0f / 192.f) + EPS);
      const float* ct = cosT + (size_t)(b * SEQ + qlo + r32) * 32 + hi * 8; const float* st = sinT + (size_t)(b * SEQ + qlo + r32) * 32 + hi * 8;
#pragma unroll
      for (int d0 = 0; d0 < 8; ++d0) { const v4f g0 = *(const v4f*)(qg + d0 * 16 + hi * 8), g1 = *(const v4f*)(qg + d0 * 16 + hi * 8 + 4);
          const float g[8] = {g0.x, g0.y, g0.z, g0.w, g1.x, g1.y, g1.z, g1.w}; float x[8];
#pragma unroll
          for (int j = 0; j < 8; ++j) x[j] = bf2f((unsigned short)raw[d0][j]) * rn * g[j];
          u32x4 w = {cvtpk(x[0], x[1]), cvtpk(x[2], x[3]), cvtpk(x[4], x[5]), cvtpk(x[6], x[7])}; qr[d0] = *reinterpret_cast<bf16x8*>(&w); }
#pragma unroll
      for (int d0 = 8; d0 < 10; ++d0) { const int i0 = (d0 - 8) * 16;
          const v4f ga0 = *(const v4f*)(qg + d0 * 16 + hi * 8), ga1 = *(const v4f*)(qg + d0 * 16 + hi * 8 + 4), gb0 = *(const v4f*)(qg + (d0 + 2) * 16 + hi * 8), gb1 = *(const v4f*)(qg + (d0 + 2) * 16 + hi * 8 + 4);
          const v4f c0 = *(const v4f*)(ct + i0), c1 = *(const v4f*)(ct + i0 + 4), s0 = *(const v4f*)(st + i0), s1 = *(const v4f*)(st + i0 + 4);
          const float ga[8] = {ga0.x, ga0.y, ga0.z, ga0.w, ga1.x, ga1.y, ga1.z, ga1.w}, gb[8] = {gb0.x, gb0.y, gb0.z, gb0.w, gb1.x, gb1.y, gb1.z, gb1.w};
          const float cs[8] = {c0.x, c0.y, c0.z, c0.w, c1.x, c1.y, c1.z, c1.w}, sn[8] = {s0.x, s0.y, s0.z, s0.w, s1.x, s1.y, s1.z, s1.w};
          float y1[8], y2[8];
#pragma unroll
          for (int j = 0; j < 8; ++j) { const float x1 = bf2f((unsigned short)raw[d0][j]) * rn * ga[j], x2 = bf2f((unsigned short)raw[d0 + 2][j]) * rn * gb[j];
              y1[j] = x1 * cs[j] - x2 * sn[j]; y2[j] = x2 * cs[j] + x1 * sn[j]; }
          u32x4 w1 = {cvtpk(y1[0], y1[1]), cvtpk(y1[2], y1[3]), cvtpk(y1[4], y1[5]), cvtpk(y1[6], y1[7])}; qr[d0] = *reinterpret_cast<bf16x8*>(&w1);
          u32x4 w2 = {cvtpk(y2[0], y2[1]), cvtpk(y2[2], y2[3]), cvtpk(y2[4], y2[5]), cvtpk(y2[6], y2[7])}; qr[d0 + 2] = *reinterpret_cast<bf16x8*>(&w2); }
    }
    const int sr = tid >> 4, sc = (tid & 15) * 8, kws = AT_KSWZ(sr, sc * 2), vst0 = v_st(sr, sc), vst1 = v_st(32 + sr, sc);
    const int rr = tid >> 3, rc = (tid & 7) * 8, krws = AT_KRSWZ(rr, rc * 2);
    const bf16* Kg = K + ((size_t)(b * SEQ) * 8 + h) * 192;
    const bf16* Vg = KV + (size_t)(b * SEQ) * 2048 + h * 256 + 128;
    bf16x8 sa_k0, sa_k1, sa_kr, sa_v0, sa_v1, sb_k0, sb_k1, sb_kr, sb_v0, sb_v1;
#define AT_SLOAD(S, kb_) do { S##_k0 = *(const bf16x8*)(Kg + (size_t)((kb_) + sr) * 1536 + sc); S##_k1 = *(const bf16x8*)(Kg + (size_t)((kb_) + 32 + sr) * 1536 + sc); \
        S##_kr = *(const bf16x8*)(Kg + (size_t)((kb_) + rr) * 1536 + 128 + rc); \
        S##_v0 = *(const bf16x8*)(Vg + (size_t)((kb_) + sr) * 2048 + sc); S##_v1 = *(const bf16x8*)(Vg + (size_t)((kb_) + 32 + sr) * 2048 + sc); } while (0)
#define AT_SWRITE(S, bf, vbf) do { *(LAS bf16x8*)(K_lds + (bf) * SHM_K + kws) = S##_k0; *(LAS bf16x8*)(K_lds + (bf) * SHM_K + kws + 32 * 256) = S##_k1; \
        *(LAS bf16x8*)(KR_lds + (bf) * SHM_KR + krws) = S##_kr; \
        *(LAS bf16x8*)(V_lds + (vbf) * SHM_V + vst0) = S##_v0; *(LAS bf16x8*)(V_lds + (vbf) * SHM_V + vst1) = S##_v1; } while (0)
    AT_SLOAD(sa, 0); AT_SLOAD(sb, 64); AT_SWRITE(sa, 0, 0);
    __syncthreads();
    float m_reg = -1e30f, l_reg = 0.f; f32x16 o[4] = {};
    const unsigned vbase = (unsigned)(size_t)V_lds + (unsigned)v_rd_base(lane);
    const bool late = wid >= 4;
    bool pend = false; int pvb = 0; int vb3 = 0;
    bf16x8 pa0, pa1, pa2, pa3;
#define AT_STEP(t, SL, SW) do { \
        const int buf = (t) & 1, kb = (t) * 64; \
        if ((t) + 2 < NT) AT_SLOAD(SL, kb + 128);                         \
        if (late && pend) { pv_tile(o, vbase + pvb * SHM_V, pa0, pa1, pa2, pa3); pend = false; AT_SBAR(); } \
        if (kb <= qlo + 31) { \
            f32x16 p0, p1; float mn, alpha; \
            qkt(p0, p1, K_lds + buf * SHM_K, KR_lds + buf * SHM_KR, r32, hi, qr); \
            if (kb + 63 > qlo) mask_tile(p0, p1, qlo + r32 - 4 * hi - kb); \
            partialSM(p0, p1, m_reg, mn, alpha); \
            finishSM(p0, p1, alpha, l_reg, pa0, pa1, pa2, pa3); \
            if (__any(alpha < 1.f)) { if (hi == 0) al_l[r32] = alpha; asm volatile("s_waitcnt lgkmcnt(0)" ::: "memory"); \
                _Pragma("unroll") for (int d_ = 0; d_ < 4; ++d_) _Pragma("unroll") for (int r = 0; r < 16; ++r) o[d_][r] *= al_l[crow(r, hi)]; \
                asm volatile("s_waitcnt lgkmcnt(0)" ::: "memory"); } \
            AT_SBAR(); \
            if (late) { pend = true; pvb = vb3; } \
            else pv_tile(o, vbase + vb3 * SHM_V, pa0, pa1, pa2, pa3); \
        } \
        const int vn3 = vb3 == 2 ? 0 : vb3 + 1; \
        if ((t) + 1 < NT) AT_SWRITE(SW, buf ^ 1, vn3);                    \
        vb3 = vn3; \
        __syncthreads(); } while (0)
    for (int t = 0; t < NT; t += 2) { AT_STEP(t, sa, sb); AT_STEP(t + 1, sb, sa); }
#undef AT_STEP
    if (late && pend) pv_tile(o, vbase + pvb * SHM_V, pa0, pa1, pa2, pa3);
    if (hi == 0) li_l[r32] = l_reg;
    asm volatile("s_waitcnt lgkmcnt(0)" ::: "memory");
    float rli[16];
#pragma unroll
    for (int r = 0; r < 16; ++r) rli[r] = 1.0f / li_l[crow(r, hi)];
#pragma unroll
    for (int d0 = 0; d0 < 4; ++d0) { const int col = h * 128 + d0 * 32 + r32;
        unsigned short zr[16];
#pragma unroll
        for (int r = 0; r < 16; ++r) zr[r] = proj[(size_t)(b * SEQ + qlo + crow(r, hi)) * NPROJ + C_ZA + col];
#pragma unroll
        for (int r = 0; r < 16; ++r) { const int row = b * SEQ + qlo + crow(r, hi);
            const float v = o[d0][r] * rli[r] * silu_f(bf2f(zr[r]));
            const float vn = lane_xor<1>(v);
            if ((r32 & 1) == 0) *(unsigned*)(YA + (size_t)row * 1024 + col) = cvtpk(v, vn); } }
    asm volatile("s_waitcnt lgkmcnt(0)" ::: "memory");
    __syncthreads();
#undef AT_SLOAD
#undef AT_SWRITE
}
}


namespace sg {
using at::bf16x8; using at::f32x16;
__device__ __forceinline__ void sgu_item(LAS unsigned char* lds, const bf16* proj, const float* rv, const float* Ws, const float* bs, const float* vg, bf16* YB, int it) {
    const int tid = otid(), wid = __builtin_amdgcn_readfirstlane(tid >> 6), lane = tid & 63, r32 = lane & 31, hi = lane >> 5;
    {
        const int ch = it >> 2, gp = it & 3, R0 = ch * 128;
#pragma unroll
        for (int i = 0; i < 8; ++i) {
            const int idx = tid + 512 * i, gsel = idx >> 11, row = (idx >> 4) & 127, cc = idx & 15;
            const v4u w = *(const v4u*)(proj + (size_t)(R0 + row) * NPROJ + C_VB + (2 * gp + gsel) * 128 + cc * 8);
            const float s = 1.0f / sqrtf(rv[R0 + row] * (1.0f / 1024.f) + EPS);
            v4u o; o.x = pk2(gelu_f(lo16(w.x)) * s, gelu_f(hi16(w.x)) * s); o.y = pk2(gelu_f(lo16(w.y)) * s, gelu_f(hi16(w.y)) * s);
            o.z = pk2(gelu_f(lo16(w.z)) * s, gelu_f(hi16(w.z)) * s); o.w = pk2(gelu_f(lo16(w.w)) * s, gelu_f(hi16(w.w)) * s);
            *(LAS v4u*)(lds + (gsel * 2 + (row >> 6)) * 16384 + at::v_st(row & 63, cc * 8)) = o;
        }
        __syncthreads();
        const int gsel = wid >> 2, g = 2 * gp + gsel, t = 32 * (wid & 3) + r32;
        f32x16 o[4] = {};
        const int nst = (wid & 3) >= 2 ? 2 : 1;
        for (int st = 0; st < nst; ++st) {
            bf16x8 pa[4];
#pragma unroll
            for (int ks = 0; ks < 4; ++ks) {
                const int s0 = st * 64 + ks * 16 + hi * 8;
                const float* wp = Ws + ((size_t)g * 128 + t) * 128 + s0;
                const v4f a = *(const v4f*)wp, b = *(const v4f*)(wp + 4);
                float x[8] = {a.x, a.y, a.z, a.w, b.x, b.y, b.z, b.w};
#pragma unroll
                for (int j = 0; j < 8; ++j) if (s0 + j > t) x[j] = 0.f;
                at::u32x4 w4 = {at::cvtpk(x[0], x[1]), at::cvtpk(x[2], x[3]), at::cvtpk(x[4], x[5]), at::cvtpk(x[6], x[7])};
                pa[ks] = *reinterpret_cast<bf16x8*>(&w4);
            }
            const unsigned vbase = (unsigned)(size_t)(lds + (gsel * 2 + st) * 16384) + (unsigned)at::v_rd_base(lane);
            at::pv_tile(o, vbase, pa[0], pa[1], pa[2], pa[3]);
        }
#pragma unroll
        for (int d0 = 0; d0 < 4; ++d0) { const int gc = g * 128 + d0 * 32 + r32; const float vgc = vg[gc];
            unsigned short ur[16], zr[16];
#pragma unroll
            for (int r = 0; r < 16; ++r) { const size_t row = (size_t)(R0 + 32 * (wid & 3) + at::crow(r, hi)); ur[r] = proj[row * NPROJ + C_UB + gc]; zr[r] = proj[row * NPROJ + C_ZB + gc]; }
#pragma unroll
            for (int r = 0; r < 16; ++r) { const int tl = 32 * (wid & 3) + at::crow(r, hi); const size_t row = (size_t)(R0 + tl);
                const float mix = o[d0][r] * vgc + bs[g * 128 + tl];
                const float y = gelu_f(bf2f(ur[r])) * mix * silu_f(bf2f(zr[r])), yn = lane_xor<1>(y);
                if ((r32 & 1) == 0) *(unsigned*)(YB + row * 1024 + gc) = at::cvtpk(y, yn); } }
        __syncthreads();
    }
}
}


namespace gl {
using at::bf16x8; using at::f32x16; using at::s16x4; using at::u32x4;
constexpr int OFF_VIMG = 0, OFF_KLIMG = 65536, OFF_ATT = 98304, OFF_DS = 131072, OFF_PART = 131584, LDS_NEED = OFF_PART + 4096;

__device__ __forceinline__ void gla_prep_item(LAS unsigned char* lds, int seg_off, const bf16* proj, const float* wa2, const float* ba, bf16* QE, bf16* KE, bf16* KL, float* DS, int ci) {
    const int tid = otid(), k2 = tid & 63, ts = tid >> 6, k = 2 * k2;
    LAS float* seg = (LAS float*)(lds + seg_off);
    {
        const int ch = ci >> 2, h = ci & 3, R0 = ch * 128 + ts * 16;
        float wa0[16], wa1[16];
#pragma unroll
        for (int j = 0; j < 16; ++j) { const v2f w = *(const v2f*)(wa2 + j * 512 + h * 128 + k); wa0[j] = w.x; wa1[j] = w.y; }
        const v2f bak = *(const v2f*)(ba + h * 128 + k);
        float la0[16], la1[16]; float run0 = 0.f, run1 = 0.f;
#pragma unroll
        for (int i = 0; i < 16; ++i) {
            const bf16* pr = proj + (size_t)(R0 + i) * NPROJ + C_AR;
            const v4u w0 = *(const v4u*)pr, w1 = *(const v4u*)(pr + 8);
            const float ar[16] = {lo16(w0.x), hi16(w0.x), lo16(w0.y), hi16(w0.y), lo16(w0.z), hi16(w0.z), lo16(w0.w), hi16(w0.w),
                                  lo16(w1.x), hi16(w1.x), lo16(w1.y), hi16(w1.y), lo16(w1.z), hi16(w1.z), lo16(w1.w), hi16(w1.w)};
            float x0 = bak.x, x1 = bak.y;
#pragma unroll
            for (int j = 0; j < 16; ++j) { x0 += ar[j] * wa0[j]; x1 += ar[j] * wa1[j]; }
            run0 += (fminf(x0, 0.f) - __logf(1.0f + __expf(-fabsf(x0)))) * 0.0625f; la0[i] = run0;
            run1 += (fminf(x1, 0.f) - __logf(1.0f + __expf(-fabsf(x1)))) * 0.0625f; la1[i] = run1;
        }
        *(LAS v2f*)(seg + ts * 128 + k) = (v2f){run0, run1};
        __syncthreads();
        float pre0 = 0.f, pre1 = 0.f, tot0 = 0.f, tot1 = 0.f;
#pragma unroll
        for (int q = 0; q < 8; ++q) { const v2f sg = *(const LAS v2f*)(seg + q * 128 + k); tot0 += sg.x; tot1 += sg.y; if (q < ts) { pre0 += sg.x; pre1 += sg.y; } }
        const float et0 = __expf(tot0), et1 = __expf(tot1);
        unsigned qw[16], kw[16];
#pragma unroll
        for (int i = 0; i < 16; ++i) { const size_t row = (size_t)(R0 + i); qw[i] = *(const unsigned*)(proj + row * NPROJ + C_QC + h * 128 + k); kw[i] = *(const unsigned*)(proj + row * NPROJ + C_KC + h * 128 + k); }
#pragma unroll
        for (int i = 0; i < 16; ++i) {
            const size_t o = (size_t)(R0 + i) * 512 + h * 128 + k;
            const float e0 = __expf(la0[i] + pre0), e1 = __expf(la1[i] + pre1), r0 = __builtin_amdgcn_rcpf(e0), r1 = __builtin_amdgcn_rcpf(e1);
            const float q0 = lo16(qw[i]) * 0.08838834764831845f, q1 = hi16(qw[i]) * 0.08838834764831845f, kk0 = lo16(kw[i]) * r0, kk1 = hi16(kw[i]) * r1;
            *(unsigned*)(QE + o) = pk2(q0 * e0, q1 * e1);
            *(unsigned*)(KE + o) = pk2(kk0, kk1);
            *(unsigned*)(KL + o) = pk2(kk0 * et0, kk1 * et1);
        }
        if (ts == 0) *(v2f*)(DS + ((size_t)ch * 4 + h) * 128 + k) = (v2f){et0, et1};
        __syncthreads();
    }
}

#define GL_PK4(P, B_, OUT) do { unsigned a0 = at::cvtpk(P[B_+0], P[B_+1]), a1 = at::cvtpk(P[B_+2], P[B_+3]);                          \
        unsigned b0 = at::cvtpk(P[B_+4], P[B_+5]), b1 = at::cvtpk(P[B_+6], P[B_+7]);                                             \
        auto r0 = __builtin_amdgcn_permlane32_swap(a0, b0, false, false); auto r1 = __builtin_amdgcn_permlane32_swap(a1, b1, false, false); \
        u32x4 w = {r0[0], r1[0], r0[1], r1[1]}; OUT = *reinterpret_cast<bf16x8*>(&w); } while (0)
#define GL_TRRD(dst, addr, off) asm volatile("ds_read_b64_tr_b16 %0, %1 offset:%2" : "=&v"(dst) : "v"(addr), "i"(off) : "memory")

__device__ __forceinline__ void gla_chunk_item(LAS unsigned char* lds, const bf16* proj, const bf16* QE, const bf16* KE, const bf16* KL, float* OI, float* DL, int ci) {
    const int tid = otid(), wid = __builtin_amdgcn_readfirstlane(tid >> 6), lane = tid & 63, r32 = lane & 31, hi = lane >> 5;
    const int h = ci & 3, R0 = (ci >> 2) * 128;
    {
        {
#pragma unroll
            for (int i = 0; i < 8; ++i) { const int idx = tid + 512 * i, s = idx >> 5, cc = idx & 31;
                const v4u w = *(const v4u*)(proj + (size_t)(R0 + s) * NPROJ + C_VC + h * 256 + cc * 8);
                *(LAS v4u*)(lds + OFF_VIMG + ((s >> 6) * 2 + (cc >> 4)) * 16384 + at::v_st(s & 63, (cc & 15) * 8)) = w; }
#pragma unroll
            for (int i = 0; i < 4; ++i) { const int idx = tid + 512 * i, s = idx >> 4, cc = idx & 15;
                const v4u w = *(const v4u*)(KL + (size_t)(R0 + s) * 512 + h * 128 + cc * 8);
                *(LAS v4u*)(lds + OFF_KLIMG + (s >> 6) * 16384 + at::v_st(s & 63, cc * 8)) = w; }
#pragma unroll
            for (int j = 0; j < 2; ++j) {
                const int ti = 2 * wid + j, st = ti >> 2, tt = ti & 3;
                if (st <= tt) {
                    f32x16 p = {};
                    const bf16* ap = KE + (size_t)(R0 + 32 * st + r32) * 512 + h * 128 + hi * 8;
                    const bf16* bp = QE + (size_t)(R0 + 32 * tt + r32) * 512 + h * 128 + hi * 8;
                    bf16x8 fa[8], fb[8];
#pragma unroll
                    for (int ks = 0; ks < 8; ++ks) { fa[ks] = *(const bf16x8*)(ap + ks * 16); fb[ks] = *(const bf16x8*)(bp + ks * 16); }
#pragma unroll
                    for (int ks = 0; ks < 8; ++ks) p = __builtin_amdgcn_mfma_f32_32x32x16_bf16(fa[ks], fb[ks], p, 0, 0, 0);
                    __builtin_amdgcn_sched_group_barrier(0x020, 16, 0); __builtin_amdgcn_sched_group_barrier(0x008, 8, 0);
                    if (st == tt) {
#pragma unroll
                        for (int r = 0; r < 16; ++r) if (at::crow(r, hi) > r32) p[r] = 0.f; }
                    const int t = 32 * tt + r32;
#pragma unroll
                    for (int g = 0; g < 4; ++g) { v2u w; w.x = at::cvtpk(p[4 * g], p[4 * g + 1]); w.y = at::cvtpk(p[4 * g + 2], p[4 * g + 3]);
                        *(LAS v2u*)(lds + OFF_ATT + t * 256 + ((64 * st + 16 * g) ^ ((t & 7) << 4)) + 8 * hi) = w; }
                }
            }
            __syncthreads();
            bf16x8 vfr[8];
            { const unsigned vaddr = (unsigned)(size_t)(lds + OFF_VIMG + (wid >> 2) * 16384) + (unsigned)at::v_rd_base(lane) + (unsigned)((wid & 3) * 512);
              s16x4 vl[8], vh[8];
#define GL_VF(ks8) do { constexpr int o_ = ((ks8) >> 2) * 32768 + ((ks8) & 3) * 4096; GL_TRRD(vl[ks8], vaddr, o_); GL_TRRD(vh[ks8], vaddr, o_ + 2048); } while (0)
              GL_VF(0); GL_VF(1); GL_VF(2); GL_VF(3); GL_VF(4); GL_VF(5); GL_VF(6); GL_VF(7);
#undef GL_VF
              asm volatile("s_waitcnt lgkmcnt(0)" ::: "memory"); AT_SBAR();
#pragma unroll
              for (int q = 0; q < 8; ++q) vfr[q] = (bf16x8){vl[q][0], vl[q][1], vl[q][2], vl[q][3], vh[q][0], vh[q][1], vh[q][2], vh[q][3]};
              AT_SBAR(); }
            float* oi = OI + (((size_t)ci * 8 + wid) * 16 * 64 + lane) * 4;
            float* dl = DL + (((size_t)ci * 8 + wid) * 16 * 64 + lane) * 4;
#pragma unroll
            for (int tt = 0; tt < 4; ++tt) {
                f32x16 acc = {};
                const int t = 32 * tt + r32;
#pragma unroll
                for (int ks8 = 0; ks8 < 8; ++ks8) if (ks8 <= 2 * tt + 1) {
                    const bf16x8 a = *(const LAS bf16x8*)(lds + OFF_ATT + t * 256 + (((16 * ks8 + 8 * hi) * 2) ^ ((t & 7) << 4)));
                    acc = __builtin_amdgcn_mfma_f32_32x32x16_bf16(a, vfr[ks8], acc, 0, 0, 0); }
#pragma unroll
                for (int r4 = 0; r4 < 4; ++r4) *(v4f*)(oi + (size_t)(tt * 4 + r4) * 256) = (v4f){acc[4 * r4], acc[4 * r4 + 1], acc[4 * r4 + 2], acc[4 * r4 + 3]};
            }
#pragma unroll
            for (int kt = 0; kt < 4; ++kt) {
                f32x16 D = {};
                const unsigned kaddr = (unsigned)(size_t)(lds + OFF_KLIMG) + (unsigned)at::v_rd_base(lane) + (unsigned)(kt * 512);
#define GL_KF(ks8) do { s16x4 l_, h_; constexpr int o_ = ((ks8) >> 2) * 16384 + ((ks8) & 3) * 4096; GL_TRRD(l_, kaddr, o_); GL_TRRD(h_, kaddr, o_ + 2048); \
                asm volatile("s_waitcnt lgkmcnt(0)" ::: "memory"); AT_SBAR(); \
                D = __builtin_amdgcn_mfma_f32_32x32x16_bf16((bf16x8){l_[0], l_[1], l_[2], l_[3], h_[0], h_[1], h_[2], h_[3]}, vfr[ks8], D, 0, 0, 0); } while (0)
                GL_KF(0); GL_KF(1); GL_KF(2); GL_KF(3); GL_KF(4); GL_KF(5); GL_KF(6); GL_KF(7);
#undef GL_KF
#pragma unroll
                for (int r4 = 0; r4 < 4; ++r4) *(v4f*)(dl + (size_t)(kt * 4 + r4) * 256) = (v4f){D[4 * r4], D[4 * r4 + 1], D[4 * r4 + 2], D[4 * r4 + 3]};
            }
            __syncthreads();
        }
    }
}

__device__ __forceinline__ void gla_stageA_item(const float* DS, const float* DL, bf16* XB, int b, int h, int vp) {
    const int tid = otid(), wid = __builtin_amdgcn_readfirstlane(tid >> 6), lane = tid & 63, hi = lane >> 5;
    const int vb = 2 * vp + (wid >> 2), kt = wid & 3;
    constexpr int PF = 4, NC = SEQ / 128;
    f32x16 X = {};
    v4f dq[PF][4], sq[PF][4];
    const size_t ci0 = (size_t)(b * 32) * 4 + h;
#define GL_ALOAD(slot, c_) do { const size_t ci_ = ci0 + (size_t)(c_) * 4; const float* dl_ = DL + ((ci_ * 8 + vb) * 16 * 64 + lane) * 4 + (size_t)(kt * 4) * 256; const float* ds_ = DS + ci_ * 128 + 32 * kt + 4 * hi; \
        _Pragma("unroll") for (int r4 = 0; r4 < 4; ++r4) { dq[slot][r4] = *(const v4f*)(dl_ + (size_t)r4 * 256); sq[slot][r4] = *(const v4f*)(ds_ + 8 * r4); } } while (0)
#pragma unroll
    for (int s = 0; s < PF; ++s) GL_ALOAD(s, s);
    for (int c0 = 0; c0 < NC; c0 += PF) {
#pragma unroll
        for (int s = 0; s < PF; ++s) {
            const int c = c0 + s; const size_t ci = ci0 + (size_t)c * 4;
            bf16* xo = XB + (((ci * 8 + vb) * 8 + kt * 2) * 64 + lane) * 8;
            bf16x8 xb0, xb1; GL_PK4(X, 0, xb0); GL_PK4(X, 8, xb1);
            *(bf16x8*)xo = xb0; *(bf16x8*)(xo + 512) = xb1;
#pragma unroll
            for (int r4 = 0; r4 < 4; ++r4) { const v4f w = dq[s][r4], d4 = sq[s][r4];
                X[4 * r4] = X[4 * r4] * d4.x + w.x; X[4 * r4 + 1] = X[4 * r4 + 1] * d4.y + w.y; X[4 * r4 + 2] = X[4 * r4 + 2] * d4.z + w.z; X[4 * r4 + 3] = X[4 * r4 + 3] * d4.w + w.w; }
            if (c + PF < NC) GL_ALOAD(s, c + PF);
        }
    }
#undef GL_ALOAD
}
__device__ __forceinline__ void gla_stageB_item(const bf16* proj, const bf16* QE, const float* OI, const bf16* XB, const float* og, bf16* YC, int b, int h, int cp) {
    const int tid = otid(), wid = __builtin_amdgcn_readfirstlane(tid >> 6), lane = tid & 63, r32 = lane & 31, hi = lane >> 5;
    {
        const int c = 2 * cp + (wid >> 2), tt = wid & 3, R0 = b * SEQ + c * 128;
        const size_t ci = (size_t)(b * 32 + c) * 4 + h;
        f32x16 acc[8];
#pragma unroll
        for (int vb = 0; vb < 8; ++vb) { const float* oi = OI + ((ci * 8 + vb) * 16 * 64 + lane) * 4 + (size_t)(tt * 4) * 256;
#pragma unroll
            for (int r4 = 0; r4 < 4; ++r4) { const v4f w = *(const v4f*)(oi + (size_t)r4 * 256); acc[vb][4 * r4] = w.x; acc[vb][4 * r4 + 1] = w.y; acc[vb][4 * r4 + 2] = w.z; acc[vb][4 * r4 + 3] = w.w; } }
        bf16x8 qa[8];
        { const bf16* qp = QE + (size_t)(R0 + 32 * tt + r32) * 512 + h * 128 + hi * 8;
#pragma unroll
          for (int ks = 0; ks < 8; ++ks) qa[ks] = *(const bf16x8*)(qp + ks * 16); }
        if (c > 0) {
            const bf16* xi = XB + (((ci * 8) * 8) * 64 + lane) * 8;
            bf16x8 xf[64];
#pragma unroll
            for (int i = 0; i < 64; ++i) xf[i] = *(const bf16x8*)(xi + (size_t)i * 512);
#pragma unroll
            for (int i = 0; i < 64; ++i) acc[i >> 3] = __builtin_amdgcn_mfma_f32_32x32x16_bf16(qa[i & 7], xf[i], acc[i >> 3], 0, 0, 0);
            __builtin_amdgcn_sched_group_barrier(0x020, 16, 0);
#pragma unroll
            for (int i = 0; i < 48; ++i) { __builtin_amdgcn_sched_group_barrier(0x008, 1, 0); __builtin_amdgcn_sched_group_barrier(0x020, 1, 0); }
            __builtin_amdgcn_sched_group_barrier(0x008, 16, 0);
        }
        float rn[16];
#pragma unroll
        for (int r = 0; r < 16; ++r) { float s = 0.f;
#pragma unroll
            for (int vb = 0; vb < 8; ++vb) s += acc[vb][r] * acc[vb][r];
            s += lane_xor<1>(s); s += lane_xor<2>(s); s += lane_xor<4>(s); s += lane_xor<8>(s); s += lane_xor<16>(s);
            rn[r] = 1.0f / sqrtf(s * (1.0f / 256.f) + EPS); }
#pragma unroll
        for (int vb = 0; vb < 8; ++vb) { const float gcol = og[32 * vb + r32];
            unsigned short zr[16];
#pragma unroll
            for (int r = 0; r < 16; ++r) zr[r] = proj[(size_t)(R0 + 32 * tt + at::crow(r, hi)) * NPROJ + C_ZC + h * 256 + 32 * vb + r32];
#pragma unroll
            for (int r = 0; r < 16; ++r) { const size_t row = (size_t)(R0 + 32 * tt + at::crow(r, hi));
                const float y = acc[vb][r] * rn[r] * gcol * silu_f(bf2f(zr[r])), yn = lane_xor<1>(y);
                if ((r32 & 1) == 0) *(unsigned*)(YC + row * 1024 + h * 256 + 32 * vb + r32) = at::cvtpk(y, yn); } }
    }
}
#undef GL_PK4
#undef GL_TRRD
}


constexpr int CW_Q = 65536;
__device__ __forceinline__ int q_pop(unsigned* ctr, LAS unsigned* slot) {
    if (otid() == 0) *slot = __hip_atomic_fetch_add(ctr, 1u, __ATOMIC_RELAXED, __HIP_MEMORY_SCOPE_AGENT);
    __syncthreads(); const int v = (int)*slot; __syncthreads(); return v; }
__device__ __forceinline__ void ph_mixers(LAS unsigned char* lds, unsigned char* ws, unsigned* qctr, const float* Ws, const float* bs, const float* vg, const float* og, const float* qg, int row0, int vb) {
    constexpr int NGLA = NBP * 8, NATT = 16 * NBP, NSGU = 16 * NBP, NQ = NGLA + NATT + NSGU;
    static_assert(NBP % 2 == 0, "NBP even");
    LAS unsigned* slot = (LAS unsigned*)(lds + LDSCTL_OFF + 64);
    bf16* proj = (bf16*)(ws + WS_PROJ);
    for (int dq = 0; dq < 8; ++dq) {
        const int q = (vb + dq) & 7;
        for (;;) {
            const int idx = q_pop(qctr + q * 64, slot);
            if (idx >= NQ) break;
            if (idx >= NATT && idx < NATT + NGLA) { const int gi = q * NGLA + (idx - NATT), bh = gi >> 4, cp = gi & 15;
                gl::gla_stageB_item(proj, (const bf16*)(ws + WS_QE), (const float*)(ws + WS_OC), (const bf16*)(ws + WS_XB), og, (bf16*)(ws + WS_YC), bh >> 2, bh & 3, cp); }
            else if (idx < NATT) { const int j = idx, qb = 15 - j / NBP, bh = q * NBP + j % NBP;
                at::attn_block(lds, (const bf16*)(ws + WS_Q), (const bf16*)(ws + WS_K), (const bf16*)(ws + WS_KV), proj, (bf16*)(ws + WS_YA), qg, (const float*)(ws + WS_COS) + (size_t)row0 * 32, (const float*)(ws + WS_SIN) + (size_t)row0 * 32, bh >> 3, bh & 7, qb); }
            else { const int it = q * NSGU + (idx - NGLA - NATT);
                sg::sgu_item(lds, proj, (const float*)(ws + WS_SSQ) + 2 * MP, Ws, bs, vg, (bf16*)(ws + WS_YB), it); }
        }
    }
}
#ifndef GEMM_SP2
#define GEMM_SP2 true
#endif
#ifndef GEMM_ALIGN
#define GEMM_ALIGN true
#endif
typedef const __attribute__((address_space(4))) Args* KArgP;
#define KARG() ({ KArgP p_ = (KArgP)__builtin_amdgcn_kernarg_segment_ptr(); asm volatile("" : "+s"(p_)); p_; })
#define INF(i) ((const float*)ap->in[i])
__device__ __forceinline__ void grid_bar(const XcdBarrier& b0) { XcdBarrier b = b0; asm volatile("" : "+s"(b.bar)); xcd_barrier(b); }

__global__ void __launch_bounds__(512, 2) fwd(Args a) {
    extern __shared__ __attribute__((aligned(16))) unsigned char lds_raw[];
    LAS unsigned char* lds = (LAS unsigned char*)lds_raw;
    const int lo = a.lo, hi = a.hi;
    XcdBarrier bar; bar.bar = (unsigned*)(a.ws + WS_CTL) + CW_BAR; bar.x = 0; bar.st = nullptr;
    if (hi - lo > 1) {
        if (threadIdx.x < 4) ((LAS unsigned*)(lds + LDSCTL_OFF))[threadIdx.x] = 0u;
        __syncthreads();
        bar = xcd_barrier_post((unsigned*)(a.ws + WS_CTL) + CW_BAR, (volatile LAS unsigned*)(lds + LDSCTL_OFF));
    }
    int step = 0;
#define PH_BEGIN if (step >= lo && step < hi) { const KArgP ap = KARG(); unsigned char* const ws = ap->ws; const int vb = obid(), nvb = gridDim.x; (void)ws; (void)vb; (void)nvb;
#define PH_END   if (step + 1 < hi) grid_bar(bar); } ++step;
#define WL(l) (ws + WS_W + (size_t)(l) * SZ_WLAYER)
#define B_(T, off) ((T*)(ws + (off)))

    for (int l = 0; l < DEPTH; ++l) {
        PH_BEGIN
            { unsigned char* wl = ws + WS_W;
              convert_T<1>(INF(3) + (size_t)l * DM * IN_COLS, DM, IN_COLS, (bf16*)wl, NBF, (LAS float*)lds, vb, nvb);
              convert_T8(INF(3) + (size_t)l * DM * IN_COLS, DM, IN_COLS, wl + SZ_WINB, NF8, (LAS float*)lds, (vb + 96) % nvb, nvb);
              convert_T<0>(INF(6) + (size_t)l * 512 * 1536, 512, 1536, (bf16*)(wl + SZ_WIN), 1536, (LAS float*)lds, (vb + 64) % nvb, nvb, INF(4) + l * 512);
              convert_T<0>(INF(7) + (size_t)l * 512 * 2048, 512, 2048, (bf16*)(wl + SZ_WIN + SZ_WUQ), 2048, (LAS float*)lds, (vb + 128) % nvb, nvb, INF(5) + l * 512);
              for (int b = 0; b < 3; ++b)
                  convert_T<0>(INF(16) + ((size_t)l * 3 + b) * 1024 * 2048, 1024, 2048, (bf16*)(wl + SZ_WIN + SZ_WUQ + SZ_WUKV) + (size_t)b * 2048 * 1024, 2048, (LAS float*)lds, (vb + 32 * b) % nvb, nvb);
              convert_T<0>(INF(17) + (size_t)l * 2048 * 2048, 2048, 2048, (bf16*)(wl + SZ_WIN + SZ_WUQ + SZ_WUKV + SZ_WB), 2048, (LAS float*)lds, (vb + 192) % nvb, nvb); }
            if (l == 0) { const int* positions = (const int*)ap->in[1]; float* cosT = B_(float, WS_COS); float* sinT = B_(float, WS_SIN);
              for (int idx = vb * 512 + otid(); idx < MTOK * 32; idx += nvb * 512) {
                const int t = idx >> 5, i = idx & 31;
                const float inv = 1.0f / powf(10000.0f, (float)(2 * i) * (1.0f / 64.0f));
                const float ang = (float)positions[t] * inv;
                float sn, cs; sincosf(ang, &sn, &cs);
                cosT[idx] = cs; sinT[idx] = sn; } }
        PH_END
        for (int p = 0; p < NPASS; ++p) {
            const int row0 = p * MP;
#define XIN ((l == 0 ? (const float*)ap->in[0] : (const float*)ap->out) + (size_t)row0 * DM)
#define WLP (ws + WS_W)
            PH_BEGIN ph_norm(XIN, INF(2) + l * DM, B_(bf16, WS_H), B_(unsigned char, WS_H8), MP, vb, nvb);
                     { float* ssq = B_(float, WS_SSQ); for (int i = vb * 512 + otid(); i < 3 * MP; i += nvb * 512) ssq[i] = 0.f; } PH_END
            PH_BEGIN { { pg8::Gemm g{B_(bf16, WS_H), (const bf16*)WLP, MP, NBF, DM}; pg8::StaticOrder S; S.init(MP, NBF, nvb, vb); pg8::EpiProj E{B_(bf16, WS_PROJ), NPROJ, B_(float, WS_SSQ), MP, 0};
                         pg8::gemm_phase<pg8::EpiProj, pg8::StaticOrder, false, GEMM_ALIGN, GEMM_SP2>(lds, g, S, E, nullptr); }
                       { pg8::Gemm g{(const bf16*)B_(unsigned char, WS_H8), (const bf16*)(WLP + SZ_WINB), MP, NF8, DM / 2}; pg8::StaticOrder S; S.init(MP, NF8, nvb, nvb - 1 - vb); pg8::EpiProj E{B_(bf16, WS_PROJ) + NBF, NPROJ, B_(float, WS_SSQ), MP, NBF / 256};
                         pg8::gemm_phase<pg8::EpiProj, pg8::StaticOrder, false, GEMM_ALIGN, GEMM_SP2, true>(lds, g, S, E, nullptr); } } PH_END
            PH_BEGIN { { pg8::Gemm g{B_(bf16, WS_PROJ) + C_CQ, (const bf16*)(WLP + SZ_WIN), MP, 1536, 512, NPROJ}; pg8::StaticOrder S; S.init(MP, 1536, nvb, vb); pg8::EpiBf16Row E{B_(bf16, WS_Q), 1536, B_(float, WS_SSQ), 1.0f / 512.f, EPS};
                         pg8::gemm_phase<pg8::EpiBf16Row, pg8::StaticOrder, false, GEMM_ALIGN, GEMM_SP2>(lds, g, S, E, nullptr); }
                       { pg8::Gemm g{B_(bf16, WS_PROJ) + C_CKV, (const bf16*)(WLP + SZ_WIN + SZ_WUQ), MP, 2048, 512, NPROJ}; pg8::StaticOrder S; S.init(MP, 2048, nvb, nvb - 1 - vb); pg8::EpiBf16Row E{B_(bf16, WS_KV), 2048, B_(float, WS_SSQ) + MP, 1.0f / 512.f, EPS};
                         pg8::gemm_phase<pg8::EpiBf16Row, pg8::StaticOrder, false, GEMM_ALIGN, GEMM_SP2>(lds, g, S, E, nullptr); }
                       for (int ci = vb; ci < (MP / 128) * 4; ci += nvb) {
                           gl::gla_prep_item(lds, 135168, B_(bf16, WS_PROJ), INF(13) + l * 16 * 512, INF(14) + l * 512, B_(bf16, WS_QE), B_(bf16, WS_KE), B_(bf16, WS_KL), B_(float, WS_DS), ci);
                           gl::gla_chunk_item(lds, B_(bf16, WS_PROJ), B_(bf16, WS_QE), B_(bf16, WS_KE), B_(bf16, WS_KL), B_(float, WS_OC), B_(float, WS_DL), ci); } } PH_END
            PH_BEGIN { constexpr int NA = NBP * 16;
                       if (nvb > 2 * NA) { if (vb < NA) gl::gla_stageA_item(B_(float, WS_DS), B_(float, WS_DL), B_(bf16, WS_XB), vb >> 4, (vb >> 2) & 3, vb & 3);
                                           else ph_kfin(B_(bf16, WS_KV), B_(bf16, WS_PROJ), B_(bf16, WS_K), INF(9) + l * 192, B_(float, WS_COS), B_(float, WS_SIN), row0, vb - NA, nvb - NA); }
                       else { for (int it = vb; it < NA; it += nvb) gl::gla_stageA_item(B_(float, WS_DS), B_(float, WS_DL), B_(bf16, WS_XB), it >> 4, (it >> 2) & 3, it & 3);
                              ph_kfin(B_(bf16, WS_KV), B_(bf16, WS_PROJ), B_(bf16, WS_K), INF(9) + l * 192, B_(float, WS_COS), B_(float, WS_SIN), row0, vb, nvb); } } PH_END
            PH_BEGIN ph_mixers(lds, ws, (unsigned*)(ws + WS_CTL) + CW_Q + (l * NPASS + p) * 8 * 64, INF(11) + (size_t)l * 8 * 128 * 128, INF(12) + l * 8 * 128, INF(10) + l * 1024, INF(15) + l * 256, INF(8) + l * 192, row0, vb); PH_END
            PH_BEGIN { pg8::Gemm g{B_(bf16, WS_YA), (const bf16*)(WLP + SZ_WIN + SZ_WUQ + SZ_WUKV), MP, 2048, 1024};
                       pg8::BranchOrder S; S.init(MP, 2048, nvb, vb); S.NB = 3; S.a_stride = (size_t)MP * 1024 * 2; S.b_stride = (size_t)2048 * 1024 * 2;
                       pg8::EpiMerge E{B_(bf16, WS_PROJ) + C_GATE, NPROJ, B_(bf16, WS_MG), 2048, 2048}; pg8::gemm_phase<pg8::EpiMerge, pg8::BranchOrder, false, GEMM_ALIGN, GEMM_SP2>(lds, g, S, E, nullptr); } PH_END
            PH_BEGIN { pg8::Gemm g{B_(bf16, WS_MG), (const bf16*)(WLP + SZ_WIN + SZ_WUQ + SZ_WUKV + SZ_WB), MP, 2048, 2048}; pg8::StaticOrder S; S.init(MP, 2048, nvb, vb); pg8::EpiRes E{XIN, ap->out + (size_t)row0 * DM, 2048};
                       pg8::gemm_phase<pg8::EpiRes, pg8::StaticOrder, false, GEMM_ALIGN, GEMM_SP2>(lds, g, S, E, nullptr); } PH_END
        }
    }
#undef PH_BEGIN
#undef PH_END
}

#ifndef ONE_LAUNCH
#define ONE_LAUNCH 1
#endif
extern "C" void kernel_launch(void* const* d_in, const int* in_sizes, int n_in, void* d_out, int out_size, void* d_ws, size_t ws_size, hipStream_t stream) {
    static int grid = 0;
    if (grid == 0) {
        if (n_in != 18 || out_size != MTOK * DM || ws_size < WS_END) { fprintf(stderr, "kernel_launch: unexpected shapes (n_in %d out %d ws %zu need %zu)\n", n_in, out_size, ws_size, (size_t)WS_END); grid = -1; return; }
        int dev = 0, cus = 0, per_cu = 0;
        if (hipGetDevice(&dev) != hipSuccess || hipDeviceGetAttribute(&cus, hipDeviceAttributeMultiprocessorCount, dev) != hipSuccess) { grid = -1; return; }
        if (hipFuncSetAttribute((const void*)fwd, hipFuncAttributeMaxDynamicSharedMemorySize, LDS_BYTES) != hipSuccess) { fprintf(stderr, "kernel_launch: hipFuncSetAttribute failed\n"); grid = -1; return; }
        if (hipOccupancyMaxActiveBlocksPerMultiprocessor(&per_cu, (const void*)fwd, 512, LDS_BYTES) != hipSuccess || per_cu < 1) { fprintf(stderr, "kernel_launch: occupancy query says %d\n", per_cu); }
        (void)hipGetLastError();
        grid = cus;
    }
    if (grid < 0) return;
    (void)hipMemsetAsync((char*)d_ws + WS_CTL, 0, CTL_BYTES, stream);
    Args a{};
    for (int i = 0; i < 18; ++i) a.in[i] = d_in[i];
    a.out = (float*)d_out; a.ws = (unsigned char*)d_ws; a.pad0 = 0; a.pad1 = 0;
#if ONE_LAUNCH
    a.lo = 0; a.hi = NSTEPS;
    hipLaunchKernelGGL(fwd, dim3(grid), dim3(512), LDS_BYTES, stream, a);
#else
    for (int s = 0; s < NSTEPS; ++s) { a.lo = s; a.hi = s + 1; hipLaunchKernelGGL(fwd, dim3(grid), dim3(512), LDS_BYTES, stream, a); }
#endif
}
```

```cpp
#include <hip/hip_runtime.h>
#include <cstdio>
#include <cstdint>
__device__ __forceinline__ int otid() { int t = threadIdx.x; asm volatile("" : "+v"(t)); return t; }
__device__ __forceinline__ int obid() { int t = blockIdx.x; asm volatile("" : "+s"(t)); return t; }
namespace pg8 {
#define PG8_LAS __attribute__((address_space(3)))
typedef unsigned short bf16_t;
typedef short bf16x8 __attribute__((ext_vector_type(8)));
typedef float f32x4 __attribute__((ext_vector_type(4)));
typedef unsigned u32x4 __attribute__((ext_vector_type(4)));
constexpr int BM = 256, BK = 64, HALF = 128, HTB = HALF * BK * 2  , STAGE_BYTES = 8 * HTB, NXCD = 8, WGM = 4;

__host__ __device__ __forceinline__ int lds_byte(int r, int c) { const int st = (r >> 4) * 2 + (c >> 5), rr = r & 15, cc = c & 31, ob = rr * 64 + cc * 2; return st * 1024 + (ob ^ (((ob >> 9) & 1) << 5)); }
__host__ __device__ __forceinline__ void stage_rc(int b, int& R, int& C) { const int st = b / 1024, sb = b % 1024, swz = sb ^ (((sb >> 9) & 1) << 5); R = (st >> 1) * 16 + swz / 64; C = (st & 1) * 32 + (swz % 64) / 2; }
__host__ __device__ __forceinline__ int perm32(int rho) { const int n = rho >> 4, i = rho & 15; return 8 * (i >> 2) + 4 * n + (i & 3); }

struct Unit { int pm, pn, pb; };
struct Gemm { const bf16_t* A; const bf16_t* Bt; int M, N, K; int lda; };

struct StaticOrder {
    int nM, nN, nwg, G, c, full = 1 << 30, skip = 0;
    __host__ __device__ void init(int M, int N, int G_, int c_) { nM = M / BM; nN = N / BM; nwg = nM * nN; G = G_; c = c_; }
    __host__ __device__ bool next(int i, Unit& u) const {
        long L; if (i < full) L = (long)i * G + c; else { if (c < skip) return false; L = (long)full * G + (long)(i - full) * (G - skip) + (c - skip); }
        if (L >= nwg) return false;
        int wgid = (int)L; { const int q = nwg / NXCD, r = nwg % NXCD, xcd = wgid % NXCD, off = wgid / NXCD; wgid = (xcd < r ? xcd * (q + 1) : r * (q + 1) + (xcd - r) * q) + off; }
        const int nig = WGM * nN, gid = wgid / nig, fm = gid * WGM, gsz = (nM - fm) < WGM ? (nM - fm) : WGM;
        u.pm = fm + ((wgid % nig) % gsz); u.pn = (wgid % nig) / gsz; u.pb = 0; return true;
    }
    __device__ __forceinline__ size_t a_off(const Unit&) const { return 0; }
    __device__ __forceinline__ size_t b_off(const Unit&) const { return 0; }
    __device__ __forceinline__ void a_ready(const Unit&) const {}
    __device__ __forceinline__ void done(const Unit&) const {}
};

struct BranchOrder : StaticOrder {
    int NB; size_t a_stride, b_stride;
    __device__ bool next(int i, Unit& u) const { const int ti = i / NB; if (!StaticOrder::next(ti, u)) return false; u.pb = i - ti * NB; return true; }
    __device__ __forceinline__ size_t a_off(const Unit& u) const { return (size_t)u.pb * a_stride; }
    __device__ __forceinline__ size_t b_off(const Unit& u) const { return (size_t)u.pb * b_stride; }
};

__device__ __forceinline__ unsigned cvt_pk_bf16(float lo, float hi) { unsigned r; asm volatile("v_cvt_pk_bf16_f32 %0, %1, %2" : "=v"(r) : "v"(lo), "v"(hi)); return r; }
__device__ __forceinline__ float gelu_tanh_f(float x) { const float u2 = 1.5957691216057308f * (x + 0.044715f * x * x * x); return x * __builtin_amdgcn_rcpf(1.f + __expf(-u2)); }
struct EpiProj {
    static constexpr bool PERM = true, AFTER_DRAIN = false;
    bf16_t* O; int ldc; float* SSQ; int mrows; int pn0;
    __device__ __forceinline__ void operator()(const f32x4 (&acc)[2][2][4][2], const Unit& u, int wr, int wc, int fr, int fq) const {
        const int row0 = u.pm * BM + wr * 64 + fr, col0 = u.pn * BM + wc * 32 + 8 * fq;
        const int apn = u.pn + pn0;
        const int seg = !SSQ ? -1 : ((apn == 25 || apn == 26) ? 0 : ((apn == 27 || apn == 28) ? 1 : ((apn >= 4 && apn < 8) ? 2 : -1)));
#pragma unroll
        for (int ai = 0; ai < 2; ++ai)
#pragma unroll
            for (int m = 0; m < 4; ++m) { const int row = row0 + ai * HALF + m * 16; bf16_t* rowp = O + (size_t)row * ldc + col0;
                float ss = 0.f;
#pragma unroll
                for (int bj = 0; bj < 2; ++bj) { const f32x4 v0 = acc[ai][bj][m][0], v1 = acc[ai][bj][m][1];
                    u32x4 w; w.x = cvt_pk_bf16(v0[0], v0[1]); w.y = cvt_pk_bf16(v0[2], v0[3]); w.z = cvt_pk_bf16(v1[0], v1[1]); w.w = cvt_pk_bf16(v1[2], v1[3]);
                    *(u32x4*)(rowp + bj * HALF) = w;
                    if (seg >= 0) {
#pragma unroll
                        for (int j = 0; j < 4; ++j) { float a = v0[j], b = v1[j]; if (seg == 2) { a = gelu_tanh_f(a); b = gelu_tanh_f(b); } ss += a * a + b * b; } } }
                if (seg >= 0) {
                    ss += __uint_as_float((unsigned)__builtin_amdgcn_ds_swizzle((int)__float_as_uint(ss), (16 << 10) | 0x1f));
                    auto rr = __builtin_amdgcn_permlane32_swap(__float_as_uint(ss), __float_as_uint(ss), false, false);
                    ss = __uint_as_float(rr[0]) + __uint_as_float(rr[1]);
                    if (fq == 0) atomicAdd(SSQ + (size_t)seg * mrows + row, ss); } }
    }
};
struct EpiBf16Row {
    static constexpr bool PERM = true, AFTER_DRAIN = false;
    bf16_t* O; int ldc; const float* SSQ; float inv_n, eps;
    __device__ __forceinline__ void operator()(const f32x4 (&acc)[2][2][4][2], const Unit& u, int wr, int wc, int fr, int fq) const {
        const int row0 = u.pm * BM + wr * 64 + fr, col0 = u.pn * BM + wc * 32 + 8 * fq;
#pragma unroll
        for (int ai = 0; ai < 2; ++ai)
#pragma unroll
            for (int m = 0; m < 4; ++m) { const int row = row0 + ai * HALF + m * 16; bf16_t* rowp = O + (size_t)row * ldc + col0;
                const float rn = 1.0f / sqrtf(SSQ[row] * inv_n + eps);
#pragma unroll
                for (int bj = 0; bj < 2; ++bj) { const f32x4 v0 = acc[ai][bj][m][0] * rn, v1 = acc[ai][bj][m][1] * rn;
                    u32x4 w; w.x = cvt_pk_bf16(v0[0], v0[1]); w.y = cvt_pk_bf16(v0[2], v0[3]); w.z = cvt_pk_bf16(v1[0], v1[1]); w.w = cvt_pk_bf16(v1[2], v1[3]);
                    *(u32x4*)(rowp + bj * HALF) = w; } }
    }
};

struct EpiRes {
    static constexpr bool PERM = false, AFTER_DRAIN = false;
    const float* base; float* C; int ldc;
    __device__ __forceinline__ void operator()(const f32x4 (&acc)[2][2][4][2], const Unit& u, int wr, int wc, int fr, int fq) const {
        const int row0 = u.pm * BM + wr * 64 + fr, col0 = u.pn * BM + wc * 32 + 4 * fq;
#pragma unroll
        for (int ai = 0; ai < 2; ++ai) {
            f32x4 bs[4][2][2];
#pragma unroll
            for (int m = 0; m < 4; ++m) { const size_t off = (size_t)(row0 + ai * HALF + m * 16) * ldc + col0;
#pragma unroll
                for (int bj = 0; bj < 2; ++bj)
#pragma unroll
                    for (int n = 0; n < 2; ++n) bs[m][bj][n] = *(const f32x4*)(base + off + bj * HALF + n * 16); }
#pragma unroll
            for (int m = 0; m < 4; ++m) { const size_t off = (size_t)(row0 + ai * HALF + m * 16) * ldc + col0;
#pragma unroll
                for (int bj = 0; bj < 2; ++bj)
#pragma unroll
                    for (int n = 0; n < 2; ++n) *(f32x4*)(C + off + bj * HALF + n * 16) = acc[ai][bj][m][n] + bs[m][bj][n]; }
            asm volatile("" ::: "memory");
        }
    }
};
struct EpiMerge {
    static constexpr bool PERM = true, AFTER_DRAIN = false;
    const bf16_t* G0; int ldg; bf16_t* MG; int ldc; int gstride;
    __device__ __forceinline__ void operator()(const f32x4 (&acc)[2][2][4][2], const Unit& u, int wr, int wc, int fr, int fq) const {
        const int row0 = u.pm * BM + wr * 64 + fr, col0 = u.pn * BM + wc * 32 + 8 * fq; const bf16_t* G = G0 + (size_t)u.pb * gstride; const bool first = u.pb == 0;
#pragma unroll
        for (int ai = 0; ai < 2; ++ai) {
            u32x4 gw[4][2], ow[4][2];
#pragma unroll
            for (int m = 0; m < 4; ++m) { const size_t row = (size_t)(row0 + ai * HALF + m * 16);
#pragma unroll
                for (int bj = 0; bj < 2; ++bj) { gw[m][bj] = *(const u32x4*)(G + row * ldg + col0 + bj * HALF); ow[m][bj] = first ? (u32x4){0u, 0u, 0u, 0u} : *(const u32x4*)(MG + row * ldc + col0 + bj * HALF); } }
#pragma unroll
            for (int m = 0; m < 4; ++m) { const size_t row = (size_t)(row0 + ai * HALF + m * 16);
#pragma unroll
                for (int bj = 0; bj < 2; ++bj) { const f32x4 v0 = acc[ai][bj][m][0], v1 = acc[ai][bj][m][1];
                    const unsigned g4[4] = {gw[m][bj].x, gw[m][bj].y, gw[m][bj].z, gw[m][bj].w}, o4[4] = {ow[m][bj].x, ow[m][bj].y, ow[m][bj].z, ow[m][bj].w};
                    const float a8[8] = {v0[0], v0[1], v0[2], v0[3], v1[0], v1[1], v1[2], v1[3]};
                    unsigned w4[4];
#pragma unroll
                    for (int q = 0; q < 4; ++q) {
                        const float g0 = __uint_as_float(g4[q] << 16), g1 = __uint_as_float(g4[q] & 0xffff0000u);
                        const float r0 = __uint_as_float(o4[q] << 16) + a8[2 * q] * __builtin_amdgcn_rcpf(1.0f + __expf(-g0));
                        const float r1 = __uint_as_float(o4[q] & 0xffff0000u) + a8[2 * q + 1] * __builtin_amdgcn_rcpf(1.0f + __expf(-g1));
                        unsigned pk; asm("v_cvt_pk_bf16_f32 %0, %1, %2" : "=v"(pk) : "v"(r0), "v"(r1)); w4[q] = pk; }
                    *(u32x4*)(MG + row * ldc + col0 + bj * HALF) = (u32x4){w4[0], w4[1], w4[2], w4[3]}; } }
            asm volatile("" ::: "memory");
        }
    }
};

typedef int pg8_v8i __attribute__((ext_vector_type(8)));
typedef int pg8_v4i __attribute__((ext_vector_type(4)));
template <class Epi, class Sched, bool STAMP = false, bool ALIGN_EPI = false, bool SP2 = false, bool FP8 = false>
__device__ __forceinline__ void gemm_phase(PG8_LAS unsigned char* lds, const Gemm g, const Sched& S, const Epi& E, unsigned long long* stamps) {
    const int tid = otid(), wid = __builtin_amdgcn_readfirstlane(tid >> 6), lane = tid & 63, wr = wid >> 2, wc = wid & 3, fr = lane & 15, fq = lane >> 4;
    const int K = g.K, nt = K / BK, LDA = g.lda ? g.lda : g.K;
    int ts_lo = 0, ts_hi = 0, nts = 0; const unsigned long long rt_entry = STAMP ? (unsigned long long)wall_clock64() : 0ull;
#define PG8_STAMP() do { if (STAMP && wid == 0 && nts < 64) { const unsigned long long _c = (unsigned long long)clock64(); \
        ts_lo = (lane == nts) ? (int)(unsigned)_c : ts_lo; ts_hi = (lane == nts) ? (int)(unsigned)(_c >> 32) : ts_hi; ++nts; } } while (0)
    PG8_STAMP();
    unsigned voffA[2], voffB[2];
#pragma unroll
    for (int i = 0; i < 2; ++i) { int R, C; stage_rc(tid * 16 + i * 8192, R, C); const int Rb = Epi::PERM ? ((R & ~31) + perm32(R & 31)) : R;
        voffA[i] = (unsigned)(R * LDA + C) * 2u; voffB[i] = (unsigned)(Rb * K + C) * 2u; }
    const size_t kstep = (size_t)(BK * 2);
    const size_t hstepB = (size_t)HALF * K * 2, hstepA = (size_t)HALF * LDA * 2;
    const size_t tstepB = 2 * hstepB, tstepA = 2 * hstepA;
    const unsigned ldsw = (unsigned)wid * 1024u;
    const int aoff = lds_byte(wr * 64 + fr, fq * 8), boff = lds_byte(wc * 32 + fr, fq * 8);
#define PG8_SA(b, h) (((b) * 2 + (h)) * HTB)
#define PG8_SB(b, h) ((4 + (b) * 2 + (h)) * HTB)
#define PG8_STAGE(bufoff, gbase, voff) do { _Pragma("unroll") for (int _i = 0; _i < 2; ++_i) \
        __builtin_amdgcn_global_load_lds((const unsigned*)((const char*)(gbase) + (voff)[_i]), (PG8_LAS unsigned*)(lds + (bufoff) + ldsw + _i * 8192), 16, 0, 0); } while (0)
#define PG8_I4(p) (*(const PG8_LAS pg8_v4i*)(p))
#define PG8_LDA(dst, b, h) do { if constexpr (FP8) { _Pragma("unroll") for (int m = 0; m < 4; ++m) dst##8[m] = __builtin_shufflevector(PG8_I4(lds + PG8_SA(b, h) + aoff + m * 2048), PG8_I4(lds + PG8_SA(b, h) + aoff + m * 2048 + 1024), 0, 1, 2, 3, 4, 5, 6, 7); } \
        else { _Pragma("unroll") for (int m = 0; m < 4; ++m) _Pragma("unroll") for (int k = 0; k < 2; ++k) dst[m][k] = *(const PG8_LAS bf16x8*)(lds + PG8_SA(b, h) + aoff + m * 2048 + k * 1024); } } while (0)
#define PG8_LDB(dst, b, h) do { if constexpr (FP8) { _Pragma("unroll") for (int n = 0; n < 2; ++n) dst##8[n] = __builtin_shufflevector(PG8_I4(lds + PG8_SB(b, h) + boff + n * 2048), PG8_I4(lds + PG8_SB(b, h) + boff + n * 2048 + 1024), 0, 1, 2, 3, 4, 5, 6, 7); } \
        else { _Pragma("unroll") for (int n = 0; n < 2; ++n) _Pragma("unroll") for (int k = 0; k < 2; ++k) dst[n][k] = *(const PG8_LAS bf16x8*)(lds + PG8_SB(b, h) + boff + n * 2048 + k * 1024); } } while (0)
#define PG8_MMA_BF(ai, bj, At, Bt) do { __builtin_amdgcn_s_setprio(1); _Pragma("unroll") for (int m = 0; m < 4; ++m) _Pragma("unroll") for (int n = 0; n < 2; ++n) _Pragma("unroll") for (int k = 0; k < 2; ++k) \
        acc[ai][bj][m][n] = __builtin_amdgcn_mfma_f32_16x16x32_bf16(Bt[n][k], At[m][k], acc[ai][bj][m][n], 0, 0, 0); __builtin_amdgcn_s_setprio(0); } while (0)
#define PG8_MMA_F8(ai, bj, At, Bt) do { __builtin_amdgcn_s_setprio(1); _Pragma("unroll") for (int m = 0; m < 4; ++m) _Pragma("unroll") for (int n = 0; n < 2; ++n) \
        asm volatile("v_mfma_scale_f32_16x16x128_f8f6f4 %0, %1, %2, %0, %3, %4 op_sel_hi:[0,0,0]" : "+v"(acc[ai][bj][m][n]) : "v"(Bt##8[n]), "v"(At##8[m]), "v"(f8_scale_w), "v"(f8_scale_x)); \
        __builtin_amdgcn_s_setprio(0); } while (0)
#define PG8_F8_DRAIN() do { if constexpr (FP8) asm volatile("s_nop 15\n\ts_nop 15" ::: "memory"); } while (0)
#define PG8_MMA(ai, bj, At, Bt) do { if constexpr (FP8) PG8_MMA_F8(ai, bj, At, Bt); else PG8_MMA_BF(ai, bj, At, Bt); } while (0)
#define PG8_WAIT_V(n) asm volatile("s_waitcnt vmcnt(" #n ")" ::: "memory")
#define PG8_WAIT_L(n) asm volatile("s_waitcnt lgkmcnt(" #n ")" ::: "memory")
#define PG8_BAR __builtin_amdgcn_s_barrier()
#define PG8_SCHED __builtin_amdgcn_sched_barrier(0)
    Unit cur, nxt; int ui = 0;
    if (!S.next(0, cur)) return;
    f32x4 acc[2][2][4][2];
#pragma unroll
    for (int a = 0; a < 2; ++a)
#pragma unroll
        for (int b = 0; b < 2; ++b)
#pragma unroll
            for (int m = 0; m < 4; ++m)
#pragma unroll
                for (int n = 0; n < 2; ++n) acc[a][b][m][n] = (f32x4){0.f, 0.f, 0.f, 0.f};
    int f8_scale_w = 0x79797979, f8_scale_x = 0x7f7f7f7f; (void)f8_scale_w; (void)f8_scale_x;
    bf16x8 At[4][2], B0[2][2], B1[2][2]; pg8_v8i At8[4], B08[2], B18[2];
    (void)At; (void)B0; (void)B1; (void)At8; (void)B08; (void)B18;
    const char* cA = (const char*)g.A + (size_t)cur.pm * tstepA + S.a_off(cur); const char* cB = (const char*)g.Bt + (size_t)cur.pn * tstepB + S.b_off(cur);
    S.a_ready(cur);
    if constexpr (SP2) {
        PG8_STAGE(PG8_SB(0, 0), cB, voffB); PG8_STAGE(PG8_SB(0, 1), cB + hstepB, voffB); PG8_STAGE(PG8_SA(0, 0), cA, voffA); PG8_STAGE(PG8_SA(0, 1), cA + hstepA, voffA);
        if (wr == 1) PG8_BAR;
        PG8_WAIT_V(2); PG8_BAR;
        PG8_STAGE(PG8_SB(1, 0), cB + kstep, voffB); PG8_STAGE(PG8_SA(1, 0), cA + kstep, voffA); PG8_STAGE(PG8_SB(1, 1), cB + hstepB + kstep, voffB);
        PG8_WAIT_V(6); PG8_BAR;
    } else {
    PG8_STAGE(PG8_SB(0, 0), cB, voffB); PG8_STAGE(PG8_SA(0, 0), cA, voffA); PG8_STAGE(PG8_SB(0, 1), cB + hstepB, voffB); PG8_STAGE(PG8_SA(0, 1), cA + hstepA, voffA);
    if (wr == 1) PG8_BAR;
    PG8_WAIT_V(4); PG8_BAR;
    PG8_STAGE(PG8_SB(1, 0), cB + kstep, voffB); PG8_STAGE(PG8_SA(1, 0), cA + kstep, voffA); PG8_STAGE(PG8_SB(1, 1), cB + hstepB + kstep, voffB);
    PG8_WAIT_V(6); PG8_BAR;
    }
    PG8_STAMP();
    for (;;) {
        const bool has_next = S.next(ui + 1, nxt);
        const char* nA = has_next ? (const char*)g.A + (size_t)nxt.pm * tstepA + S.a_off(nxt) : cA; const char* nB = has_next ? (const char*)g.Bt + (size_t)nxt.pn * tstepB + S.b_off(nxt) : cB;
        for (int t = 0; t < nt; t += 2) {
            const bool last = (t == nt - 2);
            const char* a1 = cA + (size_t)(t + 1) * kstep;
            const char* a2 = last ? nA : cA + (size_t)(t + 2) * kstep; const char* b2 = last ? nB : cB + (size_t)(t + 2) * kstep;
            const char* a3 = a2 + kstep; const char* b3 = b2 + kstep;
            if (last && has_next) S.a_ready(nxt);
            if constexpr (SP2) {
            PG8_LDB(B0, 0, 0); PG8_LDB(B1, 0, 1); PG8_SCHED; PG8_LDA(At, 0, 0); PG8_STAGE(PG8_SA(1, 1), a1 + hstepA, voffA);
            PG8_WAIT_V(8); PG8_WAIT_L(0); PG8_BAR; PG8_MMA(0, 0, At, B0); PG8_MMA(0, 1, At, B1); PG8_BAR; PG8_SCHED;
            PG8_LDA(At, 0, 1); PG8_STAGE(PG8_SB(0, 0), b2, voffB); PG8_STAGE(PG8_SB(0, 1), b2 + hstepB, voffB); PG8_STAGE(PG8_SA(0, 0), a2, voffA);
            PG8_WAIT_V(8); PG8_WAIT_L(0); PG8_BAR; PG8_MMA(1, 0, At, B0); PG8_MMA(1, 1, At, B1); PG8_BAR; PG8_SCHED;
            PG8_LDB(B0, 1, 0); PG8_LDB(B1, 1, 1); PG8_SCHED; PG8_LDA(At, 1, 0); PG8_STAGE(PG8_SA(0, 1), a2 + hstepA, voffA);
            PG8_WAIT_V(8); PG8_WAIT_L(0); PG8_BAR; PG8_MMA(0, 0, At, B0); PG8_MMA(0, 1, At, B1); PG8_BAR; PG8_SCHED;
            PG8_LDA(At, 1, 1); PG8_STAGE(PG8_SB(1, 0), b3, voffB); PG8_STAGE(PG8_SB(1, 1), b3 + hstepB, voffB); PG8_STAGE(PG8_SA(1, 0), a3, voffA);
            PG8_WAIT_V(8); PG8_WAIT_L(0); PG8_BAR; PG8_MMA(1, 0, At, B0); PG8_MMA(1, 1, At, B1); PG8_BAR; PG8_SCHED;
            } else {
            PG8_LDB(B0, 0, 0); PG8_SCHED; PG8_LDA(At, 0, 0); PG8_STAGE(PG8_SA(1, 1), a1 + hstepA, voffA);
            PG8_WAIT_L(8); PG8_BAR; PG8_WAIT_L(0); PG8_MMA(0, 0, At, B0); PG8_BAR; PG8_SCHED;
            PG8_LDB(B1, 0, 1); PG8_STAGE(PG8_SB(0, 0), b2, voffB);
            PG8_BAR; PG8_WAIT_L(0); PG8_MMA(0, 1, At, B1); PG8_BAR;
            PG8_LDA(At, 0, 1); PG8_STAGE(PG8_SA(0, 0), a2, voffA);
            PG8_BAR; PG8_WAIT_L(0); PG8_MMA(1, 0, At, B0); PG8_BAR; PG8_SCHED;
            PG8_STAGE(PG8_SB(0, 1), b2 + hstepB, voffB);
            PG8_WAIT_V(6); PG8_BAR; PG8_MMA(1, 1, At, B1); PG8_BAR;
            PG8_LDB(B0, 1, 0); PG8_SCHED; PG8_LDA(At, 1, 0); PG8_STAGE(PG8_SA(0, 1), a2 + hstepA, voffA);
            PG8_WAIT_L(8); PG8_BAR; PG8_WAIT_L(0); PG8_MMA(0, 0, At, B0); PG8_BAR; PG8_SCHED;
            PG8_LDB(B1, 1, 1); PG8_STAGE(PG8_SB(1, 0), b3, voffB);
            PG8_BAR; PG8_WAIT_L(0); PG8_MMA(0, 1, At, B1); PG8_BAR;
            PG8_LDA(At, 1, 1); PG8_STAGE(PG8_SA(1, 0), a3, voffA);
            PG8_BAR; PG8_WAIT_L(0); PG8_MMA(1, 0, At, B0); PG8_BAR; PG8_SCHED;
            PG8_STAGE(PG8_SB(1, 1), b3 + hstepB, voffB);
            PG8_WAIT_V(6); PG8_BAR; PG8_MMA(1, 1, At, B1); PG8_BAR;
            }
        }
        if constexpr (ALIGN_EPI) { if (wr == 0) PG8_BAR; }
        PG8_STAMP();
        PG8_F8_DRAIN();
        if constexpr (!Epi::AFTER_DRAIN) { E(acc, cur, wr, wc, fr, fq); S.done(cur); }
        PG8_STAMP();
        if (!has_next) break;
#pragma unroll
        for (int a = 0; a < 2; ++a)
#pragma unroll
            for (int b = 0; b < 2; ++b)
#pragma unroll
                for (int m = 0; m < 4; ++m)
#pragma unroll
                    for (int n = 0; n < 2; ++n) acc[a][b][m][n] = (f32x4){0.f, 0.f, 0.f, 0.f};
        cur = nxt; cA = nA; cB = nB; ++ui;
        if constexpr (ALIGN_EPI) { if (wr == 1) PG8_BAR; }
    }
    PG8_WAIT_V(0);
    if constexpr (!ALIGN_EPI) { if (wr == 0) PG8_BAR; }
    PG8_BAR;
    if constexpr (Epi::AFTER_DRAIN) { E.fused(acc, cur, wr, wc, fr, fq, lds, wid, lane); S.done(cur); }
    PG8_STAMP();
    if (STAMP && wid == 0) { stamps[lane] = lane < nts ? (((unsigned long long)(unsigned)ts_hi << 32) | (unsigned)ts_lo) : 0ull;
        if (lane == 62) stamps[62] = rt_entry; if (lane == 63) stamps[63] = (unsigned long long)wall_clock64(); }
#undef PG8_STAMP
#undef PG8_SA
#undef PG8_SB
#undef PG8_STAGE
#undef PG8_LDA
#undef PG8_LDB
#undef PG8_MMA
#undef PG8_MMA_BF
#undef PG8_MMA_F8
#undef PG8_I4
#undef PG8_F8_DRAIN
#undef PG8_WAIT_V
#undef PG8_WAIT_L
#undef PG8_BAR
#undef PG8_SCHED
}
}
#define XB_TMO      128
#define XB_XCNT(j)  (256  + 64 * (j))
#define XB_XSUB(j)  (1280 + 64 * (j))
#define XB_XGEN(j)  (2304 + 64 * (j))
#define XB_TOP      3328
#define XB_TOPGEN   3392
#define XCD_BAR_WORDS 3456
#define XB_SPIN_CAP (1u << 18)
#define LAS __attribute__((address_space(3)))

__device__ __forceinline__ unsigned xb_ld(unsigned* p)              { return __hip_atomic_load(p, __ATOMIC_RELAXED, __HIP_MEMORY_SCOPE_AGENT); }
__device__ __forceinline__ unsigned xb_add(unsigned* p, unsigned v) { return __hip_atomic_fetch_add(p, v, __ATOMIC_RELAXED, __HIP_MEMORY_SCOPE_AGENT); }
__device__ __forceinline__ unsigned xb_xcc_id() { return (unsigned)__builtin_amdgcn_s_getreg((3 << 11) | 20) & 0xFu; }
#define XB_SPIN(cond, bar) do { unsigned _sp = 0; while (cond) { __builtin_amdgcn_s_sleep(1); \
    if ((++_sp & 255u) == 0u) { if (xb_ld(&(bar)[XB_TMO])) break; if (_sp > XB_SPIN_CAP) { atomicAdd(&(bar)[XB_TMO], 1u); break; } } } } while (0)

struct XcdBarrier {
    unsigned* bar; unsigned x;
    volatile LAS unsigned* st;
};

__device__ __forceinline__ XcdBarrier xcd_barrier_post(unsigned* bar, volatile LAS unsigned* st) {
    XcdBarrier b; b.bar = bar; b.x = xb_xcc_id(); b.st = st;
    if (threadIdx.x == 0) (void)xb_add(&bar[XB_XCNT(b.x)], 1u);
    return b;
}
__device__ __forceinline__ void xcd_barrier_complete(unsigned* bar, unsigned x, unsigned& nloc, unsigned& nx) {
    const unsigned G = gridDim.x * gridDim.y * gridDim.z;
    unsigned sum, cnt, mine, sp = 0u;
    for (;;) {
        sum = 0u; cnt = 0u; mine = 0u;
#pragma unroll
        for (unsigned j = 0; j < 16; ++j) { const unsigned c = xb_ld(&bar[XB_XCNT(j)]); sum += c; cnt += (c > 0u) ? 1u : 0u; mine = (j == x) ? c : mine; }
        if (sum == G) break;
        __builtin_amdgcn_s_sleep(1);
        if ((++sp & 255u) == 0u) { if (xb_ld(&bar[XB_TMO])) break; if (sp > XB_SPIN_CAP) { atomicAdd(&bar[XB_TMO], 1u); break; } }
    }
    nloc = mine > 0u ? mine : 1u; nx = cnt > 0u ? cnt : 1u;
}

__device__ __forceinline__ void xcd_barrier(const XcdBarrier& b) {
    asm volatile("s_waitcnt vmcnt(0)" ::: "memory");
    __syncthreads();
    if (threadIdx.x == 0) {
        unsigned* bar = b.bar;
        __builtin_amdgcn_s_waitcnt(0);
        unsigned nloc = b.st[0], nx = b.st[1];
        if (nloc == 0u) { xcd_barrier_complete(bar, b.x, nloc, nx); b.st[0] = nloc; b.st[1] = nx; }
        const unsigned old = xb_add(&bar[XB_XSUB(b.x)], 1u);
        const unsigned gen = old / nloc;
        if (old + 1u == (gen + 1u) * nloc) {
            __builtin_amdgcn_fence(__ATOMIC_RELEASE, "agent");
            asm volatile("s_waitcnt vmcnt(0)" ::: "memory");
            const unsigned og = xb_add(&bar[XB_TOP], 1u);
            const unsigned tg = og / nx;
            if (og + 1u == (tg + 1u) * nx) xb_add(&bar[XB_TOPGEN], 1u);
            else XB_SPIN(xb_ld(&bar[XB_TOPGEN]) == tg, bar);
            __builtin_amdgcn_fence(__ATOMIC_ACQUIRE, "agent");
            xb_add(&bar[XB_XGEN(b.x)], 1u);
            asm volatile("s_waitcnt vmcnt(0)" ::: "memory");
        } else {
            XB_SPIN(xb_ld(&bar[XB_XGEN(b.x)]) == gen, bar);
            __builtin_amdgcn_fence(__ATOMIC_ACQUIRE, "agent");
            asm volatile("s_waitcnt vmcnt(0)" ::: "memory");
        }
    }
    __syncthreads();
}


typedef unsigned short bf16;
typedef unsigned v4u __attribute__((ext_vector_type(4)));
typedef unsigned v2u __attribute__((ext_vector_type(2)));
typedef float v4f __attribute__((ext_vector_type(4)));
typedef float v2f __attribute__((ext_vector_type(2)));

constexpr int DM = 2048, NBATCH = 8, SEQ = 4096, DEPTH = 2, MTOK = NBATCH * SEQ;
constexpr int IN_COLS = 14416, NPROJ = 14592;
constexpr int C_UB = 0, C_VB = 1024, C_ZB = 2048, C_QC = 3072, C_KC = 3584, C_VC = 4096, C_ZC = 5120, C_KROPE = 6144, C_AR = 6208,
              C_CQ = 6400, C_CKV = 6912, C_ZA = 7424, C_GATE = 8448;
constexpr int NBF = C_CQ, NF8 = NPROJ - NBF;
constexpr float EPS = 1e-6f;
#ifndef NBP
#define NBP 4
#endif
constexpr int MP = NBP * SEQ, NPASS = NBATCH / NBP;
constexpr int STEPS_PER_PASS = 7;
constexpr int NSTEPS = DEPTH * (1 + NPASS * STEPS_PER_PASS);

constexpr size_t al256(size_t x) { return (x + 255) & ~(size_t)255; }
constexpr size_t WS_CTL = 0, CTL_BYTES = 1u << 20;
constexpr size_t SZ_WINB = (size_t)NBF * DM * 2  , SZ_WIN = SZ_WINB + (size_t)NF8 * DM  , SZ_WUQ = (size_t)1536 * 512 * 2, SZ_WUKV = (size_t)2048 * 512 * 2, SZ_WB = (size_t)3 * 2048 * 1024 * 2, SZ_WO = (size_t)2048 * 2048 * 2;
constexpr size_t SZ_WLAYER = SZ_WIN + SZ_WUQ + SZ_WUKV + SZ_WB + SZ_WO;
constexpr size_t WS_W = CTL_BYTES;
constexpr size_t WS_COS = WS_W + SZ_WLAYER, WS_SIN = WS_COS + (size_t)MTOK * 32 * 4;
constexpr size_t WS_H = WS_SIN + (size_t)MTOK * 32 * 4;
constexpr size_t WS_MG = WS_H;
constexpr size_t WS_PROJ = WS_H + (size_t)MP * DM * 2;
constexpr size_t WS_XB = WS_PROJ + (size_t)MP * NPROJ * 2;
constexpr size_t WS_SSQ = WS_XB + (size_t)MP * 2048;
constexpr size_t WS_Q = WS_SSQ + al256((size_t)3 * MP * 4);
constexpr size_t WS_KV = WS_Q + (size_t)MP * 1536 * 2;
constexpr size_t WS_K = WS_KV + (size_t)MP * 2048 * 2;
constexpr size_t WS_YA = WS_K + (size_t)MP * 1536 * 2;
constexpr size_t WS_YB = WS_YA + (size_t)MP * 1024 * 2;
constexpr size_t WS_DL = WS_YA;
constexpr size_t WS_YC = WS_YB + (size_t)MP * 1024 * 2;
constexpr size_t WS_OC = WS_YC + (size_t)MP * 1024 * 2;
constexpr size_t WS_QE = WS_OC + (size_t)MP * 1024 * 4;
constexpr size_t WS_KE = WS_QE + (size_t)MP * 512 * 2, WS_KL = WS_KE + (size_t)MP * 512 * 2;
constexpr size_t WS_H8 = WS_KE;
constexpr size_t WS_DS = WS_KL + (size_t)MP * 512 * 2;
constexpr size_t WS_END = WS_DS + (size_t)(MP / 128) * 512 * 4;
static_assert(WS_END <= ((size_t)1 << 30), "workspace map exceeds 1 GiB");

constexpr int LDS_BYTES = 147456;
constexpr int LDSCTL_OFF = LDS_BYTES - 256;
constexpr int CW_BAR = 4096;

__device__ __forceinline__ float bf2f(unsigned v) { return __uint_as_float(v << 16); }
__device__ __forceinline__ unsigned f2bf(float f) { unsigned u = __float_as_uint(f); return (u + 0x7fffu + ((u >> 16) & 1u)) >> 16; }
__device__ __forceinline__ unsigned pk2(float lo, float hi) { return f2bf(lo) | (f2bf(hi) << 16); }
__device__ __forceinline__ float lo16(unsigned w) { return __uint_as_float(w << 16); }
__device__ __forceinline__ float hi16(unsigned w) { return __uint_as_float(w & 0xffff0000u); }
__device__ __forceinline__ float sigmoid_f(float x) { return 1.f / (1.f + __expf(-x)); }
__device__ __forceinline__ float silu_f(float x) { return x / (1.f + __expf(-x)); }
__device__ __forceinline__ float gelu_f(float x) { const float u2 = 1.5957691216057308f * (x + 0.044715f * x * x * x); return x * __builtin_amdgcn_rcpf(1.f + __expf(-u2)); }
template <int O> __device__ __forceinline__ float lane_xor(float v) {
    if (O == 1) return __uint_as_float((unsigned)__builtin_amdgcn_mov_dpp((int)__float_as_uint(v), 0xB1, 0xf, 0xf, true));
    if (O == 2) return __uint_as_float((unsigned)__builtin_amdgcn_mov_dpp((int)__float_as_uint(v), 0x4E, 0xf, 0xf, true));
    return __uint_as_float((unsigned)__builtin_amdgcn_ds_swizzle((int)__float_as_uint(v), (O << 10) | 0x1f)); }
__device__ __forceinline__ float lane_xor32(float v, int lane) {
    auto rr = __builtin_amdgcn_permlane32_swap(__float_as_uint(v), __float_as_uint(v), false, false);
    return __uint_as_float(lane < 32 ? rr[1] : rr[0]); }
__device__ __forceinline__ float wave_sum(float v) {
    v += lane_xor<1>(v); v += lane_xor<2>(v); v += lane_xor<4>(v); v += lane_xor<8>(v); v += lane_xor<16>(v);
    auto rr = __builtin_amdgcn_permlane32_swap(__float_as_uint(v), __float_as_uint(v), false, false);
    return __uint_as_float(rr[0]) + __uint_as_float(rr[1]); }
__device__ __forceinline__ float wave_max(float v) {
    v = fmaxf(v, lane_xor<1>(v)); v = fmaxf(v, lane_xor<2>(v)); v = fmaxf(v, lane_xor<4>(v)); v = fmaxf(v, lane_xor<8>(v)); v = fmaxf(v, lane_xor<16>(v));
    auto rr = __builtin_amdgcn_permlane32_swap(__float_as_uint(v), __float_as_uint(v), false, false);
    return fmaxf(__uint_as_float(rr[0]), __uint_as_float(rr[1])); }
#define LDS_FENCE() asm volatile("s_waitcnt lgkmcnt(0)" ::: "memory")

struct Args { const void* in[18]; float* out; unsigned char* ws; int lo, hi, pad0, pad1; };

template <int MODE> __device__ __forceinline__ int src_col(int n) {
    if (MODE == 0) return n;
    if (MODE == 2) n += NBF;
    if (n < C_VB) return 2112 + n;
    if (n < C_ZB) return 3136 + (n - C_VB);
    if (n < C_QC) return 4160 + (n - C_ZB);
    if (n < C_KC) return 5184 + (n - C_QC);
    if (n < C_VC) return 5696 + (n - C_KC);
    if (n < C_ZC) return 6208 + (n - C_VC);
    if (n < C_KROPE) return 7248 + (n - C_ZC);
    if (n < C_AR) return 1024 + (n - C_KROPE);
    if (n < C_AR + 16) return 7232 + (n - C_AR);
    if (n < C_CQ) return -1;
    if (n < C_CKV) return n - C_CQ;
    if (n < C_ZA) return 512 + (n - C_CKV);
    if (n < C_GATE) return 1088 + (n - C_ZA);
    return 8272 + (n - C_GATE);
}
template <int MODE> __device__ __forceinline__ void convert_T(const float* W, int K, int Nsrc, bf16* WT, int Ndst, LAS float* tile, int vb, int nvb, const float* kscale = nullptr) {
    const int tid = otid(), ntk = K / 64, ntn = Ndst / 64, ntiles = ntk * ntn;
    for (int t = vb; t < ntiles; t += nvb) {
        const int k0 = (t % ntk) * 64, n0 = (t / ntk) * 64;
        { const int nn = tid & 63, sc = src_col<MODE>(n0 + nn);
#pragma unroll
          for (int i = 0; i < 8; ++i) { const int kk = (tid >> 6) + 8 * i; tile[kk * 65 + nn] = sc >= 0 ? W[(size_t)(k0 + kk) * Nsrc + sc] * (kscale ? kscale[k0 + kk] : 1.f) : 0.f; } }
        __syncthreads();
        { const int nn = tid & 63, kg = tid >> 6;
          const LAS float* tp = tile + (kg * 8) * 65 + nn;
          v4u o; o.x = pk2(tp[0], tp[65]); o.y = pk2(tp[2 * 65], tp[3 * 65]); o.z = pk2(tp[4 * 65], tp[5 * 65]); o.w = pk2(tp[6 * 65], tp[7 * 65]);
          *(v4u*)(WT + (size_t)(n0 + nn) * K + k0 + kg * 8) = o; }
        __syncthreads();
    }
}

__device__ __forceinline__ void convert_T8(const float* W, int K, int Nsrc, unsigned char* WT, int Ndst, LAS float* tile, int vb, int nvb) {
    const int tid = otid(), ntk = K / 64, ntn = Ndst / 64, ntiles = ntk * ntn;
    for (int t = vb; t < ntiles; t += nvb) {
        const int k0 = (t % ntk) * 64, n0 = (t / ntk) * 64;
        { const int nn = tid & 63;
          const int sc = src_col<2>(n0 + nn);
#pragma unroll
          for (int i = 0; i < 8; ++i) { const int kk = (tid >> 6) + 8 * i; tile[kk * 65 + nn] = W[(size_t)(k0 + kk) * Nsrc + sc] * 64.0f; } }
        __syncthreads();
        { const int nn = tid & 63, kg = tid >> 6;
          const LAS float* tp = tile + (kg * 8) * 65 + nn;
          unsigned w0 = 0u, w1 = 0u;
          w0 = __builtin_amdgcn_cvt_pk_fp8_f32(tp[0], tp[65], w0, false); w0 = __builtin_amdgcn_cvt_pk_fp8_f32(tp[2 * 65], tp[3 * 65], w0, true);
          w1 = __builtin_amdgcn_cvt_pk_fp8_f32(tp[4 * 65], tp[5 * 65], w1, false); w1 = __builtin_amdgcn_cvt_pk_fp8_f32(tp[6 * 65], tp[7 * 65], w1, true);
          *(v2u*)(WT + (size_t)(n0 + nn) * K + k0 + kg * 8) = (v2u){w0, w1}; }
        __syncthreads();
    }
}

__device__ __forceinline__ void ph_norm(const float* xin, const float* g, bf16* h, unsigned char* h8, int rows, int vb, int nvb) {
    const int tid_ = otid(); const int lane = tid_ & 63, wave = tid_ >> 6;
    for (int r = vb * 8 + wave; r < rows; r += nvb * 8) {
        const v4f* xr = (const v4f*)(xin + (size_t)r * DM);
        v4f v[8]; float ss = 0.f;
#pragma unroll
        for (int j = 0; j < 8; ++j) { v[j] = xr[lane + 64 * j]; ss += v[j].x * v[j].x + v[j].y * v[j].y + v[j].z * v[j].z + v[j].w * v[j].w; }
        ss = wave_sum(ss);
        const float rn = 1.0f / sqrtf(ss * (1.0f / DM) + EPS);
#pragma unroll
        for (int j = 0; j < 8; ++j) { const v4f gg = ((const v4f*)g)[lane + 64 * j];
            const float y0 = v[j].x * rn * gg.x, y1 = v[j].y * rn * gg.y, y2 = v[j].z * rn * gg.z, y3 = v[j].w * rn * gg.w;
            v2u o; o.x = pk2(y0, y1); o.y = pk2(y2, y3);
            *(v2u*)(h + (size_t)r * DM + (lane + 64 * j) * 4) = o;
            unsigned w8 = 0u; w8 = __builtin_amdgcn_cvt_pk_fp8_f32(y0, y1, w8, false); w8 = __builtin_amdgcn_cvt_pk_fp8_f32(y2, y3, w8, true);
            *(unsigned*)(h8 + (size_t)r * DM + (lane + 64 * j) * 4) = w8; }
    }
}
__device__ __forceinline__ float row16_sum(float v) {
    v += __uint_as_float((unsigned)__builtin_amdgcn_mov_dpp((int)__float_as_uint(v), 0xB1, 0xf, 0xf, true));
    v += __uint_as_float((unsigned)__builtin_amdgcn_mov_dpp((int)__float_as_uint(v), 0x4E, 0xf, 0xf, true));
    v += __uint_as_float((unsigned)__builtin_amdgcn_mov_dpp((int)__float_as_uint(v), 0x141, 0xf, 0xf, true));
    v += __uint_as_float((unsigned)__builtin_amdgcn_mov_dpp((int)__float_as_uint(v), 0x140, 0xf, 0xf, true));
    return v; }
__device__ __forceinline__ void ph_kfin(const bf16* kv, const bf16* proj, bf16* K, const float* kg, const float* cosT, const float* sinT, int row0, int vb, int nvb) {
    const int tid_ = otid(); const int lane = tid_ & 63, wave = tid_ >> 6, g16 = lane >> 4, c = lane & 15;
    float gn[8], gr[8];
#pragma unroll
    for (int j = 0; j < 8; ++j) { gn[j] = kg[c * 8 + j]; gr[j] = kg[128 + (c & 7) * 8 + j]; }
    for (int r = vb * 8 + wave; r < MP; r += nvb * 8) {
        const v4u n0 = *(const v4u*)(kv + (size_t)r * 2048 + g16 * 256 + c * 8), n1 = *(const v4u*)(kv + (size_t)r * 2048 + (g16 + 4) * 256 + c * 8);
        const v4u rw = *(const v4u*)(proj + (size_t)r * NPROJ + C_KROPE + (c & 7) * 8);
        const v4f c0 = *(const v4f*)(cosT + (size_t)(row0 + r) * 32 + (c & 3) * 8), c1 = *(const v4f*)(cosT + (size_t)(row0 + r) * 32 + (c & 3) * 8 + 4);
        const v4f s0 = *(const v4f*)(sinT + (size_t)(row0 + r) * 32 + (c & 3) * 8), s1 = *(const v4f*)(sinT + (size_t)(row0 + r) * 32 + (c & 3) * 8 + 4);
        float a[8] = {lo16(n0.x), hi16(n0.x), lo16(n0.y), hi16(n0.y), lo16(n0.z), hi16(n0.z), lo16(n0.w), hi16(n0.w)};
        float b[8] = {lo16(n1.x), hi16(n1.x), lo16(n1.y), hi16(n1.y), lo16(n1.z), hi16(n1.z), lo16(n1.w), hi16(n1.w)};
        float kr[8] = {lo16(rw.x), hi16(rw.x), lo16(rw.y), hi16(rw.y), lo16(rw.z), hi16(rw.z), lo16(rw.w), hi16(rw.w)};
        const float cs[8] = {c0.x, c0.y, c0.z, c0.w, c1.x, c1.y, c1.z, c1.w}, sn[8] = {s0.x, s0.y, s0.z, s0.w, s1.x, s1.y, s1.z, s1.w};
        float sa = 0.f, sb = 0.f, sr = 0.f;
#pragma unroll
        for (int j = 0; j < 8; ++j) { sa += a[j] * a[j]; sb += b[j] * b[j]; sr += kr[j] * kr[j]; }
        if (c >= 8) sr = 0.f;
        sa = row16_sum(sa); sb = row16_sum(sb); sr = row16_sum(sr);
        const float rna = 1.0f / sqrtf((sa + sr) * (1.0f / 192.f) + EPS), rnb = 1.0f / sqrtf((sb + sr) * (1.0f / 192.f) + EPS);
        float R[8];
#pragma unroll
        for (int j = 0; j < 8; ++j) { const float mine = kr[j] * gr[j]; const float oth = lane_xor<4>(mine);
            R[j] = (c & 4) ? mine * cs[j] + oth * sn[j] : mine * cs[j] - oth * sn[j]; }
        bf16* ka = K + ((size_t)r * 8 + g16) * 192; bf16* kb = K + ((size_t)r * 8 + g16 + 4) * 192;
        { v4u o; o.x = pk2(a[0] * rna * gn[0], a[1] * rna * gn[1]); o.y = pk2(a[2] * rna * gn[2], a[3] * rna * gn[3]); o.z = pk2(a[4] * rna * gn[4], a[5] * rna * gn[5]); o.w = pk2(a[6] * rna * gn[6], a[7] * rna * gn[7]); *(v4u*)(ka + c * 8) = o; }
        { v4u o; o.x = pk2(b[0] * rnb * gn[0], b[1] * rnb * gn[1]); o.y = pk2(b[2] * rnb * gn[2], b[3] * rnb * gn[3]); o.z = pk2(b[4] * rnb * gn[4], b[5] * rnb * gn[5]); o.w = pk2(b[6] * rnb * gn[6], b[7] * rnb * gn[7]); *(v4u*)(kb + c * 8) = o; }
        if (c < 8) {
            v4u o; o.x = pk2(R[0] * rna, R[1] * rna); o.y = pk2(R[2] * rna, R[3] * rna); o.z = pk2(R[4] * rna, R[5] * rna); o.w = pk2(R[6] * rna, R[7] * rna); *(v4u*)(ka + 128 + c * 8) = o;
            v4u p; p.x = pk2(R[0] * rnb, R[1] * rnb); p.y = pk2(R[2] * rnb, R[3] * rnb); p.z = pk2(R[4] * rnb, R[5] * rnb); p.w = pk2(R[6] * rnb, R[7] * rnb); *(v4u*)(kb + 128 + c * 8) = p; }
    }
}

namespace at {
typedef short bf16x8 __attribute__((ext_vector_type(8)));
typedef short s16x4 __attribute__((ext_vector_type(4)));
typedef float f32x16 __attribute__((ext_vector_type(16)));
typedef unsigned u32x4 __attribute__((ext_vector_type(4)));
constexpr int SHM_V = 16384, SHM_K = 16384, SHM_KR = 8192;
constexpr int OFF_V = 0, OFF_K = 3 * SHM_V, OFF_KR = OFF_K + 2 * SHM_K, OFF_WS = OFF_KR + 2 * SHM_KR, LDS_NEED = OFF_WS + 8 * 64 * 4;
constexpr float SCALE = 0.07216878364870322f;
constexpr float THR = 8.f;
#define AT_KSWZ(row, colB) ((row) * 256 + ((colB) ^ (((row) & 7) << 4)))
#define AT_KRSWZ(row, colB) ((row) * 128 + ((colB) ^ (((row) & 7) << 4)))
#define AT_SBAR() __builtin_amdgcn_sched_barrier(0)
__device__ __forceinline__ int v_st(int k, int c) { const int kk = (k & ~0xC) | ((k & 4) << 1) | ((k & 8) >> 1); return ((kk >> 3) * 4 + (c >> 5)) * 512 + ((kk & 7) * 32 + (c & 31)) * 2; }
__device__ __forceinline__ int v_rd_base(int lane) { return ((lane & 3) << 3) | (((lane >> 2) & 3) << 6) | (((lane >> 4) & 1) << 5) | (((lane >> 5) & 1) << 8); }
constexpr int v_rd_off(int d0, int ks, int half) { return d0 * 512 + ks * 4096 + half * 2048; }
__device__ __forceinline__ int crow(int r, int hi) { return (r & 3) + 8 * (r >> 2) + 4 * hi; }
__device__ __forceinline__ unsigned cvtpk(float lo, float hi) { unsigned r; asm("v_cvt_pk_bf16_f32 %0, %1, %2" : "=v"(r) : "v"(lo), "v"(hi)); return r; }

__device__ __forceinline__ void mask_tile(f32x16& p0, f32x16& p1, int dq) {
    const float NEG = -__builtin_inff();
#pragma unroll
    for (int r = 0; r < 16; ++r) { const int c = (r & 3) + 8 * (r >> 2); if (dq < c) p0[r] = NEG; if (dq < c + 32) p1[r] = NEG; }
}
__device__ __forceinline__ void partialSM(f32x16& p0, f32x16& p1, float& m_reg, float& mn, float& alpha) {
    float pmax = p0[0];
#pragma unroll
    for (int r = 1; r < 16; ++r) pmax = fmaxf(pmax, p0[r]);
#pragma unroll
    for (int r = 0; r < 16; ++r) pmax = fmaxf(pmax, p1[r]);
    { auto rr = __builtin_amdgcn_permlane32_swap(__float_as_uint(pmax), __float_as_uint(pmax), false, false);
      pmax = fmaxf(__uint_as_float(rr[0]), __uint_as_float(rr[1])); }
    constexpr float C2 = 1.4426950408889634f * SCALE;
    if (__builtin_expect(__all((pmax - m_reg) * SCALE <= THR), 1)) { mn = m_reg; alpha = 1.f; }
    else { mn = fmaxf(m_reg, pmax); alpha = __builtin_amdgcn_exp2f((m_reg - mn) * C2); m_reg = mn; }
    const float mnL = -mn * C2;
#pragma unroll
    for (int r = 0; r < 16; ++r) p0[r] = fmaf(p0[r], C2, mnL);
#pragma unroll
    for (int r = 0; r < 16; ++r) p1[r] = fmaf(p1[r], C2, mnL);
#pragma unroll
    for (int r = 0; r < 16; ++r) p0[r] = __builtin_amdgcn_exp2f(p0[r]);
}
__device__ __forceinline__ void finishSM(f32x16& p0, f32x16& p1, float alpha, float& l_reg, bf16x8& pa0, bf16x8& pa1, bf16x8& pa2, bf16x8& pa3) {
#pragma unroll
    for (int r = 0; r < 16; ++r) p1[r] = __builtin_amdgcn_exp2f(p1[r]);
    float ps = 0;
#pragma unroll
    for (int r = 0; r < 16; ++r) ps += p0[r];
#pragma unroll
    for (int r = 0; r < 16; ++r) ps += p1[r];
    { auto rr = __builtin_amdgcn_permlane32_swap(__float_as_uint(ps), __float_as_uint(ps), false, false);
      ps = __uint_as_float(rr[0]) + __uint_as_float(rr[1]); }
    l_reg = l_reg * alpha + ps;
#define AT_PK4(P, B_, OUT) do { unsigned a0 = cvtpk(P[B_+0], P[B_+1]), a1 = cvtpk(P[B_+2], P[B_+3]);                          \
        unsigned b0 = cvtpk(P[B_+4], P[B_+5]), b1 = cvtpk(P[B_+6], P[B_+7]);                                             \
        auto r0 = __builtin_amdgcn_permlane32_swap(a0, b0, false, false); auto r1 = __builtin_amdgcn_permlane32_swap(a1, b1, false, false); \
        u32x4 w = {r0[0], r1[0], r0[1], r1[1]}; OUT = *reinterpret_cast<bf16x8*>(&w); } while (0)
    AT_PK4(p0, 0, pa0); AT_PK4(p0, 8, pa1); AT_PK4(p1, 0, pa2); AT_PK4(p1, 8, pa3);
#undef AT_PK4
}
__device__ __forceinline__ void qkt(f32x16& p0, f32x16& p1, const LAS unsigned char* Kb, const LAS unsigned char* KRb, int r32, int hi, const bf16x8* qr) {
    p0 = f32x16{}; p1 = f32x16{};
    const LAS unsigned char* kb[4]; const LAS unsigned char* krb[4];
#pragma unroll
    for (int dd = 0; dd < 4; ++dd) { kb[dd] = Kb + AT_KSWZ(r32, (dd * 16 + hi * 8) * 2); krb[dd] = KRb + AT_KRSWZ(r32, (dd * 16 + hi * 8) * 2); }
    bf16x8 f[24];
#pragma unroll
    for (int d0 = 0; d0 < 8; ++d0) { const LAS unsigned char* a = kb[d0 & 3] + (d0 >> 2) * 128;
        f[2 * d0] = *reinterpret_cast<const LAS bf16x8*>(a); f[2 * d0 + 1] = *reinterpret_cast<const LAS bf16x8*>(a + 32 * 256); }
#pragma unroll
    for (int d0 = 0; d0 < 4; ++d0) { const LAS unsigned char* a = krb[d0];
        f[16 + 2 * d0] = *reinterpret_cast<const LAS bf16x8*>(a); f[16 + 2 * d0 + 1] = *reinterpret_cast<const LAS bf16x8*>(a + 32 * 128); }
#pragma unroll
    for (int d0 = 0; d0 < 12; ++d0) {
        p0 = __builtin_amdgcn_mfma_f32_32x32x16_bf16(f[2 * d0], qr[d0], p0, 0, 0, 0);
        p1 = __builtin_amdgcn_mfma_f32_32x32x16_bf16(f[2 * d0 + 1], qr[d0], p1, 0, 0, 0); }
    __builtin_amdgcn_sched_group_barrier(0x100, 4, 0);
#pragma unroll
    for (int i = 0; i < 20; ++i) { __builtin_amdgcn_sched_group_barrier(0x008, 1, 0); __builtin_amdgcn_sched_group_barrier(0x100, 1, 0); }
    __builtin_amdgcn_sched_group_barrier(0x008, 4, 0);
}
__device__ __forceinline__ void pv_tile(f32x16* o, unsigned vb0, bf16x8 pa0, bf16x8 pa1, bf16x8 pa2, bf16x8 pa3) {
#define AT_TRRD(dst, off) asm volatile("ds_read_b64_tr_b16 %0, %1 offset:%2" : "=&v"(dst) : "v"(vb0), "i"(off) : "memory")
#define AT_PV_RD(d0, L, H) do { constexpr int b_ = v_rd_off(d0, 0, 0); \
        AT_TRRD(L[0], b_); AT_TRRD(H[0], b_ + 2048); AT_TRRD(L[1], b_ + 4096); AT_TRRD(H[1], b_ + 6144); AT_TRRD(L[2], b_ + 8192); AT_TRRD(H[2], b_ + 10240); AT_TRRD(L[3], b_ + 12288); AT_TRRD(H[3], b_ + 14336); } while (0)
#define AT_PV_MM(d0, L, H) do { \
        o[d0] = __builtin_amdgcn_mfma_f32_32x32x16_bf16(pa0, (bf16x8){L[0][0], L[0][1], L[0][2], L[0][3], H[0][0], H[0][1], H[0][2], H[0][3]}, o[d0], 0, 0, 0);   \
        o[d0] = __builtin_amdgcn_mfma_f32_32x32x16_bf16(pa1, (bf16x8){L[1][0], L[1][1], L[1][2], L[1][3], H[1][0], H[1][1], H[1][2], H[1][3]}, o[d0], 0, 0, 0);   \
        o[d0] = __builtin_amdgcn_mfma_f32_32x32x16_bf16(pa2, (bf16x8){L[2][0], L[2][1], L[2][2], L[2][3], H[2][0], H[2][1], H[2][2], H[2][3]}, o[d0], 0, 0, 0);   \
        o[d0] = __builtin_amdgcn_mfma_f32_32x32x16_bf16(pa3, (bf16x8){L[3][0], L[3][1], L[3][2], L[3][3], H[3][0], H[3][1], H[3][2], H[3][3]}, o[d0], 0, 0, 0); } while (0)
    s16x4 la[4], ha[4], lb[4], hb[4];
    asm volatile("s_waitcnt lgkmcnt(0)" ::: "memory");
    AT_PV_RD(0, la, ha); AT_PV_RD(1, lb, hb);
    asm volatile("s_waitcnt lgkmcnt(8)" ::: "memory"); AT_SBAR(); AT_PV_MM(0, la, ha); AT_SBAR();
    AT_PV_RD(2, la, ha);
    asm volatile("s_waitcnt lgkmcnt(8)" ::: "memory"); AT_SBAR(); AT_PV_MM(1, lb, hb); AT_SBAR();
    AT_PV_RD(3, lb, hb);
    asm volatile("s_waitcnt lgkmcnt(8)" ::: "memory"); AT_SBAR(); AT_PV_MM(2, la, ha); AT_SBAR();
    asm volatile("s_waitcnt lgkmcnt(0)" ::: "memory"); AT_SBAR(); AT_PV_MM(3, lb, hb);
#undef AT_PV_RD
#undef AT_PV_MM
#undef AT_TRRD
}

__device__ __forceinline__ void attn_block(LAS unsigned char* lds, const bf16* Q, const bf16* K, const bf16* KV, const bf16* proj, bf16* YA, const float* qg, const float* cosT, const float* sinT, int b, int h, int qb) {
    const int tid = otid(), wid = __builtin_amdgcn_readfirstlane(tid >> 6), lane = tid & 63, r32 = lane & 31, hi = lane >> 5;
    const int P0 = qb * 256, NT = 4 * (qb + 1), qlo = P0 + wid * 32;
    LAS unsigned char* V_lds = lds + OFF_V; LAS unsigned char* K_lds = lds + OFF_K; LAS unsigned char* KR_lds = lds + OFF_KR;
    LAS float* wsf = (LAS float*)(lds + OFF_WS) + wid * 64; LAS float* li_l = wsf; LAS float* al_l = wsf + 32;
    bf16x8 qr[12];
    { const bf16* qp = Q + ((size_t)(b * SEQ + qlo + r32) * 8 + h) * 192 + hi * 8;
      bf16x8 raw[12];
#pragma unroll
      for (int d0 = 0; d0 < 12; ++d0) raw[d0] = *(const bf16x8*)(qp + d0 * 16);
      float ss = 0.f;
#pragma unroll
      for (int d0 = 0; d0 < 12; ++d0)
#pragma unroll
          for (int j = 0; j < 8; ++j) { const float v = bf2f((unsigned short)raw[d0][j]); ss += v * v; }
      { auto rr = __builtin_amdgcn_permlane32_swap(__float_as_uint(ss), __float_as_uint(ss), false, false); ss = __uint_as_float(rr[0]) + __uint_as_float(rr[1]); }
      const float rn = 1.0f / sqrtf(ss * (1.0f / 192.f) + EPS);
      const float* ct = cosT + (size_t)(b * SEQ + qlo + r32) * 32 + hi * 8; const float* st = sinT + (size_t)(b * SEQ + qlo + r32) * 32 + hi * 8;
#pragma unroll
      for (int d0 = 0; d0 < 8; ++d0) { const v4f g0 = *(const v4f*)(qg + d0 * 16 + hi * 8), g1 = *(const v4f*)(qg + d0 * 16 + hi * 8 + 4);
          const float g[8] = {g0.x, g0.y, g0.z, g0.w, g1.x, g1.y, g1.z, g1.w}; float x[8];
#pragma unroll
          for (int j = 0; j < 8; ++j) x[j] = bf2f((unsigned short)raw[d0][j]) * rn * g[j];
          u32x4 w = {cvtpk(x[0], x[1]), cvtpk(x[2], x[3]), cvtpk(x[4], x[5]), cvtpk(x[6], x[7])}; qr[d0] = *reinterpret_cast<bf16x8*>(&w); }
#pragma unroll
      for (int d0 = 8; d0 < 10; ++d0) { const int i0 = (d0 - 8) * 16;
          const v4f ga0 = *(const v4f*)(qg + d0 * 16 + hi * 8), ga1 = *(const v4f*)(qg + d0 * 16 + hi * 8 + 4), gb0 = *(const v4f*)(qg + (d0 + 2) * 16 + hi * 8), gb1 = *(const v4f*)(qg + (d0 + 2) * 16 + hi * 8 + 4);
          const v4f c0 = *(const v4f*)(ct + i0), c1 = *(const v4f*)(ct + i0 + 4), s0 = *(const v4f*)(st + i0), s1 = *(const v4f*)(st + i0 + 4);
          const float ga[8] = {ga0.x, ga0.y, ga0.z, ga0.w, ga1.x, ga1.y, ga1.z, ga1.w}, gb[8] = {gb0.x, gb0.y, gb0.z, gb0.w, gb1.x, gb1.y, gb1.z, gb1.w};
          const float cs[8] = {c0.x, c0.y, c0.z, c0.w, c1.x, c1.y, c1.z, c1.w}, sn[8] = {s0.x, s0.y, s0.z, s0.w, s1.x, s1.y, s1.z, s1.w};
          float y1[8], y2[8];
#pragma unroll
          for (int j = 0; j < 8; ++j) { const float x1 = bf2f((unsigned short)raw[d0][j]) * rn * ga[j], x2 = bf2f((unsigned short)raw[d0 + 2][j]) * rn * gb[j];
              y1[j] = x1 * cs[j] - x2 * sn[j]; y2[j] = x2 * cs[j] + x1 * sn[j]; }
          u32x4 w1 = {cvtpk(y1[0], y1[1]), cvtpk(y1[2], y1[3]), cvtpk(y1[4], y1[5]), cvtpk(y1[6], y1[7])}; qr[d0] = *reinterpret_cast<bf16x8*>(&w1);
          u32x4 w2 = {cvtpk(y2[0], y2[1]), cvtpk(y2[2], y2[3]), cvtpk(y2[4], y2[5]), cvtpk(y2[6], y2[7])}; qr[d0 + 2] = *reinterpret_cast<bf16x8*>(&w2); }
    }
    const int sr = tid >> 4, sc = (tid & 15) * 8, kws = AT_KSWZ(sr, sc * 2), vst0 = v_st(sr, sc), vst1 = v_st(32 + sr, sc);
    const int rr = tid >> 3, rc = (tid & 7) * 8, krws = AT_KRSWZ(rr, rc * 2);
    const bf16* Kg = K + ((size_t)(b * SEQ) * 8 + h) * 192;
    const bf16* Vg = KV + (size_t)(b * SEQ) * 2048 + h * 256 + 128;
    bf16x8 sa_k0, sa_k1, sa_kr, sa_v0, sa_v1, sb_k0, sb_k1, sb_kr, sb_v0, sb_v1;
#define AT_SLOAD(S, kb_) do { S##_k0 = *(const bf16x8*)(Kg + (size_t)((kb_) + sr) * 1536 + sc); S##_k1 = *(const bf16x8*)(Kg + (size_t)((kb_) + 32 + sr) * 1536 + sc); \
        S##_kr = *(const bf16x8*)(Kg + (size_t)((kb_) + rr) * 1536 + 128 + rc); \
        S##_v0 = *(const bf16x8*)(Vg + (size_t)((kb_) + sr) * 2048 + sc); S##_v1 = *(const bf16x8*)(Vg + (size_t)((kb_) + 32 + sr) * 2048 + sc); } while (0)
#define AT_SWRITE(S, bf, vbf) do { *(LAS bf16x8*)(K_lds + (bf) * SHM_K + kws) = S##_k0; *(LAS bf16x8*)(K_lds + (bf) * SHM_K + kws + 32 * 256) = S##_k1; \
        *(LAS bf16x8*)(KR_lds + (bf) * SHM_KR + krws) = S##_kr; \
        *(LAS bf16x8*)(V_lds + (vbf) * SHM_V + vst0) = S##_v0; *(LAS bf16x8*)(V_lds + (vbf) * SHM_V + vst1) = S##_v1; } while (0)
    AT_SLOAD(sa, 0); AT_SLOAD(sb, 64); AT_SWRITE(sa, 0, 0);
    __syncthreads();
    float m_reg = -1e30f, l_reg = 0.f; f32x16 o[4] = {};
    const unsigned vbase = (unsigned)(size_t)V_lds + (unsigned)v_rd_base(lane);
    const bool late = wid >= 4;
    bool pend = false; int pvb = 0; int vb3 = 0;
    bf16x8 pa0, pa1, pa2, pa3;
#define AT_STEP(t, SL, SW) do { \
        const int buf = (t) & 1, kb = (t) * 64; \
        if ((t) + 2 < NT) AT_SLOAD(SL, kb + 128);                         \
        if (late && pend) { pv_tile(o, vbase + pvb * SHM_V, pa0, pa1, pa2, pa3); pend = false; AT_SBAR(); } \
        if (kb <= qlo + 31) { \
            f32x16 p0, p1; float mn, alpha; \
            qkt(p0, p1, K_lds + buf * SHM_K, KR_lds + buf * SHM_KR, r32, hi, qr); \
            if (kb + 63 > qlo) mask_tile(p0, p1, qlo + r32 - 4 * hi - kb); \
            partialSM(p0, p1, m_reg, mn, alpha); \
            finishSM(p0, p1, alpha, l_reg, pa0, pa1, pa2, pa3); \
            if (__any(alpha < 1.f)) { if (hi == 0) al_l[r32] = alpha; asm volatile("s_waitcnt lgkmcnt(0)" ::: "memory"); \
                _Pragma("unroll") for (int d_ = 0; d_ < 4; ++d_) _Pragma("unroll") for (int r = 0; r < 16; ++r) o[d_][r] *= al_l[crow(r, hi)]; \
                asm volatile("s_waitcnt lgkmcnt(0)" ::: "memory"); } \
            AT_SBAR(); \
            if (late) { pend = true; pvb = vb3; } \
            else pv_tile(o, vbase + vb3 * SHM_V, pa0, pa1, pa2, pa3); \
        } \
        const int vn3 = vb3 == 2 ? 0 : vb3 + 1; \
        if ((t) + 1 < NT) AT_SWRITE(SW, buf ^ 1, vn3);                    \
        vb3 = vn3; \
        __syncthreads(); } while (0)
    for (int t = 0; t < NT; t += 2) { AT_STEP(t, sa, sb); AT_STEP(t + 1, sb, sa); }
#undef AT_STEP
    if (late && pend) pv_tile(o, vbase + pvb * SHM_V, pa0, pa1, pa2, pa3);
    if (hi == 0) li_l[r32] = l_reg;
    asm volatile("s_waitcnt lgkmcnt(0)" ::: "memory");
    float rli[16];
#pragma unroll
    for (int r = 0; r < 16; ++r) rli[r] = 1.0f / li_l[crow(r, hi)];
#pragma unroll
    for (int d0 = 0; d0 < 4; ++d0) { const int col = h * 128 + d0 * 32 + r32;
        unsigned short zr[16];
#pragma unroll
        for (int r = 0; r < 16; ++r) zr[r] = proj[(size_t)(b * SEQ + qlo + crow(r, hi)) * NPROJ + C_ZA + col];
#pragma unroll
        for (int r = 0; r < 16; ++r) { const int row = b * SEQ + qlo + crow(r, hi);
            const float v = o[d0][r] * rli[r] * silu_f(bf2f(zr[r]));
            const float vn = lane_xor<1>(v);
            if ((r32 & 1) == 0) *(unsigned*)(YA + (size_t)row * 1024 + col) = cvtpk(v, vn); } }
    asm volatile("s_waitcnt lgkmcnt(0)" ::: "memory");
    __syncthreads();
#undef AT_SLOAD
#undef AT_SWRITE
}
}


namespace sg {
using at::bf16x8; using at::f32x16;
__device__ __forceinline__ void sgu_item(LAS unsigned char* lds, const bf16* proj, const float* rv, const float* Ws, const float* bs, const float* vg, bf16* YB, int it) {
    const int tid = otid(), wid = __builtin_amdgcn_readfirstlane(tid >> 6), lane = tid & 63, r32 = lane & 31, hi = lane >> 5;
    {
        const int ch = it >> 2, gp = it & 3, R0 = ch * 128;
#pragma unroll
        for (int i = 0; i < 8; ++i) {
            const int idx = tid + 512 * i, gsel = idx >> 11, row = (idx >> 4) & 127, cc = idx & 15;
            const v4u w = *(const v4u*)(proj + (size_t)(R0 + row) * NPROJ + C_VB + (2 * gp + gsel) * 128 + cc * 8);
            const float s = 1.0f / sqrtf(rv[R0 + row] * (1.0f / 1024.f) + EPS);
            v4u o; o.x = pk2(gelu_f(lo16(w.x)) * s, gelu_f(hi16(w.x)) * s); o.y = pk2(gelu_f(lo16(w.y)) * s, gelu_f(hi16(w.y)) * s);
            o.z = pk2(gelu_f(lo16(w.z)) * s, gelu_f(hi16(w.z)) * s); o.w = pk2(gelu_f(lo16(w.w)) * s, gelu_f(hi16(w.w)) * s);
            *(LAS v4u*)(lds + (gsel * 2 + (row >> 6)) * 16384 + at::v_st(row & 63, cc * 8)) = o;
        }
        __syncthreads();
        const int gsel = wid >> 2, g = 2 * gp + gsel, t = 32 * (wid & 3) + r32;
        f32x16 o[4] = {};
        const int nst = (wid & 3) >= 2 ? 2 : 1;
        for (int st = 0; st < nst; ++st) {
            bf16x8 pa[4];
#pragma unroll
            for (int ks = 0; ks < 4; ++ks) {
                const int s0 = st * 64 + ks * 16 + hi * 8;
                const float* wp = Ws + ((size_t)g * 128 + t) * 128 + s0;
                const v4f a = *(const v4f*)wp, b = *(const v4f*)(wp + 4);
                float x[8] = {a.x, a.y, a.z, a.w, b.x, b.y, b.z, b.w};
#pragma unroll
                for (int j = 0; j < 8; ++j) if (s0 + j > t) x[j] = 0.f;
                at::u32x4 w4 = {at::cvtpk(x[0], x[1]), at::cvtpk(x[2], x[3]), at::cvtpk(x[4], x[5]), at::cvtpk(x[6], x[7])};
                pa[ks] = *reinterpret_cast<bf16x8*>(&w4);
            }
            const unsigned vbase = (unsigned)(size_t)(lds + (gsel * 2 + st) * 16384) + (unsigned)at::v_rd_base(lane);
            at::pv_tile(o, vbase, pa[0], pa[1], pa[2], pa[3]);
        }
#pragma unroll
        for (int d0 = 0; d0 < 4; ++d0) { const int gc = g * 128 + d0 * 32 + r32; const float vgc = vg[gc];
            unsigned short ur[16], zr[16];
#pragma unroll
            for (int r = 0; r < 16; ++r) { const size_t row = (size_t)(R0 + 32 * (wid & 3) + at::crow(r, hi)); ur[r] = proj[row * NPROJ + C_UB + gc]; zr[r] = proj[row * NPROJ + C_ZB + gc]; }
#pragma unroll
            for (int r = 0; r < 16; ++r) { const int tl = 32 * (wid & 3) + at::crow(r, hi); const size_t row = (size_t)(R0 + tl);
                const float mix = o[d0][r] * vgc + bs[g * 128 + tl];
                const float y = gelu_f(bf2f(ur[r])) * mix * silu_f(bf2f(zr[r])), yn = lane_xor<1>(y);
                if ((r32 & 1) == 0) *(unsigned*)(YB + row * 1024 + gc) = at::cvtpk(y, yn); } }
        __syncthreads();
    }
}
}


namespace gl {
using at::bf16x8; using at::f32x16; using at::s16x4; using at::u32x4;
constexpr int OFF_VIMG = 0, OFF_KLIMG = 65536, OFF_ATT = 98304, OFF_DS = 131072, OFF_PART = 131584, LDS_NEED = OFF_PART + 4096;

__device__ __forceinline__ void gla_prep_item(LAS unsigned char* lds, int seg_off, const bf16* proj, const float* wa2, const float* ba, bf16* QE, bf16* KE, bf16* KL, float* DS, int ci) {
    const int tid = otid(), k2 = tid & 63, ts = tid >> 6, k = 2 * k2;
    LAS float* seg = (LAS float*)(lds + seg_off);
    {
        const int ch = ci >> 2, h = ci & 3, R0 = ch * 128 + ts * 16;
        float wa0[16], wa1[16];
#pragma unroll
        for (int j = 0; j < 16; ++j) { const v2f w = *(const v2f*)(wa2 + j * 512 + h * 128 + k); wa0[j] = w.x; wa1[j] = w.y; }
        const v2f bak = *(const v2f*)(ba + h * 128 + k);
        float la0[16], la1[16]; float run0 = 0.f, run1 = 0.f;
#pragma unroll
        for (int i = 0; i < 16; ++i) {
            const bf16* pr = proj + (size_t)(R0 + i) * NPROJ + C_AR;
            const v4u w0 = *(const v4u*)pr, w1 = *(const v4u*)(pr + 8);
            const float ar[16] = {lo16(w0.x), hi16(w0.x), lo16(w0.y), hi16(w0.y), lo16(w0.z), hi16(w0.z), lo16(w0.w), hi16(w0.w),
                                  lo16(w1.x), hi16(w1.x), lo16(w1.y), hi16(w1.y), lo16(w1.z), hi16(w1.z), lo16(w1.w), hi16(w1.w)};
            float x0 = bak.x, x1 = bak.y;
#pragma unroll
            for (int j = 0; j < 16; ++j) { x0 += ar[j] * wa0[j]; x1 += ar[j] * wa1[j]; }
            run0 += (fminf(x0, 0.f) - __logf(1.0f + __expf(-fabsf(x0)))) * 0.0625f; la0[i] = run0;
            run1 += (fminf(x1, 0.f) - __logf(1.0f + __expf(-fabsf(x1)))) * 0.0625f; la1[i] = run1;
        }
        *(LAS v2f*)(seg + ts * 128 + k) = (v2f){run0, run1};
        __syncthreads();
        float pre0 = 0.f, pre1 = 0.f, tot0 = 0.f, tot1 = 0.f;
#pragma unroll
        for (int q = 0; q < 8; ++q) { const v2f sg = *(const LAS v2f*)(seg + q * 128 + k); tot0 += sg.x; tot1 += sg.y; if (q < ts) { pre0 += sg.x; pre1 += sg.y; } }
        const float et0 = __expf(tot0), et1 = __expf(tot1);
        unsigned qw[16], kw[16];
#pragma unroll
        for (int i = 0; i < 16; ++i) { const size_t row = (size_t)(R0 + i); qw[i] = *(const unsigned*)(proj + row * NPROJ + C_QC + h * 128 + k); kw[i] = *(const unsigned*)(proj + row * NPROJ + C_KC + h * 128 + k); }
#pragma unroll
        for (int i = 0; i < 16; ++i) {
            const size_t o = (size_t)(R0 + i) * 512 + h * 128 + k;
            const float e0 = __expf(la0[i] + pre0), e1 = __expf(la1[i] + pre1), r0 = __builtin_amdgcn_rcpf(e0), r1 = __builtin_amdgcn_rcpf(e1);
            const float q0 = lo16(qw[i]) * 0.08838834764831845f, q1 = hi16(qw[i]) * 0.08838834764831845f, kk0 = lo16(kw[i]) * r0, kk1 = hi16(kw[i]) * r1;
            *(unsigned*)(QE + o) = pk2(q0 * e0, q1 * e1);
            *(unsigned*)(KE + o) = pk2(kk0, kk1);
            *(unsigned*)(KL + o) = pk2(kk0 * et0, kk1 * et1);
        }
        if (ts == 0) *(v2f*)(DS + ((size_t)ch * 4 + h) * 128 + k) = (v2f){et0, et1};
        __syncthreads();
    }
}

#define GL_PK4(P, B_, OUT) do { unsigned a0 = at::cvtpk(P[B_+0], P[B_+1]), a1 = at::cvtpk(P[B_+2], P[B_+3]);                          \
        unsigned b0 = at::cvtpk(P[B_+4], P[B_+5]), b1 = at::cvtpk(P[B_+6], P[B_+7]);                                             \
        auto r0 = __builtin_amdgcn_permlane32_swap(a0, b0, false, false); auto r1 = __builtin_amdgcn_permlane32_swap(a1, b1, false, false); \
        u32x4 w = {r0[0], r1[0], r0[1], r1[1]}; OUT = *reinterpret_cast<bf16x8*>(&w); } while (0)
#define GL_TRRD(dst, addr, off) asm volatile("ds_read_b64_tr_b16 %0, %1 offset:%2" : "=&v"(dst) : "v"(addr), "i"(off) : "memory")

__device__ __forceinline__ void gla_chunk_item(LAS unsigned char* lds, const bf16* proj, const bf16* QE, const bf16* KE, const bf16* KL, float* OI, float* DL, int ci) {
    const int tid = otid(), wid = __builtin_amdgcn_readfirstlane(tid >> 6), lane = tid & 63, r32 = lane & 31, hi = lane >> 5;
    const int h = ci & 3, R0 = (ci >> 2) * 128;
    {
        {
#pragma unroll
            for (int i = 0; i < 8; ++i) { const int idx = tid + 512 * i, s = idx >> 5, cc = idx & 31;
                const v4u w = *(const v4u*)(proj + (size_t)(R0 + s) * NPROJ + C_VC + h * 256 + cc * 8);
                *(LAS v4u*)(lds + OFF_VIMG + ((s >> 6) * 2 + (cc >> 4)) * 16384 + at::v_st(s & 63, (cc & 15) * 8)) = w; }
#pragma unroll
            for (int i = 0; i < 4; ++i) { const int idx = tid + 512 * i, s = idx >> 4, cc = idx & 15;
                const v4u w = *(const v4u*)(KL + (size_t)(R0 + s) * 512 + h * 128 + cc * 8);
                *(LAS v4u*)(lds + OFF_KLIMG + (s >> 6) * 16384 + at::v_st(s & 63, cc * 8)) = w; }
#pragma unroll
            for (int j = 0; j < 2; ++j) {
                const int ti = 2 * wid + j, st = ti >> 2, tt = ti & 3;
                if (st <= tt) {
                    f32x16 p = {};
                    const bf16* ap = KE + (size_t)(R0 + 32 * st + r32) * 512 + h * 128 + hi * 8;
                    const bf16* bp = QE + (size_t)(R0 + 32 * tt + r32) * 512 + h * 128 + hi * 8;
                    bf16x8 fa[8], fb[8];
#pragma unroll
                    for (int ks = 0; ks < 8; ++ks) { fa[ks] = *(const bf16x8*)(ap + ks * 16); fb[ks] = *(const bf16x8*)(bp + ks * 16); }
#pragma unroll
                    for (int ks = 0; ks < 8; ++ks) p = __builtin_amdgcn_mfma_f32_32x32x16_bf16(fa[ks], fb[ks], p, 0, 0, 0);
                    __builtin_amdgcn_sched_group_barrier(0x020, 16, 0); __builtin_amdgcn_sched_group_barrier(0x008, 8, 0);
                    if (st == tt) {
#pragma unroll
                        for (int r = 0; r < 16; ++r) if (at::crow(r, hi) > r32) p[r] = 0.f; }
                    const int t = 32 * tt + r32;
#pragma unroll
                    for (int g = 0; g < 4; ++g) { v2u w; w.x = at::cvtpk(p[4 * g], p[4 * g + 1]); w.y = at::cvtpk(p[4 * g + 2], p[4 * g + 3]);
                        *(LAS v2u*)(lds + OFF_ATT + t * 256 + ((64 * st + 16 * g) ^ ((t & 7) << 4)) + 8 * hi) = w; }
                }
            }
            __syncthreads();
            bf16x8 vfr[8];
            { const unsigned vaddr = (unsigned)(size_t)(lds + OFF_VIMG + (wid >> 2) * 16384) + (unsigned)at::v_rd_base(lane) + (unsigned)((wid & 3) * 512);
              s16x4 vl[8], vh[8];
#define GL_VF(ks8) do { constexpr int o_ = ((ks8) >> 2) * 32768 + ((ks8) & 3) * 4096; GL_TRRD(vl[ks8], vaddr, o_); GL_TRRD(vh[ks8], vaddr, o_ + 2048); } while (0)
              GL_VF(0); GL_VF(1); GL_VF(2); GL_VF(3); GL_VF(4); GL_VF(5); GL_VF(6); GL_VF(7);
#undef GL_VF
              asm volatile("s_waitcnt lgkmcnt(0)" ::: "memory"); AT_SBAR();
#pragma unroll
              for (int q = 0; q < 8; ++q) vfr[q] = (bf16x8){vl[q][0], vl[q][1], vl[q][2], vl[q][3], vh[q][0], vh[q][1], vh[q][2], vh[q][3]};
              AT_SBAR(); }
            float* oi = OI + (((size_t)ci * 8 + wid) * 16 * 64 + lane) * 4;
            float* dl = DL + (((size_t)ci * 8 + wid) * 16 * 64 + lane) * 4;
#pragma unroll
            for (int tt = 0; tt < 4; ++tt) {
                f32x16 acc = {};
                const int t = 32 * tt + r32;
#pragma unroll
                for (int ks8 = 0; ks8 < 8; ++ks8) if (ks8 <= 2 * tt + 1) {
                    const bf16x8 a = *(const LAS bf16x8*)(lds + OFF_ATT + t * 256 + (((16 * ks8 + 8 * hi) * 2) ^ ((t & 7) << 4)));
                    acc = __builtin_amdgcn_mfma_f32_32x32x16_bf16(a, vfr[ks8], acc, 0, 0, 0); }
#pragma unroll
                for (int r4 = 0; r4 < 4; ++r4) *(v4f*)(oi + (size_t)(tt * 4 + r4) * 256) = (v4f){acc[4 * r4], acc[4 * r4 + 1], acc[4 * r4 + 2], acc[4 * r4 + 3]};
            }
#pragma unroll
            for (int kt = 0; kt < 4; ++kt) {
                f32x16 D = {};
                const unsigned kaddr = (unsigned)(size_t)(lds + OFF_KLIMG) + (unsigned)at::v_rd_base(lane) + (unsigned)(kt * 512);
#define GL_KF(ks8) do { s16x4 l_, h_; constexpr int o_ = ((ks8) >> 2) * 16384 + ((ks8) & 3) * 4096; GL_TRRD(l_, kaddr, o_); GL_TRRD(h_, kaddr, o_ + 2048); \
                asm volatile("s_waitcnt lgkmcnt(0)" ::: "memory"); AT_SBAR(); \
                D = __builtin_amdgcn_mfma_f32_32x32x16_bf16((bf16x8){l_[0], l_[1], l_[2], l_[3], h_[0], h_[1], h_[2], h_[3]}, vfr[ks8], D, 0, 0, 0); } while (0)
                GL_KF(0); GL_KF(1); GL_KF(2); GL_KF(3); GL_KF(4); GL_KF(5); GL_KF(6); GL_KF(7);
#undef GL_KF
#pragma unroll
                for (int r4 = 0; r4 < 4; ++r4) *(v4f*)(dl + (size_t)(kt * 4 + r4) * 256) = (v4f){D[4 * r4], D[4 * r4 + 1], D[4 * r4 + 2], D[4 * r4 + 3]};
            }
            __syncthreads();
        }
    }
}

__device__ __forceinline__ void gla_stageA_item(const float* DS, const float* DL, bf16* XB, int b, int h, int vp) {
    const int tid = otid(), wid = __builtin_amdgcn_readfirstlane(tid >> 6), lane = tid & 63, hi = lane >> 5;
    const int vb = 2 * vp + (wid >> 2), kt = wid & 3;
    constexpr int PF = 4, NC = SEQ / 128;
    f32x16 X = {};
    v4f dq[PF][4], sq[PF][4];
    const size_t ci0 = (size_t)(b * 32) * 4 + h;
#define GL_ALOAD(slot, c_) do { const size_t ci_ = ci0 + (size_t)(c_) * 4; const float* dl_ = DL + ((ci_ * 8 + vb) * 16 * 64 + lane) * 4 + (size_t)(kt * 4) * 256; const float* ds_ = DS + ci_ * 128 + 32 * kt + 4 * hi; \
        _Pragma("unroll") for (int r4 = 0; r4 < 4; ++r4) { dq[slot][r4] = *(const v4f*)(dl_ + (size_t)r4 * 256); sq[slot][r4] = *(const v4f*)(ds_ + 8 * r4); } } while (0)
#pragma unroll
    for (int s = 0; s < PF; ++s) GL_ALOAD(s, s);
    for (int c0 = 0; c0 < NC; c0 += PF) {
#pragma unroll
        for (int s = 0; s < PF; ++s) {
            const int c = c0 + s; const size_t ci = ci0 + (size_t)c * 4;
            bf16* xo = XB + (((ci * 8 + vb) * 8 + kt * 2) * 64 + lane) * 8;
            bf16x8 xb0, xb1; GL_PK4(X, 0, xb0); GL_PK4(X, 8, xb1);
            *(bf16x8*)xo = xb0; *(bf16x8*)(xo + 512) = xb1;
#pragma unroll
            for (int r4 = 0; r4 < 4; ++r4) { const v4f w = dq[s][r4], d4 = sq[s][r4];
                X[4 * r4] = X[4 * r4] * d4.x + w.x; X[4 * r4 + 1] = X[4 * r4 + 1] * d4.y + w.y; X[4 * r4 + 2] = X[4 * r4 + 2] * d4.z + w.z; X[4 * r4 + 3] = X[4 * r4 + 3] * d4.w + w.w; }
            if (c + PF < NC) GL_ALOAD(s, c + PF);
        }
    }
#undef GL_ALOAD
}
__device__ __forceinline__ void gla_stageB_item(const bf16* proj, const bf16* QE, const float* OI, const bf16* XB, const float* og, bf16* YC, int b, int h, int cp) {
    const int tid = otid(), wid = __builtin_amdgcn_readfirstlane(tid >> 6), lane = tid & 63, r32 = lane & 31, hi = lane >> 5;
    {
        const int c = 2 * cp + (wid >> 2), tt = wid & 3, R0 = b * SEQ + c * 128;
        const size_t ci = (size_t)(b * 32 + c) * 4 + h;
        f32x16 acc[8];
#pragma unroll
        for (int vb = 0; vb < 8; ++vb) { const float* oi = OI + ((ci * 8 + vb) * 16 * 64 + lane) * 4 + (size_t)(tt * 4) * 256;
#pragma unroll
            for (int r4 = 0; r4 < 4; ++r4) { const v4f w = *(const v4f*)(oi + (size_t)r4 * 256); acc[vb][4 * r4] = w.x; acc[vb][4 * r4 + 1] = w.y; acc[vb][4 * r4 + 2] = w.z; acc[vb][4 * r4 + 3] = w.w; } }
        bf16x8 qa[8];
        { const bf16* qp = QE + (size_t)(R0 + 32 * tt + r32) * 512 + h * 128 + hi * 8;
#pragma unroll
          for (int ks = 0; ks < 8; ++ks) qa[ks] = *(const bf16x8*)(qp + ks * 16); }
        if (c > 0) {
            const bf16* xi = XB + (((ci * 8) * 8) * 64 + lane) * 8;
            bf16x8 xf[64];
#pragma unroll
            for (int i = 0; i < 64; ++i) xf[i] = *(const bf16x8*)(xi + (size_t)i * 512);
#pragma unroll
            for (int i = 0; i < 64; ++i) acc[i >> 3] = __builtin_amdgcn_mfma_f32_32x32x16_bf16(qa[i & 7], xf[i], acc[i >> 3], 0, 0, 0);
            __builtin_amdgcn_sched_group_barrier(0x020, 16, 0);
#pragma unroll
            for (int i = 0; i < 48; ++i) { __builtin_amdgcn_sched_group_barrier(0x008, 1, 0); __builtin_amdgcn_sched_group_barrier(0x020, 1, 0); }
            __builtin_amdgcn_sched_group_barrier(0x008, 16, 0);
        }
        float rn[16];
#pragma unroll
        for (int r = 0; r < 16; ++r) { float s = 0.f;
#pragma unroll
            for (int vb = 0; vb < 8; ++vb) s += acc[vb][r] * acc[vb][r];
            s += lane_xor<1>(s); s += lane_xor<2>(s); s += lane_xor<4>(s); s += lane_xor<8>(s); s += lane_xor<16>(s);
            rn[r] = 1.0f / sqrtf(s * (1.0f / 256.f) + EPS); }
#pragma unroll
        for (int vb = 0; vb < 8; ++vb) { const float gcol = og[32 * vb + r32];
            unsigned short zr[16];
#pragma unroll
            for (int r = 0; r < 16; ++r) zr[r] = proj[(size_t)(R0 + 32 * tt + at::crow(r, hi)) * NPROJ + C_ZC + h * 256 + 32 * vb + r32];
#pragma unroll
            for (int r = 0; r < 16; ++r) { const size_t row = (size_t)(R0 + 32 * tt + at::crow(r, hi));
                const float y = acc[vb][r] * rn[r] * gcol * silu_f(bf2f(zr[r])), yn = lane_xor<1>(y);
                if ((r32 & 1) == 0) *(unsigned*)(YC + row * 1024 + h * 256 + 32 * vb + r32) = at::cvtpk(y, yn); } }
    }
}
#undef GL_PK4
#undef GL_TRRD
}


constexpr int CW_Q = 65536;
__device__ __forceinline__ int q_pop(unsigned* ctr, LAS unsigned* slot) {
    if (otid() == 0) *slot = __hip_atomic_fetch_add(ctr, 1u, __ATOMIC_RELAXED, __HIP_MEMORY_SCOPE_AGENT);
    __syncthreads(); const int v = (int)*slot; __syncthreads(); return v; }
__device__ __forceinline__ void ph_mixers(LAS unsigned char* lds, unsigned char* ws, unsigned* qctr, const float* Ws, const float* bs, const float* vg, const float* og, const float* qg, int row0, int vb) {
    constexpr int NGLA = NBP * 8, NATT = 16 * NBP, NSGU = 16 * NBP, NQ = NGLA + NATT + NSGU;
    static_assert(NBP % 2 == 0, "NBP even");
    LAS unsigned* slot = (LAS unsigned*)(lds + LDSCTL_OFF + 64);
    bf16* proj = (bf16*)(ws + WS_PROJ);
    for (int dq = 0; dq < 8; ++dq) {
        const int q = (vb + dq) & 7;
        for (;;) {
            const int idx = q_pop(qctr + q * 64, slot);
            if (idx >= NQ) break;
            if (idx >= NATT && idx < NATT + NGLA) { const int gi = q * NGLA + (idx - NATT), bh = gi >> 4, cp = gi & 15;
                gl::gla_stageB_item(proj, (const bf16*)(ws + WS_QE), (const float*)(ws + WS_OC), (const bf16*)(ws + WS_XB), og, (bf16*)(ws + WS_YC), bh >> 2, bh & 3, cp); }
            else if (idx < NATT) { const int j = idx, qb = 15 - j / NBP, bh = q * NBP + j % NBP;
                at::attn_block(lds, (const bf16*)(ws + WS_Q), (const bf16*)(ws + WS_K), (const bf16*)(ws + WS_KV), proj, (bf16*)(ws + WS_YA), qg, (const float*)(ws + WS_COS) + (size_t)row0 * 32, (const float*)(ws + WS_SIN) + (size_t)row0 * 32, bh >> 3, bh & 7, qb); }
            else { const int it = q * NSGU + (idx - NGLA - NATT);
                sg::sgu_item(lds, proj, (const float*)(ws + WS_SSQ) + 2 * MP, Ws, bs, vg, (bf16*)(ws + WS_YB), it); }
        }
    }
}
#ifndef GEMM_SP2
#define GEMM_SP2 true
#endif
#ifndef GEMM_ALIGN
#define GEMM_ALIGN true
#endif
typedef const __attribute__((address_space(4))) Args* KArgP;
#define KARG() ({ KArgP p_ = (KArgP)__builtin_amdgcn_kernarg_segment_ptr(); asm volatile("" : "+s"(p_)); p_; })
#define INF(i) ((const float*)ap->in[i])
__device__ __forceinline__ void grid_bar(const XcdBarrier& b0) { XcdBarrier b = b0; asm volatile("" : "+s"(b.bar)); xcd_barrier(b); }

__global__ void __launch_bounds__(512, 2) fwd(Args a) {
    extern __shared__ __attribute__((aligned(16))) unsigned char lds_raw[];
    LAS unsigned char* lds = (LAS unsigned char*)lds_raw;
    const int lo = a.lo, hi = a.hi;
    XcdBarrier bar; bar.bar = (unsigned*)(a.ws + WS_CTL) + CW_BAR; bar.x = 0; bar.st = nullptr;
    if (hi - lo > 1) {
        if (threadIdx.x < 4) ((LAS unsigned*)(lds + LDSCTL_OFF))[threadIdx.x] = 0u;
        __syncthreads();
        bar = xcd_barrier_post((unsigned*)(a.ws + WS_CTL) + CW_BAR, (volatile LAS unsigned*)(lds + LDSCTL_OFF));
    }
    int step = 0;
#define PH_BEGIN if (step >= lo && step < hi) { const KArgP ap = KARG(); unsigned char* const ws = ap->ws; const int vb = obid(), nvb = gridDim.x; (void)ws; (void)vb; (void)nvb;
#define PH_END   if (step + 1 < hi) grid_bar(bar); } ++step;
#define WL(l) (ws + WS_W + (size_t)(l) * SZ_WLAYER)
#define B_(T, off) ((T*)(ws + (off)))

    for (int l = 0; l < DEPTH; ++l) {
        PH_BEGIN
            { unsigned char* wl = ws + WS_W;
              convert_T<1>(INF(3) + (size_t)l * DM * IN_COLS, DM, IN_COLS, (bf16*)wl, NBF, (LAS float*)lds, vb, nvb);
              convert_T8(INF(3) + (size_t)l * DM * IN_COLS, DM, IN_COLS, wl + SZ_WINB, NF8, (LAS float*)lds, (vb + 96) % nvb, nvb);
              convert_T<0>(INF(6) + (size_t)l * 512 * 1536, 512, 1536, (bf16*)(wl + SZ_WIN), 1536, (LAS float*)lds, (vb + 64) % nvb, nvb, INF(4) + l * 512);
              convert_T<0>(INF(7) + (size_t)l * 512 * 2048, 512, 2048, (bf16*)(wl + SZ_WIN + SZ_WUQ), 2048, (LAS float*)lds, (vb + 128) % nvb, nvb, INF(5) + l * 512);
              for (int b = 0; b < 3; ++b)
                  convert_T<0>(INF(16) + ((size_t)l * 3 + b) * 1024 * 2048, 1024, 2048, (bf16*)(wl + SZ_WIN + SZ_WUQ + SZ_WUKV) + (size_t)b * 2048 * 1024, 2048, (LAS float*)lds, (vb + 32 * b) % nvb, nvb);
              convert_T<0>(INF(17) + (size_t)l * 2048 * 2048, 2048, 2048, (bf16*)(wl + SZ_WIN + SZ_WUQ + SZ_WUKV + SZ_WB), 2048, (LAS float*)lds, (vb + 192) % nvb, nvb); }
            if (l == 0) { const int* positions = (const int*)ap->in[1]; float* cosT = B_(float, WS_COS); float* sinT = B_(float, WS_SIN);
              for (int idx = vb * 512 + otid(); idx < MTOK * 32; idx += nvb * 512) {
                const int t = idx >> 5, i = idx & 31;
                const float inv = 1.0f / powf(10000.0f, (float)(2 * i) * (1.0f / 64.0f));
                const float ang = (float)positions[t] * inv;
                float sn, cs; sincosf(ang, &sn, &cs);
                cosT[idx] = cs; sinT[idx] = sn; } }
        PH_END
        for (int p = 0; p < NPASS; ++p) {
            const int row0 = p * MP;
#define XIN ((l == 0 ? (const float*)ap->in[0] : (const float*)ap->out) + (size_t)row0 * DM)
#define WLP (ws + WS_W)
            PH_BEGIN ph_norm(XIN, INF(2) + l * DM, B_(bf16, WS_H), B_(unsigned char, WS_H8), MP, vb, nvb);
                     { float* ssq = B_(float, WS_SSQ); for (int i = vb * 512 + otid(); i < 3 * MP; i += nvb * 512) ssq[i] = 0.f; } PH_END
            PH_BEGIN { { pg8::Gemm g{B_(bf16, WS_H), (const bf16*)WLP, MP, NBF, DM}; pg8::StaticOrder S; S.init(MP, NBF, nvb, vb); pg8::EpiProj E{B_(bf16, WS_PROJ), NPROJ, B_(float, WS_SSQ), MP, 0};
                         pg8::gemm_phase<pg8::EpiProj, pg8::StaticOrder, false, GEMM_ALIGN, GEMM_SP2>(lds, g, S, E, nullptr); }
                       { pg8::Gemm g{(const bf16*)B_(unsigned char, WS_H8), (const bf16*)(WLP + SZ_WINB), MP, NF8, DM / 2}; pg8::StaticOrder S; S.init(MP, NF8, nvb, vb);
                         { const int ub = (MP / 256) * (NBF / 256), u8 = (MP / 256) * (NF8 / 256), sk = ub % nvb;
                           if (sk > 0 && sk < nvb) { S.skip = sk; S.full = (u8 - 2 * (nvb - sk)) / nvb; if (S.full < 0) S.full = 0; } }
                         pg8::EpiProj E{B_(bf16, WS_PROJ) + NBF, NPROJ, B_(float, WS_SSQ), MP, NBF / 256};
                         pg8::gemm_phase<pg8::EpiProj, pg8::StaticOrder, false, GEMM_ALIGN, GEMM_SP2, true>(lds, g, S, E, nullptr); } } PH_END
            PH_BEGIN { { pg8::Gemm g{B_(bf16, WS_PROJ) + C_CQ, (const bf16*)(WLP + SZ_WIN), MP, 1536, 512, NPROJ}; pg8::StaticOrder S; S.init(MP, 1536, nvb, vb); pg8::EpiBf16Row E{B_(bf16, WS_Q), 1536, B_(float, WS_SSQ), 1.0f / 512.f, EPS};
                         pg8::gemm_phase<pg8::EpiBf16Row, pg8::StaticOrder, false, GEMM_ALIGN, GEMM_SP2>(lds, g, S, E, nullptr); }
                       { pg8::Gemm g{B_(bf16, WS_PROJ) + C_CKV, (const bf16*)(WLP + SZ_WIN + SZ_WUQ), MP, 2048, 512, NPROJ}; pg8::StaticOrder S; S.init(MP, 2048, nvb, nvb - 1 - vb); pg8::EpiBf16Row E{B_(bf16, WS_KV), 2048, B_(float, WS_SSQ) + MP, 1.0f / 512.f, EPS};
                         pg8::gemm_phase<pg8::EpiBf16Row, pg8::StaticOrder, false, GEMM_ALIGN, GEMM_SP2>(lds, g, S, E, nullptr); }
                       for (int ci = vb; ci < (MP / 128) * 4; ci += nvb) {
                           gl::gla_prep_item(lds, 135168, B_(bf16, WS_PROJ), INF(13) + l * 16 * 512, INF(14) + l * 512, B_(bf16, WS_QE), B_(bf16, WS_KE), B_(bf16, WS_KL), B_(float, WS_DS), ci);
                           gl::gla_chunk_item(lds, B_(bf16, WS_PROJ), B_(bf16, WS_QE), B_(bf16, WS_KE), B_(bf16, WS_KL), B_(float, WS_OC), B_(float, WS_DL), ci); } } PH_END
            PH_BEGIN { constexpr int NA = NBP * 16;
                       if (nvb > 2 * NA) { if (vb < NA) gl::gla_stageA_item(B_(float, WS_DS), B_(float, WS_DL), B_(bf16, WS_XB), vb >> 4, (vb >> 2) & 3, vb & 3);
                                           else ph_kfin(B_(bf16, WS_KV), B_(bf16, WS_PROJ), B_(bf16, WS_K), INF(9) + l * 192, B_(float, WS_COS), B_(float, WS_SIN), row0, vb - NA, nvb - NA); }
                       else { for (int it = vb; it < NA; it += nvb) gl::gla_stageA_item(B_(float, WS_DS), B_(float, WS_DL), B_(bf16, WS_XB), it >> 4, (it >> 2) & 3, it & 3);
                              ph_kfin(B_(bf16, WS_KV), B_(bf16, WS_PROJ), B_(bf16, WS_K), INF(9) + l * 192, B_(float, WS_COS), B_(float, WS_SIN), row0, vb, nvb); } } PH_END
            PH_BEGIN ph_mixers(lds, ws, (unsigned*)(ws + WS_CTL) + CW_Q + (l * NPASS + p) * 8 * 64, INF(11) + (size_t)l * 8 * 128 * 128, INF(12) + l * 8 * 128, INF(10) + l * 1024, INF(15) + l * 256, INF(8) + l * 192, row0, vb); PH_END
            PH_BEGIN { pg8::Gemm g{B_(bf16, WS_YA), (const bf16*)(WLP + SZ_WIN + SZ_WUQ + SZ_WUKV), MP, 2048, 1024};
                       pg8::BranchOrder S; S.init(MP, 2048, nvb, vb); S.NB = 3; S.a_stride = (size_t)MP * 1024 * 2; S.b_stride = (size_t)2048 * 1024 * 2;
                       pg8::EpiMerge E{B_(bf16, WS_PROJ) + C_GATE, NPROJ, B_(bf16, WS_MG), 2048, 2048}; pg8::gemm_phase<pg8::EpiMerge, pg8::BranchOrder, false, GEMM_ALIGN, GEMM_SP2>(lds, g, S, E, nullptr); } PH_END
            PH_BEGIN { pg8::Gemm g{B_(bf16, WS_MG), (const bf16*)(WLP + SZ_WIN + SZ_WUQ + SZ_WUKV + SZ_WB), MP, 2048, 2048}; pg8::StaticOrder S; S.init(MP, 2048, nvb, vb); pg8::EpiRes E{XIN, ap->out + (size_t)row0 * DM, 2048};
                       pg8::gemm_phase<pg8::EpiRes, pg8::StaticOrder, false, GEMM_ALIGN, GEMM_SP2>(lds, g, S, E, nullptr); } PH_END
        }
    }
#undef PH_BEGIN
#undef PH_END
}

#ifndef ONE_LAUNCH
#define ONE_LAUNCH 1
#endif
extern "C" void kernel_launch(void* const* d_in, const int* in_sizes, int n_in, void* d_out, int out_size, void* d_ws, size_t ws_size, hipStream_t stream) {
    static int grid = 0;
    if (grid == 0) {
        if (n_in != 18 || out_size != MTOK * DM || ws_size < WS_END) { fprintf(stderr, "kernel_launch: unexpected shapes (n_in %d out %d ws %zu need %zu)\n", n_in, out_size, ws_size, (size_t)WS_END); grid = -1; return; }
        int dev = 0, cus = 0, per_cu = 0;
        if (hipGetDevice(&dev) != hipSuccess || hipDeviceGetAttribute(&cus, hipDeviceAttributeMultiprocessorCount, dev) != hipSuccess) { grid = -1; return; }
        if (hipFuncSetAttribute((const void*)fwd, hipFuncAttributeMaxDynamicSharedMemorySize, LDS_BYTES) != hipSuccess) { fprintf(stderr, "kernel_launch: hipFuncSetAttribute failed\n"); grid = -1; return; }
        if (hipOccupancyMaxActiveBlocksPerMultiprocessor(&per_cu, (const void*)fwd, 512, LDS_BYTES) != hipSuccess || per_cu < 1) { fprintf(stderr, "kernel_launch: occupancy query says %d\n", per_cu); }
        (void)hipGetLastError();
        grid = cus;
    }
    if (grid < 0) return;
    (void)hipMemsetAsync((char*)d_ws + WS_CTL, 0, CTL_BYTES, stream);
    Args a{};
    for (int i = 0; i < 18; ++i) a.in[i] = d_in[i];
    a.out = (float*)d_out; a.ws = (unsigned char*)d_ws; a.pad0 = 0; a.pad1 = 0;
#if ONE_LAUNCH
    a.lo = 0; a.hi = NSTEPS;
    hipLaunchKernelGGL(fwd, dim3(grid), dim3(512), LDS_BYTES, stream, a);
#else
    for (int s = 0; s < NSTEPS; ++s) { a.lo = s; a.hi = s + 1; hipLaunchKernelGGL(fwd, dim3(grid), dim3(512), LDS_BYTES, stream, a); }
#endif
}
```

```cpp
#include <hip/hip_runtime.h>
#include <cstdio>
#include <cstdint>
__device__ __forceinline__ int otid() { int t = threadIdx.x; asm volatile("" : "+v"(t)); return t; }
__device__ __forceinline__ int obid() { int t = blockIdx.x; asm volatile("" : "+s"(t)); return t; }
namespace pg8 {
#define PG8_LAS __attribute__((address_space(3)))
typedef unsigned short bf16_t;
typedef short bf16x8 __attribute__((ext_vector_type(8)));
typedef float f32x4 __attribute__((ext_vector_type(4)));
typedef unsigned u32x4 __attribute__((ext_vector_type(4)));
constexpr int BM = 256, BK = 64, HALF = 128, HTB = HALF * BK * 2  , STAGE_BYTES = 8 * HTB, NXCD = 8, WGM = 4;

__host__ __device__ __forceinline__ int lds_byte(int r, int c) { const int st = (r >> 4) * 2 + (c >> 5), rr = r & 15, cc = c & 31, ob = rr * 64 + cc * 2; return st * 1024 + (ob ^ (((ob >> 9) & 1) << 5)); }
__host__ __device__ __forceinline__ void stage_rc(int b, int& R, int& C) { const int st = b / 1024, sb = b % 1024, swz = sb ^ (((sb >> 9) & 1) << 5); R = (st >> 1) * 16 + swz / 64; C = (st & 1) * 32 + (swz % 64) / 2; }
__host__ __device__ __forceinline__ int perm32(int rho) { const int n = rho >> 4, i = rho & 15; return 8 * (i >> 2) + 4 * n + (i & 3); }

struct Unit { int pm, pn, pb; };
struct Gemm { const bf16_t* A; const bf16_t* Bt; int M, N, K; int lda; };

struct StaticOrder {
    int nM, nN, nwg, G, c, full = 1 << 30, skip = 0;
    __host__ __device__ void init(int M, int N, int G_, int c_) { nM = M / BM; nN = N / BM; nwg = nM * nN; G = G_; c = c_; }
    __host__ __device__ bool next(int i, Unit& u) const {
        long L; if (i < full) L = (long)i * G + c; else { if (c < skip) return false; L = (long)full * G + (long)(i - full) * (G - skip) + (c - skip); }
        if (L >= nwg) return false;
        int wgid = (int)L; { const int q = nwg / NXCD, r = nwg % NXCD, xcd = wgid % NXCD, off = wgid / NXCD; wgid = (xcd < r ? xcd * (q + 1) : r * (q + 1) + (xcd - r) * q) + off; }
        const int nig = WGM * nN, gid = wgid / nig, fm = gid * WGM, gsz = (nM - fm) < WGM ? (nM - fm) : WGM;
        u.pm = fm + ((wgid % nig) % gsz); u.pn = (wgid % nig) / gsz; u.pb = 0; return true;
    }
    __device__ __forceinline__ size_t a_off(const Unit&) const { return 0; }
    __device__ __forceinline__ size_t b_off(const Unit&) const { return 0; }
    __device__ __forceinline__ void a_ready(const Unit&) const {}
    __device__ __forceinline__ void done(const Unit&) const {}
};

struct BranchOrder : StaticOrder {
    int NB; size_t a_stride, b_stride;
    __device__ bool next(int i, Unit& u) const { const int ti = i / NB; if (!StaticOrder::next(ti, u)) return false; u.pb = i - ti * NB; return true; }
    __device__ __forceinline__ size_t a_off(const Unit& u) const { return (size_t)u.pb * a_stride; }
    __device__ __forceinline__ size_t b_off(const Unit& u) const { return (size_t)u.pb * b_stride; }
};

__device__ __forceinline__ unsigned cvt_pk_bf16(float lo, float hi) { unsigned r; asm("v_cvt_pk_bf16_f32 %0, %1, %2" : "=v"(r) : "v"(lo), "v"(hi)); return r; }
__device__ __forceinline__ float gelu_tanh_f(float x) { const float u2 = 1.5957691216057308f * (x + 0.044715f * x * x * x); return x * __builtin_amdgcn_rcpf(1.f + __expf(-u2)); }
struct EpiProj {
    static constexpr bool PERM = true, AFTER_DRAIN = false;
    bf16_t* O; int ldc; float* SSQ; int mrows; int pn0;
    __device__ __forceinline__ void operator()(const f32x4 (&acc)[2][2][4][2], const Unit& u, int wr, int wc, int fr, int fq) const {
        const int row0 = u.pm * BM + wr * 64 + fr, col0 = u.pn * BM + wc * 32 + 8 * fq;
        const int apn = u.pn + pn0;
        const int seg = !SSQ ? -1 : ((apn == 25 || apn == 26) ? 0 : ((apn == 27 || apn == 28) ? 1 : ((apn >= 4 && apn < 8) ? 2 : -1)));
#pragma unroll
        for (int ai = 0; ai < 2; ++ai)
#pragma unroll
            for (int m = 0; m < 4; ++m) { const int row = row0 + ai * HALF + m * 16; bf16_t* rowp = O + (size_t)row * ldc + col0;
                float ss = 0.f;
#pragma unroll
                for (int bj = 0; bj < 2; ++bj) { const f32x4 v0 = acc[ai][bj][m][0], v1 = acc[ai][bj][m][1];
                    u32x4 w; w.x = cvt_pk_bf16(v0[0], v0[1]); w.y = cvt_pk_bf16(v0[2], v0[3]); w.z = cvt_pk_bf16(v1[0], v1[1]); w.w = cvt_pk_bf16(v1[2], v1[3]);
                    *(u32x4*)(rowp + bj * HALF) = w;
                    if (seg >= 0) {
#pragma unroll
                        for (int j = 0; j < 4; ++j) { float a = v0[j], b = v1[j]; if (seg == 2) { a = gelu_tanh_f(a); b = gelu_tanh_f(b); } ss += a * a + b * b; } } }
                if (seg >= 0) {
                    ss += __uint_as_float((unsigned)__builtin_amdgcn_ds_swizzle((int)__float_as_uint(ss), (16 << 10) | 0x1f));
                    auto rr = __builtin_amdgcn_permlane32_swap(__float_as_uint(ss), __float_as_uint(ss), false, false);
                    ss = __uint_as_float(rr[0]) + __uint_as_float(rr[1]);
                    if (fq == 0) atomicAdd(SSQ + (size_t)seg * mrows + row, ss); } }
    }
};
struct EpiBf16Row {
    static constexpr bool PERM = true, AFTER_DRAIN = false;
    bf16_t* O; int ldc; const float* SSQ; float inv_n, eps;
    __device__ __forceinline__ void operator()(const f32x4 (&acc)[2][2][4][2], const Unit& u, int wr, int wc, int fr, int fq) const {
        const int row0 = u.pm * BM + wr * 64 + fr, col0 = u.pn * BM + wc * 32 + 8 * fq;
        float sq[2][4];
#pragma unroll
        for (int ai = 0; ai < 2; ++ai)
#pragma unroll
            for (int m = 0; m < 4; ++m) sq[ai][m] = SSQ[row0 + ai * HALF + m * 16];
#pragma unroll
        for (int ai = 0; ai < 2; ++ai)
#pragma unroll
            for (int m = 0; m < 4; ++m) { const int row = row0 + ai * HALF + m * 16; bf16_t* rowp = O + (size_t)row * ldc + col0;
                const float rn = 1.0f / sqrtf(sq[ai][m] * inv_n + eps);
#pragma unroll
                for (int bj = 0; bj < 2; ++bj) { const f32x4 v0 = acc[ai][bj][m][0] * rn, v1 = acc[ai][bj][m][1] * rn;
                    u32x4 w; w.x = cvt_pk_bf16(v0[0], v0[1]); w.y = cvt_pk_bf16(v0[2], v0[3]); w.z = cvt_pk_bf16(v1[0], v1[1]); w.w = cvt_pk_bf16(v1[2], v1[3]);
                    *(u32x4*)(rowp + bj * HALF) = w; } }
    }
};
struct EpiRes {
    static constexpr bool PERM = false, AFTER_DRAIN = false;
    const float* base; float* C; int ldc;
    __device__ __forceinline__ void operator()(const f32x4 (&acc)[2][2][4][2], const Unit& u, int wr, int wc, int fr, int fq) const {
        const int row0 = u.pm * BM + wr * 64 + fr, col0 = u.pn * BM + wc * 32 + 4 * fq;
#pragma unroll
        for (int ai = 0; ai < 2; ++ai) {
            f32x4 bs[4][2][2];
#pragma unroll
            for (int m = 0; m < 4; ++m) { const size_t off = (size_t)(row0 + ai * HALF + m * 16) * ldc + col0;
#pragma unroll
                for (int bj = 0; bj < 2; ++bj)
#pragma unroll
                    for (int n = 0; n < 2; ++n) bs[m][bj][n] = *(const f32x4*)(base + off + bj * HALF + n * 16); }
#pragma unroll
            for (int m = 0; m < 4; ++m) { const size_t off = (size_t)(row0 + ai * HALF + m * 16) * ldc + col0;
#pragma unroll
                for (int bj = 0; bj < 2; ++bj)
#pragma unroll
                    for (int n = 0; n < 2; ++n) *(f32x4*)(C + off + bj * HALF + n * 16) = acc[ai][bj][m][n] + bs[m][bj][n]; }
            asm volatile("" ::: "memory");
        }
    }
};
struct EpiMerge {
    static constexpr bool PERM = true, AFTER_DRAIN = false;
    const bf16_t* G0; int ldg; bf16_t* MG; int ldc; int gstride;
    __device__ __forceinline__ void operator()(const f32x4 (&acc)[2][2][4][2], const Unit& u, int wr, int wc, int fr, int fq) const {
        const int row0 = u.pm * BM + wr * 64 + fr, col0 = u.pn * BM + wc * 32 + 8 * fq; const bf16_t* G = G0 + (size_t)u.pb * gstride; const bool first = u.pb == 0;
#pragma unroll
        for (int ai = 0; ai < 2; ++ai) {
            u32x4 gw[4][2], ow[4][2];
#pragma unroll
            for (int m = 0; m < 4; ++m) { const size_t row = (size_t)(row0 + ai * HALF + m * 16);
#pragma unroll
                for (int bj = 0; bj < 2; ++bj) { gw[m][bj] = *(const u32x4*)(G + row * ldg + col0 + bj * HALF); ow[m][bj] = first ? (u32x4){0u, 0u, 0u, 0u} : *(const u32x4*)(MG + row * ldc + col0 + bj * HALF); } }
#pragma unroll
            for (int m = 0; m < 4; ++m) { const size_t row = (size_t)(row0 + ai * HALF + m * 16);
#pragma unroll
                for (int bj = 0; bj < 2; ++bj) { const f32x4 v0 = acc[ai][bj][m][0], v1 = acc[ai][bj][m][1];
                    const unsigned g4[4] = {gw[m][bj].x, gw[m][bj].y, gw[m][bj].z, gw[m][bj].w}, o4[4] = {ow[m][bj].x, ow[m][bj].y, ow[m][bj].z, ow[m][bj].w};
                    const float a8[8] = {v0[0], v0[1], v0[2], v0[3], v1[0], v1[1], v1[2], v1[3]};
                    unsigned w4[4];
#pragma unroll
                    for (int q = 0; q < 4; ++q) {
                        const float g0 = __uint_as_float(g4[q] << 16), g1 = __uint_as_float(g4[q] & 0xffff0000u);
                        const float r0 = __uint_as_float(o4[q] << 16) + a8[2 * q] * __builtin_amdgcn_rcpf(1.0f + __expf(-g0));
                        const float r1 = __uint_as_float(o4[q] & 0xffff0000u) + a8[2 * q + 1] * __builtin_amdgcn_rcpf(1.0f + __expf(-g1));
                        unsigned pk; asm("v_cvt_pk_bf16_f32 %0, %1, %2" : "=v"(pk) : "v"(r0), "v"(r1)); w4[q] = pk; }
                    *(u32x4*)(MG + row * ldc + col0 + bj * HALF) = (u32x4){w4[0], w4[1], w4[2], w4[3]}; } }
            asm volatile("" ::: "memory");
        }
    }
};

typedef int pg8_v8i __attribute__((ext_vector_type(8)));
typedef int pg8_v4i __attribute__((ext_vector_type(4)));
template <class Epi, class Sched, bool STAMP = false, bool ALIGN_EPI = false, bool SP2 = false, bool FP8 = false>
__device__ __forceinline__ void gemm_phase(PG8_LAS unsigned char* lds, const Gemm g, const Sched& S, const Epi& E, unsigned long long* stamps) {
    const int tid = otid(), wid = __builtin_amdgcn_readfirstlane(tid >> 6), lane = tid & 63, wr = wid >> 2, wc = wid & 3, fr = lane & 15, fq = lane >> 4;
    const int K = g.K, nt = K / BK, LDA = g.lda ? g.lda : g.K;
    int ts_lo = 0, ts_hi = 0, nts = 0; const unsigned long long rt_entry = STAMP ? (unsigned long long)wall_clock64() : 0ull;
#define PG8_STAMP() do { if (STAMP && wid == 0 && nts < 64) { const unsigned long long _c = (unsigned long long)clock64(); \
        ts_lo = (lane == nts) ? (int)(unsigned)_c : ts_lo; ts_hi = (lane == nts) ? (int)(unsigned)(_c >> 32) : ts_hi; ++nts; } } while (0)
    PG8_STAMP();
    unsigned voffA[2], voffB[2];
#pragma unroll
    for (int i = 0; i < 2; ++i) { int R, C; stage_rc(tid * 16 + i * 8192, R, C); const int Rb = Epi::PERM ? ((R & ~31) + perm32(R & 31)) : R;
        voffA[i] = (unsigned)(R * LDA + C) * 2u; voffB[i] = (unsigned)(Rb * K + C) * 2u; }
    const size_t kstep = (size_t)(BK * 2);
    const size_t hstepB = (size_t)HALF * K * 2, hstepA = (size_t)HALF * LDA * 2;
    const size_t tstepB = 2 * hstepB, tstepA = 2 * hstepA;
    const unsigned ldsw = (unsigned)wid * 1024u;
    const int aoff = lds_byte(wr * 64 + fr, fq * 8), boff = lds_byte(wc * 32 + fr, fq * 8);
#define PG8_SA(b, h) (((b) * 2 + (h)) * HTB)
#define PG8_SB(b, h) ((4 + (b) * 2 + (h)) * HTB)
#define PG8_STAGE(bufoff, gbase, voff) do { _Pragma("unroll") for (int _i = 0; _i < 2; ++_i) \
        __builtin_amdgcn_global_load_lds((const unsigned*)((const char*)(gbase) + (voff)[_i]), (PG8_LAS unsigned*)(lds + (bufoff) + ldsw + _i * 8192), 16, 0, 0); } while (0)
#define PG8_I4(p) (*(const PG8_LAS pg8_v4i*)(p))
#define PG8_LDA(dst, b, h) do { if constexpr (FP8) { _Pragma("unroll") for (int m = 0; m < 4; ++m) dst##8[m] = __builtin_shufflevector(PG8_I4(lds + PG8_SA(b, h) + aoff + m * 2048), PG8_I4(lds + PG8_SA(b, h) + aoff + m * 2048 + 1024), 0, 1, 2, 3, 4, 5, 6, 7); } \
        else { _Pragma("unroll") for (int m = 0; m < 4; ++m) _Pragma("unroll") for (int k = 0; k < 2; ++k) dst[m][k] = *(const PG8_LAS bf16x8*)(lds + PG8_SA(b, h) + aoff + m * 2048 + k * 1024); } } while (0)
#define PG8_LDB(dst, b, h) do { if constexpr (FP8) { _Pragma("unroll") for (int n = 0; n < 2; ++n) dst##8[n] = __builtin_shufflevector(PG8_I4(lds + PG8_SB(b, h) + boff + n * 2048), PG8_I4(lds + PG8_SB(b, h) + boff + n * 2048 + 1024), 0, 1, 2, 3, 4, 5, 6, 7); } \
        else { _Pragma("unroll") for (int n = 0; n < 2; ++n) _Pragma("unroll") for (int k = 0; k < 2; ++k) dst[n][k] = *(const PG8_LAS bf16x8*)(lds + PG8_SB(b, h) + boff + n * 2048 + k * 1024); } } while (0)
#define PG8_MMA_BF(ai, bj, At, Bt) do { __builtin_amdgcn_s_setprio(1); _Pragma("unroll") for (int m = 0; m < 4; ++m) _Pragma("unroll") for (int n = 0; n < 2; ++n) _Pragma("unroll") for (int k = 0; k < 2; ++k) \
        acc[ai][bj][m][n] = __builtin_amdgcn_mfma_f32_16x16x32_bf16(Bt[n][k], At[m][k], acc[ai][bj][m][n], 0, 0, 0); __builtin_amdgcn_s_setprio(0); } while (0)
#define PG8_MMA_F8(ai, bj, At, Bt) do { __builtin_amdgcn_s_setprio(1); _Pragma("unroll") for (int m = 0; m < 4; ++m) _Pragma("unroll") for (int n = 0; n < 2; ++n) \
        asm volatile("v_mfma_scale_f32_16x16x128_f8f6f4 %0, %1, %2, %0, %3, %4 op_sel_hi:[0,0,0]" : "+v"(acc[ai][bj][m][n]) : "v"(Bt##8[n]), "v"(At##8[m]), "v"(f8_scale_w), "v"(f8_scale_x)); \
        __builtin_amdgcn_s_setprio(0); } while (0)
#define PG8_F8_DRAIN() do { if constexpr (FP8) asm volatile("s_nop 15\n\ts_nop 15" ::: "memory"); } while (0)
#define PG8_MMA(ai, bj, At, Bt) do { if constexpr (FP8) PG8_MMA_F8(ai, bj, At, Bt); else PG8_MMA_BF(ai, bj, At, Bt); } while (0)
#define PG8_WAIT_V(n) asm volatile("s_waitcnt vmcnt(" #n ")" ::: "memory")
#define PG8_WAIT_L(n) asm volatile("s_waitcnt lgkmcnt(" #n ")" ::: "memory")
#define PG8_BAR __builtin_amdgcn_s_barrier()
#define PG8_SCHED __builtin_amdgcn_sched_barrier(0)
    Unit cur, nxt; int ui = 0;
    if (!S.next(0, cur)) return;
    f32x4 acc[2][2][4][2];
#pragma unroll
    for (int a = 0; a < 2; ++a)
#pragma unroll
        for (int b = 0; b < 2; ++b)
#pragma unroll
            for (int m = 0; m < 4; ++m)
#pragma unroll
                for (int n = 0; n < 2; ++n) acc[a][b][m][n] = (f32x4){0.f, 0.f, 0.f, 0.f};
    int f8_scale_w = 0x79797979, f8_scale_x = 0x7f7f7f7f; (void)f8_scale_w; (void)f8_scale_x;
    bf16x8 At[4][2], B0[2][2], B1[2][2]; pg8_v8i At8[4], B08[2], B18[2];
    (void)At; (void)B0; (void)B1; (void)At8; (void)B08; (void)B18;
    const char* cA = (const char*)g.A + (size_t)cur.pm * tstepA + S.a_off(cur); const char* cB = (const char*)g.Bt + (size_t)cur.pn * tstepB + S.b_off(cur);
    S.a_ready(cur);
    if constexpr (SP2) {
        PG8_STAGE(PG8_SB(0, 0), cB, voffB); PG8_STAGE(PG8_SB(0, 1), cB + hstepB, voffB); PG8_STAGE(PG8_SA(0, 0), cA, voffA); PG8_STAGE(PG8_SA(0, 1), cA + hstepA, voffA);
        if (wr == 1) PG8_BAR;
        PG8_WAIT_V(2); PG8_BAR;
        PG8_STAGE(PG8_SB(1, 0), cB + kstep, voffB); PG8_STAGE(PG8_SA(1, 0), cA + kstep, voffA); PG8_STAGE(PG8_SB(1, 1), cB + hstepB + kstep, voffB);
        PG8_WAIT_V(6); PG8_BAR;
    } else {
    PG8_STAGE(PG8_SB(0, 0), cB, voffB); PG8_STAGE(PG8_SA(0, 0), cA, voffA); PG8_STAGE(PG8_SB(0, 1), cB + hstepB, voffB); PG8_STAGE(PG8_SA(0, 1), cA + hstepA, voffA);
    if (wr == 1) PG8_BAR;
    PG8_WAIT_V(4); PG8_BAR;
    PG8_STAGE(PG8_SB(1, 0), cB + kstep, voffB); PG8_STAGE(PG8_SA(1, 0), cA + kstep, voffA); PG8_STAGE(PG8_SB(1, 1), cB + hstepB + kstep, voffB);
    PG8_WAIT_V(6); PG8_BAR;
    }
    PG8_STAMP();
    for (;;) {
        const bool has_next = S.next(ui + 1, nxt);
        const char* nA = has_next ? (const char*)g.A + (size_t)nxt.pm * tstepA + S.a_off(nxt) : cA; const char* nB = has_next ? (const char*)g.Bt + (size_t)nxt.pn * tstepB + S.b_off(nxt) : cB;
        for (int t = 0; t < nt; t += 2) {
            const bool last = (t == nt - 2);
            const char* a1 = cA + (size_t)(t + 1) * kstep;
            const char* a2 = last ? nA : cA + (size_t)(t + 2) * kstep; const char* b2 = last ? nB : cB + (size_t)(t + 2) * kstep;
            const char* a3 = a2 + kstep; const char* b3 = b2 + kstep;
            if (last && has_next) S.a_ready(nxt);
            if constexpr (SP2) {
            PG8_LDB(B0, 0, 0); PG8_LDB(B1, 0, 1); PG8_SCHED; PG8_LDA(At, 0, 0); PG8_STAGE(PG8_SA(1, 1), a1 + hstepA, voffA);
            PG8_WAIT_V(8); PG8_WAIT_L(0); PG8_BAR; PG8_MMA(0, 0, At, B0); PG8_MMA(0, 1, At, B1); PG8_BAR; PG8_SCHED;
            PG8_LDA(At, 0, 1); PG8_STAGE(PG8_SB(0, 0), b2, voffB); PG8_STAGE(PG8_SB(0, 1), b2 + hstepB, voffB); PG8_STAGE(PG8_SA(0, 0), a2, voffA);
            PG8_WAIT_V(8); PG8_WAIT_L(0); PG8_BAR; PG8_MMA(1, 0, At, B0); PG8_MMA(1, 1, At, B1); PG8_BAR; PG8_SCHED;
            PG8_LDB(B0, 1, 0); PG8_LDB(B1, 1, 1); PG8_SCHED; PG8_LDA(At, 1, 0); PG8_STAGE(PG8_SA(0, 1), a2 + hstepA, voffA);
            PG8_WAIT_V(8); PG8_WAIT_L(0); PG8_BAR; PG8_MMA(0, 0, At, B0); PG8_MMA(0, 1, At, B1); PG8_BAR; PG8_SCHED;
            PG8_LDA(At, 1, 1); PG8_STAGE(PG8_SB(1, 0), b3, voffB); PG8_STAGE(PG8_SB(1, 1), b3 + hstepB, voffB); PG8_STAGE(PG8_SA(1, 0), a3, voffA);
            PG8_WAIT_V(8); PG8_WAIT_L(0); PG8_BAR; PG8_MMA(1, 0, At, B0); PG8_MMA(1, 1, At, B1); PG8_BAR; PG8_SCHED;
            } else {
            PG8_LDB(B0, 0, 0); PG8_SCHED; PG8_LDA(At, 0, 0); PG8_STAGE(PG8_SA(1, 1), a1 + hstepA, voffA);
            PG8_WAIT_L(8); PG8_BAR; PG8_WAIT_L(0); PG8_MMA(0, 0, At, B0); PG8_BAR; PG8_SCHED;
            PG8_LDB(B1, 0, 1); PG8_STAGE(PG8_SB(0, 0), b2, voffB);
            PG8_BAR; PG8_WAIT_L(0); PG8_MMA(0, 1, At, B1); PG8_BAR;
            PG8_LDA(At, 0, 1); PG8_STAGE(PG8_SA(0, 0), a2, voffA);
            PG8_BAR; PG8_WAIT_L(0); PG8_MMA(1, 0, At, B0); PG8_BAR; PG8_SCHED;
            PG8_STAGE(PG8_SB(0, 1), b2 + hstepB, voffB);
            PG8_WAIT_V(6); PG8_BAR; PG8_MMA(1, 1, At, B1); PG8_BAR;
            PG8_LDB(B0, 1, 0); PG8_SCHED; PG8_LDA(At, 1, 0); PG8_STAGE(PG8_SA(0, 1), a2 + hstepA, voffA);
            PG8_WAIT_L(8); PG8_BAR; PG8_WAIT_L(0); PG8_MMA(0, 0, At, B0); PG8_BAR; PG8_SCHED;
            PG8_LDB(B1, 1, 1); PG8_STAGE(PG8_SB(1, 0), b3, voffB);
            PG8_BAR; PG8_WAIT_L(0); PG8_MMA(0, 1, At, B1); PG8_BAR;
            PG8_LDA(At, 1, 1); PG8_STAGE(PG8_SA(1, 0), a3, voffA);
            PG8_BAR; PG8_WAIT_L(0); PG8_MMA(1, 0, At, B0); PG8_BAR; PG8_SCHED;
            PG8_STAGE(PG8_SB(1, 1), b3 + hstepB, voffB);
            PG8_WAIT_V(6); PG8_BAR; PG8_MMA(1, 1, At, B1); PG8_BAR;
            }
        }
        if constexpr (ALIGN_EPI) { if (wr == 0) PG8_BAR; }
        PG8_STAMP();
        PG8_F8_DRAIN();
        if constexpr (!Epi::AFTER_DRAIN) { E(acc, cur, wr, wc, fr, fq); S.done(cur); }
        PG8_STAMP();
        if (!has_next) break;
#pragma unroll
        for (int a = 0; a < 2; ++a)
#pragma unroll
            for (int b = 0; b < 2; ++b)
#pragma unroll
                for (int m = 0; m < 4; ++m)
#pragma unroll
                    for (int n = 0; n < 2; ++n) acc[a][b][m][n] = (f32x4){0.f, 0.f, 0.f, 0.f};
        cur = nxt; cA = nA; cB = nB; ++ui;
        if constexpr (ALIGN_EPI) { if (wr == 1) PG8_BAR; }
    }
    PG8_WAIT_V(0);
    if constexpr (!ALIGN_EPI) { if (wr == 0) PG8_BAR; }
    PG8_BAR;
    if constexpr (Epi::AFTER_DRAIN) { E.fused(acc, cur, wr, wc, fr, fq, lds, wid, lane); S.done(cur); }
    PG8_STAMP();
    if (STAMP && wid == 0) { stamps[lane] = lane < nts ? (((unsigned long long)(unsigned)ts_hi << 32) | (unsigned)ts_lo) : 0ull;
        if (lane == 62) stamps[62] = rt_entry; if (lane == 63) stamps[63] = (unsigned long long)wall_clock64(); }
#undef PG8_STAMP
#undef PG8_SA
#undef PG8_SB
#undef PG8_STAGE
#undef PG8_LDA
#undef PG8_LDB
#undef PG8_MMA
#undef PG8_MMA_BF
#undef PG8_MMA_F8
#undef PG8_I4
#undef PG8_F8_DRAIN
#undef PG8_WAIT_V
#undef PG8_WAIT_L
#undef PG8_BAR
#undef PG8_SCHED
}
}
#define XB_TMO      128
#define XB_XCNT(j)  (256  + 64 * (j))
#define XB_XSUB(j)  (1280 + 64 * (j))
#define XB_XGEN(j)  (2304 + 64 * (j))
#define XB_TOP      3328
#define XB_TOPGEN   3392
#define XCD_BAR_WORDS 3456
#define XB_SPIN_CAP (1u << 18)
#define LAS __attribute__((address_space(3)))

__device__ __forceinline__ unsigned xb_ld(unsigned* p)              { return __hip_atomic_load(p, __ATOMIC_RELAXED, __HIP_MEMORY_SCOPE_AGENT); }
__device__ __forceinline__ unsigned xb_add(unsigned* p, unsigned v) { return __hip_atomic_fetch_add(p, v, __ATOMIC_RELAXED, __HIP_MEMORY_SCOPE_AGENT); }
__device__ __forceinline__ unsigned xb_xcc_id() { return (unsigned)__builtin_amdgcn_s_getreg((3 << 11) | 20) & 0xFu; }
#define XB_SPIN(cond, bar) do { unsigned _sp = 0; while (cond) { __builtin_amdgcn_s_sleep(1); \
    if ((++_sp & 255u) == 0u) { if (xb_ld(&(bar)[XB_TMO])) break; if (_sp > XB_SPIN_CAP) { atomicAdd(&(bar)[XB_TMO], 1u); break; } } } } while (0)

struct XcdBarrier {
    unsigned* bar; unsigned x;
    volatile LAS unsigned* st;
};

__device__ __forceinline__ XcdBarrier xcd_barrier_post(unsigned* bar, volatile LAS unsigned* st) {
    XcdBarrier b; b.bar = bar; b.x = xb_xcc_id(); b.st = st;
    if (threadIdx.x == 0) (void)xb_add(&bar[XB_XCNT(b.x)], 1u);
    return b;
}
__device__ __forceinline__ void xcd_barrier_complete(unsigned* bar, unsigned x, unsigned& nloc, unsigned& nx) {
    const unsigned G = gridDim.x * gridDim.y * gridDim.z;
    unsigned sum, cnt, mine, sp = 0u;
    for (;;) {
        sum = 0u; cnt = 0u; mine = 0u;
#pragma unroll
        for (unsigned j = 0; j < 16; ++j) { const unsigned c = xb_ld(&bar[XB_XCNT(j)]); sum += c; cnt += (c > 0u) ? 1u : 0u; mine = (j == x) ? c : mine; }
        if (sum == G) break;
        __builtin_amdgcn_s_sleep(1);
        if ((++sp & 255u) == 0u) { if (xb_ld(&bar[XB_TMO])) break; if (sp > XB_SPIN_CAP) { atomicAdd(&bar[XB_TMO], 1u); break; } }
    }
    nloc = mine > 0u ? mine : 1u; nx = cnt > 0u ? cnt : 1u;
}

__device__ __forceinline__ void xcd_barrier(const XcdBarrier& b) {
    asm volatile("s_waitcnt vmcnt(0)" ::: "memory");
    __syncthreads();
    if (threadIdx.x == 0) {
        unsigned* bar = b.bar;
        __builtin_amdgcn_s_waitcnt(0);
        unsigned nloc = b.st[0], nx = b.st[1];
        if (nloc == 0u) { xcd_barrier_complete(bar, b.x, nloc, nx); b.st[0] = nloc; b.st[1] = nx; }
        const unsigned old = xb_add(&bar[XB_XSUB(b.x)], 1u);
        const unsigned gen = old / nloc;
        if (old + 1u == (gen + 1u) * nloc) {
            __builtin_amdgcn_fence(__ATOMIC_RELEASE, "agent");
            asm volatile("s_waitcnt vmcnt(0)" ::: "memory");
            const unsigned og = xb_add(&bar[XB_TOP], 1u);
            const unsigned tg = og / nx;
            if (og + 1u == (tg + 1u) * nx) xb_add(&bar[XB_TOPGEN], 1u);
            else XB_SPIN(xb_ld(&bar[XB_TOPGEN]) == tg, bar);
            __builtin_amdgcn_fence(__ATOMIC_ACQUIRE, "agent");
            xb_add(&bar[XB_XGEN(b.x)], 1u);
            asm volatile("s_waitcnt vmcnt(0)" ::: "memory");
        } else {
            XB_SPIN(xb_ld(&bar[XB_XGEN(b.x)]) == gen, bar);
            __builtin_amdgcn_fence(__ATOMIC_ACQUIRE, "agent");
            asm volatile("s_waitcnt vmcnt(0)" ::: "memory");
        }
    }
    __syncthreads();
}


typedef unsigned short bf16;
typedef unsigned v4u __attribute__((ext_vector_type(4)));
typedef unsigned v2u __attribute__((ext_vector_type(2)));
typedef float v4f __attribute__((ext_vector_type(4)));
typedef float v2f __attribute__((ext_vector_type(2)));

constexpr int DM = 2048, NBATCH = 8, SEQ = 4096, DEPTH = 2, MTOK = NBATCH * SEQ;
constexpr int IN_COLS = 14416, NPROJ = 14592;
constexpr int C_UB = 0, C_VB = 1024, C_ZB = 2048, C_QC = 3072, C_KC = 3584, C_VC = 4096, C_ZC = 5120, C_KROPE = 6144, C_AR = 6208,
              C_CQ = 6400, C_CKV = 6912, C_ZA = 7424, C_GATE = 8448;
constexpr int NBF = C_CQ, NF8 = NPROJ - NBF;
constexpr float EPS = 1e-6f;
#ifndef NBP
#define NBP 4
#endif
constexpr int MP = NBP * SEQ, NPASS = NBATCH / NBP;
constexpr int STEPS_PER_PASS = 7;
constexpr int NSTEPS = DEPTH * (1 + NPASS * STEPS_PER_PASS);

constexpr size_t al256(size_t x) { return (x + 255) & ~(size_t)255; }
constexpr size_t WS_CTL = 0, CTL_BYTES = 1u << 20;
constexpr size_t SZ_WINB = (size_t)NBF * DM * 2  , SZ_WIN = SZ_WINB + (size_t)NF8 * DM  , SZ_WUQ = (size_t)1536 * 512 * 2, SZ_WUKV = (size_t)2048 * 512 * 2, SZ_WB = (size_t)3 * 2048 * 1024 * 2, SZ_WO = (size_t)2048 * 2048 * 2;
constexpr size_t SZ_WLAYER = SZ_WIN + SZ_WUQ + SZ_WUKV + SZ_WB + SZ_WO;
constexpr size_t WS_W = CTL_BYTES;
constexpr size_t WS_COS = WS_W + SZ_WLAYER, WS_SIN = WS_COS + (size_t)MTOK * 32 * 4;
constexpr size_t WS_H = WS_SIN + (size_t)MTOK * 32 * 4;
constexpr size_t WS_MG = WS_H;
constexpr size_t WS_PROJ = WS_H + (size_t)MP * DM * 2;
constexpr size_t WS_XB = WS_PROJ + (size_t)MP * NPROJ * 2;
constexpr size_t WS_SSQ = WS_XB + (size_t)MP * 2048;
constexpr size_t WS_Q = WS_SSQ + al256((size_t)3 * MP * 4);
constexpr size_t WS_KV = WS_Q + (size_t)MP * 1536 * 2;
constexpr size_t WS_K = WS_KV + (size_t)MP * 2048 * 2;
constexpr size_t WS_YA = WS_K + (size_t)MP * 1536 * 2;
constexpr size_t WS_YB = WS_YA + (size_t)MP * 1024 * 2;
constexpr size_t WS_DL = WS_YA;
constexpr size_t WS_YC = WS_YB + (size_t)MP * 1024 * 2;
constexpr size_t WS_OC = WS_YC + (size_t)MP * 1024 * 2;
constexpr size_t WS_QE = WS_OC + (size_t)MP * 1024 * 4;
constexpr size_t WS_KE = WS_QE + (size_t)MP * 512 * 2, WS_KL = WS_KE + (size_t)MP * 512 * 2;
constexpr size_t WS_H8 = WS_KE;
constexpr size_t WS_DS = WS_KL + (size_t)MP * 512 * 2;
constexpr size_t WS_END = WS_DS + (size_t)(MP / 128) * 512 * 4;
static_assert(WS_END <= ((size_t)1 << 30), "workspace map exceeds 1 GiB");

constexpr int LDS_BYTES = 147456;
constexpr int LDSCTL_OFF = LDS_BYTES - 256;
constexpr int CW_BAR = 4096;

__device__ __forceinline__ float bf2f(unsigned v) { return __uint_as_float(v << 16); }
__device__ __forceinline__ unsigned f2bf(float f) { unsigned u = __float_as_uint(f); return (u + 0x7fffu + ((u >> 16) & 1u)) >> 16; }
__device__ __forceinline__ unsigned pk2(float lo, float hi) { return f2bf(lo) | (f2bf(hi) << 16); }
__device__ __forceinline__ float lo16(unsigned w) { return __uint_as_float(w << 16); }
__device__ __forceinline__ float hi16(unsigned w) { return __uint_as_float(w & 0xffff0000u); }
__device__ __forceinline__ float sigmoid_f(float x) { return 1.f / (1.f + __expf(-x)); }
__device__ __forceinline__ float silu_f(float x) { return x / (1.f + __expf(-x)); }
__device__ __forceinline__ float gelu_f(float x) { const float u2 = 1.5957691216057308f * (x + 0.044715f * x * x * x); return x * __builtin_amdgcn_rcpf(1.f + __expf(-u2)); }
template <int O> __device__ __forceinline__ float lane_xor(float v) {
    if (O == 1) return __uint_as_float((unsigned)__builtin_amdgcn_mov_dpp((int)__float_as_uint(v), 0xB1, 0xf, 0xf, true));
    if (O == 2) return __uint_as_float((unsigned)__builtin_amdgcn_mov_dpp((int)__float_as_uint(v), 0x4E, 0xf, 0xf, true));
    return __uint_as_float((unsigned)__builtin_amdgcn_ds_swizzle((int)__float_as_uint(v), (O << 10) | 0x1f)); }
__device__ __forceinline__ float lane_xor32(float v, int lane) {
    auto rr = __builtin_amdgcn_permlane32_swap(__float_as_uint(v), __float_as_uint(v), false, false);
    return __uint_as_float(lane < 32 ? rr[1] : rr[0]); }
__device__ __forceinline__ float wave_sum(float v) {
    v += lane_xor<1>(v); v += lane_xor<2>(v); v += lane_xor<4>(v); v += lane_xor<8>(v); v += lane_xor<16>(v);
    auto rr = __builtin_amdgcn_permlane32_swap(__float_as_uint(v), __float_as_uint(v), false, false);
    return __uint_as_float(rr[0]) + __uint_as_float(rr[1]); }
__device__ __forceinline__ float wave_max(float v) {
    v = fmaxf(v, lane_xor<1>(v)); v = fmaxf(v, lane_xor<2>(v)); v = fmaxf(v, lane_xor<4>(v)); v = fmaxf(v, lane_xor<8>(v)); v = fmaxf(v, lane_xor<16>(v));
    auto rr = __builtin_amdgcn_permlane32_swap(__float_as_uint(v), __float_as_uint(v), false, false);
    return fmaxf(__uint_as_float(rr[0]), __uint_as_float(rr[1])); }
#define LDS_FENCE() asm volatile("s_waitcnt lgkmcnt(0)" ::: "memory")

struct Args { const void* in[18]; float* out; unsigned char* ws; int lo, hi, pad0, pad1; };

template <int MODE> __device__ __forceinline__ int src_col(int n) {
    if (MODE == 0) return n;
    if (MODE == 2) n += NBF;
    if (n < C_VB) return 2112 + n;
    if (n < C_ZB) return 3136 + (n - C_VB);
    if (n < C_QC) return 4160 + (n - C_ZB);
    if (n < C_KC) return 5184 + (n - C_QC);
    if (n < C_VC) return 5696 + (n - C_KC);
    if (n < C_ZC) return 6208 + (n - C_VC);
    if (n < C_KROPE) return 7248 + (n - C_ZC);
    if (n < C_AR) return 1024 + (n - C_KROPE);
    if (n < C_AR + 16) return 7232 + (n - C_AR);
    if (n < C_CQ) return -1;
    if (n < C_CKV) return n - C_CQ;
    if (n < C_ZA) return 512 + (n - C_CKV);
    if (n < C_GATE) return 1088 + (n - C_ZA);
    return 8272 + (n - C_GATE);
}
template <int MODE> __device__ __forceinline__ void convert_T(const float* W, int K, int Nsrc, bf16* WT, int Ndst, LAS float* tile, int vb, int nvb, const float* kscale = nullptr) {
    const int tid = otid(), ntk = K / 64, ntn = Ndst / 64, ntiles = ntk * ntn;
    for (int t = vb; t < ntiles; t += nvb) {
        const int k0 = (t % ntk) * 64, n0 = (t / ntk) * 64;
        { const int nn = tid & 63, sc = src_col<MODE>(n0 + nn), scc = sc >= 0 ? sc : 0; const float mul = sc >= 0 ? 1.f : 0.f;
          float v[8];
#pragma unroll
          for (int i = 0; i < 8; ++i) v[i] = W[(size_t)(k0 + (tid >> 6) + 8 * i) * Nsrc + scc];
          if (kscale) {
#pragma unroll
              for (int i = 0; i < 8; ++i) v[i] *= kscale[k0 + (tid >> 6) + 8 * i]; }
#pragma unroll
          for (int i = 0; i < 8; ++i) tile[((tid >> 6) + 8 * i) * 65 + nn] = v[i] * mul; }
        __syncthreads();
        { const int nn = tid & 63, kg = tid >> 6;
          const LAS float* tp = tile + (kg * 8) * 65 + nn;
          v4u o; o.x = pk2(tp[0], tp[65]); o.y = pk2(tp[2 * 65], tp[3 * 65]); o.z = pk2(tp[4 * 65], tp[5 * 65]); o.w = pk2(tp[6 * 65], tp[7 * 65]);
          *(v4u*)(WT + (size_t)(n0 + nn) * K + k0 + kg * 8) = o; }
        __syncthreads();
    }
}

__device__ __forceinline__ void convert_T8(const float* W, int K, int Nsrc, unsigned char* WT, int Ndst, LAS float* tile, int vb, int nvb) {
    const int tid = otid(), ntk = K / 64, ntn = Ndst / 64, ntiles = ntk * ntn;
    for (int t = vb; t < ntiles; t += nvb) {
        const int k0 = (t % ntk) * 64, n0 = (t / ntk) * 64;
        { const int nn = tid & 63;
          const int sc = src_col<2>(n0 + nn);
#pragma unroll
          for (int i = 0; i < 8; ++i) { const int kk = (tid >> 6) + 8 * i; tile[kk * 65 + nn] = W[(size_t)(k0 + kk) * Nsrc + sc] * 64.0f; } }
        __syncthreads();
        { const int nn = tid & 63, kg = tid >> 6;
          const LAS float* tp = tile + (kg * 8) * 65 + nn;
          unsigned w0 = 0u, w1 = 0u;
          w0 = __builtin_amdgcn_cvt_pk_fp8_f32(tp[0], tp[65], w0, false); w0 = __builtin_amdgcn_cvt_pk_fp8_f32(tp[2 * 65], tp[3 * 65], w0, true);
          w1 = __builtin_amdgcn_cvt_pk_fp8_f32(tp[4 * 65], tp[5 * 65], w1, false); w1 = __builtin_amdgcn_cvt_pk_fp8_f32(tp[6 * 65], tp[7 * 65], w1, true);
          *(v2u*)(WT + (size_t)(n0 + nn) * K + k0 + kg * 8) = (v2u){w0, w1}; }
        __syncthreads();
    }
}

__device__ __forceinline__ void ph_norm(const float* xin, const float* g, bf16* h, unsigned char* h8, int rows, int vb, int nvb) {
    const int tid_ = otid(); const int lane = tid_ & 63, wave = tid_ >> 6;
    for (int r = vb * 8 + wave; r < rows; r += nvb * 8) {
        const v4f* xr = (const v4f*)(xin + (size_t)r * DM);
        v4f v[8]; float ss = 0.f;
#pragma unroll
        for (int j = 0; j < 8; ++j) { v[j] = xr[lane + 64 * j]; ss += v[j].x * v[j].x + v[j].y * v[j].y + v[j].z * v[j].z + v[j].w * v[j].w; }
        ss = wave_sum(ss);
        const float rn = 1.0f / sqrtf(ss * (1.0f / DM) + EPS);
#pragma unroll
        for (int j = 0; j < 8; ++j) { const v4f gg = ((const v4f*)g)[lane + 64 * j];
            const float y0 = v[j].x * rn * gg.x, y1 = v[j].y * rn * gg.y, y2 = v[j].z * rn * gg.z, y3 = v[j].w * rn * gg.w;
            v2u o; o.x = pk2(y0, y1); o.y = pk2(y2, y3);
            *(v2u*)(h + (size_t)r * DM + (lane + 64 * j) * 4) = o;
            unsigned w8 = 0u; w8 = __builtin_amdgcn_cvt_pk_fp8_f32(y0, y1, w8, false); w8 = __builtin_amdgcn_cvt_pk_fp8_f32(y2, y3, w8, true);
            *(unsigned*)(h8 + (size_t)r * DM + (lane + 64 * j) * 4) = w8; }
    }
}
__device__ __forceinline__ float row16_sum(float v) {
    v += __uint_as_float((unsigned)__builtin_amdgcn_mov_dpp((int)__float_as_uint(v), 0xB1, 0xf, 0xf, true));
    v += __uint_as_float((unsigned)__builtin_amdgcn_mov_dpp((int)__float_as_uint(v), 0x4E, 0xf, 0xf, true));
    v += __uint_as_float((unsigned)__builtin_amdgcn_mov_dpp((int)__float_as_uint(v), 0x141, 0xf, 0xf, true));
    v += __uint_as_float((unsigned)__builtin_amdgcn_mov_dpp((int)__float_as_uint(v), 0x140, 0xf, 0xf, true));
    return v; }
__device__ __forceinline__ void ph_kfin(const bf16* kv, const bf16* proj, bf16* K, const float* kg, const float* cosT, const float* sinT, int row0, int vb, int nvb) {
    const int tid_ = otid(); const int lane = tid_ & 63, wave = tid_ >> 6, g16 = lane >> 4, c = lane & 15;
    float gn[8], gr[8];
#pragma unroll
    for (int j = 0; j < 8; ++j) { gn[j] = kg[c * 8 + j]; gr[j] = kg[128 + (c & 7) * 8 + j]; }
    for (int r = vb * 8 + wave; r < MP; r += nvb * 8) {
        const v4u n0 = *(const v4u*)(kv + (size_t)r * 2048 + g16 * 256 + c * 8), n1 = *(const v4u*)(kv + (size_t)r * 2048 + (g16 + 4) * 256 + c * 8);
        const v4u rw = *(const v4u*)(proj + (size_t)r * NPROJ + C_KROPE + (c & 7) * 8);
        const v4f c0 = *(const v4f*)(cosT + (size_t)(row0 + r) * 32 + (c & 3) * 8), c1 = *(const v4f*)(cosT + (size_t)(row0 + r) * 32 + (c & 3) * 8 + 4);
        const v4f s0 = *(const v4f*)(sinT + (size_t)(row0 + r) * 32 + (c & 3) * 8), s1 = *(const v4f*)(sinT + (size_t)(row0 + r) * 32 + (c & 3) * 8 + 4);
        float a[8] = {lo16(n0.x), hi16(n0.x), lo16(n0.y), hi16(n0.y), lo16(n0.z), hi16(n0.z), lo16(n0.w), hi16(n0.w)};
        float b[8] = {lo16(n1.x), hi16(n1.x), lo16(n1.y), hi16(n1.y), lo16(n1.z), hi16(n1.z), lo16(n1.w), hi16(n1.w)};
        float kr[8] = {lo16(rw.x), hi16(rw.x), lo16(rw.y), hi16(rw.y), lo16(rw.z), hi16(rw.z), lo16(rw.w), hi16(rw.w)};
        const float cs[8] = {c0.x, c0.y, c0.z, c0.w, c1.x, c1.y, c1.z, c1.w}, sn[8] = {s0.x, s0.y, s0.z, s0.w, s1.x, s1.y, s1.z, s1.w};
        float sa = 0.f, sb = 0.f, sr = 0.f;
#pragma unroll
        for (int j = 0; j < 8; ++j) { sa += a[j] * a[j]; sb += b[j] * b[j]; sr += kr[j] * kr[j]; }
        if (c >= 8) sr = 0.f;
        sa = row16_sum(sa); sb = row16_sum(sb); sr = row16_sum(sr);
        const float rna = 1.0f / sqrtf((sa + sr) * (1.0f / 192.f) + EPS), rnb = 1.0f / sqrtf((sb + sr) * (1.0f / 192.f) + EPS);
        float R[8];
#pragma unroll
        for (int j = 0; j < 8; ++j) { const float mine = kr[j] * gr[j]; const float oth = lane_xor<4>(mine);
            R[j] = (c & 4) ? mine * cs[j] + oth * sn[j] : mine * cs[j] - oth * sn[j]; }
        bf16* ka = K + ((size_t)r * 8 + g16) * 192; bf16* kb = K + ((size_t)r * 8 + g16 + 4) * 192;
        { v4u o; o.x = pk2(a[0] * rna * gn[0], a[1] * rna * gn[1]); o.y = pk2(a[2] * rna * gn[2], a[3] * rna * gn[3]); o.z = pk2(a[4] * rna * gn[4], a[5] * rna * gn[5]); o.w = pk2(a[6] * rna * gn[6], a[7] * rna * gn[7]); *(v4u*)(ka + c * 8) = o; }
        { v4u o; o.x = pk2(b[0] * rnb * gn[0], b[1] * rnb * gn[1]); o.y = pk2(b[2] * rnb * gn[2], b[3] * rnb * gn[3]); o.z = pk2(b[4] * rnb * gn[4], b[5] * rnb * gn[5]); o.w = pk2(b[6] * rnb * gn[6], b[7] * rnb * gn[7]); *(v4u*)(kb + c * 8) = o; }
        if (c < 8) {
            v4u o; o.x = pk2(R[0] * rna, R[1] * rna); o.y = pk2(R[2] * rna, R[3] * rna); o.z = pk2(R[4] * rna, R[5] * rna); o.w = pk2(R[6] * rna, R[7] * rna); *(v4u*)(ka + 128 + c * 8) = o;
            v4u p; p.x = pk2(R[0] * rnb, R[1] * rnb); p.y = pk2(R[2] * rnb, R[3] * rnb); p.z = pk2(R[4] * rnb, R[5] * rnb); p.w = pk2(R[6] * rnb, R[7] * rnb); *(v4u*)(kb + 128 + c * 8) = p; }
    }
}

namespace at {
typedef short bf16x8 __attribute__((ext_vector_type(8)));
typedef short s16x4 __attribute__((ext_vector_type(4)));
typedef float f32x16 __attribute__((ext_vector_type(16)));
typedef unsigned u32x4 __attribute__((ext_vector_type(4)));
constexpr int SHM_V = 16384, SHM_K = 16384, SHM_KR = 8192;
constexpr int OFF_V = 0, OFF_K = 3 * SHM_V, OFF_KR = OFF_K + 2 * SHM_K, OFF_WS = OFF_KR + 2 * SHM_KR, LDS_NEED = OFF_WS + 8 * 64 * 4;
constexpr float SCALE = 0.07216878364870322f;
constexpr float THR = 8.f;
#define AT_KSWZ(row, colB) ((row) * 256 + ((colB) ^ (((row) & 7) << 4)))
#define AT_KRSWZ(row, colB) ((row) * 128 + ((colB) ^ (((row) & 7) << 4)))
#define AT_SBAR() __builtin_amdgcn_sched_barrier(0)
__device__ __forceinline__ int v_st(int k, int c) { const int kk = (k & ~0xC) | ((k & 4) << 1) | ((k & 8) >> 1); return ((kk >> 3) * 4 + (c >> 5)) * 512 + ((kk & 7) * 32 + (c & 31)) * 2; }
__device__ __forceinline__ int v_rd_base(int lane) { return ((lane & 3) << 3) | (((lane >> 2) & 3) << 6) | (((lane >> 4) & 1) << 5) | (((lane >> 5) & 1) << 8); }
constexpr int v_rd_off(int d0, int ks, int half) { return d0 * 512 + ks * 4096 + half * 2048; }
__device__ __forceinline__ int crow(int r, int hi) { return (r & 3) + 8 * (r >> 2) + 4 * hi; }
__device__ __forceinline__ unsigned cvtpk(float lo, float hi) { unsigned r; asm("v_cvt_pk_bf16_f32 %0, %1, %2" : "=v"(r) : "v"(lo), "v"(hi)); return r; }

__device__ __forceinline__ void mask_tile(f32x16& p0, f32x16& p1, int dq) {
    const float NEG = -__builtin_inff();
#pragma unroll
    for (int r = 0; r < 16; ++r) { const int c = (r & 3) + 8 * (r >> 2); if (dq < c) p0[r] = NEG; if (dq < c + 32) p1[r] = NEG; }
}
__device__ __forceinline__ void partialSM(f32x16& p0, f32x16& p1, float& m_reg, float& mn, float& alpha) {
    float pmax = p0[0];
#pragma unroll
    for (int r = 1; r < 16; ++r) pmax = fmaxf(pmax, p0[r]);
#pragma unroll
    for (int r = 0; r < 16; ++r) pmax = fmaxf(pmax, p1[r]);
    { auto rr = __builtin_amdgcn_permlane32_swap(__float_as_uint(pmax), __float_as_uint(pmax), false, false);
      pmax = fmaxf(__uint_as_float(rr[0]), __uint_as_float(rr[1])); }
    constexpr float C2 = 1.4426950408889634f * SCALE;
    if (__builtin_expect(__all((pmax - m_reg) * SCALE <= THR), 1)) { mn = m_reg; alpha = 1.f; }
    else { mn = fmaxf(m_reg, pmax); alpha = __builtin_amdgcn_exp2f((m_reg - mn) * C2); m_reg = mn; }
    const float mnL = -mn * C2;
#pragma unroll
    for (int r = 0; r < 16; ++r) p0[r] = fmaf(p0[r], C2, mnL);
#pragma unroll
    for (int r = 0; r < 16; ++r) p1[r] = fmaf(p1[r], C2, mnL);
#pragma unroll
    for (int r = 0; r < 16; ++r) p0[r] = __builtin_amdgcn_exp2f(p0[r]);
}
__device__ __forceinline__ void finishSM(f32x16& p0, f32x16& p1, float alpha, float& l_reg, bf16x8& pa0, bf16x8& pa1, bf16x8& pa2, bf16x8& pa3) {
#pragma unroll
    for (int r = 0; r < 16; ++r) p1[r] = __builtin_amdgcn_exp2f(p1[r]);
    float ps = 0;
#pragma unroll
    for (int r = 0; r < 16; ++r) ps += p0[r];
#pragma unroll
    for (int r = 0; r < 16; ++r) ps += p1[r];
    { auto rr = __builtin_amdgcn_permlane32_swap(__float_as_uint(ps), __float_as_uint(ps), false, false);
      ps = __uint_as_float(rr[0]) + __uint_as_float(rr[1]); }
    l_reg = l_reg * alpha + ps;
#define AT_PK4(P, B_, OUT) do { unsigned a0 = cvtpk(P[B_+0], P[B_+1]), a1 = cvtpk(P[B_+2], P[B_+3]);                          \
        unsigned b0 = cvtpk(P[B_+4], P[B_+5]), b1 = cvtpk(P[B_+6], P[B_+7]);                                             \
        auto r0 = __builtin_amdgcn_permlane32_swap(a0, b0, false, false); auto r1 = __builtin_amdgcn_permlane32_swap(a1, b1, false, false); \
        u32x4 w = {r0[0], r1[0], r0[1], r1[1]}; OUT = *reinterpret_cast<bf16x8*>(&w); } while (0)
    AT_PK4(p0, 0, pa0); AT_PK4(p0, 8, pa1); AT_PK4(p1, 0, pa2); AT_PK4(p1, 8, pa3);
#undef AT_PK4
}
__device__ __forceinline__ void qkt(f32x16& p0, f32x16& p1, const LAS unsigned char* Kb, const LAS unsigned char* KRb, int r32, int hi, const bf16x8* qr) {
    p0 = f32x16{}; p1 = f32x16{};
    const LAS unsigned char* kb[4]; const LAS unsigned char* krb[4];
#pragma unroll
    for (int dd = 0; dd < 4; ++dd) { kb[dd] = Kb + AT_KSWZ(r32, (dd * 16 + hi * 8) * 2); krb[dd] = KRb + AT_KRSWZ(r32, (dd * 16 + hi * 8) * 2); }
    bf16x8 f[24];
#pragma unroll
    for (int d0 = 0; d0 < 8; ++d0) { const LAS unsigned char* a = kb[d0 & 3] + (d0 >> 2) * 128;
        f[2 * d0] = *reinterpret_cast<const LAS bf16x8*>(a); f[2 * d0 + 1] = *reinterpret_cast<const LAS bf16x8*>(a + 32 * 256); }
#pragma unroll
    for (int d0 = 0; d0 < 4; ++d0) { const LAS unsigned char* a = krb[d0];
        f[16 + 2 * d0] = *reinterpret_cast<const LAS bf16x8*>(a); f[16 + 2 * d0 + 1] = *reinterpret_cast<const LAS bf16x8*>(a + 32 * 128); }
#pragma unroll
    for (int d0 = 0; d0 < 12; ++d0) {
        p0 = __builtin_amdgcn_mfma_f32_32x32x16_bf16(f[2 * d0], qr[d0], p0, 0, 0, 0);
        p1 = __builtin_amdgcn_mfma_f32_32x32x16_bf16(f[2 * d0 + 1], qr[d0], p1, 0, 0, 0); }
    __builtin_amdgcn_sched_group_barrier(0x100, 4, 0);
#pragma unroll
    for (int i = 0; i < 20; ++i) { __builtin_amdgcn_sched_group_barrier(0x008, 1, 0); __builtin_amdgcn_sched_group_barrier(0x100, 1, 0); }
    __builtin_amdgcn_sched_group_barrier(0x008, 4, 0);
}
__device__ __forceinline__ void pv_tile(f32x16* o, unsigned vb0, bf16x8 pa0, bf16x8 pa1, bf16x8 pa2, bf16x8 pa3) {
#define AT_TRRD(dst, off) asm volatile("ds_read_b64_tr_b16 %0, %1 offset:%2" : "=&v"(dst) : "v"(vb0), "i"(off) : "memory")
#define AT_PV_RD(d0, L, H) do { constexpr int b_ = v_rd_off(d0, 0, 0); \
        AT_TRRD(L[0], b_); AT_TRRD(H[0], b_ + 2048); AT_TRRD(L[1], b_ + 4096); AT_TRRD(H[1], b_ + 6144); AT_TRRD(L[2], b_ + 8192); AT_TRRD(H[2], b_ + 10240); AT_TRRD(L[3], b_ + 12288); AT_TRRD(H[3], b_ + 14336); } while (0)
#define AT_PV_MM(d0, L, H) do { \
        o[d0] = __builtin_amdgcn_mfma_f32_32x32x16_bf16(pa0, (bf16x8){L[0][0], L[0][1], L[0][2], L[0][3], H[0][0], H[0][1], H[0][2], H[0][3]}, o[d0], 0, 0, 0);   \
        o[d0] = __builtin_amdgcn_mfma_f32_32x32x16_bf16(pa1, (bf16x8){L[1][0], L[1][1], L[1][2], L[1][3], H[1][0], H[1][1], H[1][2], H[1][3]}, o[d0], 0, 0, 0);   \
        o[d0] = __builtin_amdgcn_mfma_f32_32x32x16_bf16(pa2, (bf16x8){L[2][0], L[2][1], L[2][2], L[2][3], H[2][0], H[2][1], H[2][2], H[2][3]}, o[d0], 0, 0, 0);   \
        o[d0] = __builtin_amdgcn_mfma_f32_32x32x16_bf16(pa3, (bf16x8){L[3][0], L[3][1], L[3][2], L[3][3], H[3][0], H[3][1], H[3][2], H[3][3]}, o[d0], 0, 0, 0); } while (0)
    s16x4 la[4], ha[4], lb[4], hb[4];
    asm volatile("s_waitcnt lgkmcnt(0)" ::: "memory");
    AT_PV_RD(0, la, ha); AT_PV_RD(1, lb, hb);
    asm volatile("s_waitcnt lgkmcnt(8)" ::: "memory"); AT_SBAR(); AT_PV_MM(0, la, ha); AT_SBAR();
    AT_PV_RD(2, la, ha);
    asm volatile("s_waitcnt lgkmcnt(8)" ::: "memory"); AT_SBAR(); AT_PV_MM(1, lb, hb); AT_SBAR();
    AT_PV_RD(3, lb, hb);
    asm volatile("s_waitcnt lgkmcnt(8)" ::: "memory"); AT_SBAR(); AT_PV_MM(2, la, ha); AT_SBAR();
    asm volatile("s_waitcnt lgkmcnt(0)" ::: "memory"); AT_SBAR(); AT_PV_MM(3, lb, hb);
#undef AT_PV_RD
#undef AT_PV_MM
#undef AT_TRRD
}

__device__ __forceinline__ void attn_block(LAS unsigned char* lds, const bf16* Q, const bf16* K, const bf16* KV, const bf16* proj, bf16* YA, const float* qg, const float* cosT, const float* sinT, int b, int h, int qb) {
    const int tid = otid(), wid = __builtin_amdgcn_readfirstlane(tid >> 6), lane = tid & 63, r32 = lane & 31, hi = lane >> 5;
    const int P0 = qb * 256, NT = 4 * (qb + 1), qlo = P0 + wid * 32;
    LAS unsigned char* V_lds = lds + OFF_V; LAS unsigned char* K_lds = lds + OFF_K; LAS unsigned char* KR_lds = lds + OFF_KR;
    LAS float* wsf = (LAS float*)(lds + OFF_WS) + wid * 64; LAS float* li_l = wsf; LAS float* al_l = wsf + 32;
    bf16x8 qr[12];
    { const bf16* qp = Q + ((size_t)(b * SEQ + qlo + r32) * 8 + h) * 192 + hi * 8;
      bf16x8 raw[12];
#pragma unroll
      for (int d0 = 0; d0 < 12; ++d0) raw[d0] = *(const bf16x8*)(qp + d0 * 16);
      float ss = 0.f;
#pragma unroll
      for (int d0 = 0; d0 < 12; ++d0)
#pragma unroll
          for (int j = 0; j < 8; ++j) { const float v = bf2f((unsigned short)raw[d0][j]); ss += v * v; }
      { auto rr = __builtin_amdgcn_permlane32_swap(__float_as_uint(ss), __float_as_uint(ss), false, false); ss = __uint_as_float(rr[0]) + __uint_as_float(rr[1]); }
      const float rn = 1.0f / sqrtf(ss * (1.0f / 192.f) + EPS);
      const float* ct = cosT + (size_t)(b * SEQ + qlo + r32) * 32 + hi * 8; const float* st = sinT + (size_t)(b * SEQ + qlo + r32) * 32 + hi * 8;
#pragma unroll
      for (int d0 = 0; d0 < 8; ++d0) { const v4f g0 = *(const v4f*)(qg + d0 * 16 + hi * 8), g1 = *(const v4f*)(qg + d0 * 16 + hi * 8 + 4);
          const float g[8] = {g0.x, g0.y, g0.z, g0.w, g1.x, g1.y, g1.z, g1.w}; float x[8];
#pragma unroll
          for (int j = 0; j < 8; ++j) x[j] = bf2f((unsigned short)raw[d0][j]) * rn * g[j];
          u32x4 w = {cvtpk(x[0], x[1]), cvtpk(x[2], x[3]), cvtpk(x[4], x[5]), cvtpk(x[6], x[7])}; qr[d0] = *reinterpret_cast<bf16x8*>(&w); }
#pragma unroll
      for (int d0 = 8; d0 < 10; ++d0) { const int i0 = (d0 - 8) * 16;
          const v4f ga0 = *(const v4f*)(qg + d0 * 16 + hi * 8), ga1 = *(const v4f*)(qg + d0 * 16 + hi * 8 + 4), gb0 = *(const v4f*)(qg + (d0 + 2) * 16 + hi * 8), gb1 = *(const v4f*)(qg + (d0 + 2) * 16 + hi * 8 + 4);
          const v4f c0 = *(const v4f*)(ct + i0), c1 = *(const v4f*)(ct + i0 + 4), s0 = *(const v4f*)(st + i0), s1 = *(const v4f*)(st + i0 + 4);
          const float ga[8] = {ga0.x, ga0.y, ga0.z, ga0.w, ga1.x, ga1.y, ga1.z, ga1.w}, gb[8] = {gb0.x, gb0.y, gb0.z, gb0.w, gb1.x, gb1.y, gb1.z, gb1.w};
          const float cs[8] = {c0.x, c0.y, c0.z, c0.w, c1.x, c1.y, c1.z, c1.w}, sn[8] = {s0.x, s0.y, s0.z, s0.w, s1.x, s1.y, s1.z, s1.w};
          float y1[8], y2[8];
#pragma unroll
          for (int j = 0; j < 8; ++j) { const float x1 = bf2f((unsigned short)raw[d0][j]) * rn * ga[j], x2 = bf2f((unsigned short)raw[d0 + 2][j]) * rn * gb[j];
              y1[j] = x1 * cs[j] - x2 * sn[j]; y2[j] = x2 * cs[j] + x1 * sn[j]; }
          u32x4 w1 = {cvtpk(y1[0], y1[1]), cvtpk(y1[2], y1[3]), cvtpk(y1[4], y1[5]), cvtpk(y1[6], y1[7])}; qr[d0] = *reinterpret_cast<bf16x8*>(&w1);
          u32x4 w2 = {cvtpk(y2[0], y2[1]), cvtpk(y2[2], y2[3]), cvtpk(y2[4], y2[5]), cvtpk(y2[6], y2[7])}; qr[d0 + 2] = *reinterpret_cast<bf16x8*>(&w2); }
    }
    const int sr = tid >> 4, sc = (tid & 15) * 8, kws = AT_KSWZ(sr, sc * 2), vst0 = v_st(sr, sc), vst1 = v_st(32 + sr, sc);
    const int rr = tid >> 3, rc = (tid & 7) * 8, krws = AT_KRSWZ(rr, rc * 2);
    const bf16* Kg = K + ((size_t)(b * SEQ) * 8 + h) * 192;
    const bf16* Vg = KV + (size_t)(b * SEQ) * 2048 + h * 256 + 128;
    bf16x8 sa_k0, sa_k1, sa_kr, sa_v0, sa_v1, sb_k0, sb_k1, sb_kr, sb_v0, sb_v1;
#define AT_SLOAD(S, kb_) do { S##_k0 = *(const bf16x8*)(Kg + (size_t)((kb_) + sr) * 1536 + sc); S##_k1 = *(const bf16x8*)(Kg + (size_t)((kb_) + 32 + sr) * 1536 + sc); \
        S##_kr = *(const bf16x8*)(Kg + (size_t)((kb_) + rr) * 1536 + 128 + rc); \
        S##_v0 = *(const bf16x8*)(Vg + (size_t)((kb_) + sr) * 2048 + sc); S##_v1 = *(const bf16x8*)(Vg + (size_t)((kb_) + 32 + sr) * 2048 + sc); } while (0)
#define AT_SWRITE(S, bf, vbf) do { *(LAS bf16x8*)(K_lds + (bf) * SHM_K + kws) = S##_k0; *(LAS bf16x8*)(K_lds + (bf) * SHM_K + kws + 32 * 256) = S##_k1; \
        *(LAS bf16x8*)(KR_lds + (bf) * SHM_KR + krws) = S##_kr; \
        *(LAS bf16x8*)(V_lds + (vbf) * SHM_V + vst0) = S##_v0; *(LAS bf16x8*)(V_lds + (vbf) * SHM_V + vst1) = S##_v1; } while (0)
    AT_SLOAD(sa, 0); AT_SLOAD(sb, 64); AT_SWRITE(sa, 0, 0);
    __syncthreads();
    float m_reg = -1e30f, l_reg = 0.f; f32x16 o[4] = {};
    const unsigned vbase = (unsigned)(size_t)V_lds + (unsigned)v_rd_base(lane);
    const bool late = wid >= 4;
    bool pend = false; int pvb = 0; int vb3 = 0;
    bf16x8 pa0, pa1, pa2, pa3;
#define AT_STEP(t, SL, SW) do { \
        const int buf = (t) & 1, kb = (t) * 64; \
        if ((t) + 2 < NT) AT_SLOAD(SL, kb + 128);                         \
        if (late && pend) { pv_tile(o, vbase + pvb * SHM_V, pa0, pa1, pa2, pa3); pend = false; AT_SBAR(); } \
        if (kb <= qlo + 31) { \
            f32x16 p0, p1; float mn, alpha; \
            qkt(p0, p1, K_lds + buf * SHM_K, KR_lds + buf * SHM_KR, r32, hi, qr); \
            if (kb + 63 > qlo) mask_tile(p0, p1, qlo + r32 - 4 * hi - kb); \
            partialSM(p0, p1, m_reg, mn, alpha); \
            finishSM(p0, p1, alpha, l_reg, pa0, pa1, pa2, pa3); \
            if (__any(alpha < 1.f)) { if (hi == 0) al_l[r32] = alpha; asm volatile("s_waitcnt lgkmcnt(0)" ::: "memory"); \
                _Pragma("unroll") for (int d_ = 0; d_ < 4; ++d_) _Pragma("unroll") for (int r = 0; r < 16; ++r) o[d_][r] *= al_l[crow(r, hi)]; \
                asm volatile("s_waitcnt lgkmcnt(0)" ::: "memory"); } \
            AT_SBAR(); \
            if (late) { pend = true; pvb = vb3; } \
            else pv_tile(o, vbase + vb3 * SHM_V, pa0, pa1, pa2, pa3); \
        } \
        const int vn3 = vb3 == 2 ? 0 : vb3 + 1; \
        if ((t) + 1 < NT) AT_SWRITE(SW, buf ^ 1, vn3);                    \
        vb3 = vn3; \
        __syncthreads(); } while (0)
    for (int t = 0; t < NT; t += 2) { AT_STEP(t, sa, sb); AT_STEP(t + 1, sb, sa); }
#undef AT_STEP
    if (late && pend) pv_tile(o, vbase + pvb * SHM_V, pa0, pa1, pa2, pa3);
    if (hi == 0) li_l[r32] = l_reg;
    asm volatile("s_waitcnt lgkmcnt(0)" ::: "memory");
    float rli[16];
#pragma unroll
    for (int r = 0; r < 16; ++r) rli[r] = 1.0f / li_l[crow(r, hi)];
#pragma unroll
    for (int d0 = 0; d0 < 4; ++d0) { const int col = h * 128 + d0 * 32 + r32;
        unsigned short zr[16];
#pragma unroll
        for (int r = 0; r < 16; ++r) zr[r] = proj[(size_t)(b * SEQ + qlo + crow(r, hi)) * NPROJ + C_ZA + col];
#pragma unroll
        for (int r = 0; r < 16; ++r) { const int row = b * SEQ + qlo + crow(r, hi);
            const float v = o[d0][r] * rli[r] * silu_f(bf2f(zr[r]));
            const float vn = lane_xor<1>(v);
            if ((r32 & 1) == 0) *(unsigned*)(YA + (size_t)row * 1024 + col) = cvtpk(v, vn); } }
    asm volatile("s_waitcnt lgkmcnt(0)" ::: "memory");
    __syncthreads();
#undef AT_SLOAD
#undef AT_SWRITE
}
}


namespace sg {
using at::bf16x8; using at::f32x16;
__device__ __forceinline__ void sgu_item(LAS unsigned char* lds, const bf16* proj, const float* rv, const float* Ws, const float* bs, const float* vg, bf16* YB, int it) {
    const int tid = otid(), wid = __builtin_amdgcn_readfirstlane(tid >> 6), lane = tid & 63, r32 = lane & 31, hi = lane >> 5;
    {
        const int ch = it >> 2, gp = it & 3, R0 = ch * 128;
#pragma unroll
        for (int i = 0; i < 8; ++i) {
            const int idx = tid + 512 * i, gsel = idx >> 11, row = (idx >> 4) & 127, cc = idx & 15;
            const v4u w = *(const v4u*)(proj + (size_t)(R0 + row) * NPROJ + C_VB + (2 * gp + gsel) * 128 + cc * 8);
            const float s = 1.0f / sqrtf(rv[R0 + row] * (1.0f / 1024.f) + EPS);
            v4u o; o.x = pk2(gelu_f(lo16(w.x)) * s, gelu_f(hi16(w.x)) * s); o.y = pk2(gelu_f(lo16(w.y)) * s, gelu_f(hi16(w.y)) * s);
            o.z = pk2(gelu_f(lo16(w.z)) * s, gelu_f(hi16(w.z)) * s); o.w = pk2(gelu_f(lo16(w.w)) * s, gelu_f(hi16(w.w)) * s);
            *(LAS v4u*)(lds + (gsel * 2 + (row >> 6)) * 16384 + at::v_st(row & 63, cc * 8)) = o;
        }
        __syncthreads();
        const int gsel = wid >> 2, g = 2 * gp + gsel, t = 32 * (wid & 3) + r32;
        f32x16 o[4] = {};
        const int nst = (wid & 3) >= 2 ? 2 : 1;
        for (int st = 0; st < nst; ++st) {
            bf16x8 pa[4];
#pragma unroll
            for (int ks = 0; ks < 4; ++ks) {
                const int s0 = st * 64 + ks * 16 + hi * 8;
                const float* wp = Ws + ((size_t)g * 128 + t) * 128 + s0;
                const v4f a = *(const v4f*)wp, b = *(const v4f*)(wp + 4);
                float x[8] = {a.x, a.y, a.z, a.w, b.x, b.y, b.z, b.w};
#pragma unroll
                for (int j = 0; j < 8; ++j) if (s0 + j > t) x[j] = 0.f;
                at::u32x4 w4 = {at::cvtpk(x[0], x[1]), at::cvtpk(x[2], x[3]), at::cvtpk(x[4], x[5]), at::cvtpk(x[6], x[7])};
                pa[ks] = *reinterpret_cast<bf16x8*>(&w4);
            }
            const unsigned vbase = (unsigned)(size_t)(lds + (gsel * 2 + st) * 16384) + (unsigned)at::v_rd_base(lane);
            at::pv_tile(o, vbase, pa[0], pa[1], pa[2], pa[3]);
        }
#pragma unroll
        for (int d0 = 0; d0 < 4; ++d0) { const int gc = g * 128 + d0 * 32 + r32; const float vgc = vg[gc];
            unsigned short ur[16], zr[16];
#pragma unroll
            for (int r = 0; r < 16; ++r) { const size_t row = (size_t)(R0 + 32 * (wid & 3) + at::crow(r, hi)); ur[r] = proj[row * NPROJ + C_UB + gc]; zr[r] = proj[row * NPROJ + C_ZB + gc]; }
#pragma unroll
            for (int r = 0; r < 16; ++r) { const int tl = 32 * (wid & 3) + at::crow(r, hi); const size_t row = (size_t)(R0 + tl);
                const float mix = o[d0][r] * vgc + bs[g * 128 + tl];
                const float y = gelu_f(bf2f(ur[r])) * mix * silu_f(bf2f(zr[r])), yn = lane_xor<1>(y);
                if ((r32 & 1) == 0) *(unsigned*)(YB + row * 1024 + gc) = at::cvtpk(y, yn); } }
        __syncthreads();
    }
}
}


namespace gl {
using at::bf16x8; using at::f32x16; using at::s16x4; using at::u32x4;
constexpr int OFF_VIMG = 0, OFF_KLIMG = 65536, OFF_ATT = 98304, OFF_DS = 131072, OFF_PART = 131584, LDS_NEED = OFF_PART + 4096;

__device__ __forceinline__ void gla_prep_item(LAS unsigned char* lds, int seg_off, const bf16* proj, const float* wa2, const float* ba, bf16* QE, bf16* KE, bf16* KL, float* DS, int ci) {
    const int tid = otid(), k2 = tid & 63, ts = tid >> 6, k = 2 * k2;
    LAS float* seg = (LAS float*)(lds + seg_off);
    {
        const int ch = ci >> 2, h = ci & 3, R0 = ch * 128 + ts * 16;
        float wa0[16], wa1[16];
#pragma unroll
        for (int j = 0; j < 16; ++j) { const v2f w = *(const v2f*)(wa2 + j * 512 + h * 128 + k); wa0[j] = w.x; wa1[j] = w.y; }
        const v2f bak = *(const v2f*)(ba + h * 128 + k);
        float la0[16], la1[16]; float run0 = 0.f, run1 = 0.f;
#pragma unroll
        for (int i = 0; i < 16; ++i) {
            const bf16* pr = proj + (size_t)(R0 + i) * NPROJ + C_AR;
            const v4u w0 = *(const v4u*)pr, w1 = *(const v4u*)(pr + 8);
            const float ar[16] = {lo16(w0.x), hi16(w0.x), lo16(w0.y), hi16(w0.y), lo16(w0.z), hi16(w0.z), lo16(w0.w), hi16(w0.w),
                                  lo16(w1.x), hi16(w1.x), lo16(w1.y), hi16(w1.y), lo16(w1.z), hi16(w1.z), lo16(w1.w), hi16(w1.w)};
            float x0 = bak.x, x1 = bak.y;
#pragma unroll
            for (int j = 0; j < 16; ++j) { x0 += ar[j] * wa0[j]; x1 += ar[j] * wa1[j]; }
            run0 += (fminf(x0, 0.f) - __logf(1.0f + __expf(-fabsf(x0)))) * 0.0625f; la0[i] = run0;
            run1 += (fminf(x1, 0.f) - __logf(1.0f + __expf(-fabsf(x1)))) * 0.0625f; la1[i] = run1;
        }
        *(LAS v2f*)(seg + ts * 128 + k) = (v2f){run0, run1};
        __syncthreads();
        float pre0 = 0.f, pre1 = 0.f, tot0 = 0.f, tot1 = 0.f;
#pragma unroll
        for (int q = 0; q < 8; ++q) { const v2f sg = *(const LAS v2f*)(seg + q * 128 + k); tot0 += sg.x; tot1 += sg.y; if (q < ts) { pre0 += sg.x; pre1 += sg.y; } }
        const float et0 = __expf(tot0), et1 = __expf(tot1);
        unsigned qw[16], kw[16];
#pragma unroll
        for (int i = 0; i < 16; ++i) { const size_t row = (size_t)(R0 + i); qw[i] = *(const unsigned*)(proj + row * NPROJ + C_QC + h * 128 + k); kw[i] = *(const unsigned*)(proj + row * NPROJ + C_KC + h * 128 + k); }
#pragma unroll
        for (int i = 0; i < 16; ++i) {
            const size_t o = (size_t)(R0 + i) * 512 + h * 128 + k;
            const float e0 = __expf(la0[i] + pre0), e1 = __expf(la1[i] + pre1), r0 = __builtin_amdgcn_rcpf(e0), r1 = __builtin_amdgcn_rcpf(e1);
            const float q0 = lo16(qw[i]) * 0.08838834764831845f, q1 = hi16(qw[i]) * 0.08838834764831845f, kk0 = lo16(kw[i]) * r0, kk1 = hi16(kw[i]) * r1;
            *(unsigned*)(QE + o) = pk2(q0 * e0, q1 * e1);
            *(unsigned*)(KE + o) = pk2(kk0, kk1);
            *(unsigned*)(KL + o) = pk2(kk0 * et0, kk1 * et1);
        }
        if (ts == 0) *(v2f*)(DS + ((size_t)ch * 4 + h) * 128 + k) = (v2f){et0, et1};
        __syncthreads();
    }
}

#define GL_PK4(P, B_, OUT) do { unsigned a0 = at::cvtpk(P[B_+0], P[B_+1]), a1 = at::cvtpk(P[B_+2], P[B_+3]);                          \
        unsigned b0 = at::cvtpk(P[B_+4], P[B_+5]), b1 = at::cvtpk(P[B_+6], P[B_+7]);                                             \
        auto r0 = __builtin_amdgcn_permlane32_swap(a0, b0, false, false); auto r1 = __builtin_amdgcn_permlane32_swap(a1, b1, false, false); \
        u32x4 w = {r0[0], r1[0], r0[1], r1[1]}; OUT = *reinterpret_cast<bf16x8*>(&w); } while (0)
#define GL_TRRD(dst, addr, off) asm volatile("ds_read_b64_tr_b16 %0, %1 offset:%2" : "=&v"(dst) : "v"(addr), "i"(off) : "memory")

template <int TT> __device__ __forceinline__ void o_intra_tile(LAS unsigned char* lds, const bf16x8 (&vfr)[8], float* oi, int r32, int hi) {
    f32x16 acc = {};
    const int t = 32 * TT + r32;
    bf16x8 af[2 * TT + 2];
#pragma unroll
    for (int ks8 = 0; ks8 < 2 * TT + 2; ++ks8) af[ks8] = *(const LAS bf16x8*)(lds + OFF_ATT + t * 256 + (((16 * ks8 + 8 * hi) * 2) ^ ((t & 7) << 4)));
#pragma unroll
    for (int ks8 = 0; ks8 < 2 * TT + 2; ++ks8) acc = __builtin_amdgcn_mfma_f32_32x32x16_bf16(af[ks8], vfr[ks8], acc, 0, 0, 0);
    __builtin_amdgcn_sched_group_barrier(0x100, 2 * TT + 2, 0); __builtin_amdgcn_sched_group_barrier(0x008, 2 * TT + 2, 0);
#pragma unroll
    for (int r4 = 0; r4 < 4; ++r4) *(v4f*)(oi + (size_t)(TT * 4 + r4) * 256) = (v4f){acc[4 * r4], acc[4 * r4 + 1], acc[4 * r4 + 2], acc[4 * r4 + 3]};
}
__device__ __forceinline__ void gla_chunk_item(LAS unsigned char* lds, const bf16* proj, const bf16* QE, const bf16* KE, const bf16* KL, float* OI, float* DL, int ci) {
    const int tid = otid(), wid = __builtin_amdgcn_readfirstlane(tid >> 6), lane = tid & 63, r32 = lane & 31, hi = lane >> 5;
    const int h = ci & 3, R0 = (ci >> 2) * 128;
    {
        {
#pragma unroll
            for (int i = 0; i < 8; ++i) { const int idx = tid + 512 * i, s = idx >> 5, cc = idx & 31;
                const v4u w = *(const v4u*)(proj + (size_t)(R0 + s) * NPROJ + C_VC + h * 256 + cc * 8);
                *(LAS v4u*)(lds + OFF_VIMG + ((s >> 6) * 2 + (cc >> 4)) * 16384 + at::v_st(s & 63, (cc & 15) * 8)) = w; }
#pragma unroll
            for (int i = 0; i < 4; ++i) { const int idx = tid + 512 * i, s = idx >> 4, cc = idx & 15;
                const v4u w = *(const v4u*)(KL + (size_t)(R0 + s) * 512 + h * 128 + cc * 8);
                *(LAS v4u*)(lds + OFF_KLIMG + (s >> 6) * 16384 + at::v_st(s & 63, cc * 8)) = w; }
#pragma unroll
            for (int j = 0; j < 2; ++j) {
                const int ti = 2 * wid + j, st = ti >> 2, tt = ti & 3;
                if (st <= tt) {
                    f32x16 p = {};
                    const bf16* ap = KE + (size_t)(R0 + 32 * st + r32) * 512 + h * 128 + hi * 8;
                    const bf16* bp = QE + (size_t)(R0 + 32 * tt + r32) * 512 + h * 128 + hi * 8;
                    bf16x8 fa[8], fb[8];
#pragma unroll
                    for (int ks = 0; ks < 8; ++ks) { fa[ks] = *(const bf16x8*)(ap + ks * 16); fb[ks] = *(const bf16x8*)(bp + ks * 16); }
#pragma unroll
                    for (int ks = 0; ks < 8; ++ks) p = __builtin_amdgcn_mfma_f32_32x32x16_bf16(fa[ks], fb[ks], p, 0, 0, 0);
                    __builtin_amdgcn_sched_group_barrier(0x020, 16, 0); __builtin_amdgcn_sched_group_barrier(0x008, 8, 0);
                    if (st == tt) {
#pragma unroll
                        for (int r = 0; r < 16; ++r) if (at::crow(r, hi) > r32) p[r] = 0.f; }
                    const int t = 32 * tt + r32;
#pragma unroll
                    for (int g = 0; g < 4; ++g) { v2u w; w.x = at::cvtpk(p[4 * g], p[4 * g + 1]); w.y = at::cvtpk(p[4 * g + 2], p[4 * g + 3]);
                        *(LAS v2u*)(lds + OFF_ATT + t * 256 + ((64 * st + 16 * g) ^ ((t & 7) << 4)) + 8 * hi) = w; }
                }
            }
            __syncthreads();
            bf16x8 vfr[8];
            { const unsigned vaddr = (unsigned)(size_t)(lds + OFF_VIMG + (wid >> 2) * 16384) + (unsigned)at::v_rd_base(lane) + (unsigned)((wid & 3) * 512);
              s16x4 vl[8], vh[8];
#define GL_VF(ks8) do { constexpr int o_ = ((ks8) >> 2) * 32768 + ((ks8) & 3) * 4096; GL_TRRD(vl[ks8], vaddr, o_); GL_TRRD(vh[ks8], vaddr, o_ + 2048); } while (0)
              GL_VF(0); GL_VF(1); GL_VF(2); GL_VF(3); GL_VF(4); GL_VF(5); GL_VF(6); GL_VF(7);
#undef GL_VF
              asm volatile("s_waitcnt lgkmcnt(0)" ::: "memory"); AT_SBAR();
#pragma unroll
              for (int q = 0; q < 8; ++q) vfr[q] = (bf16x8){vl[q][0], vl[q][1], vl[q][2], vl[q][3], vh[q][0], vh[q][1], vh[q][2], vh[q][3]};
              AT_SBAR(); }
            float* oi = OI + (((size_t)ci * 8 + wid) * 16 * 64 + lane) * 4;
            float* dl = DL + (((size_t)ci * 8 + wid) * 16 * 64 + lane) * 4;
            o_intra_tile<0>(lds, vfr, oi, r32, hi); o_intra_tile<1>(lds, vfr, oi, r32, hi); o_intra_tile<2>(lds, vfr, oi, r32, hi); o_intra_tile<3>(lds, vfr, oi, r32, hi);
#pragma unroll
            for (int kt = 0; kt < 4; ++kt) {
                f32x16 D = {};
                const unsigned kaddr = (unsigned)(size_t)(lds + OFF_KLIMG) + (unsigned)at::v_rd_base(lane) + (unsigned)(kt * 512);
#define GL_KF(ks8) do { s16x4 l_, h_; constexpr int o_ = ((ks8) >> 2) * 16384 + ((ks8) & 3) * 4096; GL_TRRD(l_, kaddr, o_); GL_TRRD(h_, kaddr, o_ + 2048); \
                asm volatile("s_waitcnt lgkmcnt(0)" ::: "memory"); AT_SBAR(); \
                D = __builtin_amdgcn_mfma_f32_32x32x16_bf16((bf16x8){l_[0], l_[1], l_[2], l_[3], h_[0], h_[1], h_[2], h_[3]}, vfr[ks8], D, 0, 0, 0); } while (0)
                GL_KF(0); GL_KF(1); GL_KF(2); GL_KF(3); GL_KF(4); GL_KF(5); GL_KF(6); GL_KF(7);
#undef GL_KF
#pragma unroll
                for (int r4 = 0; r4 < 4; ++r4) *(v4f*)(dl + (size_t)(kt * 4 + r4) * 256) = (v4f){D[4 * r4], D[4 * r4 + 1], D[4 * r4 + 2], D[4 * r4 + 3]};
            }
            __syncthreads();
        }
    }
}

__device__ __forceinline__ void gla_stageA_item(const float* DS, const float* DL, bf16* XB, int b, int h, int vp) {
    const int tid = otid(), wid = __builtin_amdgcn_readfirstlane(tid >> 6), lane = tid & 63, hi = lane >> 5;
    const int vb = 2 * vp + (wid >> 2), kt = wid & 3;
    constexpr int PF = 4, NC = SEQ / 128;
    f32x16 X = {};
    v4f dq[PF][4], sq[PF][4];
    const size_t ci0 = (size_t)(b * 32) * 4 + h;
#define GL_ALOAD(slot, c_) do { const size_t ci_ = ci0 + (size_t)(c_) * 4; const float* dl_ = DL + ((ci_ * 8 + vb) * 16 * 64 + lane) * 4 + (size_t)(kt * 4) * 256; const float* ds_ = DS + ci_ * 128 + 32 * kt + 4 * hi; \
        _Pragma("unroll") for (int r4 = 0; r4 < 4; ++r4) { dq[slot][r4] = *(const v4f*)(dl_ + (size_t)r4 * 256); sq[slot][r4] = *(const v4f*)(ds_ + 8 * r4); } } while (0)
#pragma unroll
    for (int s = 0; s < PF; ++s) GL_ALOAD(s, s);
    for (int c0 = 0; c0 < NC; c0 += PF) {
#pragma unroll
        for (int s = 0; s < PF; ++s) {
            const int c = c0 + s; const size_t ci = ci0 + (size_t)c * 4;
            bf16* xo = XB + (((ci * 8 + vb) * 8 + kt * 2) * 64 + lane) * 8;
            bf16x8 xb0, xb1; GL_PK4(X, 0, xb0); GL_PK4(X, 8, xb1);
            *(bf16x8*)xo = xb0; *(bf16x8*)(xo + 512) = xb1;
#pragma unroll
            for (int r4 = 0; r4 < 4; ++r4) { const v4f w = dq[s][r4], d4 = sq[s][r4];
                X[4 * r4] = X[4 * r4] * d4.x + w.x; X[4 * r4 + 1] = X[4 * r4 + 1] * d4.y + w.y; X[4 * r4 + 2] = X[4 * r4 + 2] * d4.z + w.z; X[4 * r4 + 3] = X[4 * r4 + 3] * d4.w + w.w; }
            if (c + PF < NC) GL_ALOAD(s, c + PF);
        }
    }
#undef GL_ALOAD
}
__device__ __forceinline__ void gla_stageB_item(const bf16* proj, const bf16* QE, const float* OI, const bf16* XB, const float* og, bf16* YC, int b, int h, int cp) {
    const int tid = otid(), wid = __builtin_amdgcn_readfirstlane(tid >> 6), lane = tid & 63, r32 = lane & 31, hi = lane >> 5;
    {
        const int c = 2 * cp + (wid >> 2), tt = wid & 3, R0 = b * SEQ + c * 128;
        const size_t ci = (size_t)(b * 32 + c) * 4 + h;
        f32x16 acc[8];
#pragma unroll
        for (int vb = 0; vb < 8; ++vb) { const float* oi = OI + ((ci * 8 + vb) * 16 * 64 + lane) * 4 + (size_t)(tt * 4) * 256;
#pragma unroll
            for (int r4 = 0; r4 < 4; ++r4) { const v4f w = *(const v4f*)(oi + (size_t)r4 * 256); acc[vb][4 * r4] = w.x; acc[vb][4 * r4 + 1] = w.y; acc[vb][4 * r4 + 2] = w.z; acc[vb][4 * r4 + 3] = w.w; } }
        bf16x8 qa[8];
        { const bf16* qp = QE + (size_t)(R0 + 32 * tt + r32) * 512 + h * 128 + hi * 8;
#pragma unroll
          for (int ks = 0; ks < 8; ++ks) qa[ks] = *(const bf16x8*)(qp + ks * 16); }
        if (c > 0) {
            const bf16* xi = XB + (((ci * 8) * 8) * 64 + lane) * 8;
            bf16x8 xf[64];
#pragma unroll
            for (int i = 0; i < 64; ++i) xf[i] = *(const bf16x8*)(xi + (size_t)i * 512);
#pragma unroll
            for (int i = 0; i < 64; ++i) acc[i >> 3] = __builtin_amdgcn_mfma_f32_32x32x16_bf16(qa[i & 7], xf[i], acc[i >> 3], 0, 0, 0);
            __builtin_amdgcn_sched_group_barrier(0x020, 16, 0);
#pragma unroll
            for (int i = 0; i < 48; ++i) { __builtin_amdgcn_sched_group_barrier(0x008, 1, 0); __builtin_amdgcn_sched_group_barrier(0x020, 1, 0); }
            __builtin_amdgcn_sched_group_barrier(0x008, 16, 0);
        }
        float rn[16];
#pragma unroll
        for (int r = 0; r < 16; ++r) { float s = 0.f;
#pragma unroll
            for (int vb = 0; vb < 8; ++vb) s += acc[vb][r] * acc[vb][r];
            s += lane_xor<1>(s); s += lane_xor<2>(s); s += lane_xor<4>(s); s += lane_xor<8>(s); s += lane_xor<16>(s);
            rn[r] = 1.0f / sqrtf(s * (1.0f / 256.f) + EPS); }
#pragma unroll
        for (int vb = 0; vb < 8; ++vb) { const float gcol = og[32 * vb + r32];
            unsigned short zr[16];
#pragma unroll
            for (int r = 0; r < 16; ++r) zr[r] = proj[(size_t)(R0 + 32 * tt + at::crow(r, hi)) * NPROJ + C_ZC + h * 256 + 32 * vb + r32];
#pragma unroll
            for (int r = 0; r < 16; ++r) { const size_t row = (size_t)(R0 + 32 * tt + at::crow(r, hi));
                const float y = acc[vb][r] * rn[r] * gcol * silu_f(bf2f(zr[r])), yn = lane_xor<1>(y);
                if ((r32 & 1) == 0) *(unsigned*)(YC + row * 1024 + h * 256 + 32 * vb + r32) = at::cvtpk(y, yn); } }
    }
}
#undef GL_PK4
#undef GL_TRRD
}


constexpr int CW_Q = 65536;
__device__ __forceinline__ int q_pop(unsigned* ctr, LAS unsigned* slot) {
    if (otid() == 0) *slot = __hip_atomic_fetch_add(ctr, 1u, __ATOMIC_RELAXED, __HIP_MEMORY_SCOPE_AGENT);
    __syncthreads(); const int v = (int)*slot; __syncthreads(); return v; }
__device__ __forceinline__ void ph_mixers(LAS unsigned char* lds, unsigned char* ws, unsigned* qctr, const float* Ws, const float* bs, const float* vg, const float* og, const float* qg, int row0, int vb) {
    constexpr int NGLA = NBP * 8, NATT = 16 * NBP, NSGU = 16 * NBP, NQ = NGLA + NATT + NSGU;
    static_assert(NBP % 2 == 0, "NBP even");
    LAS unsigned* slot = (LAS unsigned*)(lds + LDSCTL_OFF + 64);
    bf16* proj = (bf16*)(ws + WS_PROJ);
    for (int dq = 0; dq < 8; ++dq) {
        const int q = (vb + dq) & 7;
        for (;;) {
            const int idx = q_pop(qctr + q * 64, slot);
            if (idx >= NQ) break;
            if (idx >= NATT && idx < NATT + NGLA) { const int gi = q * NGLA + (idx - NATT), bh = gi >> 4, cp = gi & 15;
                gl::gla_stageB_item(proj, (const bf16*)(ws + WS_QE), (const float*)(ws + WS_OC), (const bf16*)(ws + WS_XB), og, (bf16*)(ws + WS_YC), bh >> 2, bh & 3, cp); }
            else if (idx < NATT) { const int j = idx, qb = 15 - j / NBP, bh = q * NBP + j % NBP;
                at::attn_block(lds, (const bf16*)(ws + WS_Q), (const bf16*)(ws + WS_K), (const bf16*)(ws + WS_KV), proj, (bf16*)(ws + WS_YA), qg, (const float*)(ws + WS_COS) + (size_t)row0 * 32, (const float*)(ws + WS_SIN) + (size_t)row0 * 32, bh >> 3, bh & 7, qb); }
            else { const int it = q * NSGU + (idx - NGLA - NATT);
                sg::sgu_item(lds, proj, (const float*)(ws + WS_SSQ) + 2 * MP, Ws, bs, vg, (bf16*)(ws + WS_YB), it); }
        }
    }
}
#ifndef GEMM_SP2
#define GEMM_SP2 true
#endif
#ifndef GEMM_ALIGN
#define GEMM_ALIGN true
#endif
typedef const __attribute__((address_space(4))) Args* KArgP;
#define KARG() ({ KArgP p_ = (KArgP)__builtin_amdgcn_kernarg_segment_ptr(); asm volatile("" : "+s"(p_)); p_; })
#define INF(i) ((const float*)ap->in[i])
__device__ __forceinline__ void grid_bar(const XcdBarrier& b0) { XcdBarrier b = b0; asm volatile("" : "+s"(b.bar)); xcd_barrier(b); }

__global__ void __launch_bounds__(512, 2) fwd(Args a) {
    extern __shared__ __attribute__((aligned(16))) unsigned char lds_raw[];
    LAS unsigned char* lds = (LAS unsigned char*)lds_raw;
    const int lo = a.lo, hi = a.hi;
    XcdBarrier bar; bar.bar = (unsigned*)(a.ws + WS_CTL) + CW_BAR; bar.x = 0; bar.st = nullptr;
    if (hi - lo > 1) {
        if (threadIdx.x < 4) ((LAS unsigned*)(lds + LDSCTL_OFF))[threadIdx.x] = 0u;
        __syncthreads();
        bar = xcd_barrier_post((unsigned*)(a.ws + WS_CTL) + CW_BAR, (volatile LAS unsigned*)(lds + LDSCTL_OFF));
    }
    int step = 0;
#define PH_BEGIN if (step >= lo && step < hi) { const KArgP ap = KARG(); unsigned char* const ws = ap->ws; const int vb = obid(), nvb = gridDim.x; (void)ws; (void)vb; (void)nvb;
#define PH_END   if (step + 1 < hi) grid_bar(bar); } ++step;
#define WL(l) (ws + WS_W + (size_t)(l) * SZ_WLAYER)
#define B_(T, off) ((T*)(ws + (off)))

    for (int l = 0; l < DEPTH; ++l) {
        PH_BEGIN
            { unsigned char* wl = ws + WS_W;
              convert_T<1>(INF(3) + (size_t)l * DM * IN_COLS, DM, IN_COLS, (bf16*)wl, NBF, (LAS float*)lds, vb, nvb);
              convert_T8(INF(3) + (size_t)l * DM * IN_COLS, DM, IN_COLS, wl + SZ_WINB, NF8, (LAS float*)lds, (vb + 96) % nvb, nvb);
              convert_T<0>(INF(6) + (size_t)l * 512 * 1536, 512, 1536, (bf16*)(wl + SZ_WIN), 1536, (LAS float*)lds, (vb + 64) % nvb, nvb, INF(4) + l * 512);
              convert_T<0>(INF(7) + (size_t)l * 512 * 2048, 512, 2048, (bf16*)(wl + SZ_WIN + SZ_WUQ), 2048, (LAS float*)lds, (vb + 128) % nvb, nvb, INF(5) + l * 512);
              for (int b = 0; b < 3; ++b)
                  convert_T<0>(INF(16) + ((size_t)l * 3 + b) * 1024 * 2048, 1024, 2048, (bf16*)(wl + SZ_WIN + SZ_WUQ + SZ_WUKV) + (size_t)b * 2048 * 1024, 2048, (LAS float*)lds, (vb + 32 * b) % nvb, nvb);
              convert_T<0>(INF(17) + (size_t)l * 2048 * 2048, 2048, 2048, (bf16*)(wl + SZ_WIN + SZ_WUQ + SZ_WUKV + SZ_WB), 2048, (LAS float*)lds, (vb + 192) % nvb, nvb); }
            if (l == 0) { const int* positions = (const int*)ap->in[1]; float* cosT = B_(float, WS_COS); float* sinT = B_(float, WS_SIN);
              for (int idx = vb * 512 + otid(); idx < MTOK * 32; idx += nvb * 512) {
                const int t = idx >> 5, i = idx & 31;
                const float inv = 1.0f / powf(10000.0f, (float)(2 * i) * (1.0f / 64.0f));
                const float ang = (float)positions[t] * inv;
                float sn, cs; sincosf(ang, &sn, &cs);
                cosT[idx] = cs; sinT[idx] = sn; } }
        PH_END
        for (int p = 0; p < NPASS; ++p) {
            const int row0 = p * MP;
#define XIN ((l == 0 ? (const float*)ap->in[0] : (const float*)ap->out) + (size_t)row0 * DM)
#define WLP (ws + WS_W)
            PH_BEGIN ph_norm(XIN, INF(2) + l * DM, B_(bf16, WS_H), B_(unsigned char, WS_H8), MP, vb, nvb);
                     { float* ssq = B_(float, WS_SSQ); for (int i = vb * 512 + otid(); i < 3 * MP; i += nvb * 512) ssq[i] = 0.f; } PH_END
            PH_BEGIN { { pg8::Gemm g{B_(bf16, WS_H), (const bf16*)WLP, MP, NBF, DM}; pg8::StaticOrder S; S.init(MP, NBF, nvb, vb); pg8::EpiProj E{B_(bf16, WS_PROJ), NPROJ, B_(float, WS_SSQ), MP, 0};
                         pg8::gemm_phase<pg8::EpiProj, pg8::StaticOrder, false, GEMM_ALIGN, GEMM_SP2>(lds, g, S, E, nullptr); }
                       { pg8::Gemm g{(const bf16*)B_(unsigned char, WS_H8), (const bf16*)(WLP + SZ_WINB), MP, NF8, DM / 2}; pg8::StaticOrder S; S.init(MP, NF8, nvb, vb);
                         { const int ub = (MP / 256) * (NBF / 256), u8 = (MP / 256) * (NF8 / 256), sk = ub % nvb;
                           if (sk > 0 && sk < nvb) { S.skip = sk; S.full = (u8 - 2 * (nvb - sk)) / nvb; if (S.full < 0) S.full = 0; } }
                         pg8::EpiProj E{B_(bf16, WS_PROJ) + NBF, NPROJ, B_(float, WS_SSQ), MP, NBF / 256};
                         pg8::gemm_phase<pg8::EpiProj, pg8::StaticOrder, false, GEMM_ALIGN, GEMM_SP2, true>(lds, g, S, E, nullptr); } } PH_END
            PH_BEGIN { { pg8::Gemm g{B_(bf16, WS_PROJ) + C_CQ, (const bf16*)(WLP + SZ_WIN), MP, 1536, 512, NPROJ}; pg8::StaticOrder S; S.init(MP, 1536, nvb, vb); pg8::EpiBf16Row E{B_(bf16, WS_Q), 1536, B_(float, WS_SSQ), 1.0f / 512.f, EPS};
                         pg8::gemm_phase<pg8::EpiBf16Row, pg8::StaticOrder, false, GEMM_ALIGN, GEMM_SP2>(lds, g, S, E, nullptr); }
                       { pg8::Gemm g{B_(bf16, WS_PROJ) + C_CKV, (const bf16*)(WLP + SZ_WIN + SZ_WUQ), MP, 2048, 512, NPROJ}; pg8::StaticOrder S; S.init(MP, 2048, nvb, nvb - 1 - vb); pg8::EpiBf16Row E{B_(bf16, WS_KV), 2048, B_(float, WS_SSQ) + MP, 1.0f / 512.f, EPS};
                         pg8::gemm_phase<pg8::EpiBf16Row, pg8::StaticOrder, false, GEMM_ALIGN, GEMM_SP2>(lds, g, S, E, nullptr); }
                       for (int ci = vb; ci < (MP / 128) * 4; ci += nvb) {
                           gl::gla_prep_item(lds, 135168, B_(bf16, WS_PROJ), INF(13) + l * 16 * 512, INF(14) + l * 512, B_(bf16, WS_QE), B_(bf16, WS_KE), B_(bf16, WS_KL), B_(float, WS_DS), ci);
                           gl::gla_chunk_item(lds, B_(bf16, WS_PROJ), B_(bf16, WS_QE), B_(bf16, WS_KE), B_(bf16, WS_KL), B_(float, WS_OC), B_(float, WS_DL), ci); } } PH_END
            PH_BEGIN { constexpr int NA = NBP * 16;
                       if (nvb > 2 * NA) { if (vb < NA) gl::gla_stageA_item(B_(float, WS_DS), B_(float, WS_DL), B_(bf16, WS_XB), vb >> 4, (vb >> 2) & 3, vb & 3);
                                           else ph_kfin(B_(bf16, WS_KV), B_(bf16, WS_PROJ), B_(bf16, WS_K), INF(9) + l * 192, B_(float, WS_COS), B_(float, WS_SIN), row0, vb - NA, nvb - NA); }
                       else { for (int it = vb; it < NA; it += nvb) gl::gla_stageA_item(B_(float, WS_DS), B_(float, WS_DL), B_(bf16, WS_XB), it >> 4, (it >> 2) & 3, it & 3);
                              ph_kfin(B_(bf16, WS_KV), B_(bf16, WS_PROJ), B_(bf16, WS_K), INF(9) + l * 192, B_(float, WS_COS), B_(float, WS_SIN), row0, vb, nvb); } } PH_END
            PH_BEGIN ph_mixers(lds, ws, (unsigned*)(ws + WS_CTL) + CW_Q + (l * NPASS + p) * 8 * 64, INF(11) + (size_t)l * 8 * 128 * 128, INF(12) + l * 8 * 128, INF(10) + l * 1024, INF(15) + l * 256, INF(8) + l * 192, row0, vb); PH_END
            PH_BEGIN { pg8::Gemm g{B_(bf16, WS_YA), (const bf16*)(WLP + SZ_WIN + SZ_WUQ + SZ_WUKV), MP, 2048, 1024};
                       pg8::BranchOrder S; S.init(MP, 2048, nvb, vb); S.NB = 3; S.a_stride = (size_t)MP * 1024 * 2; S.b_stride = (size_t)2048 * 1024 * 2;
                       pg8::EpiMerge E{B_(bf16, WS_PROJ) + C_GATE, NPROJ, B_(bf16, WS_MG), 2048, 2048}; pg8::gemm_phase<pg8::EpiMerge, pg8::BranchOrder, false, GEMM_ALIGN, GEMM_SP2>(lds, g, S, E, nullptr); } PH_END
            PH_BEGIN { pg8::Gemm g{B_(bf16, WS_MG), (const bf16*)(WLP + SZ_WIN + SZ_WUQ + SZ_WUKV + SZ_WB), MP, 2048, 2048}; pg8::StaticOrder S; S.init(MP, 2048, nvb, vb); pg8::EpiRes E{XIN, ap->out + (size_t)row0 * DM, 2048};
                       pg8::gemm_phase<pg8::EpiRes, pg8::StaticOrder, false, GEMM_ALIGN, GEMM_SP2>(lds, g, S, E, nullptr); } PH_END
        }
    }
#undef PH_BEGIN
#undef PH_END
}

#ifndef ONE_LAUNCH
#define ONE_LAUNCH 1
#endif
extern "C" void kernel_launch(void* const* d_in, const int* in_sizes, int n_in, void* d_out, int out_size, void* d_ws, size_t ws_size, hipStream_t stream) {
    static int grid = 0;
    if (grid == 0) {
        if (n_in != 18 || out_size != MTOK * DM || ws_size < WS_END) { fprintf(stderr, "kernel_launch: unexpected shapes (n_in %d out %d ws %zu need %zu)\n", n_in, out_size, ws_size, (size_t)WS_END); grid = -1; return; }
        int dev = 0, cus = 0, per_cu = 0;
        if (hipGetDevice(&dev) != hipSuccess || hipDeviceGetAttribute(&cus, hipDeviceAttributeMultiprocessorCount, dev) != hipSuccess) { grid = -1; return; }
        if (hipFuncSetAttribute((const void*)fwd, hipFuncAttributeMaxDynamicSharedMemorySize, LDS_BYTES) != hipSuccess) { fprintf(stderr, "kernel_launch: hipFuncSetAttribute failed\n"); grid = -1; return; }
        if (hipOccupancyMaxActiveBlocksPerMultiprocessor(&per_cu, (const void*)fwd, 512, LDS_BYTES) != hipSuccess || per_cu < 1) { fprintf(stderr, "kernel_launch: occupancy query says %d\n", per_cu); }
        (void)hipGetLastError();
        grid = cus;
    }
    if (grid < 0) return;
    (void)hipMemsetAsync((char*)d_ws + WS_CTL, 0, CTL_BYTES, stream);
    Args a{};
    for (int i = 0; i < 18; ++i) a.in[i] = d_in[i];
    a.out = (float*)d_out; a.ws = (unsigned char*)d_ws; a.pad0 = 0; a.pad1 = 0;
#if ONE_LAUNCH
    a.lo = 0; a.hi = NSTEPS;
    hipLaunchKernelGGL(fwd, dim3(grid), dim3(512), LDS_BYTES, stream, a);
#else
    for (int s = 0; s < NSTEPS; ++s) { a.lo = s; a.hi = s + 1; hipLaunchKernelGGL(fwd, dim3(grid), dim3(512), LDS_BYTES, stream, a); }
#endif
}
```

```cpp
#include <hip/hip_runtime.h>
#include <cstdio>
#include <cstdint>
__device__ __forceinline__ int otid() { int t = threadIdx.x; asm volatile("" : "+v"(t)); return t; }
__device__ __forceinline__ int obid() { int t = blockIdx.x; asm volatile("" : "+s"(t)); return t; }
namespace pg8 {
#define PG8_LAS __attribute__((address_space(3)))
typedef unsigned short bf16_t;
typedef short bf16x8 __attribute__((ext_vector_type(8)));
typedef float f32x4 __attribute__((ext_vector_type(4)));
typedef unsigned u32x4 __attribute__((ext_vector_type(4)));
constexpr int BM = 256, BK = 64, HALF = 128, HTB = HALF * BK * 2  , STAGE_BYTES = 8 * HTB, NXCD = 8, WGM = 4;

__host__ __device__ __forceinline__ int lds_byte(int r, int c) { const int st = (r >> 4) * 2 + (c >> 5), rr = r & 15, cc = c & 31, ob = rr * 64 + cc * 2; return st * 1024 + (ob ^ (((ob >> 9) & 1) << 5)); }
__host__ __device__ __forceinline__ void stage_rc(int b, int& R, int& C) { const int st = b / 1024, sb = b % 1024, swz = sb ^ (((sb >> 9) & 1) << 5); R = (st >> 1) * 16 + swz / 64; C = (st & 1) * 32 + (swz % 64) / 2; }
__host__ __device__ __forceinline__ int perm32(int rho) { const int n = rho >> 4, i = rho & 15; return 8 * (i >> 2) + 4 * n + (i & 3); }

struct Unit { int pm, pn, pb; };
struct Gemm { const bf16_t* A; const bf16_t* Bt; int M, N, K; int lda; int f8sw, f8sx; };

struct StaticOrder {
    int nM, nN, nwg, G, c, full = 1 << 30, skip = 0;
    __host__ __device__ void init(int M, int N, int G_, int c_) { nM = M / BM; nN = N / BM; nwg = nM * nN; G = G_; c = c_; }
    __host__ __device__ bool next(int i, Unit& u) const {
        long L; if (i < full) L = (long)i * G + c; else { if (c < skip) return false; L = (long)full * G + (long)(i - full) * (G - skip) + (c - skip); }
        if (L >= nwg) return false;
        int wgid = (int)L; { const int q = nwg / NXCD, r = nwg % NXCD, xcd = wgid % NXCD, off = wgid / NXCD; wgid = (xcd < r ? xcd * (q + 1) : r * (q + 1) + (xcd - r) * q) + off; }
        const int nig = WGM * nN, gid = wgid / nig, fm = gid * WGM, gsz = (nM - fm) < WGM ? (nM - fm) : WGM;
        u.pm = fm + ((wgid % nig) % gsz); u.pn = (wgid % nig) / gsz; u.pb = 0; return true;
    }
    __device__ __forceinline__ size_t a_off(const Unit&) const { return 0; }
    __device__ __forceinline__ size_t b_off(const Unit&) const { return 0; }
    __device__ __forceinline__ void a_ready(const Unit&) const {}
    __device__ __forceinline__ void done(const Unit&) const {}
};

struct BranchOrder : StaticOrder {
    int NB; size_t a_stride, b_stride;
    __device__ bool next(int i, Unit& u) const { const int ti = i / NB; if (!StaticOrder::next(ti, u)) return false; u.pb = i - ti * NB; return true; }
    __device__ __forceinline__ size_t a_off(const Unit& u) const { return (size_t)u.pb * a_stride; }
    __device__ __forceinline__ size_t b_off(const Unit& u) const { return (size_t)u.pb * b_stride; }
};

__device__ __forceinline__ unsigned cvt_pk_bf16(float lo, float hi) { unsigned r; asm("v_cvt_pk_bf16_f32 %0, %1, %2" : "=v"(r) : "v"(lo), "v"(hi)); return r; }
__device__ __forceinline__ float gelu_tanh_f(float x) { const float u2 = 1.5957691216057308f * (x + 0.044715f * x * x * x); return x * __builtin_amdgcn_rcpf(1.f + __expf(-u2)); }
struct EpiProj {
    static constexpr bool PERM = true, AFTER_DRAIN = false;
    bf16_t* O; int ldc; float* SSQ; int mrows; int pn0;
    __device__ __forceinline__ void operator()(const f32x4 (&acc)[2][2][4][2], const Unit& u, int wr, int wc, int fr, int fq) const {
        const int row0 = u.pm * BM + wr * 64 + fr, col0 = u.pn * BM + wc * 32 + 8 * fq;
        const int apn = u.pn + pn0;
        const int seg = !SSQ ? -1 : ((apn == 25 || apn == 26) ? 0 : ((apn == 27 || apn == 28) ? 1 : ((apn >= 4 && apn < 8) ? 2 : -1)));
#pragma unroll
        for (int ai = 0; ai < 2; ++ai)
#pragma unroll
            for (int m = 0; m < 4; ++m) { const int row = row0 + ai * HALF + m * 16; bf16_t* rowp = O + (size_t)row * ldc + col0;
                float ss = 0.f;
#pragma unroll
                for (int bj = 0; bj < 2; ++bj) { const f32x4 v0 = acc[ai][bj][m][0], v1 = acc[ai][bj][m][1];
                    u32x4 w; w.x = cvt_pk_bf16(v0[0], v0[1]); w.y = cvt_pk_bf16(v0[2], v0[3]); w.z = cvt_pk_bf16(v1[0], v1[1]); w.w = cvt_pk_bf16(v1[2], v1[3]);
                    *(u32x4*)(rowp + bj * HALF) = w;
                    if (seg >= 0) {
#pragma unroll
                        for (int j = 0; j < 4; ++j) { float a = v0[j], b = v1[j]; if (seg == 2) { a = gelu_tanh_f(a); b = gelu_tanh_f(b); } ss += a * a + b * b; } } }
                if (seg >= 0) {
                    ss += __uint_as_float((unsigned)__builtin_amdgcn_ds_swizzle((int)__float_as_uint(ss), (16 << 10) | 0x1f));
                    auto rr = __builtin_amdgcn_permlane32_swap(__float_as_uint(ss), __float_as_uint(ss), false, false);
                    ss = __uint_as_float(rr[0]) + __uint_as_float(rr[1]);
                    if (fq == 0) atomicAdd(SSQ + (size_t)seg * mrows + row, ss); } }
    }
};
struct EpiBf16Row {
    static constexpr bool PERM = true, AFTER_DRAIN = false;
    bf16_t* O; int ldc; const float* SSQ; float inv_n, eps;
    __device__ __forceinline__ void operator()(const f32x4 (&acc)[2][2][4][2], const Unit& u, int wr, int wc, int fr, int fq) const {
        const int row0 = u.pm * BM + wr * 64 + fr, col0 = u.pn * BM + wc * 32 + 8 * fq;
        float sq[2][4];
#pragma unroll
        for (int ai = 0; ai < 2; ++ai)
#pragma unroll
            for (int m = 0; m < 4; ++m) sq[ai][m] = SSQ[row0 + ai * HALF + m * 16];
#pragma unroll
        for (int ai = 0; ai < 2; ++ai)
#pragma unroll
            for (int m = 0; m < 4; ++m) { const int row = row0 + ai * HALF + m * 16; bf16_t* rowp = O + (size_t)row * ldc + col0;
                const float rn = 1.0f / sqrtf(sq[ai][m] * inv_n + eps);
#pragma unroll
                for (int bj = 0; bj < 2; ++bj) { const f32x4 v0 = acc[ai][bj][m][0] * rn, v1 = acc[ai][bj][m][1] * rn;
                    u32x4 w; w.x = cvt_pk_bf16(v0[0], v0[1]); w.y = cvt_pk_bf16(v0[2], v0[3]); w.z = cvt_pk_bf16(v1[0], v1[1]); w.w = cvt_pk_bf16(v1[2], v1[3]);
                    *(u32x4*)(rowp + bj * HALF) = w; } }
    }
};
struct EpiRes {
    static constexpr bool PERM = false, AFTER_DRAIN = false;
    const float* base; float* C; int ldc;
    __device__ __forceinline__ void operator()(const f32x4 (&acc)[2][2][4][2], const Unit& u, int wr, int wc, int fr, int fq) const {
        const int row0 = u.pm * BM + wr * 64 + fr, col0 = u.pn * BM + wc * 32 + 4 * fq;
#pragma unroll
        for (int ai = 0; ai < 2; ++ai) {
            f32x4 bs[4][2][2];
#pragma unroll
            for (int m = 0; m < 4; ++m) { const size_t off = (size_t)(row0 + ai * HALF + m * 16) * ldc + col0;
#pragma unroll
                for (int bj = 0; bj < 2; ++bj)
#pragma unroll
                    for (int n = 0; n < 2; ++n) bs[m][bj][n] = *(const f32x4*)(base + off + bj * HALF + n * 16); }
#pragma unroll
            for (int m = 0; m < 4; ++m) { const size_t off = (size_t)(row0 + ai * HALF + m * 16) * ldc + col0;
#pragma unroll
                for (int bj = 0; bj < 2; ++bj)
#pragma unroll
                    for (int n = 0; n < 2; ++n) *(f32x4*)(C + off + bj * HALF + n * 16) = acc[ai][bj][m][n] + bs[m][bj][n]; }
            asm volatile("" ::: "memory");
        }
    }
};
struct EpiMerge {
    static constexpr bool PERM = true, AFTER_DRAIN = false;
    const bf16_t* G0; int ldg; bf16_t* MG; int ldc; int gstride; int pb0;
    __device__ __forceinline__ void operator()(const f32x4 (&acc)[2][2][4][2], const Unit& u, int wr, int wc, int fr, int fq) const {
        const int row0 = u.pm * BM + wr * 64 + fr, col0 = u.pn * BM + wc * 32 + 8 * fq; const int branch = u.pb + pb0; const bf16_t* G = G0 + (size_t)branch * gstride; const bool first = branch == 0;
#pragma unroll
        for (int ai = 0; ai < 2; ++ai) {
            u32x4 gw[4][2], ow[4][2];
#pragma unroll
            for (int m = 0; m < 4; ++m) { const size_t row = (size_t)(row0 + ai * HALF + m * 16);
#pragma unroll
                for (int bj = 0; bj < 2; ++bj) { gw[m][bj] = *(const u32x4*)(G + row * ldg + col0 + bj * HALF); ow[m][bj] = first ? (u32x4){0u, 0u, 0u, 0u} : *(const u32x4*)(MG + row * ldc + col0 + bj * HALF); } }
#pragma unroll
            for (int m = 0; m < 4; ++m) { const size_t row = (size_t)(row0 + ai * HALF + m * 16);
#pragma unroll
                for (int bj = 0; bj < 2; ++bj) { const f32x4 v0 = acc[ai][bj][m][0], v1 = acc[ai][bj][m][1];
                    const unsigned g4[4] = {gw[m][bj].x, gw[m][bj].y, gw[m][bj].z, gw[m][bj].w}, o4[4] = {ow[m][bj].x, ow[m][bj].y, ow[m][bj].z, ow[m][bj].w};
                    const float a8[8] = {v0[0], v0[1], v0[2], v0[3], v1[0], v1[1], v1[2], v1[3]};
                    unsigned w4[4];
#pragma unroll
                    for (int q = 0; q < 4; ++q) {
                        const float g0 = __uint_as_float(g4[q] << 16), g1 = __uint_as_float(g4[q] & 0xffff0000u);
                        const float r0 = __uint_as_float(o4[q] << 16) + a8[2 * q] * __builtin_amdgcn_rcpf(1.0f + __expf(-g0));
                        const float r1 = __uint_as_float(o4[q] & 0xffff0000u) + a8[2 * q + 1] * __builtin_amdgcn_rcpf(1.0f + __expf(-g1));
                        unsigned pk; asm("v_cvt_pk_bf16_f32 %0, %1, %2" : "=v"(pk) : "v"(r0), "v"(r1)); w4[q] = pk; }
                    *(u32x4*)(MG + row * ldc + col0 + bj * HALF) = (u32x4){w4[0], w4[1], w4[2], w4[3]}; } }
            asm volatile("" ::: "memory");
        }
    }
};

typedef int pg8_v8i __attribute__((ext_vector_type(8)));
typedef int pg8_v4i __attribute__((ext_vector_type(4)));
template <class Epi, class Sched, bool STAMP = false, bool ALIGN_EPI = false, bool SP2 = false, bool FP8 = false>
__device__ __forceinline__ void gemm_phase(PG8_LAS unsigned char* lds, const Gemm g, const Sched& S, const Epi& E, unsigned long long* stamps) {
    const int tid = otid(), wid = __builtin_amdgcn_readfirstlane(tid >> 6), lane = tid & 63, wr = wid >> 2, wc = wid & 3, fr = lane & 15, fq = lane >> 4;
    const int K = g.K, nt = K / BK, LDA = g.lda ? g.lda : g.K;
    int ts_lo = 0, ts_hi = 0, nts = 0; const unsigned long long rt_entry = STAMP ? (unsigned long long)wall_clock64() : 0ull;
#define PG8_STAMP() do { if (STAMP && wid == 0 && nts < 64) { const unsigned long long _c = (unsigned long long)clock64(); \
        ts_lo = (lane == nts) ? (int)(unsigned)_c : ts_lo; ts_hi = (lane == nts) ? (int)(unsigned)(_c >> 32) : ts_hi; ++nts; } } while (0)
    PG8_STAMP();
    unsigned voffA[2], voffB[2];
#pragma unroll
    for (int i = 0; i < 2; ++i) { int R, C; stage_rc(tid * 16 + i * 8192, R, C); const int Rb = Epi::PERM ? ((R & ~31) + perm32(R & 31)) : R;
        voffA[i] = (unsigned)(R * LDA + C) * 2u; voffB[i] = (unsigned)(Rb * K + C) * 2u; }
    const size_t kstep = (size_t)(BK * 2);
    const size_t hstepB = (size_t)HALF * K * 2, hstepA = (size_t)HALF * LDA * 2;
    const size_t tstepB = 2 * hstepB, tstepA = 2 * hstepA;
    const unsigned ldsw = (unsigned)wid * 1024u;
    const int aoff = lds_byte(wr * 64 + fr, fq * 8), boff = lds_byte(wc * 32 + fr, fq * 8);
#define PG8_SA(b, h) (((b) * 2 + (h)) * HTB)
#define PG8_SB(b, h) ((4 + (b) * 2 + (h)) * HTB)
#define PG8_STAGE(bufoff, gbase, voff) do { _Pragma("unroll") for (int _i = 0; _i < 2; ++_i) \
        __builtin_amdgcn_global_load_lds((const unsigned*)((const char*)(gbase) + (voff)[_i]), (PG8_LAS unsigned*)(lds + (bufoff) + ldsw + _i * 8192), 16, 0, 0); } while (0)
#define PG8_I4(p) (*(const PG8_LAS pg8_v4i*)(p))
#define PG8_LDA(dst, b, h) do { if constexpr (FP8) { _Pragma("unroll") for (int m = 0; m < 4; ++m) dst##8[m] = __builtin_shufflevector(PG8_I4(lds + PG8_SA(b, h) + aoff + m * 2048), PG8_I4(lds + PG8_SA(b, h) + aoff + m * 2048 + 1024), 0, 1, 2, 3, 4, 5, 6, 7); } \
        else { _Pragma("unroll") for (int m = 0; m < 4; ++m) _Pragma("unroll") for (int k = 0; k < 2; ++k) dst[m][k] = *(const PG8_LAS bf16x8*)(lds + PG8_SA(b, h) + aoff + m * 2048 + k * 1024); } } while (0)
#define PG8_LDB(dst, b, h) do { if constexpr (FP8) { _Pragma("unroll") for (int n = 0; n < 2; ++n) dst##8[n] = __builtin_shufflevector(PG8_I4(lds + PG8_SB(b, h) + boff + n * 2048), PG8_I4(lds + PG8_SB(b, h) + boff + n * 2048 + 1024), 0, 1, 2, 3, 4, 5, 6, 7); } \
        else { _Pragma("unroll") for (int n = 0; n < 2; ++n) _Pragma("unroll") for (int k = 0; k < 2; ++k) dst[n][k] = *(const PG8_LAS bf16x8*)(lds + PG8_SB(b, h) + boff + n * 2048 + k * 1024); } } while (0)
#define PG8_MMA_BF(ai, bj, At, Bt) do { __builtin_amdgcn_s_setprio(1); _Pragma("unroll") for (int m = 0; m < 4; ++m) _Pragma("unroll") for (int n = 0; n < 2; ++n) _Pragma("unroll") for (int k = 0; k < 2; ++k) \
        acc[ai][bj][m][n] = __builtin_amdgcn_mfma_f32_16x16x32_bf16(Bt[n][k], At[m][k], acc[ai][bj][m][n], 0, 0, 0); __builtin_amdgcn_s_setprio(0); } while (0)
#define PG8_MMA_F8(ai, bj, At, Bt) do { __builtin_amdgcn_s_setprio(1); _Pragma("unroll") for (int m = 0; m < 4; ++m) _Pragma("unroll") for (int n = 0; n < 2; ++n) \
        asm volatile("v_mfma_scale_f32_16x16x128_f8f6f4 %0, %1, %2, %0, %3, %4 op_sel_hi:[0,0,0]" : "+v"(acc[ai][bj][m][n]) : "v"(Bt##8[n]), "v"(At##8[m]), "v"(f8_scale_w), "v"(f8_scale_x)); \
        __builtin_amdgcn_s_setprio(0); } while (0)
#define PG8_F8_DRAIN() do { if constexpr (FP8) asm volatile("s_nop 15\n\ts_nop 15" ::: "memory"); } while (0)
#define PG8_MMA(ai, bj, At, Bt) do { if constexpr (FP8) PG8_MMA_F8(ai, bj, At, Bt); else PG8_MMA_BF(ai, bj, At, Bt); } while (0)
#define PG8_WAIT_V(n) asm volatile("s_waitcnt vmcnt(" #n ")" ::: "memory")
#define PG8_WAIT_L(n) asm volatile("s_waitcnt lgkmcnt(" #n ")" ::: "memory")
#define PG8_BAR __builtin_amdgcn_s_barrier()
#define PG8_SCHED __builtin_amdgcn_sched_barrier(0)
    Unit cur, nxt; int ui = 0;
    if (!S.next(0, cur)) return;
    f32x4 acc[2][2][4][2];
#pragma unroll
    for (int a = 0; a < 2; ++a)
#pragma unroll
        for (int b = 0; b < 2; ++b)
#pragma unroll
            for (int m = 0; m < 4; ++m)
#pragma unroll
                for (int n = 0; n < 2; ++n) acc[a][b][m][n] = (f32x4){0.f, 0.f, 0.f, 0.f};
    int f8_scale_w = g.f8sw ? g.f8sw : 0x79797979, f8_scale_x = g.f8sx ? g.f8sx : 0x7f7f7f7f; (void)f8_scale_w; (void)f8_scale_x;
    bf16x8 At[4][2], B0[2][2], B1[2][2]; pg8_v8i At8[4], B08[2], B18[2];
    (void)At; (void)B0; (void)B1; (void)At8; (void)B08; (void)B18;
    const char* cA = (const char*)g.A + (size_t)cur.pm * tstepA + S.a_off(cur); const char* cB = (const char*)g.Bt + (size_t)cur.pn * tstepB + S.b_off(cur);
    S.a_ready(cur);
    if constexpr (SP2) {
        PG8_STAGE(PG8_SB(0, 0), cB, voffB); PG8_STAGE(PG8_SB(0, 1), cB + hstepB, voffB); PG8_STAGE(PG8_SA(0, 0), cA, voffA); PG8_STAGE(PG8_SA(0, 1), cA + hstepA, voffA);
        if (wr == 1) PG8_BAR;
        PG8_WAIT_V(2); PG8_BAR;
        PG8_STAGE(PG8_SB(1, 0), cB + kstep, voffB); PG8_STAGE(PG8_SA(1, 0), cA + kstep, voffA); PG8_STAGE(PG8_SB(1, 1), cB + hstepB + kstep, voffB);
        PG8_WAIT_V(6); PG8_BAR;
    } else {
    PG8_STAGE(PG8_SB(0, 0), cB, voffB); PG8_STAGE(PG8_SA(0, 0), cA, voffA); PG8_STAGE(PG8_SB(0, 1), cB + hstepB, voffB); PG8_STAGE(PG8_SA(0, 1), cA + hstepA, voffA);
    if (wr == 1) PG8_BAR;
    PG8_WAIT_V(4); PG8_BAR;
    PG8_STAGE(PG8_SB(1, 0), cB + kstep, voffB); PG8_STAGE(PG8_SA(1, 0), cA + kstep, voffA); PG8_STAGE(PG8_SB(1, 1), cB + hstepB + kstep, voffB);
    PG8_WAIT_V(6); PG8_BAR;
    }
    PG8_STAMP();
    for (;;) {
        const bool has_next = S.next(ui + 1, nxt);
        const char* nA = has_next ? (const char*)g.A + (size_t)nxt.pm * tstepA + S.a_off(nxt) : cA; const char* nB = has_next ? (const char*)g.Bt + (size_t)nxt.pn * tstepB + S.b_off(nxt) : cB;
        for (int t = 0; t < nt; t += 2) {
            const bool last = (t == nt - 2);
            const char* a1 = cA + (size_t)(t + 1) * kstep;
            const char* a2 = last ? nA : cA + (size_t)(t + 2) * kstep; const char* b2 = last ? nB : cB + (size_t)(t + 2) * kstep;
            const char* a3 = a2 + kstep; const char* b3 = b2 + kstep;
            if (last && has_next) S.a_ready(nxt);
            if constexpr (SP2) {
            PG8_LDB(B0, 0, 0); PG8_LDB(B1, 0, 1); PG8_SCHED; PG8_LDA(At, 0, 0); PG8_STAGE(PG8_SA(1, 1), a1 + hstepA, voffA);
            PG8_WAIT_V(8); PG8_WAIT_L(0); PG8_BAR; PG8_MMA(0, 0, At, B0); PG8_MMA(0, 1, At, B1); PG8_BAR; PG8_SCHED;
            PG8_LDA(At, 0, 1); PG8_STAGE(PG8_SB(0, 0), b2, voffB); PG8_STAGE(PG8_SB(0, 1), b2 + hstepB, voffB); PG8_STAGE(PG8_SA(0, 0), a2, voffA);
            PG8_WAIT_V(8); PG8_WAIT_L(0); PG8_BAR; PG8_MMA(1, 0, At, B0); PG8_MMA(1, 1, At, B1); PG8_BAR; PG8_SCHED;
            PG8_LDB(B0, 1, 0); PG8_LDB(B1, 1, 1); PG8_SCHED; PG8_LDA(At, 1, 0); PG8_STAGE(PG8_SA(0, 1), a2 + hstepA, voffA);
            PG8_WAIT_V(8); PG8_WAIT_L(0); PG8_BAR; PG8_MMA(0, 0, At, B0); PG8_MMA(0, 1, At, B1); PG8_BAR; PG8_SCHED;
            PG8_LDA(At, 1, 1); PG8_STAGE(PG8_SB(1, 0), b3, voffB); PG8_STAGE(PG8_SB(1, 1), b3 + hstepB, voffB); PG8_STAGE(PG8_SA(1, 0), a3, voffA);
            PG8_WAIT_V(8); PG8_WAIT_L(0); PG8_BAR; PG8_MMA(1, 0, At, B0); PG8_MMA(1, 1, At, B1); PG8_BAR; PG8_SCHED;
            } else {
            PG8_LDB(B0, 0, 0); PG8_SCHED; PG8_LDA(At, 0, 0); PG8_STAGE(PG8_SA(1, 1), a1 + hstepA, voffA);
            PG8_WAIT_L(8); PG8_BAR; PG8_WAIT_L(0); PG8_MMA(0, 0, At, B0); PG8_BAR; PG8_SCHED;
            PG8_LDB(B1, 0, 1); PG8_STAGE(PG8_SB(0, 0), b2, voffB);
            PG8_BAR; PG8_WAIT_L(0); PG8_MMA(0, 1, At, B1); PG8_BAR;
            PG8_LDA(At, 0, 1); PG8_STAGE(PG8_SA(0, 0), a2, voffA);
            PG8_BAR; PG8_WAIT_L(0); PG8_MMA(1, 0, At, B0); PG8_BAR; PG8_SCHED;
            PG8_STAGE(PG8_SB(0, 1), b2 + hstepB, voffB);
            PG8_WAIT_V(6); PG8_BAR; PG8_MMA(1, 1, At, B1); PG8_BAR;
            PG8_LDB(B0, 1, 0); PG8_SCHED; PG8_LDA(At, 1, 0); PG8_STAGE(PG8_SA(0, 1), a2 + hstepA, voffA);
            PG8_WAIT_L(8); PG8_BAR; PG8_WAIT_L(0); PG8_MMA(0, 0, At, B0); PG8_BAR; PG8_SCHED;
            PG8_LDB(B1, 1, 1); PG8_STAGE(PG8_SB(1, 0), b3, voffB);
            PG8_BAR; PG8_WAIT_L(0); PG8_MMA(0, 1, At, B1); PG8_BAR;
            PG8_LDA(At, 1, 1); PG8_STAGE(PG8_SA(1, 0), a3, voffA);
            PG8_BAR; PG8_WAIT_L(0); PG8_MMA(1, 0, At, B0); PG8_BAR; PG8_SCHED;
            PG8_STAGE(PG8_SB(1, 1), b3 + hstepB, voffB);
            PG8_WAIT_V(6); PG8_BAR; PG8_MMA(1, 1, At, B1); PG8_BAR;
            }
        }
        if constexpr (ALIGN_EPI) { if (wr == 0) PG8_BAR; }
        PG8_STAMP();
        PG8_F8_DRAIN();
        if constexpr (!Epi::AFTER_DRAIN) { E(acc, cur, wr, wc, fr, fq); S.done(cur); }
        PG8_STAMP();
        if (!has_next) break;
#pragma unroll
        for (int a = 0; a < 2; ++a)
#pragma unroll
            for (int b = 0; b < 2; ++b)
#pragma unroll
                for (int m = 0; m < 4; ++m)
#pragma unroll
                    for (int n = 0; n < 2; ++n) acc[a][b][m][n] = (f32x4){0.f, 0.f, 0.f, 0.f};
        cur = nxt; cA = nA; cB = nB; ++ui;
        if constexpr (ALIGN_EPI) { if (wr == 1) PG8_BAR; }
    }
    PG8_WAIT_V(0);
    if constexpr (!ALIGN_EPI) { if (wr == 0) PG8_BAR; }
    PG8_BAR;
    if constexpr (Epi::AFTER_DRAIN) { E.fused(acc, cur, wr, wc, fr, fq, lds, wid, lane); S.done(cur); }
    PG8_STAMP();
    if (STAMP && wid == 0) { stamps[lane] = lane < nts ? (((unsigned long long)(unsigned)ts_hi << 32) | (unsigned)ts_lo) : 0ull;
        if (lane == 62) stamps[62] = rt_entry; if (lane == 63) stamps[63] = (unsigned long long)wall_clock64(); }
#undef PG8_STAMP
#undef PG8_SA
#undef PG8_SB
#undef PG8_STAGE
#undef PG8_LDA
#undef PG8_LDB
#undef PG8_MMA
#undef PG8_MMA_BF
#undef PG8_MMA_F8
#undef PG8_I4
#undef PG8_F8_DRAIN
#undef PG8_WAIT_V
#undef PG8_WAIT_L
#undef PG8_BAR
#undef PG8_SCHED
}
}
#define XB_TMO      128
#define XB_XCNT(j)  (256  + 64 * (j))
#define XB_XSUB(j)  (1280 + 64 * (j))
#define XB_XGEN(j)  (2304 + 64 * (j))
#define XB_TOP      3328
#define XB_TOPGEN   3392
#define XCD_BAR_WORDS 3456
#define XB_SPIN_CAP (1u << 18)
#define LAS __attribute__((address_space(3)))

__device__ __forceinline__ unsigned xb_ld(unsigned* p)              { return __hip_atomic_load(p, __ATOMIC_RELAXED, __HIP_MEMORY_SCOPE_AGENT); }
__device__ __forceinline__ unsigned xb_add(unsigned* p, unsigned v) { return __hip_atomic_fetch_add(p, v, __ATOMIC_RELAXED, __HIP_MEMORY_SCOPE_AGENT); }
__device__ __forceinline__ unsigned xb_xcc_id() { return (unsigned)__builtin_amdgcn_s_getreg((3 << 11) | 20) & 0xFu; }
#define XB_SPIN(cond, bar) do { unsigned _sp = 0; while (cond) { __builtin_amdgcn_s_sleep(1); \
    if ((++_sp & 255u) == 0u) { if (xb_ld(&(bar)[XB_TMO])) break; if (_sp > XB_SPIN_CAP) { atomicAdd(&(bar)[XB_TMO], 1u); break; } } } } while (0)

struct XcdBarrier {
    unsigned* bar; unsigned x;
    volatile LAS unsigned* st;
};

__device__ __forceinline__ XcdBarrier xcd_barrier_post(unsigned* bar, volatile LAS unsigned* st) {
    XcdBarrier b; b.bar = bar; b.x = xb_xcc_id(); b.st = st;
    if (threadIdx.x == 0) (void)xb_add(&bar[XB_XCNT(b.x)], 1u);
    return b;
}
__device__ __forceinline__ void xcd_barrier_complete(unsigned* bar, unsigned x, unsigned& nloc, unsigned& nx) {
    const unsigned G = gridDim.x * gridDim.y * gridDim.z;
    unsigned sum, cnt, mine, sp = 0u;
    for (;;) {
        sum = 0u; cnt = 0u; mine = 0u;
#pragma unroll
        for (unsigned j = 0; j < 16; ++j) { const unsigned c = xb_ld(&bar[XB_XCNT(j)]); sum += c; cnt += (c > 0u) ? 1u : 0u; mine = (j == x) ? c : mine; }
        if (sum == G) break;
        __builtin_amdgcn_s_sleep(1);
        if ((++sp & 255u) == 0u) { if (xb_ld(&bar[XB_TMO])) break; if (sp > XB_SPIN_CAP) { atomicAdd(&bar[XB_TMO], 1u); break; } }
    }
    nloc = mine > 0u ? mine : 1u; nx = cnt > 0u ? cnt : 1u;
}

__device__ __forceinline__ void xcd_barrier(const XcdBarrier& b) {
    asm volatile("s_waitcnt vmcnt(0)" ::: "memory");
    __syncthreads();
    if (threadIdx.x == 0) {
        unsigned* bar = b.bar;
        __builtin_amdgcn_s_waitcnt(0);
        unsigned nloc = b.st[0], nx = b.st[1];
        if (nloc == 0u) { xcd_barrier_complete(bar, b.x, nloc, nx); b.st[0] = nloc; b.st[1] = nx; }
        const unsigned old = xb_add(&bar[XB_XSUB(b.x)], 1u);
        const unsigned gen = old / nloc;
        if (old + 1u == (gen + 1u) * nloc) {
            __builtin_amdgcn_fence(__ATOMIC_RELEASE, "agent");
            asm volatile("s_waitcnt vmcnt(0)" ::: "memory");
            const unsigned og = xb_add(&bar[XB_TOP], 1u);
            const unsigned tg = og / nx;
            if (og + 1u == (tg + 1u) * nx) xb_add(&bar[XB_TOPGEN], 1u);
            else XB_SPIN(xb_ld(&bar[XB_TOPGEN]) == tg, bar);
            __builtin_amdgcn_fence(__ATOMIC_ACQUIRE, "agent");
            xb_add(&bar[XB_XGEN(b.x)], 1u);
            asm volatile("s_waitcnt vmcnt(0)" ::: "memory");
        } else {
            XB_SPIN(xb_ld(&bar[XB_XGEN(b.x)]) == gen, bar);
            __builtin_amdgcn_fence(__ATOMIC_ACQUIRE, "agent");
            asm volatile("s_waitcnt vmcnt(0)" ::: "memory");
        }
    }
    __syncthreads();
}


typedef unsigned short bf16;
typedef unsigned v4u __attribute__((ext_vector_type(4)));
typedef unsigned v2u __attribute__((ext_vector_type(2)));
typedef float v4f __attribute__((ext_vector_type(4)));
typedef float v2f __attribute__((ext_vector_type(2)));

constexpr int DM = 2048, NBATCH = 8, SEQ = 4096, DEPTH = 2, MTOK = NBATCH * SEQ;
constexpr int IN_COLS = 14416, NPROJ = 14592;
constexpr int C_UB = 0, C_VB = 1024, C_ZB = 2048, C_QC = 3072, C_KC = 3584, C_VC = 4096, C_ZC = 5120, C_KROPE = 6144, C_AR = 6208,
              C_CQ = 6400, C_CKV = 6912, C_ZA = 7424, C_GATE = 8448;
constexpr int NBF = C_CQ, NF8 = NPROJ - NBF;
constexpr float EPS = 1e-6f;
#ifndef NBP
#define NBP 4
#endif
constexpr int MP = NBP * SEQ, NPASS = NBATCH / NBP;
constexpr int STEPS_PER_PASS = 7;
constexpr int NSTEPS = DEPTH * (1 + NPASS * STEPS_PER_PASS);

constexpr size_t al256(size_t x) { return (x + 255) & ~(size_t)255; }
constexpr size_t WS_CTL = 0, CTL_BYTES = 1u << 20;
constexpr size_t SZ_WINB = (size_t)NBF * DM * 2  , SZ_WIN = SZ_WINB + (size_t)NF8 * DM  , SZ_WUQ = (size_t)1536 * 512 * 2, SZ_WUKV = (size_t)2048 * 512 * 2, SZ_WB = (size_t)3 * 2048 * 1024 * 2, SZ_WO = (size_t)2048 * 2048 * 2;
constexpr size_t SZ_WLAYER = SZ_WIN + SZ_WUQ + SZ_WUKV + SZ_WB + SZ_WO;
constexpr size_t WS_W = CTL_BYTES;
constexpr size_t WS_COS = WS_W + SZ_WLAYER, WS_SIN = WS_COS + (size_t)MTOK * 32 * 4;
constexpr size_t WS_H = WS_SIN + (size_t)MTOK * 32 * 4;
constexpr size_t WS_MG = WS_H;
constexpr size_t WS_PROJ = WS_H + (size_t)MP * DM * 2;
constexpr size_t WS_XB = WS_PROJ + (size_t)MP * NPROJ * 2;
constexpr size_t WS_SSQ = WS_XB + (size_t)MP * 2048;
constexpr size_t WS_Q = WS_SSQ + al256((size_t)3 * MP * 4);
constexpr size_t WS_KV = WS_Q + (size_t)MP * 1536 * 2;
constexpr size_t WS_K = WS_KV + (size_t)MP * 2048 * 2;
constexpr size_t WS_YA = WS_K + (size_t)MP * 1536 * 2;
constexpr size_t WS_YB = WS_YA + (size_t)MP * 1024 * 2;
constexpr size_t WS_DL = WS_YA;
constexpr size_t WS_YC = WS_YB + (size_t)MP * 1024 * 2;
constexpr size_t WS_OC = WS_YC + (size_t)MP * 1024 * 2;
constexpr size_t WS_QE = WS_OC + (size_t)MP * 1024 * 4;
constexpr size_t WS_KE = WS_QE + (size_t)MP * 512 * 2, WS_KL = WS_KE + (size_t)MP * 512 * 2;
constexpr size_t WS_H8 = WS_KE;
constexpr size_t WS_DS = WS_KL + (size_t)MP * 512 * 2;
constexpr size_t WS_END = WS_DS + (size_t)(MP / 128) * 512 * 4;
static_assert(WS_END <= ((size_t)1 << 30), "workspace map exceeds 1 GiB");

constexpr int LDS_BYTES = 147456;
constexpr int LDSCTL_OFF = LDS_BYTES - 256;
constexpr int CW_BAR = 4096;

__device__ __forceinline__ float bf2f(unsigned v) { return __uint_as_float(v << 16); }
__device__ __forceinline__ unsigned f2bf(float f) { unsigned u = __float_as_uint(f); return (u + 0x7fffu + ((u >> 16) & 1u)) >> 16; }
__device__ __forceinline__ unsigned pk2(float lo, float hi) { return f2bf(lo) | (f2bf(hi) << 16); }
__device__ __forceinline__ float lo16(unsigned w) { return __uint_as_float(w << 16); }
__device__ __forceinline__ float hi16(unsigned w) { return __uint_as_float(w & 0xffff0000u); }
__device__ __forceinline__ float sigmoid_f(float x) { return 1.f / (1.f + __expf(-x)); }
__device__ __forceinline__ float silu_f(float x) { return x / (1.f + __expf(-x)); }
__device__ __forceinline__ float gelu_f(float x) { const float u2 = 1.5957691216057308f * (x + 0.044715f * x * x * x); return x * __builtin_amdgcn_rcpf(1.f + __expf(-u2)); }
template <int O> __device__ __forceinline__ float lane_xor(float v) {
    if (O == 1) return __uint_as_float((unsigned)__builtin_amdgcn_mov_dpp((int)__float_as_uint(v), 0xB1, 0xf, 0xf, true));
    if (O == 2) return __uint_as_float((unsigned)__builtin_amdgcn_mov_dpp((int)__float_as_uint(v), 0x4E, 0xf, 0xf, true));
    return __uint_as_float((unsigned)__builtin_amdgcn_ds_swizzle((int)__float_as_uint(v), (O << 10) | 0x1f)); }
__device__ __forceinline__ float lane_xor32(float v, int lane) {
    auto rr = __builtin_amdgcn_permlane32_swap(__float_as_uint(v), __float_as_uint(v), false, false);
    return __uint_as_float(lane < 32 ? rr[1] : rr[0]); }
__device__ __forceinline__ float wave_sum(float v) {
    v += lane_xor<1>(v); v += lane_xor<2>(v); v += lane_xor<4>(v); v += lane_xor<8>(v); v += lane_xor<16>(v);
    auto rr = __builtin_amdgcn_permlane32_swap(__float_as_uint(v), __float_as_uint(v), false, false);
    return __uint_as_float(rr[0]) + __uint_as_float(rr[1]); }
__device__ __forceinline__ float wave_max(float v) {
    v = fmaxf(v, lane_xor<1>(v)); v = fmaxf(v, lane_xor<2>(v)); v = fmaxf(v, lane_xor<4>(v)); v = fmaxf(v, lane_xor<8>(v)); v = fmaxf(v, lane_xor<16>(v));
    auto rr = __builtin_amdgcn_permlane32_swap(__float_as_uint(v), __float_as_uint(v), false, false);
    return fmaxf(__uint_as_float(rr[0]), __uint_as_float(rr[1])); }
#define LDS_FENCE() asm volatile("s_waitcnt lgkmcnt(0)" ::: "memory")

struct Args { const void* in[18]; float* out; unsigned char* ws; int lo, hi, pad0, pad1; };

template <int MODE> __device__ __forceinline__ int src_col(int n) {
    if (MODE == 0) return n;
    if (MODE == 2) n += NBF;
    if (n < C_VB) return 2112 + n;
    if (n < C_ZB) return 3136 + (n - C_VB);
    if (n < C_QC) return 4160 + (n - C_ZB);
    if (n < C_KC) return 5184 + (n - C_QC);
    if (n < C_VC) return 5696 + (n - C_KC);
    if (n < C_ZC) return 6208 + (n - C_VC);
    if (n < C_KROPE) return 7248 + (n - C_ZC);
    if (n < C_AR) return 1024 + (n - C_KROPE);
    if (n < C_AR + 16) return 7232 + (n - C_AR);
    if (n < C_CQ) return -1;
    if (n < C_CKV) return n - C_CQ;
    if (n < C_ZA) return 512 + (n - C_CKV);
    if (n < C_GATE) return 1088 + (n - C_ZA);
    return 8272 + (n - C_GATE);
}
template <int MODE> __device__ __forceinline__ void convert_T(const float* W, int K, int Nsrc, bf16* WT, int Ndst, LAS float* tile, int vb, int nvb, const float* kscale = nullptr) {
    const int tid = otid(), ntk = K / 64, ntn = Ndst / 64, ntiles = ntk * ntn;
    for (int t = vb; t < ntiles; t += nvb) {
        const int k0 = (t % ntk) * 64, n0 = (t / ntk) * 64;
        { const int nn = tid & 63, sc = src_col<MODE>(n0 + nn), scc = sc >= 0 ? sc : 0; const float mul = sc >= 0 ? 1.f : 0.f;
          float v[8];
#pragma unroll
          for (int i = 0; i < 8; ++i) v[i] = W[(size_t)(k0 + (tid >> 6) + 8 * i) * Nsrc + scc];
          if (kscale) {
#pragma unroll
              for (int i = 0; i < 8; ++i) v[i] *= kscale[k0 + (tid >> 6) + 8 * i]; }
#pragma unroll
          for (int i = 0; i < 8; ++i) tile[((tid >> 6) + 8 * i) * 65 + nn] = v[i] * mul; }
        __syncthreads();
        { const int nn = tid & 63, kg = tid >> 6;
          const LAS float* tp = tile + (kg * 8) * 65 + nn;
          v4u o; o.x = pk2(tp[0], tp[65]); o.y = pk2(tp[2 * 65], tp[3 * 65]); o.z = pk2(tp[4 * 65], tp[5 * 65]); o.w = pk2(tp[6 * 65], tp[7 * 65]);
          *(v4u*)(WT + (size_t)(n0 + nn) * K + k0 + kg * 8) = o; }
        __syncthreads();
    }
}

template <int MODE> __device__ __forceinline__ void convert_T8(const float* W, int K, int Nsrc, unsigned char* WT, int Ndst, float wscale, LAS float* tile, int vb, int nvb) {
    const int tid = otid(), ntk = K / 64, ntn = Ndst / 64, ntiles = ntk * ntn;
    for (int t = vb; t < ntiles; t += nvb) {
        const int k0 = (t % ntk) * 64, n0 = (t / ntk) * 64;
        { const int nn = tid & 63;
          const int sc = src_col<MODE>(n0 + nn);
#pragma unroll
          for (int i = 0; i < 8; ++i) { const int kk = (tid >> 6) + 8 * i; tile[kk * 65 + nn] = W[(size_t)(k0 + kk) * Nsrc + sc] * wscale; } }
        __syncthreads();
        { const int nn = tid & 63, kg = tid >> 6;
          const LAS float* tp = tile + (kg * 8) * 65 + nn;
          unsigned w0 = 0u, w1 = 0u;
          w0 = __builtin_amdgcn_cvt_pk_fp8_f32(tp[0], tp[65], w0, false); w0 = __builtin_amdgcn_cvt_pk_fp8_f32(tp[2 * 65], tp[3 * 65], w0, true);
          w1 = __builtin_amdgcn_cvt_pk_fp8_f32(tp[4 * 65], tp[5 * 65], w1, false); w1 = __builtin_amdgcn_cvt_pk_fp8_f32(tp[6 * 65], tp[7 * 65], w1, true);
          *(v2u*)(WT + (size_t)(n0 + nn) * K + k0 + kg * 8) = (v2u){w0, w1}; }
        __syncthreads();
    }
}

__device__ __forceinline__ void ph_norm(const float* xin, const float* g, bf16* h, unsigned char* h8, int rows, int vb, int nvb) {
    const int tid_ = otid(); const int lane = tid_ & 63, wave = tid_ >> 6;
    for (int r = vb * 8 + wave; r < rows; r += nvb * 8) {
        const v4f* xr = (const v4f*)(xin + (size_t)r * DM);
        v4f v[8]; float ss = 0.f;
#pragma unroll
        for (int j = 0; j < 8; ++j) { v[j] = xr[lane + 64 * j]; ss += v[j].x * v[j].x + v[j].y * v[j].y + v[j].z * v[j].z + v[j].w * v[j].w; }
        ss = wave_sum(ss);
        const float rn = 1.0f / sqrtf(ss * (1.0f / DM) + EPS);
#pragma unroll
        for (int j = 0; j < 8; ++j) { const v4f gg = ((const v4f*)g)[lane + 64 * j];
            const float y0 = v[j].x * rn * gg.x, y1 = v[j].y * rn * gg.y, y2 = v[j].z * rn * gg.z, y3 = v[j].w * rn * gg.w;
            v2u o; o.x = pk2(y0, y1); o.y = pk2(y2, y3);
            *(v2u*)(h + (size_t)r * DM + (lane + 64 * j) * 4) = o;
            unsigned w8 = 0u; w8 = __builtin_amdgcn_cvt_pk_fp8_f32(y0, y1, w8, false); w8 = __builtin_amdgcn_cvt_pk_fp8_f32(y2, y3, w8, true);
            *(unsigned*)(h8 + (size_t)r * DM + (lane + 64 * j) * 4) = w8; }
    }
}
__device__ __forceinline__ float row16_sum(float v) {
    v += __uint_as_float((unsigned)__builtin_amdgcn_mov_dpp((int)__float_as_uint(v), 0xB1, 0xf, 0xf, true));
    v += __uint_as_float((unsigned)__builtin_amdgcn_mov_dpp((int)__float_as_uint(v), 0x4E, 0xf, 0xf, true));
    v += __uint_as_float((unsigned)__builtin_amdgcn_mov_dpp((int)__float_as_uint(v), 0x141, 0xf, 0xf, true));
    v += __uint_as_float((unsigned)__builtin_amdgcn_mov_dpp((int)__float_as_uint(v), 0x140, 0xf, 0xf, true));
    return v; }
__device__ __forceinline__ void ph_kfin(const bf16* kv, const bf16* proj, bf16* K, const float* kg, const float* cosT, const float* sinT, int row0, int vb, int nvb) {
    const int tid_ = otid(); const int lane = tid_ & 63, wave = tid_ >> 6, g16 = lane >> 4, c = lane & 15;
    float gn[8], gr[8];
#pragma unroll
    for (int j = 0; j < 8; ++j) { gn[j] = kg[c * 8 + j]; gr[j] = kg[128 + (c & 7) * 8 + j]; }
    for (int r = vb * 8 + wave; r < MP; r += nvb * 8) {
        const v4u n0 = *(const v4u*)(kv + (size_t)r * 2048 + g16 * 256 + c * 8), n1 = *(const v4u*)(kv + (size_t)r * 2048 + (g16 + 4) * 256 + c * 8);
        const v4u rw = *(const v4u*)(proj + (size_t)r * NPROJ + C_KROPE + (c & 7) * 8);
        const v4f c0 = *(const v4f*)(cosT + (size_t)(row0 + r) * 32 + (c & 3) * 8), c1 = *(const v4f*)(cosT + (size_t)(row0 + r) * 32 + (c & 3) * 8 + 4);
        const v4f s0 = *(const v4f*)(sinT + (size_t)(row0 + r) * 32 + (c & 3) * 8), s1 = *(const v4f*)(sinT + (size_t)(row0 + r) * 32 + (c & 3) * 8 + 4);
        float a[8] = {lo16(n0.x), hi16(n0.x), lo16(n0.y), hi16(n0.y), lo16(n0.z), hi16(n0.z), lo16(n0.w), hi16(n0.w)};
        float b[8] = {lo16(n1.x), hi16(n1.x), lo16(n1.y), hi16(n1.y), lo16(n1.z), hi16(n1.z), lo16(n1.w), hi16(n1.w)};
        float kr[8] = {lo16(rw.x), hi16(rw.x), lo16(rw.y), hi16(rw.y), lo16(rw.z), hi16(rw.z), lo16(rw.w), hi16(rw.w)};
        const float cs[8] = {c0.x, c0.y, c0.z, c0.w, c1.x, c1.y, c1.z, c1.w}, sn[8] = {s0.x, s0.y, s0.z, s0.w, s1.x, s1.y, s1.z, s1.w};
        float sa = 0.f, sb = 0.f, sr = 0.f;
#pragma unroll
        for (int j = 0; j < 8; ++j) { sa += a[j] * a[j]; sb += b[j] * b[j]; sr += kr[j] * kr[j]; }
        if (c >= 8) sr = 0.f;
        sa = row16_sum(sa); sb = row16_sum(sb); sr = row16_sum(sr);
        const float rna = 1.0f / sqrtf((sa + sr) * (1.0f / 192.f) + EPS), rnb = 1.0f / sqrtf((sb + sr) * (1.0f / 192.f) + EPS);
        float R[8];
#pragma unroll
        for (int j = 0; j < 8; ++j) { const float mine = kr[j] * gr[j]; const float oth = lane_xor<4>(mine);
            R[j] = (c & 4) ? mine * cs[j] + oth * sn[j] : mine * cs[j] - oth * sn[j]; }
        bf16* ka = K + ((size_t)r * 8 + g16) * 192; bf16* kb = K + ((size_t)r * 8 + g16 + 4) * 192;
        { v4u o; o.x = pk2(a[0] * rna * gn[0], a[1] * rna * gn[1]); o.y = pk2(a[2] * rna * gn[2], a[3] * rna * gn[3]); o.z = pk2(a[4] * rna * gn[4], a[5] * rna * gn[5]); o.w = pk2(a[6] * rna * gn[6], a[7] * rna * gn[7]); *(v4u*)(ka + c * 8) = o; }
        { v4u o; o.x = pk2(b[0] * rnb * gn[0], b[1] * rnb * gn[1]); o.y = pk2(b[2] * rnb * gn[2], b[3] * rnb * gn[3]); o.z = pk2(b[4] * rnb * gn[4], b[5] * rnb * gn[5]); o.w = pk2(b[6] * rnb * gn[6], b[7] * rnb * gn[7]); *(v4u*)(kb + c * 8) = o; }
        if (c < 8) {
            v4u o; o.x = pk2(R[0] * rna, R[1] * rna); o.y = pk2(R[2] * rna, R[3] * rna); o.z = pk2(R[4] * rna, R[5] * rna); o.w = pk2(R[6] * rna, R[7] * rna); *(v4u*)(ka + 128 + c * 8) = o;
            v4u p; p.x = pk2(R[0] * rnb, R[1] * rnb); p.y = pk2(R[2] * rnb, R[3] * rnb); p.z = pk2(R[4] * rnb, R[5] * rnb); p.w = pk2(R[6] * rnb, R[7] * rnb); *(v4u*)(kb + 128 + c * 8) = p; }
    }
}

namespace at {
typedef short bf16x8 __attribute__((ext_vector_type(8)));
typedef short s16x4 __attribute__((ext_vector_type(4)));
typedef float f32x16 __attribute__((ext_vector_type(16)));
typedef unsigned u32x4 __attribute__((ext_vector_type(4)));
constexpr int SHM_V = 16384, SHM_K = 16384, SHM_KR = 8192;
constexpr int OFF_V = 0, OFF_K = 3 * SHM_V, OFF_KR = OFF_K + 2 * SHM_K, OFF_WS = OFF_KR + 2 * SHM_KR, LDS_NEED = OFF_WS + 8 * 64 * 4;
constexpr float SCALE = 0.07216878364870322f;
constexpr float THR = 8.f;
#define AT_KSWZ(row, colB) ((row) * 256 + ((colB) ^ (((row) & 7) << 4)))
#define AT_KRSWZ(row, colB) ((row) * 128 + ((colB) ^ (((row) & 7) << 4)))
#define AT_SBAR() __builtin_amdgcn_sched_barrier(0)
__device__ __forceinline__ int v_st(int k, int c) { const int kk = (k & ~0xC) | ((k & 4) << 1) | ((k & 8) >> 1); return ((kk >> 3) * 4 + (c >> 5)) * 512 + ((kk & 7) * 32 + (c & 31)) * 2; }
__device__ __forceinline__ int v_rd_base(int lane) { return ((lane & 3) << 3) | (((lane >> 2) & 3) << 6) | (((lane >> 4) & 1) << 5) | (((lane >> 5) & 1) << 8); }
constexpr int v_rd_off(int d0, int ks, int half) { return d0 * 512 + ks * 4096 + half * 2048; }
__device__ __forceinline__ int crow(int r, int hi) { return (r & 3) + 8 * (r >> 2) + 4 * hi; }
__device__ __forceinline__ unsigned cvtpk(float lo, float hi) { unsigned r; asm("v_cvt_pk_bf16_f32 %0, %1, %2" : "=v"(r) : "v"(lo), "v"(hi)); return r; }

__device__ __forceinline__ void mask_tile(f32x16& p0, f32x16& p1, int dq) {
    const float NEG = -__builtin_inff();
#pragma unroll
    for (int r = 0; r < 16; ++r) { const int c = (r & 3) + 8 * (r >> 2); if (dq < c) p0[r] = NEG; if (dq < c + 32) p1[r] = NEG; }
}
__device__ __forceinline__ void partialSM(f32x16& p0, f32x16& p1, float& m_reg, float& mn, float& alpha) {
    float pmax = p0[0];
#pragma unroll
    for (int r = 1; r < 16; ++r) pmax = fmaxf(pmax, p0[r]);
#pragma unroll
    for (int r = 0; r < 16; ++r) pmax = fmaxf(pmax, p1[r]);
    { auto rr = __builtin_amdgcn_permlane32_swap(__float_as_uint(pmax), __float_as_uint(pmax), false, false);
      pmax = fmaxf(__uint_as_float(rr[0]), __uint_as_float(rr[1])); }
    constexpr float C2 = 1.4426950408889634f * SCALE;
    if (__builtin_expect(__all((pmax - m_reg) * SCALE <= THR), 1)) { mn = m_reg; alpha = 1.f; }
    else { mn = fmaxf(m_reg, pmax); alpha = __builtin_amdgcn_exp2f((m_reg - mn) * C2); m_reg = mn; }
    const float mnL = -mn * C2;
#pragma unroll
    for (int r = 0; r < 16; ++r) p0[r] = fmaf(p0[r], C2, mnL);
#pragma unroll
    for (int r = 0; r < 16; ++r) p1[r] = fmaf(p1[r], C2, mnL);
#pragma unroll
    for (int r = 0; r < 16; ++r) p0[r] = __builtin_amdgcn_exp2f(p0[r]);
}
__device__ __forceinline__ void finishSM(f32x16& p0, f32x16& p1, float alpha, float& l_reg, bf16x8& pa0, bf16x8& pa1, bf16x8& pa2, bf16x8& pa3) {
#pragma unroll
    for (int r = 0; r < 16; ++r) p1[r] = __builtin_amdgcn_exp2f(p1[r]);
    float ps = 0;
#pragma unroll
    for (int r = 0; r < 16; ++r) ps += p0[r];
#pragma unroll
    for (int r = 0; r < 16; ++r) ps += p1[r];
    { auto rr = __builtin_amdgcn_permlane32_swap(__float_as_uint(ps), __float_as_uint(ps), false, false);
      ps = __uint_as_float(rr[0]) + __uint_as_float(rr[1]); }
    l_reg = l_reg * alpha + ps;
#define AT_PK4(P, B_, OUT) do { unsigned a0 = cvtpk(P[B_+0], P[B_+1]), a1 = cvtpk(P[B_+2], P[B_+3]);                          \
        unsigned b0 = cvtpk(P[B_+4], P[B_+5]), b1 = cvtpk(P[B_+6], P[B_+7]);                                             \
        auto r0 = __builtin_amdgcn_permlane32_swap(a0, b0, false, false); auto r1 = __builtin_amdgcn_permlane32_swap(a1, b1, false, false); \
        u32x4 w = {r0[0], r1[0], r0[1], r1[1]}; OUT = *reinterpret_cast<bf16x8*>(&w); } while (0)
    AT_PK4(p0, 0, pa0); AT_PK4(p0, 8, pa1); AT_PK4(p1, 0, pa2); AT_PK4(p1, 8, pa3);
#undef AT_PK4
}
__device__ __forceinline__ void qkt(f32x16& p0, f32x16& p1, const LAS unsigned char* Kb, const LAS unsigned char* KRb, int r32, int hi, const bf16x8* qr) {
    p0 = f32x16{}; p1 = f32x16{};
    const LAS unsigned char* kb[4]; const LAS unsigned char* krb[4];
#pragma unroll
    for (int dd = 0; dd < 4; ++dd) { kb[dd] = Kb + AT_KSWZ(r32, (dd * 16 + hi * 8) * 2); krb[dd] = KRb + AT_KRSWZ(r32, (dd * 16 + hi * 8) * 2); }
    bf16x8 f[24];
#pragma unroll
    for (int d0 = 0; d0 < 8; ++d0) { const LAS unsigned char* a = kb[d0 & 3] + (d0 >> 2) * 128;
        f[2 * d0] = *reinterpret_cast<const LAS bf16x8*>(a); f[2 * d0 + 1] = *reinterpret_cast<const LAS bf16x8*>(a + 32 * 256); }
#pragma unroll
    for (int d0 = 0; d0 < 4; ++d0) { const LAS unsigned char* a = krb[d0];
        f[16 + 2 * d0] = *reinterpret_cast<const LAS bf16x8*>(a); f[16 + 2 * d0 + 1] = *reinterpret_cast<const LAS bf16x8*>(a + 32 * 128); }
#pragma unroll
    for (int d0 = 0; d0 < 12; ++d0) {
        p0 = __builtin_amdgcn_mfma_f32_32x32x16_bf16(f[2 * d0], qr[d0], p0, 0, 0, 0);
        p1 = __builtin_amdgcn_mfma_f32_32x32x16_bf16(f[2 * d0 + 1], qr[d0], p1, 0, 0, 0); }
    __builtin_amdgcn_sched_group_barrier(0x100, 4, 0);
#pragma unroll
    for (int i = 0; i < 20; ++i) { __builtin_amdgcn_sched_group_barrier(0x008, 1, 0); __builtin_amdgcn_sched_group_barrier(0x100, 1, 0); }
    __builtin_amdgcn_sched_group_barrier(0x008, 4, 0);
}
__device__ __forceinline__ void pv_tile(f32x16* o, unsigned vb0, bf16x8 pa0, bf16x8 pa1, bf16x8 pa2, bf16x8 pa3) {
#define AT_TRRD(dst, off) asm volatile("ds_read_b64_tr_b16 %0, %1 offset:%2" : "=&v"(dst) : "v"(vb0), "i"(off) : "memory")
#define AT_PV_RD(d0, L, H) do { constexpr int b_ = v_rd_off(d0, 0, 0); \
        AT_TRRD(L[0], b_); AT_TRRD(H[0], b_ + 2048); AT_TRRD(L[1], b_ + 4096); AT_TRRD(H[1], b_ + 6144); AT_TRRD(L[2], b_ + 8192); AT_TRRD(H[2], b_ + 10240); AT_TRRD(L[3], b_ + 12288); AT_TRRD(H[3], b_ + 14336); } while (0)
#define AT_PV_MM(d0, L, H) do { \
        o[d0] = __builtin_amdgcn_mfma_f32_32x32x16_bf16(pa0, (bf16x8){L[0][0], L[0][1], L[0][2], L[0][3], H[0][0], H[0][1], H[0][2], H[0][3]}, o[d0], 0, 0, 0);   \
        o[d0] = __builtin_amdgcn_mfma_f32_32x32x16_bf16(pa1, (bf16x8){L[1][0], L[1][1], L[1][2], L[1][3], H[1][0], H[1][1], H[1][2], H[1][3]}, o[d0], 0, 0, 0);   \
        o[d0] = __builtin_amdgcn_mfma_f32_32x32x16_bf16(pa2, (bf16x8){L[2][0], L[2][1], L[2][2], L[2][3], H[2][0], H[2][1], H[2][2], H[2][3]}, o[d0], 0, 0, 0);   \
        o[d0] = __builtin_amdgcn_mfma_f32_32x32x16_bf16(pa3, (bf16x8){L[3][0], L[3][1], L[3][2], L[3][3], H[3][0], H[3][1], H[3][2], H[3][3]}, o[d0], 0, 0, 0); } while (0)
    s16x4 la[4], ha[4], lb[4], hb[4];
    asm volatile("s_waitcnt lgkmcnt(0)" ::: "memory");
    AT_PV_RD(0, la, ha); AT_PV_RD(1, lb, hb);
    asm volatile("s_waitcnt lgkmcnt(8)" ::: "memory"); AT_SBAR(); AT_PV_MM(0, la, ha); AT_SBAR();
    AT_PV_RD(2, la, ha);
    asm volatile("s_waitcnt lgkmcnt(8)" ::: "memory"); AT_SBAR(); AT_PV_MM(1, lb, hb); AT_SBAR();
    AT_PV_RD(3, lb, hb);
    asm volatile("s_waitcnt lgkmcnt(8)" ::: "memory"); AT_SBAR(); AT_PV_MM(2, la, ha); AT_SBAR();
    asm volatile("s_waitcnt lgkmcnt(0)" ::: "memory"); AT_SBAR(); AT_PV_MM(3, lb, hb);
#undef AT_PV_RD
#undef AT_PV_MM
#undef AT_TRRD
}

__device__ __forceinline__ void attn_block(LAS unsigned char* lds, const bf16* Q, const bf16* K, const bf16* KV, const bf16* proj, bf16* YA, const float* qg, const float* cosT, const float* sinT, int b, int h, int qb) {
    const int tid = otid(), wid = __builtin_amdgcn_readfirstlane(tid >> 6), lane = tid & 63, r32 = lane & 31, hi = lane >> 5;
    const int P0 = qb * 256, NT = 4 * (qb + 1), qlo = P0 + wid * 32;
    LAS unsigned char* V_lds = lds + OFF_V; LAS unsigned char* K_lds = lds + OFF_K; LAS unsigned char* KR_lds = lds + OFF_KR;
    LAS float* wsf = (LAS float*)(lds + OFF_WS) + wid * 64; LAS float* li_l = wsf; LAS float* al_l = wsf + 32;
    bf16x8 qr[12];
    { const bf16* qp = Q + ((size_t)(b * SEQ + qlo + r32) * 8 + h) * 192 + hi * 8;
      bf16x8 raw[12];
#pragma unroll
      for (int d0 = 0; d0 < 12; ++d0) raw[d0] = *(const bf16x8*)(qp + d0 * 16);
      float ss = 0.f;
#pragma unroll
      for (int d0 = 0; d0 < 12; ++d0)
#pragma unroll
          for (int j = 0; j < 8; ++j) { const float v = bf2f((unsigned short)raw[d0][j]); ss += v * v; }
      { auto rr = __builtin_amdgcn_permlane32_swap(__float_as_uint(ss), __float_as_uint(ss), false, false); ss = __uint_as_float(rr[0]) + __uint_as_float(rr[1]); }
      const float rn = 1.0f / sqrtf(ss * (1.0f / 192.f) + EPS);
      const float* ct = cosT + (size_t)(b * SEQ + qlo + r32) * 32 + hi * 8; const float* st = sinT + (size_t)(b * SEQ + qlo + r32) * 32 + hi * 8;
#pragma unroll
      for (int d0 = 0; d0 < 8; ++d0) { const v4f g0 = *(const v4f*)(qg + d0 * 16 + hi * 8), g1 = *(const v4f*)(qg + d0 * 16 + hi * 8 + 4);
          const float g[8] = {g0.x, g0.y, g0.z, g0.w, g1.x, g1.y, g1.z, g1.w}; float x[8];
#pragma unroll
          for (int j = 0; j < 8; ++j) x[j] = bf2f((unsigned short)raw[d0][j]) * rn * g[j];
          u32x4 w = {cvtpk(x[0], x[1]), cvtpk(x[2], x[3]), cvtpk(x[4], x[5]), cvtpk(x[6], x[7])}; qr[d0] = *reinterpret_cast<bf16x8*>(&w); }
#pragma unroll
      for (int d0 = 8; d0 < 10; ++d0) { const int i0 = (d0 - 8) * 16;
          const v4f ga0 = *(const v4f*)(qg + d0 * 16 + hi * 8), ga1 = *(const v4f*)(qg + d0 * 16 + hi * 8 + 4), gb0 = *(const v4f*)(qg + (d0 + 2) * 16 + hi * 8), gb1 = *(const v4f*)(qg + (d0 + 2) * 16 + hi * 8 + 4);
          const v4f c0 = *(const v4f*)(ct + i0), c1 = *(const v4f*)(ct + i0 + 4), s0 = *(const v4f*)(st + i0), s1 = *(const v4f*)(st + i0 + 4);
          const float ga[8] = {ga0.x, ga0.y, ga0.z, ga0.w, ga1.x, ga1.y, ga1.z, ga1.w}, gb[8] = {gb0.x, gb0.y, gb0.z, gb0.w, gb1.x, gb1.y, gb1.z, gb1.w};
          const float cs[8] = {c0.x, c0.y, c0.z, c0.w, c1.x, c1.y, c1.z, c1.w}, sn[8] = {s0.x, s0.y, s0.z, s0.w, s1.x, s1.y, s1.z, s1.w};
          float y1[8], y2[8];
#pragma unroll
          for (int j = 0; j < 8; ++j) { const float x1 = bf2f((unsigned short)raw[d0][j]) * rn * ga[j], x2 = bf2f((unsigned short)raw[d0 + 2][j]) * rn * gb[j];
              y1[j] = x1 * cs[j] - x2 * sn[j]; y2[j] = x2 * cs[j] + x1 * sn[j]; }
          u32x4 w1 = {cvtpk(y1[0], y1[1]), cvtpk(y1[2], y1[3]), cvtpk(y1[4], y1[5]), cvtpk(y1[6], y1[7])}; qr[d0] = *reinterpret_cast<bf16x8*>(&w1);
          u32x4 w2 = {cvtpk(y2[0], y2[1]), cvtpk(y2[2], y2[3]), cvtpk(y2[4], y2[5]), cvtpk(y2[6], y2[7])}; qr[d0 + 2] = *reinterpret_cast<bf16x8*>(&w2); }
    }
    const int sr = tid >> 4, sc = (tid & 15) * 8, kws = AT_KSWZ(sr, sc * 2), vst0 = v_st(sr, sc), vst1 = v_st(32 + sr, sc);
    const int rr = tid >> 3, rc = (tid & 7) * 8, krws = AT_KRSWZ(rr, rc * 2);
    const bf16* Kg = K + ((size_t)(b * SEQ) * 8 + h) * 192;
    const bf16* Vg = KV + (size_t)(b * SEQ) * 2048 + h * 256 + 128;
    bf16x8 sa_k0, sa_k1, sa_kr, sa_v0, sa_v1, sb_k0, sb_k1, sb_kr, sb_v0, sb_v1;
#define AT_SLOAD(S, kb_) do { S##_k0 = *(const bf16x8*)(Kg + (size_t)((kb_) + sr) * 1536 + sc); S##_k1 = *(const bf16x8*)(Kg + (size_t)((kb_) + 32 + sr) * 1536 + sc); \
        S##_kr = *(const bf16x8*)(Kg + (size_t)((kb_) + rr) * 1536 + 128 + rc); \
        S##_v0 = *(const bf16x8*)(Vg + (size_t)((kb_) + sr) * 2048 + sc); S##_v1 = *(const bf16x8*)(Vg + (size_t)((kb_) + 32 + sr) * 2048 + sc); } while (0)
#define AT_SWRITE(S, bf, vbf) do { *(LAS bf16x8*)(K_lds + (bf) * SHM_K + kws) = S##_k0; *(LAS bf16x8*)(K_lds + (bf) * SHM_K + kws + 32 * 256) = S##_k1; \
        *(LAS bf16x8*)(KR_lds + (bf) * SHM_KR + krws) = S##_kr; \
        *(LAS bf16x8*)(V_lds + (vbf) * SHM_V + vst0) = S##_v0; *(LAS bf16x8*)(V_lds + (vbf) * SHM_V + vst1) = S##_v1; } while (0)
    AT_SLOAD(sa, 0); AT_SLOAD(sb, 64); AT_SWRITE(sa, 0, 0);
    __syncthreads();
    float m_reg = -1e30f, l_reg = 0.f; f32x16 o[4] = {};
    const unsigned vbase = (unsigned)(size_t)V_lds + (unsigned)v_rd_base(lane);
    const bool late = wid >= 4;
    bool pend = false; int pvb = 0; int vb3 = 0;
    bf16x8 pa0, pa1, pa2, pa3;
#define AT_STEP(t, SL, SW) do { \
        const int buf = (t) & 1, kb = (t) * 64; \
        if ((t) + 2 < NT) AT_SLOAD(SL, kb + 128);                         \
        if (late && pend) { pv_tile(o, vbase + pvb * SHM_V, pa0, pa1, pa2, pa3); pend = false; AT_SBAR(); } \
        if (kb <= qlo + 31) { \
            f32x16 p0, p1; float mn, alpha; \
            qkt(p0, p1, K_lds + buf * SHM_K, KR_lds + buf * SHM_KR, r32, hi, qr); \
            if (kb + 63 > qlo) mask_tile(p0, p1, qlo + r32 - 4 * hi - kb); \
            partialSM(p0, p1, m_reg, mn, alpha); \
            finishSM(p0, p1, alpha, l_reg, pa0, pa1, pa2, pa3); \
            if (__any(alpha < 1.f)) { if (hi == 0) al_l[r32] = alpha; asm volatile("s_waitcnt lgkmcnt(0)" ::: "memory"); \
                _Pragma("unroll") for (int d_ = 0; d_ < 4; ++d_) _Pragma("unroll") for (int r = 0; r < 16; ++r) o[d_][r] *= al_l[crow(r, hi)]; \
                asm volatile("s_waitcnt lgkmcnt(0)" ::: "memory"); } \
            AT_SBAR(); \
            if (late) { pend = true; pvb = vb3; } \
            else pv_tile(o, vbase + vb3 * SHM_V, pa0, pa1, pa2, pa3); \
        } \
        const int vn3 = vb3 == 2 ? 0 : vb3 + 1; \
        if ((t) + 1 < NT) AT_SWRITE(SW, buf ^ 1, vn3);                    \
        vb3 = vn3; \
        __syncthreads(); } while (0)
    for (int t = 0; t < NT; t += 2) { AT_STEP(t, sa, sb); AT_STEP(t + 1, sb, sa); }
#undef AT_STEP
    if (late && pend) pv_tile(o, vbase + pvb * SHM_V, pa0, pa1, pa2, pa3);
    if (hi == 0) li_l[r32] = l_reg;
    asm volatile("s_waitcnt lgkmcnt(0)" ::: "memory");
    float rli[16];
#pragma unroll
    for (int r = 0; r < 16; ++r) rli[r] = 1.0f / li_l[crow(r, hi)];
#pragma unroll
    for (int d0 = 0; d0 < 4; ++d0) { const int col = h * 128 + d0 * 32 + r32;
        unsigned short zr[16];
#pragma unroll
        for (int r = 0; r < 16; ++r) zr[r] = proj[(size_t)(b * SEQ + qlo + crow(r, hi)) * NPROJ + C_ZA + col];
#pragma unroll
        for (int r = 0; r < 16; ++r) { const int row = b * SEQ + qlo + crow(r, hi);
            const float v = o[d0][r] * rli[r] * silu_f(bf2f(zr[r])) * 16.0f;
            const float vn = lane_xor<1>(v);
            const unsigned w2 = (unsigned)__builtin_amdgcn_cvt_pk_fp8_f32(v, vn, 0, false) & 0xffffu;
            const unsigned w2o = __float_as_uint(lane_xor<2>(__uint_as_float(w2)));
            if ((r32 & 3) == 0) *(unsigned*)((unsigned char*)YA + (size_t)row * 1024 + col) = w2 | (w2o << 16); } }
    asm volatile("s_waitcnt lgkmcnt(0)" ::: "memory");
    __syncthreads();
#undef AT_SLOAD
#undef AT_SWRITE
}
}


namespace sg {
using at::bf16x8; using at::f32x16;
__device__ __forceinline__ void sgu_item(LAS unsigned char* lds, const bf16* proj, const float* rv, const float* Ws, const float* bs, const float* vg, bf16* YB, int it) {
    const int tid = otid(), wid = __builtin_amdgcn_readfirstlane(tid >> 6), lane = tid & 63, r32 = lane & 31, hi = lane >> 5;
    {
        const int ch = it >> 2, gp = it & 3, R0 = ch * 128;
#pragma unroll
        for (int i = 0; i < 8; ++i) {
            const int idx = tid + 512 * i, gsel = idx >> 11, row = (idx >> 4) & 127, cc = idx & 15;
            const v4u w = *(const v4u*)(proj + (size_t)(R0 + row) * NPROJ + C_VB + (2 * gp + gsel) * 128 + cc * 8);
            const float s = 1.0f / sqrtf(rv[R0 + row] * (1.0f / 1024.f) + EPS);
            v4u o; o.x = pk2(gelu_f(lo16(w.x)) * s, gelu_f(hi16(w.x)) * s); o.y = pk2(gelu_f(lo16(w.y)) * s, gelu_f(hi16(w.y)) * s);
            o.z = pk2(gelu_f(lo16(w.z)) * s, gelu_f(hi16(w.z)) * s); o.w = pk2(gelu_f(lo16(w.w)) * s, gelu_f(hi16(w.w)) * s);
            *(LAS v4u*)(lds + (gsel * 2 + (row >> 6)) * 16384 + at::v_st(row & 63, cc * 8)) = o;
        }
        __syncthreads();
        const int gsel = wid >> 2, g = 2 * gp + gsel, t = 32 * (wid & 3) + r32;
        f32x16 o[4] = {};
        const int nst = (wid & 3) >= 2 ? 2 : 1;
        for (int st = 0; st < nst; ++st) {
            bf16x8 pa[4];
#pragma unroll
            for (int ks = 0; ks < 4; ++ks) {
                const int s0 = st * 64 + ks * 16 + hi * 8;
                const float* wp = Ws + ((size_t)g * 128 + t) * 128 + s0;
                const v4f a = *(const v4f*)wp, b = *(const v4f*)(wp + 4);
                float x[8] = {a.x, a.y, a.z, a.w, b.x, b.y, b.z, b.w};
#pragma unroll
                for (int j = 0; j < 8; ++j) if (s0 + j > t) x[j] = 0.f;
                at::u32x4 w4 = {at::cvtpk(x[0], x[1]), at::cvtpk(x[2], x[3]), at::cvtpk(x[4], x[5]), at::cvtpk(x[6], x[7])};
                pa[ks] = *reinterpret_cast<bf16x8*>(&w4);
            }
            const unsigned vbase = (unsigned)(size_t)(lds + (gsel * 2 + st) * 16384) + (unsigned)at::v_rd_base(lane);
            at::pv_tile(o, vbase, pa[0], pa[1], pa[2], pa[3]);
        }
#pragma unroll
        for (int d0 = 0; d0 < 4; ++d0) { const int gc = g * 128 + d0 * 32 + r32; const float vgc = vg[gc];
            unsigned short ur[16], zr[16];
#pragma unroll
            for (int r = 0; r < 16; ++r) { const size_t row = (size_t)(R0 + 32 * (wid & 3) + at::crow(r, hi)); ur[r] = proj[row * NPROJ + C_UB + gc]; zr[r] = proj[row * NPROJ + C_ZB + gc]; }
#pragma unroll
            for (int r = 0; r < 16; ++r) { const int tl = 32 * (wid & 3) + at::crow(r, hi); const size_t row = (size_t)(R0 + tl);
                const float mix = o[d0][r] * vgc + bs[g * 128 + tl];
                const float y = gelu_f(bf2f(ur[r])) * mix * silu_f(bf2f(zr[r])), yn = lane_xor<1>(y);
                if ((r32 & 1) == 0) *(unsigned*)(YB + row * 1024 + gc) = at::cvtpk(y, yn); } }
        __syncthreads();
    }
}
}


namespace gl {
using at::bf16x8; using at::f32x16; using at::s16x4; using at::u32x4;
constexpr int OFF_VIMG = 0, OFF_KLIMG = 65536, OFF_ATT = 98304, OFF_DS = 131072, OFF_PART = 131584, LDS_NEED = OFF_PART + 4096;

__device__ __forceinline__ void gla_prep_item(LAS unsigned char* lds, int seg_off, const bf16* proj, const float* wa2, const float* ba, bf16* QE, bf16* KE, bf16* KL, float* DS, int ci) {
    const int tid = otid(), k2 = tid & 63, ts = tid >> 6, k = 2 * k2;
    LAS float* seg = (LAS float*)(lds + seg_off);
    {
        const int ch = ci >> 2, h = ci & 3, R0 = ch * 128 + ts * 16;
        float wa0[16], wa1[16];
#pragma unroll
        for (int j = 0; j < 16; ++j) { const v2f w = *(const v2f*)(wa2 + j * 512 + h * 128 + k); wa0[j] = w.x; wa1[j] = w.y; }
        const v2f bak = *(const v2f*)(ba + h * 128 + k);
        float la0[16], la1[16]; float run0 = 0.f, run1 = 0.f;
#pragma unroll
        for (int i = 0; i < 16; ++i) {
            const bf16* pr = proj + (size_t)(R0 + i) * NPROJ + C_AR;
            const v4u w0 = *(const v4u*)pr, w1 = *(const v4u*)(pr + 8);
            const float ar[16] = {lo16(w0.x), hi16(w0.x), lo16(w0.y), hi16(w0.y), lo16(w0.z), hi16(w0.z), lo16(w0.w), hi16(w0.w),
                                  lo16(w1.x), hi16(w1.x), lo16(w1.y), hi16(w1.y), lo16(w1.z), hi16(w1.z), lo16(w1.w), hi16(w1.w)};
            float x0 = bak.x, x1 = bak.y;
#pragma unroll
            for (int j = 0; j < 16; ++j) { x0 += ar[j] * wa0[j]; x1 += ar[j] * wa1[j]; }
            run0 += (fminf(x0, 0.f) - __logf(1.0f + __expf(-fabsf(x0)))) * 0.0625f; la0[i] = run0;
            run1 += (fminf(x1, 0.f) - __logf(1.0f + __expf(-fabsf(x1)))) * 0.0625f; la1[i] = run1;
        }
        *(LAS v2f*)(seg + ts * 128 + k) = (v2f){run0, run1};
        __syncthreads();
        float pre0 = 0.f, pre1 = 0.f, tot0 = 0.f, tot1 = 0.f;
#pragma unroll
        for (int q = 0; q < 8; ++q) { const v2f sg = *(const LAS v2f*)(seg + q * 128 + k); tot0 += sg.x; tot1 += sg.y; if (q < ts) { pre0 += sg.x; pre1 += sg.y; } }
        const float et0 = __expf(tot0), et1 = __expf(tot1);
        unsigned qw[16], kw[16];
#pragma unroll
        for (int i = 0; i < 16; ++i) { const size_t row = (size_t)(R0 + i); qw[i] = *(const unsigned*)(proj + row * NPROJ + C_QC + h * 128 + k); kw[i] = *(const unsigned*)(proj + row * NPROJ + C_KC + h * 128 + k); }
#pragma unroll
        for (int i = 0; i < 16; ++i) {
            const size_t o = (size_t)(R0 + i) * 512 + h * 128 + k;
            const float e0 = __expf(la0[i] + pre0), e1 = __expf(la1[i] + pre1), r0 = __builtin_amdgcn_rcpf(e0), r1 = __builtin_amdgcn_rcpf(e1);
            const float q0 = lo16(qw[i]) * 0.08838834764831845f, q1 = hi16(qw[i]) * 0.08838834764831845f, kk0 = lo16(kw[i]) * r0, kk1 = hi16(kw[i]) * r1;
            *(unsigned*)(QE + o) = pk2(q0 * e0, q1 * e1);
            *(unsigned*)(KE + o) = pk2(kk0, kk1);
            *(unsigned*)(KL + o) = pk2(kk0 * et0, kk1 * et1);
        }
        if (ts == 0) *(v2f*)(DS + ((size_t)ch * 4 + h) * 128 + k) = (v2f){et0, et1};
        __syncthreads();
    }
}

#define GL_PK4(P, B_, OUT) do { unsigned a0 = at::cvtpk(P[B_+0], P[B_+1]), a1 = at::cvtpk(P[B_+2], P[B_+3]);                          \
        unsigned b0 = at::cvtpk(P[B_+4], P[B_+5]), b1 = at::cvtpk(P[B_+6], P[B_+7]);                                             \
        auto r0 = __builtin_amdgcn_permlane32_swap(a0, b0, false, false); auto r1 = __builtin_amdgcn_permlane32_swap(a1, b1, false, false); \
        u32x4 w = {r0[0], r1[0], r0[1], r1[1]}; OUT = *reinterpret_cast<bf16x8*>(&w); } while (0)
#define GL_TRRD(dst, addr, off) asm volatile("ds_read_b64_tr_b16 %0, %1 offset:%2" : "=&v"(dst) : "v"(addr), "i"(off) : "memory")

template <int TT> __device__ __forceinline__ void o_intra_tile(LAS unsigned char* lds, const bf16x8 (&vfr)[8], float* oi, int r32, int hi) {
    f32x16 acc = {};
    const int t = 32 * TT + r32;
    bf16x8 af[2 * TT + 2];
#pragma unroll
    for (int ks8 = 0; ks8 < 2 * TT + 2; ++ks8) af[ks8] = *(const LAS bf16x8*)(lds + OFF_ATT + t * 256 + (((16 * ks8 + 8 * hi) * 2) ^ ((t & 7) << 4)));
#pragma unroll
    for (int ks8 = 0; ks8 < 2 * TT + 2; ++ks8) acc = __builtin_amdgcn_mfma_f32_32x32x16_bf16(af[ks8], vfr[ks8], acc, 0, 0, 0);
    __builtin_amdgcn_sched_group_barrier(0x100, 2 * TT + 2, 0); __builtin_amdgcn_sched_group_barrier(0x008, 2 * TT + 2, 0);
#pragma unroll
    for (int r4 = 0; r4 < 4; ++r4) *(v4f*)(oi + (size_t)(TT * 4 + r4) * 256) = (v4f){acc[4 * r4], acc[4 * r4 + 1], acc[4 * r4 + 2], acc[4 * r4 + 3]};
}
__device__ __forceinline__ void gla_chunk_item(LAS unsigned char* lds, const bf16* proj, const bf16* QE, const bf16* KE, const bf16* KL, float* OI, float* DL, int ci) {
    const int tid = otid(), wid = __builtin_amdgcn_readfirstlane(tid >> 6), lane = tid & 63, r32 = lane & 31, hi = lane >> 5;
    const int h = ci & 3, R0 = (ci >> 2) * 128;
    {
        {
#pragma unroll
            for (int i = 0; i < 8; ++i) { const int idx = tid + 512 * i, s = idx >> 5, cc = idx & 31;
                const v4u w = *(const v4u*)(proj + (size_t)(R0 + s) * NPROJ + C_VC + h * 256 + cc * 8);
                *(LAS v4u*)(lds + OFF_VIMG + ((s >> 6) * 2 + (cc >> 4)) * 16384 + at::v_st(s & 63, (cc & 15) * 8)) = w; }
#pragma unroll
            for (int i = 0; i < 4; ++i) { const int idx = tid + 512 * i, s = idx >> 4, cc = idx & 15;
                const v4u w = *(const v4u*)(KL + (size_t)(R0 + s) * 512 + h * 128 + cc * 8);
                *(LAS v4u*)(lds + OFF_KLIMG + (s >> 6) * 16384 + at::v_st(s & 63, cc * 8)) = w; }
#pragma unroll
            for (int j = 0; j < 2; ++j) {
                const int ti = 2 * wid + j, st = ti >> 2, tt = ti & 3;
                if (st <= tt) {
                    f32x16 p = {};
                    const bf16* ap = KE + (size_t)(R0 + 32 * st + r32) * 512 + h * 128 + hi * 8;
                    const bf16* bp = QE + (size_t)(R0 + 32 * tt + r32) * 512 + h * 128 + hi * 8;
                    bf16x8 fa[8], fb[8];
#pragma unroll
                    for (int ks = 0; ks < 8; ++ks) { fa[ks] = *(const bf16x8*)(ap + ks * 16); fb[ks] = *(const bf16x8*)(bp + ks * 16); }
#pragma unroll
                    for (int ks = 0; ks < 8; ++ks) p = __builtin_amdgcn_mfma_f32_32x32x16_bf16(fa[ks], fb[ks], p, 0, 0, 0);
                    __builtin_amdgcn_sched_group_barrier(0x020, 16, 0); __builtin_amdgcn_sched_group_barrier(0x008, 8, 0);
                    if (st == tt) {
#pragma unroll
                        for (int r = 0; r < 16; ++r) if (at::crow(r, hi) > r32) p[r] = 0.f; }
                    const int t = 32 * tt + r32;
#pragma unroll
                    for (int g = 0; g < 4; ++g) { v2u w; w.x = at::cvtpk(p[4 * g], p[4 * g + 1]); w.y = at::cvtpk(p[4 * g + 2], p[4 * g + 3]);
                        *(LAS v2u*)(lds + OFF_ATT + t * 256 + ((64 * st + 16 * g) ^ ((t & 7) << 4)) + 8 * hi) = w; }
                }
            }
            __syncthreads();
            bf16x8 vfr[8];
            { const unsigned vaddr = (unsigned)(size_t)(lds + OFF_VIMG + (wid >> 2) * 16384) + (unsigned)at::v_rd_base(lane) + (unsigned)((wid & 3) * 512);
              s16x4 vl[8], vh[8];
#define GL_VF(ks8) do { constexpr int o_ = ((ks8) >> 2) * 32768 + ((ks8) & 3) * 4096; GL_TRRD(vl[ks8], vaddr, o_); GL_TRRD(vh[ks8], vaddr, o_ + 2048); } while (0)
              GL_VF(0); GL_VF(1); GL_VF(2); GL_VF(3); GL_VF(4); GL_VF(5); GL_VF(6); GL_VF(7);
#undef GL_VF
              asm volatile("s_waitcnt lgkmcnt(0)" ::: "memory"); AT_SBAR();
#pragma unroll
              for (int q = 0; q < 8; ++q) vfr[q] = (bf16x8){vl[q][0], vl[q][1], vl[q][2], vl[q][3], vh[q][0], vh[q][1], vh[q][2], vh[q][3]};
              AT_SBAR(); }
            float* oi = OI + (((size_t)ci * 8 + wid) * 16 * 64 + lane) * 4;
            float* dl = DL + (((size_t)ci * 8 + wid) * 16 * 64 + lane) * 4;
            o_intra_tile<0>(lds, vfr, oi, r32, hi); o_intra_tile<1>(lds, vfr, oi, r32, hi); o_intra_tile<2>(lds, vfr, oi, r32, hi); o_intra_tile<3>(lds, vfr, oi, r32, hi);
#pragma unroll
            for (int kt = 0; kt < 4; ++kt) {
                f32x16 D = {};
                const unsigned kaddr = (unsigned)(size_t)(lds + OFF_KLIMG) + (unsigned)at::v_rd_base(lane) + (unsigned)(kt * 512);
#define GL_KF(ks8) do { s16x4 l_, h_; constexpr int o_ = ((ks8) >> 2) * 16384 + ((ks8) & 3) * 4096; GL_TRRD(l_, kaddr, o_); GL_TRRD(h_, kaddr, o_ + 2048); \
                asm volatile("s_waitcnt lgkmcnt(0)" ::: "memory"); AT_SBAR(); \
                D = __builtin_amdgcn_mfma_f32_32x32x16_bf16((bf16x8){l_[0], l_[1], l_[2], l_[3], h_[0], h_[1], h_[2], h_[3]}, vfr[ks8], D, 0, 0, 0); } while (0)
                GL_KF(0); GL_KF(1); GL_KF(2); GL_KF(3); GL_KF(4); GL_KF(5); GL_KF(6); GL_KF(7);
#undef GL_KF
#pragma unroll
                for (int r4 = 0; r4 < 4; ++r4) *(v4f*)(dl + (size_t)(kt * 4 + r4) * 256) = (v4f){D[4 * r4], D[4 * r4 + 1], D[4 * r4 + 2], D[4 * r4 + 3]};
            }
            __syncthreads();
        }
    }
}

__device__ __forceinline__ void gla_stageA_item(const float* DS, const float* DL, bf16* XB, int b, int h, int vp) {
    const int tid = otid(), wid = __builtin_amdgcn_readfirstlane(tid >> 6), lane = tid & 63, hi = lane >> 5;
    const int vb = 2 * vp + (wid >> 2), kt = wid & 3;
    constexpr int PF = 4, NC = SEQ / 128;
    f32x16 X = {};
    v4f dq[PF][4], sq[PF][4];
    const size_t ci0 = (size_t)(b * 32) * 4 + h;
#define GL_ALOAD(slot, c_) do { const size_t ci_ = ci0 + (size_t)(c_) * 4; const float* dl_ = DL + ((ci_ * 8 + vb) * 16 * 64 + lane) * 4 + (size_t)(kt * 4) * 256; const float* ds_ = DS + ci_ * 128 + 32 * kt + 4 * hi; \
        _Pragma("unroll") for (int r4 = 0; r4 < 4; ++r4) { dq[slot][r4] = *(const v4f*)(dl_ + (size_t)r4 * 256); sq[slot][r4] = *(const v4f*)(ds_ + 8 * r4); } } while (0)
#pragma unroll
    for (int s = 0; s < PF; ++s) GL_ALOAD(s, s);
    for (int c0 = 0; c0 < NC; c0 += PF) {
#pragma unroll
        for (int s = 0; s < PF; ++s) {
            const int c = c0 + s; const size_t ci = ci0 + (size_t)c * 4;
            bf16* xo = XB + (((ci * 8 + vb) * 8 + kt * 2) * 64 + lane) * 8;
            bf16x8 xb0, xb1; GL_PK4(X, 0, xb0); GL_PK4(X, 8, xb1);
            *(bf16x8*)xo = xb0; *(bf16x8*)(xo + 512) = xb1;
#pragma unroll
            for (int r4 = 0; r4 < 4; ++r4) { const v4f w = dq[s][r4], d4 = sq[s][r4];
                X[4 * r4] = X[4 * r4] * d4.x + w.x; X[4 * r4 + 1] = X[4 * r4 + 1] * d4.y + w.y; X[4 * r4 + 2] = X[4 * r4 + 2] * d4.z + w.z; X[4 * r4 + 3] = X[4 * r4 + 3] * d4.w + w.w; }
            if (c + PF < NC) GL_ALOAD(s, c + PF);
        }
    }
#undef GL_ALOAD
}
__device__ __forceinline__ void gla_stageB_item(const bf16* proj, const bf16* QE, const float* OI, const bf16* XB, const float* og, bf16* YC, int b, int h, int cp) {
    const int tid = otid(), wid = __builtin_amdgcn_readfirstlane(tid >> 6), lane = tid & 63, r32 = lane & 31, hi = lane >> 5;
    {
        const int c = 2 * cp + (wid >> 2), tt = wid & 3, R0 = b * SEQ + c * 128;
        const size_t ci = (size_t)(b * 32 + c) * 4 + h;
        f32x16 acc[8];
#pragma unroll
        for (int vb = 0; vb < 8; ++vb) { const float* oi = OI + ((ci * 8 + vb) * 16 * 64 + lane) * 4 + (size_t)(tt * 4) * 256;
#pragma unroll
            for (int r4 = 0; r4 < 4; ++r4) { const v4f w = *(const v4f*)(oi + (size_t)r4 * 256); acc[vb][4 * r4] = w.x; acc[vb][4 * r4 + 1] = w.y; acc[vb][4 * r4 + 2] = w.z; acc[vb][4 * r4 + 3] = w.w; } }
        bf16x8 qa[8];
        { const bf16* qp = QE + (size_t)(R0 + 32 * tt + r32) * 512 + h * 128 + hi * 8;
#pragma unroll
          for (int ks = 0; ks < 8; ++ks) qa[ks] = *(const bf16x8*)(qp + ks * 16); }
        if (c > 0) {
            const bf16* xi = XB + (((ci * 8) * 8) * 64 + lane) * 8;
            bf16x8 xf[64];
#pragma unroll
            for (int i = 0; i < 64; ++i) xf[i] = *(const bf16x8*)(xi + (size_t)i * 512);
#pragma unroll
            for (int i = 0; i < 64; ++i) acc[i >> 3] = __builtin_amdgcn_mfma_f32_32x32x16_bf16(qa[i & 7], xf[i], acc[i >> 3], 0, 0, 0);
            __builtin_amdgcn_sched_group_barrier(0x020, 16, 0);
#pragma unroll
            for (int i = 0; i < 48; ++i) { __builtin_amdgcn_sched_group_barrier(0x008, 1, 0); __builtin_amdgcn_sched_group_barrier(0x020, 1, 0); }
            __builtin_amdgcn_sched_group_barrier(0x008, 16, 0);
        }
        float rn[16];
#pragma unroll
        for (int r = 0; r < 16; ++r) { float s = 0.f;
#pragma unroll
            for (int vb = 0; vb < 8; ++vb) s += acc[vb][r] * acc[vb][r];
            s += lane_xor<1>(s); s += lane_xor<2>(s); s += lane_xor<4>(s); s += lane_xor<8>(s); s += lane_xor<16>(s);
            rn[r] = 1.0f / sqrtf(s * (1.0f / 256.f) + EPS); }
#pragma unroll
        for (int vb = 0; vb < 8; ++vb) { const float gcol = og[32 * vb + r32];
            unsigned short zr[16];
#pragma unroll
            for (int r = 0; r < 16; ++r) zr[r] = proj[(size_t)(R0 + 32 * tt + at::crow(r, hi)) * NPROJ + C_ZC + h * 256 + 32 * vb + r32];
#pragma unroll
            for (int r = 0; r < 16; ++r) { const size_t row = (size_t)(R0 + 32 * tt + at::crow(r, hi));
                const float y = acc[vb][r] * rn[r] * gcol * silu_f(bf2f(zr[r])), yn = lane_xor<1>(y);
                if ((r32 & 1) == 0) *(unsigned*)(YC + row * 1024 + h * 256 + 32 * vb + r32) = at::cvtpk(y, yn); } }
    }
}
#undef GL_PK4
#undef GL_TRRD
}


constexpr int CW_Q = 65536;
__device__ __forceinline__ int q_pop(unsigned* ctr, LAS unsigned* slot) {
    if (otid() == 0) *slot = __hip_atomic_fetch_add(ctr, 1u, __ATOMIC_RELAXED, __HIP_MEMORY_SCOPE_AGENT);
    __syncthreads(); const int v = (int)*slot; __syncthreads(); return v; }
__device__ __forceinline__ void ph_mixers(LAS unsigned char* lds, unsigned char* ws, unsigned* qctr, const float* Ws, const float* bs, const float* vg, const float* og, const float* qg, int row0, int vb) {
    constexpr int NGLA = NBP * 8, NATT = 16 * NBP, NSGU = 16 * NBP, NQ = NGLA + NATT + NSGU;
    static_assert(NBP % 2 == 0, "NBP even");
    LAS unsigned* slot = (LAS unsigned*)(lds + LDSCTL_OFF + 64);
    bf16* proj = (bf16*)(ws + WS_PROJ);
    for (int dq = 0; dq < 8; ++dq) {
        const int q = (vb + dq) & 7;
        for (;;) {
            const int idx = q_pop(qctr + q * 64, slot);
            if (idx >= NQ) break;
            if (idx >= NATT && idx < NATT + NGLA) { const int gi = q * NGLA + (idx - NATT), bh = gi >> 4, cp = gi & 15;
                gl::gla_stageB_item(proj, (const bf16*)(ws + WS_QE), (const float*)(ws + WS_OC), (const bf16*)(ws + WS_XB), og, (bf16*)(ws + WS_YC), bh >> 2, bh & 3, cp); }
            else if (idx < NATT) { const int j = idx, qb = 15 - j / NBP, bh = q * NBP + j % NBP;
                at::attn_block(lds, (const bf16*)(ws + WS_Q), (const bf16*)(ws + WS_K), (const bf16*)(ws + WS_KV), proj, (bf16*)(ws + WS_YA), qg, (const float*)(ws + WS_COS) + (size_t)row0 * 32, (const float*)(ws + WS_SIN) + (size_t)row0 * 32, bh >> 3, bh & 7, qb); }
            else { const int it = q * NSGU + (idx - NGLA - NATT);
                sg::sgu_item(lds, proj, (const float*)(ws + WS_SSQ) + 2 * MP, Ws, bs, vg, (bf16*)(ws + WS_YB), it); }
        }
    }
}
#ifndef GEMM_SP2
#define GEMM_SP2 true
#endif
#ifndef GEMM_ALIGN
#define GEMM_ALIGN true
#endif
typedef const __attribute__((address_space(4))) Args* KArgP;
#define KARG() ({ KArgP p_ = (KArgP)__builtin_amdgcn_kernarg_segment_ptr(); asm volatile("" : "+s"(p_)); p_; })
#define INF(i) ((const float*)ap->in[i])
__device__ __forceinline__ void grid_bar(const XcdBarrier& b0) { XcdBarrier b = b0; asm volatile("" : "+s"(b.bar)); xcd_barrier(b); }

__global__ void __launch_bounds__(512, 2) fwd(Args a) {
    extern __shared__ __attribute__((aligned(16))) unsigned char lds_raw[];
    LAS unsigned char* lds = (LAS unsigned char*)lds_raw;
    const int lo = a.lo, hi = a.hi;
    XcdBarrier bar; bar.bar = (unsigned*)(a.ws + WS_CTL) + CW_BAR; bar.x = 0; bar.st = nullptr;
    if (hi - lo > 1) {
        if (threadIdx.x < 4) ((LAS unsigned*)(lds + LDSCTL_OFF))[threadIdx.x] = 0u;
        __syncthreads();
        bar = xcd_barrier_post((unsigned*)(a.ws + WS_CTL) + CW_BAR, (volatile LAS unsigned*)(lds + LDSCTL_OFF));
    }
    int step = 0;
#define PH_BEGIN if (step >= lo && step < hi) { const KArgP ap = KARG(); unsigned char* const ws = ap->ws; const int vb = obid(), nvb = gridDim.x; (void)ws; (void)vb; (void)nvb;
#define PH_END   if (step + 1 < hi) grid_bar(bar); } ++step;
#define WL(l) (ws + WS_W + (size_t)(l) * SZ_WLAYER)
#define B_(T, off) ((T*)(ws + (off)))

    for (int l = 0; l < DEPTH; ++l) {
        PH_BEGIN
            { unsigned char* wl = ws + WS_W;
              convert_T<1>(INF(3) + (size_t)l * DM * IN_COLS, DM, IN_COLS, (bf16*)wl, NBF, (LAS float*)lds, vb, nvb);
              convert_T8<2>(INF(3) + (size_t)l * DM * IN_COLS, DM, IN_COLS, wl + SZ_WINB, NF8, 64.0f, (LAS float*)lds, (vb + 96) % nvb, nvb);
              convert_T<0>(INF(6) + (size_t)l * 512 * 1536, 512, 1536, (bf16*)(wl + SZ_WIN), 1536, (LAS float*)lds, (vb + 64) % nvb, nvb, INF(4) + l * 512);
              convert_T<0>(INF(7) + (size_t)l * 512 * 2048, 512, 2048, (bf16*)(wl + SZ_WIN + SZ_WUQ), 2048, (LAS float*)lds, (vb + 128) % nvb, nvb, INF(5) + l * 512);
              convert_T8<0>(INF(16) + ((size_t)l * 3) * 1024 * 2048, 1024, 2048, wl + SZ_WIN + SZ_WUQ + SZ_WUKV, 2048, 32.0f, (LAS float*)lds, vb, nvb);
              for (int b = 1; b < 3; ++b)
                  convert_T<0>(INF(16) + ((size_t)l * 3 + b) * 1024 * 2048, 1024, 2048, (bf16*)(wl + SZ_WIN + SZ_WUQ + SZ_WUKV) + (size_t)b * 2048 * 1024, 2048, (LAS float*)lds, (vb + 32 * b) % nvb, nvb);
              convert_T<0>(INF(17) + (size_t)l * 2048 * 2048, 2048, 2048, (bf16*)(wl + SZ_WIN + SZ_WUQ + SZ_WUKV + SZ_WB), 2048, (LAS float*)lds, (vb + 192) % nvb, nvb); }
            if (l == 0) { const int* positions = (const int*)ap->in[1]; float* cosT = B_(float, WS_COS); float* sinT = B_(float, WS_SIN);
              for (int idx = vb * 512 + otid(); idx < MTOK * 32; idx += nvb * 512) {
                const int t = idx >> 5, i = idx & 31;
                const float inv = 1.0f / powf(10000.0f, (float)(2 * i) * (1.0f / 64.0f));
                const float ang = (float)positions[t] * inv;
                float sn, cs; sincosf(ang, &sn, &cs);
                cosT[idx] = cs; sinT[idx] = sn; } }
        PH_END
        for (int p = 0; p < NPASS; ++p) {
            const int row0 = p * MP;
#define XIN ((l == 0 ? (const float*)ap->in[0] : (const float*)ap->out) + (size_t)row0 * DM)
#define WLP (ws + WS_W)
            PH_BEGIN ph_norm(XIN, INF(2) + l * DM, B_(bf16, WS_H), B_(unsigned char, WS_H8), MP, vb, nvb);
                     { float* ssq = B_(float, WS_SSQ); for (int i = vb * 512 + otid(); i < 3 * MP; i += nvb * 512) ssq[i] = 0.f; } PH_END
            PH_BEGIN { { pg8::Gemm g{B_(bf16, WS_H), (const bf16*)WLP, MP, NBF, DM}; pg8::StaticOrder S; S.init(MP, NBF, nvb, vb); pg8::EpiProj E{B_(bf16, WS_PROJ), NPROJ, B_(float, WS_SSQ), MP, 0};
                         pg8::gemm_phase<pg8::EpiProj, pg8::StaticOrder, false, GEMM_ALIGN, GEMM_SP2>(lds, g, S, E, nullptr); }
                       { pg8::Gemm g{(const bf16*)B_(unsigned char, WS_H8), (const bf16*)(WLP + SZ_WINB), MP, NF8, DM / 2}; pg8::StaticOrder S; S.init(MP, NF8, nvb, vb);
                         { const int ub = (MP / 256) * (NBF / 256), u8 = (MP / 256) * (NF8 / 256), sk = ub % nvb;
                           if (sk > 0 && sk < nvb) { S.skip = sk; S.full = (u8 - 2 * (nvb - sk)) / nvb; if (S.full < 0) S.full = 0; } }
                         pg8::EpiProj E{B_(bf16, WS_PROJ) + NBF, NPROJ, B_(float, WS_SSQ), MP, NBF / 256};
                         pg8::gemm_phase<pg8::EpiProj, pg8::StaticOrder, false, GEMM_ALIGN, GEMM_SP2, true>(lds, g, S, E, nullptr); } } PH_END
            PH_BEGIN { { pg8::Gemm g{B_(bf16, WS_PROJ) + C_CQ, (const bf16*)(WLP + SZ_WIN), MP, 1536, 512, NPROJ}; pg8::StaticOrder S; S.init(MP, 1536, nvb, vb); pg8::EpiBf16Row E{B_(bf16, WS_Q), 1536, B_(float, WS_SSQ), 1.0f / 512.f, EPS};
                         pg8::gemm_phase<pg8::EpiBf16Row, pg8::StaticOrder, false, GEMM_ALIGN, GEMM_SP2>(lds, g, S, E, nullptr); }
                       { pg8::Gemm g{B_(bf16, WS_PROJ) + C_CKV, (const bf16*)(WLP + SZ_WIN + SZ_WUQ), MP, 2048, 512, NPROJ}; pg8::StaticOrder S; S.init(MP, 2048, nvb, nvb - 1 - vb); pg8::EpiBf16Row E{B_(bf16, WS_KV), 2048, B_(float, WS_SSQ) + MP, 1.0f / 512.f, EPS};
                         pg8::gemm_phase<pg8::EpiBf16Row, pg8::StaticOrder, false, GEMM_ALIGN, GEMM_SP2>(lds, g, S, E, nullptr); }
                       for (int ci = vb; ci < (MP / 128) * 4; ci += nvb) {
                           gl::gla_prep_item(lds, 135168, B_(bf16, WS_PROJ), INF(13) + l * 16 * 512, INF(14) + l * 512, B_(bf16, WS_QE), B_(bf16, WS_KE), B_(bf16, WS_KL), B_(float, WS_DS), ci);
                           gl::gla_chunk_item(lds, B_(bf16, WS_PROJ), B_(bf16, WS_QE), B_(bf16, WS_KE), B_(bf16, WS_KL), B_(float, WS_OC), B_(float, WS_DL), ci); } } PH_END
            PH_BEGIN { constexpr int NA = NBP * 16;
                       if (nvb > 2 * NA) { if (vb < NA) gl::gla_stageA_item(B_(float, WS_DS), B_(float, WS_DL), B_(bf16, WS_XB), vb >> 4, (vb >> 2) & 3, vb & 3);
                                           else ph_kfin(B_(bf16, WS_KV), B_(bf16, WS_PROJ), B_(bf16, WS_K), INF(9) + l * 192, B_(float, WS_COS), B_(float, WS_SIN), row0, vb - NA, nvb - NA); }
                       else { for (int it = vb; it < NA; it += nvb) gl::gla_stageA_item(B_(float, WS_DS), B_(float, WS_DL), B_(bf16, WS_XB), it >> 4, (it >> 2) & 3, it & 3);
                              ph_kfin(B_(bf16, WS_KV), B_(bf16, WS_PROJ), B_(bf16, WS_K), INF(9) + l * 192, B_(float, WS_COS), B_(float, WS_SIN), row0, vb, nvb); } } PH_END
            PH_BEGIN ph_mixers(lds, ws, (unsigned*)(ws + WS_CTL) + CW_Q + (l * NPASS + p) * 8 * 64, INF(11) + (size_t)l * 8 * 128 * 128, INF(12) + l * 8 * 128, INF(10) + l * 1024, INF(15) + l * 256, INF(8) + l * 192, row0, vb); PH_END
            PH_BEGIN { { pg8::Gemm g{B_(bf16, WS_YA), (const bf16*)(WLP + SZ_WIN + SZ_WUQ + SZ_WUKV), MP, 2048, 512, 0, 0x7a7a7a7a, 0x7b7b7b7b};
                         pg8::StaticOrder S; S.init(MP, 2048, nvb, vb);
                         pg8::EpiMerge E{B_(bf16, WS_PROJ) + C_GATE, NPROJ, B_(bf16, WS_MG), 2048, 2048, 0}; pg8::gemm_phase<pg8::EpiMerge, pg8::StaticOrder, false, GEMM_ALIGN, GEMM_SP2, true>(lds, g, S, E, nullptr); }
                       { pg8::Gemm g{B_(bf16, WS_YB), (const bf16*)(WLP + SZ_WIN + SZ_WUQ + SZ_WUKV) + (size_t)2048 * 1024, MP, 2048, 1024};
                         pg8::BranchOrder S; S.init(MP, 2048, nvb, vb); S.NB = 2; S.a_stride = (size_t)MP * 1024 * 2; S.b_stride = (size_t)2048 * 1024 * 2;
                         pg8::EpiMerge E{B_(bf16, WS_PROJ) + C_GATE, NPROJ, B_(bf16, WS_MG), 2048, 2048, 1}; pg8::gemm_phase<pg8::EpiMerge, pg8::BranchOrder, false, GEMM_ALIGN, GEMM_SP2>(lds, g, S, E, nullptr); } } PH_END
            PH_BEGIN { pg8::Gemm g{B_(bf16, WS_MG), (const bf16*)(WLP + SZ_WIN + SZ_WUQ + SZ_WUKV + SZ_WB), MP, 2048, 2048}; pg8::StaticOrder S; S.init(MP, 2048, nvb, vb); pg8::EpiRes E{XIN, ap->out + (size_t)row0 * DM, 2048};
                       pg8::gemm_phase<pg8::EpiRes, pg8::StaticOrder, false, GEMM_ALIGN, GEMM_SP2>(lds, g, S, E, nullptr); } PH_END
        }
    }
#undef PH_BEGIN
#undef PH_END
}

#ifndef ONE_LAUNCH
#define ONE_LAUNCH 1
#endif
extern "C" void kernel_launch(void* const* d_in, const int* in_sizes, int n_in, void* d_out, int out_size, void* d_ws, size_t ws_size, hipStream_t stream) {
    static int grid = 0;
    if (grid == 0) {
        if (n_in != 18 || out_size != MTOK * DM || ws_size < WS_END) { fprintf(stderr, "kernel_launch: unexpected shapes (n_in %d out %d ws %zu need %zu)\n", n_in, out_size, ws_size, (size_t)WS_END); grid = -1; return; }
        int dev = 0, cus = 0, per_cu = 0;
        if (hipGetDevice(&dev) != hipSuccess || hipDeviceGetAttribute(&cus, hipDeviceAttributeMultiprocessorCount, dev) != hipSuccess) { grid = -1; return; }
        if (hipFuncSetAttribute((const void*)fwd, hipFuncAttributeMaxDynamicSharedMemorySize, LDS_BYTES) != hipSuccess) { fprintf(stderr, "kernel_launch: hipFuncSetAttribute failed\n"); grid = -1; return; }
        if (hipOccupancyMaxActiveBlocksPerMultiprocessor(&per_cu, (const void*)fwd, 512, LDS_BYTES) != hipSuccess || per_cu < 1) { fprintf(stderr, "kernel_launch: occupancy query says %d\n", per_cu); }
        (void)hipGetLastError();
        grid = cus;
    }
    if (grid < 0) return;
    (void)hipMemsetAsync((char*)d_ws + WS_CTL, 0, CTL_BYTES, stream);
    Args a{};
    for (int i = 0; i < 18; ++i) a.in[i] = d_in[i];
    a.out = (float*)d_out; a.ws = (unsigned char*)d_ws; a.pad0 = 0; a.pad1 = 0;
#if ONE_LAUNCH
    a.lo = 0; a.hi = NSTEPS;
    hipLaunchKernelGGL(fwd, dim3(grid), dim3(512), LDS_BYTES, stream, a);
#else
    for (int s = 0; s < NSTEPS; ++s) { a.lo = s; a.hi = s + 1; hipLaunchKernelGGL(fwd, dim3(grid), dim3(512), LDS_BYTES, stream, a); }
#endif
}
```

```cpp
#include <hip/hip_runtime.h>
#include <cstdio>
#include <cstdint>
__device__ __forceinline__ int otid() { int t = threadIdx.x; asm volatile("" : "+v"(t)); return t; }
__device__ __forceinline__ int obid() { int t = blockIdx.x; asm volatile("" : "+s"(t)); return t; }
namespace pg8 {
#define PG8_LAS __attribute__((address_space(3)))
typedef unsigned short bf16_t;
typedef short bf16x8 __attribute__((ext_vector_type(8)));
typedef float f32x4 __attribute__((ext_vector_type(4)));
typedef unsigned u32x4 __attribute__((ext_vector_type(4)));
constexpr int BM = 256, BK = 64, HALF = 128, HTB = HALF * BK * 2  , STAGE_BYTES = 8 * HTB, NXCD = 8, WGM = 4;

__host__ __device__ __forceinline__ int lds_byte(int r, int c) { const int st = (r >> 4) * 2 + (c >> 5), rr = r & 15, cc = c & 31, ob = rr * 64 + cc * 2; return st * 1024 + (ob ^ (((ob >> 9) & 1) << 5)); }
__host__ __device__ __forceinline__ void stage_rc(int b, int& R, int& C) { const int st = b / 1024, sb = b % 1024, swz = sb ^ (((sb >> 9) & 1) << 5); R = (st >> 1) * 16 + swz / 64; C = (st & 1) * 32 + (swz % 64) / 2; }
__host__ __device__ __forceinline__ int perm32(int rho) { const int n = rho >> 4, i = rho & 15; return 8 * (i >> 2) + 4 * n + (i & 3); }

struct Unit { int pm, pn, pb; };
struct Gemm { const bf16_t* A; const bf16_t* Bt; int M, N, K; int lda; int f8sw, f8sx; };

struct StaticOrder {
    int nM, nN, nwg, G, c, full = 1 << 30, skip = 0;
    __host__ __device__ void init(int M, int N, int G_, int c_) { nM = M / BM; nN = N / BM; nwg = nM * nN; G = G_; c = c_; }
    __host__ __device__ bool next(int i, Unit& u) const {
        long L; if (i < full) L = (long)i * G + c; else { if (c < skip) return false; L = (long)full * G + (long)(i - full) * (G - skip) + (c - skip); }
        if (L >= nwg) return false;
        int wgid = (int)L; { const int q = nwg / NXCD, r = nwg % NXCD, xcd = wgid % NXCD, off = wgid / NXCD; wgid = (xcd < r ? xcd * (q + 1) : r * (q + 1) + (xcd - r) * q) + off; }
        const int nig = WGM * nN, gid = wgid / nig, fm = gid * WGM, gsz = (nM - fm) < WGM ? (nM - fm) : WGM;
        u.pm = fm + ((wgid % nig) % gsz); u.pn = (wgid % nig) / gsz; u.pb = 0; return true;
    }
    __device__ __forceinline__ size_t a_off(const Unit&) const { return 0; }
    __device__ __forceinline__ size_t b_off(const Unit&) const { return 0; }
    __device__ __forceinline__ void a_ready(const Unit&) const {}
    __device__ __forceinline__ void done(const Unit&) const {}
};

struct BranchOrder : StaticOrder {
    int NB; size_t a_stride, b_stride;
    __device__ bool next(int i, Unit& u) const { const int ti = i / NB; if (!StaticOrder::next(ti, u)) return false; u.pb = i - ti * NB; return true; }
    __device__ __forceinline__ size_t a_off(const Unit& u) const { return (size_t)u.pb * a_stride; }
    __device__ __forceinline__ size_t b_off(const Unit& u) const { return (size_t)u.pb * b_stride; }
};

__device__ __forceinline__ unsigned cvt_pk_bf16(float lo, float hi) { unsigned r; asm("v_cvt_pk_bf16_f32 %0, %1, %2" : "=v"(r) : "v"(lo), "v"(hi)); return r; }
__device__ __forceinline__ float gelu_tanh_f(float x) { const float u2 = 1.5957691216057308f * (x + 0.044715f * x * x * x); return x * __builtin_amdgcn_rcpf(1.f + __expf(-u2)); }
struct EpiProj {
    static constexpr bool PERM = true, AFTER_DRAIN = false;
    bf16_t* O; int ldc; float* SSQ; int mrows; int pn0; unsigned char* C8;
    __device__ __forceinline__ void operator()(const f32x4 (&acc)[2][2][4][2], const Unit& u, int wr, int wc, int fr, int fq) const {
        const int row0 = u.pm * BM + wr * 64 + fr, col0 = u.pn * BM + wc * 32 + 8 * fq;
        const int apn = u.pn + pn0;
        const int seg = !SSQ ? -1 : ((apn == 25 || apn == 26) ? 0 : ((apn == 27 || apn == 28) ? 1 : ((apn >= 4 && apn < 8) ? 2 : -1)));
#pragma unroll
        for (int ai = 0; ai < 2; ++ai)
#pragma unroll
            for (int m = 0; m < 4; ++m) { const int row = row0 + ai * HALF + m * 16; bf16_t* rowp = O + (size_t)row * ldc + col0;
                float ss = 0.f;
#pragma unroll
                for (int bj = 0; bj < 2; ++bj) { const f32x4 v0 = acc[ai][bj][m][0], v1 = acc[ai][bj][m][1];
                    u32x4 w; w.x = cvt_pk_bf16(v0[0], v0[1]); w.y = cvt_pk_bf16(v0[2], v0[3]); w.z = cvt_pk_bf16(v1[0], v1[1]); w.w = cvt_pk_bf16(v1[2], v1[3]);
                    *(u32x4*)(rowp + bj * HALF) = w;
                    if (C8 && seg >= 0 && seg < 2) { unsigned q0 = 0u, q1 = 0u;
                        q0 = __builtin_amdgcn_cvt_pk_fp8_f32(v0[0], v0[1], q0, false); q0 = __builtin_amdgcn_cvt_pk_fp8_f32(v0[2], v0[3], q0, true);
                        q1 = __builtin_amdgcn_cvt_pk_fp8_f32(v1[0], v1[1], q1, false); q1 = __builtin_amdgcn_cvt_pk_fp8_f32(v1[2], v1[3], q1, true);
                        typedef unsigned u32x2e __attribute__((ext_vector_type(2)));
                        *(u32x2e*)(C8 + (size_t)row * 1024 + (apn - 25) * 256 + wc * 32 + 8 * fq + bj * HALF) = (u32x2e){q0, q1}; }
                    if (seg >= 0) {
#pragma unroll
                        for (int j = 0; j < 4; ++j) { float a = v0[j], b = v1[j]; if (seg == 2) { a = gelu_tanh_f(a); b = gelu_tanh_f(b); } ss += a * a + b * b; } } }
                if (seg >= 0) {
                    ss += __uint_as_float((unsigned)__builtin_amdgcn_ds_swizzle((int)__float_as_uint(ss), (16 << 10) | 0x1f));
                    auto rr = __builtin_amdgcn_permlane32_swap(__float_as_uint(ss), __float_as_uint(ss), false, false);
                    ss = __uint_as_float(rr[0]) + __uint_as_float(rr[1]);
                    if (fq == 0) atomicAdd(SSQ + (size_t)seg * mrows + row, ss); } }
    }
};
struct EpiBf16Row {
    static constexpr bool PERM = true, AFTER_DRAIN = false;
    bf16_t* O; int ldc; const float* SSQ; float inv_n, eps;
    __device__ __forceinline__ void operator()(const f32x4 (&acc)[2][2][4][2], const Unit& u, int wr, int wc, int fr, int fq) const {
        const int row0 = u.pm * BM + wr * 64 + fr, col0 = u.pn * BM + wc * 32 + 8 * fq;
        float sq[2][4];
#pragma unroll
        for (int ai = 0; ai < 2; ++ai)
#pragma unroll
            for (int m = 0; m < 4; ++m) sq[ai][m] = SSQ[row0 + ai * HALF + m * 16];
#pragma unroll
        for (int ai = 0; ai < 2; ++ai)
#pragma unroll
            for (int m = 0; m < 4; ++m) { const int row = row0 + ai * HALF + m * 16; bf16_t* rowp = O + (size_t)row * ldc + col0;
                const float rn = 1.0f / sqrtf(sq[ai][m] * inv_n + eps);
#pragma unroll
                for (int bj = 0; bj < 2; ++bj) { const f32x4 v0 = acc[ai][bj][m][0] * rn, v1 = acc[ai][bj][m][1] * rn;
                    u32x4 w; w.x = cvt_pk_bf16(v0[0], v0[1]); w.y = cvt_pk_bf16(v0[2], v0[3]); w.z = cvt_pk_bf16(v1[0], v1[1]); w.w = cvt_pk_bf16(v1[2], v1[3]);
                    *(u32x4*)(rowp + bj * HALF) = w; } }
    }
};
struct EpiRes {
    static constexpr bool PERM = false, AFTER_DRAIN = false;
    const float* base; float* C; int ldc;
    __device__ __forceinline__ void operator()(const f32x4 (&acc)[2][2][4][2], const Unit& u, int wr, int wc, int fr, int fq) const {
        const int row0 = u.pm * BM + wr * 64 + fr, col0 = u.pn * BM + wc * 32 + 4 * fq;
#pragma unroll
        for (int ai = 0; ai < 2; ++ai) {
            f32x4 bs[4][2][2];
#pragma unroll
            for (int m = 0; m < 4; ++m) { const size_t off = (size_t)(row0 + ai * HALF + m * 16) * ldc + col0;
#pragma unroll
                for (int bj = 0; bj < 2; ++bj)
#pragma unroll
                    for (int n = 0; n < 2; ++n) bs[m][bj][n] = *(const f32x4*)(base + off + bj * HALF + n * 16); }
#pragma unroll
            for (int m = 0; m < 4; ++m) { const size_t off = (size_t)(row0 + ai * HALF + m * 16) * ldc + col0;
#pragma unroll
                for (int bj = 0; bj < 2; ++bj)
#pragma unroll
                    for (int n = 0; n < 2; ++n) *(f32x4*)(C + off + bj * HALF + n * 16) = acc[ai][bj][m][n] + bs[m][bj][n]; }
            asm volatile("" ::: "memory");
        }
    }
};
struct EpiMerge {
    static constexpr bool PERM = true, AFTER_DRAIN = false;
    const bf16_t* G0; int ldg; bf16_t* MG; int ldc; int gstride; int pb0;
    __device__ __forceinline__ void operator()(const f32x4 (&acc)[2][2][4][2], const Unit& u, int wr, int wc, int fr, int fq) const {
        const int row0 = u.pm * BM + wr * 64 + fr, col0 = u.pn * BM + wc * 32 + 8 * fq; const int branch = u.pb + pb0; const bf16_t* G = G0 + (size_t)branch * gstride; const bool first = branch == 0;
#pragma unroll
        for (int ai = 0; ai < 2; ++ai) {
            u32x4 gw[4][2], ow[4][2];
#pragma unroll
            for (int m = 0; m < 4; ++m) { const size_t row = (size_t)(row0 + ai * HALF + m * 16);
#pragma unroll
                for (int bj = 0; bj < 2; ++bj) { gw[m][bj] = *(const u32x4*)(G + row * ldg + col0 + bj * HALF); ow[m][bj] = first ? (u32x4){0u, 0u, 0u, 0u} : *(const u32x4*)(MG + row * ldc + col0 + bj * HALF); } }
#pragma unroll
            for (int m = 0; m < 4; ++m) { const size_t row = (size_t)(row0 + ai * HALF + m * 16);
#pragma unroll
                for (int bj = 0; bj < 2; ++bj) { const f32x4 v0 = acc[ai][bj][m][0], v1 = acc[ai][bj][m][1];
                    const unsigned g4[4] = {gw[m][bj].x, gw[m][bj].y, gw[m][bj].z, gw[m][bj].w}, o4[4] = {ow[m][bj].x, ow[m][bj].y, ow[m][bj].z, ow[m][bj].w};
                    const float a8[8] = {v0[0], v0[1], v0[2], v0[3], v1[0], v1[1], v1[2], v1[3]};
                    unsigned w4[4];
#pragma unroll
                    for (int q = 0; q < 4; ++q) {
                        const float g0 = __uint_as_float(g4[q] << 16), g1 = __uint_as_float(g4[q] & 0xffff0000u);
                        const float r0 = __uint_as_float(o4[q] << 16) + a8[2 * q] * __builtin_amdgcn_rcpf(1.0f + __expf(-g0));
                        const float r1 = __uint_as_float(o4[q] & 0xffff0000u) + a8[2 * q + 1] * __builtin_amdgcn_rcpf(1.0f + __expf(-g1));
                        unsigned pk; asm("v_cvt_pk_bf16_f32 %0, %1, %2" : "=v"(pk) : "v"(r0), "v"(r1)); w4[q] = pk; }
                    *(u32x4*)(MG + row * ldc + col0 + bj * HALF) = (u32x4){w4[0], w4[1], w4[2], w4[3]}; } }
            asm volatile("" ::: "memory");
        }
    }
};

typedef int pg8_v8i __attribute__((ext_vector_type(8)));
typedef int pg8_v4i __attribute__((ext_vector_type(4)));
template <class Epi, class Sched, bool STAMP = false, bool ALIGN_EPI = false, bool SP2 = false, bool FP8 = false>
__device__ __forceinline__ void gemm_phase(PG8_LAS unsigned char* lds, const Gemm g, const Sched& S, const Epi& E, unsigned long long* stamps) {
    const int tid = otid(), wid = __builtin_amdgcn_readfirstlane(tid >> 6), lane = tid & 63, wr = wid >> 2, wc = wid & 3, fr = lane & 15, fq = lane >> 4;
    const int K = g.K, nt = K / BK, LDA = g.lda ? g.lda : g.K;
    int ts_lo = 0, ts_hi = 0, nts = 0; const unsigned long long rt_entry = STAMP ? (unsigned long long)wall_clock64() : 0ull;
#define PG8_STAMP() do { if (STAMP && wid == 0 && nts < 64) { const unsigned long long _c = (unsigned long long)clock64(); \
        ts_lo = (lane == nts) ? (int)(unsigned)_c : ts_lo; ts_hi = (lane == nts) ? (int)(unsigned)(_c >> 32) : ts_hi; ++nts; } } while (0)
    PG8_STAMP();
    unsigned voffA[2], voffB[2];
#pragma unroll
    for (int i = 0; i < 2; ++i) { int R, C; stage_rc(tid * 16 + i * 8192, R, C); const int Rb = Epi::PERM ? ((R & ~31) + perm32(R & 31)) : R;
        voffA[i] = (unsigned)(R * LDA + C) * 2u; voffB[i] = (unsigned)(Rb * K + C) * 2u; }
    const size_t kstep = (size_t)(BK * 2);
    const size_t hstepB = (size_t)HALF * K * 2, hstepA = (size_t)HALF * LDA * 2;
    const size_t tstepB = 2 * hstepB, tstepA = 2 * hstepA;
    const unsigned ldsw = (unsigned)wid * 1024u;
    const int aoff = lds_byte(wr * 64 + fr, fq * 8), boff = lds_byte(wc * 32 + fr, fq * 8);
#define PG8_SA(b, h) (((b) * 2 + (h)) * HTB)
#define PG8_SB(b, h) ((4 + (b) * 2 + (h)) * HTB)
#define PG8_STAGE(bufoff, gbase, voff) do { _Pragma("unroll") for (int _i = 0; _i < 2; ++_i) \
        __builtin_amdgcn_global_load_lds((const unsigned*)((const char*)(gbase) + (voff)[_i]), (PG8_LAS unsigned*)(lds + (bufoff) + ldsw + _i * 8192), 16, 0, 0); } while (0)
#define PG8_I4(p) (*(const PG8_LAS pg8_v4i*)(p))
#define PG8_LDA(dst, b, h) do { if constexpr (FP8) { _Pragma("unroll") for (int m = 0; m < 4; ++m) dst##8[m] = __builtin_shufflevector(PG8_I4(lds + PG8_SA(b, h) + aoff + m * 2048), PG8_I4(lds + PG8_SA(b, h) + aoff + m * 2048 + 1024), 0, 1, 2, 3, 4, 5, 6, 7); } \
        else { _Pragma("unroll") for (int m = 0; m < 4; ++m) _Pragma("unroll") for (int k = 0; k < 2; ++k) dst[m][k] = *(const PG8_LAS bf16x8*)(lds + PG8_SA(b, h) + aoff + m * 2048 + k * 1024); } } while (0)
#define PG8_LDB(dst, b, h) do { if constexpr (FP8) { _Pragma("unroll") for (int n = 0; n < 2; ++n) dst##8[n] = __builtin_shufflevector(PG8_I4(lds + PG8_SB(b, h) + boff + n * 2048), PG8_I4(lds + PG8_SB(b, h) + boff + n * 2048 + 1024), 0, 1, 2, 3, 4, 5, 6, 7); } \
        else { _Pragma("unroll") for (int n = 0; n < 2; ++n) _Pragma("unroll") for (int k = 0; k < 2; ++k) dst[n][k] = *(const PG8_LAS bf16x8*)(lds + PG8_SB(b, h) + boff + n * 2048 + k * 1024); } } while (0)
#define PG8_MMA_BF(ai, bj, At, Bt) do { __builtin_amdgcn_s_setprio(1); _Pragma("unroll") for (int m = 0; m < 4; ++m) _Pragma("unroll") for (int n = 0; n < 2; ++n) _Pragma("unroll") for (int k = 0; k < 2; ++k) \
        acc[ai][bj][m][n] = __builtin_amdgcn_mfma_f32_16x16x32_bf16(Bt[n][k], At[m][k], acc[ai][bj][m][n], 0, 0, 0); __builtin_amdgcn_s_setprio(0); } while (0)
#define PG8_MMA_F8(ai, bj, At, Bt) do { __builtin_amdgcn_s_setprio(1); _Pragma("unroll") for (int m = 0; m < 4; ++m) _Pragma("unroll") for (int n = 0; n < 2; ++n) \
        asm volatile("v_mfma_scale_f32_16x16x128_f8f6f4 %0, %1, %2, %0, %3, %4 op_sel_hi:[0,0,0]" : "+v"(acc[ai][bj][m][n]) : "v"(Bt##8[n]), "v"(At##8[m]), "v"(f8_scale_w), "v"(f8_scale_x)); \
        __builtin_amdgcn_s_setprio(0); } while (0)
#define PG8_F8_DRAIN() do { if constexpr (FP8) asm volatile("s_nop 15\n\ts_nop 15" ::: "memory"); } while (0)
#define PG8_MMA(ai, bj, At, Bt) do { if constexpr (FP8) PG8_MMA_F8(ai, bj, At, Bt); else PG8_MMA_BF(ai, bj, At, Bt); } while (0)
#define PG8_WAIT_V(n) asm volatile("s_waitcnt vmcnt(" #n ")" ::: "memory")
#define PG8_WAIT_L(n) asm volatile("s_waitcnt lgkmcnt(" #n ")" ::: "memory")
#define PG8_BAR __builtin_amdgcn_s_barrier()
#define PG8_SCHED __builtin_amdgcn_sched_barrier(0)
    Unit cur, nxt; int ui = 0;
    if (!S.next(0, cur)) return;
    f32x4 acc[2][2][4][2];
#pragma unroll
    for (int a = 0; a < 2; ++a)
#pragma unroll
        for (int b = 0; b < 2; ++b)
#pragma unroll
            for (int m = 0; m < 4; ++m)
#pragma unroll
                for (int n = 0; n < 2; ++n) acc[a][b][m][n] = (f32x4){0.f, 0.f, 0.f, 0.f};
    int f8_scale_w = g.f8sw ? g.f8sw : 0x79797979, f8_scale_x = g.f8sx ? g.f8sx : 0x7f7f7f7f; (void)f8_scale_w; (void)f8_scale_x;
    bf16x8 At[4][2], B0[2][2], B1[2][2]; pg8_v8i At8[4], B08[2], B18[2];
    (void)At; (void)B0; (void)B1; (void)At8; (void)B08; (void)B18;
    const char* cA = (const char*)g.A + (size_t)cur.pm * tstepA + S.a_off(cur); const char* cB = (const char*)g.Bt + (size_t)cur.pn * tstepB + S.b_off(cur);
    S.a_ready(cur);
    if constexpr (SP2) {
        PG8_STAGE(PG8_SB(0, 0), cB, voffB); PG8_STAGE(PG8_SB(0, 1), cB + hstepB, voffB); PG8_STAGE(PG8_SA(0, 0), cA, voffA); PG8_STAGE(PG8_SA(0, 1), cA + hstepA, voffA);
        if (wr == 1) PG8_BAR;
        PG8_WAIT_V(2); PG8_BAR;
        PG8_STAGE(PG8_SB(1, 0), cB + kstep, voffB); PG8_STAGE(PG8_SA(1, 0), cA + kstep, voffA); PG8_STAGE(PG8_SB(1, 1), cB + hstepB + kstep, voffB);
        PG8_WAIT_V(6); PG8_BAR;
    } else {
    PG8_STAGE(PG8_SB(0, 0), cB, voffB); PG8_STAGE(PG8_SA(0, 0), cA, voffA); PG8_STAGE(PG8_SB(0, 1), cB + hstepB, voffB); PG8_STAGE(PG8_SA(0, 1), cA + hstepA, voffA);
    if (wr == 1) PG8_BAR;
    PG8_WAIT_V(4); PG8_BAR;
    PG8_STAGE(PG8_SB(1, 0), cB + kstep, voffB); PG8_STAGE(PG8_SA(1, 0), cA + kstep, voffA); PG8_STAGE(PG8_SB(1, 1), cB + hstepB + kstep, voffB);
    PG8_WAIT_V(6); PG8_BAR;
    }
    PG8_STAMP();
    for (;;) {
        const bool has_next = S.next(ui + 1, nxt);
        const char* nA = has_next ? (const char*)g.A + (size_t)nxt.pm * tstepA + S.a_off(nxt) : cA; const char* nB = has_next ? (const char*)g.Bt + (size_t)nxt.pn * tstepB + S.b_off(nxt) : cB;
        for (int t = 0; t < nt; t += 2) {
            const bool last = (t == nt - 2);
            const char* a1 = cA + (size_t)(t + 1) * kstep;
            const char* a2 = last ? nA : cA + (size_t)(t + 2) * kstep; const char* b2 = last ? nB : cB + (size_t)(t + 2) * kstep;
            const char* a3 = a2 + kstep; const char* b3 = b2 + kstep;
            if (last && has_next) S.a_ready(nxt);
            if constexpr (SP2) {
            PG8_LDB(B0, 0, 0); PG8_LDB(B1, 0, 1); PG8_SCHED; PG8_LDA(At, 0, 0); PG8_STAGE(PG8_SA(1, 1), a1 + hstepA, voffA);
            PG8_WAIT_V(8); PG8_WAIT_L(0); PG8_BAR; PG8_MMA(0, 0, At, B0); PG8_MMA(0, 1, At, B1); PG8_BAR; PG8_SCHED;
            PG8_LDA(At, 0, 1); PG8_STAGE(PG8_SB(0, 0), b2, voffB); PG8_STAGE(PG8_SB(0, 1), b2 + hstepB, voffB); PG8_STAGE(PG8_SA(0, 0), a2, voffA);
            PG8_WAIT_V(8); PG8_WAIT_L(0); PG8_BAR; PG8_MMA(1, 0, At, B0); PG8_MMA(1, 1, At, B1); PG8_BAR; PG8_SCHED;
            PG8_LDB(B0, 1, 0); PG8_LDB(B1, 1, 1); PG8_SCHED; PG8_LDA(At, 1, 0); PG8_STAGE(PG8_SA(0, 1), a2 + hstepA, voffA);
            PG8_WAIT_V(8); PG8_WAIT_L(0); PG8_BAR; PG8_MMA(0, 0, At, B0); PG8_MMA(0, 1, At, B1); PG8_BAR; PG8_SCHED;
            PG8_LDA(At, 1, 1); PG8_STAGE(PG8_SB(1, 0), b3, voffB); PG8_STAGE(PG8_SB(1, 1), b3 + hstepB, voffB); PG8_STAGE(PG8_SA(1, 0), a3, voffA);
            PG8_WAIT_V(8); PG8_WAIT_L(0); PG8_BAR; PG8_MMA(1, 0, At, B0); PG8_MMA(1, 1, At, B1); PG8_BAR; PG8_SCHED;
            } else {
            PG8_LDB(B0, 0, 0); PG8_SCHED; PG8_LDA(At, 0, 0); PG8_STAGE(PG8_SA(1, 1), a1 + hstepA, voffA);
            PG8_WAIT_L(8); PG8_BAR; PG8_WAIT_L(0); PG8_MMA(0, 0, At, B0); PG8_BAR; PG8_SCHED;
            PG8_LDB(B1, 0, 1); PG8_STAGE(PG8_SB(0, 0), b2, voffB);
            PG8_BAR; PG8_WAIT_L(0); PG8_MMA(0, 1, At, B1); PG8_BAR;
            PG8_LDA(At, 0, 1); PG8_STAGE(PG8_SA(0, 0), a2, voffA);
            PG8_BAR; PG8_WAIT_L(0); PG8_MMA(1, 0, At, B0); PG8_BAR; PG8_SCHED;
            PG8_STAGE(PG8_SB(0, 1), b2 + hstepB, voffB);
            PG8_WAIT_V(6); PG8_BAR; PG8_MMA(1, 1, At, B1); PG8_BAR;
            PG8_LDB(B0, 1, 0); PG8_SCHED; PG8_LDA(At, 1, 0); PG8_STAGE(PG8_SA(0, 1), a2 + hstepA, voffA);
            PG8_WAIT_L(8); PG8_BAR; PG8_WAIT_L(0); PG8_MMA(0, 0, At, B0); PG8_BAR; PG8_SCHED;
            PG8_LDB(B1, 1, 1); PG8_STAGE(PG8_SB(1, 0), b3, voffB);
            PG8_BAR; PG8_WAIT_L(0); PG8_MMA(0, 1, At, B1); PG8_BAR;
            PG8_LDA(At, 1, 1); PG8_STAGE(PG8_SA(1, 0), a3, voffA);
            PG8_BAR; PG8_WAIT_L(0); PG8_MMA(1, 0, At, B0); PG8_BAR; PG8_SCHED;
            PG8_STAGE(PG8_SB(1, 1), b3 + hstepB, voffB);
            PG8_WAIT_V(6); PG8_BAR; PG8_MMA(1, 1, At, B1); PG8_BAR;
            }
        }
        if constexpr (ALIGN_EPI) { if (wr == 0) PG8_BAR; }
        PG8_STAMP();
        PG8_F8_DRAIN();
        if constexpr (!Epi::AFTER_DRAIN) { E(acc, cur, wr, wc, fr, fq); S.done(cur); }
        PG8_STAMP();
        if (!has_next) break;
#pragma unroll
        for (int a = 0; a < 2; ++a)
#pragma unroll
            for (int b = 0; b < 2; ++b)
#pragma unroll
                for (int m = 0; m < 4; ++m)
#pragma unroll
                    for (int n = 0; n < 2; ++n) acc[a][b][m][n] = (f32x4){0.f, 0.f, 0.f, 0.f};
        cur = nxt; cA = nA; cB = nB; ++ui;
        if constexpr (ALIGN_EPI) { if (wr == 1) PG8_BAR; }
    }
    PG8_WAIT_V(0);
    if constexpr (!ALIGN_EPI) { if (wr == 0) PG8_BAR; }
    PG8_BAR;
    if constexpr (Epi::AFTER_DRAIN) { E.fused(acc, cur, wr, wc, fr, fq, lds, wid, lane); S.done(cur); }
    PG8_STAMP();
    if (STAMP && wid == 0) { stamps[lane] = lane < nts ? (((unsigned long long)(unsigned)ts_hi << 32) | (unsigned)ts_lo) : 0ull;
        if (lane == 62) stamps[62] = rt_entry; if (lane == 63) stamps[63] = (unsigned long long)wall_clock64(); }
#undef PG8_STAMP
#undef PG8_SA
#undef PG8_SB
#undef PG8_STAGE
#undef PG8_LDA
#undef PG8_LDB
#undef PG8_MMA
#undef PG8_MMA_BF
#undef PG8_MMA_F8
#undef PG8_I4
#undef PG8_F8_DRAIN
#undef PG8_WAIT_V
#undef PG8_WAIT_L
#undef PG8_BAR
#undef PG8_SCHED
}
}
#define XB_TMO      128
#define XB_XCNT(j)  (256  + 64 * (j))
#define XB_XSUB(j)  (1280 + 64 * (j))
#define XB_XGEN(j)  (2304 + 64 * (j))
#define XB_TOP      3328
#define XB_TOPGEN   3392
#define XCD_BAR_WORDS 3456
#define XB_SPIN_CAP (1u << 18)
#define LAS __attribute__((address_space(3)))

__device__ __forceinline__ unsigned xb_ld(unsigned* p)              { return __hip_atomic_load(p, __ATOMIC_RELAXED, __HIP_MEMORY_SCOPE_AGENT); }
__device__ __forceinline__ unsigned xb_add(unsigned* p, unsigned v) { return __hip_atomic_fetch_add(p, v, __ATOMIC_RELAXED, __HIP_MEMORY_SCOPE_AGENT); }
__device__ __forceinline__ unsigned xb_xcc_id() { return (unsigned)__builtin_amdgcn_s_getreg((3 << 11) | 20) & 0xFu; }
#define XB_SPIN(cond, bar) do { unsigned _sp = 0; while (cond) { __builtin_amdgcn_s_sleep(1); \
    if ((++_sp & 255u) == 0u) { if (xb_ld(&(bar)[XB_TMO])) break; if (_sp > XB_SPIN_CAP) { atomicAdd(&(bar)[XB_TMO], 1u); break; } } } } while (0)

struct XcdBarrier {
    unsigned* bar; unsigned x;
    volatile LAS unsigned* st;
};

__device__ __forceinline__ XcdBarrier xcd_barrier_post(unsigned* bar, volatile LAS unsigned* st) {
    XcdBarrier b; b.bar = bar; b.x = xb_xcc_id(); b.st = st;
    if (threadIdx.x == 0) (void)xb_add(&bar[XB_XCNT(b.x)], 1u);
    return b;
}
__device__ __forceinline__ void xcd_barrier_complete(unsigned* bar, unsigned x, unsigned& nloc, unsigned& nx) {
    const unsigned G = gridDim.x * gridDim.y * gridDim.z;
    unsigned sum, cnt, mine, sp = 0u;
    for (;;) {
        sum = 0u; cnt = 0u; mine = 0u;
#pragma unroll
        for (unsigned j = 0; j < 16; ++j) { const unsigned c = xb_ld(&bar[XB_XCNT(j)]); sum += c; cnt += (c > 0u) ? 1u : 0u; mine = (j == x) ? c : mine; }
        if (sum == G) break;
        __builtin_amdgcn_s_sleep(1);
        if ((++sp & 255u) == 0u) { if (xb_ld(&bar[XB_TMO])) break; if (sp > XB_SPIN_CAP) { atomicAdd(&bar[XB_TMO], 1u); break; } }
    }
    nloc = mine > 0u ? mine : 1u; nx = cnt > 0u ? cnt : 1u;
}

__device__ __forceinline__ void xcd_barrier(const XcdBarrier& b) {
    asm volatile("s_waitcnt vmcnt(0)" ::: "memory");
    __syncthreads();
    if (threadIdx.x == 0) {
        unsigned* bar = b.bar;
        __builtin_amdgcn_s_waitcnt(0);
        unsigned nloc = b.st[0], nx = b.st[1];
        if (nloc == 0u) { xcd_barrier_complete(bar, b.x, nloc, nx); b.st[0] = nloc; b.st[1] = nx; }
        const unsigned old = xb_add(&bar[XB_XSUB(b.x)], 1u);
        const unsigned gen = old / nloc;
        if (old + 1u == (gen + 1u) * nloc) {
            __builtin_amdgcn_fence(__ATOMIC_RELEASE, "agent");
            asm volatile("s_waitcnt vmcnt(0)" ::: "memory");
            const unsigned og = xb_add(&bar[XB_TOP], 1u);
            const unsigned tg = og / nx;
            if (og + 1u == (tg + 1u) * nx) xb_add(&bar[XB_TOPGEN], 1u);
            else XB_SPIN(xb_ld(&bar[XB_TOPGEN]) == tg, bar);
            __builtin_amdgcn_fence(__ATOMIC_ACQUIRE, "agent");
            xb_add(&bar[XB_XGEN(b.x)], 1u);
            asm volatile("s_waitcnt vmcnt(0)" ::: "memory");
        } else {
            XB_SPIN(xb_ld(&bar[XB_XGEN(b.x)]) == gen, bar);
            __builtin_amdgcn_fence(__ATOMIC_ACQUIRE, "agent");
            asm volatile("s_waitcnt vmcnt(0)" ::: "memory");
        }
    }
    __syncthreads();
}


typedef unsigned short bf16;
typedef unsigned v4u __attribute__((ext_vector_type(4)));
typedef unsigned v2u __attribute__((ext_vector_type(2)));
typedef float v4f __attribute__((ext_vector_type(4)));
typedef float v2f __attribute__((ext_vector_type(2)));

constexpr int DM = 2048, NBATCH = 8, SEQ = 4096, DEPTH = 2, MTOK = NBATCH * SEQ;
constexpr int IN_COLS = 14416, NPROJ = 14592;
constexpr int C_UB = 0, C_VB = 1024, C_ZB = 2048, C_QC = 3072, C_KC = 3584, C_VC = 4096, C_ZC = 5120, C_KROPE = 6144, C_AR = 6208,
              C_CQ = 6400, C_CKV = 6912, C_ZA = 7424, C_GATE = 8448;
constexpr int NBF = C_CQ, NF8 = NPROJ - NBF;
constexpr float EPS = 1e-6f;
#ifndef NBP
#define NBP 4
#endif
constexpr int MP = NBP * SEQ, NPASS = NBATCH / NBP;
constexpr int STEPS_PER_PASS = 7;
constexpr int NSTEPS = DEPTH * (1 + NPASS * STEPS_PER_PASS);

constexpr size_t al256(size_t x) { return (x + 255) & ~(size_t)255; }
constexpr size_t WS_CTL = 0, CTL_BYTES = 1u << 20;
constexpr size_t SZ_WINB = (size_t)NBF * DM * 2  , SZ_WIN = SZ_WINB + (size_t)NF8 * DM  , SZ_WUQ = (size_t)1536 * 512 * 2, SZ_WUKV = (size_t)2048 * 512 * 2, SZ_WB = (size_t)3 * 2048 * 1024 * 2, SZ_WO = (size_t)2048 * 2048 * 2;
constexpr size_t SZ_WLAYER = SZ_WIN + SZ_WUQ + SZ_WUKV + SZ_WB + SZ_WO;
constexpr size_t WS_W = CTL_BYTES;
constexpr size_t WS_COS = WS_W + SZ_WLAYER, WS_SIN = WS_COS + (size_t)MTOK * 32 * 4;
constexpr size_t WS_H = WS_SIN + (size_t)MTOK * 32 * 4;
constexpr size_t WS_MG = WS_H;
constexpr size_t WS_PROJ = WS_H + (size_t)MP * DM * 2;
constexpr size_t WS_XB = WS_PROJ + (size_t)MP * NPROJ * 2;
constexpr size_t WS_SSQ = WS_XB + (size_t)MP * 2048;
constexpr size_t WS_Q = WS_SSQ + al256((size_t)3 * MP * 4);
constexpr size_t WS_KV = WS_Q + (size_t)MP * 1536 * 2;
constexpr size_t WS_K = WS_KV + (size_t)MP * 2048 * 2;
constexpr size_t WS_YA = WS_K + (size_t)MP * 1536 * 2;
constexpr size_t WS_YB = WS_YA + (size_t)MP * 1024 * 2;
constexpr size_t WS_DL = WS_YA;
constexpr size_t WS_YC = WS_YB + (size_t)MP * 1024 * 2;
constexpr size_t WS_OC = WS_YC + (size_t)MP * 1024 * 2;
constexpr size_t WS_QE = WS_OC + (size_t)MP * 1024 * 4;
constexpr size_t WS_KE = WS_QE + (size_t)MP * 512 * 2, WS_KL = WS_KE + (size_t)MP * 512 * 2;
constexpr size_t WS_H8 = WS_KE;
constexpr size_t WS_DS = WS_KL + (size_t)MP * 512 * 2;
constexpr size_t WS_END = WS_DS + (size_t)(MP / 128) * 512 * 4;
static_assert(WS_END <= ((size_t)1 << 30), "workspace map exceeds 1 GiB");

constexpr int LDS_BYTES = 147456;
constexpr int LDSCTL_OFF = LDS_BYTES - 256;
constexpr int CW_BAR = 4096;

__device__ __forceinline__ float bf2f(unsigned v) { return __uint_as_float(v << 16); }
__device__ __forceinline__ unsigned f2bf(float f) { unsigned u = __float_as_uint(f); return (u + 0x7fffu + ((u >> 16) & 1u)) >> 16; }
__device__ __forceinline__ unsigned pk2(float lo, float hi) { return f2bf(lo) | (f2bf(hi) << 16); }
__device__ __forceinline__ float lo16(unsigned w) { return __uint_as_float(w << 16); }
__device__ __forceinline__ float hi16(unsigned w) { return __uint_as_float(w & 0xffff0000u); }
__device__ __forceinline__ float sigmoid_f(float x) { return 1.f / (1.f + __expf(-x)); }
__device__ __forceinline__ float silu_f(float x) { return x / (1.f + __expf(-x)); }
__device__ __forceinline__ float gelu_f(float x) { const float u2 = 1.5957691216057308f * (x + 0.044715f * x * x * x); return x * __builtin_amdgcn_rcpf(1.f + __expf(-u2)); }
template <int O> __device__ __forceinline__ float lane_xor(float v) {
    if (O == 1) return __uint_as_float((unsigned)__builtin_amdgcn_mov_dpp((int)__float_as_uint(v), 0xB1, 0xf, 0xf, true));
    if (O == 2) return __uint_as_float((unsigned)__builtin_amdgcn_mov_dpp((int)__float_as_uint(v), 0x4E, 0xf, 0xf, true));
    return __uint_as_float((unsigned)__builtin_amdgcn_ds_swizzle((int)__float_as_uint(v), (O << 10) | 0x1f)); }
__device__ __forceinline__ float lane_xor32(float v, int lane) {
    auto rr = __builtin_amdgcn_permlane32_swap(__float_as_uint(v), __float_as_uint(v), false, false);
    return __uint_as_float(lane < 32 ? rr[1] : rr[0]); }
__device__ __forceinline__ float wave_sum(float v) {
    v += lane_xor<1>(v); v += lane_xor<2>(v); v += lane_xor<4>(v); v += lane_xor<8>(v); v += lane_xor<16>(v);
    auto rr = __builtin_amdgcn_permlane32_swap(__float_as_uint(v), __float_as_uint(v), false, false);
    return __uint_as_float(rr[0]) + __uint_as_float(rr[1]); }
__device__ __forceinline__ float wave_max(float v) {
    v = fmaxf(v, lane_xor<1>(v)); v = fmaxf(v, lane_xor<2>(v)); v = fmaxf(v, lane_xor<4>(v)); v = fmaxf(v, lane_xor<8>(v)); v = fmaxf(v, lane_xor<16>(v));
    auto rr = __builtin_amdgcn_permlane32_swap(__float_as_uint(v), __float_as_uint(v), false, false);
    return fmaxf(__uint_as_float(rr[0]), __uint_as_float(rr[1])); }
#define LDS_FENCE() asm volatile("s_waitcnt lgkmcnt(0)" ::: "memory")

struct Args { const void* in[18]; float* out; unsigned char* ws; int lo, hi, pad0, pad1; };

template <int MODE> __device__ __forceinline__ int src_col(int n) {
    if (MODE == 0) return n;
    if (MODE == 2) n += NBF;
    if (n < C_VB) return 2112 + n;
    if (n < C_ZB) return 3136 + (n - C_VB);
    if (n < C_QC) return 4160 + (n - C_ZB);
    if (n < C_KC) return 5184 + (n - C_QC);
    if (n < C_VC) return 5696 + (n - C_KC);
    if (n < C_ZC) return 6208 + (n - C_VC);
    if (n < C_KROPE) return 7248 + (n - C_ZC);
    if (n < C_AR) return 1024 + (n - C_KROPE);
    if (n < C_AR + 16) return 7232 + (n - C_AR);
    if (n < C_CQ) return -1;
    if (n < C_CKV) return n - C_CQ;
    if (n < C_ZA) return 512 + (n - C_CKV);
    if (n < C_GATE) return 1088 + (n - C_ZA);
    return 8272 + (n - C_GATE);
}
template <int MODE> __device__ __forceinline__ void convert_T(const float* W, int K, int Nsrc, bf16* WT, int Ndst, LAS float* tile, int vb, int nvb, const float* kscale = nullptr) {
    const int tid = otid(), ntk = K / 64, ntn = Ndst / 64, ntiles = ntk * ntn;
    for (int t = vb; t < ntiles; t += nvb) {
        const int k0 = (t % ntk) * 64, n0 = (t / ntk) * 64;
        { const int nn = tid & 63, sc = src_col<MODE>(n0 + nn), scc = sc >= 0 ? sc : 0; const float mul = sc >= 0 ? 1.f : 0.f;
          float v[8];
#pragma unroll
          for (int i = 0; i < 8; ++i) v[i] = W[(size_t)(k0 + (tid >> 6) + 8 * i) * Nsrc + scc];
          if (kscale) {
#pragma unroll
              for (int i = 0; i < 8; ++i) v[i] *= kscale[k0 + (tid >> 6) + 8 * i]; }
#pragma unroll
          for (int i = 0; i < 8; ++i) tile[((tid >> 6) + 8 * i) * 65 + nn] = v[i] * mul; }
        __syncthreads();
        { const int nn = tid & 63, kg = tid >> 6;
          const LAS float* tp = tile + (kg * 8) * 65 + nn;
          v4u o; o.x = pk2(tp[0], tp[65]); o.y = pk2(tp[2 * 65], tp[3 * 65]); o.z = pk2(tp[4 * 65], tp[5 * 65]); o.w = pk2(tp[6 * 65], tp[7 * 65]);
          *(v4u*)(WT + (size_t)(n0 + nn) * K + k0 + kg * 8) = o; }
        __syncthreads();
    }
}

template <int MODE> __device__ __forceinline__ void convert_T8(const float* W, int K, int Nsrc, unsigned char* WT, int Ndst, float wscale, LAS float* tile, int vb, int nvb, const float* kscale = nullptr) {
    const int tid = otid(), ntk = K / 64, ntn = Ndst / 64, ntiles = ntk * ntn;
    for (int t = vb; t < ntiles; t += nvb) {
        const int k0 = (t % ntk) * 64, n0 = (t / ntk) * 64;
        { const int nn = tid & 63;
          const int sc = src_col<MODE>(n0 + nn);
#pragma unroll
          for (int i = 0; i < 8; ++i) { const int kk = (tid >> 6) + 8 * i; tile[kk * 65 + nn] = W[(size_t)(k0 + kk) * Nsrc + sc] * wscale; }
          if (kscale) {
#pragma unroll
              for (int i = 0; i < 8; ++i) { const int kk = (tid >> 6) + 8 * i; tile[kk * 65 + nn] *= kscale[k0 + kk]; } } }
        __syncthreads();
        { const int nn = tid & 63, kg = tid >> 6;
          const LAS float* tp = tile + (kg * 8) * 65 + nn;
          unsigned w0 = 0u, w1 = 0u;
          w0 = __builtin_amdgcn_cvt_pk_fp8_f32(tp[0], tp[65], w0, false); w0 = __builtin_amdgcn_cvt_pk_fp8_f32(tp[2 * 65], tp[3 * 65], w0, true);
          w1 = __builtin_amdgcn_cvt_pk_fp8_f32(tp[4 * 65], tp[5 * 65], w1, false); w1 = __builtin_amdgcn_cvt_pk_fp8_f32(tp[6 * 65], tp[7 * 65], w1, true);
          *(v2u*)(WT + (size_t)(n0 + nn) * K + k0 + kg * 8) = (v2u){w0, w1}; }
        __syncthreads();
    }
}

__device__ __forceinline__ void ph_norm(const float* xin, const float* g, bf16* h, unsigned char* h8, int rows, int vb, int nvb) {
    const int tid_ = otid(); const int lane = tid_ & 63, wave = tid_ >> 6;
    for (int r = vb * 8 + wave; r < rows; r += nvb * 8) {
        const v4f* xr = (const v4f*)(xin + (size_t)r * DM);
        v4f v[8]; float ss = 0.f;
#pragma unroll
        for (int j = 0; j < 8; ++j) { v[j] = xr[lane + 64 * j]; ss += v[j].x * v[j].x + v[j].y * v[j].y + v[j].z * v[j].z + v[j].w * v[j].w; }
        ss = wave_sum(ss);
        const float rn = 1.0f / sqrtf(ss * (1.0f / DM) + EPS);
#pragma unroll
        for (int j = 0; j < 8; ++j) { const v4f gg = ((const v4f*)g)[lane + 64 * j];
            const float y0 = v[j].x * rn * gg.x, y1 = v[j].y * rn * gg.y, y2 = v[j].z * rn * gg.z, y3 = v[j].w * rn * gg.w;
            v2u o; o.x = pk2(y0, y1); o.y = pk2(y2, y3);
            *(v2u*)(h + (size_t)r * DM + (lane + 64 * j) * 4) = o;
            unsigned w8 = 0u; w8 = __builtin_amdgcn_cvt_pk_fp8_f32(y0, y1, w8, false); w8 = __builtin_amdgcn_cvt_pk_fp8_f32(y2, y3, w8, true);
            *(unsigned*)(h8 + (size_t)r * DM + (lane + 64 * j) * 4) = w8; }
    }
}
__device__ __forceinline__ float row16_sum(float v) {
    v += __uint_as_float((unsigned)__builtin_amdgcn_mov_dpp((int)__float_as_uint(v), 0xB1, 0xf, 0xf, true));
    v += __uint_as_float((unsigned)__builtin_amdgcn_mov_dpp((int)__float_as_uint(v), 0x4E, 0xf, 0xf, true));
    v += __uint_as_float((unsigned)__builtin_amdgcn_mov_dpp((int)__float_as_uint(v), 0x141, 0xf, 0xf, true));
    v += __uint_as_float((unsigned)__builtin_amdgcn_mov_dpp((int)__float_as_uint(v), 0x140, 0xf, 0xf, true));
    return v; }
__device__ __forceinline__ void ph_kfin(const bf16* kv, const bf16* proj, bf16* K, const float* kg, const float* cosT, const float* sinT, int row0, int vb, int nvb) {
    const int tid_ = otid(); const int lane = tid_ & 63, wave = tid_ >> 6, g16 = lane >> 4, c = lane & 15;
    float gn[8], gr[8];
#pragma unroll
    for (int j = 0; j < 8; ++j) { gn[j] = kg[c * 8 + j]; gr[j] = kg[128 + (c & 7) * 8 + j]; }
    for (int r = vb * 8 + wave; r < MP; r += nvb * 8) {
        const v4u n0 = *(const v4u*)(kv + (size_t)r * 2048 + g16 * 256 + c * 8), n1 = *(const v4u*)(kv + (size_t)r * 2048 + (g16 + 4) * 256 + c * 8);
        const v4u rw = *(const v4u*)(proj + (size_t)r * NPROJ + C_KROPE + (c & 7) * 8);
        const v4f c0 = *(const v4f*)(cosT + (size_t)(row0 + r) * 32 + (c & 3) * 8), c1 = *(const v4f*)(cosT + (size_t)(row0 + r) * 32 + (c & 3) * 8 + 4);
        const v4f s0 = *(const v4f*)(sinT + (size_t)(row0 + r) * 32 + (c & 3) * 8), s1 = *(const v4f*)(sinT + (size_t)(row0 + r) * 32 + (c & 3) * 8 + 4);
        float a[8] = {lo16(n0.x), hi16(n0.x), lo16(n0.y), hi16(n0.y), lo16(n0.z), hi16(n0.z), lo16(n0.w), hi16(n0.w)};
        float b[8] = {lo16(n1.x), hi16(n1.x), lo16(n1.y), hi16(n1.y), lo16(n1.z), hi16(n1.z), lo16(n1.w), hi16(n1.w)};
        float kr[8] = {lo16(rw.x), hi16(rw.x), lo16(rw.y), hi16(rw.y), lo16(rw.z), hi16(rw.z), lo16(rw.w), hi16(rw.w)};
        const float cs[8] = {c0.x, c0.y, c0.z, c0.w, c1.x, c1.y, c1.z, c1.w}, sn[8] = {s0.x, s0.y, s0.z, s0.w, s1.x, s1.y, s1.z, s1.w};
        float sa = 0.f, sb = 0.f, sr = 0.f;
#pragma unroll
        for (int j = 0; j < 8; ++j) { sa += a[j] * a[j]; sb += b[j] * b[j]; sr += kr[j] * kr[j]; }
        if (c >= 8) sr = 0.f;
        sa = row16_sum(sa); sb = row16_sum(sb); sr = row16_sum(sr);
        const float rna = 1.0f / sqrtf((sa + sr) * (1.0f / 192.f) + EPS), rnb = 1.0f / sqrtf((sb + sr) * (1.0f / 192.f) + EPS);
        float R[8];
#pragma unroll
        for (int j = 0; j < 8; ++j) { const float mine = kr[j] * gr[j]; const float oth = lane_xor<4>(mine);
            R[j] = (c & 4) ? mine * cs[j] + oth * sn[j] : mine * cs[j] - oth * sn[j]; }
        bf16* ka = K + ((size_t)r * 8 + g16) * 192; bf16* kb = K + ((size_t)r * 8 + g16 + 4) * 192;
        { v4u o; o.x = pk2(a[0] * rna * gn[0], a[1] * rna * gn[1]); o.y = pk2(a[2] * rna * gn[2], a[3] * rna * gn[3]); o.z = pk2(a[4] * rna * gn[4], a[5] * rna * gn[5]); o.w = pk2(a[6] * rna * gn[6], a[7] * rna * gn[7]); *(v4u*)(ka + c * 8) = o; }
        { v4u o; o.x = pk2(b[0] * rnb * gn[0], b[1] * rnb * gn[1]); o.y = pk2(b[2] * rnb * gn[2], b[3] * rnb * gn[3]); o.z = pk2(b[4] * rnb * gn[4], b[5] * rnb * gn[5]); o.w = pk2(b[6] * rnb * gn[6], b[7] * rnb * gn[7]); *(v4u*)(kb + c * 8) = o; }
        if (c < 8) {
            v4u o; o.x = pk2(R[0] * rna, R[1] * rna); o.y = pk2(R[2] * rna, R[3] * rna); o.z = pk2(R[4] * rna, R[5] * rna); o.w = pk2(R[6] * rna, R[7] * rna); *(v4u*)(ka + 128 + c * 8) = o;
            v4u p; p.x = pk2(R[0] * rnb, R[1] * rnb); p.y = pk2(R[2] * rnb, R[3] * rnb); p.z = pk2(R[4] * rnb, R[5] * rnb); p.w = pk2(R[6] * rnb, R[7] * rnb); *(v4u*)(kb + 128 + c * 8) = p; }
    }
}

namespace at {
typedef short bf16x8 __attribute__((ext_vector_type(8)));
typedef short s16x4 __attribute__((ext_vector_type(4)));
typedef float f32x16 __attribute__((ext_vector_type(16)));
typedef unsigned u32x4 __attribute__((ext_vector_type(4)));
constexpr int SHM_V = 16384, SHM_K = 16384, SHM_KR = 8192;
constexpr int OFF_V = 0, OFF_K = 3 * SHM_V, OFF_KR = OFF_K + 2 * SHM_K, OFF_WS = OFF_KR + 2 * SHM_KR, LDS_NEED = OFF_WS + 8 * 64 * 4;
constexpr float SCALE = 0.07216878364870322f;
constexpr float THR = 8.f;
#define AT_KSWZ(row, colB) ((row) * 256 + ((colB) ^ (((row) & 7) << 4)))
#define AT_KRSWZ(row, colB) ((row) * 128 + ((colB) ^ (((row) & 7) << 4)))
#define AT_SBAR() __builtin_amdgcn_sched_barrier(0)
__device__ __forceinline__ int v_st(int k, int c) { const int kk = (k & ~0xC) | ((k & 4) << 1) | ((k & 8) >> 1); return ((kk >> 3) * 4 + (c >> 5)) * 512 + ((kk & 7) * 32 + (c & 31)) * 2; }
__device__ __forceinline__ int v_rd_base(int lane) { return ((lane & 3) << 3) | (((lane >> 2) & 3) << 6) | (((lane >> 4) & 1) << 5) | (((lane >> 5) & 1) << 8); }
constexpr int v_rd_off(int d0, int ks, int half) { return d0 * 512 + ks * 4096 + half * 2048; }
__device__ __forceinline__ int crow(int r, int hi) { return (r & 3) + 8 * (r >> 2) + 4 * hi; }
__device__ __forceinline__ unsigned cvtpk(float lo, float hi) { unsigned r; asm("v_cvt_pk_bf16_f32 %0, %1, %2" : "=v"(r) : "v"(lo), "v"(hi)); return r; }

__device__ __forceinline__ void mask_tile(f32x16& p0, f32x16& p1, int dq) {
    const float NEG = -__builtin_inff();
#pragma unroll
    for (int r = 0; r < 16; ++r) { const int c = (r & 3) + 8 * (r >> 2); if (dq < c) p0[r] = NEG; if (dq < c + 32) p1[r] = NEG; }
}
__device__ __forceinline__ void partialSM(f32x16& p0, f32x16& p1, float& m_reg, float& mn, float& alpha) {
    float pmax = p0[0];
#pragma unroll
    for (int r = 1; r < 16; ++r) pmax = fmaxf(pmax, p0[r]);
#pragma unroll
    for (int r = 0; r < 16; ++r) pmax = fmaxf(pmax, p1[r]);
    { auto rr = __builtin_amdgcn_permlane32_swap(__float_as_uint(pmax), __float_as_uint(pmax), false, false);
      pmax = fmaxf(__uint_as_float(rr[0]), __uint_as_float(rr[1])); }
    constexpr float C2 = 1.4426950408889634f * SCALE;
    if (__builtin_expect(__all((pmax - m_reg) * SCALE <= THR), 1)) { mn = m_reg; alpha = 1.f; }
    else { mn = fmaxf(m_reg, pmax); alpha = __builtin_amdgcn_exp2f((m_reg - mn) * C2); m_reg = mn; }
    const float mnL = -mn * C2;
#pragma unroll
    for (int r = 0; r < 16; ++r) p0[r] = fmaf(p0[r], C2, mnL);
#pragma unroll
    for (int r = 0; r < 16; ++r) p1[r] = fmaf(p1[r], C2, mnL);
#pragma unroll
    for (int r = 0; r < 16; ++r) p0[r] = __builtin_amdgcn_exp2f(p0[r]);
}
__device__ __forceinline__ void finishSM(f32x16& p0, f32x16& p1, float alpha, float& l_reg, bf16x8& pa0, bf16x8& pa1, bf16x8& pa2, bf16x8& pa3) {
#pragma unroll
    for (int r = 0; r < 16; ++r) p1[r] = __builtin_amdgcn_exp2f(p1[r]);
    float ps = 0;
#pragma unroll
    for (int r = 0; r < 16; ++r) ps += p0[r];
#pragma unroll
    for (int r = 0; r < 16; ++r) ps += p1[r];
    { auto rr = __builtin_amdgcn_permlane32_swap(__float_as_uint(ps), __float_as_uint(ps), false, false);
      ps = __uint_as_float(rr[0]) + __uint_as_float(rr[1]); }
    l_reg = l_reg * alpha + ps;
#define AT_PK4(P, B_, OUT) do { unsigned a0 = cvtpk(P[B_+0], P[B_+1]), a1 = cvtpk(P[B_+2], P[B_+3]);                          \
        unsigned b0 = cvtpk(P[B_+4], P[B_+5]), b1 = cvtpk(P[B_+6], P[B_+7]);                                             \
        auto r0 = __builtin_amdgcn_permlane32_swap(a0, b0, false, false); auto r1 = __builtin_amdgcn_permlane32_swap(a1, b1, false, false); \
        u32x4 w = {r0[0], r1[0], r0[1], r1[1]}; OUT = *reinterpret_cast<bf16x8*>(&w); } while (0)
    AT_PK4(p0, 0, pa0); AT_PK4(p0, 8, pa1); AT_PK4(p1, 0, pa2); AT_PK4(p1, 8, pa3);
#undef AT_PK4
}
__device__ __forceinline__ void qkt(f32x16& p0, f32x16& p1, const LAS unsigned char* Kb, const LAS unsigned char* KRb, int r32, int hi, const bf16x8* qr) {
    p0 = f32x16{}; p1 = f32x16{};
    const LAS unsigned char* kb[4]; const LAS unsigned char* krb[4];
#pragma unroll
    for (int dd = 0; dd < 4; ++dd) { kb[dd] = Kb + AT_KSWZ(r32, (dd * 16 + hi * 8) * 2); krb[dd] = KRb + AT_KRSWZ(r32, (dd * 16 + hi * 8) * 2); }
    bf16x8 f[24];
#pragma unroll
    for (int d0 = 0; d0 < 8; ++d0) { const LAS unsigned char* a = kb[d0 & 3] + (d0 >> 2) * 128;
        f[2 * d0] = *reinterpret_cast<const LAS bf16x8*>(a); f[2 * d0 + 1] = *reinterpret_cast<const LAS bf16x8*>(a + 32 * 256); }
#pragma unroll
    for (int d0 = 0; d0 < 4; ++d0) { const LAS unsigned char* a = krb[d0];
        f[16 + 2 * d0] = *reinterpret_cast<const LAS bf16x8*>(a); f[16 + 2 * d0 + 1] = *reinterpret_cast<const LAS bf16x8*>(a + 32 * 128); }
#pragma unroll
    for (int d0 = 0; d0 < 12; ++d0) {
        p0 = __builtin_amdgcn_mfma_f32_32x32x16_bf16(f[2 * d0], qr[d0], p0, 0, 0, 0);
        p1 = __builtin_amdgcn_mfma_f32_32x32x16_bf16(f[2 * d0 + 1], qr[d0], p1, 0, 0, 0); }
    __builtin_amdgcn_sched_group_barrier(0x100, 4, 0);
#pragma unroll
    for (int i = 0; i < 20; ++i) { __builtin_amdgcn_sched_group_barrier(0x008, 1, 0); __builtin_amdgcn_sched_group_barrier(0x100, 1, 0); }
    __builtin_amdgcn_sched_group_barrier(0x008, 4, 0);
}
__device__ __forceinline__ void pv_tile(f32x16* o, unsigned vb0, bf16x8 pa0, bf16x8 pa1, bf16x8 pa2, bf16x8 pa3) {
#define AT_TRRD(dst, off) asm volatile("ds_read_b64_tr_b16 %0, %1 offset:%2" : "=&v"(dst) : "v"(vb0), "i"(off) : "memory")
#define AT_PV_RD(d0, L, H) do { constexpr int b_ = v_rd_off(d0, 0, 0); \
        AT_TRRD(L[0], b_); AT_TRRD(H[0], b_ + 2048); AT_TRRD(L[1], b_ + 4096); AT_TRRD(H[1], b_ + 6144); AT_TRRD(L[2], b_ + 8192); AT_TRRD(H[2], b_ + 10240); AT_TRRD(L[3], b_ + 12288); AT_TRRD(H[3], b_ + 14336); } while (0)
#define AT_PV_MM(d0, L, H) do { \
        o[d0] = __builtin_amdgcn_mfma_f32_32x32x16_bf16(pa0, (bf16x8){L[0][0], L[0][1], L[0][2], L[0][3], H[0][0], H[0][1], H[0][2], H[0][3]}, o[d0], 0, 0, 0);   \
        o[d0] = __builtin_amdgcn_mfma_f32_32x32x16_bf16(pa1, (bf16x8){L[1][0], L[1][1], L[1][2], L[1][3], H[1][0], H[1][1], H[1][2], H[1][3]}, o[d0], 0, 0, 0);   \
        o[d0] = __builtin_amdgcn_mfma_f32_32x32x16_bf16(pa2, (bf16x8){L[2][0], L[2][1], L[2][2], L[2][3], H[2][0], H[2][1], H[2][2], H[2][3]}, o[d0], 0, 0, 0);   \
        o[d0] = __builtin_amdgcn_mfma_f32_32x32x16_bf16(pa3, (bf16x8){L[3][0], L[3][1], L[3][2], L[3][3], H[3][0], H[3][1], H[3][2], H[3][3]}, o[d0], 0, 0, 0); } while (0)
    s16x4 la[4], ha[4], lb[4], hb[4];
    asm volatile("s_waitcnt lgkmcnt(0)" ::: "memory");
    AT_PV_RD(0, la, ha); AT_PV_RD(1, lb, hb);
    asm volatile("s_waitcnt lgkmcnt(8)" ::: "memory"); AT_SBAR(); AT_PV_MM(0, la, ha); AT_SBAR();
    AT_PV_RD(2, la, ha);
    asm volatile("s_waitcnt lgkmcnt(8)" ::: "memory"); AT_SBAR(); AT_PV_MM(1, lb, hb); AT_SBAR();
    AT_PV_RD(3, lb, hb);
    asm volatile("s_waitcnt lgkmcnt(8)" ::: "memory"); AT_SBAR(); AT_PV_MM(2, la, ha); AT_SBAR();
    asm volatile("s_waitcnt lgkmcnt(0)" ::: "memory"); AT_SBAR(); AT_PV_MM(3, lb, hb);
#undef AT_PV_RD
#undef AT_PV_MM
#undef AT_TRRD
}

__device__ __forceinline__ void attn_block(LAS unsigned char* lds, const bf16* Q, const bf16* K, const bf16* KV, const bf16* proj, bf16* YA, const float* qg, const float* cosT, const float* sinT, int b, int h, int qb) {
    const int tid = otid(), wid = __builtin_amdgcn_readfirstlane(tid >> 6), lane = tid & 63, r32 = lane & 31, hi = lane >> 5;
    const int P0 = qb * 256, NT = 4 * (qb + 1), qlo = P0 + wid * 32;
    LAS unsigned char* V_lds = lds + OFF_V; LAS unsigned char* K_lds = lds + OFF_K; LAS unsigned char* KR_lds = lds + OFF_KR;
    LAS float* wsf = (LAS float*)(lds + OFF_WS) + wid * 64; LAS float* li_l = wsf; LAS float* al_l = wsf + 32;
    bf16x8 qr[12];
    { const bf16* qp = Q + ((size_t)(b * SEQ + qlo + r32) * 8 + h) * 192 + hi * 8;
      bf16x8 raw[12];
#pragma unroll
      for (int d0 = 0; d0 < 12; ++d0) raw[d0] = *(const bf16x8*)(qp + d0 * 16);
      float ss = 0.f;
#pragma unroll
      for (int d0 = 0; d0 < 12; ++d0)
#pragma unroll
          for (int j = 0; j < 8; ++j) { const float v = bf2f((unsigned short)raw[d0][j]); ss += v * v; }
      { auto rr = __builtin_amdgcn_permlane32_swap(__float_as_uint(ss), __float_as_uint(ss), false, false); ss = __uint_as_float(rr[0]) + __uint_as_float(rr[1]); }
      const float rn = 1.0f / sqrtf(ss * (1.0f / 192.f) + EPS);
      const float* ct = cosT + (size_t)(b * SEQ + qlo + r32) * 32 + hi * 8; const float* st = sinT + (size_t)(b * SEQ + qlo + r32) * 32 + hi * 8;
#pragma unroll
      for (int d0 = 0; d0 < 8; ++d0) { const v4f g0 = *(const v4f*)(qg + d0 * 16 + hi * 8), g1 = *(const v4f*)(qg + d0 * 16 + hi * 8 + 4);
          const float g[8] = {g0.x, g0.y, g0.z, g0.w, g1.x, g1.y, g1.z, g1.w}; float x[8];
#pragma unroll
          for (int j = 0; j < 8; ++j) x[j] = bf2f((unsigned short)raw[d0][j]) * rn * g[j];
          u32x4 w = {cvtpk(x[0], x[1]), cvtpk(x[2], x[3]), cvtpk(x[4], x[5]), cvtpk(x[6], x[7])}; qr[d0] = *reinterpret_cast<bf16x8*>(&w); }
#pragma unroll
      for (int d0 = 8; d0 < 10; ++d0) { const int i0 = (d0 - 8) * 16;
          const v4f ga0 = *(const v4f*)(qg + d0 * 16 + hi * 8), ga1 = *(const v4f*)(qg + d0 * 16 + hi * 8 + 4), gb0 = *(const v4f*)(qg + (d0 + 2) * 16 + hi * 8), gb1 = *(const v4f*)(qg + (d0 + 2) * 16 + hi * 8 + 4);
          const v4f c0 = *(const v4f*)(ct + i0), c1 = *(const v4f*)(ct + i0 + 4), s0 = *(const v4f*)(st + i0), s1 = *(const v4f*)(st + i0 + 4);
          const float ga[8] = {ga0.x, ga0.y, ga0.z, ga0.w, ga1.x, ga1.y, ga1.z, ga1.w}, gb[8] = {gb0.x, gb0.y, gb0.z, gb0.w, gb1.x, gb1.y, gb1.z, gb1.w};
          const float cs[8] = {c0.x, c0.y, c0.z, c0.w, c1.x, c1.y, c1.z, c1.w}, sn[8] = {s0.x, s0.y, s0.z, s0.w, s1.x, s1.y, s1.z, s1.w};
          float y1[8], y2[8];
#pragma unroll
          for (int j = 0; j < 8; ++j) { const float x1 = bf2f((unsigned short)raw[d0][j]) * rn * ga[j], x2 = bf2f((unsigned short)raw[d0 + 2][j]) * rn * gb[j];
              y1[j] = x1 * cs[j] - x2 * sn[j]; y2[j] = x2 * cs[j] + x1 * sn[j]; }
          u32x4 w1 = {cvtpk(y1[0], y1[1]), cvtpk(y1[2], y1[3]), cvtpk(y1[4], y1[5]), cvtpk(y1[6], y1[7])}; qr[d0] = *reinterpret_cast<bf16x8*>(&w1);
          u32x4 w2 = {cvtpk(y2[0], y2[1]), cvtpk(y2[2], y2[3]), cvtpk(y2[4], y2[5]), cvtpk(y2[6], y2[7])}; qr[d0 + 2] = *reinterpret_cast<bf16x8*>(&w2); }
    }
    const int sr = tid >> 4, sc = (tid & 15) * 8, kws = AT_KSWZ(sr, sc * 2), vst0 = v_st(sr, sc), vst1 = v_st(32 + sr, sc);
    const int rr = tid >> 3, rc = (tid & 7) * 8, krws = AT_KRSWZ(rr, rc * 2);
    const bf16* Kg = K + ((size_t)(b * SEQ) * 8 + h) * 192;
    const bf16* Vg = KV + (size_t)(b * SEQ) * 2048 + h * 256 + 128;
    bf16x8 sa_k0, sa_k1, sa_kr, sa_v0, sa_v1, sb_k0, sb_k1, sb_kr, sb_v0, sb_v1;
#define AT_SLOAD(S, kb_) do { S##_k0 = *(const bf16x8*)(Kg + (size_t)((kb_) + sr) * 1536 + sc); S##_k1 = *(const bf16x8*)(Kg + (size_t)((kb_) + 32 + sr) * 1536 + sc); \
        S##_kr = *(const bf16x8*)(Kg + (size_t)((kb_) + rr) * 1536 + 128 + rc); \
        S##_v0 = *(const bf16x8*)(Vg + (size_t)((kb_) + sr) * 2048 + sc); S##_v1 = *(const bf16x8*)(Vg + (size_t)((kb_) + 32 + sr) * 2048 + sc); } while (0)
#define AT_SWRITE(S, bf, vbf) do { *(LAS bf16x8*)(K_lds + (bf) * SHM_K + kws) = S##_k0; *(LAS bf16x8*)(K_lds + (bf) * SHM_K + kws + 32 * 256) = S##_k1; \
        *(LAS bf16x8*)(KR_lds + (bf) * SHM_KR + krws) = S##_kr; \
        *(LAS bf16x8*)(V_lds + (vbf) * SHM_V + vst0) = S##_v0; *(LAS bf16x8*)(V_lds + (vbf) * SHM_V + vst1) = S##_v1; } while (0)
    AT_SLOAD(sa, 0); AT_SLOAD(sb, 64); AT_SWRITE(sa, 0, 0);
    __syncthreads();
    float m_reg = -1e30f, l_reg = 0.f; f32x16 o[4] = {};
    const unsigned vbase = (unsigned)(size_t)V_lds + (unsigned)v_rd_base(lane);
    const bool late = wid >= 4;
    bool pend = false; int pvb = 0; int vb3 = 0;
    bf16x8 pa0, pa1, pa2, pa3;
#define AT_STEP(t, SL, SW) do { \
        const int buf = (t) & 1, kb = (t) * 64; \
        if ((t) + 2 < NT) AT_SLOAD(SL, kb + 128);                         \
        if (late && pend) { pv_tile(o, vbase + pvb * SHM_V, pa0, pa1, pa2, pa3); pend = false; AT_SBAR(); } \
        if (kb <= qlo + 31) { \
            f32x16 p0, p1; float mn, alpha; \
            qkt(p0, p1, K_lds + buf * SHM_K, KR_lds + buf * SHM_KR, r32, hi, qr); \
            if (kb + 63 > qlo) mask_tile(p0, p1, qlo + r32 - 4 * hi - kb); \
            partialSM(p0, p1, m_reg, mn, alpha); \
            finishSM(p0, p1, alpha, l_reg, pa0, pa1, pa2, pa3); \
            if (__any(alpha < 1.f)) { if (hi == 0) al_l[r32] = alpha; asm volatile("s_waitcnt lgkmcnt(0)" ::: "memory"); \
                _Pragma("unroll") for (int d_ = 0; d_ < 4; ++d_) _Pragma("unroll") for (int r = 0; r < 16; ++r) o[d_][r] *= al_l[crow(r, hi)]; \
                asm volatile("s_waitcnt lgkmcnt(0)" ::: "memory"); } \
            AT_SBAR(); \
            if (late) { pend = true; pvb = vb3; } \
            else pv_tile(o, vbase + vb3 * SHM_V, pa0, pa1, pa2, pa3); \
        } \
        const int vn3 = vb3 == 2 ? 0 : vb3 + 1; \
        if ((t) + 1 < NT) AT_SWRITE(SW, buf ^ 1, vn3);                    \
        vb3 = vn3; \
        __syncthreads(); } while (0)
    for (int t = 0; t < NT; t += 2) { AT_STEP(t, sa, sb); AT_STEP(t + 1, sb, sa); }
#undef AT_STEP
    if (late && pend) pv_tile(o, vbase + pvb * SHM_V, pa0, pa1, pa2, pa3);
    if (hi == 0) li_l[r32] = l_reg;
    asm volatile("s_waitcnt lgkmcnt(0)" ::: "memory");
    float rli[16];
#pragma unroll
    for (int r = 0; r < 16; ++r) rli[r] = 1.0f / li_l[crow(r, hi)];
#pragma unroll
    for (int d0 = 0; d0 < 4; ++d0) { const int col = h * 128 + d0 * 32 + r32;
        unsigned short zr[16];
#pragma unroll
        for (int r = 0; r < 16; ++r) zr[r] = proj[(size_t)(b * SEQ + qlo + crow(r, hi)) * NPROJ + C_ZA + col];
#pragma unroll
        for (int r = 0; r < 16; ++r) { const int row = b * SEQ + qlo + crow(r, hi);
            const float v = o[d0][r] * rli[r] * silu_f(bf2f(zr[r])) * 16.0f;
            const float vn = lane_xor<1>(v);
            const unsigned w2 = (unsigned)__builtin_amdgcn_cvt_pk_fp8_f32(v, vn, 0, false) & 0xffffu;
            const unsigned w2o = __float_as_uint(lane_xor<2>(__uint_as_float(w2)));
            if ((r32 & 3) == 0) *(unsigned*)((unsigned char*)YA + (size_t)row * 1024 + col) = w2 | (w2o << 16); } }
    asm volatile("s_waitcnt lgkmcnt(0)" ::: "memory");
    __syncthreads();
#undef AT_SLOAD
#undef AT_SWRITE
}
}


namespace sg {
using at::bf16x8; using at::f32x16;
__device__ __forceinline__ void sgu_item(LAS unsigned char* lds, const bf16* proj, const float* rv, const float* Ws, const float* bs, const float* vg, bf16* YB, int it) {
    const int tid = otid(), wid = __builtin_amdgcn_readfirstlane(tid >> 6), lane = tid & 63, r32 = lane & 31, hi = lane >> 5;
    {
        const int ch = it >> 2, gp = it & 3, R0 = ch * 128;
#pragma unroll
        for (int i = 0; i < 8; ++i) {
            const int idx = tid + 512 * i, gsel = idx >> 11, row = (idx >> 4) & 127, cc = idx & 15;
            const v4u w = *(const v4u*)(proj + (size_t)(R0 + row) * NPROJ + C_VB + (2 * gp + gsel) * 128 + cc * 8);
            const float s = 1.0f / sqrtf(rv[R0 + row] * (1.0f / 1024.f) + EPS);
            v4u o; o.x = pk2(gelu_f(lo16(w.x)) * s, gelu_f(hi16(w.x)) * s); o.y = pk2(gelu_f(lo16(w.y)) * s, gelu_f(hi16(w.y)) * s);
            o.z = pk2(gelu_f(lo16(w.z)) * s, gelu_f(hi16(w.z)) * s); o.w = pk2(gelu_f(lo16(w.w)) * s, gelu_f(hi16(w.w)) * s);
            *(LAS v4u*)(lds + (gsel * 2 + (row >> 6)) * 16384 + at::v_st(row & 63, cc * 8)) = o;
        }
        __syncthreads();
        const int gsel = wid >> 2, g = 2 * gp + gsel, t = 32 * (wid & 3) + r32;
        f32x16 o[4] = {};
        const int nst = (wid & 3) >= 2 ? 2 : 1;
        for (int st = 0; st < nst; ++st) {
            bf16x8 pa[4];
#pragma unroll
            for (int ks = 0; ks < 4; ++ks) {
                const int s0 = st * 64 + ks * 16 + hi * 8;
                const float* wp = Ws + ((size_t)g * 128 + t) * 128 + s0;
                const v4f a = *(const v4f*)wp, b = *(const v4f*)(wp + 4);
                float x[8] = {a.x, a.y, a.z, a.w, b.x, b.y, b.z, b.w};
#pragma unroll
                for (int j = 0; j < 8; ++j) if (s0 + j > t) x[j] = 0.f;
                at::u32x4 w4 = {at::cvtpk(x[0], x[1]), at::cvtpk(x[2], x[3]), at::cvtpk(x[4], x[5]), at::cvtpk(x[6], x[7])};
                pa[ks] = *reinterpret_cast<bf16x8*>(&w4);
            }
            const unsigned vbase = (unsigned)(size_t)(lds + (gsel * 2 + st) * 16384) + (unsigned)at::v_rd_base(lane);
            at::pv_tile(o, vbase, pa[0], pa[1], pa[2], pa[3]);
        }
#pragma unroll
        for (int d0 = 0; d0 < 4; ++d0) { const int gc = g * 128 + d0 * 32 + r32; const float vgc = vg[gc];
            unsigned short ur[16], zr[16];
#pragma unroll
            for (int r = 0; r < 16; ++r) { const size_t row = (size_t)(R0 + 32 * (wid & 3) + at::crow(r, hi)); ur[r] = proj[row * NPROJ + C_UB + gc]; zr[r] = proj[row * NPROJ + C_ZB + gc]; }
#pragma unroll
            for (int r = 0; r < 16; ++r) { const int tl = 32 * (wid & 3) + at::crow(r, hi); const size_t row = (size_t)(R0 + tl);
                const float mix = o[d0][r] * vgc + bs[g * 128 + tl];
                const float y = gelu_f(bf2f(ur[r])) * mix * silu_f(bf2f(zr[r])), yn = lane_xor<1>(y);
                if ((r32 & 1) == 0) *(unsigned*)(YB + row * 1024 + gc) = at::cvtpk(y, yn); } }
        __syncthreads();
    }
}
}


namespace gl {
using at::bf16x8; using at::f32x16; using at::s16x4; using at::u32x4;
constexpr int OFF_VIMG = 0, OFF_KLIMG = 65536, OFF_ATT = 98304, OFF_DS = 131072, OFF_PART = 131584, LDS_NEED = OFF_PART + 4096;

__device__ __forceinline__ void gla_prep_item(LAS unsigned char* lds, int seg_off, const bf16* proj, const float* wa2, const float* ba, bf16* QE, bf16* KE, bf16* KL, float* DS, int ci) {
    const int tid = otid(), k2 = tid & 63, ts = tid >> 6, k = 2 * k2;
    LAS float* seg = (LAS float*)(lds + seg_off);
    {
        const int ch = ci >> 2, h = ci & 3, R0 = ch * 128 + ts * 16;
        float wa0[16], wa1[16];
#pragma unroll
        for (int j = 0; j < 16; ++j) { const v2f w = *(const v2f*)(wa2 + j * 512 + h * 128 + k); wa0[j] = w.x; wa1[j] = w.y; }
        const v2f bak = *(const v2f*)(ba + h * 128 + k);
        float la0[16], la1[16]; float run0 = 0.f, run1 = 0.f;
#pragma unroll
        for (int i = 0; i < 16; ++i) {
            const bf16* pr = proj + (size_t)(R0 + i) * NPROJ + C_AR;
            const v4u w0 = *(const v4u*)pr, w1 = *(const v4u*)(pr + 8);
            const float ar[16] = {lo16(w0.x), hi16(w0.x), lo16(w0.y), hi16(w0.y), lo16(w0.z), hi16(w0.z), lo16(w0.w), hi16(w0.w),
                                  lo16(w1.x), hi16(w1.x), lo16(w1.y), hi16(w1.y), lo16(w1.z), hi16(w1.z), lo16(w1.w), hi16(w1.w)};
            float x0 = bak.x, x1 = bak.y;
#pragma unroll
            for (int j = 0; j < 16; ++j) { x0 += ar[j] * wa0[j]; x1 += ar[j] * wa1[j]; }
            run0 += (fminf(x0, 0.f) - __logf(1.0f + __expf(-fabsf(x0)))) * 0.0625f; la0[i] = run0;
            run1 += (fminf(x1, 0.f) - __logf(1.0f + __expf(-fabsf(x1)))) * 0.0625f; la1[i] = run1;
        }
        *(LAS v2f*)(seg + ts * 128 + k) = (v2f){run0, run1};
        __syncthreads();
        float pre0 = 0.f, pre1 = 0.f, tot0 = 0.f, tot1 = 0.f;
#pragma unroll
        for (int q = 0; q < 8; ++q) { const v2f sg = *(const LAS v2f*)(seg + q * 128 + k); tot0 += sg.x; tot1 += sg.y; if (q < ts) { pre0 += sg.x; pre1 += sg.y; } }
        const float et0 = __expf(tot0), et1 = __expf(tot1);
        unsigned qw[16], kw[16];
#pragma unroll
        for (int i = 0; i < 16; ++i) { const size_t row = (size_t)(R0 + i); qw[i] = *(const unsigned*)(proj + row * NPROJ + C_QC + h * 128 + k); kw[i] = *(const unsigned*)(proj + row * NPROJ + C_KC + h * 128 + k); }
#pragma unroll
        for (int i = 0; i < 16; ++i) {
            const size_t o = (size_t)(R0 + i) * 512 + h * 128 + k;
            const float e0 = __expf(la0[i] + pre0), e1 = __expf(la1[i] + pre1), r0 = __builtin_amdgcn_rcpf(e0), r1 = __builtin_amdgcn_rcpf(e1);
            const float q0 = lo16(qw[i]) * 0.08838834764831845f, q1 = hi16(qw[i]) * 0.08838834764831845f, kk0 = lo16(kw[i]) * r0, kk1 = hi16(kw[i]) * r1;
            *(unsigned*)(QE + o) = pk2(q0 * e0, q1 * e1);
            *(unsigned*)(KE + o) = pk2(kk0, kk1);
            *(unsigned*)(KL + o) = pk2(kk0 * et0, kk1 * et1);
        }
        if (ts == 0) *(v2f*)(DS + ((size_t)ch * 4 + h) * 128 + k) = (v2f){et0, et1};
        __syncthreads();
    }
}

#define GL_PK4(P, B_, OUT) do { unsigned a0 = at::cvtpk(P[B_+0], P[B_+1]), a1 = at::cvtpk(P[B_+2], P[B_+3]);                          \
        unsigned b0 = at::cvtpk(P[B_+4], P[B_+5]), b1 = at::cvtpk(P[B_+6], P[B_+7]);                                             \
        auto r0 = __builtin_amdgcn_permlane32_swap(a0, b0, false, false); auto r1 = __builtin_amdgcn_permlane32_swap(a1, b1, false, false); \
        u32x4 w = {r0[0], r1[0], r0[1], r1[1]}; OUT = *reinterpret_cast<bf16x8*>(&w); } while (0)
#define GL_TRRD(dst, addr, off) asm volatile("ds_read_b64_tr_b16 %0, %1 offset:%2" : "=&v"(dst) : "v"(addr), "i"(off) : "memory")

template <int TT> __device__ __forceinline__ void o_intra_tile(LAS unsigned char* lds, const bf16x8 (&vfr)[8], float* oi, int r32, int hi) {
    f32x16 acc = {};
    const int t = 32 * TT + r32;
    bf16x8 af[2 * TT + 2];
#pragma unroll
    for (int ks8 = 0; ks8 < 2 * TT + 2; ++ks8) af[ks8] = *(const LAS bf16x8*)(lds + OFF_ATT + t * 256 + (((16 * ks8 + 8 * hi) * 2) ^ ((t & 7) << 4)));
#pragma unroll
    for (int ks8 = 0; ks8 < 2 * TT + 2; ++ks8) acc = __builtin_amdgcn_mfma_f32_32x32x16_bf16(af[ks8], vfr[ks8], acc, 0, 0, 0);
    __builtin_amdgcn_sched_group_barrier(0x100, 2 * TT + 2, 0); __builtin_amdgcn_sched_group_barrier(0x008, 2 * TT + 2, 0);
#pragma unroll
    for (int r4 = 0; r4 < 4; ++r4) *(v4f*)(oi + (size_t)(TT * 4 + r4) * 256) = (v4f){acc[4 * r4], acc[4 * r4 + 1], acc[4 * r4 + 2], acc[4 * r4 + 3]};
}
__device__ __forceinline__ void gla_chunk_item(LAS unsigned char* lds, const bf16* proj, const bf16* QE, const bf16* KE, const bf16* KL, float* OI, float* DL, int ci) {
    const int tid = otid(), wid = __builtin_amdgcn_readfirstlane(tid >> 6), lane = tid & 63, r32 = lane & 31, hi = lane >> 5;
    const int h = ci & 3, R0 = (ci >> 2) * 128;
    {
        {
#pragma unroll
            for (int i = 0; i < 8; ++i) { const int idx = tid + 512 * i, s = idx >> 5, cc = idx & 31;
                const v4u w = *(const v4u*)(proj + (size_t)(R0 + s) * NPROJ + C_VC + h * 256 + cc * 8);
                *(LAS v4u*)(lds + OFF_VIMG + ((s >> 6) * 2 + (cc >> 4)) * 16384 + at::v_st(s & 63, (cc & 15) * 8)) = w; }
#pragma unroll
            for (int i = 0; i < 4; ++i) { const int idx = tid + 512 * i, s = idx >> 4, cc = idx & 15;
                const v4u w = *(const v4u*)(KL + (size_t)(R0 + s) * 512 + h * 128 + cc * 8);
                *(LAS v4u*)(lds + OFF_KLIMG + (s >> 6) * 16384 + at::v_st(s & 63, cc * 8)) = w; }
#pragma unroll
            for (int j = 0; j < 2; ++j) {
                const int ti = 2 * wid + j, st = ti >> 2, tt = ti & 3;
                if (st <= tt) {
                    f32x16 p = {};
                    const bf16* ap = KE + (size_t)(R0 + 32 * st + r32) * 512 + h * 128 + hi * 8;
                    const bf16* bp = QE + (size_t)(R0 + 32 * tt + r32) * 512 + h * 128 + hi * 8;
                    bf16x8 fa[8], fb[8];
#pragma unroll
                    for (int ks = 0; ks < 8; ++ks) { fa[ks] = *(const bf16x8*)(ap + ks * 16); fb[ks] = *(const bf16x8*)(bp + ks * 16); }
#pragma unroll
                    for (int ks = 0; ks < 8; ++ks) p = __builtin_amdgcn_mfma_f32_32x32x16_bf16(fa[ks], fb[ks], p, 0, 0, 0);
                    __builtin_amdgcn_sched_group_barrier(0x020, 16, 0); __builtin_amdgcn_sched_group_barrier(0x008, 8, 0);
                    if (st == tt) {
#pragma unroll
                        for (int r = 0; r < 16; ++r) if (at::crow(r, hi) > r32) p[r] = 0.f; }
                    const int t = 32 * tt + r32;
#pragma unroll
                    for (int g = 0; g < 4; ++g) { v2u w; w.x = at::cvtpk(p[4 * g], p[4 * g + 1]); w.y = at::cvtpk(p[4 * g + 2], p[4 * g + 3]);
                        *(LAS v2u*)(lds + OFF_ATT + t * 256 + ((64 * st + 16 * g) ^ ((t & 7) << 4)) + 8 * hi) = w; }
                }
            }
            __syncthreads();
            bf16x8 vfr[8];
            { const unsigned vaddr = (unsigned)(size_t)(lds + OFF_VIMG + (wid >> 2) * 16384) + (unsigned)at::v_rd_base(lane) + (unsigned)((wid & 3) * 512);
              s16x4 vl[8], vh[8];
#define GL_VF(ks8) do { constexpr int o_ = ((ks8) >> 2) * 32768 + ((ks8) & 3) * 4096; GL_TRRD(vl[ks8], vaddr, o_); GL_TRRD(vh[ks8], vaddr, o_ + 2048); } while (0)
              GL_VF(0); GL_VF(1); GL_VF(2); GL_VF(3); GL_VF(4); GL_VF(5); GL_VF(6); GL_VF(7);
#undef GL_VF
              asm volatile("s_waitcnt lgkmcnt(0)" ::: "memory"); AT_SBAR();
#pragma unroll
              for (int q = 0; q < 8; ++q) vfr[q] = (bf16x8){vl[q][0], vl[q][1], vl[q][2], vl[q][3], vh[q][0], vh[q][1], vh[q][2], vh[q][3]};
              AT_SBAR(); }
            float* oi = OI + (((size_t)ci * 8 + wid) * 16 * 64 + lane) * 4;
            float* dl = DL + (((size_t)ci * 8 + wid) * 16 * 64 + lane) * 4;
            o_intra_tile<0>(lds, vfr, oi, r32, hi); o_intra_tile<1>(lds, vfr, oi, r32, hi); o_intra_tile<2>(lds, vfr, oi, r32, hi); o_intra_tile<3>(lds, vfr, oi, r32, hi);
#pragma unroll
            for (int kt = 0; kt < 4; ++kt) {
                f32x16 D = {};
                const unsigned kaddr = (unsigned)(size_t)(lds + OFF_KLIMG) + (unsigned)at::v_rd_base(lane) + (unsigned)(kt * 512);
#define GL_KF(ks8) do { s16x4 l_, h_; constexpr int o_ = ((ks8) >> 2) * 16384 + ((ks8) & 3) * 4096; GL_TRRD(l_, kaddr, o_); GL_TRRD(h_, kaddr, o_ + 2048); \
                asm volatile("s_waitcnt lgkmcnt(0)" ::: "memory"); AT_SBAR(); \
                D = __builtin_amdgcn_mfma_f32_32x32x16_bf16((bf16x8){l_[0], l_[1], l_[2], l_[3], h_[0], h_[1], h_[2], h_[3]}, vfr[ks8], D, 0, 0, 0); } while (0)
                GL_KF(0); GL_KF(1); GL_KF(2); GL_KF(3); GL_KF(4); GL_KF(5); GL_KF(6); GL_KF(7);
#undef GL_KF
#pragma unroll
                for (int r4 = 0; r4 < 4; ++r4) *(v4f*)(dl + (size_t)(kt * 4 + r4) * 256) = (v4f){D[4 * r4], D[4 * r4 + 1], D[4 * r4 + 2], D[4 * r4 + 3]};
            }
            __syncthreads();
        }
    }
}

__device__ __forceinline__ void gla_stageA_item(const float* DS, const float* DL, bf16* XB, int b, int h, int vp) {
    const int tid = otid(), wid = __builtin_amdgcn_readfirstlane(tid >> 6), lane = tid & 63, hi = lane >> 5;
    const int vb = 2 * vp + (wid >> 2), kt = wid & 3;
    constexpr int PF = 4, NC = SEQ / 128;
    f32x16 X = {};
    v4f dq[PF][4], sq[PF][4];
    const size_t ci0 = (size_t)(b * 32) * 4 + h;
#define GL_ALOAD(slot, c_) do { const size_t ci_ = ci0 + (size_t)(c_) * 4; const float* dl_ = DL + ((ci_ * 8 + vb) * 16 * 64 + lane) * 4 + (size_t)(kt * 4) * 256; const float* ds_ = DS + ci_ * 128 + 32 * kt + 4 * hi; \
        _Pragma("unroll") for (int r4 = 0; r4 < 4; ++r4) { dq[slot][r4] = *(const v4f*)(dl_ + (size_t)r4 * 256); sq[slot][r4] = *(const v4f*)(ds_ + 8 * r4); } } while (0)
#pragma unroll
    for (int s = 0; s < PF; ++s) GL_ALOAD(s, s);
    for (int c0 = 0; c0 < NC; c0 += PF) {
#pragma unroll
        for (int s = 0; s < PF; ++s) {
            const int c = c0 + s; const size_t ci = ci0 + (size_t)c * 4;
            bf16* xo = XB + (((ci * 8 + vb) * 8 + kt * 2) * 64 + lane) * 8;
            bf16x8 xb0, xb1; GL_PK4(X, 0, xb0); GL_PK4(X, 8, xb1);
            *(bf16x8*)xo = xb0; *(bf16x8*)(xo + 512) = xb1;
#pragma unroll
            for (int r4 = 0; r4 < 4; ++r4) { const v4f w = dq[s][r4], d4 = sq[s][r4];
                X[4 * r4] = X[4 * r4] * d4.x + w.x; X[4 * r4 + 1] = X[4 * r4 + 1] * d4.y + w.y; X[4 * r4 + 2] = X[4 * r4 + 2] * d4.z + w.z; X[4 * r4 + 3] = X[4 * r4 + 3] * d4.w + w.w; }
            if (c + PF < NC) GL_ALOAD(s, c + PF);
        }
    }
#undef GL_ALOAD
}
__device__ __forceinline__ void gla_stageB_item(const bf16* proj, const bf16* QE, const float* OI, const bf16* XB, const float* og, bf16* YC, int b, int h, int cp) {
    const int tid = otid(), wid = __builtin_amdgcn_readfirstlane(tid >> 6), lane = tid & 63, r32 = lane & 31, hi = lane >> 5;
    {
        const int c = 2 * cp + (wid >> 2), tt = wid & 3, R0 = b * SEQ + c * 128;
        const size_t ci = (size_t)(b * 32 + c) * 4 + h;
        f32x16 acc[8];
#pragma unroll
        for (int vb = 0; vb < 8; ++vb) { const float* oi = OI + ((ci * 8 + vb) * 16 * 64 + lane) * 4 + (size_t)(tt * 4) * 256;
#pragma unroll
            for (int r4 = 0; r4 < 4; ++r4) { const v4f w = *(const v4f*)(oi + (size_t)r4 * 256); acc[vb][4 * r4] = w.x; acc[vb][4 * r4 + 1] = w.y; acc[vb][4 * r4 + 2] = w.z; acc[vb][4 * r4 + 3] = w.w; } }
        bf16x8 qa[8];
        { const bf16* qp = QE + (size_t)(R0 + 32 * tt + r32) * 512 + h * 128 + hi * 8;
#pragma unroll
          for (int ks = 0; ks < 8; ++ks) qa[ks] = *(const bf16x8*)(qp + ks * 16); }
        if (c > 0) {
            const bf16* xi = XB + (((ci * 8) * 8) * 64 + lane) * 8;
            bf16x8 xf[64];
#pragma unroll
            for (int i = 0; i < 64; ++i) xf[i] = *(const bf16x8*)(xi + (size_t)i * 512);
#pragma unroll
            for (int i = 0; i < 64; ++i) acc[i >> 3] = __builtin_amdgcn_mfma_f32_32x32x16_bf16(qa[i & 7], xf[i], acc[i >> 3], 0, 0, 0);
            __builtin_amdgcn_sched_group_barrier(0x020, 16, 0);
#pragma unroll
            for (int i = 0; i < 48; ++i) { __builtin_amdgcn_sched_group_barrier(0x008, 1, 0); __builtin_amdgcn_sched_group_barrier(0x020, 1, 0); }
            __builtin_amdgcn_sched_group_barrier(0x008, 16, 0);
        }
        float rn[16];
#pragma unroll
        for (int r = 0; r < 16; ++r) { float s = 0.f;
#pragma unroll
            for (int vb = 0; vb < 8; ++vb) s += acc[vb][r] * acc[vb][r];
            s += lane_xor<1>(s); s += lane_xor<2>(s); s += lane_xor<4>(s); s += lane_xor<8>(s); s += lane_xor<16>(s);
            rn[r] = 1.0f / sqrtf(s * (1.0f / 256.f) + EPS); }
#pragma unroll
        for (int vb = 0; vb < 8; ++vb) { const float gcol = og[32 * vb + r32];
            unsigned short zr[16];
#pragma unroll
            for (int r = 0; r < 16; ++r) zr[r] = proj[(size_t)(R0 + 32 * tt + at::crow(r, hi)) * NPROJ + C_ZC + h * 256 + 32 * vb + r32];
#pragma unroll
            for (int r = 0; r < 16; ++r) { const size_t row = (size_t)(R0 + 32 * tt + at::crow(r, hi));
                const float y = acc[vb][r] * rn[r] * gcol * silu_f(bf2f(zr[r])), yn = lane_xor<1>(y);
                if ((r32 & 1) == 0) *(unsigned*)(YC + row * 1024 + h * 256 + 32 * vb + r32) = at::cvtpk(y, yn); } }
    }
}
#undef GL_PK4
#undef GL_TRRD
}


constexpr int CW_Q = 65536;
__device__ __forceinline__ int q_pop(unsigned* ctr, LAS unsigned* slot) {
    if (otid() == 0) *slot = __hip_atomic_fetch_add(ctr, 1u, __ATOMIC_RELAXED, __HIP_MEMORY_SCOPE_AGENT);
    __syncthreads(); const int v = (int)*slot; __syncthreads(); return v; }
__device__ __forceinline__ void ph_mixers(LAS unsigned char* lds, unsigned char* ws, unsigned* qctr, const float* Ws, const float* bs, const float* vg, const float* og, const float* qg, int row0, int vb) {
    constexpr int NGLA = NBP * 8, NATT = 16 * NBP, NSGU = 16 * NBP, NQ = NGLA + NATT + NSGU;
    static_assert(NBP % 2 == 0, "NBP even");
    LAS unsigned* slot = (LAS unsigned*)(lds + LDSCTL_OFF + 64);
    bf16* proj = (bf16*)(ws + WS_PROJ);
    for (int dq = 0; dq < 8; ++dq) {
        const int q = (vb + dq) & 7;
        for (;;) {
            const int idx = q_pop(qctr + q * 64, slot);
            if (idx >= NQ) break;
            if (idx >= NATT && idx < NATT + NGLA) { const int gi = q * NGLA + (idx - NATT), bh = gi >> 4, cp = gi & 15;
                gl::gla_stageB_item(proj, (const bf16*)(ws + WS_QE), (const float*)(ws + WS_OC), (const bf16*)(ws + WS_XB), og, (bf16*)(ws + WS_YC), bh >> 2, bh & 3, cp); }
            else if (idx < NATT) { const int j = idx, qb = 15 - j / NBP, bh = q * NBP + j % NBP;
                at::attn_block(lds, (const bf16*)(ws + WS_Q), (const bf16*)(ws + WS_K), (const bf16*)(ws + WS_KV), proj, (bf16*)(ws + WS_YA), qg, (const float*)(ws + WS_COS) + (size_t)row0 * 32, (const float*)(ws + WS_SIN) + (size_t)row0 * 32, bh >> 3, bh & 7, qb); }
            else { const int it = q * NSGU + (idx - NGLA - NATT);
                sg::sgu_item(lds, proj, (const float*)(ws + WS_SSQ) + 2 * MP, Ws, bs, vg, (bf16*)(ws + WS_YB), it); }
        }
    }
}
#ifndef GEMM_SP2
#define GEMM_SP2 true
#endif
#ifndef GEMM_ALIGN
#define GEMM_ALIGN true
#endif
typedef const __attribute__((address_space(4))) Args* KArgP;
#define KARG() ({ KArgP p_ = (KArgP)__builtin_amdgcn_kernarg_segment_ptr(); asm volatile("" : "+s"(p_)); p_; })
#define INF(i) ((const float*)ap->in[i])
__device__ __forceinline__ void grid_bar(const XcdBarrier& b0) { XcdBarrier b = b0; asm volatile("" : "+s"(b.bar)); xcd_barrier(b); }

__global__ void __launch_bounds__(512, 2) fwd(Args a) {
    extern __shared__ __attribute__((aligned(16))) unsigned char lds_raw[];
    LAS unsigned char* lds = (LAS unsigned char*)lds_raw;
    const int lo = a.lo, hi = a.hi;
    XcdBarrier bar; bar.bar = (unsigned*)(a.ws + WS_CTL) + CW_BAR; bar.x = 0; bar.st = nullptr;
    if (hi - lo > 1) {
        if (threadIdx.x < 4) ((LAS unsigned*)(lds + LDSCTL_OFF))[threadIdx.x] = 0u;
        __syncthreads();
        bar = xcd_barrier_post((unsigned*)(a.ws + WS_CTL) + CW_BAR, (volatile LAS unsigned*)(lds + LDSCTL_OFF));
    }
    int step = 0;
#define PH_BEGIN if (step >= lo && step < hi) { const KArgP ap = KARG(); unsigned char* const ws = ap->ws; const int vb = obid(), nvb = gridDim.x; (void)ws; (void)vb; (void)nvb;
#define PH_END   if (step + 1 < hi) grid_bar(bar); } ++step;
#define WL(l) (ws + WS_W + (size_t)(l) * SZ_WLAYER)
#define B_(T, off) ((T*)(ws + (off)))

    for (int l = 0; l < DEPTH; ++l) {
        PH_BEGIN
            { unsigned char* wl = ws + WS_W;
              convert_T<1>(INF(3) + (size_t)l * DM * IN_COLS, DM, IN_COLS, (bf16*)wl, NBF, (LAS float*)lds, vb, nvb);
              convert_T8<2>(INF(3) + (size_t)l * DM * IN_COLS, DM, IN_COLS, wl + SZ_WINB, NF8, 64.0f, (LAS float*)lds, (vb + 96) % nvb, nvb);
              convert_T8<0>(INF(6) + (size_t)l * 512 * 1536, 512, 1536, wl + SZ_WIN, 1536, 32.0f, (LAS float*)lds, (vb + 64) % nvb, nvb, INF(4) + l * 512);
              convert_T8<0>(INF(7) + (size_t)l * 512 * 2048, 512, 2048, wl + SZ_WIN + SZ_WUQ, 2048, 32.0f, (LAS float*)lds, (vb + 128) % nvb, nvb, INF(5) + l * 512);
              convert_T8<0>(INF(16) + ((size_t)l * 3) * 1024 * 2048, 1024, 2048, wl + SZ_WIN + SZ_WUQ + SZ_WUKV, 2048, 32.0f, (LAS float*)lds, vb, nvb);
              for (int b = 1; b < 3; ++b)
                  convert_T<0>(INF(16) + ((size_t)l * 3 + b) * 1024 * 2048, 1024, 2048, (bf16*)(wl + SZ_WIN + SZ_WUQ + SZ_WUKV) + (size_t)b * 2048 * 1024, 2048, (LAS float*)lds, (vb + 32 * b) % nvb, nvb);
              convert_T<0>(INF(17) + (size_t)l * 2048 * 2048, 2048, 2048, (bf16*)(wl + SZ_WIN + SZ_WUQ + SZ_WUKV + SZ_WB), 2048, (LAS float*)lds, (vb + 192) % nvb, nvb); }
            if (l == 0) { const int* positions = (const int*)ap->in[1]; float* cosT = B_(float, WS_COS); float* sinT = B_(float, WS_SIN);
              for (int idx = vb * 512 + otid(); idx < MTOK * 32; idx += nvb * 512) {
                const int t = idx >> 5, i = idx & 31;
                const float inv = 1.0f / powf(10000.0f, (float)(2 * i) * (1.0f / 64.0f));
                const float ang = (float)positions[t] * inv;
                float sn, cs; sincosf(ang, &sn, &cs);
                cosT[idx] = cs; sinT[idx] = sn; } }
        PH_END
        for (int p = 0; p < NPASS; ++p) {
            const int row0 = p * MP;
#define XIN ((l == 0 ? (const float*)ap->in[0] : (const float*)ap->out) + (size_t)row0 * DM)
#define WLP (ws + WS_W)
            PH_BEGIN ph_norm(XIN, INF(2) + l * DM, B_(bf16, WS_H), B_(unsigned char, WS_H8), MP, vb, nvb);
                     { float* ssq = B_(float, WS_SSQ); for (int i = vb * 512 + otid(); i < 3 * MP; i += nvb * 512) ssq[i] = 0.f; } PH_END
            PH_BEGIN { { pg8::Gemm g{B_(bf16, WS_H), (const bf16*)WLP, MP, NBF, DM}; pg8::StaticOrder S; S.init(MP, NBF, nvb, vb); pg8::EpiProj E{B_(bf16, WS_PROJ), NPROJ, B_(float, WS_SSQ), MP, 0, nullptr};
                         pg8::gemm_phase<pg8::EpiProj, pg8::StaticOrder, false, GEMM_ALIGN, GEMM_SP2>(lds, g, S, E, nullptr); }
                       { pg8::Gemm g{(const bf16*)B_(unsigned char, WS_H8), (const bf16*)(WLP + SZ_WINB), MP, NF8, DM / 2}; pg8::StaticOrder S; S.init(MP, NF8, nvb, vb);
                         { const int ub = (MP / 256) * (NBF / 256), u8 = (MP / 256) * (NF8 / 256), sk = ub % nvb;
                           if (sk > 0 && sk < nvb) { S.skip = sk; S.full = (u8 - 2 * (nvb - sk)) / nvb; if (S.full < 0) S.full = 0; } }
                         pg8::EpiProj E{B_(bf16, WS_PROJ) + NBF, NPROJ, B_(float, WS_SSQ), MP, NBF / 256, B_(unsigned char, WS_XB)};
                         pg8::gemm_phase<pg8::EpiProj, pg8::StaticOrder, false, GEMM_ALIGN, GEMM_SP2, true>(lds, g, S, E, nullptr); } } PH_END
            PH_BEGIN { { pg8::Gemm g{(const bf16*)B_(unsigned char, WS_XB), (const bf16*)(WLP + SZ_WIN), MP, 1536, 256, 512, 0x7a7a7a7a, 0x7f7f7f7f}; pg8::StaticOrder S; S.init(MP, 1536, nvb, vb); pg8::EpiBf16Row E{B_(bf16, WS_Q), 1536, B_(float, WS_SSQ), 1.0f / 512.f, EPS};
                         pg8::gemm_phase<pg8::EpiBf16Row, pg8::StaticOrder, false, GEMM_ALIGN, GEMM_SP2, true>(lds, g, S, E, nullptr); }
                       { pg8::Gemm g{(const bf16*)(B_(unsigned char, WS_XB) + 512), (const bf16*)(WLP + SZ_WIN + SZ_WUQ), MP, 2048, 256, 512, 0x7a7a7a7a, 0x7f7f7f7f}; pg8::StaticOrder S; S.init(MP, 2048, nvb, nvb - 1 - vb); pg8::EpiBf16Row E{B_(bf16, WS_KV), 2048, B_(float, WS_SSQ) + MP, 1.0f / 512.f, EPS};
                         pg8::gemm_phase<pg8::EpiBf16Row, pg8::StaticOrder, false, GEMM_ALIGN, GEMM_SP2, true>(lds, g, S, E, nullptr); }
                       for (int ci = vb; ci < (MP / 128) * 4; ci += nvb) {
                           gl::gla_prep_item(lds, 135168, B_(bf16, WS_PROJ), INF(13) + l * 16 * 512, INF(14) + l * 512, B_(bf16, WS_QE), B_(bf16, WS_KE), B_(bf16, WS_KL), B_(float, WS_DS), ci);
                           gl::gla_chunk_item(lds, B_(bf16, WS_PROJ), B_(bf16, WS_QE), B_(bf16, WS_KE), B_(bf16, WS_KL), B_(float, WS_OC), B_(float, WS_DL), ci); } } PH_END
            PH_BEGIN { constexpr int NA = NBP * 16;
                       if (nvb > 2 * NA) { if (vb < NA) gl::gla_stageA_item(B_(float, WS_DS), B_(float, WS_DL), B_(bf16, WS_XB), vb >> 4, (vb >> 2) & 3, vb & 3);
                                           else ph_kfin(B_(bf16, WS_KV), B_(bf16, WS_PROJ), B_(bf16, WS_K), INF(9) + l * 192, B_(float, WS_COS), B_(float, WS_SIN), row0, vb - NA, nvb - NA); }
                       else { for (int it = vb; it < NA; it += nvb) gl::gla_stageA_item(B_(float, WS_DS), B_(float, WS_DL), B_(bf16, WS_XB), it >> 4, (it >> 2) & 3, it & 3);
                              ph_kfin(B_(bf16, WS_KV), B_(bf16, WS_PROJ), B_(bf16, WS_K), INF(9) + l * 192, B_(float, WS_COS), B_(float, WS_SIN), row0, vb, nvb); } } PH_END
            PH_BEGIN ph_mixers(lds, ws, (unsigned*)(ws + WS_CTL) + CW_Q + (l * NPASS + p) * 8 * 64, INF(11) + (size_t)l * 8 * 128 * 128, INF(12) + l * 8 * 128, INF(10) + l * 1024, INF(15) + l * 256, INF(8) + l * 192, row0, vb); PH_END
            PH_BEGIN { { pg8::Gemm g{B_(bf16, WS_YA), (const bf16*)(WLP + SZ_WIN + SZ_WUQ + SZ_WUKV), MP, 2048, 512, 0, 0x7a7a7a7a, 0x7b7b7b7b};
                         pg8::StaticOrder S; S.init(MP, 2048, nvb, vb);
                         pg8::EpiMerge E{B_(bf16, WS_PROJ) + C_GATE, NPROJ, B_(bf16, WS_MG), 2048, 2048, 0}; pg8::gemm_phase<pg8::EpiMerge, pg8::StaticOrder, false, GEMM_ALIGN, GEMM_SP2, true>(lds, g, S, E, nullptr); }
                       { pg8::Gemm g{B_(bf16, WS_YB), (const bf16*)(WLP + SZ_WIN + SZ_WUQ + SZ_WUKV) + (size_t)2048 * 1024, MP, 2048, 1024};
                         pg8::BranchOrder S; S.init(MP, 2048, nvb, vb); S.NB = 2; S.a_stride = (size_t)MP * 1024 * 2; S.b_stride = (size_t)2048 * 1024 * 2;
                         pg8::EpiMerge E{B_(bf16, WS_PROJ) + C_GATE, NPROJ, B_(bf16, WS_MG), 2048, 2048, 1}; pg8::gemm_phase<pg8::EpiMerge, pg8::BranchOrder, false, GEMM_ALIGN, GEMM_SP2>(lds, g, S, E, nullptr); } } PH_END
            PH_BEGIN { pg8::Gemm g{B_(bf16, WS_MG), (const bf16*)(WLP + SZ_WIN + SZ_WUQ + SZ_WUKV + SZ_WB), MP, 2048, 2048}; pg8::StaticOrder S; S.init(MP, 2048, nvb, vb); pg8::EpiRes E{XIN, ap->out + (size_t)row0 * DM, 2048};
                       pg8::gemm_phase<pg8::EpiRes, pg8::StaticOrder, false, GEMM_ALIGN, GEMM_SP2>(lds, g, S, E, nullptr); } PH_END
        }
    }
#undef PH_BEGIN
#undef PH_END
}

#ifndef ONE_LAUNCH
#define ONE_LAUNCH 1
#endif
extern "C" void kernel_launch(void* const* d_in, const int* in_sizes, int n_in, void* d_out, int out_size, void* d_ws, size_t ws_size, hipStream_t stream) {
    static int grid = 0;
    if (grid == 0) {
        if (n_in != 18 || out_size != MTOK * DM || ws_size < WS_END) { fprintf(stderr, "kernel_launch: unexpected shapes (n_in %d out %d ws %zu need %zu)\n", n_in, out_size, ws_size, (size_t)WS_END); grid = -1; return; }
        int dev = 0, cus = 0, per_cu = 0;
        if (hipGetDevice(&dev) != hipSuccess || hipDeviceGetAttribute(&cus, hipDeviceAttributeMultiprocessorCount, dev) != hipSuccess) { grid = -1; return; }
        if (hipFuncSetAttribute((const void*)fwd, hipFuncAttributeMaxDynamicSharedMemorySize, LDS_BYTES) != hipSuccess) { fprintf(stderr, "kernel_launch: hipFuncSetAttribute failed\n"); grid = -1; return; }
        if (hipOccupancyMaxActiveBlocksPerMultiprocessor(&per_cu, (const void*)fwd, 512, LDS_BYTES) != hipSuccess || per_cu < 1) { fprintf(stderr, "kernel_launch: occupancy query says %d\n", per_cu); }
        (void)hipGetLastError();
        grid = cus;
    }
    if (grid < 0) return;
    (void)hipMemsetAsync((char*)d_ws + WS_CTL, 0, CTL_BYTES, stream);
    Args a{};
    for (int i = 0; i < 18; ++i) a.in[i] = d_in[i];
    a.out = (float*)d_out; a.ws = (unsigned char*)d_ws; a.pad0 = 0; a.pad1 = 0;
#if ONE_LAUNCH
    a.lo = 0; a.hi = NSTEPS;
    hipLaunchKernelGGL(fwd, dim3(grid), dim3(512), LDS_BYTES, stream, a);
#else
    for (int s = 0; s < NSTEPS; ++s) { a.lo = s; a.hi = s + 1; hipLaunchKernelGGL(fwd, dim3(grid), dim3(512), LDS_BYTES, stream, a); }
#endif
}
```

```cpp
#include <hip/hip_runtime.h>
#include <cstdio>
#include <cstdint>
__device__ __forceinline__ int otid() { int t = threadIdx.x; asm volatile("" : "+v"(t)); return t; }
__device__ __forceinline__ int obid() { int t = blockIdx.x; asm volatile("" : "+s"(t)); return t; }
namespace pg8 {
#define PG8_LAS __attribute__((address_space(3)))
typedef unsigned short bf16_t;
typedef short bf16x8 __attribute__((ext_vector_type(8)));
typedef float f32x4 __attribute__((ext_vector_type(4)));
typedef unsigned u32x4 __attribute__((ext_vector_type(4)));
constexpr int BM = 256, BK = 64, HALF = 128, HTB = HALF * BK * 2  , STAGE_BYTES = 8 * HTB, NXCD = 8, WGM = 4;

__host__ __device__ __forceinline__ int lds_byte(int r, int c) { const int st = (r >> 4) * 2 + (c >> 5), rr = r & 15, cc = c & 31, ob = rr * 64 + cc * 2; return st * 1024 + (ob ^ (((ob >> 9) & 1) << 5)); }
__host__ __device__ __forceinline__ void stage_rc(int b, int& R, int& C) { const int st = b / 1024, sb = b % 1024, swz = sb ^ (((sb >> 9) & 1) << 5); R = (st >> 1) * 16 + swz / 64; C = (st & 1) * 32 + (swz % 64) / 2; }
__host__ __device__ __forceinline__ int perm32(int rho) { const int n = rho >> 4, i = rho & 15; return 8 * (i >> 2) + 4 * n + (i & 3); }

struct Unit { int pm, pn, pb; };
struct Gemm { const bf16_t* A; const bf16_t* Bt; int M, N, K; int lda; int f8sw, f8sx; };

struct StaticOrder {
    int nM, nN, nwg, G, c, full = 1 << 30, skip = 0;
    __host__ __device__ void init(int M, int N, int G_, int c_) { nM = M / BM; nN = N / BM; nwg = nM * nN; G = G_; c = c_; }
    __host__ __device__ bool next(int i, Unit& u) const {
        long L; if (i < full) L = (long)i * G + c; else { if (c < skip) return false; L = (long)full * G + (long)(i - full) * (G - skip) + (c - skip); }
        if (L >= nwg) return false;
        int wgid = (int)L; { const int q = nwg / NXCD, r = nwg % NXCD, xcd = wgid % NXCD, off = wgid / NXCD; wgid = (xcd < r ? xcd * (q + 1) : r * (q + 1) + (xcd - r) * q) + off; }
        const int nig = WGM * nN, gid = wgid / nig, fm = gid * WGM, gsz = (nM - fm) < WGM ? (nM - fm) : WGM;
        u.pm = fm + ((wgid % nig) % gsz); u.pn = (wgid % nig) / gsz; u.pb = 0; return true;
    }
    __device__ __forceinline__ size_t a_off(const Unit&) const { return 0; }
    __device__ __forceinline__ size_t b_off(const Unit&) const { return 0; }
    __device__ __forceinline__ void a_ready(const Unit&) const {}
    __device__ __forceinline__ void done(const Unit&) const {}
};

struct BranchOrder : StaticOrder {
    int NB; size_t a_stride, b_stride;
    __device__ bool next(int i, Unit& u) const { const int ti = i / NB; if (!StaticOrder::next(ti, u)) return false; u.pb = i - ti * NB; return true; }
    __device__ __forceinline__ size_t a_off(const Unit& u) const { return (size_t)u.pb * a_stride; }
    __device__ __forceinline__ size_t b_off(const Unit& u) const { return (size_t)u.pb * b_stride; }
};

__device__ __forceinline__ unsigned cvt_pk_bf16(float lo, float hi) { unsigned r; asm("v_cvt_pk_bf16_f32 %0, %1, %2" : "=v"(r) : "v"(lo), "v"(hi)); return r; }
__device__ __forceinline__ float gelu_tanh_f(float x) { const float u2 = 1.5957691216057308f * (x + 0.044715f * x * x * x); return x * __builtin_amdgcn_rcpf(1.f + __expf(-u2)); }
__device__ __forceinline__ float silu_e(float x) { return x * __builtin_amdgcn_rcpf(1.f + __expf(-x)); }
struct EpiProj {
    static constexpr bool PERM = true, AFTER_DRAIN = false;
    bf16_t* O; int ldc; float* SSQ; int mrows; int pn0; unsigned char* O8;
    __device__ __forceinline__ void operator()(const f32x4 (&acc)[2][2][4][2], const Unit& u, int wr, int wc, int fr, int fq) const {
        const int row0 = u.pm * BM + wr * 64 + fr, col0 = u.pn * BM + wc * 32 + 8 * fq;
        const int apn = u.pn + pn0;
        const int seg = !SSQ ? -1 : ((apn == 25 || apn == 26) ? 0 : ((apn == 27 || apn == 28) ? 1 : ((apn >= 4 && apn < 8) ? 2 : -1)));
        const int act = apn < 8 ? 1 : (((apn >= 8 && apn < 12) || (apn >= 20 && apn < 24)) ? 2 : 0);
#pragma unroll
        for (int ai = 0; ai < 2; ++ai)
#pragma unroll
            for (int m = 0; m < 4; ++m) { const int row = row0 + ai * HALF + m * 16; bf16_t* rowp = O + (size_t)row * ldc + col0;
                float ss = 0.f;
#pragma unroll
                for (int bj = 0; bj < 2; ++bj) { const f32x4 v0 = acc[ai][bj][m][0], v1 = acc[ai][bj][m][1];
                    if (apn >= 33) {
                        unsigned a = 0u, b = 0u;
#pragma unroll
                        for (int j = 0; j < 4; ++j) { a = __builtin_amdgcn_cvt_pk_u8_f32(255.0f * __builtin_amdgcn_rcpf(1.0f + __expf(-v0[j])), j, a); b = __builtin_amdgcn_cvt_pk_u8_f32(255.0f * __builtin_amdgcn_rcpf(1.0f + __expf(-v1[j])), j, b); }
                        typedef unsigned u32x2g_ __attribute__((ext_vector_type(2)));
                        *(u32x2g_*)((unsigned char*)(O + (size_t)row * ldc + (33 - pn0) * BM) + (apn - 33) * BM + wc * 32 + 8 * fq + bj * HALF) = (u32x2g_){a, b};
                    } else
                    if (seg == 0 || seg == 1) {
                        int a = __builtin_amdgcn_cvt_pk_fp8_f32(v0[0] * 16.0f, v0[1] * 16.0f, 0, false); a = __builtin_amdgcn_cvt_pk_fp8_f32(v0[2] * 16.0f, v0[3] * 16.0f, a, true);
                        int b = __builtin_amdgcn_cvt_pk_fp8_f32(v1[0] * 16.0f, v1[1] * 16.0f, 0, false); b = __builtin_amdgcn_cvt_pk_fp8_f32(v1[2] * 16.0f, v1[3] * 16.0f, b, true);
                        typedef unsigned u32x2_ __attribute__((ext_vector_type(2)));
                        *(u32x2_*)(O8 + ((size_t)seg * mrows + row) * 512 + (apn - (seg == 0 ? 25 : 27)) * BM + wc * 32 + 8 * fq + bj * HALF) = (u32x2_){(unsigned)a, (unsigned)b};
                    } else {
                    f32x4 w0 = v0, w1 = v1;
                    if (act == 1) {
#pragma unroll
                        for (int j = 0; j < 4; ++j) { w0[j] = gelu_tanh_f(v0[j]); w1[j] = gelu_tanh_f(v1[j]); } }
                    else if (act == 2) {
#pragma unroll
                        for (int j = 0; j < 4; ++j) { w0[j] = silu_e(v0[j]); w1[j] = silu_e(v1[j]); } }
                    u32x4 w; w.x = cvt_pk_bf16(w0[0], w0[1]); w.y = cvt_pk_bf16(w0[2], w0[3]); w.z = cvt_pk_bf16(w1[0], w1[1]); w.w = cvt_pk_bf16(w1[2], w1[3]);
                    *(u32x4*)(rowp + bj * HALF) = w;
                    if (seg == 2) {
#pragma unroll
                        for (int j = 0; j < 4; ++j) ss += w0[j] * w0[j] + w1[j] * w1[j]; } }
                    if (seg == 0 || seg == 1) {
#pragma unroll
                        for (int j = 0; j < 4; ++j) ss += v0[j] * v0[j] + v1[j] * v1[j]; } }
                if (seg >= 0) {
                    ss += __uint_as_float((unsigned)__builtin_amdgcn_ds_swizzle((int)__float_as_uint(ss), (16 << 10) | 0x1f));
                    auto rr = __builtin_amdgcn_permlane32_swap(__float_as_uint(ss), __float_as_uint(ss), false, false);
                    ss = __uint_as_float(rr[0]) + __uint_as_float(rr[1]);
                    if (fq == 0) atomicAdd(SSQ + (size_t)seg * mrows + row, ss); } }
    }
};
struct EpiBf16Row {
    static constexpr bool PERM = true, AFTER_DRAIN = false;
    bf16_t* O; int ldc; const float* SSQ; float inv_n, eps;
    __device__ __forceinline__ void operator()(const f32x4 (&acc)[2][2][4][2], const Unit& u, int wr, int wc, int fr, int fq) const {
        const int row0 = u.pm * BM + wr * 64 + fr, col0 = u.pn * BM + wc * 32 + 8 * fq;
        float sq[2][4];
#pragma unroll
        for (int ai = 0; ai < 2; ++ai)
#pragma unroll
            for (int m = 0; m < 4; ++m) sq[ai][m] = SSQ[row0 + ai * HALF + m * 16];
#pragma unroll
        for (int ai = 0; ai < 2; ++ai)
#pragma unroll
            for (int m = 0; m < 4; ++m) { const int row = row0 + ai * HALF + m * 16; bf16_t* rowp = O + (size_t)row * ldc + col0;
                const float rn = 1.0f / sqrtf(sq[ai][m] * inv_n + eps);
#pragma unroll
                for (int bj = 0; bj < 2; ++bj) { const f32x4 v0 = acc[ai][bj][m][0] * rn, v1 = acc[ai][bj][m][1] * rn;
                    u32x4 w; w.x = cvt_pk_bf16(v0[0], v0[1]); w.y = cvt_pk_bf16(v0[2], v0[3]); w.z = cvt_pk_bf16(v1[0], v1[1]); w.w = cvt_pk_bf16(v1[2], v1[3]);
                    *(u32x4*)(rowp + bj * HALF) = w; } }
    }
};
struct EpiF8Row {
    static constexpr bool PERM = true, AFTER_DRAIN = false;
    unsigned char* O; int ldc; const float* SSQ; float inv_n, eps;
    __device__ __forceinline__ void operator()(const f32x4 (&acc)[2][2][4][2], const Unit& u, int wr, int wc, int fr, int fq) const {
        const int row0 = u.pm * BM + wr * 64 + fr, col0 = u.pn * BM + wc * 32 + 8 * fq;
        float sq[2][4];
#pragma unroll
        for (int ai = 0; ai < 2; ++ai)
#pragma unroll
            for (int m = 0; m < 4; ++m) sq[ai][m] = SSQ[row0 + ai * HALF + m * 16];
        typedef unsigned u32x2_ __attribute__((ext_vector_type(2)));
#pragma unroll
        for (int ai = 0; ai < 2; ++ai)
#pragma unroll
            for (int m = 0; m < 4; ++m) { const int row = row0 + ai * HALF + m * 16; unsigned char* rowp = O + (size_t)row * ldc + col0;
                const float rn = 8.0f / sqrtf(sq[ai][m] * inv_n + eps);
#pragma unroll
                for (int bj = 0; bj < 2; ++bj) { const f32x4 v0 = acc[ai][bj][m][0] * rn, v1 = acc[ai][bj][m][1] * rn;
                    int a = __builtin_amdgcn_cvt_pk_fp8_f32(v0[0], v0[1], 0, false); a = __builtin_amdgcn_cvt_pk_fp8_f32(v0[2], v0[3], a, true);
                    int b = __builtin_amdgcn_cvt_pk_fp8_f32(v1[0], v1[1], 0, false); b = __builtin_amdgcn_cvt_pk_fp8_f32(v1[2], v1[3], b, true);
                    *(u32x2_*)(rowp + bj * HALF) = (u32x2_){(unsigned)a, (unsigned)b}; } }
    }
};
struct EpiRes {
    static constexpr bool PERM = false, AFTER_DRAIN = false;
    const float* base; float* C; int ldc;
    __device__ __forceinline__ void operator()(const f32x4 (&acc)[2][2][4][2], const Unit& u, int wr, int wc, int fr, int fq) const {
        const int row0 = u.pm * BM + wr * 64 + fr, col0 = u.pn * BM + wc * 32 + 4 * fq;
#pragma unroll
        for (int ai = 0; ai < 2; ++ai) {
            f32x4 bs[4][2][2];
#pragma unroll
            for (int m = 0; m < 4; ++m) { const size_t off = (size_t)(row0 + ai * HALF + m * 16) * ldc + col0;
#pragma unroll
                for (int bj = 0; bj < 2; ++bj)
#pragma unroll
                    for (int n = 0; n < 2; ++n) bs[m][bj][n] = *(const f32x4*)(base + off + bj * HALF + n * 16); }
#pragma unroll
            for (int m = 0; m < 4; ++m) { const size_t off = (size_t)(row0 + ai * HALF + m * 16) * ldc + col0;
#pragma unroll
                for (int bj = 0; bj < 2; ++bj)
#pragma unroll
                    for (int n = 0; n < 2; ++n) *(f32x4*)(C + off + bj * HALF + n * 16) = acc[ai][bj][m][n] + bs[m][bj][n]; }
            asm volatile("" ::: "memory");
        }
    }
};
struct EpiMerge {
    static constexpr bool PERM = true, AFTER_DRAIN = false;
    const unsigned char* G0; int ldg; bf16_t* MG; int ldc; int gstride; int pb0;
    __device__ __forceinline__ void operator()(const f32x4 (&acc)[2][2][4][2], const Unit& u, int wr, int wc, int fr, int fq) const {
        const int row0 = u.pm * BM + wr * 64 + fr, col0 = u.pn * BM + wc * 32 + 8 * fq; const int branch = u.pb + pb0; const unsigned char* G = G0 + (size_t)branch * gstride; const bool first = branch == 0;
#pragma unroll
        for (int ai = 0; ai < 2; ++ai) {
            typedef unsigned u32x2m_ __attribute__((ext_vector_type(2)));
            u32x2m_ gw[4][2]; u32x4 ow[4][2];
#pragma unroll
            for (int m = 0; m < 4; ++m) { const size_t row = (size_t)(row0 + ai * HALF + m * 16);
#pragma unroll
                for (int bj = 0; bj < 2; ++bj) { gw[m][bj] = *(const u32x2m_*)(G + row * ldg + col0 + bj * HALF); ow[m][bj] = first ? (u32x4){0u, 0u, 0u, 0u} : *(const u32x4*)(MG + row * ldc + col0 + bj * HALF); } }
#pragma unroll
            for (int m = 0; m < 4; ++m) { const size_t row = (size_t)(row0 + ai * HALF + m * 16);
#pragma unroll
                for (int bj = 0; bj < 2; ++bj) { const f32x4 v0 = acc[ai][bj][m][0], v1 = acc[ai][bj][m][1];
                    const unsigned g2[2] = {gw[m][bj].x, gw[m][bj].y}, o4[4] = {ow[m][bj].x, ow[m][bj].y, ow[m][bj].z, ow[m][bj].w};
                    const float a8[8] = {v0[0], v0[1], v0[2], v0[3], v1[0], v1[1], v1[2], v1[3]};
                    unsigned w4[4];
#pragma unroll
                    for (int q = 0; q < 4; ++q) {
                        const float g0 = (float)((g2[q >> 1] >> (16 * (q & 1))) & 0xffu) * (1.0f / 255.0f), g1 = (float)((g2[q >> 1] >> (16 * (q & 1) + 8)) & 0xffu) * (1.0f / 255.0f);
                        const float r0 = __uint_as_float(o4[q] << 16) + a8[2 * q] * g0;
                        const float r1 = __uint_as_float(o4[q] & 0xffff0000u) + a8[2 * q + 1] * g1;
                        unsigned pk; asm("v_cvt_pk_bf16_f32 %0, %1, %2" : "=v"(pk) : "v"(r0), "v"(r1)); w4[q] = pk; }
                    *(u32x4*)(MG + row * ldc + col0 + bj * HALF) = (u32x4){w4[0], w4[1], w4[2], w4[3]}; } }
            asm volatile("" ::: "memory");
        }
    }
};

typedef int pg8_v8i __attribute__((ext_vector_type(8)));
typedef int pg8_v4i __attribute__((ext_vector_type(4)));
template <class Epi, class Sched, bool STAMP = false, bool ALIGN_EPI = false, bool SP2 = false, bool FP8 = false>
__device__ __forceinline__ void gemm_phase(PG8_LAS unsigned char* lds, const Gemm g, const Sched& S, const Epi& E, unsigned long long* stamps) {
    const int tid = otid(), wid = __builtin_amdgcn_readfirstlane(tid >> 6), lane = tid & 63, wr = wid >> 2, wc = wid & 3, fr = lane & 15, fq = lane >> 4;
    const int K = g.K, nt = K / BK, LDA = g.lda ? g.lda : g.K;
    int ts_lo = 0, ts_hi = 0, nts = 0; const unsigned long long rt_entry = STAMP ? (unsigned long long)wall_clock64() : 0ull;
#define PG8_STAMP() do { if (STAMP && wid == 0 && nts < 64) { const unsigned long long _c = (unsigned long long)clock64(); \
        ts_lo = (lane == nts) ? (int)(unsigned)_c : ts_lo; ts_hi = (lane == nts) ? (int)(unsigned)(_c >> 32) : ts_hi; ++nts; } } while (0)
    PG8_STAMP();
    unsigned voffA[2], voffB[2];
#pragma unroll
    for (int i = 0; i < 2; ++i) { int R, C; stage_rc(tid * 16 + i * 8192, R, C); const int Rb = Epi::PERM ? ((R & ~31) + perm32(R & 31)) : R;
        voffA[i] = (unsigned)(R * LDA + C) * 2u; voffB[i] = (unsigned)(Rb * K + C) * 2u; }
    const size_t kstep = (size_t)(BK * 2);
    const size_t hstepB = (size_t)HALF * K * 2, hstepA = (size_t)HALF * LDA * 2;
    const size_t tstepB = 2 * hstepB, tstepA = 2 * hstepA;
    const unsigned ldsw = (unsigned)wid * 1024u;
    const int aoff = lds_byte(wr * 64 + fr, fq * 8), boff = lds_byte(wc * 32 + fr, fq * 8);
#define PG8_SA(b, h) (((b) * 2 + (h)) * HTB)
#define PG8_SB(b, h) ((4 + (b) * 2 + (h)) * HTB)
#define PG8_STAGE(bufoff, gbase, voff) do { _Pragma("unroll") for (int _i = 0; _i < 2; ++_i) \
        __builtin_amdgcn_global_load_lds((const unsigned*)((const char*)(gbase) + (voff)[_i]), (PG8_LAS unsigned*)(lds + (bufoff) + ldsw + _i * 8192), 16, 0, 0); } while (0)
#define PG8_I4(p) (*(const PG8_LAS pg8_v4i*)(p))
#define PG8_LDA(dst, b, h) do { if constexpr (FP8) { _Pragma("unroll") for (int m = 0; m < 4; ++m) dst##8[m] = __builtin_shufflevector(PG8_I4(lds + PG8_SA(b, h) + aoff + m * 2048), PG8_I4(lds + PG8_SA(b, h) + aoff + m * 2048 + 1024), 0, 1, 2, 3, 4, 5, 6, 7); } \
        else { _Pragma("unroll") for (int m = 0; m < 4; ++m) _Pragma("unroll") for (int k = 0; k < 2; ++k) dst[m][k] = *(const PG8_LAS bf16x8*)(lds + PG8_SA(b, h) + aoff + m * 2048 + k * 1024); } } while (0)
#define PG8_LDB(dst, b, h) do { if constexpr (FP8) { _Pragma("unroll") for (int n = 0; n < 2; ++n) dst##8[n] = __builtin_shufflevector(PG8_I4(lds + PG8_SB(b, h) + boff + n * 2048), PG8_I4(lds + PG8_SB(b, h) + boff + n * 2048 + 1024), 0, 1, 2, 3, 4, 5, 6, 7); } \
        else { _Pragma("unroll") for (int n = 0; n < 2; ++n) _Pragma("unroll") for (int k = 0; k < 2; ++k) dst[n][k] = *(const PG8_LAS bf16x8*)(lds + PG8_SB(b, h) + boff + n * 2048 + k * 1024); } } while (0)
#define PG8_MMA_BF(ai, bj, At, Bt) do { __builtin_amdgcn_s_setprio(1); _Pragma("unroll") for (int m = 0; m < 4; ++m) _Pragma("unroll") for (int n = 0; n < 2; ++n) _Pragma("unroll") for (int k = 0; k < 2; ++k) \
        acc[ai][bj][m][n] = __builtin_amdgcn_mfma_f32_16x16x32_bf16(Bt[n][k], At[m][k], acc[ai][bj][m][n], 0, 0, 0); __builtin_amdgcn_s_setprio(0); } while (0)
#define PG8_MMA_F8(ai, bj, At, Bt) do { __builtin_amdgcn_s_setprio(1); _Pragma("unroll") for (int m = 0; m < 4; ++m) _Pragma("unroll") for (int n = 0; n < 2; ++n) \
        asm volatile("v_mfma_scale_f32_16x16x128_f8f6f4 %0, %1, %2, %0, %3, %4 op_sel_hi:[0,0,0]" : "+v"(acc[ai][bj][m][n]) : "v"(Bt##8[n]), "v"(At##8[m]), "v"(f8_scale_w), "v"(f8_scale_x)); \
        __builtin_amdgcn_s_setprio(0); } while (0)
#define PG8_F8_DRAIN() do { if constexpr (FP8) asm volatile("s_nop 15\n\ts_nop 15" ::: "memory"); } while (0)
#define PG8_MMA(ai, bj, At, Bt) do { if constexpr (FP8) PG8_MMA_F8(ai, bj, At, Bt); else PG8_MMA_BF(ai, bj, At, Bt); } while (0)
#define PG8_WAIT_V(n) asm volatile("s_waitcnt vmcnt(" #n ")" ::: "memory")
#define PG8_WAIT_L(n) asm volatile("s_waitcnt lgkmcnt(" #n ")" ::: "memory")
#define PG8_BAR __builtin_amdgcn_s_barrier()
#define PG8_SCHED __builtin_amdgcn_sched_barrier(0)
    Unit cur, nxt; int ui = 0;
    if (!S.next(0, cur)) return;
    f32x4 acc[2][2][4][2];
#pragma unroll
    for (int a = 0; a < 2; ++a)
#pragma unroll
        for (int b = 0; b < 2; ++b)
#pragma unroll
            for (int m = 0; m < 4; ++m)
#pragma unroll
                for (int n = 0; n < 2; ++n) acc[a][b][m][n] = (f32x4){0.f, 0.f, 0.f, 0.f};
    int f8_scale_w = g.f8sw ? g.f8sw : 0x79797979, f8_scale_x = g.f8sx ? g.f8sx : 0x7f7f7f7f; (void)f8_scale_w; (void)f8_scale_x;
    bf16x8 At[4][2], B0[2][2], B1[2][2]; pg8_v8i At8[4], B08[2], B18[2];
    (void)At; (void)B0; (void)B1; (void)At8; (void)B08; (void)B18;
    const char* cA = (const char*)g.A + (size_t)cur.pm * tstepA + S.a_off(cur); const char* cB = (const char*)g.Bt + (size_t)cur.pn * tstepB + S.b_off(cur);
    S.a_ready(cur);
    if constexpr (SP2) {
        PG8_STAGE(PG8_SB(0, 0), cB, voffB); PG8_STAGE(PG8_SB(0, 1), cB + hstepB, voffB); PG8_STAGE(PG8_SA(0, 0), cA, voffA); PG8_STAGE(PG8_SA(0, 1), cA + hstepA, voffA);
        if (wr == 1) PG8_BAR;
        PG8_WAIT_V(2); PG8_BAR;
        PG8_STAGE(PG8_SB(1, 0), cB + kstep, voffB); PG8_STAGE(PG8_SA(1, 0), cA + kstep, voffA); PG8_STAGE(PG8_SB(1, 1), cB + hstepB + kstep, voffB);
        PG8_WAIT_V(6); PG8_BAR;
    } else {
    PG8_STAGE(PG8_SB(0, 0), cB, voffB); PG8_STAGE(PG8_SA(0, 0), cA, voffA); PG8_STAGE(PG8_SB(0, 1), cB + hstepB, voffB); PG8_STAGE(PG8_SA(0, 1), cA + hstepA, voffA);
    if (wr == 1) PG8_BAR;
    PG8_WAIT_V(4); PG8_BAR;
    PG8_STAGE(PG8_SB(1, 0), cB + kstep, voffB); PG8_STAGE(PG8_SA(1, 0), cA + kstep, voffA); PG8_STAGE(PG8_SB(1, 1), cB + hstepB + kstep, voffB);
    PG8_WAIT_V(6); PG8_BAR;
    }
    PG8_STAMP();
    for (;;) {
        const bool has_next = S.next(ui + 1, nxt);
        const char* nA = has_next ? (const char*)g.A + (size_t)nxt.pm * tstepA + S.a_off(nxt) : cA; const char* nB = has_next ? (const char*)g.Bt + (size_t)nxt.pn * tstepB + S.b_off(nxt) : cB;
        for (int t = 0; t < nt; t += 2) {
            const bool last = (t == nt - 2);
            const char* a1 = cA + (size_t)(t + 1) * kstep;
            const char* a2 = last ? nA : cA + (size_t)(t + 2) * kstep; const char* b2 = last ? nB : cB + (size_t)(t + 2) * kstep;
            const char* a3 = a2 + kstep; const char* b3 = b2 + kstep;
            if (last && has_next) S.a_ready(nxt);
            if constexpr (SP2) {
            PG8_LDB(B0, 0, 0); PG8_LDB(B1, 0, 1); PG8_SCHED; PG8_LDA(At, 0, 0); PG8_STAGE(PG8_SA(1, 1), a1 + hstepA, voffA);
            PG8_WAIT_V(8); PG8_WAIT_L(0); PG8_BAR; PG8_MMA(0, 0, At, B0); PG8_MMA(0, 1, At, B1); PG8_BAR; PG8_SCHED;
            PG8_LDA(At, 0, 1); PG8_STAGE(PG8_SB(0, 0), b2, voffB); PG8_STAGE(PG8_SB(0, 1), b2 + hstepB, voffB); PG8_STAGE(PG8_SA(0, 0), a2, voffA);
            PG8_WAIT_V(8); PG8_WAIT_L(0); PG8_BAR; PG8_MMA(1, 0, At, B0); PG8_MMA(1, 1, At, B1); PG8_BAR; PG8_SCHED;
            PG8_LDB(B0, 1, 0); PG8_LDB(B1, 1, 1); PG8_SCHED; PG8_LDA(At, 1, 0); PG8_STAGE(PG8_SA(0, 1), a2 + hstepA, voffA);
            PG8_WAIT_V(8); PG8_WAIT_L(0); PG8_BAR; PG8_MMA(0, 0, At, B0); PG8_MMA(0, 1, At, B1); PG8_BAR; PG8_SCHED;
            PG8_LDA(At, 1, 1); PG8_STAGE(PG8_SB(1, 0), b3, voffB); PG8_STAGE(PG8_SB(1, 1), b3 + hstepB, voffB); PG8_STAGE(PG8_SA(1, 0), a3, voffA);
            PG8_WAIT_V(8); PG8_WAIT_L(0); PG8_BAR; PG8_MMA(1, 0, At, B0); PG8_MMA(1, 1, At, B1); PG8_BAR; PG8_SCHED;
            } else {
            PG8_LDB(B0, 0, 0); PG8_SCHED; PG8_LDA(At, 0, 0); PG8_STAGE(PG8_SA(1, 1), a1 + hstepA, voffA);
            PG8_WAIT_L(8); PG8_BAR; PG8_WAIT_L(0); PG8_MMA(0, 0, At, B0); PG8_BAR; PG8_SCHED;
            PG8_LDB(B1, 0, 1); PG8_STAGE(PG8_SB(0, 0), b2, voffB);
            PG8_BAR; PG8_WAIT_L(0); PG8_MMA(0, 1, At, B1); PG8_BAR;
            PG8_LDA(At, 0, 1); PG8_STAGE(PG8_SA(0, 0), a2, voffA);
            PG8_BAR; PG8_WAIT_L(0); PG8_MMA(1, 0, At, B0); PG8_BAR; PG8_SCHED;
            PG8_STAGE(PG8_SB(0, 1), b2 + hstepB, voffB);
            PG8_WAIT_V(6); PG8_BAR; PG8_MMA(1, 1, At, B1); PG8_BAR;
            PG8_LDB(B0, 1, 0); PG8_SCHED; PG8_LDA(At, 1, 0); PG8_STAGE(PG8_SA(0, 1), a2 + hstepA, voffA);
            PG8_WAIT_L(8); PG8_BAR; PG8_WAIT_L(0); PG8_MMA(0, 0, At, B0); PG8_BAR; PG8_SCHED;
            PG8_LDB(B1, 1, 1); PG8_STAGE(PG8_SB(1, 0), b3, voffB);
            PG8_BAR; PG8_WAIT_L(0); PG8_MMA(0, 1, At, B1); PG8_BAR;
            PG8_LDA(At, 1, 1); PG8_STAGE(PG8_SA(1, 0), a3, voffA);
            PG8_BAR; PG8_WAIT_L(0); PG8_MMA(1, 0, At, B0); PG8_BAR; PG8_SCHED;
            PG8_STAGE(PG8_SB(1, 1), b3 + hstepB, voffB);
            PG8_WAIT_V(6); PG8_BAR; PG8_MMA(1, 1, At, B1); PG8_BAR;
            }
        }
        if constexpr (ALIGN_EPI) { if (wr == 0) PG8_BAR; }
        PG8_STAMP();
        PG8_F8_DRAIN();
        if constexpr (!Epi::AFTER_DRAIN) { E(acc, cur, wr, wc, fr, fq); S.done(cur); }
        PG8_STAMP();
        if (!has_next) break;
#pragma unroll
        for (int a = 0; a < 2; ++a)
#pragma unroll
            for (int b = 0; b < 2; ++b)
#pragma unroll
                for (int m = 0; m < 4; ++m)
#pragma unroll
                    for (int n = 0; n < 2; ++n) acc[a][b][m][n] = (f32x4){0.f, 0.f, 0.f, 0.f};
        cur = nxt; cA = nA; cB = nB; ++ui;
        if constexpr (ALIGN_EPI) { if (wr == 1) PG8_BAR; }
    }
    PG8_WAIT_V(0);
    if constexpr (!ALIGN_EPI) { if (wr == 0) PG8_BAR; }
    PG8_BAR;
    if constexpr (Epi::AFTER_DRAIN) { E.fused(acc, cur, wr, wc, fr, fq, lds, wid, lane); S.done(cur); }
    PG8_STAMP();
    if (STAMP && wid == 0) { stamps[lane] = lane < nts ? (((unsigned long long)(unsigned)ts_hi << 32) | (unsigned)ts_lo) : 0ull;
        if (lane == 62) stamps[62] = rt_entry; if (lane == 63) stamps[63] = (unsigned long long)wall_clock64(); }
#undef PG8_STAMP
#undef PG8_SA
#undef PG8_SB
#undef PG8_STAGE
#undef PG8_LDA
#undef PG8_LDB
#undef PG8_MMA
#undef PG8_MMA_BF
#undef PG8_MMA_F8
#undef PG8_I4
#undef PG8_F8_DRAIN
#undef PG8_WAIT_V
#undef PG8_WAIT_L
#undef PG8_BAR
#undef PG8_SCHED
}
}
#define XB_TMO      128
#define XB_XCNT(j)  (256  + 64 * (j))
#define XB_XSUB(j)  (1280 + 64 * (j))
#define XB_XGEN(j)  (2304 + 64 * (j))
#define XB_TOP      3328
#define XB_TOPGEN   3392
#define XCD_BAR_WORDS 3456
#define XB_SPIN_CAP (1u << 18)
#define LAS __attribute__((address_space(3)))

__device__ __forceinline__ unsigned xb_ld(unsigned* p)              { return __hip_atomic_load(p, __ATOMIC_RELAXED, __HIP_MEMORY_SCOPE_AGENT); }
__device__ __forceinline__ unsigned xb_add(unsigned* p, unsigned v) { return __hip_atomic_fetch_add(p, v, __ATOMIC_RELAXED, __HIP_MEMORY_SCOPE_AGENT); }
__device__ __forceinline__ unsigned xb_xcc_id() { return (unsigned)__builtin_amdgcn_s_getreg((3 << 11) | 20) & 0xFu; }
#define XB_SPIN(cond, bar) do { unsigned _sp = 0; while (cond) { __builtin_amdgcn_s_sleep(1); \
    if ((++_sp & 255u) == 0u) { if (xb_ld(&(bar)[XB_TMO])) break; if (_sp > XB_SPIN_CAP) { atomicAdd(&(bar)[XB_TMO], 1u); break; } } } } while (0)

struct XcdBarrier {
    unsigned* bar; unsigned x;
    volatile LAS unsigned* st;
};

__device__ __forceinline__ XcdBarrier xcd_barrier_post(unsigned* bar, volatile LAS unsigned* st) {
    XcdBarrier b; b.bar = bar; b.x = xb_xcc_id(); b.st = st;
    if (threadIdx.x == 0) (void)xb_add(&bar[XB_XCNT(b.x)], 1u);
    return b;
}
__device__ __forceinline__ void xcd_barrier_complete(unsigned* bar, unsigned x, unsigned& nloc, unsigned& nx) {
    const unsigned G = gridDim.x * gridDim.y * gridDim.z;
    unsigned sum, cnt, mine, sp = 0u;
    for (;;) {
        sum = 0u; cnt = 0u; mine = 0u;
#pragma unroll
        for (unsigned j = 0; j < 16; ++j) { const unsigned c = xb_ld(&bar[XB_XCNT(j)]); sum += c; cnt += (c > 0u) ? 1u : 0u; mine = (j == x) ? c : mine; }
        if (sum == G) break;
        __builtin_amdgcn_s_sleep(1);
        if ((++sp & 255u) == 0u) { if (xb_ld(&bar[XB_TMO])) break; if (sp > XB_SPIN_CAP) { atomicAdd(&bar[XB_TMO], 1u); break; } }
    }
    nloc = mine > 0u ? mine : 1u; nx = cnt > 0u ? cnt : 1u;
}

__device__ __forceinline__ void xcd_barrier(const XcdBarrier& b) {
    asm volatile("s_waitcnt vmcnt(0)" ::: "memory");
    __syncthreads();
    if (threadIdx.x == 0) {
        unsigned* bar = b.bar;
        __builtin_amdgcn_s_waitcnt(0);
        unsigned nloc = b.st[0], nx = b.st[1];
        if (nloc == 0u) { xcd_barrier_complete(bar, b.x, nloc, nx); b.st[0] = nloc; b.st[1] = nx; }
        const unsigned old = xb_add(&bar[XB_XSUB(b.x)], 1u);
        const unsigned gen = old / nloc;
        if (old + 1u == (gen + 1u) * nloc) {
            __builtin_amdgcn_fence(__ATOMIC_RELEASE, "agent");
            asm volatile("s_waitcnt vmcnt(0)" ::: "memory");
            const unsigned og = xb_add(&bar[XB_TOP], 1u);
            const unsigned tg = og / nx;
            if (og + 1u == (tg + 1u) * nx) xb_add(&bar[XB_TOPGEN], 1u);
            else XB_SPIN(xb_ld(&bar[XB_TOPGEN]) == tg, bar);
            __builtin_amdgcn_fence(__ATOMIC_ACQUIRE, "agent");
            xb_add(&bar[XB_XGEN(b.x)], 1u);
            asm volatile("s_waitcnt vmcnt(0)" ::: "memory");
        } else {
            XB_SPIN(xb_ld(&bar[XB_XGEN(b.x)]) == gen, bar);
            __builtin_amdgcn_fence(__ATOMIC_ACQUIRE, "agent");
            asm volatile("s_waitcnt vmcnt(0)" ::: "memory");
        }
    }
    __syncthreads();
}


typedef unsigned short bf16;
typedef unsigned v4u __attribute__((ext_vector_type(4)));
typedef unsigned v2u __attribute__((ext_vector_type(2)));
typedef float v4f __attribute__((ext_vector_type(4)));
typedef float v2f __attribute__((ext_vector_type(2)));

constexpr int DM = 2048, NBATCH = 8, SEQ = 4096, DEPTH = 2, MTOK = NBATCH * SEQ;
constexpr int IN_COLS = 14416, NPROJ = 14592;
constexpr int C_UB = 0, C_VB = 1024, C_ZB = 2048, C_QC = 3072, C_KC = 3584, C_VC = 4096, C_ZC = 5120, C_KROPE = 6144, C_AR = 6208,
              C_CQ = 6400, C_CKV = 6912, C_ZA = 7424, C_GATE = 8448;
constexpr int NBF = C_CQ, NF8 = NPROJ - NBF;
constexpr float EPS = 1e-6f;
#ifndef NBP
#define NBP 4
#endif
constexpr int MP = NBP * SEQ, NPASS = NBATCH / NBP;
constexpr int STEPS_PER_PASS = 7;
constexpr int NSTEPS = DEPTH * NPASS * STEPS_PER_PASS;

constexpr size_t al256(size_t x) { return (x + 255) & ~(size_t)255; }
constexpr size_t WS_CTL = 0, CTL_BYTES = 1u << 20;
constexpr size_t SZ_WINB = (size_t)NBF * DM * 2  , SZ_WIN = SZ_WINB + (size_t)NF8 * DM  , SZ_WUQ = (size_t)1536 * 512 * 2, SZ_WUKV = (size_t)2048 * 512 * 2, SZ_WB = (size_t)3 * 2048 * 1024 * 2, SZ_WO = (size_t)2048 * 2048 * 2;
constexpr size_t SZ_WLAYER = SZ_WIN + SZ_WUQ + SZ_WUKV + SZ_WB + SZ_WO;
constexpr size_t WS_W = CTL_BYTES;
constexpr size_t WS_COS = WS_W + SZ_WLAYER, WS_SIN = WS_COS + (size_t)MTOK * 32 * 4;
constexpr size_t WS_H = WS_SIN + (size_t)MTOK * 32 * 4;
constexpr size_t WS_MG = WS_H;
constexpr size_t WS_PROJ = WS_H + (size_t)MP * DM * 2;
constexpr size_t WS_XB = WS_PROJ + (size_t)MP * NPROJ * 2;
constexpr size_t WS_SSQ = WS_XB + (size_t)MP * 2048;
constexpr size_t WS_Q = WS_SSQ + al256((size_t)3 * MP * 4);
constexpr size_t WS_KV = WS_Q + (size_t)MP * 1536 * 2;
constexpr size_t WS_K = WS_KV + (size_t)MP * 2048 * 2;
constexpr size_t WS_YA = WS_K + (size_t)MP * 1536 * 2;
constexpr size_t WS_YB = WS_YA + (size_t)MP * 1024 * 2;
constexpr size_t WS_DL = WS_YA;
constexpr size_t WS_YC = WS_YB + (size_t)MP * 1024 * 2;
constexpr size_t WS_OC = WS_YC + (size_t)MP * 1024 * 2;
constexpr size_t WS_QE = WS_OC + (size_t)MP * 1024 * 4;
constexpr size_t WS_KE = WS_QE + (size_t)MP * 512 * 2, WS_KL = WS_KE + (size_t)MP * 512 * 2;
constexpr size_t WS_HN = WS_KV;
constexpr size_t WS_H8 = WS_KE;
constexpr size_t WS_DS = WS_KL + (size_t)MP * 512 * 2;
constexpr size_t WS_END = WS_DS + (size_t)(MP / 128) * 512 * 4;
static_assert(WS_END <= ((size_t)1 << 30), "workspace map exceeds 1 GiB");

constexpr int LDS_BYTES = 147456;
constexpr int LDSCTL_OFF = LDS_BYTES - 256;
constexpr int CW_BAR = 4096;

__device__ __forceinline__ float bf2f(unsigned v) { return __uint_as_float(v << 16); }
__device__ __forceinline__ unsigned f2bf(float f) { unsigned u = __float_as_uint(f); return (u + 0x7fffu + ((u >> 16) & 1u)) >> 16; }
__device__ __forceinline__ unsigned pk2(float lo, float hi) { return f2bf(lo) | (f2bf(hi) << 16); }
__device__ __forceinline__ float lo16(unsigned w) { return __uint_as_float(w << 16); }
__device__ __forceinline__ float hi16(unsigned w) { return __uint_as_float(w & 0xffff0000u); }
__device__ __forceinline__ float sigmoid_f(float x) { return 1.f / (1.f + __expf(-x)); }
__device__ __forceinline__ float silu_f(float x) { return x / (1.f + __expf(-x)); }
__device__ __forceinline__ float gelu_f(float x) { const float u2 = 1.5957691216057308f * (x + 0.044715f * x * x * x); return x * __builtin_amdgcn_rcpf(1.f + __expf(-u2)); }
template <int O> __device__ __forceinline__ float lane_xor(float v) {
    if (O == 1) return __uint_as_float((unsigned)__builtin_amdgcn_mov_dpp((int)__float_as_uint(v), 0xB1, 0xf, 0xf, true));
    if (O == 2) return __uint_as_float((unsigned)__builtin_amdgcn_mov_dpp((int)__float_as_uint(v), 0x4E, 0xf, 0xf, true));
    return __uint_as_float((unsigned)__builtin_amdgcn_ds_swizzle((int)__float_as_uint(v), (O << 10) | 0x1f)); }
__device__ __forceinline__ float lane_xor32(float v, int lane) {
    auto rr = __builtin_amdgcn_permlane32_swap(__float_as_uint(v), __float_as_uint(v), false, false);
    return __uint_as_float(lane < 32 ? rr[1] : rr[0]); }
__device__ __forceinline__ float wave_sum(float v) {
    v += lane_xor<1>(v); v += lane_xor<2>(v); v += lane_xor<4>(v); v += lane_xor<8>(v); v += lane_xor<16>(v);
    auto rr = __builtin_amdgcn_permlane32_swap(__float_as_uint(v), __float_as_uint(v), false, false);
    return __uint_as_float(rr[0]) + __uint_as_float(rr[1]); }
__device__ __forceinline__ float wave_max(float v) {
    v = fmaxf(v, lane_xor<1>(v)); v = fmaxf(v, lane_xor<2>(v)); v = fmaxf(v, lane_xor<4>(v)); v = fmaxf(v, lane_xor<8>(v)); v = fmaxf(v, lane_xor<16>(v));
    auto rr = __builtin_amdgcn_permlane32_swap(__float_as_uint(v), __float_as_uint(v), false, false);
    return fmaxf(__uint_as_float(rr[0]), __uint_as_float(rr[1])); }
#define LDS_FENCE() asm volatile("s_waitcnt lgkmcnt(0)" ::: "memory")

struct Args { const void* in[18]; float* out; unsigned char* ws; int lo, hi, pad0, pad1; };

template <int MODE> __device__ __forceinline__ int src_col(int n) {
    if (MODE == 0) return n;
    if (MODE == 2) n += NBF;
    if (n < C_VB) return 2112 + n;
    if (n < C_ZB) return 3136 + (n - C_VB);
    if (n < C_QC) return 4160 + (n - C_ZB);
    if (n < C_KC) return 5184 + (n - C_QC);
    if (n < C_VC) return 5696 + (n - C_KC);
    if (n < C_ZC) return 6208 + (n - C_VC);
    if (n < C_KROPE) return 7248 + (n - C_ZC);
    if (n < C_AR) return 1024 + (n - C_KROPE);
    if (n < C_AR + 16) return 7232 + (n - C_AR);
    if (n < C_CQ) return -1;
    if (n < C_CKV) return n - C_CQ;
    if (n < C_ZA) return 512 + (n - C_CKV);
    if (n < C_GATE) return 1088 + (n - C_ZA);
    return 8272 + (n - C_GATE);
}
template <int MODE> __device__ __forceinline__ void convert_T(const float* W, int K, int Nsrc, bf16* WT, int Ndst, LAS float* tile, int vb, int nvb, const float* kscale = nullptr, int kmask = -1) {
    const int tid = otid(), ntk = K / 64, ntn = Ndst / 64, ntiles = ntk * ntn;
    for (int t = vb; t < ntiles; t += nvb) {
        const int k0 = (t % ntk) * 64, n0 = (t / ntk) * 64;
        { const int nn = tid & 63, sc = src_col<MODE>(n0 + nn), scc = sc >= 0 ? sc : 0; const float mul = sc >= 0 ? 1.f : 0.f;
          float v[8];
#pragma unroll
          for (int i = 0; i < 8; ++i) v[i] = W[(size_t)(k0 + (tid >> 6) + 8 * i) * Nsrc + scc];
          if (kscale) {
#pragma unroll
              for (int i = 0; i < 8; ++i) v[i] *= kscale[(k0 + (tid >> 6) + 8 * i) & kmask]; }
#pragma unroll
          for (int i = 0; i < 8; ++i) tile[((tid >> 6) + 8 * i) * 65 + nn] = v[i] * mul; }
        __syncthreads();
        { const int nn = tid & 63, kg = tid >> 6;
          const LAS float* tp = tile + (kg * 8) * 65 + nn;
          v4u o; o.x = pk2(tp[0], tp[65]); o.y = pk2(tp[2 * 65], tp[3 * 65]); o.z = pk2(tp[4 * 65], tp[5 * 65]); o.w = pk2(tp[6 * 65], tp[7 * 65]);
          *(v4u*)(WT + (size_t)(n0 + nn) * K + k0 + kg * 8) = o; }
        __syncthreads();
    }
}

template <int MODE> __device__ __forceinline__ void convert_T8(const float* W, int K, int Nsrc, unsigned char* WT, int Ndst, float wscale, LAS float* tile, int vb, int nvb, const float* kscale = nullptr) {
    const int tid = otid(), ntk = K / 64, ntn = Ndst / 64, ntiles = ntk * ntn;
    for (int t = vb; t < ntiles; t += nvb) {
        const int k0 = (t % ntk) * 64, n0 = (t / ntk) * 64;
        { const int nn = tid & 63;
          const int sc = src_col<MODE>(n0 + nn);
#pragma unroll
          for (int i = 0; i < 8; ++i) { const int kk = (tid >> 6) + 8 * i; tile[kk * 65 + nn] = W[(size_t)(k0 + kk) * Nsrc + sc] * (kscale ? wscale * kscale[k0 + kk] : wscale); } }
        __syncthreads();
        { const int nn = tid & 63, kg = tid >> 6;
          const LAS float* tp = tile + (kg * 8) * 65 + nn;
          unsigned w0 = 0u, w1 = 0u;
          w0 = __builtin_amdgcn_cvt_pk_fp8_f32(tp[0], tp[65], w0, false); w0 = __builtin_amdgcn_cvt_pk_fp8_f32(tp[2 * 65], tp[3 * 65], w0, true);
          w1 = __builtin_amdgcn_cvt_pk_fp8_f32(tp[4 * 65], tp[5 * 65], w1, false); w1 = __builtin_amdgcn_cvt_pk_fp8_f32(tp[6 * 65], tp[7 * 65], w1, true);
          *(v2u*)(WT + (size_t)(n0 + nn) * K + k0 + kg * 8) = (v2u){w0, w1}; }
        __syncthreads();
    }
}

__device__ __forceinline__ void ph_norm(const float* xin, const float* g, bf16* h, unsigned char* h8, int rows, int vb, int nvb) {
    const int tid_ = otid(); const int lane = tid_ & 63, wave = tid_ >> 6;
    for (int r = vb * 8 + wave; r < rows; r += nvb * 16) {
        const int r2 = r + nvb * 8; const bool two = r2 < rows; const int rb = two ? r2 : r;
        const v4f* xr = (const v4f*)(xin + (size_t)r * DM); const v4f* xs = (const v4f*)(xin + (size_t)rb * DM);
        v4f v[8], u[8]; float ss = 0.f, st = 0.f;
#pragma unroll
        for (int j = 0; j < 8; ++j) { v[j] = xr[lane + 64 * j]; u[j] = xs[lane + 64 * j]; }
#pragma unroll
        for (int j = 0; j < 8; ++j) { ss += v[j].x * v[j].x + v[j].y * v[j].y + v[j].z * v[j].z + v[j].w * v[j].w; st += u[j].x * u[j].x + u[j].y * u[j].y + u[j].z * u[j].z + u[j].w * u[j].w; }
        ss = wave_sum(ss); st = wave_sum(st);
        const float rn = 1.0f / sqrtf(ss * (1.0f / DM) + EPS), rm = 1.0f / sqrtf(st * (1.0f / DM) + EPS);
#pragma unroll
        for (int j = 0; j < 8; ++j) { const v4f gg = ((const v4f*)g)[lane + 64 * j];
            { const float y0 = v[j].x * rn * gg.x, y1 = v[j].y * rn * gg.y, y2 = v[j].z * rn * gg.z, y3 = v[j].w * rn * gg.w;
              v2u o; o.x = pk2(y0, y1); o.y = pk2(y2, y3);
              *(v2u*)(h + (size_t)r * DM + (lane + 64 * j) * 4) = o;
              unsigned w8 = 0u; w8 = __builtin_amdgcn_cvt_pk_fp8_f32(y0, y1, w8, false); w8 = __builtin_amdgcn_cvt_pk_fp8_f32(y2, y3, w8, true);
              *(unsigned*)(h8 + (size_t)r * DM + (lane + 64 * j) * 4) = w8; }
            if (two) { const float y0 = u[j].x * rm * gg.x, y1 = u[j].y * rm * gg.y, y2 = u[j].z * rm * gg.z, y3 = u[j].w * rm * gg.w;
              v2u o; o.x = pk2(y0, y1); o.y = pk2(y2, y3);
              *(v2u*)(h + (size_t)r2 * DM + (lane + 64 * j) * 4) = o;
              unsigned w8 = 0u; w8 = __builtin_amdgcn_cvt_pk_fp8_f32(y0, y1, w8, false); w8 = __builtin_amdgcn_cvt_pk_fp8_f32(y2, y3, w8, true);
              *(unsigned*)(h8 + (size_t)r2 * DM + (lane + 64 * j) * 4) = w8; } }
    }
}
__device__ __forceinline__ float row16_sum(float v) {
    v += __uint_as_float((unsigned)__builtin_amdgcn_mov_dpp((int)__float_as_uint(v), 0xB1, 0xf, 0xf, true));
    v += __uint_as_float((unsigned)__builtin_amdgcn_mov_dpp((int)__float_as_uint(v), 0x4E, 0xf, 0xf, true));
    v += __uint_as_float((unsigned)__builtin_amdgcn_mov_dpp((int)__float_as_uint(v), 0x141, 0xf, 0xf, true));
    v += __uint_as_float((unsigned)__builtin_amdgcn_mov_dpp((int)__float_as_uint(v), 0x140, 0xf, 0xf, true));
    return v; }
__device__ __forceinline__ void ph_vt8(const unsigned char* kv, unsigned char* V8T, int vb, int nvb) {
    const int tid = otid(), quad = tid & 31, oct = tid >> 5, g = quad >> 3, u = quad & 7, key0 = 32 * g + (u < 4 ? 8 * u : 8 * (u - 4) + 4);
    for (int it = vb; it < NBP * 8 * (SEQ / 128); it += nvb) {
        const int bh = it / (SEQ / 128), blk = it - bh * (SEQ / 128), bl = bh >> 3, h = bh & 7;
        const unsigned char* src = kv + (size_t)(bl * SEQ + blk * 128 + key0) * 2048 + h * 256 + 128 + oct * 8;
        v2u w[4];
#pragma unroll
        for (int kk = 0; kk < 4; ++kk) w[kk] = *(const v2u*)(src + (size_t)kk * 2048);
        unsigned char* dst = V8T + ((size_t)bh * 128 + oct * 8) * SEQ + blk * 128 + quad * 4;
#pragma unroll
        for (int j = 0; j < 8; ++j) {
            const unsigned e0 = j < 4 ? w[0].x : w[0].y, e1 = j < 4 ? w[1].x : w[1].y, e2 = j < 4 ? w[2].x : w[2].y, e3 = j < 4 ? w[3].x : w[3].y;
            const unsigned sel = (unsigned)(((4 + (j & 3)) << 8) | (j & 3)) | 0x0c0c0000u;
            const unsigned t01 = __builtin_amdgcn_perm(e1, e0, sel), t23 = __builtin_amdgcn_perm(e3, e2, sel);
            *(unsigned*)(dst + (size_t)j * SEQ) = t01 | (t23 << 16); }
    }
}
__device__ __forceinline__ float f8v(const v2u w, int j) { const int d = (int)(j < 4 ? w.x : w.y); const int b = j & 3;
    return (b == 0 ? __builtin_amdgcn_cvt_f32_fp8(d, 0) : b == 1 ? __builtin_amdgcn_cvt_f32_fp8(d, 1) : b == 2 ? __builtin_amdgcn_cvt_f32_fp8(d, 2) : __builtin_amdgcn_cvt_f32_fp8(d, 3)) * 0.125f; }
#define KPOS(ch) (64 * ((ch) >> 3) + 32 * ((ch) & 1) + 8 * (((ch) >> 1) & 3))
__device__ __forceinline__ v2u pk8_fp8(const float (&x)[8]) {
    int a = __builtin_amdgcn_cvt_pk_fp8_f32(x[0], x[1], 0, false); a = __builtin_amdgcn_cvt_pk_fp8_f32(x[2], x[3], a, true);
    int b = __builtin_amdgcn_cvt_pk_fp8_f32(x[4], x[5], 0, false); b = __builtin_amdgcn_cvt_pk_fp8_f32(x[6], x[7], b, true);
    v2u w; w.x = (unsigned)a; w.y = (unsigned)b; return w; }
__device__ __forceinline__ void ph_kfin(const unsigned char* kv, const bf16* proj, unsigned char* K, const float* kg, const float* cosT, const float* sinT, int row0, int vb, int nvb) {
    const int tid_ = otid(); const int lane = tid_ & 63, wave = tid_ >> 6, g16 = lane >> 4, c = lane & 15;
    float gn[8], gr[8];
#pragma unroll
    for (int j = 0; j < 8; ++j) { gn[j] = kg[c * 8 + j]; gr[j] = kg[128 + (c & 7) * 8 + j]; }
    for (int r = vb * 8 + wave; r < MP; r += nvb * 8) {
        const v2u n0 = *(const v2u*)(kv + (size_t)r * 2048 + g16 * 256 + c * 8), n1 = *(const v2u*)(kv + (size_t)r * 2048 + (g16 + 4) * 256 + c * 8);
        const v4u rw = *(const v4u*)(proj + (size_t)r * NPROJ + C_KROPE + (c & 7) * 8);
        const v4f c0 = *(const v4f*)(cosT + (size_t)(row0 + r) * 32 + (c & 3) * 8), c1 = *(const v4f*)(cosT + (size_t)(row0 + r) * 32 + (c & 3) * 8 + 4);
        const v4f s0 = *(const v4f*)(sinT + (size_t)(row0 + r) * 32 + (c & 3) * 8), s1 = *(const v4f*)(sinT + (size_t)(row0 + r) * 32 + (c & 3) * 8 + 4);
        float a[8] = {f8v(n0, 0), f8v(n0, 1), f8v(n0, 2), f8v(n0, 3), f8v(n0, 4), f8v(n0, 5), f8v(n0, 6), f8v(n0, 7)};
        float b[8] = {f8v(n1, 0), f8v(n1, 1), f8v(n1, 2), f8v(n1, 3), f8v(n1, 4), f8v(n1, 5), f8v(n1, 6), f8v(n1, 7)};
        float kr[8] = {lo16(rw.x), hi16(rw.x), lo16(rw.y), hi16(rw.y), lo16(rw.z), hi16(rw.z), lo16(rw.w), hi16(rw.w)};
        const float cs[8] = {c0.x, c0.y, c0.z, c0.w, c1.x, c1.y, c1.z, c1.w}, sn[8] = {s0.x, s0.y, s0.z, s0.w, s1.x, s1.y, s1.z, s1.w};
        float sa = 0.f, sb = 0.f, sr = 0.f;
#pragma unroll
        for (int j = 0; j < 8; ++j) { sa += a[j] * a[j]; sb += b[j] * b[j]; sr += kr[j] * kr[j]; }
        if (c >= 8) sr = 0.f;
        sa = row16_sum(sa); sb = row16_sum(sb); sr = row16_sum(sr);
        const float rna = 1.0f / sqrtf((sa + sr) * (1.0f / 192.f) + EPS), rnb = 1.0f / sqrtf((sb + sr) * (1.0f / 192.f) + EPS);
        float R[8];
#pragma unroll
        for (int j = 0; j < 8; ++j) { const float mine = kr[j] * gr[j]; const float oth = lane_xor<4>(mine);
            R[j] = (c & 4) ? mine * cs[j] + oth * sn[j] : mine * cs[j] - oth * sn[j]; }
        unsigned char* ka = K + ((size_t)r * 8 + g16) * 192; unsigned char* kb = K + ((size_t)r * 8 + g16 + 4) * 192;
        { float x[8], y[8];
#pragma unroll
          for (int j = 0; j < 8; ++j) { x[j] = a[j] * rna * gn[j] * 8.0f; y[j] = b[j] * rnb * gn[j] * 8.0f; }
          *(v2u*)(ka + KPOS(c)) = pk8_fp8(x); *(v2u*)(kb + KPOS(c)) = pk8_fp8(y); }
        if (c < 8) { float x[8], y[8];
#pragma unroll
          for (int j = 0; j < 8; ++j) { x[j] = R[j] * rna * 8.0f; y[j] = R[j] * rnb * 8.0f; }
          *(v2u*)(ka + KPOS(16 + c)) = pk8_fp8(x); *(v2u*)(kb + KPOS(16 + c)) = pk8_fp8(y); }
    }
}

namespace at {
typedef short bf16x8 __attribute__((ext_vector_type(8)));
typedef short s16x4 __attribute__((ext_vector_type(4)));
typedef float f32x16 __attribute__((ext_vector_type(16)));
typedef unsigned u32x4 __attribute__((ext_vector_type(4)));
constexpr int SHM_V = 16384, SHM_K = 16384, SHM_KR = 8192;
constexpr int OFF_V = 0, OFF_K = 3 * SHM_V, OFF_KR = OFF_K + 2 * SHM_K, OFF_WS = OFF_KR + 2 * SHM_KR, LDS_NEED = OFF_WS + 8 * 64 * 4;
constexpr float SCALE = 0.07216878364870322f;
constexpr float THR = 4.f;
#define AT_KSWZ(row, colB) ((row) * 256 + ((colB) ^ (((row) & 7) << 4)))
#define AT_KRSWZ(row, colB) ((row) * 128 + ((colB) ^ (((row) & 7) << 4)))
#define AT_SBAR() __builtin_amdgcn_sched_barrier(0)
__device__ __forceinline__ int v_st(int k, int c) { const int kk = (k & ~0xC) | ((k & 4) << 1) | ((k & 8) >> 1); return ((kk >> 3) * 4 + (c >> 5)) * 512 + ((kk & 7) * 32 + (c & 31)) * 2; }
__device__ __forceinline__ int v_rd_base(int lane) { return ((lane & 3) << 3) | (((lane >> 2) & 3) << 6) | (((lane >> 4) & 1) << 5) | (((lane >> 5) & 1) << 8); }
constexpr int v_rd_off(int d0, int ks, int half) { return d0 * 512 + ks * 4096 + half * 2048; }
__device__ __forceinline__ int crow(int r, int hi) { return (r & 3) + 8 * (r >> 2) + 4 * hi; }
__device__ __forceinline__ unsigned cvtpk(float lo, float hi) { unsigned r; asm("v_cvt_pk_bf16_f32 %0, %1, %2" : "=v"(r) : "v"(lo), "v"(hi)); return r; }

__device__ __forceinline__ void mask_tile(f32x16& p0, f32x16& p1, int dq) {
    const float NEG = -__builtin_inff();
#pragma unroll
    for (int r = 0; r < 16; ++r) { const int c = (r & 3) + 8 * (r >> 2); if (dq < c) p0[r] = NEG; if (dq < c + 32) p1[r] = NEG; }
}
__device__ __forceinline__ void partialSM(f32x16& p0, f32x16& p1, float& m_reg, float& mn, float& alpha) {
    float pmax = p0[0];
#pragma unroll
    for (int r = 1; r < 16; ++r) pmax = fmaxf(pmax, p0[r]);
#pragma unroll
    for (int r = 0; r < 16; ++r) pmax = fmaxf(pmax, p1[r]);
    { auto rr = __builtin_amdgcn_permlane32_swap(__float_as_uint(pmax), __float_as_uint(pmax), false, false);
      pmax = fmaxf(__uint_as_float(rr[0]), __uint_as_float(rr[1])); }
    constexpr float C2 = 1.4426950408889634f * SCALE;
    if (__builtin_expect(__all((pmax - m_reg) * SCALE <= THR), 1)) { mn = m_reg; alpha = 1.f; }
    else { mn = fmaxf(m_reg, pmax); alpha = __builtin_amdgcn_exp2f((m_reg - mn) * C2); m_reg = mn; }
    const float mnL = 2.0f - mn * C2;
#pragma unroll
    for (int r = 0; r < 16; ++r) p0[r] = fmaf(p0[r], C2, mnL);
#pragma unroll
    for (int r = 0; r < 16; ++r) p1[r] = fmaf(p1[r], C2, mnL);
#pragma unroll
    for (int r = 0; r < 16; ++r) p0[r] = __builtin_amdgcn_exp2f(p0[r]);
}
__device__ __forceinline__ void finishSM(f32x16& p0, f32x16& p1, float alpha, float& l_reg, bf16x8& pa0, bf16x8& pa1, bf16x8& pa2, bf16x8& pa3) {
#pragma unroll
    for (int r = 0; r < 16; ++r) p1[r] = __builtin_amdgcn_exp2f(p1[r]);
    float ps = 0;
#pragma unroll
    for (int r = 0; r < 16; ++r) ps += p0[r];
#pragma unroll
    for (int r = 0; r < 16; ++r) ps += p1[r];
    { auto rr = __builtin_amdgcn_permlane32_swap(__float_as_uint(ps), __float_as_uint(ps), false, false);
      ps = __uint_as_float(rr[0]) + __uint_as_float(rr[1]); }
    l_reg = l_reg * alpha + ps;
#define AT_PK4(P, B_, OUT) do { unsigned a0 = cvtpk(P[B_+0], P[B_+1]), a1 = cvtpk(P[B_+2], P[B_+3]);                          \
        unsigned b0 = cvtpk(P[B_+4], P[B_+5]), b1 = cvtpk(P[B_+6], P[B_+7]);                                             \
        auto r0 = __builtin_amdgcn_permlane32_swap(a0, b0, false, false); auto r1 = __builtin_amdgcn_permlane32_swap(a1, b1, false, false); \
        u32x4 w = {r0[0], r1[0], r0[1], r1[1]}; OUT = *reinterpret_cast<bf16x8*>(&w); } while (0)
    AT_PK4(p0, 0, pa0); AT_PK4(p0, 8, pa1); AT_PK4(p1, 0, pa2); AT_PK4(p1, 8, pa3);
#undef AT_PK4
}
typedef int i32x8 __attribute__((ext_vector_type(8)));
typedef int i32x4 __attribute__((ext_vector_type(4)));
__device__ __forceinline__ void finishSM8(f32x16& p0, f32x16& p1, float alpha, float& l_reg, i32x8& pop) {
#pragma unroll
    for (int r = 0; r < 16; ++r) p1[r] = __builtin_amdgcn_exp2f(p1[r]);
    float ps = 0;
#pragma unroll
    for (int r = 0; r < 16; ++r) ps += p0[r];
#pragma unroll
    for (int r = 0; r < 16; ++r) ps += p1[r];
    { auto rr = __builtin_amdgcn_permlane32_swap(__float_as_uint(ps), __float_as_uint(ps), false, false);
      ps = __uint_as_float(rr[0]) + __uint_as_float(rr[1]); }
    l_reg = l_reg * alpha + ps;
#pragma unroll
    for (int a = 0; a < 4; ++a) {
        int d0 = __builtin_amdgcn_cvt_pk_fp8_f32(p0[4 * a], p0[4 * a + 1], 0, false); d0 = __builtin_amdgcn_cvt_pk_fp8_f32(p0[4 * a + 2], p0[4 * a + 3], d0, true);
        int d1 = __builtin_amdgcn_cvt_pk_fp8_f32(p1[4 * a], p1[4 * a + 1], 0, false); d1 = __builtin_amdgcn_cvt_pk_fp8_f32(p1[4 * a + 2], p1[4 * a + 3], d1, true);
        auto sw = __builtin_amdgcn_permlane32_swap((unsigned)d0, (unsigned)d1, false, false);
        pop[a] = (int)sw[0]; pop[4 + a] = (int)sw[1]; }
}
constexpr int V8_PITCH = 80, SHM_V8 = 128 * V8_PITCH;
template <int PITCH = V8_PITCH> __device__ __forceinline__ void pv8(f32x16* o, const LAS unsigned char* vimg, int r32, int hi, const i32x8 pop) {
    const LAS unsigned char* a0 = vimg + r32 * PITCH + hi * 32;
    i32x8 f[4];
#pragma unroll
    for (int d0 = 0; d0 < 4; ++d0) f[d0] = __builtin_shufflevector(*(const LAS i32x4*)(a0 + d0 * 32 * PITCH), *(const LAS i32x4*)(a0 + d0 * 32 * PITCH + 16), 0, 1, 2, 3, 4, 5, 6, 7);
#pragma unroll
    for (int d0 = 0; d0 < 4; ++d0) o[d0] = __builtin_amdgcn_mfma_scale_f32_32x32x64_f8f6f4(f[d0], pop, o[d0], 0, 0, 0, 0x7f7f7f7f, 0, 0x7f7f7f7f);
}
constexpr int K8_PITCH = 208, SHM_K8 = 64 * K8_PITCH;
constexpr int V8D_PITCH = 144, SHM_V8D = 128 * V8D_PITCH, SHM_K8D = 128 * K8_PITCH, OFF_K8D = 3 * SHM_V8D;
__device__ __forceinline__ void qkt8(f32x16& p0, f32x16& p1, const LAS unsigned char* Kb, int r32, int hi, const i32x8* q8) {
    p0 = f32x16{}; p1 = f32x16{};
    const LAS unsigned char* a0 = Kb + r32 * K8_PITCH + hi * 32;
    i32x8 f[6];
#pragma unroll
    for (int b = 0; b < 3; ++b) {
        f[2 * b] = __builtin_shufflevector(*(const LAS i32x4*)(a0 + 64 * b), *(const LAS i32x4*)(a0 + 64 * b + 16), 0, 1, 2, 3, 4, 5, 6, 7);
        f[2 * b + 1] = __builtin_shufflevector(*(const LAS i32x4*)(a0 + 32 * K8_PITCH + 64 * b), *(const LAS i32x4*)(a0 + 32 * K8_PITCH + 64 * b + 16), 0, 1, 2, 3, 4, 5, 6, 7); }
#pragma unroll
    for (int b = 0; b < 3; ++b) {
        p0 = __builtin_amdgcn_mfma_scale_f32_32x32x64_f8f6f4(f[2 * b], q8[b], p0, 0, 0, 0, 0x7c7c7c7c, 0, 0x7c7c7c7c);
        p1 = __builtin_amdgcn_mfma_scale_f32_32x32x64_f8f6f4(f[2 * b + 1], q8[b], p1, 0, 0, 0, 0x7c7c7c7c, 0, 0x7c7c7c7c); }
    __builtin_amdgcn_sched_group_barrier(0x100, 8, 0); __builtin_amdgcn_sched_group_barrier(0x008, 2, 0); __builtin_amdgcn_sched_group_barrier(0x100, 4, 0); __builtin_amdgcn_sched_group_barrier(0x008, 4, 0);
}
__device__ __forceinline__ void qkt(f32x16& p0, f32x16& p1, const LAS unsigned char* Kb, const LAS unsigned char* KRb, int r32, int hi, const bf16x8* qr) {
    p0 = f32x16{}; p1 = f32x16{};
    const LAS unsigned char* kb[4]; const LAS unsigned char* krb[4];
#pragma unroll
    for (int dd = 0; dd < 4; ++dd) { kb[dd] = Kb + AT_KSWZ(r32, (dd * 16 + hi * 8) * 2); krb[dd] = KRb + AT_KRSWZ(r32, (dd * 16 + hi * 8) * 2); }
    bf16x8 f[24];
#pragma unroll
    for (int d0 = 0; d0 < 8; ++d0) { const LAS unsigned char* a = kb[d0 & 3] + (d0 >> 2) * 128;
        f[2 * d0] = *reinterpret_cast<const LAS bf16x8*>(a); f[2 * d0 + 1] = *reinterpret_cast<const LAS bf16x8*>(a + 32 * 256); }
#pragma unroll
    for (int d0 = 0; d0 < 4; ++d0) { const LAS unsigned char* a = krb[d0];
        f[16 + 2 * d0] = *reinterpret_cast<const LAS bf16x8*>(a); f[16 + 2 * d0 + 1] = *reinterpret_cast<const LAS bf16x8*>(a + 32 * 128); }
#pragma unroll
    for (int d0 = 0; d0 < 12; ++d0) {
        p0 = __builtin_amdgcn_mfma_f32_32x32x16_bf16(f[2 * d0], qr[d0], p0, 0, 0, 0);
        p1 = __builtin_amdgcn_mfma_f32_32x32x16_bf16(f[2 * d0 + 1], qr[d0], p1, 0, 0, 0); }
    __builtin_amdgcn_sched_group_barrier(0x100, 4, 0);
#pragma unroll
    for (int i = 0; i < 20; ++i) { __builtin_amdgcn_sched_group_barrier(0x008, 1, 0); __builtin_amdgcn_sched_group_barrier(0x100, 1, 0); }
    __builtin_amdgcn_sched_group_barrier(0x008, 4, 0);
}
template <bool SWAP = false> __device__ __forceinline__ void pv_tile(f32x16* o, unsigned vb0, bf16x8 pa0, bf16x8 pa1, bf16x8 pa2, bf16x8 pa3) {
#define AT_TRRD(dst, off) asm volatile("ds_read_b64_tr_b16 %0, %1 offset:%2" : "=&v"(dst) : "v"(vb0), "i"(off) : "memory")
#define AT_PV_RD(d0, L, H) do { constexpr int b_ = v_rd_off(d0, 0, 0); \
        AT_TRRD(L[0], b_); AT_TRRD(H[0], b_ + 2048); AT_TRRD(L[1], b_ + 4096); AT_TRRD(H[1], b_ + 6144); AT_TRRD(L[2], b_ + 8192); AT_TRRD(H[2], b_ + 10240); AT_TRRD(L[3], b_ + 12288); AT_TRRD(H[3], b_ + 14336); } while (0)
#define AT_PV_M1(d0, P, L, H, q) do { const bf16x8 vf_ = (bf16x8){L[q][0], L[q][1], L[q][2], L[q][3], H[q][0], H[q][1], H[q][2], H[q][3]}; \
        if constexpr (SWAP) o[d0] = __builtin_amdgcn_mfma_f32_32x32x16_bf16(vf_, P, o[d0], 0, 0, 0); else o[d0] = __builtin_amdgcn_mfma_f32_32x32x16_bf16(P, vf_, o[d0], 0, 0, 0); } while (0)
#define AT_PV_MM(d0, L, H) do { AT_PV_M1(d0, pa0, L, H, 0); AT_PV_M1(d0, pa1, L, H, 1); AT_PV_M1(d0, pa2, L, H, 2); AT_PV_M1(d0, pa3, L, H, 3); } while (0)
    s16x4 la[4], ha[4], lb[4], hb[4];
    asm volatile("s_waitcnt lgkmcnt(0)" ::: "memory");
    AT_PV_RD(0, la, ha); AT_PV_RD(1, lb, hb);
    asm volatile("s_waitcnt lgkmcnt(8)" ::: "memory"); AT_SBAR(); AT_PV_MM(0, la, ha); AT_SBAR();
    AT_PV_RD(2, la, ha);
    asm volatile("s_waitcnt lgkmcnt(8)" ::: "memory"); AT_SBAR(); AT_PV_MM(1, lb, hb); AT_SBAR();
    AT_PV_RD(3, lb, hb);
    asm volatile("s_waitcnt lgkmcnt(8)" ::: "memory"); AT_SBAR(); AT_PV_MM(2, la, ha); AT_SBAR();
    asm volatile("s_waitcnt lgkmcnt(0)" ::: "memory"); AT_SBAR(); AT_PV_MM(3, lb, hb);
#undef AT_PV_RD
#undef AT_PV_MM
#undef AT_PV_M1
#undef AT_TRRD
}

__device__ __forceinline__ void attn_block(LAS unsigned char* lds, const unsigned char* Q, const unsigned char* K, const unsigned char* V8T, const bf16* proj, bf16* YA, const float* qg, const float* cosT, const float* sinT, int b, int h, int qb) {
    const int tid = otid(), wid = __builtin_amdgcn_readfirstlane(tid >> 6), lane = tid & 63, r32 = lane & 31, hi = lane >> 5;
    const int P0 = qb * 256, NT = 4 * (qb + 1), qlo = P0 + wid * 32;
    LAS unsigned char* V_lds = lds + OFF_V; LAS unsigned char* K_lds = lds + OFF_K;
    LAS float* wsf = (LAS float*)(lds + OFF_WS) + wid * 64; LAS float* li_l = wsf; LAS float* al_l = wsf + 32;
    i32x8 q8[3];
    { const unsigned char* qp = Q + ((size_t)(b * SEQ + qlo + r32) * 8 + h) * 192 + hi * 8;
      v2u raw[12];
#pragma unroll
      for (int d0 = 0; d0 < 12; ++d0) raw[d0] = *(const v2u*)(qp + d0 * 16);
      float ss = 0.f;
#pragma unroll
      for (int d0 = 0; d0 < 12; ++d0)
#pragma unroll
          for (int j = 0; j < 8; ++j) { const float v = f8v(raw[d0], j); ss += v * v; }
      { auto rr = __builtin_amdgcn_permlane32_swap(__float_as_uint(ss), __float_as_uint(ss), false, false); ss = __uint_as_float(rr[0]) + __uint_as_float(rr[1]); }
      const float rn = 1.0f / sqrtf(ss * (1.0f / 192.f) + EPS);
#pragma unroll
      for (int d0 = 0; d0 < 12; ++d0) asm volatile("" : "+v"(raw[d0]));
      const float* ct = cosT + (size_t)(b * SEQ + qlo + r32) * 32 + hi * 8; const float* st = sinT + (size_t)(b * SEQ + qlo + r32) * 32 + hi * 8;
#pragma unroll
      for (int d0 = 0; d0 < 8; ++d0) { const v4f g0 = *(const v4f*)(qg + d0 * 16 + hi * 8), g1 = *(const v4f*)(qg + d0 * 16 + hi * 8 + 4);
          const float g[8] = {g0.x, g0.y, g0.z, g0.w, g1.x, g1.y, g1.z, g1.w}; float x[8];
#pragma unroll
          for (int j = 0; j < 8; ++j) x[j] = f8v(raw[d0], j) * rn * g[j] * 8.0f;
          const v2u w = pk8_fp8(x); q8[d0 >> 2][2 * (d0 & 3)] = (int)w.x; q8[d0 >> 2][2 * (d0 & 3) + 1] = (int)w.y; }
#pragma unroll
      for (int d0 = 8; d0 < 10; ++d0) { const int i0 = (d0 - 8) * 16;
          const v4f ga0 = *(const v4f*)(qg + d0 * 16 + hi * 8), ga1 = *(const v4f*)(qg + d0 * 16 + hi * 8 + 4), gb0 = *(const v4f*)(qg + (d0 + 2) * 16 + hi * 8), gb1 = *(const v4f*)(qg + (d0 + 2) * 16 + hi * 8 + 4);
          const v4f c0 = *(const v4f*)(ct + i0), c1 = *(const v4f*)(ct + i0 + 4), s0 = *(const v4f*)(st + i0), s1 = *(const v4f*)(st + i0 + 4);
          const float ga[8] = {ga0.x, ga0.y, ga0.z, ga0.w, ga1.x, ga1.y, ga1.z, ga1.w}, gb[8] = {gb0.x, gb0.y, gb0.z, gb0.w, gb1.x, gb1.y, gb1.z, gb1.w};
          const float cs[8] = {c0.x, c0.y, c0.z, c0.w, c1.x, c1.y, c1.z, c1.w}, sn[8] = {s0.x, s0.y, s0.z, s0.w, s1.x, s1.y, s1.z, s1.w};
          float y1[8], y2[8];
#pragma unroll
          for (int j = 0; j < 8; ++j) { const float x1 = f8v(raw[d0], j) * rn * ga[j], x2 = f8v(raw[d0 + 2], j) * rn * gb[j];
              y1[j] = (x1 * cs[j] - x2 * sn[j]) * 8.0f; y2[j] = (x2 * cs[j] + x1 * sn[j]) * 8.0f; }
          const v2u w1 = pk8_fp8(y1), w2 = pk8_fp8(y2);
          q8[2][2 * (d0 & 3)] = (int)w1.x; q8[2][2 * (d0 & 3) + 1] = (int)w1.y; q8[2][2 * ((d0 + 2) & 3)] = (int)w2.x; q8[2][2 * ((d0 + 2) & 3) + 1] = (int)w2.y; }
    }
    LAS unsigned char* K_ld2 = lds + OFF_K8D;
    const int kd0 = tid / 12, kc0 = tid - 12 * kd0, kd1 = (tid + 512) / 12, kc1 = (tid + 512) - 12 * kd1, kd2 = (tid + 1024) / 12, kc2 = (tid + 1024) - 12 * kd2;
    const int vdv = tid >> 3, vc16 = (tid & 7) * 16;
    const unsigned char* Kg = K + ((size_t)(b * SEQ) * 8 + h) * 192;
    const unsigned char* Vg = V8T + ((size_t)(b * 8 + h) * 128 + vdv) * SEQ + vc16;
    bf16x8 s_k0, s_k1, s_k2, s_v0, s_v1;
#define AT_SLOAD(kb_) do { s_k0 = *(const bf16x8*)(Kg + (size_t)((kb_) + kd0) * 1536 + kc0 * 16); s_k1 = *(const bf16x8*)(Kg + (size_t)((kb_) + kd1) * 1536 + kc1 * 16); \
        s_k2 = *(const bf16x8*)(Kg + (size_t)((kb_) + kd2) * 1536 + kc2 * 16); s_v0 = *(const bf16x8*)(Vg + (kb_)); s_v1 = *(const bf16x8*)(Vg + (size_t)64 * SEQ + (kb_)); } while (0)
#define AT_SWRITE(bf, vbf) do { *(LAS bf16x8*)(K_ld2 + (bf) * SHM_K8D + kd0 * K8_PITCH + kc0 * 16) = s_k0; *(LAS bf16x8*)(K_ld2 + (bf) * SHM_K8D + kd1 * K8_PITCH + kc1 * 16) = s_k1; \
        *(LAS bf16x8*)(K_ld2 + (bf) * SHM_K8D + kd2 * K8_PITCH + kc2 * 16) = s_k2; \
        *(LAS bf16x8*)(V_lds + (vbf) * SHM_V8D + vdv * V8D_PITCH + vc16) = s_v0; *(LAS bf16x8*)(V_lds + (vbf) * SHM_V8D + (vdv + 64) * V8D_PITCH + vc16) = s_v1; } while (0)
    const int NT2 = NT / 2;
    AT_SLOAD(0); AT_SWRITE(0, 0);
    __syncthreads();
    float m_reg = -1e30f, l_reg = 0.f; f32x16 o[4] = {};
    const bool late = wid >= 4;
    bool pend = false; int pvo = 0; int vb3 = 0;
    i32x8 pop;
#define AT_HALF(T, hf) do { const int kb = (T) * 128 + (hf) * 64; \
        if (late && pend) { pv8<V8D_PITCH>(o, V_lds + pvo, r32, hi, pop); pend = false; AT_SBAR(); } \
        if (kb <= qlo + 31) { \
            f32x16 p0, p1; float mn, alpha; \
            qkt8(p0, p1, K_ld2 + buf * SHM_K8D + (hf) * 64 * K8_PITCH, r32, hi, q8); \
            if (kb + 63 > qlo) mask_tile(p0, p1, qlo + r32 - 4 * hi - kb); \
            partialSM(p0, p1, m_reg, mn, alpha); \
            finishSM8(p0, p1, alpha, l_reg, pop); \
            if (__any(alpha < 1.f)) { _Pragma("unroll") for (int d_ = 0; d_ < 4; ++d_) _Pragma("unroll") for (int r = 0; r < 16; ++r) o[d_][r] *= alpha; } \
            AT_SBAR(); \
            if (late) { pend = true; pvo = vb3 * SHM_V8D + (hf) * 64; } \
            else pv8<V8D_PITCH>(o, V_lds + vb3 * SHM_V8D + (hf) * 64, r32, hi, pop); \
        } } while (0)
    for (int T = 0; T < NT2; ++T) {
        const int buf = T & 1;
        if (T + 1 < NT2) AT_SLOAD((T + 1) * 128);
        AT_HALF(T, 0); AT_HALF(T, 1);
        const int vn3 = vb3 == 2 ? 0 : vb3 + 1;
        if (T + 1 < NT2) AT_SWRITE(buf ^ 1, vn3);
        vb3 = vn3;
        __syncthreads();
    }
#undef AT_HALF
    if (late && pend) pv8<V8D_PITCH>(o, V_lds + pvo, r32, hi, pop);
    { const size_t row = (size_t)(b * SEQ + qlo + r32);
      const bf16* zp = proj + row * NPROJ + C_ZA + h * 128 + 8 * hi;
      u32x4 zw[8];
#pragma unroll
      for (int i = 0; i < 8; ++i) zw[i] = *(const u32x4*)(zp + 16 * i);
      const float rl = 2.0f / l_reg;
      unsigned char* yp = (unsigned char*)YA + row * 1024 + h * 128 + 8 * hi;
#pragma unroll
      for (int i = 0; i < 8; ++i) { const int d0 = i >> 1, j = i & 1;
          auto z0 = __builtin_amdgcn_permlane32_swap(zw[i].x, zw[i].z, false, false); auto z1 = __builtin_amdgcn_permlane32_swap(zw[i].y, zw[i].w, false, false);
          const unsigned z4[4] = {z0[0], z1[0], z0[1], z1[1]};
          float y[8];
#pragma unroll
          for (int k = 0; k < 4; ++k) { y[2 * k] = o[d0][8 * j + 2 * k] * rl * silu_f(__uint_as_float(z4[k] << 16)); y[2 * k + 1] = o[d0][8 * j + 2 * k + 1] * rl * silu_f(__uint_as_float(z4[k] & 0xffff0000u)); }
          int q0 = __builtin_amdgcn_cvt_pk_fp8_f32(y[0], y[1], 0, false); q0 = __builtin_amdgcn_cvt_pk_fp8_f32(y[2], y[3], q0, true);
          int q1 = __builtin_amdgcn_cvt_pk_fp8_f32(y[4], y[5], 0, false); q1 = __builtin_amdgcn_cvt_pk_fp8_f32(y[6], y[7], q1, true);
          auto sw = __builtin_amdgcn_permlane32_swap((unsigned)q0, (unsigned)q1, false, false);
          v2u w; w.x = sw[0]; w.y = sw[1]; *(v2u*)(yp + 16 * i) = w; } }
    asm volatile("s_waitcnt lgkmcnt(0)" ::: "memory");
    __syncthreads();
#undef AT_SLOAD
#undef AT_SWRITE
}
}


namespace sg {
using at::bf16x8; using at::f32x16;
__device__ __forceinline__ void sgu_item(LAS unsigned char* lds, const bf16* proj, const float* rv, const float* Ws, const float* bs, const float* vg, bf16* YB, int it) {
    const int tid = otid(), wid = __builtin_amdgcn_readfirstlane(tid >> 6), lane = tid & 63, r32 = lane & 31, hi = lane >> 5;
    {
        const int ch = it >> 2, gp = it & 3, R0 = ch * 128;
        { const int cc = tid & 15;
          v4f g0a = *(const v4f*)(vg + (2 * gp) * 128 + cc * 8), g0b = *(const v4f*)(vg + (2 * gp) * 128 + cc * 8 + 4), g1a = *(const v4f*)(vg + (2 * gp + 1) * 128 + cc * 8), g1b = *(const v4f*)(vg + (2 * gp + 1) * 128 + cc * 8 + 4);
#pragma unroll
          for (int i = 0; i < 8; ++i) {
            const int idx = tid + 512 * i, gsel = i >> 2, row = (idx >> 4) & 127;
            const v4u w = *(const v4u*)(proj + (size_t)(R0 + row) * NPROJ + C_VB + (2 * gp + gsel) * 128 + cc * 8);
            const float s = 1.0f / sqrtf(rv[R0 + row] * (1.0f / 1024.f) + EPS);
            const v4f ga = gsel ? g1a : g0a, gb = gsel ? g1b : g0b;
            v4u o; o.x = pk2(lo16(w.x) * (s * ga.x), hi16(w.x) * (s * ga.y)); o.y = pk2(lo16(w.y) * (s * ga.z), hi16(w.y) * (s * ga.w));
            o.z = pk2(lo16(w.z) * (s * gb.x), hi16(w.z) * (s * gb.y)); o.w = pk2(lo16(w.w) * (s * gb.z), hi16(w.w) * (s * gb.w));
            *(LAS v4u*)(lds + (gsel * 2 + (row >> 6)) * 16384 + at::v_st(row & 63, cc * 8)) = o;
          } }
        __syncthreads();
        const int gsel = wid >> 2, g = 2 * gp + gsel, t = 32 * (wid & 3) + r32;
        const size_t row = (size_t)(R0 + t);
        at::u32x4 uw[8], zw[8];
        { const bf16* up = proj + row * NPROJ + C_UB + g * 128 + 8 * hi; const bf16* zp = proj + row * NPROJ + C_ZB + g * 128 + 8 * hi;
#pragma unroll
          for (int i = 0; i < 8; ++i) { uw[i] = *(const at::u32x4*)(up + 16 * i); zw[i] = *(const at::u32x4*)(zp + 16 * i); } }
        const float bias = bs[g * 128 + t];
        f32x16 o[4] = {};
        const int nst = (wid & 3) >= 2 ? 2 : 1;
        for (int st = 0; st < nst; ++st) {
            bf16x8 pa[4];
#pragma unroll
            for (int ks = 0; ks < 4; ++ks) {
                const int s0 = st * 64 + ks * 16 + hi * 8;
                const float* wp = Ws + ((size_t)g * 128 + t) * 128 + s0;
                const v4f a = *(const v4f*)wp, b = *(const v4f*)(wp + 4);
                float x[8] = {a.x, a.y, a.z, a.w, b.x, b.y, b.z, b.w};
#pragma unroll
                for (int j = 0; j < 8; ++j) if (s0 + j > t) x[j] = 0.f;
                at::u32x4 w4 = {at::cvtpk(x[0], x[1]), at::cvtpk(x[2], x[3]), at::cvtpk(x[4], x[5]), at::cvtpk(x[6], x[7])};
                pa[ks] = *reinterpret_cast<bf16x8*>(&w4);
            }
            const unsigned vbase = (unsigned)(size_t)(lds + (gsel * 2 + st) * 16384) + (unsigned)at::v_rd_base(lane);
            at::pv_tile<true>(o, vbase, pa[0], pa[1], pa[2], pa[3]);
        }
        bf16* yp = YB + row * 1024 + g * 128 + 8 * hi;
#pragma unroll
        for (int i = 0; i < 8; ++i) { const int d0 = i >> 1, j = i & 1;
            auto u0 = __builtin_amdgcn_permlane32_swap(uw[i].x, uw[i].z, false, false); auto u1 = __builtin_amdgcn_permlane32_swap(uw[i].y, uw[i].w, false, false);
            auto z0 = __builtin_amdgcn_permlane32_swap(zw[i].x, zw[i].z, false, false); auto z1 = __builtin_amdgcn_permlane32_swap(zw[i].y, zw[i].w, false, false);
            const unsigned u4[4] = {u0[0], u1[0], u0[1], u1[1]}, z4[4] = {z0[0], z1[0], z0[1], z1[1]};
            unsigned p[4];
#pragma unroll
            for (int k = 0; k < 4; ++k) {
                const float y0 = lo16(u4[k]) * (o[d0][8 * j + 2 * k] + bias) * lo16(z4[k]);
                const float y1 = hi16(u4[k]) * (o[d0][8 * j + 2 * k + 1] + bias) * hi16(z4[k]);
                p[k] = at::cvtpk(y0, y1); }
            auto s0 = __builtin_amdgcn_permlane32_swap(p[0], p[2], false, false); auto s1 = __builtin_amdgcn_permlane32_swap(p[1], p[3], false, false);
            *(at::u32x4*)(yp + 16 * i) = (at::u32x4){s0[0], s1[0], s0[1], s1[1]}; }
        __syncthreads();
    }
}
}


namespace gl {
using at::bf16x8; using at::f32x16; using at::s16x4; using at::u32x4;
constexpr int OFF_VIMG = 0, OFF_KLIMG = 65536, OFF_ATT = 98304, OFF_DS = 131072, OFF_PART = 131584, LDS_NEED = OFF_PART + 4096;

__device__ __forceinline__ void gla_prep_item(LAS unsigned char* lds, int seg_off, const bf16* proj, const float* wa2, const float* ba, bf16* QE, bf16* KE, bf16* KL, float* DS, int ci) {
    const int tid = otid(), k2 = tid & 63, ts = tid >> 6, k = 2 * k2;
    LAS float* seg = (LAS float*)(lds + seg_off);
    {
        const int ch = ci >> 2, h = ci & 3, R0 = ch * 128 + ts * 16;
        float wa0[16], wa1[16];
#pragma unroll
        for (int j = 0; j < 16; ++j) { const v2f w = *(const v2f*)(wa2 + j * 512 + h * 128 + k); wa0[j] = w.x; wa1[j] = w.y; }
        const v2f bak = *(const v2f*)(ba + h * 128 + k);
        float la0[16], la1[16]; float run0 = 0.f, run1 = 0.f;
#pragma unroll
        for (int i = 0; i < 16; ++i) {
            const bf16* pr = proj + (size_t)(R0 + i) * NPROJ + C_AR;
            const v4u w0 = *(const v4u*)pr, w1 = *(const v4u*)(pr + 8);
            const float ar[16] = {lo16(w0.x), hi16(w0.x), lo16(w0.y), hi16(w0.y), lo16(w0.z), hi16(w0.z), lo16(w0.w), hi16(w0.w),
                                  lo16(w1.x), hi16(w1.x), lo16(w1.y), hi16(w1.y), lo16(w1.z), hi16(w1.z), lo16(w1.w), hi16(w1.w)};
            float x0 = bak.x, x1 = bak.y;
#pragma unroll
            for (int j = 0; j < 16; ++j) { x0 += ar[j] * wa0[j]; x1 += ar[j] * wa1[j]; }
            run0 += (fminf(x0, 0.f) - __logf(1.0f + __expf(-fabsf(x0)))) * 0.0625f; la0[i] = run0;
            run1 += (fminf(x1, 0.f) - __logf(1.0f + __expf(-fabsf(x1)))) * 0.0625f; la1[i] = run1;
        }
        *(LAS v2f*)(seg + ts * 128 + k) = (v2f){run0, run1};
        __syncthreads();
        float pre0 = 0.f, pre1 = 0.f, tot0 = 0.f, tot1 = 0.f;
#pragma unroll
        for (int q = 0; q < 8; ++q) { const v2f sg = *(const LAS v2f*)(seg + q * 128 + k); tot0 += sg.x; tot1 += sg.y; if (q < ts) { pre0 += sg.x; pre1 += sg.y; } }
        const float et0 = __expf(tot0), et1 = __expf(tot1);
        unsigned qw[16], kw[16];
#pragma unroll
        for (int i = 0; i < 16; ++i) { const size_t row = (size_t)(R0 + i); qw[i] = *(const unsigned*)(proj + row * NPROJ + C_QC + h * 128 + k); kw[i] = *(const unsigned*)(proj + row * NPROJ + C_KC + h * 128 + k); }
#pragma unroll
        for (int i = 0; i < 16; ++i) {
            const size_t o = (size_t)(R0 + i) * 512 + h * 128 + k;
            const float e0 = __expf(la0[i] + pre0), e1 = __expf(la1[i] + pre1), r0 = __builtin_amdgcn_rcpf(e0), r1 = __builtin_amdgcn_rcpf(e1);
            const float q0 = lo16(qw[i]) * 0.08838834764831845f, q1 = hi16(qw[i]) * 0.08838834764831845f, kk0 = lo16(kw[i]) * r0, kk1 = hi16(kw[i]) * r1;
            *(unsigned*)(QE + o) = pk2(q0 * e0, q1 * e1);
            *(unsigned*)(KE + o) = pk2(kk0, kk1);
            *(unsigned*)(KL + o) = pk2(kk0 * et0, kk1 * et1);
        }
        if (ts == 0) *(v2f*)(DS + ((size_t)ch * 4 + h) * 128 + k) = (v2f){et0, et1};
        __syncthreads();
    }
}

#define GL_PK4(P, B_, OUT) do { unsigned a0 = at::cvtpk(P[B_+0], P[B_+1]), a1 = at::cvtpk(P[B_+2], P[B_+3]);                          \
        unsigned b0 = at::cvtpk(P[B_+4], P[B_+5]), b1 = at::cvtpk(P[B_+6], P[B_+7]);                                             \
        auto r0 = __builtin_amdgcn_permlane32_swap(a0, b0, false, false); auto r1 = __builtin_amdgcn_permlane32_swap(a1, b1, false, false); \
        u32x4 w = {r0[0], r1[0], r0[1], r1[1]}; OUT = *reinterpret_cast<bf16x8*>(&w); } while (0)
#define GL_TRRD(dst, addr, off) asm volatile("ds_read_b64_tr_b16 %0, %1 offset:%2" : "=&v"(dst) : "v"(addr), "i"(off) : "memory")

template <int TT> __device__ __forceinline__ void o_intra_tile(LAS unsigned char* lds, const bf16x8 (&vfr)[8], bf16* oi, int r32, int hi) {
    f32x16 acc = {};
    const int t = 32 * TT + r32;
    bf16x8 af[2 * TT + 2];
#pragma unroll
    for (int ks8 = 0; ks8 < 2 * TT + 2; ++ks8) af[ks8] = *(const LAS bf16x8*)(lds + OFF_ATT + t * 256 + (((16 * ks8 + 8 * hi) * 2) ^ ((t & 7) << 4)));
#pragma unroll
    for (int ks8 = 0; ks8 < 2 * TT + 2; ++ks8) acc = __builtin_amdgcn_mfma_f32_32x32x16_bf16(vfr[ks8], af[ks8], acc, 0, 0, 0);
    __builtin_amdgcn_sched_group_barrier(0x100, 2 * TT + 2, 0); __builtin_amdgcn_sched_group_barrier(0x008, 2 * TT + 2, 0);
    asm volatile("s_nop 15\n\ts_nop 15" : "+v"(acc));
#pragma unroll
    for (int hf = 0; hf < 2; ++hf) *(u32x4*)(oi + (size_t)(TT * 2 + hf) * 512) = (u32x4){at::cvtpk(acc[8 * hf], acc[8 * hf + 1]), at::cvtpk(acc[8 * hf + 2], acc[8 * hf + 3]), at::cvtpk(acc[8 * hf + 4], acc[8 * hf + 5]), at::cvtpk(acc[8 * hf + 6], acc[8 * hf + 7])};
}
__device__ __forceinline__ void gla_chunk_item(LAS unsigned char* lds, const bf16* proj, const bf16* QE, const bf16* KE, const bf16* KL, bf16* OI, bf16* DL, int ci) {
    const int tid = otid(), wid = __builtin_amdgcn_readfirstlane(tid >> 6), lane = tid & 63, r32 = lane & 31, hi = lane >> 5;
    const int h = ci & 3, R0 = (ci >> 2) * 128;
    {
        {
#pragma unroll
            for (int i = 0; i < 8; ++i) { const int idx = tid + 512 * i, s = idx >> 5, cc = idx & 31;
                const v4u w = *(const v4u*)(proj + (size_t)(R0 + s) * NPROJ + C_VC + h * 256 + cc * 8);
                *(LAS v4u*)(lds + OFF_VIMG + ((s >> 6) * 2 + (cc >> 4)) * 16384 + at::v_st(s & 63, (cc & 15) * 8)) = w; }
#pragma unroll
            for (int i = 0; i < 4; ++i) { const int idx = tid + 512 * i, s = idx >> 4, cc = idx & 15;
                const v4u w = *(const v4u*)(KL + (size_t)(R0 + s) * 512 + h * 128 + cc * 8);
                *(LAS v4u*)(lds + OFF_KLIMG + (s >> 6) * 16384 + at::v_st(s & 63, cc * 8)) = w; }
#pragma unroll
            for (int j = 0; j < 2; ++j) {
                const int ti = 2 * wid + j, st = ti >> 2, tt = ti & 3;
                if (st <= tt) {
                    f32x16 p = {};
                    const bf16* ap = KE + (size_t)(R0 + 32 * st + r32) * 512 + h * 128 + hi * 8;
                    const bf16* bp = QE + (size_t)(R0 + 32 * tt + r32) * 512 + h * 128 + hi * 8;
                    bf16x8 fa[8], fb[8];
#pragma unroll
                    for (int ks = 0; ks < 8; ++ks) { fa[ks] = *(const bf16x8*)(ap + ks * 16); fb[ks] = *(const bf16x8*)(bp + ks * 16); }
#pragma unroll
                    for (int ks = 0; ks < 8; ++ks) p = __builtin_amdgcn_mfma_f32_32x32x16_bf16(fa[ks], fb[ks], p, 0, 0, 0);
                    __builtin_amdgcn_sched_group_barrier(0x020, 16, 0); __builtin_amdgcn_sched_group_barrier(0x008, 8, 0);
                    asm volatile("s_nop 15\n\ts_nop 15" : "+v"(p));
                    if (st == tt) {
#pragma unroll
                        for (int r = 0; r < 16; ++r) if (at::crow(r, hi) > r32) p[r] = 0.f; }
                    const int t = 32 * tt + r32;
#pragma unroll
                    for (int g = 0; g < 4; ++g) { v2u w; w.x = at::cvtpk(p[4 * g], p[4 * g + 1]); w.y = at::cvtpk(p[4 * g + 2], p[4 * g + 3]);
                        *(LAS v2u*)(lds + OFF_ATT + t * 256 + ((64 * st + 16 * g) ^ ((t & 7) << 4)) + 8 * hi) = w; }
                }
            }
            __syncthreads();
            bf16x8 vfr[8];
            { const unsigned vaddr = (unsigned)(size_t)(lds + OFF_VIMG + (wid >> 2) * 16384) + (unsigned)at::v_rd_base(lane) + (unsigned)((wid & 3) * 512);
              s16x4 vl[8], vh[8];
#define GL_VF(ks8) do { constexpr int o_ = ((ks8) >> 2) * 32768 + ((ks8) & 3) * 4096; GL_TRRD(vl[ks8], vaddr, o_); GL_TRRD(vh[ks8], vaddr, o_ + 2048); } while (0)
              GL_VF(0); GL_VF(1); GL_VF(2); GL_VF(3); GL_VF(4); GL_VF(5); GL_VF(6); GL_VF(7);
#undef GL_VF
              asm volatile("s_waitcnt lgkmcnt(0)" ::: "memory"); AT_SBAR();
#pragma unroll
              for (int q = 0; q < 8; ++q) vfr[q] = (bf16x8){vl[q][0], vl[q][1], vl[q][2], vl[q][3], vh[q][0], vh[q][1], vh[q][2], vh[q][3]};
              AT_SBAR(); }
            bf16* oi = OI + (((size_t)ci * 8 + wid) * 8 * 64 + lane) * 8;
            bf16* dl = DL + (((size_t)ci * 8 + wid) * 8 * 64 + lane) * 8;
            o_intra_tile<0>(lds, vfr, oi, r32, hi); o_intra_tile<1>(lds, vfr, oi, r32, hi); o_intra_tile<2>(lds, vfr, oi, r32, hi); o_intra_tile<3>(lds, vfr, oi, r32, hi);
#pragma unroll
            for (int kt = 0; kt < 4; ++kt) {
                f32x16 D = {};
                const unsigned kaddr = (unsigned)(size_t)(lds + OFF_KLIMG) + (unsigned)at::v_rd_base(lane) + (unsigned)(kt * 512);
                s16x4 kl_[8], kh_[8];
#define GL_KR(ks8) do { constexpr int o_ = ((ks8) >> 2) * 16384 + ((ks8) & 3) * 4096; GL_TRRD(kl_[ks8], kaddr, o_); GL_TRRD(kh_[ks8], kaddr, o_ + 2048); } while (0)
                GL_KR(0); GL_KR(1); GL_KR(2); GL_KR(3); GL_KR(4); GL_KR(5); GL_KR(6); GL_KR(7);
#undef GL_KR
                asm volatile("s_waitcnt lgkmcnt(0)" ::: "memory"); AT_SBAR();
#pragma unroll
                for (int ks8 = 0; ks8 < 8; ++ks8)
                    D = __builtin_amdgcn_mfma_f32_32x32x16_bf16((bf16x8){kl_[ks8][0], kl_[ks8][1], kl_[ks8][2], kl_[ks8][3], kh_[ks8][0], kh_[ks8][1], kh_[ks8][2], kh_[ks8][3]}, vfr[ks8], D, 0, 0, 0);
                AT_SBAR();
                asm volatile("s_nop 15\n\ts_nop 15" : "+v"(D));
#pragma unroll
                for (int hf = 0; hf < 2; ++hf) *(u32x4*)(dl + (size_t)(kt * 2 + hf) * 512) = (u32x4){at::cvtpk(D[8 * hf], D[8 * hf + 1]), at::cvtpk(D[8 * hf + 2], D[8 * hf + 3]), at::cvtpk(D[8 * hf + 4], D[8 * hf + 5]), at::cvtpk(D[8 * hf + 6], D[8 * hf + 7])};
            }
            __syncthreads();
        }
    }
}

__device__ __forceinline__ void gla_stageA_item(const float* DS, const bf16* DL, bf16* XB, int b, int h, int vp) {
    const int tid = otid(), wid = __builtin_amdgcn_readfirstlane(tid >> 6), lane = tid & 63, hi = lane >> 5;
    const int vb = 2 * vp + (wid >> 2), kt = wid & 3;
    constexpr int PF = 4, NC = SEQ / 128;
    f32x16 X = {};
    u32x4 dq[PF][2]; v4f sq[PF][4];
    const size_t ci0 = (size_t)(b * 32) * 4 + h;
#define GL_ALOAD(slot, c_) do { const size_t ci_ = ci0 + (size_t)(c_) * 4; const bf16* dl_ = DL + ((ci_ * 8 + vb) * 8 * 64 + lane) * 8 + (size_t)(kt * 2) * 512; const float* ds_ = DS + ci_ * 128 + 32 * kt + 4 * hi; \
        dq[slot][0] = *(const u32x4*)dl_; dq[slot][1] = *(const u32x4*)(dl_ + 512); \
        _Pragma("unroll") for (int r4 = 0; r4 < 4; ++r4) sq[slot][r4] = *(const v4f*)(ds_ + 8 * r4); } while (0)
#pragma unroll
    for (int s = 0; s < PF; ++s) GL_ALOAD(s, s);
    for (int c0 = 0; c0 < NC; c0 += PF) {
#pragma unroll
        for (int s = 0; s < PF; ++s) {
            const int c = c0 + s; const size_t ci = ci0 + (size_t)c * 4;
            bf16* xo = XB + (((ci * 8 + vb) * 8 + kt * 2) * 64 + lane) * 8;
            bf16x8 xb0, xb1; GL_PK4(X, 0, xb0); GL_PK4(X, 8, xb1);
            *(bf16x8*)xo = xb0; *(bf16x8*)(xo + 512) = xb1;
#pragma unroll
            for (int r4 = 0; r4 < 4; ++r4) { const v4f d4 = sq[s][r4]; const u32x4 q4 = dq[s][r4 >> 1]; const unsigned wa = (r4 & 1) ? q4.z : q4.x, wb = (r4 & 1) ? q4.w : q4.y;
                X[4 * r4] = X[4 * r4] * d4.x + lo16(wa); X[4 * r4 + 1] = X[4 * r4 + 1] * d4.y + hi16(wa); X[4 * r4 + 2] = X[4 * r4 + 2] * d4.z + lo16(wb); X[4 * r4 + 3] = X[4 * r4 + 3] * d4.w + hi16(wb); }
            if (c + PF < NC) GL_ALOAD(s, c + PF);
        }
    }
#undef GL_ALOAD
}
__device__ __forceinline__ void gla_stageB_item(const bf16* proj, const bf16* QE, const bf16* OI, const bf16* XB, const float* og, bf16* YC, int b, int h, int cp) {
    (void)og;
    const int tid = otid(), wid = __builtin_amdgcn_readfirstlane(tid >> 6), lane = tid & 63, r32 = lane & 31, hi = lane >> 5;
    {
        const int c = 2 * cp + (wid >> 2), tt = wid & 3, R0 = b * SEQ + c * 128;
        const size_t ci = (size_t)(b * 32 + c) * 4 + h;
        f32x16 acc[8];
#pragma unroll
        for (int vb = 0; vb < 8; ++vb) { const bf16* oi = OI + ((ci * 8 + vb) * 8 * 64 + lane) * 8 + (size_t)(tt * 2) * 512;
#pragma unroll
            for (int hf = 0; hf < 2; ++hf) { const u32x4 w = *(const u32x4*)(oi + (size_t)hf * 512);
                acc[vb][8 * hf] = lo16(w.x); acc[vb][8 * hf + 1] = hi16(w.x); acc[vb][8 * hf + 2] = lo16(w.y); acc[vb][8 * hf + 3] = hi16(w.y);
                acc[vb][8 * hf + 4] = lo16(w.z); acc[vb][8 * hf + 5] = hi16(w.z); acc[vb][8 * hf + 6] = lo16(w.w); acc[vb][8 * hf + 7] = hi16(w.w); } }
        bf16x8 qa[8];
        { const bf16* qp = QE + (size_t)(R0 + 32 * tt + r32) * 512 + h * 128 + hi * 8;
#pragma unroll
          for (int ks = 0; ks < 8; ++ks) qa[ks] = *(const bf16x8*)(qp + ks * 16); }
        if (c > 0) {
            const bf16* xi = XB + (((ci * 8) * 8) * 64 + lane) * 8;
            bf16x8 xf[64];
#pragma unroll
            for (int i = 0; i < 64; ++i) xf[i] = *(const bf16x8*)(xi + (size_t)i * 512);
#pragma unroll
            for (int i = 0; i < 64; ++i) acc[i >> 3] = __builtin_amdgcn_mfma_f32_32x32x16_bf16(xf[i], qa[i & 7], acc[i >> 3], 0, 0, 0);
            __builtin_amdgcn_sched_group_barrier(0x020, 16, 0);
#pragma unroll
            for (int i = 0; i < 48; ++i) { __builtin_amdgcn_sched_group_barrier(0x008, 1, 0); __builtin_amdgcn_sched_group_barrier(0x020, 1, 0); }
            __builtin_amdgcn_sched_group_barrier(0x008, 16, 0);
        }
        const size_t row = (size_t)(R0 + 32 * tt + r32);
        at::u32x4 zw[16];
        { const bf16* zp = proj + row * NPROJ + C_ZC + h * 256 + 8 * hi;
#pragma unroll
          for (int i = 0; i < 16; ++i) zw[i] = *(const at::u32x4*)(zp + 16 * i); }
        float s = 0.f;
#pragma unroll
        for (int vb = 0; vb < 8; ++vb)
#pragma unroll
            for (int r = 0; r < 16; ++r) s += acc[vb][r] * acc[vb][r];
        s += lane_xor32(s, lane);
        const float rn = 1.0f / sqrtf(s * (1.0f / 256.f) + EPS);
        bf16* yp = YC + row * 1024 + h * 256 + 8 * hi;
#pragma unroll
        for (int i = 0; i < 16; ++i) { const int vb = i >> 1, j = i & 1;
            auto z0 = __builtin_amdgcn_permlane32_swap(zw[i].x, zw[i].z, false, false); auto z1 = __builtin_amdgcn_permlane32_swap(zw[i].y, zw[i].w, false, false);
            const unsigned z4[4] = {z0[0], z1[0], z0[1], z1[1]};
            unsigned p[4];
#pragma unroll
            for (int k = 0; k < 4; ++k) p[k] = at::cvtpk(acc[vb][8 * j + 2 * k] * rn * lo16(z4[k]), acc[vb][8 * j + 2 * k + 1] * rn * hi16(z4[k]));
            auto s0 = __builtin_amdgcn_permlane32_swap(p[0], p[2], false, false); auto s1 = __builtin_amdgcn_permlane32_swap(p[1], p[3], false, false);
            *(at::u32x4*)(yp + 16 * i) = (at::u32x4){s0[0], s1[0], s0[1], s1[1]}; }
    }
}
#undef GL_PK4
#undef GL_TRRD
}


constexpr int CW_Q = 65536;
__device__ __forceinline__ int q_pop(unsigned* ctr, LAS unsigned* slot) {
    if (otid() == 0) *slot = __hip_atomic_fetch_add(ctr, 1u, __ATOMIC_RELAXED, __HIP_MEMORY_SCOPE_AGENT);
    __syncthreads(); const int v = (int)*slot; __syncthreads(); return v; }
__device__ __forceinline__ void ph_mixers(LAS unsigned char* lds, unsigned char* ws, unsigned* qctr, const float* Ws, const float* bs, const float* vg, const float* og, const float* qg, int row0, int vb, const float* xnext, const float* gnext) {
    constexpr int NGLA = NBP * 8, NATT = 16 * NBP, NSGU = 16 * NBP, NNORM = MP / 64 / 8; const int NQ = NGLA + NATT + NSGU + (xnext ? NNORM : 0);
    static_assert(NBP % 2 == 0, "NBP even");
    LAS unsigned* slot = (LAS unsigned*)(lds + LDSCTL_OFF + 64);
    bf16* proj = (bf16*)(ws + WS_PROJ);
    unsigned live = 0xffu;
    for (int dq = 0; dq < 8; ++dq) {
        const int q = (vb + dq) & 7;
        if (dq == 1) {
            if (otid() < 64) { const int t_ = otid() & 7; const unsigned c_ = __hip_atomic_load(qctr + t_ * 64, __ATOMIC_RELAXED, __HIP_MEMORY_SCOPE_AGENT);
                const unsigned long long b_ = __builtin_amdgcn_ballot_w64(c_ < (unsigned)NQ); if (otid() == 0) *slot = (unsigned)(b_ & 0xffull); }
            __syncthreads(); live = (unsigned)__builtin_amdgcn_readfirstlane((int)*slot); __syncthreads(); }
        if (!((live >> q) & 1u)) continue;
        for (;;) {
            const int idx = q_pop(qctr + q * 64, slot);
            if (idx >= NQ) break;
            if (idx >= NATT && idx < NATT + NGLA) { const int gi = q * NGLA + (idx - NATT), bh = gi >> 4, cp = gi & 15;
                gl::gla_stageB_item(proj, (const bf16*)(ws + WS_QE), (const bf16*)(ws + WS_OC), (const bf16*)(ws + WS_XB), og, (bf16*)(ws + WS_YC), bh >> 2, bh & 3, cp); }
            else if (idx < NATT) { const int j = idx, qb = 15 - j / NBP, bh = q * NBP + j % NBP;
                at::attn_block(lds, (const unsigned char*)(ws + WS_Q), (const unsigned char*)(ws + WS_K), (const unsigned char*)(ws + WS_K) + (size_t)MP * 1536, proj, (bf16*)(ws + WS_YA), qg, (const float*)(ws + WS_COS) + (size_t)row0 * 32, (const float*)(ws + WS_SIN) + (size_t)row0 * 32, bh >> 3, bh & 7, qb); }
            else if (idx < NATT + NGLA + NSGU) { const int it = q * NSGU + (idx - NGLA - NATT);
                sg::sgu_item(lds, proj, (const float*)(ws + WS_SSQ) + 2 * MP, Ws, bs, vg, (bf16*)(ws + WS_YB), it); }
            else { const size_t ro = (size_t)(q * NNORM + (idx - NATT - NGLA - NSGU)) * 64 * DM;
                ph_norm(xnext + ro, gnext, (bf16*)(ws + WS_HN) + ro, ws + WS_H8 + ro, 64, 0, 1); }
        }
    }
}
#ifndef GEMM_SP2
#define GEMM_SP2 true
#endif
#ifndef GEMM_ALIGN
#define GEMM_ALIGN true
#endif
typedef const __attribute__((address_space(4))) Args* KArgP;
#define KARG() ({ KArgP p_ = (KArgP)__builtin_amdgcn_kernarg_segment_ptr(); asm volatile("" : "+s"(p_)); p_; })
#define INF(i) ((const float*)ap->in[i])
__device__ __forceinline__ void grid_bar(const XcdBarrier& b0) { XcdBarrier b = b0; asm volatile("" : "+s"(b.bar)); xcd_barrier(b); }

__global__ void __launch_bounds__(512, 2) fwd(Args a) {
    extern __shared__ __attribute__((aligned(16))) unsigned char lds_raw[];
    LAS unsigned char* lds = (LAS unsigned char*)lds_raw;
    const int lo = a.lo, hi = a.hi;
    XcdBarrier bar; bar.bar = (unsigned*)(a.ws + WS_CTL) + CW_BAR; bar.x = 0; bar.st = nullptr;
    if (hi - lo > 1) {
        if (threadIdx.x < 4) ((LAS unsigned*)(lds + LDSCTL_OFF))[threadIdx.x] = 0u;
        __syncthreads();
        bar = xcd_barrier_post((unsigned*)(a.ws + WS_CTL) + CW_BAR, (volatile LAS unsigned*)(lds + LDSCTL_OFF));
    }
    int step = 0;
#define PH_BEGIN if (step >= lo && step < hi) { const KArgP ap = KARG(); unsigned char* const ws = ap->ws; const int vb = obid(), nvb = gridDim.x; (void)ws; (void)vb; (void)nvb;
#define PH_END   if (step + 1 < hi) grid_bar(bar); } ++step;
#define WL(l) (ws + WS_W + (size_t)(l) * SZ_WLAYER)
#define B_(T, off) ((T*)(ws + (off)))

    for (int l = 0; l < DEPTH; ++l) {
        for (int p = 0; p < NPASS; ++p) {
            const int row0 = p * MP;
#define XIN ((l == 0 ? (const float*)ap->in[0] : (const float*)ap->out) + (size_t)row0 * DM)
#define WLP (ws + WS_W)
            if (p != 0) { ++step; } else {
            PH_BEGIN if (p == 0) {
            { unsigned char* wl = ws + WS_W;
              convert_T<1>(INF(3) + (size_t)l * DM * IN_COLS, DM, IN_COLS, (bf16*)wl, NBF, (LAS float*)lds, vb, nvb);
              convert_T8<2>(INF(3) + (size_t)l * DM * IN_COLS, DM, IN_COLS, wl + SZ_WINB, NF8, 64.0f, (LAS float*)lds, (vb + 96) % nvb, nvb);
              convert_T8<0>(INF(6) + (size_t)l * 512 * 1536, 512, 1536, wl + SZ_WIN, 1536, 64.0f, (LAS float*)lds, (vb + 64) % nvb, nvb, INF(4) + l * 512);
              convert_T8<0>(INF(7) + (size_t)l * 512 * 2048, 512, 2048, wl + SZ_WIN + SZ_WUQ, 2048, 64.0f, (LAS float*)lds, (vb + 128) % nvb, nvb, INF(5) + l * 512);
              convert_T8<0>(INF(16) + ((size_t)l * 3) * 1024 * 2048, 1024, 2048, wl + SZ_WIN + SZ_WUQ + SZ_WUKV, 2048, 32.0f, (LAS float*)lds, vb, nvb);
              for (int b = 1; b < 3; ++b)
                  convert_T<0>(INF(16) + ((size_t)l * 3 + b) * 1024 * 2048, 1024, 2048, (bf16*)(wl + SZ_WIN + SZ_WUQ + SZ_WUKV) + (size_t)b * 2048 * 1024, 2048, (LAS float*)lds, (vb + 32 * b) % nvb, nvb, b == 2 ? INF(15) + l * 256 : nullptr, 255);
              convert_T<0>(INF(17) + (size_t)l * 2048 * 2048, 2048, 2048, (bf16*)(wl + SZ_WIN + SZ_WUQ + SZ_WUKV + SZ_WB), 2048, (LAS float*)lds, (vb + 192) % nvb, nvb); }
            if (l == 0) { const int* positions = (const int*)ap->in[1]; float* cosT = B_(float, WS_COS); float* sinT = B_(float, WS_SIN);
              for (int idx = vb * 512 + otid(); idx < MTOK * 32; idx += nvb * 512) {
                const int t = idx >> 5, i = idx & 31;
                const float inv = 1.0f / powf(10000.0f, (float)(2 * i) * (1.0f / 64.0f));
                const float ang = (float)positions[t] * inv;
                float sn, cs; sincosf(ang, &sn, &cs);
                cosT[idx] = cs; sinT[idx] = sn; } }
            }
                     if (l == 0 && p == 0) { ph_norm(XIN, INF(2) + l * DM, B_(bf16, WS_HN), B_(unsigned char, WS_H8), MP, vb, nvb);
                       float* ssq = B_(float, WS_SSQ); for (int i = vb * 512 + otid(); i < 3 * MP; i += nvb * 512) ssq[i] = 0.f; } PH_END }
            PH_BEGIN { { pg8::Gemm g{B_(bf16, WS_HN), (const bf16*)WLP, MP, NBF, DM}; pg8::StaticOrder S; S.init(MP, NBF, nvb, vb); pg8::EpiProj E{B_(bf16, WS_PROJ), NPROJ, B_(float, WS_SSQ), MP, 0, B_(unsigned char, WS_YC)};
                         pg8::gemm_phase<pg8::EpiProj, pg8::StaticOrder, false, GEMM_ALIGN, GEMM_SP2>(lds, g, S, E, nullptr); }
                       { pg8::Gemm g{(const bf16*)B_(unsigned char, WS_H8), (const bf16*)(WLP + SZ_WINB), MP, NF8, DM / 2}; pg8::StaticOrder S; S.init(MP, NF8, nvb, vb);
                         { const int ub = (MP / 256) * (NBF / 256), u8 = (MP / 256) * (NF8 / 256), sk = ub % nvb;
                           if (sk > 0 && sk < nvb) { S.skip = sk; S.full = (u8 - 2 * (nvb - sk)) / nvb; if (S.full < 0) S.full = 0; } }
                         pg8::EpiProj E{B_(bf16, WS_PROJ) + NBF, NPROJ, B_(float, WS_SSQ), MP, NBF / 256, B_(unsigned char, WS_YC)};
                         pg8::gemm_phase<pg8::EpiProj, pg8::StaticOrder, false, GEMM_ALIGN, GEMM_SP2, true>(lds, g, S, E, nullptr); } } PH_END
            PH_BEGIN { { pg8::Gemm g{(const bf16*)B_(unsigned char, WS_YC), (const bf16*)(WLP + SZ_WIN), MP, 1536, 256, 0, 0x79797979, 0x7b7b7b7b};   pg8::StaticOrder S; S.init(MP, 1536, nvb, vb); pg8::EpiF8Row E{B_(unsigned char, WS_Q), 1536, B_(float, WS_SSQ), 1.0f / 512.f, EPS};
                         pg8::gemm_phase<pg8::EpiF8Row, pg8::StaticOrder, false, GEMM_ALIGN, GEMM_SP2, true>(lds, g, S, E, nullptr); }
                       { pg8::Gemm g{(const bf16*)(B_(unsigned char, WS_YC) + (size_t)MP * 512), (const bf16*)(WLP + SZ_WIN + SZ_WUQ), MP, 2048, 256, 0, 0x79797979, 0x7b7b7b7b}; pg8::StaticOrder S; S.init(MP, 2048, nvb, nvb - 1 - vb); pg8::EpiF8Row E{B_(unsigned char, WS_KV), 2048, B_(float, WS_SSQ) + MP, 1.0f / 512.f, EPS};
                         pg8::gemm_phase<pg8::EpiF8Row, pg8::StaticOrder, false, GEMM_ALIGN, GEMM_SP2, true>(lds, g, S, E, nullptr); }
                       for (int ci = vb; ci < (MP / 128) * 4; ci += nvb) {
                           gl::gla_prep_item(lds, 135168, B_(bf16, WS_PROJ), INF(13) + l * 16 * 512, INF(14) + l * 512, B_(bf16, WS_QE), B_(bf16, WS_KE), B_(bf16, WS_KL), B_(float, WS_DS), ci);
                           gl::gla_chunk_item(lds, B_(bf16, WS_PROJ), B_(bf16, WS_QE), B_(bf16, WS_KE), B_(bf16, WS_KL), B_(bf16, WS_OC), B_(bf16, WS_DL), ci); } } PH_END
            PH_BEGIN { constexpr int NA = NBP * 16;
                       if (nvb > 2 * NA) { if (vb < NA) gl::gla_stageA_item(B_(float, WS_DS), B_(bf16, WS_DL), B_(bf16, WS_XB), vb >> 4, (vb >> 2) & 3, vb & 3);
                                           else { ph_kfin(B_(unsigned char, WS_KV), B_(bf16, WS_PROJ), B_(unsigned char, WS_K), INF(9) + l * 192, B_(float, WS_COS), B_(float, WS_SIN), row0, vb - NA, nvb - NA); ph_vt8(B_(unsigned char, WS_KV), B_(unsigned char, WS_K) + (size_t)MP * 1536, vb - NA, nvb - NA); } }
                       else { for (int it = vb; it < NA; it += nvb) gl::gla_stageA_item(B_(float, WS_DS), B_(bf16, WS_DL), B_(bf16, WS_XB), it >> 4, (it >> 2) & 3, it & 3);
                              ph_kfin(B_(unsigned char, WS_KV), B_(bf16, WS_PROJ), B_(unsigned char, WS_K), INF(9) + l * 192, B_(float, WS_COS), B_(float, WS_SIN), row0, vb, nvb); ph_vt8(B_(unsigned char, WS_KV), B_(unsigned char, WS_K) + (size_t)MP * 1536, vb, nvb); } } PH_END
            PH_BEGIN ph_mixers(lds, ws, (unsigned*)(ws + WS_CTL) + CW_Q + (l * NPASS + p) * 8 * 64, INF(11) + (size_t)l * 8 * 128 * 128, INF(12) + l * 8 * 128, INF(10) + l * 1024, INF(15) + l * 256, INF(8) + l * 192, row0, vb,
                                (p + 1 < NPASS) ? XIN + (size_t)MP * DM : ((l + 1 < DEPTH) ? (const float*)ap->out : (const float*)nullptr), INF(2) + ((p + 1 < NPASS) ? l : l + 1) * DM); PH_END
            PH_BEGIN { { pg8::Gemm g{B_(bf16, WS_YA), (const bf16*)(WLP + SZ_WIN + SZ_WUQ + SZ_WUKV), MP, 2048, 512, 0, 0x7a7a7a7a, 0x7b7b7b7b};
                         pg8::StaticOrder S; S.init(MP, 2048, nvb, vb);
                         pg8::EpiMerge E{(const unsigned char*)(B_(bf16, WS_PROJ) + C_GATE), NPROJ * 2, B_(bf16, WS_MG), 2048, 2048, 0}; pg8::gemm_phase<pg8::EpiMerge, pg8::StaticOrder, false, GEMM_ALIGN, GEMM_SP2, true>(lds, g, S, E, nullptr); }
                       { pg8::Gemm g{B_(bf16, WS_YB), (const bf16*)(WLP + SZ_WIN + SZ_WUQ + SZ_WUKV) + (size_t)2048 * 1024, MP, 2048, 1024};
                         pg8::BranchOrder S; S.init(MP, 2048, nvb, vb); S.NB = 2; S.a_stride = (size_t)MP * 1024 * 2; S.b_stride = (size_t)2048 * 1024 * 2;
                         pg8::EpiMerge E{(const unsigned char*)(B_(bf16, WS_PROJ) + C_GATE), NPROJ * 2, B_(bf16, WS_MG), 2048, 2048, 1}; pg8::gemm_phase<pg8::EpiMerge, pg8::BranchOrder, false, GEMM_ALIGN, GEMM_SP2>(lds, g, S, E, nullptr); } } PH_END
            PH_BEGIN { pg8::Gemm g{B_(bf16, WS_MG), (const bf16*)(WLP + SZ_WIN + SZ_WUQ + SZ_WUKV + SZ_WB), MP, 2048, 2048}; pg8::StaticOrder S; S.init(MP, 2048, nvb, vb); pg8::EpiRes E{XIN, ap->out + (size_t)row0 * DM, 2048};
                       pg8::gemm_phase<pg8::EpiRes, pg8::StaticOrder, false, GEMM_ALIGN, GEMM_SP2>(lds, g, S, E, nullptr);
                       float* ssq = B_(float, WS_SSQ); for (int i = vb * 512 + otid(); i < 3 * MP; i += nvb * 512) ssq[i] = 0.f; } PH_END
        }
    }
#undef PH_BEGIN
#undef PH_END
}

#ifndef ONE_LAUNCH
#define ONE_LAUNCH 1
#endif
extern "C" void kernel_launch(void* const* d_in, const int* in_sizes, int n_in, void* d_out, int out_size, void* d_ws, size_t ws_size, hipStream_t stream) {
    static int grid = 0;
    if (grid == 0) {
        if (n_in != 18 || out_size != MTOK * DM || ws_size < WS_END) { fprintf(stderr, "kernel_launch: unexpected shapes (n_in %d out %d ws %zu need %zu)\n", n_in, out_size, ws_size, (size_t)WS_END); grid = -1; return; }
        int dev = 0, cus = 0, per_cu = 0;
        if (hipGetDevice(&dev) != hipSuccess || hipDeviceGetAttribute(&cus, hipDeviceAttributeMultiprocessorCount, dev) != hipSuccess) { grid = -1; return; }
        if (hipFuncSetAttribute((const void*)fwd, hipFuncAttributeMaxDynamicSharedMemorySize, LDS_BYTES) != hipSuccess) { fprintf(stderr, "kernel_launch: hipFuncSetAttribute failed\n"); grid = -1; return; }
        if (hipOccupancyMaxActiveBlocksPerMultiprocessor(&per_cu, (const void*)fwd, 512, LDS_BYTES) != hipSuccess || per_cu < 1) { fprintf(stderr, "kernel_launch: occupancy query says %d\n", per_cu); }
        (void)hipGetLastError();
        grid = cus;
    }
    if (grid < 0) return;
    (void)hipMemsetAsync((char*)d_ws + WS_CTL, 0, CTL_BYTES, stream);
    Args a{};
    for (int i = 0; i < 18; ++i) a.in[i] = d_in[i];
    a.out = (float*)d_out; a.ws = (unsigned char*)d_ws; a.pad0 = 0; a.pad1 = 0;
#if ONE_LAUNCH
    a.lo = 0; a.hi = NSTEPS;
    hipLaunchKernelGGL(fwd, dim3(grid), dim3(512), LDS_BYTES, stream, a);
#else
    for (int s = 0; s < NSTEPS; ++s) { a.lo = s; a.hi = s + 1; hipLaunchKernelGGL(fwd, dim3(grid), dim3(512), LDS_BYTES, stream, a); }
#endif
}
```

```cpp
#include <hip/hip_runtime.h>
#include <cstdio>
#include <cstdint>
__device__ __forceinline__ int otid() { int t = threadIdx.x; asm volatile("" : "+v"(t)); return t; }
__device__ __forceinline__ int obid() { int t = blockIdx.x; asm volatile("" : "+s"(t)); return t; }
namespace pg8 {
#define PG8_LAS __attribute__((address_space(3)))
typedef unsigned short bf16_t;
typedef short bf16x8 __attribute__((ext_vector_type(8)));
typedef float f32x4 __attribute__((ext_vector_type(4)));
typedef unsigned u32x4 __attribute__((ext_vector_type(4)));
constexpr int BM = 256, BK = 64, HALF = 128, HTB = HALF * BK * 2  , STAGE_BYTES = 8 * HTB, NXCD = 8, WGM = 4;

__host__ __device__ __forceinline__ int lds_byte(int r, int c) { const int st = (r >> 4) * 2 + (c >> 5), rr = r & 15, cc = c & 31, ob = rr * 64 + cc * 2; return st * 1024 + (ob ^ (((ob >> 9) & 1) << 5)); }
__host__ __device__ __forceinline__ void stage_rc(int b, int& R, int& C) { const int st = b / 1024, sb = b % 1024, swz = sb ^ (((sb >> 9) & 1) << 5); R = (st >> 1) * 16 + swz / 64; C = (st & 1) * 32 + (swz % 64) / 2; }
__host__ __device__ __forceinline__ int perm32(int rho) { const int n = rho >> 4, i = rho & 15; return 8 * (i >> 2) + 4 * n + (i & 3); }

struct Unit { int pm, pn, pb; };
struct Gemm { const bf16_t* A; const bf16_t* Bt; int M, N, K; int lda; int f8sw, f8sx; };

struct StaticOrder {
    int nM, nN, nwg, G, c, full = 1 << 30, skip = 0;
    __host__ __device__ void init(int M, int N, int G_, int c_) { nM = M / BM; nN = N / BM; nwg = nM * nN; G = G_; c = c_; }
    __host__ __device__ bool next(int i, Unit& u) const {
        long L; if (i < full) L = (long)i * G + c; else { if (c < skip) return false; L = (long)full * G + (long)(i - full) * (G - skip) + (c - skip); }
        if (L >= nwg) return false;
        int wgid = (int)L; { const int q = nwg / NXCD, r = nwg % NXCD, xcd = wgid % NXCD, off = wgid / NXCD; wgid = (xcd < r ? xcd * (q + 1) : r * (q + 1) + (xcd - r) * q) + off; }
        const int nig = WGM * nN, gid = wgid / nig, fm = gid * WGM, gsz = (nM - fm) < WGM ? (nM - fm) : WGM;
        u.pm = fm + ((wgid % nig) % gsz); u.pn = (wgid % nig) / gsz; u.pb = 0; return true;
    }
    __device__ __forceinline__ size_t a_off(const Unit&) const { return 0; }
    __device__ __forceinline__ size_t b_off(const Unit&) const { return 0; }
    __device__ __forceinline__ void a_ready(const Unit&) const {}
    __device__ __forceinline__ void done(const Unit&) const {}
};

struct BranchOrder : StaticOrder {
    int NB; size_t a_stride, b_stride;
    __device__ bool next(int i, Unit& u) const { const int ti = i / NB; if (!StaticOrder::next(ti, u)) return false; u.pb = i - ti * NB; return true; }
    __device__ __forceinline__ size_t a_off(const Unit& u) const { return (size_t)u.pb * a_stride; }
    __device__ __forceinline__ size_t b_off(const Unit& u) const { return (size_t)u.pb * b_stride; }
};

__device__ __forceinline__ unsigned cvt_pk_bf16(float lo, float hi) { unsigned r; asm("v_cvt_pk_bf16_f32 %0, %1, %2" : "=v"(r) : "v"(lo), "v"(hi)); return r; }
__device__ __forceinline__ float gelu_tanh_f(float x) { const float u2 = 1.5957691216057308f * (x + 0.044715f * x * x * x); return x * __builtin_amdgcn_rcpf(1.f + __expf(-u2)); }
__device__ __forceinline__ float silu_e(float x) { return x * __builtin_amdgcn_rcpf(1.f + __expf(-x)); }
struct EpiProj {
    static constexpr bool CHAINS = false;
    static constexpr bool PERM = true, AFTER_DRAIN = false;
    bf16_t* O; int ldc; float* SSQ; int mrows; int pn0; unsigned char* O8;
    __device__ __forceinline__ void operator()(const f32x4 (&acc)[2][2][4][2], const Unit& u, int wr, int wc, int fr, int fq) const {
        const int row0 = u.pm * BM + wr * 64 + fr, col0 = u.pn * BM + wc * 32 + 8 * fq;
        const int apn = u.pn + pn0;
        const int seg = !SSQ ? -1 : ((apn == 25 || apn == 26) ? 0 : ((apn == 27 || apn == 28) ? 1 : ((apn >= 4 && apn < 8) ? 2 : -1)));
        const int act = apn < 8 ? 1 : (((apn >= 8 && apn < 12) || (apn >= 20 && apn < 24)) ? 2 : 0);
#pragma unroll
        for (int ai = 0; ai < 2; ++ai)
#pragma unroll
            for (int m = 0; m < 4; ++m) { const int row = row0 + ai * HALF + m * 16; bf16_t* rowp = O + (size_t)row * ldc + col0;
                float ss = 0.f;
#pragma unroll
                for (int bj = 0; bj < 2; ++bj) { const f32x4 v0 = acc[ai][bj][m][0], v1 = acc[ai][bj][m][1];
                    if (apn >= 33) {
                        unsigned a = 0u, b = 0u;
#pragma unroll
                        for (int j = 0; j < 4; ++j) { a = __builtin_amdgcn_cvt_pk_u8_f32(255.0f * __builtin_amdgcn_rcpf(1.0f + __expf(-v0[j])), j, a); b = __builtin_amdgcn_cvt_pk_u8_f32(255.0f * __builtin_amdgcn_rcpf(1.0f + __expf(-v1[j])), j, b); }
                        typedef unsigned u32x2g_ __attribute__((ext_vector_type(2)));
                        *(u32x2g_*)((unsigned char*)(O + (size_t)row * ldc + (33 - pn0) * BM) + (apn - 33) * BM + wc * 32 + 8 * fq + bj * HALF) = (u32x2g_){a, b};
                    } else
                    if (seg == 0 || seg == 1) {
                        int a = __builtin_amdgcn_cvt_pk_fp8_f32(v0[0] * 16.0f, v0[1] * 16.0f, 0, false); a = __builtin_amdgcn_cvt_pk_fp8_f32(v0[2] * 16.0f, v0[3] * 16.0f, a, true);
                        int b = __builtin_amdgcn_cvt_pk_fp8_f32(v1[0] * 16.0f, v1[1] * 16.0f, 0, false); b = __builtin_amdgcn_cvt_pk_fp8_f32(v1[2] * 16.0f, v1[3] * 16.0f, b, true);
                        typedef unsigned u32x2_ __attribute__((ext_vector_type(2)));
                        *(u32x2_*)(O8 + ((size_t)seg * mrows + row) * 512 + (apn - (seg == 0 ? 25 : 27)) * BM + wc * 32 + 8 * fq + bj * HALF) = (u32x2_){(unsigned)a, (unsigned)b};
                    } else {
                    f32x4 w0 = v0, w1 = v1;
                    if (act == 1) {
#pragma unroll
                        for (int j = 0; j < 4; ++j) { w0[j] = gelu_tanh_f(v0[j]); w1[j] = gelu_tanh_f(v1[j]); } }
                    else if (act == 2) {
#pragma unroll
                        for (int j = 0; j < 4; ++j) { w0[j] = silu_e(v0[j]); w1[j] = silu_e(v1[j]); } }
                    u32x4 w; w.x = cvt_pk_bf16(w0[0], w0[1]); w.y = cvt_pk_bf16(w0[2], w0[3]); w.z = cvt_pk_bf16(w1[0], w1[1]); w.w = cvt_pk_bf16(w1[2], w1[3]);
                    *(u32x4*)(rowp + bj * HALF) = w;
                    if (seg == 2) {
#pragma unroll
                        for (int j = 0; j < 4; ++j) ss += w0[j] * w0[j] + w1[j] * w1[j]; } }
                    if (seg == 0 || seg == 1) {
#pragma unroll
                        for (int j = 0; j < 4; ++j) ss += v0[j] * v0[j] + v1[j] * v1[j]; } }
                if (seg >= 0) {
                    ss += __uint_as_float((unsigned)__builtin_amdgcn_ds_swizzle((int)__float_as_uint(ss), (16 << 10) | 0x1f));
                    auto rr = __builtin_amdgcn_permlane32_swap(__float_as_uint(ss), __float_as_uint(ss), false, false);
                    ss = __uint_as_float(rr[0]) + __uint_as_float(rr[1]);
                    if (fq == 0) atomicAdd(SSQ + (size_t)seg * mrows + row, ss); } }
    }
};
struct EpiBf16Row {
    static constexpr bool CHAINS = false;
    static constexpr bool PERM = true, AFTER_DRAIN = false;
    bf16_t* O; int ldc; const float* SSQ; float inv_n, eps;
    __device__ __forceinline__ void operator()(const f32x4 (&acc)[2][2][4][2], const Unit& u, int wr, int wc, int fr, int fq) const {
        const int row0 = u.pm * BM + wr * 64 + fr, col0 = u.pn * BM + wc * 32 + 8 * fq;
        float sq[2][4];
#pragma unroll
        for (int ai = 0; ai < 2; ++ai)
#pragma unroll
            for (int m = 0; m < 4; ++m) sq[ai][m] = SSQ[row0 + ai * HALF + m * 16];
#pragma unroll
        for (int ai = 0; ai < 2; ++ai)
#pragma unroll
            for (int m = 0; m < 4; ++m) { const int row = row0 + ai * HALF + m * 16; bf16_t* rowp = O + (size_t)row * ldc + col0;
                const float rn = 1.0f / sqrtf(sq[ai][m] * inv_n + eps);
#pragma unroll
                for (int bj = 0; bj < 2; ++bj) { const f32x4 v0 = acc[ai][bj][m][0] * rn, v1 = acc[ai][bj][m][1] * rn;
                    u32x4 w; w.x = cvt_pk_bf16(v0[0], v0[1]); w.y = cvt_pk_bf16(v0[2], v0[3]); w.z = cvt_pk_bf16(v1[0], v1[1]); w.w = cvt_pk_bf16(v1[2], v1[3]);
                    *(u32x4*)(rowp + bj * HALF) = w; } }
    }
};
struct EpiF8Row {
    static constexpr bool CHAINS = false;
    static constexpr bool PERM = true, AFTER_DRAIN = false;
    unsigned char* O; int ldc; const float* SSQ; float inv_n, eps;
    __device__ __forceinline__ void operator()(const f32x4 (&acc)[2][2][4][2], const Unit& u, int wr, int wc, int fr, int fq) const {
        const int row0 = u.pm * BM + wr * 64 + fr, col0 = u.pn * BM + wc * 32 + 8 * fq;
        float sq[2][4];
#pragma unroll
        for (int ai = 0; ai < 2; ++ai)
#pragma unroll
            for (int m = 0; m < 4; ++m) sq[ai][m] = SSQ[row0 + ai * HALF + m * 16];
        typedef unsigned u32x2_ __attribute__((ext_vector_type(2)));
#pragma unroll
        for (int ai = 0; ai < 2; ++ai)
#pragma unroll
            for (int m = 0; m < 4; ++m) { const int row = row0 + ai * HALF + m * 16; unsigned char* rowp = O + (size_t)row * ldc + col0;
                const float rn = 8.0f / sqrtf(sq[ai][m] * inv_n + eps);
#pragma unroll
                for (int bj = 0; bj < 2; ++bj) { const f32x4 v0 = acc[ai][bj][m][0] * rn, v1 = acc[ai][bj][m][1] * rn;
                    int a = __builtin_amdgcn_cvt_pk_fp8_f32(v0[0], v0[1], 0, false); a = __builtin_amdgcn_cvt_pk_fp8_f32(v0[2], v0[3], a, true);
                    int b = __builtin_amdgcn_cvt_pk_fp8_f32(v1[0], v1[1], 0, false); b = __builtin_amdgcn_cvt_pk_fp8_f32(v1[2], v1[3], b, true);
                    *(u32x2_*)(rowp + bj * HALF) = (u32x2_){(unsigned)a, (unsigned)b}; } }
    }
};
struct EpiRes {
    static constexpr bool CHAINS = false;
    static constexpr bool PERM = false, AFTER_DRAIN = false;
    const float* base; float* C; int ldc;
    __device__ __forceinline__ void operator()(const f32x4 (&acc)[2][2][4][2], const Unit& u, int wr, int wc, int fr, int fq) const {
        const int row0 = u.pm * BM + wr * 64 + fr, col0 = u.pn * BM + wc * 32 + 4 * fq;
#pragma unroll
        for (int ai = 0; ai < 2; ++ai) {
            f32x4 bs[4][2][2];
#pragma unroll
            for (int m = 0; m < 4; ++m) { const size_t off = (size_t)(row0 + ai * HALF + m * 16) * ldc + col0;
#pragma unroll
                for (int bj = 0; bj < 2; ++bj)
#pragma unroll
                    for (int n = 0; n < 2; ++n) bs[m][bj][n] = *(const f32x4*)(base + off + bj * HALF + n * 16); }
#pragma unroll
            for (int m = 0; m < 4; ++m) { const size_t off = (size_t)(row0 + ai * HALF + m * 16) * ldc + col0;
#pragma unroll
                for (int bj = 0; bj < 2; ++bj)
#pragma unroll
                    for (int n = 0; n < 2; ++n) *(f32x4*)(C + off + bj * HALF + n * 16) = acc[ai][bj][m][n] + bs[m][bj][n]; }
            asm volatile("" ::: "memory");
        }
    }
};
struct EpiMerge {
    static constexpr bool CHAINS = true;
    static constexpr bool PERM = true, AFTER_DRAIN = false;
    const unsigned char* G0; int ldg; bf16_t* MG; int ldc; int gstride; int pb0; int chain = 0;
    __device__ __forceinline__ bool keep(const Unit& u) const { return chain && (u.pb + pb0 == 1); }
    __device__ __forceinline__ void operator()(f32x4 (&acc)[2][2][4][2], const Unit& u, int wr, int wc, int fr, int fq) const {
        const int row0 = u.pm * BM + wr * 64 + fr, col0 = u.pn * BM + wc * 32 + 8 * fq; const int branch = u.pb + pb0; const unsigned char* G = G0 + (size_t)branch * gstride; const bool first = branch == 0;
        typedef unsigned u32x2m_ __attribute__((ext_vector_type(2)));
        if (chain && branch == 1) {
#pragma unroll
            for (int ai = 0; ai < 2; ++ai) {
                u32x2m_ gb[4][2], gc[4][2]; u32x4 ow[4][2];
#pragma unroll
                for (int m = 0; m < 4; ++m) { const size_t row = (size_t)(row0 + ai * HALF + m * 16);
#pragma unroll
                    for (int bj = 0; bj < 2; ++bj) { gb[m][bj] = *(const u32x2m_*)(G + row * ldg + col0 + bj * HALF); gc[m][bj] = *(const u32x2m_*)(G + gstride + row * ldg + col0 + bj * HALF);
                        ow[m][bj] = *(const u32x4*)(MG + row * ldc + col0 + bj * HALF); } }
#pragma unroll
                for (int m = 0; m < 4; ++m)
#pragma unroll
                    for (int bj = 0; bj < 2; ++bj) { const unsigned b2[2] = {gb[m][bj].x, gb[m][bj].y}, c2[2] = {gc[m][bj].x, gc[m][bj].y}, o4[4] = {ow[m][bj].x, ow[m][bj].y, ow[m][bj].z, ow[m][bj].w};
#pragma unroll
                        for (int q = 0; q < 4; ++q) {
                            const float bb0 = (float)((b2[q >> 1] >> (16 * (q & 1))) & 0xffu), bb1 = (float)((b2[q >> 1] >> (16 * (q & 1) + 8)) & 0xffu);
                            const float cc0 = fmaxf((float)((c2[q >> 1] >> (16 * (q & 1))) & 0xffu), 1.0f), cc1 = fmaxf((float)((c2[q >> 1] >> (16 * (q & 1) + 8)) & 0xffu), 1.0f);
                            const float m0 = __uint_as_float(o4[q] << 16) * 255.0f, m1 = __uint_as_float(o4[q] & 0xffff0000u) * 255.0f;
                            const float a0 = acc[ai][bj][m][q >> 1][2 * (q & 1)], a1 = acc[ai][bj][m][q >> 1][2 * (q & 1) + 1];
                            acc[ai][bj][m][q >> 1][2 * (q & 1)] = (m0 + bb0 * a0) * __builtin_amdgcn_rcpf(cc0); acc[ai][bj][m][q >> 1][2 * (q & 1) + 1] = (m1 + bb1 * a1) * __builtin_amdgcn_rcpf(cc1); } }
                asm volatile("" ::: "memory");
            }
            return;
        }
        const bool fin = chain && branch == 2;
#pragma unroll
        for (int ai = 0; ai < 2; ++ai) {
            u32x2m_ gw[4][2]; u32x4 ow[4][2];
#pragma unroll
            for (int m = 0; m < 4; ++m) { const size_t row = (size_t)(row0 + ai * HALF + m * 16);
#pragma unroll
                for (int bj = 0; bj < 2; ++bj) { gw[m][bj] = *(const u32x2m_*)(G + row * ldg + col0 + bj * HALF); ow[m][bj] = (first || fin) ? (u32x4){0u, 0u, 0u, 0u} : *(const u32x4*)(MG + row * ldc + col0 + bj * HALF); } }
#pragma unroll
            for (int m = 0; m < 4; ++m) { const size_t row = (size_t)(row0 + ai * HALF + m * 16);
#pragma unroll
                for (int bj = 0; bj < 2; ++bj) { const f32x4 v0 = acc[ai][bj][m][0], v1 = acc[ai][bj][m][1];
                    const unsigned g2[2] = {gw[m][bj].x, gw[m][bj].y}, o4[4] = {ow[m][bj].x, ow[m][bj].y, ow[m][bj].z, ow[m][bj].w};
                    const float a8[8] = {v0[0], v0[1], v0[2], v0[3], v1[0], v1[1], v1[2], v1[3]};
                    unsigned w4[4];
#pragma unroll
                    for (int q = 0; q < 4; ++q) {
                        float gb0 = (float)((g2[q >> 1] >> (16 * (q & 1))) & 0xffu), gb1 = (float)((g2[q >> 1] >> (16 * (q & 1) + 8)) & 0xffu);
                        if (fin) { gb0 = fmaxf(gb0, 1.0f); gb1 = fmaxf(gb1, 1.0f); }
                        const float g0 = gb0 * (1.0f / 255.0f), g1 = gb1 * (1.0f / 255.0f);
                        const float r0 = __uint_as_float(o4[q] << 16) + a8[2 * q] * g0;
                        const float r1 = __uint_as_float(o4[q] & 0xffff0000u) + a8[2 * q + 1] * g1;
                        unsigned pk; asm("v_cvt_pk_bf16_f32 %0, %1, %2" : "=v"(pk) : "v"(r0), "v"(r1)); w4[q] = pk; }
                    *(u32x4*)(MG + row * ldc + col0 + bj * HALF) = (u32x4){w4[0], w4[1], w4[2], w4[3]}; } }
            asm volatile("" ::: "memory");
        }
    }
};

typedef int pg8_v8i __attribute__((ext_vector_type(8)));
typedef int pg8_v4i __attribute__((ext_vector_type(4)));
template <class Epi, class Sched, bool STAMP = false, bool ALIGN_EPI = false, bool SP2 = false, bool FP8 = false>
__device__ __forceinline__ void gemm_phase(PG8_LAS unsigned char* lds, const Gemm g, const Sched& S, const Epi& E, unsigned long long* stamps) {
    const int tid = otid(), wid = __builtin_amdgcn_readfirstlane(tid >> 6), lane = tid & 63, wr = wid >> 2, wc = wid & 3, fr = lane & 15, fq = lane >> 4;
    const int K = g.K, nt = K / BK, LDA = g.lda ? g.lda : g.K;
    int ts_lo = 0, ts_hi = 0, nts = 0; const unsigned long long rt_entry = STAMP ? (unsigned long long)wall_clock64() : 0ull;
#define PG8_STAMP() do { if (STAMP && wid == 0 && nts < 64) { const unsigned long long _c = (unsigned long long)clock64(); \
        ts_lo = (lane == nts) ? (int)(unsigned)_c : ts_lo; ts_hi = (lane == nts) ? (int)(unsigned)(_c >> 32) : ts_hi; ++nts; } } while (0)
    PG8_STAMP();
    unsigned voffA[2], voffB[2];
#pragma unroll
    for (int i = 0; i < 2; ++i) { int R, C; stage_rc(tid * 16 + i * 8192, R, C); const int Rb = Epi::PERM ? ((R & ~31) + perm32(R & 31)) : R;
        voffA[i] = (unsigned)(R * LDA + C) * 2u; voffB[i] = (unsigned)(Rb * K + C) * 2u; }
    const size_t kstep = (size_t)(BK * 2);
    const size_t hstepB = (size_t)HALF * K * 2, hstepA = (size_t)HALF * LDA * 2;
    const size_t tstepB = 2 * hstepB, tstepA = 2 * hstepA;
    const unsigned ldsw = (unsigned)wid * 1024u;
    const int aoff = lds_byte(wr * 64 + fr, fq * 8), boff = lds_byte(wc * 32 + fr, fq * 8);
#define PG8_SA(b, h) (((b) * 2 + (h)) * HTB)
#define PG8_SB(b, h) ((4 + (b) * 2 + (h)) * HTB)
#define PG8_STAGE(bufoff, gbase, voff) do { _Pragma("unroll") for (int _i = 0; _i < 2; ++_i) \
        __builtin_amdgcn_global_load_lds((const unsigned*)((const char*)(gbase) + (voff)[_i]), (PG8_LAS unsigned*)(lds + (bufoff) + ldsw + _i * 8192), 16, 0, 0); } while (0)
#define PG8_I4(p) (*(const PG8_LAS pg8_v4i*)(p))
#define PG8_LDA(dst, b, h) do { if constexpr (FP8) { _Pragma("unroll") for (int m = 0; m < 4; ++m) dst##8[m] = __builtin_shufflevector(PG8_I4(lds + PG8_SA(b, h) + aoff + m * 2048), PG8_I4(lds + PG8_SA(b, h) + aoff + m * 2048 + 1024), 0, 1, 2, 3, 4, 5, 6, 7); } \
        else { _Pragma("unroll") for (int m = 0; m < 4; ++m) _Pragma("unroll") for (int k = 0; k < 2; ++k) dst[m][k] = *(const PG8_LAS bf16x8*)(lds + PG8_SA(b, h) + aoff + m * 2048 + k * 1024); } } while (0)
#define PG8_LDB(dst, b, h) do { if constexpr (FP8) { _Pragma("unroll") for (int n = 0; n < 2; ++n) dst##8[n] = __builtin_shufflevector(PG8_I4(lds + PG8_SB(b, h) + boff + n * 2048), PG8_I4(lds + PG8_SB(b, h) + boff + n * 2048 + 1024), 0, 1, 2, 3, 4, 5, 6, 7); } \
        else { _Pragma("unroll") for (int n = 0; n < 2; ++n) _Pragma("unroll") for (int k = 0; k < 2; ++k) dst[n][k] = *(const PG8_LAS bf16x8*)(lds + PG8_SB(b, h) + boff + n * 2048 + k * 1024); } } while (0)
#define PG8_MMA_BF(ai, bj, At, Bt) do { __builtin_amdgcn_s_setprio(1); _Pragma("unroll") for (int m = 0; m < 4; ++m) _Pragma("unroll") for (int n = 0; n < 2; ++n) _Pragma("unroll") for (int k = 0; k < 2; ++k) \
        acc[ai][bj][m][n] = __builtin_amdgcn_mfma_f32_16x16x32_bf16(Bt[n][k], At[m][k], acc[ai][bj][m][n], 0, 0, 0); __builtin_amdgcn_s_setprio(0); } while (0)
#define PG8_MMA_F8(ai, bj, At, Bt) do { __builtin_amdgcn_s_setprio(1); _Pragma("unroll") for (int m = 0; m < 4; ++m) _Pragma("unroll") for (int n = 0; n < 2; ++n) \
        asm volatile("v_mfma_scale_f32_16x16x128_f8f6f4 %0, %1, %2, %0, %3, %4 op_sel_hi:[0,0,0]" : "+v"(acc[ai][bj][m][n]) : "v"(Bt##8[n]), "v"(At##8[m]), "v"(f8_scale_w), "v"(f8_scale_x)); \
        __builtin_amdgcn_s_setprio(0); } while (0)
#define PG8_F8_DRAIN() do { if constexpr (FP8) asm volatile("s_nop 15\n\ts_nop 15" ::: "memory"); } while (0)
#define PG8_MMA(ai, bj, At, Bt) do { if constexpr (FP8) PG8_MMA_F8(ai, bj, At, Bt); else PG8_MMA_BF(ai, bj, At, Bt); } while (0)
#define PG8_WAIT_V(n) asm volatile("s_waitcnt vmcnt(" #n ")" ::: "memory")
#define PG8_WAIT_L(n) asm volatile("s_waitcnt lgkmcnt(" #n ")" ::: "memory")
#define PG8_BAR __builtin_amdgcn_s_barrier()
#define PG8_SCHED __builtin_amdgcn_sched_barrier(0)
    Unit cur, nxt; int ui = 0;
    if (!S.next(0, cur)) return;
    f32x4 acc[2][2][4][2];
#pragma unroll
    for (int a = 0; a < 2; ++a)
#pragma unroll
        for (int b = 0; b < 2; ++b)
#pragma unroll
            for (int m = 0; m < 4; ++m)
#pragma unroll
                for (int n = 0; n < 2; ++n) acc[a][b][m][n] = (f32x4){0.f, 0.f, 0.f, 0.f};
    int f8_scale_w = g.f8sw ? g.f8sw : 0x79797979, f8_scale_x = g.f8sx ? g.f8sx : 0x7f7f7f7f; (void)f8_scale_w; (void)f8_scale_x;
    bf16x8 At[4][2], B0[2][2], B1[2][2]; pg8_v8i At8[4], B08[2], B18[2];
    (void)At; (void)B0; (void)B1; (void)At8; (void)B08; (void)B18;
    const char* cA = (const char*)g.A + (size_t)cur.pm * tstepA + S.a_off(cur); const char* cB = (const char*)g.Bt + (size_t)cur.pn * tstepB + S.b_off(cur);
    S.a_ready(cur);
    if constexpr (SP2) {
        PG8_STAGE(PG8_SB(0, 0), cB, voffB); PG8_STAGE(PG8_SB(0, 1), cB + hstepB, voffB); PG8_STAGE(PG8_SA(0, 0), cA, voffA); PG8_STAGE(PG8_SA(0, 1), cA + hstepA, voffA);
        if (wr == 1) PG8_BAR;
        PG8_WAIT_V(2); PG8_BAR;
        PG8_STAGE(PG8_SB(1, 0), cB + kstep, voffB); PG8_STAGE(PG8_SA(1, 0), cA + kstep, voffA); PG8_STAGE(PG8_SB(1, 1), cB + hstepB + kstep, voffB);
        PG8_WAIT_V(6); PG8_BAR;
    } else {
    PG8_STAGE(PG8_SB(0, 0), cB, voffB); PG8_STAGE(PG8_SA(0, 0), cA, voffA); PG8_STAGE(PG8_SB(0, 1), cB + hstepB, voffB); PG8_STAGE(PG8_SA(0, 1), cA + hstepA, voffA);
    if (wr == 1) PG8_BAR;
    PG8_WAIT_V(4); PG8_BAR;
    PG8_STAGE(PG8_SB(1, 0), cB + kstep, voffB); PG8_STAGE(PG8_SA(1, 0), cA + kstep, voffA); PG8_STAGE(PG8_SB(1, 1), cB + hstepB + kstep, voffB);
    PG8_WAIT_V(6); PG8_BAR;
    }
    PG8_STAMP();
    for (;;) {
        const bool has_next = S.next(ui + 1, nxt);
        const char* nA = has_next ? (const char*)g.A + (size_t)nxt.pm * tstepA + S.a_off(nxt) : cA; const char* nB = has_next ? (const char*)g.Bt + (size_t)nxt.pn * tstepB + S.b_off(nxt) : cB;
        for (int t = 0; t < nt; t += 2) {
            const bool last = (t == nt - 2);
            const char* a1 = cA + (size_t)(t + 1) * kstep;
            const char* a2 = last ? nA : cA + (size_t)(t + 2) * kstep; const char* b2 = last ? nB : cB + (size_t)(t + 2) * kstep;
            const char* a3 = a2 + kstep; const char* b3 = b2 + kstep;
            if (last && has_next) S.a_ready(nxt);
            if constexpr (SP2) {
            PG8_LDB(B0, 0, 0); PG8_LDB(B1, 0, 1); PG8_SCHED; PG8_LDA(At, 0, 0); PG8_STAGE(PG8_SA(1, 1), a1 + hstepA, voffA);
            PG8_WAIT_V(8); PG8_WAIT_L(0); PG8_BAR; PG8_MMA(0, 0, At, B0); PG8_MMA(0, 1, At, B1); PG8_BAR; PG8_SCHED;
            PG8_LDA(At, 0, 1); PG8_STAGE(PG8_SB(0, 0), b2, voffB); PG8_STAGE(PG8_SB(0, 1), b2 + hstepB, voffB); PG8_STAGE(PG8_SA(0, 0), a2, voffA);
            PG8_WAIT_V(8); PG8_WAIT_L(0); PG8_BAR; PG8_MMA(1, 0, At, B0); PG8_MMA(1, 1, At, B1); PG8_BAR; PG8_SCHED;
            PG8_LDB(B0, 1, 0); PG8_LDB(B1, 1, 1); PG8_SCHED; PG8_LDA(At, 1, 0); PG8_STAGE(PG8_SA(0, 1), a2 + hstepA, voffA);
            PG8_WAIT_V(8); PG8_WAIT_L(0); PG8_BAR; PG8_MMA(0, 0, At, B0); PG8_MMA(0, 1, At, B1); PG8_BAR; PG8_SCHED;
            PG8_LDA(At, 1, 1); PG8_STAGE(PG8_SB(1, 0), b3, voffB); PG8_STAGE(PG8_SB(1, 1), b3 + hstepB, voffB); PG8_STAGE(PG8_SA(1, 0), a3, voffA);
            PG8_WAIT_V(8); PG8_WAIT_L(0); PG8_BAR; PG8_MMA(1, 0, At, B0); PG8_MMA(1, 1, At, B1); PG8_BAR; PG8_SCHED;
            } else {
            PG8_LDB(B0, 0, 0); PG8_SCHED; PG8_LDA(At, 0, 0); PG8_STAGE(PG8_SA(1, 1), a1 + hstepA, voffA);
            PG8_WAIT_L(8); PG8_BAR; PG8_WAIT_L(0); PG8_MMA(0, 0, At, B0); PG8_BAR; PG8_SCHED;
            PG8_LDB(B1, 0, 1); PG8_STAGE(PG8_SB(0, 0), b2, voffB);
            PG8_BAR; PG8_WAIT_L(0); PG8_MMA(0, 1, At, B1); PG8_BAR;
            PG8_LDA(At, 0, 1); PG8_STAGE(PG8_SA(0, 0), a2, voffA);
            PG8_BAR; PG8_WAIT_L(0); PG8_MMA(1, 0, At, B0); PG8_BAR; PG8_SCHED;
            PG8_STAGE(PG8_SB(0, 1), b2 + hstepB, voffB);
            PG8_WAIT_V(6); PG8_BAR; PG8_MMA(1, 1, At, B1); PG8_BAR;
            PG8_LDB(B0, 1, 0); PG8_SCHED; PG8_LDA(At, 1, 0); PG8_STAGE(PG8_SA(0, 1), a2 + hstepA, voffA);
            PG8_WAIT_L(8); PG8_BAR; PG8_WAIT_L(0); PG8_MMA(0, 0, At, B0); PG8_BAR; PG8_SCHED;
            PG8_LDB(B1, 1, 1); PG8_STAGE(PG8_SB(1, 0), b3, voffB);
            PG8_BAR; PG8_WAIT_L(0); PG8_MMA(0, 1, At, B1); PG8_BAR;
            PG8_LDA(At, 1, 1); PG8_STAGE(PG8_SA(1, 0), a3, voffA);
            PG8_BAR; PG8_WAIT_L(0); PG8_MMA(1, 0, At, B0); PG8_BAR; PG8_SCHED;
            PG8_STAGE(PG8_SB(1, 1), b3 + hstepB, voffB);
            PG8_WAIT_V(6); PG8_BAR; PG8_MMA(1, 1, At, B1); PG8_BAR;
            }
        }
        if constexpr (ALIGN_EPI) { if (wr == 0) PG8_BAR; }
        PG8_STAMP();
        PG8_F8_DRAIN();
        if constexpr (!Epi::AFTER_DRAIN) { E(acc, cur, wr, wc, fr, fq); S.done(cur); }
        PG8_STAMP();
        if (!has_next) break;
        bool keep_ = false; if constexpr (Epi::CHAINS) keep_ = E.keep(cur);
        if (!keep_) {
#pragma unroll
        for (int a = 0; a < 2; ++a)
#pragma unroll
            for (int b = 0; b < 2; ++b)
#pragma unroll
                for (int m = 0; m < 4; ++m)
#pragma unroll
                    for (int n = 0; n < 2; ++n) acc[a][b][m][n] = (f32x4){0.f, 0.f, 0.f, 0.f}; }
        cur = nxt; cA = nA; cB = nB; ++ui;
        if constexpr (ALIGN_EPI) { if (wr == 1) PG8_BAR; }
    }
    PG8_WAIT_V(0);
    if constexpr (!ALIGN_EPI) { if (wr == 0) PG8_BAR; }
    PG8_BAR;
    if constexpr (Epi::AFTER_DRAIN) { E.fused(acc, cur, wr, wc, fr, fq, lds, wid, lane); S.done(cur); }
    PG8_STAMP();
    if (STAMP && wid == 0) { stamps[lane] = lane < nts ? (((unsigned long long)(unsigned)ts_hi << 32) | (unsigned)ts_lo) : 0ull;
        if (lane == 62) stamps[62] = rt_entry; if (lane == 63) stamps[63] = (unsigned long long)wall_clock64(); }
#undef PG8_STAMP
#undef PG8_SA
#undef PG8_SB
#undef PG8_STAGE
#undef PG8_LDA
#undef PG8_LDB
#undef PG8_MMA
#undef PG8_MMA_BF
#undef PG8_MMA_F8
#undef PG8_I4
#undef PG8_F8_DRAIN
#undef PG8_WAIT_V
#undef PG8_WAIT_L
#undef PG8_BAR
#undef PG8_SCHED
}
}
#define XB_TMO      128
#define XB_XCNT(j)  (256  + 64 * (j))
#define XB_XSUB(j)  (1280 + 64 * (j))
#define XB_XGEN(j)  (2304 + 64 * (j))
#define XB_TOP      3328
#define XB_TOPGEN   3392
#define XCD_BAR_WORDS 3456
#define XB_SPIN_CAP (1u << 18)
#define LAS __attribute__((address_space(3)))

__device__ __forceinline__ unsigned xb_ld(unsigned* p)              { return __hip_atomic_load(p, __ATOMIC_RELAXED, __HIP_MEMORY_SCOPE_AGENT); }
__device__ __forceinline__ unsigned xb_add(unsigned* p, unsigned v) { return __hip_atomic_fetch_add(p, v, __ATOMIC_RELAXED, __HIP_MEMORY_SCOPE_AGENT); }
__device__ __forceinline__ unsigned xb_xcc_id() { return (unsigned)__builtin_amdgcn_s_getreg((3 << 11) | 20) & 0xFu; }
#define XB_SPIN(cond, bar) do { unsigned _sp = 0; while (cond) { __builtin_amdgcn_s_sleep(1); \
    if ((++_sp & 255u) == 0u) { if (xb_ld(&(bar)[XB_TMO])) break; if (_sp > XB_SPIN_CAP) { atomicAdd(&(bar)[XB_TMO], 1u); break; } } } } while (0)

struct XcdBarrier {
    unsigned* bar; unsigned x;
    volatile LAS unsigned* st;
};

__device__ __forceinline__ XcdBarrier xcd_barrier_post(unsigned* bar, volatile LAS unsigned* st) {
    XcdBarrier b; b.bar = bar; b.x = xb_xcc_id(); b.st = st;
    if (threadIdx.x == 0) (void)xb_add(&bar[XB_XCNT(b.x)], 1u);
    return b;
}
__device__ __forceinline__ void xcd_barrier_complete(unsigned* bar, unsigned x, unsigned& nloc, unsigned& nx) {
    const unsigned G = gridDim.x * gridDim.y * gridDim.z;
    unsigned sum, cnt, mine, sp = 0u;
    for (;;) {
        sum = 0u; cnt = 0u; mine = 0u;
#pragma unroll
        for (unsigned j = 0; j < 16; ++j) { const unsigned c = xb_ld(&bar[XB_XCNT(j)]); sum += c; cnt += (c > 0u) ? 1u : 0u; mine = (j == x) ? c : mine; }
        if (sum == G) break;
        __builtin_amdgcn_s_sleep(1);
        if ((++sp & 255u) == 0u) { if (xb_ld(&bar[XB_TMO])) break; if (sp > XB_SPIN_CAP) { atomicAdd(&bar[XB_TMO], 1u); break; } }
    }
    nloc = mine > 0u ? mine : 1u; nx = cnt > 0u ? cnt : 1u;
}

__device__ __forceinline__ void xcd_barrier(const XcdBarrier& b) {
    asm volatile("s_waitcnt vmcnt(0)" ::: "memory");
    __syncthreads();
    if (threadIdx.x == 0) {
        unsigned* bar = b.bar;
        __builtin_amdgcn_s_waitcnt(0);
        unsigned nloc = b.st[0], nx = b.st[1];
        if (nloc == 0u) { xcd_barrier_complete(bar, b.x, nloc, nx); b.st[0] = nloc; b.st[1] = nx; }
        const unsigned old = xb_add(&bar[XB_XSUB(b.x)], 1u);
        const unsigned gen = old / nloc;
        if (old + 1u == (gen + 1u) * nloc) {
            __builtin_amdgcn_fence(__ATOMIC_RELEASE, "agent");
            asm volatile("s_waitcnt vmcnt(0)" ::: "memory");
            const unsigned og = xb_add(&bar[XB_TOP], 1u);
            const unsigned tg = og / nx;
            if (og + 1u == (tg + 1u) * nx) xb_add(&bar[XB_TOPGEN], 1u);
            else XB_SPIN(xb_ld(&bar[XB_TOPGEN]) == tg, bar);
            __builtin_amdgcn_fence(__ATOMIC_ACQUIRE, "agent");
            xb_add(&bar[XB_XGEN(b.x)], 1u);
            asm volatile("s_waitcnt vmcnt(0)" ::: "memory");
        } else {
            XB_SPIN(xb_ld(&bar[XB_XGEN(b.x)]) == gen, bar);
            __builtin_amdgcn_fence(__ATOMIC_ACQUIRE, "agent");
            asm volatile("s_waitcnt vmcnt(0)" ::: "memory");
        }
    }
    __syncthreads();
}


typedef unsigned short bf16;
typedef unsigned v4u __attribute__((ext_vector_type(4)));
typedef unsigned v2u __attribute__((ext_vector_type(2)));
typedef float v4f __attribute__((ext_vector_type(4)));
typedef float v2f __attribute__((ext_vector_type(2)));

constexpr int DM = 2048, NBATCH = 8, SEQ = 4096, DEPTH = 2, MTOK = NBATCH * SEQ;
constexpr int IN_COLS = 14416, NPROJ = 14592;
constexpr int C_UB = 0, C_VB = 1024, C_ZB = 2048, C_QC = 3072, C_KC = 3584, C_VC = 4096, C_ZC = 5120, C_KROPE = 6144, C_AR = 6208,
              C_CQ = 6400, C_CKV = 6912, C_ZA = 7424, C_GATE = 8448;
constexpr int NBF = C_CQ, NF8 = NPROJ - NBF;
constexpr float EPS = 1e-6f;
#ifndef NBP
#define NBP 4
#endif
constexpr int MP = NBP * SEQ, NPASS = NBATCH / NBP;
constexpr int STEPS_PER_PASS = 7;
constexpr int NSTEPS = DEPTH * NPASS * STEPS_PER_PASS;

constexpr size_t al256(size_t x) { return (x + 255) & ~(size_t)255; }
constexpr size_t WS_CTL = 0, CTL_BYTES = 1u << 20;
constexpr size_t SZ_WINB = (size_t)NBF * DM * 2  , SZ_WIN = SZ_WINB + (size_t)NF8 * DM  , SZ_WUQ = (size_t)1536 * 512 * 2, SZ_WUKV = (size_t)2048 * 512 * 2, SZ_WB = (size_t)3 * 2048 * 1024 * 2, SZ_WO = (size_t)2048 * 2048 * 2;
constexpr size_t SZ_WLAYER = SZ_WIN + SZ_WUQ + SZ_WUKV + SZ_WB + SZ_WO;
constexpr size_t WS_W = CTL_BYTES;
constexpr size_t WS_COS = WS_W + SZ_WLAYER, WS_SIN = WS_COS + (size_t)MTOK * 32 * 4;
constexpr size_t WS_H = WS_SIN + (size_t)MTOK * 32 * 4;
constexpr size_t WS_MG = WS_H;
constexpr size_t WS_PROJ = WS_H + (size_t)MP * DM * 2;
constexpr size_t WS_XB = WS_PROJ + (size_t)MP * NPROJ * 2;
constexpr size_t WS_SSQ = WS_XB + (size_t)MP * 2048;
constexpr size_t WS_Q = WS_SSQ + al256((size_t)3 * MP * 4);
constexpr size_t WS_KV = WS_Q + (size_t)MP * 1536 * 2;
constexpr size_t WS_K = WS_KV + (size_t)MP * 2048 * 2;
constexpr size_t WS_YA = WS_K + (size_t)MP * 1536 * 2;
constexpr size_t WS_YB = WS_YA + (size_t)MP * 1024 * 2;
constexpr size_t WS_DL = WS_YA;
constexpr size_t WS_YC = WS_YB + (size_t)MP * 1024 * 2;
constexpr size_t WS_OC = WS_YC + (size_t)MP * 1024 * 2;
constexpr size_t WS_QE = WS_OC + (size_t)MP * 1024 * 4;
constexpr size_t WS_KE = WS_QE + (size_t)MP * 512 * 2, WS_KL = WS_KE + (size_t)MP * 512 * 2;
constexpr size_t WS_HN = WS_KV;
constexpr size_t WS_H8 = WS_KE;
constexpr size_t WS_DS = WS_KL + (size_t)MP * 512 * 2;
constexpr size_t WS_END = WS_DS + (size_t)(MP / 128) * 512 * 4;
static_assert(WS_END <= ((size_t)1 << 30), "workspace map exceeds 1 GiB");

constexpr int LDS_BYTES = 147456;
constexpr int LDSCTL_OFF = LDS_BYTES - 256;
constexpr int CW_BAR = 4096;

__device__ __forceinline__ float bf2f(unsigned v) { return __uint_as_float(v << 16); }
__device__ __forceinline__ unsigned f2bf(float f) { unsigned u = __float_as_uint(f); return (u + 0x7fffu + ((u >> 16) & 1u)) >> 16; }
__device__ __forceinline__ unsigned pk2(float lo, float hi) { return f2bf(lo) | (f2bf(hi) << 16); }
__device__ __forceinline__ float lo16(unsigned w) { return __uint_as_float(w << 16); }
__device__ __forceinline__ float hi16(unsigned w) { return __uint_as_float(w & 0xffff0000u); }
__device__ __forceinline__ float sigmoid_f(float x) { return 1.f / (1.f + __expf(-x)); }
__device__ __forceinline__ float silu_f(float x) { return x / (1.f + __expf(-x)); }
__device__ __forceinline__ float gelu_f(float x) { const float u2 = 1.5957691216057308f * (x + 0.044715f * x * x * x); return x * __builtin_amdgcn_rcpf(1.f + __expf(-u2)); }
template <int O> __device__ __forceinline__ float lane_xor(float v) {
    if (O == 1) return __uint_as_float((unsigned)__builtin_amdgcn_mov_dpp((int)__float_as_uint(v), 0xB1, 0xf, 0xf, true));
    if (O == 2) return __uint_as_float((unsigned)__builtin_amdgcn_mov_dpp((int)__float_as_uint(v), 0x4E, 0xf, 0xf, true));
    return __uint_as_float((unsigned)__builtin_amdgcn_ds_swizzle((int)__float_as_uint(v), (O << 10) | 0x1f)); }
__device__ __forceinline__ float lane_xor32(float v, int lane) {
    auto rr = __builtin_amdgcn_permlane32_swap(__float_as_uint(v), __float_as_uint(v), false, false);
    return __uint_as_float(lane < 32 ? rr[1] : rr[0]); }
__device__ __forceinline__ float wave_sum(float v) {
    v += lane_xor<1>(v); v += lane_xor<2>(v); v += lane_xor<4>(v); v += lane_xor<8>(v); v += lane_xor<16>(v);
    auto rr = __builtin_amdgcn_permlane32_swap(__float_as_uint(v), __float_as_uint(v), false, false);
    return __uint_as_float(rr[0]) + __uint_as_float(rr[1]); }
__device__ __forceinline__ float wave_max(float v) {
    v = fmaxf(v, lane_xor<1>(v)); v = fmaxf(v, lane_xor<2>(v)); v = fmaxf(v, lane_xor<4>(v)); v = fmaxf(v, lane_xor<8>(v)); v = fmaxf(v, lane_xor<16>(v));
    auto rr = __builtin_amdgcn_permlane32_swap(__float_as_uint(v), __float_as_uint(v), false, false);
    return fmaxf(__uint_as_float(rr[0]), __uint_as_float(rr[1])); }
#define LDS_FENCE() asm volatile("s_waitcnt lgkmcnt(0)" ::: "memory")

struct Args { const void* in[18]; float* out; unsigned char* ws; int lo, hi, pad0, pad1; };

template <int MODE> __device__ __forceinline__ int src_col(int n) {
    if (MODE == 0) return n;
    if (MODE == 2) n += NBF;
    if (n < C_VB) return 2112 + n;
    if (n < C_ZB) return 3136 + (n - C_VB);
    if (n < C_QC) return 4160 + (n - C_ZB);
    if (n < C_KC) return 5184 + (n - C_QC);
    if (n < C_VC) return 5696 + (n - C_KC);
    if (n < C_ZC) return 6208 + (n - C_VC);
    if (n < C_KROPE) return 7248 + (n - C_ZC);
    if (n < C_AR) return 1024 + (n - C_KROPE);
    if (n < C_AR + 16) return 7232 + (n - C_AR);
    if (n < C_CQ) return -1;
    if (n < C_CKV) return n - C_CQ;
    if (n < C_ZA) return 512 + (n - C_CKV);
    if (n < C_GATE) return 1088 + (n - C_ZA);
    return 8272 + (n - C_GATE);
}
template <int MODE> __device__ __forceinline__ void convert_T(const float* W, int K, int Nsrc, bf16* WT, int Ndst, LAS float* tile, int vb, int nvb, const float* kscale = nullptr, int kmask = -1) {
    const int tid = otid(), ntk = K / 64, ntn = Ndst / 64, ntiles = ntk * ntn;
    for (int t = vb; t < ntiles; t += nvb) {
        const int k0 = (t % ntk) * 64, n0 = (t / ntk) * 64;
        { const int nn = tid & 63, sc = src_col<MODE>(n0 + nn), scc = sc >= 0 ? sc : 0; const float mul = sc >= 0 ? 1.f : 0.f;
          float v[8];
#pragma unroll
          for (int i = 0; i < 8; ++i) v[i] = W[(size_t)(k0 + (tid >> 6) + 8 * i) * Nsrc + scc];
          if (kscale) {
#pragma unroll
              for (int i = 0; i < 8; ++i) v[i] *= kscale[(k0 + (tid >> 6) + 8 * i) & kmask]; }
#pragma unroll
          for (int i = 0; i < 8; ++i) tile[((tid >> 6) + 8 * i) * 65 + nn] = v[i] * mul; }
        __syncthreads();
        { const int nn = tid & 63, kg = tid >> 6;
          const LAS float* tp = tile + (kg * 8) * 65 + nn;
          v4u o; o.x = pk2(tp[0], tp[65]); o.y = pk2(tp[2 * 65], tp[3 * 65]); o.z = pk2(tp[4 * 65], tp[5 * 65]); o.w = pk2(tp[6 * 65], tp[7 * 65]);
          *(v4u*)(WT + (size_t)(n0 + nn) * K + k0 + kg * 8) = o; }
        __syncthreads();
    }
}

template <int MODE> __device__ __forceinline__ void convert_T8(const float* W, int K, int Nsrc, unsigned char* WT, int Ndst, float wscale, LAS float* tile, int vb, int nvb, const float* kscale = nullptr) {
    const int tid = otid(), ntk = K / 64, ntn = Ndst / 64, ntiles = ntk * ntn;
    for (int t = vb; t < ntiles; t += nvb) {
        const int k0 = (t % ntk) * 64, n0 = (t / ntk) * 64;
        { const int nn = tid & 63;
          const int sc = src_col<MODE>(n0 + nn);
#pragma unroll
          for (int i = 0; i < 8; ++i) { const int kk = (tid >> 6) + 8 * i; tile[kk * 65 + nn] = W[(size_t)(k0 + kk) * Nsrc + sc] * (kscale ? wscale * kscale[k0 + kk] : wscale); } }
        __syncthreads();
        { const int nn = tid & 63, kg = tid >> 6;
          const LAS float* tp = tile + (kg * 8) * 65 + nn;
          unsigned w0 = 0u, w1 = 0u;
          w0 = __builtin_amdgcn_cvt_pk_fp8_f32(tp[0], tp[65], w0, false); w0 = __builtin_amdgcn_cvt_pk_fp8_f32(tp[2 * 65], tp[3 * 65], w0, true);
          w1 = __builtin_amdgcn_cvt_pk_fp8_f32(tp[4 * 65], tp[5 * 65], w1, false); w1 = __builtin_amdgcn_cvt_pk_fp8_f32(tp[6 * 65], tp[7 * 65], w1, true);
          *(v2u*)(WT + (size_t)(n0 + nn) * K + k0 + kg * 8) = (v2u){w0, w1}; }
        __syncthreads();
    }
}

__device__ __forceinline__ void ph_norm(const float* xin, const float* g, bf16* h, unsigned char* h8, int rows, int vb, int nvb) {
    const int tid_ = otid(); const int lane = tid_ & 63, wave = tid_ >> 6;
    for (int r = vb * 8 + wave; r < rows; r += nvb * 16) {
        const int r2 = r + nvb * 8; const bool two = r2 < rows; const int rb = two ? r2 : r;
        const v4f* xr = (const v4f*)(xin + (size_t)r * DM); const v4f* xs = (const v4f*)(xin + (size_t)rb * DM);
        v4f v[8], u[8]; float ss = 0.f, st = 0.f;
#pragma unroll
        for (int j = 0; j < 8; ++j) { v[j] = xr[lane + 64 * j]; u[j] = xs[lane + 64 * j]; }
#pragma unroll
        for (int j = 0; j < 8; ++j) { ss += v[j].x * v[j].x + v[j].y * v[j].y + v[j].z * v[j].z + v[j].w * v[j].w; st += u[j].x * u[j].x + u[j].y * u[j].y + u[j].z * u[j].z + u[j].w * u[j].w; }
        ss = wave_sum(ss); st = wave_sum(st);
        const float rn = 1.0f / sqrtf(ss * (1.0f / DM) + EPS), rm = 1.0f / sqrtf(st * (1.0f / DM) + EPS);
#pragma unroll
        for (int j = 0; j < 8; ++j) { const v4f gg = ((const v4f*)g)[lane + 64 * j];
            { const float y0 = v[j].x * rn * gg.x, y1 = v[j].y * rn * gg.y, y2 = v[j].z * rn * gg.z, y3 = v[j].w * rn * gg.w;
              v2u o; o.x = pk2(y0, y1); o.y = pk2(y2, y3);
              *(v2u*)(h + (size_t)r * DM + (lane + 64 * j) * 4) = o;
              unsigned w8 = 0u; w8 = __builtin_amdgcn_cvt_pk_fp8_f32(y0, y1, w8, false); w8 = __builtin_amdgcn_cvt_pk_fp8_f32(y2, y3, w8, true);
              *(unsigned*)(h8 + (size_t)r * DM + (lane + 64 * j) * 4) = w8; }
            if (two) { const float y0 = u[j].x * rm * gg.x, y1 = u[j].y * rm * gg.y, y2 = u[j].z * rm * gg.z, y3 = u[j].w * rm * gg.w;
              v2u o; o.x = pk2(y0, y1); o.y = pk2(y2, y3);
              *(v2u*)(h + (size_t)r2 * DM + (lane + 64 * j) * 4) = o;
              unsigned w8 = 0u; w8 = __builtin_amdgcn_cvt_pk_fp8_f32(y0, y1, w8, false); w8 = __builtin_amdgcn_cvt_pk_fp8_f32(y2, y3, w8, true);
              *(unsigned*)(h8 + (size_t)r2 * DM + (lane + 64 * j) * 4) = w8; } }
    }
}
__device__ __forceinline__ float row16_sum(float v) {
    v += __uint_as_float((unsigned)__builtin_amdgcn_mov_dpp((int)__float_as_uint(v), 0xB1, 0xf, 0xf, true));
    v += __uint_as_float((unsigned)__builtin_amdgcn_mov_dpp((int)__float_as_uint(v), 0x4E, 0xf, 0xf, true));
    v += __uint_as_float((unsigned)__builtin_amdgcn_mov_dpp((int)__float_as_uint(v), 0x141, 0xf, 0xf, true));
    v += __uint_as_float((unsigned)__builtin_amdgcn_mov_dpp((int)__float_as_uint(v), 0x140, 0xf, 0xf, true));
    return v; }
__device__ __forceinline__ void ph_vt8(const unsigned char* kv, unsigned char* V8T, int vb, int nvb) {
    const int tid = otid(), quad = tid & 31, oct = tid >> 5, g = quad >> 3, u = quad & 7, key0 = 32 * g + (u < 4 ? 8 * u : 8 * (u - 4) + 4);
    for (int it = vb; it < NBP * 8 * (SEQ / 128); it += nvb) {
        const int bh = it / (SEQ / 128), blk = it - bh * (SEQ / 128), bl = bh >> 3, h = bh & 7;
        const unsigned char* src = kv + (size_t)(bl * SEQ + blk * 128 + key0) * 2048 + h * 256 + 128 + oct * 8;
        v2u w[4];
#pragma unroll
        for (int kk = 0; kk < 4; ++kk) w[kk] = *(const v2u*)(src + (size_t)kk * 2048);
        unsigned char* dst = V8T + ((size_t)bh * 128 + oct * 8) * SEQ + blk * 128 + quad * 4;
#pragma unroll
        for (int j = 0; j < 8; ++j) {
            const unsigned e0 = j < 4 ? w[0].x : w[0].y, e1 = j < 4 ? w[1].x : w[1].y, e2 = j < 4 ? w[2].x : w[2].y, e3 = j < 4 ? w[3].x : w[3].y;
            const unsigned sel = (unsigned)(((4 + (j & 3)) << 8) | (j & 3)) | 0x0c0c0000u;
            const unsigned t01 = __builtin_amdgcn_perm(e1, e0, sel), t23 = __builtin_amdgcn_perm(e3, e2, sel);
            *(unsigned*)(dst + (size_t)j * SEQ) = t01 | (t23 << 16); }
    }
}
__device__ __forceinline__ float f8v(const v2u w, int j) { const int d = (int)(j < 4 ? w.x : w.y); const int b = j & 3;
    return (b == 0 ? __builtin_amdgcn_cvt_f32_fp8(d, 0) : b == 1 ? __builtin_amdgcn_cvt_f32_fp8(d, 1) : b == 2 ? __builtin_amdgcn_cvt_f32_fp8(d, 2) : __builtin_amdgcn_cvt_f32_fp8(d, 3)) * 0.125f; }
#define KPOS(ch) (64 * ((ch) >> 3) + 32 * ((ch) & 1) + 8 * (((ch) >> 1) & 3))
__device__ __forceinline__ v2u pk8_fp8(const float (&x)[8]) {
    int a = __builtin_amdgcn_cvt_pk_fp8_f32(x[0], x[1], 0, false); a = __builtin_amdgcn_cvt_pk_fp8_f32(x[2], x[3], a, true);
    int b = __builtin_amdgcn_cvt_pk_fp8_f32(x[4], x[5], 0, false); b = __builtin_amdgcn_cvt_pk_fp8_f32(x[6], x[7], b, true);
    v2u w; w.x = (unsigned)a; w.y = (unsigned)b; return w; }
__device__ __forceinline__ void ph_kfin(const unsigned char* kv, const bf16* proj, unsigned char* K, const float* kg, const float* cosT, const float* sinT, int row0, int vb, int nvb) {
    const int tid_ = otid(); const int lane = tid_ & 63, wave = tid_ >> 6, g16 = lane >> 4, c = lane & 15;
    float gn[8], gr[8];
#pragma unroll
    for (int j = 0; j < 8; ++j) { gn[j] = kg[c * 8 + j]; gr[j] = kg[128 + (c & 7) * 8 + j]; }
    for (int r = vb * 8 + wave; r < MP; r += nvb * 8) {
        const v2u n0 = *(const v2u*)(kv + (size_t)r * 2048 + g16 * 256 + c * 8), n1 = *(const v2u*)(kv + (size_t)r * 2048 + (g16 + 4) * 256 + c * 8);
        const v4u rw = *(const v4u*)(proj + (size_t)r * NPROJ + C_KROPE + (c & 7) * 8);
        const v4f c0 = *(const v4f*)(cosT + (size_t)(row0 + r) * 32 + (c & 3) * 8), c1 = *(const v4f*)(cosT + (size_t)(row0 + r) * 32 + (c & 3) * 8 + 4);
        const v4f s0 = *(const v4f*)(sinT + (size_t)(row0 + r) * 32 + (c & 3) * 8), s1 = *(const v4f*)(sinT + (size_t)(row0 + r) * 32 + (c & 3) * 8 + 4);
        float a[8] = {f8v(n0, 0), f8v(n0, 1), f8v(n0, 2), f8v(n0, 3), f8v(n0, 4), f8v(n0, 5), f8v(n0, 6), f8v(n0, 7)};
        float b[8] = {f8v(n1, 0), f8v(n1, 1), f8v(n1, 2), f8v(n1, 3), f8v(n1, 4), f8v(n1, 5), f8v(n1, 6), f8v(n1, 7)};
        float kr[8] = {lo16(rw.x), hi16(rw.x), lo16(rw.y), hi16(rw.y), lo16(rw.z), hi16(rw.z), lo16(rw.w), hi16(rw.w)};
        const float cs[8] = {c0.x, c0.y, c0.z, c0.w, c1.x, c1.y, c1.z, c1.w}, sn[8] = {s0.x, s0.y, s0.z, s0.w, s1.x, s1.y, s1.z, s1.w};
        float sa = 0.f, sb = 0.f, sr = 0.f;
#pragma unroll
        for (int j = 0; j < 8; ++j) { sa += a[j] * a[j]; sb += b[j] * b[j]; sr += kr[j] * kr[j]; }
        if (c >= 8) sr = 0.f;
        sa = row16_sum(sa); sb = row16_sum(sb); sr = row16_sum(sr);
        const float rna = 1.0f / sqrtf((sa + sr) * (1.0f / 192.f) + EPS), rnb = 1.0f / sqrtf((sb + sr) * (1.0f / 192.f) + EPS);
        float R[8];
#pragma unroll
        for (int j = 0; j < 8; ++j) { const float mine = kr[j] * gr[j]; const float oth = lane_xor<4>(mine);
            R[j] = (c & 4) ? mine * cs[j] + oth * sn[j] : mine * cs[j] - oth * sn[j]; }
        unsigned char* ka = K + ((size_t)r * 8 + g16) * 192; unsigned char* kb = K + ((size_t)r * 8 + g16 + 4) * 192;
        { float x[8], y[8];
#pragma unroll
          for (int j = 0; j < 8; ++j) { x[j] = a[j] * rna * gn[j] * 8.0f; y[j] = b[j] * rnb * gn[j] * 8.0f; }
          *(v2u*)(ka + KPOS(c)) = pk8_fp8(x); *(v2u*)(kb + KPOS(c)) = pk8_fp8(y); }
        if (c < 8) { float x[8], y[8];
#pragma unroll
          for (int j = 0; j < 8; ++j) { x[j] = R[j] * rna * 8.0f; y[j] = R[j] * rnb * 8.0f; }
          *(v2u*)(ka + KPOS(16 + c)) = pk8_fp8(x); *(v2u*)(kb + KPOS(16 + c)) = pk8_fp8(y); }
    }
}

namespace at {
typedef short bf16x8 __attribute__((ext_vector_type(8)));
typedef short s16x4 __attribute__((ext_vector_type(4)));
typedef float f32x16 __attribute__((ext_vector_type(16)));
typedef unsigned u32x4 __attribute__((ext_vector_type(4)));
constexpr int SHM_V = 16384, SHM_K = 16384, SHM_KR = 8192;
constexpr int OFF_V = 0, OFF_K = 3 * SHM_V, OFF_KR = OFF_K + 2 * SHM_K, OFF_WS = OFF_KR + 2 * SHM_KR, LDS_NEED = OFF_WS + 8 * 64 * 4;
constexpr float SCALE = 0.07216878364870322f;
constexpr float THR = 4.f;
#define AT_KSWZ(row, colB) ((row) * 256 + ((colB) ^ (((row) & 7) << 4)))
#define AT_KRSWZ(row, colB) ((row) * 128 + ((colB) ^ (((row) & 7) << 4)))
#define AT_SBAR() __builtin_amdgcn_sched_barrier(0)
__device__ __forceinline__ int v_st(int k, int c) { const int kk = (k & ~0xC) | ((k & 4) << 1) | ((k & 8) >> 1); return ((kk >> 3) * 4 + (c >> 5)) * 512 + ((kk & 7) * 32 + (c & 31)) * 2; }
__device__ __forceinline__ int v_rd_base(int lane) { return ((lane & 3) << 3) | (((lane >> 2) & 3) << 6) | (((lane >> 4) & 1) << 5) | (((lane >> 5) & 1) << 8); }
constexpr int v_rd_off(int d0, int ks, int half) { return d0 * 512 + ks * 4096 + half * 2048; }
__device__ __forceinline__ int crow(int r, int hi) { return (r & 3) + 8 * (r >> 2) + 4 * hi; }
__device__ __forceinline__ unsigned cvtpk(float lo, float hi) { unsigned r; asm("v_cvt_pk_bf16_f32 %0, %1, %2" : "=v"(r) : "v"(lo), "v"(hi)); return r; }

__device__ __forceinline__ void mask_tile(f32x16& p0, f32x16& p1, int dq) {
    const float NEG = -__builtin_inff();
#pragma unroll
    for (int r = 0; r < 16; ++r) { const int c = (r & 3) + 8 * (r >> 2); if (dq < c) p0[r] = NEG; if (dq < c + 32) p1[r] = NEG; }
}
__device__ __forceinline__ void partialSM(f32x16& p0, f32x16& p1, float& m_reg, float& mn, float& alpha) {
    float pmax = p0[0];
#pragma unroll
    for (int r = 1; r < 16; ++r) pmax = fmaxf(pmax, p0[r]);
#pragma unroll
    for (int r = 0; r < 16; ++r) pmax = fmaxf(pmax, p1[r]);
    { auto rr = __builtin_amdgcn_permlane32_swap(__float_as_uint(pmax), __float_as_uint(pmax), false, false);
      pmax = fmaxf(__uint_as_float(rr[0]), __uint_as_float(rr[1])); }
    constexpr float C2 = 1.4426950408889634f * SCALE;
    if (__builtin_expect(__all((pmax - m_reg) * SCALE <= THR), 1)) { mn = m_reg; alpha = 1.f; }
    else { mn = fmaxf(m_reg, pmax); alpha = __builtin_amdgcn_exp2f((m_reg - mn) * C2); m_reg = mn; }
    const float mnL = 2.0f - mn * C2;
#pragma unroll
    for (int r = 0; r < 16; ++r) p0[r] = fmaf(p0[r], C2, mnL);
#pragma unroll
    for (int r = 0; r < 16; ++r) p1[r] = fmaf(p1[r], C2, mnL);
#pragma unroll
    for (int r = 0; r < 16; ++r) p0[r] = __builtin_amdgcn_exp2f(p0[r]);
}
__device__ __forceinline__ void finishSM(f32x16& p0, f32x16& p1, float alpha, float& l_reg, bf16x8& pa0, bf16x8& pa1, bf16x8& pa2, bf16x8& pa3) {
#pragma unroll
    for (int r = 0; r < 16; ++r) p1[r] = __builtin_amdgcn_exp2f(p1[r]);
    float ps = 0;
#pragma unroll
    for (int r = 0; r < 16; ++r) ps += p0[r];
#pragma unroll
    for (int r = 0; r < 16; ++r) ps += p1[r];
    { auto rr = __builtin_amdgcn_permlane32_swap(__float_as_uint(ps), __float_as_uint(ps), false, false);
      ps = __uint_as_float(rr[0]) + __uint_as_float(rr[1]); }
    l_reg = l_reg * alpha + ps;
#define AT_PK4(P, B_, OUT) do { unsigned a0 = cvtpk(P[B_+0], P[B_+1]), a1 = cvtpk(P[B_+2], P[B_+3]);                          \
        unsigned b0 = cvtpk(P[B_+4], P[B_+5]), b1 = cvtpk(P[B_+6], P[B_+7]);                                             \
        auto r0 = __builtin_amdgcn_permlane32_swap(a0, b0, false, false); auto r1 = __builtin_amdgcn_permlane32_swap(a1, b1, false, false); \
        u32x4 w = {r0[0], r1[0], r0[1], r1[1]}; OUT = *reinterpret_cast<bf16x8*>(&w); } while (0)
    AT_PK4(p0, 0, pa0); AT_PK4(p0, 8, pa1); AT_PK4(p1, 0, pa2); AT_PK4(p1, 8, pa3);
#undef AT_PK4
}
typedef int i32x8 __attribute__((ext_vector_type(8)));
typedef int i32x4 __attribute__((ext_vector_type(4)));
__device__ __forceinline__ void finishSM8(f32x16& p0, f32x16& p1, float alpha, float& l_reg, i32x8& pop) {
#pragma unroll
    for (int r = 0; r < 16; ++r) p1[r] = __builtin_amdgcn_exp2f(p1[r]);
    float ps = 0;
#pragma unroll
    for (int r = 0; r < 16; ++r) ps += p0[r];
#pragma unroll
    for (int r = 0; r < 16; ++r) ps += p1[r];
    { auto rr = __builtin_amdgcn_permlane32_swap(__float_as_uint(ps), __float_as_uint(ps), false, false);
      ps = __uint_as_float(rr[0]) + __uint_as_float(rr[1]); }
    l_reg = l_reg * alpha + ps;
#pragma unroll
    for (int a = 0; a < 4; ++a) {
        int d0 = __builtin_amdgcn_cvt_pk_fp8_f32(p0[4 * a], p0[4 * a + 1], 0, false); d0 = __builtin_amdgcn_cvt_pk_fp8_f32(p0[4 * a + 2], p0[4 * a + 3], d0, true);
        int d1 = __builtin_amdgcn_cvt_pk_fp8_f32(p1[4 * a], p1[4 * a + 1], 0, false); d1 = __builtin_amdgcn_cvt_pk_fp8_f32(p1[4 * a + 2], p1[4 * a + 3], d1, true);
        auto sw = __builtin_amdgcn_permlane32_swap((unsigned)d0, (unsigned)d1, false, false);
        pop[a] = (int)sw[0]; pop[4 + a] = (int)sw[1]; }
}
constexpr int V8_PITCH = 80, SHM_V8 = 128 * V8_PITCH;
__device__ __forceinline__ void pv8(f32x16* o, const LAS unsigned char* vimg, int r32, int hi, const i32x8 pop) {
    const LAS unsigned char* a0 = vimg + r32 * V8_PITCH + hi * 32;
    i32x8 f[4];
#pragma unroll
    for (int d0 = 0; d0 < 4; ++d0) f[d0] = __builtin_shufflevector(*(const LAS i32x4*)(a0 + d0 * 32 * V8_PITCH), *(const LAS i32x4*)(a0 + d0 * 32 * V8_PITCH + 16), 0, 1, 2, 3, 4, 5, 6, 7);
#pragma unroll
    for (int d0 = 0; d0 < 4; ++d0) o[d0] = __builtin_amdgcn_mfma_scale_f32_32x32x64_f8f6f4(f[d0], pop, o[d0], 0, 0, 0, 0x7f7f7f7f, 0, 0x7f7f7f7f);
}
constexpr int K8_PITCH = 208, SHM_K8 = 64 * K8_PITCH;
__device__ __forceinline__ void qkt8(f32x16& p0, f32x16& p1, const LAS unsigned char* Kb, int r32, int hi, const i32x8* q8) {
    p0 = f32x16{}; p1 = f32x16{};
    const LAS unsigned char* a0 = Kb + r32 * K8_PITCH + hi * 32;
    i32x8 f[6];
#pragma unroll
    for (int b = 0; b < 3; ++b) {
        f[2 * b] = __builtin_shufflevector(*(const LAS i32x4*)(a0 + 64 * b), *(const LAS i32x4*)(a0 + 64 * b + 16), 0, 1, 2, 3, 4, 5, 6, 7);
        f[2 * b + 1] = __builtin_shufflevector(*(const LAS i32x4*)(a0 + 32 * K8_PITCH + 64 * b), *(const LAS i32x4*)(a0 + 32 * K8_PITCH + 64 * b + 16), 0, 1, 2, 3, 4, 5, 6, 7); }
#pragma unroll
    for (int b = 0; b < 3; ++b) {
        p0 = __builtin_amdgcn_mfma_scale_f32_32x32x64_f8f6f4(f[2 * b], q8[b], p0, 0, 0, 0, 0x7c7c7c7c, 0, 0x7c7c7c7c);
        p1 = __builtin_amdgcn_mfma_scale_f32_32x32x64_f8f6f4(f[2 * b + 1], q8[b], p1, 0, 0, 0, 0x7c7c7c7c, 0, 0x7c7c7c7c); }
    __builtin_amdgcn_sched_group_barrier(0x100, 8, 0); __builtin_amdgcn_sched_group_barrier(0x008, 2, 0); __builtin_amdgcn_sched_group_barrier(0x100, 4, 0); __builtin_amdgcn_sched_group_barrier(0x008, 4, 0);
}
__device__ __forceinline__ void qkt(f32x16& p0, f32x16& p1, const LAS unsigned char* Kb, const LAS unsigned char* KRb, int r32, int hi, const bf16x8* qr) {
    p0 = f32x16{}; p1 = f32x16{};
    const LAS unsigned char* kb[4]; const LAS unsigned char* krb[4];
#pragma unroll
    for (int dd = 0; dd < 4; ++dd) { kb[dd] = Kb + AT_KSWZ(r32, (dd * 16 + hi * 8) * 2); krb[dd] = KRb + AT_KRSWZ(r32, (dd * 16 + hi * 8) * 2); }
    bf16x8 f[24];
#pragma unroll
    for (int d0 = 0; d0 < 8; ++d0) { const LAS unsigned char* a = kb[d0 & 3] + (d0 >> 2) * 128;
        f[2 * d0] = *reinterpret_cast<const LAS bf16x8*>(a); f[2 * d0 + 1] = *reinterpret_cast<const LAS bf16x8*>(a + 32 * 256); }
#pragma unroll
    for (int d0 = 0; d0 < 4; ++d0) { const LAS unsigned char* a = krb[d0];
        f[16 + 2 * d0] = *reinterpret_cast<const LAS bf16x8*>(a); f[16 + 2 * d0 + 1] = *reinterpret_cast<const LAS bf16x8*>(a + 32 * 128); }
#pragma unroll
    for (int d0 = 0; d0 < 12; ++d0) {
        p0 = __builtin_amdgcn_mfma_f32_32x32x16_bf16(f[2 * d0], qr[d0], p0, 0, 0, 0);
        p1 = __builtin_amdgcn_mfma_f32_32x32x16_bf16(f[2 * d0 + 1], qr[d0], p1, 0, 0, 0); }
    __builtin_amdgcn_sched_group_barrier(0x100, 4, 0);
#pragma unroll
    for (int i = 0; i < 20; ++i) { __builtin_amdgcn_sched_group_barrier(0x008, 1, 0); __builtin_amdgcn_sched_group_barrier(0x100, 1, 0); }
    __builtin_amdgcn_sched_group_barrier(0x008, 4, 0);
}
template <bool SWAP = false> __device__ __forceinline__ void pv_tile(f32x16* o, unsigned vb0, bf16x8 pa0, bf16x8 pa1, bf16x8 pa2, bf16x8 pa3) {
#define AT_TRRD(dst, off) asm volatile("ds_read_b64_tr_b16 %0, %1 offset:%2" : "=&v"(dst) : "v"(vb0), "i"(off) : "memory")
#define AT_PV_RD(d0, L, H) do { constexpr int b_ = v_rd_off(d0, 0, 0); \
        AT_TRRD(L[0], b_); AT_TRRD(H[0], b_ + 2048); AT_TRRD(L[1], b_ + 4096); AT_TRRD(H[1], b_ + 6144); AT_TRRD(L[2], b_ + 8192); AT_TRRD(H[2], b_ + 10240); AT_TRRD(L[3], b_ + 12288); AT_TRRD(H[3], b_ + 14336); } while (0)
#define AT_PV_M1(d0, P, L, H, q) do { const bf16x8 vf_ = (bf16x8){L[q][0], L[q][1], L[q][2], L[q][3], H[q][0], H[q][1], H[q][2], H[q][3]}; \
        if constexpr (SWAP) o[d0] = __builtin_amdgcn_mfma_f32_32x32x16_bf16(vf_, P, o[d0], 0, 0, 0); else o[d0] = __builtin_amdgcn_mfma_f32_32x32x16_bf16(P, vf_, o[d0], 0, 0, 0); } while (0)
#define AT_PV_MM(d0, L, H) do { AT_PV_M1(d0, pa0, L, H, 0); AT_PV_M1(d0, pa1, L, H, 1); AT_PV_M1(d0, pa2, L, H, 2); AT_PV_M1(d0, pa3, L, H, 3); } while (0)
    s16x4 la[4], ha[4], lb[4], hb[4];
    asm volatile("s_waitcnt lgkmcnt(0)" ::: "memory");
    AT_PV_RD(0, la, ha); AT_PV_RD(1, lb, hb);
    asm volatile("s_waitcnt lgkmcnt(8)" ::: "memory"); AT_SBAR(); AT_PV_MM(0, la, ha); AT_SBAR();
    AT_PV_RD(2, la, ha);
    asm volatile("s_waitcnt lgkmcnt(8)" ::: "memory"); AT_SBAR(); AT_PV_MM(1, lb, hb); AT_SBAR();
    AT_PV_RD(3, lb, hb);
    asm volatile("s_waitcnt lgkmcnt(8)" ::: "memory"); AT_SBAR(); AT_PV_MM(2, la, ha); AT_SBAR();
    asm volatile("s_waitcnt lgkmcnt(0)" ::: "memory"); AT_SBAR(); AT_PV_MM(3, lb, hb);
#undef AT_PV_RD
#undef AT_PV_MM
#undef AT_PV_M1
#undef AT_TRRD
}

__device__ __forceinline__ void attn_block(LAS unsigned char* lds, const unsigned char* Q, const unsigned char* K, const unsigned char* V8T, const bf16* proj, bf16* YA, const float* qg, const float* cosT, const float* sinT, int b, int h, int qb) {
    const int tid = otid(), wid = __builtin_amdgcn_readfirstlane(tid >> 6), lane = tid & 63, r32 = lane & 31, hi = lane >> 5;
    const int P0 = qb * 256, NT = 4 * (qb + 1), qlo = P0 + wid * 32;
    LAS unsigned char* V_lds = lds + OFF_V; LAS unsigned char* K_lds = lds + OFF_K;
    LAS float* wsf = (LAS float*)(lds + OFF_WS) + wid * 64; LAS float* li_l = wsf; LAS float* al_l = wsf + 32;
    i32x8 q8[3];
    { const unsigned char* qp = Q + ((size_t)(b * SEQ + qlo + r32) * 8 + h) * 192 + hi * 8;
      v2u raw[12];
#pragma unroll
      for (int d0 = 0; d0 < 12; ++d0) raw[d0] = *(const v2u*)(qp + d0 * 16);
      float ss = 0.f;
#pragma unroll
      for (int d0 = 0; d0 < 12; ++d0)
#pragma unroll
          for (int j = 0; j < 8; ++j) { const float v = f8v(raw[d0], j); ss += v * v; }
      { auto rr = __builtin_amdgcn_permlane32_swap(__float_as_uint(ss), __float_as_uint(ss), false, false); ss = __uint_as_float(rr[0]) + __uint_as_float(rr[1]); }
      const float rn = 1.0f / sqrtf(ss * (1.0f / 192.f) + EPS);
#pragma unroll
      for (int d0 = 0; d0 < 12; ++d0) asm volatile("" : "+v"(raw[d0]));
      const float* ct = cosT + (size_t)(b * SEQ + qlo + r32) * 32 + hi * 8; const float* st = sinT + (size_t)(b * SEQ + qlo + r32) * 32 + hi * 8;
#pragma unroll
      for (int d0 = 0; d0 < 8; ++d0) { const v4f g0 = *(const v4f*)(qg + d0 * 16 + hi * 8), g1 = *(const v4f*)(qg + d0 * 16 + hi * 8 + 4);
          const float g[8] = {g0.x, g0.y, g0.z, g0.w, g1.x, g1.y, g1.z, g1.w}; float x[8];
#pragma unroll
          for (int j = 0; j < 8; ++j) x[j] = f8v(raw[d0], j) * rn * g[j] * 8.0f;
          const v2u w = pk8_fp8(x); q8[d0 >> 2][2 * (d0 & 3)] = (int)w.x; q8[d0 >> 2][2 * (d0 & 3) + 1] = (int)w.y; }
#pragma unroll
      for (int d0 = 8; d0 < 10; ++d0) { const int i0 = (d0 - 8) * 16;
          const v4f ga0 = *(const v4f*)(qg + d0 * 16 + hi * 8), ga1 = *(const v4f*)(qg + d0 * 16 + hi * 8 + 4), gb0 = *(const v4f*)(qg + (d0 + 2) * 16 + hi * 8), gb1 = *(const v4f*)(qg + (d0 + 2) * 16 + hi * 8 + 4);
          const v4f c0 = *(const v4f*)(ct + i0), c1 = *(const v4f*)(ct + i0 + 4), s0 = *(const v4f*)(st + i0), s1 = *(const v4f*)(st + i0 + 4);
          const float ga[8] = {ga0.x, ga0.y, ga0.z, ga0.w, ga1.x, ga1.y, ga1.z, ga1.w}, gb[8] = {gb0.x, gb0.y, gb0.z, gb0.w, gb1.x, gb1.y, gb1.z, gb1.w};
          const float cs[8] = {c0.x, c0.y, c0.z, c0.w, c1.x, c1.y, c1.z, c1.w}, sn[8] = {s0.x, s0.y, s0.z, s0.w, s1.x, s1.y, s1.z, s1.w};
          float y1[8], y2[8];
#pragma unroll
          for (int j = 0; j < 8; ++j) { const float x1 = f8v(raw[d0], j) * rn * ga[j], x2 = f8v(raw[d0 + 2], j) * rn * gb[j];
              y1[j] = (x1 * cs[j] - x2 * sn[j]) * 8.0f; y2[j] = (x2 * cs[j] + x1 * sn[j]) * 8.0f; }
          const v2u w1 = pk8_fp8(y1), w2 = pk8_fp8(y2);
          q8[2][2 * (d0 & 3)] = (int)w1.x; q8[2][2 * (d0 & 3) + 1] = (int)w1.y; q8[2][2 * ((d0 + 2) & 3)] = (int)w2.x; q8[2][2 * ((d0 + 2) & 3) + 1] = (int)w2.y; }
    }
    const int vdv = tid >> 2, vc16 = (tid & 3) * 16;
    const int kr0 = tid / 12, kc0 = tid - 12 * kr0, kr1 = (tid + 512) / 12, kc1 = (tid + 512) - 12 * kr1;
    const bool k2 = tid < 256;
    const unsigned char* Kg = K + ((size_t)(b * SEQ) * 8 + h) * 192;
    const unsigned char* Vg = V8T + ((size_t)(b * 8 + h) * 128 + vdv) * SEQ + vc16;
    bf16x8 sa_k0, sa_k1 = {}, sa_v0, sb_k0, sb_k1 = {}, sb_v0;
#define AT_SLOAD(S, kb_) do { S##_k0 = *(const bf16x8*)(Kg + (size_t)((kb_) + kr0) * 1536 + kc0 * 16); if (k2) S##_k1 = *(const bf16x8*)(Kg + (size_t)((kb_) + kr1) * 1536 + kc1 * 16); \
        S##_v0 = *(const bf16x8*)(Vg + (kb_)); } while (0)
#define AT_SWRITE(S, bf, vbf) do { *(LAS bf16x8*)(K_lds + (bf) * SHM_K8 + kr0 * K8_PITCH + kc0 * 16) = S##_k0; if (k2) *(LAS bf16x8*)(K_lds + (bf) * SHM_K8 + kr1 * K8_PITCH + kc1 * 16) = S##_k1; \
        *(LAS bf16x8*)(V_lds + (vbf) * SHM_V8 + vdv * V8_PITCH + vc16) = S##_v0; } while (0)
    AT_SLOAD(sa, 0); AT_SLOAD(sb, 64); AT_SWRITE(sa, 0, 0);
    __syncthreads();
    float m_reg = -1e30f, l_reg = 0.f; f32x16 o[4] = {};
    const bool late = wid >= 4;
    bool pend = false; int pvb = 0; int vb3 = 0;
    i32x8 pop;
#define AT_STEP(t, SL, SW) do { \
        const int buf = (t) & 1, kb = (t) * 64; \
        if ((t) + 2 < NT) AT_SLOAD(SL, kb + 128);                         \
        if (late && pend) { pv8(o, V_lds + pvb * SHM_V8, r32, hi, pop); pend = false; AT_SBAR(); } \
        if (kb <= qlo + 31) { \
            f32x16 p0, p1; float mn, alpha; \
            qkt8(p0, p1, K_lds + buf * SHM_K8, r32, hi, q8); \
            if (kb + 63 > qlo) mask_tile(p0, p1, qlo + r32 - 4 * hi - kb); \
            partialSM(p0, p1, m_reg, mn, alpha); \
            finishSM8(p0, p1, alpha, l_reg, pop); \
            if (__any(alpha < 1.f)) { _Pragma("unroll") for (int d_ = 0; d_ < 4; ++d_) _Pragma("unroll") for (int r = 0; r < 16; ++r) o[d_][r] *= alpha; } \
            AT_SBAR(); \
            if (late) { pend = true; pvb = vb3; } \
            else pv8(o, V_lds + vb3 * SHM_V8, r32, hi, pop); \
        } \
        const int vn3 = vb3 == 2 ? 0 : vb3 + 1; \
        if ((t) + 1 < NT) AT_SWRITE(SW, buf ^ 1, vn3);                    \
        vb3 = vn3; \
        __syncthreads(); } while (0)
    for (int t = 0; t < NT; t += 2) { AT_STEP(t, sa, sb); AT_STEP(t + 1, sb, sa); }
#undef AT_STEP
    if (late && pend) pv8(o, V_lds + pvb * SHM_V8, r32, hi, pop);
    { const size_t row = (size_t)(b * SEQ + qlo + r32);
      const bf16* zp = proj + row * NPROJ + C_ZA + h * 128 + 8 * hi;
      u32x4 zw[8];
#pragma unroll
      for (int i = 0; i < 8; ++i) zw[i] = *(const u32x4*)(zp + 16 * i);
      const float rl = 2.0f / l_reg;
      unsigned char* yp = (unsigned char*)YA + row * 1024 + h * 128 + 8 * hi;
#pragma unroll
      for (int i = 0; i < 8; ++i) { const int d0 = i >> 1, j = i & 1;
          auto z0 = __builtin_amdgcn_permlane32_swap(zw[i].x, zw[i].z, false, false); auto z1 = __builtin_amdgcn_permlane32_swap(zw[i].y, zw[i].w, false, false);
          const unsigned z4[4] = {z0[0], z1[0], z0[1], z1[1]};
          float y[8];
#pragma unroll
          for (int k = 0; k < 4; ++k) { y[2 * k] = o[d0][8 * j + 2 * k] * rl * silu_f(__uint_as_float(z4[k] << 16)); y[2 * k + 1] = o[d0][8 * j + 2 * k + 1] * rl * silu_f(__uint_as_float(z4[k] & 0xffff0000u)); }
          int q0 = __builtin_amdgcn_cvt_pk_fp8_f32(y[0], y[1], 0, false); q0 = __builtin_amdgcn_cvt_pk_fp8_f32(y[2], y[3], q0, true);
          int q1 = __builtin_amdgcn_cvt_pk_fp8_f32(y[4], y[5], 0, false); q1 = __builtin_amdgcn_cvt_pk_fp8_f32(y[6], y[7], q1, true);
          auto sw = __builtin_amdgcn_permlane32_swap((unsigned)q0, (unsigned)q1, false, false);
          v2u w; w.x = sw[0]; w.y = sw[1]; *(v2u*)(yp + 16 * i) = w; } }
    asm volatile("s_waitcnt lgkmcnt(0)" ::: "memory");
    __syncthreads();
#undef AT_SLOAD
#undef AT_SWRITE
}
}


namespace sg {
using at::bf16x8; using at::f32x16;
__device__ __forceinline__ void sgu_item(LAS unsigned char* lds, const bf16* proj, const float* rv, const float* Ws, const float* bs, const float* vg, bf16* YB, int it) {
    const int tid = otid(), wid = __builtin_amdgcn_readfirstlane(tid >> 6), lane = tid & 63, r32 = lane & 31, hi = lane >> 5;
    {
        const int ch = it >> 2, gp = it & 3, R0 = ch * 128;
        { const int cc = tid & 15;
          v4f g0a = *(const v4f*)(vg + (2 * gp) * 128 + cc * 8), g0b = *(const v4f*)(vg + (2 * gp) * 128 + cc * 8 + 4), g1a = *(const v4f*)(vg + (2 * gp + 1) * 128 + cc * 8), g1b = *(const v4f*)(vg + (2 * gp + 1) * 128 + cc * 8 + 4);
#pragma unroll
          for (int i = 0; i < 8; ++i) {
            const int idx = tid + 512 * i, gsel = i >> 2, row = (idx >> 4) & 127;
            const v4u w = *(const v4u*)(proj + (size_t)(R0 + row) * NPROJ + C_VB + (2 * gp + gsel) * 128 + cc * 8);
            const float s = 1.0f / sqrtf(rv[R0 + row] * (1.0f / 1024.f) + EPS);
            const v4f ga = gsel ? g1a : g0a, gb = gsel ? g1b : g0b;
            v4u o; o.x = pk2(lo16(w.x) * (s * ga.x), hi16(w.x) * (s * ga.y)); o.y = pk2(lo16(w.y) * (s * ga.z), hi16(w.y) * (s * ga.w));
            o.z = pk2(lo16(w.z) * (s * gb.x), hi16(w.z) * (s * gb.y)); o.w = pk2(lo16(w.w) * (s * gb.z), hi16(w.w) * (s * gb.w));
            *(LAS v4u*)(lds + (gsel * 2 + (row >> 6)) * 16384 + at::v_st(row & 63, cc * 8)) = o;
          } }
        __syncthreads();
        const int gsel = wid >> 2, g = 2 * gp + gsel, t = 32 * (wid & 3) + r32;
        const size_t row = (size_t)(R0 + t);
        at::u32x4 uw[8], zw[8];
        { const bf16* up = proj + row * NPROJ + C_UB + g * 128 + 8 * hi; const bf16* zp = proj + row * NPROJ + C_ZB + g * 128 + 8 * hi;
#pragma unroll
          for (int i = 0; i < 8; ++i) { uw[i] = *(const at::u32x4*)(up + 16 * i); zw[i] = *(const at::u32x4*)(zp + 16 * i); } }
        const float bias = bs[g * 128 + t];
        f32x16 o[4] = {};
        const int nst = (wid & 3) >= 2 ? 2 : 1;
        for (int st = 0; st < nst; ++st) {
            bf16x8 pa[4];
#pragma unroll
            for (int ks = 0; ks < 4; ++ks) {
                const int s0 = st * 64 + ks * 16 + hi * 8;
                const float* wp = Ws + ((size_t)g * 128 + t) * 128 + s0;
                const v4f a = *(const v4f*)wp, b = *(const v4f*)(wp + 4);
                float x[8] = {a.x, a.y, a.z, a.w, b.x, b.y, b.z, b.w};
#pragma unroll
                for (int j = 0; j < 8; ++j) if (s0 + j > t) x[j] = 0.f;
                at::u32x4 w4 = {at::cvtpk(x[0], x[1]), at::cvtpk(x[2], x[3]), at::cvtpk(x[4], x[5]), at::cvtpk(x[6], x[7])};
                pa[ks] = *reinterpret_cast<bf16x8*>(&w4);
            }
            const unsigned vbase = (unsigned)(size_t)(lds + (gsel * 2 + st) * 16384) + (unsigned)at::v_rd_base(lane);
            at::pv_tile<true>(o, vbase, pa[0], pa[1], pa[2], pa[3]);
        }
        bf16* yp = YB + row * 1024 + g * 128 + 8 * hi;
#pragma unroll
        for (int i = 0; i < 8; ++i) { const int d0 = i >> 1, j = i & 1;
            auto u0 = __builtin_amdgcn_permlane32_swap(uw[i].x, uw[i].z, false, false); auto u1 = __builtin_amdgcn_permlane32_swap(uw[i].y, uw[i].w, false, false);
            auto z0 = __builtin_amdgcn_permlane32_swap(zw[i].x, zw[i].z, false, false); auto z1 = __builtin_amdgcn_permlane32_swap(zw[i].y, zw[i].w, false, false);
            const unsigned u4[4] = {u0[0], u1[0], u0[1], u1[1]}, z4[4] = {z0[0], z1[0], z0[1], z1[1]};
            unsigned p[4];
#pragma unroll
            for (int k = 0; k < 4; ++k) {
                const float y0 = lo16(u4[k]) * (o[d0][8 * j + 2 * k] + bias) * lo16(z4[k]);
                const float y1 = hi16(u4[k]) * (o[d0][8 * j + 2 * k + 1] + bias) * hi16(z4[k]);
                p[k] = at::cvtpk(y0, y1); }
            auto s0 = __builtin_amdgcn_permlane32_swap(p[0], p[2], false, false); auto s1 = __builtin_amdgcn_permlane32_swap(p[1], p[3], false, false);
            *(at::u32x4*)(yp + 16 * i) = (at::u32x4){s0[0], s1[0], s0[1], s1[1]}; }
        __syncthreads();
    }
}
}


namespace gl {
using at::bf16x8; using at::f32x16; using at::s16x4; using at::u32x4;
constexpr int OFF_VIMG = 0, OFF_KLIMG = 65536, OFF_ATT = 98304, OFF_DS = 131072, OFF_PART = 131584, LDS_NEED = OFF_PART + 4096;

__device__ __forceinline__ void gla_prep_item(LAS unsigned char* lds, int seg_off, const bf16* proj, const float* wa2, const float* ba, bf16* QE, bf16* KE, bf16* KL, float* DS, int ci) {
    const int tid = otid(), k2 = tid & 63, ts = tid >> 6, k = 2 * k2;
    LAS float* seg = (LAS float*)(lds + seg_off);
    {
        const int ch = ci >> 2, h = ci & 3, R0 = ch * 128 + ts * 16;
        float wa0[16], wa1[16];
#pragma unroll
        for (int j = 0; j < 16; ++j) { const v2f w = *(const v2f*)(wa2 + j * 512 + h * 128 + k); wa0[j] = w.x; wa1[j] = w.y; }
        const v2f bak = *(const v2f*)(ba + h * 128 + k);
        float la0[16], la1[16]; float run0 = 0.f, run1 = 0.f;
#pragma unroll
        for (int i = 0; i < 16; ++i) {
            const bf16* pr = proj + (size_t)(R0 + i) * NPROJ + C_AR;
            const v4u w0 = *(const v4u*)pr, w1 = *(const v4u*)(pr + 8);
            const float ar[16] = {lo16(w0.x), hi16(w0.x), lo16(w0.y), hi16(w0.y), lo16(w0.z), hi16(w0.z), lo16(w0.w), hi16(w0.w),
                                  lo16(w1.x), hi16(w1.x), lo16(w1.y), hi16(w1.y), lo16(w1.z), hi16(w1.z), lo16(w1.w), hi16(w1.w)};
            float x0 = bak.x, x1 = bak.y;
#pragma unroll
            for (int j = 0; j < 16; ++j) { x0 += ar[j] * wa0[j]; x1 += ar[j] * wa1[j]; }
            run0 += (fminf(x0, 0.f) - __logf(1.0f + __expf(-fabsf(x0)))) * 0.0625f; la0[i] = run0;
            run1 += (fminf(x1, 0.f) - __logf(1.0f + __expf(-fabsf(x1)))) * 0.0625f; la1[i] = run1;
        }
        *(LAS v2f*)(seg + ts * 128 + k) = (v2f){run0, run1};
        __syncthreads();
        float pre0 = 0.f, pre1 = 0.f, tot0 = 0.f, tot1 = 0.f;
#pragma unroll
        for (int q = 0; q < 8; ++q) { const v2f sg = *(const LAS v2f*)(seg + q * 128 + k); tot0 += sg.x; tot1 += sg.y; if (q < ts) { pre0 += sg.x; pre1 += sg.y; } }
        const float et0 = __expf(tot0), et1 = __expf(tot1);
        unsigned qw[16], kw[16];
#pragma unroll
        for (int i = 0; i < 16; ++i) { const size_t row = (size_t)(R0 + i); qw[i] = *(const unsigned*)(proj + row * NPROJ + C_QC + h * 128 + k); kw[i] = *(const unsigned*)(proj + row * NPROJ + C_KC + h * 128 + k); }
#pragma unroll
        for (int i = 0; i < 16; ++i) {
            const size_t o = (size_t)(R0 + i) * 512 + h * 128 + k;
            const float e0 = __expf(la0[i] + pre0), e1 = __expf(la1[i] + pre1), r0 = __builtin_amdgcn_rcpf(e0), r1 = __builtin_amdgcn_rcpf(e1);
            const float q0 = lo16(qw[i]) * 0.08838834764831845f, q1 = hi16(qw[i]) * 0.08838834764831845f, kk0 = lo16(kw[i]) * r0, kk1 = hi16(kw[i]) * r1;
            *(unsigned*)(QE + o) = pk2(q0 * e0, q1 * e1);
            *(unsigned*)(KE + o) = pk2(kk0, kk1);
            *(unsigned*)(KL + o) = pk2(kk0 * et0, kk1 * et1);
        }
        if (ts == 0) *(v2f*)(DS + ((size_t)ch * 4 + h) * 128 + k) = (v2f){et0, et1};
        __syncthreads();
    }
}

#define GL_PK4(P, B_, OUT) do { unsigned a0 = at::cvtpk(P[B_+0], P[B_+1]), a1 = at::cvtpk(P[B_+2], P[B_+3]);                          \
        unsigned b0 = at::cvtpk(P[B_+4], P[B_+5]), b1 = at::cvtpk(P[B_+6], P[B_+7]);                                             \
        auto r0 = __builtin_amdgcn_permlane32_swap(a0, b0, false, false); auto r1 = __builtin_amdgcn_permlane32_swap(a1, b1, false, false); \
        u32x4 w = {r0[0], r1[0], r0[1], r1[1]}; OUT = *reinterpret_cast<bf16x8*>(&w); } while (0)
#define GL_TRRD(dst, addr, off) asm volatile("ds_read_b64_tr_b16 %0, %1 offset:%2" : "=&v"(dst) : "v"(addr), "i"(off) : "memory")

template <int TT> __device__ __forceinline__ void o_intra_tile(LAS unsigned char* lds, const bf16x8 (&vfr)[8], bf16* oi, int r32, int hi) {
    f32x16 acc = {};
    const int t = 32 * TT + r32;
    bf16x8 af[2 * TT + 2];
#pragma unroll
    for (int ks8 = 0; ks8 < 2 * TT + 2; ++ks8) af[ks8] = *(const LAS bf16x8*)(lds + OFF_ATT + t * 256 + (((16 * ks8 + 8 * hi) * 2) ^ ((t & 7) << 4)));
#pragma unroll
    for (int ks8 = 0; ks8 < 2 * TT + 2; ++ks8) acc = __builtin_amdgcn_mfma_f32_32x32x16_bf16(vfr[ks8], af[ks8], acc, 0, 0, 0);
    __builtin_amdgcn_sched_group_barrier(0x100, 2 * TT + 2, 0); __builtin_amdgcn_sched_group_barrier(0x008, 2 * TT + 2, 0);
    asm volatile("s_nop 15\n\ts_nop 15" : "+v"(acc));
#pragma unroll
    for (int hf = 0; hf < 2; ++hf) *(u32x4*)(oi + (size_t)(TT * 2 + hf) * 512) = (u32x4){at::cvtpk(acc[8 * hf], acc[8 * hf + 1]), at::cvtpk(acc[8 * hf + 2], acc[8 * hf + 3]), at::cvtpk(acc[8 * hf + 4], acc[8 * hf + 5]), at::cvtpk(acc[8 * hf + 6], acc[8 * hf + 7])};
}
__device__ __forceinline__ void gla_chunk_item(LAS unsigned char* lds, const bf16* proj, const bf16* QE, const bf16* KE, const bf16* KL, bf16* OI, bf16* DL, int ci) {
    const int tid = otid(), wid = __builtin_amdgcn_readfirstlane(tid >> 6), lane = tid & 63, r32 = lane & 31, hi = lane >> 5;
    const int h = ci & 3, R0 = (ci >> 2) * 128;
    {
        {
#pragma unroll
            for (int i = 0; i < 8; ++i) { const int idx = tid + 512 * i, s = idx >> 5, cc = idx & 31;
                const v4u w = *(const v4u*)(proj + (size_t)(R0 + s) * NPROJ + C_VC + h * 256 + cc * 8);
                *(LAS v4u*)(lds + OFF_VIMG + ((s >> 6) * 2 + (cc >> 4)) * 16384 + at::v_st(s & 63, (cc & 15) * 8)) = w; }
#pragma unroll
            for (int i = 0; i < 4; ++i) { const int idx = tid + 512 * i, s = idx >> 4, cc = idx & 15;
                const v4u w = *(const v4u*)(KL + (size_t)(R0 + s) * 512 + h * 128 + cc * 8);
                *(LAS v4u*)(lds + OFF_KLIMG + (s >> 6) * 16384 + at::v_st(s & 63, cc * 8)) = w; }
#pragma unroll
            for (int j = 0; j < 2; ++j) {
                const int ti = 2 * wid + j, st = ti >> 2, tt = ti & 3;
                if (st <= tt) {
                    f32x16 p = {};
                    const bf16* ap = KE + (size_t)(R0 + 32 * st + r32) * 512 + h * 128 + hi * 8;
                    const bf16* bp = QE + (size_t)(R0 + 32 * tt + r32) * 512 + h * 128 + hi * 8;
                    bf16x8 fa[8], fb[8];
#pragma unroll
                    for (int ks = 0; ks < 8; ++ks) { fa[ks] = *(const bf16x8*)(ap + ks * 16); fb[ks] = *(const bf16x8*)(bp + ks * 16); }
#pragma unroll
                    for (int ks = 0; ks < 8; ++ks) p = __builtin_amdgcn_mfma_f32_32x32x16_bf16(fa[ks], fb[ks], p, 0, 0, 0);
                    __builtin_amdgcn_sched_group_barrier(0x020, 16, 0); __builtin_amdgcn_sched_group_barrier(0x008, 8, 0);
                    asm volatile("s_nop 15\n\ts_nop 15" : "+v"(p));
                    if (st == tt) {
#pragma unroll
                        for (int r = 0; r < 16; ++r) if (at::crow(r, hi) > r32) p[r] = 0.f; }
                    const int t = 32 * tt + r32;
#pragma unroll
                    for (int g = 0; g < 4; ++g) { v2u w; w.x = at::cvtpk(p[4 * g], p[4 * g + 1]); w.y = at::cvtpk(p[4 * g + 2], p[4 * g + 3]);
                        *(LAS v2u*)(lds + OFF_ATT + t * 256 + ((64 * st + 16 * g) ^ ((t & 7) << 4)) + 8 * hi) = w; }
                }
            }
            __syncthreads();
            bf16x8 vfr[8];
            { const unsigned vaddr = (unsigned)(size_t)(lds + OFF_VIMG + (wid >> 2) * 16384) + (unsigned)at::v_rd_base(lane) + (unsigned)((wid & 3) * 512);
              s16x4 vl[8], vh[8];
#define GL_VF(ks8) do { constexpr int o_ = ((ks8) >> 2) * 32768 + ((ks8) & 3) * 4096; GL_TRRD(vl[ks8], vaddr, o_); GL_TRRD(vh[ks8], vaddr, o_ + 2048); } while (0)
              GL_VF(0); GL_VF(1); GL_VF(2); GL_VF(3); GL_VF(4); GL_VF(5); GL_VF(6); GL_VF(7);
#undef GL_VF
              asm volatile("s_waitcnt lgkmcnt(0)" ::: "memory"); AT_SBAR();
#pragma unroll
              for (int q = 0; q < 8; ++q) vfr[q] = (bf16x8){vl[q][0], vl[q][1], vl[q][2], vl[q][3], vh[q][0], vh[q][1], vh[q][2], vh[q][3]};
              AT_SBAR(); }
            bf16* oi = OI + (((size_t)ci * 8 + wid) * 8 * 64 + lane) * 8;
            bf16* dl = DL + (((size_t)ci * 8 + wid) * 8 * 64 + lane) * 8;
            o_intra_tile<0>(lds, vfr, oi, r32, hi); o_intra_tile<1>(lds, vfr, oi, r32, hi); o_intra_tile<2>(lds, vfr, oi, r32, hi); o_intra_tile<3>(lds, vfr, oi, r32, hi);
#pragma unroll
            for (int kt = 0; kt < 4; ++kt) {
                f32x16 D = {};
                const unsigned kaddr = (unsigned)(size_t)(lds + OFF_KLIMG) + (unsigned)at::v_rd_base(lane) + (unsigned)(kt * 512);
                s16x4 kl_[8], kh_[8];
#define GL_KR(ks8) do { constexpr int o_ = ((ks8) >> 2) * 16384 + ((ks8) & 3) * 4096; GL_TRRD(kl_[ks8], kaddr, o_); GL_TRRD(kh_[ks8], kaddr, o_ + 2048); } while (0)
                GL_KR(0); GL_KR(1); GL_KR(2); GL_KR(3); GL_KR(4); GL_KR(5); GL_KR(6); GL_KR(7);
#undef GL_KR
                asm volatile("s_waitcnt lgkmcnt(0)" ::: "memory"); AT_SBAR();
#pragma unroll
                for (int ks8 = 0; ks8 < 8; ++ks8)
                    D = __builtin_amdgcn_mfma_f32_32x32x16_bf16((bf16x8){kl_[ks8][0], kl_[ks8][1], kl_[ks8][2], kl_[ks8][3], kh_[ks8][0], kh_[ks8][1], kh_[ks8][2], kh_[ks8][3]}, vfr[ks8], D, 0, 0, 0);
                AT_SBAR();
                asm volatile("s_nop 15\n\ts_nop 15" : "+v"(D));
#pragma unroll
                for (int hf = 0; hf < 2; ++hf) *(u32x4*)(dl + (size_t)(kt * 2 + hf) * 512) = (u32x4){at::cvtpk(D[8 * hf], D[8 * hf + 1]), at::cvtpk(D[8 * hf + 2], D[8 * hf + 3]), at::cvtpk(D[8 * hf + 4], D[8 * hf + 5]), at::cvtpk(D[8 * hf + 6], D[8 * hf + 7])};
            }
            __syncthreads();
        }
    }
}

__device__ __forceinline__ void gla_stageA_item(const float* DS, const bf16* DL, bf16* XB, int b, int h, int vp) {
    const int tid = otid(), wid = __builtin_amdgcn_readfirstlane(tid >> 6), lane = tid & 63, hi = lane >> 5;
    const int vb = 2 * vp + (wid >> 2), kt = wid & 3;
    constexpr int PF = 4, NC = SEQ / 128;
    f32x16 X = {};
    u32x4 dq[PF][2]; v4f sq[PF][4];
    const size_t ci0 = (size_t)(b * 32) * 4 + h;
#define GL_ALOAD(slot, c_) do { const size_t ci_ = ci0 + (size_t)(c_) * 4; const bf16* dl_ = DL + ((ci_ * 8 + vb) * 8 * 64 + lane) * 8 + (size_t)(kt * 2) * 512; const float* ds_ = DS + ci_ * 128 + 32 * kt + 4 * hi; \
        dq[slot][0] = *(const u32x4*)dl_; dq[slot][1] = *(const u32x4*)(dl_ + 512); \
        _Pragma("unroll") for (int r4 = 0; r4 < 4; ++r4) sq[slot][r4] = *(const v4f*)(ds_ + 8 * r4); } while (0)
#pragma unroll
    for (int s = 0; s < PF; ++s) GL_ALOAD(s, s);
    for (int c0 = 0; c0 < NC; c0 += PF) {
#pragma unroll
        for (int s = 0; s < PF; ++s) {
            const int c = c0 + s; const size_t ci = ci0 + (size_t)c * 4;
            bf16* xo = XB + (((ci * 8 + vb) * 8 + kt * 2) * 64 + lane) * 8;
            bf16x8 xb0, xb1; GL_PK4(X, 0, xb0); GL_PK4(X, 8, xb1);
            *(bf16x8*)xo = xb0; *(bf16x8*)(xo + 512) = xb1;
#pragma unroll
            for (int r4 = 0; r4 < 4; ++r4) { const v4f d4 = sq[s][r4]; const u32x4 q4 = dq[s][r4 >> 1]; const unsigned wa = (r4 & 1) ? q4.z : q4.x, wb = (r4 & 1) ? q4.w : q4.y;
                X[4 * r4] = X[4 * r4] * d4.x + lo16(wa); X[4 * r4 + 1] = X[4 * r4 + 1] * d4.y + hi16(wa); X[4 * r4 + 2] = X[4 * r4 + 2] * d4.z + lo16(wb); X[4 * r4 + 3] = X[4 * r4 + 3] * d4.w + hi16(wb); }
            if (c + PF < NC) GL_ALOAD(s, c + PF);
        }
    }
#undef GL_ALOAD
}
__device__ __forceinline__ void gla_stageB_item(const bf16* proj, const bf16* QE, const bf16* OI, const bf16* XB, const float* og, bf16* YC, int b, int h, int cp) {
    (void)og;
    const int tid = otid(), wid = __builtin_amdgcn_readfirstlane(tid >> 6), lane = tid & 63, r32 = lane & 31, hi = lane >> 5;
    {
        const int c = 2 * cp + (wid >> 2), tt = wid & 3, R0 = b * SEQ + c * 128;
        const size_t ci = (size_t)(b * 32 + c) * 4 + h;
        f32x16 acc[8];
#pragma unroll
        for (int vb = 0; vb < 8; ++vb) { const bf16* oi = OI + ((ci * 8 + vb) * 8 * 64 + lane) * 8 + (size_t)(tt * 2) * 512;
#pragma unroll
            for (int hf = 0; hf < 2; ++hf) { const u32x4 w = *(const u32x4*)(oi + (size_t)hf * 512);
                acc[vb][8 * hf] = lo16(w.x); acc[vb][8 * hf + 1] = hi16(w.x); acc[vb][8 * hf + 2] = lo16(w.y); acc[vb][8 * hf + 3] = hi16(w.y);
                acc[vb][8 * hf + 4] = lo16(w.z); acc[vb][8 * hf + 5] = hi16(w.z); acc[vb][8 * hf + 6] = lo16(w.w); acc[vb][8 * hf + 7] = hi16(w.w); } }
        bf16x8 qa[8];
        { const bf16* qp = QE + (size_t)(R0 + 32 * tt + r32) * 512 + h * 128 + hi * 8;
#pragma unroll
          for (int ks = 0; ks < 8; ++ks) qa[ks] = *(const bf16x8*)(qp + ks * 16); }
        if (c > 0) {
            const bf16* xi = XB + (((ci * 8) * 8) * 64 + lane) * 8;
            bf16x8 xf[64];
#pragma unroll
            for (int i = 0; i < 64; ++i) xf[i] = *(const bf16x8*)(xi + (size_t)i * 512);
#pragma unroll
            for (int i = 0; i < 64; ++i) acc[i >> 3] = __builtin_amdgcn_mfma_f32_32x32x16_bf16(xf[i], qa[i & 7], acc[i >> 3], 0, 0, 0);
            __builtin_amdgcn_sched_group_barrier(0x020, 16, 0);
#pragma unroll
            for (int i = 0; i < 48; ++i) { __builtin_amdgcn_sched_group_barrier(0x008, 1, 0); __builtin_amdgcn_sched_group_barrier(0x020, 1, 0); }
            __builtin_amdgcn_sched_group_barrier(0x008, 16, 0);
        }
        const size_t row = (size_t)(R0 + 32 * tt + r32);
        at::u32x4 zw[16];
        { const bf16* zp = proj + row * NPROJ + C_ZC + h * 256 + 8 * hi;
#pragma unroll
          for (int i = 0; i < 16; ++i) zw[i] = *(const at::u32x4*)(zp + 16 * i); }
        float s = 0.f;
#pragma unroll
        for (int vb = 0; vb < 8; ++vb)
#pragma unroll
            for (int r = 0; r < 16; ++r) s += acc[vb][r] * acc[vb][r];
        s += lane_xor32(s, lane);
        const float rn = 1.0f / sqrtf(s * (1.0f / 256.f) + EPS);
        bf16* yp = YC + row * 1024 + h * 256 + 8 * hi;
#pragma unroll
        for (int i = 0; i < 16; ++i) { const int vb = i >> 1, j = i & 1;
            auto z0 = __builtin_amdgcn_permlane32_swap(zw[i].x, zw[i].z, false, false); auto z1 = __builtin_amdgcn_permlane32_swap(zw[i].y, zw[i].w, false, false);
            const unsigned z4[4] = {z0[0], z1[0], z0[1], z1[1]};
            unsigned p[4];
#pragma unroll
            for (int k = 0; k < 4; ++k) p[k] = at::cvtpk(acc[vb][8 * j + 2 * k] * rn * lo16(z4[k]), acc[vb][8 * j + 2 * k + 1] * rn * hi16(z4[k]));
            auto s0 = __builtin_amdgcn_permlane32_swap(p[0], p[2], false, false); auto s1 = __builtin_amdgcn_permlane32_swap(p[1], p[3], false, false);
            *(at::u32x4*)(yp + 16 * i) = (at::u32x4){s0[0], s1[0], s0[1], s1[1]}; }
    }
}
#undef GL_PK4
#undef GL_TRRD
}


constexpr int CW_Q = 65536;
__device__ __forceinline__ int q_pop(unsigned* ctr, LAS unsigned* slot) {
    if (otid() == 0) *slot = __hip_atomic_fetch_add(ctr, 1u, __ATOMIC_RELAXED, __HIP_MEMORY_SCOPE_AGENT);
    __syncthreads(); const int v = (int)*slot; __syncthreads(); return v; }
__device__ __forceinline__ void ph_mixers(LAS unsigned char* lds, unsigned char* ws, unsigned* qctr, const float* Ws, const float* bs, const float* vg, const float* og, const float* qg, int row0, int vb, const float* xnext, const float* gnext) {
    constexpr int NGLA = NBP * 8, NATT = 16 * NBP, NSGU = 16 * NBP, NNORM = MP / 64 / 8; const int NQ = NGLA + NATT + NSGU + (xnext ? NNORM : 0);
    static_assert(NBP % 2 == 0, "NBP even");
    LAS unsigned* slot = (LAS unsigned*)(lds + LDSCTL_OFF + 64);
    bf16* proj = (bf16*)(ws + WS_PROJ);
    unsigned live = 0xffu;
    for (int dq = 0; dq < 8; ++dq) {
        const int q = (vb + dq) & 7;
        if (dq == 1) {
            if (otid() < 64) { const int t_ = otid() & 7; const unsigned c_ = __hip_atomic_load(qctr + t_ * 64, __ATOMIC_RELAXED, __HIP_MEMORY_SCOPE_AGENT);
                const unsigned long long b_ = __builtin_amdgcn_ballot_w64(c_ < (unsigned)NQ); if (otid() == 0) *slot = (unsigned)(b_ & 0xffull); }
            __syncthreads(); live = (unsigned)__builtin_amdgcn_readfirstlane((int)*slot); __syncthreads(); }
        if (!((live >> q) & 1u)) continue;
        for (;;) {
            const int idx = q_pop(qctr + q * 64, slot);
            if (idx >= NQ) break;
            if (idx >= NATT && idx < NATT + NGLA) { const int gi = q * NGLA + (idx - NATT), bh = gi >> 4, cp = gi & 15;
                gl::gla_stageB_item(proj, (const bf16*)(ws + WS_QE), (const bf16*)(ws + WS_OC), (const bf16*)(ws + WS_XB), og, (bf16*)(ws + WS_YC), bh >> 2, bh & 3, cp); }
            else if (idx < NATT) { const int j = idx, qb = 15 - j / NBP, bh = q * NBP + j % NBP;
                at::attn_block(lds, (const unsigned char*)(ws + WS_Q), (const unsigned char*)(ws + WS_K), (const unsigned char*)(ws + WS_K) + (size_t)MP * 1536, proj, (bf16*)(ws + WS_YA), qg, (const float*)(ws + WS_COS) + (size_t)row0 * 32, (const float*)(ws + WS_SIN) + (size_t)row0 * 32, bh >> 3, bh & 7, qb); }
            else if (idx < NATT + NGLA + NSGU) { const int it = q * NSGU + (idx - NGLA - NATT);
                sg::sgu_item(lds, proj, (const float*)(ws + WS_SSQ) + 2 * MP, Ws, bs, vg, (bf16*)(ws + WS_YB), it); }
            else { const size_t ro = (size_t)(q * NNORM + (idx - NATT - NGLA - NSGU)) * 64 * DM;
                ph_norm(xnext + ro, gnext, (bf16*)(ws + WS_HN) + ro, ws + WS_H8 + ro, 64, 0, 1); }
        }
    }
}
#ifndef GEMM_SP2
#define GEMM_SP2 true
#endif
#ifndef GEMM_ALIGN
#define GEMM_ALIGN true
#endif
typedef const __attribute__((address_space(4))) Args* KArgP;
#define KARG() ({ KArgP p_ = (KArgP)__builtin_amdgcn_kernarg_segment_ptr(); asm volatile("" : "+s"(p_)); p_; })
#define INF(i) ((const float*)ap->in[i])
__device__ __forceinline__ void grid_bar(const XcdBarrier& b0) { XcdBarrier b = b0; asm volatile("" : "+s"(b.bar)); xcd_barrier(b); }

__global__ void __launch_bounds__(512, 2) fwd(Args a) {
    extern __shared__ __attribute__((aligned(16))) unsigned char lds_raw[];
    LAS unsigned char* lds = (LAS unsigned char*)lds_raw;
    const int lo = a.lo, hi = a.hi;
    XcdBarrier bar; bar.bar = (unsigned*)(a.ws + WS_CTL) + CW_BAR; bar.x = 0; bar.st = nullptr;
    if (hi - lo > 1) {
        if (threadIdx.x < 4) ((LAS unsigned*)(lds + LDSCTL_OFF))[threadIdx.x] = 0u;
        __syncthreads();
        bar = xcd_barrier_post((unsigned*)(a.ws + WS_CTL) + CW_BAR, (volatile LAS unsigned*)(lds + LDSCTL_OFF));
    }
    int step = 0;
#define PH_BEGIN if (step >= lo && step < hi) { const KArgP ap = KARG(); unsigned char* const ws = ap->ws; const int vb = obid(), nvb = gridDim.x; (void)ws; (void)vb; (void)nvb;
#define PH_END   if (step + 1 < hi) grid_bar(bar); } ++step;
#define WL(l) (ws + WS_W + (size_t)(l) * SZ_WLAYER)
#define B_(T, off) ((T*)(ws + (off)))

    for (int l = 0; l < DEPTH; ++l) {
        for (int p = 0; p < NPASS; ++p) {
            const int row0 = p * MP;
#define XIN ((l == 0 ? (const float*)ap->in[0] : (const float*)ap->out) + (size_t)row0 * DM)
#define WLP (ws + WS_W)
            if (p != 0) { ++step; } else {
            PH_BEGIN if (p == 0) {
            { unsigned char* wl = ws + WS_W;
              convert_T<1>(INF(3) + (size_t)l * DM * IN_COLS, DM, IN_COLS, (bf16*)wl, NBF, (LAS float*)lds, vb, nvb);
              convert_T8<2>(INF(3) + (size_t)l * DM * IN_COLS, DM, IN_COLS, wl + SZ_WINB, NF8, 64.0f, (LAS float*)lds, (vb + 96) % nvb, nvb);
              convert_T8<0>(INF(6) + (size_t)l * 512 * 1536, 512, 1536, wl + SZ_WIN, 1536, 64.0f, (LAS float*)lds, (vb + 64) % nvb, nvb, INF(4) + l * 512);
              convert_T8<0>(INF(7) + (size_t)l * 512 * 2048, 512, 2048, wl + SZ_WIN + SZ_WUQ, 2048, 64.0f, (LAS float*)lds, (vb + 128) % nvb, nvb, INF(5) + l * 512);
              convert_T8<0>(INF(16) + ((size_t)l * 3) * 1024 * 2048, 1024, 2048, wl + SZ_WIN + SZ_WUQ + SZ_WUKV, 2048, 32.0f, (LAS float*)lds, vb, nvb);
              for (int b = 1; b < 3; ++b)
                  convert_T<0>(INF(16) + ((size_t)l * 3 + b) * 1024 * 2048, 1024, 2048, (bf16*)(wl + SZ_WIN + SZ_WUQ + SZ_WUKV) + (size_t)b * 2048 * 1024, 2048, (LAS float*)lds, (vb + 32 * b) % nvb, nvb, b == 2 ? INF(15) + l * 256 : nullptr, 255);
              convert_T<0>(INF(17) + (size_t)l * 2048 * 2048, 2048, 2048, (bf16*)(wl + SZ_WIN + SZ_WUQ + SZ_WUKV + SZ_WB), 2048, (LAS float*)lds, (vb + 192) % nvb, nvb); }
            if (l == 0) { const int* positions = (const int*)ap->in[1]; float* cosT = B_(float, WS_COS); float* sinT = B_(float, WS_SIN);
              for (int idx = vb * 512 + otid(); idx < MTOK * 32; idx += nvb * 512) {
                const int t = idx >> 5, i = idx & 31;
                const float inv = 1.0f / powf(10000.0f, (float)(2 * i) * (1.0f / 64.0f));
                const float ang = (float)positions[t] * inv;
                float sn, cs; sincosf(ang, &sn, &cs);
                cosT[idx] = cs; sinT[idx] = sn; } }
            }
                     if (l == 0 && p == 0) { ph_norm(XIN, INF(2) + l * DM, B_(bf16, WS_HN), B_(unsigned char, WS_H8), MP, vb, nvb);
                       float* ssq = B_(float, WS_SSQ); for (int i = vb * 512 + otid(); i < 3 * MP; i += nvb * 512) ssq[i] = 0.f; } PH_END }
            PH_BEGIN { { pg8::Gemm g{B_(bf16, WS_HN), (const bf16*)WLP, MP, NBF, DM}; pg8::StaticOrder S; S.init(MP, NBF, nvb, vb); pg8::EpiProj E{B_(bf16, WS_PROJ), NPROJ, B_(float, WS_SSQ), MP, 0, B_(unsigned char, WS_YC)};
                         pg8::gemm_phase<pg8::EpiProj, pg8::StaticOrder, false, GEMM_ALIGN, GEMM_SP2>(lds, g, S, E, nullptr); }
                       { pg8::Gemm g{(const bf16*)B_(unsigned char, WS_H8), (const bf16*)(WLP + SZ_WINB), MP, NF8, DM / 2}; pg8::StaticOrder S; S.init(MP, NF8, nvb, vb);
                         { const int ub = (MP / 256) * (NBF / 256), u8 = (MP / 256) * (NF8 / 256), sk = ub % nvb;
                           if (sk > 0 && sk < nvb) { S.skip = sk; S.full = (u8 - 2 * (nvb - sk)) / nvb; if (S.full < 0) S.full = 0; } }
                         pg8::EpiProj E{B_(bf16, WS_PROJ) + NBF, NPROJ, B_(float, WS_SSQ), MP, NBF / 256, B_(unsigned char, WS_YC)};
                         pg8::gemm_phase<pg8::EpiProj, pg8::StaticOrder, false, GEMM_ALIGN, GEMM_SP2, true>(lds, g, S, E, nullptr); } } PH_END
            PH_BEGIN { { pg8::Gemm g{(const bf16*)B_(unsigned char, WS_YC), (const bf16*)(WLP + SZ_WIN), MP, 1536, 256, 0, 0x79797979, 0x7b7b7b7b};   pg8::StaticOrder S; S.init(MP, 1536, nvb, vb); pg8::EpiF8Row E{B_(unsigned char, WS_Q), 1536, B_(float, WS_SSQ), 1.0f / 512.f, EPS};
                         pg8::gemm_phase<pg8::EpiF8Row, pg8::StaticOrder, false, GEMM_ALIGN, GEMM_SP2, true>(lds, g, S, E, nullptr); }
                       { pg8::Gemm g{(const bf16*)(B_(unsigned char, WS_YC) + (size_t)MP * 512), (const bf16*)(WLP + SZ_WIN + SZ_WUQ), MP, 2048, 256, 0, 0x79797979, 0x7b7b7b7b}; pg8::StaticOrder S; S.init(MP, 2048, nvb, nvb - 1 - vb); pg8::EpiF8Row E{B_(unsigned char, WS_KV), 2048, B_(float, WS_SSQ) + MP, 1.0f / 512.f, EPS};
                         pg8::gemm_phase<pg8::EpiF8Row, pg8::StaticOrder, false, GEMM_ALIGN, GEMM_SP2, true>(lds, g, S, E, nullptr); }
                       for (int ci = vb; ci < (MP / 128) * 4; ci += nvb) {
                           gl::gla_prep_item(lds, 135168, B_(bf16, WS_PROJ), INF(13) + l * 16 * 512, INF(14) + l * 512, B_(bf16, WS_QE), B_(bf16, WS_KE), B_(bf16, WS_KL), B_(float, WS_DS), ci);
                           gl::gla_chunk_item(lds, B_(bf16, WS_PROJ), B_(bf16, WS_QE), B_(bf16, WS_KE), B_(bf16, WS_KL), B_(bf16, WS_OC), B_(bf16, WS_DL), ci); } } PH_END
            PH_BEGIN { constexpr int NA = NBP * 16;
                       if (nvb > 2 * NA) { if (vb < NA) gl::gla_stageA_item(B_(float, WS_DS), B_(bf16, WS_DL), B_(bf16, WS_XB), vb >> 4, (vb >> 2) & 3, vb & 3);
                                           else { ph_kfin(B_(unsigned char, WS_KV), B_(bf16, WS_PROJ), B_(unsigned char, WS_K), INF(9) + l * 192, B_(float, WS_COS), B_(float, WS_SIN), row0, vb - NA, nvb - NA); ph_vt8(B_(unsigned char, WS_KV), B_(unsigned char, WS_K) + (size_t)MP * 1536, vb - NA, nvb - NA); } }
                       else { for (int it = vb; it < NA; it += nvb) gl::gla_stageA_item(B_(float, WS_DS), B_(bf16, WS_DL), B_(bf16, WS_XB), it >> 4, (it >> 2) & 3, it & 3);
                              ph_kfin(B_(unsigned char, WS_KV), B_(bf16, WS_PROJ), B_(unsigned char, WS_K), INF(9) + l * 192, B_(float, WS_COS), B_(float, WS_SIN), row0, vb, nvb); ph_vt8(B_(unsigned char, WS_KV), B_(unsigned char, WS_K) + (size_t)MP * 1536, vb, nvb); } } PH_END
            PH_BEGIN ph_mixers(lds, ws, (unsigned*)(ws + WS_CTL) + CW_Q + (l * NPASS + p) * 8 * 64, INF(11) + (size_t)l * 8 * 128 * 128, INF(12) + l * 8 * 128, INF(10) + l * 1024, INF(15) + l * 256, INF(8) + l * 192, row0, vb,
                                (p + 1 < NPASS) ? XIN + (size_t)MP * DM : ((l + 1 < DEPTH) ? (const float*)ap->out : (const float*)nullptr), INF(2) + ((p + 1 < NPASS) ? l : l + 1) * DM); PH_END
            PH_BEGIN { { pg8::Gemm g{B_(bf16, WS_YA), (const bf16*)(WLP + SZ_WIN + SZ_WUQ + SZ_WUKV), MP, 2048, 512, 0, 0x7a7a7a7a, 0x7b7b7b7b};
                         pg8::StaticOrder S; S.init(MP, 2048, nvb, vb);
                         pg8::EpiMerge E{(const unsigned char*)(B_(bf16, WS_PROJ) + C_GATE), NPROJ * 2, B_(bf16, WS_MG), 2048, 2048, 0}; pg8::gemm_phase<pg8::EpiMerge, pg8::StaticOrder, false, GEMM_ALIGN, GEMM_SP2, true>(lds, g, S, E, nullptr); }
                       { pg8::Gemm g{B_(bf16, WS_YB), (const bf16*)(WLP + SZ_WIN + SZ_WUQ + SZ_WUKV) + (size_t)2048 * 1024, MP, 2048, 1024};
                         pg8::BranchOrder S; S.init(MP, 2048, nvb, vb); S.NB = 2; S.a_stride = (size_t)MP * 1024 * 2; S.b_stride = (size_t)2048 * 1024 * 2;
                         pg8::EpiMerge E{(const unsigned char*)(B_(bf16, WS_PROJ) + C_GATE), NPROJ * 2, B_(bf16, WS_MG), 2048, 2048, 1, 1}; pg8::gemm_phase<pg8::EpiMerge, pg8::BranchOrder, false, GEMM_ALIGN, GEMM_SP2>(lds, g, S, E, nullptr); } } PH_END
            PH_BEGIN { pg8::Gemm g{B_(bf16, WS_MG), (const bf16*)(WLP + SZ_WIN + SZ_WUQ + SZ_WUKV + SZ_WB), MP, 2048, 2048}; pg8::StaticOrder S; S.init(MP, 2048, nvb, vb); pg8::EpiRes E{XIN, ap->out + (size_t)row0 * DM, 2048};
                       pg8::gemm_phase<pg8::EpiRes, pg8::StaticOrder, false, GEMM_ALIGN, GEMM_SP2>(lds, g, S, E, nullptr);
                       float* ssq = B_(float, WS_SSQ); for (int i = vb * 512 + otid(); i < 3 * MP; i += nvb * 512) ssq[i] = 0.f; } PH_END
        }
    }
#undef PH_BEGIN
#undef PH_END
}

#ifndef ONE_LAUNCH
#define ONE_LAUNCH 1
#endif
extern "C" void kernel_launch(void* const* d_in, const int* in_sizes, int n_in, void* d_out, int out_size, void* d_ws, size_t ws_size, hipStream_t stream) {
    static int grid = 0;
    if (grid == 0) {
        if (n_in != 18 || out_size != MTOK * DM || ws_size < WS_END) { fprintf(stderr, "kernel_launch: unexpected shapes (n_in %d out %d ws %zu need %zu)\n", n_in, out_size, ws_size, (size_t)WS_END); grid = -1; return; }
        int dev = 0, cus = 0, per_cu = 0;
        if (hipGetDevice(&dev) != hipSuccess || hipDeviceGetAttribute(&cus, hipDeviceAttributeMultiprocessorCount, dev) != hipSuccess) { grid = -1; return; }
        if (hipFuncSetAttribute((const void*)fwd, hipFuncAttributeMaxDynamicSharedMemorySize, LDS_BYTES) != hipSuccess) { fprintf(stderr, "kernel_launch: hipFuncSetAttribute failed\n"); grid = -1; return; }
        if (hipOccupancyMaxActiveBlocksPerMultiprocessor(&per_cu, (const void*)fwd, 512, LDS_BYTES) != hipSuccess || per_cu < 1) { fprintf(stderr, "kernel_launch: occupancy query says %d\n", per_cu); }
        (void)hipGetLastError();
        grid = cus;
    }
    if (grid < 0) return;
    (void)hipMemsetAsync((char*)d_ws + WS_CTL, 0, CTL_BYTES, stream);
    Args a{};
    for (int i = 0; i < 18; ++i) a.in[i] = d_in[i];
    a.out = (float*)d_out; a.ws = (unsigned char*)d_ws; a.pad0 = 0; a.pad1 = 0;
#if ONE_LAUNCH
    a.lo = 0; a.hi = NSTEPS;
    hipLaunchKernelGGL(fwd, dim3(grid), dim3(512), LDS_BYTES, stream, a);
#else
    for (int s = 0; s < NSTEPS; ++s) { a.lo = s; a.hi = s + 1; hipLaunchKernelGGL(fwd, dim3(grid), dim3(512), LDS_BYTES, stream, a); }
#endif
}
```

```cpp
#include <hip/hip_runtime.h>
#include <cstdio>
#include <cstdint>
__device__ __forceinline__ int otid() { int t = threadIdx.x; asm volatile("" : "+v"(t)); return t; }
__device__ __forceinline__ int obid() { int t = blockIdx.x; asm volatile("" : "+s"(t)); return t; }
namespace pg8 {
#define PG8_LAS __attribute__((address_space(3)))
typedef unsigned short bf16_t;
typedef short bf16x8 __attribute__((ext_vector_type(8)));
typedef float f32x4 __attribute__((ext_vector_type(4)));
typedef unsigned u32x4 __attribute__((ext_vector_type(4)));
constexpr int BM = 256, BK = 64, HALF = 128, HTB = HALF * BK * 2  , STAGE_BYTES = 8 * HTB, NXCD = 8, WGM = 4;

__host__ __device__ __forceinline__ int lds_byte(int r, int c) { const int st = (r >> 4) * 2 + (c >> 5), rr = r & 15, cc = c & 31, ob = rr * 64 + cc * 2; return st * 1024 + (ob ^ (((ob >> 9) & 1) << 5)); }
__host__ __device__ __forceinline__ void stage_rc(int b, int& R, int& C) { const int st = b / 1024, sb = b % 1024, swz = sb ^ (((sb >> 9) & 1) << 5); R = (st >> 1) * 16 + swz / 64; C = (st & 1) * 32 + (swz % 64) / 2; }
__host__ __device__ __forceinline__ int perm32(int rho) { const int n = rho >> 4, i = rho & 15; return 8 * (i >> 2) + 4 * n + (i & 3); }

struct Unit { int pm, pn, pb; };
struct Gemm { const bf16_t* A; const bf16_t* Bt; int M, N, K; int lda; int f8sw, f8sx; };

struct StaticOrder {
    int nM, nN, nwg, G, c, full = 1 << 30, skip = 0;
    __host__ __device__ void init(int M, int N, int G_, int c_) { nM = M / BM; nN = N / BM; nwg = nM * nN; G = G_; c = c_; }
    __host__ __device__ bool next(int i, Unit& u) const {
        long L; if (i < full) L = (long)i * G + c; else { if (c < skip) return false; L = (long)full * G + (long)(i - full) * (G - skip) + (c - skip); }
        if (L >= nwg) return false;
        int wgid = (int)L; { const int q = nwg / NXCD, r = nwg % NXCD, xcd = wgid % NXCD, off = wgid / NXCD; wgid = (xcd < r ? xcd * (q + 1) : r * (q + 1) + (xcd - r) * q) + off; }
        const int nig = WGM * nN, gid = wgid / nig, fm = gid * WGM, gsz = (nM - fm) < WGM ? (nM - fm) : WGM;
        u.pm = fm + ((wgid % nig) % gsz); u.pn = (wgid % nig) / gsz; u.pb = 0; return true;
    }
    __device__ __forceinline__ size_t a_off(const Unit&) const { return 0; }
    __device__ __forceinline__ size_t b_off(const Unit&) const { return 0; }
    __device__ __forceinline__ void a_ready(const Unit&) const {}
    __device__ __forceinline__ void done(const Unit&) const {}
};

struct BranchOrder : StaticOrder {
    int NB; size_t a_stride, b_stride;
    __device__ bool next(int i, Unit& u) const { const int ti = i / NB; if (!StaticOrder::next(ti, u)) return false; u.pb = i - ti * NB; return true; }
    __device__ __forceinline__ size_t a_off(const Unit& u) const { return (size_t)u.pb * a_stride; }
    __device__ __forceinline__ size_t b_off(const Unit& u) const { return (size_t)u.pb * b_stride; }
};

__device__ __forceinline__ unsigned cvt_pk_bf16(float lo, float hi) { unsigned r; asm("v_cvt_pk_bf16_f32 %0, %1, %2" : "=v"(r) : "v"(lo), "v"(hi)); return r; }
__device__ __forceinline__ float gelu_tanh_f(float x) { const float u2 = 1.5957691216057308f * (x + 0.044715f * x * x * x); return x * __builtin_amdgcn_rcpf(1.f + __expf(-u2)); }
__device__ __forceinline__ float silu_e(float x) { return x * __builtin_amdgcn_rcpf(1.f + __expf(-x)); }
struct EpiProj {
    static constexpr bool CHAINS = false;
    static constexpr bool PERM = true, AFTER_DRAIN = false;
    bf16_t* O; int ldc; float* SSQ; int mrows; int pn0; unsigned char* O8;
    __device__ __forceinline__ void operator()(const f32x4 (&acc)[2][2][4][2], const Unit& u, int wr, int wc, int fr, int fq) const {
        const int row0 = u.pm * BM + wr * 64 + fr, col0 = u.pn * BM + wc * 32 + 8 * fq;
        const int apn = u.pn + pn0;
        const int seg = !SSQ ? -1 : ((apn == 25 || apn == 26) ? 0 : ((apn == 27 || apn == 28) ? 1 : ((apn >= 4 && apn < 8) ? 2 : -1)));
        const int act = apn < 8 ? 1 : (((apn >= 8 && apn < 12) || (apn >= 20 && apn < 24)) ? 2 : 0);
#pragma unroll
        for (int ai = 0; ai < 2; ++ai)
#pragma unroll
            for (int m = 0; m < 4; ++m) { const int row = row0 + ai * HALF + m * 16; bf16_t* rowp = O + (size_t)row * ldc + col0;
                float ss = 0.f;
#pragma unroll
                for (int bj = 0; bj < 2; ++bj) { const f32x4 v0 = acc[ai][bj][m][0], v1 = acc[ai][bj][m][1];
                    if (apn >= 33) {
                        unsigned a = 0u, b = 0u;
#pragma unroll
                        for (int j = 0; j < 4; ++j) { a = __builtin_amdgcn_cvt_pk_u8_f32(255.0f * __builtin_amdgcn_rcpf(1.0f + __expf(-v0[j])), j, a); b = __builtin_amdgcn_cvt_pk_u8_f32(255.0f * __builtin_amdgcn_rcpf(1.0f + __expf(-v1[j])), j, b); }
                        typedef unsigned u32x2g_ __attribute__((ext_vector_type(2)));
                        *(u32x2g_*)((unsigned char*)(O + (size_t)row * ldc + (33 - pn0) * BM) + (apn - 33) * BM + wc * 32 + 8 * fq + bj * HALF) = (u32x2g_){a, b};
                    } else
                    if (seg == 0 || seg == 1) {
                        int a = __builtin_amdgcn_cvt_pk_fp8_f32(v0[0] * 16.0f, v0[1] * 16.0f, 0, false); a = __builtin_amdgcn_cvt_pk_fp8_f32(v0[2] * 16.0f, v0[3] * 16.0f, a, true);
                        int b = __builtin_amdgcn_cvt_pk_fp8_f32(v1[0] * 16.0f, v1[1] * 16.0f, 0, false); b = __builtin_amdgcn_cvt_pk_fp8_f32(v1[2] * 16.0f, v1[3] * 16.0f, b, true);
                        typedef unsigned u32x2_ __attribute__((ext_vector_type(2)));
                        *(u32x2_*)(O8 + ((size_t)seg * mrows + row) * 512 + (apn - (seg == 0 ? 25 : 27)) * BM + wc * 32 + 8 * fq + bj * HALF) = (u32x2_){(unsigned)a, (unsigned)b};
                    } else {
                    f32x4 w0 = v0, w1 = v1;
                    if (act == 1) {
#pragma unroll
                        for (int j = 0; j < 4; ++j) { w0[j] = gelu_tanh_f(v0[j]); w1[j] = gelu_tanh_f(v1[j]); } }
                    else if (act == 2) {
#pragma unroll
                        for (int j = 0; j < 4; ++j) { w0[j] = silu_e(v0[j]); w1[j] = silu_e(v1[j]); } }
                    u32x4 w; w.x = cvt_pk_bf16(w0[0], w0[1]); w.y = cvt_pk_bf16(w0[2], w0[3]); w.z = cvt_pk_bf16(w1[0], w1[1]); w.w = cvt_pk_bf16(w1[2], w1[3]);
                    *(u32x4*)(rowp + bj * HALF) = w;
                    if (seg == 2) {
#pragma unroll
                        for (int j = 0; j < 4; ++j) ss += w0[j] * w0[j] + w1[j] * w1[j]; } }
                    if (seg == 0 || seg == 1) {
#pragma unroll
                        for (int j = 0; j < 4; ++j) ss += v0[j] * v0[j] + v1[j] * v1[j]; } }
                if (seg >= 0) {
                    ss += __uint_as_float((unsigned)__builtin_amdgcn_ds_swizzle((int)__float_as_uint(ss), (16 << 10) | 0x1f));
                    auto rr = __builtin_amdgcn_permlane32_swap(__float_as_uint(ss), __float_as_uint(ss), false, false);
                    ss = __uint_as_float(rr[0]) + __uint_as_float(rr[1]);
                    if (fq == 0) atomicAdd(SSQ + (size_t)seg * mrows + row, ss); } }
    }
};
struct EpiBf16Row {
    static constexpr bool CHAINS = false;
    static constexpr bool PERM = true, AFTER_DRAIN = false;
    bf16_t* O; int ldc; const float* SSQ; float inv_n, eps;
    __device__ __forceinline__ void operator()(const f32x4 (&acc)[2][2][4][2], const Unit& u, int wr, int wc, int fr, int fq) const {
        const int row0 = u.pm * BM + wr * 64 + fr, col0 = u.pn * BM + wc * 32 + 8 * fq;
        float sq[2][4];
#pragma unroll
        for (int ai = 0; ai < 2; ++ai)
#pragma unroll
            for (int m = 0; m < 4; ++m) sq[ai][m] = SSQ[row0 + ai * HALF + m * 16];
#pragma unroll
        for (int ai = 0; ai < 2; ++ai)
#pragma unroll
            for (int m = 0; m < 4; ++m) { const int row = row0 + ai * HALF + m * 16; bf16_t* rowp = O + (size_t)row * ldc + col0;
                const float rn = 1.0f / sqrtf(sq[ai][m] * inv_n + eps);
#pragma unroll
                for (int bj = 0; bj < 2; ++bj) { const f32x4 v0 = acc[ai][bj][m][0] * rn, v1 = acc[ai][bj][m][1] * rn;
                    u32x4 w; w.x = cvt_pk_bf16(v0[0], v0[1]); w.y = cvt_pk_bf16(v0[2], v0[3]); w.z = cvt_pk_bf16(v1[0], v1[1]); w.w = cvt_pk_bf16(v1[2], v1[3]);
                    *(u32x4*)(rowp + bj * HALF) = w; } }
    }
};
struct EpiF8Row {
    static constexpr bool CHAINS = false;
    static constexpr bool PERM = true, AFTER_DRAIN = false;
    unsigned char* O; int ldc; const float* SSQ; float inv_n, eps;
    __device__ __forceinline__ void operator()(const f32x4 (&acc)[2][2][4][2], const Unit& u, int wr, int wc, int fr, int fq) const {
        const int row0 = u.pm * BM + wr * 64 + fr, col0 = u.pn * BM + wc * 32 + 8 * fq;
        float sq[2][4];
#pragma unroll
        for (int ai = 0; ai < 2; ++ai)
#pragma unroll
            for (int m = 0; m < 4; ++m) sq[ai][m] = SSQ[row0 + ai * HALF + m * 16];
        typedef unsigned u32x2_ __attribute__((ext_vector_type(2)));
#pragma unroll
        for (int ai = 0; ai < 2; ++ai)
#pragma unroll
            for (int m = 0; m < 4; ++m) { const int row = row0 + ai * HALF + m * 16; unsigned char* rowp = O + (size_t)row * ldc + col0;
                const float rn = 8.0f / sqrtf(sq[ai][m] * inv_n + eps);
#pragma unroll
                for (int bj = 0; bj < 2; ++bj) { const f32x4 v0 = acc[ai][bj][m][0] * rn, v1 = acc[ai][bj][m][1] * rn;
                    int a = __builtin_amdgcn_cvt_pk_fp8_f32(v0[0], v0[1], 0, false); a = __builtin_amdgcn_cvt_pk_fp8_f32(v0[2], v0[3], a, true);
                    int b = __builtin_amdgcn_cvt_pk_fp8_f32(v1[0], v1[1], 0, false); b = __builtin_amdgcn_cvt_pk_fp8_f32(v1[2], v1[3], b, true);
                    *(u32x2_*)(rowp + bj * HALF) = (u32x2_){(unsigned)a, (unsigned)b}; } }
    }
};
struct EpiRes {
    static constexpr bool CHAINS = false;
    static constexpr bool PERM = false, AFTER_DRAIN = false;
    const float* base; float* C; int ldc;
    __device__ __forceinline__ void operator()(const f32x4 (&acc)[2][2][4][2], const Unit& u, int wr, int wc, int fr, int fq) const {
        const int row0 = u.pm * BM + wr * 64 + fr, col0 = u.pn * BM + wc * 32 + 4 * fq;
#pragma unroll
        for (int ai = 0; ai < 2; ++ai) {
            f32x4 bs[4][2][2];
#pragma unroll
            for (int m = 0; m < 4; ++m) { const size_t off = (size_t)(row0 + ai * HALF + m * 16) * ldc + col0;
#pragma unroll
                for (int bj = 0; bj < 2; ++bj)
#pragma unroll
                    for (int n = 0; n < 2; ++n) bs[m][bj][n] = *(const f32x4*)(base + off + bj * HALF + n * 16); }
#pragma unroll
            for (int m = 0; m < 4; ++m) { const size_t off = (size_t)(row0 + ai * HALF + m * 16) * ldc + col0;
#pragma unroll
                for (int bj = 0; bj < 2; ++bj)
#pragma unroll
                    for (int n = 0; n < 2; ++n) *(f32x4*)(C + off + bj * HALF + n * 16) = acc[ai][bj][m][n] + bs[m][bj][n]; }
            asm volatile("" ::: "memory");
        }
    }
};
struct EpiMerge {
    static constexpr bool CHAINS = true;
    static constexpr bool PERM = true, AFTER_DRAIN = false;
    const unsigned char* G0; int ldg; bf16_t* MG; int ldc; int gstride; int pb0; int chain = 0;
    __device__ __forceinline__ bool keep(const Unit& u) const { return chain && (u.pb + pb0 == 1); }
    __device__ __forceinline__ void operator()(f32x4 (&acc)[2][2][4][2], const Unit& u, int wr, int wc, int fr, int fq) const {
        const int row0 = u.pm * BM + wr * 64 + fr, col0 = u.pn * BM + wc * 32 + 8 * fq; const int branch = u.pb + pb0; const unsigned char* G = G0 + (size_t)branch * gstride; const bool first = branch == 0;
        typedef unsigned u32x2m_ __attribute__((ext_vector_type(2)));
        if (chain && branch == 1) {
#pragma unroll
            for (int ai = 0; ai < 2; ++ai) {
                u32x2m_ gb[4][2], gc[4][2]; u32x4 ow[4][2];
#pragma unroll
                for (int m = 0; m < 4; ++m) { const size_t row = (size_t)(row0 + ai * HALF + m * 16);
#pragma unroll
                    for (int bj = 0; bj < 2; ++bj) { gb[m][bj] = *(const u32x2m_*)(G + row * ldg + col0 + bj * HALF); gc[m][bj] = *(const u32x2m_*)(G + gstride + row * ldg + col0 + bj * HALF);
                        ow[m][bj] = *(const u32x4*)(MG + row * ldc + col0 + bj * HALF); } }
#pragma unroll
                for (int m = 0; m < 4; ++m)
#pragma unroll
                    for (int bj = 0; bj < 2; ++bj) { const unsigned b2[2] = {gb[m][bj].x, gb[m][bj].y}, c2[2] = {gc[m][bj].x, gc[m][bj].y}, o4[4] = {ow[m][bj].x, ow[m][bj].y, ow[m][bj].z, ow[m][bj].w};
#pragma unroll
                        for (int q = 0; q < 4; ++q) {
                            const float bb0 = (float)((b2[q >> 1] >> (16 * (q & 1))) & 0xffu), bb1 = (float)((b2[q >> 1] >> (16 * (q & 1) + 8)) & 0xffu);
                            const float cc0 = fmaxf((float)((c2[q >> 1] >> (16 * (q & 1))) & 0xffu), 1.0f), cc1 = fmaxf((float)((c2[q >> 1] >> (16 * (q & 1) + 8)) & 0xffu), 1.0f);
                            const float m0 = __uint_as_float(o4[q] << 16) * 255.0f, m1 = __uint_as_float(o4[q] & 0xffff0000u) * 255.0f;
                            const float a0 = acc[ai][bj][m][q >> 1][2 * (q & 1)], a1 = acc[ai][bj][m][q >> 1][2 * (q & 1) + 1];
                            acc[ai][bj][m][q >> 1][2 * (q & 1)] = (m0 + bb0 * a0) * __builtin_amdgcn_rcpf(cc0); acc[ai][bj][m][q >> 1][2 * (q & 1) + 1] = (m1 + bb1 * a1) * __builtin_amdgcn_rcpf(cc1); } }
                asm volatile("" ::: "memory");
            }
            return;
        }
        const bool fin = chain && branch == 2;
#pragma unroll
        for (int ai = 0; ai < 2; ++ai) {
            u32x2m_ gw[4][2]; u32x4 ow[4][2];
#pragma unroll
            for (int m = 0; m < 4; ++m) { const size_t row = (size_t)(row0 + ai * HALF + m * 16);
#pragma unroll
                for (int bj = 0; bj < 2; ++bj) { gw[m][bj] = *(const u32x2m_*)(G + row * ldg + col0 + bj * HALF); ow[m][bj] = (first || fin) ? (u32x4){0u, 0u, 0u, 0u} : *(const u32x4*)(MG + row * ldc + col0 + bj * HALF); } }
#pragma unroll
            for (int m = 0; m < 4; ++m) { const size_t row = (size_t)(row0 + ai * HALF + m * 16);
#pragma unroll
                for (int bj = 0; bj < 2; ++bj) { const f32x4 v0 = acc[ai][bj][m][0], v1 = acc[ai][bj][m][1];
                    const unsigned g2[2] = {gw[m][bj].x, gw[m][bj].y}, o4[4] = {ow[m][bj].x, ow[m][bj].y, ow[m][bj].z, ow[m][bj].w};
                    const float a8[8] = {v0[0], v0[1], v0[2], v0[3], v1[0], v1[1], v1[2], v1[3]};
                    unsigned w4[4];
#pragma unroll
                    for (int q = 0; q < 4; ++q) {
                        float gb0 = (float)((g2[q >> 1] >> (16 * (q & 1))) & 0xffu), gb1 = (float)((g2[q >> 1] >> (16 * (q & 1) + 8)) & 0xffu);
                        if (fin) { gb0 = fmaxf(gb0, 1.0f); gb1 = fmaxf(gb1, 1.0f); }
                        const float g0 = gb0 * (1.0f / 255.0f), g1 = gb1 * (1.0f / 255.0f);
                        const float r0 = __uint_as_float(o4[q] << 16) + a8[2 * q] * g0;
                        const float r1 = __uint_as_float(o4[q] & 0xffff0000u) + a8[2 * q + 1] * g1;
                        unsigned pk; asm("v_cvt_pk_bf16_f32 %0, %1, %2" : "=v"(pk) : "v"(r0), "v"(r1)); w4[q] = pk; }
                    *(u32x4*)(MG + row * ldc + col0 + bj * HALF) = (u32x4){w4[0], w4[1], w4[2], w4[3]}; } }
            asm volatile("" ::: "memory");
        }
    }
};

typedef int pg8_v8i __attribute__((ext_vector_type(8)));
typedef int pg8_v4i __attribute__((ext_vector_type(4)));
template <class Epi, class Sched, bool STAMP = false, bool ALIGN_EPI = false, bool SP2 = false, bool FP8 = false>
__device__ __forceinline__ void gemm_phase(PG8_LAS unsigned char* lds, const Gemm g, const Sched& S, const Epi& E, unsigned long long* stamps) {
    const int tid = otid(), wid = __builtin_amdgcn_readfirstlane(tid >> 6), lane = tid & 63, wr = wid >> 2, wc = wid & 3, fr = lane & 15, fq = lane >> 4;
    const int K = g.K, nt = K / BK, LDA = g.lda ? g.lda : g.K;
    int ts_lo = 0, ts_hi = 0, nts = 0; const unsigned long long rt_entry = STAMP ? (unsigned long long)wall_clock64() : 0ull;
#define PG8_STAMP() do { if (STAMP && wid == 0 && nts < 64) { const unsigned long long _c = (unsigned long long)clock64(); \
        ts_lo = (lane == nts) ? (int)(unsigned)_c : ts_lo; ts_hi = (lane == nts) ? (int)(unsigned)(_c >> 32) : ts_hi; ++nts; } } while (0)
    PG8_STAMP();
    unsigned voffA[2], voffB[2];
#pragma unroll
    for (int i = 0; i < 2; ++i) { int R, C; stage_rc(tid * 16 + i * 8192, R, C); const int Rb = Epi::PERM ? ((R & ~31) + perm32(R & 31)) : R;
        voffA[i] = (unsigned)(R * LDA + C) * 2u; voffB[i] = (unsigned)(Rb * K + C) * 2u; }
    const size_t kstep = (size_t)(BK * 2);
    const size_t hstepB = (size_t)HALF * K * 2, hstepA = (size_t)HALF * LDA * 2;
    const size_t tstepB = 2 * hstepB, tstepA = 2 * hstepA;
    const unsigned ldsw = (unsigned)wid * 1024u;
    const int aoff = lds_byte(wr * 64 + fr, fq * 8), boff = lds_byte(wc * 32 + fr, fq * 8);
#define PG8_SA(b, h) (((b) * 2 + (h)) * HTB)
#define PG8_SB(b, h) ((4 + (b) * 2 + (h)) * HTB)
#define PG8_STAGE(bufoff, gbase, voff) do { _Pragma("unroll") for (int _i = 0; _i < 2; ++_i) \
        __builtin_amdgcn_global_load_lds((const unsigned*)((const char*)(gbase) + (voff)[_i]), (PG8_LAS unsigned*)(lds + (bufoff) + ldsw + _i * 8192), 16, 0, 0); } while (0)
#define PG8_I4(p) (*(const PG8_LAS pg8_v4i*)(p))
#define PG8_LDA(dst, b, h) do { if constexpr (FP8) { _Pragma("unroll") for (int m = 0; m < 4; ++m) dst##8[m] = __builtin_shufflevector(PG8_I4(lds + PG8_SA(b, h) + aoff + m * 2048), PG8_I4(lds + PG8_SA(b, h) + aoff + m * 2048 + 1024), 0, 1, 2, 3, 4, 5, 6, 7); } \
        else { _Pragma("unroll") for (int m = 0; m < 4; ++m) _Pragma("unroll") for (int k = 0; k < 2; ++k) dst[m][k] = *(const PG8_LAS bf16x8*)(lds + PG8_SA(b, h) + aoff + m * 2048 + k * 1024); } } while (0)
#define PG8_LDB(dst, b, h) do { if constexpr (FP8) { _Pragma("unroll") for (int n = 0; n < 2; ++n) dst##8[n] = __builtin_shufflevector(PG8_I4(lds + PG8_SB(b, h) + boff + n * 2048), PG8_I4(lds + PG8_SB(b, h) + boff + n * 2048 + 1024), 0, 1, 2, 3, 4, 5, 6, 7); } \
        else { _Pragma("unroll") for (int n = 0; n < 2; ++n) _Pragma("unroll") for (int k = 0; k < 2; ++k) dst[n][k] = *(const PG8_LAS bf16x8*)(lds + PG8_SB(b, h) + boff + n * 2048 + k * 1024); } } while (0)
#define PG8_MMA_BF(ai, bj, At, Bt) do { __builtin_amdgcn_s_setprio(1); _Pragma("unroll") for (int m = 0; m < 4; ++m) _Pragma("unroll") for (int n = 0; n < 2; ++n) _Pragma("unroll") for (int k = 0; k < 2; ++k) \
        acc[ai][bj][m][n] = __builtin_amdgcn_mfma_f32_16x16x32_bf16(Bt[n][k], At[m][k], acc[ai][bj][m][n], 0, 0, 0); __builtin_amdgcn_s_setprio(0); } while (0)
#define PG8_MMA_F8(ai, bj, At, Bt) do { __builtin_amdgcn_s_setprio(1); _Pragma("unroll") for (int m = 0; m < 4; ++m) _Pragma("unroll") for (int n = 0; n < 2; ++n) \
        asm volatile("v_mfma_scale_f32_16x16x128_f8f6f4 %0, %1, %2, %0, %3, %4 op_sel_hi:[0,0,0]" : "+v"(acc[ai][bj][m][n]) : "v"(Bt##8[n]), "v"(At##8[m]), "v"(f8_scale_w), "v"(f8_scale_x)); \
        __builtin_amdgcn_s_setprio(0); } while (0)
#define PG8_F8_DRAIN() do { if constexpr (FP8) asm volatile("s_nop 15\n\ts_nop 15" ::: "memory"); } while (0)
#define PG8_MMA(ai, bj, At, Bt) do { if constexpr (FP8) PG8_MMA_F8(ai, bj, At, Bt); else PG8_MMA_BF(ai, bj, At, Bt); } while (0)
#define PG8_WAIT_V(n) asm volatile("s_waitcnt vmcnt(" #n ")" ::: "memory")
#define PG8_WAIT_L(n) asm volatile("s_waitcnt lgkmcnt(" #n ")" ::: "memory")
#define PG8_BAR __builtin_amdgcn_s_barrier()
#define PG8_SCHED __builtin_amdgcn_sched_barrier(0)
    Unit cur, nxt; int ui = 0;
    if (!S.next(0, cur)) return;
    f32x4 acc[2][2][4][2];
#pragma unroll
    for (int a = 0; a < 2; ++a)
#pragma unroll
        for (int b = 0; b < 2; ++b)
#pragma unroll
            for (int m = 0; m < 4; ++m)
#pragma unroll
                for (int n = 0; n < 2; ++n) acc[a][b][m][n] = (f32x4){0.f, 0.f, 0.f, 0.f};
    int f8_scale_w = g.f8sw ? g.f8sw : 0x79797979, f8_scale_x = g.f8sx ? g.f8sx : 0x7f7f7f7f; (void)f8_scale_w; (void)f8_scale_x;
    bf16x8 At[4][2], B0[2][2], B1[2][2]; pg8_v8i At8[4], B08[2], B18[2];
    (void)At; (void)B0; (void)B1; (void)At8; (void)B08; (void)B18;
    const char* cA = (const char*)g.A + (size_t)cur.pm * tstepA + S.a_off(cur); const char* cB = (const char*)g.Bt + (size_t)cur.pn * tstepB + S.b_off(cur);
    S.a_ready(cur);
    if constexpr (SP2) {
        PG8_STAGE(PG8_SB(0, 0), cB, voffB); PG8_STAGE(PG8_SB(0, 1), cB + hstepB, voffB); PG8_STAGE(PG8_SA(0, 0), cA, voffA); PG8_STAGE(PG8_SA(0, 1), cA + hstepA, voffA);
        if (wr == 1) PG8_BAR;
        PG8_WAIT_V(2); PG8_BAR;
        PG8_STAGE(PG8_SB(1, 0), cB + kstep, voffB); PG8_STAGE(PG8_SA(1, 0), cA + kstep, voffA); PG8_STAGE(PG8_SB(1, 1), cB + hstepB + kstep, voffB);
        PG8_WAIT_V(6); PG8_BAR;
    } else {
    PG8_STAGE(PG8_SB(0, 0), cB, voffB); PG8_STAGE(PG8_SA(0, 0), cA, voffA); PG8_STAGE(PG8_SB(0, 1), cB + hstepB, voffB); PG8_STAGE(PG8_SA(0, 1), cA + hstepA, voffA);
    if (wr == 1) PG8_BAR;
    PG8_WAIT_V(4); PG8_BAR;
    PG8_STAGE(PG8_SB(1, 0), cB + kstep, voffB); PG8_STAGE(PG8_SA(1, 0), cA + kstep, voffA); PG8_STAGE(PG8_SB(1, 1), cB + hstepB + kstep, voffB);
    PG8_WAIT_V(6); PG8_BAR;
    }
    PG8_STAMP();
    for (;;) {
        const bool has_next = S.next(ui + 1, nxt);
        const char* nA = has_next ? (const char*)g.A + (size_t)nxt.pm * tstepA + S.a_off(nxt) : cA; const char* nB = has_next ? (const char*)g.Bt + (size_t)nxt.pn * tstepB + S.b_off(nxt) : cB;
        for (int t = 0; t < nt; t += 2) {
            const bool last = (t == nt - 2);
            const char* a1 = cA + (size_t)(t + 1) * kstep;
            const char* a2 = last ? nA : cA + (size_t)(t + 2) * kstep; const char* b2 = last ? nB : cB + (size_t)(t + 2) * kstep;
            const char* a3 = a2 + kstep; const char* b3 = b2 + kstep;
            if (last && has_next) S.a_ready(nxt);
            if constexpr (SP2) {
            PG8_LDB(B0, 0, 0); PG8_LDB(B1, 0, 1); PG8_SCHED; PG8_LDA(At, 0, 0); PG8_STAGE(PG8_SA(1, 1), a1 + hstepA, voffA);
            PG8_WAIT_V(8); PG8_WAIT_L(0); PG8_BAR; PG8_MMA(0, 0, At, B0); PG8_MMA(0, 1, At, B1); PG8_BAR; PG8_SCHED;
            PG8_LDA(At, 0, 1); PG8_STAGE(PG8_SB(0, 0), b2, voffB); PG8_STAGE(PG8_SB(0, 1), b2 + hstepB, voffB); PG8_STAGE(PG8_SA(0, 0), a2, voffA);
            PG8_WAIT_V(8); PG8_WAIT_L(0); PG8_BAR; PG8_MMA(1, 0, At, B0); PG8_MMA(1, 1, At, B1); PG8_BAR; PG8_SCHED;
            PG8_LDB(B0, 1, 0); PG8_LDB(B1, 1, 1); PG8_SCHED; PG8_LDA(At, 1, 0); PG8_STAGE(PG8_SA(0, 1), a2 + hstepA, voffA);
            PG8_WAIT_V(8); PG8_WAIT_L(0); PG8_BAR; PG8_MMA(0, 0, At, B0); PG8_MMA(0, 1, At, B1); PG8_BAR; PG8_SCHED;
            PG8_LDA(At, 1, 1); PG8_STAGE(PG8_SB(1, 0), b3, voffB); PG8_STAGE(PG8_SB(1, 1), b3 + hstepB, voffB); PG8_STAGE(PG8_SA(1, 0), a3, voffA);
            PG8_WAIT_V(8); PG8_WAIT_L(0); PG8_BAR; PG8_MMA(1, 0, At, B0); PG8_MMA(1, 1, At, B1); PG8_BAR; PG8_SCHED;
            } else {
            PG8_LDB(B0, 0, 0); PG8_SCHED; PG8_LDA(At, 0, 0); PG8_STAGE(PG8_SA(1, 1), a1 + hstepA, voffA);
            PG8_WAIT_L(8); PG8_BAR; PG8_WAIT_L(0); PG8_MMA(0, 0, At, B0); PG8_BAR; PG8_SCHED;
            PG8_LDB(B1, 0, 1); PG8_STAGE(PG8_SB(0, 0), b2, voffB);
            PG8_BAR; PG8_WAIT_L(0); PG8_MMA(0, 1, At, B1); PG8_BAR;
            PG8_LDA(At, 0, 1); PG8_STAGE(PG8_SA(0, 0), a2, voffA);
            PG8_BAR; PG8_WAIT_L(0); PG8_MMA(1, 0, At, B0); PG8_BAR; PG8_SCHED;
            PG8_STAGE(PG8_SB(0, 1), b2 + hstepB, voffB);
            PG8_WAIT_V(6); PG8_BAR; PG8_MMA(1, 1, At, B1); PG8_BAR;
            PG8_LDB(B0, 1, 0); PG8_SCHED; PG8_LDA(At, 1, 0); PG8_STAGE(PG8_SA(0, 1), a2 + hstepA, voffA);
            PG8_WAIT_L(8); PG8_BAR; PG8_WAIT_L(0); PG8_MMA(0, 0, At, B0); PG8_BAR; PG8_SCHED;
            PG8_LDB(B1, 1, 1); PG8_STAGE(PG8_SB(1, 0), b3, voffB);
            PG8_BAR; PG8_WAIT_L(0); PG8_MMA(0, 1, At, B1); PG8_BAR;
            PG8_LDA(At, 1, 1); PG8_STAGE(PG8_SA(1, 0), a3, voffA);
            PG8_BAR; PG8_WAIT_L(0); PG8_MMA(1, 0, At, B0); PG8_BAR; PG8_SCHED;
            PG8_STAGE(PG8_SB(1, 1), b3 + hstepB, voffB);
            PG8_WAIT_V(6); PG8_BAR; PG8_MMA(1, 1, At, B1); PG8_BAR;
            }
        }
        if constexpr (ALIGN_EPI) { if (wr == 0) PG8_BAR; }
        PG8_STAMP();
        PG8_F8_DRAIN();
        if constexpr (!Epi::AFTER_DRAIN) { E(acc, cur, wr, wc, fr, fq); S.done(cur); }
        PG8_STAMP();
        if (!has_next) break;
        bool keep_ = false; if constexpr (Epi::CHAINS) keep_ = E.keep(cur);
        if (!keep_) {
#pragma unroll
        for (int a = 0; a < 2; ++a)
#pragma unroll
            for (int b = 0; b < 2; ++b)
#pragma unroll
                for (int m = 0; m < 4; ++m)
#pragma unroll
                    for (int n = 0; n < 2; ++n) acc[a][b][m][n] = (f32x4){0.f, 0.f, 0.f, 0.f}; }
        cur = nxt; cA = nA; cB = nB; ++ui;
        if constexpr (ALIGN_EPI) { if (wr == 1) PG8_BAR; }
    }
    PG8_WAIT_V(0);
    if constexpr (!ALIGN_EPI) { if (wr == 0) PG8_BAR; }
    PG8_BAR;
    if constexpr (Epi::AFTER_DRAIN) { E.fused(acc, cur, wr, wc, fr, fq, lds, wid, lane); S.done(cur); }
    PG8_STAMP();
    if (STAMP && wid == 0) { stamps[lane] = lane < nts ? (((unsigned long long)(unsigned)ts_hi << 32) | (unsigned)ts_lo) : 0ull;
        if (lane == 62) stamps[62] = rt_entry; if (lane == 63) stamps[63] = (unsigned long long)wall_clock64(); }
#undef PG8_STAMP
#undef PG8_SA
#undef PG8_SB
#undef PG8_STAGE
#undef PG8_LDA
#undef PG8_LDB
#undef PG8_MMA
#undef PG8_MMA_BF
#undef PG8_MMA_F8
#undef PG8_I4
#undef PG8_F8_DRAIN
#undef PG8_WAIT_V
#undef PG8_WAIT_L
#undef PG8_BAR
#undef PG8_SCHED
}
}
#define XB_TMO      128
#define XB_XCNT(j)  (256  + 64 * (j))
#define XB_XSUB(j)  (1280 + 64 * (j))
#define XB_XGEN(j)  (2304 + 64 * (j))
#define XB_TOP      3328
#define XB_TOPGEN   3392
#define XCD_BAR_WORDS 3456
#define XB_SPIN_CAP (1u << 18)
#define LAS __attribute__((address_space(3)))

__device__ __forceinline__ unsigned xb_ld(unsigned* p)              { return __hip_atomic_load(p, __ATOMIC_RELAXED, __HIP_MEMORY_SCOPE_AGENT); }
__device__ __forceinline__ unsigned xb_add(unsigned* p, unsigned v) { return __hip_atomic_fetch_add(p, v, __ATOMIC_RELAXED, __HIP_MEMORY_SCOPE_AGENT); }
__device__ __forceinline__ unsigned xb_xcc_id() { return (unsigned)__builtin_amdgcn_s_getreg((3 << 11) | 20) & 0xFu; }
#define XB_SPIN(cond, bar) do { unsigned _sp = 0; while (cond) { __builtin_amdgcn_s_sleep(1); \
    if ((++_sp & 255u) == 0u) { if (xb_ld(&(bar)[XB_TMO])) break; if (_sp > XB_SPIN_CAP) { atomicAdd(&(bar)[XB_TMO], 1u); break; } } } } while (0)

struct XcdBarrier {
    unsigned* bar; unsigned x;
    volatile LAS unsigned* st;
};

__device__ __forceinline__ XcdBarrier xcd_barrier_post(unsigned* bar, volatile LAS unsigned* st) {
    XcdBarrier b; b.bar = bar; b.x = xb_xcc_id(); b.st = st;
    if (threadIdx.x == 0) (void)xb_add(&bar[XB_XCNT(b.x)], 1u);
    return b;
}
__device__ __forceinline__ void xcd_barrier_complete(unsigned* bar, unsigned x, unsigned& nloc, unsigned& nx) {
    const unsigned G = gridDim.x * gridDim.y * gridDim.z;
    unsigned sum, cnt, mine, sp = 0u;
    for (;;) {
        sum = 0u; cnt = 0u; mine = 0u;
#pragma unroll
        for (unsigned j = 0; j < 16; ++j) { const unsigned c = xb_ld(&bar[XB_XCNT(j)]); sum += c; cnt += (c > 0u) ? 1u : 0u; mine = (j == x) ? c : mine; }
        if (sum == G) break;
        __builtin_amdgcn_s_sleep(1);
        if ((++sp & 255u) == 0u) { if (xb_ld(&bar[XB_TMO])) break; if (sp > XB_SPIN_CAP) { atomicAdd(&bar[XB_TMO], 1u); break; } }
    }
    nloc = mine > 0u ? mine : 1u; nx = cnt > 0u ? cnt : 1u;
}

__device__ __forceinline__ void xcd_barrier(const XcdBarrier& b) {
    asm volatile("s_waitcnt vmcnt(0)" ::: "memory");
    __syncthreads();
    if (threadIdx.x == 0) {
        unsigned* bar = b.bar;
        __builtin_amdgcn_s_waitcnt(0);
        unsigned nloc = b.st[0], nx = b.st[1];
        if (nloc == 0u) { xcd_barrier_complete(bar, b.x, nloc, nx); b.st[0] = nloc; b.st[1] = nx; }
        const unsigned old = xb_add(&bar[XB_XSUB(b.x)], 1u);
        const unsigned gen = old / nloc;
        if (old + 1u == (gen + 1u) * nloc) {
            __builtin_amdgcn_fence(__ATOMIC_RELEASE, "agent");
            asm volatile("s_waitcnt vmcnt(0)" ::: "memory");
            const unsigned og = xb_add(&bar[XB_TOP], 1u);
            const unsigned tg = og / nx;
            if (og + 1u == (tg + 1u) * nx) xb_add(&bar[XB_TOPGEN], 1u);
            else XB_SPIN(xb_ld(&bar[XB_TOPGEN]) == tg, bar);
            __builtin_amdgcn_fence(__ATOMIC_ACQUIRE, "agent");
            xb_add(&bar[XB_XGEN(b.x)], 1u);
            asm volatile("s_waitcnt vmcnt(0)" ::: "memory");
        } else {
            XB_SPIN(xb_ld(&bar[XB_XGEN(b.x)]) == gen, bar);
            __builtin_amdgcn_fence(__ATOMIC_ACQUIRE, "agent");
            asm volatile("s_waitcnt vmcnt(0)" ::: "memory");
        }
    }
    __syncthreads();
}


typedef unsigned short bf16;
typedef unsigned v4u __attribute__((ext_vector_type(4)));
typedef unsigned v2u __attribute__((ext_vector_type(2)));
typedef float v4f __attribute__((ext_vector_type(4)));
typedef float v2f __attribute__((ext_vector_type(2)));

constexpr int DM = 2048, NBATCH = 8, SEQ = 4096, DEPTH = 2, MTOK = NBATCH * SEQ;
constexpr int IN_COLS = 14416, NPROJ = 14592;
constexpr int C_UB = 0, C_VB = 1024, C_ZB = 2048, C_QC = 3072, C_KC = 3584, C_VC = 4096, C_ZC = 5120, C_KROPE = 6144, C_AR = 6208,
              C_CQ = 6400, C_CKV = 6912, C_ZA = 7424, C_GATE = 8448;
constexpr int NBF = C_CQ, NF8 = NPROJ - NBF;
constexpr float EPS = 1e-6f;
#ifndef NBP
#define NBP 4
#endif
constexpr int MP = NBP * SEQ, NPASS = NBATCH / NBP;
constexpr int STEPS_PER_PASS = 7;
constexpr int NSTEPS = DEPTH * NPASS * STEPS_PER_PASS;

constexpr size_t al256(size_t x) { return (x + 255) & ~(size_t)255; }
constexpr size_t WS_CTL = 0, CTL_BYTES = 1u << 20;
constexpr size_t SZ_WINB = (size_t)NBF * DM * 2  , SZ_WIN = SZ_WINB + (size_t)NF8 * DM  , SZ_WUQ = (size_t)1536 * 512 * 2, SZ_WUKV = (size_t)2048 * 512 * 2, SZ_WB = (size_t)3 * 2048 * 1024 * 2, SZ_WO = (size_t)2048 * 2048 * 2;
constexpr size_t SZ_WLAYER = SZ_WIN + SZ_WUQ + SZ_WUKV + SZ_WB + SZ_WO;
constexpr size_t WS_W = CTL_BYTES;
constexpr size_t WS_COS = WS_W + SZ_WLAYER, WS_SIN = WS_COS + (size_t)MTOK * 32 * 4;
constexpr size_t WS_H = WS_SIN + (size_t)MTOK * 32 * 4;
constexpr size_t WS_MG = WS_H;
constexpr size_t WS_PROJ = WS_H + (size_t)MP * DM * 2;
constexpr size_t WS_XB = WS_PROJ + (size_t)MP * NPROJ * 2;
constexpr size_t WS_SSQ = WS_XB + (size_t)MP * 2048;
constexpr size_t WS_Q = WS_SSQ + al256((size_t)3 * MP * 4);
constexpr size_t WS_KV = WS_Q + (size_t)MP * 1536 * 2;
constexpr size_t WS_K = WS_KV + (size_t)MP * 2048 * 2;
constexpr size_t WS_YA = WS_K + (size_t)MP * 1536 * 2;
constexpr size_t WS_YB = WS_YA + (size_t)MP * 1024 * 2;
constexpr size_t WS_DL = WS_YA;
constexpr size_t WS_YC = WS_YB + (size_t)MP * 1024 * 2;
constexpr size_t WS_OC = WS_YC + (size_t)MP * 1024 * 2;
constexpr size_t WS_QE = WS_OC + (size_t)MP * 1024 * 4;
constexpr size_t WS_KE = WS_QE + (size_t)MP * 512 * 2, WS_KL = WS_KE + (size_t)MP * 512 * 2;
constexpr size_t WS_HN = WS_KV;
constexpr size_t WS_H8 = WS_KE;
constexpr size_t WS_DS = WS_KL + (size_t)MP * 512 * 2;
constexpr size_t WS_END = WS_DS + (size_t)(MP / 128) * 512 * 4;
static_assert(WS_END <= ((size_t)1 << 30), "workspace map exceeds 1 GiB");

constexpr int LDS_BYTES = 147456;
constexpr int LDSCTL_OFF = LDS_BYTES - 256;
constexpr int CW_BAR = 4096;

__device__ __forceinline__ float bf2f(unsigned v) { return __uint_as_float(v << 16); }
__device__ __forceinline__ unsigned f2bf(float f) { unsigned u = __float_as_uint(f); return (u + 0x7fffu + ((u >> 16) & 1u)) >> 16; }
__device__ __forceinline__ unsigned pk2(float lo, float hi) { return f2bf(lo) | (f2bf(hi) << 16); }
__device__ __forceinline__ float lo16(unsigned w) { return __uint_as_float(w << 16); }
__device__ __forceinline__ float hi16(unsigned w) { return __uint_as_float(w & 0xffff0000u); }
__device__ __forceinline__ float sigmoid_f(float x) { return 1.f / (1.f + __expf(-x)); }
__device__ __forceinline__ float silu_f(float x) { return x / (1.f + __expf(-x)); }
__device__ __forceinline__ float gelu_f(float x) { const float u2 = 1.5957691216057308f * (x + 0.044715f * x * x * x); return x * __builtin_amdgcn_rcpf(1.f + __expf(-u2)); }
template <int O> __device__ __forceinline__ float lane_xor(float v) {
    if (O == 1) return __uint_as_float((unsigned)__builtin_amdgcn_mov_dpp((int)__float_as_uint(v), 0xB1, 0xf, 0xf, true));
    if (O == 2) return __uint_as_float((unsigned)__builtin_amdgcn_mov_dpp((int)__float_as_uint(v), 0x4E, 0xf, 0xf, true));
    return __uint_as_float((unsigned)__builtin_amdgcn_ds_swizzle((int)__float_as_uint(v), (O << 10) | 0x1f)); }
__device__ __forceinline__ float lane_xor32(float v, int lane) {
    auto rr = __builtin_amdgcn_permlane32_swap(__float_as_uint(v), __float_as_uint(v), false, false);
    return __uint_as_float(lane < 32 ? rr[1] : rr[0]); }
__device__ __forceinline__ float wave_sum(float v) {
    v += lane_xor<1>(v); v += lane_xor<2>(v); v += lane_xor<4>(v); v += lane_xor<8>(v); v += lane_xor<16>(v);
    auto rr = __builtin_amdgcn_permlane32_swap(__float_as_uint(v), __float_as_uint(v), false, false);
    return __uint_as_float(rr[0]) + __uint_as_float(rr[1]); }
__device__ __forceinline__ float wave_max(float v) {
    v = fmaxf(v, lane_xor<1>(v)); v = fmaxf(v, lane_xor<2>(v)); v = fmaxf(v, lane_xor<4>(v)); v = fmaxf(v, lane_xor<8>(v)); v = fmaxf(v, lane_xor<16>(v));
    auto rr = __builtin_amdgcn_permlane32_swap(__float_as_uint(v), __float_as_uint(v), false, false);
    return fmaxf(__uint_as_float(rr[0]), __uint_as_float(rr[1])); }
#define LDS_FENCE() asm volatile("s_waitcnt lgkmcnt(0)" ::: "memory")

struct Args { const void* in[18]; float* out; unsigned char* ws; int lo, hi, pad0, pad1; };

template <int MODE> __device__ __forceinline__ int src_col(int n) {
    if (MODE == 0) return n;
    if (MODE == 2) n += NBF;
    if (n < C_VB) return 2112 + n;
    if (n < C_ZB) return 3136 + (n - C_VB);
    if (n < C_QC) return 4160 + (n - C_ZB);
    if (n < C_KC) return 5184 + (n - C_QC);
    if (n < C_VC) return 5696 + (n - C_KC);
    if (n < C_ZC) return 6208 + (n - C_VC);
    if (n < C_KROPE) return 7248 + (n - C_ZC);
    if (n < C_AR) return 1024 + (n - C_KROPE);
    if (n < C_AR + 16) return 7232 + (n - C_AR);
    if (n < C_CQ) return -1;
    if (n < C_CKV) return n - C_CQ;
    if (n < C_ZA) return 512 + (n - C_CKV);
    if (n < C_GATE) return 1088 + (n - C_ZA);
    return 8272 + (n - C_GATE);
}
template <int MODE> __device__ __forceinline__ void convert_T(const float* W, int K, int Nsrc, bf16* WT, int Ndst, LAS float* tile, int vb, int nvb, const float* kscale = nullptr, int kmask = -1) {
    const int tid = otid(), ntk = K / 64, ntn = Ndst / 64, ntiles = ntk * ntn;
    for (int t = vb; t < ntiles; t += nvb) {
        const int k0 = (t % ntk) * 64, n0 = (t / ntk) * 64;
        { const int nn = tid & 63, sc = src_col<MODE>(n0 + nn), scc = sc >= 0 ? sc : 0; const float mul = sc >= 0 ? 1.f : 0.f;
          float v[8];
#pragma unroll
          for (int i = 0; i < 8; ++i) v[i] = W[(size_t)(k0 + (tid >> 6) + 8 * i) * Nsrc + scc];
          if (kscale) {
#pragma unroll
              for (int i = 0; i < 8; ++i) v[i] *= kscale[(k0 + (tid >> 6) + 8 * i) & kmask]; }
#pragma unroll
          for (int i = 0; i < 8; ++i) tile[((tid >> 6) + 8 * i) * 65 + nn] = v[i] * mul; }
        __syncthreads();
        { const int nn = tid & 63, kg = tid >> 6;
          const LAS float* tp = tile + (kg * 8) * 65 + nn;
          v4u o; o.x = pk2(tp[0], tp[65]); o.y = pk2(tp[2 * 65], tp[3 * 65]); o.z = pk2(tp[4 * 65], tp[5 * 65]); o.w = pk2(tp[6 * 65], tp[7 * 65]);
          *(v4u*)(WT + (size_t)(n0 + nn) * K + k0 + kg * 8) = o; }
        __syncthreads();
    }
}

template <int MODE> __device__ __forceinline__ void convert_T8(const float* W, int K, int Nsrc, unsigned char* WT, int Ndst, float wscale, LAS float* tile, int vb, int nvb, const float* kscale = nullptr) {
    const int tid = otid(), ntk = K / 64, ntn = Ndst / 64, ntiles = ntk * ntn;
    for (int t = vb; t < ntiles; t += nvb) {
        const int k0 = (t % ntk) * 64, n0 = (t / ntk) * 64;
        { const int nn = tid & 63;
          const int sc = src_col<MODE>(n0 + nn);
#pragma unroll
          for (int i = 0; i < 8; ++i) { const int kk = (tid >> 6) + 8 * i; tile[kk * 65 + nn] = W[(size_t)(k0 + kk) * Nsrc + sc] * (kscale ? wscale * kscale[k0 + kk] : wscale); } }
        __syncthreads();
        { const int nn = tid & 63, kg = tid >> 6;
          const LAS float* tp = tile + (kg * 8) * 65 + nn;
          unsigned w0 = 0u, w1 = 0u;
          w0 = __builtin_amdgcn_cvt_pk_fp8_f32(tp[0], tp[65], w0, false); w0 = __builtin_amdgcn_cvt_pk_fp8_f32(tp[2 * 65], tp[3 * 65], w0, true);
          w1 = __builtin_amdgcn_cvt_pk_fp8_f32(tp[4 * 65], tp[5 * 65], w1, false); w1 = __builtin_amdgcn_cvt_pk_fp8_f32(tp[6 * 65], tp[7 * 65], w1, true);
          *(v2u*)(WT + (size_t)(n0 + nn) * K + k0 + kg * 8) = (v2u){w0, w1}; }
        __syncthreads();
    }
}

__device__ __forceinline__ void ph_norm(const float* xin, const float* g, bf16* h, unsigned char* h8, int rows, int vb, int nvb) {
    const int tid_ = otid(); const int lane = tid_ & 63, wave = tid_ >> 6;
    for (int r = vb * 8 + wave; r < rows; r += nvb * 16) {
        const int r2 = r + nvb * 8; const bool two = r2 < rows; const int rb = two ? r2 : r;
        const v4f* xr = (const v4f*)(xin + (size_t)r * DM); const v4f* xs = (const v4f*)(xin + (size_t)rb * DM);
        v4f v[8], u[8]; float ss = 0.f, st = 0.f;
#pragma unroll
        for (int j = 0; j < 8; ++j) { v[j] = xr[lane + 64 * j]; u[j] = xs[lane + 64 * j]; }
#pragma unroll
        for (int j = 0; j < 8; ++j) { ss += v[j].x * v[j].x + v[j].y * v[j].y + v[j].z * v[j].z + v[j].w * v[j].w; st += u[j].x * u[j].x + u[j].y * u[j].y + u[j].z * u[j].z + u[j].w * u[j].w; }
        ss = wave_sum(ss); st = wave_sum(st);
        const float rn = 1.0f / sqrtf(ss * (1.0f / DM) + EPS), rm = 1.0f / sqrtf(st * (1.0f / DM) + EPS);
#pragma unroll
        for (int j = 0; j < 8; ++j) { const v4f gg = ((const v4f*)g)[lane + 64 * j];
            { const float y0 = v[j].x * rn * gg.x, y1 = v[j].y * rn * gg.y, y2 = v[j].z * rn * gg.z, y3 = v[j].w * rn * gg.w;
              v2u o; o.x = pk2(y0, y1); o.y = pk2(y2, y3);
              *(v2u*)(h + (size_t)r * DM + (lane + 64 * j) * 4) = o;
              unsigned w8 = 0u; w8 = __builtin_amdgcn_cvt_pk_fp8_f32(y0, y1, w8, false); w8 = __builtin_amdgcn_cvt_pk_fp8_f32(y2, y3, w8, true);
              *(unsigned*)(h8 + (size_t)r * DM + (lane + 64 * j) * 4) = w8; }
            if (two) { const float y0 = u[j].x * rm * gg.x, y1 = u[j].y * rm * gg.y, y2 = u[j].z * rm * gg.z, y3 = u[j].w * rm * gg.w;
              v2u o; o.x = pk2(y0, y1); o.y = pk2(y2, y3);
              *(v2u*)(h + (size_t)r2 * DM + (lane + 64 * j) * 4) = o;
              unsigned w8 = 0u; w8 = __builtin_amdgcn_cvt_pk_fp8_f32(y0, y1, w8, false); w8 = __builtin_amdgcn_cvt_pk_fp8_f32(y2, y3, w8, true);
              *(unsigned*)(h8 + (size_t)r2 * DM + (lane + 64 * j) * 4) = w8; } }
    }
}
__device__ __forceinline__ float row16_sum(float v) {
    v += __uint_as_float((unsigned)__builtin_amdgcn_mov_dpp((int)__float_as_uint(v), 0xB1, 0xf, 0xf, true));
    v += __uint_as_float((unsigned)__builtin_amdgcn_mov_dpp((int)__float_as_uint(v), 0x4E, 0xf, 0xf, true));
    v += __uint_as_float((unsigned)__builtin_amdgcn_mov_dpp((int)__float_as_uint(v), 0x141, 0xf, 0xf, true));
    v += __uint_as_float((unsigned)__builtin_amdgcn_mov_dpp((int)__float_as_uint(v), 0x140, 0xf, 0xf, true));
    return v; }
__device__ __forceinline__ void ph_vt8(const unsigned char* kv, unsigned char* V8T, int vb, int nvb) {
    const int tid = otid(), quad = tid & 31, oct = tid >> 5, g = quad >> 3, u = quad & 7, key0 = 32 * g + (u < 4 ? 8 * u : 8 * (u - 4) + 4);
    constexpr int NI = NBP * 8 * (SEQ / 128);
    for (int it0 = vb; it0 < NI; it0 += 2 * nvb) {
        v2u w[2][4];
#pragma unroll
        for (int q = 0; q < 2; ++q) { const int itq = it0 + q * nvb, it = itq < NI ? itq : it0; const int bh = it / (SEQ / 128), blk = it - bh * (SEQ / 128), bl = bh >> 3, h = bh & 7;
            const unsigned char* src = kv + (size_t)(bl * SEQ + blk * 128 + key0) * 2048 + h * 256 + 128 + oct * 8;
#pragma unroll
            for (int kk = 0; kk < 4; ++kk) w[q][kk] = *(const v2u*)(src + (size_t)kk * 2048); }
#pragma unroll
        for (int q = 0; q < 2; ++q) { const int it = it0 + q * nvb; if (it < NI) { const int bh = it / (SEQ / 128), blk = it - bh * (SEQ / 128);
            unsigned char* dst = V8T + ((size_t)bh * 128 + oct * 8) * SEQ + blk * 128 + quad * 4;
#pragma unroll
            for (int j = 0; j < 8; ++j) {
                const unsigned e0 = j < 4 ? w[q][0].x : w[q][0].y, e1 = j < 4 ? w[q][1].x : w[q][1].y, e2 = j < 4 ? w[q][2].x : w[q][2].y, e3 = j < 4 ? w[q][3].x : w[q][3].y;
                const unsigned sel = (unsigned)(((4 + (j & 3)) << 8) | (j & 3)) | 0x0c0c0000u;
                const unsigned t01 = __builtin_amdgcn_perm(e1, e0, sel), t23 = __builtin_amdgcn_perm(e3, e2, sel);
                *(unsigned*)(dst + (size_t)j * SEQ) = t01 | (t23 << 16); } } }
    }
}
__device__ __forceinline__ float f8v(const v2u w, int j) { const int d = (int)(j < 4 ? w.x : w.y); const int b = j & 3;
    return (b == 0 ? __builtin_amdgcn_cvt_f32_fp8(d, 0) : b == 1 ? __builtin_amdgcn_cvt_f32_fp8(d, 1) : b == 2 ? __builtin_amdgcn_cvt_f32_fp8(d, 2) : __builtin_amdgcn_cvt_f32_fp8(d, 3)) * 0.125f; }
#define KPOS(ch) (64 * ((ch) >> 3) + 32 * ((ch) & 1) + 8 * (((ch) >> 1) & 3))
__device__ __forceinline__ v2u pk8_fp8(const float (&x)[8]) {
    int a = __builtin_amdgcn_cvt_pk_fp8_f32(x[0], x[1], 0, false); a = __builtin_amdgcn_cvt_pk_fp8_f32(x[2], x[3], a, true);
    int b = __builtin_amdgcn_cvt_pk_fp8_f32(x[4], x[5], 0, false); b = __builtin_amdgcn_cvt_pk_fp8_f32(x[6], x[7], b, true);
    v2u w; w.x = (unsigned)a; w.y = (unsigned)b; return w; }
__device__ __forceinline__ void ph_kfin(const unsigned char* kv, const bf16* proj, unsigned char* K, const float* kg, const float* cosT, const float* sinT, int row0, int vb, int nvb) {
    const int tid_ = otid(); const int lane = tid_ & 63, wave = tid_ >> 6, g16 = lane >> 4, c = lane & 15;
    float gn[8], gr[8];
#pragma unroll
    for (int j = 0; j < 8; ++j) { gn[j] = kg[c * 8 + j]; gr[j] = kg[128 + (c & 7) * 8 + j]; }
    constexpr int NR = 2;
    for (int rbase = vb * 8 + wave; rbase < MP; rbase += nvb * 8 * NR) {
        v2u n0_[NR], n1_[NR]; v4u rw_[NR]; v4f c0_[NR], c1_[NR], s0_[NR], s1_[NR];
#pragma unroll
        for (int q = 0; q < NR; ++q) { const int rq = rbase + q * nvb * 8; const int r = rq < MP ? rq : rbase;
            n0_[q] = *(const v2u*)(kv + (size_t)r * 2048 + g16 * 256 + c * 8); n1_[q] = *(const v2u*)(kv + (size_t)r * 2048 + (g16 + 4) * 256 + c * 8);
            rw_[q] = *(const v4u*)(proj + (size_t)r * NPROJ + C_KROPE + (c & 7) * 8);
            c0_[q] = *(const v4f*)(cosT + (size_t)(row0 + r) * 32 + (c & 3) * 8); c1_[q] = *(const v4f*)(cosT + (size_t)(row0 + r) * 32 + (c & 3) * 8 + 4);
            s0_[q] = *(const v4f*)(sinT + (size_t)(row0 + r) * 32 + (c & 3) * 8); s1_[q] = *(const v4f*)(sinT + (size_t)(row0 + r) * 32 + (c & 3) * 8 + 4); }
#pragma unroll
        for (int q = 0; q < NR; ++q) { const int r = rbase + q * nvb * 8; if (r < MP) {
        const v2u n0 = n0_[q], n1 = n1_[q]; const v4u rw = rw_[q]; const v4f c0 = c0_[q], c1 = c1_[q], s0 = s0_[q], s1 = s1_[q];
        float a[8] = {f8v(n0, 0), f8v(n0, 1), f8v(n0, 2), f8v(n0, 3), f8v(n0, 4), f8v(n0, 5), f8v(n0, 6), f8v(n0, 7)};
        float b[8] = {f8v(n1, 0), f8v(n1, 1), f8v(n1, 2), f8v(n1, 3), f8v(n1, 4), f8v(n1, 5), f8v(n1, 6), f8v(n1, 7)};
        float kr[8] = {lo16(rw.x), hi16(rw.x), lo16(rw.y), hi16(rw.y), lo16(rw.z), hi16(rw.z), lo16(rw.w), hi16(rw.w)};
        const float cs[8] = {c0.x, c0.y, c0.z, c0.w, c1.x, c1.y, c1.z, c1.w}, sn[8] = {s0.x, s0.y, s0.z, s0.w, s1.x, s1.y, s1.z, s1.w};
        float sa = 0.f, sb = 0.f, sr = 0.f;
#pragma unroll
        for (int j = 0; j < 8; ++j) { sa += a[j] * a[j]; sb += b[j] * b[j]; sr += kr[j] * kr[j]; }
        if (c >= 8) sr = 0.f;
        sa = row16_sum(sa); sb = row16_sum(sb); sr = row16_sum(sr);
        const float rna = 1.0f / sqrtf((sa + sr) * (1.0f / 192.f) + EPS), rnb = 1.0f / sqrtf((sb + sr) * (1.0f / 192.f) + EPS);
        float R[8];
#pragma unroll
        for (int j = 0; j < 8; ++j) { const float mine = kr[j] * gr[j]; const float oth = lane_xor<4>(mine);
            R[j] = (c & 4) ? mine * cs[j] + oth * sn[j] : mine * cs[j] - oth * sn[j]; }
        unsigned char* ka = K + ((size_t)r * 8 + g16) * 192; unsigned char* kb = K + ((size_t)r * 8 + g16 + 4) * 192;
        { float x[8], y[8];
#pragma unroll
          for (int j = 0; j < 8; ++j) { x[j] = a[j] * rna * gn[j] * 8.0f; y[j] = b[j] * rnb * gn[j] * 8.0f; }
          *(v2u*)(ka + KPOS(c)) = pk8_fp8(x); *(v2u*)(kb + KPOS(c)) = pk8_fp8(y); }
        if (c < 8) { float x[8], y[8];
#pragma unroll
          for (int j = 0; j < 8; ++j) { x[j] = R[j] * rna * 8.0f; y[j] = R[j] * rnb * 8.0f; }
          *(v2u*)(ka + KPOS(16 + c)) = pk8_fp8(x); *(v2u*)(kb + KPOS(16 + c)) = pk8_fp8(y); }
        } }
    }
}

namespace at {
typedef short bf16x8 __attribute__((ext_vector_type(8)));
typedef short s16x4 __attribute__((ext_vector_type(4)));
typedef float f32x16 __attribute__((ext_vector_type(16)));
typedef unsigned u32x4 __attribute__((ext_vector_type(4)));
constexpr int SHM_V = 16384, SHM_K = 16384, SHM_KR = 8192;
constexpr int OFF_V = 0, OFF_K = 3 * SHM_V, OFF_KR = OFF_K + 2 * SHM_K, OFF_WS = OFF_KR + 2 * SHM_KR, LDS_NEED = OFF_WS + 8 * 64 * 4;
constexpr float SCALE = 0.07216878364870322f;
constexpr float THR = 4.f;
#define AT_KSWZ(row, colB) ((row) * 256 + ((colB) ^ (((row) & 7) << 4)))
#define AT_KRSWZ(row, colB) ((row) * 128 + ((colB) ^ (((row) & 7) << 4)))
#define AT_SBAR() __builtin_amdgcn_sched_barrier(0)
__device__ __forceinline__ int v_st(int k, int c) { const int kk = (k & ~0xC) | ((k & 4) << 1) | ((k & 8) >> 1); return ((kk >> 3) * 4 + (c >> 5)) * 512 + ((kk & 7) * 32 + (c & 31)) * 2; }
__device__ __forceinline__ int v_rd_base(int lane) { return ((lane & 3) << 3) | (((lane >> 2) & 3) << 6) | (((lane >> 4) & 1) << 5) | (((lane >> 5) & 1) << 8); }
constexpr int v_rd_off(int d0, int ks, int half) { return d0 * 512 + ks * 4096 + half * 2048; }
__device__ __forceinline__ int crow(int r, int hi) { return (r & 3) + 8 * (r >> 2) + 4 * hi; }
__device__ __forceinline__ unsigned cvtpk(float lo, float hi) { unsigned r; asm("v_cvt_pk_bf16_f32 %0, %1, %2" : "=v"(r) : "v"(lo), "v"(hi)); return r; }

__device__ __forceinline__ void mask_tile(f32x16& p0, f32x16& p1, int dq) {
    const float NEG = -__builtin_inff();
#pragma unroll
    for (int r = 0; r < 16; ++r) { const int c = (r & 3) + 8 * (r >> 2); if (dq < c) p0[r] = NEG; if (dq < c + 32) p1[r] = NEG; }
}
__device__ __forceinline__ void partialSM(f32x16& p0, f32x16& p1, float& m_reg, float& mn, float& alpha) {
    float pmax = p0[0];
#pragma unroll
    for (int r = 1; r < 16; ++r) pmax = fmaxf(pmax, p0[r]);
#pragma unroll
    for (int r = 0; r < 16; ++r) pmax = fmaxf(pmax, p1[r]);
    { auto rr = __builtin_amdgcn_permlane32_swap(__float_as_uint(pmax), __float_as_uint(pmax), false, false);
      pmax = fmaxf(__uint_as_float(rr[0]), __uint_as_float(rr[1])); }
    constexpr float C2 = 1.4426950408889634f * SCALE;
    if (__builtin_expect(__all((pmax - m_reg) * SCALE <= THR), 1)) { mn = m_reg; alpha = 1.f; }
    else { mn = fmaxf(m_reg, pmax); alpha = __builtin_amdgcn_exp2f((m_reg - mn) * C2); m_reg = mn; }
    const float mnL = 2.0f - mn * C2;
#pragma unroll
    for (int r = 0; r < 16; ++r) p0[r] = fmaf(p0[r], C2, mnL);
#pragma unroll
    for (int r = 0; r < 16; ++r) p1[r] = fmaf(p1[r], C2, mnL);
#pragma unroll
    for (int r = 0; r < 16; ++r) p0[r] = __builtin_amdgcn_exp2f(p0[r]);
}
__device__ __forceinline__ void finishSM(f32x16& p0, f32x16& p1, float alpha, float& l_reg, bf16x8& pa0, bf16x8& pa1, bf16x8& pa2, bf16x8& pa3) {
#pragma unroll
    for (int r = 0; r < 16; ++r) p1[r] = __builtin_amdgcn_exp2f(p1[r]);
    float ps = 0;
#pragma unroll
    for (int r = 0; r < 16; ++r) ps += p0[r];
#pragma unroll
    for (int r = 0; r < 16; ++r) ps += p1[r];
    { auto rr = __builtin_amdgcn_permlane32_swap(__float_as_uint(ps), __float_as_uint(ps), false, false);
      ps = __uint_as_float(rr[0]) + __uint_as_float(rr[1]); }
    l_reg = l_reg * alpha + ps;
#define AT_PK4(P, B_, OUT) do { unsigned a0 = cvtpk(P[B_+0], P[B_+1]), a1 = cvtpk(P[B_+2], P[B_+3]);                          \
        unsigned b0 = cvtpk(P[B_+4], P[B_+5]), b1 = cvtpk(P[B_+6], P[B_+7]);                                             \
        auto r0 = __builtin_amdgcn_permlane32_swap(a0, b0, false, false); auto r1 = __builtin_amdgcn_permlane32_swap(a1, b1, false, false); \
        u32x4 w = {r0[0], r1[0], r0[1], r1[1]}; OUT = *reinterpret_cast<bf16x8*>(&w); } while (0)
    AT_PK4(p0, 0, pa0); AT_PK4(p0, 8, pa1); AT_PK4(p1, 0, pa2); AT_PK4(p1, 8, pa3);
#undef AT_PK4
}
typedef int i32x8 __attribute__((ext_vector_type(8)));
typedef int i32x4 __attribute__((ext_vector_type(4)));
__device__ __forceinline__ void finishSM8(f32x16& p0, f32x16& p1, float alpha, float& l_reg, i32x8& pop) {
#pragma unroll
    for (int r = 0; r < 16; ++r) p1[r] = __builtin_amdgcn_exp2f(p1[r]);
    float ps = 0;
#pragma unroll
    for (int r = 0; r < 16; ++r) ps += p0[r];
#pragma unroll
    for (int r = 0; r < 16; ++r) ps += p1[r];
    { auto rr = __builtin_amdgcn_permlane32_swap(__float_as_uint(ps), __float_as_uint(ps), false, false);
      ps = __uint_as_float(rr[0]) + __uint_as_float(rr[1]); }
    l_reg = l_reg * alpha + ps;
#pragma unroll
    for (int a = 0; a < 4; ++a) {
        int d0 = __builtin_amdgcn_cvt_pk_fp8_f32(p0[4 * a], p0[4 * a + 1], 0, false); d0 = __builtin_amdgcn_cvt_pk_fp8_f32(p0[4 * a + 2], p0[4 * a + 3], d0, true);
        int d1 = __builtin_amdgcn_cvt_pk_fp8_f32(p1[4 * a], p1[4 * a + 1], 0, false); d1 = __builtin_amdgcn_cvt_pk_fp8_f32(p1[4 * a + 2], p1[4 * a + 3], d1, true);
        auto sw = __builtin_amdgcn_permlane32_swap((unsigned)d0, (unsigned)d1, false, false);
        pop[a] = (int)sw[0]; pop[4 + a] = (int)sw[1]; }
}
constexpr int V8_PITCH = 80, SHM_V8 = 128 * V8_PITCH;
__device__ __forceinline__ void pv8(f32x16* o, const LAS unsigned char* vimg, int r32, int hi, const i32x8 pop) {
    const LAS unsigned char* a0 = vimg + r32 * V8_PITCH + hi * 32;
    i32x8 f[4];
#pragma unroll
    for (int d0 = 0; d0 < 4; ++d0) f[d0] = __builtin_shufflevector(*(const LAS i32x4*)(a0 + d0 * 32 * V8_PITCH), *(const LAS i32x4*)(a0 + d0 * 32 * V8_PITCH + 16), 0, 1, 2, 3, 4, 5, 6, 7);
#pragma unroll
    for (int d0 = 0; d0 < 4; ++d0) o[d0] = __builtin_amdgcn_mfma_scale_f32_32x32x64_f8f6f4(f[d0], pop, o[d0], 0, 0, 0, 0x7f7f7f7f, 0, 0x7f7f7f7f);
}
constexpr int K8_PITCH = 208, SHM_K8 = 64 * K8_PITCH;
__device__ __forceinline__ void qkt8(f32x16& p0, f32x16& p1, const LAS unsigned char* Kb, int r32, int hi, const i32x8* q8) {
    p0 = f32x16{}; p1 = f32x16{};
    const LAS unsigned char* a0 = Kb + r32 * K8_PITCH + hi * 32;
    i32x8 f[6];
#pragma unroll
    for (int b = 0; b < 3; ++b) {
        f[2 * b] = __builtin_shufflevector(*(const LAS i32x4*)(a0 + 64 * b), *(const LAS i32x4*)(a0 + 64 * b + 16), 0, 1, 2, 3, 4, 5, 6, 7);
        f[2 * b + 1] = __builtin_shufflevector(*(const LAS i32x4*)(a0 + 32 * K8_PITCH + 64 * b), *(const LAS i32x4*)(a0 + 32 * K8_PITCH + 64 * b + 16), 0, 1, 2, 3, 4, 5, 6, 7); }
#pragma unroll
    for (int b = 0; b < 3; ++b) {
        p0 = __builtin_amdgcn_mfma_scale_f32_32x32x64_f8f6f4(f[2 * b], q8[b], p0, 0, 0, 0, 0x7c7c7c7c, 0, 0x7c7c7c7c);
        p1 = __builtin_amdgcn_mfma_scale_f32_32x32x64_f8f6f4(f[2 * b + 1], q8[b], p1, 0, 0, 0, 0x7c7c7c7c, 0, 0x7c7c7c7c); }
    __builtin_amdgcn_sched_group_barrier(0x100, 8, 0); __builtin_amdgcn_sched_group_barrier(0x008, 2, 0); __builtin_amdgcn_sched_group_barrier(0x100, 4, 0); __builtin_amdgcn_sched_group_barrier(0x008, 4, 0);
}
__device__ __forceinline__ void qkt(f32x16& p0, f32x16& p1, const LAS unsigned char* Kb, const LAS unsigned char* KRb, int r32, int hi, const bf16x8* qr) {
    p0 = f32x16{}; p1 = f32x16{};
    const LAS unsigned char* kb[4]; const LAS unsigned char* krb[4];
#pragma unroll
    for (int dd = 0; dd < 4; ++dd) { kb[dd] = Kb + AT_KSWZ(r32, (dd * 16 + hi * 8) * 2); krb[dd] = KRb + AT_KRSWZ(r32, (dd * 16 + hi * 8) * 2); }
    bf16x8 f[24];
#pragma unroll
    for (int d0 = 0; d0 < 8; ++d0) { const LAS unsigned char* a = kb[d0 & 3] + (d0 >> 2) * 128;
        f[2 * d0] = *reinterpret_cast<const LAS bf16x8*>(a); f[2 * d0 + 1] = *reinterpret_cast<const LAS bf16x8*>(a + 32 * 256); }
#pragma unroll
    for (int d0 = 0; d0 < 4; ++d0) { const LAS unsigned char* a = krb[d0];
        f[16 + 2 * d0] = *reinterpret_cast<const LAS bf16x8*>(a); f[16 + 2 * d0 + 1] = *reinterpret_cast<const LAS bf16x8*>(a + 32 * 128); }
#pragma unroll
    for (int d0 = 0; d0 < 12; ++d0) {
        p0 = __builtin_amdgcn_mfma_f32_32x32x16_bf16(f[2 * d0], qr[d0], p0, 0, 0, 0);
        p1 = __builtin_amdgcn_mfma_f32_32x32x16_bf16(f[2 * d0 + 1], qr[d0], p1, 0, 0, 0); }
    __builtin_amdgcn_sched_group_barrier(0x100, 4, 0);
#pragma unroll
    for (int i = 0; i < 20; ++i) { __builtin_amdgcn_sched_group_barrier(0x008, 1, 0); __builtin_amdgcn_sched_group_barrier(0x100, 1, 0); }
    __builtin_amdgcn_sched_group_barrier(0x008, 4, 0);
}
template <bool SWAP = false> __device__ __forceinline__ void pv_tile(f32x16* o, unsigned vb0, bf16x8 pa0, bf16x8 pa1, bf16x8 pa2, bf16x8 pa3) {
#define AT_TRRD(dst, off) asm volatile("ds_read_b64_tr_b16 %0, %1 offset:%2" : "=&v"(dst) : "v"(vb0), "i"(off) : "memory")
#define AT_PV_RD(d0, L, H) do { constexpr int b_ = v_rd_off(d0, 0, 0); \
        AT_TRRD(L[0], b_); AT_TRRD(H[0], b_ + 2048); AT_TRRD(L[1], b_ + 4096); AT_TRRD(H[1], b_ + 6144); AT_TRRD(L[2], b_ + 8192); AT_TRRD(H[2], b_ + 10240); AT_TRRD(L[3], b_ + 12288); AT_TRRD(H[3], b_ + 14336); } while (0)
#define AT_PV_M1(d0, P, L, H, q) do { const bf16x8 vf_ = (bf16x8){L[q][0], L[q][1], L[q][2], L[q][3], H[q][0], H[q][1], H[q][2], H[q][3]}; \
        if constexpr (SWAP) o[d0] = __builtin_amdgcn_mfma_f32_32x32x16_bf16(vf_, P, o[d0], 0, 0, 0); else o[d0] = __builtin_amdgcn_mfma_f32_32x32x16_bf16(P, vf_, o[d0], 0, 0, 0); } while (0)
#define AT_PV_MM(d0, L, H) do { AT_PV_M1(d0, pa0, L, H, 0); AT_PV_M1(d0, pa1, L, H, 1); AT_PV_M1(d0, pa2, L, H, 2); AT_PV_M1(d0, pa3, L, H, 3); } while (0)
    s16x4 la[4], ha[4], lb[4], hb[4];
    asm volatile("s_waitcnt lgkmcnt(0)" ::: "memory");
    AT_PV_RD(0, la, ha); AT_PV_RD(1, lb, hb);
    asm volatile("s_waitcnt lgkmcnt(8)" ::: "memory"); AT_SBAR(); AT_PV_MM(0, la, ha); AT_SBAR();
    AT_PV_RD(2, la, ha);
    asm volatile("s_waitcnt lgkmcnt(8)" ::: "memory"); AT_SBAR(); AT_PV_MM(1, lb, hb); AT_SBAR();
    AT_PV_RD(3, lb, hb);
    asm volatile("s_waitcnt lgkmcnt(8)" ::: "memory"); AT_SBAR(); AT_PV_MM(2, la, ha); AT_SBAR();
    asm volatile("s_waitcnt lgkmcnt(0)" ::: "memory"); AT_SBAR(); AT_PV_MM(3, lb, hb);
#undef AT_PV_RD
#undef AT_PV_MM
#undef AT_PV_M1
#undef AT_TRRD
}

__device__ __forceinline__ void attn_block(LAS unsigned char* lds, const unsigned char* Q, const unsigned char* K, const unsigned char* V8T, const bf16* proj, bf16* YA, const float* qg, const float* cosT, const float* sinT, int b, int h, int qb) {
    const int tid = otid(), wid = __builtin_amdgcn_readfirstlane(tid >> 6), lane = tid & 63, r32 = lane & 31, hi = lane >> 5;
    const int P0 = qb * 256, NT = 4 * (qb + 1), qlo = P0 + wid * 32;
    LAS unsigned char* V_lds = lds + OFF_V; LAS unsigned char* K_lds = lds + OFF_K;
    LAS float* wsf = (LAS float*)(lds + OFF_WS) + wid * 64; LAS float* li_l = wsf; LAS float* al_l = wsf + 32;
    i32x8 q8[3];
    { const unsigned char* qp = Q + ((size_t)(b * SEQ + qlo + r32) * 8 + h) * 192 + hi * 8;
      v2u raw[12];
#pragma unroll
      for (int d0 = 0; d0 < 12; ++d0) raw[d0] = *(const v2u*)(qp + d0 * 16);
      float ss = 0.f;
#pragma unroll
      for (int d0 = 0; d0 < 12; ++d0)
#pragma unroll
          for (int j = 0; j < 8; ++j) { const float v = f8v(raw[d0], j); ss += v * v; }
      { auto rr = __builtin_amdgcn_permlane32_swap(__float_as_uint(ss), __float_as_uint(ss), false, false); ss = __uint_as_float(rr[0]) + __uint_as_float(rr[1]); }
      const float rn = 1.0f / sqrtf(ss * (1.0f / 192.f) + EPS);
#pragma unroll
      for (int d0 = 0; d0 < 12; ++d0) asm volatile("" : "+v"(raw[d0]));
      const float* ct = cosT + (size_t)(b * SEQ + qlo + r32) * 32 + hi * 8; const float* st = sinT + (size_t)(b * SEQ + qlo + r32) * 32 + hi * 8;
#pragma unroll
      for (int d0 = 0; d0 < 8; ++d0) { const v4f g0 = *(const v4f*)(qg + d0 * 16 + hi * 8), g1 = *(const v4f*)(qg + d0 * 16 + hi * 8 + 4);
          const float g[8] = {g0.x, g0.y, g0.z, g0.w, g1.x, g1.y, g1.z, g1.w}; float x[8];
#pragma unroll
          for (int j = 0; j < 8; ++j) x[j] = f8v(raw[d0], j) * rn * g[j] * 8.0f;
          const v2u w = pk8_fp8(x); q8[d0 >> 2][2 * (d0 & 3)] = (int)w.x; q8[d0 >> 2][2 * (d0 & 3) + 1] = (int)w.y; }
#pragma unroll
      for (int d0 = 8; d0 < 10; ++d0) { const int i0 = (d0 - 8) * 16;
          const v4f ga0 = *(const v4f*)(qg + d0 * 16 + hi * 8), ga1 = *(const v4f*)(qg + d0 * 16 + hi * 8 + 4), gb0 = *(const v4f*)(qg + (d0 + 2) * 16 + hi * 8), gb1 = *(const v4f*)(qg + (d0 + 2) * 16 + hi * 8 + 4);
          const v4f c0 = *(const v4f*)(ct + i0), c1 = *(const v4f*)(ct + i0 + 4), s0 = *(const v4f*)(st + i0), s1 = *(const v4f*)(st + i0 + 4);
          const float ga[8] = {ga0.x, ga0.y, ga0.z, ga0.w, ga1.x, ga1.y, ga1.z, ga1.w}, gb[8] = {gb0.x, gb0.y, gb0.z, gb0.w, gb1.x, gb1.y, gb1.z, gb1.w};
          const float cs[8] = {c0.x, c0.y, c0.z, c0.w, c1.x, c1.y, c1.z, c1.w}, sn[8] = {s0.x, s0.y, s0.z, s0.w, s1.x, s1.y, s1.z, s1.w};
          float y1[8], y2[8];
#pragma unroll
          for (int j = 0; j < 8; ++j) { const float x1 = f8v(raw[d0], j) * rn * ga[j], x2 = f8v(raw[d0 + 2], j) * rn * gb[j];
              y1[j] = (x1 * cs[j] - x2 * sn[j]) * 8.0f; y2[j] = (x2 * cs[j] + x1 * sn[j]) * 8.0f; }
          const v2u w1 = pk8_fp8(y1), w2 = pk8_fp8(y2);
          q8[2][2 * (d0 & 3)] = (int)w1.x; q8[2][2 * (d0 & 3) + 1] = (int)w1.y; q8[2][2 * ((d0 + 2) & 3)] = (int)w2.x; q8[2][2 * ((d0 + 2) & 3) + 1] = (int)w2.y; }
    }
    const int vdv = tid >> 2, vc16 = (tid & 3) * 16;
    const int kr0 = tid / 12, kc0 = tid - 12 * kr0, kr1 = (tid + 512) / 12, kc1 = (tid + 512) - 12 * kr1;
    const bool k2 = tid < 256;
    const unsigned char* Kg = K + ((size_t)(b * SEQ) * 8 + h) * 192;
    const unsigned char* Vg = V8T + ((size_t)(b * 8 + h) * 128 + vdv) * SEQ + vc16;
    bf16x8 sa_k0, sa_k1 = {}, sa_v0, sb_k0, sb_k1 = {}, sb_v0;
#define AT_SLOAD(S, kb_) do { S##_k0 = *(const bf16x8*)(Kg + (size_t)((kb_) + kr0) * 1536 + kc0 * 16); if (k2) S##_k1 = *(const bf16x8*)(Kg + (size_t)((kb_) + kr1) * 1536 + kc1 * 16); \
        S##_v0 = *(const bf16x8*)(Vg + (kb_)); } while (0)
#define AT_SWRITE(S, bf, vbf) do { *(LAS bf16x8*)(K_lds + (bf) * SHM_K8 + kr0 * K8_PITCH + kc0 * 16) = S##_k0; if (k2) *(LAS bf16x8*)(K_lds + (bf) * SHM_K8 + kr1 * K8_PITCH + kc1 * 16) = S##_k1; \
        *(LAS bf16x8*)(V_lds + (vbf) * SHM_V8 + vdv * V8_PITCH + vc16) = S##_v0; } while (0)
    AT_SLOAD(sa, 0); AT_SLOAD(sb, 64); AT_SWRITE(sa, 0, 0);
    __syncthreads();
    float m_reg = -1e30f, l_reg = 0.f; f32x16 o[4] = {};
    const bool late = wid >= 4;
    bool pend = false; int pvb = 0; int vb3 = 0;
    i32x8 pop;
#define AT_STEP(t, SL, SW) do { \
        const int buf = (t) & 1, kb = (t) * 64; \
        if ((t) + 2 < NT) AT_SLOAD(SL, kb + 128);                         \
        if (late && pend) { pv8(o, V_lds + pvb * SHM_V8, r32, hi, pop); pend = false; AT_SBAR(); } \
        if (kb <= qlo + 31) { \
            f32x16 p0, p1; float mn, alpha; \
            qkt8(p0, p1, K_lds + buf * SHM_K8, r32, hi, q8); \
            if (kb + 63 > qlo) mask_tile(p0, p1, qlo + r32 - 4 * hi - kb); \
            partialSM(p0, p1, m_reg, mn, alpha); \
            finishSM8(p0, p1, alpha, l_reg, pop); \
            if (__any(alpha < 1.f)) { _Pragma("unroll") for (int d_ = 0; d_ < 4; ++d_) _Pragma("unroll") for (int r = 0; r < 16; ++r) o[d_][r] *= alpha; } \
            AT_SBAR(); \
            if (late) { pend = true; pvb = vb3; } \
            else pv8(o, V_lds + vb3 * SHM_V8, r32, hi, pop); \
        } \
        const int vn3 = vb3 == 2 ? 0 : vb3 + 1; \
        if ((t) + 1 < NT) AT_SWRITE(SW, buf ^ 1, vn3);                    \
        vb3 = vn3; \
        __syncthreads(); } while (0)
    for (int t = 0; t < NT; t += 2) { AT_STEP(t, sa, sb); AT_STEP(t + 1, sb, sa); }
#undef AT_STEP
    if (late && pend) pv8(o, V_lds + pvb * SHM_V8, r32, hi, pop);
    { const size_t row = (size_t)(b * SEQ + qlo + r32);
      const bf16* zp = proj + row * NPROJ + C_ZA + h * 128 + 8 * hi;
      u32x4 zw[8];
#pragma unroll
      for (int i = 0; i < 8; ++i) zw[i] = *(const u32x4*)(zp + 16 * i);
      const float rl = 2.0f / l_reg;
      unsigned char* yp = (unsigned char*)YA + row * 1024 + h * 128 + 8 * hi;
#pragma unroll
      for (int i = 0; i < 8; ++i) { const int d0 = i >> 1, j = i & 1;
          auto z0 = __builtin_amdgcn_permlane32_swap(zw[i].x, zw[i].z, false, false); auto z1 = __builtin_amdgcn_permlane32_swap(zw[i].y, zw[i].w, false, false);
          const unsigned z4[4] = {z0[0], z1[0], z0[1], z1[1]};
          float y[8];
#pragma unroll
          for (int k = 0; k < 4; ++k) { y[2 * k] = o[d0][8 * j + 2 * k] * rl * silu_f(__uint_as_float(z4[k] << 16)); y[2 * k + 1] = o[d0][8 * j + 2 * k + 1] * rl * silu_f(__uint_as_float(z4[k] & 0xffff0000u)); }
          int q0 = __builtin_amdgcn_cvt_pk_fp8_f32(y[0], y[1], 0, false); q0 = __builtin_amdgcn_cvt_pk_fp8_f32(y[2], y[3], q0, true);
          int q1 = __builtin_amdgcn_cvt_pk_fp8_f32(y[4], y[5], 0, false); q1 = __builtin_amdgcn_cvt_pk_fp8_f32(y[6], y[7], q1, true);
          auto sw = __builtin_amdgcn_permlane32_swap((unsigned)q0, (unsigned)q1, false, false);
          v2u w; w.x = sw[0]; w.y = sw[1]; *(v2u*)(yp + 16 * i) = w; } }
    asm volatile("s_waitcnt lgkmcnt(0)" ::: "memory");
    __syncthreads();
#undef AT_SLOAD
#undef AT_SWRITE
}
}


namespace sg {
using at::bf16x8; using at::f32x16;
__device__ __forceinline__ void sgu_item(LAS unsigned char* lds, const bf16* proj, const float* rv, const float* Ws, const float* bs, const float* vg, bf16* YB, int it) {
    const int tid = otid(), wid = __builtin_amdgcn_readfirstlane(tid >> 6), lane = tid & 63, r32 = lane & 31, hi = lane >> 5;
    {
        const int ch = it >> 2, gp = it & 3, R0 = ch * 128;
        { const int cc = tid & 15;
          v4f g0a = *(const v4f*)(vg + (2 * gp) * 128 + cc * 8), g0b = *(const v4f*)(vg + (2 * gp) * 128 + cc * 8 + 4), g1a = *(const v4f*)(vg + (2 * gp + 1) * 128 + cc * 8), g1b = *(const v4f*)(vg + (2 * gp + 1) * 128 + cc * 8 + 4);
#pragma unroll
          for (int i = 0; i < 8; ++i) {
            const int idx = tid + 512 * i, gsel = i >> 2, row = (idx >> 4) & 127;
            const v4u w = *(const v4u*)(proj + (size_t)(R0 + row) * NPROJ + C_VB + (2 * gp + gsel) * 128 + cc * 8);
            const float s = 1.0f / sqrtf(rv[R0 + row] * (1.0f / 1024.f) + EPS);
            const v4f ga = gsel ? g1a : g0a, gb = gsel ? g1b : g0b;
            v4u o; o.x = pk2(lo16(w.x) * (s * ga.x), hi16(w.x) * (s * ga.y)); o.y = pk2(lo16(w.y) * (s * ga.z), hi16(w.y) * (s * ga.w));
            o.z = pk2(lo16(w.z) * (s * gb.x), hi16(w.z) * (s * gb.y)); o.w = pk2(lo16(w.w) * (s * gb.z), hi16(w.w) * (s * gb.w));
            *(LAS v4u*)(lds + (gsel * 2 + (row >> 6)) * 16384 + at::v_st(row & 63, cc * 8)) = o;
          } }
        __syncthreads();
        const int gsel = wid >> 2, g = 2 * gp + gsel, t = 32 * (wid & 3) + r32;
        const size_t row = (size_t)(R0 + t);
        at::u32x4 uw[8], zw[8];
        { const bf16* up = proj + row * NPROJ + C_UB + g * 128 + 8 * hi; const bf16* zp = proj + row * NPROJ + C_ZB + g * 128 + 8 * hi;
#pragma unroll
          for (int i = 0; i < 8; ++i) { uw[i] = *(const at::u32x4*)(up + 16 * i); zw[i] = *(const at::u32x4*)(zp + 16 * i); } }
        const float bias = bs[g * 128 + t];
        f32x16 o[4] = {};
        const int nst = (wid & 3) >= 2 ? 2 : 1;
        for (int st = 0; st < nst; ++st) {
            bf16x8 pa[4];
#pragma unroll
            for (int ks = 0; ks < 4; ++ks) {
                const int s0 = st * 64 + ks * 16 + hi * 8;
                const float* wp = Ws + ((size_t)g * 128 + t) * 128 + s0;
                const v4f a = *(const v4f*)wp, b = *(const v4f*)(wp + 4);
                float x[8] = {a.x, a.y, a.z, a.w, b.x, b.y, b.z, b.w};
#pragma unroll
                for (int j = 0; j < 8; ++j) if (s0 + j > t) x[j] = 0.f;
                at::u32x4 w4 = {at::cvtpk(x[0], x[1]), at::cvtpk(x[2], x[3]), at::cvtpk(x[4], x[5]), at::cvtpk(x[6], x[7])};
                pa[ks] = *reinterpret_cast<bf16x8*>(&w4);
            }
            const unsigned vbase = (unsigned)(size_t)(lds + (gsel * 2 + st) * 16384) + (unsigned)at::v_rd_base(lane);
            at::pv_tile<true>(o, vbase, pa[0], pa[1], pa[2], pa[3]);
        }
        bf16* yp = YB + row * 1024 + g * 128 + 8 * hi;
#pragma unroll
        for (int i = 0; i < 8; ++i) { const int d0 = i >> 1, j = i & 1;
            auto u0 = __builtin_amdgcn_permlane32_swap(uw[i].x, uw[i].z, false, false); auto u1 = __builtin_amdgcn_permlane32_swap(uw[i].y, uw[i].w, false, false);
            auto z0 = __builtin_amdgcn_permlane32_swap(zw[i].x, zw[i].z, false, false); auto z1 = __builtin_amdgcn_permlane32_swap(zw[i].y, zw[i].w, false, false);
            const unsigned u4[4] = {u0[0], u1[0], u0[1], u1[1]}, z4[4] = {z0[0], z1[0], z0[1], z1[1]};
            unsigned p[4];
#pragma unroll
            for (int k = 0; k < 4; ++k) {
                const float y0 = lo16(u4[k]) * (o[d0][8 * j + 2 * k] + bias) * lo16(z4[k]);
                const float y1 = hi16(u4[k]) * (o[d0][8 * j + 2 * k + 1] + bias) * hi16(z4[k]);
                p[k] = at::cvtpk(y0, y1); }
            auto s0 = __builtin_amdgcn_permlane32_swap(p[0], p[2], false, false); auto s1 = __builtin_amdgcn_permlane32_swap(p[1], p[3], false, false);
            *(at::u32x4*)(yp + 16 * i) = (at::u32x4){s0[0], s1[0], s0[1], s1[1]}; }
        __syncthreads();
    }
}
}


namespace gl {
using at::bf16x8; using at::f32x16; using at::s16x4; using at::u32x4;
constexpr int OFF_VIMG = 0, OFF_KLIMG = 65536, OFF_ATT = 98304, OFF_DS = 131072, OFF_PART = 131584, LDS_NEED = OFF_PART + 4096;

__device__ __forceinline__ void gla_prep_item(LAS unsigned char* lds, int seg_off, const bf16* proj, const float* wa2, const float* ba, bf16* QE, bf16* KE, bf16* KL, float* DS, int ci) {
    const int tid = otid(), k2 = tid & 63, ts = tid >> 6, k = 2 * k2;
    LAS float* seg = (LAS float*)(lds + seg_off);
    {
        const int ch = ci >> 2, h = ci & 3, R0 = ch * 128 + ts * 16;
        float wa0[16], wa1[16];
#pragma unroll
        for (int j = 0; j < 16; ++j) { const v2f w = *(const v2f*)(wa2 + j * 512 + h * 128 + k); wa0[j] = w.x; wa1[j] = w.y; }
        const v2f bak = *(const v2f*)(ba + h * 128 + k);
        unsigned qw[16], kw[16];
#pragma unroll
        for (int i = 0; i < 16; ++i) { const size_t row = (size_t)(R0 + i); qw[i] = *(const unsigned*)(proj + row * NPROJ + C_QC + h * 128 + k); kw[i] = *(const unsigned*)(proj + row * NPROJ + C_KC + h * 128 + k); }
        float la0[16], la1[16]; float run0 = 0.f, run1 = 0.f;
#pragma unroll
        for (int i = 0; i < 16; ++i) {
            const bf16* pr = proj + (size_t)(R0 + i) * NPROJ + C_AR;
            const v4u w0 = *(const v4u*)pr, w1 = *(const v4u*)(pr + 8);
            const float ar[16] = {lo16(w0.x), hi16(w0.x), lo16(w0.y), hi16(w0.y), lo16(w0.z), hi16(w0.z), lo16(w0.w), hi16(w0.w),
                                  lo16(w1.x), hi16(w1.x), lo16(w1.y), hi16(w1.y), lo16(w1.z), hi16(w1.z), lo16(w1.w), hi16(w1.w)};
            float x0 = bak.x, x1 = bak.y;
#pragma unroll
            for (int j = 0; j < 16; ++j) { x0 += ar[j] * wa0[j]; x1 += ar[j] * wa1[j]; }
            run0 += (fminf(x0, 0.f) - __logf(1.0f + __expf(-fabsf(x0)))) * 0.0625f; la0[i] = run0;
            run1 += (fminf(x1, 0.f) - __logf(1.0f + __expf(-fabsf(x1)))) * 0.0625f; la1[i] = run1;
        }
        *(LAS v2f*)(seg + ts * 128 + k) = (v2f){run0, run1};
        __syncthreads();
        float pre0 = 0.f, pre1 = 0.f, tot0 = 0.f, tot1 = 0.f;
#pragma unroll
        for (int q = 0; q < 8; ++q) { const v2f sg = *(const LAS v2f*)(seg + q * 128 + k); tot0 += sg.x; tot1 += sg.y; if (q < ts) { pre0 += sg.x; pre1 += sg.y; } }
        const float et0 = __expf(tot0), et1 = __expf(tot1);
#pragma unroll
        for (int i = 0; i < 16; ++i) {
            const size_t o = (size_t)(R0 + i) * 512 + h * 128 + k;
            const float e0 = __expf(la0[i] + pre0), e1 = __expf(la1[i] + pre1), r0 = __builtin_amdgcn_rcpf(e0), r1 = __builtin_amdgcn_rcpf(e1);
            const float q0 = lo16(qw[i]) * 0.08838834764831845f, q1 = hi16(qw[i]) * 0.08838834764831845f, kk0 = lo16(kw[i]) * r0, kk1 = hi16(kw[i]) * r1;
            const int s = ts * 16 + i; const unsigned sw = (unsigned)(s * 256 + ((((k * 2) >> 4) ^ (s & 15)) << 4) + ((k * 2) & 15));
            const unsigned qe = pk2(q0 * e0, q1 * e1);
            *(unsigned*)(QE + o) = qe;
            *(LAS unsigned*)(lds + sw) = qe;
            *(LAS unsigned*)(lds + 32768 + sw) = pk2(kk0, kk1);
            *(LAS unsigned*)(lds + 65536 + (s >> 6) * 16384 + at::v_st(s & 63, k)) = pk2(kk0 * et0, kk1 * et1);
        }
        if (ts == 0) *(v2f*)(DS + ((size_t)ch * 4 + h) * 128 + k) = (v2f){et0, et1};
        asm volatile("s_waitcnt lgkmcnt(0)\n\ts_barrier" ::: "memory");
    }
}

#define GL_PK4(P, B_, OUT) do { unsigned a0 = at::cvtpk(P[B_+0], P[B_+1]), a1 = at::cvtpk(P[B_+2], P[B_+3]);                          \
        unsigned b0 = at::cvtpk(P[B_+4], P[B_+5]), b1 = at::cvtpk(P[B_+6], P[B_+7]);                                             \
        auto r0 = __builtin_amdgcn_permlane32_swap(a0, b0, false, false); auto r1 = __builtin_amdgcn_permlane32_swap(a1, b1, false, false); \
        u32x4 w = {r0[0], r1[0], r0[1], r1[1]}; OUT = *reinterpret_cast<bf16x8*>(&w); } while (0)
#define GL_TRRD(dst, addr, off) asm volatile("ds_read_b64_tr_b16 %0, %1 offset:%2" : "=&v"(dst) : "v"(addr), "i"(off) : "memory")

template <int TT> __device__ __forceinline__ void o_intra_tile(LAS unsigned char* lds, const bf16x8 (&vfr)[8], bf16* oi, int r32, int hi) {
    f32x16 acc = {};
    const int t = 32 * TT + r32;
    bf16x8 af[2 * TT + 2];
#pragma unroll
    for (int ks8 = 0; ks8 < 2 * TT + 2; ++ks8) af[ks8] = *(const LAS bf16x8*)(lds + OFF_ATT + t * 256 + (((16 * ks8 + 8 * hi) * 2) ^ ((t & 7) << 4)));
#pragma unroll
    for (int ks8 = 0; ks8 < 2 * TT + 2; ++ks8) acc = __builtin_amdgcn_mfma_f32_32x32x16_bf16(vfr[ks8], af[ks8], acc, 0, 0, 0);
    __builtin_amdgcn_sched_group_barrier(0x100, 2 * TT + 2, 0); __builtin_amdgcn_sched_group_barrier(0x008, 2 * TT + 2, 0);
    asm volatile("s_nop 15\n\ts_nop 15" : "+v"(acc));
#pragma unroll
    for (int hf = 0; hf < 2; ++hf) *(u32x4*)(oi + (size_t)(TT * 2 + hf) * 512) = (u32x4){at::cvtpk(acc[8 * hf], acc[8 * hf + 1]), at::cvtpk(acc[8 * hf + 2], acc[8 * hf + 3]), at::cvtpk(acc[8 * hf + 4], acc[8 * hf + 5]), at::cvtpk(acc[8 * hf + 6], acc[8 * hf + 7])};
}
__device__ __forceinline__ void gla_chunk_item(LAS unsigned char* lds, const bf16* proj, const bf16* QE, const bf16* KE, const bf16* KL, bf16* OI, bf16* DL, int ci) {
    const int tid = otid(), wid = __builtin_amdgcn_readfirstlane(tid >> 6), lane = tid & 63, r32 = lane & 31, hi = lane >> 5;
    const int h = ci & 3, R0 = (ci >> 2) * 128;
    {
        {
            v4u vr[8];
#pragma unroll
            for (int i = 0; i < 8; ++i) { const int idx = tid + 512 * i, s = idx >> 5, cc = idx & 31;
                vr[i] = *(const v4u*)(proj + (size_t)(R0 + s) * NPROJ + C_VC + h * 256 + cc * 8); }
#pragma unroll
            for (int j = 0; j < 2; ++j) {
                const int ti = 2 * wid + j, st = ti >> 2, tt = ti & 3;
                if (st <= tt) {
                    f32x16 p = {};
                    const int ra = 32 * st + r32, rb = 32 * tt + r32;
                    bf16x8 fa[8], fb[8];
#pragma unroll
                    for (int ks = 0; ks < 8; ++ks) { fa[ks] = *(const LAS bf16x8*)(lds + 32768 + ra * 256 + (((hi + 2 * ks) ^ (ra & 15)) << 4)); fb[ks] = *(const LAS bf16x8*)(lds + rb * 256 + (((hi + 2 * ks) ^ (rb & 15)) << 4)); }
#pragma unroll
                    for (int ks = 0; ks < 8; ++ks) p = __builtin_amdgcn_mfma_f32_32x32x16_bf16(fa[ks], fb[ks], p, 0, 0, 0);
                    __builtin_amdgcn_sched_group_barrier(0x100, 16, 0); __builtin_amdgcn_sched_group_barrier(0x008, 8, 0);
                    asm volatile("s_nop 15\n\ts_nop 15" : "+v"(p));
                    if (st == tt) {
#pragma unroll
                        for (int r = 0; r < 16; ++r) if (at::crow(r, hi) > r32) p[r] = 0.f; }
                    const int t = 32 * tt + r32;
#pragma unroll
                    for (int g = 0; g < 4; ++g) { v2u w; w.x = at::cvtpk(p[4 * g], p[4 * g + 1]); w.y = at::cvtpk(p[4 * g + 2], p[4 * g + 3]);
                        *(LAS v2u*)(lds + OFF_ATT + t * 256 + ((64 * st + 16 * g) ^ ((t & 7) << 4)) + 8 * hi) = w; }
                }
            }
            __syncthreads();
#pragma unroll
            for (int i = 0; i < 8; ++i) { const int idx = tid + 512 * i, s = idx >> 5, cc = idx & 31;
                *(LAS v4u*)(lds + OFF_VIMG + ((s >> 6) * 2 + (cc >> 4)) * 16384 + at::v_st(s & 63, (cc & 15) * 8)) = vr[i]; }
            __syncthreads();
            bf16x8 vfr[8];
            { const unsigned vaddr = (unsigned)(size_t)(lds + OFF_VIMG + (wid >> 2) * 16384) + (unsigned)at::v_rd_base(lane) + (unsigned)((wid & 3) * 512);
              s16x4 vl[8], vh[8];
#define GL_VF(ks8) do { constexpr int o_ = ((ks8) >> 2) * 32768 + ((ks8) & 3) * 4096; GL_TRRD(vl[ks8], vaddr, o_); GL_TRRD(vh[ks8], vaddr, o_ + 2048); } while (0)
              GL_VF(0); GL_VF(1); GL_VF(2); GL_VF(3); GL_VF(4); GL_VF(5); GL_VF(6); GL_VF(7);
#undef GL_VF
              asm volatile("s_waitcnt lgkmcnt(0)" ::: "memory"); AT_SBAR();
#pragma unroll
              for (int q = 0; q < 8; ++q) vfr[q] = (bf16x8){vl[q][0], vl[q][1], vl[q][2], vl[q][3], vh[q][0], vh[q][1], vh[q][2], vh[q][3]};
              AT_SBAR(); }
            bf16* oi = OI + (((size_t)ci * 8 + wid) * 8 * 64 + lane) * 8;
            bf16* dl = DL + (((size_t)ci * 8 + wid) * 8 * 64 + lane) * 8;
            o_intra_tile<0>(lds, vfr, oi, r32, hi); o_intra_tile<1>(lds, vfr, oi, r32, hi); o_intra_tile<2>(lds, vfr, oi, r32, hi); o_intra_tile<3>(lds, vfr, oi, r32, hi);
#pragma unroll
            for (int kt = 0; kt < 4; ++kt) {
                f32x16 D = {};
                const unsigned kaddr = (unsigned)(size_t)(lds + OFF_KLIMG) + (unsigned)at::v_rd_base(lane) + (unsigned)(kt * 512);
                s16x4 kl_[8], kh_[8];
#define GL_KR(ks8) do { constexpr int o_ = ((ks8) >> 2) * 16384 + ((ks8) & 3) * 4096; GL_TRRD(kl_[ks8], kaddr, o_); GL_TRRD(kh_[ks8], kaddr, o_ + 2048); } while (0)
                GL_KR(0); GL_KR(1); GL_KR(2); GL_KR(3); GL_KR(4); GL_KR(5); GL_KR(6); GL_KR(7);
#undef GL_KR
                asm volatile("s_waitcnt lgkmcnt(0)" ::: "memory"); AT_SBAR();
#pragma unroll
                for (int ks8 = 0; ks8 < 8; ++ks8)
                    D = __builtin_amdgcn_mfma_f32_32x32x16_bf16((bf16x8){kl_[ks8][0], kl_[ks8][1], kl_[ks8][2], kl_[ks8][3], kh_[ks8][0], kh_[ks8][1], kh_[ks8][2], kh_[ks8][3]}, vfr[ks8], D, 0, 0, 0);
                AT_SBAR();
                asm volatile("s_nop 15\n\ts_nop 15" : "+v"(D));
#pragma unroll
                for (int hf = 0; hf < 2; ++hf) *(u32x4*)(dl + (size_t)(kt * 2 + hf) * 512) = (u32x4){at::cvtpk(D[8 * hf], D[8 * hf + 1]), at::cvtpk(D[8 * hf + 2], D[8 * hf + 3]), at::cvtpk(D[8 * hf + 4], D[8 * hf + 5]), at::cvtpk(D[8 * hf + 6], D[8 * hf + 7])};
            }
            __syncthreads();
        }
    }
}

__device__ __forceinline__ void gla_stageA_item(LAS unsigned char* lds, const float* DS, const bf16* DL, bf16* XB, int b, int h, int vp) {
    const int tid = otid(), wid = __builtin_amdgcn_readfirstlane(tid >> 6), lane = tid & 63, hi = lane >> 5;
    const int vb = 2 * vp + (wid >> 2), kt = wid & 3;
    constexpr int PF = 8, NC = SEQ / 128;
    f32x16 X = {};
    u32x4 dq[PF][2];
    const size_t ci0 = (size_t)(b * 32) * 4 + h;
    LAS float* dsl = (LAS float*)lds;
#pragma unroll
    for (int i = 0; i < 2; ++i) { const int idx = tid + 512 * i, c = idx >> 5, j = idx & 31; *(LAS v4f*)(dsl + idx * 4) = *(const v4f*)(DS + (ci0 + (size_t)c * 4) * 128 + j * 4); }
    __syncthreads();
#define GL_ALOAD(slot, c_) do { const size_t ci_ = ci0 + (size_t)(c_) * 4; const bf16* dl_ = DL + ((ci_ * 8 + vb) * 8 * 64 + lane) * 8 + (size_t)(kt * 2) * 512; \
        dq[slot][0] = *(const u32x4*)dl_; dq[slot][1] = *(const u32x4*)(dl_ + 512); } while (0)
#pragma unroll
    for (int s = 0; s < PF; ++s) GL_ALOAD(s, s);
    for (int c0 = 0; c0 < NC; c0 += PF) {
#pragma unroll
        for (int s = 0; s < PF; ++s) {
            const int c = c0 + s; const size_t ci = ci0 + (size_t)c * 4;
            bf16* xo = XB + (((ci * 8 + vb) * 8 + kt * 2) * 64 + lane) * 8;
            bf16x8 xb0, xb1; GL_PK4(X, 0, xb0); GL_PK4(X, 8, xb1);
            *(bf16x8*)xo = xb0; *(bf16x8*)(xo + 512) = xb1;
#pragma unroll
            for (int r4 = 0; r4 < 4; ++r4) { const v4f d4 = *(const LAS v4f*)(dsl + c * 128 + 32 * kt + 8 * r4 + 4 * hi); const u32x4 q4 = dq[s][r4 >> 1]; const unsigned wa = (r4 & 1) ? q4.z : q4.x, wb = (r4 & 1) ? q4.w : q4.y;
                X[4 * r4] = X[4 * r4] * d4.x + lo16(wa); X[4 * r4 + 1] = X[4 * r4 + 1] * d4.y + hi16(wa); X[4 * r4 + 2] = X[4 * r4 + 2] * d4.z + lo16(wb); X[4 * r4 + 3] = X[4 * r4 + 3] * d4.w + hi16(wb); }
            if (c + PF < NC) GL_ALOAD(s, c + PF);
        }
    }
#undef GL_ALOAD
    __syncthreads();
}
__device__ __forceinline__ void gla_stageB_item(const bf16* proj, const bf16* QE, const bf16* OI, const bf16* XB, const float* og, bf16* YC, int b, int h, int cp) {
    (void)og;
    const int tid = otid(), wid = __builtin_amdgcn_readfirstlane(tid >> 6), lane = tid & 63, r32 = lane & 31, hi = lane >> 5;
    {
        const int c = 2 * cp + (wid >> 2), tt = wid & 3, R0 = b * SEQ + c * 128;
        const size_t ci = (size_t)(b * 32 + c) * 4 + h;
        f32x16 acc[8];
#pragma unroll
        for (int vb = 0; vb < 8; ++vb) { const bf16* oi = OI + ((ci * 8 + vb) * 8 * 64 + lane) * 8 + (size_t)(tt * 2) * 512;
#pragma unroll
            for (int hf = 0; hf < 2; ++hf) { const u32x4 w = *(const u32x4*)(oi + (size_t)hf * 512);
                acc[vb][8 * hf] = lo16(w.x); acc[vb][8 * hf + 1] = hi16(w.x); acc[vb][8 * hf + 2] = lo16(w.y); acc[vb][8 * hf + 3] = hi16(w.y);
                acc[vb][8 * hf + 4] = lo16(w.z); acc[vb][8 * hf + 5] = hi16(w.z); acc[vb][8 * hf + 6] = lo16(w.w); acc[vb][8 * hf + 7] = hi16(w.w); } }
        bf16x8 qa[8];
        { const bf16* qp = QE + (size_t)(R0 + 32 * tt + r32) * 512 + h * 128 + hi * 8;
#pragma unroll
          for (int ks = 0; ks < 8; ++ks) qa[ks] = *(const bf16x8*)(qp + ks * 16); }
        if (c > 0) {
            const bf16* xi = XB + (((ci * 8) * 8) * 64 + lane) * 8;
            bf16x8 xf[64];
#pragma unroll
            for (int i = 0; i < 64; ++i) xf[i] = *(const bf16x8*)(xi + (size_t)i * 512);
#pragma unroll
            for (int i = 0; i < 64; ++i) acc[i >> 3] = __builtin_amdgcn_mfma_f32_32x32x16_bf16(xf[i], qa[i & 7], acc[i >> 3], 0, 0, 0);
            __builtin_amdgcn_sched_group_barrier(0x020, 16, 0);
#pragma unroll
            for (int i = 0; i < 48; ++i) { __builtin_amdgcn_sched_group_barrier(0x008, 1, 0); __builtin_amdgcn_sched_group_barrier(0x020, 1, 0); }
            __builtin_amdgcn_sched_group_barrier(0x008, 16, 0);
        }
        const size_t row = (size_t)(R0 + 32 * tt + r32);
        at::u32x4 zw[16];
        { const bf16* zp = proj + row * NPROJ + C_ZC + h * 256 + 8 * hi;
#pragma unroll
          for (int i = 0; i < 16; ++i) zw[i] = *(const at::u32x4*)(zp + 16 * i); }
        float s = 0.f;
#pragma unroll
        for (int vb = 0; vb < 8; ++vb)
#pragma unroll
            for (int r = 0; r < 16; ++r) s += acc[vb][r] * acc[vb][r];
        s += lane_xor32(s, lane);
        const float rn = 1.0f / sqrtf(s * (1.0f / 256.f) + EPS);
        bf16* yp = YC + row * 1024 + h * 256 + 8 * hi;
#pragma unroll
        for (int i = 0; i < 16; ++i) { const int vb = i >> 1, j = i & 1;
            auto z0 = __builtin_amdgcn_permlane32_swap(zw[i].x, zw[i].z, false, false); auto z1 = __builtin_amdgcn_permlane32_swap(zw[i].y, zw[i].w, false, false);
            const unsigned z4[4] = {z0[0], z1[0], z0[1], z1[1]};
            unsigned p[4];
#pragma unroll
            for (int k = 0; k < 4; ++k) p[k] = at::cvtpk(acc[vb][8 * j + 2 * k] * rn * lo16(z4[k]), acc[vb][8 * j + 2 * k + 1] * rn * hi16(z4[k]));
            auto s0 = __builtin_amdgcn_permlane32_swap(p[0], p[2], false, false); auto s1 = __builtin_amdgcn_permlane32_swap(p[1], p[3], false, false);
            *(at::u32x4*)(yp + 16 * i) = (at::u32x4){s0[0], s1[0], s0[1], s1[1]}; }
    }
}
#undef GL_PK4
#undef GL_TRRD
}


constexpr int CW_Q = 65536;
__device__ __forceinline__ int q_pop(unsigned* ctr, LAS unsigned* slot) {
    if (otid() == 0) *slot = __hip_atomic_fetch_add(ctr, 1u, __ATOMIC_RELAXED, __HIP_MEMORY_SCOPE_AGENT);
    __syncthreads(); const int v = (int)*slot; __syncthreads(); return v; }
__device__ __forceinline__ void ph_mixers(LAS unsigned char* lds, unsigned char* ws, unsigned* qctr, const float* Ws, const float* bs, const float* vg, const float* og, const float* qg, int row0, int vb, const float* xnext, const float* gnext) {
    constexpr int NGLA = NBP * 8, NATT = 16 * NBP, NSGU = 16 * NBP, NNORM = MP / 64 / 8; const int NQ = NGLA + NATT + NSGU + (xnext ? NNORM : 0);
    static_assert(NBP % 2 == 0, "NBP even");
    LAS unsigned* slot = (LAS unsigned*)(lds + LDSCTL_OFF + 64);
    bf16* proj = (bf16*)(ws + WS_PROJ);
    unsigned live = 0xffu;
    for (int dq = 0; dq < 8; ++dq) {
        const int q = (vb + dq) & 7;
        if (dq == 1) {
            if (otid() < 64) { const int t_ = otid() & 7; const unsigned c_ = __hip_atomic_load(qctr + t_ * 64, __ATOMIC_RELAXED, __HIP_MEMORY_SCOPE_AGENT);
                const unsigned long long b_ = __builtin_amdgcn_ballot_w64(c_ < (unsigned)NQ); if (otid() == 0) *slot = (unsigned)(b_ & 0xffull); }
            __syncthreads(); live = (unsigned)__builtin_amdgcn_readfirstlane((int)*slot); __syncthreads(); }
        if (!((live >> q) & 1u)) continue;
        for (;;) {
            const int idx = q_pop(qctr + q * 64, slot);
            if (idx >= NQ) break;
            if (idx >= NATT && idx < NATT + NGLA) { const int gi = q * NGLA + (idx - NATT), bh = gi >> 4, cp = gi & 15;
                gl::gla_stageB_item(proj, (const bf16*)(ws + WS_QE), (const bf16*)(ws + WS_OC), (const bf16*)(ws + WS_XB), og, (bf16*)(ws + WS_YC), bh >> 2, bh & 3, cp); }
            else if (idx < NATT) { const int j = idx, qb = 15 - j / NBP, bh = q * NBP + j % NBP;
                at::attn_block(lds, (const unsigned char*)(ws + WS_Q), (const unsigned char*)(ws + WS_K), (const unsigned char*)(ws + WS_K) + (size_t)MP * 1536, proj, (bf16*)(ws + WS_YA), qg, (const float*)(ws + WS_COS) + (size_t)row0 * 32, (const float*)(ws + WS_SIN) + (size_t)row0 * 32, bh >> 3, bh & 7, qb); }
            else if (idx < NATT + NGLA + NSGU) { const int it = q * NSGU + (idx - NGLA - NATT);
                sg::sgu_item(lds, proj, (const float*)(ws + WS_SSQ) + 2 * MP, Ws, bs, vg, (bf16*)(ws + WS_YB), it); }
            else { const size_t ro = (size_t)(q * NNORM + (idx - NATT - NGLA - NSGU)) * 64 * DM;
                ph_norm(xnext + ro, gnext, (bf16*)(ws + WS_HN) + ro, ws + WS_H8 + ro, 64, 0, 1); }
        }
    }
}
#ifndef GEMM_SP2
#define GEMM_SP2 true
#endif
#ifndef GEMM_ALIGN
#define GEMM_ALIGN true
#endif
typedef const __attribute__((address_space(4))) Args* KArgP;
#define KARG() ({ KArgP p_ = (KArgP)__builtin_amdgcn_kernarg_segment_ptr(); asm volatile("" : "+s"(p_)); p_; })
#define INF(i) ((const float*)ap->in[i])
__device__ __forceinline__ void grid_bar(const XcdBarrier& b0) { XcdBarrier b = b0; asm volatile("" : "+s"(b.bar)); xcd_barrier(b); }

__global__ void __launch_bounds__(512, 2) fwd(Args a) {
    extern __shared__ __attribute__((aligned(16))) unsigned char lds_raw[];
    LAS unsigned char* lds = (LAS unsigned char*)lds_raw;
    const int lo = a.lo, hi = a.hi;
    XcdBarrier bar; bar.bar = (unsigned*)(a.ws + WS_CTL) + CW_BAR; bar.x = 0; bar.st = nullptr;
    if (hi - lo > 1) {
        if (threadIdx.x < 4) ((LAS unsigned*)(lds + LDSCTL_OFF))[threadIdx.x] = 0u;
        __syncthreads();
        bar = xcd_barrier_post((unsigned*)(a.ws + WS_CTL) + CW_BAR, (volatile LAS unsigned*)(lds + LDSCTL_OFF));
    }
    int step = 0;
#define PH_BEGIN if (step >= lo && step < hi) { const KArgP ap = KARG(); unsigned char* const ws = ap->ws; const int vb = obid(), nvb = gridDim.x; (void)ws; (void)vb; (void)nvb;
#define PH_END   if (step + 1 < hi) grid_bar(bar); } ++step;
#define WL(l) (ws + WS_W + (size_t)(l) * SZ_WLAYER)
#define B_(T, off) ((T*)(ws + (off)))

    for (int l = 0; l < DEPTH; ++l) {
        for (int p = 0; p < NPASS; ++p) {
            const int row0 = p * MP;
#define XIN ((l == 0 ? (const float*)ap->in[0] : (const float*)ap->out) + (size_t)row0 * DM)
#define WLP (ws + WS_W)
            if (p != 0) { ++step; } else {
            PH_BEGIN if (p == 0) {
            { unsigned char* wl = ws + WS_W;
              convert_T<1>(INF(3) + (size_t)l * DM * IN_COLS, DM, IN_COLS, (bf16*)wl, NBF, (LAS float*)lds, vb, nvb);
              convert_T8<2>(INF(3) + (size_t)l * DM * IN_COLS, DM, IN_COLS, wl + SZ_WINB, NF8, 64.0f, (LAS float*)lds, (vb + 96) % nvb, nvb);
              convert_T8<0>(INF(6) + (size_t)l * 512 * 1536, 512, 1536, wl + SZ_WIN, 1536, 64.0f, (LAS float*)lds, (vb + 64) % nvb, nvb, INF(4) + l * 512);
              convert_T8<0>(INF(7) + (size_t)l * 512 * 2048, 512, 2048, wl + SZ_WIN + SZ_WUQ, 2048, 64.0f, (LAS float*)lds, (vb + 128) % nvb, nvb, INF(5) + l * 512);
              convert_T8<0>(INF(16) + ((size_t)l * 3) * 1024 * 2048, 1024, 2048, wl + SZ_WIN + SZ_WUQ + SZ_WUKV, 2048, 32.0f, (LAS float*)lds, vb, nvb);
              for (int b = 1; b < 3; ++b)
                  convert_T<0>(INF(16) + ((size_t)l * 3 + b) * 1024 * 2048, 1024, 2048, (bf16*)(wl + SZ_WIN + SZ_WUQ + SZ_WUKV) + (size_t)b * 2048 * 1024, 2048, (LAS float*)lds, (vb + 32 * b) % nvb, nvb, b == 2 ? INF(15) + l * 256 : nullptr, 255);
              convert_T<0>(INF(17) + (size_t)l * 2048 * 2048, 2048, 2048, (bf16*)(wl + SZ_WIN + SZ_WUQ + SZ_WUKV + SZ_WB), 2048, (LAS float*)lds, (vb + 192) % nvb, nvb); }
            if (l == 0) { const int* positions = (const int*)ap->in[1]; float* cosT = B_(float, WS_COS); float* sinT = B_(float, WS_SIN);
              for (int idx = vb * 512 + otid(); idx < MTOK * 32; idx += nvb * 512) {
                const int t = idx >> 5, i = idx & 31;
                const float inv = 1.0f / powf(10000.0f, (float)(2 * i) * (1.0f / 64.0f));
                const float ang = (float)positions[t] * inv;
                float sn, cs; sincosf(ang, &sn, &cs);
                cosT[idx] = cs; sinT[idx] = sn; } }
            }
                     if (l == 0 && p == 0) { ph_norm(XIN, INF(2) + l * DM, B_(bf16, WS_HN), B_(unsigned char, WS_H8), MP, vb, nvb);
                       float* ssq = B_(float, WS_SSQ); for (int i = vb * 512 + otid(); i < 3 * MP; i += nvb * 512) ssq[i] = 0.f; } PH_END }
            PH_BEGIN { { pg8::Gemm g{B_(bf16, WS_HN), (const bf16*)WLP, MP, NBF, DM}; pg8::StaticOrder S; S.init(MP, NBF, nvb, vb); pg8::EpiProj E{B_(bf16, WS_PROJ), NPROJ, B_(float, WS_SSQ), MP, 0, B_(unsigned char, WS_YC)};
                         pg8::gemm_phase<pg8::EpiProj, pg8::StaticOrder, false, GEMM_ALIGN, GEMM_SP2>(lds, g, S, E, nullptr); }
                       { pg8::Gemm g{(const bf16*)B_(unsigned char, WS_H8), (const bf16*)(WLP + SZ_WINB), MP, NF8, DM / 2}; pg8::StaticOrder S; S.init(MP, NF8, nvb, vb);
                         { const int ub = (MP / 256) * (NBF / 256), u8 = (MP / 256) * (NF8 / 256), sk = ub % nvb;
                           if (sk > 0 && sk < nvb) { S.skip = sk; S.full = (u8 - 2 * (nvb - sk)) / nvb; if (S.full < 0) S.full = 0; } }
                         pg8::EpiProj E{B_(bf16, WS_PROJ) + NBF, NPROJ, B_(float, WS_SSQ), MP, NBF / 256, B_(unsigned char, WS_YC)};
                         pg8::gemm_phase<pg8::EpiProj, pg8::StaticOrder, false, GEMM_ALIGN, GEMM_SP2, true>(lds, g, S, E, nullptr); } } PH_END
            PH_BEGIN { { pg8::Gemm g{(const bf16*)B_(unsigned char, WS_YC), (const bf16*)(WLP + SZ_WIN), MP, 1536, 256, 0, 0x79797979, 0x7b7b7b7b};   pg8::StaticOrder S; S.init(MP, 1536, nvb, vb); pg8::EpiF8Row E{B_(unsigned char, WS_Q), 1536, B_(float, WS_SSQ), 1.0f / 512.f, EPS};
                         pg8::gemm_phase<pg8::EpiF8Row, pg8::StaticOrder, false, GEMM_ALIGN, GEMM_SP2, true>(lds, g, S, E, nullptr); }
                       { pg8::Gemm g{(const bf16*)(B_(unsigned char, WS_YC) + (size_t)MP * 512), (const bf16*)(WLP + SZ_WIN + SZ_WUQ), MP, 2048, 256, 0, 0x79797979, 0x7b7b7b7b}; pg8::StaticOrder S; S.init(MP, 2048, nvb, nvb - 1 - vb); pg8::EpiF8Row E{B_(unsigned char, WS_KV), 2048, B_(float, WS_SSQ) + MP, 1.0f / 512.f, EPS};
                         pg8::gemm_phase<pg8::EpiF8Row, pg8::StaticOrder, false, GEMM_ALIGN, GEMM_SP2, true>(lds, g, S, E, nullptr); }
                       for (int ci = vb; ci < (MP / 128) * 4; ci += nvb) {
                           gl::gla_prep_item(lds, 135168, B_(bf16, WS_PROJ), INF(13) + l * 16 * 512, INF(14) + l * 512, B_(bf16, WS_QE), B_(bf16, WS_KE), B_(bf16, WS_KL), B_(float, WS_DS), ci);
                           gl::gla_chunk_item(lds, B_(bf16, WS_PROJ), B_(bf16, WS_QE), B_(bf16, WS_KE), B_(bf16, WS_KL), B_(bf16, WS_OC), B_(bf16, WS_DL), ci); } } PH_END
            PH_BEGIN { constexpr int NA = NBP * 16;
                       if (nvb > 2 * NA) { if (vb < NA) { gl::gla_stageA_item(lds, B_(float, WS_DS), B_(bf16, WS_DL), B_(bf16, WS_XB), vb >> 4, (vb >> 2) & 3, vb & 3); ph_vt8(B_(unsigned char, WS_KV), B_(unsigned char, WS_K) + (size_t)MP * 1536, nvb - 1 - vb, nvb); }
                                           else { ph_kfin(B_(unsigned char, WS_KV), B_(bf16, WS_PROJ), B_(unsigned char, WS_K), INF(9) + l * 192, B_(float, WS_COS), B_(float, WS_SIN), row0, vb - NA, nvb - NA); ph_vt8(B_(unsigned char, WS_KV), B_(unsigned char, WS_K) + (size_t)MP * 1536, nvb - 1 - vb, nvb); } }
                       else { for (int it = vb; it < NA; it += nvb) gl::gla_stageA_item(lds, B_(float, WS_DS), B_(bf16, WS_DL), B_(bf16, WS_XB), it >> 4, (it >> 2) & 3, it & 3);
                              ph_kfin(B_(unsigned char, WS_KV), B_(bf16, WS_PROJ), B_(unsigned char, WS_K), INF(9) + l * 192, B_(float, WS_COS), B_(float, WS_SIN), row0, vb, nvb); ph_vt8(B_(unsigned char, WS_KV), B_(unsigned char, WS_K) + (size_t)MP * 1536, vb, nvb); } } PH_END
            PH_BEGIN ph_mixers(lds, ws, (unsigned*)(ws + WS_CTL) + CW_Q + (l * NPASS + p) * 8 * 64, INF(11) + (size_t)l * 8 * 128 * 128, INF(12) + l * 8 * 128, INF(10) + l * 1024, INF(15) + l * 256, INF(8) + l * 192, row0, vb,
                                (p + 1 < NPASS) ? XIN + (size_t)MP * DM : ((l + 1 < DEPTH) ? (const float*)ap->out : (const float*)nullptr), INF(2) + ((p + 1 < NPASS) ? l : l + 1) * DM); PH_END
            PH_BEGIN { { pg8::Gemm g{B_(bf16, WS_YA), (const bf16*)(WLP + SZ_WIN + SZ_WUQ + SZ_WUKV), MP, 2048, 512, 0, 0x7a7a7a7a, 0x7b7b7b7b};
                         pg8::StaticOrder S; S.init(MP, 2048, nvb, vb);
                         pg8::EpiMerge E{(const unsigned char*)(B_(bf16, WS_PROJ) + C_GATE), NPROJ * 2, B_(bf16, WS_MG), 2048, 2048, 0}; pg8::gemm_phase<pg8::EpiMerge, pg8::StaticOrder, false, GEMM_ALIGN, GEMM_SP2, true>(lds, g, S, E, nullptr); }
                       { pg8::Gemm g{B_(bf16, WS_YB), (const bf16*)(WLP + SZ_WIN + SZ_WUQ + SZ_WUKV) + (size_t)2048 * 1024, MP, 2048, 1024};
                         pg8::BranchOrder S; S.init(MP, 2048, nvb, vb); S.NB = 2; S.a_stride = (size_t)MP * 1024 * 2; S.b_stride = (size_t)2048 * 1024 * 2;
                         pg8::EpiMerge E{(const unsigned char*)(B_(bf16, WS_PROJ) + C_GATE), NPROJ * 2, B_(bf16, WS_MG), 2048, 2048, 1, 1}; pg8::gemm_phase<pg8::EpiMerge, pg8::BranchOrder, false, GEMM_ALIGN, GEMM_SP2>(lds, g, S, E, nullptr); } } PH_END
            PH_BEGIN { pg8::Gemm g{B_(bf16, WS_MG), (const bf16*)(WLP + SZ_WIN + SZ_WUQ + SZ_WUKV + SZ_WB), MP, 2048, 2048}; pg8::StaticOrder S; S.init(MP, 2048, nvb, vb); pg8::EpiRes E{XIN, ap->out + (size_t)row0 * DM, 2048};
                       pg8::gemm_phase<pg8::EpiRes, pg8::StaticOrder, false, GEMM_ALIGN, GEMM_SP2>(lds, g, S, E, nullptr);
                       float* ssq = B_(float, WS_SSQ); for (int i = vb * 512 + otid(); i < 3 * MP; i += nvb * 512) ssq[i] = 0.f; } PH_END
        }
    }
#undef PH_BEGIN
#undef PH_END
}

#ifndef ONE_LAUNCH
#define ONE_LAUNCH 1
#endif
extern "C" void kernel_launch(void* const* d_in, const int* in_sizes, int n_in, void* d_out, int out_size, void* d_ws, size_t ws_size, hipStream_t stream) {
    static int grid = 0;
    if (grid == 0) {
        if (n_in != 18 || out_size != MTOK * DM || ws_size < WS_END) { fprintf(stderr, "kernel_launch: unexpected shapes (n_in %d out %d ws %zu need %zu)\n", n_in, out_size, ws_size, (size_t)WS_END); grid = -1; return; }
        int dev = 0, cus = 0, per_cu = 0;
        if (hipGetDevice(&dev) != hipSuccess || hipDeviceGetAttribute(&cus, hipDeviceAttributeMultiprocessorCount, dev) != hipSuccess) { grid = -1; return; }
        if (hipFuncSetAttribute((const void*)fwd, hipFuncAttributeMaxDynamicSharedMemorySize, LDS_BYTES) != hipSuccess) { fprintf(stderr, "kernel_launch: hipFuncSetAttribute failed\n"); grid = -1; return; }
        if (hipOccupancyMaxActiveBlocksPerMultiprocessor(&per_cu, (const void*)fwd, 512, LDS_BYTES) != hipSuccess || per_cu < 1) { fprintf(stderr, "kernel_launch: occupancy query says %d\n", per_cu); }
        (void)hipGetLastError();
        grid = cus;
    }
    if (grid < 0) return;
    (void)hipMemsetAsync((char*)d_ws + WS_CTL, 0, CTL_BYTES, stream);
    Args a{};
    for (int i = 0; i < 18; ++i) a.in[i] = d_in[i];
    a.out = (float*)d_out; a.ws = (unsigned char*)d_ws; a.pad0 = 0; a.pad1 = 0;
#if ONE_LAUNCH
    a.lo = 0; a.hi = NSTEPS;
    hipLaunchKernelGGL(fwd, dim3(grid), dim3(512), LDS_BYTES, stream, a);
#else
    for (int s = 0; s < NSTEPS; ++s) { a.lo = s; a.hi = s + 1; hipLaunchKernelGGL(fwd, dim3(grid), dim3(512), LDS_BYTES, stream, a); }
#endif
}
```
